# Optimizing an MI355X kernel written in HIP

```python
import math
import jax
import jax.numpy as jnp
from jax import lax
import numpy as np

D_MODEL = 1024
BATCH = 4
SEQ = 8192
DEPTH = 1

GRID_W = 64
CTX_LEN = 256
N_MOD = 6
NORM_EPS = 1e-6
FOURIER_GROUPS = 4
FOURIER_GROUP_DIM = 64
FOURIER_WIDTH = FOURIER_GROUPS * FOURIER_GROUP_DIM
DIFF_HEADS = 6
DIFF_HEAD_DIM = 64
DIFF_VALUE_DIM = 2 * DIFF_HEAD_DIM
DIFF_QK_WIDTH = DIFF_HEADS * 2 * DIFF_HEAD_DIM
DIFF_V_WIDTH = DIFF_HEADS * DIFF_VALUE_DIM
IN_WIDTH = FOURIER_WIDTH + 2 * DIFF_QK_WIDTH + DIFF_V_WIDTH
MIX_WIDTH = FOURIER_WIDTH + DIFF_V_WIDTH
QUERY_BLOCK = 128
ROPE_BASE = 10000.0
ROPE_AXIS_DIM = DIFF_HEAD_DIM // 2
N_EXPERTS = 64
TOP_K = 8
N_EXPERT_GROUPS = 8
TOP_K_GROUPS = 4
D_EXPERT = 256
ROUTED_SCALE = 2.5
EXPERT_BLOCK = 128

kernel_name = "hybrid_fourier_diffattn_moe_dit"


def rms_norm(x, g):
    xf = x.astype(jnp.float32)
    y = xf * lax.rsqrt(jnp.mean(xf * xf, axis=-1, keepdims=True) + NORM_EPS)
    return (y * g.astype(jnp.float32)).astype(x.dtype)


def modulate(h, shift, scale):
    return h * (1 + scale) + shift


def ada_params(cond, w_mod, b_mod):
    m = jax.nn.silu(cond) @ w_mod + b_mod
    return m.reshape(cond.shape[:-1] + (N_MOD, D_MODEL))


def axial_rope_tables(n_tokens):
    rows = n_tokens // GRID_W
    row = jnp.broadcast_to(jnp.arange(rows)[:, None], (rows, GRID_W)).reshape(-1)
    col = jnp.broadcast_to(jnp.arange(GRID_W)[None, :], (rows, GRID_W)).reshape(-1)
    inv_freq = ROPE_BASE ** (-jnp.arange(0, ROPE_AXIS_DIM, 2, dtype=jnp.float32) / ROPE_AXIS_DIM)
    pos = jnp.stack([row, col], axis=-1).astype(jnp.float32)
    ang = pos[:, :, None] * inv_freq
    return jnp.cos(ang), jnp.sin(ang)


def apply_axial_rope(t, cos, sin):
    xf = t.astype(jnp.float32).reshape(t.shape[:-1] + (2, 2, ROPE_AXIS_DIM // 2))
    x1 = xf[..., 0, :]
    x2 = xf[..., 1, :]
    cb = cos[None, :, None, None]
    sb = sin[None, :, None, None]
    out = jnp.stack([x1 * cb - x2 * sb, x2 * cb + x1 * sb], axis=-2)
    return out.reshape(t.shape).astype(t.dtype)


def split_groups(p):
    b, n, _ = p.shape
    o1 = FOURIER_WIDTH
    o2 = o1 + DIFF_QK_WIDTH
    o3 = o2 + DIFF_QK_WIDTH
    f = p[..., :o1]
    q = p[..., o1:o2].reshape(b, n, DIFF_HEADS, 2, DIFF_HEAD_DIM)
    k = p[..., o2:o3].reshape(b, n, DIFF_HEADS, 2, DIFF_HEAD_DIM)
    v = p[..., o3:].reshape(b, n, DIFF_HEADS, DIFF_VALUE_DIM)
    return f, q, k, v


def fourier_mix(f, w_fourier):
    b, n, _ = f.shape
    fg = f.astype(jnp.float32).reshape(b, n, FOURIER_GROUPS, FOURIER_GROUP_DIM)
    spec = jnp.fft.fft2(fg, axes=(1, 3), norm="ortho").real.astype(f.dtype)
    out = jnp.einsum("bngc,gcd->bngd", spec, w_fourier)
    return out.reshape(b, n, FOURIER_WIDTH)


def diff_attn_block(q, k, v, lam):
    s = jnp.einsum("bqhmd,bkhmd->bhmqk", q, k).astype(jnp.float32) * (DIFF_HEAD_DIM ** -0.5)
    p = jax.nn.softmax(s, axis=-1)
    a = p[:, :, 0] - lam * p[:, :, 1]
    return jnp.einsum("bhqk,bkhe->bqhe", a.astype(v.dtype), v)


def latent_diff_attention(qx, kx, vx, kc, vc, lam):
    b, n = qx.shape[:2]
    n_blocks = n // QUERY_BLOCK
    k_all = jnp.concatenate([kc, kx], axis=1)
    v_all = jnp.concatenate([vc, vx], axis=1)
    qb = qx.reshape(b, n_blocks, QUERY_BLOCK, DIFF_HEADS, 2, DIFF_HEAD_DIM).transpose(1, 0, 2, 3, 4, 5)
    o = lax.map(lambda q_blk: diff_attn_block(q_blk, k_all, v_all, lam), qb)
    return o.transpose(1, 0, 2, 3, 4).reshape(b, n, DIFF_HEADS, DIFF_VALUE_DIM)


def diff_subln(o, g, lam_init):
    b, n = o.shape[:2]
    return (rms_norm(o, g) * (1.0 - lam_init)).reshape(b, n, DIFF_V_WIDTH)


def swiglu(h, w_gate, w_up, w_down):
    return (jax.nn.silu(h @ w_gate) * (h @ w_up)) @ w_down


def moe_ffn(h, w_router, router_bias, w_gate, w_up, w_down, ws_gate, ws_up, ws_down):
    b, n, d = h.shape
    ht = h.reshape(b * n, d)
    n_tok = b * n
    scores = jax.nn.sigmoid((ht @ w_router).astype(jnp.float32))
    sel = scores + router_bias.astype(jnp.float32)
    grouped = sel.reshape(n_tok, N_EXPERT_GROUPS, N_EXPERTS // N_EXPERT_GROUPS)
    group_score = lax.top_k(grouped, 2)[0].sum(-1)
    gidx = lax.top_k(group_score, TOP_K_GROUPS)[1]
    group_mask = jnp.any(gidx[..., None] == jnp.arange(N_EXPERT_GROUPS), axis=-2)
    expert_mask = jnp.repeat(group_mask, N_EXPERTS // N_EXPERT_GROUPS, axis=-1)
    _, idx = lax.top_k(jnp.where(expert_mask, sel, -jnp.inf), TOP_K)
    wts = jnp.take_along_axis(scores, idx, axis=-1)
    wts = wts / (wts.sum(-1, keepdims=True) + 1e-20) * ROUTED_SCALE
    n_assign = n_tok * TOP_K
    n_blocks = -(-n_assign // EXPERT_BLOCK) + N_EXPERTS
    n_slots = n_blocks * EXPERT_BLOCK
    flat_e = idx.reshape(-1)
    flat_w = wts.reshape(-1).astype(h.dtype)
    flat_tok = jnp.arange(n_assign, dtype=jnp.int32) // TOP_K
    order = jnp.argsort(flat_e)
    e_sorted = flat_e[order]
    counts = jnp.zeros((N_EXPERTS,), jnp.int32).at[flat_e].add(1)
    start = jnp.cumsum(counts) - counts
    padded = (counts + EXPERT_BLOCK - 1) // EXPERT_BLOCK * EXPERT_BLOCK
    pad_end = jnp.cumsum(padded)
    pad_start = pad_end - padded
    dest = pad_start[e_sorted] + (jnp.arange(n_assign, dtype=jnp.int32) - start[e_sorted])
    slot_tok = jnp.full((n_slots,), n_tok, jnp.int32).at[dest].set(flat_tok[order])
    slot_w = jnp.zeros((n_slots,), h.dtype).at[dest].set(flat_w[order])
    block_expert = jnp.minimum(
        jnp.searchsorted(pad_end, jnp.arange(n_blocks, dtype=jnp.int32) * EXPERT_BLOCK, side="right"),
        N_EXPERTS - 1)
    h_pad = jnp.concatenate([ht, jnp.zeros((1, d), h.dtype)], axis=0)

    def expert_block(args):
        tok, w, e = args
        xb = h_pad[tok]
        return swiglu(xb, w_gate[e], w_up[e], w_down[e]) * w[:, None]

    y = lax.map(expert_block, (slot_tok.reshape(n_blocks, EXPERT_BLOCK),
                               slot_w.reshape(n_blocks, EXPERT_BLOCK), block_expert))
    routed = jnp.zeros((n_tok + 1, d), h.dtype).at[slot_tok].add(y.reshape(n_slots, d))[:n_tok]
    shared = swiglu(ht, ws_gate, ws_up, ws_down)
    return (routed + shared).reshape(b, n, d)


def setup_inputs(seed: int = 0) -> dict:
    key = jax.random.key(seed)
    ks = jax.random.split(key, 26)

    def nrm(k, shape, scale):
        return jax.random.normal(k, shape, jnp.float32) * scale

    def gain(k, shape):
        return 1.0 + 0.1 * jax.random.normal(k, shape, jnp.float32)

    d = D_MODEL
    return {
        "x": nrm(ks[0], (BATCH, SEQ, d), 1.0),
        "c": nrm(ks[1], (BATCH, d), 1.0),
        "ctx": nrm(ks[2], (BATCH, CTX_LEN, d), 1.0),
        "c_ctx": nrm(ks[3], (d,), 1.0),
        "w_mod": nrm(ks[4], (DEPTH, d, N_MOD * d), d ** -0.5),
        "b_mod": nrm(ks[5], (DEPTH, N_MOD * d), 0.02),
        "g_attn_pre": gain(ks[6], (DEPTH, d)),
        "g_attn_post": gain(ks[7], (DEPTH, d)),
        "w_in": nrm(ks[8], (DEPTH, d, IN_WIDTH), d ** -0.5),
        "w_fourier": nrm(ks[9], (DEPTH, FOURIER_GROUPS, FOURIER_GROUP_DIM, FOURIER_GROUP_DIM), FOURIER_GROUP_DIM ** -0.5),
        "lambda_q1": nrm(ks[10], (DEPTH, DIFF_HEAD_DIM), 0.1),
        "lambda_k1": nrm(ks[11], (DEPTH, DIFF_HEAD_DIM), 0.1),
        "lambda_q2": nrm(ks[12], (DEPTH, DIFF_HEAD_DIM), 0.1),
        "lambda_k2": nrm(ks[13], (DEPTH, DIFF_HEAD_DIM), 0.1),
        "g_subln": gain(ks[14], (DEPTH, DIFF_VALUE_DIM)),
        "w_out": nrm(ks[15], (DEPTH, MIX_WIDTH, d), MIX_WIDTH ** -0.5),
        "g_ffn_pre": gain(ks[16], (DEPTH, d)),
        "g_ffn_post": gain(ks[17], (DEPTH, d)),
        "w_router": nrm(ks[18], (DEPTH, d, N_EXPERTS), d ** -0.5),
        "router_bias": nrm(ks[19], (DEPTH, N_EXPERTS), 0.01),
        "w_gate": nrm(ks[20], (DEPTH, N_EXPERTS, d, D_EXPERT), d ** -0.5),
        "w_up": nrm(ks[21], (DEPTH, N_EXPERTS, d, D_EXPERT), d ** -0.5),
        "w_down": nrm(ks[22], (DEPTH, N_EXPERTS, D_EXPERT, d), D_EXPERT ** -0.5),
        "ws_gate": nrm(ks[23], (DEPTH, d, D_EXPERT), d ** -0.5),
        "ws_up": nrm(ks[24], (DEPTH, d, D_EXPERT), d ** -0.5),
        "ws_down": nrm(ks[25], (DEPTH, D_EXPERT, d), D_EXPERT ** -0.5),
    }


def reference(x, c, ctx, c_ctx, w_mod, b_mod, g_attn_pre, g_attn_post, w_in, w_fourier,
              lambda_q1, lambda_k1, lambda_q2, lambda_k2, g_subln, w_out, g_ffn_pre, g_ffn_post,
              w_router, router_bias, w_gate, w_up, w_down, ws_gate, ws_up, ws_down):
    n_lat = x.shape[1]
    cos, sin = axial_rope_tables(n_lat)
    for l in range(DEPTH):
        last = l == DEPTH - 1
        lam_init = 0.8 - 0.6 * math.exp(-0.3 * l)
        lam = (jnp.exp(jnp.sum(lambda_q1[l].astype(jnp.float32) * lambda_k1[l].astype(jnp.float32)))
               - jnp.exp(jnp.sum(lambda_q2[l].astype(jnp.float32) * lambda_k2[l].astype(jnp.float32)))
               + lam_init)
        mx = ada_params(c, w_mod[l], b_mod[l])[:, None]
        mc = ada_params(c_ctx, w_mod[l], b_mod[l])

        hx = modulate(rms_norm(x, g_attn_pre[l]), mx[..., 0, :], mx[..., 1, :])
        hc = modulate(rms_norm(ctx, g_attn_pre[l]), mc[..., 0, :], mc[..., 1, :])
        fx, qx, kx, vx = split_groups(hx @ w_in[l])
        fc, qc, kc, vc = split_groups(hc @ w_in[l])
        qx = apply_axial_rope(qx, cos, sin)
        kx = apply_axial_rope(kx, cos, sin)
        ox = latent_diff_attention(qx, kx, vx, kc, vc, lam)
        yx = jnp.concatenate([fourier_mix(fx, w_fourier[l]), diff_subln(ox, g_subln[l], lam_init)], axis=-1) @ w_out[l]
        x = x + mx[..., 2, :] * rms_norm(yx, g_attn_post[l])
        if not last:
            oc = diff_attn_block(qc, kc, vc, lam)
            yc = jnp.concatenate([fourier_mix(fc, w_fourier[l]), diff_subln(oc, g_subln[l], lam_init)], axis=-1) @ w_out[l]
            ctx = ctx + mc[..., 2, :] * rms_norm(yc, g_attn_post[l])

        moe_args = (w_router[l], router_bias[l], w_gate[l], w_up[l], w_down[l], ws_gate[l], ws_up[l], ws_down[l])
        hx = modulate(rms_norm(x, g_ffn_pre[l]), mx[..., 3, :], mx[..., 4, :])
        x = x + mx[..., 5, :] * rms_norm(moe_ffn(hx, *moe_args), g_ffn_post[l])
        if not last:
            hc = modulate(rms_norm(ctx, g_ffn_pre[l]), mc[..., 3, :], mc[..., 4, :])
            ctx = ctx + mc[..., 5, :] * rms_norm(moe_ffn(hc, *moe_args), g_ffn_post[l])
    return x
```

```cpp
#include <hip/hip_runtime.h>
#include <cstdio>
#include <cstdint>

typedef unsigned short bf16_t;
typedef float f32x4 __attribute__((ext_vector_type(4)));

constexpr int D = 1024, BATCH = 4, SEQ = 8192, T = BATCH * SEQ, CTX = 256, TC = BATCH * CTX;
constexpr int MTOT = T + TC;
constexpr int KVLEN = CTX + SEQ;
constexpr int INW = 2560, NH = 6, QKW = 768, FW = 256;
constexpr int NE = 64, DE = 256, TOPK = 8;
constexpr int NT = 512, NWV = 8;
constexpr int SLOTS_B = 90112;
constexpr float EPS = 1e-6f;
constexpr float LAM_INIT = 0.2f;

constexpr size_t MiB = 1u << 20;
constexpr size_t WS_CTL = 0;
constexpr size_t WS_MOD = 1 * MiB;
constexpr size_t WS_TABW = WS_MOD + 128 * 1024;
constexpr size_t WS_ROPE = WS_MOD + 192 * 1024;
constexpr size_t WS_GCS = WS_MOD + 256 * 1024;
constexpr size_t WS_TE = 107 * MiB;
constexpr size_t WS_TP = 108 * MiB;
constexpr size_t WS_TW = 109 * MiB;
constexpr size_t WS_TOKL = 110 * MiB;
constexpr size_t WS_AO = 118 * MiB;
constexpr size_t WS_ACT = 118 * MiB;
constexpr size_t WS_Q = 182 * MiB;
constexpr size_t WS_K = 230 * MiB;
constexpr size_t WS_V = WS_K + (size_t)BATCH * KVLEN * QKW * 2;
constexpr size_t WS_F = 329 * MiB;
constexpr size_t WS_FY = 361 * MiB;
constexpr size_t WS_HX = 425 * MiB;
constexpr size_t WS_YX = 358 * MiB;
constexpr size_t WS_H2 = 294 * MiB;
constexpr size_t WS_Y = 294 * MiB;
constexpr size_t WS_END = 491 * MiB;

struct Params {
    const float* in[26];
    float* out;
    unsigned char* ws;
    int chunk;
    int pad;
};
enum { I_X = 0, I_C, I_CTX, I_CCTX, I_WMOD, I_BMOD, I_GAPRE, I_GAPOST, I_WIN, I_WF, I_LQ1, I_LK1, I_LQ2, I_LK2, I_GSUB, I_WOUT,
       I_GFPRE, I_GFPOST, I_WR, I_RB, I_WG, I_WU, I_WD, I_WSG, I_WSU, I_WSD };

__device__ __forceinline__ float bf2f(bf16_t v) { return __uint_as_float(((unsigned)v) << 16); }
__device__ __forceinline__ bf16_t f2bf(float f) { unsigned u = __float_as_uint(f); return (bf16_t)((u + 0x7fffu + ((u >> 16) & 1u)) >> 16); }
__device__ __forceinline__ unsigned pk2(float lo, float hi) { return (unsigned)f2bf(lo) | ((unsigned)f2bf(hi) << 16); }
__device__ __forceinline__ float wave_sum(float v) {
#pragma unroll
    for (int o = 1; o < 64; o <<= 1) v += __shfl_xor(v, o);
    return v;
}
__device__ __forceinline__ float silu_f(float x) { return x / (1.f + expf(-x)); }

__device__ __forceinline__ void ph_prep(const Params& p, float* lds) {
    const int tid = threadIdx.x, bid = blockIdx.x, nblk = gridDim.x;
    const int gt = bid * NT + tid, GT = nblk * NT;
    unsigned char* ws = p.ws;
    float2* tabw = (float2*)(ws + WS_TABW);
    for (int i = gt; i < 8192; i += GT) { float s, c; sincospif((float)i * (1.0f / 4096.0f), &s, &c); tabw[i] = make_float2(c, s); }
    float* rope = (float*)(ws + WS_ROPE);
    for (int i = gt; i < 192 * 16; i += GT) {
        const int pos = (i < 2048) ? (i >> 4) : ((i - 2048) >> 4); const int f = i & 15;
        const float inv = powf(10000.0f, -(float)(2 * f) / 32.0f); const float ang = (float)pos * inv;
        const float c = cosf(ang), s = sinf(ang);
        if (i < 2048) { rope[i] = c; rope[2048 + i] = s; } else { rope[4096 + (i - 2048)] = c; rope[4096 + 1024 + (i - 2048)] = s; }
    }
    float* gcs = (float*)(ws + WS_GCS);
    const float* wf = p.in[I_WF];
    for (int i = gt; i < 4 * 64 * 64; i += GT) {
        const int g = i >> 12, c = (i >> 6) & 63, d = i & 63;
        float ac = 0.f, as = 0.f;
        for (int j = 0; j < 64; ++j) { float s, co; sincospif((float)((c * j) & 63) * (1.0f / 32.0f), &s, &co); const float w = wf[(g * 64 + j) * 64 + d]; ac += co * w; as += s * w; }
        const float scl = 0.0013810679320049757f;
        gcs[i] = ac * scl; gcs[16384 + i] = as * scl;
    }
    if (gt == 0) {
        float s1 = 0.f, s2 = 0.f;
        for (int i = 0; i < 64; ++i) { s1 += p.in[I_LQ1][i] * p.in[I_LK1][i]; s2 += p.in[I_LQ2][i] * p.in[I_LK2][i]; }
        ((float*)(ws + WS_CTL))[1024] = expf(s1) - expf(s2) + LAM_INIT;
    }
    float* sc = lds;
    float* red = lds + 5 * 1024;
    for (int i = tid; i < 5 * 1024; i += NT) { const int r = i >> 10, k = i & 1023; const float v = (r < 4) ? p.in[I_C][r * 1024 + k] : p.in[I_CCTX][k]; sc[i] = silu_f(v); }
    __syncthreads();
    const int wave = tid >> 6, lane = tid & 63;
    float* mod = (float*)(ws + WS_MOD);
    for (int task = bid; task < 96; task += nblk) {
        const int col = task * 64 + lane;
        float a0 = 0, a1 = 0, a2 = 0, a3 = 0, a4 = 0;
        const float* wm = p.in[I_WMOD];
#pragma unroll 8
        for (int k = wave * 128; k < wave * 128 + 128; ++k) { const float w = wm[(size_t)k * 6144 + col]; a0 += sc[k] * w; a1 += sc[1024 + k] * w; a2 += sc[2048 + k] * w; a3 += sc[3072 + k] * w; a4 += sc[4096 + k] * w; }
        red[(wave * 5 + 0) * 64 + lane] = a0; red[(wave * 5 + 1) * 64 + lane] = a1; red[(wave * 5 + 2) * 64 + lane] = a2; red[(wave * 5 + 3) * 64 + lane] = a3; red[(wave * 5 + 4) * 64 + lane] = a4;
        __syncthreads();
        if (tid < 320) { const int r = tid >> 6, l = tid & 63; float s = 0.f; for (int w = 0; w < 8; ++w) s += red[(w * 5 + r) * 64 + l]; mod[r * 6144 + task * 64 + l] = s + p.in[I_BMOD][task * 64 + l]; }
        __syncthreads();
    }
}

__device__ __forceinline__ void ph_norm1(const Params& p) {
    const int tid = threadIdx.x, wave = tid >> 6, lane = tid & 63;
    const int gw = blockIdx.x * NWV + wave, GW = gridDim.x * NWV;
    const float* mod = (const float*)(p.ws + WS_MOD);
    bf16_t* hx = (bf16_t*)(p.ws + WS_HX);
    const float* g = p.in[I_GAPRE];
    for (int m = gw; m < MTOT; m += GW) {
        const float* src = (m < T) ? p.in[I_X] + (size_t)m * D : p.in[I_CTX] + (size_t)(m - T) * D;
        const int r = (m < T) ? (m >> 13) : 4;
        const float* shift = mod + r * 6144; const float* scale = shift + 1024;
        f32x4 v[4]; float ss = 0.f;
#pragma unroll
        for (int j = 0; j < 4; ++j) { v[j] = ((const f32x4*)src)[lane + 64 * j]; ss += v[j][0] * v[j][0] + v[j][1] * v[j][1] + v[j][2] * v[j][2] + v[j][3] * v[j][3]; }
        ss = wave_sum(ss);
        const float rs = 1.0f / sqrtf(ss * (1.0f / D) + EPS);
#pragma unroll
        for (int j = 0; j < 4; ++j) {
            const int col = 4 * (lane + 64 * j);
            const f32x4 g4 = *(const f32x4*)(g + col), sc4 = *(const f32x4*)(scale + col), sh4 = *(const f32x4*)(shift + col);
            float h[4];
#pragma unroll
            for (int i = 0; i < 4; ++i) h[i] = v[j][i] * rs * g4[i] * (1.f + sc4[i]) + sh4[i];
            uint2 o; o.x = pk2(h[0], h[1]); o.y = pk2(h[2], h[3]);
            *(uint2*)(hx + (size_t)m * D + col) = o;
        }
    }
}

template <bool DUAL, class RowF, class Epi>
__device__ __forceinline__ void naive_tile(const bf16_t* A, int K, RowF rowf, const float* B0, const float* B1, int ldb, int n0, float* lds, Epi epi) {
    const int tid = threadIdx.x, ty = tid >> 4, tx = tid & 15;
    float* As = lds;
    float* Bs0 = lds + 16 * 132;
    float* Bs1 = Bs0 + 16 * 128;
    float acc0[4][8], acc1[4][8];
#pragma unroll
    for (int i = 0; i < 4; ++i)
#pragma unroll
        for (int j = 0; j < 8; ++j) { acc0[i][j] = 0.f; acc1[i][j] = 0.f; }
    const int ar = tid >> 2, akq = (tid & 3) * 4;
    const bf16_t* arow = A + (size_t)rowf(ar) * K + akq;
    const int bk = tid >> 5, bc = (tid & 31) * 4;
    for (int k0 = 0; k0 < K; k0 += 16) {
        const uint2 av = *(const uint2*)(arow + k0);
        const f32x4 b0v = *(const f32x4*)(B0 + (size_t)(k0 + bk) * ldb + n0 + bc);
        f32x4 b1v = {0.f, 0.f, 0.f, 0.f};
        if (DUAL) b1v = *(const f32x4*)(B1 + (size_t)(k0 + bk) * ldb + n0 + bc);
        __syncthreads();
        As[(akq + 0) * 132 + ar] = __uint_as_float(av.x << 16); As[(akq + 1) * 132 + ar] = __uint_as_float(av.x & 0xffff0000u);
        As[(akq + 2) * 132 + ar] = __uint_as_float(av.y << 16); As[(akq + 3) * 132 + ar] = __uint_as_float(av.y & 0xffff0000u);
        *(f32x4*)(Bs0 + bk * 128 + bc) = b0v;
        if (DUAL) *(f32x4*)(Bs1 + bk * 128 + bc) = b1v;
        __syncthreads();
#pragma unroll
        for (int kk = 0; kk < 16; ++kk) {
            const f32x4 a4 = *(const f32x4*)(As + kk * 132 + ty * 4);
            const f32x4 bA = *(const f32x4*)(Bs0 + kk * 128 + tx * 8), bB = *(const f32x4*)(Bs0 + kk * 128 + tx * 8 + 4);
#pragma unroll
            for (int i = 0; i < 4; ++i) {
#pragma unroll
                for (int j = 0; j < 4; ++j) { acc0[i][j] += a4[i] * bA[j]; acc0[i][4 + j] += a4[i] * bB[j]; }
            }
            if (DUAL) {
                const f32x4 cA = *(const f32x4*)(Bs1 + kk * 128 + tx * 8), cB = *(const f32x4*)(Bs1 + kk * 128 + tx * 8 + 4);
#pragma unroll
                for (int i = 0; i < 4; ++i) {
#pragma unroll
                    for (int j = 0; j < 4; ++j) { acc1[i][j] += a4[i] * cA[j]; acc1[i][4 + j] += a4[i] * cB[j]; }
                }
            }
        }
    }
#pragma unroll
    for (int i = 0; i < 4; ++i)
#pragma unroll
        for (int j = 0; j < 8; ++j) epi(ty * 4 + i, n0 + tx * 8 + j, acc0[i][j], acc1[i][j]);
    __syncthreads();
}

__device__ __forceinline__ void ph_inproj_naive(const Params& p, float* lds) {
    unsigned char* ws = p.ws;
    const bf16_t* hx = (const bf16_t*)(ws + WS_HX);
    float* F = (float*)(ws + WS_F); bf16_t* Q = (bf16_t*)(ws + WS_Q); bf16_t* Kb = (bf16_t*)(ws + WS_K); bf16_t* Vb = (bf16_t*)(ws + WS_V);
    constexpr int NMT = MTOT / 128, NNT = INW / 128;
    for (int u = blockIdx.x; u < NMT * NNT; u += gridDim.x) {
        const int mt = u / NNT, nt = u % NNT, m0 = mt * 128;
        naive_tile<false>(hx, D, [&](int r) { return m0 + r; }, p.in[I_WIN], nullptr, INW, nt * 128, lds,
            [&](int r, int n, float v, float) {
                const int m = m0 + r;
                if (m < T) {
                    const int b = m >> 13, t = m & 8191;
                    if (n < 256) F[(size_t)m * 256 + n] = v;
                    else if (n < 1024) Q[(size_t)m * QKW + (n - 256)] = f2bf(v);
                    else if (n < 1792) Kb[((size_t)b * KVLEN + CTX + t) * QKW + (n - 1024)] = f2bf(v);
                    else Vb[((size_t)b * KVLEN + CTX + t) * QKW + (n - 1792)] = f2bf(v);
                } else {
                    const int j = m - T, b = j >> 8, jj = j & 255;
                    if (n >= 1792) Vb[((size_t)b * KVLEN + jj) * QKW + (n - 1792)] = f2bf(v);
                    else if (n >= 1024) Kb[((size_t)b * KVLEN + jj) * QKW + (n - 1024)] = f2bf(v);
                }
            });
    }
}

__device__ __forceinline__ void ph_rope(const Params& p) {
    unsigned char* ws = p.ws;
    bf16_t* Q = (bf16_t*)(ws + WS_Q); bf16_t* Kb = (bf16_t*)(ws + WS_K);
    const float* rope = (const float*)(ws + WS_ROPE);
    const long total = 2L * T * 384;
    for (long i = (long)blockIdx.x * NT + threadIdx.x; i < total; i += (long)gridDim.x * NT) {
        const int which = (int)(i / ((long)T * 384)); const long rem = i - (long)which * T * 384;
        const int m = (int)(rem / 384), pi = (int)(rem % 384);
        const int h = pi >> 6, mm = (pi >> 5) & 1, axis = (pi >> 4) & 1, f = pi & 15;
        const int b = m >> 13, t = m & 8191;
        const int col = h * 128 + mm * 64 + axis * 32 + f;
        float c, s;
        if (axis == 0) { const int pos = t >> 6; c = rope[pos * 16 + f]; s = rope[2048 + pos * 16 + f]; }
        else { const int pos = t & 63; c = rope[4096 + pos * 16 + f]; s = rope[4096 + 1024 + pos * 16 + f]; }
        bf16_t* buf = (which == 0) ? Q + (size_t)m * QKW : Kb + ((size_t)b * KVLEN + CTX + t) * QKW;
        const float x1 = bf2f(buf[col]), x2 = bf2f(buf[col + 16]);
        buf[col] = f2bf(x1 * c - x2 * s); buf[col + 16] = f2bf(x2 * c + x1 * s);
    }
}

__device__ __forceinline__ void ph_attn_naive(const Params& p, float* lds) {
    unsigned char* ws = p.ws;
    const bf16_t* Q = (const bf16_t*)(ws + WS_Q); const bf16_t* Kb = (const bf16_t*)(ws + WS_K); const bf16_t* Vb = (const bf16_t*)(ws + WS_V);
    bf16_t* AO = (bf16_t*)(ws + WS_AO);
    const float lam = ((const float*)(ws + WS_CTL))[1024];
    const int tid = threadIdx.x, q = tid & 127, mm = (tid >> 7) & 1, vh = tid >> 8;
    float* Ks = lds;
    float* Vs = lds + 64 * 128;
    float* ssq = lds + 2 * 64 * 128;
    for (int u = blockIdx.x; u < BATCH * NH * 64; u += gridDim.x) {
        const int b = u / (NH * 64), h = (u / 64) % NH, qb = u % 64;
        const size_t qrow = (size_t)b * SEQ + qb * 128 + q;
        float qv[64], o[64];
        {
            const bf16_t* qp = Q + qrow * QKW + h * 128 + mm * 64;
#pragma unroll
            for (int d = 0; d < 64; d += 8) { const uint4 w = *(const uint4*)(qp + d);
                qv[d] = __uint_as_float(w.x << 16) * 0.125f; qv[d + 1] = __uint_as_float(w.x & 0xffff0000u) * 0.125f; qv[d + 2] = __uint_as_float(w.y << 16) * 0.125f; qv[d + 3] = __uint_as_float(w.y & 0xffff0000u) * 0.125f;
                qv[d + 4] = __uint_as_float(w.z << 16) * 0.125f; qv[d + 5] = __uint_as_float(w.z & 0xffff0000u) * 0.125f; qv[d + 6] = __uint_as_float(w.w << 16) * 0.125f; qv[d + 7] = __uint_as_float(w.w & 0xffff0000u) * 0.125f; }
        }
#pragma unroll
        for (int e = 0; e < 64; ++e) o[e] = 0.f;
        float mrun = -1e30f, l = 0.f;
        const int lr = tid >> 3, lc = (tid & 7) * 16;
        for (int j = 0; j < KVLEN / 64; ++j) {
            const size_t krow = ((size_t)b * KVLEN + j * 64 + lr) * QKW + h * 128 + lc;
            const uint4 k0 = *(const uint4*)(Kb + krow), k1 = *(const uint4*)(Kb + krow + 8);
            const uint4 v0 = *(const uint4*)(Vb + krow), v1 = *(const uint4*)(Vb + krow + 8);
            __syncthreads();
            {
                float* kd = Ks + lr * 128 + lc; float* vd = Vs + lr * 128 + lc;
                const unsigned kw[8] = {k0.x, k0.y, k0.z, k0.w, k1.x, k1.y, k1.z, k1.w};
                const unsigned vw[8] = {v0.x, v0.y, v0.z, v0.w, v1.x, v1.y, v1.z, v1.w};
#pragma unroll
                for (int i = 0; i < 8; ++i) { kd[2 * i] = __uint_as_float(kw[i] << 16); kd[2 * i + 1] = __uint_as_float(kw[i] & 0xffff0000u); vd[2 * i] = __uint_as_float(vw[i] << 16); vd[2 * i + 1] = __uint_as_float(vw[i] & 0xffff0000u); }
            }
            __syncthreads();
            for (int r = 0; r < 64; ++r) {
                const float* kr = Ks + r * 128 + mm * 64;
                float s = 0.f;
#pragma unroll
                for (int d = 0; d < 64; d += 4) { const f32x4 kk = *(const f32x4*)(kr + d); s += qv[d] * kk[0] + qv[d + 1] * kk[1] + qv[d + 2] * kk[2] + qv[d + 3] * kk[3]; }
                if (s > mrun) { const float scl = expf(mrun - s); l *= scl;
#pragma unroll
                    for (int e = 0; e < 64; ++e) o[e] *= scl;
                    mrun = s; }
                const float pe = expf(s - mrun); l += pe;
                const float* vr = Vs + r * 128 + vh * 64;
#pragma unroll
                for (int e = 0; e < 64; e += 4) { const f32x4 vv = *(const f32x4*)(vr + e); o[e] += pe * vv[0]; o[e + 1] += pe * vv[1]; o[e + 2] += pe * vv[2]; o[e + 3] += pe * vv[3]; }
            }
        }
        __syncthreads();
        const float il = 1.0f / l;
        float* o1s = lds;
        if (mm == 1) {
#pragma unroll
            for (int e = 0; e < 64; ++e) o1s[q * 128 + vh * 64 + e] = o[e] * il * lam;
        }
        __syncthreads();
        float ss = 0.f;
        if (mm == 0) {
#pragma unroll
            for (int e = 0; e < 64; ++e) { o[e] = o[e] * il - o1s[q * 128 + vh * 64 + e]; ss += o[e] * o[e]; }
            ssq[q * 2 + vh] = ss;
        }
        __syncthreads();
        if (mm == 0) {
            const float rs = 1.0f / sqrtf((ssq[q * 2] + ssq[q * 2 + 1]) * (1.0f / 128.0f) + EPS);
            const float* gs = p.in[I_GSUB];
            bf16_t* dst = AO + qrow * D + 256 + h * 128 + vh * 64;
#pragma unroll
            for (int e = 0; e < 64; e += 2) { const unsigned w = pk2(o[e] * rs * gs[vh * 64 + e] * (1.f - LAM_INIT), o[e + 1] * rs * gs[vh * 64 + e + 1] * (1.f - LAM_INIT)); *(unsigned*)(dst + e) = w; }
        }
        __syncthreads();
    }
}

__device__ __forceinline__ void ph_fourierA(const Params& p, float* lds) {
    unsigned char* ws = p.ws;
    const float* F = (const float*)(ws + WS_F); float2* FY = (float2*)(ws + WS_FY);
    const float2* tabw = (const float2*)(ws + WS_TABW);
    const int tid = threadIdx.x, c = tid & 255, kh = tid >> 8;
    float* tile = lds;
    float2* w128 = (float2*)(lds + 128 * 256);
    for (int task = blockIdx.x; task < BATCH * 64; task += gridDim.x) {
        const int b = task >> 6, n2 = task & 63;
        __syncthreads();
        if (tid < 128) w128[tid] = tabw[tid * 64];
        for (int i = tid; i < 128 * 64; i += NT) { const int n1 = i >> 6, c4 = (i & 63) * 4; *(f32x4*)(tile + n1 * 256 + c4) = *(const f32x4*)(F + ((size_t)b * SEQ + 64 * n1 + n2) * 256 + c4); }
        __syncthreads();
        for (int k1 = kh * 64; k1 < kh * 64 + 64; ++k1) {
            float re = 0.f, im = 0.f;
#pragma unroll 8
            for (int n1 = 0; n1 < 128; ++n1) { const float2 w = w128[(n1 * k1) & 127]; const float f = tile[n1 * 256 + c]; re += f * w.x; im -= f * w.y; }
            FY[(((size_t)b * 128 + k1) * 64 + n2) * 256 + c] = make_float2(re, im);
        }
    }
}

__device__ __forceinline__ void ph_fourierB(const Params& p, float* lds) {
    unsigned char* ws = p.ws;
    const float2* FY = (const float2*)(ws + WS_FY); const float2* tabw = (const float2*)(ws + WS_TABW);
    const float* gcs = (const float*)(ws + WS_GCS);
    bf16_t* AO = (bf16_t*)(ws + WS_AO);
    const int tid = threadIdx.x;
    float2* Z = (float2*)lds;
    float2* X = Z + 4096;
    float* GC = (float*)(X + 4096);
    float* GS = GC + 4096;
    float2* w64 = (float2*)(GS + 4096);
    for (int task = blockIdx.x; task < BATCH * 128 * 4; task += gridDim.x) {
        const int g = task & 3, k1 = (task >> 2) & 127, b = task >> 9;
        __syncthreads();
        if (tid < 64) w64[tid] = tabw[tid * 128];
        for (int i = tid; i < 4096; i += NT) {
            const int n2 = i >> 6, c = i & 63;
            const float2 y = FY[(((size_t)b * 128 + k1) * 64 + n2) * 256 + g * 64 + c]; const float2 tw = tabw[n2 * k1];
            Z[i] = make_float2(y.x * tw.x + y.y * tw.y, y.y * tw.x - y.x * tw.y);
            GC[i] = gcs[g * 4096 + i]; GS[i] = gcs[16384 + g * 4096 + i];
        }
        __syncthreads();
        {
            const int c = tid & 63, kg = tid >> 6;
            for (int k2 = kg * 8; k2 < kg * 8 + 8; ++k2) {
                float re = 0.f, im = 0.f;
#pragma unroll 8
                for (int n2 = 0; n2 < 64; ++n2) { const float2 w = w64[(n2 * k2) & 63]; const float2 z = Z[n2 * 64 + c]; re += z.x * w.x + z.y * w.y; im += z.y * w.x - z.x * w.y; }
                X[k2 * 64 + c] = make_float2(re, im);
            }
        }
        __syncthreads();
        {
            const int d = tid & 63, kg = tid >> 6;
            for (int k2 = kg * 8; k2 < kg * 8 + 8; ++k2) {
                float acc = 0.f;
#pragma unroll 8
                for (int c = 0; c < 64; ++c) { const float2 x = X[k2 * 64 + c]; acc += x.x * GC[c * 64 + d] + x.y * GS[c * 64 + d]; }
                AO[((size_t)b * SEQ + k1 + 128 * k2) * D + g * 64 + d] = f2bf(acc);
            }
        }
    }
}

__device__ __forceinline__ void ph_outproj_naive(const Params& p, float* lds) {
    unsigned char* ws = p.ws;
    const bf16_t* AO = (const bf16_t*)(ws + WS_AO); float* YX = (float*)(ws + WS_YX);
    for (int u = blockIdx.x; u < (T / 128) * 8; u += gridDim.x) {
        const int mt = u >> 3, nt = u & 7, m0 = mt * 128;
        naive_tile<false>(AO, D, [&](int r) { return m0 + r; }, p.in[I_WOUT], nullptr, D, nt * 128, lds,
            [&](int r, int n, float v, float) { YX[(size_t)(m0 + r) * D + n] = v; });
    }
}

__device__ __forceinline__ void ph_mid(const Params& p, float* lds) {
    unsigned char* ws = p.ws;
    const int tid = threadIdx.x, wave = tid >> 6, lane = tid & 63;
    const int gw = blockIdx.x * NWV + wave, GW = gridDim.x * NWV;
    const float* mod = (const float*)(ws + WS_MOD);
    const float* YX = (const float*)(ws + WS_YX);
    bf16_t* H2 = (bf16_t*)(ws + WS_H2);
    unsigned* counts = (unsigned*)(ws + WS_CTL);
    int* TE = (int*)(ws + WS_TE); int* TP = (int*)(ws + WS_TP); float* TW = (float*)(ws + WS_TW); int* TOKL = (int*)(ws + WS_TOKL);
    float* hrow = lds + wave * 1024;
    const float* wr = p.in[I_WR];
    const float rbias = p.in[I_RB][lane];
    for (int m = gw; m < T; m += GW) {
        const int b = m >> 13;
        const float* mrow = mod + b * 6144;
        f32x4 y[4], xv[4]; float ss = 0.f;
#pragma unroll
        for (int j = 0; j < 4; ++j) { y[j] = ((const f32x4*)(YX + (size_t)m * D))[lane + 64 * j]; xv[j] = ((const f32x4*)(p.in[I_X] + (size_t)m * D))[lane + 64 * j];
            ss += y[j][0] * y[j][0] + y[j][1] * y[j][1] + y[j][2] * y[j][2] + y[j][3] * y[j][3]; }
        ss = wave_sum(ss);
        const float r1 = 1.0f / sqrtf(ss * (1.0f / D) + EPS);
        float ss2 = 0.f;
#pragma unroll
        for (int j = 0; j < 4; ++j) {
            const int col = 4 * (lane + 64 * j);
            const f32x4 gp = *(const f32x4*)(p.in[I_GAPOST] + col), gt = *(const f32x4*)(mrow + 2 * 1024 + col);
#pragma unroll
            for (int i = 0; i < 4; ++i) { xv[j][i] = xv[j][i] + gt[i] * (y[j][i] * r1 * gp[i]); ss2 += xv[j][i] * xv[j][i]; }
            ((f32x4*)(p.out + (size_t)m * D))[lane + 64 * j] = xv[j];
        }
        ss2 = wave_sum(ss2);
        const float r2 = 1.0f / sqrtf(ss2 * (1.0f / D) + EPS);
#pragma unroll
        for (int j = 0; j < 4; ++j) {
            const int col = 4 * (lane + 64 * j);
            const f32x4 gp = *(const f32x4*)(p.in[I_GFPRE] + col), sh = *(const f32x4*)(mrow + 3 * 1024 + col), sc = *(const f32x4*)(mrow + 4 * 1024 + col);
            f32x4 h;
#pragma unroll
            for (int i = 0; i < 4; ++i) h[i] = xv[j][i] * r2 * gp[i] * (1.f + sc[i]) + sh[i];
            *(f32x4*)(hrow + col) = h;
            uint2 o; o.x = pk2(h[0], h[1]); o.y = pk2(h[2], h[3]);
            *(uint2*)(H2 + (size_t)m * D + col) = o;
        }
        float lg = 0.f;
#pragma unroll 8
        for (int k = 0; k < D; ++k) lg += hrow[k] * wr[k * 64 + lane];
        const float score = 1.0f / (1.0f + expf(-lg));
        const float sel = score + rbias;
        float t1 = sel, t2 = -INFINITY;
#pragma unroll
        for (int off = 1; off < 8; off <<= 1) { const float o1 = __shfl_xor(t1, off), o2 = __shfl_xor(t2, off); const float n1 = fmaxf(t1, o1), n2 = fmaxf(fminf(t1, o1), fmaxf(t2, o2)); t1 = n1; t2 = n2; }
        const float gs = t1 + t2; const int grp = lane >> 3;
        int gr = 0;
#pragma unroll
        for (int j = 0; j < 8; ++j) { const float sj = __shfl(gs, j * 8); gr += (sj > gs || (sj == gs && j < grp)) ? 1 : 0; }
        const bool gsel = gr < 4;
        const float v = gsel ? sel : -INFINITY;
        int rk = 0;
        for (int j = 0; j < 64; ++j) { const float vj = __shfl(v, j); rk += (vj > v || (vj == v && j < lane)) ? 1 : 0; }
        const bool chosen = gsel && rk < TOPK;
        const float ssum = wave_sum(chosen ? score : 0.f);
        const float w = score / (ssum + 1e-20f) * 2.5f;
        if (chosen) {
            const unsigned pos = atomicAdd(&counts[b * 65 + lane], 1u);
            TOKL[((size_t)b * 64 + lane) * 8192 + pos] = m * 8 + rk;
            TE[m * 8 + rk] = lane; TP[m * 8 + rk] = (int)pos; TW[m * 8 + rk] = w;
        }
    }
}

__device__ __forceinline__ void build_lists(const Params& p, int* tab, int TM, int ntn, int b_lo, int b_hi) {
    const unsigned* counts = (const unsigned*)(p.ws + WS_CTL);
    __syncthreads();
    if (threadIdx.x == 0) {
        int up = 0;
        for (int b = 0; b < BATCH; ++b) {
            int base = 0;
            for (int e = 0; e < 65; ++e) {
                const int i = b * 65 + e; const int c = (e < 64) ? (int)counts[i] : SEQ;
                tab[i] = c; tab[260 + i] = base; tab[520 + i] = up;
                base += (c + 255) & ~255;
                if (b >= b_lo && b < b_hi) up += ((c + TM - 1) / TM) * ntn;
            }
        }
        tab[520 + 260] = up;
    }
    __syncthreads();
}

__device__ __forceinline__ void ph_moe_gu_naive(const Params& p, float* lds) {
    unsigned char* ws = p.ws;
    int* tab = (int*)(lds + 16 * 132 + 2 * 16 * 128);
    build_lists(p, tab, 128, 2, 0, BATCH);
    const bf16_t* H2 = (const bf16_t*)(ws + WS_H2); bf16_t* ACT = (bf16_t*)(ws + WS_ACT);
    const int* TOKL = (const int*)(ws + WS_TOKL); const float* TW = (const float*)(ws + WS_TW);
    const int U = tab[780];
    for (int u = blockIdx.x; u < U; u += gridDim.x) {
        int i = 0; while (i < 259 && tab[520 + i + 1] <= u) ++i;
        const int b = i / 65, e = i % 65, cnt = tab[i], base = tab[260 + i], loc = u - tab[520 + i], mt = loc >> 1, nt = loc & 1;
        const int* tl = TOKL + ((size_t)b * 64 + e) * 8192;
        const float* B0 = (e < 64) ? p.in[I_WG] + (size_t)e * D * DE : p.in[I_WSG];
        const float* B1 = (e < 64) ? p.in[I_WU] + (size_t)e * D * DE : p.in[I_WSU];
        naive_tile<true>(H2, D,
            [&](int r) { const int pos = mt * 128 + r; return (e < 64) ? ((pos < cnt) ? (tl[pos] >> 3) : 0) : (b * SEQ + pos); },
            B0, B1, DE, nt * 128, lds,
            [&](int r, int n, float gv, float uv) {
                const int pos = mt * 128 + r;
                if (pos < cnt) { const float w = (e < 64) ? TW[tl[pos]] : 1.0f;
                    ACT[((size_t)b * SLOTS_B + base + pos) * DE + n] = f2bf(silu_f(gv) * uv * w); }
            });
    }
}

__device__ __forceinline__ void ph_moe_down_naive(const Params& p, float* lds, int b) {
    unsigned char* ws = p.ws;
    int* tab = (int*)(lds + 16 * 132 + 2 * 16 * 128);
    build_lists(p, tab, 128, 8, b, b + 1);
    const bf16_t* ACT = (const bf16_t*)(ws + WS_ACT); bf16_t* Y = (bf16_t*)(ws + WS_Y);
    const int U = tab[780];
    for (int u = blockIdx.x; u < U; u += gridDim.x) {
        int i = b * 65; while (i < b * 65 + 64 && tab[520 + i + 1] <= u) ++i;
        const int e = i % 65, cnt = tab[i], base = tab[260 + i], loc = u - tab[520 + i], mt = loc >> 3, nt = loc & 7;
        const float* B0 = (e < 64) ? p.in[I_WD] + (size_t)e * DE * D : p.in[I_WSD];
        const size_t arow0 = (size_t)b * SLOTS_B + base + mt * 128;
        naive_tile<false>(ACT, DE, [&](int r) { return arow0 + r; }, B0, nullptr, D, nt * 128, lds,
            [&](int r, int n, float v, float) { const int pos = mt * 128 + r; if (pos < cnt) Y[((size_t)base + pos) * D + n] = f2bf(v); });
    }
}

__device__ __forceinline__ void ph_final(const Params& p, float* lds, int b) {
    unsigned char* ws = p.ws;
    int* tab = (int*)lds;
    build_lists(p, tab, 128, 1, b, b + 1);
    const int tid = threadIdx.x, wave = tid >> 6, lane = tid & 63;
    const int gw = blockIdx.x * NWV + wave, GW = gridDim.x * NWV;
    const float* mod = (const float*)(ws + WS_MOD) + b * 6144 + 5 * 1024;
    const bf16_t* Y = (const bf16_t*)(ws + WS_Y);
    const int* TE = (const int*)(ws + WS_TE); const int* TP = (const int*)(ws + WS_TP);
    for (int t = gw; t < SEQ; t += GW) {
        const int m = b * SEQ + t;
        float acc[16];
#pragma unroll
        for (int i = 0; i < 16; ++i) acc[i] = 0.f;
#pragma unroll
        for (int k = 0; k < 9; ++k) {
            size_t row;
            if (k < 8) { const int e = TE[m * 8 + k]; row = (size_t)tab[260 + b * 65 + e] + TP[m * 8 + k]; }
            else row = (size_t)tab[260 + b * 65 + 64] + t;
#pragma unroll
            for (int j = 0; j < 4; ++j) { const uint2 w = *(const uint2*)(Y + row * D + 4 * (lane + 64 * j));
                acc[4 * j] += __uint_as_float(w.x << 16); acc[4 * j + 1] += __uint_as_float(w.x & 0xffff0000u); acc[4 * j + 2] += __uint_as_float(w.y << 16); acc[4 * j + 3] += __uint_as_float(w.y & 0xffff0000u); }
        }
        float ss = 0.f;
#pragma unroll
        for (int i = 0; i < 16; ++i) ss += acc[i] * acc[i];
        ss = wave_sum(ss);
        const float rs = 1.0f / sqrtf(ss * (1.0f / D) + EPS);
#pragma unroll
        for (int j = 0; j < 4; ++j) {
            const int col = 4 * (lane + 64 * j);
            const f32x4 gp = *(const f32x4*)(p.in[I_GFPOST] + col), gt = *(const f32x4*)(mod + col);
            f32x4 x1 = ((const f32x4*)(p.out + (size_t)m * D))[lane + 64 * j];
#pragma unroll
            for (int i = 0; i < 4; ++i) x1[i] += gt[i] * (acc[4 * j + i] * rs * gp[i]);
            ((f32x4*)(p.out + (size_t)m * D))[lane + 64 * j] = x1;
        }
    }
}

constexpr int LDS_BYTES = 144 * 1024;
template <int PH>
__global__ void __launch_bounds__(NT) k_phase(Params p) {
    extern __shared__ __attribute__((aligned(16))) unsigned char smem[];
    float* lds = (float*)smem;
    if (PH == 0) ph_prep(p, lds);
    if (PH == 1) ph_norm1(p);
    if (PH == 2) ph_inproj_naive(p, lds);
    if (PH == 3) ph_rope(p);
    if (PH == 4) { ph_attn_naive(p, lds); ph_fourierA(p, lds); }
    if (PH == 5) ph_fourierB(p, lds);
    if (PH == 6) ph_outproj_naive(p, lds);
    if (PH == 7) ph_mid(p, lds);
    if (PH == 8) ph_moe_gu_naive(p, lds);
    if (PH == 9) ph_moe_down_naive(p, lds, p.chunk);
    if (PH == 10) ph_final(p, lds, p.chunk);
}

template <int PH> static void launch_phase(const Params& p, int grid, hipStream_t s) {
    static bool attr = false;
    if (!attr) { (void)hipFuncSetAttribute((const void*)k_phase<PH>, hipFuncAttributeMaxDynamicSharedMemorySize, LDS_BYTES); attr = true; }
    hipLaunchKernelGGL(k_phase<PH>, dim3(grid), dim3(NT), LDS_BYTES, s, p);
}

extern "C" void kernel_launch(void* const* d_in, const int* in_sizes, int n_in, void* d_out, int out_size, void* d_ws, size_t ws_size, hipStream_t stream) {
    if (n_in != 26 || ws_size < WS_END) { fprintf(stderr, "kernel_launch: unexpected n_in %d / ws %zu\n", n_in, ws_size); return; }
    Params p{};
    for (int i = 0; i < 26; ++i) p.in[i] = (const float*)d_in[i];
    p.out = (float*)d_out; p.ws = (unsigned char*)d_ws; p.chunk = 0; p.pad = 0;
    (void)hipMemsetAsync((char*)d_ws + WS_CTL, 0, 4096, stream);
    const int G = 256;
    launch_phase<0>(p, G, stream);
    launch_phase<1>(p, G, stream);
    launch_phase<2>(p, G, stream);
    launch_phase<3>(p, G, stream);
    launch_phase<4>(p, G, stream);
    launch_phase<5>(p, G, stream);
    launch_phase<6>(p, G, stream);
    launch_phase<7>(p, G, stream);
    launch_phase<8>(p, G, stream);
    for (int b = 0; b < BATCH; ++b) { p.chunk = b; launch_phase<9>(p, G, stream); launch_phase<10>(p, G, stream); }
}
```

```cpp
#include <hip/hip_runtime.h>
#include <hip/hip_cooperative_groups.h>
#include <cstdio>
#include <cstdint>

typedef unsigned short bf16_t;
typedef float f32x4 __attribute__((ext_vector_type(4)));

constexpr int D = 1024, BATCH = 4, SEQ = 8192, T = BATCH * SEQ, CTX = 256, TC = BATCH * CTX;
constexpr int MTOT = T + TC;
constexpr int KVLEN = CTX + SEQ;
constexpr int INW = 2560, NH = 6, QKW = 768, FW = 256;
constexpr int NE = 64, DE = 256, TOPK = 8;
constexpr int NT = 512, NWV = 8;
constexpr int SLOTS_B = 90112;
constexpr float EPS = 1e-6f;
constexpr float LAM_INIT = 0.2f;
constexpr float QSCALE = 0.125f * 1.4426950408889634f;

constexpr size_t MiB = 1u << 20;
constexpr size_t WS_CTL = 0;
constexpr size_t WS_MOD = 1 * MiB;
constexpr size_t WS_TABW = WS_MOD + 128 * 1024;
constexpr size_t WS_ROPE = WS_MOD + 192 * 1024;
constexpr size_t WS_GCS = WS_MOD + 256 * 1024;
constexpr size_t WS_W128E = WS_MOD + 768 * 1024;
constexpr size_t WS_M64E = WS_MOD + 832 * 1024;
constexpr size_t WS_GT = WS_MOD + 864 * 1024;
constexpr size_t WS_WRT = WS_MOD + 512 * 1024;
constexpr size_t WS_WINT = 2 * MiB;
constexpr size_t WS_WOUTT = 7 * MiB;
constexpr size_t WS_WGUT = 9 * MiB;
constexpr size_t WS_WDT = 74 * MiB;
constexpr size_t WS_TE = 107 * MiB;
constexpr size_t WS_TP = 108 * MiB;
constexpr size_t WS_TW = 109 * MiB;
constexpr size_t WS_TOKL = 110 * MiB;
constexpr size_t WS_AO = 118 * MiB;
constexpr size_t WS_ACT = 118 * MiB;
constexpr size_t WS_Q = 182 * MiB;
constexpr size_t WS_K = 230 * MiB;
constexpr size_t WS_V = WS_K + (size_t)BATCH * KVLEN * QKW * 2;
constexpr size_t WS_F = 329 * MiB;
constexpr size_t WS_FY = 361 * MiB;
constexpr size_t WS_HX = 425 * MiB;
constexpr size_t WS_YX = 358 * MiB;
constexpr size_t WS_H2 = 294 * MiB;
constexpr size_t WS_Y = 294 * MiB;
constexpr size_t WS_END = 491 * MiB;

struct Params {
    const float* in[26];
    float* out;
    unsigned char* ws;
    int chunk;
    int pad;
};
enum { I_X = 0, I_C, I_CTX, I_CCTX, I_WMOD, I_BMOD, I_GAPRE, I_GAPOST, I_WIN, I_WF, I_LQ1, I_LK1, I_LQ2, I_LK2, I_GSUB, I_WOUT,
       I_GFPRE, I_GFPOST, I_WR, I_RB, I_WG, I_WU, I_WD, I_WSG, I_WSU, I_WSD };

__device__ __forceinline__ float bf2f(bf16_t v) { return __uint_as_float(((unsigned)v) << 16); }
__device__ __forceinline__ bf16_t f2bf(float f) { unsigned u = __float_as_uint(f); return (bf16_t)((u + 0x7fffu + ((u >> 16) & 1u)) >> 16); }
__device__ __forceinline__ unsigned pk2(float lo, float hi) { return (unsigned)f2bf(lo) | ((unsigned)f2bf(hi) << 16); }
template <int M> __device__ __forceinline__ float sx(float v) { return __int_as_float(__builtin_amdgcn_ds_swizzle(__float_as_int(v), (M << 10) | 0x1f)); }
template <int M> __device__ __forceinline__ int sxi(int v) { return __builtin_amdgcn_ds_swizzle(v, (M << 10) | 0x1f); }
__device__ __forceinline__ float wave_sum(float v) {
    v += sx<1>(v); v += sx<2>(v); v += sx<4>(v); v += sx<8>(v); v += sx<16>(v);
    auto rr = __builtin_amdgcn_permlane32_swap(__float_as_uint(v), __float_as_uint(v), false, false);
    return __uint_as_float(rr[0]) + __uint_as_float(rr[1]);
}
__device__ __forceinline__ float dpp_f(float v, const int ctrl_sel) {
    const int x = __float_as_int(v); int r;
    if (ctrl_sel == 0) r = __builtin_amdgcn_update_dpp(x, x, 0xB1, 0xf, 0xf, false);
    else if (ctrl_sel == 1) r = __builtin_amdgcn_update_dpp(x, x, 0x4E, 0xf, 0xf, false);
    else if (ctrl_sel == 2) r = __builtin_amdgcn_update_dpp(x, x, 0x141, 0xf, 0xf, false);
    else r = __builtin_amdgcn_update_dpp(x, x, 0x140, 0xf, 0xf, false);
    return __int_as_float(r);
}
__device__ __forceinline__ float wave_max(float v) {
    v = fmaxf(v, dpp_f(v, 0)); v = fmaxf(v, dpp_f(v, 1)); v = fmaxf(v, dpp_f(v, 2)); v = fmaxf(v, dpp_f(v, 3));
    const float a = __uint_as_float(__builtin_amdgcn_readlane(__float_as_uint(v), 0)), b = __uint_as_float(__builtin_amdgcn_readlane(__float_as_uint(v), 16));
    const float c = __uint_as_float(__builtin_amdgcn_readlane(__float_as_uint(v), 32)), d = __uint_as_float(__builtin_amdgcn_readlane(__float_as_uint(v), 48));
    return fmaxf(fmaxf(a, b), fmaxf(c, d));
}
__device__ __forceinline__ int lane_id() { int l; asm volatile("v_mbcnt_lo_u32_b32 %0, -1, 0\n\tv_mbcnt_hi_u32_b32 %0, -1, %0" : "=v"(l)); return l; }
__device__ __forceinline__ int otid_w(int wv) { return wv * 64 + lane_id(); }
#define otid() otid_w(p.chunk)
__device__ __forceinline__ float silu_f(float x) { return x / (1.f + expf(-x)); }

__device__ __forceinline__ void ph_prep(const Params& p, float* lds) {
    const int tid = otid(), bid = blockIdx.x, nblk = gridDim.x;
    const int gt = bid * NT + tid, GT = nblk * NT;
    unsigned char* ws = p.ws;
    float2* tabw = (float2*)(ws + WS_TABW);
    for (int i = gt; i < 8192; i += GT) { float s, c; sincospif((float)i * (1.0f / 4096.0f), &s, &c); tabw[i] = make_float2(c, s); }
    float* rope = (float*)(ws + WS_ROPE);
    for (int i = gt; i < 192 * 16; i += GT) {
        const int pos = (i < 2048) ? (i >> 4) : ((i - 2048) >> 4); const int f = i & 15;
        const float inv = powf(10000.0f, -(float)(2 * f) / 32.0f); const float ang = (float)pos * inv;
        const float c = cosf(ang), s = sinf(ang);
        if (i < 2048) { rope[i] = c; rope[2048 + i] = s; } else { rope[4096 + (i - 2048)] = c; rope[4096 + 1024 + (i - 2048)] = s; }
    }
    { bf16_t* gt = (bf16_t*)(ws + WS_GT); const float* wf = p.in[I_WF];
      for (int i = bid * NT + tid; i < 4 * 64 * 128; i += GT) {
        const int g = i >> 13, d = (i >> 7) & 63, part = (i >> 6) & 1, c = i & 63;
        float a = 0.f;
        for (int j = 0; j < 64; ++j) { float s, co; sincospif((float)((c * j) & 63) * (1.0f / 32.0f), &s, &co); a += (part ? s : co) * wf[(g * 64 + j) * 64 + d]; }
        gt[i] = f2bf(a * 0.0013810679320049757f);
      }
      bf16_t* w128 = (bf16_t*)(ws + WS_W128E);
      for (int i = bid * NT + tid; i < 256 * 128; i += GT) { const int kk = i >> 7, n1 = i & 127; float s, co; sincospif((float)(((kk & 127) * n1) & 127) * (1.0f / 64.0f), &s, &co); w128[i] = f2bf(kk < 128 ? co : -s); }
      bf16_t* m64 = (bf16_t*)(ws + WS_M64E);
      for (int i = bid * NT + tid; i < 128 * 128; i += GT) { const int ro = i >> 7, ci = i & 127, po = ro >> 6, k2 = ro & 63, pi = ci >> 6, n2 = ci & 63;
        float s, co; sincospif((float)((k2 * n2) & 63) * (1.0f / 32.0f), &s, &co); m64[i] = f2bf(po == pi ? co : (po == 0 ? s : -s)); }
    }
    {
      bf16_t* wrt = (bf16_t*)(ws + WS_WRT); const float* wr = p.in[I_WR];
      for (int i = gt; i < 64 * 1024; i += GT) {
        const int j = i & 7, ln = (i >> 3) & 63, nb = (i >> 9) & 3, ks = (i >> 11) & 3, wv_ = i >> 13;
        const int e = 16 * nb + (ln & 15), k = wv_ * 128 + ks * 32 + 8 * (ln >> 4) + j;
        const float w = wr[k * 64 + e]; const bf16_t h = f2bf(w);
        const int o = ((((wv_ * 4 + ks) * 4 + nb) * 2) * 64 + ln) * 8 + j;
        wrt[o] = h; wrt[o + 512] = f2bf(w - bf2f(h)); } }
    if (gt == 0) {
        float s1 = 0.f, s2 = 0.f;
        for (int i = 0; i < 64; ++i) { s1 += p.in[I_LQ1][i] * p.in[I_LK1][i]; s2 += p.in[I_LQ2][i] * p.in[I_LK2][i]; }
        ((float*)(ws + WS_CTL))[1024] = expf(s1) - expf(s2) + LAM_INIT;
    }
    float* sc = lds;
    float* red = lds + 5 * 1024;
    for (int i = tid; i < 5 * 1024; i += NT) { const int r = i >> 10, k = i & 1023; const float v = (r < 4) ? p.in[I_C][r * 1024 + k] : p.in[I_CCTX][k]; sc[i] = silu_f(v); }
    __syncthreads();
    const int wave = tid >> 6, lane = tid & 63;
    float* mod = (float*)(ws + WS_MOD);
    for (int task = bid; task < 96; task += nblk) {
        const int col = task * 64 + lane;
        float a0 = 0, a1 = 0, a2 = 0, a3 = 0, a4 = 0;
        const float* wm = p.in[I_WMOD];
#pragma unroll 32
        for (int k = wave * 128; k < wave * 128 + 128; ++k) { const float w = wm[(size_t)k * 6144 + col]; a0 += sc[k] * w; a1 += sc[1024 + k] * w; a2 += sc[2048 + k] * w; a3 += sc[3072 + k] * w; a4 += sc[4096 + k] * w; }
        red[(wave * 5 + 0) * 64 + lane] = a0; red[(wave * 5 + 1) * 64 + lane] = a1; red[(wave * 5 + 2) * 64 + lane] = a2; red[(wave * 5 + 3) * 64 + lane] = a3; red[(wave * 5 + 4) * 64 + lane] = a4;
        __syncthreads();
        if (tid < 320) { const int r = tid >> 6, l = tid & 63; float s = 0.f; for (int w = 0; w < 8; ++w) s += red[(w * 5 + r) * 64 + l]; mod[r * 6144 + task * 64 + l] = s + p.in[I_BMOD][task * 64 + l]; }
        __syncthreads();
    }
}

__device__ __forceinline__ void ph_norm1(const Params& p) {
    const int tid = otid(), wave = tid >> 6, lane = tid & 63;
    const int gw = blockIdx.x * NWV + wave, GW = gridDim.x * NWV;
    const float* mod = (const float*)(p.ws + WS_MOD);
    bf16_t* hx = (bf16_t*)(p.ws + WS_HX);
    const float* g = p.in[I_GAPRE];
    for (int m = gw; m < MTOT; m += GW) {
        const float* src = (m < T) ? p.in[I_X] + (size_t)m * D : p.in[I_CTX] + (size_t)(m - T) * D;
        const int r = (m < T) ? (m >> 13) : 4;
        const float* shift = mod + r * 6144; const float* scale = shift + 1024;
        f32x4 v[4]; float ss = 0.f;
#pragma unroll
        for (int j = 0; j < 4; ++j) { v[j] = ((const f32x4*)src)[lane + 64 * j]; ss += v[j][0] * v[j][0] + v[j][1] * v[j][1] + v[j][2] * v[j][2] + v[j][3] * v[j][3]; }
        ss = wave_sum(ss);
        const float rs = 1.0f / sqrtf(ss * (1.0f / D) + EPS);
#pragma unroll
        for (int j = 0; j < 4; ++j) {
            const int col = 4 * (lane + 64 * j);
            const f32x4 g4 = *(const f32x4*)(g + col), sc4 = *(const f32x4*)(scale + col), sh4 = *(const f32x4*)(shift + col);
            float h[4];
#pragma unroll
            for (int i = 0; i < 4; ++i) h[i] = v[j][i] * rs * g4[i] * (1.f + sc4[i]) + sh4[i];
            uint2 o; o.x = pk2(h[0], h[1]); o.y = pk2(h[2], h[3]);
            *(uint2*)(hx + (size_t)m * D + col) = o;
        }
    }
}

namespace gp {
#define GP_LAS __attribute__((address_space(3)))
typedef short bf16x8 __attribute__((ext_vector_type(8)));
typedef unsigned u32x4 __attribute__((ext_vector_type(4)));
constexpr int BM = 256, BK = 64, HALF = 128, HTB = HALF * BK * 2, STAGE_BYTES = 8 * HTB;
__device__ __forceinline__ int lds_byte(int r, int c) { const int st = (r >> 4) * 2 + (c >> 5), rr = r & 15, cc = c & 31, ob = rr * 64 + cc * 2; return st * 1024 + (ob ^ (((ob >> 9) & 1) << 5)); }
__device__ __forceinline__ void stage_rc(int b, int& R, int& C) { const int st = b / 1024, sb = b % 1024, swz = sb ^ (((sb >> 9) & 1) << 5); R = (st >> 1) * 16 + swz / 64; C = (st & 1) * 32 + (swz % 64) / 2; }
__device__ __forceinline__ int perm32(int rho) { const int n = rho >> 4, i = rho & 15; return 8 * (i >> 2) + 4 * n + (i & 3); }
struct Unit { int pm, pn, e, b, cnt, base; };
__device__ __forceinline__ unsigned cvt_pk_bf16(float lo, float hi) { unsigned r; asm volatile("v_cvt_pk_bf16_f32 %0, %1, %2" : "=v"(r) : "v"(lo), "v"(hi)); return r; }

template <class Epi, class Sched, bool ALIGN_EPI>
__device__ __forceinline__ void gemm_phase(const int wv, GP_LAS unsigned char* lds, const char* Abase, const int K, const Sched& S, const Epi& E) {
    const int wid = wv, wr = wid >> 2, wc = wid & 3;
    const int nt = K / BK;
    unsigned voffB[2];
#pragma unroll
    for (int i = 0; i < 2; ++i) { int R, C; stage_rc(otid_w(wv) * 16 + i * 8192, R, C); const int Rb = (R & ~31) + perm32(R & 31); voffB[i] = (unsigned)(Rb * K + C) * 2u; }
#define GP_AOFFS(u, o00, o01, o10, o11) do { int R0, C0, R1, C1; const int t_ = otid_w(wv); stage_rc(t_ * 16, R0, C0); stage_rc(t_ * 16 + 8192, R1, C1); \
        o00 = S.arow(u, R0) + (unsigned)C0 * 2u; o01 = S.arow(u, R1) + (unsigned)C1 * 2u; o10 = S.arow(u, HALF + R0) + (unsigned)C0 * 2u; o11 = S.arow(u, HALF + R1) + (unsigned)C1 * 2u; } while (0)
    const size_t kstep = (size_t)(BK * 2);
    const size_t hstep = (size_t)HALF * K * 2;
    const unsigned ldsw = (unsigned)wid * 1024u;
    int aoff, boff; { const int l_ = lane_id(), fr = l_ & 15, fq = l_ >> 4; aoff = lds_byte(wr * 64 + fr, fq * 8); boff = lds_byte(wc * 32 + fr, fq * 8); }
#define GP_SA(b, h) (((b) * 2 + (h)) * HTB)
#define GP_SB(b, h) ((4 + (b) * 2 + (h)) * HTB)
#define GP_STAGE_B(bufoff, gbase) do { _Pragma("unroll") for (int _i = 0; _i < 2; ++_i) \
        __builtin_amdgcn_global_load_lds((const unsigned*)((const char*)(gbase) + voffB[_i]), (GP_LAS unsigned*)(lds + (bufoff) + ldsw + _i * 8192), 16, 0, 0); } while (0)
#define GP_STAGE_A(bufoff, gbase, o0, o1) do { \
        __builtin_amdgcn_global_load_lds((const unsigned*)((const char*)(gbase) + (o0)), (GP_LAS unsigned*)(lds + (bufoff) + ldsw), 16, 0, 0); \
        __builtin_amdgcn_global_load_lds((const unsigned*)((const char*)(gbase) + (o1)), (GP_LAS unsigned*)(lds + (bufoff) + ldsw + 8192), 16, 0, 0); } while (0)
#define GP_LDA(dst, b, h) do { _Pragma("unroll") for (int m = 0; m < 4; ++m) _Pragma("unroll") for (int k = 0; k < 2; ++k) dst[m][k] = *(const GP_LAS bf16x8*)(lds + GP_SA(b, h) + aoff + m * 2048 + k * 1024); } while (0)
#define GP_LDB(dst, b, h) do { _Pragma("unroll") for (int n = 0; n < 2; ++n) _Pragma("unroll") for (int k = 0; k < 2; ++k) dst[n][k] = *(const GP_LAS bf16x8*)(lds + GP_SB(b, h) + boff + n * 2048 + k * 1024); } while (0)
#define GP_MMA(ai, bj, At, Bt) do { __builtin_amdgcn_s_setprio(1); _Pragma("unroll") for (int m = 0; m < 4; ++m) _Pragma("unroll") for (int n = 0; n < 2; ++n) _Pragma("unroll") for (int k = 0; k < 2; ++k) \
        acc[ai][bj][m][n] = __builtin_amdgcn_mfma_f32_16x16x32_bf16(Bt[n][k], At[m][k], acc[ai][bj][m][n], 0, 0, 0); __builtin_amdgcn_s_setprio(0); } while (0)
#define GP_WAIT_V(n) asm volatile("s_waitcnt vmcnt(" #n ")" ::: "memory")
#define GP_WAIT_L(n) asm volatile("s_waitcnt lgkmcnt(" #n ")" ::: "memory")
#define GP_BAR __builtin_amdgcn_s_barrier()
#define GP_SCHED __builtin_amdgcn_sched_barrier(0)
    Unit cur, nxt; int ui = 0;
    if (!S.next(0, cur)) return;
    f32x4 acc[2][2][4][2];
#pragma unroll
    for (int a = 0; a < 2; ++a)
#pragma unroll
        for (int b = 0; b < 2; ++b)
#pragma unroll
            for (int m = 0; m < 4; ++m)
#pragma unroll
                for (int n = 0; n < 2; ++n) acc[a][b][m][n] = (f32x4){0.f, 0.f, 0.f, 0.f};
    bf16x8 At[4][2], B0[2][2], B1[2][2];
    unsigned ac00, ac01, ac10, ac11, an00, an01, an10, an11;
    GP_AOFFS(cur, ac00, ac01, ac10, ac11);
    const char* cB = S.bptr(cur);
    GP_STAGE_B(GP_SB(0, 0), cB); GP_STAGE_B(GP_SB(0, 1), cB + hstep); GP_STAGE_A(GP_SA(0, 0), Abase, ac00, ac01); GP_STAGE_A(GP_SA(0, 1), Abase, ac10, ac11);
    if (wr == 1) GP_BAR;
    GP_WAIT_V(2); GP_BAR;
    GP_STAGE_B(GP_SB(1, 0), cB + kstep); GP_STAGE_A(GP_SA(1, 0), Abase + kstep, ac00, ac01); GP_STAGE_B(GP_SB(1, 1), cB + hstep + kstep);
    GP_WAIT_V(6); GP_BAR;
    for (;;) {
        const bool has_next = S.next(ui + 1, nxt);
        if (has_next) { GP_AOFFS(nxt, an00, an01, an10, an11); }
        else { an00 = ac00; an01 = ac01; an10 = ac10; an11 = ac11; }
        const char* nB = has_next ? S.bptr(nxt) : cB;
        for (int t = 0; t < nt; t += 2) {
            const bool last = (t == nt - 2);
            const char* a1 = Abase + (size_t)(t + 1) * kstep;
            const char* a2 = last ? Abase : Abase + (size_t)(t + 2) * kstep; const char* b2 = last ? nB : cB + (size_t)(t + 2) * kstep;
            const char* a3 = a2 + kstep; const char* b3 = b2 + kstep;
            const unsigned x00 = last ? an00 : ac00, x01 = last ? an01 : ac01, x10 = last ? an10 : ac10, x11 = last ? an11 : ac11;
            GP_LDB(B0, 0, 0); GP_LDB(B1, 0, 1); GP_SCHED; GP_LDA(At, 0, 0); GP_STAGE_A(GP_SA(1, 1), a1, ac10, ac11);
            GP_WAIT_V(8); GP_WAIT_L(0); GP_BAR; GP_MMA(0, 0, At, B0); GP_MMA(0, 1, At, B1); GP_BAR; GP_SCHED;
            GP_LDA(At, 0, 1); GP_STAGE_B(GP_SB(0, 0), b2); GP_STAGE_B(GP_SB(0, 1), b2 + hstep); GP_STAGE_A(GP_SA(0, 0), a2, x00, x01);
            GP_WAIT_V(8); GP_WAIT_L(0); GP_BAR; GP_MMA(1, 0, At, B0); GP_MMA(1, 1, At, B1); GP_BAR; GP_SCHED;
            GP_LDB(B0, 1, 0); GP_LDB(B1, 1, 1); GP_SCHED; GP_LDA(At, 1, 0); GP_STAGE_A(GP_SA(0, 1), a2, x10, x11);
            GP_WAIT_V(8); GP_WAIT_L(0); GP_BAR; GP_MMA(0, 0, At, B0); GP_MMA(0, 1, At, B1); GP_BAR; GP_SCHED;
            GP_LDA(At, 1, 1); GP_STAGE_B(GP_SB(1, 0), b3); GP_STAGE_B(GP_SB(1, 1), b3 + hstep); GP_STAGE_A(GP_SA(1, 0), a3, x00, x01);
            GP_WAIT_V(8); GP_WAIT_L(0); GP_BAR; GP_MMA(1, 0, At, B0); GP_MMA(1, 1, At, B1); GP_BAR; GP_SCHED;
        }
        if constexpr (ALIGN_EPI) { if (wr == 0) GP_BAR; }
        { const int l_ = lane_id(); E(acc, cur, wr, wc, l_ & 15, l_ >> 4); }
        if (!has_next) break;
#pragma unroll
        for (int a = 0; a < 2; ++a)
#pragma unroll
            for (int b = 0; b < 2; ++b)
#pragma unroll
                for (int m = 0; m < 4; ++m)
#pragma unroll
                    for (int n = 0; n < 2; ++n) acc[a][b][m][n] = (f32x4){0.f, 0.f, 0.f, 0.f};
        cur = nxt; cB = nB; ac00 = an00; ac01 = an01; ac10 = an10; ac11 = an11; ++ui;
        if constexpr (ALIGN_EPI) { if (wr == 1) GP_BAR; }
    }
    GP_WAIT_V(0);
    if constexpr (!ALIGN_EPI) { if (wr == 0) GP_BAR; }
    GP_BAR;
#undef GP_AOFFS
#undef GP_SA
#undef GP_SB
#undef GP_STAGE_A
#undef GP_STAGE_B
#undef GP_LDA
#undef GP_LDB
#undef GP_MMA
#undef GP_WAIT_V
#undef GP_WAIT_L
#undef GP_BAR
#undef GP_SCHED
}

struct DenseSched {
    int nM, nN, nwg, G, c, K; const char* Bt;
    __device__ __forceinline__ void init(int M, int N, int K_, const void* Bt_, int G_, int c_) { nM = M / BM; nN = N / BM; nwg = nM * nN; G = G_; c = c_; K = K_; Bt = (const char*)Bt_; }
    __device__ __forceinline__ bool next(int i, Unit& u) const {
        const long L = (long)i * G + c; if (L >= nwg) return false;
        int wgid = (int)L; { const int q = nwg / 8, r = nwg % 8, xcd = wgid % 8, off = wgid / 8; wgid = (xcd < r ? xcd * (q + 1) : r * (q + 1) + (xcd - r) * q) + off; }
        const int nig = 8 * nN, gid = wgid / nig, fm = gid * 8, gsz = (nM - fm) < 8 ? (nM - fm) : 8;
        u.pm = fm + ((wgid % nig) % gsz); u.pn = (wgid % nig) / gsz; u.e = 0; u.b = 0; u.cnt = 0; u.base = 0; return true;
    }
    __device__ __forceinline__ unsigned arow(const Unit& u, int r) const { return (unsigned)(u.pm * BM + r) * (unsigned)(K * 2); }
    __device__ __forceinline__ const char* bptr(const Unit& u) const { return Bt + (size_t)u.pn * BM * K * 2; }
};
}

struct EpiInProj {
    bf16_t* F; bf16_t* Q; bf16_t* Kb; bf16_t* Vb; const float* rope;
    __device__ __forceinline__ void operator()(const f32x4 (&acc)[2][2][4][2], const gp::Unit& u, int wr, int wc, int fr, int fq) const {
        const int pn = u.pn, pm = u.pm; const bool isctx = pm >= T / 256;
        if (isctx && pn < 4) return;
        if (pn >= 7) {
            unsigned char* V8 = (unsigned char*)Vb;
#pragma unroll
            for (int ai = 0; ai < 2; ++ai) {
                const int row0 = pm * 256 + ai * 128 + wr * 64;
                int b, tile;
                if (!isctx) { b = row0 >> 13; tile = (CTX >> 6) + ((row0 & 8191) >> 6); } else { const int j = row0 - T; b = j >> 8; tile = (j & 255) >> 6; }
#pragma unroll
                for (int bj = 0; bj < 2; ++bj) {
                    const int head = (pn - 7) * 2 + bj;
                    unsigned char* dst = V8 + ((size_t)(b * NH + head) * (KVLEN / 64) + tile) * 8192 + wc * 2048 + fq * 64 + (fr >> 3) * 32 + (fr & 1) * 16 + ((fr >> 1) & 3) * 4;
#pragma unroll
                    for (int e = 0; e < 8; ++e) {
                        int w = __builtin_amdgcn_cvt_pk_fp8_f32(acc[ai][bj][0][e >> 2][e & 3], acc[ai][bj][1][e >> 2][e & 3], 0, false);
                        w = __builtin_amdgcn_cvt_pk_fp8_f32(acc[ai][bj][2][e >> 2][e & 3], acc[ai][bj][3][e >> 2][e & 3], w, true);
                        *(int*)(dst + e * 256) = w;
                    }
                }
            }
            return;
        }
        const int axis = wc & 1; const float* ct = rope + (axis ? 4096 : 0); const float* st = rope + (axis ? 4096 + 1024 : 2048);
#pragma unroll
        for (int ai = 0; ai < 2; ++ai)
#pragma unroll
            for (int m = 0; m < 4; ++m) {
                const int row = pm * 256 + ai * 128 + wr * 64 + m * 16 + fr;
                int t, kvrow;
                if (!isctx) { const int b = row >> 13; t = row & 8191; kvrow = b * KVLEN + CTX + t; } else { const int j = row - T; t = 0; kvrow = (j >> 8) * KVLEN + (j & 255); }
                const int pos = axis ? (t & 63) : (t >> 6);
#pragma unroll
                for (int bj = 0; bj < 2; ++bj) {
                    const int col0 = pn * 256 + bj * 128 + wc * 32 + fq * 8;
                    f32x4 v0 = acc[ai][bj][m][0], v1 = acc[ai][bj][m][1];
                    if (pn == 0) { gp::u32x4 w; w.x = gp::cvt_pk_bf16(v0[0], v0[1]); w.y = gp::cvt_pk_bf16(v0[2], v0[3]); w.z = gp::cvt_pk_bf16(v1[0], v1[1]); w.w = gp::cvt_pk_bf16(v1[2], v1[3]);
                        *(gp::u32x4*)(F + (size_t)row * 256 + col0) = w; continue; }
                    if (pn < 7 && !isctx) {
                        const f32x4 c0 = *(const f32x4*)(ct + pos * 16 + 8 * (fq & 1)), c1 = *(const f32x4*)(ct + pos * 16 + 8 * (fq & 1) + 4);
                        const f32x4 s0 = *(const f32x4*)(st + pos * 16 + 8 * (fq & 1)), s1 = *(const f32x4*)(st + pos * 16 + 8 * (fq & 1) + 4);
                        const float sg = (fq < 2) ? -1.f : 1.f;
#pragma unroll
                        for (int i = 0; i < 4; ++i) {
                            const auto r0 = __builtin_amdgcn_permlane32_swap(__float_as_uint(v0[i]), __float_as_uint(v0[i]), false, false);
                            const auto r1 = __builtin_amdgcn_permlane32_swap(__float_as_uint(v1[i]), __float_as_uint(v1[i]), false, false);
                            const float p0 = __uint_as_float(fq < 2 ? r0[1] : r0[0]), p1 = __uint_as_float(fq < 2 ? r1[1] : r1[0]);
                            v0[i] = v0[i] * c0[i] + sg * p0 * s0[i]; v1[i] = v1[i] * c1[i] + sg * p1 * s1[i]; }
                    }
                    if (pn < 4) { v0 = v0 * QSCALE; v1 = v1 * QSCALE; }
                    gp::u32x4 w; w.x = gp::cvt_pk_bf16(v0[0], v0[1]); w.y = gp::cvt_pk_bf16(v0[2], v0[3]); w.z = gp::cvt_pk_bf16(v1[0], v1[1]); w.w = gp::cvt_pk_bf16(v1[2], v1[3]);
                    bf16_t* d;
                    if (pn < 4) d = Q + (size_t)row * QKW + (col0 - 256);
                    else d = Kb + (size_t)kvrow * QKW + (col0 - 1024);
                    *(gp::u32x4*)d = w;
                }
            }
    }
};
struct EpiStoreBf16 {
    bf16_t* O; int ldc;
    __device__ __forceinline__ void operator()(const f32x4 (&acc)[2][2][4][2], const gp::Unit& u, int wr, int wc, int fr, int fq) const {
#pragma unroll
        for (int ai = 0; ai < 2; ++ai)
#pragma unroll
            for (int m = 0; m < 4; ++m) {
                bf16_t* rowp = O + (size_t)(u.pm * 256 + ai * 128 + wr * 64 + m * 16 + fr) * ldc + u.pn * 256 + wc * 32 + fq * 8;
#pragma unroll
                for (int bj = 0; bj < 2; ++bj) { const f32x4 v0 = acc[ai][bj][m][0], v1 = acc[ai][bj][m][1];
                    gp::u32x4 w; w.x = gp::cvt_pk_bf16(v0[0], v0[1]); w.y = gp::cvt_pk_bf16(v0[2], v0[3]); w.z = gp::cvt_pk_bf16(v1[0], v1[1]); w.w = gp::cvt_pk_bf16(v1[2], v1[3]);
                    *(gp::u32x4*)(rowp + bj * 128) = w; }
            }
    }
};

__device__ __forceinline__ void ph_inproj(const Params& p, unsigned char* smem) {
    unsigned char* ws = p.ws;
    gp::DenseSched S; S.init(MTOT, INW, D, ws + WS_WINT, gridDim.x, blockIdx.x);
    EpiInProj E{(bf16_t*)(ws + WS_F), (bf16_t*)(ws + WS_Q), (bf16_t*)(ws + WS_K), (bf16_t*)(ws + WS_V), (const float*)(ws + WS_ROPE)};
    gp::gemm_phase<EpiInProj, gp::DenseSched, true>(p.chunk, (GP_LAS unsigned char*)smem, (const char*)(ws + WS_HX), D, S, E);
}
__device__ __forceinline__ void ph_outproj(const Params& p, unsigned char* smem) {
    unsigned char* ws = p.ws;
    gp::DenseSched S; S.init(T, D, D, ws + WS_WOUTT, gridDim.x, blockIdx.x);
    EpiStoreBf16 E{(bf16_t*)(ws + WS_YX), D};
    gp::gemm_phase<EpiStoreBf16, gp::DenseSched, true>(p.chunk, (GP_LAS unsigned char*)smem, (const char*)(ws + WS_AO), D, S, E);
}

__device__ __forceinline__ void transpose_item(const float* W, int K, int N, bf16_t* WT, int row_base, int kb, int nb, float* scr, int lane) {
    const int k0 = 64 * kb, n0 = 32 * nb;
    float tv[32];
#pragma unroll
    for (int i = 0; i < 32; ++i) tv[i] = W[(size_t)(k0 + 2 * i + (lane >> 5)) * N + n0 + (lane & 31)];
#pragma unroll
    for (int i = 0; i < 32; ++i) scr[(2 * i + (lane >> 5)) * 33 + (lane & 31)] = tv[i];
    asm volatile("s_waitcnt lgkmcnt(0)" ::: "memory");
    const int c = lane & 7;
#pragma unroll
    for (int j = 0; j < 4; ++j) { const int n = (lane >> 3) + 8 * j; const float* s = scr + (8 * c) * 33 + n;
        uint4 o; o.x = pk2(s[0 * 33], s[1 * 33]); o.y = pk2(s[2 * 33], s[3 * 33]); o.z = pk2(s[4 * 33], s[5 * 33]); o.w = pk2(s[6 * 33], s[7 * 33]);
        *(uint4*)(WT + (size_t)(row_base + n0 + n) * K + k0 + 8 * c) = o; }
    asm volatile("s_waitcnt lgkmcnt(0)" ::: "memory");
}
__device__ __forceinline__ void ph_prep_weights(const Params& p, float* lds, const int part, const int first) {
    const int tid = otid(), wave = tid >> 6, lane = tid & 63;
    float* scr = lds + 8192 + wave * (64 * 33);
    if ((int)blockIdx.x < first) return;
    const int gw = ((int)blockIdx.x - first) * NWV + wave, GW = ((int)gridDim.x - first) * NWV;
    unsigned char* ws = p.ws;
    constexpr int I_IN = 16 * 80, I_OUT = 16 * 32, I_GU = 16 * 8, I_D = 4 * 32;
    constexpr int NITEMS = I_IN + I_OUT + 65 * (2 * I_GU + I_D);
    const int it_lo = part ? I_IN + I_OUT : 0, it_hi = part ? NITEMS : I_IN + I_OUT;
    for (int it = it_lo + gw; it < it_hi; it += GW) {
        int r = it;
        if (r < I_IN) { transpose_item(p.in[I_WIN], D, INW, (bf16_t*)(ws + WS_WINT), 0, r / 80, r % 80, scr, lane); continue; } r -= I_IN;
        if (r < I_OUT) { transpose_item(p.in[I_WOUT], D, D, (bf16_t*)(ws + WS_WOUTT), 0, r / 32, r % 32, scr, lane); continue; } r -= I_OUT;
        const int e = r / (2 * I_GU + I_D); r -= e * (2 * I_GU + I_D);
        if (r < 2 * I_GU) {
            const int half = r / I_GU, q = r % I_GU, kb = q / 8, nb = q % 8;
            const float* W = (e < 64) ? p.in[half ? I_WU : I_WG] + (size_t)e * D * DE : p.in[half ? I_WSU : I_WSG];
            const int n0 = 32 * nb, drow = e * 512 + (n0 >> 7) * 256 + half * 128 + (n0 & 127);
            transpose_item(W, D, DE, (bf16_t*)(ws + WS_WGUT), drow - n0, kb, nb, scr, lane);
        } else {
            r -= 2 * I_GU;
            const float* W = (e < 64) ? p.in[I_WD] + (size_t)e * DE * D : p.in[I_WSD];
            transpose_item(W, DE, D, (bf16_t*)(ws + WS_WDT), e * 1024, r / 32, r % 32, scr, lane);
        }
    }
}

namespace fa {
typedef short bf16x8 __attribute__((ext_vector_type(8)));
typedef short s16x4 __attribute__((ext_vector_type(4)));
typedef float f32x16 __attribute__((ext_vector_type(16)));
typedef unsigned u32x4 __attribute__((ext_vector_type(4)));
constexpr int KVBLK = 64, LDK = QKW;
constexpr float SCALE = 0.125f, THR = 8.f;
constexpr size_t SHM_V = KVBLK * 128 * 2, SHM_K = KVBLK * 128 * 2;
#define KSWZ(row, colB) ((row) * 256 + ((colB) ^ (((row) & 15) << 4)))
#define SBAR() __builtin_amdgcn_sched_barrier(0)
__device__ __forceinline__ int crow(int r, int hi) { return (r & 3) + 8 * (r >> 2) + 4 * hi; }
__device__ __forceinline__ unsigned cvtpk(float lo, float hi) { unsigned r; asm volatile("v_cvt_pk_bf16_f32 %0, %1, %2" : "=v"(r) : "v"(lo), "v"(hi)); return r; }
constexpr float PBIAS = 5.f, THR2 = PBIAS + 3.5f;
template <bool FIRST>
__device__ __forceinline__ void partialSM(f32x16& p0, f32x16& p1, float& m_reg, f32x16& negm, float& alpha) {
  float pmax = p0[0];
#pragma unroll
  for (int r = 1; r < 16; ++r) pmax = fmaxf(pmax, p0[r]);
#pragma unroll
  for (int r = 0; r < 16; ++r) pmax = fmaxf(pmax, p1[r]);
  { auto rr = __builtin_amdgcn_permlane32_swap(__float_as_uint(pmax), __float_as_uint(pmax), false, false);
    pmax = fmaxf(__uint_as_float(rr[0]), __uint_as_float(rr[1])); }
  if (!FIRST && __builtin_expect(__all(pmax <= THR2), 1)) { alpha = 1.f; }
  else { const float dl = FIRST ? pmax - PBIAS : fmaxf(pmax - PBIAS, 0.f); alpha = FIRST ? 0.f : __builtin_amdgcn_exp2f(-dl); m_reg += dl;
#pragma unroll
    for (int r = 0; r < 16; ++r) { p0[r] -= dl; p1[r] -= dl; }
#pragma unroll
    for (int r = 0; r < 16; ++r) negm[r] = -m_reg;
    asm volatile("" : "+v"(negm)); }
#pragma unroll
  for (int r = 0; r < 16; ++r) p0[r] = __builtin_amdgcn_exp2f(p0[r]);
}
typedef int i32x8 __attribute__((ext_vector_type(8)));
__device__ __forceinline__ void finishSM_T(f32x16& p0, f32x16& p1, float alpha, float& l_reg, i32x8& pb) {
#pragma unroll
  for (int r = 0; r < 16; ++r) p1[r] = __builtin_amdgcn_exp2f(p1[r]);
  typedef float f32x2 __attribute__((ext_vector_type(2)));
  f32x2 s2 = {p0[0], p0[1]};
#pragma unroll
  for (int r = 2; r < 16; r += 2) s2 += (f32x2){p0[r], p0[r + 1]};
#pragma unroll
  for (int r = 0; r < 16; r += 2) s2 += (f32x2){p1[r], p1[r + 1]};
  float ps = s2[0] + s2[1];
  { auto rr = __builtin_amdgcn_permlane32_swap(__float_as_uint(ps), __float_as_uint(ps), false, false);
    ps = __uint_as_float(rr[0]) + __uint_as_float(rr[1]); }
  l_reg = l_reg * alpha + ps;
#pragma unroll
  for (int g = 0; g < 4; ++g) {
    int w0 = __builtin_amdgcn_cvt_pk_fp8_f32(p0[4 * g], p0[4 * g + 1], 0, false); w0 = __builtin_amdgcn_cvt_pk_fp8_f32(p0[4 * g + 2], p0[4 * g + 3], w0, true); pb[g] = w0;
    int w1 = __builtin_amdgcn_cvt_pk_fp8_f32(p1[4 * g], p1[4 * g + 1], 0, false); w1 = __builtin_amdgcn_cvt_pk_fp8_f32(p1[4 * g + 2], p1[4 * g + 3], w1, true); pb[4 + g] = w1; }
}
__device__ __forceinline__ void qkt(f32x16& p0, f32x16& p1, const char* Ks, const bf16x8* qr, int r32, int hi, int mm, const f32x16& negm) {
#pragma unroll
  for (int d0 = 0; d0 < 4; ++d0) { const int cb = (mm * 64 + d0 * 16 + hi * 8) * 2;
    const bf16x8 b0 = *reinterpret_cast<const bf16x8*>(Ks + KSWZ(r32, cb));
    const bf16x8 b1 = *reinterpret_cast<const bf16x8*>(Ks + KSWZ(32 + r32, cb));
    if (d0 == 0) { p0 = __builtin_amdgcn_mfma_f32_32x32x16_bf16(b0, qr[0], negm, 0, 0, 0); p1 = __builtin_amdgcn_mfma_f32_32x32x16_bf16(b1, qr[0], negm, 0, 0, 0); }
    else { p0 = __builtin_amdgcn_mfma_f32_32x32x16_bf16(b0, qr[d0], p0, 0, 0, 0); p1 = __builtin_amdgcn_mfma_f32_32x32x16_bf16(b1, qr[d0], p1, 0, 0, 0); } }
}
__device__ __forceinline__ int v_st(int k, int c) { const int kk = (k & ~0xC) | ((k & 4) << 1) | ((k & 8) >> 1); return ((kk >> 3) * 4 + (c >> 5)) * 512 + ((kk & 7) * 32 + (c & 31)) * 2; }
__device__ __forceinline__ int v_rd_base(int lane) { return ((lane & 3) << 3) | (((lane >> 2) & 3) << 6) | (((lane >> 4) & 1) << 5) | (((lane >> 5) & 1) << 8); }
constexpr int v_rd_off(int d0, int ks, int half) { return d0 * 512 + ks * 4096 + half * 2048; }
template <int OFF> __device__ __forceinline__ s16x4 tr_read(int vb) {
  s16x4 r; asm volatile("ds_read_b64_tr_b16 %0, %1 offset:%2" : "=&v"(r) : "v"(vb), "i"(OFF) : "memory"); return r;
}
template <int D0> __device__ __forceinline__ void pv_one(f32x16& od, int vb, bf16x8 pa0, bf16x8 pa1, bf16x8 pa2, bf16x8 pa3) {
  const s16x4 l0 = tr_read<v_rd_off(D0, 0, 0)>(vb), h0 = tr_read<v_rd_off(D0, 0, 1)>(vb), l1 = tr_read<v_rd_off(D0, 1, 0)>(vb), h1 = tr_read<v_rd_off(D0, 1, 1)>(vb);
  const s16x4 l2 = tr_read<v_rd_off(D0, 2, 0)>(vb), h2 = tr_read<v_rd_off(D0, 2, 1)>(vb), l3 = tr_read<v_rd_off(D0, 3, 0)>(vb), h3 = tr_read<v_rd_off(D0, 3, 1)>(vb);
  asm volatile("s_waitcnt lgkmcnt(0)" ::: "memory"); SBAR();
#define PK(L, H) (bf16x8){L[0], L[1], L[2], L[3], H[0], H[1], H[2], H[3]}
  od = __builtin_amdgcn_mfma_f32_32x32x16_bf16(pa0, PK(l0, h0), od, 0, 0, 0);
  od = __builtin_amdgcn_mfma_f32_32x32x16_bf16(pa1, PK(l1, h1), od, 0, 0, 0);
  od = __builtin_amdgcn_mfma_f32_32x32x16_bf16(pa2, PK(l2, h2), od, 0, 0, 0);
  od = __builtin_amdgcn_mfma_f32_32x32x16_bf16(pa3, PK(l3, h3), od, 0, 0, 0);
#undef PK
}
__device__ __forceinline__ void pv_d0(f32x16* o, int vb, bf16x8 pa0, bf16x8 pa1, bf16x8 pa2, bf16x8 pa3) {
  pv_one<0>(o[0], vb, pa0, pa1, pa2, pa3); pv_one<1>(o[1], vb, pa0, pa1, pa2, pa3); pv_one<2>(o[2], vb, pa0, pa1, pa2, pa3); pv_one<3>(o[3], vb, pa0, pa1, pa2, pa3);
}

template <int OFF> __device__ __forceinline__ u32x4 rd128(int vb) { u32x4 r; asm volatile("ds_read_b128 %0, %1 offset:%2" : "=&v"(r) : "v"(vb), "i"(OFF) : "memory"); return r; }
#define PV_RD(D0) const u32x4 va##D0 = rd128<D0 * 2048>(vb), vc##D0 = rd128<D0 * 2048 + 1024>(vb); SBAR()
#define PV_MM(D0) do { asm volatile("s_waitcnt lgkmcnt(0)" ::: "memory"); SBAR(); \
    o[D0] = __builtin_amdgcn_mfma_scale_f32_32x32x64_f8f6f4((i32x8){(int)va##D0.x, (int)va##D0.y, (int)va##D0.z, (int)va##D0.w, (int)vc##D0.x, (int)vc##D0.y, (int)vc##D0.z, (int)vc##D0.w}, pb, o[D0], 0, 0, 0, 0, 0, 0); } while (0)
__device__ __forceinline__ float max3f(float a, float b, float c) { float r; asm("v_max3_f32 %0, %1, %2, %3" : "=v"(r) : "v"(a), "v"(b), "v"(c)); return r; }
__device__ __forceinline__ void pv_psm(f32x16* o, int vb, i32x8 pb, f32x16& p0, f32x16& p1, float& m_reg, f32x16& negm, float& alpha) {
  float pmax;
  { PV_RD(0);
    pmax = max3f(p0[0], p0[1], p0[2]);
#pragma unroll
    for (int r = 3; r < 15; r += 2) pmax = max3f(pmax, p0[r], p0[r + 1]);
    pmax = max3f(pmax, p0[15], p1[0]);
    SBAR(); PV_MM(0); }
  { PV_RD(1);
#pragma unroll
    for (int r = 1; r < 15; r += 2) pmax = max3f(pmax, p1[r], p1[r + 1]);
    pmax = max3f(pmax, p1[15], p1[15]);
    { auto rr = __builtin_amdgcn_permlane32_swap(__float_as_uint(pmax), __float_as_uint(pmax), false, false);
      pmax = max3f(__uint_as_float(rr[0]), __uint_as_float(rr[1]), __uint_as_float(rr[1])); }
    if (__builtin_expect(__all(pmax <= THR2), 1)) { alpha = 1.f; }
    else { const float dl = fmaxf(pmax - PBIAS, 0.f); alpha = __builtin_amdgcn_exp2f(-dl); m_reg += dl;
#pragma unroll
      for (int r = 0; r < 16; ++r) { p0[r] -= dl; p1[r] -= dl; }
#pragma unroll
      for (int r = 0; r < 16; ++r) negm[r] = -m_reg;
      asm volatile("" : "+v"(negm)); }
    SBAR(); PV_MM(1); }
  { PV_RD(2);
#pragma unroll
    for (int r = 0; r < 8; ++r) p0[r] = __builtin_amdgcn_exp2f(p0[r]);
    asm volatile("" : "+v"(p0));
    SBAR(); PV_MM(2); }
  { PV_RD(3);
#pragma unroll
    for (int r = 8; r < 16; ++r) p0[r] = __builtin_amdgcn_exp2f(p0[r]);
    asm volatile("" : "+v"(p0));
    SBAR(); PV_MM(3); }
}
__device__ __forceinline__ void pvT_d0(f32x16* o, int vb, i32x8 pb) {
  { PV_RD(0); PV_MM(0); } { PV_RD(1); PV_MM(1); } { PV_RD(2); PV_MM(2); } { PV_RD(3); PV_MM(3); }
}
#undef PV_RD
#undef PV_MM

__device__ __forceinline__ void attn_unit(const bf16_t* __restrict__ Qb, const bf16_t* __restrict__ Kh, const unsigned char* __restrict__ Vh, bf16_t* __restrict__ Ob,
                                          const float* __restrict__ gsub, const float lam, char* lds, const int wv) {
  typedef __attribute__((address_space(3))) unsigned* ldsu_t;
  const int tid = otid_w(wv), wid = wv, lane = tid & 63, r32 = lane & 31, hi = lane >> 5, mm = wid >> 2, wq = wid & 3;
  constexpr int NB = 4;
  constexpr int SHM_V8 = KVBLK * 128;
  char* V_lds = lds; char* K_lds = lds + NB * SHM_V8;
  float m_reg = 0.f, l_reg = 0; f32x16 o[4] = {}; bf16x8 qr[4]; f32x16 negm = {}; asm volatile("" : "+v"(negm));
  unsigned koff[2];
#pragma unroll
  for (int i = 0; i < 2; ++i) { const int piece = 2 * wid + i;
    const int row = 4 * piece + (lane >> 4), slot = lane & 15, key = 16 * (row & 3) + 8 * (row >> 5) + 2 * ((row >> 3) & 3) + ((row >> 2) & 1);
    koff[i] = 2u * (unsigned)(key * LDK + 8 * (slot ^ (row & 15))); }
  const unsigned voff = (unsigned)((wid >> 1) * 2048 + (lane & 7) * 256 + ((lane >> 3) & 3) * 64 + (wid & 1) * 32 + (lane >> 5) * 16);
#define DMA(t, buf) do { const char* kb_ = (const char*)(Kh + (size_t)(t) * KVBLK * LDK); const char* vb_ = (const char*)(Vh + (size_t)(t) * SHM_V8); asm volatile("" : "+s"(kb_), "+s"(vb_)); \
    _Pragma("unroll") for (int i_ = 0; i_ < 2; ++i_) \
      __builtin_amdgcn_global_load_lds((const unsigned*)(kb_ + koff[i_]), (ldsu_t)(K_lds + (buf) * SHM_K + (2 * wid + i_) * 1024), 16, 0, 0); \
    __builtin_amdgcn_global_load_lds((const unsigned*)(vb_ + voff), (ldsu_t)(V_lds + (buf) * SHM_V8 + wid * 1024), 16, 0, 0); } while (0)
#define WAIT_BAR(N) asm volatile("s_waitcnt vmcnt(" #N ") lgkmcnt(0)\n\ts_barrier" ::: "memory")
#define RESC(a) do { if (__any((a) < 1.f)) { _Pragma("unroll") for (int d = 0; d < 4; ++d) _Pragma("unroll") for (int r = 0; r < 16; ++r) o[d][r] *= (a); } } while (0)
  DMA(0, 0); DMA(1, 1);
  const bf16_t* Qw = Qb + (long)(wq * 32 + r32) * QKW + mm * 64 + hi * 8;
#pragma unroll
  for (int d0 = 0; d0 < 4; ++d0) qr[d0] = *reinterpret_cast<const bf16x8*>(Qw + d0 * 16);
  const int vb0 = (int)(uintptr_t)V_lds + lane * 16;
  f32x16 pA0, pA1, pB0, pB1; float alA, alB; i32x8 pb; constexpr int NTL = KVLEN / KVBLK;
  WAIT_BAR(0);
  DMA(2, 2);
  qkt(pA0, pA1, K_lds, qr, r32, hi, mm, negm); partialSM<true>(pA0, pA1, m_reg, negm, alA);
  WAIT_BAR(3);
  for (int j = 1; j + 1 < NTL; j += 2) {
    DMA(j + 2, (j + 2) & 3);
    SBAR(); qkt(pB0, pB1, K_lds + (j & 3) * SHM_K, qr, r32, hi, mm, negm);
    finishSM_T(pA0, pA1, alA, l_reg, pb); SBAR();
    pv_psm(o, vb0 + ((j - 1) & 3) * SHM_V8, pb, pB0, pB1, m_reg, negm, alB);
    RESC(alB);
    WAIT_BAR(3);
    if (j + 3 < NTL) DMA(j + 3, (j + 3) & 3);
    SBAR(); qkt(pA0, pA1, K_lds + ((j + 1) & 3) * SHM_K, qr, r32, hi, mm, negm);
    finishSM_T(pB0, pB1, alB, l_reg, pb); SBAR();
    pv_psm(o, vb0 + (j & 3) * SHM_V8, pb, pA0, pA1, m_reg, negm, alA);
    RESC(alA);
    if (j + 3 < NTL) WAIT_BAR(3); else WAIT_BAR(0);
  }
  SBAR(); qkt(pB0, pB1, K_lds + ((NTL - 1) & 3) * SHM_K, qr, r32, hi, mm, negm);
  finishSM_T(pA0, pA1, alA, l_reg, pb); SBAR();
  pv_psm(o, vb0 + ((NTL - 2) & 3) * SHM_V8, pb, pB0, pB1, m_reg, negm, alB);
  RESC(alB);
  finishSM_T(pB0, pB1, alB, l_reg, pb); SBAR();
  pvT_d0(o, vb0 + ((NTL - 1) & 3) * SHM_V8, pb);
#undef DMA
#undef WAIT_BAR
  const float rl = __builtin_amdgcn_rcpf(l_reg) * (mm ? lam : 1.0f);
  __syncthreads();
  constexpr int XS = 132;
  float* X = (float*)lds;
  if (mm == 1) {
#pragma unroll
    for (int r = 0; r < 16; ++r)
#pragma unroll
      for (int d0 = 0; d0 < 4; ++d0) X[(wq * 32 + r32) * XS + d0 * 32 + crow(r, hi)] = o[d0][r] * rl;
  }
  __syncthreads();
  if (mm == 0) {
#pragma unroll
    for (int r = 0; r < 16; ++r)
#pragma unroll
      for (int d0 = 0; d0 < 4; ++d0) { float* xp = X + (wq * 32 + r32) * XS + d0 * 32 + crow(r, hi); *xp = o[d0][r] * rl - *xp; }
  }
  __syncthreads();
  {
    const int row = tid >> 2, seg = tid & 3;
    const float* xr = X + row * XS + seg * 32;
    f32x4 v[8]; float ss = 0.f;
#pragma unroll
    for (int i = 0; i < 8; ++i) { v[i] = *(const f32x4*)(xr + 4 * i); ss += v[i][0] * v[i][0] + v[i][1] * v[i][1] + v[i][2] * v[i][2] + v[i][3] * v[i][3]; }
    ss += sx<1>(ss); ss += sx<2>(ss);
    const float rs = (1.0f - LAM_INIT) / sqrtf(ss * (1.0f / 128.0f) + EPS);
    bf16_t* dst = Ob + (long)row * D + seg * 32;
#pragma unroll
    for (int i = 0; i < 8; i += 2) {
      const f32x4 g0 = *(const f32x4*)(gsub + seg * 32 + 4 * i), g1 = *(const f32x4*)(gsub + seg * 32 + 4 * i + 4);
      u32x4 w; w.x = cvtpk(v[i][0] * rs * g0[0], v[i][1] * rs * g0[1]); w.y = cvtpk(v[i][2] * rs * g0[2], v[i][3] * rs * g0[3]);
      w.z = cvtpk(v[i + 1][0] * rs * g1[0], v[i + 1][1] * rs * g1[1]); w.w = cvtpk(v[i + 1][2] * rs * g1[2], v[i + 1][3] * rs * g1[3]);
      *(u32x4*)(dst + 4 * i) = w;
    }
  }
  __syncthreads();
#undef RESC
}
#undef KSWZ
#undef SBAR
}

__device__ __forceinline__ void ph_attn(const Params& p, unsigned char* smem) {
    unsigned char* ws = p.ws;
    const bf16_t* Q = (const bf16_t*)(ws + WS_Q); const bf16_t* Kb = (const bf16_t*)(ws + WS_K); const unsigned char* Vb = ws + WS_V;
    bf16_t* AO = (bf16_t*)(ws + WS_AO);
    const float lam = ((const float*)(ws + WS_CTL))[1024];
    const int c = blockIdx.x, G = gridDim.x;
    if (G == 256) {
        const int x = c & 7, s = c >> 3;
        for (int rd = 0; rd < 6; ++rd) {
            const int bh = rd * 4 + (x >> 1), qb = (x & 1) * 32 + s, b = bh / NH, h = bh % NH;
            fa::attn_unit(Q + ((size_t)b * SEQ + qb * 128) * QKW + h * 128, Kb + (size_t)b * KVLEN * QKW + h * 128, Vb + (size_t)(b * NH + h) * (KVLEN / 64) * 8192,
                          AO + ((size_t)b * SEQ + qb * 128) * D + 256 + h * 128, p.in[I_GSUB], lam, (char*)smem, p.chunk);
        }
    } else {
        for (int u = c; u < BATCH * NH * 64; u += G) {
            const int bh = u >> 6, qb = u & 63, b = bh / NH, h = bh % NH;
            fa::attn_unit(Q + ((size_t)b * SEQ + qb * 128) * QKW + h * 128, Kb + (size_t)b * KVLEN * QKW + h * 128, Vb + (size_t)(b * NH + h) * (KVLEN / 64) * 8192,
                          AO + ((size_t)b * SEQ + qb * 128) * D + 256 + h * 128, p.in[I_GSUB], lam, (char*)smem, p.chunk);
        }
    }
}

__device__ __forceinline__ void ph_fourierA(const Params& p, unsigned char* smem) {
    using namespace fa;
    unsigned char* ws = p.ws;
    const bf16_t* F = (const bf16_t*)(ws + WS_F); bf16_t* FY = (bf16_t*)(ws + WS_FY); const bf16_t* W = (const bf16_t*)(ws + WS_W128E);
    const int tid = otid(), wid = tid >> 6, lane = tid & 63, r32 = lane & 31, hi = lane >> 5;
    const int sr = tid >> 4, sc = (tid & 15) * 8, vst0 = v_st(sr, sc), vst1 = v_st(32 + sr, sc);
    const int vb0 = (int)(uintptr_t)smem + v_rd_base(lane);
    for (int task = blockIdx.x; task < BATCH * 64; task += gridDim.x) {
        const int b = task >> 6, n2 = task & 63;
        bf16x8 st[4][2];
#pragma unroll
        for (int kt = 0; kt < 2; ++kt)
#pragma unroll
            for (int ct = 0; ct < 2; ++ct) {
                st[kt * 2 + ct][0] = *(const bf16x8*)(F + ((size_t)b * SEQ + 64 * (64 * kt + sr) + n2) * 256 + 128 * ct + sc);
                st[kt * 2 + ct][1] = *(const bf16x8*)(F + ((size_t)b * SEQ + 64 * (64 * kt + 32 + sr) + n2) * 256 + 128 * ct + sc);
            }
        bf16x8 pa[2][4];
#pragma unroll
        for (int kt = 0; kt < 2; ++kt)
#pragma unroll
            for (int ks = 0; ks < 4; ++ks) pa[kt][ks] = *(const bf16x8*)(W + (size_t)(32 * wid + r32) * 128 + 64 * kt + 16 * ks + 8 * hi);
        __syncthreads();
#pragma unroll
        for (int q = 0; q < 4; ++q) { *(bf16x8*)(smem + q * 16384 + vst0) = st[q][0]; *(bf16x8*)(smem + q * 16384 + vst1) = st[q][1]; }
        __syncthreads();
        f32x16 o[2][4] = {};
#pragma unroll
        for (int ct = 0; ct < 2; ++ct)
#pragma unroll
            for (int kt = 0; kt < 2; ++kt) pv_d0(o[ct], vb0 + (kt * 2 + ct) * 16384, pa[kt][0], pa[kt][1], pa[kt][2], pa[kt][3]);
        const int plane = wid >> 2;
#pragma unroll
        for (int r = 0; r < 16; ++r) {
            const int k1 = 32 * (wid & 3) + crow(r, hi);
            bf16_t* dst = FY + ((((size_t)plane * BATCH + b) * 128 + k1) * 64 + n2) * 256 + r32;
#pragma unroll
            for (int ct = 0; ct < 2; ++ct)
#pragma unroll
                for (int d0 = 0; d0 < 4; ++d0) dst[128 * ct + 32 * d0] = f2bf(o[ct][d0][r]);
        }
    }
    __syncthreads();
}
__device__ __forceinline__ void ph_fourierB(const Params& p, unsigned char* smem) {
    using namespace fa;
    unsigned char* ws = p.ws;
    const bf16_t* FY = (const bf16_t*)(ws + WS_FY); const float2* tabw = (const float2*)(ws + WS_TABW);
    const bf16_t* M64 = (const bf16_t*)(ws + WS_M64E); const bf16_t* GT = (const bf16_t*)(ws + WS_GT);
    bf16_t* AO = (bf16_t*)(ws + WS_AO);
    const int tid = otid(), wid = tid >> 6, lane = tid & 63, r32 = lane & 31, hi = lane >> 5;
    const int sr = tid >> 4, sc = (tid & 15) * 8, vst0 = v_st(sr, sc), vst1 = v_st(32 + sr, sc);
    const int vb0 = (int)(uintptr_t)smem + v_rd_base(lane);
    constexpr int XRS = 528;
    unsigned char* XL = smem + 65536;
    const int mt = wid & 3, ctw = wid >> 2;
    for (int task = blockIdx.x; task < BATCH * 128; task += gridDim.x) {
        const int b = task >> 7, k1 = task & 127;
        __syncthreads();
#pragma unroll
        for (int ct = 0; ct < 2; ++ct)
#pragma unroll
            for (int rh = 0; rh < 2; ++rh) {
                const int n2 = sr + 32 * rh;
                const size_t off = ((((size_t)b) * 128 + k1) * 64 + n2) * 256 + 128 * ct + sc;
                const uint4 yr = *(const uint4*)(FY + off), yi = *(const uint4*)(FY + (size_t)BATCH * 128 * 64 * 256 + off);
                const float2 tw = tabw[n2 * k1];
                const unsigned yrw[4] = {yr.x, yr.y, yr.z, yr.w}, yiw[4] = {yi.x, yi.y, yi.z, yi.w};
                unsigned zr[4], zi[4];
#pragma unroll
                for (int q = 0; q < 4; ++q) {
                    const float a0 = __uint_as_float(yrw[q] << 16), a1 = __uint_as_float(yrw[q] & 0xffff0000u), b0 = __uint_as_float(yiw[q] << 16), b1 = __uint_as_float(yiw[q] & 0xffff0000u);
                    zr[q] = pk2(a0 * tw.x + b0 * tw.y, a1 * tw.x + b1 * tw.y); zi[q] = pk2(b0 * tw.x - a0 * tw.y, b1 * tw.x - a1 * tw.y);
                }
                const int vs = rh ? vst1 : vst0;
                *(uint4*)(smem + (0 * 2 + ct) * 16384 + vs) = make_uint4(zr[0], zr[1], zr[2], zr[3]);
                *(uint4*)(smem + (1 * 2 + ct) * 16384 + vs) = make_uint4(zi[0], zi[1], zi[2], zi[3]);
            }
        __syncthreads();
        {
            f32x16 o[4] = {};
#pragma unroll
            for (int kt = 0; kt < 2; ++kt) {
                bf16x8 pa[4];
#pragma unroll
                for (int ks = 0; ks < 4; ++ks) pa[ks] = *(const bf16x8*)(M64 + (size_t)(32 * mt + r32) * 128 + 64 * kt + 16 * ks + 8 * hi);
                pv_d0(o, vb0 + (kt * 2 + ctw) * 16384, pa[0], pa[1], pa[2], pa[3]);
            }
#pragma unroll
            for (int r = 0; r < 16; ++r) {
                const int ro = 32 * mt + crow(r, hi);
                bf16_t* xr = (bf16_t*)(XL + ((ro >> 6) * 64 + (ro & 63)) * XRS) + 128 * ctw + r32;
#pragma unroll
                for (int d0 = 0; d0 < 4; ++d0) xr[32 * d0] = f2bf(o[d0][r]);
            }
        }
        __syncthreads();
#pragma unroll
        for (int tt = 0; tt < 2; ++tt) {
            const int tau = 2 * wid + tt, g = tau >> 2, mt2 = (tau >> 1) & 1, nt2 = tau & 1;
            f32x16 acc = {};
#pragma unroll
            for (int ks8 = 0; ks8 < 8; ++ks8) {
                const int part = ks8 >> 2, cb = ks8 & 3;
                const bf16x8 af = *(const bf16x8*)(XL + (part * 64 + 32 * mt2 + r32) * XRS + (g * 64 + 16 * cb + 8 * hi) * 2);
                const bf16x8 bfr = *(const bf16x8*)(GT + ((size_t)g * 64 + 32 * nt2 + r32) * 128 + part * 64 + 16 * cb + 8 * hi);
                acc = __builtin_amdgcn_mfma_f32_32x32x16_bf16(af, bfr, acc, 0, 0, 0);
            }
#pragma unroll
            for (int r = 0; r < 16; ++r) { const int k2 = 32 * mt2 + crow(r, hi);
                AO[((size_t)b * SEQ + k1 + 128 * k2) * D + g * 64 + 32 * nt2 + r32] = f2bf(acc[r]); }
        }
    }
    __syncthreads();
}

__device__ __forceinline__ void ph_mid(const Params& p, unsigned char* smem) {
    typedef short bf16x8 __attribute__((ext_vector_type(8)));
    unsigned char* ws = p.ws;
    const int tid = otid(), wave = tid >> 6, lane = tid & 63, fr = lane & 15, fq = lane >> 4;
    const float* mod = (const float*)(ws + WS_MOD);
    const bf16_t* YX = (const bf16_t*)(ws + WS_YX);
    bf16_t* H2 = (bf16_t*)(ws + WS_H2);
    unsigned* counts = (unsigned*)(ws + WS_CTL);
    int* TE = (int*)(ws + WS_TE); int* TP = (int*)(ws + WS_TP); float* TW = (float*)(ws + WS_TW); int* TOKL = (int*)(ws + WS_TOKL);
    constexpr int RS = 2064;
    unsigned char* Ahi = smem; unsigned char* Alo = smem + 16 * RS; float* Pp = (float*)(smem + 2 * 16 * RS + 512);
    const float rbias = p.in[I_RB][lane];
    int* lcnt = (int*)(smem + 99328); int* gb = lcnt + 64; int* PE = gb + 64; float* PW = (float*)(PE + 1024); float* PV = PW + 1024;
    for (int chunk = blockIdx.x; chunk < T / 128; chunk += gridDim.x) {
      const int mc = chunk * 128, b = mc >> 13;
      if (tid < 64) lcnt[tid] = 0;
      {
          const float* mrow_ = mod + b * 6144;
          for (int i = tid; i < 5 * 256; i += NT) { const int v_ = i >> 8, q_ = (i & 255) * 4;
              const float* s_ = (v_ == 0) ? p.in[I_GAPOST] + q_ : (v_ == 1) ? mrow_ + 2 * 1024 + q_ : (v_ == 2) ? p.in[I_GFPRE] + q_ : (v_ == 3) ? mrow_ + 3 * 1024 + q_ : mrow_ + 4 * 1024 + q_;
              *(f32x4*)(PV + v_ * 1024 + q_) = *(const f32x4*)s_; }
          __syncthreads();
      }
      uint2 yw[2][4]; f32x4 xv[2][4];
#define MID_LOAD(m0_) do { _Pragma("unroll") for (int rr = 0; rr < 2; ++rr) { const int m_ = (m0_) + 2 * wave + rr; _Pragma("unroll") for (int j = 0; j < 4; ++j) { \
          yw[rr][j] = *(const uint2*)(YX + (size_t)m_ * D + 4 * (lane + 64 * j)); xv[rr][j] = ((const f32x4*)(p.in[I_X] + (size_t)m_ * D))[lane + 64 * j]; } } } while (0)
      MID_LOAD(mc);
      for (int it = 0; it < 8; ++it) {
        const int m0 = mc + it * 16;
        {
            float ss[2] = {0.f, 0.f};
#define YV(rr, j, i) ((i) == 0 ? __uint_as_float(yw[rr][j].x << 16) : (i) == 1 ? __uint_as_float(yw[rr][j].x & 0xffff0000u) : (i) == 2 ? __uint_as_float(yw[rr][j].y << 16) : __uint_as_float(yw[rr][j].y & 0xffff0000u))
#pragma unroll
            for (int rr = 0; rr < 2; ++rr) {
#pragma unroll
                for (int j = 0; j < 4; ++j) ss[rr] += YV(rr, j, 0) * YV(rr, j, 0) + YV(rr, j, 1) * YV(rr, j, 1) + YV(rr, j, 2) * YV(rr, j, 2) + YV(rr, j, 3) * YV(rr, j, 3);
                ss[rr] = wave_sum(ss[rr]);
            }
#pragma unroll
            for (int rr = 0; rr < 2; ++rr) {
                const int lr = 2 * wave + rr, m = m0 + lr;
                const float r1 = 1.0f / sqrtf(ss[rr] * (1.0f / D) + EPS);
                float ss2 = 0.f;
#pragma unroll
                for (int j = 0; j < 4; ++j) {
                    const int col = 4 * (lane + 64 * j);
                    const f32x4 gp = *(const f32x4*)(PV + col), gt = *(const f32x4*)(PV + 1024 + col);
#pragma unroll
                    for (int i = 0; i < 4; ++i) { xv[rr][j][i] = xv[rr][j][i] + gt[i] * (YV(rr, j, i) * r1 * gp[i]); ss2 += xv[rr][j][i] * xv[rr][j][i]; }
                    ((f32x4*)(p.out + (size_t)m * D))[lane + 64 * j] = xv[rr][j];
                }
                ss2 = wave_sum(ss2);
                const float r2 = 1.0f / sqrtf(ss2 * (1.0f / D) + EPS);
#pragma unroll
                for (int j = 0; j < 4; ++j) {
                    const int col = 4 * (lane + 64 * j);
                    const f32x4 gp = *(const f32x4*)(PV + 2048 + col), sh = *(const f32x4*)(PV + 3072 + col), sc = *(const f32x4*)(PV + 4096 + col);
                    float h[4]; bf16_t hb[4]; float lo[4];
#pragma unroll
                    for (int i = 0; i < 4; ++i) { h[i] = xv[rr][j][i] * r2 * gp[i] * (1.f + sc[i]) + sh[i]; hb[i] = f2bf(h[i]); lo[i] = h[i] - bf2f(hb[i]); }
                    uint2 o; o.x = (unsigned)hb[0] | ((unsigned)hb[1] << 16); o.y = (unsigned)hb[2] | ((unsigned)hb[3] << 16);
                    *(uint2*)(H2 + (size_t)m * D + col) = o;
                    *(uint2*)(Ahi + lr * RS + col * 2) = o;
                    uint2 ol; ol.x = pk2(lo[0], lo[1]); ol.y = pk2(lo[2], lo[3]);
                    *(uint2*)(Alo + lr * RS + col * 2) = ol;
                }
            }
            if (it < 7) MID_LOAD(m0 + 16);
        }
        asm volatile("s_waitcnt lgkmcnt(0)\n\ts_barrier" ::: "memory");
        {
            f32x4 acc[4];
#pragma unroll
            for (int nb = 0; nb < 4; ++nb) acc[nb] = (f32x4){0.f, 0.f, 0.f, 0.f};
            const bf16_t* wrtlo = (const bf16_t*)(ws + WS_WRT); asm volatile("" : "+s"(wrtlo));
#pragma unroll
            for (int ks = 0; ks < 4; ++ks) {
                const int ko = (wave * 128 + ks * 32 + 8 * fq) * 2;
                const bf16x8 ah = *(const bf16x8*)(Ahi + fr * RS + ko), al = *(const bf16x8*)(Alo + fr * RS + ko);
#pragma unroll
                for (int nb = 0; nb < 4; ++nb) {
                    const size_t wo_ = ((size_t)(((wave * 4 + ks) * 4 + nb) * 2) * 64 + lane) * 8;
                    const bf16x8 bhv = *(const bf16x8*)(wrtlo + wo_), bl = *(const bf16x8*)(wrtlo + wo_ + 512);
                    acc[nb] = __builtin_amdgcn_mfma_f32_16x16x32_bf16(ah, bhv, acc[nb], 0, 0, 0);
                    acc[nb] = __builtin_amdgcn_mfma_f32_16x16x32_bf16(ah, bl, acc[nb], 0, 0, 0);
                    acc[nb] = __builtin_amdgcn_mfma_f32_16x16x32_bf16(al, bhv, acc[nb], 0, 0, 0);
                }
            }
#pragma unroll
            for (int nb = 0; nb < 4; ++nb)
#pragma unroll
                for (int j = 0; j < 4; ++j) Pp[(wave * 16 + 4 * fq + j) * 64 + 16 * nb + fr] = acc[nb][j];
        }
        asm volatile("s_waitcnt lgkmcnt(0)\n\ts_barrier" ::: "memory");
#pragma unroll
        for (int rr = 0; rr < 2; ++rr) {
            const int lr = 2 * wave + rr;
            float lg = 0.f;
#pragma unroll
            for (int w = 0; w < 8; ++w) lg += Pp[(w * 16 + lr) * 64 + lane];
            const float score = 1.0f / (1.0f + expf(-lg));
            const float sel = score + rbias;
            float t1 = sel, t2 = -INFINITY;
#define TOP2(M) do { const float o1 = sx<M>(t1), o2 = sx<M>(t2); const float n1 = fmaxf(t1, o1), n2 = fmaxf(fminf(t1, o1), fmaxf(t2, o2)); t1 = n1; t2 = n2; } while (0)
            TOP2(1); TOP2(2); TOP2(4);
#undef TOP2
            const float gs = t1 + t2; const int grp = lane >> 3;
            int gr = 0;
#pragma unroll
            for (int j = 0; j < 8; ++j) { const float sj = __uint_as_float(__builtin_amdgcn_readlane(__float_as_uint(gs), j * 8)); gr += (sj > gs || (sj == gs && j < grp)) ? 1 : 0; }
            const bool gsel = gr < 4;
            float v = gsel ? sel : -INFINITY;
            int rk = TOPK;
#pragma unroll
            for (int it8 = 0; it8 < TOPK; ++it8) {
                const float mx = wave_max(v);
                const unsigned long long eq = __ballot(v == mx);
                const int win = __builtin_ctzll(eq);
                if (lane == win) { rk = it8; v = -INFINITY; }
            }
            const bool chosen = rk < TOPK;
            const float ssum = wave_sum(chosen ? score : 0.f);
            const float w = score / (ssum + 1e-20f) * 2.5f;
            if (chosen) {
                const int lpos = atomicAdd(&lcnt[lane], 1);
                const int idx = (it * 16 + lr) * 8 + rk;
                PE[idx] = lane | (lpos << 8); PW[idx] = w;
            }
        }
      }
      __syncthreads();
      if (tid < 64) { const int c = lcnt[tid]; gb[tid] = c ? (int)atomicAdd(&counts[b * 65 + tid], (unsigned)c) : 0; }
      __syncthreads();
      for (int i = tid; i < 1024; i += NT) {
          const int pe = PE[i], e = pe & 255, pos = gb[e] + (pe >> 8), mk = mc * 8 + i;
          TOKL[((size_t)b * 64 + e) * 8192 + pos] = mk; TE[mk] = e; TP[mk] = pos; TW[mk] = PW[i];
      }
      __syncthreads();
    }
}

constexpr int T_CNT = 0;
constexpr int T_TOT = 256;
constexpr int T_AB = 328;
constexpr int T_OFF = 400;
constexpr int T_GUP = 660;
constexpr int T_YC = 730;
constexpr int T_YB = 990;
constexpr int T_DUP = 1250;
constexpr int T_UL = 1520;
constexpr int T_END = 1520 + 512;
__device__ __forceinline__ int scan_incl(int v, int lane) {
#pragma unroll
    for (int off = 1; off < 64; off <<= 1) { const int t = __builtin_amdgcn_ds_bpermute(((lane - off) & 63) << 2, v); if (lane >= off) v += t; }
    return v;
}
__device__ __forceinline__ void build_moe(const Params& p, int* tab) {
    const unsigned* counts = (const unsigned*)(p.ws + WS_CTL);
    __syncthreads();
    const int tid = otid(), wave = tid >> 6, lane = tid & 63;
    if (wave == 0) {
        const int c0 = (int)counts[0 * 65 + lane], c1 = (int)counts[1 * 65 + lane], c2 = (int)counts[2 * 65 + lane], c3 = (int)counts[3 * 65 + lane];
        tab[T_CNT + 0 * 64 + lane] = c0; tab[T_CNT + 1 * 64 + lane] = c1; tab[T_CNT + 2 * 64 + lane] = c2; tab[T_CNT + 3 * 64 + lane] = c3;
        tab[T_OFF + lane * 4 + 0] = 0; tab[T_OFF + lane * 4 + 1] = c0; tab[T_OFF + lane * 4 + 2] = c0 + c1; tab[T_OFF + lane * 4 + 3] = c0 + c1 + c2;
        const int tot = c0 + c1 + c2 + c3, pad = (tot + 255) & ~255, gu = ((tot + 255) >> 8) * 2;
        const int sp = scan_incl(pad, lane), sg = scan_incl(gu, lane);
        tab[T_TOT + lane] = tot; tab[T_AB + lane] = sp - pad; tab[T_GUP + lane] = sg - gu;
        const int cb[4] = {c0, c1, c2, c3};
#pragma unroll
        for (int b = 0; b < 4; ++b) {
            const int du = ((cb[b] + 255) >> 8) * 4;
            const int sy = scan_incl(cb[b], lane), sd = scan_incl(du, lane);
            tab[T_YB + 65 * b + lane] = sy - cb[b]; tab[T_DUP + 66 * b + lane] = sd - du;
            if (lane == 63) { tab[T_YB + 65 * b + 64] = sy; tab[T_DUP + 66 * b + 64] = sd; tab[T_DUP + 66 * b + 65] = sd + (SEQ / 256) * 4; }
        }
        if (lane == 63) { tab[T_TOT + 64] = T; tab[T_AB + 64] = sp; tab[T_GUP + 64] = sg; tab[T_GUP + 65] = sg + (T / 256) * 2; }
    }
    __syncthreads();
}

__device__ __forceinline__ void moe_decode(const GP_LAS int* tab, int e, int pos_e, int& b, int& pos) {
    const int o1 = tab[T_OFF + e * 4 + 1], o2 = tab[T_OFF + e * 4 + 2], o3 = tab[T_OFF + e * 4 + 3];
    b = (pos_e >= o1 ? 1 : 0) + (pos_e >= o2 ? 1 : 0) + (pos_e >= o3 ? 1 : 0);
    pos = pos_e - (b == 0 ? 0 : (b == 1 ? o1 : (b == 2 ? o2 : o3)));
}
struct MoeSched {
    const GP_LAS int* tab; int G, c, ntn, U, down, chunk; const int* TOKL; const char* Bt;
    __device__ __forceinline__ void prepare(int* tabw, int wv) const {
        if (wv == 0) {
            const int i = lane_id(), L = i * G + c;
            if (L < U) {
                const int pre = down ? T_DUP + 66 * chunk : T_GUP;
                int lo = 0, hi = 64;
                while (lo < hi) { const int mid = (lo + hi + 1) >> 1; if (tabw[pre + mid] <= L) lo = mid; else hi = mid - 1; }
                const int loc = L - tabw[pre + lo];
                int cnt, base, bb;
                if (down) { cnt = (lo < 64) ? tabw[T_CNT + chunk * 64 + (lo & 63)] : SEQ; base = tabw[T_YB + 65 * chunk + lo];
                            bb = tabw[T_AB + lo] + (lo < 64 ? tabw[T_OFF + (lo & 63) * 4 + chunk] : chunk * SEQ); }
                else { cnt = tabw[T_TOT + lo]; base = tabw[T_AB + lo]; bb = 0; }
                int* ul = tabw + T_UL + 8 * i;
                ul[0] = lo; ul[1] = loc / ntn; ul[2] = loc % ntn; ul[3] = cnt; ul[4] = base; ul[5] = bb;
            }
        }
        __syncthreads();
    }
    __device__ __forceinline__ bool next(int i, gp::Unit& u) const {
        if (i * G + c >= U) return false;
        const GP_LAS int* ul = tab + T_UL + 8 * i;
        u.e = __builtin_amdgcn_readfirstlane(ul[0]); u.pm = __builtin_amdgcn_readfirstlane(ul[1]); u.pn = __builtin_amdgcn_readfirstlane(ul[2]);
        u.cnt = __builtin_amdgcn_readfirstlane(ul[3]); u.base = __builtin_amdgcn_readfirstlane(ul[4]); u.b = __builtin_amdgcn_readfirstlane(ul[5]);
        return true;
    }
    __device__ __forceinline__ unsigned arow(const gp::Unit& u, int r) const {
        const int pos_e = u.pm * 256 + r;
        if (down) return (unsigned)(u.b + pos_e) * 512u;
        int tok;
        if (u.e < 64) { int b, pos; moe_decode(tab, u.e, pos_e, b, pos); tok = (pos_e < u.cnt) ? (TOKL[((size_t)b * 64 + u.e) * 8192 + pos] >> 3) : 0; } else tok = pos_e;
        return (unsigned)tok * 2048u;
    }
    __device__ __forceinline__ const char* bptr(const gp::Unit& u) const {
        return down ? Bt + ((size_t)u.e * 1024 + u.pn * 256) * 512 : Bt + ((size_t)u.e * 512 + u.pn * 256) * 2048;
    }
};
struct EpiGU {
    bf16_t* ACT; const int* TOKL; const float* TW; const GP_LAS int* tab;
    __device__ __forceinline__ void operator()(const f32x4 (&acc)[2][2][4][2], const gp::Unit& u, int wr, int wc, int fr, int fq) const {
#pragma unroll
        for (int ai = 0; ai < 2; ++ai)
#pragma unroll
            for (int m = 0; m < 4; ++m) {
                const int pos_e = u.pm * 256 + ai * 128 + wr * 64 + m * 16 + fr;
                if (pos_e < u.cnt) {
                    float w = 1.0f;
                    if (u.e < 64) { int b, pos; moe_decode(tab, u.e, pos_e, b, pos); w = TW[TOKL[((size_t)b * 64 + u.e) * 8192 + pos]]; }
                    float a[8];
#pragma unroll
                    for (int n = 0; n < 2; ++n)
#pragma unroll
                        for (int i = 0; i < 4; ++i) { const float g = acc[ai][0][m][n][i], up = acc[ai][1][m][n][i];
                            a[4 * n + i] = g * __builtin_amdgcn_rcpf(1.0f + __builtin_amdgcn_exp2f(-1.4426950408889634f * g)) * up * w; }
                    gp::u32x4 o; o.x = gp::cvt_pk_bf16(a[0], a[1]); o.y = gp::cvt_pk_bf16(a[2], a[3]); o.z = gp::cvt_pk_bf16(a[4], a[5]); o.w = gp::cvt_pk_bf16(a[6], a[7]);
                    *(gp::u32x4*)(ACT + ((size_t)u.base + pos_e) * DE + u.pn * 128 + wc * 32 + fq * 8) = o;
                }
            }
    }
};
struct EpiDown {
    unsigned char* ws;
    __device__ __forceinline__ void operator()(const f32x4 (&acc)[2][2][4][2], const gp::Unit& u, int wr, int wc, int fr, int fq) const {
#pragma unroll
        for (int ai = 0; ai < 2; ++ai)
#pragma unroll
            for (int m = 0; m < 4; ++m) {
                const int pos = u.pm * 256 + ai * 128 + wr * 64 + m * 16 + fr;
                if (pos < u.cnt) {
                    bf16_t* rowp = (bf16_t*)(ws + WS_Y) + (size_t)(u.base + pos) * D + u.pn * 256 + wc * 32 + fq * 8;
#pragma unroll
                    for (int bj = 0; bj < 2; ++bj) { const f32x4 v0 = acc[ai][bj][m][0], v1 = acc[ai][bj][m][1];
                        gp::u32x4 o; o.x = gp::cvt_pk_bf16(v0[0], v0[1]); o.y = gp::cvt_pk_bf16(v0[2], v0[3]); o.z = gp::cvt_pk_bf16(v1[0], v1[1]); o.w = gp::cvt_pk_bf16(v1[2], v1[3]);
                        *(gp::u32x4*)(rowp + bj * 128) = o; }
                }
            }
    }
};
__device__ __forceinline__ void ph_moe_gu(const Params& p, unsigned char* smem) {
    unsigned char* ws = p.ws;
    int* tab = (int*)(smem + gp::STAGE_BYTES);
    build_moe(p, tab);
    MoeSched S; S.tab = (const GP_LAS int*)tab; S.G = gridDim.x; S.c = (gridDim.x % 8 == 0) ? (int)((blockIdx.x % 8) * (gridDim.x / 8) + blockIdx.x / 8) : (int)blockIdx.x;   S.ntn = 2; S.U = __builtin_amdgcn_readfirstlane(tab[T_GUP + 65]); S.down = 0; S.chunk = 0;
    S.TOKL = (const int*)(ws + WS_TOKL); S.Bt = (const char*)(ws + WS_WGUT);
    S.prepare(tab, p.chunk);
    EpiGU E{(bf16_t*)(ws + WS_ACT), (const int*)(ws + WS_TOKL), (const float*)(ws + WS_TW), (const GP_LAS int*)tab};
    gp::gemm_phase<EpiGU, MoeSched, true>(p.chunk, (GP_LAS unsigned char*)smem, (const char*)(ws + WS_H2), D, S, E);
}
__device__ __forceinline__ void ph_moe_down(const Params& p, unsigned char* smem, int c) {
    unsigned char* ws = p.ws;
    int* tab = (int*)(smem + gp::STAGE_BYTES);
    build_moe(p, tab);
    MoeSched S; S.tab = (const GP_LAS int*)tab; S.G = gridDim.x; S.c = (gridDim.x % 8 == 0) ? (int)((blockIdx.x % 8) * (gridDim.x / 8) + blockIdx.x / 8) : (int)blockIdx.x;   S.ntn = 4; S.U = __builtin_amdgcn_readfirstlane(tab[T_DUP + 66 * c + 65]); S.down = 1; S.chunk = c;
    S.TOKL = nullptr; S.Bt = (const char*)(ws + WS_WDT);
    S.prepare(tab, p.chunk);
    EpiDown E{ws};
    gp::gemm_phase<EpiDown, MoeSched, false>(p.chunk, (GP_LAS unsigned char*)smem, (const char*)(ws + WS_ACT), DE, S, E);
}

__device__ __forceinline__ void ph_final(const Params& p, float* lds, int b) {
    unsigned char* ws = p.ws;
    int* tab = (int*)lds;
    build_moe(p, tab);
    const int tid = otid(), wave = tid >> 6, lane = tid & 63;
    const int gw = blockIdx.x * NWV + wave, GW = gridDim.x * NWV;
    const int* TE = (const int*)(ws + WS_TE); const int* TP = (const int*)(ws + WS_TP);
    const bf16_t* Y = (const bf16_t*)(ws + WS_Y);
    const float* mod = (const float*)(ws + WS_MOD) + b * 6144 + 5 * 1024;
    for (int t = gw; t < SEQ; t += GW) {
        const int m = b * SEQ + t;
        float acc[16];
#pragma unroll
        for (int i = 0; i < 16; ++i) acc[i] = 0.f;
#pragma unroll
        for (int k = 0; k < 9; ++k) {
            int row;
            if (k < 8) { const int e = TE[m * 8 + k]; row = tab[T_YB + 65 * b + e] + TP[m * 8 + k]; }
            else row = tab[T_YB + 65 * b + 64] + t;
            const bf16_t* yr = Y + (size_t)row * D;
#pragma unroll
            for (int j = 0; j < 4; ++j) { const uint2 w = *(const uint2*)(yr + 4 * (lane + 64 * j));
                acc[4 * j] += __uint_as_float(w.x << 16); acc[4 * j + 1] += __uint_as_float(w.x & 0xffff0000u); acc[4 * j + 2] += __uint_as_float(w.y << 16); acc[4 * j + 3] += __uint_as_float(w.y & 0xffff0000u); }
        }
        float ss = 0.f;
#pragma unroll
        for (int i = 0; i < 16; ++i) ss += acc[i] * acc[i];
        ss = wave_sum(ss);
        const float rs = 1.0f / sqrtf(ss * (1.0f / D) + EPS);
#pragma unroll
        for (int j = 0; j < 4; ++j) {
            const int col = 4 * (lane + 64 * j);
            const f32x4 gp = *(const f32x4*)(p.in[I_GFPOST] + col), gt = *(const f32x4*)(mod + col);
            f32x4 x1 = ((const f32x4*)(p.out + (size_t)m * D))[lane + 64 * j];
#pragma unroll
            for (int i = 0; i < 4; ++i) x1[i] += gt[i] * (acc[4 * j + i] * rs * gp[i]);
            ((f32x4*)(p.out + (size_t)m * D))[lane + 64 * j] = x1;
        }
    }
}

#define GAS __attribute__((address_space(1)))
#define LAS __attribute__((address_space(3)))
#define XB_TMO      128
#define XB_XCNT(j)  (256  + 64 * (j))
#define XB_XSUB(j)  (1280 + 64 * (j))
#define XB_XGEN(j)  (2304 + 64 * (j))
#define XB_TOP      3328
#define XB_TOPGEN   3392
#define XCD_BAR_WORDS 3456
#define XB_SPIN_CAP (1u << 21)
__device__ __forceinline__ unsigned xb_ld(unsigned* p)              { return __hip_atomic_load(p, __ATOMIC_RELAXED, __HIP_MEMORY_SCOPE_AGENT); }
__device__ __forceinline__ unsigned xb_add(unsigned* p, unsigned v) { return __hip_atomic_fetch_add(p, v, __ATOMIC_RELAXED, __HIP_MEMORY_SCOPE_AGENT); }
__device__ __forceinline__ unsigned xb_xcc_id() { return (unsigned)__builtin_amdgcn_s_getreg((3 << 11) | 20) & 0xFu; }
#define XB_SPIN(cond, bar) do { unsigned _sp = 0; while (cond) { __builtin_amdgcn_s_sleep(1); \
    if ((++_sp & 255u) == 0u) { if (xb_ld(&(bar)[XB_TMO])) break; if (_sp > XB_SPIN_CAP) { atomicAdd(&(bar)[XB_TMO], 1u); break; } } } } while (0)
struct XcdBarrier { unsigned* bar; unsigned x; volatile LAS unsigned* st; };
__device__ __forceinline__ XcdBarrier xcd_barrier_post(unsigned* bar, volatile LAS unsigned* st, int wv) {
    XcdBarrier b; b.bar = bar; b.x = xb_xcc_id(); b.st = st;
    if (wv == 0 && lane_id() == 0) (void)xb_add(&bar[XB_XCNT(b.x)], 1u);
    return b;
}
__device__ __forceinline__ void xcd_barrier_complete(unsigned* bar, unsigned x, unsigned& nloc, unsigned& nx) {
    const unsigned G = gridDim.x * gridDim.y * gridDim.z;
    unsigned sum, cnt, mine, sp = 0u;
    for (;;) {
        sum = 0u; cnt = 0u; mine = 0u;
#pragma unroll
        for (unsigned j = 0; j < 16; ++j) { const unsigned c = xb_ld(&bar[XB_XCNT(j)]); sum += c; cnt += (c > 0u) ? 1u : 0u; mine = (j == x) ? c : mine; }
        if (sum == G) break;
        __builtin_amdgcn_s_sleep(1);
        if ((++sp & 255u) == 0u) { if (xb_ld(&bar[XB_TMO])) break; if (sp > XB_SPIN_CAP) { atomicAdd(&bar[XB_TMO], 1u); break; } }
    }
    nloc = mine > 0u ? mine : 1u; nx = cnt > 0u ? cnt : 1u;
}
__device__ __forceinline__ void xcd_barrier(const XcdBarrier& b, int wv) {
    asm volatile("s_waitcnt vmcnt(0)" ::: "memory");
    __syncthreads();
    if (wv == 0 && lane_id() == 0) {
        unsigned* bar = b.bar;
        __builtin_amdgcn_s_waitcnt(0);
        unsigned nloc = b.st[0], nx = b.st[1];
        if (nloc == 0u) { xcd_barrier_complete(bar, b.x, nloc, nx); b.st[0] = nloc; b.st[1] = nx; }
        const unsigned old = xb_add(&bar[XB_XSUB(b.x)], 1u);
        const unsigned gen = old / nloc;
        if (old + 1u == (gen + 1u) * nloc) {
            __builtin_amdgcn_fence(__ATOMIC_RELEASE, "agent");
            asm volatile("s_waitcnt vmcnt(0)" ::: "memory");
            const unsigned og = xb_add(&bar[XB_TOP], 1u);
            const unsigned tg = og / nx;
            if (og + 1u == (tg + 1u) * nx) xb_add(&bar[XB_TOPGEN], 1u);
            else XB_SPIN(xb_ld(&bar[XB_TOPGEN]) == tg, bar);
            __builtin_amdgcn_fence(__ATOMIC_ACQUIRE, "agent");
            xb_add(&bar[XB_XGEN(b.x)], 1u);
            asm volatile("s_waitcnt vmcnt(0)" ::: "memory");
        } else {
            XB_SPIN(xb_ld(&bar[XB_XGEN(b.x)]) == gen, bar);
            __builtin_amdgcn_fence(__ATOMIC_ACQUIRE, "agent");
            asm volatile("s_waitcnt vmcnt(0)" ::: "memory");
        }
    }
    __syncthreads();
}

namespace cg = cooperative_groups;
constexpr int LDS_BYTES = 144 * 1024;
typedef const __attribute__((address_space(4))) Params* KP;
__device__ __forceinline__ Params kargs() {
    Params p;
#if defined(__HIP_DEVICE_COMPILE__)
    typedef const __attribute__((address_space(4))) unsigned long long* KQ;
    KQ kq = (KQ)__builtin_amdgcn_kernarg_segment_ptr(); asm volatile("" : "+s"(kq));
    unsigned long long* d = (unsigned long long*)&p;
#pragma unroll
    for (int i = 0; i < (int)(sizeof(Params) / 8); ++i) d[i] = kq[i];
#endif
    return p;
}
#define PH(call) do { Params p = kargs(); p.chunk = wv; call; } while (0)
__global__ void __launch_bounds__(NT) mega_fwd(Params p_unused) {
    extern __shared__ __attribute__((aligned(16))) unsigned char smem[];
    float* lds = (float*)smem;
    volatile LAS unsigned* misc = (volatile LAS unsigned*)((LAS unsigned char*)smem + (LDS_BYTES - 64));
    if (threadIdx.x < 16) misc[threadIdx.x] = 0u;
    __syncthreads();
    unsigned* barw; { const Params p = kargs(); barw = (unsigned*)(p.ws + WS_CTL) + 4096; }
    const int wv = __builtin_amdgcn_readfirstlane(threadIdx.x >> 6);
    const XcdBarrier bar = xcd_barrier_post(barw, misc, wv);
#define SYNC() xcd_barrier(bar, wv)
    PH(ph_prep(p, lds)); PH(ph_prep_weights(p, lds, 0, 0));   SYNC();
    PH(ph_norm1(p));                SYNC();
    PH(ph_inproj(p, smem)); PH(ph_prep_weights(p, lds, 1, (MTOT / 256) * (INW / 256) % (int)gridDim.x));         SYNC();
    PH(ph_attn(p, smem)); PH(ph_fourierA(p, smem));  SYNC();
    PH(ph_fourierB(p, smem));       SYNC();
    PH(ph_outproj(p, smem));        SYNC();
    PH(ph_mid(p, smem));            SYNC();
    PH(ph_moe_gu(p, smem));         SYNC();
#pragma unroll 1
    for (int c = 0; c < BATCH; ++c) {
        PH(ph_moe_down(p, smem, c)); SYNC();
        PH(ph_final(p, lds, c));
        if (c + 1 < BATCH) SYNC();
    }
#undef SYNC
}

extern "C" void kernel_launch(void* const* d_in, const int* in_sizes, int n_in, void* d_out, int out_size, void* d_ws, size_t ws_size, hipStream_t stream) {
    if (n_in != 26 || ws_size < WS_END) { fprintf(stderr, "kernel_launch: unexpected n_in %d / ws %zu\n", n_in, ws_size); return; }
    static int grid_blocks = 0;
    if (!grid_blocks) {
        int dev = 0, cus = 0, per_cu = 0;
        (void)hipGetDevice(&dev);
        (void)hipDeviceGetAttribute(&cus, hipDeviceAttributeMultiprocessorCount, dev);
        (void)hipFuncSetAttribute((const void*)mega_fwd, hipFuncAttributeMaxDynamicSharedMemorySize, LDS_BYTES);
        (void)hipOccupancyMaxActiveBlocksPerMultiprocessor(&per_cu, (const void*)mega_fwd, NT, LDS_BYTES);
        if (per_cu < 1) { fprintf(stderr, "kernel_launch: occupancy query says %d blocks/CU\n", per_cu); per_cu = 1; }
        if (per_cu > 1) per_cu = 1;
        grid_blocks = cus * per_cu;
    }
    Params p{};
    for (int i = 0; i < 26; ++i) p.in[i] = (const float*)d_in[i];
    p.out = (float*)d_out; p.ws = (unsigned char*)d_ws; p.chunk = 0; p.pad = 0;
    (void)hipMemsetAsync((char*)d_ws + WS_CTL, 0, 32768, stream);
    void* args[] = {&p};
    hipError_t e = hipLaunchCooperativeKernel((const void*)mega_fwd, dim3(grid_blocks), dim3(NT), args, LDS_BYTES, stream);
    if (e != hipSuccess) fprintf(stderr, "cooperative launch failed: %s (grid %d)\n", hipGetErrorString(e), grid_blocks);
}
```

```cpp
#include <hip/hip_runtime.h>
#include <hip/hip_cooperative_groups.h>
#include <cstdio>
#include <cstdint>

typedef unsigned short bf16_t;
typedef float f32x4 __attribute__((ext_vector_type(4)));

constexpr int D = 1024, BATCH = 4, SEQ = 8192, T = BATCH * SEQ, CTX = 256, TC = BATCH * CTX;
constexpr int MTOT = T + TC;
constexpr int KVLEN = CTX + SEQ;
constexpr int INW = 2560, NH = 6, QKW = 768, FW = 256;
constexpr int NE = 64, DE = 256, TOPK = 8;
constexpr int NT = 512, NWV = 8;
constexpr int SLOTS_B = 90112;
constexpr float EPS = 1e-6f;
constexpr float LAM_INIT = 0.2f;
constexpr float QSCALE = 0.125f * 1.4426950408889634f;
constexpr float SQS = 0.42466090014400953f;

constexpr size_t MiB = 1u << 20;
constexpr size_t WS_CTL = 0;
constexpr size_t WS_MOD = 1 * MiB;
constexpr size_t WS_TABW = WS_MOD + 128 * 1024;
constexpr size_t WS_ROPE = WS_MOD + 192 * 1024;
constexpr size_t WS_GCS = WS_MOD + 256 * 1024;
constexpr size_t WS_W128E = WS_MOD + 768 * 1024;
constexpr size_t WS_M64E = WS_MOD + 832 * 1024;
constexpr size_t WS_GT = WS_MOD + 864 * 1024;
constexpr size_t WS_WRT = WS_MOD + 512 * 1024;
constexpr size_t WS_WINT = 2 * MiB;
constexpr size_t WS_WOUTT = 7 * MiB;
constexpr size_t WS_WGUT = 9 * MiB;
constexpr size_t WS_WDT = 74 * MiB;
constexpr size_t WS_TE = 107 * MiB;
constexpr size_t WS_TP = 108 * MiB;
constexpr size_t WS_TW = 109 * MiB;
constexpr size_t WS_TOKL = 110 * MiB;
constexpr size_t WS_AO = 118 * MiB;
constexpr size_t WS_ACT = 118 * MiB;
constexpr size_t WS_Q = 182 * MiB;
constexpr size_t WS_K = 230 * MiB;
constexpr size_t WS_V = WS_K + (size_t)BATCH * KVLEN * QKW * 2;
constexpr size_t WS_F = 329 * MiB;
constexpr size_t WS_FY = 361 * MiB;
constexpr size_t WS_HX = 425 * MiB;
constexpr size_t WS_YX = 358 * MiB;
constexpr size_t WS_H2 = 294 * MiB;
constexpr size_t WS_Y = 294 * MiB;
constexpr size_t WS_END = 491 * MiB;

struct Params {
    const float* in[26];
    float* out;
    unsigned char* ws;
    int chunk;
    int pad;
};
enum { I_X = 0, I_C, I_CTX, I_CCTX, I_WMOD, I_BMOD, I_GAPRE, I_GAPOST, I_WIN, I_WF, I_LQ1, I_LK1, I_LQ2, I_LK2, I_GSUB, I_WOUT,
       I_GFPRE, I_GFPOST, I_WR, I_RB, I_WG, I_WU, I_WD, I_WSG, I_WSU, I_WSD };

__device__ __forceinline__ float bf2f(bf16_t v) { return __uint_as_float(((unsigned)v) << 16); }
__device__ __forceinline__ bf16_t f2bf(float f) { unsigned u = __float_as_uint(f); return (bf16_t)((u + 0x7fffu + ((u >> 16) & 1u)) >> 16); }
__device__ __forceinline__ unsigned pk2(float lo, float hi) { return (unsigned)f2bf(lo) | ((unsigned)f2bf(hi) << 16); }
template <int M> __device__ __forceinline__ float sx(float v) { return __int_as_float(__builtin_amdgcn_ds_swizzle(__float_as_int(v), (M << 10) | 0x1f)); }
template <int M> __device__ __forceinline__ int sxi(int v) { return __builtin_amdgcn_ds_swizzle(v, (M << 10) | 0x1f); }
__device__ __forceinline__ float wave_sum(float v) {
    v += sx<1>(v); v += sx<2>(v); v += sx<4>(v); v += sx<8>(v); v += sx<16>(v);
    auto rr = __builtin_amdgcn_permlane32_swap(__float_as_uint(v), __float_as_uint(v), false, false);
    return __uint_as_float(rr[0]) + __uint_as_float(rr[1]);
}
__device__ __forceinline__ float dpp_f(float v, const int ctrl_sel) {
    const int x = __float_as_int(v); int r;
    if (ctrl_sel == 0) r = __builtin_amdgcn_update_dpp(x, x, 0xB1, 0xf, 0xf, false);
    else if (ctrl_sel == 1) r = __builtin_amdgcn_update_dpp(x, x, 0x4E, 0xf, 0xf, false);
    else if (ctrl_sel == 2) r = __builtin_amdgcn_update_dpp(x, x, 0x141, 0xf, 0xf, false);
    else r = __builtin_amdgcn_update_dpp(x, x, 0x140, 0xf, 0xf, false);
    return __int_as_float(r);
}
__device__ __forceinline__ float wave_max(float v) {
    v = fmaxf(v, dpp_f(v, 0)); v = fmaxf(v, dpp_f(v, 1)); v = fmaxf(v, dpp_f(v, 2)); v = fmaxf(v, dpp_f(v, 3));
    const float a = __uint_as_float(__builtin_amdgcn_readlane(__float_as_uint(v), 0)), b = __uint_as_float(__builtin_amdgcn_readlane(__float_as_uint(v), 16));
    const float c = __uint_as_float(__builtin_amdgcn_readlane(__float_as_uint(v), 32)), d = __uint_as_float(__builtin_amdgcn_readlane(__float_as_uint(v), 48));
    return fmaxf(fmaxf(a, b), fmaxf(c, d));
}
__device__ __forceinline__ int lane_id() { int l; asm volatile("v_mbcnt_lo_u32_b32 %0, -1, 0\n\tv_mbcnt_hi_u32_b32 %0, -1, %0" : "=v"(l)); return l; }
__device__ __forceinline__ int otid_w(int wv) { return wv * 64 + lane_id(); }
#define otid() otid_w(p.chunk)
__device__ __forceinline__ float silu_f(float x) { return x / (1.f + expf(-x)); }

__device__ __forceinline__ void ph_prep(const Params& p, float* lds) {
    const int tid = otid(), bid = blockIdx.x, nblk = gridDim.x;
    const int gt = bid * NT + tid, GT = nblk * NT;
    unsigned char* ws = p.ws;
    float2* tabw = (float2*)(ws + WS_TABW);
    for (int i = gt; i < 8192; i += GT) { float s, c; sincospif((float)i * (1.0f / 4096.0f), &s, &c); tabw[i] = make_float2(c, s); }
    float* rope = (float*)(ws + WS_ROPE);
    for (int i = gt; i < 192 * 16; i += GT) {
        const int pos = (i < 2048) ? (i >> 4) : ((i - 2048) >> 4); const int f = i & 15;
        const float inv = powf(10000.0f, -(float)(2 * f) / 32.0f); const float ang = (float)pos * inv;
        const float c = cosf(ang), s = sinf(ang);
        if (i < 2048) { rope[i] = c; rope[2048 + i] = s; } else { rope[4096 + (i - 2048)] = c; rope[4096 + 1024 + (i - 2048)] = s; }
    }
    { bf16_t* gt = (bf16_t*)(ws + WS_GT); const float* wf = p.in[I_WF];
      for (int i = bid * NT + tid; i < 4 * 64 * 128; i += GT) {
        const int g = i >> 13, d = (i >> 7) & 63, part = (i >> 6) & 1, c = i & 63;
        float a = 0.f;
        for (int j = 0; j < 64; ++j) { float s, co; sincospif((float)((c * j) & 63) * (1.0f / 32.0f), &s, &co); a += (part ? s : co) * wf[(g * 64 + j) * 64 + d]; }
        gt[i] = f2bf(a * 0.0013810679320049757f);
      }
      bf16_t* w128 = (bf16_t*)(ws + WS_W128E);
      for (int i = bid * NT + tid; i < 256 * 128; i += GT) { const int kk = i >> 7, n1 = i & 127; float s, co; sincospif((float)(((kk & 127) * n1) & 127) * (1.0f / 64.0f), &s, &co); w128[i] = f2bf(kk < 128 ? co : -s); }
      bf16_t* m64 = (bf16_t*)(ws + WS_M64E);
      for (int i = bid * NT + tid; i < 128 * 128; i += GT) { const int ro = i >> 7, ci = i & 127, po = ro >> 6, k2 = ro & 63, pi = ci >> 6, n2 = ci & 63;
        float s, co; sincospif((float)((k2 * n2) & 63) * (1.0f / 32.0f), &s, &co); m64[i] = f2bf(po == pi ? co : (po == 0 ? s : -s)); }
    }
    {
      bf16_t* wrt = (bf16_t*)(ws + WS_WRT); const float* wr = p.in[I_WR];
      for (int i = gt; i < 64 * 1024; i += GT) {
        const int j = i & 7, ln = (i >> 3) & 63, nb = (i >> 9) & 3, ks = (i >> 11) & 3, wv_ = i >> 13;
        const int e = 16 * nb + (ln & 15), k = wv_ * 128 + ks * 32 + 8 * (ln >> 4) + j;
        const float w = wr[k * 64 + e]; const bf16_t h = f2bf(w);
        const int o = ((((wv_ * 4 + ks) * 4 + nb) * 2) * 64 + ln) * 8 + j;
        wrt[o] = h; wrt[o + 512] = f2bf(w - bf2f(h)); } }
    if (gt == 0) {
        float s1 = 0.f, s2 = 0.f;
        for (int i = 0; i < 64; ++i) { s1 += p.in[I_LQ1][i] * p.in[I_LK1][i]; s2 += p.in[I_LQ2][i] * p.in[I_LK2][i]; }
        ((float*)(ws + WS_CTL))[1024] = expf(s1) - expf(s2) + LAM_INIT;
    }
    float* sc = lds;
    float* red = lds + 5 * 1024;
    for (int i = tid; i < 5 * 1024; i += NT) { const int r = i >> 10, k = i & 1023; const float v = (r < 4) ? p.in[I_C][r * 1024 + k] : p.in[I_CCTX][k]; sc[i] = silu_f(v); }
    __syncthreads();
    const int wave = tid >> 6, lane = tid & 63;
    float* mod = (float*)(ws + WS_MOD);
    for (int task = bid; task < 96; task += nblk) {
        const int col = task * 64 + lane;
        float a0 = 0, a1 = 0, a2 = 0, a3 = 0, a4 = 0;
        const float* wm = p.in[I_WMOD];
#pragma unroll 32
        for (int k = wave * 128; k < wave * 128 + 128; ++k) { const float w = wm[(size_t)k * 6144 + col]; a0 += sc[k] * w; a1 += sc[1024 + k] * w; a2 += sc[2048 + k] * w; a3 += sc[3072 + k] * w; a4 += sc[4096 + k] * w; }
        red[(wave * 5 + 0) * 64 + lane] = a0; red[(wave * 5 + 1) * 64 + lane] = a1; red[(wave * 5 + 2) * 64 + lane] = a2; red[(wave * 5 + 3) * 64 + lane] = a3; red[(wave * 5 + 4) * 64 + lane] = a4;
        __syncthreads();
        if (tid < 320) { const int r = tid >> 6, l = tid & 63; float s = 0.f; for (int w = 0; w < 8; ++w) s += red[(w * 5 + r) * 64 + l]; mod[r * 6144 + task * 64 + l] = s + p.in[I_BMOD][task * 64 + l]; }
        __syncthreads();
    }
}

__device__ __forceinline__ void ph_norm1(const Params& p) {
    const int tid = otid(), wave = tid >> 6, lane = tid & 63;
    const int gw = blockIdx.x * NWV + wave, GW = gridDim.x * NWV;
    const float* mod = (const float*)(p.ws + WS_MOD);
    bf16_t* hx = (bf16_t*)(p.ws + WS_HX);
    const float* g = p.in[I_GAPRE];
    for (int m = gw; m < MTOT; m += GW) {
        const float* src = (m < T) ? p.in[I_X] + (size_t)m * D : p.in[I_CTX] + (size_t)(m - T) * D;
        const int r = (m < T) ? (m >> 13) : 4;
        const float* shift = mod + r * 6144; const float* scale = shift + 1024;
        f32x4 v[4]; float ss = 0.f;
#pragma unroll
        for (int j = 0; j < 4; ++j) { v[j] = ((const f32x4*)src)[lane + 64 * j]; ss += v[j][0] * v[j][0] + v[j][1] * v[j][1] + v[j][2] * v[j][2] + v[j][3] * v[j][3]; }
        ss = wave_sum(ss);
        const float rs = 1.0f / sqrtf(ss * (1.0f / D) + EPS);
#pragma unroll
        for (int j = 0; j < 4; ++j) {
            const int col = 4 * (lane + 64 * j);
            const f32x4 g4 = *(const f32x4*)(g + col), sc4 = *(const f32x4*)(scale + col), sh4 = *(const f32x4*)(shift + col);
            float h[4];
#pragma unroll
            for (int i = 0; i < 4; ++i) h[i] = v[j][i] * rs * g4[i] * (1.f + sc4[i]) + sh4[i];
            uint2 o; o.x = pk2(h[0], h[1]); o.y = pk2(h[2], h[3]);
            *(uint2*)(hx + (size_t)m * D + col) = o;
        }
    }
}

namespace gp {
#define GP_LAS __attribute__((address_space(3)))
typedef short bf16x8 __attribute__((ext_vector_type(8)));
typedef unsigned u32x4 __attribute__((ext_vector_type(4)));
constexpr int BM = 256, BK = 64, HALF = 128, HTB = HALF * BK * 2, STAGE_BYTES = 8 * HTB;
__device__ __forceinline__ int lds_byte(int r, int c) { const int st = (r >> 4) * 2 + (c >> 5), rr = r & 15, cc = c & 31, ob = rr * 64 + cc * 2; return st * 1024 + (ob ^ (((ob >> 9) & 1) << 5)); }
__device__ __forceinline__ void stage_rc(int b, int& R, int& C) { const int st = b / 1024, sb = b % 1024, swz = sb ^ (((sb >> 9) & 1) << 5); R = (st >> 1) * 16 + swz / 64; C = (st & 1) * 32 + (swz % 64) / 2; }
__device__ __forceinline__ int perm32(int rho) { const int n = rho >> 4, i = rho & 15; return 8 * (i >> 2) + 4 * n + (i & 3); }
struct Unit { int pm, pn, e, b, cnt, base; };
__device__ __forceinline__ unsigned cvt_pk_bf16(float lo, float hi) { unsigned r; asm volatile("v_cvt_pk_bf16_f32 %0, %1, %2" : "=v"(r) : "v"(lo), "v"(hi)); return r; }

template <class Epi, class Sched, bool ALIGN_EPI>
__device__ __forceinline__ void gemm_phase(const int wv, GP_LAS unsigned char* lds, const char* Abase, const int K, const Sched& S, const Epi& E) {
    const int wid = wv, wr = wid >> 2, wc = wid & 3;
    const int nt = K / BK;
    unsigned voffB[2];
#pragma unroll
    for (int i = 0; i < 2; ++i) { int R, C; stage_rc(otid_w(wv) * 16 + i * 8192, R, C); const int Rb = (R & ~31) + perm32(R & 31); voffB[i] = (unsigned)(Rb * K + C) * 2u; }
#define GP_AOFFS(u, o00, o01, o10, o11) do { int R0, C0, R1, C1; const int t_ = otid_w(wv); stage_rc(t_ * 16, R0, C0); stage_rc(t_ * 16 + 8192, R1, C1); \
        o00 = S.arow(u, R0) + (unsigned)C0 * 2u; o01 = S.arow(u, R1) + (unsigned)C1 * 2u; o10 = S.arow(u, HALF + R0) + (unsigned)C0 * 2u; o11 = S.arow(u, HALF + R1) + (unsigned)C1 * 2u; } while (0)
    const size_t kstep = (size_t)(BK * 2);
    const size_t hstep = (size_t)HALF * K * 2;
    const unsigned ldsw = (unsigned)wid * 1024u;
    int aoff, boff; { const int l_ = lane_id(), fr = l_ & 15, fq = l_ >> 4; aoff = lds_byte(wr * 64 + fr, fq * 8); boff = lds_byte(wc * 32 + fr, fq * 8); }
#define GP_SA(b, h) (((b) * 2 + (h)) * HTB)
#define GP_SB(b, h) ((4 + (b) * 2 + (h)) * HTB)
#define GP_STAGE_B(bufoff, gbase) do { _Pragma("unroll") for (int _i = 0; _i < 2; ++_i) \
        __builtin_amdgcn_global_load_lds((const unsigned*)((const char*)(gbase) + voffB[_i]), (GP_LAS unsigned*)(lds + (bufoff) + ldsw + _i * 8192), 16, 0, 0); } while (0)
#define GP_STAGE_A(bufoff, gbase, o0, o1) do { \
        __builtin_amdgcn_global_load_lds((const unsigned*)((const char*)(gbase) + (o0)), (GP_LAS unsigned*)(lds + (bufoff) + ldsw), 16, 0, 0); \
        __builtin_amdgcn_global_load_lds((const unsigned*)((const char*)(gbase) + (o1)), (GP_LAS unsigned*)(lds + (bufoff) + ldsw + 8192), 16, 0, 0); } while (0)
#define GP_LDA(dst, b, h) do { _Pragma("unroll") for (int m = 0; m < 4; ++m) _Pragma("unroll") for (int k = 0; k < 2; ++k) dst[m][k] = *(const GP_LAS bf16x8*)(lds + GP_SA(b, h) + aoff + m * 2048 + k * 1024); } while (0)
#define GP_LDB(dst, b, h) do { _Pragma("unroll") for (int n = 0; n < 2; ++n) _Pragma("unroll") for (int k = 0; k < 2; ++k) dst[n][k] = *(const GP_LAS bf16x8*)(lds + GP_SB(b, h) + boff + n * 2048 + k * 1024); } while (0)
#define GP_MMA(ai, bj, At, Bt) do { __builtin_amdgcn_s_setprio(1); _Pragma("unroll") for (int m = 0; m < 4; ++m) _Pragma("unroll") for (int n = 0; n < 2; ++n) _Pragma("unroll") for (int k = 0; k < 2; ++k) \
        acc[ai][bj][m][n] = __builtin_amdgcn_mfma_f32_16x16x32_bf16(Bt[n][k], At[m][k], acc[ai][bj][m][n], 0, 0, 0); __builtin_amdgcn_s_setprio(0); } while (0)
#define GP_WAIT_V(n) asm volatile("s_waitcnt vmcnt(" #n ")" ::: "memory")
#define GP_WAIT_L(n) asm volatile("s_waitcnt lgkmcnt(" #n ")" ::: "memory")
#define GP_BAR __builtin_amdgcn_s_barrier()
#define GP_SCHED __builtin_amdgcn_sched_barrier(0)
    Unit cur, nxt; int ui = 0;
    if (!S.next(0, cur)) return;
    f32x4 acc[2][2][4][2];
#pragma unroll
    for (int a = 0; a < 2; ++a)
#pragma unroll
        for (int b = 0; b < 2; ++b)
#pragma unroll
            for (int m = 0; m < 4; ++m)
#pragma unroll
                for (int n = 0; n < 2; ++n) acc[a][b][m][n] = (f32x4){0.f, 0.f, 0.f, 0.f};
    bf16x8 At[4][2], B0[2][2], B1[2][2];
    unsigned ac00, ac01, ac10, ac11, an00, an01, an10, an11;
    GP_AOFFS(cur, ac00, ac01, ac10, ac11);
    const char* cB = S.bptr(cur);
    GP_STAGE_B(GP_SB(0, 0), cB); GP_STAGE_B(GP_SB(0, 1), cB + hstep); GP_STAGE_A(GP_SA(0, 0), Abase, ac00, ac01); GP_STAGE_A(GP_SA(0, 1), Abase, ac10, ac11);
    if (wr == 1) GP_BAR;
    GP_WAIT_V(2); GP_BAR;
    GP_STAGE_B(GP_SB(1, 0), cB + kstep); GP_STAGE_A(GP_SA(1, 0), Abase + kstep, ac00, ac01); GP_STAGE_B(GP_SB(1, 1), cB + hstep + kstep);
    GP_WAIT_V(6); GP_BAR;
    for (;;) {
        const bool has_next = S.next(ui + 1, nxt);
        if (has_next) { GP_AOFFS(nxt, an00, an01, an10, an11); }
        else { an00 = ac00; an01 = ac01; an10 = ac10; an11 = ac11; }
        const char* nB = has_next ? S.bptr(nxt) : cB;
        for (int t = 0; t < nt; t += 2) {
            const bool last = (t == nt - 2);
            const char* a1 = Abase + (size_t)(t + 1) * kstep;
            const char* a2 = last ? Abase : Abase + (size_t)(t + 2) * kstep; const char* b2 = last ? nB : cB + (size_t)(t + 2) * kstep;
            const char* a3 = a2 + kstep; const char* b3 = b2 + kstep;
            const unsigned x00 = last ? an00 : ac00, x01 = last ? an01 : ac01, x10 = last ? an10 : ac10, x11 = last ? an11 : ac11;
            GP_LDB(B0, 0, 0); GP_LDB(B1, 0, 1); GP_SCHED; GP_LDA(At, 0, 0); GP_STAGE_A(GP_SA(1, 1), a1, ac10, ac11);
            GP_WAIT_V(8); GP_WAIT_L(0); GP_BAR; GP_MMA(0, 0, At, B0); GP_MMA(0, 1, At, B1); GP_BAR; GP_SCHED;
            GP_LDA(At, 0, 1); GP_STAGE_B(GP_SB(0, 0), b2); GP_STAGE_B(GP_SB(0, 1), b2 + hstep); GP_STAGE_A(GP_SA(0, 0), a2, x00, x01);
            GP_WAIT_V(8); GP_WAIT_L(0); GP_BAR; GP_MMA(1, 0, At, B0); GP_MMA(1, 1, At, B1); GP_BAR; GP_SCHED;
            GP_LDB(B0, 1, 0); GP_LDB(B1, 1, 1); GP_SCHED; GP_LDA(At, 1, 0); GP_STAGE_A(GP_SA(0, 1), a2, x10, x11);
            GP_WAIT_V(8); GP_WAIT_L(0); GP_BAR; GP_MMA(0, 0, At, B0); GP_MMA(0, 1, At, B1); GP_BAR; GP_SCHED;
            GP_LDA(At, 1, 1); GP_STAGE_B(GP_SB(1, 0), b3); GP_STAGE_B(GP_SB(1, 1), b3 + hstep); GP_STAGE_A(GP_SA(1, 0), a3, x00, x01);
            GP_WAIT_V(8); GP_WAIT_L(0); GP_BAR; GP_MMA(1, 0, At, B0); GP_MMA(1, 1, At, B1); GP_BAR; GP_SCHED;
        }
        if constexpr (ALIGN_EPI) { if (wr == 0) GP_BAR; }
        { const int l_ = lane_id(); E(acc, cur, wr, wc, l_ & 15, l_ >> 4); }
        if (!has_next) break;
#pragma unroll
        for (int a = 0; a < 2; ++a)
#pragma unroll
            for (int b = 0; b < 2; ++b)
#pragma unroll
                for (int m = 0; m < 4; ++m)
#pragma unroll
                    for (int n = 0; n < 2; ++n) acc[a][b][m][n] = (f32x4){0.f, 0.f, 0.f, 0.f};
        cur = nxt; cB = nB; ac00 = an00; ac01 = an01; ac10 = an10; ac11 = an11; ++ui;
        if constexpr (ALIGN_EPI) { if (wr == 1) GP_BAR; }
    }
    GP_WAIT_V(0);
    if constexpr (!ALIGN_EPI) { if (wr == 0) GP_BAR; }
    GP_BAR;
#undef GP_AOFFS
#undef GP_SA
#undef GP_SB
#undef GP_STAGE_A
#undef GP_STAGE_B
#undef GP_LDA
#undef GP_LDB
#undef GP_MMA
#undef GP_WAIT_V
#undef GP_WAIT_L
#undef GP_BAR
#undef GP_SCHED
}

struct DenseSched {
    int nM, nN, nwg, G, c, K; const char* Bt;
    __device__ __forceinline__ void init(int M, int N, int K_, const void* Bt_, int G_, int c_) { nM = M / BM; nN = N / BM; nwg = nM * nN; G = G_; c = c_; K = K_; Bt = (const char*)Bt_; }
    __device__ __forceinline__ bool next(int i, Unit& u) const {
        const long L = (long)i * G + c; if (L >= nwg) return false;
        int wgid = (int)L; { const int q = nwg / 8, r = nwg % 8, xcd = wgid % 8, off = wgid / 8; wgid = (xcd < r ? xcd * (q + 1) : r * (q + 1) + (xcd - r) * q) + off; }
        const int nig = 8 * nN, gid = wgid / nig, fm = gid * 8, gsz = (nM - fm) < 8 ? (nM - fm) : 8;
        u.pm = fm + ((wgid % nig) % gsz); u.pn = (wgid % nig) / gsz; u.e = 0; u.b = 0; u.cnt = 0; u.base = 0; return true;
    }
    __device__ __forceinline__ unsigned arow(const Unit& u, int r) const { return (unsigned)(u.pm * BM + r) * (unsigned)(K * 2); }
    __device__ __forceinline__ const char* bptr(const Unit& u) const { return Bt + (size_t)u.pn * BM * K * 2; }
};
}

struct EpiInProj {
    bf16_t* F; bf16_t* Q; bf16_t* Kb; bf16_t* Vb; const float* rope;
    __device__ __forceinline__ void operator()(const f32x4 (&acc)[2][2][4][2], const gp::Unit& u, int wr, int wc, int fr, int fq) const {
        const int pn = u.pn, pm = u.pm; const bool isctx = pm >= T / 256;
        if (isctx && pn < 4) return;
        if (pn >= 7) {
            unsigned char* V8 = (unsigned char*)Vb;
#pragma unroll
            for (int ai = 0; ai < 2; ++ai) {
                const int row0 = pm * 256 + ai * 128 + wr * 64;
                int b, tile;
                if (!isctx) { b = row0 >> 13; tile = (CTX >> 6) + ((row0 & 8191) >> 6); } else { const int j = row0 - T; b = j >> 8; tile = (j & 255) >> 6; }
#pragma unroll
                for (int bj = 0; bj < 2; ++bj) {
                    const int head = (pn - 7) * 2 + bj;
                    unsigned char* dst = V8 + ((size_t)(b * NH + head) * (KVLEN / 64) + tile) * 8192 + wc * 2048 + fq * 64 + (fr >> 3) * 32 + (fr & 1) * 16 + ((fr >> 1) & 3) * 4;
#pragma unroll
                    for (int e = 0; e < 8; ++e) {
                        int w = __builtin_amdgcn_cvt_pk_fp8_f32(acc[ai][bj][0][e >> 2][e & 3], acc[ai][bj][1][e >> 2][e & 3], 0, false);
                        w = __builtin_amdgcn_cvt_pk_fp8_f32(acc[ai][bj][2][e >> 2][e & 3], acc[ai][bj][3][e >> 2][e & 3], w, true);
                        *(int*)(dst + e * 256) = w;
                    }
                }
            }
            return;
        }
        const int axis = wc & 1; const float* ct = rope + (axis ? 4096 : 0); const float* st = rope + (axis ? 4096 + 1024 : 2048);
#pragma unroll
        for (int ai = 0; ai < 2; ++ai)
#pragma unroll
            for (int m = 0; m < 4; ++m) {
                const int row = pm * 256 + ai * 128 + wr * 64 + m * 16 + fr;
                int t, kb, tile;
                if (!isctx) { kb = row >> 13; t = row & 8191; tile = (CTX >> 6) + (t >> 6); } else { const int j = row - T; t = 0; kb = j >> 8; tile = (j & 255) >> 6; }
                const int pos = axis ? (t & 63) : (t >> 6);
#pragma unroll
                for (int bj = 0; bj < 2; ++bj) {
                    const int col0 = pn * 256 + bj * 128 + wc * 32 + fq * 8;
                    f32x4 v0 = acc[ai][bj][m][0], v1 = acc[ai][bj][m][1];
                    if (pn == 0) { gp::u32x4 w; w.x = gp::cvt_pk_bf16(v0[0], v0[1]); w.y = gp::cvt_pk_bf16(v0[2], v0[3]); w.z = gp::cvt_pk_bf16(v1[0], v1[1]); w.w = gp::cvt_pk_bf16(v1[2], v1[3]);
                        *(gp::u32x4*)(F + (size_t)row * 256 + col0) = w; continue; }
                    if (pn < 7 && !isctx) {
                        const f32x4 c0 = *(const f32x4*)(ct + pos * 16 + 8 * (fq & 1)), c1 = *(const f32x4*)(ct + pos * 16 + 8 * (fq & 1) + 4);
                        const f32x4 s0 = *(const f32x4*)(st + pos * 16 + 8 * (fq & 1)), s1 = *(const f32x4*)(st + pos * 16 + 8 * (fq & 1) + 4);
                        const float sg = (fq < 2) ? -1.f : 1.f;
#pragma unroll
                        for (int i = 0; i < 4; ++i) {
                            const auto r0 = __builtin_amdgcn_permlane32_swap(__float_as_uint(v0[i]), __float_as_uint(v0[i]), false, false);
                            const auto r1 = __builtin_amdgcn_permlane32_swap(__float_as_uint(v1[i]), __float_as_uint(v1[i]), false, false);
                            const float p0 = __uint_as_float(fq < 2 ? r0[1] : r0[0]), p1 = __uint_as_float(fq < 2 ? r1[1] : r1[0]);
                            v0[i] = v0[i] * c0[i] + sg * p0 * s0[i]; v1[i] = v1[i] * c1[i] + sg * p1 * s1[i]; }
                    }
                    v0 = v0 * SQS; v1 = v1 * SQS;
                    int w0 = __builtin_amdgcn_cvt_pk_fp8_f32(v0[0], v0[1], 0, false); w0 = __builtin_amdgcn_cvt_pk_fp8_f32(v0[2], v0[3], w0, true);
                    int w1 = __builtin_amdgcn_cvt_pk_fp8_f32(v1[0], v1[1], 0, false); w1 = __builtin_amdgcn_cvt_pk_fp8_f32(v1[2], v1[3], w1, true);
                    unsigned char* d;
                    if (pn < 4) d = (unsigned char*)Q + (size_t)row * QKW + (col0 - 256);
                    else d = (unsigned char*)Kb + ((size_t)(kb * NH + (pn - 4) * 2 + bj) * (KVLEN / 64) + tile) * 8192 + wc * 2048 + m * 512 + fr * 32 + fq * 8;
                    typedef int i32x2_t __attribute__((ext_vector_type(2)));
                    *(i32x2_t*)d = (i32x2_t){w0, w1};
                }
            }
    }
};
struct EpiStoreBf16 {
    bf16_t* O; int ldc;
    __device__ __forceinline__ void operator()(const f32x4 (&acc)[2][2][4][2], const gp::Unit& u, int wr, int wc, int fr, int fq) const {
#pragma unroll
        for (int ai = 0; ai < 2; ++ai)
#pragma unroll
            for (int m = 0; m < 4; ++m) {
                bf16_t* rowp = O + (size_t)(u.pm * 256 + ai * 128 + wr * 64 + m * 16 + fr) * ldc + u.pn * 256 + wc * 32 + fq * 8;
#pragma unroll
                for (int bj = 0; bj < 2; ++bj) { const f32x4 v0 = acc[ai][bj][m][0], v1 = acc[ai][bj][m][1];
                    gp::u32x4 w; w.x = gp::cvt_pk_bf16(v0[0], v0[1]); w.y = gp::cvt_pk_bf16(v0[2], v0[3]); w.z = gp::cvt_pk_bf16(v1[0], v1[1]); w.w = gp::cvt_pk_bf16(v1[2], v1[3]);
                    *(gp::u32x4*)(rowp + bj * 128) = w; }
            }
    }
};

__device__ __forceinline__ void ph_inproj(const Params& p, unsigned char* smem) {
    unsigned char* ws = p.ws;
    gp::DenseSched S; S.init(MTOT, INW, D, ws + WS_WINT, gridDim.x, blockIdx.x);
    EpiInProj E{(bf16_t*)(ws + WS_F), (bf16_t*)(ws + WS_Q), (bf16_t*)(ws + WS_K), (bf16_t*)(ws + WS_V), (const float*)(ws + WS_ROPE)};
    gp::gemm_phase<EpiInProj, gp::DenseSched, true>(p.chunk, (GP_LAS unsigned char*)smem, (const char*)(ws + WS_HX), D, S, E);
}
__device__ __forceinline__ void ph_outproj(const Params& p, unsigned char* smem) {
    unsigned char* ws = p.ws;
    gp::DenseSched S; S.init(T, D, D, ws + WS_WOUTT, gridDim.x, blockIdx.x);
    EpiStoreBf16 E{(bf16_t*)(ws + WS_YX), D};
    gp::gemm_phase<EpiStoreBf16, gp::DenseSched, true>(p.chunk, (GP_LAS unsigned char*)smem, (const char*)(ws + WS_AO), D, S, E);
}

__device__ __forceinline__ void transpose_item(const float* W, int K, int N, bf16_t* WT, int row_base, int kb, int nb, float* scr, int lane) {
    const int k0 = 64 * kb, n0 = 32 * nb;
    float tv[32];
#pragma unroll
    for (int i = 0; i < 32; ++i) tv[i] = W[(size_t)(k0 + 2 * i + (lane >> 5)) * N + n0 + (lane & 31)];
#pragma unroll
    for (int i = 0; i < 32; ++i) scr[(2 * i + (lane >> 5)) * 33 + (lane & 31)] = tv[i];
    asm volatile("s_waitcnt lgkmcnt(0)" ::: "memory");
    const int c = lane & 7;
#pragma unroll
    for (int j = 0; j < 4; ++j) { const int n = (lane >> 3) + 8 * j; const float* s = scr + (8 * c) * 33 + n;
        uint4 o; o.x = pk2(s[0 * 33], s[1 * 33]); o.y = pk2(s[2 * 33], s[3 * 33]); o.z = pk2(s[4 * 33], s[5 * 33]); o.w = pk2(s[6 * 33], s[7 * 33]);
        *(uint4*)(WT + (size_t)(row_base + n0 + n) * K + k0 + 8 * c) = o; }
    asm volatile("s_waitcnt lgkmcnt(0)" ::: "memory");
}
__device__ __forceinline__ void ph_prep_weights(const Params& p, float* lds, const int part, const int first) {
    const int tid = otid(), wave = tid >> 6, lane = tid & 63;
    float* scr = lds + 8192 + wave * (64 * 33);
    if ((int)blockIdx.x < first) return;
    const int gw = ((int)blockIdx.x - first) * NWV + wave, GW = ((int)gridDim.x - first) * NWV;
    unsigned char* ws = p.ws;
    constexpr int I_IN = 16 * 80, I_OUT = 16 * 32, I_GU = 16 * 8, I_D = 4 * 32;
    constexpr int NITEMS = I_IN + I_OUT + 65 * (2 * I_GU + I_D);
    const int it_lo = part ? I_IN + I_OUT : 0, it_hi = part ? NITEMS : I_IN + I_OUT;
    for (int it = it_lo + gw; it < it_hi; it += GW) {
        int r = it;
        if (r < I_IN) { transpose_item(p.in[I_WIN], D, INW, (bf16_t*)(ws + WS_WINT), 0, r / 80, r % 80, scr, lane); continue; } r -= I_IN;
        if (r < I_OUT) { transpose_item(p.in[I_WOUT], D, D, (bf16_t*)(ws + WS_WOUTT), 0, r / 32, r % 32, scr, lane); continue; } r -= I_OUT;
        const int e = r / (2 * I_GU + I_D); r -= e * (2 * I_GU + I_D);
        if (r < 2 * I_GU) {
            const int half = r / I_GU, q = r % I_GU, kb = q / 8, nb = q % 8;
            const float* W = (e < 64) ? p.in[half ? I_WU : I_WG] + (size_t)e * D * DE : p.in[half ? I_WSU : I_WSG];
            const int n0 = 32 * nb, drow = e * 512 + (n0 >> 7) * 256 + half * 128 + (n0 & 127);
            transpose_item(W, D, DE, (bf16_t*)(ws + WS_WGUT), drow - n0, kb, nb, scr, lane);
        } else {
            r -= 2 * I_GU;
            const float* W = (e < 64) ? p.in[I_WD] + (size_t)e * DE * D : p.in[I_WSD];
            transpose_item(W, DE, D, (bf16_t*)(ws + WS_WDT), e * 1024, r / 32, r % 32, scr, lane);
        }
    }
}

namespace fa {
typedef short bf16x8 __attribute__((ext_vector_type(8)));
typedef short s16x4 __attribute__((ext_vector_type(4)));
typedef float f32x16 __attribute__((ext_vector_type(16)));
typedef unsigned u32x4 __attribute__((ext_vector_type(4)));
constexpr int KVBLK = 64, LDK = QKW;
constexpr float SCALE = 0.125f, THR = 8.f;
constexpr size_t SHM_V = KVBLK * 128 * 2, SHM_K = KVBLK * 128 * 2;
#define KSWZ(row, colB) ((row) * 256 + ((colB) ^ (((row) & 15) << 4)))
#define SBAR() __builtin_amdgcn_sched_barrier(0)
__device__ __forceinline__ int crow(int r, int hi) { return (r & 3) + 8 * (r >> 2) + 4 * hi; }
__device__ __forceinline__ unsigned cvtpk(float lo, float hi) { unsigned r; asm volatile("v_cvt_pk_bf16_f32 %0, %1, %2" : "=v"(r) : "v"(lo), "v"(hi)); return r; }
constexpr float PBIAS = 5.f, THR2 = PBIAS + 3.5f;
template <bool FIRST>
__device__ __forceinline__ void partialSM(f32x16& p0, f32x16& p1, float& m_reg, f32x16& negm, float& alpha) {
  float pmax = p0[0];
#pragma unroll
  for (int r = 1; r < 16; ++r) pmax = fmaxf(pmax, p0[r]);
#pragma unroll
  for (int r = 0; r < 16; ++r) pmax = fmaxf(pmax, p1[r]);
  { auto rr = __builtin_amdgcn_permlane32_swap(__float_as_uint(pmax), __float_as_uint(pmax), false, false);
    pmax = fmaxf(__uint_as_float(rr[0]), __uint_as_float(rr[1])); }
  if (!FIRST && __builtin_expect(__all(pmax <= THR2), 1)) { alpha = 1.f; }
  else { const float dl = FIRST ? pmax - PBIAS : fmaxf(pmax - PBIAS, 0.f); alpha = FIRST ? 0.f : __builtin_amdgcn_exp2f(-dl); m_reg += dl;
#pragma unroll
    for (int r = 0; r < 16; ++r) { p0[r] -= dl; p1[r] -= dl; }
#pragma unroll
    for (int r = 0; r < 16; ++r) negm[r] = -m_reg;
    asm volatile("" : "+v"(negm)); }
#pragma unroll
  for (int r = 0; r < 16; ++r) p0[r] = __builtin_amdgcn_exp2f(p0[r]);
}
typedef int i32x8 __attribute__((ext_vector_type(8)));
__device__ __forceinline__ void finishSM_T(f32x16& p0, f32x16& p1, float alpha, float& l_reg, i32x8& pb) {
#pragma unroll
  for (int r = 0; r < 16; ++r) p1[r] = __builtin_amdgcn_exp2f(p1[r]);
  float ps = 0;
#pragma unroll
  for (int r = 0; r < 16; ++r) ps += p0[r];
#pragma unroll
  for (int r = 0; r < 16; ++r) ps += p1[r];
  { auto rr = __builtin_amdgcn_permlane32_swap(__float_as_uint(ps), __float_as_uint(ps), false, false);
    ps = __uint_as_float(rr[0]) + __uint_as_float(rr[1]); }
  l_reg = l_reg * alpha + ps;
#pragma unroll
  for (int g = 0; g < 4; ++g) {
    int w0 = __builtin_amdgcn_cvt_pk_fp8_f32(p0[4 * g], p0[4 * g + 1], 0, false); w0 = __builtin_amdgcn_cvt_pk_fp8_f32(p0[4 * g + 2], p0[4 * g + 3], w0, true); pb[g] = w0;
    int w1 = __builtin_amdgcn_cvt_pk_fp8_f32(p1[4 * g], p1[4 * g + 1], 0, false); w1 = __builtin_amdgcn_cvt_pk_fp8_f32(p1[4 * g + 2], p1[4 * g + 3], w1, true); pb[4 + g] = w1; }
}
__device__ __forceinline__ void qkt(f32x16& p0, f32x16& p1, const char* Ks, const i32x8 qf, int lane, int mm, const f32x16& negm) {
  const char* kp = Ks + mm * 4096 + lane * 16;
  const u32x4 a0 = *reinterpret_cast<const u32x4*>(kp), a1 = *reinterpret_cast<const u32x4*>(kp + 1024), b0 = *reinterpret_cast<const u32x4*>(kp + 2048), b1 = *reinterpret_cast<const u32x4*>(kp + 3072);
  p0 = __builtin_amdgcn_mfma_scale_f32_32x32x64_f8f6f4((i32x8){(int)a0.x, (int)a0.y, (int)a0.z, (int)a0.w, (int)a1.x, (int)a1.y, (int)a1.z, (int)a1.w}, qf, negm, 0, 0, 0, 0, 0, 0);
  p1 = __builtin_amdgcn_mfma_scale_f32_32x32x64_f8f6f4((i32x8){(int)b0.x, (int)b0.y, (int)b0.z, (int)b0.w, (int)b1.x, (int)b1.y, (int)b1.z, (int)b1.w}, qf, negm, 0, 0, 0, 0, 0, 0);
}
__device__ __forceinline__ int v_st(int k, int c) { const int kk = (k & ~0xC) | ((k & 4) << 1) | ((k & 8) >> 1); return ((kk >> 3) * 4 + (c >> 5)) * 512 + ((kk & 7) * 32 + (c & 31)) * 2; }
__device__ __forceinline__ int v_rd_base(int lane) { return ((lane & 3) << 3) | (((lane >> 2) & 3) << 6) | (((lane >> 4) & 1) << 5) | (((lane >> 5) & 1) << 8); }
constexpr int v_rd_off(int d0, int ks, int half) { return d0 * 512 + ks * 4096 + half * 2048; }
template <int OFF> __device__ __forceinline__ s16x4 tr_read(int vb) {
  s16x4 r; asm volatile("ds_read_b64_tr_b16 %0, %1 offset:%2" : "=&v"(r) : "v"(vb), "i"(OFF) : "memory"); return r;
}
template <int D0> __device__ __forceinline__ void pv_one(f32x16& od, int vb, bf16x8 pa0, bf16x8 pa1, bf16x8 pa2, bf16x8 pa3) {
  const s16x4 l0 = tr_read<v_rd_off(D0, 0, 0)>(vb), h0 = tr_read<v_rd_off(D0, 0, 1)>(vb), l1 = tr_read<v_rd_off(D0, 1, 0)>(vb), h1 = tr_read<v_rd_off(D0, 1, 1)>(vb);
  const s16x4 l2 = tr_read<v_rd_off(D0, 2, 0)>(vb), h2 = tr_read<v_rd_off(D0, 2, 1)>(vb), l3 = tr_read<v_rd_off(D0, 3, 0)>(vb), h3 = tr_read<v_rd_off(D0, 3, 1)>(vb);
  asm volatile("s_waitcnt lgkmcnt(0)" ::: "memory"); SBAR();
#define PK(L, H) (bf16x8){L[0], L[1], L[2], L[3], H[0], H[1], H[2], H[3]}
  od = __builtin_amdgcn_mfma_f32_32x32x16_bf16(pa0, PK(l0, h0), od, 0, 0, 0);
  od = __builtin_amdgcn_mfma_f32_32x32x16_bf16(pa1, PK(l1, h1), od, 0, 0, 0);
  od = __builtin_amdgcn_mfma_f32_32x32x16_bf16(pa2, PK(l2, h2), od, 0, 0, 0);
  od = __builtin_amdgcn_mfma_f32_32x32x16_bf16(pa3, PK(l3, h3), od, 0, 0, 0);
#undef PK
}
__device__ __forceinline__ void pv_d0(f32x16* o, int vb, bf16x8 pa0, bf16x8 pa1, bf16x8 pa2, bf16x8 pa3) {
  pv_one<0>(o[0], vb, pa0, pa1, pa2, pa3); pv_one<1>(o[1], vb, pa0, pa1, pa2, pa3); pv_one<2>(o[2], vb, pa0, pa1, pa2, pa3); pv_one<3>(o[3], vb, pa0, pa1, pa2, pa3);
}

template <int OFF> __device__ __forceinline__ u32x4 rd128(int vb) { u32x4 r; asm volatile("ds_read_b128 %0, %1 offset:%2" : "=&v"(r) : "v"(vb), "i"(OFF) : "memory"); return r; }
#define PV_RD(D0) const u32x4 va##D0 = rd128<D0 * 2048>(vb), vc##D0 = rd128<D0 * 2048 + 1024>(vb); SBAR()
#define PV_MM(D0) do { asm volatile("s_waitcnt lgkmcnt(0)" ::: "memory"); SBAR(); \
    o[D0] = __builtin_amdgcn_mfma_scale_f32_32x32x64_f8f6f4((i32x8){(int)va##D0.x, (int)va##D0.y, (int)va##D0.z, (int)va##D0.w, (int)vc##D0.x, (int)vc##D0.y, (int)vc##D0.z, (int)vc##D0.w}, pb, o[D0], 0, 0, 0, 0, 0, 0); } while (0)
__device__ __forceinline__ float max3f(float a, float b, float c) { float r; asm("v_max3_f32 %0, %1, %2, %3" : "=v"(r) : "v"(a), "v"(b), "v"(c)); return r; }
__device__ __forceinline__ void pv_psm(f32x16* o, int vb, i32x8 pb, f32x16& p0, f32x16& p1, float& m_reg, f32x16& negm, float& alpha) {
  float pmax;
  { PV_RD(0);
    pmax = max3f(p0[0], p0[1], p0[2]);
#pragma unroll
    for (int r = 3; r < 15; r += 2) pmax = max3f(pmax, p0[r], p0[r + 1]);
    pmax = max3f(pmax, p0[15], p1[0]);
    SBAR(); PV_MM(0); }
  { PV_RD(1);
#pragma unroll
    for (int r = 1; r < 15; r += 2) pmax = max3f(pmax, p1[r], p1[r + 1]);
    pmax = max3f(pmax, p1[15], p1[15]);
    { auto rr = __builtin_amdgcn_permlane32_swap(__float_as_uint(pmax), __float_as_uint(pmax), false, false);
      pmax = max3f(__uint_as_float(rr[0]), __uint_as_float(rr[1]), __uint_as_float(rr[1])); }
    if (__builtin_expect(__all(pmax <= THR2), 1)) { alpha = 1.f; }
    else { const float dl = fmaxf(pmax - PBIAS, 0.f); alpha = __builtin_amdgcn_exp2f(-dl); m_reg += dl;
#pragma unroll
      for (int r = 0; r < 16; ++r) { p0[r] -= dl; p1[r] -= dl; }
#pragma unroll
      for (int r = 0; r < 16; ++r) negm[r] = -m_reg;
      asm volatile("" : "+v"(negm)); }
    SBAR(); PV_MM(1); }
  { PV_RD(2);
#pragma unroll
    for (int r = 0; r < 8; ++r) p0[r] = __builtin_amdgcn_exp2f(p0[r]);
    asm volatile("" : "+v"(p0));
    SBAR(); PV_MM(2); }
  { PV_RD(3);
#pragma unroll
    for (int r = 8; r < 16; ++r) p0[r] = __builtin_amdgcn_exp2f(p0[r]);
    asm volatile("" : "+v"(p0));
    SBAR(); PV_MM(3); }
}
__device__ __forceinline__ void pvT_d0(f32x16* o, int vb, i32x8 pb) {
  { PV_RD(0); PV_MM(0); } { PV_RD(1); PV_MM(1); } { PV_RD(2); PV_MM(2); } { PV_RD(3); PV_MM(3); }
}
#undef PV_RD
#undef PV_MM

__device__ __forceinline__ void attn_unit(const unsigned char* __restrict__ Qb, const unsigned char* __restrict__ Kh, const unsigned char* __restrict__ Vh, bf16_t* __restrict__ Ob,
                                          const float* __restrict__ gsub, const float lam, char* lds, const int wv) {
  typedef __attribute__((address_space(3))) unsigned* ldsu_t;
  const int tid = otid_w(wv), wid = wv, lane = tid & 63, r32 = lane & 31, hi = lane >> 5, mm = wid >> 2, wq = wid & 3;
  constexpr int NB = 4;
  constexpr int SHM_V8 = KVBLK * 128;
  char* V_lds = lds; char* K_lds = lds + NB * SHM_V8; constexpr int SHM_K8 = KVBLK * 128;
  float m_reg = 0.f, l_reg = 0; f32x16 o[4] = {}; i32x8 qf; f32x16 negm = {}; asm volatile("" : "+v"(negm));
  const unsigned koff = (unsigned)((2 * (wid >> 2) + (lane >> 5)) * 2048 + (lane & 3) * 512 + (8 * ((wid >> 1) & 1) + 2 * ((lane & 31) >> 3) + ((lane >> 2) & 1)) * 32 + (wid & 1) * 16);
  const unsigned voff = (unsigned)((wid >> 1) * 2048 + (lane & 7) * 256 + ((lane >> 3) & 3) * 64 + (wid & 1) * 32 + (lane >> 5) * 16);
#define DMA(t, buf) do { const char* kb_ = (const char*)(Kh + (size_t)(t) * SHM_K8); const char* vb_ = (const char*)(Vh + (size_t)(t) * SHM_V8); asm volatile("" : "+s"(kb_), "+s"(vb_)); \
    __builtin_amdgcn_global_load_lds((const unsigned*)(kb_ + koff), (ldsu_t)(K_lds + (buf) * SHM_K8 + wid * 1024), 16, 0, 0); \
    __builtin_amdgcn_global_load_lds((const unsigned*)(vb_ + voff), (ldsu_t)(V_lds + (buf) * SHM_V8 + wid * 1024), 16, 0, 0); } while (0)
#define WAIT_BAR(N) asm volatile("s_waitcnt vmcnt(" #N ") lgkmcnt(0)\n\ts_barrier" ::: "memory")
#define RESC(a) do { if (__any((a) < 1.f)) { _Pragma("unroll") for (int d = 0; d < 4; ++d) _Pragma("unroll") for (int r = 0; r < 16; ++r) o[d][r] *= (a); } } while (0)
  DMA(0, 0); DMA(1, 1);
  { const unsigned char* Qw = Qb + (long)(wq * 32 + r32) * QKW + mm * 64 + hi * 32;
    const u32x4 q0 = *reinterpret_cast<const u32x4*>(Qw), q1 = *reinterpret_cast<const u32x4*>(Qw + 16);
    qf = (i32x8){(int)q0.x, (int)q0.y, (int)q0.z, (int)q0.w, (int)q1.x, (int)q1.y, (int)q1.z, (int)q1.w}; }
  const int vb0 = (int)(uintptr_t)V_lds + lane * 16;
  f32x16 pA0, pA1, pB0, pB1; float alA, alB; i32x8 pb; constexpr int NTL = KVLEN / KVBLK;
  WAIT_BAR(0);
  DMA(2, 2);
  qkt(pA0, pA1, K_lds, qf, lane, mm, negm); partialSM<true>(pA0, pA1, m_reg, negm, alA);
  WAIT_BAR(2);
  for (int j = 1; j + 1 < NTL; j += 2) {
    DMA(j + 2, (j + 2) & 3);
    SBAR(); qkt(pB0, pB1, K_lds + (j & 3) * SHM_K8, qf, lane, mm, negm);
    finishSM_T(pA0, pA1, alA, l_reg, pb); SBAR();
    pv_psm(o, vb0 + ((j - 1) & 3) * SHM_V8, pb, pB0, pB1, m_reg, negm, alB);
    RESC(alB);
    WAIT_BAR(2);
    if (j + 3 < NTL) DMA(j + 3, (j + 3) & 3);
    SBAR(); qkt(pA0, pA1, K_lds + ((j + 1) & 3) * SHM_K8, qf, lane, mm, negm);
    finishSM_T(pB0, pB1, alB, l_reg, pb); SBAR();
    pv_psm(o, vb0 + (j & 3) * SHM_V8, pb, pA0, pA1, m_reg, negm, alA);
    RESC(alA);
    if (j + 3 < NTL) WAIT_BAR(2); else WAIT_BAR(0);
  }
  SBAR(); qkt(pB0, pB1, K_lds + ((NTL - 1) & 3) * SHM_K8, qf, lane, mm, negm);
  finishSM_T(pA0, pA1, alA, l_reg, pb); SBAR();
  pv_psm(o, vb0 + ((NTL - 2) & 3) * SHM_V8, pb, pB0, pB1, m_reg, negm, alB);
  RESC(alB);
  finishSM_T(pB0, pB1, alB, l_reg, pb); SBAR();
  pvT_d0(o, vb0 + ((NTL - 1) & 3) * SHM_V8, pb);
#undef DMA
#undef WAIT_BAR
  const float rl = __builtin_amdgcn_rcpf(l_reg) * (mm ? lam : 1.0f);
  __syncthreads();
  constexpr int XS = 132;
  float* X = (float*)lds;
  if (mm == 1) {
#pragma unroll
    for (int r = 0; r < 16; ++r)
#pragma unroll
      for (int d0 = 0; d0 < 4; ++d0) X[(wq * 32 + r32) * XS + d0 * 32 + crow(r, hi)] = o[d0][r] * rl;
  }
  __syncthreads();
  if (mm == 0) {
#pragma unroll
    for (int r = 0; r < 16; ++r)
#pragma unroll
      for (int d0 = 0; d0 < 4; ++d0) { float* xp = X + (wq * 32 + r32) * XS + d0 * 32 + crow(r, hi); *xp = o[d0][r] * rl - *xp; }
  }
  __syncthreads();
  {
    const int row = tid >> 2, seg = tid & 3;
    const float* xr = X + row * XS + seg * 32;
    f32x4 v[8]; float ss = 0.f;
#pragma unroll
    for (int i = 0; i < 8; ++i) { v[i] = *(const f32x4*)(xr + 4 * i); ss += v[i][0] * v[i][0] + v[i][1] * v[i][1] + v[i][2] * v[i][2] + v[i][3] * v[i][3]; }
    ss += sx<1>(ss); ss += sx<2>(ss);
    const float rs = (1.0f - LAM_INIT) / sqrtf(ss * (1.0f / 128.0f) + EPS);
    bf16_t* dst = Ob + (long)row * D + seg * 32;
#pragma unroll
    for (int i = 0; i < 8; i += 2) {
      const f32x4 g0 = *(const f32x4*)(gsub + seg * 32 + 4 * i), g1 = *(const f32x4*)(gsub + seg * 32 + 4 * i + 4);
      u32x4 w; w.x = cvtpk(v[i][0] * rs * g0[0], v[i][1] * rs * g0[1]); w.y = cvtpk(v[i][2] * rs * g0[2], v[i][3] * rs * g0[3]);
      w.z = cvtpk(v[i + 1][0] * rs * g1[0], v[i + 1][1] * rs * g1[1]); w.w = cvtpk(v[i + 1][2] * rs * g1[2], v[i + 1][3] * rs * g1[3]);
      *(u32x4*)(dst + 4 * i) = w;
    }
  }
  __syncthreads();
#undef RESC
}
#undef KSWZ
#undef SBAR
}

__device__ __forceinline__ void ph_attn(const Params& p, unsigned char* smem) {
    unsigned char* ws = p.ws;
    const unsigned char* Q = ws + WS_Q; const unsigned char* Kb = ws + WS_K; const unsigned char* Vb = ws + WS_V;
    bf16_t* AO = (bf16_t*)(ws + WS_AO);
    const float lam = ((const float*)(ws + WS_CTL))[1024];
    const int c = blockIdx.x, G = gridDim.x;
    if (G == 256) {
        const int x = c & 7, s = c >> 3;
        for (int rd = 0; rd < 6; ++rd) {
            const int bh = rd * 4 + (x >> 1), qb = (x & 1) * 32 + s, b = bh / NH, h = bh % NH;
            fa::attn_unit(Q + ((size_t)b * SEQ + qb * 128) * QKW + h * 128, Kb + (size_t)(b * NH + h) * (KVLEN / 64) * 8192, Vb + (size_t)(b * NH + h) * (KVLEN / 64) * 8192,
                          AO + ((size_t)b * SEQ + qb * 128) * D + 256 + h * 128, p.in[I_GSUB], lam, (char*)smem, p.chunk);
        }
    } else {
        for (int u = c; u < BATCH * NH * 64; u += G) {
            const int bh = u >> 6, qb = u & 63, b = bh / NH, h = bh % NH;
            fa::attn_unit(Q + ((size_t)b * SEQ + qb * 128) * QKW + h * 128, Kb + (size_t)(b * NH + h) * (KVLEN / 64) * 8192, Vb + (size_t)(b * NH + h) * (KVLEN / 64) * 8192,
                          AO + ((size_t)b * SEQ + qb * 128) * D + 256 + h * 128, p.in[I_GSUB], lam, (char*)smem, p.chunk);
        }
    }
}

__device__ __forceinline__ void ph_fourierA(const Params& p, unsigned char* smem) {
    using namespace fa;
    unsigned char* ws = p.ws;
    const bf16_t* F = (const bf16_t*)(ws + WS_F); bf16_t* FY = (bf16_t*)(ws + WS_FY); const bf16_t* W = (const bf16_t*)(ws + WS_W128E);
    const int tid = otid(), wid = tid >> 6, lane = tid & 63, r32 = lane & 31, hi = lane >> 5;
    const int sr = tid >> 4, sc = (tid & 15) * 8, vst0 = v_st(sr, sc), vst1 = v_st(32 + sr, sc);
    const int vb0 = (int)(uintptr_t)smem + v_rd_base(lane);
    for (int task = blockIdx.x; task < BATCH * 64; task += gridDim.x) {
        const int b = task >> 6, n2 = task & 63;
        bf16x8 st[4][2];
#pragma unroll
        for (int kt = 0; kt < 2; ++kt)
#pragma unroll
            for (int ct = 0; ct < 2; ++ct) {
                st[kt * 2 + ct][0] = *(const bf16x8*)(F + ((size_t)b * SEQ + 64 * (64 * kt + sr) + n2) * 256 + 128 * ct + sc);
                st[kt * 2 + ct][1] = *(const bf16x8*)(F + ((size_t)b * SEQ + 64 * (64 * kt + 32 + sr) + n2) * 256 + 128 * ct + sc);
            }
        bf16x8 pa[2][4];
#pragma unroll
        for (int kt = 0; kt < 2; ++kt)
#pragma unroll
            for (int ks = 0; ks < 4; ++ks) pa[kt][ks] = *(const bf16x8*)(W + (size_t)(32 * wid + r32) * 128 + 64 * kt + 16 * ks + 8 * hi);
        __syncthreads();
#pragma unroll
        for (int q = 0; q < 4; ++q) { *(bf16x8*)(smem + q * 16384 + vst0) = st[q][0]; *(bf16x8*)(smem + q * 16384 + vst1) = st[q][1]; }
        __syncthreads();
        f32x16 o[2][4] = {};
#pragma unroll
        for (int ct = 0; ct < 2; ++ct)
#pragma unroll
            for (int kt = 0; kt < 2; ++kt) pv_d0(o[ct], vb0 + (kt * 2 + ct) * 16384, pa[kt][0], pa[kt][1], pa[kt][2], pa[kt][3]);
        const int plane = wid >> 2;
#pragma unroll
        for (int r = 0; r < 16; ++r) {
            const int k1 = 32 * (wid & 3) + crow(r, hi);
            bf16_t* dst = FY + ((((size_t)plane * BATCH + b) * 128 + k1) * 64 + n2) * 256 + r32;
#pragma unroll
            for (int ct = 0; ct < 2; ++ct)
#pragma unroll
                for (int d0 = 0; d0 < 4; ++d0) dst[128 * ct + 32 * d0] = f2bf(o[ct][d0][r]);
        }
    }
    __syncthreads();
}
__device__ __forceinline__ void ph_fourierB(const Params& p, unsigned char* smem) {
    using namespace fa;
    unsigned char* ws = p.ws;
    const bf16_t* FY = (const bf16_t*)(ws + WS_FY); const float2* tabw = (const float2*)(ws + WS_TABW);
    const bf16_t* M64 = (const bf16_t*)(ws + WS_M64E); const bf16_t* GT = (const bf16_t*)(ws + WS_GT);
    bf16_t* AO = (bf16_t*)(ws + WS_AO);
    const int tid = otid(), wid = tid >> 6, lane = tid & 63, r32 = lane & 31, hi = lane >> 5;
    const int sr = tid >> 4, sc = (tid & 15) * 8, vst0 = v_st(sr, sc), vst1 = v_st(32 + sr, sc);
    const int vb0 = (int)(uintptr_t)smem + v_rd_base(lane);
    constexpr int XRS = 528;
    unsigned char* XL = smem + 65536;
    const int mt = wid & 3, ctw = wid >> 2;
    for (int task = blockIdx.x; task < BATCH * 128; task += gridDim.x) {
        const int b = task >> 7, k1 = task & 127;
        __syncthreads();
#pragma unroll
        for (int ct = 0; ct < 2; ++ct)
#pragma unroll
            for (int rh = 0; rh < 2; ++rh) {
                const int n2 = sr + 32 * rh;
                const size_t off = ((((size_t)b) * 128 + k1) * 64 + n2) * 256 + 128 * ct + sc;
                const uint4 yr = *(const uint4*)(FY + off), yi = *(const uint4*)(FY + (size_t)BATCH * 128 * 64 * 256 + off);
                const float2 tw = tabw[n2 * k1];
                const unsigned yrw[4] = {yr.x, yr.y, yr.z, yr.w}, yiw[4] = {yi.x, yi.y, yi.z, yi.w};
                unsigned zr[4], zi[4];
#pragma unroll
                for (int q = 0; q < 4; ++q) {
                    const float a0 = __uint_as_float(yrw[q] << 16), a1 = __uint_as_float(yrw[q] & 0xffff0000u), b0 = __uint_as_float(yiw[q] << 16), b1 = __uint_as_float(yiw[q] & 0xffff0000u);
                    zr[q] = pk2(a0 * tw.x + b0 * tw.y, a1 * tw.x + b1 * tw.y); zi[q] = pk2(b0 * tw.x - a0 * tw.y, b1 * tw.x - a1 * tw.y);
                }
                const int vs = rh ? vst1 : vst0;
                *(uint4*)(smem + (0 * 2 + ct) * 16384 + vs) = make_uint4(zr[0], zr[1], zr[2], zr[3]);
                *(uint4*)(smem + (1 * 2 + ct) * 16384 + vs) = make_uint4(zi[0], zi[1], zi[2], zi[3]);
            }
        __syncthreads();
        {
            f32x16 o[4] = {};
#pragma unroll
            for (int kt = 0; kt < 2; ++kt) {
                bf16x8 pa[4];
#pragma unroll
                for (int ks = 0; ks < 4; ++ks) pa[ks] = *(const bf16x8*)(M64 + (size_t)(32 * mt + r32) * 128 + 64 * kt + 16 * ks + 8 * hi);
                pv_d0(o, vb0 + (kt * 2 + ctw) * 16384, pa[0], pa[1], pa[2], pa[3]);
            }
#pragma unroll
            for (int r = 0; r < 16; ++r) {
                const int ro = 32 * mt + crow(r, hi);
                bf16_t* xr = (bf16_t*)(XL + ((ro >> 6) * 64 + (ro & 63)) * XRS) + 128 * ctw + r32;
#pragma unroll
                for (int d0 = 0; d0 < 4; ++d0) xr[32 * d0] = f2bf(o[d0][r]);
            }
        }
        __syncthreads();
#pragma unroll
        for (int tt = 0; tt < 2; ++tt) {
            const int tau = 2 * wid + tt, g = tau >> 2, mt2 = (tau >> 1) & 1, nt2 = tau & 1;
            f32x16 acc = {};
#pragma unroll
            for (int ks8 = 0; ks8 < 8; ++ks8) {
                const int part = ks8 >> 2, cb = ks8 & 3;
                const bf16x8 af = *(const bf16x8*)(XL + (part * 64 + 32 * mt2 + r32) * XRS + (g * 64 + 16 * cb + 8 * hi) * 2);
                const bf16x8 bfr = *(const bf16x8*)(GT + ((size_t)g * 64 + 32 * nt2 + r32) * 128 + part * 64 + 16 * cb + 8 * hi);
                acc = __builtin_amdgcn_mfma_f32_32x32x16_bf16(af, bfr, acc, 0, 0, 0);
            }
#pragma unroll
            for (int r = 0; r < 16; ++r) { const int k2 = 32 * mt2 + crow(r, hi);
                AO[((size_t)b * SEQ + k1 + 128 * k2) * D + g * 64 + 32 * nt2 + r32] = f2bf(acc[r]); }
        }
    }
    __syncthreads();
}

__device__ __forceinline__ void ph_mid(const Params& p, unsigned char* smem) {
    typedef short bf16x8 __attribute__((ext_vector_type(8)));
    unsigned char* ws = p.ws;
    const int tid = otid(), wave = tid >> 6, lane = tid & 63, fr = lane & 15, fq = lane >> 4;
    const float* mod = (const float*)(ws + WS_MOD);
    const bf16_t* YX = (const bf16_t*)(ws + WS_YX);
    bf16_t* H2 = (bf16_t*)(ws + WS_H2);
    unsigned* counts = (unsigned*)(ws + WS_CTL);
    int* TE = (int*)(ws + WS_TE); int* TP = (int*)(ws + WS_TP); float* TW = (float*)(ws + WS_TW); int* TOKL = (int*)(ws + WS_TOKL);
    constexpr int RS = 2064;
    unsigned char* Ahi = smem; unsigned char* Alo = smem + 16 * RS; float* Pp = (float*)(smem + 2 * 16 * RS + 512);
    const float rbias = p.in[I_RB][lane];
    int* lcnt = (int*)(smem + 99328); int* gb = lcnt + 64; int* PE = gb + 64; float* PW = (float*)(PE + 1024); float* PV = PW + 1024;
    for (int chunk = blockIdx.x; chunk < T / 128; chunk += gridDim.x) {
      const int mc = chunk * 128, b = mc >> 13;
      if (tid < 64) lcnt[tid] = 0;
      {
          const float* mrow_ = mod + b * 6144;
          for (int i = tid; i < 5 * 256; i += NT) { const int v_ = i >> 8, q_ = (i & 255) * 4;
              const float* s_ = (v_ == 0) ? p.in[I_GAPOST] + q_ : (v_ == 1) ? mrow_ + 2 * 1024 + q_ : (v_ == 2) ? p.in[I_GFPRE] + q_ : (v_ == 3) ? mrow_ + 3 * 1024 + q_ : mrow_ + 4 * 1024 + q_;
              *(f32x4*)(PV + v_ * 1024 + q_) = *(const f32x4*)s_; }
          __syncthreads();
      }
      uint2 yw[2][4]; f32x4 xv[2][4];
#define MID_LOAD(m0_) do { _Pragma("unroll") for (int rr = 0; rr < 2; ++rr) { const int m_ = (m0_) + 2 * wave + rr; _Pragma("unroll") for (int j = 0; j < 4; ++j) { \
          yw[rr][j] = *(const uint2*)(YX + (size_t)m_ * D + 4 * (lane + 64 * j)); xv[rr][j] = ((const f32x4*)(p.in[I_X] + (size_t)m_ * D))[lane + 64 * j]; } } } while (0)
      MID_LOAD(mc);
      for (int it = 0; it < 8; ++it) {
        const int m0 = mc + it * 16;
        {
            float ss[2] = {0.f, 0.f};
#define YV(rr, j, i) ((i) == 0 ? __uint_as_float(yw[rr][j].x << 16) : (i) == 1 ? __uint_as_float(yw[rr][j].x & 0xffff0000u) : (i) == 2 ? __uint_as_float(yw[rr][j].y << 16) : __uint_as_float(yw[rr][j].y & 0xffff0000u))
#pragma unroll
            for (int rr = 0; rr < 2; ++rr) {
#pragma unroll
                for (int j = 0; j < 4; ++j) ss[rr] += YV(rr, j, 0) * YV(rr, j, 0) + YV(rr, j, 1) * YV(rr, j, 1) + YV(rr, j, 2) * YV(rr, j, 2) + YV(rr, j, 3) * YV(rr, j, 3);
                ss[rr] = wave_sum(ss[rr]);
            }
#pragma unroll
            for (int rr = 0; rr < 2; ++rr) {
                const int lr = 2 * wave + rr, m = m0 + lr;
                const float r1 = 1.0f / sqrtf(ss[rr] * (1.0f / D) + EPS);
                float ss2 = 0.f;
#pragma unroll
                for (int j = 0; j < 4; ++j) {
                    const int col = 4 * (lane + 64 * j);
                    const f32x4 gp = *(const f32x4*)(PV + col), gt = *(const f32x4*)(PV + 1024 + col);
#pragma unroll
                    for (int i = 0; i < 4; ++i) { xv[rr][j][i] = xv[rr][j][i] + gt[i] * (YV(rr, j, i) * r1 * gp[i]); ss2 += xv[rr][j][i] * xv[rr][j][i]; }
                    ((f32x4*)(p.out + (size_t)m * D))[lane + 64 * j] = xv[rr][j];
                }
                ss2 = wave_sum(ss2);
                const float r2 = 1.0f / sqrtf(ss2 * (1.0f / D) + EPS);
#pragma unroll
                for (int j = 0; j < 4; ++j) {
                    const int col = 4 * (lane + 64 * j);
                    const f32x4 gp = *(const f32x4*)(PV + 2048 + col), sh = *(const f32x4*)(PV + 3072 + col), sc = *(const f32x4*)(PV + 4096 + col);
                    float h[4]; bf16_t hb[4]; float lo[4];
#pragma unroll
                    for (int i = 0; i < 4; ++i) { h[i] = xv[rr][j][i] * r2 * gp[i] * (1.f + sc[i]) + sh[i]; hb[i] = f2bf(h[i]); lo[i] = h[i] - bf2f(hb[i]); }
                    uint2 o; o.x = (unsigned)hb[0] | ((unsigned)hb[1] << 16); o.y = (unsigned)hb[2] | ((unsigned)hb[3] << 16);
                    *(uint2*)(H2 + (size_t)m * D + col) = o;
                    *(uint2*)(Ahi + lr * RS + col * 2) = o;
                    uint2 ol; ol.x = pk2(lo[0], lo[1]); ol.y = pk2(lo[2], lo[3]);
                    *(uint2*)(Alo + lr * RS + col * 2) = ol;
                }
            }
            if (it < 7) MID_LOAD(m0 + 16);
        }
        asm volatile("s_waitcnt lgkmcnt(0)\n\ts_barrier" ::: "memory");
        {
            f32x4 acc[4];
#pragma unroll
            for (int nb = 0; nb < 4; ++nb) acc[nb] = (f32x4){0.f, 0.f, 0.f, 0.f};
            const bf16_t* wrtlo = (const bf16_t*)(ws + WS_WRT); asm volatile("" : "+s"(wrtlo));
#pragma unroll
            for (int ks = 0; ks < 4; ++ks) {
                const int ko = (wave * 128 + ks * 32 + 8 * fq) * 2;
                const bf16x8 ah = *(const bf16x8*)(Ahi + fr * RS + ko), al = *(const bf16x8*)(Alo + fr * RS + ko);
#pragma unroll
                for (int nb = 0; nb < 4; ++nb) {
                    const size_t wo_ = ((size_t)(((wave * 4 + ks) * 4 + nb) * 2) * 64 + lane) * 8;
                    const bf16x8 bhv = *(const bf16x8*)(wrtlo + wo_), bl = *(const bf16x8*)(wrtlo + wo_ + 512);
                    acc[nb] = __builtin_amdgcn_mfma_f32_16x16x32_bf16(ah, bhv, acc[nb], 0, 0, 0);
                    acc[nb] = __builtin_amdgcn_mfma_f32_16x16x32_bf16(ah, bl, acc[nb], 0, 0, 0);
                    acc[nb] = __builtin_amdgcn_mfma_f32_16x16x32_bf16(al, bhv, acc[nb], 0, 0, 0);
                }
            }
#pragma unroll
            for (int nb = 0; nb < 4; ++nb)
#pragma unroll
                for (int j = 0; j < 4; ++j) Pp[(wave * 16 + 4 * fq + j) * 64 + 16 * nb + fr] = acc[nb][j];
        }
        asm volatile("s_waitcnt lgkmcnt(0)\n\ts_barrier" ::: "memory");
#pragma unroll
        for (int rr = 0; rr < 2; ++rr) {
            const int lr = 2 * wave + rr;
            float lg = 0.f;
#pragma unroll
            for (int w = 0; w < 8; ++w) lg += Pp[(w * 16 + lr) * 64 + lane];
            const float score = 1.0f / (1.0f + expf(-lg));
            const float sel = score + rbias;
            float t1 = sel, t2 = -INFINITY;
#define TOP2(M) do { const float o1 = sx<M>(t1), o2 = sx<M>(t2); const float n1 = fmaxf(t1, o1), n2 = fmaxf(fminf(t1, o1), fmaxf(t2, o2)); t1 = n1; t2 = n2; } while (0)
            TOP2(1); TOP2(2); TOP2(4);
#undef TOP2
            const float gs = t1 + t2; const int grp = lane >> 3;
            int gr = 0;
#pragma unroll
            for (int j = 0; j < 8; ++j) { const float sj = __uint_as_float(__builtin_amdgcn_readlane(__float_as_uint(gs), j * 8)); gr += (sj > gs || (sj == gs && j < grp)) ? 1 : 0; }
            const bool gsel = gr < 4;
            float v = gsel ? sel : -INFINITY;
            int rk = TOPK;
#pragma unroll
            for (int it8 = 0; it8 < TOPK; ++it8) {
                const float mx = wave_max(v);
                const unsigned long long eq = __ballot(v == mx);
                const int win = __builtin_ctzll(eq);
                if (lane == win) { rk = it8; v = -INFINITY; }
            }
            const bool chosen = rk < TOPK;
            const float ssum = wave_sum(chosen ? score : 0.f);
            const float w = score / (ssum + 1e-20f) * 2.5f;
            if (chosen) {
                const int lpos = atomicAdd(&lcnt[lane], 1);
                const int idx = (it * 16 + lr) * 8 + rk;
                PE[idx] = lane | (lpos << 8); PW[idx] = w;
            }
        }
      }
      __syncthreads();
      if (tid < 64) { const int c = lcnt[tid]; gb[tid] = c ? (int)atomicAdd(&counts[b * 65 + tid], (unsigned)c) : 0; }
      __syncthreads();
      for (int i = tid; i < 1024; i += NT) {
          const int pe = PE[i], e = pe & 255, pos = gb[e] + (pe >> 8), mk = mc * 8 + i;
          TOKL[((size_t)b * 64 + e) * 8192 + pos] = mk; TE[mk] = e; TP[mk] = pos; TW[mk] = PW[i];
      }
      __syncthreads();
    }
}

constexpr int T_CNT = 0;
constexpr int T_TOT = 256;
constexpr int T_AB = 328;
constexpr int T_OFF = 400;
constexpr int T_GUP = 660;
constexpr int T_YC = 730;
constexpr int T_YB = 990;
constexpr int T_DUP = 1250;
constexpr int T_UL = 1520;
constexpr int T_END = 1520 + 512;
__device__ __forceinline__ int scan_incl(int v, int lane) {
#pragma unroll
    for (int off = 1; off < 64; off <<= 1) { const int t = __builtin_amdgcn_ds_bpermute(((lane - off) & 63) << 2, v); if (lane >= off) v += t; }
    return v;
}
__device__ __forceinline__ void build_moe(const Params& p, int* tab) {
    const unsigned* counts = (const unsigned*)(p.ws + WS_CTL);
    __syncthreads();
    const int tid = otid(), wave = tid >> 6, lane = tid & 63;
    if (wave == 0) {
        const int c0 = (int)counts[0 * 65 + lane], c1 = (int)counts[1 * 65 + lane], c2 = (int)counts[2 * 65 + lane], c3 = (int)counts[3 * 65 + lane];
        tab[T_CNT + 0 * 64 + lane] = c0; tab[T_CNT + 1 * 64 + lane] = c1; tab[T_CNT + 2 * 64 + lane] = c2; tab[T_CNT + 3 * 64 + lane] = c3;
        tab[T_OFF + lane * 4 + 0] = 0; tab[T_OFF + lane * 4 + 1] = c0; tab[T_OFF + lane * 4 + 2] = c0 + c1; tab[T_OFF + lane * 4 + 3] = c0 + c1 + c2;
        const int tot = c0 + c1 + c2 + c3, pad = (tot + 255) & ~255, gu = ((tot + 255) >> 8) * 2;
        const int sp = scan_incl(pad, lane), sg = scan_incl(gu, lane);
        tab[T_TOT + lane] = tot; tab[T_AB + lane] = sp - pad; tab[T_GUP + lane] = sg - gu;
        const int cb[4] = {c0, c1, c2, c3};
#pragma unroll
        for (int b = 0; b < 4; ++b) {
            const int du = ((cb[b] + 255) >> 8) * 4;
            const int sy = scan_incl(cb[b], lane), sd = scan_incl(du, lane);
            tab[T_YB + 65 * b + lane] = sy - cb[b]; tab[T_DUP + 66 * b + lane] = sd - du;
            if (lane == 63) { tab[T_YB + 65 * b + 64] = sy; tab[T_DUP + 66 * b + 64] = sd; tab[T_DUP + 66 * b + 65] = sd + (SEQ / 256) * 4; }
        }
        if (lane == 63) { tab[T_TOT + 64] = T; tab[T_AB + 64] = sp; tab[T_GUP + 64] = sg; tab[T_GUP + 65] = sg + (T / 256) * 2; }
    }
    __syncthreads();
}

__device__ __forceinline__ void moe_decode(const GP_LAS int* tab, int e, int pos_e, int& b, int& pos) {
    const int o1 = tab[T_OFF + e * 4 + 1], o2 = tab[T_OFF + e * 4 + 2], o3 = tab[T_OFF + e * 4 + 3];
    b = (pos_e >= o1 ? 1 : 0) + (pos_e >= o2 ? 1 : 0) + (pos_e >= o3 ? 1 : 0);
    pos = pos_e - (b == 0 ? 0 : (b == 1 ? o1 : (b == 2 ? o2 : o3)));
}
struct MoeSched {
    const GP_LAS int* tab; int G, c, ntn, U, down, chunk; const int* TOKL; const char* Bt;
    __device__ __forceinline__ void prepare(int* tabw, int wv) const {
        if (wv == 0) {
            const int i = lane_id(), L = i * G + c;
            if (L < U) {
                const int pre = down ? T_DUP + 66 * chunk : T_GUP;
                int lo = 0, hi = 64;
                while (lo < hi) { const int mid = (lo + hi + 1) >> 1; if (tabw[pre + mid] <= L) lo = mid; else hi = mid - 1; }
                const int loc = L - tabw[pre + lo];
                int cnt, base, bb;
                if (down) { cnt = (lo < 64) ? tabw[T_CNT + chunk * 64 + (lo & 63)] : SEQ; base = tabw[T_YB + 65 * chunk + lo];
                            bb = tabw[T_AB + lo] + (lo < 64 ? tabw[T_OFF + (lo & 63) * 4 + chunk] : chunk * SEQ); }
                else { cnt = tabw[T_TOT + lo]; base = tabw[T_AB + lo]; bb = 0; }
                int* ul = tabw + T_UL + 8 * i;
                ul[0] = lo; ul[1] = loc / ntn; ul[2] = loc % ntn; ul[3] = cnt; ul[4] = base; ul[5] = bb;
            }
        }
        __syncthreads();
    }
    __device__ __forceinline__ bool next(int i, gp::Unit& u) const {
        if (i * G + c >= U) return false;
        const GP_LAS int* ul = tab + T_UL + 8 * i;
        u.e = __builtin_amdgcn_readfirstlane(ul[0]); u.pm = __builtin_amdgcn_readfirstlane(ul[1]); u.pn = __builtin_amdgcn_readfirstlane(ul[2]);
        u.cnt = __builtin_amdgcn_readfirstlane(ul[3]); u.base = __builtin_amdgcn_readfirstlane(ul[4]); u.b = __builtin_amdgcn_readfirstlane(ul[5]);
        return true;
    }
    __device__ __forceinline__ unsigned arow(const gp::Unit& u, int r) const {
        const int pos_e = u.pm * 256 + r;
        if (down) return (unsigned)(u.b + pos_e) * 512u;
        int tok;
        if (u.e < 64) { int b, pos; moe_decode(tab, u.e, pos_e, b, pos); tok = (pos_e < u.cnt) ? (TOKL[((size_t)b * 64 + u.e) * 8192 + pos] >> 3) : 0; } else tok = pos_e;
        return (unsigned)tok * 2048u;
    }
    __device__ __forceinline__ const char* bptr(const gp::Unit& u) const {
        return down ? Bt + ((size_t)u.e * 1024 + u.pn * 256) * 512 : Bt + ((size_t)u.e * 512 + u.pn * 256) * 2048;
    }
};
struct EpiGU {
    bf16_t* ACT; const int* TOKL; const float* TW; const GP_LAS int* tab;
    __device__ __forceinline__ void operator()(const f32x4 (&acc)[2][2][4][2], const gp::Unit& u, int wr, int wc, int fr, int fq) const {
#pragma unroll
        for (int ai = 0; ai < 2; ++ai)
#pragma unroll
            for (int m = 0; m < 4; ++m) {
                const int pos_e = u.pm * 256 + ai * 128 + wr * 64 + m * 16 + fr;
                if (pos_e < u.cnt) {
                    float w = 1.0f;
                    if (u.e < 64) { int b, pos; moe_decode(tab, u.e, pos_e, b, pos); w = TW[TOKL[((size_t)b * 64 + u.e) * 8192 + pos]]; }
                    float a[8];
#pragma unroll
                    for (int n = 0; n < 2; ++n)
#pragma unroll
                        for (int i = 0; i < 4; ++i) { const float g = acc[ai][0][m][n][i], up = acc[ai][1][m][n][i];
                            a[4 * n + i] = g * __builtin_amdgcn_rcpf(1.0f + __builtin_amdgcn_exp2f(-1.4426950408889634f * g)) * up * w; }
                    gp::u32x4 o; o.x = gp::cvt_pk_bf16(a[0], a[1]); o.y = gp::cvt_pk_bf16(a[2], a[3]); o.z = gp::cvt_pk_bf16(a[4], a[5]); o.w = gp::cvt_pk_bf16(a[6], a[7]);
                    *(gp::u32x4*)(ACT + ((size_t)u.base + pos_e) * DE + u.pn * 128 + wc * 32 + fq * 8) = o;
                }
            }
    }
};
struct EpiDown {
    unsigned char* ws;
    __device__ __forceinline__ void operator()(const f32x4 (&acc)[2][2][4][2], const gp::Unit& u, int wr, int wc, int fr, int fq) const {
#pragma unroll
        for (int ai = 0; ai < 2; ++ai)
#pragma unroll
            for (int m = 0; m < 4; ++m) {
                const int pos = u.pm * 256 + ai * 128 + wr * 64 + m * 16 + fr;
                if (pos < u.cnt) {
                    bf16_t* rowp = (bf16_t*)(ws + WS_Y) + (size_t)(u.base + pos) * D + u.pn * 256 + wc * 32 + fq * 8;
#pragma unroll
                    for (int bj = 0; bj < 2; ++bj) { const f32x4 v0 = acc[ai][bj][m][0], v1 = acc[ai][bj][m][1];
                        gp::u32x4 o; o.x = gp::cvt_pk_bf16(v0[0], v0[1]); o.y = gp::cvt_pk_bf16(v0[2], v0[3]); o.z = gp::cvt_pk_bf16(v1[0], v1[1]); o.w = gp::cvt_pk_bf16(v1[2], v1[3]);
                        *(gp::u32x4*)(rowp + bj * 128) = o; }
                }
            }
    }
};
__device__ __forceinline__ void ph_moe_gu(const Params& p, unsigned char* smem) {
    unsigned char* ws = p.ws;
    int* tab = (int*)(smem + gp::STAGE_BYTES);
    build_moe(p, tab);
    MoeSched S; S.tab = (const GP_LAS int*)tab; S.G = gridDim.x; S.c = (gridDim.x % 8 == 0) ? (int)((blockIdx.x % 8) * (gridDim.x / 8) + blockIdx.x / 8) : (int)blockIdx.x;   S.ntn = 2; S.U = __builtin_amdgcn_readfirstlane(tab[T_GUP + 65]); S.down = 0; S.chunk = 0;
    S.TOKL = (const int*)(ws + WS_TOKL); S.Bt = (const char*)(ws + WS_WGUT);
    S.prepare(tab, p.chunk);
    EpiGU E{(bf16_t*)(ws + WS_ACT), (const int*)(ws + WS_TOKL), (const float*)(ws + WS_TW), (const GP_LAS int*)tab};
    gp::gemm_phase<EpiGU, MoeSched, true>(p.chunk, (GP_LAS unsigned char*)smem, (const char*)(ws + WS_H2), D, S, E);
}
__device__ __forceinline__ void ph_moe_down(const Params& p, unsigned char* smem, int c) {
    unsigned char* ws = p.ws;
    int* tab = (int*)(smem + gp::STAGE_BYTES);
    build_moe(p, tab);
    MoeSched S; S.tab = (const GP_LAS int*)tab; S.G = gridDim.x; S.c = (gridDim.x % 8 == 0) ? (int)((blockIdx.x % 8) * (gridDim.x / 8) + blockIdx.x / 8) : (int)blockIdx.x;   S.ntn = 4; S.U = __builtin_amdgcn_readfirstlane(tab[T_DUP + 66 * c + 65]); S.down = 1; S.chunk = c;
    S.TOKL = nullptr; S.Bt = (const char*)(ws + WS_WDT);
    S.prepare(tab, p.chunk);
    EpiDown E{ws};
    gp::gemm_phase<EpiDown, MoeSched, false>(p.chunk, (GP_LAS unsigned char*)smem, (const char*)(ws + WS_ACT), DE, S, E);
}

__device__ __forceinline__ void ph_final(const Params& p, float* lds, int b) {
    unsigned char* ws = p.ws;
    int* tab = (int*)lds;
    build_moe(p, tab);
    const int tid = otid(), wave = tid >> 6, lane = tid & 63;
    const int gw = blockIdx.x * NWV + wave, GW = gridDim.x * NWV;
    const int* TE = (const int*)(ws + WS_TE); const int* TP = (const int*)(ws + WS_TP);
    const bf16_t* Y = (const bf16_t*)(ws + WS_Y);
    const float* mod = (const float*)(ws + WS_MOD) + b * 6144 + 5 * 1024;
    for (int t = gw; t < SEQ; t += GW) {
        const int m = b * SEQ + t;
        float acc[16];
#pragma unroll
        for (int i = 0; i < 16; ++i) acc[i] = 0.f;
#pragma unroll
        for (int k = 0; k < 9; ++k) {
            int row;
            if (k < 8) { const int e = TE[m * 8 + k]; row = tab[T_YB + 65 * b + e] + TP[m * 8 + k]; }
            else row = tab[T_YB + 65 * b + 64] + t;
            const bf16_t* yr = Y + (size_t)row * D;
#pragma unroll
            for (int j = 0; j < 4; ++j) { const uint2 w = *(const uint2*)(yr + 4 * (lane + 64 * j));
                acc[4 * j] += __uint_as_float(w.x << 16); acc[4 * j + 1] += __uint_as_float(w.x & 0xffff0000u); acc[4 * j + 2] += __uint_as_float(w.y << 16); acc[4 * j + 3] += __uint_as_float(w.y & 0xffff0000u); }
        }
        float ss = 0.f;
#pragma unroll
        for (int i = 0; i < 16; ++i) ss += acc[i] * acc[i];
        ss = wave_sum(ss);
        const float rs = 1.0f / sqrtf(ss * (1.0f / D) + EPS);
#pragma unroll
        for (int j = 0; j < 4; ++j) {
            const int col = 4 * (lane + 64 * j);
            const f32x4 gp = *(const f32x4*)(p.in[I_GFPOST] + col), gt = *(const f32x4*)(mod + col);
            f32x4 x1 = ((const f32x4*)(p.out + (size_t)m * D))[lane + 64 * j];
#pragma unroll
            for (int i = 0; i < 4; ++i) x1[i] += gt[i] * (acc[4 * j + i] * rs * gp[i]);
            ((f32x4*)(p.out + (size_t)m * D))[lane + 64 * j] = x1;
        }
    }
}

#define GAS __attribute__((address_space(1)))
#define LAS __attribute__((address_space(3)))
#define XB_TMO      128
#define XB_XCNT(j)  (256  + 64 * (j))
#define XB_XSUB(j)  (1280 + 64 * (j))
#define XB_XGEN(j)  (2304 + 64 * (j))
#define XB_TOP      3328
#define XB_TOPGEN   3392
#define XCD_BAR_WORDS 3456
#define XB_SPIN_CAP (1u << 21)
__device__ __forceinline__ unsigned xb_ld(unsigned* p)              { return __hip_atomic_load(p, __ATOMIC_RELAXED, __HIP_MEMORY_SCOPE_AGENT); }
__device__ __forceinline__ unsigned xb_add(unsigned* p, unsigned v) { return __hip_atomic_fetch_add(p, v, __ATOMIC_RELAXED, __HIP_MEMORY_SCOPE_AGENT); }
__device__ __forceinline__ unsigned xb_xcc_id() { return (unsigned)__builtin_amdgcn_s_getreg((3 << 11) | 20) & 0xFu; }
#define XB_SPIN(cond, bar) do { unsigned _sp = 0; while (cond) { __builtin_amdgcn_s_sleep(1); \
    if ((++_sp & 255u) == 0u) { if (xb_ld(&(bar)[XB_TMO])) break; if (_sp > XB_SPIN_CAP) { atomicAdd(&(bar)[XB_TMO], 1u); break; } } } } while (0)
struct XcdBarrier { unsigned* bar; unsigned x; volatile LAS unsigned* st; };
__device__ __forceinline__ XcdBarrier xcd_barrier_post(unsigned* bar, volatile LAS unsigned* st, int wv) {
    XcdBarrier b; b.bar = bar; b.x = xb_xcc_id(); b.st = st;
    if (wv == 0 && lane_id() == 0) (void)xb_add(&bar[XB_XCNT(b.x)], 1u);
    return b;
}
__device__ __forceinline__ void xcd_barrier_complete(unsigned* bar, unsigned x, unsigned& nloc, unsigned& nx) {
    const unsigned G = gridDim.x * gridDim.y * gridDim.z;
    unsigned sum, cnt, mine, sp = 0u;
    for (;;) {
        sum = 0u; cnt = 0u; mine = 0u;
#pragma unroll
        for (unsigned j = 0; j < 16; ++j) { const unsigned c = xb_ld(&bar[XB_XCNT(j)]); sum += c; cnt += (c > 0u) ? 1u : 0u; mine = (j == x) ? c : mine; }
        if (sum == G) break;
        __builtin_amdgcn_s_sleep(1);
        if ((++sp & 255u) == 0u) { if (xb_ld(&bar[XB_TMO])) break; if (sp > XB_SPIN_CAP) { atomicAdd(&bar[XB_TMO], 1u); break; } }
    }
    nloc = mine > 0u ? mine : 1u; nx = cnt > 0u ? cnt : 1u;
}
__device__ __forceinline__ void xcd_barrier(const XcdBarrier& b, int wv) {
    asm volatile("s_waitcnt vmcnt(0)" ::: "memory");
    __syncthreads();
    if (wv == 0 && lane_id() == 0) {
        unsigned* bar = b.bar;
        __builtin_amdgcn_s_waitcnt(0);
        unsigned nloc = b.st[0], nx = b.st[1];
        if (nloc == 0u) { xcd_barrier_complete(bar, b.x, nloc, nx); b.st[0] = nloc; b.st[1] = nx; }
        const unsigned old = xb_add(&bar[XB_XSUB(b.x)], 1u);
        const unsigned gen = old / nloc;
        if (old + 1u == (gen + 1u) * nloc) {
            __builtin_amdgcn_fence(__ATOMIC_RELEASE, "agent");
            asm volatile("s_waitcnt vmcnt(0)" ::: "memory");
            const unsigned og = xb_add(&bar[XB_TOP], 1u);
            const unsigned tg = og / nx;
            if (og + 1u == (tg + 1u) * nx) xb_add(&bar[XB_TOPGEN], 1u);
            else XB_SPIN(xb_ld(&bar[XB_TOPGEN]) == tg, bar);
            __builtin_amdgcn_fence(__ATOMIC_ACQUIRE, "agent");
            xb_add(&bar[XB_XGEN(b.x)], 1u);
            asm volatile("s_waitcnt vmcnt(0)" ::: "memory");
        } else {
            XB_SPIN(xb_ld(&bar[XB_XGEN(b.x)]) == gen, bar);
            __builtin_amdgcn_fence(__ATOMIC_ACQUIRE, "agent");
            asm volatile("s_waitcnt vmcnt(0)" ::: "memory");
        }
    }
    __syncthreads();
}

namespace cg = cooperative_groups;
constexpr int LDS_BYTES = 144 * 1024;
typedef const __attribute__((address_space(4))) Params* KP;
__device__ __forceinline__ Params kargs() {
    Params p;
#if defined(__HIP_DEVICE_COMPILE__)
    typedef const __attribute__((address_space(4))) unsigned long long* KQ;
    KQ kq = (KQ)__builtin_amdgcn_kernarg_segment_ptr(); asm volatile("" : "+s"(kq));
    unsigned long long* d = (unsigned long long*)&p;
#pragma unroll
    for (int i = 0; i < (int)(sizeof(Params) / 8); ++i) d[i] = kq[i];
#endif
    return p;
}
#define PH(call) do { Params p = kargs(); p.chunk = wv; call; } while (0)
__global__ void __launch_bounds__(NT) mega_fwd(Params p_unused) {
    extern __shared__ __attribute__((aligned(16))) unsigned char smem[];
    float* lds = (float*)smem;
    volatile LAS unsigned* misc = (volatile LAS unsigned*)((LAS unsigned char*)smem + (LDS_BYTES - 64));
    if (threadIdx.x < 16) misc[threadIdx.x] = 0u;
    __syncthreads();
    unsigned* barw; { const Params p = kargs(); barw = (unsigned*)(p.ws + WS_CTL) + 4096; }
    const int wv = __builtin_amdgcn_readfirstlane(threadIdx.x >> 6);
    const XcdBarrier bar = xcd_barrier_post(barw, misc, wv);
#define SYNC() xcd_barrier(bar, wv)
    PH(ph_prep(p, lds)); PH(ph_prep_weights(p, lds, 0, 0));   SYNC();
    PH(ph_norm1(p));                SYNC();
    PH(ph_inproj(p, smem)); PH(ph_prep_weights(p, lds, 1, (MTOT / 256) * (INW / 256) % (int)gridDim.x));         SYNC();
    PH(ph_attn(p, smem)); PH(ph_fourierA(p, smem));  SYNC();
    PH(ph_fourierB(p, smem));       SYNC();
    PH(ph_outproj(p, smem));        SYNC();
    PH(ph_mid(p, smem));            SYNC();
    PH(ph_moe_gu(p, smem));         SYNC();
#pragma unroll 1
    for (int c = 0; c < BATCH; ++c) {
        PH(ph_moe_down(p, smem, c)); SYNC();
        PH(ph_final(p, lds, c));
        if (c + 1 < BATCH) SYNC();
    }
#undef SYNC
}

extern "C" void kernel_launch(void* const* d_in, const int* in_sizes, int n_in, void* d_out, int out_size, void* d_ws, size_t ws_size, hipStream_t stream) {
    if (n_in != 26 || ws_size < WS_END) { fprintf(stderr, "kernel_launch: unexpected n_in %d / ws %zu\n", n_in, ws_size); return; }
    static int grid_blocks = 0;
    if (!grid_blocks) {
        int dev = 0, cus = 0, per_cu = 0;
        (void)hipGetDevice(&dev);
        (void)hipDeviceGetAttribute(&cus, hipDeviceAttributeMultiprocessorCount, dev);
        (void)hipFuncSetAttribute((const void*)mega_fwd, hipFuncAttributeMaxDynamicSharedMemorySize, LDS_BYTES);
        (void)hipOccupancyMaxActiveBlocksPerMultiprocessor(&per_cu, (const void*)mega_fwd, NT, LDS_BYTES);
        if (per_cu < 1) { fprintf(stderr, "kernel_launch: occupancy query says %d blocks/CU\n", per_cu); per_cu = 1; }
        if (per_cu > 1) per_cu = 1;
        grid_blocks = cus * per_cu;
    }
    Params p{};
    for (int i = 0; i < 26; ++i) p.in[i] = (const float*)d_in[i];
    p.out = (float*)d_out; p.ws = (unsigned char*)d_ws; p.chunk = 0; p.pad = 0;
    (void)hipMemsetAsync((char*)d_ws + WS_CTL, 0, 32768, stream);
    void* args[] = {&p};
    hipError_t e = hipLaunchCooperativeKernel((const void*)mega_fwd, dim3(grid_blocks), dim3(NT), args, LDS_BYTES, stream);
    if (e != hipSuccess) fprintf(stderr, "cooperative launch failed: %s (grid %d)\n", hipGetErrorString(e), grid_blocks);
}
```

```cpp
#include <hip/hip_runtime.h>
#include <hip/hip_cooperative_groups.h>
#include <cstdio>
#include <cstdint>

typedef unsigned short bf16_t;
typedef float f32x4 __attribute__((ext_vector_type(4)));

constexpr int D = 1024, BATCH = 4, SEQ = 8192, T = BATCH * SEQ, CTX = 256, TC = BATCH * CTX;
constexpr int MTOT = T + TC;
constexpr int KVLEN = CTX + SEQ;
constexpr int INW = 2560, NH = 6, QKW = 768, FW = 256;
constexpr int NE = 64, DE = 256, TOPK = 8;
constexpr int NT = 512, NWV = 8;
constexpr int SLOTS_B = 90112;
constexpr float EPS = 1e-6f;
constexpr float LAM_INIT = 0.2f;
constexpr float QSCALE = 0.125f * 1.4426950408889634f;
constexpr float SQS = 0.42466090014400953f;

constexpr size_t MiB = 1u << 20;
constexpr size_t WS_CTL = 0;
constexpr size_t WS_MOD = 1 * MiB;
constexpr size_t WS_TABW = WS_MOD + 128 * 1024;
constexpr size_t WS_ROPE = WS_MOD + 192 * 1024;
constexpr size_t WS_GCS = WS_MOD + 256 * 1024;
constexpr size_t WS_W128E = WS_MOD + 768 * 1024;
constexpr size_t WS_M64E = WS_MOD + 832 * 1024;
constexpr size_t WS_GT = WS_MOD + 864 * 1024;
constexpr size_t WS_WRT = WS_MOD + 512 * 1024;
constexpr size_t WS_WINT = 2 * MiB;
constexpr size_t WS_WOUTT = 7 * MiB;
constexpr size_t WS_WGUT = 9 * MiB;
constexpr size_t WS_WDT = 74 * MiB;
constexpr size_t WS_TE = 107 * MiB;
constexpr size_t WS_TP = 108 * MiB;
constexpr size_t WS_TW = 109 * MiB;
constexpr size_t WS_TOKL = 110 * MiB;
constexpr size_t WS_AO = 118 * MiB;
constexpr size_t WS_ACT = 118 * MiB;
constexpr size_t WS_Q = 182 * MiB;
constexpr size_t WS_K = 230 * MiB;
constexpr size_t WS_V = WS_K + (size_t)BATCH * KVLEN * QKW * 2;
constexpr size_t WS_F = 329 * MiB;
constexpr size_t WS_FY = 361 * MiB;
constexpr size_t WS_HX = 425 * MiB;
constexpr size_t WS_YX = 358 * MiB;
constexpr size_t WS_H2 = 294 * MiB;
constexpr size_t WS_Y = 294 * MiB;
constexpr size_t WS_END = 491 * MiB;

struct Params {
    const float* in[26];
    float* out;
    unsigned char* ws;
    int chunk;
    int pad;
};
enum { I_X = 0, I_C, I_CTX, I_CCTX, I_WMOD, I_BMOD, I_GAPRE, I_GAPOST, I_WIN, I_WF, I_LQ1, I_LK1, I_LQ2, I_LK2, I_GSUB, I_WOUT,
       I_GFPRE, I_GFPOST, I_WR, I_RB, I_WG, I_WU, I_WD, I_WSG, I_WSU, I_WSD };

__device__ __forceinline__ float bf2f(bf16_t v) { return __uint_as_float(((unsigned)v) << 16); }
__device__ __forceinline__ bf16_t f2bf(float f) { unsigned u = __float_as_uint(f); return (bf16_t)((u + 0x7fffu + ((u >> 16) & 1u)) >> 16); }
__device__ __forceinline__ unsigned pk2(float lo, float hi) { return (unsigned)f2bf(lo) | ((unsigned)f2bf(hi) << 16); }
template <int M> __device__ __forceinline__ float sx(float v) { return __int_as_float(__builtin_amdgcn_ds_swizzle(__float_as_int(v), (M << 10) | 0x1f)); }
template <int M> __device__ __forceinline__ int sxi(int v) { return __builtin_amdgcn_ds_swizzle(v, (M << 10) | 0x1f); }
__device__ __forceinline__ float wave_sum(float v) {
    v += sx<1>(v); v += sx<2>(v); v += sx<4>(v); v += sx<8>(v); v += sx<16>(v);
    auto rr = __builtin_amdgcn_permlane32_swap(__float_as_uint(v), __float_as_uint(v), false, false);
    return __uint_as_float(rr[0]) + __uint_as_float(rr[1]);
}
__device__ __forceinline__ float dpp_f(float v, const int ctrl_sel) {
    const int x = __float_as_int(v); int r;
    if (ctrl_sel == 0) r = __builtin_amdgcn_update_dpp(x, x, 0xB1, 0xf, 0xf, false);
    else if (ctrl_sel == 1) r = __builtin_amdgcn_update_dpp(x, x, 0x4E, 0xf, 0xf, false);
    else if (ctrl_sel == 2) r = __builtin_amdgcn_update_dpp(x, x, 0x141, 0xf, 0xf, false);
    else r = __builtin_amdgcn_update_dpp(x, x, 0x140, 0xf, 0xf, false);
    return __int_as_float(r);
}
__device__ __forceinline__ float wave_max(float v) {
    v = fmaxf(v, dpp_f(v, 0)); v = fmaxf(v, dpp_f(v, 1)); v = fmaxf(v, dpp_f(v, 2)); v = fmaxf(v, dpp_f(v, 3));
    const float a = __uint_as_float(__builtin_amdgcn_readlane(__float_as_uint(v), 0)), b = __uint_as_float(__builtin_amdgcn_readlane(__float_as_uint(v), 16));
    const float c = __uint_as_float(__builtin_amdgcn_readlane(__float_as_uint(v), 32)), d = __uint_as_float(__builtin_amdgcn_readlane(__float_as_uint(v), 48));
    return fmaxf(fmaxf(a, b), fmaxf(c, d));
}
__device__ __forceinline__ int lane_id() { int l; asm volatile("v_mbcnt_lo_u32_b32 %0, -1, 0\n\tv_mbcnt_hi_u32_b32 %0, -1, %0" : "=v"(l)); return l; }
__device__ __forceinline__ int otid_w(int wv) { return wv * 64 + lane_id(); }
#define otid() otid_w(p.chunk)
__device__ __forceinline__ float silu_f(float x) { return x / (1.f + expf(-x)); }

__device__ __forceinline__ void ph_prep(const Params& p, float* lds) {
    const int tid = otid(), bid = blockIdx.x, nblk = gridDim.x;
    const int gt = bid * NT + tid, GT = nblk * NT;
    unsigned char* ws = p.ws;
    float2* tabw = (float2*)(ws + WS_TABW);
    for (int i = gt; i < 8192; i += GT) { float s, c; sincospif((float)i * (1.0f / 4096.0f), &s, &c); tabw[i] = make_float2(c, s); }
    float* rope = (float*)(ws + WS_ROPE);
    for (int i = gt; i < 192 * 16; i += GT) {
        const int pos = (i < 2048) ? (i >> 4) : ((i - 2048) >> 4); const int f = i & 15;
        const float inv = powf(10000.0f, -(float)(2 * f) / 32.0f); const float ang = (float)pos * inv;
        const float c = cosf(ang), s = sinf(ang);
        if (i < 2048) { rope[i] = c; rope[2048 + i] = s; } else { rope[4096 + (i - 2048)] = c; rope[4096 + 1024 + (i - 2048)] = s; }
    }
    { bf16_t* gt = (bf16_t*)(ws + WS_GT); const float* wf = p.in[I_WF];
      for (int i = bid * NT + tid; i < 4 * 64 * 128; i += GT) {
        const int g = i >> 13, d = (i >> 7) & 63, part = (i >> 6) & 1, c = i & 63;
        float a = 0.f;
        for (int j = 0; j < 64; ++j) { float s, co; sincospif((float)((c * j) & 63) * (1.0f / 32.0f), &s, &co); a += (part ? s : co) * wf[(g * 64 + j) * 64 + d]; }
        gt[i] = f2bf(a * 0.0013810679320049757f);
      }
      bf16_t* w128 = (bf16_t*)(ws + WS_W128E);
      for (int i = bid * NT + tid; i < 256 * 128; i += GT) { const int kk = i >> 7, n1 = i & 127; float s, co; sincospif((float)(((kk & 127) * n1) & 127) * (1.0f / 64.0f), &s, &co); w128[i] = f2bf(kk < 128 ? co : -s); }
      bf16_t* m64 = (bf16_t*)(ws + WS_M64E);
      for (int i = bid * NT + tid; i < 128 * 128; i += GT) { const int ro = i >> 7, ci = i & 127, po = ro >> 6, k2 = ro & 63, pi = ci >> 6, n2 = ci & 63;
        float s, co; sincospif((float)((k2 * n2) & 63) * (1.0f / 32.0f), &s, &co); m64[i] = f2bf(po == pi ? co : (po == 0 ? s : -s)); }
    }
    {
      bf16_t* wrt = (bf16_t*)(ws + WS_WRT); const float* wr = p.in[I_WR];
      for (int i = gt; i < 64 * 1024; i += GT) {
        const int j = i & 7, ln = (i >> 3) & 63, nb = (i >> 9) & 3, ks = (i >> 11) & 3, wv_ = i >> 13;
        const int e = 16 * nb + (ln & 15), k = wv_ * 128 + ks * 32 + 8 * (ln >> 4) + j;
        const float w = wr[k * 64 + e]; const bf16_t h = f2bf(w);
        const int o = ((((wv_ * 4 + ks) * 4 + nb) * 2) * 64 + ln) * 8 + j;
        wrt[o] = h; wrt[o + 512] = f2bf(w - bf2f(h)); } }
    if (gt == 0) {
        float s1 = 0.f, s2 = 0.f;
        for (int i = 0; i < 64; ++i) { s1 += p.in[I_LQ1][i] * p.in[I_LK1][i]; s2 += p.in[I_LQ2][i] * p.in[I_LK2][i]; }
        ((float*)(ws + WS_CTL))[1024] = expf(s1) - expf(s2) + LAM_INIT;
    }
    float* sc = lds;
    float* red = lds + 5 * 1024;
    for (int i = tid; i < 5 * 1024; i += NT) { const int r = i >> 10, k = i & 1023; const float v = (r < 4) ? p.in[I_C][r * 1024 + k] : p.in[I_CCTX][k]; sc[i] = silu_f(v); }
    __syncthreads();
    const int wave = tid >> 6, lane = tid & 63;
    float* mod = (float*)(ws + WS_MOD);
    for (int task = bid; task < 96; task += nblk) {
        const int col = task * 64 + lane;
        float a0 = 0, a1 = 0, a2 = 0, a3 = 0, a4 = 0;
        const float* wm = p.in[I_WMOD];
#pragma unroll 32
        for (int k = wave * 128; k < wave * 128 + 128; ++k) { const float w = wm[(size_t)k * 6144 + col]; a0 += sc[k] * w; a1 += sc[1024 + k] * w; a2 += sc[2048 + k] * w; a3 += sc[3072 + k] * w; a4 += sc[4096 + k] * w; }
        red[(wave * 5 + 0) * 64 + lane] = a0; red[(wave * 5 + 1) * 64 + lane] = a1; red[(wave * 5 + 2) * 64 + lane] = a2; red[(wave * 5 + 3) * 64 + lane] = a3; red[(wave * 5 + 4) * 64 + lane] = a4;
        __syncthreads();
        if (tid < 320) { const int r = tid >> 6, l = tid & 63; float s = 0.f; for (int w = 0; w < 8; ++w) s += red[(w * 5 + r) * 64 + l]; mod[r * 6144 + task * 64 + l] = s + p.in[I_BMOD][task * 64 + l]; }
        __syncthreads();
    }
}

__device__ __forceinline__ void ph_norm1(const Params& p) {
    const int tid = otid(), wave = tid >> 6, lane = tid & 63;
    const int gw = blockIdx.x * NWV + wave, GW = gridDim.x * NWV;
    const float* mod = (const float*)(p.ws + WS_MOD);
    bf16_t* hx = (bf16_t*)(p.ws + WS_HX);
    const float* g = p.in[I_GAPRE];
    for (int m = gw; m < MTOT; m += GW) {
        const float* src = (m < T) ? p.in[I_X] + (size_t)m * D : p.in[I_CTX] + (size_t)(m - T) * D;
        const int r = (m < T) ? (m >> 13) : 4;
        const float* shift = mod + r * 6144; const float* scale = shift + 1024;
        f32x4 v[4]; float ss = 0.f;
#pragma unroll
        for (int j = 0; j < 4; ++j) { v[j] = ((const f32x4*)src)[lane + 64 * j]; ss += v[j][0] * v[j][0] + v[j][1] * v[j][1] + v[j][2] * v[j][2] + v[j][3] * v[j][3]; }
        ss = wave_sum(ss);
        const float rs = 1.0f / sqrtf(ss * (1.0f / D) + EPS);
#pragma unroll
        for (int j = 0; j < 4; ++j) {
            const int col = 4 * (lane + 64 * j);
            const f32x4 g4 = *(const f32x4*)(g + col), sc4 = *(const f32x4*)(scale + col), sh4 = *(const f32x4*)(shift + col);
            float h[4];
#pragma unroll
            for (int i = 0; i < 4; ++i) h[i] = v[j][i] * rs * g4[i] * (1.f + sc4[i]) + sh4[i];
            uint2 o; o.x = pk2(h[0], h[1]); o.y = pk2(h[2], h[3]);
            *(uint2*)(hx + (size_t)m * D + col) = o;
        }
    }
}

namespace gp {
#define GP_LAS __attribute__((address_space(3)))
typedef short bf16x8 __attribute__((ext_vector_type(8)));
typedef unsigned u32x4 __attribute__((ext_vector_type(4)));
typedef int i32x4 __attribute__((ext_vector_type(4)));
constexpr int BM = 256, BK = 64, HALF = 128, HTB = HALF * BK * 2, STAGE_BYTES = 8 * HTB;
__device__ __forceinline__ int lds_byte(int r, int c) { const int st = (r >> 4) * 2 + (c >> 5), rr = r & 15, cc = c & 31, ob = rr * 64 + cc * 2; return st * 1024 + (ob ^ (((ob >> 9) & 1) << 5)); }
__device__ __forceinline__ void stage_rc(int b, int& R, int& C) { const int st = b / 1024, sb = b % 1024, swz = sb ^ (((sb >> 9) & 1) << 5); R = (st >> 1) * 16 + swz / 64; C = (st & 1) * 32 + (swz % 64) / 2; }
__device__ __forceinline__ int perm32(int rho) { const int n = rho >> 4, i = rho & 15; return 8 * (i >> 2) + 4 * n + (i & 3); }
struct Unit { int pm, pn, e, b, cnt, base; };
__device__ __forceinline__ unsigned cvt_pk_bf16(float lo, float hi) { unsigned r; asm volatile("v_cvt_pk_bf16_f32 %0, %1, %2" : "=v"(r) : "v"(lo), "v"(hi)); return r; }

template <class Epi, class Sched, bool ALIGN_EPI, bool F8 = false>
__device__ __forceinline__ void gemm_phase(const int wv, GP_LAS unsigned char* lds, const char* Abase, const int K, const Sched& S, const Epi& E) {
    const int wid = wv, wr = wid >> 2, wc = wid & 3;
    const int nt = K / BK;
    unsigned voffB[2];
#pragma unroll
    for (int i = 0; i < 2; ++i) { int R, C; stage_rc(otid_w(wv) * 16 + i * 8192, R, C); const int Rb = (R & ~31) + perm32(R & 31); voffB[i] = (unsigned)(Rb * K + C) * 2u; }
#define GP_AOFFS(u, o00, o01, o10, o11) do { int R0, C0, R1, C1; const int t_ = otid_w(wv); stage_rc(t_ * 16, R0, C0); stage_rc(t_ * 16 + 8192, R1, C1); \
        o00 = S.arow(u, R0) + (unsigned)C0 * 2u; o01 = S.arow(u, R1) + (unsigned)C1 * 2u; o10 = S.arow(u, HALF + R0) + (unsigned)C0 * 2u; o11 = S.arow(u, HALF + R1) + (unsigned)C1 * 2u; } while (0)
    const size_t kstep = (size_t)(BK * 2);
    const size_t hstep = (size_t)HALF * K * 2;
    const unsigned ldsw = (unsigned)wid * 1024u;
    int aoff, boff; { const int l_ = lane_id(), fr = l_ & 15, fq = l_ >> 4; aoff = lds_byte(wr * 64 + fr, fq * 8); boff = lds_byte(wc * 32 + fr, fq * 8); }
#define GP_SA(b, h) (((b) * 2 + (h)) * HTB)
#define GP_SB(b, h) ((4 + (b) * 2 + (h)) * HTB)
#define GP_STAGE_B(bufoff, gbase) do { _Pragma("unroll") for (int _i = 0; _i < 2; ++_i) \
        __builtin_amdgcn_global_load_lds((const unsigned*)((const char*)(gbase) + voffB[_i]), (GP_LAS unsigned*)(lds + (bufoff) + ldsw + _i * 8192), 16, 0, 0); } while (0)
#define GP_STAGE_A(bufoff, gbase, o0, o1) do { \
        __builtin_amdgcn_global_load_lds((const unsigned*)((const char*)(gbase) + (o0)), (GP_LAS unsigned*)(lds + (bufoff) + ldsw), 16, 0, 0); \
        __builtin_amdgcn_global_load_lds((const unsigned*)((const char*)(gbase) + (o1)), (GP_LAS unsigned*)(lds + (bufoff) + ldsw + 8192), 16, 0, 0); } while (0)
#define GP_LDA(dst, b, h) do { _Pragma("unroll") for (int m = 0; m < 4; ++m) _Pragma("unroll") for (int k = 0; k < 2; ++k) dst[m][k] = *(const GP_LAS bf16x8*)(lds + GP_SA(b, h) + aoff + m * 2048 + k * 1024); } while (0)
#define GP_LDB(dst, b, h) do { _Pragma("unroll") for (int n = 0; n < 2; ++n) _Pragma("unroll") for (int k = 0; k < 2; ++k) dst[n][k] = *(const GP_LAS bf16x8*)(lds + GP_SB(b, h) + boff + n * 2048 + k * 1024); } while (0)
#define GP_CAT8(x) __builtin_shufflevector(__builtin_bit_cast(i32x4, x[0]), __builtin_bit_cast(i32x4, x[1]), 0, 1, 2, 3, 4, 5, 6, 7)
#define GP_MMA(ai, bj, At, Bt) do { __builtin_amdgcn_s_setprio(1); _Pragma("unroll") for (int m = 0; m < 4; ++m) _Pragma("unroll") for (int n = 0; n < 2; ++n) { \
        if constexpr (F8) acc[ai][bj][m][n] = __builtin_amdgcn_mfma_scale_f32_16x16x128_f8f6f4(GP_CAT8(Bt[n]), GP_CAT8(At[m]), acc[ai][bj][m][n], 0, 0, 0, 0, 0, 0); \
        else { _Pragma("unroll") for (int k = 0; k < 2; ++k) acc[ai][bj][m][n] = __builtin_amdgcn_mfma_f32_16x16x32_bf16(Bt[n][k], At[m][k], acc[ai][bj][m][n], 0, 0, 0); } } \
        __builtin_amdgcn_s_setprio(0); } while (0)
#define GP_WAIT_V(n) asm volatile("s_waitcnt vmcnt(" #n ")" ::: "memory")
#define GP_WAIT_L(n) asm volatile("s_waitcnt lgkmcnt(" #n ")" ::: "memory")
#define GP_BAR __builtin_amdgcn_s_barrier()
#define GP_SCHED __builtin_amdgcn_sched_barrier(0)
    Unit cur, nxt; int ui = 0;
    if (!S.next(0, cur)) return;
    f32x4 acc[2][2][4][2];
#pragma unroll
    for (int a = 0; a < 2; ++a)
#pragma unroll
        for (int b = 0; b < 2; ++b)
#pragma unroll
            for (int m = 0; m < 4; ++m)
#pragma unroll
                for (int n = 0; n < 2; ++n) acc[a][b][m][n] = (f32x4){0.f, 0.f, 0.f, 0.f};
    bf16x8 At[4][2], B0[2][2], B1[2][2];
    unsigned ac00, ac01, ac10, ac11, an00, an01, an10, an11;
    GP_AOFFS(cur, ac00, ac01, ac10, ac11);
    const char* cB = S.bptr(cur);
    GP_STAGE_B(GP_SB(0, 0), cB); GP_STAGE_B(GP_SB(0, 1), cB + hstep); GP_STAGE_A(GP_SA(0, 0), Abase, ac00, ac01); GP_STAGE_A(GP_SA(0, 1), Abase, ac10, ac11);
    if (wr == 1) GP_BAR;
    GP_WAIT_V(2); GP_BAR;
    GP_STAGE_B(GP_SB(1, 0), cB + kstep); GP_STAGE_A(GP_SA(1, 0), Abase + kstep, ac00, ac01); GP_STAGE_B(GP_SB(1, 1), cB + hstep + kstep);
    GP_WAIT_V(6); GP_BAR;
    for (;;) {
        const bool has_next = S.next(ui + 1, nxt);
        if (has_next) { GP_AOFFS(nxt, an00, an01, an10, an11); }
        else { an00 = ac00; an01 = ac01; an10 = ac10; an11 = ac11; }
        const char* nB = has_next ? S.bptr(nxt) : cB;
#pragma unroll 1
        for (int t = 0; t < nt; t += 2) {
            const bool last = (t == nt - 2);
            const char* a1 = Abase + (size_t)(t + 1) * kstep;
            const char* a2 = last ? Abase : Abase + (size_t)(t + 2) * kstep; const char* b2 = last ? nB : cB + (size_t)(t + 2) * kstep;
            const char* a3 = a2 + kstep; const char* b3 = b2 + kstep;
            GP_LDB(B0, 0, 0); GP_LDB(B1, 0, 1); GP_SCHED; GP_LDA(At, 0, 0); GP_STAGE_A(GP_SA(1, 1), a1, ac10, ac11);
            if (last) { ac00 = an00; ac01 = an01; ac10 = an10; ac11 = an11; }
            GP_WAIT_V(8); GP_WAIT_L(0); GP_BAR; GP_MMA(0, 0, At, B0); GP_MMA(0, 1, At, B1); GP_BAR; GP_SCHED;
            GP_LDA(At, 0, 1); GP_STAGE_B(GP_SB(0, 0), b2); GP_STAGE_B(GP_SB(0, 1), b2 + hstep); GP_STAGE_A(GP_SA(0, 0), a2, ac00, ac01);
            GP_WAIT_V(8); GP_WAIT_L(0); GP_BAR; GP_MMA(1, 0, At, B0); GP_MMA(1, 1, At, B1); GP_BAR; GP_SCHED;
            GP_LDB(B0, 1, 0); GP_LDB(B1, 1, 1); GP_SCHED; GP_LDA(At, 1, 0); GP_STAGE_A(GP_SA(0, 1), a2, ac10, ac11);
            GP_WAIT_V(8); GP_WAIT_L(0); GP_BAR; GP_MMA(0, 0, At, B0); GP_MMA(0, 1, At, B1); GP_BAR; GP_SCHED;
            GP_LDA(At, 1, 1); GP_STAGE_B(GP_SB(1, 0), b3); GP_STAGE_B(GP_SB(1, 1), b3 + hstep); GP_STAGE_A(GP_SA(1, 0), a3, ac00, ac01);
            GP_WAIT_V(8); GP_WAIT_L(0); GP_BAR; GP_MMA(1, 0, At, B0); GP_MMA(1, 1, At, B1); GP_BAR; GP_SCHED;
        }
        if constexpr (ALIGN_EPI) { if (wr == 0) GP_BAR; }
        { const int l_ = lane_id(); E(acc, cur, wr, wc, l_ & 15, l_ >> 4); }
        if (!has_next) break;
#pragma unroll
        for (int a = 0; a < 2; ++a)
#pragma unroll
            for (int b = 0; b < 2; ++b)
#pragma unroll
                for (int m = 0; m < 4; ++m)
#pragma unroll
                    for (int n = 0; n < 2; ++n) acc[a][b][m][n] = (f32x4){0.f, 0.f, 0.f, 0.f};
        cur = nxt; cB = nB; ++ui;
        if constexpr (ALIGN_EPI) { if (wr == 1) GP_BAR; }
    }
    GP_WAIT_V(0);
    if constexpr (!ALIGN_EPI) { if (wr == 0) GP_BAR; }
    GP_BAR;
#undef GP_AOFFS
#undef GP_SA
#undef GP_SB
#undef GP_STAGE_A
#undef GP_STAGE_B
#undef GP_LDA
#undef GP_LDB
#undef GP_MMA
#undef GP_CAT8
#undef GP_WAIT_V
#undef GP_WAIT_L
#undef GP_BAR
#undef GP_SCHED
}

struct DenseSched {
    int nM, nN, nwg, G, c, K; const char* Bt;
    __device__ __forceinline__ void init(int M, int N, int K_, const void* Bt_, int G_, int c_) { nM = M / BM; nN = N / BM; nwg = nM * nN; G = G_; c = c_; K = K_; Bt = (const char*)Bt_; }
    __device__ __forceinline__ bool next(int i, Unit& u) const {
        const long L = (long)i * G + c; if (L >= nwg) return false;
        int wgid = (int)L; { const int q = nwg / 8, r = nwg % 8, xcd = wgid % 8, off = wgid / 8; wgid = (xcd < r ? xcd * (q + 1) : r * (q + 1) + (xcd - r) * q) + off; }
        const int nig = 8 * nN, gid = wgid / nig, fm = gid * 8, gsz = (nM - fm) < 8 ? (nM - fm) : 8;
        u.pm = fm + ((wgid % nig) % gsz); u.pn = (wgid % nig) / gsz; u.e = 0; u.b = 0; u.cnt = 0; u.base = 0; return true;
    }
    __device__ __forceinline__ unsigned arow(const Unit& u, int r) const { return (unsigned)(u.pm * BM + r) * (unsigned)(K * 2); }
    __device__ __forceinline__ const char* bptr(const Unit& u) const { return Bt + (size_t)u.pn * BM * K * 2; }
};
}

struct EpiInProj {
    bf16_t* F; bf16_t* Q; bf16_t* Kb; bf16_t* Vb; const float* rope;
    __device__ __forceinline__ void operator()(const f32x4 (&acc)[2][2][4][2], const gp::Unit& u, int wr, int wc, int fr, int fq) const {
        const int pn = u.pn, pm = u.pm; const bool isctx = pm >= T / 256;
        if (isctx && pn < 4) return;
        if (pn >= 7) {
            unsigned char* V8 = (unsigned char*)Vb;
#pragma unroll
            for (int ai = 0; ai < 2; ++ai) {
                const int row0 = pm * 256 + ai * 128 + wr * 64;
                int b, tile;
                if (!isctx) { b = row0 >> 13; tile = (CTX >> 6) + ((row0 & 8191) >> 6); } else { const int j = row0 - T; b = j >> 8; tile = (j & 255) >> 6; }
#pragma unroll
                for (int bj = 0; bj < 2; ++bj) {
                    const int head = (pn - 7) * 2 + bj;
                    unsigned char* dst = V8 + ((size_t)(b * NH + head) * (KVLEN / 64) + tile) * 8192 + wc * 2048 + fq * 64 + (fr >> 3) * 32 + (fr & 1) * 16 + ((fr >> 1) & 3) * 4;
#pragma unroll
                    for (int e = 0; e < 8; ++e) {
                        int w = __builtin_amdgcn_cvt_pk_fp8_f32(acc[ai][bj][0][e >> 2][e & 3], acc[ai][bj][1][e >> 2][e & 3], 0, false);
                        w = __builtin_amdgcn_cvt_pk_fp8_f32(acc[ai][bj][2][e >> 2][e & 3], acc[ai][bj][3][e >> 2][e & 3], w, true);
                        *(int*)(dst + e * 256) = w;
                    }
                }
            }
            return;
        }
        const int axis = wc & 1; const float* ct = rope + (axis ? 4096 : 0); const float* st = rope + (axis ? 4096 + 1024 : 2048);
#pragma unroll
        for (int ai = 0; ai < 2; ++ai)
#pragma unroll
            for (int m = 0; m < 4; ++m) {
                const int row = pm * 256 + ai * 128 + wr * 64 + m * 16 + fr;
                int t, kb, tile;
                if (!isctx) { kb = row >> 13; t = row & 8191; tile = (CTX >> 6) + (t >> 6); } else { const int j = row - T; t = 0; kb = j >> 8; tile = (j & 255) >> 6; }
                const int pos = axis ? (t & 63) : (t >> 6);
#pragma unroll
                for (int bj = 0; bj < 2; ++bj) {
                    const int col0 = pn * 256 + bj * 128 + wc * 32 + fq * 8;
                    f32x4 v0 = acc[ai][bj][m][0], v1 = acc[ai][bj][m][1];
                    if (pn == 0) { gp::u32x4 w; w.x = gp::cvt_pk_bf16(v0[0], v0[1]); w.y = gp::cvt_pk_bf16(v0[2], v0[3]); w.z = gp::cvt_pk_bf16(v1[0], v1[1]); w.w = gp::cvt_pk_bf16(v1[2], v1[3]);
                        *(gp::u32x4*)(F + (size_t)row * 256 + col0) = w; continue; }
                    if (pn < 7 && !isctx) {
                        const f32x4 c0 = *(const f32x4*)(ct + pos * 16 + 8 * (fq & 1)), c1 = *(const f32x4*)(ct + pos * 16 + 8 * (fq & 1) + 4);
                        const f32x4 s0 = *(const f32x4*)(st + pos * 16 + 8 * (fq & 1)), s1 = *(const f32x4*)(st + pos * 16 + 8 * (fq & 1) + 4);
                        const float sg = (fq < 2) ? -1.f : 1.f;
#pragma unroll
                        for (int i = 0; i < 4; ++i) {
                            const auto r0 = __builtin_amdgcn_permlane32_swap(__float_as_uint(v0[i]), __float_as_uint(v0[i]), false, false);
                            const auto r1 = __builtin_amdgcn_permlane32_swap(__float_as_uint(v1[i]), __float_as_uint(v1[i]), false, false);
                            const float p0 = __uint_as_float(fq < 2 ? r0[1] : r0[0]), p1 = __uint_as_float(fq < 2 ? r1[1] : r1[0]);
                            v0[i] = v0[i] * c0[i] + sg * p0 * s0[i]; v1[i] = v1[i] * c1[i] + sg * p1 * s1[i]; }
                    }
                    v0 = v0 * SQS; v1 = v1 * SQS;
                    int w0 = __builtin_amdgcn_cvt_pk_fp8_f32(v0[0], v0[1], 0, false); w0 = __builtin_amdgcn_cvt_pk_fp8_f32(v0[2], v0[3], w0, true);
                    int w1 = __builtin_amdgcn_cvt_pk_fp8_f32(v1[0], v1[1], 0, false); w1 = __builtin_amdgcn_cvt_pk_fp8_f32(v1[2], v1[3], w1, true);
                    unsigned char* d;
                    if (pn < 4) d = (unsigned char*)Q + (size_t)row * QKW + (col0 - 256);
                    else d = (unsigned char*)Kb + ((size_t)(kb * NH + (pn - 4) * 2 + bj) * (KVLEN / 64) + tile) * 8192 + wc * 2048 + m * 512 + fr * 32 + fq * 8;
                    typedef int i32x2_t __attribute__((ext_vector_type(2)));
                    *(i32x2_t*)d = (i32x2_t){w0, w1};
                }
            }
    }
};
struct EpiStoreBf16 {
    bf16_t* O; int ldc;
    __device__ __forceinline__ void operator()(const f32x4 (&acc)[2][2][4][2], const gp::Unit& u, int wr, int wc, int fr, int fq) const {
#pragma unroll
        for (int ai = 0; ai < 2; ++ai)
#pragma unroll
            for (int m = 0; m < 4; ++m) {
                bf16_t* rowp = O + (size_t)(u.pm * 256 + ai * 128 + wr * 64 + m * 16 + fr) * ldc + u.pn * 256 + wc * 32 + fq * 8;
#pragma unroll
                for (int bj = 0; bj < 2; ++bj) { const f32x4 v0 = acc[ai][bj][m][0], v1 = acc[ai][bj][m][1];
                    gp::u32x4 w; w.x = gp::cvt_pk_bf16(v0[0], v0[1]); w.y = gp::cvt_pk_bf16(v0[2], v0[3]); w.z = gp::cvt_pk_bf16(v1[0], v1[1]); w.w = gp::cvt_pk_bf16(v1[2], v1[3]);
                    *(gp::u32x4*)(rowp + bj * 128) = w; }
            }
    }
};

__device__ __forceinline__ void ph_inproj(const Params& p, unsigned char* smem) {
    unsigned char* ws = p.ws;
    gp::DenseSched S; S.init(MTOT, INW, D, ws + WS_WINT, gridDim.x, blockIdx.x);
    EpiInProj E{(bf16_t*)(ws + WS_F), (bf16_t*)(ws + WS_Q), (bf16_t*)(ws + WS_K), (bf16_t*)(ws + WS_V), (const float*)(ws + WS_ROPE)};
    gp::gemm_phase<EpiInProj, gp::DenseSched, true>(p.chunk, (GP_LAS unsigned char*)smem, (const char*)(ws + WS_HX), D, S, E);
}
__device__ __forceinline__ void ph_outproj(const Params& p, unsigned char* smem) {
    unsigned char* ws = p.ws;
    gp::DenseSched S; S.init(T, D, D, ws + WS_WOUTT, gridDim.x, blockIdx.x);
    EpiStoreBf16 E{(bf16_t*)(ws + WS_YX), D};
    gp::gemm_phase<EpiStoreBf16, gp::DenseSched, true>(p.chunk, (GP_LAS unsigned char*)smem, (const char*)(ws + WS_AO), D, S, E);
}

constexpr float GUSCALE = 64.f;
__device__ __forceinline__ void transpose_item8(const float* W, int K, int N, unsigned char* WT, int row_base, int kb, int nb, float* scr, int lane) {
    const int k0 = 64 * kb, n0 = 32 * nb;
    float tv[32];
#pragma unroll
    for (int i = 0; i < 32; ++i) tv[i] = W[(size_t)(k0 + 2 * i + (lane >> 5)) * N + n0 + (lane & 31)];
#pragma unroll
    for (int i = 0; i < 32; ++i) scr[(2 * i + (lane >> 5)) * 33 + (lane & 31)] = tv[i] * GUSCALE;
    asm volatile("s_waitcnt lgkmcnt(0)" ::: "memory");
    const int c = lane & 7;
#pragma unroll
    for (int j = 0; j < 4; ++j) { const int n = (lane >> 3) + 8 * j; const float* s = scr + (8 * c) * 33 + n;
        int w0 = __builtin_amdgcn_cvt_pk_fp8_f32(s[0 * 33], s[1 * 33], 0, false); w0 = __builtin_amdgcn_cvt_pk_fp8_f32(s[2 * 33], s[3 * 33], w0, true);
        int w1 = __builtin_amdgcn_cvt_pk_fp8_f32(s[4 * 33], s[5 * 33], 0, false); w1 = __builtin_amdgcn_cvt_pk_fp8_f32(s[6 * 33], s[7 * 33], w1, true);
        uint2 o; o.x = (unsigned)w0; o.y = (unsigned)w1;
        *(uint2*)(WT + (size_t)(row_base + n0 + n) * K + k0 + 8 * c) = o; }
    asm volatile("s_waitcnt lgkmcnt(0)" ::: "memory");
}
__device__ __forceinline__ void transpose_item(const float* W, int K, int N, bf16_t* WT, int row_base, int kb, int nb, float* scr, int lane) {
    const int k0 = 64 * kb, n0 = 32 * nb;
    float tv[32];
#pragma unroll
    for (int i = 0; i < 32; ++i) tv[i] = W[(size_t)(k0 + 2 * i + (lane >> 5)) * N + n0 + (lane & 31)];
#pragma unroll
    for (int i = 0; i < 32; ++i) scr[(2 * i + (lane >> 5)) * 33 + (lane & 31)] = tv[i];
    asm volatile("s_waitcnt lgkmcnt(0)" ::: "memory");
    const int c = lane & 7;
#pragma unroll
    for (int j = 0; j < 4; ++j) { const int n = (lane >> 3) + 8 * j; const float* s = scr + (8 * c) * 33 + n;
        uint4 o; o.x = pk2(s[0 * 33], s[1 * 33]); o.y = pk2(s[2 * 33], s[3 * 33]); o.z = pk2(s[4 * 33], s[5 * 33]); o.w = pk2(s[6 * 33], s[7 * 33]);
        *(uint4*)(WT + (size_t)(row_base + n0 + n) * K + k0 + 8 * c) = o; }
    asm volatile("s_waitcnt lgkmcnt(0)" ::: "memory");
}
__device__ __forceinline__ void ph_prep_weights(const Params& p, float* lds, const int part, const int first) {
    const int tid = otid(), wave = tid >> 6, lane = tid & 63;
    float* scr = lds + 8192 + wave * (64 * 33);
    if ((int)blockIdx.x < first) return;
    const int gw = ((int)blockIdx.x - first) * NWV + wave, GW = ((int)gridDim.x - first) * NWV;
    unsigned char* ws = p.ws;
    constexpr int I_IN = 16 * 80, I_OUT = 16 * 32, I_GU = 16 * 8, I_D = 4 * 32;
    constexpr int NITEMS = I_IN + I_OUT + 65 * (2 * I_GU + I_D);
    const int it_lo = part ? I_IN + I_OUT : 0, it_hi = part ? NITEMS : I_IN + I_OUT;
    for (int it = it_lo + gw; it < it_hi; it += GW) {
        int r = it;
        if (r < I_IN) { transpose_item(p.in[I_WIN], D, INW, (bf16_t*)(ws + WS_WINT), 0, r / 80, r % 80, scr, lane); continue; } r -= I_IN;
        if (r < I_OUT) { transpose_item(p.in[I_WOUT], D, D, (bf16_t*)(ws + WS_WOUTT), 0, r / 32, r % 32, scr, lane); continue; } r -= I_OUT;
        const int e = r / (2 * I_GU + I_D); r -= e * (2 * I_GU + I_D);
        if (r < 2 * I_GU) {
            const int half = r / I_GU, q = r % I_GU, kb = q / 8, nb = q % 8;
            const float* W = (e < 64) ? p.in[half ? I_WU : I_WG] + (size_t)e * D * DE : p.in[half ? I_WSU : I_WSG];
            const int n0 = 32 * nb, drow = e * 512 + (n0 >> 7) * 256 + half * 128 + (n0 & 127);
            transpose_item8(W, D, DE, ws + WS_WGUT, drow - n0, kb, nb, scr, lane);
        } else {
            r -= 2 * I_GU;
            const float* W = (e < 64) ? p.in[I_WD] + (size_t)e * DE * D : p.in[I_WSD];
            transpose_item(W, DE, D, (bf16_t*)(ws + WS_WDT), e * 1024, r / 32, r % 32, scr, lane);
        }
    }
}

namespace fa {
typedef short bf16x8 __attribute__((ext_vector_type(8)));
typedef short s16x4 __attribute__((ext_vector_type(4)));
typedef float f32x16 __attribute__((ext_vector_type(16)));
typedef unsigned u32x4 __attribute__((ext_vector_type(4)));
constexpr int KVBLK = 64, LDK = QKW;
constexpr float SCALE = 0.125f, THR = 8.f;
constexpr size_t SHM_V = KVBLK * 128 * 2, SHM_K = KVBLK * 128 * 2;
#define KSWZ(row, colB) ((row) * 256 + ((colB) ^ (((row) & 15) << 4)))
#define SBAR() __builtin_amdgcn_sched_barrier(0)
__device__ __forceinline__ int crow(int r, int hi) { return (r & 3) + 8 * (r >> 2) + 4 * hi; }
__device__ __forceinline__ unsigned cvtpk(float lo, float hi) { unsigned r; asm volatile("v_cvt_pk_bf16_f32 %0, %1, %2" : "=v"(r) : "v"(lo), "v"(hi)); return r; }
constexpr float PBIAS = 5.f, THR2 = PBIAS + 3.5f;
template <bool FIRST>
__device__ __forceinline__ void partialSM(f32x16& p0, f32x16& p1, float& m_reg, f32x16& negm, float& alpha) {
  float pmax = p0[0];
#pragma unroll
  for (int r = 1; r < 16; ++r) pmax = fmaxf(pmax, p0[r]);
#pragma unroll
  for (int r = 0; r < 16; ++r) pmax = fmaxf(pmax, p1[r]);
  { auto rr = __builtin_amdgcn_permlane32_swap(__float_as_uint(pmax), __float_as_uint(pmax), false, false);
    pmax = fmaxf(__uint_as_float(rr[0]), __uint_as_float(rr[1])); }
  if (!FIRST && __builtin_expect(__all(pmax <= THR2), 1)) { alpha = 1.f; }
  else { const float dl = FIRST ? pmax - PBIAS : fmaxf(pmax - PBIAS, 0.f); alpha = FIRST ? 0.f : __builtin_amdgcn_exp2f(-dl); m_reg += dl;
#pragma unroll
    for (int r = 0; r < 16; ++r) { p0[r] -= dl; p1[r] -= dl; }
#pragma unroll
    for (int r = 0; r < 16; ++r) negm[r] = -m_reg;
    asm volatile("" : "+v"(negm)); }
#pragma unroll
  for (int r = 0; r < 16; ++r) p0[r] = __builtin_amdgcn_exp2f(p0[r]);
}
typedef int i32x8 __attribute__((ext_vector_type(8)));
__device__ __forceinline__ void finishSM_T(f32x16& p0, f32x16& p1, float alpha, float& l_reg, i32x8& pb) {
#pragma unroll
  for (int r = 0; r < 16; ++r) p1[r] = __builtin_amdgcn_exp2f(p1[r]);
  float ps = 0;
#pragma unroll
  for (int r = 0; r < 16; ++r) ps += p0[r];
#pragma unroll
  for (int r = 0; r < 16; ++r) ps += p1[r];
  { auto rr = __builtin_amdgcn_permlane32_swap(__float_as_uint(ps), __float_as_uint(ps), false, false);
    ps = __uint_as_float(rr[0]) + __uint_as_float(rr[1]); }
  l_reg = l_reg * alpha + ps;
#pragma unroll
  for (int g = 0; g < 4; ++g) {
    int w0 = __builtin_amdgcn_cvt_pk_fp8_f32(p0[4 * g], p0[4 * g + 1], 0, false); w0 = __builtin_amdgcn_cvt_pk_fp8_f32(p0[4 * g + 2], p0[4 * g + 3], w0, true); pb[g] = w0;
    int w1 = __builtin_amdgcn_cvt_pk_fp8_f32(p1[4 * g], p1[4 * g + 1], 0, false); w1 = __builtin_amdgcn_cvt_pk_fp8_f32(p1[4 * g + 2], p1[4 * g + 3], w1, true); pb[4 + g] = w1; }
}
__device__ __forceinline__ void qkt(f32x16& p0, f32x16& p1, const char* Ks, const i32x8 qf, int lane, int mm, const f32x16& negm) {
  const char* kp = Ks + mm * 4096 + lane * 16;
  const u32x4 a0 = *reinterpret_cast<const u32x4*>(kp), a1 = *reinterpret_cast<const u32x4*>(kp + 1024), b0 = *reinterpret_cast<const u32x4*>(kp + 2048), b1 = *reinterpret_cast<const u32x4*>(kp + 3072);
  p0 = __builtin_amdgcn_mfma_scale_f32_32x32x64_f8f6f4((i32x8){(int)a0.x, (int)a0.y, (int)a0.z, (int)a0.w, (int)a1.x, (int)a1.y, (int)a1.z, (int)a1.w}, qf, negm, 0, 0, 0, 0, 0, 0);
  p1 = __builtin_amdgcn_mfma_scale_f32_32x32x64_f8f6f4((i32x8){(int)b0.x, (int)b0.y, (int)b0.z, (int)b0.w, (int)b1.x, (int)b1.y, (int)b1.z, (int)b1.w}, qf, negm, 0, 0, 0, 0, 0, 0);
}
__device__ __forceinline__ int v_st(int k, int c) { const int kk = (k & ~0xC) | ((k & 4) << 1) | ((k & 8) >> 1); return ((kk >> 3) * 4 + (c >> 5)) * 512 + ((kk & 7) * 32 + (c & 31)) * 2; }
__device__ __forceinline__ int v_rd_base(int lane) { return ((lane & 3) << 3) | (((lane >> 2) & 3) << 6) | (((lane >> 4) & 1) << 5) | (((lane >> 5) & 1) << 8); }
constexpr int v_rd_off(int d0, int ks, int half) { return d0 * 512 + ks * 4096 + half * 2048; }
template <int OFF> __device__ __forceinline__ s16x4 tr_read(int vb) {
  s16x4 r; asm volatile("ds_read_b64_tr_b16 %0, %1 offset:%2" : "=&v"(r) : "v"(vb), "i"(OFF) : "memory"); return r;
}
template <int D0> __device__ __forceinline__ void pv_one(f32x16& od, int vb, bf16x8 pa0, bf16x8 pa1, bf16x8 pa2, bf16x8 pa3) {
  const s16x4 l0 = tr_read<v_rd_off(D0, 0, 0)>(vb), h0 = tr_read<v_rd_off(D0, 0, 1)>(vb), l1 = tr_read<v_rd_off(D0, 1, 0)>(vb), h1 = tr_read<v_rd_off(D0, 1, 1)>(vb);
  const s16x4 l2 = tr_read<v_rd_off(D0, 2, 0)>(vb), h2 = tr_read<v_rd_off(D0, 2, 1)>(vb), l3 = tr_read<v_rd_off(D0, 3, 0)>(vb), h3 = tr_read<v_rd_off(D0, 3, 1)>(vb);
  asm volatile("s_waitcnt lgkmcnt(0)" ::: "memory"); SBAR();
#define PK(L, H) (bf16x8){L[0], L[1], L[2], L[3], H[0], H[1], H[2], H[3]}
  od = __builtin_amdgcn_mfma_f32_32x32x16_bf16(pa0, PK(l0, h0), od, 0, 0, 0);
  od = __builtin_amdgcn_mfma_f32_32x32x16_bf16(pa1, PK(l1, h1), od, 0, 0, 0);
  od = __builtin_amdgcn_mfma_f32_32x32x16_bf16(pa2, PK(l2, h2), od, 0, 0, 0);
  od = __builtin_amdgcn_mfma_f32_32x32x16_bf16(pa3, PK(l3, h3), od, 0, 0, 0);
#undef PK
}
__device__ __forceinline__ void pv_d0(f32x16* o, int vb, bf16x8 pa0, bf16x8 pa1, bf16x8 pa2, bf16x8 pa3) {
  pv_one<0>(o[0], vb, pa0, pa1, pa2, pa3); pv_one<1>(o[1], vb, pa0, pa1, pa2, pa3); pv_one<2>(o[2], vb, pa0, pa1, pa2, pa3); pv_one<3>(o[3], vb, pa0, pa1, pa2, pa3);
}

template <int OFF> __device__ __forceinline__ u32x4 rd128(int vb) { u32x4 r; asm volatile("ds_read_b128 %0, %1 offset:%2" : "=&v"(r) : "v"(vb), "i"(OFF) : "memory"); return r; }
#define PV_RD(D0) const u32x4 va##D0 = rd128<D0 * 2048>(vb), vc##D0 = rd128<D0 * 2048 + 1024>(vb); SBAR()
#define PV_MM(D0) do { asm volatile("s_waitcnt lgkmcnt(0)" ::: "memory"); SBAR(); \
    o[D0] = __builtin_amdgcn_mfma_scale_f32_32x32x64_f8f6f4((i32x8){(int)va##D0.x, (int)va##D0.y, (int)va##D0.z, (int)va##D0.w, (int)vc##D0.x, (int)vc##D0.y, (int)vc##D0.z, (int)vc##D0.w}, pb, o[D0], 0, 0, 0, 0, 0, 0); } while (0)
__device__ __forceinline__ float max3f(float a, float b, float c) { float r; asm("v_max3_f32 %0, %1, %2, %3" : "=v"(r) : "v"(a), "v"(b), "v"(c)); return r; }
__device__ __forceinline__ void pv_psm(f32x16* o, int vb, i32x8 pb, f32x16& p0, f32x16& p1, float& m_reg, f32x16& negm, float& alpha) {
  float pmax;
  { PV_RD(0);
    pmax = max3f(p0[0], p0[1], p0[2]);
#pragma unroll
    for (int r = 3; r < 15; r += 2) pmax = max3f(pmax, p0[r], p0[r + 1]);
    pmax = max3f(pmax, p0[15], p1[0]);
    SBAR(); PV_MM(0); }
  { PV_RD(1);
#pragma unroll
    for (int r = 1; r < 15; r += 2) pmax = max3f(pmax, p1[r], p1[r + 1]);
    pmax = max3f(pmax, p1[15], p1[15]);
    { auto rr = __builtin_amdgcn_permlane32_swap(__float_as_uint(pmax), __float_as_uint(pmax), false, false);
      pmax = max3f(__uint_as_float(rr[0]), __uint_as_float(rr[1]), __uint_as_float(rr[1])); }
    if (__builtin_expect(__all(pmax <= THR2), 1)) { alpha = 1.f; }
    else { const float dl = fmaxf(pmax - PBIAS, 0.f); alpha = __builtin_amdgcn_exp2f(-dl); m_reg += dl;
#pragma unroll
      for (int r = 0; r < 16; ++r) { p0[r] -= dl; p1[r] -= dl; }
#pragma unroll
      for (int r = 0; r < 16; ++r) negm[r] = -m_reg;
      asm volatile("" : "+v"(negm)); }
    SBAR(); PV_MM(1); }
  { PV_RD(2);
#pragma unroll
    for (int r = 0; r < 8; ++r) p0[r] = __builtin_amdgcn_exp2f(p0[r]);
    asm volatile("" : "+v"(p0));
    SBAR(); PV_MM(2); }
  { PV_RD(3);
#pragma unroll
    for (int r = 8; r < 16; ++r) p0[r] = __builtin_amdgcn_exp2f(p0[r]);
    asm volatile("" : "+v"(p0));
    SBAR(); PV_MM(3); }
}
__device__ __forceinline__ void pvT_d0(f32x16* o, int vb, i32x8 pb) {
  { PV_RD(0); PV_MM(0); } { PV_RD(1); PV_MM(1); } { PV_RD(2); PV_MM(2); } { PV_RD(3); PV_MM(3); }
}
#undef PV_RD
#undef PV_MM

__device__ __forceinline__ void attn_unit(const unsigned char* __restrict__ Qb, const unsigned char* __restrict__ Kh, const unsigned char* __restrict__ Vh, bf16_t* __restrict__ Ob,
                                          const float* __restrict__ gsub, const float lam, char* lds, const int wv) {
  typedef __attribute__((address_space(3))) unsigned* ldsu_t;
  const int tid = otid_w(wv), wid = wv, lane = tid & 63, r32 = lane & 31, hi = lane >> 5, mm = wid >> 2, wq = wid & 3;
  constexpr int NB = 4;
  constexpr int SHM_V8 = KVBLK * 128;
  char* V_lds = lds; char* K_lds = lds + NB * SHM_V8; constexpr int SHM_K8 = KVBLK * 128;
  float m_reg = 0.f, l_reg = 0; f32x16 o[4] = {}; i32x8 qf; f32x16 negm = {}; asm volatile("" : "+v"(negm));
  const unsigned koff = (unsigned)((2 * (wid >> 2) + (lane >> 5)) * 2048 + (lane & 3) * 512 + (8 * ((wid >> 1) & 1) + 2 * ((lane & 31) >> 3) + ((lane >> 2) & 1)) * 32 + (wid & 1) * 16);
  const unsigned voff = (unsigned)((wid >> 1) * 2048 + (lane & 7) * 256 + ((lane >> 3) & 3) * 64 + (wid & 1) * 32 + (lane >> 5) * 16);
#define DMA(t, buf) do { const char* kb_ = (const char*)(Kh + (size_t)(t) * SHM_K8); const char* vb_ = (const char*)(Vh + (size_t)(t) * SHM_V8); asm volatile("" : "+s"(kb_), "+s"(vb_)); \
    __builtin_amdgcn_global_load_lds((const unsigned*)(kb_ + koff), (ldsu_t)(K_lds + (buf) * SHM_K8 + wid * 1024), 16, 0, 0); \
    __builtin_amdgcn_global_load_lds((const unsigned*)(vb_ + voff), (ldsu_t)(V_lds + (buf) * SHM_V8 + wid * 1024), 16, 0, 0); } while (0)
#define WAIT_BAR(N) asm volatile("s_waitcnt vmcnt(" #N ") lgkmcnt(0)\n\ts_barrier" ::: "memory")
#define RESC(a) do { if (__any((a) < 1.f)) { _Pragma("unroll") for (int d = 0; d < 4; ++d) _Pragma("unroll") for (int r = 0; r < 16; ++r) o[d][r] *= (a); } } while (0)
  DMA(0, 0); DMA(1, 1);
  { const unsigned char* Qw = Qb + (long)(wq * 32 + r32) * QKW + mm * 64 + hi * 32;
    const u32x4 q0 = *reinterpret_cast<const u32x4*>(Qw), q1 = *reinterpret_cast<const u32x4*>(Qw + 16);
    qf = (i32x8){(int)q0.x, (int)q0.y, (int)q0.z, (int)q0.w, (int)q1.x, (int)q1.y, (int)q1.z, (int)q1.w}; }
  const int vb0 = (int)(uintptr_t)V_lds + lane * 16;
  f32x16 pA0, pA1, pB0, pB1; float alA, alB; i32x8 pb; constexpr int NTL = KVLEN / KVBLK;
  WAIT_BAR(0);
  DMA(2, 2);
  qkt(pA0, pA1, K_lds, qf, lane, mm, negm); partialSM<true>(pA0, pA1, m_reg, negm, alA);
  WAIT_BAR(2);
  for (int j = 1; j + 1 < NTL; j += 2) {
    DMA(j + 2, (j + 2) & 3);
    SBAR(); qkt(pB0, pB1, K_lds + (j & 3) * SHM_K8, qf, lane, mm, negm);
    finishSM_T(pA0, pA1, alA, l_reg, pb); SBAR();
    pv_psm(o, vb0 + ((j - 1) & 3) * SHM_V8, pb, pB0, pB1, m_reg, negm, alB);
    RESC(alB);
    WAIT_BAR(2);
    if (j + 3 < NTL) DMA(j + 3, (j + 3) & 3);
    SBAR(); qkt(pA0, pA1, K_lds + ((j + 1) & 3) * SHM_K8, qf, lane, mm, negm);
    finishSM_T(pB0, pB1, alB, l_reg, pb); SBAR();
    pv_psm(o, vb0 + (j & 3) * SHM_V8, pb, pA0, pA1, m_reg, negm, alA);
    RESC(alA);
    if (j + 3 < NTL) WAIT_BAR(2); else WAIT_BAR(0);
  }
  SBAR(); qkt(pB0, pB1, K_lds + ((NTL - 1) & 3) * SHM_K8, qf, lane, mm, negm);
  finishSM_T(pA0, pA1, alA, l_reg, pb); SBAR();
  pv_psm(o, vb0 + ((NTL - 2) & 3) * SHM_V8, pb, pB0, pB1, m_reg, negm, alB);
  RESC(alB);
  finishSM_T(pB0, pB1, alB, l_reg, pb); SBAR();
  pvT_d0(o, vb0 + ((NTL - 1) & 3) * SHM_V8, pb);
#undef DMA
#undef WAIT_BAR
  const float rl = __builtin_amdgcn_rcpf(l_reg) * (mm ? lam : 1.0f);
  __syncthreads();
  constexpr int XS = 132;
  float* X = (float*)lds;
  if (mm == 1) {
#pragma unroll
    for (int r = 0; r < 16; ++r)
#pragma unroll
      for (int d0 = 0; d0 < 4; ++d0) X[(wq * 32 + r32) * XS + d0 * 32 + crow(r, hi)] = o[d0][r] * rl;
  }
  __syncthreads();
  if (mm == 0) {
#pragma unroll
    for (int r = 0; r < 16; ++r)
#pragma unroll
      for (int d0 = 0; d0 < 4; ++d0) { float* xp = X + (wq * 32 + r32) * XS + d0 * 32 + crow(r, hi); *xp = o[d0][r] * rl - *xp; }
  }
  __syncthreads();
  {
    const int row = tid >> 2, seg = tid & 3;
    const float* xr = X + row * XS + seg * 32;
    f32x4 v[8]; float ss = 0.f;
#pragma unroll
    for (int i = 0; i < 8; ++i) { v[i] = *(const f32x4*)(xr + 4 * i); ss += v[i][0] * v[i][0] + v[i][1] * v[i][1] + v[i][2] * v[i][2] + v[i][3] * v[i][3]; }
    ss += sx<1>(ss); ss += sx<2>(ss);
    const float rs = (1.0f - LAM_INIT) / sqrtf(ss * (1.0f / 128.0f) + EPS);
    bf16_t* dst = Ob + (long)row * D + seg * 32;
#pragma unroll
    for (int i = 0; i < 8; i += 2) {
      const f32x4 g0 = *(const f32x4*)(gsub + seg * 32 + 4 * i), g1 = *(const f32x4*)(gsub + seg * 32 + 4 * i + 4);
      u32x4 w; w.x = cvtpk(v[i][0] * rs * g0[0], v[i][1] * rs * g0[1]); w.y = cvtpk(v[i][2] * rs * g0[2], v[i][3] * rs * g0[3]);
      w.z = cvtpk(v[i + 1][0] * rs * g1[0], v[i + 1][1] * rs * g1[1]); w.w = cvtpk(v[i + 1][2] * rs * g1[2], v[i + 1][3] * rs * g1[3]);
      *(u32x4*)(dst + 4 * i) = w;
    }
  }
  __syncthreads();
#undef RESC
}
#undef KSWZ
#undef SBAR
}

__device__ __forceinline__ void ph_attn(const Params& p, unsigned char* smem) {
    unsigned char* ws = p.ws;
    const unsigned char* Q = ws + WS_Q; const unsigned char* Kb = ws + WS_K; const unsigned char* Vb = ws + WS_V;
    bf16_t* AO = (bf16_t*)(ws + WS_AO);
    const float lam = ((const float*)(ws + WS_CTL))[1024];
    const int c = blockIdx.x, G = gridDim.x;
    if (G == 256) {
        const int x = c & 7, s = c >> 3;
        for (int rd = 0; rd < 6; ++rd) {
            const int bh = rd * 4 + (x >> 1), qb = (x & 1) * 32 + s, b = bh / NH, h = bh % NH;
            fa::attn_unit(Q + ((size_t)b * SEQ + qb * 128) * QKW + h * 128, Kb + (size_t)(b * NH + h) * (KVLEN / 64) * 8192, Vb + (size_t)(b * NH + h) * (KVLEN / 64) * 8192,
                          AO + ((size_t)b * SEQ + qb * 128) * D + 256 + h * 128, p.in[I_GSUB], lam, (char*)smem, p.chunk);
        }
    } else {
        for (int u = c; u < BATCH * NH * 64; u += G) {
            const int bh = u >> 6, qb = u & 63, b = bh / NH, h = bh % NH;
            fa::attn_unit(Q + ((size_t)b * SEQ + qb * 128) * QKW + h * 128, Kb + (size_t)(b * NH + h) * (KVLEN / 64) * 8192, Vb + (size_t)(b * NH + h) * (KVLEN / 64) * 8192,
                          AO + ((size_t)b * SEQ + qb * 128) * D + 256 + h * 128, p.in[I_GSUB], lam, (char*)smem, p.chunk);
        }
    }
}

__device__ __forceinline__ void ph_fourierA(const Params& p, unsigned char* smem) {
    using namespace fa;
    unsigned char* ws = p.ws;
    const bf16_t* F = (const bf16_t*)(ws + WS_F); bf16_t* FY = (bf16_t*)(ws + WS_FY); const bf16_t* W = (const bf16_t*)(ws + WS_W128E);
    const int tid = otid(), wid = tid >> 6, lane = tid & 63, r32 = lane & 31, hi = lane >> 5;
    const int sr = tid >> 4, sc = (tid & 15) * 8, vst0 = v_st(sr, sc), vst1 = v_st(32 + sr, sc);
    const int vb0 = (int)(uintptr_t)smem + v_rd_base(lane);
    for (int task = blockIdx.x; task < BATCH * 64; task += gridDim.x) {
        const int b = task >> 6, n2 = task & 63;
        bf16x8 st[4][2];
#pragma unroll
        for (int kt = 0; kt < 2; ++kt)
#pragma unroll
            for (int ct = 0; ct < 2; ++ct) {
                st[kt * 2 + ct][0] = *(const bf16x8*)(F + ((size_t)b * SEQ + 64 * (64 * kt + sr) + n2) * 256 + 128 * ct + sc);
                st[kt * 2 + ct][1] = *(const bf16x8*)(F + ((size_t)b * SEQ + 64 * (64 * kt + 32 + sr) + n2) * 256 + 128 * ct + sc);
            }
        bf16x8 pa[2][4];
#pragma unroll
        for (int kt = 0; kt < 2; ++kt)
#pragma unroll
            for (int ks = 0; ks < 4; ++ks) pa[kt][ks] = *(const bf16x8*)(W + (size_t)(32 * wid + r32) * 128 + 64 * kt + 16 * ks + 8 * hi);
        __syncthreads();
#pragma unroll
        for (int q = 0; q < 4; ++q) { *(bf16x8*)(smem + q * 16384 + vst0) = st[q][0]; *(bf16x8*)(smem + q * 16384 + vst1) = st[q][1]; }
        __syncthreads();
        f32x16 o[2][4] = {};
#pragma unroll
        for (int ct = 0; ct < 2; ++ct)
#pragma unroll
            for (int kt = 0; kt < 2; ++kt) pv_d0(o[ct], vb0 + (kt * 2 + ct) * 16384, pa[kt][0], pa[kt][1], pa[kt][2], pa[kt][3]);
        const int plane = wid >> 2;
#pragma unroll
        for (int r = 0; r < 16; ++r) {
            const int k1 = 32 * (wid & 3) + crow(r, hi);
            bf16_t* dst = FY + ((((size_t)plane * BATCH + b) * 128 + k1) * 64 + n2) * 256 + r32;
#pragma unroll
            for (int ct = 0; ct < 2; ++ct)
#pragma unroll
                for (int d0 = 0; d0 < 4; ++d0) dst[128 * ct + 32 * d0] = f2bf(o[ct][d0][r]);
        }
    }
    __syncthreads();
}
__device__ __forceinline__ void ph_fourierB(const Params& p, unsigned char* smem) {
    using namespace fa;
    unsigned char* ws = p.ws;
    const bf16_t* FY = (const bf16_t*)(ws + WS_FY); const float2* tabw = (const float2*)(ws + WS_TABW);
    const bf16_t* M64 = (const bf16_t*)(ws + WS_M64E); const bf16_t* GT = (const bf16_t*)(ws + WS_GT);
    bf16_t* AO = (bf16_t*)(ws + WS_AO);
    const int tid = otid(), wid = tid >> 6, lane = tid & 63, r32 = lane & 31, hi = lane >> 5;
    const int sr = tid >> 4, sc = (tid & 15) * 8, vst0 = v_st(sr, sc), vst1 = v_st(32 + sr, sc);
    const int vb0 = (int)(uintptr_t)smem + v_rd_base(lane);
    constexpr int XRS = 528;
    unsigned char* XL = smem + 65536;
    const int mt = wid & 3, ctw = wid >> 2;
    for (int task = blockIdx.x; task < BATCH * 128; task += gridDim.x) {
        const int b = task >> 7, k1 = task & 127;
        __syncthreads();
#pragma unroll
        for (int ct = 0; ct < 2; ++ct)
#pragma unroll
            for (int rh = 0; rh < 2; ++rh) {
                const int n2 = sr + 32 * rh;
                const size_t off = ((((size_t)b) * 128 + k1) * 64 + n2) * 256 + 128 * ct + sc;
                const uint4 yr = *(const uint4*)(FY + off), yi = *(const uint4*)(FY + (size_t)BATCH * 128 * 64 * 256 + off);
                const float2 tw = tabw[n2 * k1];
                const unsigned yrw[4] = {yr.x, yr.y, yr.z, yr.w}, yiw[4] = {yi.x, yi.y, yi.z, yi.w};
                unsigned zr[4], zi[4];
#pragma unroll
                for (int q = 0; q < 4; ++q) {
                    const float a0 = __uint_as_float(yrw[q] << 16), a1 = __uint_as_float(yrw[q] & 0xffff0000u), b0 = __uint_as_float(yiw[q] << 16), b1 = __uint_as_float(yiw[q] & 0xffff0000u);
                    zr[q] = pk2(a0 * tw.x + b0 * tw.y, a1 * tw.x + b1 * tw.y); zi[q] = pk2(b0 * tw.x - a0 * tw.y, b1 * tw.x - a1 * tw.y);
                }
                const int vs = rh ? vst1 : vst0;
                *(uint4*)(smem + (0 * 2 + ct) * 16384 + vs) = make_uint4(zr[0], zr[1], zr[2], zr[3]);
                *(uint4*)(smem + (1 * 2 + ct) * 16384 + vs) = make_uint4(zi[0], zi[1], zi[2], zi[3]);
            }
        __syncthreads();
        {
            f32x16 o[4] = {};
#pragma unroll
            for (int kt = 0; kt < 2; ++kt) {
                bf16x8 pa[4];
#pragma unroll
                for (int ks = 0; ks < 4; ++ks) pa[ks] = *(const bf16x8*)(M64 + (size_t)(32 * mt + r32) * 128 + 64 * kt + 16 * ks + 8 * hi);
                pv_d0(o, vb0 + (kt * 2 + ctw) * 16384, pa[0], pa[1], pa[2], pa[3]);
            }
#pragma unroll
            for (int r = 0; r < 16; ++r) {
                const int ro = 32 * mt + crow(r, hi);
                bf16_t* xr = (bf16_t*)(XL + ((ro >> 6) * 64 + (ro & 63)) * XRS) + 128 * ctw + r32;
#pragma unroll
                for (int d0 = 0; d0 < 4; ++d0) xr[32 * d0] = f2bf(o[d0][r]);
            }
        }
        __syncthreads();
#pragma unroll
        for (int tt = 0; tt < 2; ++tt) {
            const int tau = 2 * wid + tt, g = tau >> 2, mt2 = (tau >> 1) & 1, nt2 = tau & 1;
            f32x16 acc = {};
#pragma unroll
            for (int ks8 = 0; ks8 < 8; ++ks8) {
                const int part = ks8 >> 2, cb = ks8 & 3;
                const bf16x8 af = *(const bf16x8*)(XL + (part * 64 + 32 * mt2 + r32) * XRS + (g * 64 + 16 * cb + 8 * hi) * 2);
                const bf16x8 bfr = *(const bf16x8*)(GT + ((size_t)g * 64 + 32 * nt2 + r32) * 128 + part * 64 + 16 * cb + 8 * hi);
                acc = __builtin_amdgcn_mfma_f32_32x32x16_bf16(af, bfr, acc, 0, 0, 0);
            }
#pragma unroll
            for (int r = 0; r < 16; ++r) { const int k2 = 32 * mt2 + crow(r, hi);
                AO[((size_t)b * SEQ + k1 + 128 * k2) * D + g * 64 + 32 * nt2 + r32] = f2bf(acc[r]); }
        }
    }
    __syncthreads();
}

__device__ __forceinline__ void ph_mid(const Params& p, unsigned char* smem) {
    typedef short bf16x8 __attribute__((ext_vector_type(8)));
    unsigned char* ws = p.ws;
    const int tid = otid(), wave = tid >> 6, lane = tid & 63, fr = lane & 15, fq = lane >> 4;
    const float* mod = (const float*)(ws + WS_MOD);
    const bf16_t* YX = (const bf16_t*)(ws + WS_YX);
    unsigned char* H2 = ws + WS_H2;
    unsigned* counts = (unsigned*)(ws + WS_CTL);
    int* TE = (int*)(ws + WS_TE); int* TP = (int*)(ws + WS_TP); float* TW = (float*)(ws + WS_TW); int* TOKL = (int*)(ws + WS_TOKL);
    constexpr int RS = 2064;
    unsigned char* Ahi = smem; unsigned char* Alo = smem + 16 * RS; float* Pp = (float*)(smem + 2 * 16 * RS + 512);
    const float rbias = p.in[I_RB][lane];
    int* lcnt = (int*)(smem + 99328); int* gb = lcnt + 64; int* PE = gb + 64; float* PW = (float*)(PE + 1024); float* PV = PW + 1024;
    for (int chunk = blockIdx.x; chunk < T / 128; chunk += gridDim.x) {
      const int mc = chunk * 128, b = mc >> 13;
      if (tid < 64) lcnt[tid] = 0;
      {
          const float* mrow_ = mod + b * 6144;
          for (int i = tid; i < 5 * 256; i += NT) { const int v_ = i >> 8, q_ = (i & 255) * 4;
              const float* s_ = (v_ == 0) ? p.in[I_GAPOST] + q_ : (v_ == 1) ? mrow_ + 2 * 1024 + q_ : (v_ == 2) ? p.in[I_GFPRE] + q_ : (v_ == 3) ? mrow_ + 3 * 1024 + q_ : mrow_ + 4 * 1024 + q_;
              *(f32x4*)(PV + v_ * 1024 + q_) = *(const f32x4*)s_; }
          __syncthreads();
      }
      uint2 yw[2][4]; f32x4 xv[2][4];
#define MID_LOAD(m0_) do { _Pragma("unroll") for (int rr = 0; rr < 2; ++rr) { const int m_ = (m0_) + 2 * wave + rr; _Pragma("unroll") for (int j = 0; j < 4; ++j) { \
          yw[rr][j] = *(const uint2*)(YX + (size_t)m_ * D + 4 * (lane + 64 * j)); xv[rr][j] = ((const f32x4*)(p.in[I_X] + (size_t)m_ * D))[lane + 64 * j]; } } } while (0)
      MID_LOAD(mc);
      for (int it = 0; it < 8; ++it) {
        const int m0 = mc + it * 16;
        {
            float ss[2] = {0.f, 0.f};
#define YV(rr, j, i) ((i) == 0 ? __uint_as_float(yw[rr][j].x << 16) : (i) == 1 ? __uint_as_float(yw[rr][j].x & 0xffff0000u) : (i) == 2 ? __uint_as_float(yw[rr][j].y << 16) : __uint_as_float(yw[rr][j].y & 0xffff0000u))
#pragma unroll
            for (int rr = 0; rr < 2; ++rr) {
#pragma unroll
                for (int j = 0; j < 4; ++j) ss[rr] += YV(rr, j, 0) * YV(rr, j, 0) + YV(rr, j, 1) * YV(rr, j, 1) + YV(rr, j, 2) * YV(rr, j, 2) + YV(rr, j, 3) * YV(rr, j, 3);
                ss[rr] = wave_sum(ss[rr]);
            }
#pragma unroll
            for (int rr = 0; rr < 2; ++rr) {
                const int lr = 2 * wave + rr, m = m0 + lr;
                const float r1 = 1.0f / sqrtf(ss[rr] * (1.0f / D) + EPS);
                float ss2 = 0.f;
#pragma unroll
                for (int j = 0; j < 4; ++j) {
                    const int col = 4 * (lane + 64 * j);
                    const f32x4 gp = *(const f32x4*)(PV + col), gt = *(const f32x4*)(PV + 1024 + col);
#pragma unroll
                    for (int i = 0; i < 4; ++i) { xv[rr][j][i] = xv[rr][j][i] + gt[i] * (YV(rr, j, i) * r1 * gp[i]); ss2 += xv[rr][j][i] * xv[rr][j][i]; }
                    ((f32x4*)(p.out + (size_t)m * D))[lane + 64 * j] = xv[rr][j];
                }
                ss2 = wave_sum(ss2);
                const float r2 = 1.0f / sqrtf(ss2 * (1.0f / D) + EPS);
#pragma unroll
                for (int j = 0; j < 4; ++j) {
                    const int col = 4 * (lane + 64 * j);
                    const f32x4 gp = *(const f32x4*)(PV + 2048 + col), sh = *(const f32x4*)(PV + 3072 + col), sc = *(const f32x4*)(PV + 4096 + col);
                    float h[4]; bf16_t hb[4]; float lo[4];
#pragma unroll
                    for (int i = 0; i < 4; ++i) { h[i] = xv[rr][j][i] * r2 * gp[i] * (1.f + sc[i]) + sh[i]; hb[i] = f2bf(h[i]); lo[i] = h[i] - bf2f(hb[i]); }
                    uint2 o; o.x = (unsigned)hb[0] | ((unsigned)hb[1] << 16); o.y = (unsigned)hb[2] | ((unsigned)hb[3] << 16);
                    { int w8 = __builtin_amdgcn_cvt_pk_fp8_f32(h[0], h[1], 0, false); w8 = __builtin_amdgcn_cvt_pk_fp8_f32(h[2], h[3], w8, true); *(int*)(H2 + (size_t)m * D + col) = w8; }
                    *(uint2*)(Ahi + lr * RS + col * 2) = o;
                    uint2 ol; ol.x = pk2(lo[0], lo[1]); ol.y = pk2(lo[2], lo[3]);
                    *(uint2*)(Alo + lr * RS + col * 2) = ol;
                }
            }
            if (it < 7) MID_LOAD(m0 + 16);
        }
        asm volatile("s_waitcnt lgkmcnt(0)\n\ts_barrier" ::: "memory");
        {
            f32x4 acc[4];
#pragma unroll
            for (int nb = 0; nb < 4; ++nb) acc[nb] = (f32x4){0.f, 0.f, 0.f, 0.f};
            const bf16_t* wrtlo = (const bf16_t*)(ws + WS_WRT); asm volatile("" : "+s"(wrtlo));
#pragma unroll
            for (int ks = 0; ks < 4; ++ks) {
                const int ko = (wave * 128 + ks * 32 + 8 * fq) * 2;
                const bf16x8 ah = *(const bf16x8*)(Ahi + fr * RS + ko), al = *(const bf16x8*)(Alo + fr * RS + ko);
#pragma unroll
                for (int nb = 0; nb < 4; ++nb) {
                    const size_t wo_ = ((size_t)(((wave * 4 + ks) * 4 + nb) * 2) * 64 + lane) * 8;
                    const bf16x8 bhv = *(const bf16x8*)(wrtlo + wo_), bl = *(const bf16x8*)(wrtlo + wo_ + 512);
                    acc[nb] = __builtin_amdgcn_mfma_f32_16x16x32_bf16(ah, bhv, acc[nb], 0, 0, 0);
                    acc[nb] = __builtin_amdgcn_mfma_f32_16x16x32_bf16(ah, bl, acc[nb], 0, 0, 0);
                    acc[nb] = __builtin_amdgcn_mfma_f32_16x16x32_bf16(al, bhv, acc[nb], 0, 0, 0);
                }
            }
#pragma unroll
            for (int nb = 0; nb < 4; ++nb)
#pragma unroll
                for (int j = 0; j < 4; ++j) Pp[(wave * 16 + 4 * fq + j) * 64 + 16 * nb + fr] = acc[nb][j];
        }
        asm volatile("s_waitcnt lgkmcnt(0)\n\ts_barrier" ::: "memory");
#pragma unroll
        for (int rr = 0; rr < 2; ++rr) {
            const int lr = 2 * wave + rr;
            float lg = 0.f;
#pragma unroll
            for (int w = 0; w < 8; ++w) lg += Pp[(w * 16 + lr) * 64 + lane];
            const float score = 1.0f / (1.0f + expf(-lg));
            const float sel = score + rbias;
            float t1 = sel, t2 = -INFINITY;
#define TOP2(M) do { const float o1 = sx<M>(t1), o2 = sx<M>(t2); const float n1 = fmaxf(t1, o1), n2 = fmaxf(fminf(t1, o1), fmaxf(t2, o2)); t1 = n1; t2 = n2; } while (0)
            TOP2(1); TOP2(2); TOP2(4);
#undef TOP2
            const float gs = t1 + t2; const int grp = lane >> 3;
            int gr = 0;
#pragma unroll
            for (int j = 0; j < 8; ++j) { const float sj = __uint_as_float(__builtin_amdgcn_readlane(__float_as_uint(gs), j * 8)); gr += (sj > gs || (sj == gs && j < grp)) ? 1 : 0; }
            const bool gsel = gr < 4;
            float v = gsel ? sel : -INFINITY;
            int rk = TOPK;
#pragma unroll
            for (int it8 = 0; it8 < TOPK; ++it8) {
                const float mx = wave_max(v);
                const unsigned long long eq = __ballot(v == mx);
                const int win = __builtin_ctzll(eq);
                if (lane == win) { rk = it8; v = -INFINITY; }
            }
            const bool chosen = rk < TOPK;
            const float ssum = wave_sum(chosen ? score : 0.f);
            const float w = score / (ssum + 1e-20f) * 2.5f;
            if (chosen) {
                const int lpos = atomicAdd(&lcnt[lane], 1);
                const int idx = (it * 16 + lr) * 8 + rk;
                PE[idx] = lane | (lpos << 8); PW[idx] = w;
            }
        }
      }
      __syncthreads();
      if (tid < 64) { const int c = lcnt[tid]; gb[tid] = c ? (int)atomicAdd(&counts[b * 65 + tid], (unsigned)c) : 0; }
      __syncthreads();
      for (int i = tid; i < 1024; i += NT) {
          const int pe = PE[i], e = pe & 255, pos = gb[e] + (pe >> 8), mk = mc * 8 + i;
          TOKL[((size_t)b * 64 + e) * 8192 + pos] = mk; TE[mk] = e; TP[mk] = pos; TW[mk] = PW[i];
      }
      __syncthreads();
    }
}

constexpr int T_CNT = 0;
constexpr int T_TOT = 256;
constexpr int T_AB = 328;
constexpr int T_OFF = 400;
constexpr int T_GUP = 660;
constexpr int T_YC = 730;
constexpr int T_YB = 990;
constexpr int T_DUP = 1250;
constexpr int T_UL = 1520;
constexpr int T_END = 1520 + 512;
__device__ __forceinline__ int scan_incl(int v, int lane) {
#pragma unroll
    for (int off = 1; off < 64; off <<= 1) { const int t = __builtin_amdgcn_ds_bpermute(((lane - off) & 63) << 2, v); if (lane >= off) v += t; }
    return v;
}
__device__ __forceinline__ void build_moe(const Params& p, int* tab) {
    const unsigned* counts = (const unsigned*)(p.ws + WS_CTL);
    __syncthreads();
    const int tid = otid(), wave = tid >> 6, lane = tid & 63;
    if (wave == 0) {
        const int c0 = (int)counts[0 * 65 + lane], c1 = (int)counts[1 * 65 + lane], c2 = (int)counts[2 * 65 + lane], c3 = (int)counts[3 * 65 + lane];
        tab[T_CNT + 0 * 64 + lane] = c0; tab[T_CNT + 1 * 64 + lane] = c1; tab[T_CNT + 2 * 64 + lane] = c2; tab[T_CNT + 3 * 64 + lane] = c3;
        tab[T_OFF + lane * 4 + 0] = 0; tab[T_OFF + lane * 4 + 1] = c0; tab[T_OFF + lane * 4 + 2] = c0 + c1; tab[T_OFF + lane * 4 + 3] = c0 + c1 + c2;
        const int tot = c0 + c1 + c2 + c3, pad = (tot + 255) & ~255, gu = ((tot + 255) >> 8) * 2;
        const int sp = scan_incl(pad, lane), sg = scan_incl(gu, lane);
        tab[T_TOT + lane] = tot; tab[T_AB + lane] = sp - pad; tab[T_GUP + lane] = sg - gu;
        const int cb[4] = {c0, c1, c2, c3};
#pragma unroll
        for (int b = 0; b < 4; ++b) {
            const int du = ((cb[b] + 255) >> 8) * 4;
            const int sy = scan_incl(cb[b], lane), sd = scan_incl(du, lane);
            tab[T_YB + 65 * b + lane] = sy - cb[b]; tab[T_DUP + 66 * b + lane] = sd - du;
            if (lane == 63) { tab[T_YB + 65 * b + 64] = sy; tab[T_DUP + 66 * b + 64] = sd; tab[T_DUP + 66 * b + 65] = sd + (SEQ / 256) * 4; }
        }
        if (lane == 63) { tab[T_TOT + 64] = T; tab[T_AB + 64] = sp; tab[T_GUP + 64] = sg; tab[T_GUP + 65] = sg + (T / 256) * 2; }
    }
    __syncthreads();
}

__device__ __forceinline__ void moe_decode(const GP_LAS int* tab, int e, int pos_e, int& b, int& pos) {
    const int o1 = tab[T_OFF + e * 4 + 1], o2 = tab[T_OFF + e * 4 + 2], o3 = tab[T_OFF + e * 4 + 3];
    b = (pos_e >= o1 ? 1 : 0) + (pos_e >= o2 ? 1 : 0) + (pos_e >= o3 ? 1 : 0);
    pos = pos_e - (b == 0 ? 0 : (b == 1 ? o1 : (b == 2 ? o2 : o3)));
}
struct MoeSched {
    const GP_LAS int* tab; int G, c, ntn, U, down, chunk; const int* TOKL; const char* Bt;
    __device__ __forceinline__ void prepare(int* tabw, int wv) const {
        if (wv == 0) {
            const int i = lane_id(), L = i * G + c;
            if (L < U) {
                const int pre = down ? T_DUP + 66 * chunk : T_GUP;
                int lo = 0, hi = 64;
                while (lo < hi) { const int mid = (lo + hi + 1) >> 1; if (tabw[pre + mid] <= L) lo = mid; else hi = mid - 1; }
                const int loc = L - tabw[pre + lo];
                int cnt, base, bb;
                if (down) { cnt = (lo < 64) ? tabw[T_CNT + chunk * 64 + (lo & 63)] : SEQ; base = tabw[T_YB + 65 * chunk + lo];
                            bb = tabw[T_AB + lo] + (lo < 64 ? tabw[T_OFF + (lo & 63) * 4 + chunk] : chunk * SEQ); }
                else { cnt = tabw[T_TOT + lo]; base = tabw[T_AB + lo]; bb = 0; }
                int* ul = tabw + T_UL + 8 * i;
                ul[0] = lo; ul[1] = loc / ntn; ul[2] = loc % ntn; ul[3] = cnt; ul[4] = base; ul[5] = bb;
            }
        }
        __syncthreads();
    }
    __device__ __forceinline__ bool next(int i, gp::Unit& u) const {
        if (i * G + c >= U) return false;
        const GP_LAS int* ul = tab + T_UL + 8 * i;
        u.e = __builtin_amdgcn_readfirstlane(ul[0]); u.pm = __builtin_amdgcn_readfirstlane(ul[1]); u.pn = __builtin_amdgcn_readfirstlane(ul[2]);
        u.cnt = __builtin_amdgcn_readfirstlane(ul[3]); u.base = __builtin_amdgcn_readfirstlane(ul[4]); u.b = __builtin_amdgcn_readfirstlane(ul[5]);
        return true;
    }
    __device__ __forceinline__ unsigned arow(const gp::Unit& u, int r) const {
        const int pos_e = u.pm * 256 + r;
        if (down) return (unsigned)(u.b + pos_e) * 512u;
        int tok;
        if (u.e < 64) { int b, pos; moe_decode(tab, u.e, pos_e, b, pos); tok = (pos_e < u.cnt) ? (TOKL[((size_t)b * 64 + u.e) * 8192 + pos] >> 3) : 0; } else tok = pos_e;
        return (unsigned)tok * 1024u;
    }
    __device__ __forceinline__ const char* bptr(const gp::Unit& u) const {
        return down ? Bt + ((size_t)u.e * 1024 + u.pn * 256) * 512 : Bt + ((size_t)u.e * 512 + u.pn * 256) * 1024;
    }
};
struct EpiGU {
    bf16_t* ACT; const int* TOKL; const float* TW; const GP_LAS int* tab;
    __device__ __forceinline__ void operator()(const f32x4 (&acc)[2][2][4][2], const gp::Unit& u, int wr, int wc, int fr, int fq) const {
#pragma unroll
        for (int ai = 0; ai < 2; ++ai)
#pragma unroll
            for (int m = 0; m < 4; ++m) {
                const int pos_e = u.pm * 256 + ai * 128 + wr * 64 + m * 16 + fr;
                if (pos_e < u.cnt) {
                    float w = 1.0f;
                    if (u.e < 64) { int b, pos; moe_decode(tab, u.e, pos_e, b, pos); w = TW[TOKL[((size_t)b * 64 + u.e) * 8192 + pos]]; }
                    float a[8];
#pragma unroll
                    for (int n = 0; n < 2; ++n)
#pragma unroll
                        for (int i = 0; i < 4; ++i) { const float g = acc[ai][0][m][n][i] * (1.f / GUSCALE), up = acc[ai][1][m][n][i] * (1.f / GUSCALE);
                            a[4 * n + i] = g * __builtin_amdgcn_rcpf(1.0f + __builtin_amdgcn_exp2f(-1.4426950408889634f * g)) * up * w; }
                    gp::u32x4 o; o.x = gp::cvt_pk_bf16(a[0], a[1]); o.y = gp::cvt_pk_bf16(a[2], a[3]); o.z = gp::cvt_pk_bf16(a[4], a[5]); o.w = gp::cvt_pk_bf16(a[6], a[7]);
                    *(gp::u32x4*)(ACT + ((size_t)u.base + pos_e) * DE + u.pn * 128 + wc * 32 + fq * 8) = o;
                }
            }
    }
};
struct EpiDown {
    unsigned char* ws;
    __device__ __forceinline__ void operator()(const f32x4 (&acc)[2][2][4][2], const gp::Unit& u, int wr, int wc, int fr, int fq) const {
#pragma unroll
        for (int ai = 0; ai < 2; ++ai)
#pragma unroll
            for (int m = 0; m < 4; ++m) {
                const int pos = u.pm * 256 + ai * 128 + wr * 64 + m * 16 + fr;
                if (pos < u.cnt) {
                    bf16_t* rowp = (bf16_t*)(ws + WS_Y) + (size_t)(u.base + pos) * D + u.pn * 256 + wc * 32 + fq * 8;
#pragma unroll
                    for (int bj = 0; bj < 2; ++bj) { const f32x4 v0 = acc[ai][bj][m][0], v1 = acc[ai][bj][m][1];
                        gp::u32x4 o; o.x = gp::cvt_pk_bf16(v0[0], v0[1]); o.y = gp::cvt_pk_bf16(v0[2], v0[3]); o.z = gp::cvt_pk_bf16(v1[0], v1[1]); o.w = gp::cvt_pk_bf16(v1[2], v1[3]);
                        *(gp::u32x4*)(rowp + bj * 128) = o; }
                }
            }
    }
};
__device__ __forceinline__ void ph_moe_gu(const Params& p, unsigned char* smem) {
    unsigned char* ws = p.ws;
    int* tab = (int*)(smem + gp::STAGE_BYTES);
    build_moe(p, tab);
    MoeSched S; S.tab = (const GP_LAS int*)tab; S.G = gridDim.x; S.c = (gridDim.x % 8 == 0) ? (int)((blockIdx.x % 8) * (gridDim.x / 8) + blockIdx.x / 8) : (int)blockIdx.x;   S.ntn = 2; S.U = __builtin_amdgcn_readfirstlane(tab[T_GUP + 65]); S.down = 0; S.chunk = 0;
    S.TOKL = (const int*)(ws + WS_TOKL); S.Bt = (const char*)(ws + WS_WGUT);
    S.prepare(tab, p.chunk);
    EpiGU E{(bf16_t*)(ws + WS_ACT), (const int*)(ws + WS_TOKL), (const float*)(ws + WS_TW), (const GP_LAS int*)tab};
    gp::gemm_phase<EpiGU, MoeSched, true, true>(p.chunk, (GP_LAS unsigned char*)smem, (const char*)(ws + WS_H2), D / 2, S, E);
}
__device__ __forceinline__ void ph_moe_down(const Params& p, unsigned char* smem, int c) {
    unsigned char* ws = p.ws;
    int* tab = (int*)(smem + gp::STAGE_BYTES);
    build_moe(p, tab);
    MoeSched S; S.tab = (const GP_LAS int*)tab; S.G = gridDim.x; S.c = (gridDim.x % 8 == 0) ? (int)((blockIdx.x % 8) * (gridDim.x / 8) + blockIdx.x / 8) : (int)blockIdx.x;   S.ntn = 4; S.U = __builtin_amdgcn_readfirstlane(tab[T_DUP + 66 * c + 65]); S.down = 1; S.chunk = c;
    S.TOKL = nullptr; S.Bt = (const char*)(ws + WS_WDT);
    S.prepare(tab, p.chunk);
    EpiDown E{ws};
    gp::gemm_phase<EpiDown, MoeSched, false>(p.chunk, (GP_LAS unsigned char*)smem, (const char*)(ws + WS_ACT), DE, S, E);
}

__device__ __forceinline__ void ph_final(const Params& p, float* lds, int b) {
    unsigned char* ws = p.ws;
    int* tab = (int*)lds;
    build_moe(p, tab);
    const int tid = otid(), wave = tid >> 6, lane = tid & 63;
    const int gw = blockIdx.x * NWV + wave, GW = gridDim.x * NWV;
    const int* TE = (const int*)(ws + WS_TE); const int* TP = (const int*)(ws + WS_TP);
    const bf16_t* Y = (const bf16_t*)(ws + WS_Y);
    const float* mod = (const float*)(ws + WS_MOD) + b * 6144 + 5 * 1024;
    for (int t = gw; t < SEQ; t += GW) {
        const int m = b * SEQ + t;
        float acc[16];
#pragma unroll
        for (int i = 0; i < 16; ++i) acc[i] = 0.f;
#pragma unroll
        for (int k = 0; k < 9; ++k) {
            int row;
            if (k < 8) { const int e = TE[m * 8 + k]; row = tab[T_YB + 65 * b + e] + TP[m * 8 + k]; }
            else row = tab[T_YB + 65 * b + 64] + t;
            const bf16_t* yr = Y + (size_t)row * D;
#pragma unroll
            for (int j = 0; j < 4; ++j) { const uint2 w = *(const uint2*)(yr + 4 * (lane + 64 * j));
                acc[4 * j] += __uint_as_float(w.x << 16); acc[4 * j + 1] += __uint_as_float(w.x & 0xffff0000u); acc[4 * j + 2] += __uint_as_float(w.y << 16); acc[4 * j + 3] += __uint_as_float(w.y & 0xffff0000u); }
        }
        float ss = 0.f;
#pragma unroll
        for (int i = 0; i < 16; ++i) ss += acc[i] * acc[i];
        ss = wave_sum(ss);
        const float rs = 1.0f / sqrtf(ss * (1.0f / D) + EPS);
#pragma unroll
        for (int j = 0; j < 4; ++j) {
            const int col = 4 * (lane + 64 * j);
            const f32x4 gp = *(const f32x4*)(p.in[I_GFPOST] + col), gt = *(const f32x4*)(mod + col);
            f32x4 x1 = ((const f32x4*)(p.out + (size_t)m * D))[lane + 64 * j];
#pragma unroll
            for (int i = 0; i < 4; ++i) x1[i] += gt[i] * (acc[4 * j + i] * rs * gp[i]);
            ((f32x4*)(p.out + (size_t)m * D))[lane + 64 * j] = x1;
        }
    }
}

#define GAS __attribute__((address_space(1)))
#define LAS __attribute__((address_space(3)))
#define XB_TMO      128
#define XB_XCNT(j)  (256  + 64 * (j))
#define XB_XSUB(j)  (1280 + 64 * (j))
#define XB_XGEN(j)  (2304 + 64 * (j))
#define XB_TOP      3328
#define XB_TOPGEN   3392
#define XCD_BAR_WORDS 3456
#define XB_SPIN_CAP (1u << 21)
__device__ __forceinline__ unsigned xb_ld(unsigned* p)              { return __hip_atomic_load(p, __ATOMIC_RELAXED, __HIP_MEMORY_SCOPE_AGENT); }
__device__ __forceinline__ unsigned xb_add(unsigned* p, unsigned v) { return __hip_atomic_fetch_add(p, v, __ATOMIC_RELAXED, __HIP_MEMORY_SCOPE_AGENT); }
__device__ __forceinline__ unsigned xb_xcc_id() { return (unsigned)__builtin_amdgcn_s_getreg((3 << 11) | 20) & 0xFu; }
#define XB_SPIN(cond, bar) do { unsigned _sp = 0; while (cond) { __builtin_amdgcn_s_sleep(1); \
    if ((++_sp & 255u) == 0u) { if (xb_ld(&(bar)[XB_TMO])) break; if (_sp > XB_SPIN_CAP) { atomicAdd(&(bar)[XB_TMO], 1u); break; } } } } while (0)
struct XcdBarrier { unsigned* bar; unsigned x; volatile LAS unsigned* st; };
__device__ __forceinline__ XcdBarrier xcd_barrier_post(unsigned* bar, volatile LAS unsigned* st, int wv) {
    XcdBarrier b; b.bar = bar; b.x = xb_xcc_id(); b.st = st;
    if (wv == 0 && lane_id() == 0) (void)xb_add(&bar[XB_XCNT(b.x)], 1u);
    return b;
}
__device__ __forceinline__ void xcd_barrier_complete(unsigned* bar, unsigned x, unsigned& nloc, unsigned& nx) {
    const unsigned G = gridDim.x * gridDim.y * gridDim.z;
    unsigned sum, cnt, mine, sp = 0u;
    for (;;) {
        sum = 0u; cnt = 0u; mine = 0u;
#pragma unroll
        for (unsigned j = 0; j < 16; ++j) { const unsigned c = xb_ld(&bar[XB_XCNT(j)]); sum += c; cnt += (c > 0u) ? 1u : 0u; mine = (j == x) ? c : mine; }
        if (sum == G) break;
        __builtin_amdgcn_s_sleep(1);
        if ((++sp & 255u) == 0u) { if (xb_ld(&bar[XB_TMO])) break; if (sp > XB_SPIN_CAP) { atomicAdd(&bar[XB_TMO], 1u); break; } }
    }
    nloc = mine > 0u ? mine : 1u; nx = cnt > 0u ? cnt : 1u;
}
__device__ __forceinline__ void xcd_barrier(const XcdBarrier& b, int wv) {
    asm volatile("s_waitcnt vmcnt(0)" ::: "memory");
    __syncthreads();
    if (wv == 0 && lane_id() == 0) {
        unsigned* bar = b.bar;
        __builtin_amdgcn_s_waitcnt(0);
        unsigned nloc = b.st[0], nx = b.st[1];
        if (nloc == 0u) { xcd_barrier_complete(bar, b.x, nloc, nx); b.st[0] = nloc; b.st[1] = nx; }
        const unsigned old = xb_add(&bar[XB_XSUB(b.x)], 1u);
        const unsigned gen = old / nloc;
        if (old + 1u == (gen + 1u) * nloc) {
            __builtin_amdgcn_fence(__ATOMIC_RELEASE, "agent");
            asm volatile("s_waitcnt vmcnt(0)" ::: "memory");
            const unsigned og = xb_add(&bar[XB_TOP], 1u);
            const unsigned tg = og / nx;
            if (og + 1u == (tg + 1u) * nx) xb_add(&bar[XB_TOPGEN], 1u);
            else XB_SPIN(xb_ld(&bar[XB_TOPGEN]) == tg, bar);
            __builtin_amdgcn_fence(__ATOMIC_ACQUIRE, "agent");
            xb_add(&bar[XB_XGEN(b.x)], 1u);
            asm volatile("s_waitcnt vmcnt(0)" ::: "memory");
        } else {
            XB_SPIN(xb_ld(&bar[XB_XGEN(b.x)]) == gen, bar);
            __builtin_amdgcn_fence(__ATOMIC_ACQUIRE, "agent");
            asm volatile("s_waitcnt vmcnt(0)" ::: "memory");
        }
    }
    __syncthreads();
}

namespace cg = cooperative_groups;
constexpr int LDS_BYTES = 144 * 1024;
typedef const __attribute__((address_space(4))) Params* KP;
__device__ __forceinline__ Params kargs() {
    Params p;
#if defined(__HIP_DEVICE_COMPILE__)
    typedef const __attribute__((address_space(4))) unsigned long long* KQ;
    KQ kq = (KQ)__builtin_amdgcn_kernarg_segment_ptr(); asm volatile("" : "+s"(kq));
    unsigned long long* d = (unsigned long long*)&p;
#pragma unroll
    for (int i = 0; i < (int)(sizeof(Params) / 8); ++i) d[i] = kq[i];
#endif
    return p;
}
#define PH(call) do { Params p = kargs(); p.chunk = wv; call; } while (0)
__global__ void __launch_bounds__(NT) mega_fwd(Params p_unused) {
    extern __shared__ __attribute__((aligned(16))) unsigned char smem[];
    float* lds = (float*)smem;
    volatile LAS unsigned* misc = (volatile LAS unsigned*)((LAS unsigned char*)smem + (LDS_BYTES - 64));
    if (threadIdx.x < 16) misc[threadIdx.x] = 0u;
    __syncthreads();
    unsigned* barw; { const Params p = kargs(); barw = (unsigned*)(p.ws + WS_CTL) + 4096; }
    const int wv = __builtin_amdgcn_readfirstlane(threadIdx.x >> 6);
    const XcdBarrier bar = xcd_barrier_post(barw, misc, wv);
#define SYNC() xcd_barrier(bar, wv)
    PH(ph_prep(p, lds)); PH(ph_prep_weights(p, lds, 0, 0));   SYNC();
    PH(ph_norm1(p));                SYNC();
    PH(ph_inproj(p, smem)); PH(ph_prep_weights(p, lds, 1, (MTOT / 256) * (INW / 256) % (int)gridDim.x));         SYNC();
    PH(ph_attn(p, smem)); PH(ph_fourierA(p, smem));  SYNC();
    PH(ph_fourierB(p, smem));       SYNC();
    PH(ph_outproj(p, smem));        SYNC();
    PH(ph_mid(p, smem));            SYNC();
    PH(ph_moe_gu(p, smem));         SYNC();
#pragma unroll 1
    for (int c = 0; c < BATCH; ++c) {
        PH(ph_moe_down(p, smem, c)); SYNC();
        PH(ph_final(p, lds, c));
        if (c + 1 < BATCH) SYNC();
    }
#undef SYNC
}

extern "C" void kernel_launch(void* const* d_in, const int* in_sizes, int n_in, void* d_out, int out_size, void* d_ws, size_t ws_size, hipStream_t stream) {
    if (n_in != 26 || ws_size < WS_END) { fprintf(stderr, "kernel_launch: unexpected n_in %d / ws %zu\n", n_in, ws_size); return; }
    static int grid_blocks = 0;
    if (!grid_blocks) {
        int dev = 0, cus = 0, per_cu = 0;
        (void)hipGetDevice(&dev);
        (void)hipDeviceGetAttribute(&cus, hipDeviceAttributeMultiprocessorCount, dev);
        (void)hipFuncSetAttribute((const void*)mega_fwd, hipFuncAttributeMaxDynamicSharedMemorySize, LDS_BYTES);
        (void)hipOccupancyMaxActiveBlocksPerMultiprocessor(&per_cu, (const void*)mega_fwd, NT, LDS_BYTES);
        if (per_cu < 1) { fprintf(stderr, "kernel_launch: occupancy query says %d blocks/CU\n", per_cu); per_cu = 1; }
        if (per_cu > 1) per_cu = 1;
        grid_blocks = cus * per_cu;
    }
    Params p{};
    for (int i = 0; i < 26; ++i) p.in[i] = (const float*)d_in[i];
    p.out = (float*)d_out; p.ws = (unsigned char*)d_ws; p.chunk = 0; p.pad = 0;
    (void)hipMemsetAsync((char*)d_ws + WS_CTL, 0, 32768, stream);
    void* args[] = {&p};
    hipError_t e = hipLaunchCooperativeKernel((const void*)mega_fwd, dim3(grid_blocks), dim3(NT), args, LDS_BYTES, stream);
    if (e != hipSuccess) fprintf(stderr, "cooperative launch failed: %s (grid %d)\n", hipGetErrorString(e), grid_blocks);
}
```

```cpp
#include <hip/hip_runtime.h>
#include <hip/hip_cooperative_groups.h>
#include <cstdio>
#include <cstdint>

typedef unsigned short bf16_t;
typedef float f32x4 __attribute__((ext_vector_type(4)));

constexpr int D = 1024, BATCH = 4, SEQ = 8192, T = BATCH * SEQ, CTX = 256, TC = BATCH * CTX;
constexpr int MTOT = T + TC;
constexpr int KVLEN = CTX + SEQ;
constexpr int INW = 2560, NH = 6, QKW = 768, FW = 256;
constexpr int NE = 64, DE = 256, TOPK = 8;
constexpr int NT = 512, NWV = 8;
constexpr int SLOTS_B = 90112;
constexpr float EPS = 1e-6f;
constexpr float LAM_INIT = 0.2f;
constexpr float QSCALE = 0.125f * 1.4426950408889634f;
constexpr float SQS = 0.42466090014400953f;

constexpr size_t MiB = 1u << 20;
constexpr size_t WS_CTL = 0;
constexpr size_t WS_MOD = 1 * MiB;
constexpr size_t WS_TABW = WS_MOD + 128 * 1024;
constexpr size_t WS_ROPE = WS_MOD + 192 * 1024;
constexpr size_t WS_GCS = WS_MOD + 256 * 1024;
constexpr size_t WS_W128E = WS_MOD + 768 * 1024;
constexpr size_t WS_M64E = WS_MOD + 832 * 1024;
constexpr size_t WS_GT = WS_MOD + 864 * 1024;
constexpr size_t WS_WRT = WS_MOD + 512 * 1024;
constexpr size_t WS_WINT = 2 * MiB;
constexpr size_t WS_WOUTT = 7 * MiB;
constexpr size_t WS_WGUT = 9 * MiB;
constexpr size_t WS_WDT = 74 * MiB;
constexpr size_t WS_TE = 107 * MiB;
constexpr size_t WS_TP = 108 * MiB;
constexpr size_t WS_TW = 109 * MiB;
constexpr size_t WS_TOKL = 110 * MiB;
constexpr size_t WS_AO = 118 * MiB;
constexpr size_t WS_ACT = 118 * MiB;
constexpr size_t WS_Q = 182 * MiB;
constexpr size_t WS_K = 230 * MiB;
constexpr size_t WS_V = WS_K + (size_t)BATCH * KVLEN * QKW * 2;
constexpr size_t WS_F = 329 * MiB;
constexpr size_t WS_FY = 361 * MiB;
constexpr size_t WS_HX = 425 * MiB;
constexpr size_t WS_YX = 358 * MiB;
constexpr size_t WS_H2 = 294 * MiB;
constexpr size_t WS_Y = 294 * MiB;
constexpr size_t WS_END = 491 * MiB;

struct Params {
    const float* in[26];
    float* out;
    unsigned char* ws;
    int chunk;
    int pad;
};
enum { I_X = 0, I_C, I_CTX, I_CCTX, I_WMOD, I_BMOD, I_GAPRE, I_GAPOST, I_WIN, I_WF, I_LQ1, I_LK1, I_LQ2, I_LK2, I_GSUB, I_WOUT,
       I_GFPRE, I_GFPOST, I_WR, I_RB, I_WG, I_WU, I_WD, I_WSG, I_WSU, I_WSD };

__device__ __forceinline__ float bf2f(bf16_t v) { return __uint_as_float(((unsigned)v) << 16); }
__device__ __forceinline__ bf16_t f2bf(float f) { unsigned u = __float_as_uint(f); return (bf16_t)((u + 0x7fffu + ((u >> 16) & 1u)) >> 16); }
__device__ __forceinline__ unsigned pk2(float lo, float hi) { return (unsigned)f2bf(lo) | ((unsigned)f2bf(hi) << 16); }
template <int M> __device__ __forceinline__ float sx(float v) { return __int_as_float(__builtin_amdgcn_ds_swizzle(__float_as_int(v), (M << 10) | 0x1f)); }
template <int M> __device__ __forceinline__ int sxi(int v) { return __builtin_amdgcn_ds_swizzle(v, (M << 10) | 0x1f); }
__device__ __forceinline__ float wave_sum(float v) {
    v += sx<1>(v); v += sx<2>(v); v += sx<4>(v); v += sx<8>(v); v += sx<16>(v);
    auto rr = __builtin_amdgcn_permlane32_swap(__float_as_uint(v), __float_as_uint(v), false, false);
    return __uint_as_float(rr[0]) + __uint_as_float(rr[1]);
}
__device__ __forceinline__ float dpp_f(float v, const int ctrl_sel) {
    const int x = __float_as_int(v); int r;
    if (ctrl_sel == 0) r = __builtin_amdgcn_update_dpp(x, x, 0xB1, 0xf, 0xf, false);
    else if (ctrl_sel == 1) r = __builtin_amdgcn_update_dpp(x, x, 0x4E, 0xf, 0xf, false);
    else if (ctrl_sel == 2) r = __builtin_amdgcn_update_dpp(x, x, 0x141, 0xf, 0xf, false);
    else r = __builtin_amdgcn_update_dpp(x, x, 0x140, 0xf, 0xf, false);
    return __int_as_float(r);
}
__device__ __forceinline__ float wave_max(float v) {
    v = fmaxf(v, dpp_f(v, 0)); v = fmaxf(v, dpp_f(v, 1)); v = fmaxf(v, dpp_f(v, 2)); v = fmaxf(v, dpp_f(v, 3));
    const float a = __uint_as_float(__builtin_amdgcn_readlane(__float_as_uint(v), 0)), b = __uint_as_float(__builtin_amdgcn_readlane(__float_as_uint(v), 16));
    const float c = __uint_as_float(__builtin_amdgcn_readlane(__float_as_uint(v), 32)), d = __uint_as_float(__builtin_amdgcn_readlane(__float_as_uint(v), 48));
    return fmaxf(fmaxf(a, b), fmaxf(c, d));
}
__device__ __forceinline__ int lane_id() { int l; asm volatile("v_mbcnt_lo_u32_b32 %0, -1, 0\n\tv_mbcnt_hi_u32_b32 %0, -1, %0" : "=v"(l)); return l; }
__device__ __forceinline__ int otid_w(int wv) { return wv * 64 + lane_id(); }
#define otid() otid_w(p.chunk)
__device__ __forceinline__ float silu_f(float x) { return x / (1.f + expf(-x)); }

__device__ __forceinline__ void ph_prep(const Params& p, float* lds) {
    const int tid = otid(), bid = blockIdx.x, nblk = gridDim.x;
    const int gt = bid * NT + tid, GT = nblk * NT;
    unsigned char* ws = p.ws;
    float2* tabw = (float2*)(ws + WS_TABW);
    for (int i = gt; i < 8192; i += GT) { float s, c; sincospif((float)i * (1.0f / 4096.0f), &s, &c); tabw[i] = make_float2(c, s); }
    float* rope = (float*)(ws + WS_ROPE);
    for (int i = gt; i < 192 * 16; i += GT) {
        const int pos = (i < 2048) ? (i >> 4) : ((i - 2048) >> 4); const int f = i & 15;
        const float inv = powf(10000.0f, -(float)(2 * f) / 32.0f); const float ang = (float)pos * inv;
        const float c = cosf(ang), s = sinf(ang);
        if (i < 2048) { rope[i] = c; rope[2048 + i] = s; } else { rope[4096 + (i - 2048)] = c; rope[4096 + 1024 + (i - 2048)] = s; }
    }
    { bf16_t* gt = (bf16_t*)(ws + WS_GT); const float* wf = p.in[I_WF];
      for (int i = bid * NT + tid; i < 4 * 64 * 128; i += GT) {
        const int g = i >> 13, d = (i >> 7) & 63, part = (i >> 6) & 1, c = i & 63;
        float a = 0.f;
        for (int j = 0; j < 64; ++j) { float s, co; sincospif((float)((c * j) & 63) * (1.0f / 32.0f), &s, &co); a += (part ? s : co) * wf[(g * 64 + j) * 64 + d]; }
        gt[i] = f2bf(a * 0.0013810679320049757f);
      }
      bf16_t* w128 = (bf16_t*)(ws + WS_W128E);
      for (int i = bid * NT + tid; i < 256 * 128; i += GT) { const int kk = i >> 7, n1 = i & 127; float s, co; sincospif((float)(((kk & 127) * n1) & 127) * (1.0f / 64.0f), &s, &co); w128[i] = f2bf(kk < 128 ? co : -s); }
      bf16_t* m64 = (bf16_t*)(ws + WS_M64E);
      for (int i = bid * NT + tid; i < 128 * 128; i += GT) { const int ro = i >> 7, ci = i & 127, po = ro >> 6, k2 = ro & 63, pi = ci >> 6, n2 = ci & 63;
        float s, co; sincospif((float)((k2 * n2) & 63) * (1.0f / 32.0f), &s, &co); m64[i] = f2bf(po == pi ? co : (po == 0 ? s : -s)); }
    }
    {
      bf16_t* wrt = (bf16_t*)(ws + WS_WRT); const float* wr = p.in[I_WR];
      for (int i = gt; i < 64 * 1024; i += GT) {
        const int j = i & 7, ln = (i >> 3) & 63, nb = (i >> 9) & 3, ks = (i >> 11) & 3, wv_ = i >> 13;
        const int e = 16 * nb + (ln & 15), k = wv_ * 128 + ks * 32 + 8 * (ln >> 4) + j;
        const float w = wr[k * 64 + e]; const bf16_t h = f2bf(w);
        const int o = ((((wv_ * 4 + ks) * 4 + nb) * 2) * 64 + ln) * 8 + j;
        wrt[o] = h; wrt[o + 512] = f2bf(w - bf2f(h)); } }
    if (gt == 0) {
        float s1 = 0.f, s2 = 0.f;
        for (int i = 0; i < 64; ++i) { s1 += p.in[I_LQ1][i] * p.in[I_LK1][i]; s2 += p.in[I_LQ2][i] * p.in[I_LK2][i]; }
        ((float*)(ws + WS_CTL))[1024] = expf(s1) - expf(s2) + LAM_INIT;
    }
    float* sc = lds;
    float* red = lds + 5 * 1024;
    for (int i = tid; i < 5 * 1024; i += NT) { const int r = i >> 10, k = i & 1023; const float v = (r < 4) ? p.in[I_C][r * 1024 + k] : p.in[I_CCTX][k]; sc[i] = silu_f(v); }
    __syncthreads();
    const int wave = tid >> 6, lane = tid & 63;
    float* mod = (float*)(ws + WS_MOD);
    for (int task = bid; task < 96; task += nblk) {
        const int col = task * 64 + lane;
        float a0 = 0, a1 = 0, a2 = 0, a3 = 0, a4 = 0;
        const float* wm = p.in[I_WMOD];
#pragma unroll 32
        for (int k = wave * 128; k < wave * 128 + 128; ++k) { const float w = wm[(size_t)k * 6144 + col]; a0 += sc[k] * w; a1 += sc[1024 + k] * w; a2 += sc[2048 + k] * w; a3 += sc[3072 + k] * w; a4 += sc[4096 + k] * w; }
        red[(wave * 5 + 0) * 64 + lane] = a0; red[(wave * 5 + 1) * 64 + lane] = a1; red[(wave * 5 + 2) * 64 + lane] = a2; red[(wave * 5 + 3) * 64 + lane] = a3; red[(wave * 5 + 4) * 64 + lane] = a4;
        __syncthreads();
        if (tid < 320) { const int r = tid >> 6, l = tid & 63; float s = 0.f; for (int w = 0; w < 8; ++w) s += red[(w * 5 + r) * 64 + l]; mod[r * 6144 + task * 64 + l] = s + p.in[I_BMOD][task * 64 + l]; }
        __syncthreads();
    }
}

__device__ __forceinline__ void ph_norm1(const Params& p) {
    const int tid = otid(), wave = tid >> 6, lane = tid & 63;
    const int gw = blockIdx.x * NWV + wave, GW = gridDim.x * NWV;
    const float* mod = (const float*)(p.ws + WS_MOD);
    bf16_t* hx = (bf16_t*)(p.ws + WS_HX);
    const float* g = p.in[I_GAPRE];
    for (int m = gw; m < MTOT; m += GW) {
        const float* src = (m < T) ? p.in[I_X] + (size_t)m * D : p.in[I_CTX] + (size_t)(m - T) * D;
        const int r = (m < T) ? (m >> 13) : 4;
        const float* shift = mod + r * 6144; const float* scale = shift + 1024;
        f32x4 v[4]; float ss = 0.f;
#pragma unroll
        for (int j = 0; j < 4; ++j) { v[j] = ((const f32x4*)src)[lane + 64 * j]; ss += v[j][0] * v[j][0] + v[j][1] * v[j][1] + v[j][2] * v[j][2] + v[j][3] * v[j][3]; }
        ss = wave_sum(ss);
        const float rs = 1.0f / sqrtf(ss * (1.0f / D) + EPS);
#pragma unroll
        for (int j = 0; j < 4; ++j) {
            const int col = 4 * (lane + 64 * j);
            const f32x4 g4 = *(const f32x4*)(g + col), sc4 = *(const f32x4*)(scale + col), sh4 = *(const f32x4*)(shift + col);
            float h[4];
#pragma unroll
            for (int i = 0; i < 4; ++i) h[i] = v[j][i] * rs * g4[i] * (1.f + sc4[i]) + sh4[i];
            uint2 o; o.x = pk2(h[0], h[1]); o.y = pk2(h[2], h[3]);
            *(uint2*)(hx + (size_t)m * D + col) = o;
        }
    }
}

namespace gp {
#define GP_LAS __attribute__((address_space(3)))
typedef short bf16x8 __attribute__((ext_vector_type(8)));
typedef unsigned u32x4 __attribute__((ext_vector_type(4)));
typedef int i32x4 __attribute__((ext_vector_type(4)));
constexpr int BM = 256, BK = 64, HALF = 128, HTB = HALF * BK * 2, STAGE_BYTES = 8 * HTB;
__device__ __forceinline__ int lds_byte(int r, int c) { const int st = (r >> 4) * 2 + (c >> 5), rr = r & 15, cc = c & 31, ob = rr * 64 + cc * 2; return st * 1024 + (ob ^ (((ob >> 9) & 1) << 5)); }
__device__ __forceinline__ void stage_rc(int b, int& R, int& C) { const int st = b / 1024, sb = b % 1024, swz = sb ^ (((sb >> 9) & 1) << 5); R = (st >> 1) * 16 + swz / 64; C = (st & 1) * 32 + (swz % 64) / 2; }
__device__ __forceinline__ int perm32(int rho) { const int n = rho >> 4, i = rho & 15; return 8 * (i >> 2) + 4 * n + (i & 3); }
struct Unit { int pm, pn, e, b, cnt, base; };
__device__ __forceinline__ unsigned cvt_pk_bf16(float lo, float hi) { unsigned r; asm volatile("v_cvt_pk_bf16_f32 %0, %1, %2" : "=v"(r) : "v"(lo), "v"(hi)); return r; }

template <class Epi, class Sched, bool ALIGN_EPI, bool F8 = false>
__device__ __forceinline__ void gemm_phase(const int wv, GP_LAS unsigned char* lds, const char* Abase, const int K, const Sched& S, const Epi& E) {
    const int wid = wv, wr = wid >> 2, wc = wid & 3;
    const int nt = K / BK;
    unsigned voffB[2];
#pragma unroll
    for (int i = 0; i < 2; ++i) { int R, C; stage_rc(otid_w(wv) * 16 + i * 8192, R, C); const int Rb = (R & ~31) + perm32(R & 31); voffB[i] = (unsigned)(Rb * K + C) * 2u; }
#define GP_AOFFS(u, o00, o01, o10, o11) do { int R0, C0, R1, C1; const int t_ = otid_w(wv); stage_rc(t_ * 16, R0, C0); stage_rc(t_ * 16 + 8192, R1, C1); \
        o00 = S.arow(u, R0) + (unsigned)C0 * 2u; o01 = S.arow(u, R1) + (unsigned)C1 * 2u; o10 = S.arow(u, HALF + R0) + (unsigned)C0 * 2u; o11 = S.arow(u, HALF + R1) + (unsigned)C1 * 2u; } while (0)
    const size_t kstep = (size_t)(BK * 2);
    const size_t hstep = (size_t)HALF * K * 2;
    const unsigned ldsw = (unsigned)wid * 1024u;
    int aoff, boff; { const int l_ = lane_id(), fr = l_ & 15, fq = l_ >> 4; aoff = lds_byte(wr * 64 + fr, fq * 8); boff = lds_byte(wc * 32 + fr, fq * 8); }
#define GP_SA(b, h) (((b) * 2 + (h)) * HTB)
#define GP_SB(b, h) ((4 + (b) * 2 + (h)) * HTB)
#define GP_STAGE_B(bufoff, gbase) do { _Pragma("unroll") for (int _i = 0; _i < 2; ++_i) \
        __builtin_amdgcn_global_load_lds((const unsigned*)((const char*)(gbase) + voffB[_i]), (GP_LAS unsigned*)(lds + (bufoff) + ldsw + _i * 8192), 16, 0, 0); } while (0)
#define GP_STAGE_A(bufoff, gbase, o0, o1) do { \
        __builtin_amdgcn_global_load_lds((const unsigned*)((const char*)(gbase) + (o0)), (GP_LAS unsigned*)(lds + (bufoff) + ldsw), 16, 0, 0); \
        __builtin_amdgcn_global_load_lds((const unsigned*)((const char*)(gbase) + (o1)), (GP_LAS unsigned*)(lds + (bufoff) + ldsw + 8192), 16, 0, 0); } while (0)
#define GP_LDA(dst, b, h) do { _Pragma("unroll") for (int m = 0; m < 4; ++m) _Pragma("unroll") for (int k = 0; k < 2; ++k) dst[m][k] = *(const GP_LAS bf16x8*)(lds + GP_SA(b, h) + aoff + m * 2048 + k * 1024); } while (0)
#define GP_LDB(dst, b, h) do { _Pragma("unroll") for (int n = 0; n < 2; ++n) _Pragma("unroll") for (int k = 0; k < 2; ++k) dst[n][k] = *(const GP_LAS bf16x8*)(lds + GP_SB(b, h) + boff + n * 2048 + k * 1024); } while (0)
#define GP_CAT8(x) __builtin_shufflevector(__builtin_bit_cast(i32x4, x[0]), __builtin_bit_cast(i32x4, x[1]), 0, 1, 2, 3, 4, 5, 6, 7)
#define GP_MMA(ai, bj, At, Bt) do { __builtin_amdgcn_s_setprio(1); _Pragma("unroll") for (int m = 0; m < 4; ++m) _Pragma("unroll") for (int n = 0; n < 2; ++n) { \
        if constexpr (F8) acc[ai][bj][m][n] = __builtin_amdgcn_mfma_scale_f32_16x16x128_f8f6f4(GP_CAT8(Bt[n]), GP_CAT8(At[m]), acc[ai][bj][m][n], 0, 0, 0, 0, 0, 0); \
        else { _Pragma("unroll") for (int k = 0; k < 2; ++k) acc[ai][bj][m][n] = __builtin_amdgcn_mfma_f32_16x16x32_bf16(Bt[n][k], At[m][k], acc[ai][bj][m][n], 0, 0, 0); } } \
        __builtin_amdgcn_s_setprio(0); } while (0)
#define GP_WAIT_V(n) asm volatile("s_waitcnt vmcnt(" #n ")" ::: "memory")
#define GP_WAIT_L(n) asm volatile("s_waitcnt lgkmcnt(" #n ")" ::: "memory")
#define GP_BAR __builtin_amdgcn_s_barrier()
#define GP_SCHED __builtin_amdgcn_sched_barrier(0)
    Unit cur, nxt; int ui = 0;
    if (!S.next(0, cur)) return;
    f32x4 acc[2][2][4][2];
#pragma unroll
    for (int a = 0; a < 2; ++a)
#pragma unroll
        for (int b = 0; b < 2; ++b)
#pragma unroll
            for (int m = 0; m < 4; ++m)
#pragma unroll
                for (int n = 0; n < 2; ++n) acc[a][b][m][n] = (f32x4){0.f, 0.f, 0.f, 0.f};
    bf16x8 At[4][2], B0[2][2], B1[2][2];
    unsigned ac00, ac01, ac10, ac11, an00, an01, an10, an11;
    GP_AOFFS(cur, ac00, ac01, ac10, ac11);
    const char* cB = S.bptr(cur);
    GP_STAGE_B(GP_SB(0, 0), cB); GP_STAGE_B(GP_SB(0, 1), cB + hstep); GP_STAGE_A(GP_SA(0, 0), Abase, ac00, ac01); GP_STAGE_A(GP_SA(0, 1), Abase, ac10, ac11);
    if (wr == 1) GP_BAR;
    GP_WAIT_V(2); GP_BAR;
    GP_STAGE_B(GP_SB(1, 0), cB + kstep); GP_STAGE_A(GP_SA(1, 0), Abase + kstep, ac00, ac01); GP_STAGE_B(GP_SB(1, 1), cB + hstep + kstep);
    GP_WAIT_V(6); GP_BAR;
    for (;;) {
        const bool has_next = S.next(ui + 1, nxt);
        if (has_next) { GP_AOFFS(nxt, an00, an01, an10, an11); }
        else { an00 = ac00; an01 = ac01; an10 = ac10; an11 = ac11; }
        const char* nB = has_next ? S.bptr(nxt) : cB;
#pragma unroll 1
        for (int t = 0; t < nt; t += 2) {
            const bool last = (t == nt - 2);
            const char* a1 = Abase + (size_t)(t + 1) * kstep;
            const char* a2 = last ? Abase : Abase + (size_t)(t + 2) * kstep; const char* b2 = last ? nB : cB + (size_t)(t + 2) * kstep;
            const char* a3 = a2 + kstep; const char* b3 = b2 + kstep;
            GP_LDB(B0, 0, 0); GP_LDB(B1, 0, 1); GP_SCHED; GP_LDA(At, 0, 0); GP_STAGE_A(GP_SA(1, 1), a1, ac10, ac11);
            if (last) { ac00 = an00; ac01 = an01; ac10 = an10; ac11 = an11; }
            GP_WAIT_V(8); GP_WAIT_L(0); GP_BAR; GP_MMA(0, 0, At, B0); GP_MMA(0, 1, At, B1); GP_BAR; GP_SCHED;
            GP_LDA(At, 0, 1); GP_STAGE_B(GP_SB(0, 0), b2); GP_STAGE_B(GP_SB(0, 1), b2 + hstep); GP_STAGE_A(GP_SA(0, 0), a2, ac00, ac01);
            GP_WAIT_V(8); GP_WAIT_L(0); GP_BAR; GP_MMA(1, 0, At, B0); GP_MMA(1, 1, At, B1); GP_BAR; GP_SCHED;
            GP_LDB(B0, 1, 0); GP_LDB(B1, 1, 1); GP_SCHED; GP_LDA(At, 1, 0); GP_STAGE_A(GP_SA(0, 1), a2, ac10, ac11);
            GP_WAIT_V(8); GP_WAIT_L(0); GP_BAR; GP_MMA(0, 0, At, B0); GP_MMA(0, 1, At, B1); GP_BAR; GP_SCHED;
            GP_LDA(At, 1, 1); GP_STAGE_B(GP_SB(1, 0), b3); GP_STAGE_B(GP_SB(1, 1), b3 + hstep); GP_STAGE_A(GP_SA(1, 0), a3, ac00, ac01);
            GP_WAIT_V(8); GP_WAIT_L(0); GP_BAR; GP_MMA(1, 0, At, B0); GP_MMA(1, 1, At, B1); GP_BAR; GP_SCHED;
        }
        if constexpr (ALIGN_EPI) { if (wr == 0) GP_BAR; }
        { const int l_ = lane_id(); E(acc, cur, wr, wc, l_ & 15, l_ >> 4); }
        if (!has_next) break;
#pragma unroll
        for (int a = 0; a < 2; ++a)
#pragma unroll
            for (int b = 0; b < 2; ++b)
#pragma unroll
                for (int m = 0; m < 4; ++m)
#pragma unroll
                    for (int n = 0; n < 2; ++n) acc[a][b][m][n] = (f32x4){0.f, 0.f, 0.f, 0.f};
        cur = nxt; cB = nB; ++ui;
        if constexpr (ALIGN_EPI) { if (wr == 1) GP_BAR; }
    }
    GP_WAIT_V(0);
    if constexpr (!ALIGN_EPI) { if (wr == 0) GP_BAR; }
    GP_BAR;
#undef GP_AOFFS
#undef GP_SA
#undef GP_SB
#undef GP_STAGE_A
#undef GP_STAGE_B
#undef GP_LDA
#undef GP_LDB
#undef GP_MMA
#undef GP_CAT8
#undef GP_WAIT_V
#undef GP_WAIT_L
#undef GP_BAR
#undef GP_SCHED
}

struct DenseSched {
    int nM, nN, nwg, G, c, K; const char* Bt;
    __device__ __forceinline__ void init(int M, int N, int K_, const void* Bt_, int G_, int c_) { nM = M / BM; nN = N / BM; nwg = nM * nN; G = G_; c = c_; K = K_; Bt = (const char*)Bt_; }
    __device__ __forceinline__ bool next(int i, Unit& u) const {
        const long L = (long)i * G + c; if (L >= nwg) return false;
        int wgid = (int)L; { const int q = nwg / 8, r = nwg % 8, xcd = wgid % 8, off = wgid / 8; wgid = (xcd < r ? xcd * (q + 1) : r * (q + 1) + (xcd - r) * q) + off; }
        const int nig = 8 * nN, gid = wgid / nig, fm = gid * 8, gsz = (nM - fm) < 8 ? (nM - fm) : 8;
        u.pm = fm + ((wgid % nig) % gsz); u.pn = (wgid % nig) / gsz; u.e = 0; u.b = 0; u.cnt = 0; u.base = 0; return true;
    }
    __device__ __forceinline__ unsigned arow(const Unit& u, int r) const { return (unsigned)(u.pm * BM + r) * (unsigned)(K * 2); }
    __device__ __forceinline__ const char* bptr(const Unit& u) const { return Bt + (size_t)u.pn * BM * K * 2; }
};
}

struct EpiInProj {
    bf16_t* F; bf16_t* Q; bf16_t* Kb; bf16_t* Vb; const float* rope;
    __device__ __forceinline__ void operator()(const f32x4 (&acc)[2][2][4][2], const gp::Unit& u, int wr, int wc, int fr, int fq) const {
        const int pn = u.pn, pm = u.pm; const bool isctx = pm >= T / 256;
        if (isctx && pn < 4) return;
        if (pn >= 7) {
            unsigned char* V8 = (unsigned char*)Vb;
#pragma unroll
            for (int ai = 0; ai < 2; ++ai) {
                const int row0 = pm * 256 + ai * 128 + wr * 64;
                int b, tile;
                if (!isctx) { b = row0 >> 13; tile = (CTX >> 6) + ((row0 & 8191) >> 6); } else { const int j = row0 - T; b = j >> 8; tile = (j & 255) >> 6; }
#pragma unroll
                for (int bj = 0; bj < 2; ++bj) {
                    const int head = (pn - 7) * 2 + bj;
                    unsigned char* dst = V8 + ((size_t)(b * NH + head) * (KVLEN / 64) + tile) * 8192 + wc * 2048 + fq * 64 + (fr >> 3) * 32 + (fr & 1) * 16 + ((fr >> 1) & 3) * 4;
#pragma unroll
                    for (int e = 0; e < 8; ++e) {
                        int w = __builtin_amdgcn_cvt_pk_fp8_f32(acc[ai][bj][0][e >> 2][e & 3], acc[ai][bj][1][e >> 2][e & 3], 0, false);
                        w = __builtin_amdgcn_cvt_pk_fp8_f32(acc[ai][bj][2][e >> 2][e & 3], acc[ai][bj][3][e >> 2][e & 3], w, true);
                        *(int*)(dst + e * 256) = w;
                    }
                }
            }
            return;
        }
        const int axis = wc & 1; const float* ct = rope + (axis ? 4096 : 0); const float* st = rope + (axis ? 4096 + 1024 : 2048);
#pragma unroll
        for (int ai = 0; ai < 2; ++ai)
#pragma unroll
            for (int m = 0; m < 4; ++m) {
                const int row = pm * 256 + ai * 128 + wr * 64 + m * 16 + fr;
                int t, kb, tile;
                if (!isctx) { kb = row >> 13; t = row & 8191; tile = (CTX >> 6) + (t >> 6); } else { const int j = row - T; t = 0; kb = j >> 8; tile = (j & 255) >> 6; }
                const int pos = axis ? (t & 63) : (t >> 6);
#pragma unroll
                for (int bj = 0; bj < 2; ++bj) {
                    const int col0 = pn * 256 + bj * 128 + wc * 32 + fq * 8;
                    f32x4 v0 = acc[ai][bj][m][0], v1 = acc[ai][bj][m][1];
                    if (pn == 0) { gp::u32x4 w; w.x = gp::cvt_pk_bf16(v0[0], v0[1]); w.y = gp::cvt_pk_bf16(v0[2], v0[3]); w.z = gp::cvt_pk_bf16(v1[0], v1[1]); w.w = gp::cvt_pk_bf16(v1[2], v1[3]);
                        *(gp::u32x4*)(F + (size_t)row * 256 + col0) = w; continue; }
                    if (pn < 7 && !isctx) {
                        const f32x4 c0 = *(const f32x4*)(ct + pos * 16 + 8 * (fq & 1)), c1 = *(const f32x4*)(ct + pos * 16 + 8 * (fq & 1) + 4);
                        const f32x4 s0 = *(const f32x4*)(st + pos * 16 + 8 * (fq & 1)), s1 = *(const f32x4*)(st + pos * 16 + 8 * (fq & 1) + 4);
                        const float sg = (fq < 2) ? -1.f : 1.f;
#pragma unroll
                        for (int i = 0; i < 4; ++i) {
                            const auto r0 = __builtin_amdgcn_permlane32_swap(__float_as_uint(v0[i]), __float_as_uint(v0[i]), false, false);
                            const auto r1 = __builtin_amdgcn_permlane32_swap(__float_as_uint(v1[i]), __float_as_uint(v1[i]), false, false);
                            const float p0 = __uint_as_float(fq < 2 ? r0[1] : r0[0]), p1 = __uint_as_float(fq < 2 ? r1[1] : r1[0]);
                            v0[i] = v0[i] * c0[i] + sg * p0 * s0[i]; v1[i] = v1[i] * c1[i] + sg * p1 * s1[i]; }
                    }
                    v0 = v0 * SQS; v1 = v1 * SQS;
                    int w0 = __builtin_amdgcn_cvt_pk_fp8_f32(v0[0], v0[1], 0, false); w0 = __builtin_amdgcn_cvt_pk_fp8_f32(v0[2], v0[3], w0, true);
                    int w1 = __builtin_amdgcn_cvt_pk_fp8_f32(v1[0], v1[1], 0, false); w1 = __builtin_amdgcn_cvt_pk_fp8_f32(v1[2], v1[3], w1, true);
                    unsigned char* d;
                    if (pn < 4) d = (unsigned char*)Q + (size_t)row * QKW + (col0 - 256);
                    else d = (unsigned char*)Kb + ((size_t)(kb * NH + (pn - 4) * 2 + bj) * (KVLEN / 64) + tile) * 8192 + wc * 2048 + m * 512 + fr * 32 + fq * 8;
                    typedef int i32x2_t __attribute__((ext_vector_type(2)));
                    *(i32x2_t*)d = (i32x2_t){w0, w1};
                }
            }
    }
};
struct EpiStoreBf16 {
    bf16_t* O; int ldc;
    __device__ __forceinline__ void operator()(const f32x4 (&acc)[2][2][4][2], const gp::Unit& u, int wr, int wc, int fr, int fq) const {
#pragma unroll
        for (int ai = 0; ai < 2; ++ai)
#pragma unroll
            for (int m = 0; m < 4; ++m) {
                bf16_t* rowp = O + (size_t)(u.pm * 256 + ai * 128 + wr * 64 + m * 16 + fr) * ldc + u.pn * 256 + wc * 32 + fq * 8;
#pragma unroll
                for (int bj = 0; bj < 2; ++bj) { const f32x4 v0 = acc[ai][bj][m][0], v1 = acc[ai][bj][m][1];
                    gp::u32x4 w; w.x = gp::cvt_pk_bf16(v0[0], v0[1]); w.y = gp::cvt_pk_bf16(v0[2], v0[3]); w.z = gp::cvt_pk_bf16(v1[0], v1[1]); w.w = gp::cvt_pk_bf16(v1[2], v1[3]);
                    *(gp::u32x4*)(rowp + bj * 128) = w; }
            }
    }
};

__device__ __forceinline__ void ph_inproj(const Params& p, unsigned char* smem) {
    unsigned char* ws = p.ws;
    gp::DenseSched S; S.init(MTOT, INW, D, ws + WS_WINT, gridDim.x, blockIdx.x);
    EpiInProj E{(bf16_t*)(ws + WS_F), (bf16_t*)(ws + WS_Q), (bf16_t*)(ws + WS_K), (bf16_t*)(ws + WS_V), (const float*)(ws + WS_ROPE)};
    gp::gemm_phase<EpiInProj, gp::DenseSched, true>(p.chunk, (GP_LAS unsigned char*)smem, (const char*)(ws + WS_HX), D, S, E);
}
__device__ __forceinline__ void ph_outproj(const Params& p, unsigned char* smem) {
    unsigned char* ws = p.ws;
    gp::DenseSched S; S.init(T, D, D, ws + WS_WOUTT, gridDim.x, blockIdx.x);
    EpiStoreBf16 E{(bf16_t*)(ws + WS_YX), D};
    gp::gemm_phase<EpiStoreBf16, gp::DenseSched, true>(p.chunk, (GP_LAS unsigned char*)smem, (const char*)(ws + WS_AO), D, S, E);
}

constexpr float GUSCALE = 64.f;
__device__ __forceinline__ void transpose_item8(const float* W, int K, int N, unsigned char* WT, int row_base, int kb, int nb, float* scr, int lane) {
    const int k0 = 64 * kb, n0 = 32 * nb;
    float tv[32];
#pragma unroll
    for (int i = 0; i < 32; ++i) tv[i] = W[(size_t)(k0 + 2 * i + (lane >> 5)) * N + n0 + (lane & 31)];
#pragma unroll
    for (int i = 0; i < 32; ++i) scr[(2 * i + (lane >> 5)) * 33 + (lane & 31)] = tv[i] * GUSCALE;
    asm volatile("s_waitcnt lgkmcnt(0)" ::: "memory");
    const int c = lane & 7;
#pragma unroll
    for (int j = 0; j < 4; ++j) { const int n = (lane >> 3) + 8 * j; const float* s = scr + (8 * c) * 33 + n;
        int w0 = __builtin_amdgcn_cvt_pk_fp8_f32(s[0 * 33], s[1 * 33], 0, false); w0 = __builtin_amdgcn_cvt_pk_fp8_f32(s[2 * 33], s[3 * 33], w0, true);
        int w1 = __builtin_amdgcn_cvt_pk_fp8_f32(s[4 * 33], s[5 * 33], 0, false); w1 = __builtin_amdgcn_cvt_pk_fp8_f32(s[6 * 33], s[7 * 33], w1, true);
        uint2 o; o.x = (unsigned)w0; o.y = (unsigned)w1;
        *(uint2*)(WT + (size_t)(row_base + n0 + n) * K + k0 + 8 * c) = o; }
    asm volatile("s_waitcnt lgkmcnt(0)" ::: "memory");
}
__device__ __forceinline__ void transpose_item(const float* W, int K, int N, bf16_t* WT, int row_base, int kb, int nb, float* scr, int lane) {
    const int k0 = 64 * kb, n0 = 32 * nb;
    float tv[32];
#pragma unroll
    for (int i = 0; i < 32; ++i) tv[i] = W[(size_t)(k0 + 2 * i + (lane >> 5)) * N + n0 + (lane & 31)];
#pragma unroll
    for (int i = 0; i < 32; ++i) scr[(2 * i + (lane >> 5)) * 33 + (lane & 31)] = tv[i];
    asm volatile("s_waitcnt lgkmcnt(0)" ::: "memory");
    const int c = lane & 7;
#pragma unroll
    for (int j = 0; j < 4; ++j) { const int n = (lane >> 3) + 8 * j; const float* s = scr + (8 * c) * 33 + n;
        uint4 o; o.x = pk2(s[0 * 33], s[1 * 33]); o.y = pk2(s[2 * 33], s[3 * 33]); o.z = pk2(s[4 * 33], s[5 * 33]); o.w = pk2(s[6 * 33], s[7 * 33]);
        *(uint4*)(WT + (size_t)(row_base + n0 + n) * K + k0 + 8 * c) = o; }
    asm volatile("s_waitcnt lgkmcnt(0)" ::: "memory");
}
__device__ __forceinline__ void ph_prep_weights(const Params& p, float* lds, const int part, const int first) {
    const int tid = otid(), wave = tid >> 6, lane = tid & 63;
    float* scr = lds + 8192 + wave * (64 * 33);
    if ((int)blockIdx.x < first) return;
    const int gw = ((int)blockIdx.x - first) * NWV + wave, GW = ((int)gridDim.x - first) * NWV;
    unsigned char* ws = p.ws;
    constexpr int I_IN = 16 * 80, I_OUT = 16 * 32, I_GU = 16 * 8, I_D = 4 * 32;
    constexpr int NITEMS = I_IN + I_OUT + 65 * (2 * I_GU + I_D);
    const int it_lo = part ? I_IN + I_OUT : 0, it_hi = part ? NITEMS : I_IN + I_OUT;
    for (int it = it_lo + gw; it < it_hi; it += GW) {
        int r = it;
        if (r < I_IN) { transpose_item(p.in[I_WIN], D, INW, (bf16_t*)(ws + WS_WINT), 0, r / 80, r % 80, scr, lane); continue; } r -= I_IN;
        if (r < I_OUT) { transpose_item(p.in[I_WOUT], D, D, (bf16_t*)(ws + WS_WOUTT), 0, r / 32, r % 32, scr, lane); continue; } r -= I_OUT;
        const int e = r / (2 * I_GU + I_D); r -= e * (2 * I_GU + I_D);
        if (r < 2 * I_GU) {
            const int half = r / I_GU, q = r % I_GU, kb = q / 8, nb = q % 8;
            const float* W = (e < 64) ? p.in[half ? I_WU : I_WG] + (size_t)e * D * DE : p.in[half ? I_WSU : I_WSG];
            const int n0 = 32 * nb, drow = e * 512 + (n0 >> 7) * 256 + half * 128 + (n0 & 127);
            transpose_item8(W, D, DE, ws + WS_WGUT, drow - n0, kb, nb, scr, lane);
        } else {
            r -= 2 * I_GU;
            const float* W = (e < 64) ? p.in[I_WD] + (size_t)e * DE * D : p.in[I_WSD];
            transpose_item(W, DE, D, (bf16_t*)(ws + WS_WDT), e * 1024, r / 32, r % 32, scr, lane);
        }
    }
}

namespace fa {
typedef short bf16x8 __attribute__((ext_vector_type(8)));
typedef short s16x4 __attribute__((ext_vector_type(4)));
typedef float f32x16 __attribute__((ext_vector_type(16)));
typedef unsigned u32x4 __attribute__((ext_vector_type(4)));
constexpr int KVBLK = 64, LDK = QKW;
constexpr float SCALE = 0.125f, THR = 8.f;
constexpr size_t SHM_V = KVBLK * 128 * 2, SHM_K = KVBLK * 128 * 2;
#define KSWZ(row, colB) ((row) * 256 + ((colB) ^ (((row) & 15) << 4)))
#define SBAR() __builtin_amdgcn_sched_barrier(0)
__device__ __forceinline__ int crow(int r, int hi) { return (r & 3) + 8 * (r >> 2) + 4 * hi; }
__device__ __forceinline__ unsigned cvtpk(float lo, float hi) { unsigned r; asm volatile("v_cvt_pk_bf16_f32 %0, %1, %2" : "=v"(r) : "v"(lo), "v"(hi)); return r; }
constexpr float PBIAS = 5.f, THR2 = PBIAS + 3.5f;
template <bool FIRST>
__device__ __forceinline__ void partialSM(f32x16& p0, f32x16& p1, float& m_reg, f32x16& negm, float& alpha) {
  float pmax = p0[0];
#pragma unroll
  for (int r = 1; r < 16; ++r) pmax = fmaxf(pmax, p0[r]);
#pragma unroll
  for (int r = 0; r < 16; ++r) pmax = fmaxf(pmax, p1[r]);
  { auto rr = __builtin_amdgcn_permlane32_swap(__float_as_uint(pmax), __float_as_uint(pmax), false, false);
    pmax = fmaxf(__uint_as_float(rr[0]), __uint_as_float(rr[1])); }
  if (!FIRST && __builtin_expect(__all(pmax <= THR2), 1)) { alpha = 1.f; }
  else { const float dl = FIRST ? pmax - PBIAS : fmaxf(pmax - PBIAS, 0.f); alpha = FIRST ? 0.f : __builtin_amdgcn_exp2f(-dl); m_reg += dl;
#pragma unroll
    for (int r = 0; r < 16; ++r) { p0[r] -= dl; p1[r] -= dl; }
#pragma unroll
    for (int r = 0; r < 16; ++r) negm[r] = -m_reg;
    asm volatile("" : "+v"(negm)); }
#pragma unroll
  for (int r = 0; r < 16; ++r) p0[r] = __builtin_amdgcn_exp2f(p0[r]);
}
typedef int i32x8 __attribute__((ext_vector_type(8)));
__device__ __forceinline__ void finishSM_T(f32x16& p0, f32x16& p1, float alpha, float& l_reg, i32x8& pb) {
#pragma unroll
  for (int r = 0; r < 16; ++r) p1[r] = __builtin_amdgcn_exp2f(p1[r]);
  float ps = 0;
#pragma unroll
  for (int r = 0; r < 16; ++r) ps += p0[r];
#pragma unroll
  for (int r = 0; r < 16; ++r) ps += p1[r];
  { auto rr = __builtin_amdgcn_permlane32_swap(__float_as_uint(ps), __float_as_uint(ps), false, false);
    ps = __uint_as_float(rr[0]) + __uint_as_float(rr[1]); }
  l_reg = l_reg * alpha + ps;
#pragma unroll
  for (int g = 0; g < 4; ++g) {
    int w0 = __builtin_amdgcn_cvt_pk_fp8_f32(p0[4 * g], p0[4 * g + 1], 0, false); w0 = __builtin_amdgcn_cvt_pk_fp8_f32(p0[4 * g + 2], p0[4 * g + 3], w0, true); pb[g] = w0;
    int w1 = __builtin_amdgcn_cvt_pk_fp8_f32(p1[4 * g], p1[4 * g + 1], 0, false); w1 = __builtin_amdgcn_cvt_pk_fp8_f32(p1[4 * g + 2], p1[4 * g + 3], w1, true); pb[4 + g] = w1; }
}
__device__ __forceinline__ void qkt(f32x16& p0, f32x16& p1, const char* Ks, const i32x8 qf, int lane, int mm, const f32x16& negm) {
  const char* kp = Ks + mm * 4096 + lane * 16;
  const u32x4 a0 = *reinterpret_cast<const u32x4*>(kp), a1 = *reinterpret_cast<const u32x4*>(kp + 1024), b0 = *reinterpret_cast<const u32x4*>(kp + 2048), b1 = *reinterpret_cast<const u32x4*>(kp + 3072);
  p0 = __builtin_amdgcn_mfma_scale_f32_32x32x64_f8f6f4((i32x8){(int)a0.x, (int)a0.y, (int)a0.z, (int)a0.w, (int)a1.x, (int)a1.y, (int)a1.z, (int)a1.w}, qf, negm, 0, 0, 0, 0, 0, 0);
  p1 = __builtin_amdgcn_mfma_scale_f32_32x32x64_f8f6f4((i32x8){(int)b0.x, (int)b0.y, (int)b0.z, (int)b0.w, (int)b1.x, (int)b1.y, (int)b1.z, (int)b1.w}, qf, negm, 0, 0, 0, 0, 0, 0);
}
__device__ __forceinline__ int v_st(int k, int c) { const int kk = (k & ~0xC) | ((k & 4) << 1) | ((k & 8) >> 1); return ((kk >> 3) * 4 + (c >> 5)) * 512 + ((kk & 7) * 32 + (c & 31)) * 2; }
__device__ __forceinline__ int v_rd_base(int lane) { return ((lane & 3) << 3) | (((lane >> 2) & 3) << 6) | (((lane >> 4) & 1) << 5) | (((lane >> 5) & 1) << 8); }
constexpr int v_rd_off(int d0, int ks, int half) { return d0 * 512 + ks * 4096 + half * 2048; }
template <int OFF> __device__ __forceinline__ s16x4 tr_read(int vb) {
  s16x4 r; asm volatile("ds_read_b64_tr_b16 %0, %1 offset:%2" : "=&v"(r) : "v"(vb), "i"(OFF) : "memory"); return r;
}
template <int D0> __device__ __forceinline__ void pv_one(f32x16& od, int vb, bf16x8 pa0, bf16x8 pa1, bf16x8 pa2, bf16x8 pa3) {
  const s16x4 l0 = tr_read<v_rd_off(D0, 0, 0)>(vb), h0 = tr_read<v_rd_off(D0, 0, 1)>(vb), l1 = tr_read<v_rd_off(D0, 1, 0)>(vb), h1 = tr_read<v_rd_off(D0, 1, 1)>(vb);
  const s16x4 l2 = tr_read<v_rd_off(D0, 2, 0)>(vb), h2 = tr_read<v_rd_off(D0, 2, 1)>(vb), l3 = tr_read<v_rd_off(D0, 3, 0)>(vb), h3 = tr_read<v_rd_off(D0, 3, 1)>(vb);
  asm volatile("s_waitcnt lgkmcnt(0)" ::: "memory"); SBAR();
#define PK(L, H) (bf16x8){L[0], L[1], L[2], L[3], H[0], H[1], H[2], H[3]}
  od = __builtin_amdgcn_mfma_f32_32x32x16_bf16(pa0, PK(l0, h0), od, 0, 0, 0);
  od = __builtin_amdgcn_mfma_f32_32x32x16_bf16(pa1, PK(l1, h1), od, 0, 0, 0);
  od = __builtin_amdgcn_mfma_f32_32x32x16_bf16(pa2, PK(l2, h2), od, 0, 0, 0);
  od = __builtin_amdgcn_mfma_f32_32x32x16_bf16(pa3, PK(l3, h3), od, 0, 0, 0);
#undef PK
}
__device__ __forceinline__ void pv_d0(f32x16* o, int vb, bf16x8 pa0, bf16x8 pa1, bf16x8 pa2, bf16x8 pa3) {
  pv_one<0>(o[0], vb, pa0, pa1, pa2, pa3); pv_one<1>(o[1], vb, pa0, pa1, pa2, pa3); pv_one<2>(o[2], vb, pa0, pa1, pa2, pa3); pv_one<3>(o[3], vb, pa0, pa1, pa2, pa3);
}

template <int OFF> __device__ __forceinline__ u32x4 rd128(int vb) { u32x4 r; asm volatile("ds_read_b128 %0, %1 offset:%2" : "=&v"(r) : "v"(vb), "i"(OFF) : "memory"); return r; }
#define PV_RD(D0) const u32x4 va##D0 = rd128<D0 * 2048>(vb), vc##D0 = rd128<D0 * 2048 + 1024>(vb); SBAR()
#define PV_MM(D0) do { asm volatile("s_waitcnt lgkmcnt(0)" ::: "memory"); SBAR(); \
    o[D0] = __builtin_amdgcn_mfma_scale_f32_32x32x64_f8f6f4((i32x8){(int)va##D0.x, (int)va##D0.y, (int)va##D0.z, (int)va##D0.w, (int)vc##D0.x, (int)vc##D0.y, (int)vc##D0.z, (int)vc##D0.w}, pb, o[D0], 0, 0, 0, 0, 0, 0); } while (0)
__device__ __forceinline__ float max3f(float a, float b, float c) { float r; asm("v_max3_f32 %0, %1, %2, %3" : "=v"(r) : "v"(a), "v"(b), "v"(c)); return r; }
__device__ __forceinline__ void pv_psm(f32x16* o, int vb, i32x8 pb, f32x16& p0, f32x16& p1, float& m_reg, f32x16& negm, float& alpha) {
  float pmax;
  { PV_RD(0);
    pmax = max3f(p0[0], p0[1], p0[2]);
#pragma unroll
    for (int r = 3; r < 15; r += 2) pmax = max3f(pmax, p0[r], p0[r + 1]);
    pmax = max3f(pmax, p0[15], p1[0]);
    SBAR(); PV_MM(0); }
  { PV_RD(1);
#pragma unroll
    for (int r = 1; r < 15; r += 2) pmax = max3f(pmax, p1[r], p1[r + 1]);
    pmax = max3f(pmax, p1[15], p1[15]);
    { auto rr = __builtin_amdgcn_permlane32_swap(__float_as_uint(pmax), __float_as_uint(pmax), false, false);
      pmax = max3f(__uint_as_float(rr[0]), __uint_as_float(rr[1]), __uint_as_float(rr[1])); }
    if (__builtin_expect(__all(pmax <= THR2), 1)) { alpha = 1.f; }
    else { const float dl = fmaxf(pmax - PBIAS, 0.f); alpha = __builtin_amdgcn_exp2f(-dl); m_reg += dl;
#pragma unroll
      for (int r = 0; r < 16; ++r) { p0[r] -= dl; p1[r] -= dl; }
#pragma unroll
      for (int r = 0; r < 16; ++r) negm[r] = -m_reg;
      asm volatile("" : "+v"(negm)); }
    SBAR(); PV_MM(1); }
  { PV_RD(2);
#pragma unroll
    for (int r = 0; r < 8; ++r) p0[r] = __builtin_amdgcn_exp2f(p0[r]);
    asm volatile("" : "+v"(p0));
    SBAR(); PV_MM(2); }
  { PV_RD(3);
#pragma unroll
    for (int r = 8; r < 16; ++r) p0[r] = __builtin_amdgcn_exp2f(p0[r]);
    asm volatile("" : "+v"(p0));
    SBAR(); PV_MM(3); }
}
__device__ __forceinline__ void pvT_d0(f32x16* o, int vb, i32x8 pb) {
  { PV_RD(0); PV_MM(0); } { PV_RD(1); PV_MM(1); } { PV_RD(2); PV_MM(2); } { PV_RD(3); PV_MM(3); }
}
#undef PV_RD
#undef PV_MM

__device__ __forceinline__ void attn_unit(const unsigned char* __restrict__ Qb, const unsigned char* __restrict__ Kh, const unsigned char* __restrict__ Vh, bf16_t* __restrict__ Ob,
                                          const float* __restrict__ gsub, const float lam, char* lds, const int wv) {
  typedef __attribute__((address_space(3))) unsigned* ldsu_t;
  const int tid = otid_w(wv), wid = wv, lane = tid & 63, r32 = lane & 31, hi = lane >> 5, mm = wid >> 2, wq = wid & 3;
  constexpr int NB = 4;
  constexpr int SHM_V8 = KVBLK * 128;
  char* V_lds = lds; char* K_lds = lds + NB * SHM_V8; constexpr int SHM_K8 = KVBLK * 128;
  float m_reg = 0.f, l_reg = 0; f32x16 o[4] = {}; i32x8 qf; f32x16 negm = {}; asm volatile("" : "+v"(negm));
  const unsigned koff = (unsigned)((2 * (wid >> 2) + (lane >> 5)) * 2048 + (lane & 3) * 512 + (8 * ((wid >> 1) & 1) + 2 * ((lane & 31) >> 3) + ((lane >> 2) & 1)) * 32 + (wid & 1) * 16);
  const unsigned voff = (unsigned)((wid >> 1) * 2048 + (lane & 7) * 256 + ((lane >> 3) & 3) * 64 + (wid & 1) * 32 + (lane >> 5) * 16);
#define DMA(t, buf) do { const char* kb_ = (const char*)(Kh + (size_t)(t) * SHM_K8); const char* vb_ = (const char*)(Vh + (size_t)(t) * SHM_V8); asm volatile("" : "+s"(kb_), "+s"(vb_)); \
    __builtin_amdgcn_global_load_lds((const unsigned*)(kb_ + koff), (ldsu_t)(K_lds + (buf) * SHM_K8 + wid * 1024), 16, 0, 0); \
    __builtin_amdgcn_global_load_lds((const unsigned*)(vb_ + voff), (ldsu_t)(V_lds + (buf) * SHM_V8 + wid * 1024), 16, 0, 0); } while (0)
#define WAIT_BAR(N) asm volatile("s_waitcnt vmcnt(" #N ") lgkmcnt(0)\n\ts_barrier" ::: "memory")
#define RESC(a) do { if (__any((a) < 1.f)) { _Pragma("unroll") for (int d = 0; d < 4; ++d) _Pragma("unroll") for (int r = 0; r < 16; ++r) o[d][r] *= (a); } } while (0)
  DMA(0, 0); DMA(1, 1);
  { const unsigned char* Qw = Qb + (long)(wq * 32 + r32) * QKW + mm * 64 + hi * 32;
    const u32x4 q0 = *reinterpret_cast<const u32x4*>(Qw), q1 = *reinterpret_cast<const u32x4*>(Qw + 16);
    qf = (i32x8){(int)q0.x, (int)q0.y, (int)q0.z, (int)q0.w, (int)q1.x, (int)q1.y, (int)q1.z, (int)q1.w}; }
  const int vb0 = (int)(uintptr_t)V_lds + lane * 16;
  f32x16 pA0, pA1, pB0, pB1; float alA, alB; i32x8 pb; constexpr int NTL = KVLEN / KVBLK;
  WAIT_BAR(0);
  DMA(2, 2);
  qkt(pA0, pA1, K_lds, qf, lane, mm, negm); partialSM<true>(pA0, pA1, m_reg, negm, alA);
  WAIT_BAR(2);
  for (int j = 1; j + 1 < NTL; j += 2) {
    DMA(j + 2, (j + 2) & 3);
    SBAR(); qkt(pB0, pB1, K_lds + (j & 3) * SHM_K8, qf, lane, mm, negm);
    finishSM_T(pA0, pA1, alA, l_reg, pb); SBAR();
    pv_psm(o, vb0 + ((j - 1) & 3) * SHM_V8, pb, pB0, pB1, m_reg, negm, alB);
    RESC(alB);
    WAIT_BAR(2);
    if (j + 3 < NTL) DMA(j + 3, (j + 3) & 3);
    SBAR(); qkt(pA0, pA1, K_lds + ((j + 1) & 3) * SHM_K8, qf, lane, mm, negm);
    finishSM_T(pB0, pB1, alB, l_reg, pb); SBAR();
    pv_psm(o, vb0 + (j & 3) * SHM_V8, pb, pA0, pA1, m_reg, negm, alA);
    RESC(alA);
    if (j + 3 < NTL) WAIT_BAR(2); else WAIT_BAR(0);
  }
  SBAR(); qkt(pB0, pB1, K_lds + ((NTL - 1) & 3) * SHM_K8, qf, lane, mm, negm);
  finishSM_T(pA0, pA1, alA, l_reg, pb); SBAR();
  pv_psm(o, vb0 + ((NTL - 2) & 3) * SHM_V8, pb, pB0, pB1, m_reg, negm, alB);
  RESC(alB);
  finishSM_T(pB0, pB1, alB, l_reg, pb); SBAR();
  pvT_d0(o, vb0 + ((NTL - 1) & 3) * SHM_V8, pb);
#undef DMA
#undef WAIT_BAR
  const float rl = __builtin_amdgcn_rcpf(l_reg) * (mm ? lam : 1.0f);
  __syncthreads();
  constexpr int XS = 132;
  float* X = (float*)lds;
  if (mm == 1) {
#pragma unroll
    for (int r = 0; r < 16; ++r)
#pragma unroll
      for (int d0 = 0; d0 < 4; ++d0) X[(wq * 32 + r32) * XS + d0 * 32 + crow(r, hi)] = o[d0][r] * rl;
  }
  __syncthreads();
  if (mm == 0) {
#pragma unroll
    for (int r = 0; r < 16; ++r)
#pragma unroll
      for (int d0 = 0; d0 < 4; ++d0) { float* xp = X + (wq * 32 + r32) * XS + d0 * 32 + crow(r, hi); *xp = o[d0][r] * rl - *xp; }
  }
  __syncthreads();
  {
    const int row = tid >> 2, seg = tid & 3;
    const float* xr = X + row * XS + seg * 32;
    f32x4 v[8]; float ss = 0.f;
#pragma unroll
    for (int i = 0; i < 8; ++i) { v[i] = *(const f32x4*)(xr + 4 * i); ss += v[i][0] * v[i][0] + v[i][1] * v[i][1] + v[i][2] * v[i][2] + v[i][3] * v[i][3]; }
    ss += sx<1>(ss); ss += sx<2>(ss);
    const float rs = (1.0f - LAM_INIT) / sqrtf(ss * (1.0f / 128.0f) + EPS);
    bf16_t* dst = Ob + (long)row * D + seg * 32;
#pragma unroll
    for (int i = 0; i < 8; i += 2) {
      const f32x4 g0 = *(const f32x4*)(gsub + seg * 32 + 4 * i), g1 = *(const f32x4*)(gsub + seg * 32 + 4 * i + 4);
      u32x4 w; w.x = cvtpk(v[i][0] * rs * g0[0], v[i][1] * rs * g0[1]); w.y = cvtpk(v[i][2] * rs * g0[2], v[i][3] * rs * g0[3]);
      w.z = cvtpk(v[i + 1][0] * rs * g1[0], v[i + 1][1] * rs * g1[1]); w.w = cvtpk(v[i + 1][2] * rs * g1[2], v[i + 1][3] * rs * g1[3]);
      *(u32x4*)(dst + 4 * i) = w;
    }
  }
  __syncthreads();
#undef RESC
}
#undef KSWZ
#undef SBAR
}

__device__ __forceinline__ void ph_attn(const Params& p, unsigned char* smem) {
    unsigned char* ws = p.ws;
    const unsigned char* Q = ws + WS_Q; const unsigned char* Kb = ws + WS_K; const unsigned char* Vb = ws + WS_V;
    bf16_t* AO = (bf16_t*)(ws + WS_AO);
    const float lam = ((const float*)(ws + WS_CTL))[1024];
    const int c = blockIdx.x, G = gridDim.x;
    if (G == 256) {
        const int x = c & 7, s = c >> 3;
        for (int rd = 0; rd < 6; ++rd) {
            const int bh = rd * 4 + (x >> 1), qb = (x & 1) * 32 + s, b = bh / NH, h = bh % NH;
            fa::attn_unit(Q + ((size_t)b * SEQ + qb * 128) * QKW + h * 128, Kb + (size_t)(b * NH + h) * (KVLEN / 64) * 8192, Vb + (size_t)(b * NH + h) * (KVLEN / 64) * 8192,
                          AO + ((size_t)b * SEQ + qb * 128) * D + 256 + h * 128, p.in[I_GSUB], lam, (char*)smem, p.chunk);
        }
    } else {
        for (int u = c; u < BATCH * NH * 64; u += G) {
            const int bh = u >> 6, qb = u & 63, b = bh / NH, h = bh % NH;
            fa::attn_unit(Q + ((size_t)b * SEQ + qb * 128) * QKW + h * 128, Kb + (size_t)(b * NH + h) * (KVLEN / 64) * 8192, Vb + (size_t)(b * NH + h) * (KVLEN / 64) * 8192,
                          AO + ((size_t)b * SEQ + qb * 128) * D + 256 + h * 128, p.in[I_GSUB], lam, (char*)smem, p.chunk);
        }
    }
}

__device__ __forceinline__ void ph_fourierA(const Params& p, unsigned char* smem) {
    using namespace fa;
    unsigned char* ws = p.ws;
    const bf16_t* F = (const bf16_t*)(ws + WS_F); bf16_t* FY = (bf16_t*)(ws + WS_FY); const bf16_t* W = (const bf16_t*)(ws + WS_W128E);
    const int tid = otid(), wid = tid >> 6, lane = tid & 63, r32 = lane & 31, hi = lane >> 5;
    const int sr = tid >> 4, sc = (tid & 15) * 8, vst0 = v_st(sr, sc), vst1 = v_st(32 + sr, sc);
    const int vb0 = (int)(uintptr_t)smem + v_rd_base(lane);
    for (int task = blockIdx.x; task < BATCH * 64; task += gridDim.x) {
        const int b = task >> 6, n2 = task & 63;
        bf16x8 st[4][2];
#pragma unroll
        for (int kt = 0; kt < 2; ++kt)
#pragma unroll
            for (int ct = 0; ct < 2; ++ct) {
                st[kt * 2 + ct][0] = *(const bf16x8*)(F + ((size_t)b * SEQ + 64 * (64 * kt + sr) + n2) * 256 + 128 * ct + sc);
                st[kt * 2 + ct][1] = *(const bf16x8*)(F + ((size_t)b * SEQ + 64 * (64 * kt + 32 + sr) + n2) * 256 + 128 * ct + sc);
            }
        bf16x8 pa[2][4];
#pragma unroll
        for (int kt = 0; kt < 2; ++kt)
#pragma unroll
            for (int ks = 0; ks < 4; ++ks) pa[kt][ks] = *(const bf16x8*)(W + (size_t)(32 * wid + r32) * 128 + 64 * kt + 16 * ks + 8 * hi);
        __syncthreads();
#pragma unroll
        for (int q = 0; q < 4; ++q) { *(bf16x8*)(smem + q * 16384 + vst0) = st[q][0]; *(bf16x8*)(smem + q * 16384 + vst1) = st[q][1]; }
        __syncthreads();
        f32x16 o[2][4] = {};
#pragma unroll
        for (int ct = 0; ct < 2; ++ct)
#pragma unroll
            for (int kt = 0; kt < 2; ++kt) pv_d0(o[ct], vb0 + (kt * 2 + ct) * 16384, pa[kt][0], pa[kt][1], pa[kt][2], pa[kt][3]);
        const int plane = wid >> 2;
#pragma unroll
        for (int r = 0; r < 16; ++r) {
            const int k1 = 32 * (wid & 3) + crow(r, hi);
            bf16_t* dst = FY + ((((size_t)plane * BATCH + b) * 128 + k1) * 64 + n2) * 256 + r32;
#pragma unroll
            for (int ct = 0; ct < 2; ++ct)
#pragma unroll
                for (int d0 = 0; d0 < 4; ++d0) dst[128 * ct + 32 * d0] = f2bf(o[ct][d0][r]);
        }
    }
    __syncthreads();
}
__device__ __forceinline__ void ph_fourierB(const Params& p, unsigned char* smem) {
    using namespace fa;
    unsigned char* ws = p.ws;
    const bf16_t* FY = (const bf16_t*)(ws + WS_FY); const float2* tabw = (const float2*)(ws + WS_TABW);
    const bf16_t* M64 = (const bf16_t*)(ws + WS_M64E); const bf16_t* GT = (const bf16_t*)(ws + WS_GT);
    bf16_t* AO = (bf16_t*)(ws + WS_AO);
    const int tid = otid(), wid = tid >> 6, lane = tid & 63, r32 = lane & 31, hi = lane >> 5;
    const int sr = tid >> 4, sc = (tid & 15) * 8, vst0 = v_st(sr, sc), vst1 = v_st(32 + sr, sc);
    const int vb0 = (int)(uintptr_t)smem + v_rd_base(lane);
    constexpr int XRS = 528;
    unsigned char* XL = smem + 65536;
    const int mt = wid & 3, ctw = wid >> 2;
    for (int task = blockIdx.x; task < BATCH * 128; task += gridDim.x) {
        const int b = task >> 7, k1 = task & 127;
        __syncthreads();
#pragma unroll
        for (int ct = 0; ct < 2; ++ct)
#pragma unroll
            for (int rh = 0; rh < 2; ++rh) {
                const int n2 = sr + 32 * rh;
                const size_t off = ((((size_t)b) * 128 + k1) * 64 + n2) * 256 + 128 * ct + sc;
                const uint4 yr = *(const uint4*)(FY + off), yi = *(const uint4*)(FY + (size_t)BATCH * 128 * 64 * 256 + off);
                const float2 tw = tabw[n2 * k1];
                const unsigned yrw[4] = {yr.x, yr.y, yr.z, yr.w}, yiw[4] = {yi.x, yi.y, yi.z, yi.w};
                unsigned zr[4], zi[4];
#pragma unroll
                for (int q = 0; q < 4; ++q) {
                    const float a0 = __uint_as_float(yrw[q] << 16), a1 = __uint_as_float(yrw[q] & 0xffff0000u), b0 = __uint_as_float(yiw[q] << 16), b1 = __uint_as_float(yiw[q] & 0xffff0000u);
                    zr[q] = pk2(a0 * tw.x + b0 * tw.y, a1 * tw.x + b1 * tw.y); zi[q] = pk2(b0 * tw.x - a0 * tw.y, b1 * tw.x - a1 * tw.y);
                }
                const int vs = rh ? vst1 : vst0;
                *(uint4*)(smem + (0 * 2 + ct) * 16384 + vs) = make_uint4(zr[0], zr[1], zr[2], zr[3]);
                *(uint4*)(smem + (1 * 2 + ct) * 16384 + vs) = make_uint4(zi[0], zi[1], zi[2], zi[3]);
            }
        __syncthreads();
        {
            f32x16 o[4] = {};
#pragma unroll
            for (int kt = 0; kt < 2; ++kt) {
                bf16x8 pa[4];
#pragma unroll
                for (int ks = 0; ks < 4; ++ks) pa[ks] = *(const bf16x8*)(M64 + (size_t)(32 * mt + r32) * 128 + 64 * kt + 16 * ks + 8 * hi);
                pv_d0(o, vb0 + (kt * 2 + ctw) * 16384, pa[0], pa[1], pa[2], pa[3]);
            }
#pragma unroll
            for (int r = 0; r < 16; ++r) {
                const int ro = 32 * mt + crow(r, hi);
                bf16_t* xr = (bf16_t*)(XL + ((ro >> 6) * 64 + (ro & 63)) * XRS) + 128 * ctw + r32;
#pragma unroll
                for (int d0 = 0; d0 < 4; ++d0) xr[32 * d0] = f2bf(o[d0][r]);
            }
        }
        __syncthreads();
#pragma unroll
        for (int tt = 0; tt < 2; ++tt) {
            const int tau = 2 * wid + tt, g = tau >> 2, mt2 = (tau >> 1) & 1, nt2 = tau & 1;
            f32x16 acc = {};
#pragma unroll
            for (int ks8 = 0; ks8 < 8; ++ks8) {
                const int part = ks8 >> 2, cb = ks8 & 3;
                const bf16x8 af = *(const bf16x8*)(XL + (part * 64 + 32 * mt2 + r32) * XRS + (g * 64 + 16 * cb + 8 * hi) * 2);
                const bf16x8 bfr = *(const bf16x8*)(GT + ((size_t)g * 64 + 32 * nt2 + r32) * 128 + part * 64 + 16 * cb + 8 * hi);
                acc = __builtin_amdgcn_mfma_f32_32x32x16_bf16(af, bfr, acc, 0, 0, 0);
            }
#pragma unroll
            for (int r = 0; r < 16; ++r) { const int k2 = 32 * mt2 + crow(r, hi);
                AO[((size_t)b * SEQ + k1 + 128 * k2) * D + g * 64 + 32 * nt2 + r32] = f2bf(acc[r]); }
        }
    }
    __syncthreads();
}

__device__ __forceinline__ void ph_mid(const Params& p, unsigned char* smem) {
    typedef short bf16x8 __attribute__((ext_vector_type(8)));
    unsigned char* ws = p.ws;
    const int tid = otid(), wave = tid >> 6, lane = tid & 63, fr = lane & 15, fq = lane >> 4;
    const float* mod = (const float*)(ws + WS_MOD);
    const bf16_t* YX = (const bf16_t*)(ws + WS_YX);
    unsigned char* H2 = ws + WS_H2;
    unsigned* counts = (unsigned*)(ws + WS_CTL);
    int* TE = (int*)(ws + WS_TE); int* TP = (int*)(ws + WS_TP); float* TW = (float*)(ws + WS_TW); int* TOKL = (int*)(ws + WS_TOKL);
    constexpr int RS = 2064;
    unsigned char* Ahi = smem; unsigned char* Alo = smem + 16 * RS; float* Pp = (float*)(smem + 2 * 16 * RS + 512);
    const float rbias = p.in[I_RB][lane];
    int* lcnt = (int*)(smem + 99328); int* gb = lcnt + 64; int* PE = gb + 64; float* PW = (float*)(PE + 1024); float* PV = PW + 1024;
    for (int chunk = blockIdx.x; chunk < T / 128; chunk += gridDim.x) {
      const int mc = chunk * 128, b = mc >> 13;
      if (tid < 64) lcnt[tid] = 0;
      {
          const float* mrow_ = mod + b * 6144;
          for (int i = tid; i < 5 * 256; i += NT) { const int v_ = i >> 8, q_ = (i & 255) * 4;
              const float* s_ = (v_ == 0) ? p.in[I_GAPOST] + q_ : (v_ == 1) ? mrow_ + 2 * 1024 + q_ : (v_ == 2) ? p.in[I_GFPRE] + q_ : (v_ == 3) ? mrow_ + 3 * 1024 + q_ : mrow_ + 4 * 1024 + q_;
              *(f32x4*)(PV + v_ * 1024 + q_) = *(const f32x4*)s_; }
          __syncthreads();
      }
      uint2 yw[2][4]; f32x4 xv[2][4];
#define MID_LOAD(m0_) do { _Pragma("unroll") for (int rr = 0; rr < 2; ++rr) { const int m_ = (m0_) + 2 * wave + rr; _Pragma("unroll") for (int j = 0; j < 4; ++j) { \
          yw[rr][j] = *(const uint2*)(YX + (size_t)m_ * D + 4 * (lane + 64 * j)); xv[rr][j] = ((const f32x4*)(p.in[I_X] + (size_t)m_ * D))[lane + 64 * j]; } } } while (0)
      MID_LOAD(mc);
      for (int it = 0; it < 8; ++it) {
        const int m0 = mc + it * 16;
        {
            float ss[2] = {0.f, 0.f};
#define YV(rr, j, i) ((i) == 0 ? __uint_as_float(yw[rr][j].x << 16) : (i) == 1 ? __uint_as_float(yw[rr][j].x & 0xffff0000u) : (i) == 2 ? __uint_as_float(yw[rr][j].y << 16) : __uint_as_float(yw[rr][j].y & 0xffff0000u))
#pragma unroll
            for (int rr = 0; rr < 2; ++rr) {
#pragma unroll
                for (int j = 0; j < 4; ++j) ss[rr] += YV(rr, j, 0) * YV(rr, j, 0) + YV(rr, j, 1) * YV(rr, j, 1) + YV(rr, j, 2) * YV(rr, j, 2) + YV(rr, j, 3) * YV(rr, j, 3);
                ss[rr] = wave_sum(ss[rr]);
            }
#pragma unroll
            for (int rr = 0; rr < 2; ++rr) {
                const int lr = 2 * wave + rr, m = m0 + lr;
                const float r1 = 1.0f / sqrtf(ss[rr] * (1.0f / D) + EPS);
                float ss2 = 0.f;
#pragma unroll
                for (int j = 0; j < 4; ++j) {
                    const int col = 4 * (lane + 64 * j);
                    const f32x4 gp = *(const f32x4*)(PV + col), gt = *(const f32x4*)(PV + 1024 + col);
#pragma unroll
                    for (int i = 0; i < 4; ++i) { xv[rr][j][i] = xv[rr][j][i] + gt[i] * (YV(rr, j, i) * r1 * gp[i]); ss2 += xv[rr][j][i] * xv[rr][j][i]; }
                    ((f32x4*)(p.out + (size_t)m * D))[lane + 64 * j] = xv[rr][j];
                }
                ss2 = wave_sum(ss2);
                const float r2 = 1.0f / sqrtf(ss2 * (1.0f / D) + EPS);
#pragma unroll
                for (int j = 0; j < 4; ++j) {
                    const int col = 4 * (lane + 64 * j);
                    const f32x4 gp = *(const f32x4*)(PV + 2048 + col), sh = *(const f32x4*)(PV + 3072 + col), sc = *(const f32x4*)(PV + 4096 + col);
                    float h[4]; bf16_t hb[4]; float lo[4];
#pragma unroll
                    for (int i = 0; i < 4; ++i) { h[i] = xv[rr][j][i] * r2 * gp[i] * (1.f + sc[i]) + sh[i]; hb[i] = f2bf(h[i]); lo[i] = h[i] - bf2f(hb[i]); }
                    uint2 o; o.x = (unsigned)hb[0] | ((unsigned)hb[1] << 16); o.y = (unsigned)hb[2] | ((unsigned)hb[3] << 16);
                    { int w8 = __builtin_amdgcn_cvt_pk_fp8_f32(h[0], h[1], 0, false); w8 = __builtin_amdgcn_cvt_pk_fp8_f32(h[2], h[3], w8, true); *(int*)(H2 + (size_t)m * D + col) = w8; }
                    *(uint2*)(Ahi + lr * RS + col * 2) = o;
                    uint2 ol; ol.x = pk2(lo[0], lo[1]); ol.y = pk2(lo[2], lo[3]);
                    *(uint2*)(Alo + lr * RS + col * 2) = ol;
                }
            }
            if (it < 7) MID_LOAD(m0 + 16);
        }
        asm volatile("s_waitcnt lgkmcnt(0)\n\ts_barrier" ::: "memory");
        {
            f32x4 acc[4];
#pragma unroll
            for (int nb = 0; nb < 4; ++nb) acc[nb] = (f32x4){0.f, 0.f, 0.f, 0.f};
            const bf16_t* wrtlo = (const bf16_t*)(ws + WS_WRT); asm volatile("" : "+s"(wrtlo));
#pragma unroll
            for (int ks = 0; ks < 4; ++ks) {
                const int ko = (wave * 128 + ks * 32 + 8 * fq) * 2;
                const bf16x8 ah = *(const bf16x8*)(Ahi + fr * RS + ko), al = *(const bf16x8*)(Alo + fr * RS + ko);
#pragma unroll
                for (int nb = 0; nb < 4; ++nb) {
                    const size_t wo_ = ((size_t)(((wave * 4 + ks) * 4 + nb) * 2) * 64 + lane) * 8;
                    const bf16x8 bhv = *(const bf16x8*)(wrtlo + wo_), bl = *(const bf16x8*)(wrtlo + wo_ + 512);
                    acc[nb] = __builtin_amdgcn_mfma_f32_16x16x32_bf16(ah, bhv, acc[nb], 0, 0, 0);
                    acc[nb] = __builtin_amdgcn_mfma_f32_16x16x32_bf16(ah, bl, acc[nb], 0, 0, 0);
                    acc[nb] = __builtin_amdgcn_mfma_f32_16x16x32_bf16(al, bhv, acc[nb], 0, 0, 0);
                }
            }
#pragma unroll
            for (int nb = 0; nb < 4; ++nb)
#pragma unroll
                for (int j = 0; j < 4; ++j) Pp[(wave * 16 + 4 * fq + j) * 64 + 16 * nb + fr] = acc[nb][j];
        }
        asm volatile("s_waitcnt lgkmcnt(0)\n\ts_barrier" ::: "memory");
#pragma unroll
        for (int rr = 0; rr < 2; ++rr) {
            const int lr = 2 * wave + rr;
            float lg = 0.f;
#pragma unroll
            for (int w = 0; w < 8; ++w) lg += Pp[(w * 16 + lr) * 64 + lane];
            const float score = 1.0f / (1.0f + expf(-lg));
            const float sel = score + rbias;
            float t1 = sel, t2 = -INFINITY;
#define TOP2(M) do { const float o1 = sx<M>(t1), o2 = sx<M>(t2); const float n1 = fmaxf(t1, o1), n2 = fmaxf(fminf(t1, o1), fmaxf(t2, o2)); t1 = n1; t2 = n2; } while (0)
            TOP2(1); TOP2(2); TOP2(4);
#undef TOP2
            const float gs = t1 + t2; const int grp = lane >> 3;
            int gr = 0;
#pragma unroll
            for (int j = 0; j < 8; ++j) { const float sj = __uint_as_float(__builtin_amdgcn_readlane(__float_as_uint(gs), j * 8)); gr += (sj > gs || (sj == gs && j < grp)) ? 1 : 0; }
            const bool gsel = gr < 4;
            float v = gsel ? sel : -INFINITY;
            int rk = TOPK;
#pragma unroll
            for (int it8 = 0; it8 < TOPK; ++it8) {
                const float mx = wave_max(v);
                const unsigned long long eq = __ballot(v == mx);
                const int win = __builtin_ctzll(eq);
                if (lane == win) { rk = it8; v = -INFINITY; }
            }
            const bool chosen = rk < TOPK;
            const float ssum = wave_sum(chosen ? score : 0.f);
            const float w = score / (ssum + 1e-20f) * 2.5f;
            if (chosen) {
                const int lpos = atomicAdd(&lcnt[lane], 1);
                const int idx = (it * 16 + lr) * 8 + rk;
                PE[idx] = lane | (lpos << 8); PW[idx] = w;
            }
        }
      }
      __syncthreads();
      if (tid < 64) { const int c = lcnt[tid]; gb[tid] = c ? (int)atomicAdd(&counts[b * 65 + tid], (unsigned)c) : 0; }
      __syncthreads();
      for (int i = tid; i < 1024; i += NT) {
          const int pe = PE[i], e = pe & 255, pos = gb[e] + (pe >> 8), mk = mc * 8 + i;
          TOKL[((size_t)b * 64 + e) * 8192 + pos] = mk; TE[mk] = e; TP[mk] = pos; TW[mk] = PW[i];
      }
      __syncthreads();
    }
}

constexpr int T_CNT = 0;
constexpr int T_TOT = 256;
constexpr int T_AB = 328;
constexpr int T_OFF = 400;
constexpr int T_GUP = 660;
constexpr int T_YC = 730;
constexpr int T_YB = 990;
constexpr int T_DUP = 1250;
constexpr int T_UL = 1520;
constexpr int T_END = 1520 + 512;
__device__ __forceinline__ int scan_incl(int v, int lane) {
#pragma unroll
    for (int off = 1; off < 64; off <<= 1) { const int t = __builtin_amdgcn_ds_bpermute(((lane - off) & 63) << 2, v); if (lane >= off) v += t; }
    return v;
}
__device__ __forceinline__ void build_moe(const Params& p, int* tab) {
    const unsigned* counts = (const unsigned*)(p.ws + WS_CTL);
    __syncthreads();
    const int tid = otid(), wave = tid >> 6, lane = tid & 63;
    if (wave == 0) {
        const int c0 = (int)counts[0 * 65 + lane], c1 = (int)counts[1 * 65 + lane], c2 = (int)counts[2 * 65 + lane], c3 = (int)counts[3 * 65 + lane];
        tab[T_CNT + 0 * 64 + lane] = c0; tab[T_CNT + 1 * 64 + lane] = c1; tab[T_CNT + 2 * 64 + lane] = c2; tab[T_CNT + 3 * 64 + lane] = c3;
        tab[T_OFF + lane * 4 + 0] = 0; tab[T_OFF + lane * 4 + 1] = c0; tab[T_OFF + lane * 4 + 2] = c0 + c1; tab[T_OFF + lane * 4 + 3] = c0 + c1 + c2;
        const int tot = c0 + c1 + c2 + c3, pad = (tot + 255) & ~255, gu = ((tot + 255) >> 8) * 2;
        const int sp = scan_incl(pad, lane), sg = scan_incl(gu, lane);
        tab[T_TOT + lane] = tot; tab[T_AB + lane] = sp - pad; tab[T_GUP + lane] = sg - gu;
        const int cb[4] = {c0, c1, c2, c3};
#pragma unroll
        for (int b = 0; b < 4; ++b) {
            const int du = ((cb[b] + 255) >> 8) * 4;
            const int sy = scan_incl(cb[b], lane), sd = scan_incl(du, lane);
            tab[T_YB + 65 * b + lane] = sy - cb[b]; tab[T_DUP + 66 * b + lane] = sd - du;
            if (lane == 63) { tab[T_YB + 65 * b + 64] = sy; tab[T_DUP + 66 * b + 64] = sd; tab[T_DUP + 66 * b + 65] = sd + (SEQ / 256) * 4; }
        }
        if (lane == 63) { tab[T_TOT + 64] = T; tab[T_AB + 64] = sp; tab[T_GUP + 64] = sg; tab[T_GUP + 65] = sg + (T / 256) * 2; }
    }
    __syncthreads();
}

__device__ __forceinline__ void moe_decode(const GP_LAS int* tab, int e, int pos_e, int& b, int& pos) {
    const int o1 = tab[T_OFF + e * 4 + 1], o2 = tab[T_OFF + e * 4 + 2], o3 = tab[T_OFF + e * 4 + 3];
    b = (pos_e >= o1 ? 1 : 0) + (pos_e >= o2 ? 1 : 0) + (pos_e >= o3 ? 1 : 0);
    pos = pos_e - (b == 0 ? 0 : (b == 1 ? o1 : (b == 2 ? o2 : o3)));
}
struct MoeSched {
    const GP_LAS int* tab; int G, c, ntn, U, down, chunk; const int* TOKL; const char* Bt;
    __device__ __forceinline__ void prepare(int* tabw, int wv) const {
        if (wv == 0) {
            const int i = lane_id(), L = i * G + c;
            if (L < U) {
                const int pre = down ? T_DUP + 66 * chunk : T_GUP;
                int lo = 0, hi = 64;
                while (lo < hi) { const int mid = (lo + hi + 1) >> 1; if (tabw[pre + mid] <= L) lo = mid; else hi = mid - 1; }
                const int loc = L - tabw[pre + lo];
                int cnt, base, bb;
                if (down) { cnt = (lo < 64) ? tabw[T_CNT + chunk * 64 + (lo & 63)] : SEQ; base = tabw[T_YB + 65 * chunk + lo];
                            bb = tabw[T_AB + lo] + (lo < 64 ? tabw[T_OFF + (lo & 63) * 4 + chunk] : chunk * SEQ); }
                else { cnt = tabw[T_TOT + lo]; base = tabw[T_AB + lo]; bb = 0; }
                int* ul = tabw + T_UL + 8 * i;
                ul[0] = lo; ul[1] = loc / ntn; ul[2] = loc % ntn; ul[3] = cnt; ul[4] = base; ul[5] = bb;
            }
        }
        __syncthreads();
    }
    __device__ __forceinline__ bool next(int i, gp::Unit& u) const {
        if (i * G + c >= U) return false;
        const GP_LAS int* ul = tab + T_UL + 8 * i;
        u.e = __builtin_amdgcn_readfirstlane(ul[0]); u.pm = __builtin_amdgcn_readfirstlane(ul[1]); u.pn = __builtin_amdgcn_readfirstlane(ul[2]);
        u.cnt = __builtin_amdgcn_readfirstlane(ul[3]); u.base = __builtin_amdgcn_readfirstlane(ul[4]); u.b = __builtin_amdgcn_readfirstlane(ul[5]);
        return true;
    }
    __device__ __forceinline__ unsigned arow(const gp::Unit& u, int r) const {
        const int pos_e = u.pm * 256 + r;
        if (down) return (unsigned)(u.b + pos_e) * 512u;
        int tok;
        if (u.e < 64) { int b, pos; moe_decode(tab, u.e, pos_e, b, pos); tok = (pos_e < u.cnt) ? (TOKL[((size_t)b * 64 + u.e) * 8192 + pos] >> 3) : 0; } else tok = pos_e;
        return (unsigned)tok * 1024u;
    }
    __device__ __forceinline__ const char* bptr(const gp::Unit& u) const {
        return down ? Bt + ((size_t)u.e * 1024 + u.pn * 256) * 512 : Bt + ((size_t)u.e * 512 + u.pn * 256) * 1024;
    }
};
struct EpiGU {
    bf16_t* ACT; const int* TOKL; const float* TW; const GP_LAS int* tab;
    __device__ __forceinline__ void operator()(const f32x4 (&acc)[2][2][4][2], const gp::Unit& u, int wr, int wc, int fr, int fq) const {
#pragma unroll
        for (int ai = 0; ai < 2; ++ai)
#pragma unroll
            for (int m = 0; m < 4; ++m) {
                const int pos_e = u.pm * 256 + ai * 128 + wr * 64 + m * 16 + fr;
                if (pos_e < u.cnt) {
                    float w = 1.0f;
                    if (u.e < 64) { int b, pos; moe_decode(tab, u.e, pos_e, b, pos); w = TW[TOKL[((size_t)b * 64 + u.e) * 8192 + pos]]; }
                    float a[8];
#pragma unroll
                    for (int n = 0; n < 2; ++n)
#pragma unroll
                        for (int i = 0; i < 4; ++i) { const float g = acc[ai][0][m][n][i] * (1.f / GUSCALE), up = acc[ai][1][m][n][i] * (1.f / GUSCALE);
                            a[4 * n + i] = g * __builtin_amdgcn_rcpf(1.0f + __builtin_amdgcn_exp2f(-1.4426950408889634f * g)) * up * w; }
                    gp::u32x4 o; o.x = gp::cvt_pk_bf16(a[0], a[1]); o.y = gp::cvt_pk_bf16(a[2], a[3]); o.z = gp::cvt_pk_bf16(a[4], a[5]); o.w = gp::cvt_pk_bf16(a[6], a[7]);
                    *(gp::u32x4*)(ACT + ((size_t)u.base + pos_e) * DE + u.pn * 128 + wc * 32 + fq * 8) = o;
                }
            }
    }
};
constexpr float YSCALE = 16.f;
struct EpiDown {
    unsigned char* ws;
    __device__ __forceinline__ void operator()(const f32x4 (&acc)[2][2][4][2], const gp::Unit& u, int wr, int wc, int fr, int fq) const {
#pragma unroll
        for (int ai = 0; ai < 2; ++ai)
#pragma unroll
            for (int m = 0; m < 4; ++m) {
                const int pos = u.pm * 256 + ai * 128 + wr * 64 + m * 16 + fr;
                if (pos < u.cnt) {
                    unsigned char* rowp = ws + WS_Y + (size_t)(u.base + pos) * D + u.pn * 256 + wc * 32 + fq * 8;
#pragma unroll
                    for (int bj = 0; bj < 2; ++bj) { const f32x4 v0 = acc[ai][bj][m][0] * YSCALE, v1 = acc[ai][bj][m][1] * YSCALE;
                        int w0 = __builtin_amdgcn_cvt_pk_fp8_f32(v0[0], v0[1], 0, false); w0 = __builtin_amdgcn_cvt_pk_fp8_f32(v0[2], v0[3], w0, true);
                        int w1 = __builtin_amdgcn_cvt_pk_fp8_f32(v1[0], v1[1], 0, false); w1 = __builtin_amdgcn_cvt_pk_fp8_f32(v1[2], v1[3], w1, true);
                        uint2 o; o.x = (unsigned)w0; o.y = (unsigned)w1;
                        *(uint2*)(rowp + bj * 128) = o; }
                }
            }
    }
};
__device__ __forceinline__ void ph_moe_gu(const Params& p, unsigned char* smem) {
    unsigned char* ws = p.ws;
    int* tab = (int*)(smem + gp::STAGE_BYTES);
    build_moe(p, tab);
    MoeSched S; S.tab = (const GP_LAS int*)tab; S.G = gridDim.x; S.c = (gridDim.x % 8 == 0) ? (int)((blockIdx.x % 8) * (gridDim.x / 8) + blockIdx.x / 8) : (int)blockIdx.x;   S.ntn = 2; S.U = __builtin_amdgcn_readfirstlane(tab[T_GUP + 65]); S.down = 0; S.chunk = 0;
    S.TOKL = (const int*)(ws + WS_TOKL); S.Bt = (const char*)(ws + WS_WGUT);
    S.prepare(tab, p.chunk);
    EpiGU E{(bf16_t*)(ws + WS_ACT), (const int*)(ws + WS_TOKL), (const float*)(ws + WS_TW), (const GP_LAS int*)tab};
    gp::gemm_phase<EpiGU, MoeSched, true, true>(p.chunk, (GP_LAS unsigned char*)smem, (const char*)(ws + WS_H2), D / 2, S, E);
}
__device__ __forceinline__ void ph_moe_down(const Params& p, unsigned char* smem, int c) {
    unsigned char* ws = p.ws;
    int* tab = (int*)(smem + gp::STAGE_BYTES);
    build_moe(p, tab);
    MoeSched S; S.tab = (const GP_LAS int*)tab; S.G = gridDim.x; S.c = (gridDim.x % 8 == 0) ? (int)((blockIdx.x % 8) * (gridDim.x / 8) + blockIdx.x / 8) : (int)blockIdx.x;   S.ntn = 4; S.U = __builtin_amdgcn_readfirstlane(tab[T_DUP + 66 * c + 65]); S.down = 1; S.chunk = c;
    S.TOKL = nullptr; S.Bt = (const char*)(ws + WS_WDT);
    S.prepare(tab, p.chunk);
    EpiDown E{ws};
    gp::gemm_phase<EpiDown, MoeSched, false>(p.chunk, (GP_LAS unsigned char*)smem, (const char*)(ws + WS_ACT), DE, S, E);
}

__device__ __forceinline__ void ph_final(const Params& p, float* lds, int b) {
    unsigned char* ws = p.ws;
    int* tab = (int*)lds;
    build_moe(p, tab);
    const int tid = otid(), wave = tid >> 6, lane = tid & 63;
    const int gw = blockIdx.x * NWV + wave, GW = gridDim.x * NWV;
    const int* TE = (const int*)(ws + WS_TE); const int* TP = (const int*)(ws + WS_TP);
    const unsigned char* Y = ws + WS_Y;
    const float* mod = (const float*)(ws + WS_MOD) + b * 6144 + 5 * 1024;
    for (int t = gw; t < SEQ; t += GW) {
        const int m = b * SEQ + t;
        float acc[16];
#pragma unroll
        for (int i = 0; i < 16; ++i) acc[i] = 0.f;
#pragma unroll
        for (int k = 0; k < 9; ++k) {
            int row;
            if (k < 8) { const int e = TE[m * 8 + k]; row = tab[T_YB + 65 * b + e] + TP[m * 8 + k]; }
            else row = tab[T_YB + 65 * b + 64] + t;
            const unsigned char* yr = Y + (size_t)row * D;
#pragma unroll
            for (int j = 0; j < 4; ++j) { const int w = *(const int*)(yr + 4 * (lane + 64 * j));
                acc[4 * j] += __builtin_amdgcn_cvt_f32_fp8(w, 0); acc[4 * j + 1] += __builtin_amdgcn_cvt_f32_fp8(w, 1); acc[4 * j + 2] += __builtin_amdgcn_cvt_f32_fp8(w, 2); acc[4 * j + 3] += __builtin_amdgcn_cvt_f32_fp8(w, 3); }
        }
        float ss = 0.f;
#pragma unroll
        for (int i = 0; i < 16; ++i) { acc[i] *= (1.f / YSCALE); ss += acc[i] * acc[i]; }
        ss = wave_sum(ss);
        const float rs = 1.0f / sqrtf(ss * (1.0f / D) + EPS);
#pragma unroll
        for (int j = 0; j < 4; ++j) {
            const int col = 4 * (lane + 64 * j);
            const f32x4 gp = *(const f32x4*)(p.in[I_GFPOST] + col), gt = *(const f32x4*)(mod + col);
            f32x4 x1 = ((const f32x4*)(p.out + (size_t)m * D))[lane + 64 * j];
#pragma unroll
            for (int i = 0; i < 4; ++i) x1[i] += gt[i] * (acc[4 * j + i] * rs * gp[i]);
            ((f32x4*)(p.out + (size_t)m * D))[lane + 64 * j] = x1;
        }
    }
}

#define GAS __attribute__((address_space(1)))
#define LAS __attribute__((address_space(3)))
#define XB_TMO      128
#define XB_XCNT(j)  (256  + 64 * (j))
#define XB_XSUB(j)  (1280 + 64 * (j))
#define XB_XGEN(j)  (2304 + 64 * (j))
#define XB_TOP      3328
#define XB_TOPGEN   3392
#define XCD_BAR_WORDS 3456
#define XB_SPIN_CAP (1u << 21)
__device__ __forceinline__ unsigned xb_ld(unsigned* p)              { return __hip_atomic_load(p, __ATOMIC_RELAXED, __HIP_MEMORY_SCOPE_AGENT); }
__device__ __forceinline__ unsigned xb_add(unsigned* p, unsigned v) { return __hip_atomic_fetch_add(p, v, __ATOMIC_RELAXED, __HIP_MEMORY_SCOPE_AGENT); }
__device__ __forceinline__ unsigned xb_xcc_id() { return (unsigned)__builtin_amdgcn_s_getreg((3 << 11) | 20) & 0xFu; }
#define XB_SPIN(cond, bar) do { unsigned _sp = 0; while (cond) { __builtin_amdgcn_s_sleep(1); \
    if ((++_sp & 255u) == 0u) { if (xb_ld(&(bar)[XB_TMO])) break; if (_sp > XB_SPIN_CAP) { atomicAdd(&(bar)[XB_TMO], 1u); break; } } } } while (0)
struct XcdBarrier { unsigned* bar; unsigned x; volatile LAS unsigned* st; };
__device__ __forceinline__ XcdBarrier xcd_barrier_post(unsigned* bar, volatile LAS unsigned* st, int wv) {
    XcdBarrier b; b.bar = bar; b.x = xb_xcc_id(); b.st = st;
    if (wv == 0 && lane_id() == 0) (void)xb_add(&bar[XB_XCNT(b.x)], 1u);
    return b;
}
__device__ __forceinline__ void xcd_barrier_complete(unsigned* bar, unsigned x, unsigned& nloc, unsigned& nx) {
    const unsigned G = gridDim.x * gridDim.y * gridDim.z;
    unsigned sum, cnt, mine, sp = 0u;
    for (;;) {
        sum = 0u; cnt = 0u; mine = 0u;
#pragma unroll
        for (unsigned j = 0; j < 16; ++j) { const unsigned c = xb_ld(&bar[XB_XCNT(j)]); sum += c; cnt += (c > 0u) ? 1u : 0u; mine = (j == x) ? c : mine; }
        if (sum == G) break;
        __builtin_amdgcn_s_sleep(1);
        if ((++sp & 255u) == 0u) { if (xb_ld(&bar[XB_TMO])) break; if (sp > XB_SPIN_CAP) { atomicAdd(&bar[XB_TMO], 1u); break; } }
    }
    nloc = mine > 0u ? mine : 1u; nx = cnt > 0u ? cnt : 1u;
}
__device__ __forceinline__ void xcd_barrier(const XcdBarrier& b, int wv) {
    asm volatile("s_waitcnt vmcnt(0)" ::: "memory");
    __syncthreads();
    if (wv == 0 && lane_id() == 0) {
        unsigned* bar = b.bar;
        __builtin_amdgcn_s_waitcnt(0);
        unsigned nloc = b.st[0], nx = b.st[1];
        if (nloc == 0u) { xcd_barrier_complete(bar, b.x, nloc, nx); b.st[0] = nloc; b.st[1] = nx; }
        const unsigned old = xb_add(&bar[XB_XSUB(b.x)], 1u);
        const unsigned gen = old / nloc;
        if (old + 1u == (gen + 1u) * nloc) {
            __builtin_amdgcn_fence(__ATOMIC_RELEASE, "agent");
            asm volatile("s_waitcnt vmcnt(0)" ::: "memory");
            const unsigned og = xb_add(&bar[XB_TOP], 1u);
            const unsigned tg = og / nx;
            if (og + 1u == (tg + 1u) * nx) xb_add(&bar[XB_TOPGEN], 1u);
            else XB_SPIN(xb_ld(&bar[XB_TOPGEN]) == tg, bar);
            __builtin_amdgcn_fence(__ATOMIC_ACQUIRE, "agent");
            xb_add(&bar[XB_XGEN(b.x)], 1u);
            asm volatile("s_waitcnt vmcnt(0)" ::: "memory");
        } else {
            XB_SPIN(xb_ld(&bar[XB_XGEN(b.x)]) == gen, bar);
            __builtin_amdgcn_fence(__ATOMIC_ACQUIRE, "agent");
            asm volatile("s_waitcnt vmcnt(0)" ::: "memory");
        }
    }
    __syncthreads();
}

namespace cg = cooperative_groups;
constexpr int LDS_BYTES = 144 * 1024;
typedef const __attribute__((address_space(4))) Params* KP;
__device__ __forceinline__ Params kargs() {
    Params p;
#if defined(__HIP_DEVICE_COMPILE__)
    typedef const __attribute__((address_space(4))) unsigned long long* KQ;
    KQ kq = (KQ)__builtin_amdgcn_kernarg_segment_ptr(); asm volatile("" : "+s"(kq));
    unsigned long long* d = (unsigned long long*)&p;
#pragma unroll
    for (int i = 0; i < (int)(sizeof(Params) / 8); ++i) d[i] = kq[i];
#endif
    return p;
}
#define PH(call) do { Params p = kargs(); p.chunk = wv; call; } while (0)
__global__ void __launch_bounds__(NT) mega_fwd(Params p_unused) {
    extern __shared__ __attribute__((aligned(16))) unsigned char smem[];
    float* lds = (float*)smem;
    volatile LAS unsigned* misc = (volatile LAS unsigned*)((LAS unsigned char*)smem + (LDS_BYTES - 64));
    if (threadIdx.x < 16) misc[threadIdx.x] = 0u;
    __syncthreads();
    unsigned* barw; { const Params p = kargs(); barw = (unsigned*)(p.ws + WS_CTL) + 4096; }
    const int wv = __builtin_amdgcn_readfirstlane(threadIdx.x >> 6);
    const XcdBarrier bar = xcd_barrier_post(barw, misc, wv);
#define SYNC() xcd_barrier(bar, wv)
    PH(ph_prep(p, lds)); PH(ph_prep_weights(p, lds, 0, 0));   SYNC();
    PH(ph_norm1(p));                SYNC();
    PH(ph_inproj(p, smem)); PH(ph_prep_weights(p, lds, 1, (MTOT / 256) * (INW / 256) % (int)gridDim.x));         SYNC();
    PH(ph_attn(p, smem)); PH(ph_fourierA(p, smem));  SYNC();
    PH(ph_fourierB(p, smem));       SYNC();
    PH(ph_outproj(p, smem));        SYNC();
    PH(ph_mid(p, smem));            SYNC();
    PH(ph_moe_gu(p, smem));         SYNC();
#pragma unroll 1
    for (int c = 0; c < BATCH; ++c) {
        PH(ph_moe_down(p, smem, c)); SYNC();
        PH(ph_final(p, lds, c));
        if (c + 1 < BATCH) SYNC();
    }
#undef SYNC
}

extern "C" void kernel_launch(void* const* d_in, const int* in_sizes, int n_in, void* d_out, int out_size, void* d_ws, size_t ws_size, hipStream_t stream) {
    if (n_in != 26 || ws_size < WS_END) { fprintf(stderr, "kernel_launch: unexpected n_in %d / ws %zu\n", n_in, ws_size); return; }
    static int grid_blocks = 0;
    if (!grid_blocks) {
        int dev = 0, cus = 0, per_cu = 0;
        (void)hipGetDevice(&dev);
        (void)hipDeviceGetAttribute(&cus, hipDeviceAttributeMultiprocessorCount, dev);
        (void)hipFuncSetAttribute((const void*)mega_fwd, hipFuncAttributeMaxDynamicSharedMemorySize, LDS_BYTES);
        (void)hipOccupancyMaxActiveBlocksPerMultiprocessor(&per_cu, (const void*)mega_fwd, NT, LDS_BYTES);
        if (per_cu < 1) { fprintf(stderr, "kernel_launch: occupancy query says %d blocks/CU\n", per_cu); per_cu = 1; }
        if (per_cu > 1) per_cu = 1;
        grid_blocks = cus * per_cu;
    }
    Params p{};
    for (int i = 0; i < 26; ++i) p.in[i] = (const float*)d_in[i];
    p.out = (float*)d_out; p.ws = (unsigned char*)d_ws; p.chunk = 0; p.pad = 0;
    (void)hipMemsetAsync((char*)d_ws + WS_CTL, 0, 32768, stream);
    void* args[] = {&p};
    hipError_t e = hipLaunchCooperativeKernel((const void*)mega_fwd, dim3(grid_blocks), dim3(NT), args, LDS_BYTES, stream);
    if (e != hipSuccess) fprintf(stderr, "cooperative launch failed: %s (grid %d)\n", hipGetErrorString(e), grid_blocks);
}
```

```cpp
#include <hip/hip_runtime.h>
#include <hip/hip_cooperative_groups.h>
#include <cstdio>
#include <cstdint>

typedef unsigned short bf16_t;
typedef float f32x4 __attribute__((ext_vector_type(4)));

constexpr int D = 1024, BATCH = 4, SEQ = 8192, T = BATCH * SEQ, CTX = 256, TC = BATCH * CTX;
constexpr int MTOT = T + TC;
constexpr int KVLEN = CTX + SEQ;
constexpr int INW = 2560, NH = 6, QKW = 768, FW = 256;
constexpr int NE = 64, DE = 256, TOPK = 8;
constexpr int NT = 512, NWV = 8;
constexpr int SLOTS_B = 90112;
constexpr float EPS = 1e-6f;
constexpr float LAM_INIT = 0.2f;
constexpr float QSCALE = 0.125f * 1.4426950408889634f;
constexpr float SQS = 0.42466090014400953f;

constexpr size_t MiB = 1u << 20;
constexpr size_t WS_CTL = 0;
constexpr size_t WS_MOD = 1 * MiB;
constexpr size_t WS_TABW = WS_MOD + 128 * 1024;
constexpr size_t WS_ROPE = WS_MOD + 192 * 1024;
constexpr size_t WS_GCS = WS_MOD + 256 * 1024;
constexpr size_t WS_W128E = WS_MOD + 768 * 1024;
constexpr size_t WS_M64E = WS_MOD + 832 * 1024;
constexpr size_t WS_GT = WS_MOD + 864 * 1024;
constexpr size_t WS_WRT = WS_MOD + 512 * 1024;
constexpr size_t WS_WINT = 2 * MiB;
constexpr size_t WS_WOUTT = 7 * MiB;
constexpr size_t WS_WGUT = 9 * MiB;
constexpr size_t WS_WDT = 74 * MiB;
constexpr size_t WS_TE = 107 * MiB;
constexpr size_t WS_TP = 108 * MiB;
constexpr size_t WS_TW = 109 * MiB;
constexpr size_t WS_TOKL = 110 * MiB;
constexpr size_t WS_AO = 118 * MiB;
constexpr size_t WS_ACT = 118 * MiB;
constexpr size_t WS_Q = 182 * MiB;
constexpr size_t WS_K = 230 * MiB;
constexpr size_t WS_V = WS_K + (size_t)BATCH * KVLEN * QKW * 2;
constexpr size_t WS_F = 329 * MiB;
constexpr size_t WS_FY = 361 * MiB;
constexpr size_t WS_HX = 425 * MiB;
constexpr size_t WS_YX = 358 * MiB;
constexpr size_t WS_H2 = 294 * MiB;
constexpr size_t WS_Y = 294 * MiB;
constexpr size_t WS_END = 491 * MiB;

struct Params {
    const float* in[26];
    float* out;
    unsigned char* ws;
    int chunk;
    int pad;
};
enum { I_X = 0, I_C, I_CTX, I_CCTX, I_WMOD, I_BMOD, I_GAPRE, I_GAPOST, I_WIN, I_WF, I_LQ1, I_LK1, I_LQ2, I_LK2, I_GSUB, I_WOUT,
       I_GFPRE, I_GFPOST, I_WR, I_RB, I_WG, I_WU, I_WD, I_WSG, I_WSU, I_WSD };

__device__ __forceinline__ float bf2f(bf16_t v) { return __uint_as_float(((unsigned)v) << 16); }
__device__ __forceinline__ bf16_t f2bf(float f) { unsigned u = __float_as_uint(f); return (bf16_t)((u + 0x7fffu + ((u >> 16) & 1u)) >> 16); }
__device__ __forceinline__ unsigned pk2(float lo, float hi) { return (unsigned)f2bf(lo) | ((unsigned)f2bf(hi) << 16); }
template <int M> __device__ __forceinline__ float sx(float v) { return __int_as_float(__builtin_amdgcn_ds_swizzle(__float_as_int(v), (M << 10) | 0x1f)); }
template <int M> __device__ __forceinline__ int sxi(int v) { return __builtin_amdgcn_ds_swizzle(v, (M << 10) | 0x1f); }
__device__ __forceinline__ float wave_sum(float v) {
    v += sx<1>(v); v += sx<2>(v); v += sx<4>(v); v += sx<8>(v); v += sx<16>(v);
    auto rr = __builtin_amdgcn_permlane32_swap(__float_as_uint(v), __float_as_uint(v), false, false);
    return __uint_as_float(rr[0]) + __uint_as_float(rr[1]);
}
__device__ __forceinline__ float dpp_f(float v, const int ctrl_sel) {
    const int x = __float_as_int(v); int r;
    if (ctrl_sel == 0) r = __builtin_amdgcn_update_dpp(x, x, 0xB1, 0xf, 0xf, false);
    else if (ctrl_sel == 1) r = __builtin_amdgcn_update_dpp(x, x, 0x4E, 0xf, 0xf, false);
    else if (ctrl_sel == 2) r = __builtin_amdgcn_update_dpp(x, x, 0x141, 0xf, 0xf, false);
    else r = __builtin_amdgcn_update_dpp(x, x, 0x140, 0xf, 0xf, false);
    return __int_as_float(r);
}
__device__ __forceinline__ float wave_max(float v) {
    v = fmaxf(v, dpp_f(v, 0)); v = fmaxf(v, dpp_f(v, 1)); v = fmaxf(v, dpp_f(v, 2)); v = fmaxf(v, dpp_f(v, 3));
    const float a = __uint_as_float(__builtin_amdgcn_readlane(__float_as_uint(v), 0)), b = __uint_as_float(__builtin_amdgcn_readlane(__float_as_uint(v), 16));
    const float c = __uint_as_float(__builtin_amdgcn_readlane(__float_as_uint(v), 32)), d = __uint_as_float(__builtin_amdgcn_readlane(__float_as_uint(v), 48));
    return fmaxf(fmaxf(a, b), fmaxf(c, d));
}
__device__ __forceinline__ int lane_id() { int l; asm volatile("v_mbcnt_lo_u32_b32 %0, -1, 0\n\tv_mbcnt_hi_u32_b32 %0, -1, %0" : "=v"(l)); return l; }
__device__ __forceinline__ int otid_w(int wv) { return wv * 64 + lane_id(); }
#define otid() otid_w(p.chunk)
__device__ __forceinline__ float silu_f(float x) { return x / (1.f + expf(-x)); }

__device__ __forceinline__ void ph_prep(const Params& p, float* lds) {
    const int tid = otid(), bid = blockIdx.x, nblk = gridDim.x;
    const int gt = bid * NT + tid, GT = nblk * NT;
    unsigned char* ws = p.ws;
    float2* tabw = (float2*)(ws + WS_TABW);
    for (int i = gt; i < 8192; i += GT) { float s, c; sincospif((float)i * (1.0f / 4096.0f), &s, &c); tabw[i] = make_float2(c, s); }
    float* rope = (float*)(ws + WS_ROPE);
    for (int i = gt; i < 192 * 16; i += GT) {
        const int pos = (i < 2048) ? (i >> 4) : ((i - 2048) >> 4); const int f = i & 15;
        const float inv = powf(10000.0f, -(float)(2 * f) / 32.0f); const float ang = (float)pos * inv;
        const float c = cosf(ang), s = sinf(ang);
        if (i < 2048) { rope[i] = c; rope[2048 + i] = s; } else { rope[4096 + (i - 2048)] = c; rope[4096 + 1024 + (i - 2048)] = s; }
    }
    { bf16_t* gt = (bf16_t*)(ws + WS_GT); const float* wf = p.in[I_WF];
      for (int i = bid * NT + tid; i < 4 * 64 * 128; i += GT) {
        const int g = i >> 13, d = (i >> 7) & 63, part = (i >> 6) & 1, c = i & 63;
        float a = 0.f;
        for (int j = 0; j < 64; ++j) { float s, co; sincospif((float)((c * j) & 63) * (1.0f / 32.0f), &s, &co); a += (part ? s : co) * wf[(g * 64 + j) * 64 + d]; }
        gt[i] = f2bf(a * 0.0013810679320049757f);
      }
      bf16_t* w128 = (bf16_t*)(ws + WS_W128E);
      for (int i = bid * NT + tid; i < 256 * 128; i += GT) { const int kk = i >> 7, n1 = i & 127; float s, co; sincospif((float)(((kk & 127) * n1) & 127) * (1.0f / 64.0f), &s, &co); w128[i] = f2bf(kk < 128 ? co : -s); }
      bf16_t* m64 = (bf16_t*)(ws + WS_M64E);
      for (int i = bid * NT + tid; i < 128 * 128; i += GT) { const int ro = i >> 7, ci = i & 127, po = ro >> 6, k2 = ro & 63, pi = ci >> 6, n2 = ci & 63;
        float s, co; sincospif((float)((k2 * n2) & 63) * (1.0f / 32.0f), &s, &co); m64[i] = f2bf(po == pi ? co : (po == 0 ? s : -s)); }
    }
    {
      bf16_t* wrt = (bf16_t*)(ws + WS_WRT); const float* wr = p.in[I_WR];
      for (int i = gt; i < 64 * 1024; i += GT) {
        const int j = i & 7, ln = (i >> 3) & 63, nb = (i >> 9) & 3, ks = (i >> 11) & 3, wv_ = i >> 13;
        const int e = 16 * nb + (ln & 15), k = wv_ * 128 + ks * 32 + 8 * (ln >> 4) + j;
        const float w = wr[k * 64 + e]; const bf16_t h = f2bf(w);
        const int o = ((((wv_ * 4 + ks) * 4 + nb) * 2) * 64 + ln) * 8 + j;
        wrt[o] = h; wrt[o + 512] = f2bf(w - bf2f(h)); } }
    if (gt == 0) {
        float s1 = 0.f, s2 = 0.f;
        for (int i = 0; i < 64; ++i) { s1 += p.in[I_LQ1][i] * p.in[I_LK1][i]; s2 += p.in[I_LQ2][i] * p.in[I_LK2][i]; }
        ((float*)(ws + WS_CTL))[1024] = expf(s1) - expf(s2) + LAM_INIT;
    }
    float* sc = lds;
    float* red = lds + 5 * 1024;
    for (int i = tid; i < 5 * 1024; i += NT) { const int r = i >> 10, k = i & 1023; const float v = (r < 4) ? p.in[I_C][r * 1024 + k] : p.in[I_CCTX][k]; sc[i] = silu_f(v); }
    __syncthreads();
    const int wave = tid >> 6, lane = tid & 63;
    float* mod = (float*)(ws + WS_MOD);
    for (int task = bid; task < 96; task += nblk) {
        const int col = task * 64 + lane;
        float a0 = 0, a1 = 0, a2 = 0, a3 = 0, a4 = 0;
        const float* wm = p.in[I_WMOD];
#pragma unroll 32
        for (int k = wave * 128; k < wave * 128 + 128; ++k) { const float w = wm[(size_t)k * 6144 + col]; a0 += sc[k] * w; a1 += sc[1024 + k] * w; a2 += sc[2048 + k] * w; a3 += sc[3072 + k] * w; a4 += sc[4096 + k] * w; }
        red[(wave * 5 + 0) * 64 + lane] = a0; red[(wave * 5 + 1) * 64 + lane] = a1; red[(wave * 5 + 2) * 64 + lane] = a2; red[(wave * 5 + 3) * 64 + lane] = a3; red[(wave * 5 + 4) * 64 + lane] = a4;
        __syncthreads();
        if (tid < 320) { const int r = tid >> 6, l = tid & 63; float s = 0.f; for (int w = 0; w < 8; ++w) s += red[(w * 5 + r) * 64 + l]; mod[r * 6144 + task * 64 + l] = s + p.in[I_BMOD][task * 64 + l]; }
        __syncthreads();
    }
}

__device__ __forceinline__ void ph_norm1(const Params& p) {
    const int tid = otid(), wave = tid >> 6, lane = tid & 63;
    const int gw = blockIdx.x * NWV + wave, GW = gridDim.x * NWV;
    const float* mod = (const float*)(p.ws + WS_MOD);
    bf16_t* hx = (bf16_t*)(p.ws + WS_HX);
    const float* g = p.in[I_GAPRE];
    for (int m = gw; m < MTOT; m += GW) {
        const float* src = (m < T) ? p.in[I_X] + (size_t)m * D : p.in[I_CTX] + (size_t)(m - T) * D;
        const int r = (m < T) ? (m >> 13) : 4;
        const float* shift = mod + r * 6144; const float* scale = shift + 1024;
        f32x4 v[4]; float ss = 0.f;
#pragma unroll
        for (int j = 0; j < 4; ++j) { v[j] = ((const f32x4*)src)[lane + 64 * j]; ss += v[j][0] * v[j][0] + v[j][1] * v[j][1] + v[j][2] * v[j][2] + v[j][3] * v[j][3]; }
        ss = wave_sum(ss);
        const float rs = 1.0f / sqrtf(ss * (1.0f / D) + EPS);
#pragma unroll
        for (int j = 0; j < 4; ++j) {
            const int col = 4 * (lane + 64 * j);
            const f32x4 g4 = *(const f32x4*)(g + col), sc4 = *(const f32x4*)(scale + col), sh4 = *(const f32x4*)(shift + col);
            float h[4];
#pragma unroll
            for (int i = 0; i < 4; ++i) h[i] = v[j][i] * rs * g4[i] * (1.f + sc4[i]) + sh4[i];
            uint2 o; o.x = pk2(h[0], h[1]); o.y = pk2(h[2], h[3]);
            *(uint2*)(hx + (size_t)m * D + col) = o;
        }
    }
}

namespace gp {
#define GP_LAS __attribute__((address_space(3)))
typedef short bf16x8 __attribute__((ext_vector_type(8)));
typedef unsigned u32x4 __attribute__((ext_vector_type(4)));
typedef int i32x4 __attribute__((ext_vector_type(4)));
constexpr int BM = 256, BK = 64, HALF = 128, HTB = HALF * BK * 2, STAGE_BYTES = 8 * HTB;
__device__ __forceinline__ int lds_byte(int r, int c) { const int st = (r >> 4) * 2 + (c >> 5), rr = r & 15, cc = c & 31, ob = rr * 64 + cc * 2; return st * 1024 + (ob ^ (((ob >> 9) & 1) << 5)); }
__device__ __forceinline__ void stage_rc(int b, int& R, int& C) { const int st = b / 1024, sb = b % 1024, swz = sb ^ (((sb >> 9) & 1) << 5); R = (st >> 1) * 16 + swz / 64; C = (st & 1) * 32 + (swz % 64) / 2; }
__device__ __forceinline__ int perm32(int rho) { const int n = rho >> 4, i = rho & 15; return 8 * (i >> 2) + 4 * n + (i & 3); }
struct Unit { int pm, pn, e, b, cnt, base; };
__device__ __forceinline__ unsigned cvt_pk_bf16(float lo, float hi) { unsigned r; asm volatile("v_cvt_pk_bf16_f32 %0, %1, %2" : "=v"(r) : "v"(lo), "v"(hi)); return r; }

template <class Epi, class Sched, bool ALIGN_EPI, bool F8 = false>
__device__ __forceinline__ void gemm_phase(const int wv, GP_LAS unsigned char* lds, const char* Abase, const int K, const Sched& S, const Epi& E) {
    const int wid = wv, wr = wid >> 2, wc = wid & 3;
    const int nt = K / BK;
    unsigned voffB[2];
#pragma unroll
    for (int i = 0; i < 2; ++i) { int R, C; stage_rc(otid_w(wv) * 16 + i * 8192, R, C); const int Rb = (R & ~31) + perm32(R & 31); voffB[i] = (unsigned)(Rb * K + C) * 2u; }
#define GP_AOFFS(u, o00, o01, o10, o11) do { int R0, C0, R1, C1; const int t_ = otid_w(wv); stage_rc(t_ * 16, R0, C0); stage_rc(t_ * 16 + 8192, R1, C1); \
        o00 = S.arow(u, R0) + (unsigned)C0 * 2u; o01 = S.arow(u, R1) + (unsigned)C1 * 2u; o10 = S.arow(u, HALF + R0) + (unsigned)C0 * 2u; o11 = S.arow(u, HALF + R1) + (unsigned)C1 * 2u; } while (0)
    const size_t kstep = (size_t)(BK * 2);
    const size_t hstep = (size_t)HALF * K * 2;
    const unsigned ldsw = (unsigned)wid * 1024u;
    int aoff, boff; { const int l_ = lane_id(), fr = l_ & 15, fq = l_ >> 4; aoff = lds_byte(wr * 64 + fr, fq * 8); boff = lds_byte(wc * 32 + fr, fq * 8); }
#define GP_SA(b, h) (((b) * 2 + (h)) * HTB)
#define GP_SB(b, h) ((4 + (b) * 2 + (h)) * HTB)
#define GP_STAGE_B(bufoff, gbase) do { _Pragma("unroll") for (int _i = 0; _i < 2; ++_i) \
        __builtin_amdgcn_global_load_lds((const unsigned*)((const char*)(gbase) + voffB[_i]), (GP_LAS unsigned*)(lds + (bufoff) + ldsw + _i * 8192), 16, 0, 0); } while (0)
#define GP_STAGE_A(bufoff, gbase, o0, o1) do { \
        __builtin_amdgcn_global_load_lds((const unsigned*)((const char*)(gbase) + (o0)), (GP_LAS unsigned*)(lds + (bufoff) + ldsw), 16, 0, 0); \
        __builtin_amdgcn_global_load_lds((const unsigned*)((const char*)(gbase) + (o1)), (GP_LAS unsigned*)(lds + (bufoff) + ldsw + 8192), 16, 0, 0); } while (0)
#define GP_LDA(dst, b, h) do { _Pragma("unroll") for (int m = 0; m < 4; ++m) _Pragma("unroll") for (int k = 0; k < 2; ++k) dst[m][k] = *(const GP_LAS bf16x8*)(lds + GP_SA(b, h) + aoff + m * 2048 + k * 1024); } while (0)
#define GP_LDB(dst, b, h) do { _Pragma("unroll") for (int n = 0; n < 2; ++n) _Pragma("unroll") for (int k = 0; k < 2; ++k) dst[n][k] = *(const GP_LAS bf16x8*)(lds + GP_SB(b, h) + boff + n * 2048 + k * 1024); } while (0)
#define GP_CAT8(x) __builtin_shufflevector(__builtin_bit_cast(i32x4, x[0]), __builtin_bit_cast(i32x4, x[1]), 0, 1, 2, 3, 4, 5, 6, 7)
#define GP_MMA(ai, bj, At, Bt) do { __builtin_amdgcn_s_setprio(1); _Pragma("unroll") for (int m = 0; m < 4; ++m) _Pragma("unroll") for (int n = 0; n < 2; ++n) { \
        if constexpr (F8) acc[ai][bj][m][n] = __builtin_amdgcn_mfma_scale_f32_16x16x128_f8f6f4(GP_CAT8(Bt[n]), GP_CAT8(At[m]), acc[ai][bj][m][n], 0, 0, 0, 0, 0, 0); \
        else { _Pragma("unroll") for (int k = 0; k < 2; ++k) acc[ai][bj][m][n] = __builtin_amdgcn_mfma_f32_16x16x32_bf16(Bt[n][k], At[m][k], acc[ai][bj][m][n], 0, 0, 0); } } \
        __builtin_amdgcn_s_setprio(0); } while (0)
#define GP_WAIT_V(n) asm volatile("s_waitcnt vmcnt(" #n ")" ::: "memory")
#define GP_WAIT_L(n) asm volatile("s_waitcnt lgkmcnt(" #n ")" ::: "memory")
#define GP_BAR __builtin_amdgcn_s_barrier()
#define GP_SCHED __builtin_amdgcn_sched_barrier(0)
    Unit cur, nxt; int ui = 0;
    if (!S.next(0, cur)) return;
    f32x4 acc[2][2][4][2];
#pragma unroll
    for (int a = 0; a < 2; ++a)
#pragma unroll
        for (int b = 0; b < 2; ++b)
#pragma unroll
            for (int m = 0; m < 4; ++m)
#pragma unroll
                for (int n = 0; n < 2; ++n) acc[a][b][m][n] = (f32x4){0.f, 0.f, 0.f, 0.f};
    bf16x8 At[4][2], B0[2][2], B1[2][2];
    unsigned ac00, ac01, ac10, ac11, an00, an01, an10, an11;
    GP_AOFFS(cur, ac00, ac01, ac10, ac11);
    const char* cB = S.bptr(cur);
    GP_STAGE_B(GP_SB(0, 0), cB); GP_STAGE_B(GP_SB(0, 1), cB + hstep); GP_STAGE_A(GP_SA(0, 0), Abase, ac00, ac01); GP_STAGE_A(GP_SA(0, 1), Abase, ac10, ac11);
    if (wr == 1) GP_BAR;
    GP_WAIT_V(2); GP_BAR;
    GP_STAGE_B(GP_SB(1, 0), cB + kstep); GP_STAGE_A(GP_SA(1, 0), Abase + kstep, ac00, ac01); GP_STAGE_B(GP_SB(1, 1), cB + hstep + kstep);
    GP_WAIT_V(6); GP_BAR;
    for (;;) {
        const bool has_next = S.next(ui + 1, nxt);
        if (has_next) { GP_AOFFS(nxt, an00, an01, an10, an11); }
        else { an00 = ac00; an01 = ac01; an10 = ac10; an11 = ac11; }
        const char* nB = has_next ? S.bptr(nxt) : cB;
#pragma unroll 1
        for (int t = 0; t < nt; t += 2) {
            const bool last = (t == nt - 2);
            const char* a1 = Abase + (size_t)(t + 1) * kstep;
            const char* a2 = last ? Abase : Abase + (size_t)(t + 2) * kstep; const char* b2 = last ? nB : cB + (size_t)(t + 2) * kstep;
            const char* a3 = a2 + kstep; const char* b3 = b2 + kstep;
            GP_LDB(B0, 0, 0); GP_LDB(B1, 0, 1); GP_SCHED; GP_LDA(At, 0, 0); GP_STAGE_A(GP_SA(1, 1), a1, ac10, ac11);
            if (last) { ac00 = an00; ac01 = an01; ac10 = an10; ac11 = an11; }
            GP_WAIT_V(8); GP_WAIT_L(0); GP_BAR; GP_MMA(0, 0, At, B0); GP_MMA(0, 1, At, B1); GP_BAR; GP_SCHED;
            GP_LDA(At, 0, 1); GP_STAGE_B(GP_SB(0, 0), b2); GP_STAGE_B(GP_SB(0, 1), b2 + hstep); GP_STAGE_A(GP_SA(0, 0), a2, ac00, ac01);
            GP_WAIT_V(8); GP_WAIT_L(0); GP_BAR; GP_MMA(1, 0, At, B0); GP_MMA(1, 1, At, B1); GP_BAR; GP_SCHED;
            GP_LDB(B0, 1, 0); GP_LDB(B1, 1, 1); GP_SCHED; GP_LDA(At, 1, 0); GP_STAGE_A(GP_SA(0, 1), a2, ac10, ac11);
            GP_WAIT_V(8); GP_WAIT_L(0); GP_BAR; GP_MMA(0, 0, At, B0); GP_MMA(0, 1, At, B1); GP_BAR; GP_SCHED;
            GP_LDA(At, 1, 1); GP_STAGE_B(GP_SB(1, 0), b3); GP_STAGE_B(GP_SB(1, 1), b3 + hstep); GP_STAGE_A(GP_SA(1, 0), a3, ac00, ac01);
            GP_WAIT_V(8); GP_WAIT_L(0); GP_BAR; GP_MMA(1, 0, At, B0); GP_MMA(1, 1, At, B1); GP_BAR; GP_SCHED;
        }
        if constexpr (ALIGN_EPI) { if (wr == 0) GP_BAR; }
        { const int l_ = lane_id(); E(acc, cur, wr, wc, l_ & 15, l_ >> 4); }
        if (!has_next) break;
#pragma unroll
        for (int a = 0; a < 2; ++a)
#pragma unroll
            for (int b = 0; b < 2; ++b)
#pragma unroll
                for (int m = 0; m < 4; ++m)
#pragma unroll
                    for (int n = 0; n < 2; ++n) acc[a][b][m][n] = (f32x4){0.f, 0.f, 0.f, 0.f};
        cur = nxt; cB = nB; ++ui;
        if constexpr (ALIGN_EPI) { if (wr == 1) GP_BAR; }
    }
    GP_WAIT_V(0);
    if constexpr (!ALIGN_EPI) { if (wr == 0) GP_BAR; }
    GP_BAR;
#undef GP_AOFFS
#undef GP_SA
#undef GP_SB
#undef GP_STAGE_A
#undef GP_STAGE_B
#undef GP_LDA
#undef GP_LDB
#undef GP_MMA
#undef GP_CAT8
#undef GP_WAIT_V
#undef GP_WAIT_L
#undef GP_BAR
#undef GP_SCHED
}

struct DenseSched {
    int nM, nN, nwg, G, c, K; const char* Bt;
    __device__ __forceinline__ void init(int M, int N, int K_, const void* Bt_, int G_, int c_) { nM = M / BM; nN = N / BM; nwg = nM * nN; G = G_; c = c_; K = K_; Bt = (const char*)Bt_; }
    __device__ __forceinline__ bool next(int i, Unit& u) const {
        const long L = (long)i * G + c; if (L >= nwg) return false;
        int wgid = (int)L; { const int q = nwg / 8, r = nwg % 8, xcd = wgid % 8, off = wgid / 8; wgid = (xcd < r ? xcd * (q + 1) : r * (q + 1) + (xcd - r) * q) + off; }
        const int nig = 8 * nN, gid = wgid / nig, fm = gid * 8, gsz = (nM - fm) < 8 ? (nM - fm) : 8;
        u.pm = fm + ((wgid % nig) % gsz); u.pn = (wgid % nig) / gsz; u.e = 0; u.b = 0; u.cnt = 0; u.base = 0; return true;
    }
    __device__ __forceinline__ unsigned arow(const Unit& u, int r) const { return (unsigned)(u.pm * BM + r) * (unsigned)(K * 2); }
    __device__ __forceinline__ const char* bptr(const Unit& u) const { return Bt + (size_t)u.pn * BM * K * 2; }
};
}

struct EpiInProj {
    bf16_t* F; bf16_t* Q; bf16_t* Kb; bf16_t* Vb; const float* rope;
    __device__ __forceinline__ void operator()(const f32x4 (&acc)[2][2][4][2], const gp::Unit& u, int wr, int wc, int fr, int fq) const {
        const int pn = u.pn, pm = u.pm; const bool isctx = pm >= T / 256;
        if (isctx && pn < 4) return;
        if (pn >= 7) {
            unsigned char* V8 = (unsigned char*)Vb;
#pragma unroll
            for (int ai = 0; ai < 2; ++ai) {
                const int row0 = pm * 256 + ai * 128 + wr * 64;
                int b, tile;
                if (!isctx) { b = row0 >> 13; tile = (CTX >> 6) + ((row0 & 8191) >> 6); } else { const int j = row0 - T; b = j >> 8; tile = (j & 255) >> 6; }
#pragma unroll
                for (int bj = 0; bj < 2; ++bj) {
                    const int head = (pn - 7) * 2 + bj;
                    unsigned char* dst = V8 + ((size_t)(b * NH + head) * (KVLEN / 64) + tile) * 8192 + wc * 2048 + fq * 64 + (fr >> 3) * 32 + (fr & 1) * 16 + ((fr >> 1) & 3) * 4;
#pragma unroll
                    for (int e = 0; e < 8; ++e) {
                        int w = __builtin_amdgcn_cvt_pk_fp8_f32(acc[ai][bj][0][e >> 2][e & 3], acc[ai][bj][1][e >> 2][e & 3], 0, false);
                        w = __builtin_amdgcn_cvt_pk_fp8_f32(acc[ai][bj][2][e >> 2][e & 3], acc[ai][bj][3][e >> 2][e & 3], w, true);
                        *(int*)(dst + e * 256) = w;
                    }
                }
            }
            return;
        }
        const int axis = wc & 1; const float* ct = rope + (axis ? 4096 : 0); const float* st = rope + (axis ? 4096 + 1024 : 2048);
#pragma unroll
        for (int ai = 0; ai < 2; ++ai)
#pragma unroll
            for (int m = 0; m < 4; ++m) {
                const int row = pm * 256 + ai * 128 + wr * 64 + m * 16 + fr;
                int t, kb, tile;
                if (!isctx) { kb = row >> 13; t = row & 8191; tile = (CTX >> 6) + (t >> 6); } else { const int j = row - T; t = 0; kb = j >> 8; tile = (j & 255) >> 6; }
                const int pos = axis ? (t & 63) : (t >> 6);
#pragma unroll
                for (int bj = 0; bj < 2; ++bj) {
                    const int col0 = pn * 256 + bj * 128 + wc * 32 + fq * 8;
                    f32x4 v0 = acc[ai][bj][m][0], v1 = acc[ai][bj][m][1];
                    if (pn == 0) { gp::u32x4 w; w.x = gp::cvt_pk_bf16(v0[0], v0[1]); w.y = gp::cvt_pk_bf16(v0[2], v0[3]); w.z = gp::cvt_pk_bf16(v1[0], v1[1]); w.w = gp::cvt_pk_bf16(v1[2], v1[3]);
                        *(gp::u32x4*)(F + (size_t)row * 256 + col0) = w; continue; }
                    if (pn < 7 && !isctx) {
                        const f32x4 c0 = *(const f32x4*)(ct + pos * 16 + 8 * (fq & 1)), c1 = *(const f32x4*)(ct + pos * 16 + 8 * (fq & 1) + 4);
                        const f32x4 s0 = *(const f32x4*)(st + pos * 16 + 8 * (fq & 1)), s1 = *(const f32x4*)(st + pos * 16 + 8 * (fq & 1) + 4);
                        const float sg = (fq < 2) ? -1.f : 1.f;
#pragma unroll
                        for (int i = 0; i < 4; ++i) {
                            const auto r0 = __builtin_amdgcn_permlane32_swap(__float_as_uint(v0[i]), __float_as_uint(v0[i]), false, false);
                            const auto r1 = __builtin_amdgcn_permlane32_swap(__float_as_uint(v1[i]), __float_as_uint(v1[i]), false, false);
                            const float p0 = __uint_as_float(fq < 2 ? r0[1] : r0[0]), p1 = __uint_as_float(fq < 2 ? r1[1] : r1[0]);
                            v0[i] = v0[i] * c0[i] + sg * p0 * s0[i]; v1[i] = v1[i] * c1[i] + sg * p1 * s1[i]; }
                    }
                    v0 = v0 * SQS; v1 = v1 * SQS;
                    int w0 = __builtin_amdgcn_cvt_pk_fp8_f32(v0[0], v0[1], 0, false); w0 = __builtin_amdgcn_cvt_pk_fp8_f32(v0[2], v0[3], w0, true);
                    int w1 = __builtin_amdgcn_cvt_pk_fp8_f32(v1[0], v1[1], 0, false); w1 = __builtin_amdgcn_cvt_pk_fp8_f32(v1[2], v1[3], w1, true);
                    unsigned char* d;
                    if (pn < 4) d = (unsigned char*)Q + (size_t)row * QKW + (col0 - 256);
                    else d = (unsigned char*)Kb + ((size_t)(kb * NH + (pn - 4) * 2 + bj) * (KVLEN / 64) + tile) * 8192 + wc * 2048 + m * 512 + fr * 32 + fq * 8;
                    typedef int i32x2_t __attribute__((ext_vector_type(2)));
                    *(i32x2_t*)d = (i32x2_t){w0, w1};
                }
            }
    }
};
struct EpiStoreBf16 {
    bf16_t* O; int ldc;
    __device__ __forceinline__ void operator()(const f32x4 (&acc)[2][2][4][2], const gp::Unit& u, int wr, int wc, int fr, int fq) const {
#pragma unroll
        for (int ai = 0; ai < 2; ++ai)
#pragma unroll
            for (int m = 0; m < 4; ++m) {
                bf16_t* rowp = O + (size_t)(u.pm * 256 + ai * 128 + wr * 64 + m * 16 + fr) * ldc + u.pn * 256 + wc * 32 + fq * 8;
#pragma unroll
                for (int bj = 0; bj < 2; ++bj) { const f32x4 v0 = acc[ai][bj][m][0], v1 = acc[ai][bj][m][1];
                    gp::u32x4 w; w.x = gp::cvt_pk_bf16(v0[0], v0[1]); w.y = gp::cvt_pk_bf16(v0[2], v0[3]); w.z = gp::cvt_pk_bf16(v1[0], v1[1]); w.w = gp::cvt_pk_bf16(v1[2], v1[3]);
                    *(gp::u32x4*)(rowp + bj * 128) = w; }
            }
    }
};

__device__ __forceinline__ void ph_inproj(const Params& p, unsigned char* smem) {
    unsigned char* ws = p.ws;
    gp::DenseSched S; S.init(MTOT, INW, D, ws + WS_WINT, gridDim.x, blockIdx.x);
    EpiInProj E{(bf16_t*)(ws + WS_F), (bf16_t*)(ws + WS_Q), (bf16_t*)(ws + WS_K), (bf16_t*)(ws + WS_V), (const float*)(ws + WS_ROPE)};
    gp::gemm_phase<EpiInProj, gp::DenseSched, true>(p.chunk, (GP_LAS unsigned char*)smem, (const char*)(ws + WS_HX), D, S, E);
}
__device__ __forceinline__ void ph_outproj(const Params& p, unsigned char* smem) {
    unsigned char* ws = p.ws;
    gp::DenseSched S; S.init(T, D, D, ws + WS_WOUTT, gridDim.x, blockIdx.x);
    EpiStoreBf16 E{(bf16_t*)(ws + WS_YX), D};
    gp::gemm_phase<EpiStoreBf16, gp::DenseSched, true>(p.chunk, (GP_LAS unsigned char*)smem, (const char*)(ws + WS_AO), D, S, E);
}

constexpr float GUSCALE = 64.f;
__device__ __forceinline__ void transpose_item8(const float* W, int K, int N, unsigned char* WT, int row_base, int kb, int nb, float* scr, int lane) {
    const int k0 = 64 * kb, n0 = 32 * nb;
    float tv[32];
#pragma unroll
    for (int i = 0; i < 32; ++i) tv[i] = W[(size_t)(k0 + 2 * i + (lane >> 5)) * N + n0 + (lane & 31)];
#pragma unroll
    for (int i = 0; i < 32; ++i) scr[(2 * i + (lane >> 5)) * 33 + (lane & 31)] = tv[i] * GUSCALE;
    asm volatile("s_waitcnt lgkmcnt(0)" ::: "memory");
    const int c = lane & 7;
#pragma unroll
    for (int j = 0; j < 4; ++j) { const int n = (lane >> 3) + 8 * j; const float* s = scr + (8 * c) * 33 + n;
        int w0 = __builtin_amdgcn_cvt_pk_fp8_f32(s[0 * 33], s[1 * 33], 0, false); w0 = __builtin_amdgcn_cvt_pk_fp8_f32(s[2 * 33], s[3 * 33], w0, true);
        int w1 = __builtin_amdgcn_cvt_pk_fp8_f32(s[4 * 33], s[5 * 33], 0, false); w1 = __builtin_amdgcn_cvt_pk_fp8_f32(s[6 * 33], s[7 * 33], w1, true);
        uint2 o; o.x = (unsigned)w0; o.y = (unsigned)w1;
        *(uint2*)(WT + (size_t)(row_base + n0 + n) * K + k0 + 8 * c) = o; }
    asm volatile("s_waitcnt lgkmcnt(0)" ::: "memory");
}
__device__ __forceinline__ void transpose_item(const float* W, int K, int N, bf16_t* WT, int row_base, int kb, int nb, float* scr, int lane) {
    const int k0 = 64 * kb, n0 = 32 * nb;
    float tv[32];
#pragma unroll
    for (int i = 0; i < 32; ++i) tv[i] = W[(size_t)(k0 + 2 * i + (lane >> 5)) * N + n0 + (lane & 31)];
#pragma unroll
    for (int i = 0; i < 32; ++i) scr[(2 * i + (lane >> 5)) * 33 + (lane & 31)] = tv[i];
    asm volatile("s_waitcnt lgkmcnt(0)" ::: "memory");
    const int c = lane & 7;
#pragma unroll
    for (int j = 0; j < 4; ++j) { const int n = (lane >> 3) + 8 * j; const float* s = scr + (8 * c) * 33 + n;
        uint4 o; o.x = pk2(s[0 * 33], s[1 * 33]); o.y = pk2(s[2 * 33], s[3 * 33]); o.z = pk2(s[4 * 33], s[5 * 33]); o.w = pk2(s[6 * 33], s[7 * 33]);
        *(uint4*)(WT + (size_t)(row_base + n0 + n) * K + k0 + 8 * c) = o; }
    asm volatile("s_waitcnt lgkmcnt(0)" ::: "memory");
}
__device__ __forceinline__ void ph_prep_weights(const Params& p, float* lds, const int part, const int first) {
    const int tid = otid(), wave = tid >> 6, lane = tid & 63;
    float* scr = lds + 8192 + wave * (64 * 33);
    if ((int)blockIdx.x < first) return;
    const int gw = ((int)blockIdx.x - first) * NWV + wave, GW = ((int)gridDim.x - first) * NWV;
    unsigned char* ws = p.ws;
    constexpr int I_IN = 16 * 80, I_OUT = 16 * 32, I_GU = 16 * 8, I_D = 4 * 32;
    constexpr int NITEMS = I_IN + I_OUT + 65 * (2 * I_GU + I_D);
    const int it_lo = part ? I_IN + I_OUT : 0, it_hi = part ? NITEMS : I_IN + I_OUT;
    for (int it = it_lo + gw; it < it_hi; it += GW) {
        int r = it;
        if (r < I_IN) { transpose_item(p.in[I_WIN], D, INW, (bf16_t*)(ws + WS_WINT), 0, r / 80, r % 80, scr, lane); continue; } r -= I_IN;
        if (r < I_OUT) { transpose_item(p.in[I_WOUT], D, D, (bf16_t*)(ws + WS_WOUTT), 0, r / 32, r % 32, scr, lane); continue; } r -= I_OUT;
        const int e = r / (2 * I_GU + I_D); r -= e * (2 * I_GU + I_D);
        if (r < 2 * I_GU) {
            const int half = r / I_GU, q = r % I_GU, kb = q / 8, nb = q % 8;
            const float* W = (e < 64) ? p.in[half ? I_WU : I_WG] + (size_t)e * D * DE : p.in[half ? I_WSU : I_WSG];
            const int n0 = 32 * nb, drow = e * 512 + (n0 >> 7) * 256 + half * 128 + (n0 & 127);
            transpose_item8(W, D, DE, ws + WS_WGUT, drow - n0, kb, nb, scr, lane);
        } else {
            r -= 2 * I_GU;
            const float* W = (e < 64) ? p.in[I_WD] + (size_t)e * DE * D : p.in[I_WSD];
            transpose_item(W, DE, D, (bf16_t*)(ws + WS_WDT), e * 1024, r / 32, r % 32, scr, lane);
        }
    }
}

namespace fa {
typedef short bf16x8 __attribute__((ext_vector_type(8)));
typedef short s16x4 __attribute__((ext_vector_type(4)));
typedef float f32x16 __attribute__((ext_vector_type(16)));
typedef unsigned u32x4 __attribute__((ext_vector_type(4)));
constexpr int KVBLK = 64, LDK = QKW;
constexpr float SCALE = 0.125f, THR = 8.f;
constexpr size_t SHM_V = KVBLK * 128 * 2, SHM_K = KVBLK * 128 * 2;
#define KSWZ(row, colB) ((row) * 256 + ((colB) ^ (((row) & 15) << 4)))
#define SBAR() __builtin_amdgcn_sched_barrier(0)
__device__ __forceinline__ int crow(int r, int hi) { return (r & 3) + 8 * (r >> 2) + 4 * hi; }
__device__ __forceinline__ unsigned cvtpk(float lo, float hi) { unsigned r; asm volatile("v_cvt_pk_bf16_f32 %0, %1, %2" : "=v"(r) : "v"(lo), "v"(hi)); return r; }
constexpr float PBIAS = 5.f, THR2 = PBIAS + 3.5f;
template <bool FIRST>
__device__ __forceinline__ void partialSM(f32x16& p0, f32x16& p1, float& m_reg, f32x16& negm, float& alpha) {
  float pmax = p0[0];
#pragma unroll
  for (int r = 1; r < 16; ++r) pmax = fmaxf(pmax, p0[r]);
#pragma unroll
  for (int r = 0; r < 16; ++r) pmax = fmaxf(pmax, p1[r]);
  { auto rr = __builtin_amdgcn_permlane32_swap(__float_as_uint(pmax), __float_as_uint(pmax), false, false);
    pmax = fmaxf(__uint_as_float(rr[0]), __uint_as_float(rr[1])); }
  if (!FIRST && __builtin_expect(__all(pmax <= THR2), 1)) { alpha = 1.f; }
  else { const float dl = FIRST ? pmax - PBIAS : fmaxf(pmax - PBIAS, 0.f); alpha = FIRST ? 0.f : __builtin_amdgcn_exp2f(-dl); m_reg += dl;
#pragma unroll
    for (int r = 0; r < 16; ++r) { p0[r] -= dl; p1[r] -= dl; }
#pragma unroll
    for (int r = 0; r < 16; ++r) negm[r] = -m_reg;
    asm volatile("" : "+v"(negm)); }
#pragma unroll
  for (int r = 0; r < 16; ++r) p0[r] = __builtin_amdgcn_exp2f(p0[r]);
}
typedef int i32x8 __attribute__((ext_vector_type(8)));
__device__ __forceinline__ void finishSM_T(f32x16& p0, f32x16& p1, float alpha, float& l_reg, i32x8& pb) {
#pragma unroll
  for (int r = 0; r < 16; ++r) p1[r] = __builtin_amdgcn_exp2f(p1[r]);
  float ps = 0;
#pragma unroll
  for (int r = 0; r < 16; ++r) ps += p0[r];
#pragma unroll
  for (int r = 0; r < 16; ++r) ps += p1[r];
  { auto rr = __builtin_amdgcn_permlane32_swap(__float_as_uint(ps), __float_as_uint(ps), false, false);
    ps = __uint_as_float(rr[0]) + __uint_as_float(rr[1]); }
  l_reg = l_reg * alpha + ps;
#pragma unroll
  for (int g = 0; g < 4; ++g) {
    int w0 = __builtin_amdgcn_cvt_pk_fp8_f32(p0[4 * g], p0[4 * g + 1], 0, false); w0 = __builtin_amdgcn_cvt_pk_fp8_f32(p0[4 * g + 2], p0[4 * g + 3], w0, true); pb[g] = w0;
    int w1 = __builtin_amdgcn_cvt_pk_fp8_f32(p1[4 * g], p1[4 * g + 1], 0, false); w1 = __builtin_amdgcn_cvt_pk_fp8_f32(p1[4 * g + 2], p1[4 * g + 3], w1, true); pb[4 + g] = w1; }
}
__device__ __forceinline__ void qkt(f32x16& p0, f32x16& p1, const char* Ks, const i32x8 qf, int lane, int mm, const f32x16& negm) {
  const char* kp = Ks + mm * 4096 + lane * 16;
  const u32x4 a0 = *reinterpret_cast<const u32x4*>(kp), a1 = *reinterpret_cast<const u32x4*>(kp + 1024), b0 = *reinterpret_cast<const u32x4*>(kp + 2048), b1 = *reinterpret_cast<const u32x4*>(kp + 3072);
  p0 = __builtin_amdgcn_mfma_scale_f32_32x32x64_f8f6f4((i32x8){(int)a0.x, (int)a0.y, (int)a0.z, (int)a0.w, (int)a1.x, (int)a1.y, (int)a1.z, (int)a1.w}, qf, negm, 0, 0, 0, 0, 0, 0);
  p1 = __builtin_amdgcn_mfma_scale_f32_32x32x64_f8f6f4((i32x8){(int)b0.x, (int)b0.y, (int)b0.z, (int)b0.w, (int)b1.x, (int)b1.y, (int)b1.z, (int)b1.w}, qf, negm, 0, 0, 0, 0, 0, 0);
}
__device__ __forceinline__ int v_st(int k, int c) { const int kk = (k & ~0xC) | ((k & 4) << 1) | ((k & 8) >> 1); return ((kk >> 3) * 4 + (c >> 5)) * 512 + ((kk & 7) * 32 + (c & 31)) * 2; }
__device__ __forceinline__ int v_rd_base(int lane) { return ((lane & 3) << 3) | (((lane >> 2) & 3) << 6) | (((lane >> 4) & 1) << 5) | (((lane >> 5) & 1) << 8); }
constexpr int v_rd_off(int d0, int ks, int half) { return d0 * 512 + ks * 4096 + half * 2048; }
template <int OFF> __device__ __forceinline__ s16x4 tr_read(int vb) {
  s16x4 r; asm volatile("ds_read_b64_tr_b16 %0, %1 offset:%2" : "=&v"(r) : "v"(vb), "i"(OFF) : "memory"); return r;
}
template <int D0> __device__ __forceinline__ void pv_one(f32x16& od, int vb, bf16x8 pa0, bf16x8 pa1, bf16x8 pa2, bf16x8 pa3) {
  const s16x4 l0 = tr_read<v_rd_off(D0, 0, 0)>(vb), h0 = tr_read<v_rd_off(D0, 0, 1)>(vb), l1 = tr_read<v_rd_off(D0, 1, 0)>(vb), h1 = tr_read<v_rd_off(D0, 1, 1)>(vb);
  const s16x4 l2 = tr_read<v_rd_off(D0, 2, 0)>(vb), h2 = tr_read<v_rd_off(D0, 2, 1)>(vb), l3 = tr_read<v_rd_off(D0, 3, 0)>(vb), h3 = tr_read<v_rd_off(D0, 3, 1)>(vb);
  asm volatile("s_waitcnt lgkmcnt(0)" ::: "memory"); SBAR();
#define PK(L, H) (bf16x8){L[0], L[1], L[2], L[3], H[0], H[1], H[2], H[3]}
  od = __builtin_amdgcn_mfma_f32_32x32x16_bf16(pa0, PK(l0, h0), od, 0, 0, 0);
  od = __builtin_amdgcn_mfma_f32_32x32x16_bf16(pa1, PK(l1, h1), od, 0, 0, 0);
  od = __builtin_amdgcn_mfma_f32_32x32x16_bf16(pa2, PK(l2, h2), od, 0, 0, 0);
  od = __builtin_amdgcn_mfma_f32_32x32x16_bf16(pa3, PK(l3, h3), od, 0, 0, 0);
#undef PK
}
__device__ __forceinline__ void pv_d0(f32x16* o, int vb, bf16x8 pa0, bf16x8 pa1, bf16x8 pa2, bf16x8 pa3) {
  pv_one<0>(o[0], vb, pa0, pa1, pa2, pa3); pv_one<1>(o[1], vb, pa0, pa1, pa2, pa3); pv_one<2>(o[2], vb, pa0, pa1, pa2, pa3); pv_one<3>(o[3], vb, pa0, pa1, pa2, pa3);
}

template <int OFF> __device__ __forceinline__ u32x4 rd128(int vb) { u32x4 r; asm volatile("ds_read_b128 %0, %1 offset:%2" : "=&v"(r) : "v"(vb), "i"(OFF) : "memory"); return r; }
#define PV_RD(D0) const u32x4 va##D0 = rd128<D0 * 2048>(vb), vc##D0 = rd128<D0 * 2048 + 1024>(vb); SBAR()
#define PV_MM(D0) do { asm volatile("s_waitcnt lgkmcnt(0)" ::: "memory"); SBAR(); \
    o[D0] = __builtin_amdgcn_mfma_scale_f32_32x32x64_f8f6f4((i32x8){(int)va##D0.x, (int)va##D0.y, (int)va##D0.z, (int)va##D0.w, (int)vc##D0.x, (int)vc##D0.y, (int)vc##D0.z, (int)vc##D0.w}, pb, o[D0], 0, 0, 0, 0, 0, 0); } while (0)
__device__ __forceinline__ float max3f(float a, float b, float c) { float r; asm("v_max3_f32 %0, %1, %2, %3" : "=v"(r) : "v"(a), "v"(b), "v"(c)); return r; }
__device__ __forceinline__ void pv_psm(f32x16* o, int vb, i32x8 pb, f32x16& p0, f32x16& p1, float& m_reg, f32x16& negm, float& alpha) {
  float pmax;
  { PV_RD(0);
    pmax = max3f(p0[0], p0[1], p0[2]);
#pragma unroll
    for (int r = 3; r < 15; r += 2) pmax = max3f(pmax, p0[r], p0[r + 1]);
    pmax = max3f(pmax, p0[15], p1[0]);
    SBAR(); PV_MM(0); }
  { PV_RD(1);
#pragma unroll
    for (int r = 1; r < 15; r += 2) pmax = max3f(pmax, p1[r], p1[r + 1]);
    pmax = max3f(pmax, p1[15], p1[15]);
    { auto rr = __builtin_amdgcn_permlane32_swap(__float_as_uint(pmax), __float_as_uint(pmax), false, false);
      pmax = max3f(__uint_as_float(rr[0]), __uint_as_float(rr[1]), __uint_as_float(rr[1])); }
    if (__builtin_expect(__all(pmax <= THR2), 1)) { alpha = 1.f; }
    else { const float dl = fmaxf(pmax - PBIAS, 0.f); alpha = __builtin_amdgcn_exp2f(-dl); m_reg += dl;
#pragma unroll
      for (int r = 0; r < 16; ++r) { p0[r] -= dl; p1[r] -= dl; }
#pragma unroll
      for (int r = 0; r < 16; ++r) negm[r] = -m_reg;
      asm volatile("" : "+v"(negm)); }
    SBAR(); PV_MM(1); }
  { PV_RD(2);
#pragma unroll
    for (int r = 0; r < 8; ++r) p0[r] = __builtin_amdgcn_exp2f(p0[r]);
    asm volatile("" : "+v"(p0));
    SBAR(); PV_MM(2); }
  { PV_RD(3);
#pragma unroll
    for (int r = 8; r < 16; ++r) p0[r] = __builtin_amdgcn_exp2f(p0[r]);
    asm volatile("" : "+v"(p0));
    SBAR(); PV_MM(3); }
}
__device__ __forceinline__ void pvT_d0(f32x16* o, int vb, i32x8 pb) {
  { PV_RD(0); PV_MM(0); } { PV_RD(1); PV_MM(1); } { PV_RD(2); PV_MM(2); } { PV_RD(3); PV_MM(3); }
}
#undef PV_RD
#undef PV_MM

__device__ __forceinline__ void attn_unit(const unsigned char* __restrict__ Qb, const unsigned char* __restrict__ Kh, const unsigned char* __restrict__ Vh, bf16_t* __restrict__ Ob,
                                          const float* __restrict__ gsub, const float lam, char* lds, const int wv) {
  typedef __attribute__((address_space(3))) unsigned* ldsu_t;
  const int tid = otid_w(wv), wid = wv, lane = tid & 63, r32 = lane & 31, hi = lane >> 5, mm = wid >> 2, wq = wid & 3;
  constexpr int NB = 4;
  constexpr int SHM_V8 = KVBLK * 128;
  char* V_lds = lds; char* K_lds = lds + NB * SHM_V8; constexpr int SHM_K8 = KVBLK * 128;
  float m_reg = 0.f, l_reg = 0; f32x16 o[4] = {}; i32x8 qf; f32x16 negm = {}; asm volatile("" : "+v"(negm));
  const unsigned koff = (unsigned)((2 * (wid >> 2) + (lane >> 5)) * 2048 + (lane & 3) * 512 + (8 * ((wid >> 1) & 1) + 2 * ((lane & 31) >> 3) + ((lane >> 2) & 1)) * 32 + (wid & 1) * 16);
  const unsigned voff = (unsigned)((wid >> 1) * 2048 + (lane & 7) * 256 + ((lane >> 3) & 3) * 64 + (wid & 1) * 32 + (lane >> 5) * 16);
#define DMA(t, buf) do { const char* kb_ = (const char*)(Kh + (size_t)(t) * SHM_K8); const char* vb_ = (const char*)(Vh + (size_t)(t) * SHM_V8); asm volatile("" : "+s"(kb_), "+s"(vb_)); \
    __builtin_amdgcn_global_load_lds((const unsigned*)(kb_ + koff), (ldsu_t)(K_lds + (buf) * SHM_K8 + wid * 1024), 16, 0, 0); \
    __builtin_amdgcn_global_load_lds((const unsigned*)(vb_ + voff), (ldsu_t)(V_lds + (buf) * SHM_V8 + wid * 1024), 16, 0, 0); } while (0)
#define WAIT_BAR(N) asm volatile("s_waitcnt vmcnt(" #N ") lgkmcnt(0)\n\ts_barrier" ::: "memory")
#define RESC(a) do { if (__any((a) < 1.f)) { _Pragma("unroll") for (int d = 0; d < 4; ++d) _Pragma("unroll") for (int r = 0; r < 16; ++r) o[d][r] *= (a); } } while (0)
  DMA(0, 0); DMA(1, 1);
  { const unsigned char* Qw = Qb + (long)(wq * 32 + r32) * QKW + mm * 64 + hi * 32;
    const u32x4 q0 = *reinterpret_cast<const u32x4*>(Qw), q1 = *reinterpret_cast<const u32x4*>(Qw + 16);
    qf = (i32x8){(int)q0.x, (int)q0.y, (int)q0.z, (int)q0.w, (int)q1.x, (int)q1.y, (int)q1.z, (int)q1.w}; }
  const int vb0 = (int)(uintptr_t)V_lds + lane * 16;
  f32x16 pA0, pA1, pB0, pB1; float alA, alB; i32x8 pb; constexpr int NTL = KVLEN / KVBLK;
  WAIT_BAR(0);
  DMA(2, 2);
  qkt(pA0, pA1, K_lds, qf, lane, mm, negm); partialSM<true>(pA0, pA1, m_reg, negm, alA);
  WAIT_BAR(2);
  for (int j = 1; j + 1 < NTL; j += 2) {
    DMA(j + 2, (j + 2) & 3);
    SBAR(); qkt(pB0, pB1, K_lds + (j & 3) * SHM_K8, qf, lane, mm, negm);
    finishSM_T(pA0, pA1, alA, l_reg, pb); SBAR();
    pv_psm(o, vb0 + ((j - 1) & 3) * SHM_V8, pb, pB0, pB1, m_reg, negm, alB);
    RESC(alB);
    WAIT_BAR(2);
    if (j + 3 < NTL) DMA(j + 3, (j + 3) & 3);
    SBAR(); qkt(pA0, pA1, K_lds + ((j + 1) & 3) * SHM_K8, qf, lane, mm, negm);
    finishSM_T(pB0, pB1, alB, l_reg, pb); SBAR();
    pv_psm(o, vb0 + (j & 3) * SHM_V8, pb, pA0, pA1, m_reg, negm, alA);
    RESC(alA);
    if (j + 3 < NTL) WAIT_BAR(2); else WAIT_BAR(0);
  }
  SBAR(); qkt(pB0, pB1, K_lds + ((NTL - 1) & 3) * SHM_K8, qf, lane, mm, negm);
  finishSM_T(pA0, pA1, alA, l_reg, pb); SBAR();
  pv_psm(o, vb0 + ((NTL - 2) & 3) * SHM_V8, pb, pB0, pB1, m_reg, negm, alB);
  RESC(alB);
  finishSM_T(pB0, pB1, alB, l_reg, pb); SBAR();
  pvT_d0(o, vb0 + ((NTL - 1) & 3) * SHM_V8, pb);
#undef DMA
#undef WAIT_BAR
  const float rl = __builtin_amdgcn_rcpf(l_reg) * (mm ? lam : 1.0f);
  __syncthreads();
  constexpr int XS = 132;
  float* X = (float*)lds;
  if (mm == 1) {
#pragma unroll
    for (int r = 0; r < 16; ++r)
#pragma unroll
      for (int d0 = 0; d0 < 4; ++d0) X[(wq * 32 + r32) * XS + d0 * 32 + crow(r, hi)] = o[d0][r] * rl;
  }
  __syncthreads();
  if (mm == 0) {
#pragma unroll
    for (int r = 0; r < 16; ++r)
#pragma unroll
      for (int d0 = 0; d0 < 4; ++d0) { float* xp = X + (wq * 32 + r32) * XS + d0 * 32 + crow(r, hi); *xp = o[d0][r] * rl - *xp; }
  }
  __syncthreads();
  {
    const int row = tid >> 2, seg = tid & 3;
    const float* xr = X + row * XS + seg * 32;
    f32x4 v[8]; float ss = 0.f;
#pragma unroll
    for (int i = 0; i < 8; ++i) { v[i] = *(const f32x4*)(xr + 4 * i); ss += v[i][0] * v[i][0] + v[i][1] * v[i][1] + v[i][2] * v[i][2] + v[i][3] * v[i][3]; }
    ss += sx<1>(ss); ss += sx<2>(ss);
    const float rs = (1.0f - LAM_INIT) / sqrtf(ss * (1.0f / 128.0f) + EPS);
    bf16_t* dst = Ob + (long)row * D + seg * 32;
#pragma unroll
    for (int i = 0; i < 8; i += 2) {
      const f32x4 g0 = *(const f32x4*)(gsub + seg * 32 + 4 * i), g1 = *(const f32x4*)(gsub + seg * 32 + 4 * i + 4);
      u32x4 w; w.x = cvtpk(v[i][0] * rs * g0[0], v[i][1] * rs * g0[1]); w.y = cvtpk(v[i][2] * rs * g0[2], v[i][3] * rs * g0[3]);
      w.z = cvtpk(v[i + 1][0] * rs * g1[0], v[i + 1][1] * rs * g1[1]); w.w = cvtpk(v[i + 1][2] * rs * g1[2], v[i + 1][3] * rs * g1[3]);
      *(u32x4*)(dst + 4 * i) = w;
    }
  }
  __syncthreads();
#undef RESC
}
#undef KSWZ
#undef SBAR
}

__device__ __forceinline__ void ph_attn(const Params& p, unsigned char* smem) {
    unsigned char* ws = p.ws;
    const unsigned char* Q = ws + WS_Q; const unsigned char* Kb = ws + WS_K; const unsigned char* Vb = ws + WS_V;
    bf16_t* AO = (bf16_t*)(ws + WS_AO);
    const float lam = ((const float*)(ws + WS_CTL))[1024];
    const int c = blockIdx.x, G = gridDim.x;
    if (G == 256) {
        const int x = c & 7, s = c >> 3;
        for (int rd = 0; rd < 6; ++rd) {
            const int bh = rd * 4 + (x >> 1), qb = (x & 1) * 32 + s, b = bh / NH, h = bh % NH;
            fa::attn_unit(Q + ((size_t)b * SEQ + qb * 128) * QKW + h * 128, Kb + (size_t)(b * NH + h) * (KVLEN / 64) * 8192, Vb + (size_t)(b * NH + h) * (KVLEN / 64) * 8192,
                          AO + ((size_t)b * SEQ + qb * 128) * D + 256 + h * 128, p.in[I_GSUB], lam, (char*)smem, p.chunk);
        }
    } else {
        for (int u = c; u < BATCH * NH * 64; u += G) {
            const int bh = u >> 6, qb = u & 63, b = bh / NH, h = bh % NH;
            fa::attn_unit(Q + ((size_t)b * SEQ + qb * 128) * QKW + h * 128, Kb + (size_t)(b * NH + h) * (KVLEN / 64) * 8192, Vb + (size_t)(b * NH + h) * (KVLEN / 64) * 8192,
                          AO + ((size_t)b * SEQ + qb * 128) * D + 256 + h * 128, p.in[I_GSUB], lam, (char*)smem, p.chunk);
        }
    }
}

__device__ __forceinline__ void ph_fourierA(const Params& p, unsigned char* smem) {
    using namespace fa;
    unsigned char* ws = p.ws;
    const bf16_t* F = (const bf16_t*)(ws + WS_F); bf16_t* FY = (bf16_t*)(ws + WS_FY); const bf16_t* W = (const bf16_t*)(ws + WS_W128E);
    const int tid = otid(), wid = tid >> 6, lane = tid & 63, r32 = lane & 31, hi = lane >> 5;
    const int sr = tid >> 4, sc = (tid & 15) * 8, vst0 = v_st(sr, sc), vst1 = v_st(32 + sr, sc);
    const int vb0 = (int)(uintptr_t)smem + v_rd_base(lane);
    for (int task = blockIdx.x; task < BATCH * 64; task += gridDim.x) {
        const int b = task >> 6, n2 = task & 63;
        bf16x8 st[4][2];
#pragma unroll
        for (int kt = 0; kt < 2; ++kt)
#pragma unroll
            for (int ct = 0; ct < 2; ++ct) {
                st[kt * 2 + ct][0] = *(const bf16x8*)(F + ((size_t)b * SEQ + 64 * (64 * kt + sr) + n2) * 256 + 128 * ct + sc);
                st[kt * 2 + ct][1] = *(const bf16x8*)(F + ((size_t)b * SEQ + 64 * (64 * kt + 32 + sr) + n2) * 256 + 128 * ct + sc);
            }
        bf16x8 pa[2][4];
#pragma unroll
        for (int kt = 0; kt < 2; ++kt)
#pragma unroll
            for (int ks = 0; ks < 4; ++ks) pa[kt][ks] = *(const bf16x8*)(W + (size_t)(32 * wid + r32) * 128 + 64 * kt + 16 * ks + 8 * hi);
        __syncthreads();
#pragma unroll
        for (int q = 0; q < 4; ++q) { *(bf16x8*)(smem + q * 16384 + vst0) = st[q][0]; *(bf16x8*)(smem + q * 16384 + vst1) = st[q][1]; }
        __syncthreads();
        f32x16 o[2][4] = {};
#pragma unroll
        for (int ct = 0; ct < 2; ++ct)
#pragma unroll
            for (int kt = 0; kt < 2; ++kt) pv_d0(o[ct], vb0 + (kt * 2 + ct) * 16384, pa[kt][0], pa[kt][1], pa[kt][2], pa[kt][3]);
        const int plane = wid >> 2;
#pragma unroll
        for (int r = 0; r < 16; ++r) {
            const int k1 = 32 * (wid & 3) + crow(r, hi);
            bf16_t* dst = FY + ((((size_t)plane * BATCH + b) * 128 + k1) * 64 + n2) * 256 + r32;
#pragma unroll
            for (int ct = 0; ct < 2; ++ct)
#pragma unroll
                for (int d0 = 0; d0 < 4; ++d0) dst[128 * ct + 32 * d0] = f2bf(o[ct][d0][r]);
        }
    }
    __syncthreads();
}
__device__ __forceinline__ void ph_fourierB(const Params& p, unsigned char* smem) {
    using namespace fa;
    unsigned char* ws = p.ws;
    const bf16_t* FY = (const bf16_t*)(ws + WS_FY); const float2* tabw = (const float2*)(ws + WS_TABW);
    const bf16_t* M64 = (const bf16_t*)(ws + WS_M64E); const bf16_t* GT = (const bf16_t*)(ws + WS_GT);
    bf16_t* AO = (bf16_t*)(ws + WS_AO);
    const int tid = otid(), wid = tid >> 6, lane = tid & 63, r32 = lane & 31, hi = lane >> 5;
    const int sr = tid >> 4, sc = (tid & 15) * 8, vst0 = v_st(sr, sc), vst1 = v_st(32 + sr, sc);
    const int vb0 = (int)(uintptr_t)smem + v_rd_base(lane);
    constexpr int XRS = 528;
    unsigned char* XL = smem + 65536;
    const int mt = wid & 3, ctw = wid >> 2;
    for (int task = blockIdx.x; task < BATCH * 128; task += gridDim.x) {
        const int b = task >> 7, k1 = task & 127;
        __syncthreads();
#pragma unroll
        for (int ct = 0; ct < 2; ++ct)
#pragma unroll
            for (int rh = 0; rh < 2; ++rh) {
                const int n2 = sr + 32 * rh;
                const size_t off = ((((size_t)b) * 128 + k1) * 64 + n2) * 256 + 128 * ct + sc;
                const uint4 yr = *(const uint4*)(FY + off), yi = *(const uint4*)(FY + (size_t)BATCH * 128 * 64 * 256 + off);
                const float2 tw = tabw[n2 * k1];
                const unsigned yrw[4] = {yr.x, yr.y, yr.z, yr.w}, yiw[4] = {yi.x, yi.y, yi.z, yi.w};
                unsigned zr[4], zi[4];
#pragma unroll
                for (int q = 0; q < 4; ++q) {
                    const float a0 = __uint_as_float(yrw[q] << 16), a1 = __uint_as_float(yrw[q] & 0xffff0000u), b0 = __uint_as_float(yiw[q] << 16), b1 = __uint_as_float(yiw[q] & 0xffff0000u);
                    zr[q] = pk2(a0 * tw.x + b0 * tw.y, a1 * tw.x + b1 * tw.y); zi[q] = pk2(b0 * tw.x - a0 * tw.y, b1 * tw.x - a1 * tw.y);
                }
                const int vs = rh ? vst1 : vst0;
                *(uint4*)(smem + (0 * 2 + ct) * 16384 + vs) = make_uint4(zr[0], zr[1], zr[2], zr[3]);
                *(uint4*)(smem + (1 * 2 + ct) * 16384 + vs) = make_uint4(zi[0], zi[1], zi[2], zi[3]);
            }
        __syncthreads();
        {
            f32x16 o[4] = {};
#pragma unroll
            for (int kt = 0; kt < 2; ++kt) {
                bf16x8 pa[4];
#pragma unroll
                for (int ks = 0; ks < 4; ++ks) pa[ks] = *(const bf16x8*)(M64 + (size_t)(32 * mt + r32) * 128 + 64 * kt + 16 * ks + 8 * hi);
                pv_d0(o, vb0 + (kt * 2 + ctw) * 16384, pa[0], pa[1], pa[2], pa[3]);
            }
#pragma unroll
            for (int r = 0; r < 16; ++r) {
                const int ro = 32 * mt + crow(r, hi);
                bf16_t* xr = (bf16_t*)(XL + ((ro >> 6) * 64 + (ro & 63)) * XRS) + 128 * ctw + r32;
#pragma unroll
                for (int d0 = 0; d0 < 4; ++d0) xr[32 * d0] = f2bf(o[d0][r]);
            }
        }
        __syncthreads();
#pragma unroll
        for (int tt = 0; tt < 2; ++tt) {
            const int tau = 2 * wid + tt, g = tau >> 2, mt2 = (tau >> 1) & 1, nt2 = tau & 1;
            f32x16 acc = {};
#pragma unroll
            for (int ks8 = 0; ks8 < 8; ++ks8) {
                const int part = ks8 >> 2, cb = ks8 & 3;
                const bf16x8 af = *(const bf16x8*)(XL + (part * 64 + 32 * mt2 + r32) * XRS + (g * 64 + 16 * cb + 8 * hi) * 2);
                const bf16x8 bfr = *(const bf16x8*)(GT + ((size_t)g * 64 + 32 * nt2 + r32) * 128 + part * 64 + 16 * cb + 8 * hi);
                acc = __builtin_amdgcn_mfma_f32_32x32x16_bf16(af, bfr, acc, 0, 0, 0);
            }
#pragma unroll
            for (int r = 0; r < 16; ++r) { const int k2 = 32 * mt2 + crow(r, hi);
                AO[((size_t)b * SEQ + k1 + 128 * k2) * D + g * 64 + 32 * nt2 + r32] = f2bf(acc[r]); }
        }
    }
    __syncthreads();
}

__device__ __forceinline__ void ph_mid(const Params& p, unsigned char* smem) {
    typedef short bf16x8 __attribute__((ext_vector_type(8)));
    unsigned char* ws = p.ws;
    const int tid = otid(), wave = tid >> 6, lane = tid & 63, fr = lane & 15, fq = lane >> 4;
    const float* mod = (const float*)(ws + WS_MOD);
    const bf16_t* YX = (const bf16_t*)(ws + WS_YX);
    unsigned char* H2 = ws + WS_H2;
    unsigned* counts = (unsigned*)(ws + WS_CTL);
    int* TE = (int*)(ws + WS_TE); int* TP = (int*)(ws + WS_TP); float* TW = (float*)(ws + WS_TW); int* TOKL = (int*)(ws + WS_TOKL);
    constexpr int RS = 2064;
    unsigned char* Ahi = smem; unsigned char* Alo = smem + 16 * RS; float* Pp = (float*)(smem + 2 * 16 * RS + 512);
    const float rbias = p.in[I_RB][lane];
    int* lcnt = (int*)(smem + 99328); int* gb = lcnt + 64; int* PE = gb + 64; float* PW = (float*)(PE + 1024); float* PV = PW + 1024;
    for (int chunk = blockIdx.x; chunk < T / 128; chunk += gridDim.x) {
      const int mc = chunk * 128, b = mc >> 13;
      if (tid < 64) lcnt[tid] = 0;
      {
          const float* mrow_ = mod + b * 6144;
          for (int i = tid; i < 5 * 256; i += NT) { const int v_ = i >> 8, q_ = (i & 255) * 4;
              const float* s_ = (v_ == 0) ? p.in[I_GAPOST] + q_ : (v_ == 1) ? mrow_ + 2 * 1024 + q_ : (v_ == 2) ? p.in[I_GFPRE] + q_ : (v_ == 3) ? mrow_ + 3 * 1024 + q_ : mrow_ + 4 * 1024 + q_;
              *(f32x4*)(PV + v_ * 1024 + q_) = *(const f32x4*)s_; }
          __syncthreads();
      }
      uint2 yw[2][4]; f32x4 xv[2][4];
#define MID_LOAD(m0_) do { _Pragma("unroll") for (int rr = 0; rr < 2; ++rr) { const int m_ = (m0_) + 2 * wave + rr; _Pragma("unroll") for (int j = 0; j < 4; ++j) { \
          yw[rr][j] = *(const uint2*)(YX + (size_t)m_ * D + 4 * (lane + 64 * j)); xv[rr][j] = ((const f32x4*)(p.in[I_X] + (size_t)m_ * D))[lane + 64 * j]; } } } while (0)
      MID_LOAD(mc);
      for (int it = 0; it < 8; ++it) {
        const int m0 = mc + it * 16;
        {
            float ss[2] = {0.f, 0.f};
#define YV(rr, j, i) ((i) == 0 ? __uint_as_float(yw[rr][j].x << 16) : (i) == 1 ? __uint_as_float(yw[rr][j].x & 0xffff0000u) : (i) == 2 ? __uint_as_float(yw[rr][j].y << 16) : __uint_as_float(yw[rr][j].y & 0xffff0000u))
#pragma unroll
            for (int rr = 0; rr < 2; ++rr) {
#pragma unroll
                for (int j = 0; j < 4; ++j) ss[rr] += YV(rr, j, 0) * YV(rr, j, 0) + YV(rr, j, 1) * YV(rr, j, 1) + YV(rr, j, 2) * YV(rr, j, 2) + YV(rr, j, 3) * YV(rr, j, 3);
                ss[rr] = wave_sum(ss[rr]);
            }
#pragma unroll
            for (int rr = 0; rr < 2; ++rr) {
                const int lr = 2 * wave + rr, m = m0 + lr;
                const float r1 = 1.0f / sqrtf(ss[rr] * (1.0f / D) + EPS);
                float ss2 = 0.f;
#pragma unroll
                for (int j = 0; j < 4; ++j) {
                    const int col = 4 * (lane + 64 * j);
                    const f32x4 gp = *(const f32x4*)(PV + col), gt = *(const f32x4*)(PV + 1024 + col);
#pragma unroll
                    for (int i = 0; i < 4; ++i) { xv[rr][j][i] = xv[rr][j][i] + gt[i] * (YV(rr, j, i) * r1 * gp[i]); ss2 += xv[rr][j][i] * xv[rr][j][i]; }
                    ((f32x4*)(p.out + (size_t)m * D))[lane + 64 * j] = xv[rr][j];
                }
                ss2 = wave_sum(ss2);
                const float r2 = 1.0f / sqrtf(ss2 * (1.0f / D) + EPS);
#pragma unroll
                for (int j = 0; j < 4; ++j) {
                    const int col = 4 * (lane + 64 * j);
                    const f32x4 gp = *(const f32x4*)(PV + 2048 + col), sh = *(const f32x4*)(PV + 3072 + col), sc = *(const f32x4*)(PV + 4096 + col);
                    float h[4]; bf16_t hb[4]; float lo[4];
#pragma unroll
                    for (int i = 0; i < 4; ++i) { h[i] = xv[rr][j][i] * r2 * gp[i] * (1.f + sc[i]) + sh[i]; hb[i] = f2bf(h[i]); lo[i] = h[i] - bf2f(hb[i]); }
                    uint2 o; o.x = (unsigned)hb[0] | ((unsigned)hb[1] << 16); o.y = (unsigned)hb[2] | ((unsigned)hb[3] << 16);
                    { int w8 = __builtin_amdgcn_cvt_pk_fp8_f32(h[0], h[1], 0, false); w8 = __builtin_amdgcn_cvt_pk_fp8_f32(h[2], h[3], w8, true); *(int*)(H2 + (size_t)m * D + col) = w8; }
                    *(uint2*)(Ahi + lr * RS + col * 2) = o;
                    uint2 ol; ol.x = pk2(lo[0], lo[1]); ol.y = pk2(lo[2], lo[3]);
                    *(uint2*)(Alo + lr * RS + col * 2) = ol;
                }
            }
            if (it < 7) MID_LOAD(m0 + 16);
        }
        asm volatile("s_waitcnt lgkmcnt(0)\n\ts_barrier" ::: "memory");
        {
            f32x4 acc[4];
#pragma unroll
            for (int nb = 0; nb < 4; ++nb) acc[nb] = (f32x4){0.f, 0.f, 0.f, 0.f};
            const bf16_t* wrtlo = (const bf16_t*)(ws + WS_WRT); asm volatile("" : "+s"(wrtlo));
#pragma unroll
            for (int ks = 0; ks < 4; ++ks) {
                const int ko = (wave * 128 + ks * 32 + 8 * fq) * 2;
                const bf16x8 ah = *(const bf16x8*)(Ahi + fr * RS + ko), al = *(const bf16x8*)(Alo + fr * RS + ko);
#pragma unroll
                for (int nb = 0; nb < 4; ++nb) {
                    const size_t wo_ = ((size_t)(((wave * 4 + ks) * 4 + nb) * 2) * 64 + lane) * 8;
                    const bf16x8 bhv = *(const bf16x8*)(wrtlo + wo_), bl = *(const bf16x8*)(wrtlo + wo_ + 512);
                    acc[nb] = __builtin_amdgcn_mfma_f32_16x16x32_bf16(ah, bhv, acc[nb], 0, 0, 0);
                    acc[nb] = __builtin_amdgcn_mfma_f32_16x16x32_bf16(ah, bl, acc[nb], 0, 0, 0);
                    acc[nb] = __builtin_amdgcn_mfma_f32_16x16x32_bf16(al, bhv, acc[nb], 0, 0, 0);
                }
            }
#pragma unroll
            for (int nb = 0; nb < 4; ++nb)
#pragma unroll
                for (int j = 0; j < 4; ++j) Pp[(wave * 16 + 4 * fq + j) * 64 + 16 * nb + fr] = acc[nb][j];
        }
        asm volatile("s_waitcnt lgkmcnt(0)\n\ts_barrier" ::: "memory");
#pragma unroll
        for (int rr = 0; rr < 2; ++rr) {
            const int lr = 2 * wave + rr;
            float lg = 0.f;
#pragma unroll
            for (int w = 0; w < 8; ++w) lg += Pp[(w * 16 + lr) * 64 + lane];
            const float score = 1.0f / (1.0f + expf(-lg));
            const float sel = score + rbias;
            float t1 = sel, t2 = -INFINITY;
#define TOP2(M) do { const float o1 = sx<M>(t1), o2 = sx<M>(t2); const float n1 = fmaxf(t1, o1), n2 = fmaxf(fminf(t1, o1), fmaxf(t2, o2)); t1 = n1; t2 = n2; } while (0)
            TOP2(1); TOP2(2); TOP2(4);
#undef TOP2
            const float gs = t1 + t2; const int grp = lane >> 3;
            int gr = 0;
#pragma unroll
            for (int j = 0; j < 8; ++j) { const float sj = __uint_as_float(__builtin_amdgcn_readlane(__float_as_uint(gs), j * 8)); gr += (sj > gs || (sj == gs && j < grp)) ? 1 : 0; }
            const bool gsel = gr < 4;
            float v = gsel ? sel : -INFINITY;
            int rk = TOPK;
#pragma unroll
            for (int it8 = 0; it8 < TOPK; ++it8) {
                const float mx = wave_max(v);
                const unsigned long long eq = __ballot(v == mx);
                const int win = __builtin_ctzll(eq);
                if (lane == win) { rk = it8; v = -INFINITY; }
            }
            const bool chosen = rk < TOPK;
            const float ssum = wave_sum(chosen ? score : 0.f);
            const float w = score / (ssum + 1e-20f) * 2.5f;
            if (chosen) {
                const int lpos = atomicAdd(&lcnt[lane], 1);
                const int idx = (it * 16 + lr) * 8 + rk;
                PE[idx] = lane | (lpos << 8); PW[idx] = w;
            }
        }
      }
      __syncthreads();
      if (tid < 64) { const int c = lcnt[tid]; gb[tid] = c ? (int)atomicAdd(&counts[b * 65 + tid], (unsigned)c) : 0; }
      __syncthreads();
      for (int i = tid; i < 1024; i += NT) {
          const int pe = PE[i], e = pe & 255, pos = gb[e] + (pe >> 8), mk = mc * 8 + i;
          TOKL[((size_t)b * 64 + e) * 8192 + pos] = mk; TE[mk] = e; TP[mk] = pos; TW[mk] = PW[i];
      }
      __syncthreads();
    }
}

constexpr int T_CNT = 0;
constexpr int T_TOT = 256;
constexpr int T_AB = 328;
constexpr int T_OFF = 400;
constexpr int T_GUP = 660;
constexpr int T_YC = 730;
constexpr int T_YB = 990;
constexpr int T_DUP = 1250;
constexpr int T_UL = 1520;
constexpr int T_END = 1520 + 512;
__device__ __forceinline__ int scan_incl(int v, int lane) {
#pragma unroll
    for (int off = 1; off < 64; off <<= 1) { const int t = __builtin_amdgcn_ds_bpermute(((lane - off) & 63) << 2, v); if (lane >= off) v += t; }
    return v;
}
__device__ __forceinline__ void build_moe(const Params& p, int* tab) {
    const unsigned* counts = (const unsigned*)(p.ws + WS_CTL);
    __syncthreads();
    const int tid = otid(), wave = tid >> 6, lane = tid & 63;
    if (wave == 0) {
        const int c0 = (int)counts[0 * 65 + lane], c1 = (int)counts[1 * 65 + lane], c2 = (int)counts[2 * 65 + lane], c3 = (int)counts[3 * 65 + lane];
        tab[T_CNT + 0 * 64 + lane] = c0; tab[T_CNT + 1 * 64 + lane] = c1; tab[T_CNT + 2 * 64 + lane] = c2; tab[T_CNT + 3 * 64 + lane] = c3;
        tab[T_OFF + lane * 4 + 0] = 0; tab[T_OFF + lane * 4 + 1] = c0; tab[T_OFF + lane * 4 + 2] = c0 + c1; tab[T_OFF + lane * 4 + 3] = c0 + c1 + c2;
        const int tot = c0 + c1 + c2 + c3, pad = (tot + 255) & ~255, gu = ((tot + 255) >> 8) * 2;
        const int sp = scan_incl(pad, lane), sg = scan_incl(gu, lane);
        tab[T_TOT + lane] = tot; tab[T_AB + lane] = sp - pad; tab[T_GUP + lane] = sg - gu;
        const int cb[4] = {c0, c1, c2, c3};
#pragma unroll
        for (int b = 0; b < 4; ++b) {
            const int du = ((cb[b] + 255) >> 8) * 4;
            const int sy = scan_incl(cb[b], lane), sd = scan_incl(du, lane);
            tab[T_YB + 65 * b + lane] = sy - cb[b]; tab[T_DUP + 66 * b + lane] = sd - du;
            if (lane == 63) { tab[T_YB + 65 * b + 64] = sy; tab[T_DUP + 66 * b + 64] = sd; tab[T_DUP + 66 * b + 65] = sd + (SEQ / 256) * 4; }
        }
        if (lane == 63) { tab[T_TOT + 64] = T; tab[T_AB + 64] = sp; tab[T_GUP + 64] = sg; tab[T_GUP + 65] = sg + (T / 256) * 2; }
    }
    __syncthreads();
}

__device__ __forceinline__ void moe_decode(const GP_LAS int* tab, int e, int pos_e, int& b, int& pos) {
    const int o1 = tab[T_OFF + e * 4 + 1], o2 = tab[T_OFF + e * 4 + 2], o3 = tab[T_OFF + e * 4 + 3];
    b = (pos_e >= o1 ? 1 : 0) + (pos_e >= o2 ? 1 : 0) + (pos_e >= o3 ? 1 : 0);
    pos = pos_e - (b == 0 ? 0 : (b == 1 ? o1 : (b == 2 ? o2 : o3)));
}
constexpr int YROWS = SEQ * 9;
struct MoeSched {
    const GP_LAS int* tab; int G, c, ntn, U, down, chunk; const int* TOKL; const char* Bt;
    __device__ __forceinline__ void prepare(int* tabw, int wv) const {
        if (wv == 0) {
            const int i = lane_id(); int L = i * G + c;
            if (L < U) {
                int bt = 0;
                if (down) { bt = 2 * chunk; const int u0 = tabw[T_DUP + 66 * bt + 65]; if (L >= u0) { L -= u0; ++bt; } }
                const int pre = down ? T_DUP + 66 * bt : T_GUP;
                int lo = 0, hi = 64;
                while (lo < hi) { const int mid = (lo + hi + 1) >> 1; if (tabw[pre + mid] <= L) lo = mid; else hi = mid - 1; }
                const int loc = L - tabw[pre + lo];
                int cnt, base, bb;
                if (down) { cnt = (lo < 64) ? tabw[T_CNT + bt * 64 + (lo & 63)] : SEQ; base = tabw[T_YB + 65 * bt + lo] + (bt & 1) * YROWS;
                            bb = tabw[T_AB + lo] + (lo < 64 ? tabw[T_OFF + (lo & 63) * 4 + bt] : bt * SEQ); }
                else { cnt = tabw[T_TOT + lo]; base = tabw[T_AB + lo]; bb = 0; }
                int* ul = tabw + T_UL + 8 * i;
                ul[0] = lo; ul[1] = loc / ntn; ul[2] = loc % ntn; ul[3] = cnt; ul[4] = base; ul[5] = bb;
            }
        }
        __syncthreads();
    }
    __device__ __forceinline__ bool next(int i, gp::Unit& u) const {
        if (i * G + c >= U) return false;
        const GP_LAS int* ul = tab + T_UL + 8 * i;
        u.e = __builtin_amdgcn_readfirstlane(ul[0]); u.pm = __builtin_amdgcn_readfirstlane(ul[1]); u.pn = __builtin_amdgcn_readfirstlane(ul[2]);
        u.cnt = __builtin_amdgcn_readfirstlane(ul[3]); u.base = __builtin_amdgcn_readfirstlane(ul[4]); u.b = __builtin_amdgcn_readfirstlane(ul[5]);
        return true;
    }
    __device__ __forceinline__ unsigned arow(const gp::Unit& u, int r) const {
        const int pos_e = u.pm * 256 + r;
        if (down) return (unsigned)(u.b + pos_e) * 512u;
        int tok;
        if (u.e < 64) { int b, pos; moe_decode(tab, u.e, pos_e, b, pos); tok = (pos_e < u.cnt) ? (TOKL[((size_t)b * 64 + u.e) * 8192 + pos] >> 3) : 0; } else tok = pos_e;
        return (unsigned)tok * 1024u;
    }
    __device__ __forceinline__ const char* bptr(const gp::Unit& u) const {
        return down ? Bt + ((size_t)u.e * 1024 + u.pn * 256) * 512 : Bt + ((size_t)u.e * 512 + u.pn * 256) * 1024;
    }
};
struct EpiGU {
    bf16_t* ACT; const int* TOKL; const float* TW; const GP_LAS int* tab;
    __device__ __forceinline__ void operator()(const f32x4 (&acc)[2][2][4][2], const gp::Unit& u, int wr, int wc, int fr, int fq) const {
#pragma unroll
        for (int ai = 0; ai < 2; ++ai)
#pragma unroll
            for (int m = 0; m < 4; ++m) {
                const int pos_e = u.pm * 256 + ai * 128 + wr * 64 + m * 16 + fr;
                if (pos_e < u.cnt) {
                    float w = 1.0f;
                    if (u.e < 64) { int b, pos; moe_decode(tab, u.e, pos_e, b, pos); w = TW[TOKL[((size_t)b * 64 + u.e) * 8192 + pos]]; }
                    float a[8];
#pragma unroll
                    for (int n = 0; n < 2; ++n)
#pragma unroll
                        for (int i = 0; i < 4; ++i) { const float g = acc[ai][0][m][n][i] * (1.f / GUSCALE), up = acc[ai][1][m][n][i] * (1.f / GUSCALE);
                            a[4 * n + i] = g * __builtin_amdgcn_rcpf(1.0f + __builtin_amdgcn_exp2f(-1.4426950408889634f * g)) * up * w; }
                    gp::u32x4 o; o.x = gp::cvt_pk_bf16(a[0], a[1]); o.y = gp::cvt_pk_bf16(a[2], a[3]); o.z = gp::cvt_pk_bf16(a[4], a[5]); o.w = gp::cvt_pk_bf16(a[6], a[7]);
                    *(gp::u32x4*)(ACT + ((size_t)u.base + pos_e) * DE + u.pn * 128 + wc * 32 + fq * 8) = o;
                }
            }
    }
};
constexpr float YSCALE = 16.f;
struct EpiDown {
    unsigned char* ws;
    __device__ __forceinline__ void operator()(const f32x4 (&acc)[2][2][4][2], const gp::Unit& u, int wr, int wc, int fr, int fq) const {
#pragma unroll
        for (int ai = 0; ai < 2; ++ai)
#pragma unroll
            for (int m = 0; m < 4; ++m) {
                const int pos = u.pm * 256 + ai * 128 + wr * 64 + m * 16 + fr;
                if (pos < u.cnt) {
                    unsigned char* rowp = ws + WS_Y + (size_t)(u.base + pos) * D + u.pn * 256 + wc * 32 + fq * 8;
#pragma unroll
                    for (int bj = 0; bj < 2; ++bj) { const f32x4 v0 = acc[ai][bj][m][0] * YSCALE, v1 = acc[ai][bj][m][1] * YSCALE;
                        int w0 = __builtin_amdgcn_cvt_pk_fp8_f32(v0[0], v0[1], 0, false); w0 = __builtin_amdgcn_cvt_pk_fp8_f32(v0[2], v0[3], w0, true);
                        int w1 = __builtin_amdgcn_cvt_pk_fp8_f32(v1[0], v1[1], 0, false); w1 = __builtin_amdgcn_cvt_pk_fp8_f32(v1[2], v1[3], w1, true);
                        uint2 o; o.x = (unsigned)w0; o.y = (unsigned)w1;
                        *(uint2*)(rowp + bj * 128) = o; }
                }
            }
    }
};
__device__ __forceinline__ void ph_moe_gu(const Params& p, unsigned char* smem) {
    unsigned char* ws = p.ws;
    int* tab = (int*)(smem + gp::STAGE_BYTES);
    build_moe(p, tab);
    MoeSched S; S.tab = (const GP_LAS int*)tab; S.G = gridDim.x; S.c = (gridDim.x % 8 == 0) ? (int)((blockIdx.x % 8) * (gridDim.x / 8) + blockIdx.x / 8) : (int)blockIdx.x;   S.ntn = 2; S.U = __builtin_amdgcn_readfirstlane(tab[T_GUP + 65]); S.down = 0; S.chunk = 0;
    S.TOKL = (const int*)(ws + WS_TOKL); S.Bt = (const char*)(ws + WS_WGUT);
    S.prepare(tab, p.chunk);
    EpiGU E{(bf16_t*)(ws + WS_ACT), (const int*)(ws + WS_TOKL), (const float*)(ws + WS_TW), (const GP_LAS int*)tab};
    gp::gemm_phase<EpiGU, MoeSched, true, true>(p.chunk, (GP_LAS unsigned char*)smem, (const char*)(ws + WS_H2), D / 2, S, E);
}
__device__ __forceinline__ void ph_moe_down(const Params& p, unsigned char* smem, int c) {
    unsigned char* ws = p.ws;
    int* tab = (int*)(smem + gp::STAGE_BYTES);
    build_moe(p, tab);
    MoeSched S; S.tab = (const GP_LAS int*)tab; S.G = gridDim.x; S.c = (gridDim.x % 8 == 0) ? (int)((blockIdx.x % 8) * (gridDim.x / 8) + blockIdx.x / 8) : (int)blockIdx.x;   S.ntn = 4; S.U = __builtin_amdgcn_readfirstlane(tab[T_DUP + 66 * (2 * c) + 65] + tab[T_DUP + 66 * (2 * c + 1) + 65]); S.down = 1; S.chunk = c;
    S.TOKL = nullptr; S.Bt = (const char*)(ws + WS_WDT);
    S.prepare(tab, p.chunk);
    EpiDown E{ws};
    gp::gemm_phase<EpiDown, MoeSched, false>(p.chunk, (GP_LAS unsigned char*)smem, (const char*)(ws + WS_ACT), DE, S, E);
}

__device__ __forceinline__ void ph_final(const Params& p, float* lds, int b) {
    unsigned char* ws = p.ws;
    int* tab = (int*)lds;
    build_moe(p, tab);
    const int tid = otid(), wave = tid >> 6, lane = tid & 63;
    const int gw = blockIdx.x * NWV + wave, GW = gridDim.x * NWV;
    const int* TE = (const int*)(ws + WS_TE); const int* TP = (const int*)(ws + WS_TP);
    const unsigned char* Y = ws + WS_Y;
    const float* mod = (const float*)(ws + WS_MOD) + b * 6144 + 5 * 1024;
    for (int t = gw; t < SEQ; t += GW) {
        const int m = b * SEQ + t;
        float acc[16];
#pragma unroll
        for (int i = 0; i < 16; ++i) acc[i] = 0.f;
#pragma unroll
        for (int k = 0; k < 9; ++k) {
            int row;
            if (k < 8) { const int e = TE[m * 8 + k]; row = tab[T_YB + 65 * b + e] + TP[m * 8 + k]; }
            else row = tab[T_YB + 65 * b + 64] + t;
            row += (b & 1) * YROWS;
            const unsigned char* yr = Y + (size_t)row * D;
#pragma unroll
            for (int j = 0; j < 4; ++j) { const int w = *(const int*)(yr + 4 * (lane + 64 * j));
                acc[4 * j] += __builtin_amdgcn_cvt_f32_fp8(w, 0); acc[4 * j + 1] += __builtin_amdgcn_cvt_f32_fp8(w, 1); acc[4 * j + 2] += __builtin_amdgcn_cvt_f32_fp8(w, 2); acc[4 * j + 3] += __builtin_amdgcn_cvt_f32_fp8(w, 3); }
        }
        float ss = 0.f;
#pragma unroll
        for (int i = 0; i < 16; ++i) { acc[i] *= (1.f / YSCALE); ss += acc[i] * acc[i]; }
        ss = wave_sum(ss);
        const float rs = 1.0f / sqrtf(ss * (1.0f / D) + EPS);
#pragma unroll
        for (int j = 0; j < 4; ++j) {
            const int col = 4 * (lane + 64 * j);
            const f32x4 gp = *(const f32x4*)(p.in[I_GFPOST] + col), gt = *(const f32x4*)(mod + col);
            f32x4 x1 = ((const f32x4*)(p.out + (size_t)m * D))[lane + 64 * j];
#pragma unroll
            for (int i = 0; i < 4; ++i) x1[i] += gt[i] * (acc[4 * j + i] * rs * gp[i]);
            ((f32x4*)(p.out + (size_t)m * D))[lane + 64 * j] = x1;
        }
    }
}

#define GAS __attribute__((address_space(1)))
#define LAS __attribute__((address_space(3)))
#define XB_TMO      128
#define XB_XCNT(j)  (256  + 64 * (j))
#define XB_XSUB(j)  (1280 + 64 * (j))
#define XB_XGEN(j)  (2304 + 64 * (j))
#define XB_TOP      3328
#define XB_TOPGEN   3392
#define XCD_BAR_WORDS 3456
#define XB_SPIN_CAP (1u << 21)
__device__ __forceinline__ unsigned xb_ld(unsigned* p)              { return __hip_atomic_load(p, __ATOMIC_RELAXED, __HIP_MEMORY_SCOPE_AGENT); }
__device__ __forceinline__ unsigned xb_add(unsigned* p, unsigned v) { return __hip_atomic_fetch_add(p, v, __ATOMIC_RELAXED, __HIP_MEMORY_SCOPE_AGENT); }
__device__ __forceinline__ unsigned xb_xcc_id() { return (unsigned)__builtin_amdgcn_s_getreg((3 << 11) | 20) & 0xFu; }
#define XB_SPIN(cond, bar) do { unsigned _sp = 0; while (cond) { __builtin_amdgcn_s_sleep(1); \
    if ((++_sp & 255u) == 0u) { if (xb_ld(&(bar)[XB_TMO])) break; if (_sp > XB_SPIN_CAP) { atomicAdd(&(bar)[XB_TMO], 1u); break; } } } } while (0)
struct XcdBarrier { unsigned* bar; unsigned x; volatile LAS unsigned* st; };
__device__ __forceinline__ XcdBarrier xcd_barrier_post(unsigned* bar, volatile LAS unsigned* st, int wv) {
    XcdBarrier b; b.bar = bar; b.x = xb_xcc_id(); b.st = st;
    if (wv == 0 && lane_id() == 0) (void)xb_add(&bar[XB_XCNT(b.x)], 1u);
    return b;
}
__device__ __forceinline__ void xcd_barrier_complete(unsigned* bar, unsigned x, unsigned& nloc, unsigned& nx) {
    const unsigned G = gridDim.x * gridDim.y * gridDim.z;
    unsigned sum, cnt, mine, sp = 0u;
    for (;;) {
        sum = 0u; cnt = 0u; mine = 0u;
#pragma unroll
        for (unsigned j = 0; j < 16; ++j) { const unsigned c = xb_ld(&bar[XB_XCNT(j)]); sum += c; cnt += (c > 0u) ? 1u : 0u; mine = (j == x) ? c : mine; }
        if (sum == G) break;
        __builtin_amdgcn_s_sleep(1);
        if ((++sp & 255u) == 0u) { if (xb_ld(&bar[XB_TMO])) break; if (sp > XB_SPIN_CAP) { atomicAdd(&bar[XB_TMO], 1u); break; } }
    }
    nloc = mine > 0u ? mine : 1u; nx = cnt > 0u ? cnt : 1u;
}
__device__ __forceinline__ void xcd_barrier(const XcdBarrier& b, int wv) {
    asm volatile("s_waitcnt vmcnt(0)" ::: "memory");
    __syncthreads();
    if (wv == 0 && lane_id() == 0) {
        unsigned* bar = b.bar;
        __builtin_amdgcn_s_waitcnt(0);
        unsigned nloc = b.st[0], nx = b.st[1];
        if (nloc == 0u) { xcd_barrier_complete(bar, b.x, nloc, nx); b.st[0] = nloc; b.st[1] = nx; }
        const unsigned old = xb_add(&bar[XB_XSUB(b.x)], 1u);
        const unsigned gen = old / nloc;
        if (old + 1u == (gen + 1u) * nloc) {
            __builtin_amdgcn_fence(__ATOMIC_RELEASE, "agent");
            asm volatile("s_waitcnt vmcnt(0)" ::: "memory");
            const unsigned og = xb_add(&bar[XB_TOP], 1u);
            const unsigned tg = og / nx;
            if (og + 1u == (tg + 1u) * nx) xb_add(&bar[XB_TOPGEN], 1u);
            else XB_SPIN(xb_ld(&bar[XB_TOPGEN]) == tg, bar);
            __builtin_amdgcn_fence(__ATOMIC_ACQUIRE, "agent");
            xb_add(&bar[XB_XGEN(b.x)], 1u);
            asm volatile("s_waitcnt vmcnt(0)" ::: "memory");
        } else {
            XB_SPIN(xb_ld(&bar[XB_XGEN(b.x)]) == gen, bar);
            __builtin_amdgcn_fence(__ATOMIC_ACQUIRE, "agent");
            asm volatile("s_waitcnt vmcnt(0)" ::: "memory");
        }
    }
    __syncthreads();
}

namespace cg = cooperative_groups;
constexpr int LDS_BYTES = 144 * 1024;
typedef const __attribute__((address_space(4))) Params* KP;
__device__ __forceinline__ Params kargs() {
    Params p;
#if defined(__HIP_DEVICE_COMPILE__)
    typedef const __attribute__((address_space(4))) unsigned long long* KQ;
    KQ kq = (KQ)__builtin_amdgcn_kernarg_segment_ptr(); asm volatile("" : "+s"(kq));
    unsigned long long* d = (unsigned long long*)&p;
#pragma unroll
    for (int i = 0; i < (int)(sizeof(Params) / 8); ++i) d[i] = kq[i];
#endif
    return p;
}
#define PH(call) do { Params p = kargs(); p.chunk = wv; call; } while (0)
__global__ void __launch_bounds__(NT) mega_fwd(Params p_unused) {
    extern __shared__ __attribute__((aligned(16))) unsigned char smem[];
    float* lds = (float*)smem;
    volatile LAS unsigned* misc = (volatile LAS unsigned*)((LAS unsigned char*)smem + (LDS_BYTES - 64));
    if (threadIdx.x < 16) misc[threadIdx.x] = 0u;
    __syncthreads();
    unsigned* barw; { const Params p = kargs(); barw = (unsigned*)(p.ws + WS_CTL) + 4096; }
    const int wv = __builtin_amdgcn_readfirstlane(threadIdx.x >> 6);
    const XcdBarrier bar = xcd_barrier_post(barw, misc, wv);
#define SYNC() xcd_barrier(bar, wv)
    PH(ph_prep(p, lds)); PH(ph_prep_weights(p, lds, 0, 0));   SYNC();
    PH(ph_norm1(p));                SYNC();
    PH(ph_inproj(p, smem)); PH(ph_prep_weights(p, lds, 1, (MTOT / 256) * (INW / 256) % (int)gridDim.x));         SYNC();
    PH(ph_attn(p, smem)); PH(ph_fourierA(p, smem));  SYNC();
    PH(ph_fourierB(p, smem));       SYNC();
    PH(ph_outproj(p, smem));        SYNC();
    PH(ph_mid(p, smem));            SYNC();
    PH(ph_moe_gu(p, smem));         SYNC();
#pragma unroll 1
    for (int c = 0; c < BATCH / 2; ++c) {
        PH(ph_moe_down(p, smem, c)); SYNC();
        PH(ph_final(p, lds, 2 * c)); PH(ph_final(p, lds, 2 * c + 1));
        if (c + 1 < BATCH / 2) SYNC();
    }
#undef SYNC
}

extern "C" void kernel_launch(void* const* d_in, const int* in_sizes, int n_in, void* d_out, int out_size, void* d_ws, size_t ws_size, hipStream_t stream) {
    if (n_in != 26 || ws_size < WS_END) { fprintf(stderr, "kernel_launch: unexpected n_in %d / ws %zu\n", n_in, ws_size); return; }
    static int grid_blocks = 0;
    if (!grid_blocks) {
        int dev = 0, cus = 0, per_cu = 0;
        (void)hipGetDevice(&dev);
        (void)hipDeviceGetAttribute(&cus, hipDeviceAttributeMultiprocessorCount, dev);
        (void)hipFuncSetAttribute((const void*)mega_fwd, hipFuncAttributeMaxDynamicSharedMemorySize, LDS_BYTES);
        (void)hipOccupancyMaxActiveBlocksPerMultiprocessor(&per_cu, (const void*)mega_fwd, NT, LDS_BYTES);
        if (per_cu < 1) { fprintf(stderr, "kernel_launch: occupancy query says %d blocks/CU\n", per_cu); per_cu = 1; }
        if (per_cu > 1) per_cu = 1;
        grid_blocks = cus * per_cu;
    }
    Params p{};
    for (int i = 0; i < 26; ++i) p.in[i] = (const float*)d_in[i];
    p.out = (float*)d_out; p.ws = (unsigned char*)d_ws; p.chunk = 0; p.pad = 0;
    (void)hipMemsetAsync((char*)d_ws + WS_CTL, 0, 32768, stream);
    void* args[] = {&p};
    hipError_t e = hipLaunchCooperativeKernel((const void*)mega_fwd, dim3(grid_blocks), dim3(NT), args, LDS_BYTES, stream);
    if (e != hipSuccess) fprintf(stderr, "cooperative launch failed: %s (grid %d)\n", hipGetErrorString(e), grid_blocks);
}
```

```cpp
#include <hip/hip_runtime.h>
#include <hip/hip_cooperative_groups.h>
#include <cstdio>
#include <cstdint>

typedef unsigned short bf16_t;
typedef float f32x4 __attribute__((ext_vector_type(4)));

constexpr int D = 1024, BATCH = 4, SEQ = 8192, T = BATCH * SEQ, CTX = 256, TC = BATCH * CTX;
constexpr int MTOT = T + TC;
constexpr int KVLEN = CTX + SEQ;
constexpr int INW = 2560, NH = 6, QKW = 768, FW = 256;
constexpr int NE = 64, DE = 256, TOPK = 8;
constexpr int NT = 512, NWV = 8;
constexpr int SLOTS_B = 90112;
constexpr float EPS = 1e-6f;
constexpr float LAM_INIT = 0.2f;
constexpr float QSCALE = 0.125f * 1.4426950408889634f;
constexpr float SQS = 0.42466090014400953f;

constexpr size_t MiB = 1u << 20;
constexpr size_t WS_CTL = 0;
constexpr size_t WS_MOD = 1 * MiB;
constexpr size_t WS_TABW = WS_MOD + 128 * 1024;
constexpr size_t WS_ROPE = WS_MOD + 192 * 1024;
constexpr size_t WS_GCS = WS_MOD + 256 * 1024;
constexpr size_t WS_W128E = WS_MOD + 768 * 1024;
constexpr size_t WS_M64E = WS_MOD + 832 * 1024;
constexpr size_t WS_GT = WS_MOD + 864 * 1024;
constexpr size_t WS_WRT = WS_MOD + 512 * 1024;
constexpr size_t WS_WINT = 2 * MiB;
constexpr size_t WS_WOUTT = 7 * MiB;
constexpr size_t WS_WGUT = 9 * MiB;
constexpr size_t WS_WDT = 74 * MiB;
constexpr size_t WS_TE = 107 * MiB;
constexpr size_t WS_TP = 108 * MiB;
constexpr size_t WS_TW = 109 * MiB;
constexpr size_t WS_TOKL = 110 * MiB;
constexpr size_t WS_AO = 118 * MiB;
constexpr size_t WS_ACT = 118 * MiB;
constexpr size_t WS_Q = 182 * MiB;
constexpr size_t WS_K = 230 * MiB;
constexpr size_t WS_V = WS_K + (size_t)BATCH * KVLEN * QKW * 2;
constexpr size_t WS_F = 329 * MiB;
constexpr size_t WS_FY = 361 * MiB;
constexpr size_t WS_HX = 425 * MiB;
constexpr size_t WS_YX = 358 * MiB;
constexpr size_t WS_H2 = 294 * MiB;
constexpr size_t WS_Y = 294 * MiB;
constexpr size_t WS_END = 491 * MiB;

struct Params {
    const float* in[26];
    float* out;
    unsigned char* ws;
    int chunk;
    int pad;
};
enum { I_X = 0, I_C, I_CTX, I_CCTX, I_WMOD, I_BMOD, I_GAPRE, I_GAPOST, I_WIN, I_WF, I_LQ1, I_LK1, I_LQ2, I_LK2, I_GSUB, I_WOUT,
       I_GFPRE, I_GFPOST, I_WR, I_RB, I_WG, I_WU, I_WD, I_WSG, I_WSU, I_WSD };

__device__ __forceinline__ float bf2f(bf16_t v) { return __uint_as_float(((unsigned)v) << 16); }
__device__ __forceinline__ bf16_t f2bf(float f) { unsigned u = __float_as_uint(f); return (bf16_t)((u + 0x7fffu + ((u >> 16) & 1u)) >> 16); }
__device__ __forceinline__ unsigned pk2(float lo, float hi) { return (unsigned)f2bf(lo) | ((unsigned)f2bf(hi) << 16); }
template <int M> __device__ __forceinline__ float sx(float v) { return __int_as_float(__builtin_amdgcn_ds_swizzle(__float_as_int(v), (M << 10) | 0x1f)); }
template <int M> __device__ __forceinline__ int sxi(int v) { return __builtin_amdgcn_ds_swizzle(v, (M << 10) | 0x1f); }
__device__ __forceinline__ float wave_sum(float v) {
    v += sx<1>(v); v += sx<2>(v); v += sx<4>(v); v += sx<8>(v); v += sx<16>(v);
    auto rr = __builtin_amdgcn_permlane32_swap(__float_as_uint(v), __float_as_uint(v), false, false);
    return __uint_as_float(rr[0]) + __uint_as_float(rr[1]);
}
__device__ __forceinline__ float dpp_f(float v, const int ctrl_sel) {
    const int x = __float_as_int(v); int r;
    if (ctrl_sel == 0) r = __builtin_amdgcn_update_dpp(x, x, 0xB1, 0xf, 0xf, false);
    else if (ctrl_sel == 1) r = __builtin_amdgcn_update_dpp(x, x, 0x4E, 0xf, 0xf, false);
    else if (ctrl_sel == 2) r = __builtin_amdgcn_update_dpp(x, x, 0x141, 0xf, 0xf, false);
    else r = __builtin_amdgcn_update_dpp(x, x, 0x140, 0xf, 0xf, false);
    return __int_as_float(r);
}
__device__ __forceinline__ float wave_max(float v) {
    v = fmaxf(v, dpp_f(v, 0)); v = fmaxf(v, dpp_f(v, 1)); v = fmaxf(v, dpp_f(v, 2)); v = fmaxf(v, dpp_f(v, 3));
    const float a = __uint_as_float(__builtin_amdgcn_readlane(__float_as_uint(v), 0)), b = __uint_as_float(__builtin_amdgcn_readlane(__float_as_uint(v), 16));
    const float c = __uint_as_float(__builtin_amdgcn_readlane(__float_as_uint(v), 32)), d = __uint_as_float(__builtin_amdgcn_readlane(__float_as_uint(v), 48));
    return fmaxf(fmaxf(a, b), fmaxf(c, d));
}
__device__ __forceinline__ int lane_id() { int l; asm volatile("v_mbcnt_lo_u32_b32 %0, -1, 0\n\tv_mbcnt_hi_u32_b32 %0, -1, %0" : "=v"(l)); return l; }
__device__ __forceinline__ int otid_w(int wv) { return wv * 64 + lane_id(); }
#define otid() otid_w(p.chunk)
__device__ __forceinline__ float silu_f(float x) { return x / (1.f + expf(-x)); }

__device__ __forceinline__ void ph_prep(const Params& p, float* lds) {
    const int tid = otid(), bid = blockIdx.x, nblk = gridDim.x;
    const int gt = bid * NT + tid, GT = nblk * NT;
    unsigned char* ws = p.ws;
    float2* tabw = (float2*)(ws + WS_TABW);
    for (int i = gt; i < 8192; i += GT) { float s, c; sincospif((float)i * (1.0f / 4096.0f), &s, &c); tabw[i] = make_float2(c, s); }
    float* rope = (float*)(ws + WS_ROPE);
    for (int i = gt; i < 192 * 16; i += GT) {
        const int pos = (i < 2048) ? (i >> 4) : ((i - 2048) >> 4); const int f = i & 15;
        const float inv = powf(10000.0f, -(float)(2 * f) / 32.0f); const float ang = (float)pos * inv;
        const float c = cosf(ang), s = sinf(ang);
        if (i < 2048) { rope[i] = c; rope[2048 + i] = s; } else { rope[4096 + (i - 2048)] = c; rope[4096 + 1024 + (i - 2048)] = s; }
    }
    { bf16_t* gt = (bf16_t*)(ws + WS_GT); const float* wf = p.in[I_WF];
      for (int i = bid * NT + tid; i < 4 * 64 * 128; i += GT) {
        const int g = i >> 13, d = (i >> 7) & 63, part = (i >> 6) & 1, c = i & 63;
        float a = 0.f;
        for (int j = 0; j < 64; ++j) { float s, co; sincospif((float)((c * j) & 63) * (1.0f / 32.0f), &s, &co); a += (part ? s : co) * wf[(g * 64 + j) * 64 + d]; }
        gt[i] = f2bf(a * 0.0013810679320049757f);
      }
      bf16_t* w128 = (bf16_t*)(ws + WS_W128E);
      for (int i = bid * NT + tid; i < 256 * 128; i += GT) { const int kk = i >> 7, n1 = i & 127; float s, co; sincospif((float)(((kk & 127) * n1) & 127) * (1.0f / 64.0f), &s, &co); w128[i] = f2bf(kk < 128 ? co : -s); }
      bf16_t* m64 = (bf16_t*)(ws + WS_M64E);
      for (int i = bid * NT + tid; i < 128 * 128; i += GT) { const int ro = i >> 7, ci = i & 127, po = ro >> 6, k2 = ro & 63, pi = ci >> 6, n2 = ci & 63;
        float s, co; sincospif((float)((k2 * n2) & 63) * (1.0f / 32.0f), &s, &co); m64[i] = f2bf(po == pi ? co : (po == 0 ? s : -s)); }
    }
    {
      bf16_t* wrt = (bf16_t*)(ws + WS_WRT); const float* wr = p.in[I_WR];
      for (int i = gt; i < 64 * 1024; i += GT) {
        const int j = i & 7, ln = (i >> 3) & 63, nb = (i >> 9) & 3, ks = (i >> 11) & 3, wv_ = i >> 13;
        const int e = 16 * nb + (ln & 15), k = wv_ * 128 + ks * 32 + 8 * (ln >> 4) + j;
        const float w = wr[k * 64 + e]; const bf16_t h = f2bf(w);
        const int o = ((((wv_ * 4 + ks) * 4 + nb) * 2) * 64 + ln) * 8 + j;
        wrt[o] = h; wrt[o + 512] = f2bf(w - bf2f(h)); } }
    if (gt == 0) {
        float s1 = 0.f, s2 = 0.f;
        for (int i = 0; i < 64; ++i) { s1 += p.in[I_LQ1][i] * p.in[I_LK1][i]; s2 += p.in[I_LQ2][i] * p.in[I_LK2][i]; }
        ((float*)(ws + WS_CTL))[1024] = expf(s1) - expf(s2) + LAM_INIT;
    }
    float* sc = lds;
    float* red = lds + 5 * 1024;
    for (int i = tid; i < 5 * 1024; i += NT) { const int r = i >> 10, k = i & 1023; const float v = (r < 4) ? p.in[I_C][r * 1024 + k] : p.in[I_CCTX][k]; sc[i] = silu_f(v); }
    __syncthreads();
    const int wave = tid >> 6, lane = tid & 63;
    float* mod = (float*)(ws + WS_MOD);
    for (int task = bid; task < 96; task += nblk) {
        const int col = task * 64 + lane;
        float a0 = 0, a1 = 0, a2 = 0, a3 = 0, a4 = 0;
        const float* wm = p.in[I_WMOD];
#pragma unroll 32
        for (int k = wave * 128; k < wave * 128 + 128; ++k) { const float w = wm[(size_t)k * 6144 + col]; a0 += sc[k] * w; a1 += sc[1024 + k] * w; a2 += sc[2048 + k] * w; a3 += sc[3072 + k] * w; a4 += sc[4096 + k] * w; }
        red[(wave * 5 + 0) * 64 + lane] = a0; red[(wave * 5 + 1) * 64 + lane] = a1; red[(wave * 5 + 2) * 64 + lane] = a2; red[(wave * 5 + 3) * 64 + lane] = a3; red[(wave * 5 + 4) * 64 + lane] = a4;
        __syncthreads();
        if (tid < 320) { const int r = tid >> 6, l = tid & 63; float s = 0.f; for (int w = 0; w < 8; ++w) s += red[(w * 5 + r) * 64 + l]; mod[r * 6144 + task * 64 + l] = s + p.in[I_BMOD][task * 64 + l]; }
        __syncthreads();
    }
}

__device__ __forceinline__ void ph_norm1(const Params& p) {
    const int tid = otid(), wave = tid >> 6, lane = tid & 63;
    const int gw = blockIdx.x * NWV + wave, GW = gridDim.x * NWV;
    const float* mod = (const float*)(p.ws + WS_MOD);
    bf16_t* hx = (bf16_t*)(p.ws + WS_HX);
    const float* g = p.in[I_GAPRE];
    for (int m = gw; m < MTOT; m += GW) {
        const float* src = (m < T) ? p.in[I_X] + (size_t)m * D : p.in[I_CTX] + (size_t)(m - T) * D;
        const int r = (m < T) ? (m >> 13) : 4;
        const float* shift = mod + r * 6144; const float* scale = shift + 1024;
        f32x4 v[4]; float ss = 0.f;
#pragma unroll
        for (int j = 0; j < 4; ++j) { v[j] = ((const f32x4*)src)[lane + 64 * j]; ss += v[j][0] * v[j][0] + v[j][1] * v[j][1] + v[j][2] * v[j][2] + v[j][3] * v[j][3]; }
        ss = wave_sum(ss);
        const float rs = 1.0f / sqrtf(ss * (1.0f / D) + EPS);
#pragma unroll
        for (int j = 0; j < 4; ++j) {
            const int col = 4 * (lane + 64 * j);
            const f32x4 g4 = *(const f32x4*)(g + col), sc4 = *(const f32x4*)(scale + col), sh4 = *(const f32x4*)(shift + col);
            float h[4];
#pragma unroll
            for (int i = 0; i < 4; ++i) h[i] = v[j][i] * rs * g4[i] * (1.f + sc4[i]) + sh4[i];
            uint2 o; o.x = pk2(h[0], h[1]); o.y = pk2(h[2], h[3]);
            *(uint2*)(hx + (size_t)m * D + col) = o;
        }
    }
}

namespace gp {
#define GP_LAS __attribute__((address_space(3)))
typedef short bf16x8 __attribute__((ext_vector_type(8)));
typedef unsigned u32x4 __attribute__((ext_vector_type(4)));
typedef int i32x4 __attribute__((ext_vector_type(4)));
constexpr int BM = 256, BK = 64, HALF = 128, HTB = HALF * BK * 2, STAGE_BYTES = 8 * HTB;
__device__ __forceinline__ int lds_byte(int r, int c) { const int st = (r >> 4) * 2 + (c >> 5), rr = r & 15, cc = c & 31, ob = rr * 64 + cc * 2; return st * 1024 + (ob ^ (((ob >> 9) & 1) << 5)); }
__device__ __forceinline__ void stage_rc(int b, int& R, int& C) { const int st = b / 1024, sb = b % 1024, swz = sb ^ (((sb >> 9) & 1) << 5); R = (st >> 1) * 16 + swz / 64; C = (st & 1) * 32 + (swz % 64) / 2; }
__device__ __forceinline__ int perm32(int rho) { const int n = rho >> 4, i = rho & 15; return 8 * (i >> 2) + 4 * n + (i & 3); }
struct Unit { int pm, pn, e, b, cnt, base; };
__device__ __forceinline__ unsigned cvt_pk_bf16(float lo, float hi) { unsigned r; asm volatile("v_cvt_pk_bf16_f32 %0, %1, %2" : "=v"(r) : "v"(lo), "v"(hi)); return r; }

template <class Epi, class Sched, bool ALIGN_EPI, bool F8 = false>
__device__ __forceinline__ void gemm_phase(const int wv, GP_LAS unsigned char* lds, const char* Abase, const int K, const Sched& S, const Epi& E) {
    const int wid = wv, wr = wid >> 2, wc = wid & 3;
    const int nt = K / BK;
    unsigned voffB[2];
#pragma unroll
    for (int i = 0; i < 2; ++i) { int R, C; stage_rc(otid_w(wv) * 16 + i * 8192, R, C); const int Rb = (R & ~31) + perm32(R & 31); voffB[i] = (unsigned)(Rb * K + C) * 2u; }
#define GP_AOFFS(u, o00, o01, o10, o11) do { int R0, C0, R1, C1; const int t_ = otid_w(wv); stage_rc(t_ * 16, R0, C0); stage_rc(t_ * 16 + 8192, R1, C1); \
        o00 = S.arow(u, R0) + (unsigned)C0 * 2u; o01 = S.arow(u, R1) + (unsigned)C1 * 2u; o10 = S.arow(u, HALF + R0) + (unsigned)C0 * 2u; o11 = S.arow(u, HALF + R1) + (unsigned)C1 * 2u; } while (0)
    const size_t kstep = (size_t)(BK * 2);
    const size_t hstep = (size_t)HALF * K * 2;
    const unsigned ldsw = (unsigned)wid * 1024u;
    int aoff, boff; { const int l_ = lane_id(), fr = l_ & 15, fq = l_ >> 4; aoff = lds_byte(wr * 64 + fr, fq * 8); boff = lds_byte(wc * 32 + fr, fq * 8); }
#define GP_SA(b, h) (((b) * 2 + (h)) * HTB)
#define GP_SB(b, h) ((4 + (b) * 2 + (h)) * HTB)
#define GP_STAGE_B(bufoff, gbase) do { _Pragma("unroll") for (int _i = 0; _i < 2; ++_i) \
        __builtin_amdgcn_global_load_lds((const unsigned*)((const char*)(gbase) + voffB[_i]), (GP_LAS unsigned*)(lds + (bufoff) + ldsw + _i * 8192), 16, 0, 0); } while (0)
#define GP_STAGE_A(bufoff, gbase, o0, o1) do { \
        __builtin_amdgcn_global_load_lds((const unsigned*)((const char*)(gbase) + (o0)), (GP_LAS unsigned*)(lds + (bufoff) + ldsw), 16, 0, 0); \
        __builtin_amdgcn_global_load_lds((const unsigned*)((const char*)(gbase) + (o1)), (GP_LAS unsigned*)(lds + (bufoff) + ldsw + 8192), 16, 0, 0); } while (0)
#define GP_LDA(dst, b, h) do { _Pragma("unroll") for (int m = 0; m < 4; ++m) _Pragma("unroll") for (int k = 0; k < 2; ++k) dst[m][k] = *(const GP_LAS bf16x8*)(lds + GP_SA(b, h) + aoff + m * 2048 + k * 1024); } while (0)
#define GP_LDB(dst, b, h) do { _Pragma("unroll") for (int n = 0; n < 2; ++n) _Pragma("unroll") for (int k = 0; k < 2; ++k) dst[n][k] = *(const GP_LAS bf16x8*)(lds + GP_SB(b, h) + boff + n * 2048 + k * 1024); } while (0)
#define GP_CAT8(x) __builtin_shufflevector(__builtin_bit_cast(i32x4, x[0]), __builtin_bit_cast(i32x4, x[1]), 0, 1, 2, 3, 4, 5, 6, 7)
#define GP_MMA(ai, bj, At, Bt) do { __builtin_amdgcn_s_setprio(1); _Pragma("unroll") for (int m = 0; m < 4; ++m) _Pragma("unroll") for (int n = 0; n < 2; ++n) { \
        if constexpr (F8) acc[ai][bj][m][n] = __builtin_amdgcn_mfma_scale_f32_16x16x128_f8f6f4(GP_CAT8(Bt[n]), GP_CAT8(At[m]), acc[ai][bj][m][n], 0, 0, 0, 0, 0, 0); \
        else { _Pragma("unroll") for (int k = 0; k < 2; ++k) acc[ai][bj][m][n] = __builtin_amdgcn_mfma_f32_16x16x32_bf16(Bt[n][k], At[m][k], acc[ai][bj][m][n], 0, 0, 0); } } \
        __builtin_amdgcn_s_setprio(0); } while (0)
#define GP_WAIT_V(n) asm volatile("s_waitcnt vmcnt(" #n ")" ::: "memory")
#define GP_WAIT_L(n) asm volatile("s_waitcnt lgkmcnt(" #n ")" ::: "memory")
#define GP_BAR __builtin_amdgcn_s_barrier()
#define GP_SCHED __builtin_amdgcn_sched_barrier(0)
    Unit cur, nxt; int ui = 0;
    if (!S.next(0, cur)) return;
    f32x4 acc[2][2][4][2];
#pragma unroll
    for (int a = 0; a < 2; ++a)
#pragma unroll
        for (int b = 0; b < 2; ++b)
#pragma unroll
            for (int m = 0; m < 4; ++m)
#pragma unroll
                for (int n = 0; n < 2; ++n) acc[a][b][m][n] = (f32x4){0.f, 0.f, 0.f, 0.f};
    bf16x8 At[4][2], B0[2][2], B1[2][2];
    unsigned ac00, ac01, ac10, ac11, an00, an01, an10, an11;
    GP_AOFFS(cur, ac00, ac01, ac10, ac11);
    const char* cB = S.bptr(cur);
    GP_STAGE_B(GP_SB(0, 0), cB); GP_STAGE_B(GP_SB(0, 1), cB + hstep); GP_STAGE_A(GP_SA(0, 0), Abase, ac00, ac01); GP_STAGE_A(GP_SA(0, 1), Abase, ac10, ac11);
    if (wr == 1) GP_BAR;
    GP_WAIT_V(2); GP_BAR;
    GP_STAGE_B(GP_SB(1, 0), cB + kstep); GP_STAGE_A(GP_SA(1, 0), Abase + kstep, ac00, ac01); GP_STAGE_B(GP_SB(1, 1), cB + hstep + kstep);
    GP_WAIT_V(6); GP_BAR;
    for (;;) {
        const bool has_next = S.next(ui + 1, nxt);
        if (has_next) { GP_AOFFS(nxt, an00, an01, an10, an11); }
        else { an00 = ac00; an01 = ac01; an10 = ac10; an11 = ac11; }
        const char* nB = has_next ? S.bptr(nxt) : cB;
#pragma unroll 1
        for (int t = 0; t < nt; t += 2) {
            const bool last = (t == nt - 2);
            const char* a1 = Abase + (size_t)(t + 1) * kstep;
            const char* a2 = last ? Abase : Abase + (size_t)(t + 2) * kstep; const char* b2 = last ? nB : cB + (size_t)(t + 2) * kstep;
            const char* a3 = a2 + kstep; const char* b3 = b2 + kstep;
            GP_LDB(B0, 0, 0); GP_LDB(B1, 0, 1); GP_SCHED; GP_LDA(At, 0, 0); GP_STAGE_A(GP_SA(1, 1), a1, ac10, ac11);
            if (last) { ac00 = an00; ac01 = an01; ac10 = an10; ac11 = an11; }
            GP_WAIT_V(8); GP_WAIT_L(0); GP_BAR; GP_MMA(0, 0, At, B0); GP_MMA(0, 1, At, B1); GP_BAR; GP_SCHED;
            GP_LDA(At, 0, 1); GP_STAGE_B(GP_SB(0, 0), b2); GP_STAGE_B(GP_SB(0, 1), b2 + hstep); GP_STAGE_A(GP_SA(0, 0), a2, ac00, ac01);
            GP_WAIT_V(8); GP_WAIT_L(0); GP_BAR; GP_MMA(1, 0, At, B0); GP_MMA(1, 1, At, B1); GP_BAR; GP_SCHED;
            GP_LDB(B0, 1, 0); GP_LDB(B1, 1, 1); GP_SCHED; GP_LDA(At, 1, 0); GP_STAGE_A(GP_SA(0, 1), a2, ac10, ac11);
            GP_WAIT_V(8); GP_WAIT_L(0); GP_BAR; GP_MMA(0, 0, At, B0); GP_MMA(0, 1, At, B1); GP_BAR; GP_SCHED;
            GP_LDA(At, 1, 1); GP_STAGE_B(GP_SB(1, 0), b3); GP_STAGE_B(GP_SB(1, 1), b3 + hstep); GP_STAGE_A(GP_SA(1, 0), a3, ac00, ac01);
            GP_WAIT_V(8); GP_WAIT_L(0); GP_BAR; GP_MMA(1, 0, At, B0); GP_MMA(1, 1, At, B1); GP_BAR; GP_SCHED;
        }
        if constexpr (ALIGN_EPI) { if (wr == 0) GP_BAR; }
        { const int l_ = lane_id(); E(acc, cur, wr, wc, l_ & 15, l_ >> 4); }
        if (!has_next) break;
#pragma unroll
        for (int a = 0; a < 2; ++a)
#pragma unroll
            for (int b = 0; b < 2; ++b)
#pragma unroll
                for (int m = 0; m < 4; ++m)
#pragma unroll
                    for (int n = 0; n < 2; ++n) acc[a][b][m][n] = (f32x4){0.f, 0.f, 0.f, 0.f};
        cur = nxt; cB = nB; ++ui;
        if constexpr (ALIGN_EPI) { if (wr == 1) GP_BAR; }
    }
    GP_WAIT_V(0);
    if constexpr (!ALIGN_EPI) { if (wr == 0) GP_BAR; }
    GP_BAR;
#undef GP_AOFFS
#undef GP_SA
#undef GP_SB
#undef GP_STAGE_A
#undef GP_STAGE_B
#undef GP_LDA
#undef GP_LDB
#undef GP_MMA
#undef GP_CAT8
#undef GP_WAIT_V
#undef GP_WAIT_L
#undef GP_BAR
#undef GP_SCHED
}

struct DenseSched {
    int nM, nN, nwg, G, c, K; const char* Bt;
    __device__ __forceinline__ void init(int M, int N, int K_, const void* Bt_, int G_, int c_) { nM = M / BM; nN = N / BM; nwg = nM * nN; G = G_; c = c_; K = K_; Bt = (const char*)Bt_; }
    __device__ __forceinline__ bool next(int i, Unit& u) const {
        const long L = (long)i * G + c; if (L >= nwg) return false;
        int wgid = (int)L; { const int q = nwg / 8, r = nwg % 8, xcd = wgid % 8, off = wgid / 8; wgid = (xcd < r ? xcd * (q + 1) : r * (q + 1) + (xcd - r) * q) + off; }
        const int nig = 8 * nN, gid = wgid / nig, fm = gid * 8, gsz = (nM - fm) < 8 ? (nM - fm) : 8;
        u.pm = fm + ((wgid % nig) % gsz); u.pn = (wgid % nig) / gsz; u.e = 0; u.b = 0; u.cnt = 0; u.base = 0; return true;
    }
    __device__ __forceinline__ unsigned arow(const Unit& u, int r) const { return (unsigned)(u.pm * BM + r) * (unsigned)(K * 2); }
    __device__ __forceinline__ const char* bptr(const Unit& u) const { return Bt + (size_t)u.pn * BM * K * 2; }
};
}

struct EpiInProj {
    bf16_t* F; bf16_t* Q; bf16_t* Kb; bf16_t* Vb; const float* rope;
    __device__ __forceinline__ void operator()(const f32x4 (&acc)[2][2][4][2], const gp::Unit& u, int wr, int wc, int fr, int fq) const {
        const int pn = u.pn, pm = u.pm; const bool isctx = pm >= T / 256;
        if (isctx && pn < 4) return;
        if (pn >= 7) {
            unsigned char* V8 = (unsigned char*)Vb;
#pragma unroll
            for (int ai = 0; ai < 2; ++ai) {
                const int row0 = pm * 256 + ai * 128 + wr * 64;
                int b, tile;
                if (!isctx) { b = row0 >> 13; tile = (CTX >> 6) + ((row0 & 8191) >> 6); } else { const int j = row0 - T; b = j >> 8; tile = (j & 255) >> 6; }
#pragma unroll
                for (int bj = 0; bj < 2; ++bj) {
                    const int head = (pn - 7) * 2 + bj;
                    unsigned char* dst = V8 + ((size_t)(b * NH + head) * (KVLEN / 64) + tile) * 8192 + wc * 2048 + fq * 64 + (fr >> 3) * 32 + (fr & 1) * 16 + ((fr >> 1) & 3) * 4;
#pragma unroll
                    for (int e = 0; e < 8; ++e) {
                        int w = __builtin_amdgcn_cvt_pk_fp8_f32(acc[ai][bj][0][e >> 2][e & 3], acc[ai][bj][1][e >> 2][e & 3], 0, false);
                        w = __builtin_amdgcn_cvt_pk_fp8_f32(acc[ai][bj][2][e >> 2][e & 3], acc[ai][bj][3][e >> 2][e & 3], w, true);
                        *(int*)(dst + e * 256) = w;
                    }
                }
            }
            return;
        }
        const int axis = wc & 1; const float* ct = rope + (axis ? 4096 : 0); const float* st = rope + (axis ? 4096 + 1024 : 2048);
#pragma unroll
        for (int ai = 0; ai < 2; ++ai)
#pragma unroll
            for (int m = 0; m < 4; ++m) {
                const int row = pm * 256 + ai * 128 + wr * 64 + m * 16 + fr;
                int t, kb, tile;
                if (!isctx) { kb = row >> 13; t = row & 8191; tile = (CTX >> 6) + (t >> 6); } else { const int j = row - T; t = 0; kb = j >> 8; tile = (j & 255) >> 6; }
                const int pos = axis ? (t & 63) : (t >> 6);
#pragma unroll
                for (int bj = 0; bj < 2; ++bj) {
                    const int col0 = pn * 256 + bj * 128 + wc * 32 + fq * 8;
                    f32x4 v0 = acc[ai][bj][m][0], v1 = acc[ai][bj][m][1];
                    if (pn == 0) { gp::u32x4 w; w.x = gp::cvt_pk_bf16(v0[0], v0[1]); w.y = gp::cvt_pk_bf16(v0[2], v0[3]); w.z = gp::cvt_pk_bf16(v1[0], v1[1]); w.w = gp::cvt_pk_bf16(v1[2], v1[3]);
                        *(gp::u32x4*)(F + (size_t)row * 256 + col0) = w; continue; }
                    if (pn < 7 && !isctx) {
                        const f32x4 c0 = *(const f32x4*)(ct + pos * 16 + 8 * (fq & 1)), c1 = *(const f32x4*)(ct + pos * 16 + 8 * (fq & 1) + 4);
                        const f32x4 s0 = *(const f32x4*)(st + pos * 16 + 8 * (fq & 1)), s1 = *(const f32x4*)(st + pos * 16 + 8 * (fq & 1) + 4);
                        const float sg = (fq < 2) ? -1.f : 1.f;
#pragma unroll
                        for (int i = 0; i < 4; ++i) {
                            const auto r0 = __builtin_amdgcn_permlane32_swap(__float_as_uint(v0[i]), __float_as_uint(v0[i]), false, false);
                            const auto r1 = __builtin_amdgcn_permlane32_swap(__float_as_uint(v1[i]), __float_as_uint(v1[i]), false, false);
                            const float p0 = __uint_as_float(fq < 2 ? r0[1] : r0[0]), p1 = __uint_as_float(fq < 2 ? r1[1] : r1[0]);
                            v0[i] = v0[i] * c0[i] + sg * p0 * s0[i]; v1[i] = v1[i] * c1[i] + sg * p1 * s1[i]; }
                    }
                    v0 = v0 * SQS; v1 = v1 * SQS;
                    int w0 = __builtin_amdgcn_cvt_pk_fp8_f32(v0[0], v0[1], 0, false); w0 = __builtin_amdgcn_cvt_pk_fp8_f32(v0[2], v0[3], w0, true);
                    int w1 = __builtin_amdgcn_cvt_pk_fp8_f32(v1[0], v1[1], 0, false); w1 = __builtin_amdgcn_cvt_pk_fp8_f32(v1[2], v1[3], w1, true);
                    unsigned char* d;
                    if (pn < 4) d = (unsigned char*)Q + (size_t)row * QKW + (col0 - 256);
                    else d = (unsigned char*)Kb + ((size_t)(kb * NH + (pn - 4) * 2 + bj) * (KVLEN / 64) + tile) * 8192 + wc * 2048 + m * 512 + fr * 32 + fq * 8;
                    typedef int i32x2_t __attribute__((ext_vector_type(2)));
                    *(i32x2_t*)d = (i32x2_t){w0, w1};
                }
            }
    }
};
struct EpiStoreBf16 {
    bf16_t* O; int ldc;
    __device__ __forceinline__ void operator()(const f32x4 (&acc)[2][2][4][2], const gp::Unit& u, int wr, int wc, int fr, int fq) const {
#pragma unroll
        for (int ai = 0; ai < 2; ++ai)
#pragma unroll
            for (int m = 0; m < 4; ++m) {
                bf16_t* rowp = O + (size_t)(u.pm * 256 + ai * 128 + wr * 64 + m * 16 + fr) * ldc + u.pn * 256 + wc * 32 + fq * 8;
#pragma unroll
                for (int bj = 0; bj < 2; ++bj) { const f32x4 v0 = acc[ai][bj][m][0], v1 = acc[ai][bj][m][1];
                    gp::u32x4 w; w.x = gp::cvt_pk_bf16(v0[0], v0[1]); w.y = gp::cvt_pk_bf16(v0[2], v0[3]); w.z = gp::cvt_pk_bf16(v1[0], v1[1]); w.w = gp::cvt_pk_bf16(v1[2], v1[3]);
                    *(gp::u32x4*)(rowp + bj * 128) = w; }
            }
    }
};

__device__ __forceinline__ void ph_inproj(const Params& p, unsigned char* smem) {
    unsigned char* ws = p.ws;
    gp::DenseSched S; S.init(MTOT, INW, D, ws + WS_WINT, gridDim.x, blockIdx.x);
    EpiInProj E{(bf16_t*)(ws + WS_F), (bf16_t*)(ws + WS_Q), (bf16_t*)(ws + WS_K), (bf16_t*)(ws + WS_V), (const float*)(ws + WS_ROPE)};
    gp::gemm_phase<EpiInProj, gp::DenseSched, true>(p.chunk, (GP_LAS unsigned char*)smem, (const char*)(ws + WS_HX), D, S, E);
}
__device__ __forceinline__ void ph_outproj(const Params& p, unsigned char* smem) {
    unsigned char* ws = p.ws;
    gp::DenseSched S; S.init(T, D, D, ws + WS_WOUTT, gridDim.x, blockIdx.x);
    EpiStoreBf16 E{(bf16_t*)(ws + WS_YX), D};
    gp::gemm_phase<EpiStoreBf16, gp::DenseSched, true>(p.chunk, (GP_LAS unsigned char*)smem, (const char*)(ws + WS_AO), D, S, E);
}

constexpr float GUSCALE = 64.f;
__device__ __forceinline__ void transpose_item8(const float* W, int K, int N, unsigned char* WT, int row_base, int kb, int nb, float* scr, int lane) {
    const int k0 = 64 * kb, n0 = 32 * nb;
    float tv[32];
#pragma unroll
    for (int i = 0; i < 32; ++i) tv[i] = W[(size_t)(k0 + 2 * i + (lane >> 5)) * N + n0 + (lane & 31)];
#pragma unroll
    for (int i = 0; i < 32; ++i) scr[(2 * i + (lane >> 5)) * 33 + (lane & 31)] = tv[i] * GUSCALE;
    asm volatile("s_waitcnt lgkmcnt(0)" ::: "memory");
    const int c = lane & 7;
#pragma unroll
    for (int j = 0; j < 4; ++j) { const int n = (lane >> 3) + 8 * j; const float* s = scr + (8 * c) * 33 + n;
        int w0 = __builtin_amdgcn_cvt_pk_fp8_f32(s[0 * 33], s[1 * 33], 0, false); w0 = __builtin_amdgcn_cvt_pk_fp8_f32(s[2 * 33], s[3 * 33], w0, true);
        int w1 = __builtin_amdgcn_cvt_pk_fp8_f32(s[4 * 33], s[5 * 33], 0, false); w1 = __builtin_amdgcn_cvt_pk_fp8_f32(s[6 * 33], s[7 * 33], w1, true);
        uint2 o; o.x = (unsigned)w0; o.y = (unsigned)w1;
        *(uint2*)(WT + (size_t)(row_base + n0 + n) * K + k0 + 8 * c) = o; }
    asm volatile("s_waitcnt lgkmcnt(0)" ::: "memory");
}
__device__ __forceinline__ void transpose_item(const float* W, int K, int N, bf16_t* WT, int row_base, int kb, int nb, float* scr, int lane) {
    const int k0 = 64 * kb, n0 = 32 * nb;
    float tv[32];
#pragma unroll
    for (int i = 0; i < 32; ++i) tv[i] = W[(size_t)(k0 + 2 * i + (lane >> 5)) * N + n0 + (lane & 31)];
#pragma unroll
    for (int i = 0; i < 32; ++i) scr[(2 * i + (lane >> 5)) * 33 + (lane & 31)] = tv[i];
    asm volatile("s_waitcnt lgkmcnt(0)" ::: "memory");
    const int c = lane & 7;
#pragma unroll
    for (int j = 0; j < 4; ++j) { const int n = (lane >> 3) + 8 * j; const float* s = scr + (8 * c) * 33 + n;
        uint4 o; o.x = pk2(s[0 * 33], s[1 * 33]); o.y = pk2(s[2 * 33], s[3 * 33]); o.z = pk2(s[4 * 33], s[5 * 33]); o.w = pk2(s[6 * 33], s[7 * 33]);
        *(uint4*)(WT + (size_t)(row_base + n0 + n) * K + k0 + 8 * c) = o; }
    asm volatile("s_waitcnt lgkmcnt(0)" ::: "memory");
}
__device__ __forceinline__ void ph_prep_weights(const Params& p, float* lds, const int part, const int first) {
    const int tid = otid(), wave = tid >> 6, lane = tid & 63;
    float* scr = lds + 8192 + wave * (64 * 33);
    if ((int)blockIdx.x < first) return;
    const int gw = ((int)blockIdx.x - first) * NWV + wave, GW = ((int)gridDim.x - first) * NWV;
    unsigned char* ws = p.ws;
    constexpr int I_IN = 16 * 80, I_OUT = 16 * 32, I_GU = 16 * 8, I_D = 4 * 32;
    constexpr int NITEMS = I_IN + I_OUT + 65 * (2 * I_GU + I_D);
    const int it_lo = part ? I_IN + I_OUT : 0, it_hi = part ? NITEMS : I_IN + I_OUT;
    for (int it = it_lo + gw; it < it_hi; it += GW) {
        int r = it;
        if (r < I_IN) { transpose_item(p.in[I_WIN], D, INW, (bf16_t*)(ws + WS_WINT), 0, r / 80, r % 80, scr, lane); continue; } r -= I_IN;
        if (r < I_OUT) { transpose_item(p.in[I_WOUT], D, D, (bf16_t*)(ws + WS_WOUTT), 0, r / 32, r % 32, scr, lane); continue; } r -= I_OUT;
        const int e = r / (2 * I_GU + I_D); r -= e * (2 * I_GU + I_D);
        if (r < 2 * I_GU) {
            const int half = r / I_GU, q = r % I_GU, kb = q / 8, nb = q % 8;
            const float* W = (e < 64) ? p.in[half ? I_WU : I_WG] + (size_t)e * D * DE : p.in[half ? I_WSU : I_WSG];
            const int n0 = 32 * nb, drow = e * 512 + (n0 >> 7) * 256 + half * 128 + (n0 & 127);
            transpose_item8(W, D, DE, ws + WS_WGUT, drow - n0, kb, nb, scr, lane);
        } else {
            r -= 2 * I_GU;
            const float* W = (e < 64) ? p.in[I_WD] + (size_t)e * DE * D : p.in[I_WSD];
            transpose_item(W, DE, D, (bf16_t*)(ws + WS_WDT), e * 1024, r / 32, r % 32, scr, lane);
        }
    }
}

namespace fa {
typedef short bf16x8 __attribute__((ext_vector_type(8)));
typedef short s16x4 __attribute__((ext_vector_type(4)));
typedef float f32x16 __attribute__((ext_vector_type(16)));
typedef unsigned u32x4 __attribute__((ext_vector_type(4)));
constexpr int KVBLK = 64, LDK = QKW;
constexpr float SCALE = 0.125f, THR = 8.f;
constexpr size_t SHM_V = KVBLK * 128 * 2, SHM_K = KVBLK * 128 * 2;
#define KSWZ(row, colB) ((row) * 256 + ((colB) ^ (((row) & 15) << 4)))
#define SBAR() __builtin_amdgcn_sched_barrier(0)
__device__ __forceinline__ int crow(int r, int hi) { return (r & 3) + 8 * (r >> 2) + 4 * hi; }
__device__ __forceinline__ unsigned cvtpk(float lo, float hi) { unsigned r; asm volatile("v_cvt_pk_bf16_f32 %0, %1, %2" : "=v"(r) : "v"(lo), "v"(hi)); return r; }
constexpr float PBIAS = 5.f, THR2 = PBIAS + 3.5f;
template <bool FIRST>
__device__ __forceinline__ void partialSM(f32x16& p0, f32x16& p1, float& m_reg, f32x16& negm, float& alpha) {
  float pmax = p0[0];
#pragma unroll
  for (int r = 1; r < 16; ++r) pmax = fmaxf(pmax, p0[r]);
#pragma unroll
  for (int r = 0; r < 16; ++r) pmax = fmaxf(pmax, p1[r]);
  { auto rr = __builtin_amdgcn_permlane32_swap(__float_as_uint(pmax), __float_as_uint(pmax), false, false);
    pmax = fmaxf(__uint_as_float(rr[0]), __uint_as_float(rr[1])); }
  if (!FIRST && __builtin_expect(__all(pmax <= THR2), 1)) { alpha = 1.f; }
  else { const float dl = FIRST ? pmax - PBIAS : fmaxf(pmax - PBIAS, 0.f); alpha = FIRST ? 0.f : __builtin_amdgcn_exp2f(-dl); m_reg += dl;
#pragma unroll
    for (int r = 0; r < 16; ++r) { p0[r] -= dl; p1[r] -= dl; }
#pragma unroll
    for (int r = 0; r < 16; ++r) negm[r] = -m_reg;
    asm volatile("" : "+v"(negm)); }
#pragma unroll
  for (int r = 0; r < 16; ++r) p0[r] = __builtin_amdgcn_exp2f(p0[r]);
}
typedef int i32x8 __attribute__((ext_vector_type(8)));
__device__ __forceinline__ void finishSM_T(f32x16& p0, f32x16& p1, float alpha, float& l_reg, i32x8& pb) {
#pragma unroll
  for (int r = 0; r < 16; ++r) p1[r] = __builtin_amdgcn_exp2f(p1[r]);
  float ps = 0;
#pragma unroll
  for (int r = 0; r < 16; ++r) ps += p0[r];
#pragma unroll
  for (int r = 0; r < 16; ++r) ps += p1[r];
  { auto rr = __builtin_amdgcn_permlane32_swap(__float_as_uint(ps), __float_as_uint(ps), false, false);
    ps = __uint_as_float(rr[0]) + __uint_as_float(rr[1]); }
  l_reg = l_reg * alpha + ps;
#pragma unroll
  for (int g = 0; g < 4; ++g) {
    int w0 = __builtin_amdgcn_cvt_pk_fp8_f32(p0[4 * g], p0[4 * g + 1], 0, false); w0 = __builtin_amdgcn_cvt_pk_fp8_f32(p0[4 * g + 2], p0[4 * g + 3], w0, true); pb[g] = w0;
    int w1 = __builtin_amdgcn_cvt_pk_fp8_f32(p1[4 * g], p1[4 * g + 1], 0, false); w1 = __builtin_amdgcn_cvt_pk_fp8_f32(p1[4 * g + 2], p1[4 * g + 3], w1, true); pb[4 + g] = w1; }
}
__device__ __forceinline__ void qkt(f32x16& p0, f32x16& p1, const char* Ks, const i32x8 qf, int lane, int mm, const f32x16& negm) {
  const char* kp = Ks + mm * 4096 + lane * 16;
  const u32x4 a0 = *reinterpret_cast<const u32x4*>(kp), a1 = *reinterpret_cast<const u32x4*>(kp + 1024), b0 = *reinterpret_cast<const u32x4*>(kp + 2048), b1 = *reinterpret_cast<const u32x4*>(kp + 3072);
  p0 = __builtin_amdgcn_mfma_scale_f32_32x32x64_f8f6f4((i32x8){(int)a0.x, (int)a0.y, (int)a0.z, (int)a0.w, (int)a1.x, (int)a1.y, (int)a1.z, (int)a1.w}, qf, negm, 0, 0, 0, 0, 0, 0);
  p1 = __builtin_amdgcn_mfma_scale_f32_32x32x64_f8f6f4((i32x8){(int)b0.x, (int)b0.y, (int)b0.z, (int)b0.w, (int)b1.x, (int)b1.y, (int)b1.z, (int)b1.w}, qf, negm, 0, 0, 0, 0, 0, 0);
}
__device__ __forceinline__ int v_st(int k, int c) { const int kk = (k & ~0xC) | ((k & 4) << 1) | ((k & 8) >> 1); return ((kk >> 3) * 4 + (c >> 5)) * 512 + ((kk & 7) * 32 + (c & 31)) * 2; }
__device__ __forceinline__ int v_rd_base(int lane) { return ((lane & 3) << 3) | (((lane >> 2) & 3) << 6) | (((lane >> 4) & 1) << 5) | (((lane >> 5) & 1) << 8); }
constexpr int v_rd_off(int d0, int ks, int half) { return d0 * 512 + ks * 4096 + half * 2048; }
template <int OFF> __device__ __forceinline__ s16x4 tr_read(int vb) {
  s16x4 r; asm volatile("ds_read_b64_tr_b16 %0, %1 offset:%2" : "=&v"(r) : "v"(vb), "i"(OFF) : "memory"); return r;
}
template <int D0> __device__ __forceinline__ void pv_one(f32x16& od, int vb, bf16x8 pa0, bf16x8 pa1, bf16x8 pa2, bf16x8 pa3) {
  const s16x4 l0 = tr_read<v_rd_off(D0, 0, 0)>(vb), h0 = tr_read<v_rd_off(D0, 0, 1)>(vb), l1 = tr_read<v_rd_off(D0, 1, 0)>(vb), h1 = tr_read<v_rd_off(D0, 1, 1)>(vb);
  const s16x4 l2 = tr_read<v_rd_off(D0, 2, 0)>(vb), h2 = tr_read<v_rd_off(D0, 2, 1)>(vb), l3 = tr_read<v_rd_off(D0, 3, 0)>(vb), h3 = tr_read<v_rd_off(D0, 3, 1)>(vb);
  asm volatile("s_waitcnt lgkmcnt(0)" ::: "memory"); SBAR();
#define PK(L, H) (bf16x8){L[0], L[1], L[2], L[3], H[0], H[1], H[2], H[3]}
  od = __builtin_amdgcn_mfma_f32_32x32x16_bf16(pa0, PK(l0, h0), od, 0, 0, 0);
  od = __builtin_amdgcn_mfma_f32_32x32x16_bf16(pa1, PK(l1, h1), od, 0, 0, 0);
  od = __builtin_amdgcn_mfma_f32_32x32x16_bf16(pa2, PK(l2, h2), od, 0, 0, 0);
  od = __builtin_amdgcn_mfma_f32_32x32x16_bf16(pa3, PK(l3, h3), od, 0, 0, 0);
#undef PK
}
__device__ __forceinline__ void pv_d0(f32x16* o, int vb, bf16x8 pa0, bf16x8 pa1, bf16x8 pa2, bf16x8 pa3) {
  pv_one<0>(o[0], vb, pa0, pa1, pa2, pa3); pv_one<1>(o[1], vb, pa0, pa1, pa2, pa3); pv_one<2>(o[2], vb, pa0, pa1, pa2, pa3); pv_one<3>(o[3], vb, pa0, pa1, pa2, pa3);
}

template <int OFF> __device__ __forceinline__ u32x4 rd128(int vb) { u32x4 r; asm volatile("ds_read_b128 %0, %1 offset:%2" : "=&v"(r) : "v"(vb), "i"(OFF) : "memory"); return r; }
#define PV_RD(D0) const u32x4 va##D0 = rd128<D0 * 2048>(vb), vc##D0 = rd128<D0 * 2048 + 1024>(vb); SBAR()
#define PV_MM(D0) do { asm volatile("s_waitcnt lgkmcnt(0)" ::: "memory"); SBAR(); \
    o[D0] = __builtin_amdgcn_mfma_scale_f32_32x32x64_f8f6f4((i32x8){(int)va##D0.x, (int)va##D0.y, (int)va##D0.z, (int)va##D0.w, (int)vc##D0.x, (int)vc##D0.y, (int)vc##D0.z, (int)vc##D0.w}, pb, o[D0], 0, 0, 0, 0, 0, 0); } while (0)
__device__ __forceinline__ float max3f(float a, float b, float c) { float r; asm("v_max3_f32 %0, %1, %2, %3" : "=v"(r) : "v"(a), "v"(b), "v"(c)); return r; }
__device__ __forceinline__ void pv_psm(f32x16* o, int vb, i32x8 pb, f32x16& p0, f32x16& p1, float& m_reg, f32x16& negm, float& alpha) {
  float pmax;
  { PV_RD(0);
    pmax = max3f(p0[0], p0[1], p0[2]);
#pragma unroll
    for (int r = 3; r < 15; r += 2) pmax = max3f(pmax, p0[r], p0[r + 1]);
    pmax = max3f(pmax, p0[15], p1[0]);
    SBAR(); PV_MM(0); }
  { PV_RD(1);
#pragma unroll
    for (int r = 1; r < 15; r += 2) pmax = max3f(pmax, p1[r], p1[r + 1]);
    pmax = max3f(pmax, p1[15], p1[15]);
    { auto rr = __builtin_amdgcn_permlane32_swap(__float_as_uint(pmax), __float_as_uint(pmax), false, false);
      pmax = max3f(__uint_as_float(rr[0]), __uint_as_float(rr[1]), __uint_as_float(rr[1])); }
    if (__builtin_expect(__all(pmax <= THR2), 1)) { alpha = 1.f; }
    else { const float dl = fmaxf(pmax - PBIAS, 0.f); alpha = __builtin_amdgcn_exp2f(-dl); m_reg += dl;
#pragma unroll
      for (int r = 0; r < 16; ++r) { p0[r] -= dl; p1[r] -= dl; }
#pragma unroll
      for (int r = 0; r < 16; ++r) negm[r] = -m_reg;
      asm volatile("" : "+v"(negm)); }
    SBAR(); PV_MM(1); }
  { PV_RD(2);
#pragma unroll
    for (int r = 0; r < 8; ++r) p0[r] = __builtin_amdgcn_exp2f(p0[r]);
    asm volatile("" : "+v"(p0));
    SBAR(); PV_MM(2); }
  { PV_RD(3);
#pragma unroll
    for (int r = 8; r < 16; ++r) p0[r] = __builtin_amdgcn_exp2f(p0[r]);
    asm volatile("" : "+v"(p0));
    SBAR(); PV_MM(3); }
}
__device__ __forceinline__ void pvT_d0(f32x16* o, int vb, i32x8 pb) {
  { PV_RD(0); PV_MM(0); } { PV_RD(1); PV_MM(1); } { PV_RD(2); PV_MM(2); } { PV_RD(3); PV_MM(3); }
}
#undef PV_RD
#undef PV_MM

__device__ __forceinline__ void attn_unit(const unsigned char* __restrict__ Qb, const unsigned char* __restrict__ Kh, const unsigned char* __restrict__ Vh, bf16_t* __restrict__ Ob,
                                          const float* __restrict__ gsub, const float lam, char* lds, const int wv) {
  typedef __attribute__((address_space(3))) unsigned* ldsu_t;
  const int tid = otid_w(wv), wid = wv, lane = tid & 63, r32 = lane & 31, hi = lane >> 5, mm = wid >> 2, wq = wid & 3;
  constexpr int NB = 4;
  constexpr int SHM_V8 = KVBLK * 128;
  char* V_lds = lds; char* K_lds = lds + NB * SHM_V8; constexpr int SHM_K8 = KVBLK * 128;
  float m_reg = 0.f, l_reg = 0; f32x16 o[4] = {}; i32x8 qf; f32x16 negm = {}; asm volatile("" : "+v"(negm));
  const unsigned koff = (unsigned)((2 * (wid >> 2) + (lane >> 5)) * 2048 + (lane & 3) * 512 + (8 * ((wid >> 1) & 1) + 2 * ((lane & 31) >> 3) + ((lane >> 2) & 1)) * 32 + (wid & 1) * 16);
  const unsigned voff = (unsigned)((wid >> 1) * 2048 + (lane & 7) * 256 + ((lane >> 3) & 3) * 64 + (wid & 1) * 32 + (lane >> 5) * 16);
#define DMA(t, buf) do { const char* kb_ = (const char*)(Kh + (size_t)(t) * SHM_K8); const char* vb_ = (const char*)(Vh + (size_t)(t) * SHM_V8); asm volatile("" : "+s"(kb_), "+s"(vb_)); \
    __builtin_amdgcn_global_load_lds((const unsigned*)(kb_ + koff), (ldsu_t)(K_lds + (buf) * SHM_K8 + wid * 1024), 16, 0, 0); \
    __builtin_amdgcn_global_load_lds((const unsigned*)(vb_ + voff), (ldsu_t)(V_lds + (buf) * SHM_V8 + wid * 1024), 16, 0, 0); } while (0)
#define WAIT_BAR(N) asm volatile("s_waitcnt vmcnt(" #N ") lgkmcnt(0)\n\ts_barrier" ::: "memory")
#define RESC(a) do { if (__any((a) < 1.f)) { _Pragma("unroll") for (int d = 0; d < 4; ++d) _Pragma("unroll") for (int r = 0; r < 16; ++r) o[d][r] *= (a); } } while (0)
  DMA(0, 0); DMA(1, 1);
  { const unsigned char* Qw = Qb + (long)(wq * 32 + r32) * QKW + mm * 64 + hi * 32;
    const u32x4 q0 = *reinterpret_cast<const u32x4*>(Qw), q1 = *reinterpret_cast<const u32x4*>(Qw + 16);
    qf = (i32x8){(int)q0.x, (int)q0.y, (int)q0.z, (int)q0.w, (int)q1.x, (int)q1.y, (int)q1.z, (int)q1.w}; }
  const int vb0 = (int)(uintptr_t)V_lds + lane * 16;
  f32x16 pA0, pA1, pB0, pB1; float alA, alB; i32x8 pb; constexpr int NTL = KVLEN / KVBLK;
  WAIT_BAR(0);
  DMA(2, 2);
  qkt(pA0, pA1, K_lds, qf, lane, mm, negm); partialSM<true>(pA0, pA1, m_reg, negm, alA);
  WAIT_BAR(2);
  for (int j = 1; j + 1 < NTL; j += 2) {
    DMA(j + 2, (j + 2) & 3);
    SBAR(); qkt(pB0, pB1, K_lds + (j & 3) * SHM_K8, qf, lane, mm, negm);
    finishSM_T(pA0, pA1, alA, l_reg, pb); SBAR();
    pv_psm(o, vb0 + ((j - 1) & 3) * SHM_V8, pb, pB0, pB1, m_reg, negm, alB);
    RESC(alB);
    WAIT_BAR(2);
    if (j + 3 < NTL) DMA(j + 3, (j + 3) & 3);
    SBAR(); qkt(pA0, pA1, K_lds + ((j + 1) & 3) * SHM_K8, qf, lane, mm, negm);
    finishSM_T(pB0, pB1, alB, l_reg, pb); SBAR();
    pv_psm(o, vb0 + (j & 3) * SHM_V8, pb, pA0, pA1, m_reg, negm, alA);
    RESC(alA);
    if (j + 3 < NTL) WAIT_BAR(2); else WAIT_BAR(0);
  }
  SBAR(); qkt(pB0, pB1, K_lds + ((NTL - 1) & 3) * SHM_K8, qf, lane, mm, negm);
  finishSM_T(pA0, pA1, alA, l_reg, pb); SBAR();
  pv_psm(o, vb0 + ((NTL - 2) & 3) * SHM_V8, pb, pB0, pB1, m_reg, negm, alB);
  RESC(alB);
  finishSM_T(pB0, pB1, alB, l_reg, pb); SBAR();
  pvT_d0(o, vb0 + ((NTL - 1) & 3) * SHM_V8, pb);
#undef DMA
#undef WAIT_BAR
  const float rl = __builtin_amdgcn_rcpf(l_reg) * (mm ? lam : 1.0f);
  __syncthreads();
  constexpr int XS = 132;
  float* X = (float*)lds;
  if (mm == 1) {
#pragma unroll
    for (int r = 0; r < 16; ++r)
#pragma unroll
      for (int d0 = 0; d0 < 4; ++d0) X[(wq * 32 + r32) * XS + d0 * 32 + crow(r, hi)] = o[d0][r] * rl;
  }
  __syncthreads();
  if (mm == 0) {
#pragma unroll
    for (int r = 0; r < 16; ++r)
#pragma unroll
      for (int d0 = 0; d0 < 4; ++d0) { float* xp = X + (wq * 32 + r32) * XS + d0 * 32 + crow(r, hi); *xp = o[d0][r] * rl - *xp; }
  }
  __syncthreads();
  {
    const int row = tid >> 2, seg = tid & 3;
    const float* xr = X + row * XS + seg * 32;
    f32x4 v[8]; float ss = 0.f;
#pragma unroll
    for (int i = 0; i < 8; ++i) { v[i] = *(const f32x4*)(xr + 4 * i); ss += v[i][0] * v[i][0] + v[i][1] * v[i][1] + v[i][2] * v[i][2] + v[i][3] * v[i][3]; }
    ss += sx<1>(ss); ss += sx<2>(ss);
    const float rs = (1.0f - LAM_INIT) / sqrtf(ss * (1.0f / 128.0f) + EPS);
    bf16_t* dst = Ob + (long)row * D + seg * 32;
#pragma unroll
    for (int i = 0; i < 8; i += 2) {
      const f32x4 g0 = *(const f32x4*)(gsub + seg * 32 + 4 * i), g1 = *(const f32x4*)(gsub + seg * 32 + 4 * i + 4);
      u32x4 w; w.x = cvtpk(v[i][0] * rs * g0[0], v[i][1] * rs * g0[1]); w.y = cvtpk(v[i][2] * rs * g0[2], v[i][3] * rs * g0[3]);
      w.z = cvtpk(v[i + 1][0] * rs * g1[0], v[i + 1][1] * rs * g1[1]); w.w = cvtpk(v[i + 1][2] * rs * g1[2], v[i + 1][3] * rs * g1[3]);
      *(u32x4*)(dst + 4 * i) = w;
    }
  }
  __syncthreads();
#undef RESC
}
#undef KSWZ
#undef SBAR
}

__device__ __forceinline__ void ph_attn(const Params& p, unsigned char* smem) {
    unsigned char* ws = p.ws;
    const unsigned char* Q = ws + WS_Q; const unsigned char* Kb = ws + WS_K; const unsigned char* Vb = ws + WS_V;
    bf16_t* AO = (bf16_t*)(ws + WS_AO);
    const float lam = ((const float*)(ws + WS_CTL))[1024];
    const int c = blockIdx.x, G = gridDim.x;
    if (G == 256) {
        const int x = c & 7, s = c >> 3;
        for (int rd = 0; rd < 6; ++rd) {
            const int bh = rd * 4 + (x >> 1), qb = (x & 1) * 32 + s, b = bh / NH, h = bh % NH;
            fa::attn_unit(Q + ((size_t)b * SEQ + qb * 128) * QKW + h * 128, Kb + (size_t)(b * NH + h) * (KVLEN / 64) * 8192, Vb + (size_t)(b * NH + h) * (KVLEN / 64) * 8192,
                          AO + ((size_t)b * SEQ + qb * 128) * D + 256 + h * 128, p.in[I_GSUB], lam, (char*)smem, p.chunk);
        }
    } else {
        for (int u = c; u < BATCH * NH * 64; u += G) {
            const int bh = u >> 6, qb = u & 63, b = bh / NH, h = bh % NH;
            fa::attn_unit(Q + ((size_t)b * SEQ + qb * 128) * QKW + h * 128, Kb + (size_t)(b * NH + h) * (KVLEN / 64) * 8192, Vb + (size_t)(b * NH + h) * (KVLEN / 64) * 8192,
                          AO + ((size_t)b * SEQ + qb * 128) * D + 256 + h * 128, p.in[I_GSUB], lam, (char*)smem, p.chunk);
        }
    }
}

__device__ __forceinline__ void ph_fourierA(const Params& p, unsigned char* smem) {
    using namespace fa;
    unsigned char* ws = p.ws;
    const bf16_t* F = (const bf16_t*)(ws + WS_F); bf16_t* FY = (bf16_t*)(ws + WS_FY); const bf16_t* W = (const bf16_t*)(ws + WS_W128E);
    const int tid = otid(), wid = tid >> 6, lane = tid & 63, r32 = lane & 31, hi = lane >> 5;
    const int sr = tid >> 4, sc = (tid & 15) * 8, vst0 = v_st(sr, sc), vst1 = v_st(32 + sr, sc);
    const int vb0 = (int)(uintptr_t)smem + v_rd_base(lane);
    for (int task = blockIdx.x; task < BATCH * 64; task += gridDim.x) {
        const int b = task >> 6, n2 = task & 63;
        bf16x8 st[4][2];
#pragma unroll
        for (int kt = 0; kt < 2; ++kt)
#pragma unroll
            for (int ct = 0; ct < 2; ++ct) {
                st[kt * 2 + ct][0] = *(const bf16x8*)(F + ((size_t)b * SEQ + 64 * (64 * kt + sr) + n2) * 256 + 128 * ct + sc);
                st[kt * 2 + ct][1] = *(const bf16x8*)(F + ((size_t)b * SEQ + 64 * (64 * kt + 32 + sr) + n2) * 256 + 128 * ct + sc);
            }
        bf16x8 pa[2][4];
#pragma unroll
        for (int kt = 0; kt < 2; ++kt)
#pragma unroll
            for (int ks = 0; ks < 4; ++ks) pa[kt][ks] = *(const bf16x8*)(W + (size_t)(32 * wid + r32) * 128 + 64 * kt + 16 * ks + 8 * hi);
        __syncthreads();
#pragma unroll
        for (int q = 0; q < 4; ++q) { *(bf16x8*)(smem + q * 16384 + vst0) = st[q][0]; *(bf16x8*)(smem + q * 16384 + vst1) = st[q][1]; }
        __syncthreads();
        f32x16 o[2][4] = {};
#pragma unroll
        for (int ct = 0; ct < 2; ++ct)
#pragma unroll
            for (int kt = 0; kt < 2; ++kt) pv_d0(o[ct], vb0 + (kt * 2 + ct) * 16384, pa[kt][0], pa[kt][1], pa[kt][2], pa[kt][3]);
        const int plane = wid >> 2;
#pragma unroll
        for (int r = 0; r < 16; ++r) {
            const int k1 = 32 * (wid & 3) + crow(r, hi);
            bf16_t* dst = FY + ((((size_t)plane * BATCH + b) * 128 + k1) * 64 + n2) * 256 + r32;
#pragma unroll
            for (int ct = 0; ct < 2; ++ct)
#pragma unroll
                for (int d0 = 0; d0 < 4; ++d0) dst[128 * ct + 32 * d0] = f2bf(o[ct][d0][r]);
        }
    }
    __syncthreads();
}
__device__ __forceinline__ void ph_fourierB(const Params& p, unsigned char* smem) {
    using namespace fa;
    unsigned char* ws = p.ws;
    const bf16_t* FY = (const bf16_t*)(ws + WS_FY); const float2* tabw = (const float2*)(ws + WS_TABW);
    const bf16_t* M64 = (const bf16_t*)(ws + WS_M64E); const bf16_t* GT = (const bf16_t*)(ws + WS_GT);
    bf16_t* AO = (bf16_t*)(ws + WS_AO);
    const int tid = otid(), wid = tid >> 6, lane = tid & 63, r32 = lane & 31, hi = lane >> 5;
    const int sr = tid >> 4, sc = (tid & 15) * 8, vst0 = v_st(sr, sc), vst1 = v_st(32 + sr, sc);
    const int vb0 = (int)(uintptr_t)smem + v_rd_base(lane);
    constexpr int XRS = 528;
    unsigned char* XL = smem + 65536;
    const int mt = wid & 3, ctw = wid >> 2;
    for (int task = blockIdx.x; task < BATCH * 128; task += gridDim.x) {
        const int b = task >> 7, k1 = task & 127;
        __syncthreads();
#pragma unroll
        for (int ct = 0; ct < 2; ++ct)
#pragma unroll
            for (int rh = 0; rh < 2; ++rh) {
                const int n2 = sr + 32 * rh;
                const size_t off = ((((size_t)b) * 128 + k1) * 64 + n2) * 256 + 128 * ct + sc;
                const uint4 yr = *(const uint4*)(FY + off), yi = *(const uint4*)(FY + (size_t)BATCH * 128 * 64 * 256 + off);
                const float2 tw = tabw[n2 * k1];
                const unsigned yrw[4] = {yr.x, yr.y, yr.z, yr.w}, yiw[4] = {yi.x, yi.y, yi.z, yi.w};
                unsigned zr[4], zi[4];
#pragma unroll
                for (int q = 0; q < 4; ++q) {
                    const float a0 = __uint_as_float(yrw[q] << 16), a1 = __uint_as_float(yrw[q] & 0xffff0000u), b0 = __uint_as_float(yiw[q] << 16), b1 = __uint_as_float(yiw[q] & 0xffff0000u);
                    zr[q] = pk2(a0 * tw.x + b0 * tw.y, a1 * tw.x + b1 * tw.y); zi[q] = pk2(b0 * tw.x - a0 * tw.y, b1 * tw.x - a1 * tw.y);
                }
                const int vs = rh ? vst1 : vst0;
                *(uint4*)(smem + (0 * 2 + ct) * 16384 + vs) = make_uint4(zr[0], zr[1], zr[2], zr[3]);
                *(uint4*)(smem + (1 * 2 + ct) * 16384 + vs) = make_uint4(zi[0], zi[1], zi[2], zi[3]);
            }
        __syncthreads();
        {
            f32x16 o[4] = {};
#pragma unroll
            for (int kt = 0; kt < 2; ++kt) {
                bf16x8 pa[4];
#pragma unroll
                for (int ks = 0; ks < 4; ++ks) pa[ks] = *(const bf16x8*)(M64 + (size_t)(32 * mt + r32) * 128 + 64 * kt + 16 * ks + 8 * hi);
                pv_d0(o, vb0 + (kt * 2 + ctw) * 16384, pa[0], pa[1], pa[2], pa[3]);
            }
#pragma unroll
            for (int r = 0; r < 16; ++r) {
                const int ro = 32 * mt + crow(r, hi);
                bf16_t* xr = (bf16_t*)(XL + ((ro >> 6) * 64 + (ro & 63)) * XRS) + 128 * ctw + r32;
#pragma unroll
                for (int d0 = 0; d0 < 4; ++d0) xr[32 * d0] = f2bf(o[d0][r]);
            }
        }
        __syncthreads();
#pragma unroll
        for (int tt = 0; tt < 2; ++tt) {
            const int tau = 2 * wid + tt, g = tau >> 2, mt2 = (tau >> 1) & 1, nt2 = tau & 1;
            f32x16 acc = {};
#pragma unroll
            for (int ks8 = 0; ks8 < 8; ++ks8) {
                const int part = ks8 >> 2, cb = ks8 & 3;
                const bf16x8 af = *(const bf16x8*)(XL + (part * 64 + 32 * mt2 + r32) * XRS + (g * 64 + 16 * cb + 8 * hi) * 2);
                const bf16x8 bfr = *(const bf16x8*)(GT + ((size_t)g * 64 + 32 * nt2 + r32) * 128 + part * 64 + 16 * cb + 8 * hi);
                acc = __builtin_amdgcn_mfma_f32_32x32x16_bf16(af, bfr, acc, 0, 0, 0);
            }
#pragma unroll
            for (int r = 0; r < 16; ++r) { const int k2 = 32 * mt2 + crow(r, hi);
                AO[((size_t)b * SEQ + k1 + 128 * k2) * D + g * 64 + 32 * nt2 + r32] = f2bf(acc[r]); }
        }
    }
    __syncthreads();
}

__device__ __forceinline__ void ph_mid(const Params& p, unsigned char* smem) {
    typedef short bf16x8 __attribute__((ext_vector_type(8)));
    unsigned char* ws = p.ws;
    const int tid = otid(), wave = tid >> 6, lane = tid & 63, fr = lane & 15, fq = lane >> 4;
    const float* mod = (const float*)(ws + WS_MOD);
    const bf16_t* YX = (const bf16_t*)(ws + WS_YX);
    unsigned char* H2 = ws + WS_H2;
    unsigned* counts = (unsigned*)(ws + WS_CTL);
    int* TE = (int*)(ws + WS_TE); int* TP = (int*)(ws + WS_TP); float* TW = (float*)(ws + WS_TW); int* TOKL = (int*)(ws + WS_TOKL);
    constexpr int RS = 2064;
    unsigned char* Ahi = smem; unsigned char* Alo = smem + 16 * RS; float* Pp = (float*)(smem + 2 * 16 * RS + 512);
    const float rbias = p.in[I_RB][lane];
    int* lcnt = (int*)(smem + 99328); int* gb = lcnt + 64; int* PE = gb + 64; float* PW = (float*)(PE + 1024); float* PV = PW + 1024;
    for (int chunk = blockIdx.x; chunk < T / 128; chunk += gridDim.x) {
      const int mc = chunk * 128, b = mc >> 13;
      if (tid < 64) lcnt[tid] = 0;
      {
          const float* mrow_ = mod + b * 6144;
          for (int i = tid; i < 5 * 256; i += NT) { const int v_ = i >> 8, q_ = (i & 255) * 4;
              const float* s_ = (v_ == 0) ? p.in[I_GAPOST] + q_ : (v_ == 1) ? mrow_ + 2 * 1024 + q_ : (v_ == 2) ? p.in[I_GFPRE] + q_ : (v_ == 3) ? mrow_ + 3 * 1024 + q_ : mrow_ + 4 * 1024 + q_;
              *(f32x4*)(PV + v_ * 1024 + q_) = *(const f32x4*)s_; }
          __syncthreads();
      }
      uint2 yw[2][4]; f32x4 xv[2][4];
#define MID_LOAD(m0_) do { _Pragma("unroll") for (int rr = 0; rr < 2; ++rr) { const int m_ = (m0_) + 2 * wave + rr; _Pragma("unroll") for (int j = 0; j < 4; ++j) { \
          yw[rr][j] = *(const uint2*)(YX + (size_t)m_ * D + 4 * (lane + 64 * j)); xv[rr][j] = ((const f32x4*)(p.in[I_X] + (size_t)m_ * D))[lane + 64 * j]; } } } while (0)
      MID_LOAD(mc);
      for (int it = 0; it < 8; ++it) {
        const int m0 = mc + it * 16;
        {
            float ss[2] = {0.f, 0.f};
#define YV(rr, j, i) ((i) == 0 ? __uint_as_float(yw[rr][j].x << 16) : (i) == 1 ? __uint_as_float(yw[rr][j].x & 0xffff0000u) : (i) == 2 ? __uint_as_float(yw[rr][j].y << 16) : __uint_as_float(yw[rr][j].y & 0xffff0000u))
#pragma unroll
            for (int rr = 0; rr < 2; ++rr) {
#pragma unroll
                for (int j = 0; j < 4; ++j) ss[rr] += YV(rr, j, 0) * YV(rr, j, 0) + YV(rr, j, 1) * YV(rr, j, 1) + YV(rr, j, 2) * YV(rr, j, 2) + YV(rr, j, 3) * YV(rr, j, 3);
                ss[rr] = wave_sum(ss[rr]);
            }
#pragma unroll
            for (int rr = 0; rr < 2; ++rr) {
                const int lr = 2 * wave + rr, m = m0 + lr;
                const float r1 = 1.0f / sqrtf(ss[rr] * (1.0f / D) + EPS);
                float ss2 = 0.f;
#pragma unroll
                for (int j = 0; j < 4; ++j) {
                    const int col = 4 * (lane + 64 * j);
                    const f32x4 gp = *(const f32x4*)(PV + col), gt = *(const f32x4*)(PV + 1024 + col);
#pragma unroll
                    for (int i = 0; i < 4; ++i) { xv[rr][j][i] = xv[rr][j][i] + gt[i] * (YV(rr, j, i) * r1 * gp[i]); ss2 += xv[rr][j][i] * xv[rr][j][i]; }
                    ((f32x4*)(p.out + (size_t)m * D))[lane + 64 * j] = xv[rr][j];
                }
                ss2 = wave_sum(ss2);
                const float r2 = 1.0f / sqrtf(ss2 * (1.0f / D) + EPS);
#pragma unroll
                for (int j = 0; j < 4; ++j) {
                    const int col = 4 * (lane + 64 * j);
                    const f32x4 gp = *(const f32x4*)(PV + 2048 + col), sh = *(const f32x4*)(PV + 3072 + col), sc = *(const f32x4*)(PV + 4096 + col);
                    float h[4]; bf16_t hb[4]; float lo[4];
#pragma unroll
                    for (int i = 0; i < 4; ++i) { h[i] = xv[rr][j][i] * r2 * gp[i] * (1.f + sc[i]) + sh[i]; hb[i] = f2bf(h[i]); lo[i] = h[i] - bf2f(hb[i]); }
                    uint2 o; o.x = (unsigned)hb[0] | ((unsigned)hb[1] << 16); o.y = (unsigned)hb[2] | ((unsigned)hb[3] << 16);
                    { int w8 = __builtin_amdgcn_cvt_pk_fp8_f32(h[0], h[1], 0, false); w8 = __builtin_amdgcn_cvt_pk_fp8_f32(h[2], h[3], w8, true); *(int*)(H2 + (size_t)m * D + col) = w8; }
                    *(uint2*)(Ahi + lr * RS + col * 2) = o;
                    uint2 ol; ol.x = pk2(lo[0], lo[1]); ol.y = pk2(lo[2], lo[3]);
                    *(uint2*)(Alo + lr * RS + col * 2) = ol;
                }
            }
            if (it < 7) MID_LOAD(m0 + 16);
        }
        asm volatile("s_waitcnt lgkmcnt(0)\n\ts_barrier" ::: "memory");
        {
            f32x4 acc[4];
#pragma unroll
            for (int nb = 0; nb < 4; ++nb) acc[nb] = (f32x4){0.f, 0.f, 0.f, 0.f};
            const bf16_t* wrtlo = (const bf16_t*)(ws + WS_WRT); asm volatile("" : "+s"(wrtlo));
#pragma unroll
            for (int ks = 0; ks < 4; ++ks) {
                const int ko = (wave * 128 + ks * 32 + 8 * fq) * 2;
                const bf16x8 ah = *(const bf16x8*)(Ahi + fr * RS + ko), al = *(const bf16x8*)(Alo + fr * RS + ko);
#pragma unroll
                for (int nb = 0; nb < 4; ++nb) {
                    const size_t wo_ = ((size_t)(((wave * 4 + ks) * 4 + nb) * 2) * 64 + lane) * 8;
                    const bf16x8 bhv = *(const bf16x8*)(wrtlo + wo_), bl = *(const bf16x8*)(wrtlo + wo_ + 512);
                    acc[nb] = __builtin_amdgcn_mfma_f32_16x16x32_bf16(ah, bhv, acc[nb], 0, 0, 0);
                    acc[nb] = __builtin_amdgcn_mfma_f32_16x16x32_bf16(ah, bl, acc[nb], 0, 0, 0);
                    acc[nb] = __builtin_amdgcn_mfma_f32_16x16x32_bf16(al, bhv, acc[nb], 0, 0, 0);
                }
            }
#pragma unroll
            for (int nb = 0; nb < 4; ++nb)
#pragma unroll
                for (int j = 0; j < 4; ++j) Pp[(wave * 16 + 4 * fq + j) * 64 + 16 * nb + fr] = acc[nb][j];
        }
        asm volatile("s_waitcnt lgkmcnt(0)\n\ts_barrier" ::: "memory");
#pragma unroll
        for (int rr = 0; rr < 2; ++rr) {
            const int lr = 2 * wave + rr;
            float lg = 0.f;
#pragma unroll
            for (int w = 0; w < 8; ++w) lg += Pp[(w * 16 + lr) * 64 + lane];
            const float score = 1.0f / (1.0f + expf(-lg));
            const float sel = score + rbias;
            float t1 = sel, t2 = -INFINITY;
#define TOP2(M) do { const float o1 = sx<M>(t1), o2 = sx<M>(t2); const float n1 = fmaxf(t1, o1), n2 = fmaxf(fminf(t1, o1), fmaxf(t2, o2)); t1 = n1; t2 = n2; } while (0)
            TOP2(1); TOP2(2); TOP2(4);
#undef TOP2
            const float gs = t1 + t2; const int grp = lane >> 3;
            int gr = 0;
#pragma unroll
            for (int j = 0; j < 8; ++j) { const float sj = __uint_as_float(__builtin_amdgcn_readlane(__float_as_uint(gs), j * 8)); gr += (sj > gs || (sj == gs && j < grp)) ? 1 : 0; }
            const bool gsel = gr < 4;
            float v = gsel ? sel : -INFINITY;
            int rk = TOPK;
#pragma unroll
            for (int it8 = 0; it8 < TOPK; ++it8) {
                const float mx = wave_max(v);
                const unsigned long long eq = __ballot(v == mx);
                const int win = __builtin_ctzll(eq);
                if (lane == win) { rk = it8; v = -INFINITY; }
            }
            const bool chosen = rk < TOPK;
            const float ssum = wave_sum(chosen ? score : 0.f);
            const float w = score / (ssum + 1e-20f) * 2.5f;
            if (chosen) {
                const int lpos = atomicAdd(&lcnt[lane], 1);
                const int idx = (it * 16 + lr) * 8 + rk;
                PE[idx] = lane | (lpos << 8); PW[idx] = w;
            }
        }
      }
      __syncthreads();
      if (tid < 64) { const int c = lcnt[tid]; gb[tid] = c ? (int)atomicAdd(&counts[b * 65 + tid], (unsigned)c) : 0; }
      __syncthreads();
      for (int i = tid; i < 1024; i += NT) {
          const int pe = PE[i], e = pe & 255, pos = gb[e] + (pe >> 8), mk = mc * 8 + i;
          TOKL[((size_t)b * 64 + e) * 8192 + pos] = mk; TE[mk] = e; TP[mk] = pos; TW[mk] = PW[i];
      }
      __syncthreads();
    }
}

constexpr int T_CNT = 0;
constexpr int T_TOT = 256;
constexpr int T_AB = 328;
constexpr int T_OFF = 400;
constexpr int T_GUP = 660;
constexpr int T_YC = 730;
constexpr int T_YB = 990;
constexpr int T_DUP = 1250;
constexpr int T_UL = 1520;
constexpr int T_END = 1520 + 512;
__device__ __forceinline__ int scan_incl(int v, int lane) {
#pragma unroll
    for (int off = 1; off < 64; off <<= 1) { const int t = __builtin_amdgcn_ds_bpermute(((lane - off) & 63) << 2, v); if (lane >= off) v += t; }
    return v;
}
__device__ __forceinline__ void build_moe(const Params& p, int* tab) {
    const unsigned* counts = (const unsigned*)(p.ws + WS_CTL);
    __syncthreads();
    const int tid = otid(), wave = tid >> 6, lane = tid & 63;
    if (wave == 0) {
        const int c0 = (int)counts[0 * 65 + lane], c1 = (int)counts[1 * 65 + lane], c2 = (int)counts[2 * 65 + lane], c3 = (int)counts[3 * 65 + lane];
        tab[T_CNT + 0 * 64 + lane] = c0; tab[T_CNT + 1 * 64 + lane] = c1; tab[T_CNT + 2 * 64 + lane] = c2; tab[T_CNT + 3 * 64 + lane] = c3;
        tab[T_OFF + lane * 4 + 0] = 0; tab[T_OFF + lane * 4 + 1] = c0; tab[T_OFF + lane * 4 + 2] = c0 + c1; tab[T_OFF + lane * 4 + 3] = c0 + c1 + c2;
        const int tot = c0 + c1 + c2 + c3, pad = (tot + 255) & ~255, gu = ((tot + 255) >> 8) * 2;
        const int sp = scan_incl(pad, lane), sg = scan_incl(gu, lane);
        tab[T_TOT + lane] = tot; tab[T_AB + lane] = sp - pad; tab[T_GUP + lane] = sg - gu;
        const int cb[4] = {c0, c1, c2, c3};
#pragma unroll
        for (int b = 0; b < 4; ++b) {
            const int du = ((cb[b] + 255) >> 8) * 4;
            const int sy = scan_incl(cb[b], lane), sd = scan_incl(du, lane);
            tab[T_YB + 65 * b + lane] = sy - cb[b]; tab[T_DUP + 66 * b + lane] = sd - du;
            if (lane == 63) { tab[T_YB + 65 * b + 64] = sy; tab[T_DUP + 66 * b + 64] = sd; tab[T_DUP + 66 * b + 65] = sd + (SEQ / 256) * 4; }
        }
        if (lane == 63) { tab[T_TOT + 64] = T; tab[T_AB + 64] = sp; tab[T_GUP + 64] = sg; tab[T_GUP + 65] = sg + (T / 256) * 2; }
    }
    __syncthreads();
}

__device__ __forceinline__ void moe_decode(const GP_LAS int* tab, int e, int pos_e, int& b, int& pos) {
    const int o1 = tab[T_OFF + e * 4 + 1], o2 = tab[T_OFF + e * 4 + 2], o3 = tab[T_OFF + e * 4 + 3];
    b = (pos_e >= o1 ? 1 : 0) + (pos_e >= o2 ? 1 : 0) + (pos_e >= o3 ? 1 : 0);
    pos = pos_e - (b == 0 ? 0 : (b == 1 ? o1 : (b == 2 ? o2 : o3)));
}
__device__ __forceinline__ int yrow0(int b) { return b == 0 ? 2 * 1024 : (272 + 72 * (b - 1)) * 1024; }
struct MoeSched {
    const GP_LAS int* tab; int G, c, ntn, U, down, chunk; const int* TOKL; const char* Bt;
    __device__ __forceinline__ void prepare(int* tabw, int wv) const {
        if (wv == 0) {
            const int i = lane_id(); int L = i * G + c;
            if (L < U) {
                int bt = 0;
                if (down) {
#pragma unroll
                    for (int q = 0; q < 3; ++q) { const int u0 = tabw[T_DUP + 66 * bt + 65]; if (L >= u0) { L -= u0; ++bt; } } }
                const int pre = down ? T_DUP + 66 * bt : T_GUP;
                int lo = 0, hi = 64;
                while (lo < hi) { const int mid = (lo + hi + 1) >> 1; if (tabw[pre + mid] <= L) lo = mid; else hi = mid - 1; }
                const int loc = L - tabw[pre + lo];
                int cnt, base, bb;
                if (down) { cnt = (lo < 64) ? tabw[T_CNT + bt * 64 + (lo & 63)] : SEQ; base = tabw[T_YB + 65 * bt + lo] + yrow0(bt);
                            bb = tabw[T_AB + lo] + (lo < 64 ? tabw[T_OFF + (lo & 63) * 4 + bt] : bt * SEQ); }
                else { cnt = tabw[T_TOT + lo]; base = tabw[T_AB + lo]; bb = 0; }
                int* ul = tabw + T_UL + 8 * i;
                ul[0] = lo; ul[1] = loc / ntn; ul[2] = loc % ntn; ul[3] = cnt; ul[4] = base; ul[5] = bb;
            }
        }
        __syncthreads();
    }
    __device__ __forceinline__ bool next(int i, gp::Unit& u) const {
        if (i * G + c >= U) return false;
        const GP_LAS int* ul = tab + T_UL + 8 * i;
        u.e = __builtin_amdgcn_readfirstlane(ul[0]); u.pm = __builtin_amdgcn_readfirstlane(ul[1]); u.pn = __builtin_amdgcn_readfirstlane(ul[2]);
        u.cnt = __builtin_amdgcn_readfirstlane(ul[3]); u.base = __builtin_amdgcn_readfirstlane(ul[4]); u.b = __builtin_amdgcn_readfirstlane(ul[5]);
        return true;
    }
    __device__ __forceinline__ unsigned arow(const gp::Unit& u, int r) const {
        const int pos_e = u.pm * 256 + r;
        if (down) return (unsigned)(u.b + pos_e) * 512u;
        int tok;
        if (u.e < 64) { int b, pos; moe_decode(tab, u.e, pos_e, b, pos); tok = (pos_e < u.cnt) ? (TOKL[((size_t)b * 64 + u.e) * 8192 + pos] >> 3) : 0; } else tok = pos_e;
        return (unsigned)tok * 1024u;
    }
    __device__ __forceinline__ const char* bptr(const gp::Unit& u) const {
        return down ? Bt + ((size_t)u.e * 1024 + u.pn * 256) * 512 : Bt + ((size_t)u.e * 512 + u.pn * 256) * 1024;
    }
};
struct EpiGU {
    bf16_t* ACT; const int* TOKL; const float* TW; const GP_LAS int* tab;
    __device__ __forceinline__ void operator()(const f32x4 (&acc)[2][2][4][2], const gp::Unit& u, int wr, int wc, int fr, int fq) const {
#pragma unroll
        for (int ai = 0; ai < 2; ++ai)
#pragma unroll
            for (int m = 0; m < 4; ++m) {
                const int pos_e = u.pm * 256 + ai * 128 + wr * 64 + m * 16 + fr;
                if (pos_e < u.cnt) {
                    float w = 1.0f;
                    if (u.e < 64) { int b, pos; moe_decode(tab, u.e, pos_e, b, pos); w = TW[TOKL[((size_t)b * 64 + u.e) * 8192 + pos]]; }
                    float a[8];
#pragma unroll
                    for (int n = 0; n < 2; ++n)
#pragma unroll
                        for (int i = 0; i < 4; ++i) { const float g = acc[ai][0][m][n][i] * (1.f / GUSCALE), up = acc[ai][1][m][n][i] * (1.f / GUSCALE);
                            a[4 * n + i] = g * __builtin_amdgcn_rcpf(1.0f + __builtin_amdgcn_exp2f(-1.4426950408889634f * g)) * up * w; }
                    gp::u32x4 o; o.x = gp::cvt_pk_bf16(a[0], a[1]); o.y = gp::cvt_pk_bf16(a[2], a[3]); o.z = gp::cvt_pk_bf16(a[4], a[5]); o.w = gp::cvt_pk_bf16(a[6], a[7]);
                    *(gp::u32x4*)(ACT + ((size_t)u.base + pos_e) * DE + u.pn * 128 + wc * 32 + fq * 8) = o;
                }
            }
    }
};
constexpr float YSCALE = 16.f;
struct EpiDown {
    unsigned char* ws;
    __device__ __forceinline__ void operator()(const f32x4 (&acc)[2][2][4][2], const gp::Unit& u, int wr, int wc, int fr, int fq) const {
#pragma unroll
        for (int ai = 0; ai < 2; ++ai)
#pragma unroll
            for (int m = 0; m < 4; ++m) {
                const int pos = u.pm * 256 + ai * 128 + wr * 64 + m * 16 + fr;
                if (pos < u.cnt) {
                    unsigned char* rowp = ws + (size_t)(u.base + pos) * D + u.pn * 256 + wc * 32 + fq * 8;
#pragma unroll
                    for (int bj = 0; bj < 2; ++bj) { const f32x4 v0 = acc[ai][bj][m][0] * YSCALE, v1 = acc[ai][bj][m][1] * YSCALE;
                        int w0 = __builtin_amdgcn_cvt_pk_fp8_f32(v0[0], v0[1], 0, false); w0 = __builtin_amdgcn_cvt_pk_fp8_f32(v0[2], v0[3], w0, true);
                        int w1 = __builtin_amdgcn_cvt_pk_fp8_f32(v1[0], v1[1], 0, false); w1 = __builtin_amdgcn_cvt_pk_fp8_f32(v1[2], v1[3], w1, true);
                        uint2 o; o.x = (unsigned)w0; o.y = (unsigned)w1;
                        *(uint2*)(rowp + bj * 128) = o; }
                }
            }
    }
};
__device__ __forceinline__ void ph_moe_gu(const Params& p, unsigned char* smem) {
    unsigned char* ws = p.ws;
    int* tab = (int*)(smem + gp::STAGE_BYTES);
    build_moe(p, tab);
    MoeSched S; S.tab = (const GP_LAS int*)tab; S.G = gridDim.x; S.c = (gridDim.x % 8 == 0) ? (int)((blockIdx.x % 8) * (gridDim.x / 8) + blockIdx.x / 8) : (int)blockIdx.x;   S.ntn = 2; S.U = __builtin_amdgcn_readfirstlane(tab[T_GUP + 65]); S.down = 0; S.chunk = 0;
    S.TOKL = (const int*)(ws + WS_TOKL); S.Bt = (const char*)(ws + WS_WGUT);
    S.prepare(tab, p.chunk);
    EpiGU E{(bf16_t*)(ws + WS_ACT), (const int*)(ws + WS_TOKL), (const float*)(ws + WS_TW), (const GP_LAS int*)tab};
    gp::gemm_phase<EpiGU, MoeSched, true, true>(p.chunk, (GP_LAS unsigned char*)smem, (const char*)(ws + WS_H2), D / 2, S, E);
}
__device__ __forceinline__ void ph_moe_down(const Params& p, unsigned char* smem, int c) {
    unsigned char* ws = p.ws;
    int* tab = (int*)(smem + gp::STAGE_BYTES);
    build_moe(p, tab);
    MoeSched S; S.tab = (const GP_LAS int*)tab; S.G = gridDim.x; S.c = (gridDim.x % 8 == 0) ? (int)((blockIdx.x % 8) * (gridDim.x / 8) + blockIdx.x / 8) : (int)blockIdx.x;   S.ntn = 4; S.U = __builtin_amdgcn_readfirstlane(tab[T_DUP + 65] + tab[T_DUP + 66 + 65] + tab[T_DUP + 132 + 65] + tab[T_DUP + 198 + 65]); S.down = 1; S.chunk = c;
    S.TOKL = nullptr; S.Bt = (const char*)(ws + WS_WDT);
    S.prepare(tab, p.chunk);
    EpiDown E{ws};
    gp::gemm_phase<EpiDown, MoeSched, false>(p.chunk, (GP_LAS unsigned char*)smem, (const char*)(ws + WS_ACT), DE, S, E);
}

__device__ __forceinline__ void ph_final(const Params& p, float* lds) {
    unsigned char* ws = p.ws;
    int* tab = (int*)lds;
    build_moe(p, tab);
    const int tid = otid(), wave = tid >> 6, lane = tid & 63;
    const int gw = blockIdx.x * NWV + wave, GW = gridDim.x * NWV;
    const int* TE = (const int*)(ws + WS_TE); const int* TP = (const int*)(ws + WS_TP);
    const unsigned char* Y = ws;
    for (int m = gw; m < T; m += GW) {
        const int b = m >> 13, t = m & (SEQ - 1);
        const float* mod = (const float*)(ws + WS_MOD) + b * 6144 + 5 * 1024;
        float acc[16];
#pragma unroll
        for (int i = 0; i < 16; ++i) acc[i] = 0.f;
#pragma unroll
        for (int k = 0; k < 9; ++k) {
            int row;
            if (k < 8) { const int e = TE[m * 8 + k]; row = tab[T_YB + 65 * b + e] + TP[m * 8 + k]; }
            else row = tab[T_YB + 65 * b + 64] + t;
            row += yrow0(b);
            const unsigned char* yr = Y + (size_t)row * D;
#pragma unroll
            for (int j = 0; j < 4; ++j) { const int w = *(const int*)(yr + 4 * (lane + 64 * j));
                acc[4 * j] += __builtin_amdgcn_cvt_f32_fp8(w, 0); acc[4 * j + 1] += __builtin_amdgcn_cvt_f32_fp8(w, 1); acc[4 * j + 2] += __builtin_amdgcn_cvt_f32_fp8(w, 2); acc[4 * j + 3] += __builtin_amdgcn_cvt_f32_fp8(w, 3); }
        }
        float ss = 0.f;
#pragma unroll
        for (int i = 0; i < 16; ++i) { acc[i] *= (1.f / YSCALE); ss += acc[i] * acc[i]; }
        ss = wave_sum(ss);
        const float rs = 1.0f / sqrtf(ss * (1.0f / D) + EPS);
#pragma unroll
        for (int j = 0; j < 4; ++j) {
            const int col = 4 * (lane + 64 * j);
            const f32x4 gp = *(const f32x4*)(p.in[I_GFPOST] + col), gt = *(const f32x4*)(mod + col);
            f32x4 x1 = ((const f32x4*)(p.out + (size_t)m * D))[lane + 64 * j];
#pragma unroll
            for (int i = 0; i < 4; ++i) x1[i] += gt[i] * (acc[4 * j + i] * rs * gp[i]);
            ((f32x4*)(p.out + (size_t)m * D))[lane + 64 * j] = x1;
        }
    }
}

#define GAS __attribute__((address_space(1)))
#define LAS __attribute__((address_space(3)))
#define XB_TMO      128
#define XB_XCNT(j)  (256  + 64 * (j))
#define XB_XSUB(j)  (1280 + 64 * (j))
#define XB_XGEN(j)  (2304 + 64 * (j))
#define XB_TOP      3328
#define XB_TOPGEN   3392
#define XCD_BAR_WORDS 3456
#define XB_SPIN_CAP (1u << 21)
__device__ __forceinline__ unsigned xb_ld(unsigned* p)              { return __hip_atomic_load(p, __ATOMIC_RELAXED, __HIP_MEMORY_SCOPE_AGENT); }
__device__ __forceinline__ unsigned xb_add(unsigned* p, unsigned v) { return __hip_atomic_fetch_add(p, v, __ATOMIC_RELAXED, __HIP_MEMORY_SCOPE_AGENT); }
__device__ __forceinline__ unsigned xb_xcc_id() { return (unsigned)__builtin_amdgcn_s_getreg((3 << 11) | 20) & 0xFu; }
#define XB_SPIN(cond, bar) do { unsigned _sp = 0; while (cond) { __builtin_amdgcn_s_sleep(1); \
    if ((++_sp & 255u) == 0u) { if (xb_ld(&(bar)[XB_TMO])) break; if (_sp > XB_SPIN_CAP) { atomicAdd(&(bar)[XB_TMO], 1u); break; } } } } while (0)
struct XcdBarrier { unsigned* bar; unsigned x; volatile LAS unsigned* st; };
__device__ __forceinline__ XcdBarrier xcd_barrier_post(unsigned* bar, volatile LAS unsigned* st, int wv) {
    XcdBarrier b; b.bar = bar; b.x = xb_xcc_id(); b.st = st;
    if (wv == 0 && lane_id() == 0) (void)xb_add(&bar[XB_XCNT(b.x)], 1u);
    return b;
}
__device__ __forceinline__ void xcd_barrier_complete(unsigned* bar, unsigned x, unsigned& nloc, unsigned& nx) {
    const unsigned G = gridDim.x * gridDim.y * gridDim.z;
    unsigned sum, cnt, mine, sp = 0u;
    for (;;) {
        sum = 0u; cnt = 0u; mine = 0u;
#pragma unroll
        for (unsigned j = 0; j < 16; ++j) { const unsigned c = xb_ld(&bar[XB_XCNT(j)]); sum += c; cnt += (c > 0u) ? 1u : 0u; mine = (j == x) ? c : mine; }
        if (sum == G) break;
        __builtin_amdgcn_s_sleep(1);
        if ((++sp & 255u) == 0u) { if (xb_ld(&bar[XB_TMO])) break; if (sp > XB_SPIN_CAP) { atomicAdd(&bar[XB_TMO], 1u); break; } }
    }
    nloc = mine > 0u ? mine : 1u; nx = cnt > 0u ? cnt : 1u;
}
__device__ __forceinline__ void xcd_barrier(const XcdBarrier& b, int wv) {
    asm volatile("s_waitcnt vmcnt(0)" ::: "memory");
    __syncthreads();
    if (wv == 0 && lane_id() == 0) {
        unsigned* bar = b.bar;
        __builtin_amdgcn_s_waitcnt(0);
        unsigned nloc = b.st[0], nx = b.st[1];
        if (nloc == 0u) { xcd_barrier_complete(bar, b.x, nloc, nx); b.st[0] = nloc; b.st[1] = nx; }
        const unsigned old = xb_add(&bar[XB_XSUB(b.x)], 1u);
        const unsigned gen = old / nloc;
        if (old + 1u == (gen + 1u) * nloc) {
            __builtin_amdgcn_fence(__ATOMIC_RELEASE, "agent");
            asm volatile("s_waitcnt vmcnt(0)" ::: "memory");
            const unsigned og = xb_add(&bar[XB_TOP], 1u);
            const unsigned tg = og / nx;
            if (og + 1u == (tg + 1u) * nx) xb_add(&bar[XB_TOPGEN], 1u);
            else XB_SPIN(xb_ld(&bar[XB_TOPGEN]) == tg, bar);
            __builtin_amdgcn_fence(__ATOMIC_ACQUIRE, "agent");
            xb_add(&bar[XB_XGEN(b.x)], 1u);
            asm volatile("s_waitcnt vmcnt(0)" ::: "memory");
        } else {
            XB_SPIN(xb_ld(&bar[XB_XGEN(b.x)]) == gen, bar);
            __builtin_amdgcn_fence(__ATOMIC_ACQUIRE, "agent");
            asm volatile("s_waitcnt vmcnt(0)" ::: "memory");
        }
    }
    __syncthreads();
}

namespace cg = cooperative_groups;
constexpr int LDS_BYTES = 144 * 1024;
typedef const __attribute__((address_space(4))) Params* KP;
__device__ __forceinline__ Params kargs() {
    Params p;
#if defined(__HIP_DEVICE_COMPILE__)
    typedef const __attribute__((address_space(4))) unsigned long long* KQ;
    KQ kq = (KQ)__builtin_amdgcn_kernarg_segment_ptr(); asm volatile("" : "+s"(kq));
    unsigned long long* d = (unsigned long long*)&p;
#pragma unroll
    for (int i = 0; i < (int)(sizeof(Params) / 8); ++i) d[i] = kq[i];
#endif
    return p;
}
#define PH(call) do { Params p = kargs(); p.chunk = wv; call; } while (0)
__global__ void __launch_bounds__(NT) mega_fwd(Params p_unused) {
    extern __shared__ __attribute__((aligned(16))) unsigned char smem[];
    float* lds = (float*)smem;
    volatile LAS unsigned* misc = (volatile LAS unsigned*)((LAS unsigned char*)smem + (LDS_BYTES - 64));
    if (threadIdx.x < 16) misc[threadIdx.x] = 0u;
    __syncthreads();
    unsigned* barw; { const Params p = kargs(); barw = (unsigned*)(p.ws + WS_CTL) + 4096; }
    const int wv = __builtin_amdgcn_readfirstlane(threadIdx.x >> 6);
    const XcdBarrier bar = xcd_barrier_post(barw, misc, wv);
#define SYNC() xcd_barrier(bar, wv)
    PH(ph_prep(p, lds)); PH(ph_prep_weights(p, lds, 0, 0));   SYNC();
    PH(ph_norm1(p));                SYNC();
    PH(ph_inproj(p, smem)); PH(ph_prep_weights(p, lds, 1, (MTOT / 256) * (INW / 256) % (int)gridDim.x));         SYNC();
    PH(ph_attn(p, smem)); PH(ph_fourierA(p, smem));  SYNC();
    PH(ph_fourierB(p, smem));       SYNC();
    PH(ph_outproj(p, smem));        SYNC();
    PH(ph_mid(p, smem));            SYNC();
    PH(ph_moe_gu(p, smem));         SYNC();
#pragma unroll 1
    PH(ph_moe_down(p, smem, 0));    SYNC();
    PH(ph_final(p, lds));
#undef SYNC
}

extern "C" void kernel_launch(void* const* d_in, const int* in_sizes, int n_in, void* d_out, int out_size, void* d_ws, size_t ws_size, hipStream_t stream) {
    if (n_in != 26 || ws_size < WS_END) { fprintf(stderr, "kernel_launch: unexpected n_in %d / ws %zu\n", n_in, ws_size); return; }
    static int grid_blocks = 0;
    if (!grid_blocks) {
        int dev = 0, cus = 0, per_cu = 0;
        (void)hipGetDevice(&dev);
        (void)hipDeviceGetAttribute(&cus, hipDeviceAttributeMultiprocessorCount, dev);
        (void)hipFuncSetAttribute((const void*)mega_fwd, hipFuncAttributeMaxDynamicSharedMemorySize, LDS_BYTES);
        (void)hipOccupancyMaxActiveBlocksPerMultiprocessor(&per_cu, (const void*)mega_fwd, NT, LDS_BYTES);
        if (per_cu < 1) { fprintf(stderr, "kernel_launch: occupancy query says %d blocks/CU\n", per_cu); per_cu = 1; }
        if (per_cu > 1) per_cu = 1;
        grid_blocks = cus * per_cu;
    }
    Params p{};
    for (int i = 0; i < 26; ++i) p.in[i] = (const float*)d_in[i];
    p.out = (float*)d_out; p.ws = (unsigned char*)d_ws; p.chunk = 0; p.pad = 0;
    (void)hipMemsetAsync((char*)d_ws + WS_CTL, 0, 32768, stream);
    void* args[] = {&p};
    hipError_t e = hipLaunchCooperativeKernel((const void*)mega_fwd, dim3(grid_blocks), dim3(NT), args, LDS_BYTES, stream);
    if (e != hipSuccess) fprintf(stderr, "cooperative launch failed: %s (grid %d)\n", hipGetErrorString(e), grid_blocks);
}
```

```cpp
#include <hip/hip_runtime.h>
#include <hip/hip_cooperative_groups.h>
#include <cstdio>
#include <cstdint>

typedef unsigned short bf16_t;
typedef float f32x4 __attribute__((ext_vector_type(4)));

constexpr int D = 1024, BATCH = 4, SEQ = 8192, T = BATCH * SEQ, CTX = 256, TC = BATCH * CTX;
constexpr int MTOT = T + TC;
constexpr int KVLEN = CTX + SEQ;
constexpr int INW = 2560, NH = 6, QKW = 768, FW = 256;
constexpr int NE = 64, DE = 256, TOPK = 8;
constexpr int NT = 512, NWV = 8;
constexpr int SLOTS_B = 90112;
constexpr float EPS = 1e-6f;
constexpr float LAM_INIT = 0.2f;
constexpr float QSCALE = 0.125f * 1.4426950408889634f;
constexpr float SQS = 0.42466090014400953f;

constexpr size_t MiB = 1u << 20;
constexpr size_t WS_CTL = 0;
constexpr size_t WS_MOD = 1 * MiB;
constexpr size_t WS_TABW = WS_MOD + 128 * 1024;
constexpr size_t WS_ROPE = WS_MOD + 192 * 1024;
constexpr size_t WS_GCS = WS_MOD + 256 * 1024;
constexpr size_t WS_W128E = WS_MOD + 768 * 1024;
constexpr size_t WS_M64E = WS_MOD + 832 * 1024;
constexpr size_t WS_GT = WS_MOD + 864 * 1024;
constexpr size_t WS_WRT = WS_MOD + 512 * 1024;
constexpr size_t WS_WINT = 2 * MiB;
constexpr size_t WS_WOUTT = 7 * MiB;
constexpr size_t WS_WGUT = 9 * MiB;
constexpr size_t WS_WDT = 74 * MiB;
constexpr size_t WS_TE = 107 * MiB;
constexpr size_t WS_TP = 108 * MiB;
constexpr size_t WS_TW = 109 * MiB;
constexpr size_t WS_TOKL = 110 * MiB;
constexpr size_t WS_AO = 118 * MiB;
constexpr size_t WS_ACT = 118 * MiB;
constexpr size_t WS_Q = 182 * MiB;
constexpr size_t WS_K = 230 * MiB;
constexpr size_t WS_V = WS_K + (size_t)BATCH * KVLEN * QKW * 2;
constexpr size_t WS_F = 329 * MiB;
constexpr size_t WS_FY = 361 * MiB;
constexpr size_t WS_HX = 425 * MiB;
constexpr size_t WS_YX = 358 * MiB;
constexpr size_t WS_H2 = 294 * MiB;
constexpr size_t WS_Y = 294 * MiB;
constexpr size_t WS_END = 491 * MiB;

struct Params {
    const float* in[26];
    float* out;
    unsigned char* ws;
    int chunk;
    int pad;
};
enum { I_X = 0, I_C, I_CTX, I_CCTX, I_WMOD, I_BMOD, I_GAPRE, I_GAPOST, I_WIN, I_WF, I_LQ1, I_LK1, I_LQ2, I_LK2, I_GSUB, I_WOUT,
       I_GFPRE, I_GFPOST, I_WR, I_RB, I_WG, I_WU, I_WD, I_WSG, I_WSU, I_WSD };

__device__ __forceinline__ float bf2f(bf16_t v) { return __uint_as_float(((unsigned)v) << 16); }
__device__ __forceinline__ bf16_t f2bf(float f) { unsigned u = __float_as_uint(f); return (bf16_t)((u + 0x7fffu + ((u >> 16) & 1u)) >> 16); }
__device__ __forceinline__ unsigned pk2(float lo, float hi) { return (unsigned)f2bf(lo) | ((unsigned)f2bf(hi) << 16); }
template <int M> __device__ __forceinline__ float sx(float v) { return __int_as_float(__builtin_amdgcn_ds_swizzle(__float_as_int(v), (M << 10) | 0x1f)); }
template <int M> __device__ __forceinline__ int sxi(int v) { return __builtin_amdgcn_ds_swizzle(v, (M << 10) | 0x1f); }
__device__ __forceinline__ float wave_sum(float v) {
    v += sx<1>(v); v += sx<2>(v); v += sx<4>(v); v += sx<8>(v); v += sx<16>(v);
    auto rr = __builtin_amdgcn_permlane32_swap(__float_as_uint(v), __float_as_uint(v), false, false);
    return __uint_as_float(rr[0]) + __uint_as_float(rr[1]);
}
__device__ __forceinline__ float dpp_f(float v, const int ctrl_sel) {
    const int x = __float_as_int(v); int r;
    if (ctrl_sel == 0) r = __builtin_amdgcn_update_dpp(x, x, 0xB1, 0xf, 0xf, false);
    else if (ctrl_sel == 1) r = __builtin_amdgcn_update_dpp(x, x, 0x4E, 0xf, 0xf, false);
    else if (ctrl_sel == 2) r = __builtin_amdgcn_update_dpp(x, x, 0x141, 0xf, 0xf, false);
    else r = __builtin_amdgcn_update_dpp(x, x, 0x140, 0xf, 0xf, false);
    return __int_as_float(r);
}
__device__ __forceinline__ float wave_max(float v) {
    v = fmaxf(v, dpp_f(v, 0)); v = fmaxf(v, dpp_f(v, 1)); v = fmaxf(v, dpp_f(v, 2)); v = fmaxf(v, dpp_f(v, 3));
    const float a = __uint_as_float(__builtin_amdgcn_readlane(__float_as_uint(v), 0)), b = __uint_as_float(__builtin_amdgcn_readlane(__float_as_uint(v), 16));
    const float c = __uint_as_float(__builtin_amdgcn_readlane(__float_as_uint(v), 32)), d = __uint_as_float(__builtin_amdgcn_readlane(__float_as_uint(v), 48));
    return fmaxf(fmaxf(a, b), fmaxf(c, d));
}
__device__ __forceinline__ int lane_id() { int l; asm volatile("v_mbcnt_lo_u32_b32 %0, -1, 0\n\tv_mbcnt_hi_u32_b32 %0, -1, %0" : "=v"(l)); return l; }
__device__ __forceinline__ int otid_w(int wv) { return wv * 64 + lane_id(); }
#define otid() otid_w(p.chunk)
__device__ __forceinline__ float silu_f(float x) { return x / (1.f + expf(-x)); }

__device__ __forceinline__ void ph_prep(const Params& p, float* lds) {
    const int tid = otid(), bid = blockIdx.x, nblk = gridDim.x;
    const int gt = bid * NT + tid, GT = nblk * NT;
    unsigned char* ws = p.ws;
    float2* tabw = (float2*)(ws + WS_TABW);
    for (int i = gt; i < 8192; i += GT) { float s, c; sincospif((float)i * (1.0f / 4096.0f), &s, &c); tabw[i] = make_float2(c, s); }
    float* rope = (float*)(ws + WS_ROPE);
    for (int i = gt; i < 192 * 16; i += GT) {
        const int pos = (i < 2048) ? (i >> 4) : ((i - 2048) >> 4); const int f = i & 15;
        const float inv = powf(10000.0f, -(float)(2 * f) / 32.0f); const float ang = (float)pos * inv;
        const float c = cosf(ang), s = sinf(ang);
        if (i < 2048) { rope[i] = c; rope[2048 + i] = s; } else { rope[4096 + (i - 2048)] = c; rope[4096 + 1024 + (i - 2048)] = s; }
    }
    { bf16_t* gt = (bf16_t*)(ws + WS_GT); const float* wf = p.in[I_WF];
      for (int i = bid * NT + tid; i < 4 * 64 * 128; i += GT) {
        const int g = i >> 13, d = (i >> 7) & 63, part = (i >> 6) & 1, c = i & 63;
        float a = 0.f;
        for (int j = 0; j < 64; ++j) { float s, co; sincospif((float)((c * j) & 63) * (1.0f / 32.0f), &s, &co); a += (part ? s : co) * wf[(g * 64 + j) * 64 + d]; }
        gt[i] = f2bf(a * 0.0013810679320049757f);
      }
      bf16_t* w128 = (bf16_t*)(ws + WS_W128E);
      for (int i = bid * NT + tid; i < 256 * 128; i += GT) { const int kk = i >> 7, n1 = i & 127; float s, co; sincospif((float)(((kk & 127) * n1) & 127) * (1.0f / 64.0f), &s, &co); w128[i] = f2bf(kk < 128 ? co : -s); }
      bf16_t* m64 = (bf16_t*)(ws + WS_M64E);
      for (int i = bid * NT + tid; i < 128 * 128; i += GT) { const int ro = i >> 7, ci = i & 127, po = ro >> 6, k2 = ro & 63, pi = ci >> 6, n2 = ci & 63;
        float s, co; sincospif((float)((k2 * n2) & 63) * (1.0f / 32.0f), &s, &co); m64[i] = f2bf(po == pi ? co : (po == 0 ? s : -s)); }
    }
    {
      bf16_t* wrt = (bf16_t*)(ws + WS_WRT); const float* wr = p.in[I_WR];
      for (int i = gt; i < 64 * 1024; i += GT) {
        const int j = i & 7, ln = (i >> 3) & 63, nb = (i >> 9) & 3, ks = (i >> 11) & 3, wv_ = i >> 13;
        const int e = 16 * nb + (ln & 15), k = wv_ * 128 + ks * 32 + 8 * (ln >> 4) + j;
        const float w = wr[k * 64 + e]; const bf16_t h = f2bf(w);
        const int o = ((((wv_ * 4 + ks) * 4 + nb) * 2) * 64 + ln) * 8 + j;
        wrt[o] = h; wrt[o + 512] = f2bf(w - bf2f(h)); } }
    if (gt == 0) {
        float s1 = 0.f, s2 = 0.f;
        for (int i = 0; i < 64; ++i) { s1 += p.in[I_LQ1][i] * p.in[I_LK1][i]; s2 += p.in[I_LQ2][i] * p.in[I_LK2][i]; }
        ((float*)(ws + WS_CTL))[1024] = expf(s1) - expf(s2) + LAM_INIT;
    }
    float* sc = lds;
    float* red = lds + 5 * 1024;
    for (int i = tid; i < 5 * 1024; i += NT) { const int r = i >> 10, k = i & 1023; const float v = (r < 4) ? p.in[I_C][r * 1024 + k] : p.in[I_CCTX][k]; sc[i] = silu_f(v); }
    __syncthreads();
    const int wave = tid >> 6, lane = tid & 63;
    float* mod = (float*)(ws + WS_MOD);
    for (int task = bid; task < 96; task += nblk) {
        const int col = task * 64 + lane;
        float a0 = 0, a1 = 0, a2 = 0, a3 = 0, a4 = 0;
        const float* wm = p.in[I_WMOD];
#pragma unroll 32
        for (int k = wave * 128; k < wave * 128 + 128; ++k) { const float w = wm[(size_t)k * 6144 + col]; a0 += sc[k] * w; a1 += sc[1024 + k] * w; a2 += sc[2048 + k] * w; a3 += sc[3072 + k] * w; a4 += sc[4096 + k] * w; }
        red[(wave * 5 + 0) * 64 + lane] = a0; red[(wave * 5 + 1) * 64 + lane] = a1; red[(wave * 5 + 2) * 64 + lane] = a2; red[(wave * 5 + 3) * 64 + lane] = a3; red[(wave * 5 + 4) * 64 + lane] = a4;
        __syncthreads();
        if (tid < 320) { const int r = tid >> 6, l = tid & 63; float s = 0.f; for (int w = 0; w < 8; ++w) s += red[(w * 5 + r) * 64 + l]; mod[r * 6144 + task * 64 + l] = s + p.in[I_BMOD][task * 64 + l]; }
        __syncthreads();
    }
}

__device__ __forceinline__ void ph_norm1(const Params& p) {
    const int tid = otid(), wave = tid >> 6, lane = tid & 63;
    const int gw = blockIdx.x * NWV + wave, GW = gridDim.x * NWV;
    const float* mod = (const float*)(p.ws + WS_MOD);
    bf16_t* hx = (bf16_t*)(p.ws + WS_HX);
    const float* g = p.in[I_GAPRE];
    for (int m = gw; m < MTOT; m += GW) {
        const float* src = (m < T) ? p.in[I_X] + (size_t)m * D : p.in[I_CTX] + (size_t)(m - T) * D;
        const int r = (m < T) ? (m >> 13) : 4;
        const float* shift = mod + r * 6144; const float* scale = shift + 1024;
        f32x4 v[4]; float ss = 0.f;
#pragma unroll
        for (int j = 0; j < 4; ++j) { v[j] = ((const f32x4*)src)[lane + 64 * j]; ss += v[j][0] * v[j][0] + v[j][1] * v[j][1] + v[j][2] * v[j][2] + v[j][3] * v[j][3]; }
        ss = wave_sum(ss);
        const float rs = 1.0f / sqrtf(ss * (1.0f / D) + EPS);
#pragma unroll
        for (int j = 0; j < 4; ++j) {
            const int col = 4 * (lane + 64 * j);
            const f32x4 g4 = *(const f32x4*)(g + col), sc4 = *(const f32x4*)(scale + col), sh4 = *(const f32x4*)(shift + col);
            float h[4];
#pragma unroll
            for (int i = 0; i < 4; ++i) h[i] = v[j][i] * rs * g4[i] * (1.f + sc4[i]) + sh4[i];
            uint2 o; o.x = pk2(h[0], h[1]); o.y = pk2(h[2], h[3]);
            *(uint2*)(hx + (size_t)m * D + col) = o;
        }
    }
}

namespace gp {
#define GP_LAS __attribute__((address_space(3)))
typedef short bf16x8 __attribute__((ext_vector_type(8)));
typedef unsigned u32x4 __attribute__((ext_vector_type(4)));
typedef int i32x4 __attribute__((ext_vector_type(4)));
constexpr int BM = 256, BK = 64, HALF = 128, HTB = HALF * BK * 2, STAGE_BYTES = 8 * HTB;
__device__ __forceinline__ int lds_byte(int r, int c) { const int st = (r >> 4) * 2 + (c >> 5), rr = r & 15, cc = c & 31, ob = rr * 64 + cc * 2; return st * 1024 + (ob ^ (((ob >> 9) & 1) << 5)); }
__device__ __forceinline__ void stage_rc(int b, int& R, int& C) { const int st = b / 1024, sb = b % 1024, swz = sb ^ (((sb >> 9) & 1) << 5); R = (st >> 1) * 16 + swz / 64; C = (st & 1) * 32 + (swz % 64) / 2; }
__device__ __forceinline__ int perm32(int rho) { const int n = rho >> 4, i = rho & 15; return 8 * (i >> 2) + 4 * n + (i & 3); }
struct Unit { int pm, pn, e, b, cnt, base; };
__device__ __forceinline__ unsigned cvt_pk_bf16(float lo, float hi) { unsigned r; asm volatile("v_cvt_pk_bf16_f32 %0, %1, %2" : "=v"(r) : "v"(lo), "v"(hi)); return r; }

template <class Epi, class Sched, bool ALIGN_EPI, bool F8 = false>
__device__ __forceinline__ void gemm_phase(const int wv, GP_LAS unsigned char* lds, const char* Abase, const int K, const Sched& S, const Epi& E) {
    const int wid = wv, wr = wid >> 2, wc = wid & 3;
    const int nt = K / BK;
    unsigned voffB[2];
#pragma unroll
    for (int i = 0; i < 2; ++i) { int R, C; stage_rc(otid_w(wv) * 16 + i * 8192, R, C); const int Rb = (R & ~31) + perm32(R & 31); voffB[i] = (unsigned)(Rb * K + C) * 2u; }
#define GP_AOFFS(u, o00, o01, o10, o11) do { int R0, C0, R1, C1; const int t_ = otid_w(wv); stage_rc(t_ * 16, R0, C0); stage_rc(t_ * 16 + 8192, R1, C1); \
        o00 = S.arow(u, R0) + (unsigned)C0 * 2u; o01 = S.arow(u, R1) + (unsigned)C1 * 2u; o10 = S.arow(u, HALF + R0) + (unsigned)C0 * 2u; o11 = S.arow(u, HALF + R1) + (unsigned)C1 * 2u; } while (0)
    const size_t kstep = (size_t)(BK * 2);
    const size_t hstep = (size_t)HALF * K * 2;
    const unsigned ldsw = (unsigned)wid * 1024u;
    int aoff, boff; { const int l_ = lane_id(), fr = l_ & 15, fq = l_ >> 4; aoff = lds_byte(wr * 64 + fr, fq * 8); boff = lds_byte(wc * 32 + fr, fq * 8); }
#define GP_SA(b, h) (((b) * 2 + (h)) * HTB)
#define GP_SB(b, h) ((4 + (b) * 2 + (h)) * HTB)
#define GP_STAGE_B(bufoff, gbase) do { _Pragma("unroll") for (int _i = 0; _i < 2; ++_i) \
        __builtin_amdgcn_global_load_lds((const unsigned*)((const char*)(gbase) + voffB[_i]), (GP_LAS unsigned*)(lds + (bufoff) + ldsw + _i * 8192), 16, 0, 0); } while (0)
#define GP_STAGE_A(bufoff, gbase, o0, o1) do { \
        __builtin_amdgcn_global_load_lds((const unsigned*)((const char*)(gbase) + (o0)), (GP_LAS unsigned*)(lds + (bufoff) + ldsw), 16, 0, 0); \
        __builtin_amdgcn_global_load_lds((const unsigned*)((const char*)(gbase) + (o1)), (GP_LAS unsigned*)(lds + (bufoff) + ldsw + 8192), 16, 0, 0); } while (0)
#define GP_LDA(dst, b, h) do { _Pragma("unroll") for (int m = 0; m < 4; ++m) _Pragma("unroll") for (int k = 0; k < 2; ++k) dst[m][k] = *(const GP_LAS bf16x8*)(lds + GP_SA(b, h) + aoff + m * 2048 + k * 1024); } while (0)
#define GP_LDB(dst, b, h) do { _Pragma("unroll") for (int n = 0; n < 2; ++n) _Pragma("unroll") for (int k = 0; k < 2; ++k) dst[n][k] = *(const GP_LAS bf16x8*)(lds + GP_SB(b, h) + boff + n * 2048 + k * 1024); } while (0)
#define GP_CAT8(x) __builtin_shufflevector(__builtin_bit_cast(i32x4, x[0]), __builtin_bit_cast(i32x4, x[1]), 0, 1, 2, 3, 4, 5, 6, 7)
#define GP_MMA(ai, bj, At, Bt) do { __builtin_amdgcn_s_setprio(1); _Pragma("unroll") for (int m = 0; m < 4; ++m) _Pragma("unroll") for (int n = 0; n < 2; ++n) { \
        if constexpr (F8) acc[ai][bj][m][n] = __builtin_amdgcn_mfma_scale_f32_16x16x128_f8f6f4(GP_CAT8(Bt[n]), GP_CAT8(At[m]), acc[ai][bj][m][n], 0, 0, 0, 0, 0, 0); \
        else { _Pragma("unroll") for (int k = 0; k < 2; ++k) acc[ai][bj][m][n] = __builtin_amdgcn_mfma_f32_16x16x32_bf16(Bt[n][k], At[m][k], acc[ai][bj][m][n], 0, 0, 0); } } \
        __builtin_amdgcn_s_setprio(0); } while (0)
#define GP_WAIT_V(n) asm volatile("s_waitcnt vmcnt(" #n ")" ::: "memory")
#define GP_WAIT_L(n) asm volatile("s_waitcnt lgkmcnt(" #n ")" ::: "memory")
#define GP_BAR __builtin_amdgcn_s_barrier()
#define GP_SCHED __builtin_amdgcn_sched_barrier(0)
    Unit cur, nxt; int ui = 0;
    if (!S.next(0, cur)) return;
    f32x4 acc[2][2][4][2];
#pragma unroll
    for (int a = 0; a < 2; ++a)
#pragma unroll
        for (int b = 0; b < 2; ++b)
#pragma unroll
            for (int m = 0; m < 4; ++m)
#pragma unroll
                for (int n = 0; n < 2; ++n) acc[a][b][m][n] = (f32x4){0.f, 0.f, 0.f, 0.f};
    bf16x8 At[4][2], B0[2][2], B1[2][2];
    unsigned ac00, ac01, ac10, ac11, an00, an01, an10, an11;
    GP_AOFFS(cur, ac00, ac01, ac10, ac11);
    const char* cB = S.bptr(cur);
    GP_STAGE_B(GP_SB(0, 0), cB); GP_STAGE_B(GP_SB(0, 1), cB + hstep); GP_STAGE_A(GP_SA(0, 0), Abase, ac00, ac01); GP_STAGE_A(GP_SA(0, 1), Abase, ac10, ac11);
    if (wr == 1) GP_BAR;
    GP_WAIT_V(2); GP_BAR;
    GP_STAGE_B(GP_SB(1, 0), cB + kstep); GP_STAGE_A(GP_SA(1, 0), Abase + kstep, ac00, ac01); GP_STAGE_B(GP_SB(1, 1), cB + hstep + kstep);
    GP_WAIT_V(6); GP_BAR;
    for (;;) {
        const bool has_next = S.next(ui + 1, nxt);
        if (has_next) { GP_AOFFS(nxt, an00, an01, an10, an11); }
        else { an00 = ac00; an01 = ac01; an10 = ac10; an11 = ac11; }
        const char* nB = has_next ? S.bptr(nxt) : cB;
#pragma unroll 1
        for (int t = 0; t < nt; t += 2) {
            const bool last = (t == nt - 2);
            const char* a1 = Abase + (size_t)(t + 1) * kstep;
            const char* a2 = last ? Abase : Abase + (size_t)(t + 2) * kstep; const char* b2 = last ? nB : cB + (size_t)(t + 2) * kstep;
            const char* a3 = a2 + kstep; const char* b3 = b2 + kstep;
            GP_LDB(B0, 0, 0); GP_LDB(B1, 0, 1); GP_SCHED; GP_LDA(At, 0, 0); GP_STAGE_A(GP_SA(1, 1), a1, ac10, ac11);
            if (last) { ac00 = an00; ac01 = an01; ac10 = an10; ac11 = an11; }
            GP_WAIT_V(8); GP_WAIT_L(0); GP_BAR; GP_MMA(0, 0, At, B0); GP_MMA(0, 1, At, B1); GP_BAR; GP_SCHED;
            GP_LDA(At, 0, 1); GP_STAGE_B(GP_SB(0, 0), b2); GP_STAGE_B(GP_SB(0, 1), b2 + hstep); GP_STAGE_A(GP_SA(0, 0), a2, ac00, ac01);
            GP_WAIT_V(8); GP_WAIT_L(0); GP_BAR; GP_MMA(1, 0, At, B0); GP_MMA(1, 1, At, B1); GP_BAR; GP_SCHED;
            GP_LDB(B0, 1, 0); GP_LDB(B1, 1, 1); GP_SCHED; GP_LDA(At, 1, 0); GP_STAGE_A(GP_SA(0, 1), a2, ac10, ac11);
            GP_WAIT_V(8); GP_WAIT_L(0); GP_BAR; GP_MMA(0, 0, At, B0); GP_MMA(0, 1, At, B1); GP_BAR; GP_SCHED;
            GP_LDA(At, 1, 1); GP_STAGE_B(GP_SB(1, 0), b3); GP_STAGE_B(GP_SB(1, 1), b3 + hstep); GP_STAGE_A(GP_SA(1, 0), a3, ac00, ac01);
            GP_WAIT_V(8); GP_WAIT_L(0); GP_BAR; GP_MMA(1, 0, At, B0); GP_MMA(1, 1, At, B1); GP_BAR; GP_SCHED;
        }
        if constexpr (ALIGN_EPI) { if (wr == 0) GP_BAR; }
        { const int l_ = lane_id(); E(acc, cur, wr, wc, l_ & 15, l_ >> 4); }
        if (!has_next) break;
#pragma unroll
        for (int a = 0; a < 2; ++a)
#pragma unroll
            for (int b = 0; b < 2; ++b)
#pragma unroll
                for (int m = 0; m < 4; ++m)
#pragma unroll
                    for (int n = 0; n < 2; ++n) acc[a][b][m][n] = (f32x4){0.f, 0.f, 0.f, 0.f};
        cur = nxt; cB = nB; ++ui;
        if constexpr (ALIGN_EPI) { if (wr == 1) GP_BAR; }
    }
    GP_WAIT_V(0);
    if constexpr (!ALIGN_EPI) { if (wr == 0) GP_BAR; }
    GP_BAR;
#undef GP_AOFFS
#undef GP_SA
#undef GP_SB
#undef GP_STAGE_A
#undef GP_STAGE_B
#undef GP_LDA
#undef GP_LDB
#undef GP_MMA
#undef GP_CAT8
#undef GP_WAIT_V
#undef GP_WAIT_L
#undef GP_BAR
#undef GP_SCHED
}

struct DenseSched {
    int nM, nN, nwg, G, c, K; const char* Bt;
    __device__ __forceinline__ void init(int M, int N, int K_, const void* Bt_, int G_, int c_) { nM = M / BM; nN = N / BM; nwg = nM * nN; G = G_; c = c_; K = K_; Bt = (const char*)Bt_; }
    __device__ __forceinline__ bool next(int i, Unit& u) const {
        const long L = (long)i * G + c; if (L >= nwg) return false;
        int wgid = (int)L; { const int q = nwg / 8, r = nwg % 8, xcd = wgid % 8, off = wgid / 8; wgid = (xcd < r ? xcd * (q + 1) : r * (q + 1) + (xcd - r) * q) + off; }
        const int nig = 8 * nN, gid = wgid / nig, fm = gid * 8, gsz = (nM - fm) < 8 ? (nM - fm) : 8;
        u.pm = fm + ((wgid % nig) % gsz); u.pn = (wgid % nig) / gsz; u.e = 0; u.b = 0; u.cnt = 0; u.base = 0; return true;
    }
    __device__ __forceinline__ unsigned arow(const Unit& u, int r) const { return (unsigned)(u.pm * BM + r) * (unsigned)(K * 2); }
    __device__ __forceinline__ const char* bptr(const Unit& u) const { return Bt + (size_t)u.pn * BM * K * 2; }
};
}

struct EpiInProj {
    bf16_t* F; bf16_t* Q; bf16_t* Kb; bf16_t* Vb; const float* rope;
    __device__ __forceinline__ void operator()(const f32x4 (&acc)[2][2][4][2], const gp::Unit& u, int wr, int wc, int fr, int fq) const {
        const int pn = u.pn, pm = u.pm; const bool isctx = pm >= T / 256;
        if (isctx && pn < 4) return;
        if (pn >= 7) {
            unsigned char* V8 = (unsigned char*)Vb;
#pragma unroll
            for (int ai = 0; ai < 2; ++ai) {
                const int row0 = pm * 256 + ai * 128 + wr * 64;
                int b, tile;
                if (!isctx) { b = row0 >> 13; tile = (CTX >> 6) + ((row0 & 8191) >> 6); } else { const int j = row0 - T; b = j >> 8; tile = (j & 255) >> 6; }
#pragma unroll
                for (int bj = 0; bj < 2; ++bj) {
                    const int head = (pn - 7) * 2 + bj;
                    unsigned char* dst = V8 + ((size_t)(b * NH + head) * (KVLEN / 64) + tile) * 8192 + wc * 2048 + fq * 64 + (fr >> 3) * 32 + (fr & 1) * 16 + ((fr >> 1) & 3) * 4;
#pragma unroll
                    for (int e = 0; e < 8; ++e) {
                        int w = __builtin_amdgcn_cvt_pk_fp8_f32(acc[ai][bj][0][e >> 2][e & 3], acc[ai][bj][1][e >> 2][e & 3], 0, false);
                        w = __builtin_amdgcn_cvt_pk_fp8_f32(acc[ai][bj][2][e >> 2][e & 3], acc[ai][bj][3][e >> 2][e & 3], w, true);
                        *(int*)(dst + e * 256) = w;
                    }
                }
            }
            return;
        }
        const int axis = wc & 1; const float* ct = rope + (axis ? 4096 : 0); const float* st = rope + (axis ? 4096 + 1024 : 2048);
#pragma unroll
        for (int ai = 0; ai < 2; ++ai)
#pragma unroll
            for (int m = 0; m < 4; ++m) {
                const int row = pm * 256 + ai * 128 + wr * 64 + m * 16 + fr;
                int t, kb, tile;
                if (!isctx) { kb = row >> 13; t = row & 8191; tile = (CTX >> 6) + (t >> 6); } else { const int j = row - T; t = 0; kb = j >> 8; tile = (j & 255) >> 6; }
                const int pos = axis ? (t & 63) : (t >> 6);
#pragma unroll
                for (int bj = 0; bj < 2; ++bj) {
                    const int col0 = pn * 256 + bj * 128 + wc * 32 + fq * 8;
                    f32x4 v0 = acc[ai][bj][m][0], v1 = acc[ai][bj][m][1];
                    if (pn == 0) { gp::u32x4 w; w.x = gp::cvt_pk_bf16(v0[0], v0[1]); w.y = gp::cvt_pk_bf16(v0[2], v0[3]); w.z = gp::cvt_pk_bf16(v1[0], v1[1]); w.w = gp::cvt_pk_bf16(v1[2], v1[3]);
                        *(gp::u32x4*)(F + (size_t)row * 256 + col0) = w; continue; }
                    if (pn < 7 && !isctx) {
                        const f32x4 c0 = *(const f32x4*)(ct + pos * 16 + 8 * (fq & 1)), c1 = *(const f32x4*)(ct + pos * 16 + 8 * (fq & 1) + 4);
                        const f32x4 s0 = *(const f32x4*)(st + pos * 16 + 8 * (fq & 1)), s1 = *(const f32x4*)(st + pos * 16 + 8 * (fq & 1) + 4);
                        const float sg = (fq < 2) ? -1.f : 1.f;
#pragma unroll
                        for (int i = 0; i < 4; ++i) {
                            const auto r0 = __builtin_amdgcn_permlane32_swap(__float_as_uint(v0[i]), __float_as_uint(v0[i]), false, false);
                            const auto r1 = __builtin_amdgcn_permlane32_swap(__float_as_uint(v1[i]), __float_as_uint(v1[i]), false, false);
                            const float p0 = __uint_as_float(fq < 2 ? r0[1] : r0[0]), p1 = __uint_as_float(fq < 2 ? r1[1] : r1[0]);
                            v0[i] = v0[i] * c0[i] + sg * p0 * s0[i]; v1[i] = v1[i] * c1[i] + sg * p1 * s1[i]; }
                    }
                    v0 = v0 * SQS; v1 = v1 * SQS;
                    int w0 = __builtin_amdgcn_cvt_pk_fp8_f32(v0[0], v0[1], 0, false); w0 = __builtin_amdgcn_cvt_pk_fp8_f32(v0[2], v0[3], w0, true);
                    int w1 = __builtin_amdgcn_cvt_pk_fp8_f32(v1[0], v1[1], 0, false); w1 = __builtin_amdgcn_cvt_pk_fp8_f32(v1[2], v1[3], w1, true);
                    unsigned char* d;
                    if (pn < 4) d = (unsigned char*)Q + (size_t)row * QKW + (col0 - 256);
                    else d = (unsigned char*)Kb + ((size_t)(kb * NH + (pn - 4) * 2 + bj) * (KVLEN / 64) + tile) * 8192 + wc * 2048 + m * 512 + fr * 32 + fq * 8;
                    typedef int i32x2_t __attribute__((ext_vector_type(2)));
                    *(i32x2_t*)d = (i32x2_t){w0, w1};
                }
            }
    }
};
struct EpiStoreBf16 {
    bf16_t* O; int ldc;
    __device__ __forceinline__ void operator()(const f32x4 (&acc)[2][2][4][2], const gp::Unit& u, int wr, int wc, int fr, int fq) const {
#pragma unroll
        for (int ai = 0; ai < 2; ++ai)
#pragma unroll
            for (int m = 0; m < 4; ++m) {
                bf16_t* rowp = O + (size_t)(u.pm * 256 + ai * 128 + wr * 64 + m * 16 + fr) * ldc + u.pn * 256 + wc * 32 + fq * 8;
#pragma unroll
                for (int bj = 0; bj < 2; ++bj) { const f32x4 v0 = acc[ai][bj][m][0], v1 = acc[ai][bj][m][1];
                    gp::u32x4 w; w.x = gp::cvt_pk_bf16(v0[0], v0[1]); w.y = gp::cvt_pk_bf16(v0[2], v0[3]); w.z = gp::cvt_pk_bf16(v1[0], v1[1]); w.w = gp::cvt_pk_bf16(v1[2], v1[3]);
                    *(gp::u32x4*)(rowp + bj * 128) = w; }
            }
    }
};

__device__ __forceinline__ void ph_inproj(const Params& p, unsigned char* smem) {
    unsigned char* ws = p.ws;
    gp::DenseSched S; S.init(MTOT, INW, D, ws + WS_WINT, gridDim.x, blockIdx.x);
    EpiInProj E{(bf16_t*)(ws + WS_F), (bf16_t*)(ws + WS_Q), (bf16_t*)(ws + WS_K), (bf16_t*)(ws + WS_V), (const float*)(ws + WS_ROPE)};
    gp::gemm_phase<EpiInProj, gp::DenseSched, true>(p.chunk, (GP_LAS unsigned char*)smem, (const char*)(ws + WS_HX), D, S, E);
}
__device__ __forceinline__ void ph_outproj(const Params& p, unsigned char* smem) {
    unsigned char* ws = p.ws;
    gp::DenseSched S; S.init(T, D, D, ws + WS_WOUTT, gridDim.x, blockIdx.x);
    EpiStoreBf16 E{(bf16_t*)(ws + WS_YX), D};
    gp::gemm_phase<EpiStoreBf16, gp::DenseSched, true>(p.chunk, (GP_LAS unsigned char*)smem, (const char*)(ws + WS_AO), D, S, E);
}

constexpr float GUSCALE = 64.f;
__device__ __forceinline__ void transpose_item8(const float* W, int K, int N, unsigned char* WT, int row_base, int kb, int nb, float* scr, int lane) {
    const int k0 = 64 * kb, n0 = 32 * nb;
    float tv[32];
#pragma unroll
    for (int i = 0; i < 32; ++i) tv[i] = W[(size_t)(k0 + 2 * i + (lane >> 5)) * N + n0 + (lane & 31)];
#pragma unroll
    for (int i = 0; i < 32; ++i) scr[(2 * i + (lane >> 5)) * 33 + (lane & 31)] = tv[i] * GUSCALE;
    asm volatile("s_waitcnt lgkmcnt(0)" ::: "memory");
    const int c = lane & 7;
#pragma unroll
    for (int j = 0; j < 4; ++j) { const int n = (lane >> 3) + 8 * j; const float* s = scr + (8 * c) * 33 + n;
        int w0 = __builtin_amdgcn_cvt_pk_fp8_f32(s[0 * 33], s[1 * 33], 0, false); w0 = __builtin_amdgcn_cvt_pk_fp8_f32(s[2 * 33], s[3 * 33], w0, true);
        int w1 = __builtin_amdgcn_cvt_pk_fp8_f32(s[4 * 33], s[5 * 33], 0, false); w1 = __builtin_amdgcn_cvt_pk_fp8_f32(s[6 * 33], s[7 * 33], w1, true);
        uint2 o; o.x = (unsigned)w0; o.y = (unsigned)w1;
        *(uint2*)(WT + (size_t)(row_base + n0 + n) * K + k0 + 8 * c) = o; }
    asm volatile("s_waitcnt lgkmcnt(0)" ::: "memory");
}
__device__ __forceinline__ void transpose_item(const float* W, int K, int N, bf16_t* WT, int row_base, int kb, int nb, float* scr, int lane) {
    const int k0 = 64 * kb, n0 = 32 * nb;
    float tv[32];
#pragma unroll
    for (int i = 0; i < 32; ++i) tv[i] = W[(size_t)(k0 + 2 * i + (lane >> 5)) * N + n0 + (lane & 31)];
#pragma unroll
    for (int i = 0; i < 32; ++i) scr[(2 * i + (lane >> 5)) * 33 + (lane & 31)] = tv[i];
    asm volatile("s_waitcnt lgkmcnt(0)" ::: "memory");
    const int c = lane & 7;
#pragma unroll
    for (int j = 0; j < 4; ++j) { const int n = (lane >> 3) + 8 * j; const float* s = scr + (8 * c) * 33 + n;
        uint4 o; o.x = pk2(s[0 * 33], s[1 * 33]); o.y = pk2(s[2 * 33], s[3 * 33]); o.z = pk2(s[4 * 33], s[5 * 33]); o.w = pk2(s[6 * 33], s[7 * 33]);
        *(uint4*)(WT + (size_t)(row_base + n0 + n) * K + k0 + 8 * c) = o; }
    asm volatile("s_waitcnt lgkmcnt(0)" ::: "memory");
}
__device__ __forceinline__ void ph_prep_weights(const Params& p, float* lds, const int part, const int first) {
    const int tid = otid(), wave = tid >> 6, lane = tid & 63;
    float* scr = lds + 8192 + wave * (64 * 33);
    if ((int)blockIdx.x < first) return;
    const int gw = ((int)blockIdx.x - first) * NWV + wave, GW = ((int)gridDim.x - first) * NWV;
    unsigned char* ws = p.ws;
    constexpr int I_IN = 16 * 80, I_OUT = 16 * 32, I_GU = 16 * 8, I_D = 4 * 32;
    constexpr int NITEMS = I_IN + I_OUT + 65 * (2 * I_GU + I_D);
    const int it_lo = part ? I_IN + I_OUT : 0, it_hi = part ? NITEMS : I_IN + I_OUT;
    for (int it = it_lo + gw; it < it_hi; it += GW) {
        int r = it;
        if (r < I_IN) { transpose_item(p.in[I_WIN], D, INW, (bf16_t*)(ws + WS_WINT), 0, r / 80, r % 80, scr, lane); continue; } r -= I_IN;
        if (r < I_OUT) { transpose_item(p.in[I_WOUT], D, D, (bf16_t*)(ws + WS_WOUTT), 0, r / 32, r % 32, scr, lane); continue; } r -= I_OUT;
        const int e = r / (2 * I_GU + I_D); r -= e * (2 * I_GU + I_D);
        if (r < 2 * I_GU) {
            const int half = r / I_GU, q = r % I_GU, kb = q / 8, nb = q % 8;
            const float* W = (e < 64) ? p.in[half ? I_WU : I_WG] + (size_t)e * D * DE : p.in[half ? I_WSU : I_WSG];
            const int n0 = 32 * nb, drow = e * 512 + (n0 >> 7) * 256 + half * 128 + (n0 & 127);
            transpose_item8(W, D, DE, ws + WS_WGUT, drow - n0, kb, nb, scr, lane);
        } else {
            r -= 2 * I_GU;
            const float* W = (e < 64) ? p.in[I_WD] + (size_t)e * DE * D : p.in[I_WSD];
            transpose_item(W, DE, D, (bf16_t*)(ws + WS_WDT), e * 1024, r / 32, r % 32, scr, lane);
        }
    }
}

namespace fa {
typedef short bf16x8 __attribute__((ext_vector_type(8)));
typedef short s16x4 __attribute__((ext_vector_type(4)));
typedef float f32x16 __attribute__((ext_vector_type(16)));
typedef unsigned u32x4 __attribute__((ext_vector_type(4)));
constexpr int KVBLK = 64, LDK = QKW;
constexpr float SCALE = 0.125f, THR = 8.f;
constexpr size_t SHM_V = KVBLK * 128 * 2, SHM_K = KVBLK * 128 * 2;
#define KSWZ(row, colB) ((row) * 256 + ((colB) ^ (((row) & 15) << 4)))
#define SBAR() __builtin_amdgcn_sched_barrier(0)
__device__ __forceinline__ int crow(int r, int hi) { return (r & 3) + 8 * (r >> 2) + 4 * hi; }
__device__ __forceinline__ unsigned cvtpk(float lo, float hi) { unsigned r; asm volatile("v_cvt_pk_bf16_f32 %0, %1, %2" : "=v"(r) : "v"(lo), "v"(hi)); return r; }
constexpr float PBIAS = 5.f, THR2 = PBIAS + 3.5f;
template <bool FIRST>
__device__ __forceinline__ void partialSM(f32x16& p0, f32x16& p1, float& m_reg, f32x16& negm, float& alpha) {
  float pmax = p0[0];
#pragma unroll
  for (int r = 1; r < 16; ++r) pmax = fmaxf(pmax, p0[r]);
#pragma unroll
  for (int r = 0; r < 16; ++r) pmax = fmaxf(pmax, p1[r]);
  { auto rr = __builtin_amdgcn_permlane32_swap(__float_as_uint(pmax), __float_as_uint(pmax), false, false);
    pmax = fmaxf(__uint_as_float(rr[0]), __uint_as_float(rr[1])); }
  if (!FIRST && __builtin_expect(__all(pmax <= THR2), 1)) { alpha = 1.f; }
  else { const float dl = FIRST ? pmax - PBIAS : fmaxf(pmax - PBIAS, 0.f); alpha = FIRST ? 0.f : __builtin_amdgcn_exp2f(-dl); m_reg += dl;
#pragma unroll
    for (int r = 0; r < 16; ++r) { p0[r] -= dl; p1[r] -= dl; }
#pragma unroll
    for (int r = 0; r < 16; ++r) negm[r] = -m_reg;
    asm volatile("" : "+v"(negm)); }
#pragma unroll
  for (int r = 0; r < 16; ++r) p0[r] = __builtin_amdgcn_exp2f(p0[r]);
}
typedef int i32x8 __attribute__((ext_vector_type(8)));
__device__ __forceinline__ int pk4_fp8(float a, float b, float c, float d) { int w; asm("v_cvt_pk_fp8_f32 %0, %1, %2" : "=v"(w) : "v"(a), "v"(b)); asm("v_cvt_pk_fp8_f32 %0, %1, %2 op_sel:[0,0,1]" : "+v"(w) : "v"(c), "v"(d)); return w; }
__device__ __forceinline__ void finishSM_T(f32x16& p0, f32x16& p1, i32x8& pb) {
#pragma unroll
  for (int r = 0; r < 16; ++r) p1[r] = __builtin_amdgcn_exp2f(p1[r]);
#pragma unroll
  for (int g = 0; g < 4; ++g) {
    pb[g] = pk4_fp8(p0[4 * g], p0[4 * g + 1], p0[4 * g + 2], p0[4 * g + 3]); pb[4 + g] = pk4_fp8(p1[4 * g], p1[4 * g + 1], p1[4 * g + 2], p1[4 * g + 3]); }
}
__device__ __forceinline__ void qkt(f32x16& p0, f32x16& p1, const char* Ks, const i32x8 qf, int lane, int mm, const f32x16& negm) {
  const char* kp = Ks + mm * 4096 + lane * 16;
  const u32x4 a0 = *reinterpret_cast<const u32x4*>(kp), a1 = *reinterpret_cast<const u32x4*>(kp + 1024), b0 = *reinterpret_cast<const u32x4*>(kp + 2048), b1 = *reinterpret_cast<const u32x4*>(kp + 3072);
  p0 = __builtin_amdgcn_mfma_scale_f32_32x32x64_f8f6f4((i32x8){(int)a0.x, (int)a0.y, (int)a0.z, (int)a0.w, (int)a1.x, (int)a1.y, (int)a1.z, (int)a1.w}, qf, negm, 0, 0, 0, 0, 0, 0);
  p1 = __builtin_amdgcn_mfma_scale_f32_32x32x64_f8f6f4((i32x8){(int)b0.x, (int)b0.y, (int)b0.z, (int)b0.w, (int)b1.x, (int)b1.y, (int)b1.z, (int)b1.w}, qf, negm, 0, 0, 0, 0, 0, 0);
}
__device__ __forceinline__ int v_st(int k, int c) { const int kk = (k & ~0xC) | ((k & 4) << 1) | ((k & 8) >> 1); return ((kk >> 3) * 4 + (c >> 5)) * 512 + ((kk & 7) * 32 + (c & 31)) * 2; }
__device__ __forceinline__ int v_rd_base(int lane) { return ((lane & 3) << 3) | (((lane >> 2) & 3) << 6) | (((lane >> 4) & 1) << 5) | (((lane >> 5) & 1) << 8); }
constexpr int v_rd_off(int d0, int ks, int half) { return d0 * 512 + ks * 4096 + half * 2048; }
template <int OFF> __device__ __forceinline__ s16x4 tr_read(int vb) {
  s16x4 r; asm volatile("ds_read_b64_tr_b16 %0, %1 offset:%2" : "=&v"(r) : "v"(vb), "i"(OFF) : "memory"); return r;
}
template <int D0> __device__ __forceinline__ void pv_one(f32x16& od, int vb, bf16x8 pa0, bf16x8 pa1, bf16x8 pa2, bf16x8 pa3) {
  const s16x4 l0 = tr_read<v_rd_off(D0, 0, 0)>(vb), h0 = tr_read<v_rd_off(D0, 0, 1)>(vb), l1 = tr_read<v_rd_off(D0, 1, 0)>(vb), h1 = tr_read<v_rd_off(D0, 1, 1)>(vb);
  const s16x4 l2 = tr_read<v_rd_off(D0, 2, 0)>(vb), h2 = tr_read<v_rd_off(D0, 2, 1)>(vb), l3 = tr_read<v_rd_off(D0, 3, 0)>(vb), h3 = tr_read<v_rd_off(D0, 3, 1)>(vb);
  asm volatile("s_waitcnt lgkmcnt(0)" ::: "memory"); SBAR();
#define PK(L, H) (bf16x8){L[0], L[1], L[2], L[3], H[0], H[1], H[2], H[3]}
  od = __builtin_amdgcn_mfma_f32_32x32x16_bf16(pa0, PK(l0, h0), od, 0, 0, 0);
  od = __builtin_amdgcn_mfma_f32_32x32x16_bf16(pa1, PK(l1, h1), od, 0, 0, 0);
  od = __builtin_amdgcn_mfma_f32_32x32x16_bf16(pa2, PK(l2, h2), od, 0, 0, 0);
  od = __builtin_amdgcn_mfma_f32_32x32x16_bf16(pa3, PK(l3, h3), od, 0, 0, 0);
#undef PK
}
__device__ __forceinline__ void pv_d0(f32x16* o, int vb, bf16x8 pa0, bf16x8 pa1, bf16x8 pa2, bf16x8 pa3) {
  pv_one<0>(o[0], vb, pa0, pa1, pa2, pa3); pv_one<1>(o[1], vb, pa0, pa1, pa2, pa3); pv_one<2>(o[2], vb, pa0, pa1, pa2, pa3); pv_one<3>(o[3], vb, pa0, pa1, pa2, pa3);
}

template <int OFF> __device__ __forceinline__ u32x4 rd128(int vb) { u32x4 r; asm volatile("ds_read_b128 %0, %1 offset:%2" : "=&v"(r) : "v"(vb), "i"(OFF) : "memory"); return r; }
#define PV_RD(D0) const u32x4 va##D0 = rd128<D0 * 2048>(vb), vc##D0 = rd128<D0 * 2048 + 1024>(vb); SBAR()
#define PV_MM(D0) do { asm volatile("s_waitcnt lgkmcnt(0)" ::: "memory"); SBAR(); \
    o[D0] = __builtin_amdgcn_mfma_scale_f32_32x32x64_f8f6f4((i32x8){(int)va##D0.x, (int)va##D0.y, (int)va##D0.z, (int)va##D0.w, (int)vc##D0.x, (int)vc##D0.y, (int)vc##D0.z, (int)vc##D0.w}, pb, o[D0], 0, 0, 0, 0, 0, 0); } while (0)
__device__ __forceinline__ float max3f(float a, float b, float c) { float r; asm("v_max3_f32 %0, %1, %2, %3" : "=v"(r) : "v"(a), "v"(b), "v"(c)); return r; }
#define PV_LSUM() lacc = __builtin_amdgcn_mfma_scale_f32_32x32x64_f8f6f4((i32x8){0x38383838, 0x38383838, 0x38383838, 0x38383838, 0x38383838, 0x38383838, 0x38383838, 0x38383838}, pb, lacc, 0, 0, 0, 0, 0, 0)
__device__ __forceinline__ void pv_psm(f32x16* o, f32x16& lacc, int vb, i32x8 pb, f32x16& p0, f32x16& p1, float& m_reg, f32x16& negm, float& alpha) {
  float pmax;
  { PV_RD(0);
    pmax = max3f(p0[0], p0[1], p0[2]);
#pragma unroll
    for (int r = 3; r < 15; r += 2) pmax = max3f(pmax, p0[r], p0[r + 1]);
    pmax = max3f(pmax, p0[15], p1[0]);
    SBAR(); PV_MM(0); }
  { PV_RD(1);
#pragma unroll
    for (int r = 1; r < 15; r += 2) pmax = max3f(pmax, p1[r], p1[r + 1]);
    pmax = max3f(pmax, p1[15], p1[15]);
    { auto rr = __builtin_amdgcn_permlane32_swap(__float_as_uint(pmax), __float_as_uint(pmax), false, false);
      pmax = max3f(__uint_as_float(rr[0]), __uint_as_float(rr[1]), __uint_as_float(rr[1])); }
    if (__builtin_expect(__all(pmax <= THR2), 1)) { alpha = 1.f; }
    else { const float dl = fmaxf(pmax - PBIAS, 0.f); alpha = __builtin_amdgcn_exp2f(-dl); m_reg += dl;
#pragma unroll
      for (int r = 0; r < 16; ++r) { p0[r] -= dl; p1[r] -= dl; }
#pragma unroll
      for (int r = 0; r < 16; ++r) negm[r] = -m_reg;
      asm volatile("" : "+v"(negm)); }
    SBAR(); PV_MM(1); }
  { PV_RD(2);
#pragma unroll
    for (int r = 0; r < 8; ++r) p0[r] = __builtin_amdgcn_exp2f(p0[r]);
    asm volatile("" : "+v"(p0));
    SBAR(); PV_MM(2); }
  { PV_RD(3);
#pragma unroll
    for (int r = 8; r < 16; ++r) p0[r] = __builtin_amdgcn_exp2f(p0[r]);
    asm volatile("" : "+v"(p0));
    SBAR(); PV_MM(3); PV_LSUM(); }
}
__device__ __forceinline__ void pvT_d0(f32x16* o, f32x16& lacc, int vb, i32x8 pb) {
  { PV_RD(0); PV_MM(0); } { PV_RD(1); PV_MM(1); } { PV_RD(2); PV_MM(2); } { PV_RD(3); PV_MM(3); PV_LSUM(); }
}
#undef PV_RD
#undef PV_MM
#undef PV_LSUM

__device__ __forceinline__ void attn_unit(const unsigned char* __restrict__ Qb, const unsigned char* __restrict__ Kh, const unsigned char* __restrict__ Vh, bf16_t* __restrict__ Ob,
                                          const float* __restrict__ gsub, const float lam, char* lds, const int wv) {
  typedef __attribute__((address_space(3))) unsigned* ldsu_t;
  const int tid = otid_w(wv), wid = wv, lane = tid & 63, r32 = lane & 31, hi = lane >> 5, mm = wid >> 2, wq = wid & 3;
  constexpr int NB = 4;
  constexpr int SHM_V8 = KVBLK * 128;
  char* V_lds = lds; char* K_lds = lds + NB * SHM_V8; constexpr int SHM_K8 = KVBLK * 128;
  float m_reg = 0.f; f32x16 o[4] = {}; f32x16 lacc = {}; i32x8 qf; f32x16 negm = {}; asm volatile("" : "+v"(negm));
  const unsigned koff = (unsigned)((2 * (wid >> 2) + (lane >> 5)) * 2048 + (lane & 3) * 512 + (8 * ((wid >> 1) & 1) + 2 * ((lane & 31) >> 3) + ((lane >> 2) & 1)) * 32 + (wid & 1) * 16);
  const unsigned voff = (unsigned)((wid >> 1) * 2048 + (lane & 7) * 256 + ((lane >> 3) & 3) * 64 + (wid & 1) * 32 + (lane >> 5) * 16);
#define DMA(t, buf) do { const char* kb_ = (const char*)(Kh + (size_t)(t) * SHM_K8); const char* vb_ = (const char*)(Vh + (size_t)(t) * SHM_V8); asm volatile("" : "+s"(kb_), "+s"(vb_)); \
    __builtin_amdgcn_global_load_lds((const unsigned*)(kb_ + koff), (ldsu_t)(K_lds + (buf) * SHM_K8 + wid * 1024), 16, 0, 0); \
    __builtin_amdgcn_global_load_lds((const unsigned*)(vb_ + voff), (ldsu_t)(V_lds + (buf) * SHM_V8 + wid * 1024), 16, 0, 0); } while (0)
#define WAIT_BAR(N) asm volatile("s_waitcnt vmcnt(" #N ") lgkmcnt(0)\n\ts_barrier" ::: "memory")
#define RESC(a) do { if (__any((a) < 1.f)) { _Pragma("unroll") for (int d = 0; d < 4; ++d) _Pragma("unroll") for (int r = 0; r < 16; ++r) o[d][r] *= (a); lacc[0] *= (a); } } while (0)
  DMA(0, 0); DMA(1, 1);
  { const unsigned char* Qw = Qb + (long)(wq * 32 + r32) * QKW + mm * 64 + hi * 32;
    const u32x4 q0 = *reinterpret_cast<const u32x4*>(Qw), q1 = *reinterpret_cast<const u32x4*>(Qw + 16);
    qf = (i32x8){(int)q0.x, (int)q0.y, (int)q0.z, (int)q0.w, (int)q1.x, (int)q1.y, (int)q1.z, (int)q1.w}; }
  const int vb0 = (int)(uintptr_t)V_lds + lane * 16;
  f32x16 pA0, pA1, pB0, pB1; float alA, alB; i32x8 pb; constexpr int NTL = KVLEN / KVBLK;
  WAIT_BAR(0);
  DMA(2, 2);
  qkt(pA0, pA1, K_lds, qf, lane, mm, negm); partialSM<true>(pA0, pA1, m_reg, negm, alA);
  WAIT_BAR(2);
  for (int j = 1; j + 1 < NTL; j += 2) {
    DMA(j + 2, (j + 2) & 3);
    SBAR(); qkt(pB0, pB1, K_lds + (j & 3) * SHM_K8, qf, lane, mm, negm);
    finishSM_T(pA0, pA1, pb); SBAR();
    pv_psm(o, lacc, vb0 + ((j - 1) & 3) * SHM_V8, pb, pB0, pB1, m_reg, negm, alB);
    RESC(alB);
    WAIT_BAR(2);
    if (j + 3 < NTL) DMA(j + 3, (j + 3) & 3);
    SBAR(); qkt(pA0, pA1, K_lds + ((j + 1) & 3) * SHM_K8, qf, lane, mm, negm);
    finishSM_T(pB0, pB1, pb); SBAR();
    pv_psm(o, lacc, vb0 + (j & 3) * SHM_V8, pb, pA0, pA1, m_reg, negm, alA);
    RESC(alA);
    if (j + 3 < NTL) WAIT_BAR(2); else WAIT_BAR(0);
  }
  SBAR(); qkt(pB0, pB1, K_lds + ((NTL - 1) & 3) * SHM_K8, qf, lane, mm, negm);
  finishSM_T(pA0, pA1, pb); SBAR();
  pv_psm(o, lacc, vb0 + ((NTL - 2) & 3) * SHM_V8, pb, pB0, pB1, m_reg, negm, alB);
  RESC(alB);
  finishSM_T(pB0, pB1, pb); SBAR();
  pvT_d0(o, lacc, vb0 + ((NTL - 1) & 3) * SHM_V8, pb);
#undef DMA
#undef WAIT_BAR
  const float rl = __builtin_amdgcn_rcpf(lacc[0]) * (mm ? lam : 1.0f);
  __syncthreads();
  constexpr int XS = 132;
  float* X = (float*)lds;
  if (mm == 1) {
#pragma unroll
    for (int r = 0; r < 16; ++r)
#pragma unroll
      for (int d0 = 0; d0 < 4; ++d0) X[(wq * 32 + r32) * XS + d0 * 32 + crow(r, hi)] = o[d0][r] * rl;
  }
  __syncthreads();
  if (mm == 0) {
#pragma unroll
    for (int r = 0; r < 16; ++r)
#pragma unroll
      for (int d0 = 0; d0 < 4; ++d0) { float* xp = X + (wq * 32 + r32) * XS + d0 * 32 + crow(r, hi); *xp = o[d0][r] * rl - *xp; }
  }
  __syncthreads();
  {
    const int row = tid >> 2, seg = tid & 3;
    const float* xr = X + row * XS + seg * 32;
    f32x4 v[8]; float ss = 0.f;
#pragma unroll
    for (int i = 0; i < 8; ++i) { v[i] = *(const f32x4*)(xr + 4 * i); ss += v[i][0] * v[i][0] + v[i][1] * v[i][1] + v[i][2] * v[i][2] + v[i][3] * v[i][3]; }
    ss += sx<1>(ss); ss += sx<2>(ss);
    const float rs = (1.0f - LAM_INIT) / sqrtf(ss * (1.0f / 128.0f) + EPS);
    bf16_t* dst = Ob + (long)row * D + seg * 32;
#pragma unroll
    for (int i = 0; i < 8; i += 2) {
      const f32x4 g0 = *(const f32x4*)(gsub + seg * 32 + 4 * i), g1 = *(const f32x4*)(gsub + seg * 32 + 4 * i + 4);
      u32x4 w; w.x = cvtpk(v[i][0] * rs * g0[0], v[i][1] * rs * g0[1]); w.y = cvtpk(v[i][2] * rs * g0[2], v[i][3] * rs * g0[3]);
      w.z = cvtpk(v[i + 1][0] * rs * g1[0], v[i + 1][1] * rs * g1[1]); w.w = cvtpk(v[i + 1][2] * rs * g1[2], v[i + 1][3] * rs * g1[3]);
      *(u32x4*)(dst + 4 * i) = w;
    }
  }
  __syncthreads();
#undef RESC
}
#undef KSWZ
#undef SBAR
}

__device__ __forceinline__ void ph_attn(const Params& p, unsigned char* smem) {
    unsigned char* ws = p.ws;
    const unsigned char* Q = ws + WS_Q; const unsigned char* Kb = ws + WS_K; const unsigned char* Vb = ws + WS_V;
    bf16_t* AO = (bf16_t*)(ws + WS_AO);
    const float lam = ((const float*)(ws + WS_CTL))[1024];
    const int c = blockIdx.x, G = gridDim.x;
    if (G == 256) {
        const int x = c & 7, s = c >> 3;
        for (int rd = 0; rd < 6; ++rd) {
            const int bh = rd * 4 + (x >> 1), qb = (x & 1) * 32 + s, b = bh / NH, h = bh % NH;
            fa::attn_unit(Q + ((size_t)b * SEQ + qb * 128) * QKW + h * 128, Kb + (size_t)(b * NH + h) * (KVLEN / 64) * 8192, Vb + (size_t)(b * NH + h) * (KVLEN / 64) * 8192,
                          AO + ((size_t)b * SEQ + qb * 128) * D + 256 + h * 128, p.in[I_GSUB], lam, (char*)smem, p.chunk);
        }
    } else {
        for (int u = c; u < BATCH * NH * 64; u += G) {
            const int bh = u >> 6, qb = u & 63, b = bh / NH, h = bh % NH;
            fa::attn_unit(Q + ((size_t)b * SEQ + qb * 128) * QKW + h * 128, Kb + (size_t)(b * NH + h) * (KVLEN / 64) * 8192, Vb + (size_t)(b * NH + h) * (KVLEN / 64) * 8192,
                          AO + ((size_t)b * SEQ + qb * 128) * D + 256 + h * 128, p.in[I_GSUB], lam, (char*)smem, p.chunk);
        }
    }
}

__device__ __forceinline__ void ph_fourierA(const Params& p, unsigned char* smem) {
    using namespace fa;
    unsigned char* ws = p.ws;
    const bf16_t* F = (const bf16_t*)(ws + WS_F); bf16_t* FY = (bf16_t*)(ws + WS_FY); const bf16_t* W = (const bf16_t*)(ws + WS_W128E);
    const int tid = otid(), wid = tid >> 6, lane = tid & 63, r32 = lane & 31, hi = lane >> 5;
    const int sr = tid >> 4, sc = (tid & 15) * 8, vst0 = v_st(sr, sc), vst1 = v_st(32 + sr, sc);
    const int vb0 = (int)(uintptr_t)smem + v_rd_base(lane);
    for (int task = blockIdx.x; task < BATCH * 64; task += gridDim.x) {
        const int b = task >> 6, n2 = task & 63;
        bf16x8 st[4][2];
#pragma unroll
        for (int kt = 0; kt < 2; ++kt)
#pragma unroll
            for (int ct = 0; ct < 2; ++ct) {
                st[kt * 2 + ct][0] = *(const bf16x8*)(F + ((size_t)b * SEQ + 64 * (64 * kt + sr) + n2) * 256 + 128 * ct + sc);
                st[kt * 2 + ct][1] = *(const bf16x8*)(F + ((size_t)b * SEQ + 64 * (64 * kt + 32 + sr) + n2) * 256 + 128 * ct + sc);
            }
        bf16x8 pa[2][4];
#pragma unroll
        for (int kt = 0; kt < 2; ++kt)
#pragma unroll
            for (int ks = 0; ks < 4; ++ks) pa[kt][ks] = *(const bf16x8*)(W + (size_t)(32 * wid + r32) * 128 + 64 * kt + 16 * ks + 8 * hi);
        __syncthreads();
#pragma unroll
        for (int q = 0; q < 4; ++q) { *(bf16x8*)(smem + q * 16384 + vst0) = st[q][0]; *(bf16x8*)(smem + q * 16384 + vst1) = st[q][1]; }
        __syncthreads();
        f32x16 o[2][4] = {};
#pragma unroll
        for (int ct = 0; ct < 2; ++ct)
#pragma unroll
            for (int kt = 0; kt < 2; ++kt) pv_d0(o[ct], vb0 + (kt * 2 + ct) * 16384, pa[kt][0], pa[kt][1], pa[kt][2], pa[kt][3]);
        const int plane = wid >> 2;
#pragma unroll
        for (int r = 0; r < 16; ++r) {
            const int k1 = 32 * (wid & 3) + crow(r, hi);
            bf16_t* dst = FY + ((((size_t)plane * BATCH + b) * 128 + k1) * 64 + n2) * 256 + r32;
#pragma unroll
            for (int ct = 0; ct < 2; ++ct)
#pragma unroll
                for (int d0 = 0; d0 < 4; ++d0) dst[128 * ct + 32 * d0] = f2bf(o[ct][d0][r]);
        }
    }
    __syncthreads();
}
__device__ __forceinline__ void ph_fourierB(const Params& p, unsigned char* smem) {
    using namespace fa;
    unsigned char* ws = p.ws;
    const bf16_t* FY = (const bf16_t*)(ws + WS_FY); const float2* tabw = (const float2*)(ws + WS_TABW);
    const bf16_t* M64 = (const bf16_t*)(ws + WS_M64E); const bf16_t* GT = (const bf16_t*)(ws + WS_GT);
    bf16_t* AO = (bf16_t*)(ws + WS_AO);
    const int tid = otid(), wid = tid >> 6, lane = tid & 63, r32 = lane & 31, hi = lane >> 5;
    const int sr = tid >> 4, sc = (tid & 15) * 8, vst0 = v_st(sr, sc), vst1 = v_st(32 + sr, sc);
    const int vb0 = (int)(uintptr_t)smem + v_rd_base(lane);
    constexpr int XRS = 528;
    unsigned char* XL = smem + 65536;
    const int mt = wid & 3, ctw = wid >> 2;
    for (int task = blockIdx.x; task < BATCH * 128; task += gridDim.x) {
        const int b = task >> 7, k1 = task & 127;
        __syncthreads();
#pragma unroll
        for (int ct = 0; ct < 2; ++ct)
#pragma unroll
            for (int rh = 0; rh < 2; ++rh) {
                const int n2 = sr + 32 * rh;
                const size_t off = ((((size_t)b) * 128 + k1) * 64 + n2) * 256 + 128 * ct + sc;
                const uint4 yr = *(const uint4*)(FY + off), yi = *(const uint4*)(FY + (size_t)BATCH * 128 * 64 * 256 + off);
                const float2 tw = tabw[n2 * k1];
                const unsigned yrw[4] = {yr.x, yr.y, yr.z, yr.w}, yiw[4] = {yi.x, yi.y, yi.z, yi.w};
                unsigned zr[4], zi[4];
#pragma unroll
                for (int q = 0; q < 4; ++q) {
                    const float a0 = __uint_as_float(yrw[q] << 16), a1 = __uint_as_float(yrw[q] & 0xffff0000u), b0 = __uint_as_float(yiw[q] << 16), b1 = __uint_as_float(yiw[q] & 0xffff0000u);
                    zr[q] = pk2(a0 * tw.x + b0 * tw.y, a1 * tw.x + b1 * tw.y); zi[q] = pk2(b0 * tw.x - a0 * tw.y, b1 * tw.x - a1 * tw.y);
                }
                const int vs = rh ? vst1 : vst0;
                *(uint4*)(smem + (0 * 2 + ct) * 16384 + vs) = make_uint4(zr[0], zr[1], zr[2], zr[3]);
                *(uint4*)(smem + (1 * 2 + ct) * 16384 + vs) = make_uint4(zi[0], zi[1], zi[2], zi[3]);
            }
        __syncthreads();
        {
            f32x16 o[4] = {};
#pragma unroll
            for (int kt = 0; kt < 2; ++kt) {
                bf16x8 pa[4];
#pragma unroll
                for (int ks = 0; ks < 4; ++ks) pa[ks] = *(const bf16x8*)(M64 + (size_t)(32 * mt + r32) * 128 + 64 * kt + 16 * ks + 8 * hi);
                pv_d0(o, vb0 + (kt * 2 + ctw) * 16384, pa[0], pa[1], pa[2], pa[3]);
            }
#pragma unroll
            for (int r = 0; r < 16; ++r) {
                const int ro = 32 * mt + crow(r, hi);
                bf16_t* xr = (bf16_t*)(XL + ((ro >> 6) * 64 + (ro & 63)) * XRS) + 128 * ctw + r32;
#pragma unroll
                for (int d0 = 0; d0 < 4; ++d0) xr[32 * d0] = f2bf(o[d0][r]);
            }
        }
        __syncthreads();
#pragma unroll
        for (int tt = 0; tt < 2; ++tt) {
            const int tau = 2 * wid + tt, g = tau >> 2, mt2 = (tau >> 1) & 1, nt2 = tau & 1;
            f32x16 acc = {};
#pragma unroll
            for (int ks8 = 0; ks8 < 8; ++ks8) {
                const int part = ks8 >> 2, cb = ks8 & 3;
                const bf16x8 af = *(const bf16x8*)(XL + (part * 64 + 32 * mt2 + r32) * XRS + (g * 64 + 16 * cb + 8 * hi) * 2);
                const bf16x8 bfr = *(const bf16x8*)(GT + ((size_t)g * 64 + 32 * nt2 + r32) * 128 + part * 64 + 16 * cb + 8 * hi);
                acc = __builtin_amdgcn_mfma_f32_32x32x16_bf16(af, bfr, acc, 0, 0, 0);
            }
#pragma unroll
            for (int r = 0; r < 16; ++r) { const int k2 = 32 * mt2 + crow(r, hi);
                AO[((size_t)b * SEQ + k1 + 128 * k2) * D + g * 64 + 32 * nt2 + r32] = f2bf(acc[r]); }
        }
    }
    __syncthreads();
}

__device__ __forceinline__ void ph_mid(const Params& p, unsigned char* smem) {
    typedef short bf16x8 __attribute__((ext_vector_type(8)));
    unsigned char* ws = p.ws;
    const int tid = otid(), wave = tid >> 6, lane = tid & 63, fr = lane & 15, fq = lane >> 4;
    const float* mod = (const float*)(ws + WS_MOD);
    const bf16_t* YX = (const bf16_t*)(ws + WS_YX);
    unsigned char* H2 = ws + WS_H2;
    unsigned* counts = (unsigned*)(ws + WS_CTL);
    int* TE = (int*)(ws + WS_TE); int* TP = (int*)(ws + WS_TP); float* TW = (float*)(ws + WS_TW); int* TOKL = (int*)(ws + WS_TOKL);
    constexpr int RS = 2064;
    unsigned char* Ahi = smem; unsigned char* Alo = smem + 16 * RS; float* Pp = (float*)(smem + 2 * 16 * RS + 512);
    const float rbias = p.in[I_RB][lane];
    int* lcnt = (int*)(smem + 99328); int* gb = lcnt + 64; int* PE = gb + 64; float* PW = (float*)(PE + 1024); float* PV = PW + 1024;
    for (int chunk = blockIdx.x; chunk < T / 128; chunk += gridDim.x) {
      const int mc = chunk * 128, b = mc >> 13;
      if (tid < 64) lcnt[tid] = 0;
      {
          const float* mrow_ = mod + b * 6144;
          for (int i = tid; i < 5 * 256; i += NT) { const int v_ = i >> 8, q_ = (i & 255) * 4;
              const float* s_ = (v_ == 0) ? p.in[I_GAPOST] + q_ : (v_ == 1) ? mrow_ + 2 * 1024 + q_ : (v_ == 2) ? p.in[I_GFPRE] + q_ : (v_ == 3) ? mrow_ + 3 * 1024 + q_ : mrow_ + 4 * 1024 + q_;
              *(f32x4*)(PV + v_ * 1024 + q_) = *(const f32x4*)s_; }
          __syncthreads();
      }
      uint2 yw[2][4]; f32x4 xv[2][4];
#define MID_LOAD(m0_) do { _Pragma("unroll") for (int rr = 0; rr < 2; ++rr) { const int m_ = (m0_) + 2 * wave + rr; _Pragma("unroll") for (int j = 0; j < 4; ++j) { \
          yw[rr][j] = *(const uint2*)(YX + (size_t)m_ * D + 4 * (lane + 64 * j)); xv[rr][j] = ((const f32x4*)(p.in[I_X] + (size_t)m_ * D))[lane + 64 * j]; } } } while (0)
      MID_LOAD(mc);
      for (int it = 0; it < 8; ++it) {
        const int m0 = mc + it * 16;
        {
            float ss[2] = {0.f, 0.f};
#define YV(rr, j, i) ((i) == 0 ? __uint_as_float(yw[rr][j].x << 16) : (i) == 1 ? __uint_as_float(yw[rr][j].x & 0xffff0000u) : (i) == 2 ? __uint_as_float(yw[rr][j].y << 16) : __uint_as_float(yw[rr][j].y & 0xffff0000u))
#pragma unroll
            for (int rr = 0; rr < 2; ++rr) {
#pragma unroll
                for (int j = 0; j < 4; ++j) ss[rr] += YV(rr, j, 0) * YV(rr, j, 0) + YV(rr, j, 1) * YV(rr, j, 1) + YV(rr, j, 2) * YV(rr, j, 2) + YV(rr, j, 3) * YV(rr, j, 3);
                ss[rr] = wave_sum(ss[rr]);
            }
#pragma unroll
            for (int rr = 0; rr < 2; ++rr) {
                const int lr = 2 * wave + rr, m = m0 + lr;
                const float r1 = 1.0f / sqrtf(ss[rr] * (1.0f / D) + EPS);
                float ss2 = 0.f;
#pragma unroll
                for (int j = 0; j < 4; ++j) {
                    const int col = 4 * (lane + 64 * j);
                    const f32x4 gp = *(const f32x4*)(PV + col), gt = *(const f32x4*)(PV + 1024 + col);
#pragma unroll
                    for (int i = 0; i < 4; ++i) { xv[rr][j][i] = xv[rr][j][i] + gt[i] * (YV(rr, j, i) * r1 * gp[i]); ss2 += xv[rr][j][i] * xv[rr][j][i]; }
                    ((f32x4*)(p.out + (size_t)m * D))[lane + 64 * j] = xv[rr][j];
                }
                ss2 = wave_sum(ss2);
                const float r2 = 1.0f / sqrtf(ss2 * (1.0f / D) + EPS);
#pragma unroll
                for (int j = 0; j < 4; ++j) {
                    const int col = 4 * (lane + 64 * j);
                    const f32x4 gp = *(const f32x4*)(PV + 2048 + col), sh = *(const f32x4*)(PV + 3072 + col), sc = *(const f32x4*)(PV + 4096 + col);
                    float h[4]; bf16_t hb[4]; float lo[4];
#pragma unroll
                    for (int i = 0; i < 4; ++i) { h[i] = xv[rr][j][i] * r2 * gp[i] * (1.f + sc[i]) + sh[i]; hb[i] = f2bf(h[i]); lo[i] = h[i] - bf2f(hb[i]); }
                    uint2 o; o.x = (unsigned)hb[0] | ((unsigned)hb[1] << 16); o.y = (unsigned)hb[2] | ((unsigned)hb[3] << 16);
                    { int w8 = __builtin_amdgcn_cvt_pk_fp8_f32(h[0], h[1], 0, false); w8 = __builtin_amdgcn_cvt_pk_fp8_f32(h[2], h[3], w8, true); *(int*)(H2 + (size_t)m * D + col) = w8; }
                    *(uint2*)(Ahi + lr * RS + col * 2) = o;
                    uint2 ol; ol.x = pk2(lo[0], lo[1]); ol.y = pk2(lo[2], lo[3]);
                    *(uint2*)(Alo + lr * RS + col * 2) = ol;
                }
            }
            if (it < 7) MID_LOAD(m0 + 16);
        }
        asm volatile("s_waitcnt lgkmcnt(0)\n\ts_barrier" ::: "memory");
        {
            f32x4 acc[4];
#pragma unroll
            for (int nb = 0; nb < 4; ++nb) acc[nb] = (f32x4){0.f, 0.f, 0.f, 0.f};
            const bf16_t* wrtlo = (const bf16_t*)(ws + WS_WRT); asm volatile("" : "+s"(wrtlo));
#pragma unroll
            for (int ks = 0; ks < 4; ++ks) {
                const int ko = (wave * 128 + ks * 32 + 8 * fq) * 2;
                const bf16x8 ah = *(const bf16x8*)(Ahi + fr * RS + ko), al = *(const bf16x8*)(Alo + fr * RS + ko);
#pragma unroll
                for (int nb = 0; nb < 4; ++nb) {
                    const size_t wo_ = ((size_t)(((wave * 4 + ks) * 4 + nb) * 2) * 64 + lane) * 8;
                    const bf16x8 bhv = *(const bf16x8*)(wrtlo + wo_), bl = *(const bf16x8*)(wrtlo + wo_ + 512);
                    acc[nb] = __builtin_amdgcn_mfma_f32_16x16x32_bf16(ah, bhv, acc[nb], 0, 0, 0);
                    acc[nb] = __builtin_amdgcn_mfma_f32_16x16x32_bf16(ah, bl, acc[nb], 0, 0, 0);
                    acc[nb] = __builtin_amdgcn_mfma_f32_16x16x32_bf16(al, bhv, acc[nb], 0, 0, 0);
                }
            }
#pragma unroll
            for (int nb = 0; nb < 4; ++nb)
#pragma unroll
                for (int j = 0; j < 4; ++j) Pp[(wave * 16 + 4 * fq + j) * 64 + 16 * nb + fr] = acc[nb][j];
        }
        asm volatile("s_waitcnt lgkmcnt(0)\n\ts_barrier" ::: "memory");
#pragma unroll
        for (int rr = 0; rr < 2; ++rr) {
            const int lr = 2 * wave + rr;
            float lg = 0.f;
#pragma unroll
            for (int w = 0; w < 8; ++w) lg += Pp[(w * 16 + lr) * 64 + lane];
            const float score = 1.0f / (1.0f + expf(-lg));
            const float sel = score + rbias;
            float t1 = sel, t2 = -INFINITY;
#define TOP2(M) do { const float o1 = sx<M>(t1), o2 = sx<M>(t2); const float n1 = fmaxf(t1, o1), n2 = fmaxf(fminf(t1, o1), fmaxf(t2, o2)); t1 = n1; t2 = n2; } while (0)
            TOP2(1); TOP2(2); TOP2(4);
#undef TOP2
            const float gs = t1 + t2; const int grp = lane >> 3;
            int gr = 0;
#pragma unroll
            for (int j = 0; j < 8; ++j) { const float sj = __uint_as_float(__builtin_amdgcn_readlane(__float_as_uint(gs), j * 8)); gr += (sj > gs || (sj == gs && j < grp)) ? 1 : 0; }
            const bool gsel = gr < 4;
            float v = gsel ? sel : -INFINITY;
            int rk = TOPK;
#pragma unroll
            for (int it8 = 0; it8 < TOPK; ++it8) {
                const float mx = wave_max(v);
                const unsigned long long eq = __ballot(v == mx);
                const int win = __builtin_ctzll(eq);
                if (lane == win) { rk = it8; v = -INFINITY; }
            }
            const bool chosen = rk < TOPK;
            const float ssum = wave_sum(chosen ? score : 0.f);
            const float w = score / (ssum + 1e-20f) * 2.5f;
            if (chosen) {
                const int lpos = atomicAdd(&lcnt[lane], 1);
                const int idx = (it * 16 + lr) * 8 + rk;
                PE[idx] = lane | (lpos << 8); PW[idx] = w;
            }
        }
      }
      __syncthreads();
      if (tid < 64) { const int c = lcnt[tid]; gb[tid] = c ? (int)atomicAdd(&counts[b * 65 + tid], (unsigned)c) : 0; }
      __syncthreads();
      for (int i = tid; i < 1024; i += NT) {
          const int pe = PE[i], e = pe & 255, pos = gb[e] + (pe >> 8), mk = mc * 8 + i;
          TOKL[((size_t)b * 64 + e) * 8192 + pos] = mk; TE[mk] = e; TP[mk] = pos; TW[mk] = PW[i];
      }
      __syncthreads();
    }
}

constexpr int T_CNT = 0;
constexpr int T_TOT = 256;
constexpr int T_AB = 328;
constexpr int T_OFF = 400;
constexpr int T_GUP = 660;
constexpr int T_YC = 730;
constexpr int T_YB = 990;
constexpr int T_DUP = 1250;
constexpr int T_UL = 1520;
constexpr int T_END = 1520 + 512;
__device__ __forceinline__ int scan_incl(int v, int lane) {
#pragma unroll
    for (int off = 1; off < 64; off <<= 1) { const int t = __builtin_amdgcn_ds_bpermute(((lane - off) & 63) << 2, v); if (lane >= off) v += t; }
    return v;
}
__device__ __forceinline__ void build_moe(const Params& p, int* tab) {
    const unsigned* counts = (const unsigned*)(p.ws + WS_CTL);
    __syncthreads();
    const int tid = otid(), wave = tid >> 6, lane = tid & 63;
    if (wave == 0) {
        const int c0 = (int)counts[0 * 65 + lane], c1 = (int)counts[1 * 65 + lane], c2 = (int)counts[2 * 65 + lane], c3 = (int)counts[3 * 65 + lane];
        tab[T_CNT + 0 * 64 + lane] = c0; tab[T_CNT + 1 * 64 + lane] = c1; tab[T_CNT + 2 * 64 + lane] = c2; tab[T_CNT + 3 * 64 + lane] = c3;
        tab[T_OFF + lane * 4 + 0] = 0; tab[T_OFF + lane * 4 + 1] = c0; tab[T_OFF + lane * 4 + 2] = c0 + c1; tab[T_OFF + lane * 4 + 3] = c0 + c1 + c2;
        const int tot = c0 + c1 + c2 + c3, pad = (tot + 255) & ~255, gu = ((tot + 255) >> 8) * 2;
        const int sp = scan_incl(pad, lane), sg = scan_incl(gu, lane);
        tab[T_TOT + lane] = tot; tab[T_AB + lane] = sp - pad; tab[T_GUP + lane] = sg - gu;
        const int cb[4] = {c0, c1, c2, c3};
#pragma unroll
        for (int b = 0; b < 4; ++b) {
            const int du = ((cb[b] + 255) >> 8) * 4;
            const int sy = scan_incl(cb[b], lane), sd = scan_incl(du, lane);
            tab[T_YB + 65 * b + lane] = sy - cb[b]; tab[T_DUP + 66 * b + lane] = sd - du;
            if (lane == 63) { tab[T_YB + 65 * b + 64] = sy; tab[T_DUP + 66 * b + 64] = sd; tab[T_DUP + 66 * b + 65] = sd + (SEQ / 256) * 4; }
        }
        if (lane == 63) { tab[T_TOT + 64] = T; tab[T_AB + 64] = sp; tab[T_GUP + 64] = sg; tab[T_GUP + 65] = sg + (T / 256) * 2; }
    }
    __syncthreads();
}

__device__ __forceinline__ void moe_decode(const GP_LAS int* tab, int e, int pos_e, int& b, int& pos) {
    const int o1 = tab[T_OFF + e * 4 + 1], o2 = tab[T_OFF + e * 4 + 2], o3 = tab[T_OFF + e * 4 + 3];
    b = (pos_e >= o1 ? 1 : 0) + (pos_e >= o2 ? 1 : 0) + (pos_e >= o3 ? 1 : 0);
    pos = pos_e - (b == 0 ? 0 : (b == 1 ? o1 : (b == 2 ? o2 : o3)));
}
__device__ __forceinline__ int yrow0(int b) { return b == 0 ? 2 * 1024 : (272 + 72 * (b - 1)) * 1024; }
struct MoeSched {
    const GP_LAS int* tab; int G, c, ntn, U, down, chunk; const int* TOKL; const char* Bt;
    __device__ __forceinline__ void prepare(int* tabw, int wv) const {
        if (wv == 0) {
            const int i = lane_id(); int L = i * G + c;
            if (L < U) {
                int bt = 0;
                if (down) {
#pragma unroll
                    for (int q = 0; q < 3; ++q) { const int u0 = tabw[T_DUP + 66 * bt + 65]; if (L >= u0) { L -= u0; ++bt; } } }
                const int pre = down ? T_DUP + 66 * bt : T_GUP;
                int lo = 0, hi = 64;
                while (lo < hi) { const int mid = (lo + hi + 1) >> 1; if (tabw[pre + mid] <= L) lo = mid; else hi = mid - 1; }
                const int loc = L - tabw[pre + lo];
                int cnt, base, bb;
                if (down) { cnt = (lo < 64) ? tabw[T_CNT + bt * 64 + (lo & 63)] : SEQ; base = tabw[T_YB + 65 * bt + lo] + yrow0(bt);
                            bb = tabw[T_AB + lo] + (lo < 64 ? tabw[T_OFF + (lo & 63) * 4 + bt] : bt * SEQ); }
                else { cnt = tabw[T_TOT + lo]; base = tabw[T_AB + lo]; bb = 0; }
                int* ul = tabw + T_UL + 8 * i;
                ul[0] = lo; ul[1] = loc / ntn; ul[2] = loc % ntn; ul[3] = cnt; ul[4] = base; ul[5] = bb;
            }
        }
        __syncthreads();
    }
    __device__ __forceinline__ bool next(int i, gp::Unit& u) const {
        if (i * G + c >= U) return false;
        const GP_LAS int* ul = tab + T_UL + 8 * i;
        u.e = __builtin_amdgcn_readfirstlane(ul[0]); u.pm = __builtin_amdgcn_readfirstlane(ul[1]); u.pn = __builtin_amdgcn_readfirstlane(ul[2]);
        u.cnt = __builtin_amdgcn_readfirstlane(ul[3]); u.base = __builtin_amdgcn_readfirstlane(ul[4]); u.b = __builtin_amdgcn_readfirstlane(ul[5]);
        return true;
    }
    __device__ __forceinline__ unsigned arow(const gp::Unit& u, int r) const {
        const int pos_e = u.pm * 256 + r;
        if (down) return (unsigned)(u.b + pos_e) * 512u;
        int tok;
        if (u.e < 64) { int b, pos; moe_decode(tab, u.e, pos_e, b, pos); tok = (pos_e < u.cnt) ? (TOKL[((size_t)b * 64 + u.e) * 8192 + pos] >> 3) : 0; } else tok = pos_e;
        return (unsigned)tok * 1024u;
    }
    __device__ __forceinline__ const char* bptr(const gp::Unit& u) const {
        return down ? Bt + ((size_t)u.e * 1024 + u.pn * 256) * 512 : Bt + ((size_t)u.e * 512 + u.pn * 256) * 1024;
    }
};
struct EpiGU {
    bf16_t* ACT; const int* TOKL; const float* TW; const GP_LAS int* tab;
    __device__ __forceinline__ void operator()(const f32x4 (&acc)[2][2][4][2], const gp::Unit& u, int wr, int wc, int fr, int fq) const {
#pragma unroll
        for (int ai = 0; ai < 2; ++ai)
#pragma unroll
            for (int m = 0; m < 4; ++m) {
                const int pos_e = u.pm * 256 + ai * 128 + wr * 64 + m * 16 + fr;
                if (pos_e < u.cnt) {
                    float w = 1.0f;
                    if (u.e < 64) { int b, pos; moe_decode(tab, u.e, pos_e, b, pos); w = TW[TOKL[((size_t)b * 64 + u.e) * 8192 + pos]]; }
                    float a[8];
#pragma unroll
                    for (int n = 0; n < 2; ++n)
#pragma unroll
                        for (int i = 0; i < 4; ++i) { const float g = acc[ai][0][m][n][i] * (1.f / GUSCALE), up = acc[ai][1][m][n][i] * (1.f / GUSCALE);
                            a[4 * n + i] = g * __builtin_amdgcn_rcpf(1.0f + __builtin_amdgcn_exp2f(-1.4426950408889634f * g)) * up * w; }
                    gp::u32x4 o; o.x = gp::cvt_pk_bf16(a[0], a[1]); o.y = gp::cvt_pk_bf16(a[2], a[3]); o.z = gp::cvt_pk_bf16(a[4], a[5]); o.w = gp::cvt_pk_bf16(a[6], a[7]);
                    *(gp::u32x4*)(ACT + ((size_t)u.base + pos_e) * DE + u.pn * 128 + wc * 32 + fq * 8) = o;
                }
            }
    }
};
constexpr float YSCALE = 16.f;
struct EpiDown {
    unsigned char* ws;
    __device__ __forceinline__ void operator()(const f32x4 (&acc)[2][2][4][2], const gp::Unit& u, int wr, int wc, int fr, int fq) const {
#pragma unroll
        for (int ai = 0; ai < 2; ++ai)
#pragma unroll
            for (int m = 0; m < 4; ++m) {
                const int pos = u.pm * 256 + ai * 128 + wr * 64 + m * 16 + fr;
                if (pos < u.cnt) {
                    unsigned char* rowp = ws + (size_t)(u.base + pos) * D + u.pn * 256 + wc * 32 + fq * 8;
#pragma unroll
                    for (int bj = 0; bj < 2; ++bj) { const f32x4 v0 = acc[ai][bj][m][0] * YSCALE, v1 = acc[ai][bj][m][1] * YSCALE;
                        int w0 = __builtin_amdgcn_cvt_pk_fp8_f32(v0[0], v0[1], 0, false); w0 = __builtin_amdgcn_cvt_pk_fp8_f32(v0[2], v0[3], w0, true);
                        int w1 = __builtin_amdgcn_cvt_pk_fp8_f32(v1[0], v1[1], 0, false); w1 = __builtin_amdgcn_cvt_pk_fp8_f32(v1[2], v1[3], w1, true);
                        uint2 o; o.x = (unsigned)w0; o.y = (unsigned)w1;
                        *(uint2*)(rowp + bj * 128) = o; }
                }
            }
    }
};
__device__ __forceinline__ void ph_moe_gu(const Params& p, unsigned char* smem) {
    unsigned char* ws = p.ws;
    int* tab = (int*)(smem + gp::STAGE_BYTES);
    build_moe(p, tab);
    MoeSched S; S.tab = (const GP_LAS int*)tab; S.G = gridDim.x; S.c = (gridDim.x % 8 == 0) ? (int)((blockIdx.x % 8) * (gridDim.x / 8) + blockIdx.x / 8) : (int)blockIdx.x;   S.ntn = 2; S.U = __builtin_amdgcn_readfirstlane(tab[T_GUP + 65]); S.down = 0; S.chunk = 0;
    S.TOKL = (const int*)(ws + WS_TOKL); S.Bt = (const char*)(ws + WS_WGUT);
    S.prepare(tab, p.chunk);
    EpiGU E{(bf16_t*)(ws + WS_ACT), (const int*)(ws + WS_TOKL), (const float*)(ws + WS_TW), (const GP_LAS int*)tab};
    gp::gemm_phase<EpiGU, MoeSched, true, true>(p.chunk, (GP_LAS unsigned char*)smem, (const char*)(ws + WS_H2), D / 2, S, E);
}
__device__ __forceinline__ void ph_moe_down(const Params& p, unsigned char* smem, int c) {
    unsigned char* ws = p.ws;
    int* tab = (int*)(smem + gp::STAGE_BYTES);
    build_moe(p, tab);
    MoeSched S; S.tab = (const GP_LAS int*)tab; S.G = gridDim.x; S.c = (gridDim.x % 8 == 0) ? (int)((blockIdx.x % 8) * (gridDim.x / 8) + blockIdx.x / 8) : (int)blockIdx.x;   S.ntn = 4; S.U = __builtin_amdgcn_readfirstlane(tab[T_DUP + 65] + tab[T_DUP + 66 + 65] + tab[T_DUP + 132 + 65] + tab[T_DUP + 198 + 65]); S.down = 1; S.chunk = c;
    S.TOKL = nullptr; S.Bt = (const char*)(ws + WS_WDT);
    S.prepare(tab, p.chunk);
    EpiDown E{ws};
    gp::gemm_phase<EpiDown, MoeSched, false>(p.chunk, (GP_LAS unsigned char*)smem, (const char*)(ws + WS_ACT), DE, S, E);
}

__device__ __forceinline__ void ph_final(const Params& p, float* lds) {
    unsigned char* ws = p.ws;
    int* tab = (int*)lds;
    build_moe(p, tab);
    const int tid = otid(), wave = tid >> 6, lane = tid & 63;
    const int gw = blockIdx.x * NWV + wave, GW = gridDim.x * NWV;
    const int* TE = (const int*)(ws + WS_TE); const int* TP = (const int*)(ws + WS_TP);
    const unsigned char* Y = ws;
    for (int m = gw; m < T; m += GW) {
        const int b = m >> 13, t = m & (SEQ - 1);
        const float* mod = (const float*)(ws + WS_MOD) + b * 6144 + 5 * 1024;
        float acc[16];
#pragma unroll
        for (int i = 0; i < 16; ++i) acc[i] = 0.f;
#pragma unroll
        for (int k = 0; k < 9; ++k) {
            int row;
            if (k < 8) { const int e = TE[m * 8 + k]; row = tab[T_YB + 65 * b + e] + TP[m * 8 + k]; }
            else row = tab[T_YB + 65 * b + 64] + t;
            row += yrow0(b);
            const unsigned char* yr = Y + (size_t)row * D;
#pragma unroll
            for (int j = 0; j < 4; ++j) { const int w = *(const int*)(yr + 4 * (lane + 64 * j));
                acc[4 * j] += __builtin_amdgcn_cvt_f32_fp8(w, 0); acc[4 * j + 1] += __builtin_amdgcn_cvt_f32_fp8(w, 1); acc[4 * j + 2] += __builtin_amdgcn_cvt_f32_fp8(w, 2); acc[4 * j + 3] += __builtin_amdgcn_cvt_f32_fp8(w, 3); }
        }
        float ss = 0.f;
#pragma unroll
        for (int i = 0; i < 16; ++i) { acc[i] *= (1.f / YSCALE); ss += acc[i] * acc[i]; }
        ss = wave_sum(ss);
        const float rs = 1.0f / sqrtf(ss * (1.0f / D) + EPS);
#pragma unroll
        for (int j = 0; j < 4; ++j) {
            const int col = 4 * (lane + 64 * j);
            const f32x4 gp = *(const f32x4*)(p.in[I_GFPOST] + col), gt = *(const f32x4*)(mod + col);
            f32x4 x1 = ((const f32x4*)(p.out + (size_t)m * D))[lane + 64 * j];
#pragma unroll
            for (int i = 0; i < 4; ++i) x1[i] += gt[i] * (acc[4 * j + i] * rs * gp[i]);
            ((f32x4*)(p.out + (size_t)m * D))[lane + 64 * j] = x1;
        }
    }
}

#define GAS __attribute__((address_space(1)))
#define LAS __attribute__((address_space(3)))
#define XB_TMO      128
#define XB_XCNT(j)  (256  + 64 * (j))
#define XB_XSUB(j)  (1280 + 64 * (j))
#define XB_XGEN(j)  (2304 + 64 * (j))
#define XB_TOP      3328
#define XB_TOPGEN   3392
#define XCD_BAR_WORDS 3456
#define XB_SPIN_CAP (1u << 21)
__device__ __forceinline__ unsigned xb_ld(unsigned* p)              { return __hip_atomic_load(p, __ATOMIC_RELAXED, __HIP_MEMORY_SCOPE_AGENT); }
__device__ __forceinline__ unsigned xb_add(unsigned* p, unsigned v) { return __hip_atomic_fetch_add(p, v, __ATOMIC_RELAXED, __HIP_MEMORY_SCOPE_AGENT); }
__device__ __forceinline__ unsigned xb_xcc_id() { return (unsigned)__builtin_amdgcn_s_getreg((3 << 11) | 20) & 0xFu; }
#define XB_SPIN(cond, bar) do { unsigned _sp = 0; while (cond) { __builtin_amdgcn_s_sleep(1); \
    if ((++_sp & 255u) == 0u) { if (xb_ld(&(bar)[XB_TMO])) break; if (_sp > XB_SPIN_CAP) { atomicAdd(&(bar)[XB_TMO], 1u); break; } } } } while (0)
struct XcdBarrier { unsigned* bar; unsigned x; volatile LAS unsigned* st; };
__device__ __forceinline__ XcdBarrier xcd_barrier_post(unsigned* bar, volatile LAS unsigned* st, int wv) {
    XcdBarrier b; b.bar = bar; b.x = xb_xcc_id(); b.st = st;
    if (wv == 0 && lane_id() == 0) (void)xb_add(&bar[XB_XCNT(b.x)], 1u);
    return b;
}
__device__ __forceinline__ void xcd_barrier_complete(unsigned* bar, unsigned x, unsigned& nloc, unsigned& nx) {
    const unsigned G = gridDim.x * gridDim.y * gridDim.z;
    unsigned sum, cnt, mine, sp = 0u;
    for (;;) {
        sum = 0u; cnt = 0u; mine = 0u;
#pragma unroll
        for (unsigned j = 0; j < 16; ++j) { const unsigned c = xb_ld(&bar[XB_XCNT(j)]); sum += c; cnt += (c > 0u) ? 1u : 0u; mine = (j == x) ? c : mine; }
        if (sum == G) break;
        __builtin_amdgcn_s_sleep(1);
        if ((++sp & 255u) == 0u) { if (xb_ld(&bar[XB_TMO])) break; if (sp > XB_SPIN_CAP) { atomicAdd(&bar[XB_TMO], 1u); break; } }
    }
    nloc = mine > 0u ? mine : 1u; nx = cnt > 0u ? cnt : 1u;
}
__device__ __forceinline__ void xcd_barrier(const XcdBarrier& b, int wv) {
    asm volatile("s_waitcnt vmcnt(0)" ::: "memory");
    __syncthreads();
    if (wv == 0 && lane_id() == 0) {
        unsigned* bar = b.bar;
        __builtin_amdgcn_s_waitcnt(0);
        unsigned nloc = b.st[0], nx = b.st[1];
        if (nloc == 0u) { xcd_barrier_complete(bar, b.x, nloc, nx); b.st[0] = nloc; b.st[1] = nx; }
        const unsigned old = xb_add(&bar[XB_XSUB(b.x)], 1u);
        const unsigned gen = old / nloc;
        if (old + 1u == (gen + 1u) * nloc) {
            __builtin_amdgcn_fence(__ATOMIC_RELEASE, "agent");
            asm volatile("s_waitcnt vmcnt(0)" ::: "memory");
            const unsigned og = xb_add(&bar[XB_TOP], 1u);
            const unsigned tg = og / nx;
            if (og + 1u == (tg + 1u) * nx) xb_add(&bar[XB_TOPGEN], 1u);
            else XB_SPIN(xb_ld(&bar[XB_TOPGEN]) == tg, bar);
            __builtin_amdgcn_fence(__ATOMIC_ACQUIRE, "agent");
            xb_add(&bar[XB_XGEN(b.x)], 1u);
            asm volatile("s_waitcnt vmcnt(0)" ::: "memory");
        } else {
            XB_SPIN(xb_ld(&bar[XB_XGEN(b.x)]) == gen, bar);
            __builtin_amdgcn_fence(__ATOMIC_ACQUIRE, "agent");
            asm volatile("s_waitcnt vmcnt(0)" ::: "memory");
        }
    }
    __syncthreads();
}

namespace cg = cooperative_groups;
constexpr int LDS_BYTES = 144 * 1024;
typedef const __attribute__((address_space(4))) Params* KP;
__device__ __forceinline__ Params kargs() {
    Params p;
#if defined(__HIP_DEVICE_COMPILE__)
    typedef const __attribute__((address_space(4))) unsigned long long* KQ;
    KQ kq = (KQ)__builtin_amdgcn_kernarg_segment_ptr(); asm volatile("" : "+s"(kq));
    unsigned long long* d = (unsigned long long*)&p;
#pragma unroll
    for (int i = 0; i < (int)(sizeof(Params) / 8); ++i) d[i] = kq[i];
#endif
    return p;
}
#define PH(call) do { Params p = kargs(); p.chunk = wv; call; } while (0)
__global__ void __launch_bounds__(NT) mega_fwd(Params p_unused) {
    extern __shared__ __attribute__((aligned(16))) unsigned char smem[];
    float* lds = (float*)smem;
    volatile LAS unsigned* misc = (volatile LAS unsigned*)((LAS unsigned char*)smem + (LDS_BYTES - 64));
    if (threadIdx.x < 16) misc[threadIdx.x] = 0u;
    __syncthreads();
    unsigned* barw; { const Params p = kargs(); barw = (unsigned*)(p.ws + WS_CTL) + 4096; }
    const int wv = __builtin_amdgcn_readfirstlane(threadIdx.x >> 6);
    const XcdBarrier bar = xcd_barrier_post(barw, misc, wv);
#define SYNC() xcd_barrier(bar, wv)
    PH(ph_prep(p, lds)); PH(ph_prep_weights(p, lds, 0, 0));   SYNC();
    PH(ph_norm1(p));                SYNC();
    PH(ph_inproj(p, smem)); PH(ph_prep_weights(p, lds, 1, (MTOT / 256) * (INW / 256) % (int)gridDim.x));         SYNC();
    PH(ph_attn(p, smem)); PH(ph_fourierA(p, smem));  SYNC();
    PH(ph_fourierB(p, smem));       SYNC();
    PH(ph_outproj(p, smem));        SYNC();
    PH(ph_mid(p, smem));            SYNC();
    PH(ph_moe_gu(p, smem));         SYNC();
#pragma unroll 1
    PH(ph_moe_down(p, smem, 0));    SYNC();
    PH(ph_final(p, lds));
#undef SYNC
}

extern "C" void kernel_launch(void* const* d_in, const int* in_sizes, int n_in, void* d_out, int out_size, void* d_ws, size_t ws_size, hipStream_t stream) {
    if (n_in != 26 || ws_size < WS_END) { fprintf(stderr, "kernel_launch: unexpected n_in %d / ws %zu\n", n_in, ws_size); return; }
    static int grid_blocks = 0;
    if (!grid_blocks) {
        int dev = 0, cus = 0, per_cu = 0;
        (void)hipGetDevice(&dev);
        (void)hipDeviceGetAttribute(&cus, hipDeviceAttributeMultiprocessorCount, dev);
        (void)hipFuncSetAttribute((const void*)mega_fwd, hipFuncAttributeMaxDynamicSharedMemorySize, LDS_BYTES);
        (void)hipOccupancyMaxActiveBlocksPerMultiprocessor(&per_cu, (const void*)mega_fwd, NT, LDS_BYTES);
        if (per_cu < 1) { fprintf(stderr, "kernel_launch: occupancy query says %d blocks/CU\n", per_cu); per_cu = 1; }
        if (per_cu > 1) per_cu = 1;
        grid_blocks = cus * per_cu;
    }
    Params p{};
    for (int i = 0; i < 26; ++i) p.in[i] = (const float*)d_in[i];
    p.out = (float*)d_out; p.ws = (unsigned char*)d_ws; p.chunk = 0; p.pad = 0;
    (void)hipMemsetAsync((char*)d_ws + WS_CTL, 0, 32768, stream);
    void* args[] = {&p};
    hipError_t e = hipLaunchCooperativeKernel((const void*)mega_fwd, dim3(grid_blocks), dim3(NT), args, LDS_BYTES, stream);
    if (e != hipSuccess) fprintf(stderr, "cooperative launch failed: %s (grid %d)\n", hipGetErrorString(e), grid_blocks);
}
```

```cpp
#include <hip/hip_runtime.h>
#include <hip/hip_cooperative_groups.h>
#include <cstdio>
#include <cstdint>

typedef unsigned short bf16_t;
typedef float f32x4 __attribute__((ext_vector_type(4)));

constexpr int D = 1024, BATCH = 4, SEQ = 8192, T = BATCH * SEQ, CTX = 256, TC = BATCH * CTX;
constexpr int MTOT = T + TC;
constexpr int KVLEN = CTX + SEQ;
constexpr int INW = 2560, NH = 6, QKW = 768, FW = 256;
constexpr int NE = 64, DE = 256, TOPK = 8;
constexpr int NT = 512, NWV = 8;
constexpr int SLOTS_B = 90112;
constexpr float EPS = 1e-6f;
constexpr float LAM_INIT = 0.2f;
constexpr float QSCALE = 0.125f * 1.4426950408889634f;
constexpr float SQS = 0.42466090014400953f;

constexpr size_t MiB = 1u << 20;
constexpr size_t WS_CTL = 0;
constexpr size_t WS_MOD = 1 * MiB;
constexpr size_t WS_TABW = WS_MOD + 128 * 1024;
constexpr size_t WS_ROPE = WS_MOD + 192 * 1024;
constexpr size_t WS_GCS = WS_MOD + 256 * 1024;
constexpr size_t WS_W128E = WS_MOD + 768 * 1024;
constexpr size_t WS_M64E = WS_MOD + 832 * 1024;
constexpr size_t WS_GT = WS_MOD + 864 * 1024;
constexpr size_t WS_WRT = WS_MOD + 512 * 1024;
constexpr size_t WS_WINT = 2 * MiB;
constexpr size_t WS_WOUTT = 7 * MiB;
constexpr size_t WS_WGUT = 9 * MiB;
constexpr size_t WS_WDT = 74 * MiB;
constexpr size_t WS_TE = 107 * MiB;
constexpr size_t WS_TP = 108 * MiB;
constexpr size_t WS_TW = 109 * MiB;
constexpr size_t WS_TOKL = 110 * MiB;
constexpr size_t WS_AO = 118 * MiB;
constexpr size_t WS_ACT = 118 * MiB;
constexpr size_t WS_Q = 182 * MiB;
constexpr size_t WS_K = 230 * MiB;
constexpr size_t WS_V = WS_K + (size_t)BATCH * KVLEN * QKW * 2;
constexpr size_t WS_F = 329 * MiB;
constexpr size_t WS_FY = 361 * MiB;
constexpr size_t WS_HX = 425 * MiB;
constexpr size_t WS_YX = 358 * MiB;
constexpr size_t WS_H2 = 294 * MiB;
constexpr size_t WS_Y = 294 * MiB;
constexpr size_t WS_END = 491 * MiB;

struct Params {
    const float* in[26];
    float* out;
    unsigned char* ws;
    int chunk;
    int pad;
};
enum { I_X = 0, I_C, I_CTX, I_CCTX, I_WMOD, I_BMOD, I_GAPRE, I_GAPOST, I_WIN, I_WF, I_LQ1, I_LK1, I_LQ2, I_LK2, I_GSUB, I_WOUT,
       I_GFPRE, I_GFPOST, I_WR, I_RB, I_WG, I_WU, I_WD, I_WSG, I_WSU, I_WSD };

__device__ __forceinline__ float bf2f(bf16_t v) { return __uint_as_float(((unsigned)v) << 16); }
__device__ __forceinline__ bf16_t f2bf(float f) { unsigned u = __float_as_uint(f); return (bf16_t)((u + 0x7fffu + ((u >> 16) & 1u)) >> 16); }
__device__ __forceinline__ unsigned pk2(float lo, float hi) { return (unsigned)f2bf(lo) | ((unsigned)f2bf(hi) << 16); }
template <int M> __device__ __forceinline__ float sx(float v) { return __int_as_float(__builtin_amdgcn_ds_swizzle(__float_as_int(v), (M << 10) | 0x1f)); }
template <int M> __device__ __forceinline__ int sxi(int v) { return __builtin_amdgcn_ds_swizzle(v, (M << 10) | 0x1f); }
__device__ __forceinline__ float wave_sum(float v) {
    v += sx<1>(v); v += sx<2>(v); v += sx<4>(v); v += sx<8>(v); v += sx<16>(v);
    auto rr = __builtin_amdgcn_permlane32_swap(__float_as_uint(v), __float_as_uint(v), false, false);
    return __uint_as_float(rr[0]) + __uint_as_float(rr[1]);
}
__device__ __forceinline__ float dpp_f(float v, const int ctrl_sel) {
    const int x = __float_as_int(v); int r;
    if (ctrl_sel == 0) r = __builtin_amdgcn_update_dpp(x, x, 0xB1, 0xf, 0xf, false);
    else if (ctrl_sel == 1) r = __builtin_amdgcn_update_dpp(x, x, 0x4E, 0xf, 0xf, false);
    else if (ctrl_sel == 2) r = __builtin_amdgcn_update_dpp(x, x, 0x141, 0xf, 0xf, false);
    else r = __builtin_amdgcn_update_dpp(x, x, 0x140, 0xf, 0xf, false);
    return __int_as_float(r);
}
__device__ __forceinline__ float wave_max(float v) {
    v = fmaxf(v, dpp_f(v, 0)); v = fmaxf(v, dpp_f(v, 1)); v = fmaxf(v, dpp_f(v, 2)); v = fmaxf(v, dpp_f(v, 3));
    const float a = __uint_as_float(__builtin_amdgcn_readlane(__float_as_uint(v), 0)), b = __uint_as_float(__builtin_amdgcn_readlane(__float_as_uint(v), 16));
    const float c = __uint_as_float(__builtin_amdgcn_readlane(__float_as_uint(v), 32)), d = __uint_as_float(__builtin_amdgcn_readlane(__float_as_uint(v), 48));
    return fmaxf(fmaxf(a, b), fmaxf(c, d));
}
__device__ __forceinline__ int lane_id() { int l; asm volatile("v_mbcnt_lo_u32_b32 %0, -1, 0\n\tv_mbcnt_hi_u32_b32 %0, -1, %0" : "=v"(l)); return l; }
__device__ __forceinline__ int otid_w(int wv) { return wv * 64 + lane_id(); }
#define otid() otid_w(p.chunk)
__device__ __forceinline__ float silu_f(float x) { return x / (1.f + expf(-x)); }

__device__ __forceinline__ void ph_prep(const Params& p, float* lds) {
    const int tid = otid(), bid = blockIdx.x, nblk = gridDim.x;
    const int gt = bid * NT + tid, GT = nblk * NT;
    unsigned char* ws = p.ws;
    float2* tabw = (float2*)(ws + WS_TABW);
    for (int i = gt; i < 8192; i += GT) { float s, c; sincospif((float)i * (1.0f / 4096.0f), &s, &c); tabw[i] = make_float2(c, s); }
    float* rope = (float*)(ws + WS_ROPE);
    for (int i = gt; i < 192 * 16; i += GT) {
        const int pos = (i < 2048) ? (i >> 4) : ((i - 2048) >> 4); const int f = i & 15;
        const float inv = powf(10000.0f, -(float)(2 * f) / 32.0f); const float ang = (float)pos * inv;
        const float c = cosf(ang), s = sinf(ang);
        if (i < 2048) { rope[i] = c; rope[2048 + i] = s; } else { rope[4096 + (i - 2048)] = c; rope[4096 + 1024 + (i - 2048)] = s; }
    }
    { bf16_t* gt = (bf16_t*)(ws + WS_GT); const float* wf = p.in[I_WF];
      for (int i = bid * NT + tid; i < 4 * 64 * 128; i += GT) {
        const int g = i >> 13, d = (i >> 7) & 63, part = (i >> 6) & 1, c = i & 63;
        float a = 0.f;
        for (int j = 0; j < 64; ++j) { float s, co; sincospif((float)((c * j) & 63) * (1.0f / 32.0f), &s, &co); a += (part ? s : co) * wf[(g * 64 + j) * 64 + d]; }
        gt[i] = f2bf(a * 0.0013810679320049757f);
      }
      bf16_t* w128 = (bf16_t*)(ws + WS_W128E);
      for (int i = bid * NT + tid; i < 256 * 128; i += GT) { const int kk = i >> 7, n1 = i & 127; float s, co; sincospif((float)(((kk & 127) * n1) & 127) * (1.0f / 64.0f), &s, &co); w128[i] = f2bf(kk < 128 ? co : -s); }
      bf16_t* m64 = (bf16_t*)(ws + WS_M64E);
      for (int i = bid * NT + tid; i < 128 * 128; i += GT) { const int ro = i >> 7, ci = i & 127, po = ro >> 6, k2 = ro & 63, pi = ci >> 6, n2 = ci & 63;
        float s, co; sincospif((float)((k2 * n2) & 63) * (1.0f / 32.0f), &s, &co); m64[i] = f2bf(po == pi ? co : (po == 0 ? s : -s)); }
    }
    {
      bf16_t* wrt = (bf16_t*)(ws + WS_WRT); const float* wr = p.in[I_WR];
      for (int i = gt; i < 64 * 1024; i += GT) {
        const int j = i & 7, ln = (i >> 3) & 63, nb = (i >> 9) & 3, ks = (i >> 11) & 3, wv_ = i >> 13;
        const int e = 16 * nb + (ln & 15), k = wv_ * 128 + ks * 32 + 8 * (ln >> 4) + j;
        const float w = wr[k * 64 + e]; const bf16_t h = f2bf(w);
        const int o = ((((wv_ * 4 + ks) * 4 + nb) * 2) * 64 + ln) * 8 + j;
        wrt[o] = h; wrt[o + 512] = f2bf(w - bf2f(h)); } }
    if (gt == 0) {
        float s1 = 0.f, s2 = 0.f;
        for (int i = 0; i < 64; ++i) { s1 += p.in[I_LQ1][i] * p.in[I_LK1][i]; s2 += p.in[I_LQ2][i] * p.in[I_LK2][i]; }
        ((float*)(ws + WS_CTL))[1024] = expf(s1) - expf(s2) + LAM_INIT;
    }
    float* sc = lds;
    float* red = lds + 5 * 1024;
    for (int i = tid; i < 5 * 1024; i += NT) { const int r = i >> 10, k = i & 1023; const float v = (r < 4) ? p.in[I_C][r * 1024 + k] : p.in[I_CCTX][k]; sc[i] = silu_f(v); }
    __syncthreads();
    const int wave = tid >> 6, lane = tid & 63;
    float* mod = (float*)(ws + WS_MOD);
    for (int task = bid; task < 96; task += nblk) {
        const int col = task * 64 + lane;
        float a0 = 0, a1 = 0, a2 = 0, a3 = 0, a4 = 0;
        const float* wm = p.in[I_WMOD];
#pragma unroll 32
        for (int k = wave * 128; k < wave * 128 + 128; ++k) { const float w = wm[(size_t)k * 6144 + col]; a0 += sc[k] * w; a1 += sc[1024 + k] * w; a2 += sc[2048 + k] * w; a3 += sc[3072 + k] * w; a4 += sc[4096 + k] * w; }
        red[(wave * 5 + 0) * 64 + lane] = a0; red[(wave * 5 + 1) * 64 + lane] = a1; red[(wave * 5 + 2) * 64 + lane] = a2; red[(wave * 5 + 3) * 64 + lane] = a3; red[(wave * 5 + 4) * 64 + lane] = a4;
        __syncthreads();
        if (tid < 320) { const int r = tid >> 6, l = tid & 63; float s = 0.f; for (int w = 0; w < 8; ++w) s += red[(w * 5 + r) * 64 + l]; mod[r * 6144 + task * 64 + l] = s + p.in[I_BMOD][task * 64 + l]; }
        __syncthreads();
    }
}

__device__ __forceinline__ void ph_norm1(const Params& p) {
    const int tid = otid(), wave = tid >> 6, lane = tid & 63;
    const int gw = blockIdx.x * NWV + wave, GW = gridDim.x * NWV;
    const float* mod = (const float*)(p.ws + WS_MOD);
    bf16_t* hx = (bf16_t*)(p.ws + WS_HX);
    const float* g = p.in[I_GAPRE];
    for (int m = gw; m < MTOT; m += GW) {
        const float* src = (m < T) ? p.in[I_X] + (size_t)m * D : p.in[I_CTX] + (size_t)(m - T) * D;
        const int r = (m < T) ? (m >> 13) : 4;
        const float* shift = mod + r * 6144; const float* scale = shift + 1024;
        f32x4 v[4]; float ss = 0.f;
#pragma unroll
        for (int j = 0; j < 4; ++j) { v[j] = ((const f32x4*)src)[lane + 64 * j]; ss += v[j][0] * v[j][0] + v[j][1] * v[j][1] + v[j][2] * v[j][2] + v[j][3] * v[j][3]; }
        ss = wave_sum(ss);
        const float rs = 1.0f / sqrtf(ss * (1.0f / D) + EPS);
#pragma unroll
        for (int j = 0; j < 4; ++j) {
            const int col = 4 * (lane + 64 * j);
            const f32x4 g4 = *(const f32x4*)(g + col), sc4 = *(const f32x4*)(scale + col), sh4 = *(const f32x4*)(shift + col);
            float h[4];
#pragma unroll
            for (int i = 0; i < 4; ++i) h[i] = v[j][i] * rs * g4[i] * (1.f + sc4[i]) + sh4[i];
            uint2 o; o.x = pk2(h[0], h[1]); o.y = pk2(h[2], h[3]);
            *(uint2*)(hx + (size_t)m * D + col) = o;
        }
    }
}

namespace gp {
#define GP_LAS __attribute__((address_space(3)))
typedef short bf16x8 __attribute__((ext_vector_type(8)));
typedef unsigned u32x4 __attribute__((ext_vector_type(4)));
typedef int i32x4 __attribute__((ext_vector_type(4)));
constexpr int BM = 256, BK = 64, HALF = 128, HTB = HALF * BK * 2, STAGE_BYTES = 8 * HTB;
__device__ __forceinline__ int lds_byte(int r, int c) { const int st = (r >> 4) * 2 + (c >> 5), rr = r & 15, cc = c & 31, ob = rr * 64 + cc * 2; return st * 1024 + (ob ^ (((ob >> 9) & 1) << 5)); }
__device__ __forceinline__ void stage_rc(int b, int& R, int& C) { const int st = b / 1024, sb = b % 1024, swz = sb ^ (((sb >> 9) & 1) << 5); R = (st >> 1) * 16 + swz / 64; C = (st & 1) * 32 + (swz % 64) / 2; }
__device__ __forceinline__ int perm32(int rho) { const int n = rho >> 4, i = rho & 15; return 8 * (i >> 2) + 4 * n + (i & 3); }
struct Unit { int pm, pn, e, b, cnt, base; };
__device__ __forceinline__ unsigned cvt_pk_bf16(float lo, float hi) { unsigned r; asm volatile("v_cvt_pk_bf16_f32 %0, %1, %2" : "=v"(r) : "v"(lo), "v"(hi)); return r; }

template <class Epi, class Sched, bool ALIGN_EPI, bool F8 = false>
__device__ __forceinline__ void gemm_phase(const int wv, GP_LAS unsigned char* lds, const char* Abase, const int K, const Sched& S, const Epi& E) {
    const int wid = wv, wr = wid >> 2, wc = wid & 3;
    const int nt = K / BK;
    unsigned voffB[2];
#pragma unroll
    for (int i = 0; i < 2; ++i) { int R, C; stage_rc(otid_w(wv) * 16 + i * 8192, R, C); const int Rb = (R & ~31) + perm32(R & 31); voffB[i] = (unsigned)(Rb * K + C) * 2u; }
#define GP_AOFFS(u, o00, o01, o10, o11) do { int R0, C0, R1, C1; const int t_ = otid_w(wv); stage_rc(t_ * 16, R0, C0); stage_rc(t_ * 16 + 8192, R1, C1); \
        o00 = S.arow(u, R0) + (unsigned)C0 * 2u; o01 = S.arow(u, R1) + (unsigned)C1 * 2u; o10 = S.arow(u, HALF + R0) + (unsigned)C0 * 2u; o11 = S.arow(u, HALF + R1) + (unsigned)C1 * 2u; } while (0)
    const size_t kstep = (size_t)(BK * 2);
    const size_t hstep = (size_t)HALF * K * 2;
    const unsigned ldsw = (unsigned)wid * 1024u;
    int aoff, boff; { const int l_ = lane_id(), fr = l_ & 15, fq = l_ >> 4; aoff = lds_byte(wr * 64 + fr, fq * 8); boff = lds_byte(wc * 32 + fr, fq * 8); }
#define GP_SA(b, h) (((b) * 2 + (h)) * HTB)
#define GP_SB(b, h) ((4 + (b) * 2 + (h)) * HTB)
#define GP_STAGE_B(bufoff, gbase) do { _Pragma("unroll") for (int _i = 0; _i < 2; ++_i) \
        __builtin_amdgcn_global_load_lds((const unsigned*)((const char*)(gbase) + voffB[_i]), (GP_LAS unsigned*)(lds + (bufoff) + ldsw + _i * 8192), 16, 0, 0); } while (0)
#define GP_STAGE_A(bufoff, gbase, o0, o1) do { \
        __builtin_amdgcn_global_load_lds((const unsigned*)((const char*)(gbase) + (o0)), (GP_LAS unsigned*)(lds + (bufoff) + ldsw), 16, 0, 0); \
        __builtin_amdgcn_global_load_lds((const unsigned*)((const char*)(gbase) + (o1)), (GP_LAS unsigned*)(lds + (bufoff) + ldsw + 8192), 16, 0, 0); } while (0)
#define GP_LDA(dst, b, h) do { _Pragma("unroll") for (int m = 0; m < 4; ++m) _Pragma("unroll") for (int k = 0; k < 2; ++k) dst[m][k] = *(const GP_LAS bf16x8*)(lds + GP_SA(b, h) + aoff + m * 2048 + k * 1024); } while (0)
#define GP_LDB(dst, b, h) do { _Pragma("unroll") for (int n = 0; n < 2; ++n) _Pragma("unroll") for (int k = 0; k < 2; ++k) dst[n][k] = *(const GP_LAS bf16x8*)(lds + GP_SB(b, h) + boff + n * 2048 + k * 1024); } while (0)
#define GP_CAT8(x) __builtin_shufflevector(__builtin_bit_cast(i32x4, x[0]), __builtin_bit_cast(i32x4, x[1]), 0, 1, 2, 3, 4, 5, 6, 7)
#define GP_MMA(ai, bj, At, Bt) do { __builtin_amdgcn_s_setprio(1); _Pragma("unroll") for (int m = 0; m < 4; ++m) _Pragma("unroll") for (int n = 0; n < 2; ++n) { \
        if constexpr (F8) acc[ai][bj][m][n] = __builtin_amdgcn_mfma_scale_f32_16x16x128_f8f6f4(GP_CAT8(Bt[n]), GP_CAT8(At[m]), acc[ai][bj][m][n], 0, 0, 0, 0, 0, 0); \
        else { _Pragma("unroll") for (int k = 0; k < 2; ++k) acc[ai][bj][m][n] = __builtin_amdgcn_mfma_f32_16x16x32_bf16(Bt[n][k], At[m][k], acc[ai][bj][m][n], 0, 0, 0); } } \
        __builtin_amdgcn_s_setprio(0); } while (0)
#define GP_WAIT_V(n) asm volatile("s_waitcnt vmcnt(" #n ")" ::: "memory")
#define GP_WAIT_L(n) asm volatile("s_waitcnt lgkmcnt(" #n ")" ::: "memory")
#define GP_BAR __builtin_amdgcn_s_barrier()
#define GP_SCHED __builtin_amdgcn_sched_barrier(0)
    Unit cur, nxt; int ui = 0;
    if (!S.next(0, cur)) return;
    f32x4 acc[2][2][4][2];
#pragma unroll
    for (int a = 0; a < 2; ++a)
#pragma unroll
        for (int b = 0; b < 2; ++b)
#pragma unroll
            for (int m = 0; m < 4; ++m)
#pragma unroll
                for (int n = 0; n < 2; ++n) acc[a][b][m][n] = (f32x4){0.f, 0.f, 0.f, 0.f};
    bf16x8 At[4][2], B0[2][2], B1[2][2];
    unsigned ac00, ac01, ac10, ac11, an00, an01, an10, an11;
    GP_AOFFS(cur, ac00, ac01, ac10, ac11);
    const char* cB = S.bptr(cur);
    GP_STAGE_B(GP_SB(0, 0), cB); GP_STAGE_B(GP_SB(0, 1), cB + hstep); GP_STAGE_A(GP_SA(0, 0), Abase, ac00, ac01); GP_STAGE_A(GP_SA(0, 1), Abase, ac10, ac11);
    if (wr == 1) GP_BAR;
    GP_WAIT_V(2); GP_BAR;
    GP_STAGE_B(GP_SB(1, 0), cB + kstep); GP_STAGE_A(GP_SA(1, 0), Abase + kstep, ac00, ac01); GP_STAGE_B(GP_SB(1, 1), cB + hstep + kstep);
    GP_WAIT_V(6); GP_BAR;
    for (;;) {
        const bool has_next = S.next(ui + 1, nxt);
        if (has_next) { GP_AOFFS(nxt, an00, an01, an10, an11); }
        else { an00 = ac00; an01 = ac01; an10 = ac10; an11 = ac11; }
        const char* nB = has_next ? S.bptr(nxt) : cB;
#pragma unroll 1
        for (int t = 0; t < nt; t += 2) {
            const bool last = (t == nt - 2);
            const char* a1 = Abase + (size_t)(t + 1) * kstep;
            const char* a2 = last ? Abase : Abase + (size_t)(t + 2) * kstep; const char* b2 = last ? nB : cB + (size_t)(t + 2) * kstep;
            const char* a3 = a2 + kstep; const char* b3 = b2 + kstep;
            asm volatile("" : "+s"(a1), "+s"(a2), "+s"(b2), "+s"(a3), "+s"(b3));
            GP_LDB(B0, 0, 0); GP_LDB(B1, 0, 1); GP_SCHED; GP_LDA(At, 0, 0); GP_STAGE_A(GP_SA(1, 1), a1, ac10, ac11);
            if (last) { ac00 = an00; ac01 = an01; ac10 = an10; ac11 = an11; }
            GP_WAIT_V(8); GP_WAIT_L(0); GP_BAR; GP_MMA(0, 0, At, B0); GP_MMA(0, 1, At, B1); GP_BAR; GP_SCHED;
            GP_LDA(At, 0, 1); GP_STAGE_B(GP_SB(0, 0), b2); GP_STAGE_B(GP_SB(0, 1), b2 + hstep); GP_STAGE_A(GP_SA(0, 0), a2, ac00, ac01);
            GP_WAIT_V(8); GP_WAIT_L(0); GP_BAR; GP_MMA(1, 0, At, B0); GP_MMA(1, 1, At, B1); GP_BAR; GP_SCHED;
            GP_LDB(B0, 1, 0); GP_LDB(B1, 1, 1); GP_SCHED; GP_LDA(At, 1, 0); GP_STAGE_A(GP_SA(0, 1), a2, ac10, ac11);
            GP_WAIT_V(8); GP_WAIT_L(0); GP_BAR; GP_MMA(0, 0, At, B0); GP_MMA(0, 1, At, B1); GP_BAR; GP_SCHED;
            GP_LDA(At, 1, 1); GP_STAGE_B(GP_SB(1, 0), b3); GP_STAGE_B(GP_SB(1, 1), b3 + hstep); GP_STAGE_A(GP_SA(1, 0), a3, ac00, ac01);
            GP_WAIT_V(8); GP_WAIT_L(0); GP_BAR; GP_MMA(1, 0, At, B0); GP_MMA(1, 1, At, B1); GP_BAR; GP_SCHED;
        }
        if constexpr (ALIGN_EPI) { if (wr == 0) GP_BAR; }
        { const int l_ = lane_id(); E(acc, cur, wr, wc, l_ & 15, l_ >> 4); }
        if (!has_next) break;
#pragma unroll
        for (int a = 0; a < 2; ++a)
#pragma unroll
            for (int b = 0; b < 2; ++b)
#pragma unroll
                for (int m = 0; m < 4; ++m)
#pragma unroll
                    for (int n = 0; n < 2; ++n) acc[a][b][m][n] = (f32x4){0.f, 0.f, 0.f, 0.f};
        cur = nxt; cB = nB; ++ui;
        if constexpr (ALIGN_EPI) { if (wr == 1) GP_BAR; }
    }
    GP_WAIT_V(0);
    if constexpr (!ALIGN_EPI) { if (wr == 0) GP_BAR; }
    GP_BAR;
#undef GP_AOFFS
#undef GP_SA
#undef GP_SB
#undef GP_STAGE_A
#undef GP_STAGE_B
#undef GP_LDA
#undef GP_LDB
#undef GP_MMA
#undef GP_CAT8
#undef GP_WAIT_V
#undef GP_WAIT_L
#undef GP_BAR
#undef GP_SCHED
}

struct DenseSched {
    int nM, nN, nwg, G, c, K; const char* Bt;
    __device__ __forceinline__ void init(int M, int N, int K_, const void* Bt_, int G_, int c_) { nM = M / BM; nN = N / BM; nwg = nM * nN; G = G_; c = c_; K = K_; Bt = (const char*)Bt_; }
    __device__ __forceinline__ bool next(int i, Unit& u) const {
        const long L = (long)i * G + c; if (L >= nwg) return false;
        int wgid = (int)L; { const int q = nwg / 8, r = nwg % 8, xcd = wgid % 8, off = wgid / 8; wgid = (xcd < r ? xcd * (q + 1) : r * (q + 1) + (xcd - r) * q) + off; }
        const int nig = 8 * nN, gid = wgid / nig, fm = gid * 8, gsz = (nM - fm) < 8 ? (nM - fm) : 8;
        u.pm = fm + ((wgid % nig) % gsz); u.pn = (wgid % nig) / gsz; u.e = 0; u.b = 0; u.cnt = 0; u.base = 0; return true;
    }
    __device__ __forceinline__ unsigned arow(const Unit& u, int r) const { return (unsigned)(u.pm * BM + r) * (unsigned)(K * 2); }
    __device__ __forceinline__ const char* bptr(const Unit& u) const { return Bt + (size_t)u.pn * BM * K * 2; }
};
}

struct EpiInProj {
    bf16_t* F; bf16_t* Q; bf16_t* Kb; bf16_t* Vb; const float* rope;
    __device__ __forceinline__ void operator()(const f32x4 (&acc)[2][2][4][2], const gp::Unit& u, int wr, int wc, int fr, int fq) const {
        const int pn = u.pn, pm = u.pm; const bool isctx = pm >= T / 256;
        if (isctx && pn < 4) return;
        if (pn >= 7) {
            unsigned char* V8 = (unsigned char*)Vb;
#pragma unroll
            for (int ai = 0; ai < 2; ++ai) {
                const int row0 = pm * 256 + ai * 128 + wr * 64;
                int b, tile;
                if (!isctx) { b = row0 >> 13; tile = (CTX >> 6) + ((row0 & 8191) >> 6); } else { const int j = row0 - T; b = j >> 8; tile = (j & 255) >> 6; }
#pragma unroll
                for (int bj = 0; bj < 2; ++bj) {
                    const int head = (pn - 7) * 2 + bj;
                    unsigned char* dst = V8 + ((size_t)(b * NH + head) * (KVLEN / 64) + tile) * 8192 + wc * 2048 + fq * 64 + (fr >> 3) * 32 + (fr & 1) * 16 + ((fr >> 1) & 3) * 4;
#pragma unroll
                    for (int e = 0; e < 8; ++e) {
                        int w = __builtin_amdgcn_cvt_pk_fp8_f32(acc[ai][bj][0][e >> 2][e & 3], acc[ai][bj][1][e >> 2][e & 3], 0, false);
                        w = __builtin_amdgcn_cvt_pk_fp8_f32(acc[ai][bj][2][e >> 2][e & 3], acc[ai][bj][3][e >> 2][e & 3], w, true);
                        *(int*)(dst + e * 256) = w;
                    }
                }
            }
            return;
        }
        const int axis = wc & 1; const float* ct = rope + (axis ? 4096 : 0); const float* st = rope + (axis ? 4096 + 1024 : 2048);
#pragma unroll
        for (int ai = 0; ai < 2; ++ai)
#pragma unroll
            for (int m = 0; m < 4; ++m) {
                const int row = pm * 256 + ai * 128 + wr * 64 + m * 16 + fr;
                int t, kb, tile;
                if (!isctx) { kb = row >> 13; t = row & 8191; tile = (CTX >> 6) + (t >> 6); } else { const int j = row - T; t = 0; kb = j >> 8; tile = (j & 255) >> 6; }
                const int pos = axis ? (t & 63) : (t >> 6);
#pragma unroll
                for (int bj = 0; bj < 2; ++bj) {
                    const int col0 = pn * 256 + bj * 128 + wc * 32 + fq * 8;
                    f32x4 v0 = acc[ai][bj][m][0], v1 = acc[ai][bj][m][1];
                    if (pn == 0) { gp::u32x4 w; w.x = gp::cvt_pk_bf16(v0[0], v0[1]); w.y = gp::cvt_pk_bf16(v0[2], v0[3]); w.z = gp::cvt_pk_bf16(v1[0], v1[1]); w.w = gp::cvt_pk_bf16(v1[2], v1[3]);
                        *(gp::u32x4*)(F + (size_t)row * 256 + col0) = w; continue; }
                    if (pn < 7 && !isctx) {
                        const f32x4 c0 = *(const f32x4*)(ct + pos * 16 + 8 * (fq & 1)), c1 = *(const f32x4*)(ct + pos * 16 + 8 * (fq & 1) + 4);
                        const f32x4 s0 = *(const f32x4*)(st + pos * 16 + 8 * (fq & 1)), s1 = *(const f32x4*)(st + pos * 16 + 8 * (fq & 1) + 4);
                        const float sg = (fq < 2) ? -1.f : 1.f;
#pragma unroll
                        for (int i = 0; i < 4; ++i) {
                            const auto r0 = __builtin_amdgcn_permlane32_swap(__float_as_uint(v0[i]), __float_as_uint(v0[i]), false, false);
                            const auto r1 = __builtin_amdgcn_permlane32_swap(__float_as_uint(v1[i]), __float_as_uint(v1[i]), false, false);
                            const float p0 = __uint_as_float(fq < 2 ? r0[1] : r0[0]), p1 = __uint_as_float(fq < 2 ? r1[1] : r1[0]);
                            v0[i] = v0[i] * c0[i] + sg * p0 * s0[i]; v1[i] = v1[i] * c1[i] + sg * p1 * s1[i]; }
                    }
                    v0 = v0 * SQS; v1 = v1 * SQS;
                    int w0 = __builtin_amdgcn_cvt_pk_fp8_f32(v0[0], v0[1], 0, false); w0 = __builtin_amdgcn_cvt_pk_fp8_f32(v0[2], v0[3], w0, true);
                    int w1 = __builtin_amdgcn_cvt_pk_fp8_f32(v1[0], v1[1], 0, false); w1 = __builtin_amdgcn_cvt_pk_fp8_f32(v1[2], v1[3], w1, true);
                    unsigned char* d;
                    if (pn < 4) d = (unsigned char*)Q + (size_t)row * QKW + (col0 - 256);
                    else d = (unsigned char*)Kb + ((size_t)(kb * NH + (pn - 4) * 2 + bj) * (KVLEN / 64) + tile) * 8192 + wc * 2048 + m * 512 + fr * 32 + fq * 8;
                    typedef int i32x2_t __attribute__((ext_vector_type(2)));
                    *(i32x2_t*)d = (i32x2_t){w0, w1};
                }
            }
    }
};
struct EpiStoreBf16 {
    bf16_t* O; int ldc;
    __device__ __forceinline__ void operator()(const f32x4 (&acc)[2][2][4][2], const gp::Unit& u, int wr, int wc, int fr, int fq) const {
#pragma unroll
        for (int ai = 0; ai < 2; ++ai)
#pragma unroll
            for (int m = 0; m < 4; ++m) {
                bf16_t* rowp = O + (size_t)(u.pm * 256 + ai * 128 + wr * 64 + m * 16 + fr) * ldc + u.pn * 256 + wc * 32 + fq * 8;
#pragma unroll
                for (int bj = 0; bj < 2; ++bj) { const f32x4 v0 = acc[ai][bj][m][0], v1 = acc[ai][bj][m][1];
                    gp::u32x4 w; w.x = gp::cvt_pk_bf16(v0[0], v0[1]); w.y = gp::cvt_pk_bf16(v0[2], v0[3]); w.z = gp::cvt_pk_bf16(v1[0], v1[1]); w.w = gp::cvt_pk_bf16(v1[2], v1[3]);
                    *(gp::u32x4*)(rowp + bj * 128) = w; }
            }
    }
};

__device__ __forceinline__ void ph_inproj(const Params& p, unsigned char* smem) {
    unsigned char* ws = p.ws;
    gp::DenseSched S; S.init(MTOT, INW, D, ws + WS_WINT, gridDim.x, blockIdx.x);
    EpiInProj E{(bf16_t*)(ws + WS_F), (bf16_t*)(ws + WS_Q), (bf16_t*)(ws + WS_K), (bf16_t*)(ws + WS_V), (const float*)(ws + WS_ROPE)};
    gp::gemm_phase<EpiInProj, gp::DenseSched, true>(p.chunk, (GP_LAS unsigned char*)smem, (const char*)(ws + WS_HX), D, S, E);
}
__device__ __forceinline__ void ph_outproj(const Params& p, unsigned char* smem) {
    unsigned char* ws = p.ws;
    gp::DenseSched S; S.init(T, D, D, ws + WS_WOUTT, gridDim.x, blockIdx.x);
    EpiStoreBf16 E{(bf16_t*)(ws + WS_YX), D};
    gp::gemm_phase<EpiStoreBf16, gp::DenseSched, true>(p.chunk, (GP_LAS unsigned char*)smem, (const char*)(ws + WS_AO), D, S, E);
}

constexpr float GUSCALE = 64.f;
constexpr float WDSCALE = 16.f, ASCALE = 4.f;
__device__ __forceinline__ void transpose_item8(const float* W, int K, int N, unsigned char* WT, int row_base, int kb, int nb, float* scr, int lane, const float wscale) {
    const int k0 = 64 * kb, n0 = 32 * nb;
    float tv[32];
#pragma unroll
    for (int i = 0; i < 32; ++i) tv[i] = W[(size_t)(k0 + 2 * i + (lane >> 5)) * N + n0 + (lane & 31)];
#pragma unroll
    for (int i = 0; i < 32; ++i) scr[(2 * i + (lane >> 5)) * 33 + (lane & 31)] = tv[i] * wscale;
    asm volatile("s_waitcnt lgkmcnt(0)" ::: "memory");
    const int c = lane & 7;
#pragma unroll
    for (int j = 0; j < 4; ++j) { const int n = (lane >> 3) + 8 * j; const float* s = scr + (8 * c) * 33 + n;
        int w0 = __builtin_amdgcn_cvt_pk_fp8_f32(s[0 * 33], s[1 * 33], 0, false); w0 = __builtin_amdgcn_cvt_pk_fp8_f32(s[2 * 33], s[3 * 33], w0, true);
        int w1 = __builtin_amdgcn_cvt_pk_fp8_f32(s[4 * 33], s[5 * 33], 0, false); w1 = __builtin_amdgcn_cvt_pk_fp8_f32(s[6 * 33], s[7 * 33], w1, true);
        uint2 o; o.x = (unsigned)w0; o.y = (unsigned)w1;
        *(uint2*)(WT + (size_t)(row_base + n0 + n) * K + k0 + 8 * c) = o; }
    asm volatile("s_waitcnt lgkmcnt(0)" ::: "memory");
}
__device__ __forceinline__ void transpose_item(const float* W, int K, int N, bf16_t* WT, int row_base, int kb, int nb, float* scr, int lane) {
    const int k0 = 64 * kb, n0 = 32 * nb;
    float tv[32];
#pragma unroll
    for (int i = 0; i < 32; ++i) tv[i] = W[(size_t)(k0 + 2 * i + (lane >> 5)) * N + n0 + (lane & 31)];
#pragma unroll
    for (int i = 0; i < 32; ++i) scr[(2 * i + (lane >> 5)) * 33 + (lane & 31)] = tv[i];
    asm volatile("s_waitcnt lgkmcnt(0)" ::: "memory");
    const int c = lane & 7;
#pragma unroll
    for (int j = 0; j < 4; ++j) { const int n = (lane >> 3) + 8 * j; const float* s = scr + (8 * c) * 33 + n;
        uint4 o; o.x = pk2(s[0 * 33], s[1 * 33]); o.y = pk2(s[2 * 33], s[3 * 33]); o.z = pk2(s[4 * 33], s[5 * 33]); o.w = pk2(s[6 * 33], s[7 * 33]);
        *(uint4*)(WT + (size_t)(row_base + n0 + n) * K + k0 + 8 * c) = o; }
    asm volatile("s_waitcnt lgkmcnt(0)" ::: "memory");
}
__device__ __forceinline__ void ph_prep_weights(const Params& p, float* lds, const int part, const int first) {
    const int tid = otid(), wave = tid >> 6, lane = tid & 63;
    float* scr = lds + 8192 + wave * (64 * 33);
    if ((int)blockIdx.x < first) return;
    const int gw = ((int)blockIdx.x - first) * NWV + wave, GW = ((int)gridDim.x - first) * NWV;
    unsigned char* ws = p.ws;
    constexpr int I_IN = 16 * 80, I_OUT = 16 * 32, I_GU = 16 * 8, I_D = 4 * 32;
    constexpr int NITEMS = I_IN + I_OUT + 65 * (2 * I_GU + I_D);
    const int it_lo = part ? I_IN + I_OUT : 0, it_hi = part ? NITEMS : I_IN + I_OUT;
    for (int it = it_lo + gw; it < it_hi; it += GW) {
        int r = it;
        if (r < I_IN) { transpose_item(p.in[I_WIN], D, INW, (bf16_t*)(ws + WS_WINT), 0, r / 80, r % 80, scr, lane); continue; } r -= I_IN;
        if (r < I_OUT) { transpose_item(p.in[I_WOUT], D, D, (bf16_t*)(ws + WS_WOUTT), 0, r / 32, r % 32, scr, lane); continue; } r -= I_OUT;
        const int e = r / (2 * I_GU + I_D); r -= e * (2 * I_GU + I_D);
        if (r < 2 * I_GU) {
            const int half = r / I_GU, q = r % I_GU, kb = q / 8, nb = q % 8;
            const float* W = (e < 64) ? p.in[half ? I_WU : I_WG] + (size_t)e * D * DE : p.in[half ? I_WSU : I_WSG];
            const int n0 = 32 * nb, drow = e * 512 + (n0 >> 7) * 256 + half * 128 + (n0 & 127);
            transpose_item8(W, D, DE, ws + WS_WGUT, drow - n0, kb, nb, scr, lane, GUSCALE);
        } else {
            r -= 2 * I_GU;
            const float* W = (e < 64) ? p.in[I_WD] + (size_t)e * DE * D : p.in[I_WSD];
            transpose_item8(W, DE, D, ws + WS_WDT, e * 1024, r / 32, r % 32, scr, lane, WDSCALE);
        }
    }
}

namespace fa {
typedef short bf16x8 __attribute__((ext_vector_type(8)));
typedef short s16x4 __attribute__((ext_vector_type(4)));
typedef float f32x16 __attribute__((ext_vector_type(16)));
typedef unsigned u32x4 __attribute__((ext_vector_type(4)));
constexpr int KVBLK = 64, LDK = QKW;
constexpr float SCALE = 0.125f, THR = 8.f;
constexpr size_t SHM_V = KVBLK * 128 * 2, SHM_K = KVBLK * 128 * 2;
#define KSWZ(row, colB) ((row) * 256 + ((colB) ^ (((row) & 15) << 4)))
#define SBAR() __builtin_amdgcn_sched_barrier(0)
__device__ __forceinline__ int crow(int r, int hi) { return (r & 3) + 8 * (r >> 2) + 4 * hi; }
__device__ __forceinline__ unsigned cvtpk(float lo, float hi) { unsigned r; asm volatile("v_cvt_pk_bf16_f32 %0, %1, %2" : "=v"(r) : "v"(lo), "v"(hi)); return r; }
constexpr float PBIAS = 5.f, THR2 = PBIAS + 3.5f;
template <bool FIRST>
__device__ __forceinline__ void partialSM(f32x16& p0, f32x16& p1, float& m_reg, f32x16& negm, float& alpha) {
  float pmax = p0[0];
#pragma unroll
  for (int r = 1; r < 16; ++r) pmax = fmaxf(pmax, p0[r]);
#pragma unroll
  for (int r = 0; r < 16; ++r) pmax = fmaxf(pmax, p1[r]);
  { auto rr = __builtin_amdgcn_permlane32_swap(__float_as_uint(pmax), __float_as_uint(pmax), false, false);
    pmax = fmaxf(__uint_as_float(rr[0]), __uint_as_float(rr[1])); }
  if (!FIRST && __builtin_expect(__all(pmax <= THR2), 1)) { alpha = 1.f; }
  else { const float dl = FIRST ? pmax - PBIAS : fmaxf(pmax - PBIAS, 0.f); alpha = FIRST ? 0.f : __builtin_amdgcn_exp2f(-dl); m_reg += dl;
#pragma unroll
    for (int r = 0; r < 16; ++r) { p0[r] -= dl; p1[r] -= dl; }
#pragma unroll
    for (int r = 0; r < 16; ++r) negm[r] = -m_reg;
    asm volatile("" : "+v"(negm)); }
#pragma unroll
  for (int r = 0; r < 16; ++r) p0[r] = __builtin_amdgcn_exp2f(p0[r]);
}
typedef int i32x8 __attribute__((ext_vector_type(8)));
__device__ __forceinline__ int pk4_fp8(float a, float b, float c, float d) { int w; asm("v_cvt_pk_fp8_f32 %0, %1, %2" : "=v"(w) : "v"(a), "v"(b)); asm("v_cvt_pk_fp8_f32 %0, %1, %2 op_sel:[0,0,1]" : "+v"(w) : "v"(c), "v"(d)); return w; }
__device__ __forceinline__ void finishSM_T(f32x16& p0, f32x16& p1, i32x8& pb) {
#pragma unroll
  for (int r = 0; r < 16; ++r) p1[r] = __builtin_amdgcn_exp2f(p1[r]);
#pragma unroll
  for (int g = 0; g < 4; ++g) {
    pb[g] = pk4_fp8(p0[4 * g], p0[4 * g + 1], p0[4 * g + 2], p0[4 * g + 3]); pb[4 + g] = pk4_fp8(p1[4 * g], p1[4 * g + 1], p1[4 * g + 2], p1[4 * g + 3]); }
}
__device__ __forceinline__ void qkt(f32x16& p0, f32x16& p1, const char* Ks, const i32x8 qf, int lane, int mm, const f32x16& negm) {
  const char* kp = Ks + mm * 4096 + lane * 16;
  const u32x4 a0 = *reinterpret_cast<const u32x4*>(kp), a1 = *reinterpret_cast<const u32x4*>(kp + 1024), b0 = *reinterpret_cast<const u32x4*>(kp + 2048), b1 = *reinterpret_cast<const u32x4*>(kp + 3072);
  p0 = __builtin_amdgcn_mfma_scale_f32_32x32x64_f8f6f4((i32x8){(int)a0.x, (int)a0.y, (int)a0.z, (int)a0.w, (int)a1.x, (int)a1.y, (int)a1.z, (int)a1.w}, qf, negm, 0, 0, 0, 0, 0, 0);
  p1 = __builtin_amdgcn_mfma_scale_f32_32x32x64_f8f6f4((i32x8){(int)b0.x, (int)b0.y, (int)b0.z, (int)b0.w, (int)b1.x, (int)b1.y, (int)b1.z, (int)b1.w}, qf, negm, 0, 0, 0, 0, 0, 0);
}
__device__ __forceinline__ int v_st(int k, int c) { const int kk = (k & ~0xC) | ((k & 4) << 1) | ((k & 8) >> 1); return ((kk >> 3) * 4 + (c >> 5)) * 512 + ((kk & 7) * 32 + (c & 31)) * 2; }
__device__ __forceinline__ int v_rd_base(int lane) { return ((lane & 3) << 3) | (((lane >> 2) & 3) << 6) | (((lane >> 4) & 1) << 5) | (((lane >> 5) & 1) << 8); }
constexpr int v_rd_off(int d0, int ks, int half) { return d0 * 512 + ks * 4096 + half * 2048; }
template <int OFF> __device__ __forceinline__ s16x4 tr_read(int vb) {
  s16x4 r; asm volatile("ds_read_b64_tr_b16 %0, %1 offset:%2" : "=&v"(r) : "v"(vb), "i"(OFF) : "memory"); return r;
}
template <int D0> __device__ __forceinline__ void pv_one(f32x16& od, int vb, bf16x8 pa0, bf16x8 pa1, bf16x8 pa2, bf16x8 pa3) {
  const s16x4 l0 = tr_read<v_rd_off(D0, 0, 0)>(vb), h0 = tr_read<v_rd_off(D0, 0, 1)>(vb), l1 = tr_read<v_rd_off(D0, 1, 0)>(vb), h1 = tr_read<v_rd_off(D0, 1, 1)>(vb);
  const s16x4 l2 = tr_read<v_rd_off(D0, 2, 0)>(vb), h2 = tr_read<v_rd_off(D0, 2, 1)>(vb), l3 = tr_read<v_rd_off(D0, 3, 0)>(vb), h3 = tr_read<v_rd_off(D0, 3, 1)>(vb);
  asm volatile("s_waitcnt lgkmcnt(0)" ::: "memory"); SBAR();
#define PK(L, H) (bf16x8){L[0], L[1], L[2], L[3], H[0], H[1], H[2], H[3]}
  od = __builtin_amdgcn_mfma_f32_32x32x16_bf16(pa0, PK(l0, h0), od, 0, 0, 0);
  od = __builtin_amdgcn_mfma_f32_32x32x16_bf16(pa1, PK(l1, h1), od, 0, 0, 0);
  od = __builtin_amdgcn_mfma_f32_32x32x16_bf16(pa2, PK(l2, h2), od, 0, 0, 0);
  od = __builtin_amdgcn_mfma_f32_32x32x16_bf16(pa3, PK(l3, h3), od, 0, 0, 0);
#undef PK
}
__device__ __forceinline__ void pv_d0(f32x16* o, int vb, bf16x8 pa0, bf16x8 pa1, bf16x8 pa2, bf16x8 pa3) {
  pv_one<0>(o[0], vb, pa0, pa1, pa2, pa3); pv_one<1>(o[1], vb, pa0, pa1, pa2, pa3); pv_one<2>(o[2], vb, pa0, pa1, pa2, pa3); pv_one<3>(o[3], vb, pa0, pa1, pa2, pa3);
}

template <int OFF> __device__ __forceinline__ u32x4 rd128(int vb) { u32x4 r; asm volatile("ds_read_b128 %0, %1 offset:%2" : "=&v"(r) : "v"(vb), "i"(OFF) : "memory"); return r; }
#define PV_RD(D0) const u32x4 va##D0 = rd128<D0 * 2048>(vb), vc##D0 = rd128<D0 * 2048 + 1024>(vb); SBAR()
#define PV_MM(D0) do { asm volatile("s_waitcnt lgkmcnt(0)" ::: "memory"); SBAR(); \
    o[D0] = __builtin_amdgcn_mfma_scale_f32_32x32x64_f8f6f4((i32x8){(int)va##D0.x, (int)va##D0.y, (int)va##D0.z, (int)va##D0.w, (int)vc##D0.x, (int)vc##D0.y, (int)vc##D0.z, (int)vc##D0.w}, pb, o[D0], 0, 0, 0, 0, 0, 0); } while (0)
__device__ __forceinline__ float max3f(float a, float b, float c) { float r; asm("v_max3_f32 %0, %1, %2, %3" : "=v"(r) : "v"(a), "v"(b), "v"(c)); return r; }
#define PV_LSUM() lacc = __builtin_amdgcn_mfma_scale_f32_32x32x64_f8f6f4((i32x8){0x38383838, 0x38383838, 0x38383838, 0x38383838, 0x38383838, 0x38383838, 0x38383838, 0x38383838}, pb, lacc, 0, 0, 0, 0, 0, 0)
__device__ __forceinline__ void pv_psm(f32x16* o, f32x16& lacc, int vb, i32x8 pb, f32x16& p0, f32x16& p1, float& m_reg, f32x16& negm, float& alpha) {
  float pmax;
  { PV_RD(0);
    pmax = max3f(p0[0], p0[1], p0[2]);
#pragma unroll
    for (int r = 3; r < 15; r += 2) pmax = max3f(pmax, p0[r], p0[r + 1]);
    pmax = max3f(pmax, p0[15], p1[0]);
    SBAR(); PV_MM(0); }
  { PV_RD(1);
#pragma unroll
    for (int r = 1; r < 15; r += 2) pmax = max3f(pmax, p1[r], p1[r + 1]);
    pmax = max3f(pmax, p1[15], p1[15]);
    { auto rr = __builtin_amdgcn_permlane32_swap(__float_as_uint(pmax), __float_as_uint(pmax), false, false);
      pmax = max3f(__uint_as_float(rr[0]), __uint_as_float(rr[1]), __uint_as_float(rr[1])); }
    if (__builtin_expect(__all(pmax <= THR2), 1)) { alpha = 1.f; }
    else { const float dl = fmaxf(pmax - PBIAS, 0.f); alpha = __builtin_amdgcn_exp2f(-dl); m_reg += dl;
#pragma unroll
      for (int r = 0; r < 16; ++r) { p0[r] -= dl; p1[r] -= dl; }
#pragma unroll
      for (int r = 0; r < 16; ++r) negm[r] = -m_reg;
      asm volatile("" : "+v"(negm)); }
    SBAR(); PV_MM(1); }
  { PV_RD(2);
#pragma unroll
    for (int r = 0; r < 8; ++r) p0[r] = __builtin_amdgcn_exp2f(p0[r]);
    asm volatile("" : "+v"(p0));
    SBAR(); PV_MM(2); }
  { PV_RD(3);
#pragma unroll
    for (int r = 8; r < 16; ++r) p0[r] = __builtin_amdgcn_exp2f(p0[r]);
    asm volatile("" : "+v"(p0));
    SBAR(); PV_MM(3); PV_LSUM(); }
}
__device__ __forceinline__ void pvT_d0(f32x16* o, f32x16& lacc, int vb, i32x8 pb) {
  { PV_RD(0); PV_MM(0); } { PV_RD(1); PV_MM(1); } { PV_RD(2); PV_MM(2); } { PV_RD(3); PV_MM(3); PV_LSUM(); }
}
#undef PV_RD
#undef PV_MM
#undef PV_LSUM

__device__ __forceinline__ void attn_unit(const unsigned char* __restrict__ Qb, const unsigned char* __restrict__ Kh, const unsigned char* __restrict__ Vh, bf16_t* __restrict__ Ob,
                                          const float* __restrict__ gsub, const float lam, char* lds, const int wv) {
  typedef __attribute__((address_space(3))) unsigned* ldsu_t;
  const int tid = otid_w(wv), wid = wv, lane = tid & 63, r32 = lane & 31, hi = lane >> 5, mm = wid >> 2, wq = wid & 3;
  constexpr int NB = 4;
  constexpr int SHM_V8 = KVBLK * 128;
  char* V_lds = lds; char* K_lds = lds + NB * SHM_V8; constexpr int SHM_K8 = KVBLK * 128;
  float m_reg = 0.f; f32x16 o[4] = {}; f32x16 lacc = {}; i32x8 qf; f32x16 negm = {}; asm volatile("" : "+v"(negm));
  const unsigned koff = (unsigned)((2 * (wid >> 2) + (lane >> 5)) * 2048 + (lane & 3) * 512 + (8 * ((wid >> 1) & 1) + 2 * ((lane & 31) >> 3) + ((lane >> 2) & 1)) * 32 + (wid & 1) * 16);
  const unsigned voff = (unsigned)((wid >> 1) * 2048 + (lane & 7) * 256 + ((lane >> 3) & 3) * 64 + (wid & 1) * 32 + (lane >> 5) * 16);
#define DMA(t, buf) do { const char* kb_ = (const char*)(Kh + (size_t)(t) * SHM_K8); const char* vb_ = (const char*)(Vh + (size_t)(t) * SHM_V8); asm volatile("" : "+s"(kb_), "+s"(vb_)); \
    __builtin_amdgcn_global_load_lds((const unsigned*)(kb_ + koff), (ldsu_t)(K_lds + (buf) * SHM_K8 + wid * 1024), 16, 0, 0); \
    __builtin_amdgcn_global_load_lds((const unsigned*)(vb_ + voff), (ldsu_t)(V_lds + (buf) * SHM_V8 + wid * 1024), 16, 0, 0); } while (0)
#define WAIT_BAR(N) asm volatile("s_waitcnt vmcnt(" #N ") lgkmcnt(0)\n\ts_barrier" ::: "memory")
#define RESC(a) do { if (__any((a) < 1.f)) { _Pragma("unroll") for (int d = 0; d < 4; ++d) _Pragma("unroll") for (int r = 0; r < 16; ++r) o[d][r] *= (a); lacc[0] *= (a); } } while (0)
  DMA(0, 0); DMA(1, 1);
  { const unsigned char* Qw = Qb + (long)(wq * 32 + r32) * QKW + mm * 64 + hi * 32;
    const u32x4 q0 = *reinterpret_cast<const u32x4*>(Qw), q1 = *reinterpret_cast<const u32x4*>(Qw + 16);
    qf = (i32x8){(int)q0.x, (int)q0.y, (int)q0.z, (int)q0.w, (int)q1.x, (int)q1.y, (int)q1.z, (int)q1.w}; }
  const int vb0 = (int)(uintptr_t)V_lds + lane * 16;
  f32x16 pA0, pA1, pB0, pB1; float alA, alB; i32x8 pb; constexpr int NTL = KVLEN / KVBLK;
  WAIT_BAR(0);
  DMA(2, 2);
  qkt(pA0, pA1, K_lds, qf, lane, mm, negm); partialSM<true>(pA0, pA1, m_reg, negm, alA);
  WAIT_BAR(2);
  for (int j = 1; j + 1 < NTL; j += 2) {
    DMA(j + 2, (j + 2) & 3);
    SBAR(); qkt(pB0, pB1, K_lds + (j & 3) * SHM_K8, qf, lane, mm, negm);
    finishSM_T(pA0, pA1, pb); SBAR();
    pv_psm(o, lacc, vb0 + ((j - 1) & 3) * SHM_V8, pb, pB0, pB1, m_reg, negm, alB);
    RESC(alB);
    WAIT_BAR(2);
    if (j + 3 < NTL) DMA(j + 3, (j + 3) & 3);
    SBAR(); qkt(pA0, pA1, K_lds + ((j + 1) & 3) * SHM_K8, qf, lane, mm, negm);
    finishSM_T(pB0, pB1, pb); SBAR();
    pv_psm(o, lacc, vb0 + (j & 3) * SHM_V8, pb, pA0, pA1, m_reg, negm, alA);
    RESC(alA);
    if (j + 3 < NTL) WAIT_BAR(2); else WAIT_BAR(0);
  }
  SBAR(); qkt(pB0, pB1, K_lds + ((NTL - 1) & 3) * SHM_K8, qf, lane, mm, negm);
  finishSM_T(pA0, pA1, pb); SBAR();
  pv_psm(o, lacc, vb0 + ((NTL - 2) & 3) * SHM_V8, pb, pB0, pB1, m_reg, negm, alB);
  RESC(alB);
  finishSM_T(pB0, pB1, pb); SBAR();
  pvT_d0(o, lacc, vb0 + ((NTL - 1) & 3) * SHM_V8, pb);
#undef DMA
#undef WAIT_BAR
  const float rl = __builtin_amdgcn_rcpf(lacc[0]) * (mm ? lam : 1.0f);
  __syncthreads();
  constexpr int XS = 132;
  float* X = (float*)lds;
  if (mm == 1) {
#pragma unroll
    for (int r = 0; r < 16; ++r)
#pragma unroll
      for (int d0 = 0; d0 < 4; ++d0) X[(wq * 32 + r32) * XS + d0 * 32 + crow(r, hi)] = o[d0][r] * rl;
  }
  __syncthreads();
  if (mm == 0) {
#pragma unroll
    for (int r = 0; r < 16; ++r)
#pragma unroll
      for (int d0 = 0; d0 < 4; ++d0) { float* xp = X + (wq * 32 + r32) * XS + d0 * 32 + crow(r, hi); *xp = o[d0][r] * rl - *xp; }
  }
  __syncthreads();
  {
    const int row = tid >> 2, seg = tid & 3;
    const float* xr = X + row * XS + seg * 32;
    f32x4 v[8]; float ss = 0.f;
#pragma unroll
    for (int i = 0; i < 8; ++i) { v[i] = *(const f32x4*)(xr + 4 * i); ss += v[i][0] * v[i][0] + v[i][1] * v[i][1] + v[i][2] * v[i][2] + v[i][3] * v[i][3]; }
    ss += sx<1>(ss); ss += sx<2>(ss);
    const float rs = (1.0f - LAM_INIT) / sqrtf(ss * (1.0f / 128.0f) + EPS);
    bf16_t* dst = Ob + (long)row * D + seg * 32;
#pragma unroll
    for (int i = 0; i < 8; i += 2) {
      const f32x4 g0 = *(const f32x4*)(gsub + seg * 32 + 4 * i), g1 = *(const f32x4*)(gsub + seg * 32 + 4 * i + 4);
      u32x4 w; w.x = cvtpk(v[i][0] * rs * g0[0], v[i][1] * rs * g0[1]); w.y = cvtpk(v[i][2] * rs * g0[2], v[i][3] * rs * g0[3]);
      w.z = cvtpk(v[i + 1][0] * rs * g1[0], v[i + 1][1] * rs * g1[1]); w.w = cvtpk(v[i + 1][2] * rs * g1[2], v[i + 1][3] * rs * g1[3]);
      *(u32x4*)(dst + 4 * i) = w;
    }
  }
  __syncthreads();
#undef RESC
}
#undef KSWZ
#undef SBAR
}

__device__ __forceinline__ void ph_attn(const Params& p, unsigned char* smem) {
    unsigned char* ws = p.ws;
    const unsigned char* Q = ws + WS_Q; const unsigned char* Kb = ws + WS_K; const unsigned char* Vb = ws + WS_V;
    bf16_t* AO = (bf16_t*)(ws + WS_AO);
    const float lam = ((const float*)(ws + WS_CTL))[1024];
    const int c = blockIdx.x, G = gridDim.x;
    if (G == 256) {
        const int x = c & 7, s = c >> 3;
        for (int rd = 0; rd < 6; ++rd) {
            const int bh = rd * 4 + (x >> 1), qb = (x & 1) * 32 + s, b = bh / NH, h = bh % NH;
            fa::attn_unit(Q + ((size_t)b * SEQ + qb * 128) * QKW + h * 128, Kb + (size_t)(b * NH + h) * (KVLEN / 64) * 8192, Vb + (size_t)(b * NH + h) * (KVLEN / 64) * 8192,
                          AO + ((size_t)b * SEQ + qb * 128) * D + 256 + h * 128, p.in[I_GSUB], lam, (char*)smem, p.chunk);
        }
    } else {
        for (int u = c; u < BATCH * NH * 64; u += G) {
            const int bh = u >> 6, qb = u & 63, b = bh / NH, h = bh % NH;
            fa::attn_unit(Q + ((size_t)b * SEQ + qb * 128) * QKW + h * 128, Kb + (size_t)(b * NH + h) * (KVLEN / 64) * 8192, Vb + (size_t)(b * NH + h) * (KVLEN / 64) * 8192,
                          AO + ((size_t)b * SEQ + qb * 128) * D + 256 + h * 128, p.in[I_GSUB], lam, (char*)smem, p.chunk);
        }
    }
}

__device__ __forceinline__ void ph_fourierA(const Params& p, unsigned char* smem) {
    using namespace fa;
    unsigned char* ws = p.ws;
    const bf16_t* F = (const bf16_t*)(ws + WS_F); bf16_t* FY = (bf16_t*)(ws + WS_FY); const bf16_t* W = (const bf16_t*)(ws + WS_W128E);
    const int tid = otid(), wid = tid >> 6, lane = tid & 63, r32 = lane & 31, hi = lane >> 5;
    const int sr = tid >> 4, sc = (tid & 15) * 8, vst0 = v_st(sr, sc), vst1 = v_st(32 + sr, sc);
    const int vb0 = (int)(uintptr_t)smem + v_rd_base(lane);
    for (int task = blockIdx.x; task < BATCH * 64; task += gridDim.x) {
        const int b = task >> 6, n2 = task & 63;
        bf16x8 st[4][2];
#pragma unroll
        for (int kt = 0; kt < 2; ++kt)
#pragma unroll
            for (int ct = 0; ct < 2; ++ct) {
                st[kt * 2 + ct][0] = *(const bf16x8*)(F + ((size_t)b * SEQ + 64 * (64 * kt + sr) + n2) * 256 + 128 * ct + sc);
                st[kt * 2 + ct][1] = *(const bf16x8*)(F + ((size_t)b * SEQ + 64 * (64 * kt + 32 + sr) + n2) * 256 + 128 * ct + sc);
            }
        bf16x8 pa[2][4];
#pragma unroll
        for (int kt = 0; kt < 2; ++kt)
#pragma unroll
            for (int ks = 0; ks < 4; ++ks) pa[kt][ks] = *(const bf16x8*)(W + (size_t)(32 * wid + r32) * 128 + 64 * kt + 16 * ks + 8 * hi);
        __syncthreads();
#pragma unroll
        for (int q = 0; q < 4; ++q) { *(bf16x8*)(smem + q * 16384 + vst0) = st[q][0]; *(bf16x8*)(smem + q * 16384 + vst1) = st[q][1]; }
        __syncthreads();
        f32x16 o[2][4] = {};
#pragma unroll
        for (int ct = 0; ct < 2; ++ct)
#pragma unroll
            for (int kt = 0; kt < 2; ++kt) pv_d0(o[ct], vb0 + (kt * 2 + ct) * 16384, pa[kt][0], pa[kt][1], pa[kt][2], pa[kt][3]);
        const int plane = wid >> 2;
#pragma unroll
        for (int r = 0; r < 16; ++r) {
            const int k1 = 32 * (wid & 3) + crow(r, hi);
            bf16_t* dst = FY + ((((size_t)plane * BATCH + b) * 128 + k1) * 64 + n2) * 256 + r32;
#pragma unroll
            for (int ct = 0; ct < 2; ++ct)
#pragma unroll
                for (int d0 = 0; d0 < 4; ++d0) dst[128 * ct + 32 * d0] = f2bf(o[ct][d0][r]);
        }
    }
    __syncthreads();
}
__device__ __forceinline__ void ph_fourierB(const Params& p, unsigned char* smem) {
    using namespace fa;
    unsigned char* ws = p.ws;
    const bf16_t* FY = (const bf16_t*)(ws + WS_FY); const float2* tabw = (const float2*)(ws + WS_TABW);
    const bf16_t* M64 = (const bf16_t*)(ws + WS_M64E); const bf16_t* GT = (const bf16_t*)(ws + WS_GT);
    bf16_t* AO = (bf16_t*)(ws + WS_AO);
    const int tid = otid(), wid = tid >> 6, lane = tid & 63, r32 = lane & 31, hi = lane >> 5;
    const int sr = tid >> 4, sc = (tid & 15) * 8, vst0 = v_st(sr, sc), vst1 = v_st(32 + sr, sc);
    const int vb0 = (int)(uintptr_t)smem + v_rd_base(lane);
    constexpr int XRS = 528;
    unsigned char* XL = smem + 65536;
    const int mt = wid & 3, ctw = wid >> 2;
    for (int task = blockIdx.x; task < BATCH * 128; task += gridDim.x) {
        const int b = task >> 7, k1 = task & 127;
        __syncthreads();
#pragma unroll
        for (int ct = 0; ct < 2; ++ct)
#pragma unroll
            for (int rh = 0; rh < 2; ++rh) {
                const int n2 = sr + 32 * rh;
                const size_t off = ((((size_t)b) * 128 + k1) * 64 + n2) * 256 + 128 * ct + sc;
                const uint4 yr = *(const uint4*)(FY + off), yi = *(const uint4*)(FY + (size_t)BATCH * 128 * 64 * 256 + off);
                const float2 tw = tabw[n2 * k1];
                const unsigned yrw[4] = {yr.x, yr.y, yr.z, yr.w}, yiw[4] = {yi.x, yi.y, yi.z, yi.w};
                unsigned zr[4], zi[4];
#pragma unroll
                for (int q = 0; q < 4; ++q) {
                    const float a0 = __uint_as_float(yrw[q] << 16), a1 = __uint_as_float(yrw[q] & 0xffff0000u), b0 = __uint_as_float(yiw[q] << 16), b1 = __uint_as_float(yiw[q] & 0xffff0000u);
                    zr[q] = pk2(a0 * tw.x + b0 * tw.y, a1 * tw.x + b1 * tw.y); zi[q] = pk2(b0 * tw.x - a0 * tw.y, b1 * tw.x - a1 * tw.y);
                }
                const int vs = rh ? vst1 : vst0;
                *(uint4*)(smem + (0 * 2 + ct) * 16384 + vs) = make_uint4(zr[0], zr[1], zr[2], zr[3]);
                *(uint4*)(smem + (1 * 2 + ct) * 16384 + vs) = make_uint4(zi[0], zi[1], zi[2], zi[3]);
            }
        __syncthreads();
        {
            f32x16 o[4] = {};
#pragma unroll
            for (int kt = 0; kt < 2; ++kt) {
                bf16x8 pa[4];
#pragma unroll
                for (int ks = 0; ks < 4; ++ks) pa[ks] = *(const bf16x8*)(M64 + (size_t)(32 * mt + r32) * 128 + 64 * kt + 16 * ks + 8 * hi);
                pv_d0(o, vb0 + (kt * 2 + ctw) * 16384, pa[0], pa[1], pa[2], pa[3]);
            }
#pragma unroll
            for (int r = 0; r < 16; ++r) {
                const int ro = 32 * mt + crow(r, hi);
                bf16_t* xr = (bf16_t*)(XL + ((ro >> 6) * 64 + (ro & 63)) * XRS) + 128 * ctw + r32;
#pragma unroll
                for (int d0 = 0; d0 < 4; ++d0) xr[32 * d0] = f2bf(o[d0][r]);
            }
        }
        __syncthreads();
#pragma unroll
        for (int tt = 0; tt < 2; ++tt) {
            const int tau = 2 * wid + tt, g = tau >> 2, mt2 = (tau >> 1) & 1, nt2 = tau & 1;
            f32x16 acc = {};
#pragma unroll
            for (int ks8 = 0; ks8 < 8; ++ks8) {
                const int part = ks8 >> 2, cb = ks8 & 3;
                const bf16x8 af = *(const bf16x8*)(XL + (part * 64 + 32 * mt2 + r32) * XRS + (g * 64 + 16 * cb + 8 * hi) * 2);
                const bf16x8 bfr = *(const bf16x8*)(GT + ((size_t)g * 64 + 32 * nt2 + r32) * 128 + part * 64 + 16 * cb + 8 * hi);
                acc = __builtin_amdgcn_mfma_f32_32x32x16_bf16(af, bfr, acc, 0, 0, 0);
            }
#pragma unroll
            for (int r = 0; r < 16; ++r) { const int k2 = 32 * mt2 + crow(r, hi);
                AO[((size_t)b * SEQ + k1 + 128 * k2) * D + g * 64 + 32 * nt2 + r32] = f2bf(acc[r]); }
        }
    }
    __syncthreads();
}

__device__ __forceinline__ void ph_mid(const Params& p, unsigned char* smem) {
    typedef short bf16x8 __attribute__((ext_vector_type(8)));
    unsigned char* ws = p.ws;
    const int tid = otid(), wave = tid >> 6, lane = tid & 63, fr = lane & 15, fq = lane >> 4;
    const float* mod = (const float*)(ws + WS_MOD);
    const bf16_t* YX = (const bf16_t*)(ws + WS_YX);
    unsigned char* H2 = ws + WS_H2;
    unsigned* counts = (unsigned*)(ws + WS_CTL);
    int* TE = (int*)(ws + WS_TE); int* TP = (int*)(ws + WS_TP); float* TW = (float*)(ws + WS_TW); int* TOKL = (int*)(ws + WS_TOKL);
    constexpr int RS = 2064;
    unsigned char* Ahi = smem; unsigned char* Alo = smem + 16 * RS; float* Pp = (float*)(smem + 2 * 16 * RS + 512);
    const float rbias = p.in[I_RB][lane];
    int* lcnt = (int*)(smem + 99328); int* gb = lcnt + 64; int* PE = gb + 64; float* PW = (float*)(PE + 1024); float* PV = PW + 1024;
    for (int chunk = blockIdx.x; chunk < T / 128; chunk += gridDim.x) {
      const int mc = chunk * 128, b = mc >> 13;
      if (tid < 64) lcnt[tid] = 0;
      {
          const float* mrow_ = mod + b * 6144;
          for (int i = tid; i < 5 * 256; i += NT) { const int v_ = i >> 8, q_ = (i & 255) * 4;
              const float* s_ = (v_ == 0) ? p.in[I_GAPOST] + q_ : (v_ == 1) ? mrow_ + 2 * 1024 + q_ : (v_ == 2) ? p.in[I_GFPRE] + q_ : (v_ == 3) ? mrow_ + 3 * 1024 + q_ : mrow_ + 4 * 1024 + q_;
              *(f32x4*)(PV + v_ * 1024 + q_) = *(const f32x4*)s_; }
          __syncthreads();
      }
      uint2 yw[2][4]; f32x4 xv[2][4];
#define MID_LOAD(m0_) do { _Pragma("unroll") for (int rr = 0; rr < 2; ++rr) { const int m_ = (m0_) + 2 * wave + rr; _Pragma("unroll") for (int j = 0; j < 4; ++j) { \
          yw[rr][j] = *(const uint2*)(YX + (size_t)m_ * D + 4 * (lane + 64 * j)); xv[rr][j] = ((const f32x4*)(p.in[I_X] + (size_t)m_ * D))[lane + 64 * j]; } } } while (0)
      MID_LOAD(mc);
      for (int it = 0; it < 8; ++it) {
        const int m0 = mc + it * 16;
        {
            float ss[2] = {0.f, 0.f};
#define YV(rr, j, i) ((i) == 0 ? __uint_as_float(yw[rr][j].x << 16) : (i) == 1 ? __uint_as_float(yw[rr][j].x & 0xffff0000u) : (i) == 2 ? __uint_as_float(yw[rr][j].y << 16) : __uint_as_float(yw[rr][j].y & 0xffff0000u))
#pragma unroll
            for (int rr = 0; rr < 2; ++rr) {
#pragma unroll
                for (int j = 0; j < 4; ++j) ss[rr] += YV(rr, j, 0) * YV(rr, j, 0) + YV(rr, j, 1) * YV(rr, j, 1) + YV(rr, j, 2) * YV(rr, j, 2) + YV(rr, j, 3) * YV(rr, j, 3);
                ss[rr] = wave_sum(ss[rr]);
            }
#pragma unroll
            for (int rr = 0; rr < 2; ++rr) {
                const int lr = 2 * wave + rr, m = m0 + lr;
                const float r1 = 1.0f / sqrtf(ss[rr] * (1.0f / D) + EPS);
                float ss2 = 0.f;
#pragma unroll
                for (int j = 0; j < 4; ++j) {
                    const int col = 4 * (lane + 64 * j);
                    const f32x4 gp = *(const f32x4*)(PV + col), gt = *(const f32x4*)(PV + 1024 + col);
#pragma unroll
                    for (int i = 0; i < 4; ++i) { xv[rr][j][i] = xv[rr][j][i] + gt[i] * (YV(rr, j, i) * r1 * gp[i]); ss2 += xv[rr][j][i] * xv[rr][j][i]; }
                    ((f32x4*)(p.out + (size_t)m * D))[lane + 64 * j] = xv[rr][j];
                }
                ss2 = wave_sum(ss2);
                const float r2 = 1.0f / sqrtf(ss2 * (1.0f / D) + EPS);
#pragma unroll
                for (int j = 0; j < 4; ++j) {
                    const int col = 4 * (lane + 64 * j);
                    const f32x4 gp = *(const f32x4*)(PV + 2048 + col), sh = *(const f32x4*)(PV + 3072 + col), sc = *(const f32x4*)(PV + 4096 + col);
                    float h[4]; bf16_t hb[4]; float lo[4];
#pragma unroll
                    for (int i = 0; i < 4; ++i) { h[i] = xv[rr][j][i] * r2 * gp[i] * (1.f + sc[i]) + sh[i]; hb[i] = f2bf(h[i]); lo[i] = h[i] - bf2f(hb[i]); }
                    uint2 o; o.x = (unsigned)hb[0] | ((unsigned)hb[1] << 16); o.y = (unsigned)hb[2] | ((unsigned)hb[3] << 16);
                    { int w8 = __builtin_amdgcn_cvt_pk_fp8_f32(h[0], h[1], 0, false); w8 = __builtin_amdgcn_cvt_pk_fp8_f32(h[2], h[3], w8, true); *(int*)(H2 + (size_t)m * D + col) = w8; }
                    *(uint2*)(Ahi + lr * RS + col * 2) = o;
                    uint2 ol; ol.x = pk2(lo[0], lo[1]); ol.y = pk2(lo[2], lo[3]);
                    *(uint2*)(Alo + lr * RS + col * 2) = ol;
                }
            }
            if (it < 7) MID_LOAD(m0 + 16);
        }
        asm volatile("s_waitcnt lgkmcnt(0)\n\ts_barrier" ::: "memory");
        {
            f32x4 acc[4];
#pragma unroll
            for (int nb = 0; nb < 4; ++nb) acc[nb] = (f32x4){0.f, 0.f, 0.f, 0.f};
            const bf16_t* wrtlo = (const bf16_t*)(ws + WS_WRT); asm volatile("" : "+s"(wrtlo));
#pragma unroll
            for (int ks = 0; ks < 4; ++ks) {
                const int ko = (wave * 128 + ks * 32 + 8 * fq) * 2;
                const bf16x8 ah = *(const bf16x8*)(Ahi + fr * RS + ko), al = *(const bf16x8*)(Alo + fr * RS + ko);
#pragma unroll
                for (int nb = 0; nb < 4; ++nb) {
                    const size_t wo_ = ((size_t)(((wave * 4 + ks) * 4 + nb) * 2) * 64 + lane) * 8;
                    const bf16x8 bhv = *(const bf16x8*)(wrtlo + wo_), bl = *(const bf16x8*)(wrtlo + wo_ + 512);
                    acc[nb] = __builtin_amdgcn_mfma_f32_16x16x32_bf16(ah, bhv, acc[nb], 0, 0, 0);
                    acc[nb] = __builtin_amdgcn_mfma_f32_16x16x32_bf16(ah, bl, acc[nb], 0, 0, 0);
                    acc[nb] = __builtin_amdgcn_mfma_f32_16x16x32_bf16(al, bhv, acc[nb], 0, 0, 0);
                }
            }
#pragma unroll
            for (int nb = 0; nb < 4; ++nb)
#pragma unroll
                for (int j = 0; j < 4; ++j) Pp[(wave * 16 + 4 * fq + j) * 64 + 16 * nb + fr] = acc[nb][j];
        }
        asm volatile("s_waitcnt lgkmcnt(0)\n\ts_barrier" ::: "memory");
#pragma unroll
        for (int rr = 0; rr < 2; ++rr) {
            const int lr = 2 * wave + rr;
            float lg = 0.f;
#pragma unroll
            for (int w = 0; w < 8; ++w) lg += Pp[(w * 16 + lr) * 64 + lane];
            const float score = 1.0f / (1.0f + expf(-lg));
            const float sel = score + rbias;
            float t1 = sel, t2 = -INFINITY;
#define TOP2(M) do { const float o1 = sx<M>(t1), o2 = sx<M>(t2); const float n1 = fmaxf(t1, o1), n2 = fmaxf(fminf(t1, o1), fmaxf(t2, o2)); t1 = n1; t2 = n2; } while (0)
            TOP2(1); TOP2(2); TOP2(4);
#undef TOP2
            const float gs = t1 + t2; const int grp = lane >> 3;
            int gr = 0;
#pragma unroll
            for (int j = 0; j < 8; ++j) { const float sj = __uint_as_float(__builtin_amdgcn_readlane(__float_as_uint(gs), j * 8)); gr += (sj > gs || (sj == gs && j < grp)) ? 1 : 0; }
            const bool gsel = gr < 4;
            float v = gsel ? sel : -INFINITY;
            int rk = TOPK;
#pragma unroll
            for (int it8 = 0; it8 < TOPK; ++it8) {
                const float mx = wave_max(v);
                const unsigned long long eq = __ballot(v == mx);
                const int win = __builtin_ctzll(eq);
                if (lane == win) { rk = it8; v = -INFINITY; }
            }
            const bool chosen = rk < TOPK;
            const float ssum = wave_sum(chosen ? score : 0.f);
            const float w = score / (ssum + 1e-20f) * 2.5f;
            if (chosen) {
                const int lpos = atomicAdd(&lcnt[lane], 1);
                const int idx = (it * 16 + lr) * 8 + rk;
                PE[idx] = lane | (lpos << 8); PW[idx] = w;
            }
        }
      }
      __syncthreads();
      if (tid < 64) { const int c = lcnt[tid]; gb[tid] = c ? (int)atomicAdd(&counts[b * 65 + tid], (unsigned)c) : 0; }
      __syncthreads();
      for (int i = tid; i < 1024; i += NT) {
          const int pe = PE[i], e = pe & 255, pos = gb[e] + (pe >> 8), mk = mc * 8 + i;
          TOKL[((size_t)b * 64 + e) * 8192 + pos] = mk; TE[mk] = e; TP[mk] = pos; TW[mk] = PW[i];
      }
      __syncthreads();
    }
}

constexpr int T_CNT = 0;
constexpr int T_TOT = 256;
constexpr int T_AB = 328;
constexpr int T_OFF = 400;
constexpr int T_GUP = 660;
constexpr int T_YC = 730;
constexpr int T_YB = 990;
constexpr int T_DUP = 1250;
constexpr int T_UL = 1520;
constexpr int T_END = 1520 + 512;
__device__ __forceinline__ int scan_incl(int v, int lane) {
#pragma unroll
    for (int off = 1; off < 64; off <<= 1) { const int t = __builtin_amdgcn_ds_bpermute(((lane - off) & 63) << 2, v); if (lane >= off) v += t; }
    return v;
}
__device__ __forceinline__ void build_moe(const Params& p, int* tab) {
    const unsigned* counts = (const unsigned*)(p.ws + WS_CTL);
    __syncthreads();
    const int tid = otid(), wave = tid >> 6, lane = tid & 63;
    if (wave == 0) {
        const int c0 = (int)counts[0 * 65 + lane], c1 = (int)counts[1 * 65 + lane], c2 = (int)counts[2 * 65 + lane], c3 = (int)counts[3 * 65 + lane];
        tab[T_CNT + 0 * 64 + lane] = c0; tab[T_CNT + 1 * 64 + lane] = c1; tab[T_CNT + 2 * 64 + lane] = c2; tab[T_CNT + 3 * 64 + lane] = c3;
        tab[T_OFF + lane * 4 + 0] = 0; tab[T_OFF + lane * 4 + 1] = c0; tab[T_OFF + lane * 4 + 2] = c0 + c1; tab[T_OFF + lane * 4 + 3] = c0 + c1 + c2;
        const int tot = c0 + c1 + c2 + c3, pad = (tot + 255) & ~255, gu = ((tot + 255) >> 8) * 2;
        const int sp = scan_incl(pad, lane), sg = scan_incl(gu, lane);
        tab[T_TOT + lane] = tot; tab[T_AB + lane] = sp - pad; tab[T_GUP + lane] = sg - gu;
        const int cb[4] = {c0, c1, c2, c3};
#pragma unroll
        for (int b = 0; b < 4; ++b) {
            const int du = ((cb[b] + 255) >> 8) * 4;
            const int sy = scan_incl(cb[b], lane), sd = scan_incl(du, lane);
            tab[T_YB + 65 * b + lane] = sy - cb[b]; tab[T_DUP + 66 * b + lane] = sd - du;
            if (lane == 63) { tab[T_YB + 65 * b + 64] = sy; tab[T_DUP + 66 * b + 64] = sd; tab[T_DUP + 66 * b + 65] = sd + (SEQ / 256) * 4; }
        }
        if (lane == 63) { tab[T_TOT + 64] = T; tab[T_AB + 64] = sp; tab[T_GUP + 64] = sg; tab[T_GUP + 65] = sg + (T / 256) * 2; }
    }
    __syncthreads();
}

__device__ __forceinline__ void moe_decode(const GP_LAS int* tab, int e, int pos_e, int& b, int& pos) {
    const int o1 = tab[T_OFF + e * 4 + 1], o2 = tab[T_OFF + e * 4 + 2], o3 = tab[T_OFF + e * 4 + 3];
    b = (pos_e >= o1 ? 1 : 0) + (pos_e >= o2 ? 1 : 0) + (pos_e >= o3 ? 1 : 0);
    pos = pos_e - (b == 0 ? 0 : (b == 1 ? o1 : (b == 2 ? o2 : o3)));
}
__device__ __forceinline__ int yrow0(int b) { return b == 0 ? 2 * 1024 : (272 + 72 * (b - 1)) * 1024; }
struct MoeSched {
    const GP_LAS int* tab; int G, c, ntn, U, down, chunk; const int* TOKL; const char* Bt;
    __device__ __forceinline__ void prepare(int* tabw, int wv) const {
        if (wv == 0) {
            const int i = lane_id(); int L = i * G + c;
            if (L < U) {
                int bt = 0;
                if (down) {
#pragma unroll
                    for (int q = 0; q < 3; ++q) { const int u0 = tabw[T_DUP + 66 * bt + 65]; if (L >= u0) { L -= u0; ++bt; } } }
                const int pre = down ? T_DUP + 66 * bt : T_GUP;
                int lo = 0, hi = 64;
                while (lo < hi) { const int mid = (lo + hi + 1) >> 1; if (tabw[pre + mid] <= L) lo = mid; else hi = mid - 1; }
                const int loc = L - tabw[pre + lo];
                int cnt, base, bb;
                if (down) { cnt = (lo < 64) ? tabw[T_CNT + bt * 64 + (lo & 63)] : SEQ; base = tabw[T_YB + 65 * bt + lo] + yrow0(bt);
                            bb = tabw[T_AB + lo] + (lo < 64 ? tabw[T_OFF + (lo & 63) * 4 + bt] : bt * SEQ); }
                else { cnt = tabw[T_TOT + lo]; base = tabw[T_AB + lo]; bb = 0; }
                int* ul = tabw + T_UL + 8 * i;
                ul[0] = lo; ul[1] = loc / ntn; ul[2] = loc % ntn; ul[3] = cnt; ul[4] = base; ul[5] = bb;
            }
        }
        __syncthreads();
    }
    __device__ __forceinline__ bool next(int i, gp::Unit& u) const {
        if (i * G + c >= U) return false;
        const GP_LAS int* ul = tab + T_UL + 8 * i;
        u.e = __builtin_amdgcn_readfirstlane(ul[0]); u.pm = __builtin_amdgcn_readfirstlane(ul[1]); u.pn = __builtin_amdgcn_readfirstlane(ul[2]);
        u.cnt = __builtin_amdgcn_readfirstlane(ul[3]); u.base = __builtin_amdgcn_readfirstlane(ul[4]); u.b = __builtin_amdgcn_readfirstlane(ul[5]);
        return true;
    }
    __device__ __forceinline__ unsigned arow(const gp::Unit& u, int r) const {
        const int pos_e = u.pm * 256 + r;
        if (down) return (unsigned)(u.b + pos_e) * 256u;
        int tok;
        if (u.e < 64) { int b, pos; moe_decode(tab, u.e, pos_e, b, pos); tok = (pos_e < u.cnt) ? (TOKL[((size_t)b * 64 + u.e) * 8192 + pos] >> 3) : 0; } else tok = pos_e;
        return (unsigned)tok * 1024u;
    }
    __device__ __forceinline__ const char* bptr(const gp::Unit& u) const {
        return down ? Bt + ((size_t)u.e * 1024 + u.pn * 256) * 256 : Bt + ((size_t)u.e * 512 + u.pn * 256) * 1024;
    }
};
struct EpiGU {
    unsigned char* ACT; const int* TOKL; const float* TW; const GP_LAS int* tab;
    __device__ __forceinline__ void operator()(const f32x4 (&acc)[2][2][4][2], const gp::Unit& u, int wr, int wc, int fr, int fq) const {
#pragma unroll
        for (int ai = 0; ai < 2; ++ai)
#pragma unroll
            for (int m = 0; m < 4; ++m) {
                const int pos_e = u.pm * 256 + ai * 128 + wr * 64 + m * 16 + fr;
                if (pos_e < u.cnt) {
                    float w = 1.0f;
                    if (u.e < 64) { int b, pos; moe_decode(tab, u.e, pos_e, b, pos); w = TW[TOKL[((size_t)b * 64 + u.e) * 8192 + pos]]; }
                    float a[8];
#pragma unroll
                    for (int n = 0; n < 2; ++n)
#pragma unroll
                        for (int i = 0; i < 4; ++i) { const float g = acc[ai][0][m][n][i] * (1.f / GUSCALE), up = acc[ai][1][m][n][i] * (1.f / GUSCALE);
                            a[4 * n + i] = __builtin_amdgcn_fmed3f(g * __builtin_amdgcn_rcpf(1.0f + __builtin_amdgcn_exp2f(-1.4426950408889634f * g)) * up * (w * ASCALE), -448.f, 448.f); }
                    int w0 = __builtin_amdgcn_cvt_pk_fp8_f32(a[0], a[1], 0, false); w0 = __builtin_amdgcn_cvt_pk_fp8_f32(a[2], a[3], w0, true);
                    int w1 = __builtin_amdgcn_cvt_pk_fp8_f32(a[4], a[5], 0, false); w1 = __builtin_amdgcn_cvt_pk_fp8_f32(a[6], a[7], w1, true);
                    uint2 o; o.x = (unsigned)w0; o.y = (unsigned)w1;
                    *(uint2*)(ACT + ((size_t)u.base + pos_e) * DE + u.pn * 128 + wc * 32 + fq * 8) = o;
                }
            }
    }
};
constexpr float YSCALE = 16.f;
struct EpiDown {
    unsigned char* ws;
    __device__ __forceinline__ void operator()(const f32x4 (&acc)[2][2][4][2], const gp::Unit& u, int wr, int wc, int fr, int fq) const {
#pragma unroll
        for (int ai = 0; ai < 2; ++ai)
#pragma unroll
            for (int m = 0; m < 4; ++m) {
                const int pos = u.pm * 256 + ai * 128 + wr * 64 + m * 16 + fr;
                if (pos < u.cnt) {
                    unsigned char* rowp = ws + (size_t)(u.base + pos) * D + u.pn * 256 + wc * 32 + fq * 8;
#pragma unroll
                    for (int bj = 0; bj < 2; ++bj) { const f32x4 v0 = acc[ai][bj][m][0] * (YSCALE / (WDSCALE * ASCALE)), v1 = acc[ai][bj][m][1] * (YSCALE / (WDSCALE * ASCALE));
                        int w0 = __builtin_amdgcn_cvt_pk_fp8_f32(v0[0], v0[1], 0, false); w0 = __builtin_amdgcn_cvt_pk_fp8_f32(v0[2], v0[3], w0, true);
                        int w1 = __builtin_amdgcn_cvt_pk_fp8_f32(v1[0], v1[1], 0, false); w1 = __builtin_amdgcn_cvt_pk_fp8_f32(v1[2], v1[3], w1, true);
                        uint2 o; o.x = (unsigned)w0; o.y = (unsigned)w1;
                        *(uint2*)(rowp + bj * 128) = o; }
                }
            }
    }
};
__device__ __forceinline__ void ph_moe_gu(const Params& p, unsigned char* smem) {
    unsigned char* ws = p.ws;
    int* tab = (int*)(smem + gp::STAGE_BYTES);
    build_moe(p, tab);
    MoeSched S; S.tab = (const GP_LAS int*)tab; S.G = gridDim.x; S.c = (gridDim.x % 8 == 0) ? (int)((blockIdx.x % 8) * (gridDim.x / 8) + blockIdx.x / 8) : (int)blockIdx.x;   S.ntn = 2; S.U = __builtin_amdgcn_readfirstlane(tab[T_GUP + 65]); S.down = 0; S.chunk = 0;
    S.TOKL = (const int*)(ws + WS_TOKL); S.Bt = (const char*)(ws + WS_WGUT);
    S.prepare(tab, p.chunk);
    EpiGU E{ws + WS_ACT, (const int*)(ws + WS_TOKL), (const float*)(ws + WS_TW), (const GP_LAS int*)tab};
    gp::gemm_phase<EpiGU, MoeSched, true, true>(p.chunk, (GP_LAS unsigned char*)smem, (const char*)(ws + WS_H2), D / 2, S, E);
}
__device__ __forceinline__ void ph_moe_down(const Params& p, unsigned char* smem, int c) {
    unsigned char* ws = p.ws;
    int* tab = (int*)(smem + gp::STAGE_BYTES);
    build_moe(p, tab);
    MoeSched S; S.tab = (const GP_LAS int*)tab; S.G = gridDim.x; S.c = (gridDim.x % 8 == 0) ? (int)((blockIdx.x % 8) * (gridDim.x / 8) + blockIdx.x / 8) : (int)blockIdx.x;   S.ntn = 4; S.U = __builtin_amdgcn_readfirstlane(tab[T_DUP + 65] + tab[T_DUP + 66 + 65] + tab[T_DUP + 132 + 65] + tab[T_DUP + 198 + 65]); S.down = 1; S.chunk = c;
    S.TOKL = nullptr; S.Bt = (const char*)(ws + WS_WDT);
    S.prepare(tab, p.chunk);
    EpiDown E{ws};
    gp::gemm_phase<EpiDown, MoeSched, false, true>(p.chunk, (GP_LAS unsigned char*)smem, (const char*)(ws + WS_ACT), DE / 2, S, E);
}

__device__ __forceinline__ void ph_final(const Params& p, float* lds) {
    unsigned char* ws = p.ws;
    int* tab = (int*)lds;
    build_moe(p, tab);
    const int tid = otid(), wave = tid >> 6, lane = tid & 63;
    const int gw = blockIdx.x * NWV + wave, GW = gridDim.x * NWV;
    const int* TE = (const int*)(ws + WS_TE); const int* TP = (const int*)(ws + WS_TP);
    const unsigned char* Y = ws;
    for (int m = gw; m < T; m += GW) {
        const int b = m >> 13, t = m & (SEQ - 1);
        const float* mod = (const float*)(ws + WS_MOD) + b * 6144 + 5 * 1024;
        float acc[16];
#pragma unroll
        for (int i = 0; i < 16; ++i) acc[i] = 0.f;
#pragma unroll
        for (int k = 0; k < 9; ++k) {
            int row;
            if (k < 8) { const int e = TE[m * 8 + k]; row = tab[T_YB + 65 * b + e] + TP[m * 8 + k]; }
            else row = tab[T_YB + 65 * b + 64] + t;
            row += yrow0(b);
            const unsigned char* yr = Y + (size_t)row * D;
#pragma unroll
            for (int j = 0; j < 4; ++j) { const int w = *(const int*)(yr + 4 * (lane + 64 * j));
                acc[4 * j] += __builtin_amdgcn_cvt_f32_fp8(w, 0); acc[4 * j + 1] += __builtin_amdgcn_cvt_f32_fp8(w, 1); acc[4 * j + 2] += __builtin_amdgcn_cvt_f32_fp8(w, 2); acc[4 * j + 3] += __builtin_amdgcn_cvt_f32_fp8(w, 3); }
        }
        float ss = 0.f;
#pragma unroll
        for (int i = 0; i < 16; ++i) { acc[i] *= (1.f / YSCALE); ss += acc[i] * acc[i]; }
        ss = wave_sum(ss);
        const float rs = 1.0f / sqrtf(ss * (1.0f / D) + EPS);
#pragma unroll
        for (int j = 0; j < 4; ++j) {
            const int col = 4 * (lane + 64 * j);
            const f32x4 gp = *(const f32x4*)(p.in[I_GFPOST] + col), gt = *(const f32x4*)(mod + col);
            f32x4 x1 = ((const f32x4*)(p.out + (size_t)m * D))[lane + 64 * j];
#pragma unroll
            for (int i = 0; i < 4; ++i) x1[i] += gt[i] * (acc[4 * j + i] * rs * gp[i]);
            ((f32x4*)(p.out + (size_t)m * D))[lane + 64 * j] = x1;
        }
    }
}

#define GAS __attribute__((address_space(1)))
#define LAS __attribute__((address_space(3)))
#define XB_TMO      128
#define XB_XCNT(j)  (256  + 64 * (j))
#define XB_XSUB(j)  (1280 + 64 * (j))
#define XB_XGEN(j)  (2304 + 64 * (j))
#define XB_TOP      3328
#define XB_TOPGEN   3392
#define XCD_BAR_WORDS 3456
#define XB_SPIN_CAP (1u << 21)
__device__ __forceinline__ unsigned xb_ld(unsigned* p)              { return __hip_atomic_load(p, __ATOMIC_RELAXED, __HIP_MEMORY_SCOPE_AGENT); }
__device__ __forceinline__ unsigned xb_add(unsigned* p, unsigned v) { return __hip_atomic_fetch_add(p, v, __ATOMIC_RELAXED, __HIP_MEMORY_SCOPE_AGENT); }
__device__ __forceinline__ unsigned xb_xcc_id() { return (unsigned)__builtin_amdgcn_s_getreg((3 << 11) | 20) & 0xFu; }
#define XB_SPIN(cond, bar) do { unsigned _sp = 0; while (cond) { __builtin_amdgcn_s_sleep(1); \
    if ((++_sp & 255u) == 0u) { if (xb_ld(&(bar)[XB_TMO])) break; if (_sp > XB_SPIN_CAP) { atomicAdd(&(bar)[XB_TMO], 1u); break; } } } } while (0)
struct XcdBarrier { unsigned* bar; unsigned x; volatile LAS unsigned* st; };
__device__ __forceinline__ XcdBarrier xcd_barrier_post(unsigned* bar, volatile LAS unsigned* st, int wv) {
    XcdBarrier b; b.bar = bar; b.x = xb_xcc_id(); b.st = st;
    if (wv == 0 && lane_id() == 0) (void)xb_add(&bar[XB_XCNT(b.x)], 1u);
    return b;
}
__device__ __forceinline__ void xcd_barrier_complete(unsigned* bar, unsigned x, unsigned& nloc, unsigned& nx) {
    const unsigned G = gridDim.x * gridDim.y * gridDim.z;
    unsigned sum, cnt, mine, sp = 0u;
    for (;;) {
        sum = 0u; cnt = 0u; mine = 0u;
#pragma unroll
        for (unsigned j = 0; j < 16; ++j) { const unsigned c = xb_ld(&bar[XB_XCNT(j)]); sum += c; cnt += (c > 0u) ? 1u : 0u; mine = (j == x) ? c : mine; }
        if (sum == G) break;
        __builtin_amdgcn_s_sleep(1);
        if ((++sp & 255u) == 0u) { if (xb_ld(&bar[XB_TMO])) break; if (sp > XB_SPIN_CAP) { atomicAdd(&bar[XB_TMO], 1u); break; } }
    }
    nloc = mine > 0u ? mine : 1u; nx = cnt > 0u ? cnt : 1u;
}
__device__ __forceinline__ void xcd_barrier(const XcdBarrier& b, int wv) {
    asm volatile("s_waitcnt vmcnt(0)" ::: "memory");
    __syncthreads();
    if (wv == 0 && lane_id() == 0) {
        unsigned* bar = b.bar;
        __builtin_amdgcn_s_waitcnt(0);
        unsigned nloc = b.st[0], nx = b.st[1];
        if (nloc == 0u) { xcd_barrier_complete(bar, b.x, nloc, nx); b.st[0] = nloc; b.st[1] = nx; }
        const unsigned old = xb_add(&bar[XB_XSUB(b.x)], 1u);
        const unsigned gen = old / nloc;
        if (old + 1u == (gen + 1u) * nloc) {
            __builtin_amdgcn_fence(__ATOMIC_RELEASE, "agent");
            asm volatile("s_waitcnt vmcnt(0)" ::: "memory");
            const unsigned og = xb_add(&bar[XB_TOP], 1u);
            const unsigned tg = og / nx;
            if (og + 1u == (tg + 1u) * nx) xb_add(&bar[XB_TOPGEN], 1u);
            else XB_SPIN(xb_ld(&bar[XB_TOPGEN]) == tg, bar);
            __builtin_amdgcn_fence(__ATOMIC_ACQUIRE, "agent");
            xb_add(&bar[XB_XGEN(b.x)], 1u);
            asm volatile("s_waitcnt vmcnt(0)" ::: "memory");
        } else {
            XB_SPIN(xb_ld(&bar[XB_XGEN(b.x)]) == gen, bar);
            __builtin_amdgcn_fence(__ATOMIC_ACQUIRE, "agent");
            asm volatile("s_waitcnt vmcnt(0)" ::: "memory");
        }
    }
    __syncthreads();
}

namespace cg = cooperative_groups;
constexpr int LDS_BYTES = 144 * 1024;
typedef const __attribute__((address_space(4))) Params* KP;
__device__ __forceinline__ Params kargs() {
    Params p;
#if defined(__HIP_DEVICE_COMPILE__)
    typedef const __attribute__((address_space(4))) unsigned long long* KQ;
    KQ kq = (KQ)__builtin_amdgcn_kernarg_segment_ptr(); asm volatile("" : "+s"(kq));
    unsigned long long* d = (unsigned long long*)&p;
#pragma unroll
    for (int i = 0; i < (int)(sizeof(Params) / 8); ++i) d[i] = kq[i];
#endif
    return p;
}
#define PH(call) do { Params p = kargs(); p.chunk = wv; call; } while (0)
__global__ void __launch_bounds__(NT) mega_fwd(Params p_unused) {
    extern __shared__ __attribute__((aligned(16))) unsigned char smem[];
    float* lds = (float*)smem;
    volatile LAS unsigned* misc = (volatile LAS unsigned*)((LAS unsigned char*)smem + (LDS_BYTES - 64));
    if (threadIdx.x < 16) misc[threadIdx.x] = 0u;
    __syncthreads();
    unsigned* barw; { const Params p = kargs(); barw = (unsigned*)(p.ws + WS_CTL) + 4096; }
    const int wv = __builtin_amdgcn_readfirstlane(threadIdx.x >> 6);
    const XcdBarrier bar = xcd_barrier_post(barw, misc, wv);
#define SYNC() xcd_barrier(bar, wv)
    PH(ph_prep(p, lds)); PH(ph_prep_weights(p, lds, 0, 0));   SYNC();
    PH(ph_norm1(p));                SYNC();
    PH(ph_inproj(p, smem)); PH(ph_prep_weights(p, lds, 1, (MTOT / 256) * (INW / 256) % (int)gridDim.x));         SYNC();
    PH(ph_attn(p, smem)); PH(ph_fourierA(p, smem));  SYNC();
    PH(ph_fourierB(p, smem));       SYNC();
    PH(ph_outproj(p, smem));        SYNC();
    PH(ph_mid(p, smem));            SYNC();
    PH(ph_moe_gu(p, smem));         SYNC();
#pragma unroll 1
    PH(ph_moe_down(p, smem, 0));    SYNC();
    PH(ph_final(p, lds));
#undef SYNC
}

extern "C" void kernel_launch(void* const* d_in, const int* in_sizes, int n_in, void* d_out, int out_size, void* d_ws, size_t ws_size, hipStream_t stream) {
    if (n_in != 26 || ws_size < WS_END) { fprintf(stderr, "kernel_launch: unexpected n_in %d / ws %zu\n", n_in, ws_size); return; }
    static int grid_blocks = 0;
    if (!grid_blocks) {
        int dev = 0, cus = 0, per_cu = 0;
        (void)hipGetDevice(&dev);
        (void)hipDeviceGetAttribute(&cus, hipDeviceAttributeMultiprocessorCount, dev);
        (void)hipFuncSetAttribute((const void*)mega_fwd, hipFuncAttributeMaxDynamicSharedMemorySize, LDS_BYTES);
        (void)hipOccupancyMaxActiveBlocksPerMultiprocessor(&per_cu, (const void*)mega_fwd, NT, LDS_BYTES);
        if (per_cu < 1) { fprintf(stderr, "kernel_launch: occupancy query says %d blocks/CU\n", per_cu); per_cu = 1; }
        if (per_cu > 1) per_cu = 1;
        grid_blocks = cus * per_cu;
    }
    Params p{};
    for (int i = 0; i < 26; ++i) p.in[i] = (const float*)d_in[i];
    p.out = (float*)d_out; p.ws = (unsigned char*)d_ws; p.chunk = 0; p.pad = 0;
    (void)hipMemsetAsync((char*)d_ws + WS_CTL, 0, 32768, stream);
    void* args[] = {&p};
    hipError_t e = hipLaunchCooperativeKernel((const void*)mega_fwd, dim3(grid_blocks), dim3(NT), args, LDS_BYTES, stream);
    if (e != hipSuccess) fprintf(stderr, "cooperative launch failed: %s (grid %d)\n", hipGetErrorString(e), grid_blocks);
}
```

```cpp
#include <hip/hip_runtime.h>
#include <hip/hip_cooperative_groups.h>
#include <cstdio>
#include <cstdint>

typedef unsigned short bf16_t;
typedef float f32x4 __attribute__((ext_vector_type(4)));

constexpr int D = 1024, BATCH = 4, SEQ = 8192, T = BATCH * SEQ, CTX = 256, TC = BATCH * CTX;
constexpr int MTOT = T + TC;
constexpr int KVLEN = CTX + SEQ;
constexpr int INW = 2560, NH = 6, QKW = 768, FW = 256;
constexpr int NE = 64, DE = 256, TOPK = 8;
constexpr int NT = 512, NWV = 8;
constexpr int SLOTS_B = 90112;
constexpr float EPS = 1e-6f;
constexpr float LAM_INIT = 0.2f;
constexpr float QSCALE = 0.125f * 1.4426950408889634f;
constexpr float SQS = 0.42466090014400953f;

constexpr size_t MiB = 1u << 20;
constexpr size_t WS_CTL = 0;
constexpr size_t WS_MOD = 1 * MiB;
constexpr size_t WS_TABW = WS_MOD + 128 * 1024;
constexpr size_t WS_ROPE = WS_MOD + 192 * 1024;
constexpr size_t WS_GCS = WS_MOD + 256 * 1024;
constexpr size_t WS_W128E = WS_MOD + 768 * 1024;
constexpr size_t WS_M64E = WS_MOD + 832 * 1024;
constexpr size_t WS_GT = WS_MOD + 864 * 1024;
constexpr size_t WS_WRT = WS_MOD + 512 * 1024;
constexpr size_t WS_WINT = 2 * MiB;
constexpr size_t WS_WOUTT = 7 * MiB;
constexpr size_t WS_WGUT = 9 * MiB;
constexpr size_t WS_WDT = 74 * MiB;
constexpr size_t WS_TE = 107 * MiB;
constexpr size_t WS_TP = 108 * MiB;
constexpr size_t WS_TW = 109 * MiB;
constexpr size_t WS_TOKL = 110 * MiB;
constexpr size_t WS_AO = 118 * MiB;
constexpr size_t WS_ACT = 118 * MiB;
constexpr size_t WS_Q = 182 * MiB;
constexpr size_t WS_K = 230 * MiB;
constexpr size_t WS_V = WS_K + (size_t)BATCH * KVLEN * QKW * 2;
constexpr size_t WS_F = 329 * MiB;
constexpr size_t WS_FY = 361 * MiB;
constexpr size_t WS_HX = 425 * MiB;
constexpr size_t WS_YX = 358 * MiB;
constexpr size_t WS_H2 = 294 * MiB;
constexpr size_t WS_Y = 294 * MiB;
constexpr size_t WS_END = 491 * MiB;

struct Params {
    const float* in[26];
    float* out;
    unsigned char* ws;
    int chunk;
    int pad;
};
enum { I_X = 0, I_C, I_CTX, I_CCTX, I_WMOD, I_BMOD, I_GAPRE, I_GAPOST, I_WIN, I_WF, I_LQ1, I_LK1, I_LQ2, I_LK2, I_GSUB, I_WOUT,
       I_GFPRE, I_GFPOST, I_WR, I_RB, I_WG, I_WU, I_WD, I_WSG, I_WSU, I_WSD };

__device__ __forceinline__ float bf2f(bf16_t v) { return __uint_as_float(((unsigned)v) << 16); }
__device__ __forceinline__ bf16_t f2bf(float f) { unsigned u = __float_as_uint(f); return (bf16_t)((u + 0x7fffu + ((u >> 16) & 1u)) >> 16); }
__device__ __forceinline__ unsigned pk2(float lo, float hi) { return (unsigned)f2bf(lo) | ((unsigned)f2bf(hi) << 16); }
template <int M> __device__ __forceinline__ float sx(float v) { return __int_as_float(__builtin_amdgcn_ds_swizzle(__float_as_int(v), (M << 10) | 0x1f)); }
template <int M> __device__ __forceinline__ int sxi(int v) { return __builtin_amdgcn_ds_swizzle(v, (M << 10) | 0x1f); }
__device__ __forceinline__ float wave_sum(float v) {
    v += sx<1>(v); v += sx<2>(v); v += sx<4>(v); v += sx<8>(v); v += sx<16>(v);
    auto rr = __builtin_amdgcn_permlane32_swap(__float_as_uint(v), __float_as_uint(v), false, false);
    return __uint_as_float(rr[0]) + __uint_as_float(rr[1]);
}
__device__ __forceinline__ float dpp_f(float v, const int ctrl_sel) {
    const int x = __float_as_int(v); int r;
    if (ctrl_sel == 0) r = __builtin_amdgcn_update_dpp(x, x, 0xB1, 0xf, 0xf, false);
    else if (ctrl_sel == 1) r = __builtin_amdgcn_update_dpp(x, x, 0x4E, 0xf, 0xf, false);
    else if (ctrl_sel == 2) r = __builtin_amdgcn_update_dpp(x, x, 0x141, 0xf, 0xf, false);
    else r = __builtin_amdgcn_update_dpp(x, x, 0x140, 0xf, 0xf, false);
    return __int_as_float(r);
}
__device__ __forceinline__ float wave_max(float v) {
    v = fmaxf(v, dpp_f(v, 0)); v = fmaxf(v, dpp_f(v, 1)); v = fmaxf(v, dpp_f(v, 2)); v = fmaxf(v, dpp_f(v, 3));
    const float a = __uint_as_float(__builtin_amdgcn_readlane(__float_as_uint(v), 0)), b = __uint_as_float(__builtin_amdgcn_readlane(__float_as_uint(v), 16));
    const float c = __uint_as_float(__builtin_amdgcn_readlane(__float_as_uint(v), 32)), d = __uint_as_float(__builtin_amdgcn_readlane(__float_as_uint(v), 48));
    return fmaxf(fmaxf(a, b), fmaxf(c, d));
}
__device__ __forceinline__ int lane_id() { int l; asm volatile("v_mbcnt_lo_u32_b32 %0, -1, 0\n\tv_mbcnt_hi_u32_b32 %0, -1, %0" : "=v"(l)); return l; }
__device__ __forceinline__ int otid_w(int wv) { return wv * 64 + lane_id(); }
#define otid() otid_w(p.chunk)
__device__ __forceinline__ float silu_f(float x) { return x / (1.f + expf(-x)); }

__device__ __forceinline__ void ph_prep(const Params& p, float* lds) {
    const int tid = otid(), bid = blockIdx.x, nblk = gridDim.x;
    const int gt = bid * NT + tid, GT = nblk * NT;
    unsigned char* ws = p.ws;
    float2* tabw = (float2*)(ws + WS_TABW);
    for (int i = gt; i < 8192; i += GT) { float s, c; sincospif((float)i * (1.0f / 4096.0f), &s, &c); tabw[i] = make_float2(c, s); }
    float* rope = (float*)(ws + WS_ROPE);
    for (int i = gt; i < 192 * 16; i += GT) {
        const int pos = (i < 2048) ? (i >> 4) : ((i - 2048) >> 4); const int f = i & 15;
        const float inv = powf(10000.0f, -(float)(2 * f) / 32.0f); const float ang = (float)pos * inv;
        const float c = cosf(ang), s = sinf(ang);
        if (i < 2048) { rope[i] = c; rope[2048 + i] = s; } else { rope[4096 + (i - 2048)] = c; rope[4096 + 1024 + (i - 2048)] = s; }
    }
    { bf16_t* gt = (bf16_t*)(ws + WS_GT); const float* wf = p.in[I_WF];
      for (int i = bid * NT + tid; i < 4 * 64 * 128; i += GT) {
        const int g = i >> 13, d = (i >> 7) & 63, part = (i >> 6) & 1, c = i & 63;
        float a = 0.f;
        for (int j = 0; j < 64; ++j) { float s, co; sincospif((float)((c * j) & 63) * (1.0f / 32.0f), &s, &co); a += (part ? s : co) * wf[(g * 64 + j) * 64 + d]; }
        gt[i] = f2bf(a * 0.0013810679320049757f);
      }
      bf16_t* w128 = (bf16_t*)(ws + WS_W128E);
      for (int i = bid * NT + tid; i < 256 * 128; i += GT) { const int kk = i >> 7, n1 = i & 127; float s, co; sincospif((float)(((kk & 127) * n1) & 127) * (1.0f / 64.0f), &s, &co); w128[i] = f2bf(kk < 128 ? co : -s); }
      bf16_t* m64 = (bf16_t*)(ws + WS_M64E);
      for (int i = bid * NT + tid; i < 128 * 128; i += GT) { const int ro = i >> 7, ci = i & 127, po = ro >> 6, k2 = ro & 63, pi = ci >> 6, n2 = ci & 63;
        float s, co; sincospif((float)((k2 * n2) & 63) * (1.0f / 32.0f), &s, &co); m64[i] = f2bf(po == pi ? co : (po == 0 ? s : -s)); }
    }
    {
      bf16_t* wrt = (bf16_t*)(ws + WS_WRT); const float* wr = p.in[I_WR];
      for (int i = gt; i < 64 * 1024; i += GT) {
        const int j = i & 7, ln = (i >> 3) & 63, nb = (i >> 9) & 3, ks = (i >> 11) & 3, wv_ = i >> 13;
        const int e = 16 * nb + (ln & 15), k = wv_ * 128 + ks * 32 + 8 * (ln >> 4) + j;
        const float w = wr[k * 64 + e]; const bf16_t h = f2bf(w);
        const int o = ((((wv_ * 4 + ks) * 4 + nb) * 2) * 64 + ln) * 8 + j;
        wrt[o] = h; wrt[o + 512] = f2bf(w - bf2f(h)); } }
    if (gt == 0) {
        float s1 = 0.f, s2 = 0.f;
        for (int i = 0; i < 64; ++i) { s1 += p.in[I_LQ1][i] * p.in[I_LK1][i]; s2 += p.in[I_LQ2][i] * p.in[I_LK2][i]; }
        ((float*)(ws + WS_CTL))[1024] = expf(s1) - expf(s2) + LAM_INIT;
    }
    float* sc = lds;
    float* red = lds + 5 * 1024;
    for (int i = tid; i < 5 * 1024; i += NT) { const int r = i >> 10, k = i & 1023; const float v = (r < 4) ? p.in[I_C][r * 1024 + k] : p.in[I_CCTX][k]; sc[i] = silu_f(v); }
    __syncthreads();
    const int wave = tid >> 6, lane = tid & 63;
    float* mod = (float*)(ws + WS_MOD);
    for (int task = bid; task < 96; task += nblk) {
        const int col = task * 64 + lane;
        float a0 = 0, a1 = 0, a2 = 0, a3 = 0, a4 = 0;
        const float* wm = p.in[I_WMOD];
#pragma unroll 32
        for (int k = wave * 128; k < wave * 128 + 128; ++k) { const float w = wm[(size_t)k * 6144 + col]; a0 += sc[k] * w; a1 += sc[1024 + k] * w; a2 += sc[2048 + k] * w; a3 += sc[3072 + k] * w; a4 += sc[4096 + k] * w; }
        red[(wave * 5 + 0) * 64 + lane] = a0; red[(wave * 5 + 1) * 64 + lane] = a1; red[(wave * 5 + 2) * 64 + lane] = a2; red[(wave * 5 + 3) * 64 + lane] = a3; red[(wave * 5 + 4) * 64 + lane] = a4;
        __syncthreads();
        if (tid < 320) { const int r = tid >> 6, l = tid & 63; float s = 0.f; for (int w = 0; w < 8; ++w) s += red[(w * 5 + r) * 64 + l]; mod[r * 6144 + task * 64 + l] = s + p.in[I_BMOD][task * 64 + l]; }
        __syncthreads();
    }
}

__device__ __forceinline__ void ph_norm1(const Params& p) {
    const int tid = otid(), wave = tid >> 6, lane = tid & 63;
    const int gw = blockIdx.x * NWV + wave, GW = gridDim.x * NWV;
    const float* mod = (const float*)(p.ws + WS_MOD);
    bf16_t* hx = (bf16_t*)(p.ws + WS_HX);
    const float* g = p.in[I_GAPRE];
    for (int m = gw; m < MTOT; m += GW) {
        const float* src = (m < T) ? p.in[I_X] + (size_t)m * D : p.in[I_CTX] + (size_t)(m - T) * D;
        const int r = (m < T) ? (m >> 13) : 4;
        const float* shift = mod + r * 6144; const float* scale = shift + 1024;
        f32x4 v[4]; float ss = 0.f;
#pragma unroll
        for (int j = 0; j < 4; ++j) { v[j] = ((const f32x4*)src)[lane + 64 * j]; ss += v[j][0] * v[j][0] + v[j][1] * v[j][1] + v[j][2] * v[j][2] + v[j][3] * v[j][3]; }
        ss = wave_sum(ss);
        const float rs = 1.0f / sqrtf(ss * (1.0f / D) + EPS);
#pragma unroll
        for (int j = 0; j < 4; ++j) {
            const int col = 4 * (lane + 64 * j);
            const f32x4 g4 = *(const f32x4*)(g + col), sc4 = *(const f32x4*)(scale + col), sh4 = *(const f32x4*)(shift + col);
            float h[4];
#pragma unroll
            for (int i = 0; i < 4; ++i) h[i] = v[j][i] * rs * g4[i] * (1.f + sc4[i]) + sh4[i];
            uint2 o; o.x = pk2(h[0], h[1]); o.y = pk2(h[2], h[3]);
            *(uint2*)(hx + (size_t)m * D + col) = o;
        }
    }
}

namespace gp {
#define GP_LAS __attribute__((address_space(3)))
typedef short bf16x8 __attribute__((ext_vector_type(8)));
typedef unsigned u32x4 __attribute__((ext_vector_type(4)));
typedef int i32x4 __attribute__((ext_vector_type(4)));
constexpr int BM = 256, BK = 64, HALF = 128, HTB = HALF * BK * 2, STAGE_BYTES = 8 * HTB;
__device__ __forceinline__ int lds_byte(int r, int c) { const int st = (r >> 4) * 2 + (c >> 5), rr = r & 15, cc = c & 31, ob = rr * 64 + cc * 2; return st * 1024 + (ob ^ (((ob >> 9) & 1) << 5)); }
__device__ __forceinline__ void stage_rc(int b, int& R, int& C) { const int st = b / 1024, sb = b % 1024, swz = sb ^ (((sb >> 9) & 1) << 5); R = (st >> 1) * 16 + swz / 64; C = (st & 1) * 32 + (swz % 64) / 2; }
__device__ __forceinline__ int perm32(int rho) { const int n = rho >> 4, i = rho & 15; return 8 * (i >> 2) + 4 * n + (i & 3); }
struct Unit { int pm, pn, e, b, cnt, base; };
__device__ __forceinline__ unsigned cvt_pk_bf16(float lo, float hi) { unsigned r; asm volatile("v_cvt_pk_bf16_f32 %0, %1, %2" : "=v"(r) : "v"(lo), "v"(hi)); return r; }

template <class Epi, class Sched, bool ALIGN_EPI, bool F8 = false>
__device__ __forceinline__ void gemm_phase(const int wv, GP_LAS unsigned char* lds, const char* Abase, const int K, const Sched& S, const Epi& E) {
    const int wid = wv, wr = wid >> 2, wc = wid & 3;
    const int nt = K / BK;
    unsigned voffB[2];
#pragma unroll
    for (int i = 0; i < 2; ++i) { int R, C; stage_rc(otid_w(wv) * 16 + i * 8192, R, C); const int Rb = (R & ~31) + perm32(R & 31); voffB[i] = (unsigned)(Rb * K + C) * 2u; }
#define GP_AOFFS(u, o00, o01, o10, o11) do { int R0, C0, R1, C1; const int t_ = otid_w(wv); stage_rc(t_ * 16, R0, C0); stage_rc(t_ * 16 + 8192, R1, C1); \
        o00 = S.arow(u, R0) + (unsigned)C0 * 2u; o01 = S.arow(u, R1) + (unsigned)C1 * 2u; o10 = S.arow(u, HALF + R0) + (unsigned)C0 * 2u; o11 = S.arow(u, HALF + R1) + (unsigned)C1 * 2u; } while (0)
    const size_t kstep = (size_t)(BK * 2);
    const size_t hstep = (size_t)HALF * K * 2;
    const unsigned ldsw = (unsigned)wid * 1024u;
    int aoff, boff; { const int l_ = lane_id(), fr = l_ & 15, fq = l_ >> 4; aoff = lds_byte(wr * 64 + fr, fq * 8); boff = lds_byte(wc * 32 + fr, fq * 8); }
#define GP_SA(b, h) (((b) * 2 + (h)) * HTB)
#define GP_SB(b, h) ((4 + (b) * 2 + (h)) * HTB)
#define GP_STAGE_B(bufoff, gbase) do { _Pragma("unroll") for (int _i = 0; _i < 2; ++_i) \
        __builtin_amdgcn_global_load_lds((const unsigned*)((const char*)(gbase) + voffB[_i]), (GP_LAS unsigned*)(lds + (bufoff) + ldsw + _i * 8192), 16, 0, 0); } while (0)
#define GP_STAGE_A(bufoff, gbase, o0, o1) do { \
        __builtin_amdgcn_global_load_lds((const unsigned*)((const char*)(gbase) + (o0)), (GP_LAS unsigned*)(lds + (bufoff) + ldsw), 16, 0, 0); \
        __builtin_amdgcn_global_load_lds((const unsigned*)((const char*)(gbase) + (o1)), (GP_LAS unsigned*)(lds + (bufoff) + ldsw + 8192), 16, 0, 0); } while (0)
#define GP_LDA(dst, b, h) do { _Pragma("unroll") for (int m = 0; m < 4; ++m) _Pragma("unroll") for (int k = 0; k < 2; ++k) dst[m][k] = *(const GP_LAS bf16x8*)(lds + GP_SA(b, h) + aoff + m * 2048 + k * 1024); } while (0)
#define GP_LDB(dst, b, h) do { _Pragma("unroll") for (int n = 0; n < 2; ++n) _Pragma("unroll") for (int k = 0; k < 2; ++k) dst[n][k] = *(const GP_LAS bf16x8*)(lds + GP_SB(b, h) + boff + n * 2048 + k * 1024); } while (0)
#define GP_CAT8(x) __builtin_shufflevector(__builtin_bit_cast(i32x4, x[0]), __builtin_bit_cast(i32x4, x[1]), 0, 1, 2, 3, 4, 5, 6, 7)
#define GP_MMA(ai, bj, At, Bt) do { __builtin_amdgcn_s_setprio(1); _Pragma("unroll") for (int m = 0; m < 4; ++m) _Pragma("unroll") for (int n = 0; n < 2; ++n) { \
        if constexpr (F8) acc[ai][bj][m][n] = __builtin_amdgcn_mfma_scale_f32_16x16x128_f8f6f4(GP_CAT8(Bt[n]), GP_CAT8(At[m]), acc[ai][bj][m][n], 0, 0, 0, 0, 0, 0); \
        else { _Pragma("unroll") for (int k = 0; k < 2; ++k) acc[ai][bj][m][n] = __builtin_amdgcn_mfma_f32_16x16x32_bf16(Bt[n][k], At[m][k], acc[ai][bj][m][n], 0, 0, 0); } } \
        __builtin_amdgcn_s_setprio(0); } while (0)
#define GP_WAIT_V(n) asm volatile("s_waitcnt vmcnt(" #n ")" ::: "memory")
#define GP_WAIT_L(n) asm volatile("s_waitcnt lgkmcnt(" #n ")" ::: "memory")
#define GP_BAR __builtin_amdgcn_s_barrier()
#define GP_SCHED __builtin_amdgcn_sched_barrier(0)
    Unit cur, nxt; int ui = 0;
    if (!S.next(0, cur)) return;
    f32x4 acc[2][2][4][2];
#pragma unroll
    for (int a = 0; a < 2; ++a)
#pragma unroll
        for (int b = 0; b < 2; ++b)
#pragma unroll
            for (int m = 0; m < 4; ++m)
#pragma unroll
                for (int n = 0; n < 2; ++n) acc[a][b][m][n] = (f32x4){0.f, 0.f, 0.f, 0.f};
    bf16x8 At[4][2], B0[2][2], B1[2][2];
    unsigned ac00, ac01, ac10, ac11, an00, an01, an10, an11;
    GP_AOFFS(cur, ac00, ac01, ac10, ac11);
    const char* cB = S.bptr(cur);
    GP_STAGE_B(GP_SB(0, 0), cB); GP_STAGE_B(GP_SB(0, 1), cB + hstep); GP_STAGE_A(GP_SA(0, 0), Abase, ac00, ac01); GP_STAGE_A(GP_SA(0, 1), Abase, ac10, ac11);
    if (wr == 1) GP_BAR;
    GP_WAIT_V(2); GP_BAR;
    GP_STAGE_B(GP_SB(1, 0), cB + kstep); GP_STAGE_A(GP_SA(1, 0), Abase + kstep, ac00, ac01); GP_STAGE_B(GP_SB(1, 1), cB + hstep + kstep);
    GP_WAIT_V(6); GP_BAR;
    for (;;) {
        const bool has_next = S.next(ui + 1, nxt);
        if (has_next) { GP_AOFFS(nxt, an00, an01, an10, an11); }
        else { an00 = ac00; an01 = ac01; an10 = ac10; an11 = ac11; }
        const char* nB = has_next ? S.bptr(nxt) : cB;
#pragma unroll 1
        for (int t = 0; t < nt; t += 2) {
            const bool last = (t == nt - 2);
            const char* a1 = Abase + (size_t)(t + 1) * kstep;
            const char* a2 = last ? Abase : Abase + (size_t)(t + 2) * kstep; const char* b2 = last ? nB : cB + (size_t)(t + 2) * kstep;
            const char* a3 = a2 + kstep; const char* b3 = b2 + kstep;
            asm volatile("" : "+s"(a1), "+s"(a2), "+s"(b2), "+s"(a3), "+s"(b3));
            GP_LDB(B0, 0, 0); GP_LDB(B1, 0, 1); GP_SCHED; GP_LDA(At, 0, 0); GP_STAGE_A(GP_SA(1, 1), a1, ac10, ac11);
            if (last) { ac00 = an00; ac01 = an01; ac10 = an10; ac11 = an11; }
            GP_WAIT_V(8); GP_WAIT_L(0); GP_BAR; GP_MMA(0, 0, At, B0); GP_MMA(0, 1, At, B1); GP_BAR; GP_SCHED;
            GP_LDA(At, 0, 1); GP_STAGE_B(GP_SB(0, 0), b2); GP_STAGE_B(GP_SB(0, 1), b2 + hstep); GP_STAGE_A(GP_SA(0, 0), a2, ac00, ac01);
            GP_WAIT_V(8); GP_WAIT_L(0); GP_BAR; GP_MMA(1, 0, At, B0); GP_MMA(1, 1, At, B1); GP_BAR; GP_SCHED;
            GP_LDB(B0, 1, 0); GP_LDB(B1, 1, 1); GP_SCHED; GP_LDA(At, 1, 0); GP_STAGE_A(GP_SA(0, 1), a2, ac10, ac11);
            GP_WAIT_V(8); GP_WAIT_L(0); GP_BAR; GP_MMA(0, 0, At, B0); GP_MMA(0, 1, At, B1); GP_BAR; GP_SCHED;
            GP_LDA(At, 1, 1); GP_STAGE_B(GP_SB(1, 0), b3); GP_STAGE_B(GP_SB(1, 1), b3 + hstep); GP_STAGE_A(GP_SA(1, 0), a3, ac00, ac01);
            GP_WAIT_V(8); GP_WAIT_L(0); GP_BAR; GP_MMA(1, 0, At, B0); GP_MMA(1, 1, At, B1); GP_BAR; GP_SCHED;
        }
        if constexpr (ALIGN_EPI) { if (wr == 0) GP_BAR; }
        { const int l_ = lane_id(); E(acc, cur, wr, wc, l_ & 15, l_ >> 4); }
        if (!has_next) break;
#pragma unroll
        for (int a = 0; a < 2; ++a)
#pragma unroll
            for (int b = 0; b < 2; ++b)
#pragma unroll
                for (int m = 0; m < 4; ++m)
#pragma unroll
                    for (int n = 0; n < 2; ++n) acc[a][b][m][n] = (f32x4){0.f, 0.f, 0.f, 0.f};
        cur = nxt; cB = nB; ++ui;
        if constexpr (ALIGN_EPI) { if (wr == 1) GP_BAR; }
    }
    GP_WAIT_V(0);
    if constexpr (!ALIGN_EPI) { if (wr == 0) GP_BAR; }
    GP_BAR;
#undef GP_AOFFS
#undef GP_SA
#undef GP_SB
#undef GP_STAGE_A
#undef GP_STAGE_B
#undef GP_LDA
#undef GP_LDB
#undef GP_MMA
#undef GP_CAT8
#undef GP_WAIT_V
#undef GP_WAIT_L
#undef GP_BAR
#undef GP_SCHED
}

struct DenseSched {
    int nM, nN, nwg, G, c, K; const char* Bt;
    __device__ __forceinline__ void init(int M, int N, int K_, const void* Bt_, int G_, int c_) { nM = M / BM; nN = N / BM; nwg = nM * nN; G = G_; c = c_; K = K_; Bt = (const char*)Bt_; }
    __device__ __forceinline__ bool next(int i, Unit& u) const {
        const long L = (long)i * G + c; if (L >= nwg) return false;
        int wgid = (int)L; { const int q = nwg / 8, r = nwg % 8, xcd = wgid % 8, off = wgid / 8; wgid = (xcd < r ? xcd * (q + 1) : r * (q + 1) + (xcd - r) * q) + off; }
        const int nig = 8 * nN, gid = wgid / nig, fm = gid * 8, gsz = (nM - fm) < 8 ? (nM - fm) : 8;
        u.pm = fm + ((wgid % nig) % gsz); u.pn = (wgid % nig) / gsz; u.e = 0; u.b = 0; u.cnt = 0; u.base = 0; return true;
    }
    __device__ __forceinline__ unsigned arow(const Unit& u, int r) const { return (unsigned)(u.pm * BM + r) * (unsigned)(K * 2); }
    __device__ __forceinline__ const char* bptr(const Unit& u) const { return Bt + (size_t)u.pn * BM * K * 2; }
};
}

struct EpiInProj {
    bf16_t* F; bf16_t* Q; bf16_t* Kb; bf16_t* Vb; const float* rope;
    __device__ __forceinline__ void operator()(const f32x4 (&acc)[2][2][4][2], const gp::Unit& u, int wr, int wc, int fr, int fq) const {
        const int pn = u.pn, pm = u.pm; const bool isctx = pm >= T / 256;
        if (isctx && pn < 4) return;
        if (pn >= 7) {
            unsigned char* V8 = (unsigned char*)Vb;
#pragma unroll
            for (int ai = 0; ai < 2; ++ai) {
                const int row0 = pm * 256 + ai * 128 + wr * 64;
                int b, tile;
                if (!isctx) { b = row0 >> 13; tile = (CTX >> 6) + ((row0 & 8191) >> 6); } else { const int j = row0 - T; b = j >> 8; tile = (j & 255) >> 6; }
#pragma unroll
                for (int bj = 0; bj < 2; ++bj) {
                    const int head = (pn - 7) * 2 + bj;
                    unsigned char* dst = V8 + ((size_t)(b * NH + head) * (KVLEN / 64) + tile) * 8192 + wc * 2048 + fq * 64 + (fr >> 3) * 32 + (fr & 1) * 16 + ((fr >> 1) & 3) * 4;
#pragma unroll
                    for (int e = 0; e < 8; ++e) {
                        int w = __builtin_amdgcn_cvt_pk_fp8_f32(acc[ai][bj][0][e >> 2][e & 3], acc[ai][bj][1][e >> 2][e & 3], 0, false);
                        w = __builtin_amdgcn_cvt_pk_fp8_f32(acc[ai][bj][2][e >> 2][e & 3], acc[ai][bj][3][e >> 2][e & 3], w, true);
                        *(int*)(dst + e * 256) = w;
                    }
                }
            }
            return;
        }
        const int axis = wc & 1; const float* ct = rope + (axis ? 4096 : 0); const float* st = rope + (axis ? 4096 + 1024 : 2048);
#pragma unroll
        for (int ai = 0; ai < 2; ++ai)
#pragma unroll
            for (int m = 0; m < 4; ++m) {
                const int row = pm * 256 + ai * 128 + wr * 64 + m * 16 + fr;
                int t, kb, tile;
                if (!isctx) { kb = row >> 13; t = row & 8191; tile = (CTX >> 6) + (t >> 6); } else { const int j = row - T; t = 0; kb = j >> 8; tile = (j & 255) >> 6; }
                const int pos = axis ? (t & 63) : (t >> 6);
#pragma unroll
                for (int bj = 0; bj < 2; ++bj) {
                    const int col0 = pn * 256 + bj * 128 + wc * 32 + fq * 8;
                    f32x4 v0 = acc[ai][bj][m][0], v1 = acc[ai][bj][m][1];
                    if (pn == 0) { gp::u32x4 w; w.x = gp::cvt_pk_bf16(v0[0], v0[1]); w.y = gp::cvt_pk_bf16(v0[2], v0[3]); w.z = gp::cvt_pk_bf16(v1[0], v1[1]); w.w = gp::cvt_pk_bf16(v1[2], v1[3]);
                        *(gp::u32x4*)(F + (size_t)row * 256 + col0) = w; continue; }
                    if (pn < 7 && !isctx) {
                        const f32x4 c0 = *(const f32x4*)(ct + pos * 16 + 8 * (fq & 1)), c1 = *(const f32x4*)(ct + pos * 16 + 8 * (fq & 1) + 4);
                        const f32x4 s0 = *(const f32x4*)(st + pos * 16 + 8 * (fq & 1)), s1 = *(const f32x4*)(st + pos * 16 + 8 * (fq & 1) + 4);
                        const float sg = (fq < 2) ? -1.f : 1.f;
#pragma unroll
                        for (int i = 0; i < 4; ++i) {
                            const auto r0 = __builtin_amdgcn_permlane32_swap(__float_as_uint(v0[i]), __float_as_uint(v0[i]), false, false);
                            const auto r1 = __builtin_amdgcn_permlane32_swap(__float_as_uint(v1[i]), __float_as_uint(v1[i]), false, false);
                            const float p0 = __uint_as_float(fq < 2 ? r0[1] : r0[0]), p1 = __uint_as_float(fq < 2 ? r1[1] : r1[0]);
                            v0[i] = v0[i] * c0[i] + sg * p0 * s0[i]; v1[i] = v1[i] * c1[i] + sg * p1 * s1[i]; }
                    }
                    v0 = v0 * SQS; v1 = v1 * SQS;
                    int w0 = __builtin_amdgcn_cvt_pk_fp8_f32(v0[0], v0[1], 0, false); w0 = __builtin_amdgcn_cvt_pk_fp8_f32(v0[2], v0[3], w0, true);
                    int w1 = __builtin_amdgcn_cvt_pk_fp8_f32(v1[0], v1[1], 0, false); w1 = __builtin_amdgcn_cvt_pk_fp8_f32(v1[2], v1[3], w1, true);
                    unsigned char* d;
                    if (pn < 4) d = (unsigned char*)Q + (size_t)row * QKW + (col0 - 256);
                    else d = (unsigned char*)Kb + ((size_t)(kb * NH + (pn - 4) * 2 + bj) * (KVLEN / 64) + tile) * 8192 + wc * 2048 + m * 512 + fr * 32 + fq * 8;
                    typedef int i32x2_t __attribute__((ext_vector_type(2)));
                    *(i32x2_t*)d = (i32x2_t){w0, w1};
                }
            }
    }
};
struct EpiStoreBf16 {
    bf16_t* O; int ldc;
    __device__ __forceinline__ void operator()(const f32x4 (&acc)[2][2][4][2], const gp::Unit& u, int wr, int wc, int fr, int fq) const {
#pragma unroll
        for (int ai = 0; ai < 2; ++ai)
#pragma unroll
            for (int m = 0; m < 4; ++m) {
                bf16_t* rowp = O + (size_t)(u.pm * 256 + ai * 128 + wr * 64 + m * 16 + fr) * ldc + u.pn * 256 + wc * 32 + fq * 8;
#pragma unroll
                for (int bj = 0; bj < 2; ++bj) { const f32x4 v0 = acc[ai][bj][m][0], v1 = acc[ai][bj][m][1];
                    gp::u32x4 w; w.x = gp::cvt_pk_bf16(v0[0], v0[1]); w.y = gp::cvt_pk_bf16(v0[2], v0[3]); w.z = gp::cvt_pk_bf16(v1[0], v1[1]); w.w = gp::cvt_pk_bf16(v1[2], v1[3]);
                    *(gp::u32x4*)(rowp + bj * 128) = w; }
            }
    }
};

__device__ __forceinline__ void ph_inproj(const Params& p, unsigned char* smem) {
    unsigned char* ws = p.ws;
    gp::DenseSched S; S.init(MTOT, INW, D, ws + WS_WINT, gridDim.x, blockIdx.x);
    EpiInProj E{(bf16_t*)(ws + WS_F), (bf16_t*)(ws + WS_Q), (bf16_t*)(ws + WS_K), (bf16_t*)(ws + WS_V), (const float*)(ws + WS_ROPE)};
    gp::gemm_phase<EpiInProj, gp::DenseSched, true>(p.chunk, (GP_LAS unsigned char*)smem, (const char*)(ws + WS_HX), D, S, E);
}
__device__ __forceinline__ void ph_outproj(const Params& p, unsigned char* smem) {
    unsigned char* ws = p.ws;
    gp::DenseSched S; S.init(T, D, D, ws + WS_WOUTT, gridDim.x, blockIdx.x);
    EpiStoreBf16 E{(bf16_t*)(ws + WS_YX), D};
    gp::gemm_phase<EpiStoreBf16, gp::DenseSched, true>(p.chunk, (GP_LAS unsigned char*)smem, (const char*)(ws + WS_AO), D, S, E);
}

constexpr float GUSCALE = 64.f;
constexpr float WDSCALE = 16.f, ASCALE = 4.f;
struct TItem8 { const float* W; unsigned char* WT; int K, N, row_base, k0, n0; float sc; };
__device__ __forceinline__ void titem8_load(const TItem8& t, float (&tv)[32], int lane) {
#pragma unroll
    for (int i = 0; i < 32; ++i) tv[i] = t.W[(size_t)(t.k0 + 2 * i + (lane >> 5)) * t.N + t.n0 + (lane & 31)];
}
__device__ __forceinline__ void titem8_finish(const TItem8& t, const float (&tv)[32], float* scr, int lane) {
#pragma unroll
    for (int i = 0; i < 32; ++i) scr[(2 * i + (lane >> 5)) * 33 + (lane & 31)] = tv[i] * t.sc;
    asm volatile("s_waitcnt lgkmcnt(0)" ::: "memory");
    const int c = lane & 7;
#pragma unroll
    for (int j = 0; j < 4; ++j) { const int n = (lane >> 3) + 8 * j; const float* s = scr + (8 * c) * 33 + n;
        int w0 = __builtin_amdgcn_cvt_pk_fp8_f32(s[0 * 33], s[1 * 33], 0, false); w0 = __builtin_amdgcn_cvt_pk_fp8_f32(s[2 * 33], s[3 * 33], w0, true);
        int w1 = __builtin_amdgcn_cvt_pk_fp8_f32(s[4 * 33], s[5 * 33], 0, false); w1 = __builtin_amdgcn_cvt_pk_fp8_f32(s[6 * 33], s[7 * 33], w1, true);
        uint2 o; o.x = (unsigned)w0; o.y = (unsigned)w1;
        *(uint2*)(t.WT + (size_t)(t.row_base + t.n0 + n) * t.K + t.k0 + 8 * c) = o; }
    asm volatile("s_waitcnt lgkmcnt(0)" ::: "memory");
}
__device__ __forceinline__ void transpose_item(const float* W, int K, int N, bf16_t* WT, int row_base, int kb, int nb, float* scr, int lane) {
    const int k0 = 64 * kb, n0 = 32 * nb;
    float tv[32];
#pragma unroll
    for (int i = 0; i < 32; ++i) tv[i] = W[(size_t)(k0 + 2 * i + (lane >> 5)) * N + n0 + (lane & 31)];
#pragma unroll
    for (int i = 0; i < 32; ++i) scr[(2 * i + (lane >> 5)) * 33 + (lane & 31)] = tv[i];
    asm volatile("s_waitcnt lgkmcnt(0)" ::: "memory");
    const int c = lane & 7;
#pragma unroll
    for (int j = 0; j < 4; ++j) { const int n = (lane >> 3) + 8 * j; const float* s = scr + (8 * c) * 33 + n;
        uint4 o; o.x = pk2(s[0 * 33], s[1 * 33]); o.y = pk2(s[2 * 33], s[3 * 33]); o.z = pk2(s[4 * 33], s[5 * 33]); o.w = pk2(s[6 * 33], s[7 * 33]);
        *(uint4*)(WT + (size_t)(row_base + n0 + n) * K + k0 + 8 * c) = o; }
    asm volatile("s_waitcnt lgkmcnt(0)" ::: "memory");
}
__device__ __forceinline__ void ph_prep_weights(const Params& p, float* lds, const int part, const int first) {
    const int tid = otid(), wave = tid >> 6, lane = tid & 63;
    float* scr = lds + 8192 + wave * (64 * 33);
    if ((int)blockIdx.x < first) return;
    const int gw = ((int)blockIdx.x - first) * NWV + wave, GW = ((int)gridDim.x - first) * NWV;
    unsigned char* ws = p.ws;
    constexpr int I_IN = 16 * 80, I_OUT = 16 * 32, I_GU = 16 * 8, I_D = 4 * 32;
    constexpr int NITEMS = I_IN + I_OUT + 65 * (2 * I_GU + I_D);
    const int it_lo = part ? I_IN + I_OUT : 0, it_hi = part ? NITEMS : I_IN + I_OUT;
    if (part == 0) {
        for (int it = it_lo + gw; it < it_hi; it += GW) {
            int r = it;
            if (r < I_IN) { transpose_item(p.in[I_WIN], D, INW, (bf16_t*)(ws + WS_WINT), 0, r / 80, r % 80, scr, lane); continue; } r -= I_IN;
            transpose_item(p.in[I_WOUT], D, D, (bf16_t*)(ws + WS_WOUTT), 0, r / 32, r % 32, scr, lane);
        }
        return;
    }
    auto decode = [&](int it, TItem8& t) {
        int r = it - (I_IN + I_OUT);
        const int e = r / (2 * I_GU + I_D); r -= e * (2 * I_GU + I_D);
        if (r < 2 * I_GU) {
            const int half = r / I_GU, q = r % I_GU, kb = q / 8, nb = q % 8;
            t.W = (e < 64) ? p.in[half ? I_WU : I_WG] + (size_t)e * D * DE : p.in[half ? I_WSU : I_WSG];
            const int n0 = 32 * nb, drow = e * 512 + (n0 >> 7) * 256 + half * 128 + (n0 & 127);
            t.WT = ws + WS_WGUT; t.K = D; t.N = DE; t.row_base = drow - n0; t.k0 = 64 * kb; t.n0 = n0; t.sc = GUSCALE;
        } else {
            r -= 2 * I_GU;
            t.W = (e < 64) ? p.in[I_WD] + (size_t)e * DE * D : p.in[I_WSD];
            t.WT = ws + WS_WDT; t.K = DE; t.N = D; t.row_base = e * 1024; t.k0 = 64 * (r / 32); t.n0 = 32 * (r % 32); t.sc = WDSCALE;
        }
    };
    int it = it_lo + gw;
    if (it >= it_hi) return;
    TItem8 ta, tb; float va[32], vb[32];
    decode(it, ta); titem8_load(ta, va, lane);
    for (;;) {
        const bool hb = it + GW < it_hi;
        if (hb) { decode(it + GW, tb); titem8_load(tb, vb, lane); }
        titem8_finish(ta, va, scr, lane);
        if (!hb) break;
        const bool ha = it + 2 * GW < it_hi;
        if (ha) { decode(it + 2 * GW, ta); titem8_load(ta, va, lane); }
        titem8_finish(tb, vb, scr, lane);
        if (!ha) break;
        it += 2 * GW;
    }
}

namespace fa {
typedef short bf16x8 __attribute__((ext_vector_type(8)));
typedef short s16x4 __attribute__((ext_vector_type(4)));
typedef float f32x16 __attribute__((ext_vector_type(16)));
typedef unsigned u32x4 __attribute__((ext_vector_type(4)));
constexpr int KVBLK = 64, LDK = QKW;
constexpr float SCALE = 0.125f, THR = 8.f;
constexpr size_t SHM_V = KVBLK * 128 * 2, SHM_K = KVBLK * 128 * 2;
#define KSWZ(row, colB) ((row) * 256 + ((colB) ^ (((row) & 15) << 4)))
#define SBAR() __builtin_amdgcn_sched_barrier(0)
__device__ __forceinline__ int crow(int r, int hi) { return (r & 3) + 8 * (r >> 2) + 4 * hi; }
__device__ __forceinline__ unsigned cvtpk(float lo, float hi) { unsigned r; asm volatile("v_cvt_pk_bf16_f32 %0, %1, %2" : "=v"(r) : "v"(lo), "v"(hi)); return r; }
constexpr float PBIAS = 5.f, THR2 = PBIAS + 3.5f;
template <bool FIRST>
__device__ __forceinline__ void partialSM(f32x16& p0, f32x16& p1, float& m_reg, f32x16& negm, float& alpha) {
  float pmax = p0[0];
#pragma unroll
  for (int r = 1; r < 16; ++r) pmax = fmaxf(pmax, p0[r]);
#pragma unroll
  for (int r = 0; r < 16; ++r) pmax = fmaxf(pmax, p1[r]);
  { auto rr = __builtin_amdgcn_permlane32_swap(__float_as_uint(pmax), __float_as_uint(pmax), false, false);
    pmax = fmaxf(__uint_as_float(rr[0]), __uint_as_float(rr[1])); }
  if (!FIRST && __builtin_expect(__all(pmax <= THR2), 1)) { alpha = 1.f; }
  else { const float dl = FIRST ? pmax - PBIAS : fmaxf(pmax - PBIAS, 0.f); alpha = FIRST ? 0.f : __builtin_amdgcn_exp2f(-dl); m_reg += dl;
#pragma unroll
    for (int r = 0; r < 16; ++r) { p0[r] -= dl; p1[r] -= dl; }
#pragma unroll
    for (int r = 0; r < 16; ++r) negm[r] = -m_reg;
    asm volatile("" : "+v"(negm)); }
#pragma unroll
  for (int r = 0; r < 16; ++r) p0[r] = __builtin_amdgcn_exp2f(p0[r]);
}
typedef int i32x8 __attribute__((ext_vector_type(8)));
__device__ __forceinline__ int pk4_fp8(float a, float b, float c, float d) { int w; asm("v_cvt_pk_fp8_f32 %0, %1, %2" : "=v"(w) : "v"(a), "v"(b)); asm("v_cvt_pk_fp8_f32 %0, %1, %2 op_sel:[0,0,1]" : "+v"(w) : "v"(c), "v"(d)); return w; }
__device__ __forceinline__ void finishSM_T(f32x16& p0, f32x16& p1, i32x8& pb) {
#pragma unroll
  for (int r = 0; r < 16; ++r) p1[r] = __builtin_amdgcn_exp2f(p1[r]);
#pragma unroll
  for (int g = 0; g < 4; ++g) {
    pb[g] = pk4_fp8(p0[4 * g], p0[4 * g + 1], p0[4 * g + 2], p0[4 * g + 3]); pb[4 + g] = pk4_fp8(p1[4 * g], p1[4 * g + 1], p1[4 * g + 2], p1[4 * g + 3]); }
}
__device__ __forceinline__ void qkt(f32x16& p0, f32x16& p1, const char* Ks, const i32x8 qf, int lane, int mm, const f32x16& negm) {
  const char* kp = Ks + mm * 4096 + lane * 16;
  const u32x4 a0 = *reinterpret_cast<const u32x4*>(kp), a1 = *reinterpret_cast<const u32x4*>(kp + 1024), b0 = *reinterpret_cast<const u32x4*>(kp + 2048), b1 = *reinterpret_cast<const u32x4*>(kp + 3072);
  p0 = __builtin_amdgcn_mfma_scale_f32_32x32x64_f8f6f4((i32x8){(int)a0.x, (int)a0.y, (int)a0.z, (int)a0.w, (int)a1.x, (int)a1.y, (int)a1.z, (int)a1.w}, qf, negm, 0, 0, 0, 0, 0, 0);
  p1 = __builtin_amdgcn_mfma_scale_f32_32x32x64_f8f6f4((i32x8){(int)b0.x, (int)b0.y, (int)b0.z, (int)b0.w, (int)b1.x, (int)b1.y, (int)b1.z, (int)b1.w}, qf, negm, 0, 0, 0, 0, 0, 0);
}
__device__ __forceinline__ int v_st(int k, int c) { const int kk = (k & ~0xC) | ((k & 4) << 1) | ((k & 8) >> 1); return ((kk >> 3) * 4 + (c >> 5)) * 512 + ((kk & 7) * 32 + (c & 31)) * 2; }
__device__ __forceinline__ int v_rd_base(int lane) { return ((lane & 3) << 3) | (((lane >> 2) & 3) << 6) | (((lane >> 4) & 1) << 5) | (((lane >> 5) & 1) << 8); }
constexpr int v_rd_off(int d0, int ks, int half) { return d0 * 512 + ks * 4096 + half * 2048; }
template <int OFF> __device__ __forceinline__ s16x4 tr_read(int vb) {
  s16x4 r; asm volatile("ds_read_b64_tr_b16 %0, %1 offset:%2" : "=&v"(r) : "v"(vb), "i"(OFF) : "memory"); return r;
}
template <int D0> __device__ __forceinline__ void pv_one(f32x16& od, int vb, bf16x8 pa0, bf16x8 pa1, bf16x8 pa2, bf16x8 pa3) {
  const s16x4 l0 = tr_read<v_rd_off(D0, 0, 0)>(vb), h0 = tr_read<v_rd_off(D0, 0, 1)>(vb), l1 = tr_read<v_rd_off(D0, 1, 0)>(vb), h1 = tr_read<v_rd_off(D0, 1, 1)>(vb);
  const s16x4 l2 = tr_read<v_rd_off(D0, 2, 0)>(vb), h2 = tr_read<v_rd_off(D0, 2, 1)>(vb), l3 = tr_read<v_rd_off(D0, 3, 0)>(vb), h3 = tr_read<v_rd_off(D0, 3, 1)>(vb);
  asm volatile("s_waitcnt lgkmcnt(0)" ::: "memory"); SBAR();
#define PK(L, H) (bf16x8){L[0], L[1], L[2], L[3], H[0], H[1], H[2], H[3]}
  od = __builtin_amdgcn_mfma_f32_32x32x16_bf16(pa0, PK(l0, h0), od, 0, 0, 0);
  od = __builtin_amdgcn_mfma_f32_32x32x16_bf16(pa1, PK(l1, h1), od, 0, 0, 0);
  od = __builtin_amdgcn_mfma_f32_32x32x16_bf16(pa2, PK(l2, h2), od, 0, 0, 0);
  od = __builtin_amdgcn_mfma_f32_32x32x16_bf16(pa3, PK(l3, h3), od, 0, 0, 0);
#undef PK
}
__device__ __forceinline__ void pv_d0(f32x16* o, int vb, bf16x8 pa0, bf16x8 pa1, bf16x8 pa2, bf16x8 pa3) {
  pv_one<0>(o[0], vb, pa0, pa1, pa2, pa3); pv_one<1>(o[1], vb, pa0, pa1, pa2, pa3); pv_one<2>(o[2], vb, pa0, pa1, pa2, pa3); pv_one<3>(o[3], vb, pa0, pa1, pa2, pa3);
}

template <int OFF> __device__ __forceinline__ u32x4 rd128(int vb) { u32x4 r; asm volatile("ds_read_b128 %0, %1 offset:%2" : "=&v"(r) : "v"(vb), "i"(OFF) : "memory"); return r; }
#define PV_RD(D0) const u32x4 va##D0 = rd128<D0 * 2048>(vb), vc##D0 = rd128<D0 * 2048 + 1024>(vb); SBAR()
#define PV_MM(D0) do { asm volatile("s_waitcnt lgkmcnt(0)" ::: "memory"); SBAR(); \
    o[D0] = __builtin_amdgcn_mfma_scale_f32_32x32x64_f8f6f4((i32x8){(int)va##D0.x, (int)va##D0.y, (int)va##D0.z, (int)va##D0.w, (int)vc##D0.x, (int)vc##D0.y, (int)vc##D0.z, (int)vc##D0.w}, pb, o[D0], 0, 0, 0, 0, 0, 0); } while (0)
__device__ __forceinline__ float max3f(float a, float b, float c) { float r; asm("v_max3_f32 %0, %1, %2, %3" : "=v"(r) : "v"(a), "v"(b), "v"(c)); return r; }
#define PV_LSUM() lacc = __builtin_amdgcn_mfma_scale_f32_32x32x64_f8f6f4((i32x8){0x38383838, 0x38383838, 0x38383838, 0x38383838, 0x38383838, 0x38383838, 0x38383838, 0x38383838}, pb, lacc, 0, 0, 0, 0, 0, 0)
__device__ __forceinline__ void pv_psm(f32x16* o, f32x16& lacc, int vb, i32x8 pb, f32x16& p0, f32x16& p1, float& m_reg, f32x16& negm, float& alpha) {
  float pmax;
  { PV_RD(0);
    pmax = max3f(p0[0], p0[1], p0[2]);
#pragma unroll
    for (int r = 3; r < 15; r += 2) pmax = max3f(pmax, p0[r], p0[r + 1]);
    pmax = max3f(pmax, p0[15], p1[0]);
    SBAR(); PV_MM(0); }
  { PV_RD(1);
#pragma unroll
    for (int r = 1; r < 15; r += 2) pmax = max3f(pmax, p1[r], p1[r + 1]);
    pmax = max3f(pmax, p1[15], p1[15]);
    { auto rr = __builtin_amdgcn_permlane32_swap(__float_as_uint(pmax), __float_as_uint(pmax), false, false);
      pmax = max3f(__uint_as_float(rr[0]), __uint_as_float(rr[1]), __uint_as_float(rr[1])); }
    if (__builtin_expect(__all(pmax <= THR2), 1)) { alpha = 1.f; }
    else { const float dl = fmaxf(pmax - PBIAS, 0.f); alpha = __builtin_amdgcn_exp2f(-dl); m_reg += dl;
#pragma unroll
      for (int r = 0; r < 16; ++r) { p0[r] -= dl; p1[r] -= dl; }
#pragma unroll
      for (int r = 0; r < 16; ++r) negm[r] = -m_reg;
      asm volatile("" : "+v"(negm)); }
    SBAR(); PV_MM(1); }
  { PV_RD(2);
#pragma unroll
    for (int r = 0; r < 8; ++r) p0[r] = __builtin_amdgcn_exp2f(p0[r]);
    asm volatile("" : "+v"(p0));
    SBAR(); PV_MM(2); }
  { PV_RD(3);
#pragma unroll
    for (int r = 8; r < 16; ++r) p0[r] = __builtin_amdgcn_exp2f(p0[r]);
    asm volatile("" : "+v"(p0));
    SBAR(); PV_MM(3); PV_LSUM(); }
}
__device__ __forceinline__ void pvT_d0(f32x16* o, f32x16& lacc, int vb, i32x8 pb) {
  { PV_RD(0); PV_MM(0); } { PV_RD(1); PV_MM(1); } { PV_RD(2); PV_MM(2); } { PV_RD(3); PV_MM(3); PV_LSUM(); }
}
#undef PV_RD
#undef PV_MM
#undef PV_LSUM

__device__ __forceinline__ void attn_unit(const unsigned char* __restrict__ Qb, const unsigned char* __restrict__ Kh, const unsigned char* __restrict__ Vh, bf16_t* __restrict__ Ob,
                                          const float* __restrict__ gsub, const float lam, char* lds, const int wv) {
  typedef __attribute__((address_space(3))) unsigned* ldsu_t;
  const int tid = otid_w(wv), wid = wv, lane = tid & 63, r32 = lane & 31, hi = lane >> 5, mm = wid >> 2, wq = wid & 3;
  constexpr int NB = 4;
  constexpr int SHM_V8 = KVBLK * 128;
  char* V_lds = lds; char* K_lds = lds + NB * SHM_V8; constexpr int SHM_K8 = KVBLK * 128;
  float m_reg = 0.f; f32x16 o[4] = {}; f32x16 lacc = {}; i32x8 qf; f32x16 negm = {}; asm volatile("" : "+v"(negm));
  const unsigned koff = (unsigned)((2 * (wid >> 2) + (lane >> 5)) * 2048 + (lane & 3) * 512 + (8 * ((wid >> 1) & 1) + 2 * ((lane & 31) >> 3) + ((lane >> 2) & 1)) * 32 + (wid & 1) * 16);
  const unsigned voff = (unsigned)((wid >> 1) * 2048 + (lane & 7) * 256 + ((lane >> 3) & 3) * 64 + (wid & 1) * 32 + (lane >> 5) * 16);
#define DMA(t, buf) do { const char* kb_ = (const char*)(Kh + (size_t)(t) * SHM_K8); const char* vb_ = (const char*)(Vh + (size_t)(t) * SHM_V8); asm volatile("" : "+s"(kb_), "+s"(vb_)); \
    __builtin_amdgcn_global_load_lds((const unsigned*)(kb_ + koff), (ldsu_t)(K_lds + (buf) * SHM_K8 + wid * 1024), 16, 0, 0); \
    __builtin_amdgcn_global_load_lds((const unsigned*)(vb_ + voff), (ldsu_t)(V_lds + (buf) * SHM_V8 + wid * 1024), 16, 0, 0); } while (0)
#define WAIT_BAR(N) asm volatile("s_waitcnt vmcnt(" #N ") lgkmcnt(0)\n\ts_barrier" ::: "memory")
#define RESC(a) do { if (__any((a) < 1.f)) { _Pragma("unroll") for (int d = 0; d < 4; ++d) _Pragma("unroll") for (int r = 0; r < 16; ++r) o[d][r] *= (a); lacc[0] *= (a); } } while (0)
  DMA(0, 0); DMA(1, 1);
  { const unsigned char* Qw = Qb + (long)(wq * 32 + r32) * QKW + mm * 64 + hi * 32;
    const u32x4 q0 = *reinterpret_cast<const u32x4*>(Qw), q1 = *reinterpret_cast<const u32x4*>(Qw + 16);
    qf = (i32x8){(int)q0.x, (int)q0.y, (int)q0.z, (int)q0.w, (int)q1.x, (int)q1.y, (int)q1.z, (int)q1.w}; }
  const int vb0 = (int)(uintptr_t)V_lds + lane * 16;
  f32x16 pA0, pA1, pB0, pB1; float alA, alB; i32x8 pb; constexpr int NTL = KVLEN / KVBLK;
  WAIT_BAR(0);
  DMA(2, 2);
  qkt(pA0, pA1, K_lds, qf, lane, mm, negm); partialSM<true>(pA0, pA1, m_reg, negm, alA);
  WAIT_BAR(2);
  for (int j = 1; j + 1 < NTL; j += 2) {
    DMA(j + 2, (j + 2) & 3);
    SBAR(); qkt(pB0, pB1, K_lds + (j & 3) * SHM_K8, qf, lane, mm, negm);
    finishSM_T(pA0, pA1, pb); SBAR();
    pv_psm(o, lacc, vb0 + ((j - 1) & 3) * SHM_V8, pb, pB0, pB1, m_reg, negm, alB);
    RESC(alB);
    WAIT_BAR(2);
    if (j + 3 < NTL) DMA(j + 3, (j + 3) & 3);
    SBAR(); qkt(pA0, pA1, K_lds + ((j + 1) & 3) * SHM_K8, qf, lane, mm, negm);
    finishSM_T(pB0, pB1, pb); SBAR();
    pv_psm(o, lacc, vb0 + (j & 3) * SHM_V8, pb, pA0, pA1, m_reg, negm, alA);
    RESC(alA);
    if (j + 3 < NTL) WAIT_BAR(2); else WAIT_BAR(0);
  }
  SBAR(); qkt(pB0, pB1, K_lds + ((NTL - 1) & 3) * SHM_K8, qf, lane, mm, negm);
  finishSM_T(pA0, pA1, pb); SBAR();
  pv_psm(o, lacc, vb0 + ((NTL - 2) & 3) * SHM_V8, pb, pB0, pB1, m_reg, negm, alB);
  RESC(alB);
  finishSM_T(pB0, pB1, pb); SBAR();
  pvT_d0(o, lacc, vb0 + ((NTL - 1) & 3) * SHM_V8, pb);
#undef DMA
#undef WAIT_BAR
  const float rl = __builtin_amdgcn_rcpf(lacc[0]) * (mm ? lam : 1.0f);
  __syncthreads();
  constexpr int XS = 132;
  float* X = (float*)lds;
  if (mm == 1) {
#pragma unroll
    for (int r = 0; r < 16; ++r)
#pragma unroll
      for (int d0 = 0; d0 < 4; ++d0) X[(wq * 32 + r32) * XS + d0 * 32 + crow(r, hi)] = o[d0][r] * rl;
  }
  __syncthreads();
  if (mm == 0) {
#pragma unroll
    for (int r = 0; r < 16; ++r)
#pragma unroll
      for (int d0 = 0; d0 < 4; ++d0) { float* xp = X + (wq * 32 + r32) * XS + d0 * 32 + crow(r, hi); *xp = o[d0][r] * rl - *xp; }
  }
  __syncthreads();
  {
    const int row = tid >> 2, seg = tid & 3;
    const float* xr = X + row * XS + seg * 32;
    f32x4 v[8]; float ss = 0.f;
#pragma unroll
    for (int i = 0; i < 8; ++i) { v[i] = *(const f32x4*)(xr + 4 * i); ss += v[i][0] * v[i][0] + v[i][1] * v[i][1] + v[i][2] * v[i][2] + v[i][3] * v[i][3]; }
    ss += sx<1>(ss); ss += sx<2>(ss);
    const float rs = (1.0f - LAM_INIT) / sqrtf(ss * (1.0f / 128.0f) + EPS);
    bf16_t* dst = Ob + (long)row * D + seg * 32;
#pragma unroll
    for (int i = 0; i < 8; i += 2) {
      const f32x4 g0 = *(const f32x4*)(gsub + seg * 32 + 4 * i), g1 = *(const f32x4*)(gsub + seg * 32 + 4 * i + 4);
      u32x4 w; w.x = cvtpk(v[i][0] * rs * g0[0], v[i][1] * rs * g0[1]); w.y = cvtpk(v[i][2] * rs * g0[2], v[i][3] * rs * g0[3]);
      w.z = cvtpk(v[i + 1][0] * rs * g1[0], v[i + 1][1] * rs * g1[1]); w.w = cvtpk(v[i + 1][2] * rs * g1[2], v[i + 1][3] * rs * g1[3]);
      *(u32x4*)(dst + 4 * i) = w;
    }
  }
  __syncthreads();
#undef RESC
}
#undef KSWZ
#undef SBAR
}

__device__ __forceinline__ void ph_attn(const Params& p, unsigned char* smem) {
    unsigned char* ws = p.ws;
    const unsigned char* Q = ws + WS_Q; const unsigned char* Kb = ws + WS_K; const unsigned char* Vb = ws + WS_V;
    bf16_t* AO = (bf16_t*)(ws + WS_AO);
    const float lam = ((const float*)(ws + WS_CTL))[1024];
    const int c = blockIdx.x, G = gridDim.x;
    if (G == 256) {
        const int x = c & 7, s = c >> 3;
        for (int rd = 0; rd < 6; ++rd) {
            const int bh = rd * 4 + (x >> 1), qb = (x & 1) * 32 + s, b = bh / NH, h = bh % NH;
            fa::attn_unit(Q + ((size_t)b * SEQ + qb * 128) * QKW + h * 128, Kb + (size_t)(b * NH + h) * (KVLEN / 64) * 8192, Vb + (size_t)(b * NH + h) * (KVLEN / 64) * 8192,
                          AO + ((size_t)b * SEQ + qb * 128) * D + 256 + h * 128, p.in[I_GSUB], lam, (char*)smem, p.chunk);
        }
    } else {
        for (int u = c; u < BATCH * NH * 64; u += G) {
            const int bh = u >> 6, qb = u & 63, b = bh / NH, h = bh % NH;
            fa::attn_unit(Q + ((size_t)b * SEQ + qb * 128) * QKW + h * 128, Kb + (size_t)(b * NH + h) * (KVLEN / 64) * 8192, Vb + (size_t)(b * NH + h) * (KVLEN / 64) * 8192,
                          AO + ((size_t)b * SEQ + qb * 128) * D + 256 + h * 128, p.in[I_GSUB], lam, (char*)smem, p.chunk);
        }
    }
}

__device__ __forceinline__ void ph_fourierA(const Params& p, unsigned char* smem) {
    using namespace fa;
    unsigned char* ws = p.ws;
    const bf16_t* F = (const bf16_t*)(ws + WS_F); bf16_t* FY = (bf16_t*)(ws + WS_FY); const bf16_t* W = (const bf16_t*)(ws + WS_W128E);
    const int tid = otid(), wid = tid >> 6, lane = tid & 63, r32 = lane & 31, hi = lane >> 5;
    const int sr = tid >> 4, sc = (tid & 15) * 8, vst0 = v_st(sr, sc), vst1 = v_st(32 + sr, sc);
    const int vb0 = (int)(uintptr_t)smem + v_rd_base(lane);
    for (int task = blockIdx.x; task < BATCH * 64; task += gridDim.x) {
        const int b = task >> 6, n2 = task & 63;
        bf16x8 st[4][2];
#pragma unroll
        for (int kt = 0; kt < 2; ++kt)
#pragma unroll
            for (int ct = 0; ct < 2; ++ct) {
                st[kt * 2 + ct][0] = *(const bf16x8*)(F + ((size_t)b * SEQ + 64 * (64 * kt + sr) + n2) * 256 + 128 * ct + sc);
                st[kt * 2 + ct][1] = *(const bf16x8*)(F + ((size_t)b * SEQ + 64 * (64 * kt + 32 + sr) + n2) * 256 + 128 * ct + sc);
            }
        bf16x8 pa[2][4];
#pragma unroll
        for (int kt = 0; kt < 2; ++kt)
#pragma unroll
            for (int ks = 0; ks < 4; ++ks) pa[kt][ks] = *(const bf16x8*)(W + (size_t)(32 * wid + r32) * 128 + 64 * kt + 16 * ks + 8 * hi);
        __syncthreads();
#pragma unroll
        for (int q = 0; q < 4; ++q) { *(bf16x8*)(smem + q * 16384 + vst0) = st[q][0]; *(bf16x8*)(smem + q * 16384 + vst1) = st[q][1]; }
        __syncthreads();
        f32x16 o[2][4] = {};
#pragma unroll
        for (int ct = 0; ct < 2; ++ct)
#pragma unroll
            for (int kt = 0; kt < 2; ++kt) pv_d0(o[ct], vb0 + (kt * 2 + ct) * 16384, pa[kt][0], pa[kt][1], pa[kt][2], pa[kt][3]);
        const int plane = wid >> 2;
#pragma unroll
        for (int r = 0; r < 16; ++r) {
            const int k1 = 32 * (wid & 3) + crow(r, hi);
            bf16_t* dst = FY + ((((size_t)plane * BATCH + b) * 128 + k1) * 64 + n2) * 256 + r32;
#pragma unroll
            for (int ct = 0; ct < 2; ++ct)
#pragma unroll
                for (int d0 = 0; d0 < 4; ++d0) dst[128 * ct + 32 * d0] = f2bf(o[ct][d0][r]);
        }
    }
    __syncthreads();
}
__device__ __forceinline__ void ph_fourierB(const Params& p, unsigned char* smem) {
    using namespace fa;
    unsigned char* ws = p.ws;
    const bf16_t* FY = (const bf16_t*)(ws + WS_FY); const float2* tabw = (const float2*)(ws + WS_TABW);
    const bf16_t* M64 = (const bf16_t*)(ws + WS_M64E); const bf16_t* GT = (const bf16_t*)(ws + WS_GT);
    bf16_t* AO = (bf16_t*)(ws + WS_AO);
    const int tid = otid(), wid = tid >> 6, lane = tid & 63, r32 = lane & 31, hi = lane >> 5;
    const int sr = tid >> 4, sc = (tid & 15) * 8, vst0 = v_st(sr, sc), vst1 = v_st(32 + sr, sc);
    const int vb0 = (int)(uintptr_t)smem + v_rd_base(lane);
    constexpr int XRS = 528;
    unsigned char* XL = smem + 65536;
    const int mt = wid & 3, ctw = wid >> 2;
    for (int task = blockIdx.x; task < BATCH * 128; task += gridDim.x) {
        const int b = task >> 7, k1 = task & 127;
        __syncthreads();
#pragma unroll
        for (int ct = 0; ct < 2; ++ct)
#pragma unroll
            for (int rh = 0; rh < 2; ++rh) {
                const int n2 = sr + 32 * rh;
                const size_t off = ((((size_t)b) * 128 + k1) * 64 + n2) * 256 + 128 * ct + sc;
                const uint4 yr = *(const uint4*)(FY + off), yi = *(const uint4*)(FY + (size_t)BATCH * 128 * 64 * 256 + off);
                const float2 tw = tabw[n2 * k1];
                const unsigned yrw[4] = {yr.x, yr.y, yr.z, yr.w}, yiw[4] = {yi.x, yi.y, yi.z, yi.w};
                unsigned zr[4], zi[4];
#pragma unroll
                for (int q = 0; q < 4; ++q) {
                    const float a0 = __uint_as_float(yrw[q] << 16), a1 = __uint_as_float(yrw[q] & 0xffff0000u), b0 = __uint_as_float(yiw[q] << 16), b1 = __uint_as_float(yiw[q] & 0xffff0000u);
                    zr[q] = pk2(a0 * tw.x + b0 * tw.y, a1 * tw.x + b1 * tw.y); zi[q] = pk2(b0 * tw.x - a0 * tw.y, b1 * tw.x - a1 * tw.y);
                }
                const int vs = rh ? vst1 : vst0;
                *(uint4*)(smem + (0 * 2 + ct) * 16384 + vs) = make_uint4(zr[0], zr[1], zr[2], zr[3]);
                *(uint4*)(smem + (1 * 2 + ct) * 16384 + vs) = make_uint4(zi[0], zi[1], zi[2], zi[3]);
            }
        __syncthreads();
        {
            f32x16 o[4] = {};
#pragma unroll
            for (int kt = 0; kt < 2; ++kt) {
                bf16x8 pa[4];
#pragma unroll
                for (int ks = 0; ks < 4; ++ks) pa[ks] = *(const bf16x8*)(M64 + (size_t)(32 * mt + r32) * 128 + 64 * kt + 16 * ks + 8 * hi);
                pv_d0(o, vb0 + (kt * 2 + ctw) * 16384, pa[0], pa[1], pa[2], pa[3]);
            }
#pragma unroll
            for (int r = 0; r < 16; ++r) {
                const int ro = 32 * mt + crow(r, hi);
                bf16_t* xr = (bf16_t*)(XL + ((ro >> 6) * 64 + (ro & 63)) * XRS) + 128 * ctw + r32;
#pragma unroll
                for (int d0 = 0; d0 < 4; ++d0) xr[32 * d0] = f2bf(o[d0][r]);
            }
        }
        __syncthreads();
#pragma unroll
        for (int tt = 0; tt < 2; ++tt) {
            const int tau = 2 * wid + tt, g = tau >> 2, mt2 = (tau >> 1) & 1, nt2 = tau & 1;
            f32x16 acc = {};
#pragma unroll
            for (int ks8 = 0; ks8 < 8; ++ks8) {
                const int part = ks8 >> 2, cb = ks8 & 3;
                const bf16x8 af = *(const bf16x8*)(XL + (part * 64 + 32 * mt2 + r32) * XRS + (g * 64 + 16 * cb + 8 * hi) * 2);
                const bf16x8 bfr = *(const bf16x8*)(GT + ((size_t)g * 64 + 32 * nt2 + r32) * 128 + part * 64 + 16 * cb + 8 * hi);
                acc = __builtin_amdgcn_mfma_f32_32x32x16_bf16(af, bfr, acc, 0, 0, 0);
            }
#pragma unroll
            for (int r = 0; r < 16; ++r) { const int k2 = 32 * mt2 + crow(r, hi);
                AO[((size_t)b * SEQ + k1 + 128 * k2) * D + g * 64 + 32 * nt2 + r32] = f2bf(acc[r]); }
        }
    }
    __syncthreads();
}

__device__ __forceinline__ void ph_mid(const Params& p, unsigned char* smem) {
    typedef short bf16x8 __attribute__((ext_vector_type(8)));
    unsigned char* ws = p.ws;
    const int tid = otid(), wave = tid >> 6, lane = tid & 63, fr = lane & 15, fq = lane >> 4;
    const float* mod = (const float*)(ws + WS_MOD);
    const bf16_t* YX = (const bf16_t*)(ws + WS_YX);
    unsigned char* H2 = ws + WS_H2;
    unsigned* counts = (unsigned*)(ws + WS_CTL);
    int* TE = (int*)(ws + WS_TE); int* TP = (int*)(ws + WS_TP); float* TW = (float*)(ws + WS_TW); int* TOKL = (int*)(ws + WS_TOKL);
    constexpr int RS = 2064;
    unsigned char* Ahi = smem; unsigned char* Alo = smem + 16 * RS; float* Pp = (float*)(smem + 2 * 16 * RS + 512);
    const float rbias = p.in[I_RB][lane];
    int* lcnt = (int*)(smem + 99328); int* gb = lcnt + 64; int* PE = gb + 64; float* PW = (float*)(PE + 1024); float* PV = PW + 1024;
    for (int chunk = blockIdx.x; chunk < T / 128; chunk += gridDim.x) {
      const int mc = chunk * 128, b = mc >> 13;
      if (tid < 64) lcnt[tid] = 0;
      {
          const float* mrow_ = mod + b * 6144;
          for (int i = tid; i < 5 * 256; i += NT) { const int v_ = i >> 8, q_ = (i & 255) * 4;
              const float* s_ = (v_ == 0) ? p.in[I_GAPOST] + q_ : (v_ == 1) ? mrow_ + 2 * 1024 + q_ : (v_ == 2) ? p.in[I_GFPRE] + q_ : (v_ == 3) ? mrow_ + 3 * 1024 + q_ : mrow_ + 4 * 1024 + q_;
              *(f32x4*)(PV + v_ * 1024 + q_) = *(const f32x4*)s_; }
          __syncthreads();
      }
      uint2 yw[2][4]; f32x4 xv[2][4];
#define MID_LOAD(m0_) do { _Pragma("unroll") for (int rr = 0; rr < 2; ++rr) { const int m_ = (m0_) + 2 * wave + rr; _Pragma("unroll") for (int j = 0; j < 4; ++j) { \
          yw[rr][j] = *(const uint2*)(YX + (size_t)m_ * D + 4 * (lane + 64 * j)); xv[rr][j] = ((const f32x4*)(p.in[I_X] + (size_t)m_ * D))[lane + 64 * j]; } } } while (0)
      MID_LOAD(mc);
      for (int it = 0; it < 8; ++it) {
        const int m0 = mc + it * 16;
        {
            float ss[2] = {0.f, 0.f};
#define YV(rr, j, i) ((i) == 0 ? __uint_as_float(yw[rr][j].x << 16) : (i) == 1 ? __uint_as_float(yw[rr][j].x & 0xffff0000u) : (i) == 2 ? __uint_as_float(yw[rr][j].y << 16) : __uint_as_float(yw[rr][j].y & 0xffff0000u))
#pragma unroll
            for (int rr = 0; rr < 2; ++rr) {
#pragma unroll
                for (int j = 0; j < 4; ++j) ss[rr] += YV(rr, j, 0) * YV(rr, j, 0) + YV(rr, j, 1) * YV(rr, j, 1) + YV(rr, j, 2) * YV(rr, j, 2) + YV(rr, j, 3) * YV(rr, j, 3);
                ss[rr] = wave_sum(ss[rr]);
            }
#pragma unroll
            for (int rr = 0; rr < 2; ++rr) {
                const int lr = 2 * wave + rr, m = m0 + lr;
                const float r1 = 1.0f / sqrtf(ss[rr] * (1.0f / D) + EPS);
                float ss2 = 0.f;
#pragma unroll
                for (int j = 0; j < 4; ++j) {
                    const int col = 4 * (lane + 64 * j);
                    const f32x4 gp = *(const f32x4*)(PV + col), gt = *(const f32x4*)(PV + 1024 + col);
#pragma unroll
                    for (int i = 0; i < 4; ++i) { xv[rr][j][i] = xv[rr][j][i] + gt[i] * (YV(rr, j, i) * r1 * gp[i]); ss2 += xv[rr][j][i] * xv[rr][j][i]; }
                    ((f32x4*)(p.out + (size_t)m * D))[lane + 64 * j] = xv[rr][j];
                }
                ss2 = wave_sum(ss2);
                const float r2 = 1.0f / sqrtf(ss2 * (1.0f / D) + EPS);
#pragma unroll
                for (int j = 0; j < 4; ++j) {
                    const int col = 4 * (lane + 64 * j);
                    const f32x4 gp = *(const f32x4*)(PV + 2048 + col), sh = *(const f32x4*)(PV + 3072 + col), sc = *(const f32x4*)(PV + 4096 + col);
                    float h[4]; bf16_t hb[4]; float lo[4];
#pragma unroll
                    for (int i = 0; i < 4; ++i) { h[i] = xv[rr][j][i] * r2 * gp[i] * (1.f + sc[i]) + sh[i]; hb[i] = f2bf(h[i]); lo[i] = h[i] - bf2f(hb[i]); }
                    uint2 o; o.x = (unsigned)hb[0] | ((unsigned)hb[1] << 16); o.y = (unsigned)hb[2] | ((unsigned)hb[3] << 16);
                    { int w8 = __builtin_amdgcn_cvt_pk_fp8_f32(h[0], h[1], 0, false); w8 = __builtin_amdgcn_cvt_pk_fp8_f32(h[2], h[3], w8, true); *(int*)(H2 + (size_t)m * D + col) = w8; }
                    *(uint2*)(Ahi + lr * RS + col * 2) = o;
                    uint2 ol; ol.x = pk2(lo[0], lo[1]); ol.y = pk2(lo[2], lo[3]);
                    *(uint2*)(Alo + lr * RS + col * 2) = ol;
                }
            }
            if (it < 7) MID_LOAD(m0 + 16);
        }
        asm volatile("s_waitcnt lgkmcnt(0)\n\ts_barrier" ::: "memory");
        {
            f32x4 acc[4];
#pragma unroll
            for (int nb = 0; nb < 4; ++nb) acc[nb] = (f32x4){0.f, 0.f, 0.f, 0.f};
            const bf16_t* wrtlo = (const bf16_t*)(ws + WS_WRT); asm volatile("" : "+s"(wrtlo));
#pragma unroll
            for (int ks = 0; ks < 4; ++ks) {
                const int ko = (wave * 128 + ks * 32 + 8 * fq) * 2;
                const bf16x8 ah = *(const bf16x8*)(Ahi + fr * RS + ko), al = *(const bf16x8*)(Alo + fr * RS + ko);
#pragma unroll
                for (int nb = 0; nb < 4; ++nb) {
                    const size_t wo_ = ((size_t)(((wave * 4 + ks) * 4 + nb) * 2) * 64 + lane) * 8;
                    const bf16x8 bhv = *(const bf16x8*)(wrtlo + wo_), bl = *(const bf16x8*)(wrtlo + wo_ + 512);
                    acc[nb] = __builtin_amdgcn_mfma_f32_16x16x32_bf16(ah, bhv, acc[nb], 0, 0, 0);
                    acc[nb] = __builtin_amdgcn_mfma_f32_16x16x32_bf16(ah, bl, acc[nb], 0, 0, 0);
                    acc[nb] = __builtin_amdgcn_mfma_f32_16x16x32_bf16(al, bhv, acc[nb], 0, 0, 0);
                }
            }
#pragma unroll
            for (int nb = 0; nb < 4; ++nb)
#pragma unroll
                for (int j = 0; j < 4; ++j) Pp[(wave * 16 + 4 * fq + j) * 64 + 16 * nb + fr] = acc[nb][j];
        }
        asm volatile("s_waitcnt lgkmcnt(0)\n\ts_barrier" ::: "memory");
#pragma unroll
        for (int rr = 0; rr < 2; ++rr) {
            const int lr = 2 * wave + rr;
            float lg = 0.f;
#pragma unroll
            for (int w = 0; w < 8; ++w) lg += Pp[(w * 16 + lr) * 64 + lane];
            const float score = 1.0f / (1.0f + expf(-lg));
            const float sel = score + rbias;
            float t1 = sel, t2 = -INFINITY;
#define TOP2(M) do { const float o1 = sx<M>(t1), o2 = sx<M>(t2); const float n1 = fmaxf(t1, o1), n2 = fmaxf(fminf(t1, o1), fmaxf(t2, o2)); t1 = n1; t2 = n2; } while (0)
            TOP2(1); TOP2(2); TOP2(4);
#undef TOP2
            const float gs = t1 + t2; const int grp = lane >> 3;
            int gr = 0;
#pragma unroll
            for (int j = 0; j < 8; ++j) { const float sj = __uint_as_float(__builtin_amdgcn_readlane(__float_as_uint(gs), j * 8)); gr += (sj > gs || (sj == gs && j < grp)) ? 1 : 0; }
            const bool gsel = gr < 4;
            float v = gsel ? sel : -INFINITY;
            int rk = TOPK;
#pragma unroll
            for (int it8 = 0; it8 < TOPK; ++it8) {
                const float mx = wave_max(v);
                const unsigned long long eq = __ballot(v == mx);
                const int win = __builtin_ctzll(eq);
                if (lane == win) { rk = it8; v = -INFINITY; }
            }
            const bool chosen = rk < TOPK;
            const float ssum = wave_sum(chosen ? score : 0.f);
            const float w = score / (ssum + 1e-20f) * 2.5f;
            if (chosen) {
                const int lpos = atomicAdd(&lcnt[lane], 1);
                const int idx = (it * 16 + lr) * 8 + rk;
                PE[idx] = lane | (lpos << 8); PW[idx] = w;
            }
        }
      }
      __syncthreads();
      if (tid < 64) { const int c = lcnt[tid]; gb[tid] = c ? (int)atomicAdd(&counts[b * 65 + tid], (unsigned)c) : 0; }
      __syncthreads();
      for (int i = tid; i < 1024; i += NT) {
          const int pe = PE[i], e = pe & 255, pos = gb[e] + (pe >> 8), mk = mc * 8 + i;
          TOKL[((size_t)b * 64 + e) * 8192 + pos] = mk; TE[mk] = e; TP[mk] = pos; TW[mk] = PW[i];
      }
      __syncthreads();
    }
}

constexpr int T_CNT = 0;
constexpr int T_TOT = 256;
constexpr int T_AB = 328;
constexpr int T_OFF = 400;
constexpr int T_GUP = 660;
constexpr int T_YC = 730;
constexpr int T_YB = 990;
constexpr int T_DUP = 1250;
constexpr int T_UL = 1520;
constexpr int T_END = 1520 + 512;
__device__ __forceinline__ int scan_incl(int v, int lane) {
#pragma unroll
    for (int off = 1; off < 64; off <<= 1) { const int t = __builtin_amdgcn_ds_bpermute(((lane - off) & 63) << 2, v); if (lane >= off) v += t; }
    return v;
}
__device__ __forceinline__ void build_moe(const Params& p, int* tab) {
    const unsigned* counts = (const unsigned*)(p.ws + WS_CTL);
    __syncthreads();
    const int tid = otid(), wave = tid >> 6, lane = tid & 63;
    if (wave == 0) {
        const int c0 = (int)counts[0 * 65 + lane], c1 = (int)counts[1 * 65 + lane], c2 = (int)counts[2 * 65 + lane], c3 = (int)counts[3 * 65 + lane];
        tab[T_CNT + 0 * 64 + lane] = c0; tab[T_CNT + 1 * 64 + lane] = c1; tab[T_CNT + 2 * 64 + lane] = c2; tab[T_CNT + 3 * 64 + lane] = c3;
        tab[T_OFF + lane * 4 + 0] = 0; tab[T_OFF + lane * 4 + 1] = c0; tab[T_OFF + lane * 4 + 2] = c0 + c1; tab[T_OFF + lane * 4 + 3] = c0 + c1 + c2;
        const int tot = c0 + c1 + c2 + c3, pad = (tot + 255) & ~255, gu = ((tot + 255) >> 8) * 2;
        const int sp = scan_incl(pad, lane), sg = scan_incl(gu, lane);
        tab[T_TOT + lane] = tot; tab[T_AB + lane] = sp - pad; tab[T_GUP + lane] = sg - gu;
        const int cb[4] = {c0, c1, c2, c3};
#pragma unroll
        for (int b = 0; b < 4; ++b) {
            const int du = ((cb[b] + 255) >> 8) * 4;
            const int sy = scan_incl(cb[b], lane), sd = scan_incl(du, lane);
            tab[T_YB + 65 * b + lane] = sy - cb[b]; tab[T_DUP + 66 * b + lane] = sd - du;
            if (lane == 63) { tab[T_YB + 65 * b + 64] = sy; tab[T_DUP + 66 * b + 64] = sd; tab[T_DUP + 66 * b + 65] = sd + (SEQ / 256) * 4; }
        }
        if (lane == 63) { tab[T_TOT + 64] = T; tab[T_AB + 64] = sp; tab[T_GUP + 64] = sg; tab[T_GUP + 65] = sg + (T / 256) * 2; }
    }
    __syncthreads();
}

__device__ __forceinline__ void moe_decode(const GP_LAS int* tab, int e, int pos_e, int& b, int& pos) {
    const int o1 = tab[T_OFF + e * 4 + 1], o2 = tab[T_OFF + e * 4 + 2], o3 = tab[T_OFF + e * 4 + 3];
    b = (pos_e >= o1 ? 1 : 0) + (pos_e >= o2 ? 1 : 0) + (pos_e >= o3 ? 1 : 0);
    pos = pos_e - (b == 0 ? 0 : (b == 1 ? o1 : (b == 2 ? o2 : o3)));
}
__device__ __forceinline__ int yrow0(int b) { return b == 0 ? 2 * 1024 : (272 + 72 * (b - 1)) * 1024; }
struct MoeSched {
    const GP_LAS int* tab; int G, c, ntn, U, down, chunk; const int* TOKL; const char* Bt;
    __device__ __forceinline__ void prepare(int* tabw, int wv) const {
        if (wv == 0) {
            const int i = lane_id(); int L = i * G + c;
            if (L < U) {
                int bt = 0;
                if (down) {
#pragma unroll
                    for (int q = 0; q < 3; ++q) { const int u0 = tabw[T_DUP + 66 * bt + 65]; if (L >= u0) { L -= u0; ++bt; } } }
                const int pre = down ? T_DUP + 66 * bt : T_GUP;
                int lo = 0, hi = 64;
                while (lo < hi) { const int mid = (lo + hi + 1) >> 1; if (tabw[pre + mid] <= L) lo = mid; else hi = mid - 1; }
                const int loc = L - tabw[pre + lo];
                int cnt, base, bb;
                if (down) { cnt = (lo < 64) ? tabw[T_CNT + bt * 64 + (lo & 63)] : SEQ; base = tabw[T_YB + 65 * bt + lo] + yrow0(bt);
                            bb = tabw[T_AB + lo] + (lo < 64 ? tabw[T_OFF + (lo & 63) * 4 + bt] : bt * SEQ); }
                else { cnt = tabw[T_TOT + lo]; base = tabw[T_AB + lo]; bb = 0; }
                int* ul = tabw + T_UL + 8 * i;
                ul[0] = lo; ul[1] = loc / ntn; ul[2] = loc % ntn; ul[3] = cnt; ul[4] = base; ul[5] = bb;
            }
        }
        __syncthreads();
    }
    __device__ __forceinline__ bool next(int i, gp::Unit& u) const {
        if (i * G + c >= U) return false;
        const GP_LAS int* ul = tab + T_UL + 8 * i;
        u.e = __builtin_amdgcn_readfirstlane(ul[0]); u.pm = __builtin_amdgcn_readfirstlane(ul[1]); u.pn = __builtin_amdgcn_readfirstlane(ul[2]);
        u.cnt = __builtin_amdgcn_readfirstlane(ul[3]); u.base = __builtin_amdgcn_readfirstlane(ul[4]); u.b = __builtin_amdgcn_readfirstlane(ul[5]);
        return true;
    }
    __device__ __forceinline__ unsigned arow(const gp::Unit& u, int r) const {
        const int pos_e = u.pm * 256 + r;
        if (down) return (unsigned)(u.b + pos_e) * 256u;
        int tok;
        if (u.e < 64) { int b, pos; moe_decode(tab, u.e, pos_e, b, pos); tok = (pos_e < u.cnt) ? (TOKL[((size_t)b * 64 + u.e) * 8192 + pos] >> 3) : 0; } else tok = pos_e;
        return (unsigned)tok * 1024u;
    }
    __device__ __forceinline__ const char* bptr(const gp::Unit& u) const {
        return down ? Bt + ((size_t)u.e * 1024 + u.pn * 256) * 256 : Bt + ((size_t)u.e * 512 + u.pn * 256) * 1024;
    }
};
struct EpiGU {
    unsigned char* ACT; const int* TOKL; const float* TW; const GP_LAS int* tab;
    __device__ __forceinline__ void operator()(const f32x4 (&acc)[2][2][4][2], const gp::Unit& u, int wr, int wc, int fr, int fq) const {
#pragma unroll
        for (int ai = 0; ai < 2; ++ai)
#pragma unroll
            for (int m = 0; m < 4; ++m) {
                const int pos_e = u.pm * 256 + ai * 128 + wr * 64 + m * 16 + fr;
                if (pos_e < u.cnt) {
                    float w = 1.0f;
                    if (u.e < 64) { int b, pos; moe_decode(tab, u.e, pos_e, b, pos); w = TW[TOKL[((size_t)b * 64 + u.e) * 8192 + pos]]; }
                    float a[8];
#pragma unroll
                    for (int n = 0; n < 2; ++n)
#pragma unroll
                        for (int i = 0; i < 4; ++i) { const float g = acc[ai][0][m][n][i] * (1.f / GUSCALE), up = acc[ai][1][m][n][i] * (1.f / GUSCALE);
                            a[4 * n + i] = __builtin_amdgcn_fmed3f(g * __builtin_amdgcn_rcpf(1.0f + __builtin_amdgcn_exp2f(-1.4426950408889634f * g)) * up * (w * ASCALE), -448.f, 448.f); }
                    int w0 = __builtin_amdgcn_cvt_pk_fp8_f32(a[0], a[1], 0, false); w0 = __builtin_amdgcn_cvt_pk_fp8_f32(a[2], a[3], w0, true);
                    int w1 = __builtin_amdgcn_cvt_pk_fp8_f32(a[4], a[5], 0, false); w1 = __builtin_amdgcn_cvt_pk_fp8_f32(a[6], a[7], w1, true);
                    uint2 o; o.x = (unsigned)w0; o.y = (unsigned)w1;
                    *(uint2*)(ACT + ((size_t)u.base + pos_e) * DE + u.pn * 128 + wc * 32 + fq * 8) = o;
                }
            }
    }
};
constexpr float YSCALE = 16.f;
struct EpiDown {
    unsigned char* ws;
    __device__ __forceinline__ void operator()(const f32x4 (&acc)[2][2][4][2], const gp::Unit& u, int wr, int wc, int fr, int fq) const {
#pragma unroll
        for (int ai = 0; ai < 2; ++ai)
#pragma unroll
            for (int m = 0; m < 4; ++m) {
                const int pos = u.pm * 256 + ai * 128 + wr * 64 + m * 16 + fr;
                if (pos < u.cnt) {
                    unsigned char* rowp = ws + (size_t)(u.base + pos) * D + u.pn * 256 + wc * 32 + fq * 8;
#pragma unroll
                    for (int bj = 0; bj < 2; ++bj) { const f32x4 v0 = acc[ai][bj][m][0] * (YSCALE / (WDSCALE * ASCALE)), v1 = acc[ai][bj][m][1] * (YSCALE / (WDSCALE * ASCALE));
                        int w0 = __builtin_amdgcn_cvt_pk_fp8_f32(v0[0], v0[1], 0, false); w0 = __builtin_amdgcn_cvt_pk_fp8_f32(v0[2], v0[3], w0, true);
                        int w1 = __builtin_amdgcn_cvt_pk_fp8_f32(v1[0], v1[1], 0, false); w1 = __builtin_amdgcn_cvt_pk_fp8_f32(v1[2], v1[3], w1, true);
                        uint2 o; o.x = (unsigned)w0; o.y = (unsigned)w1;
                        *(uint2*)(rowp + bj * 128) = o; }
                }
            }
    }
};
__device__ __forceinline__ void ph_moe_gu(const Params& p, unsigned char* smem) {
    unsigned char* ws = p.ws;
    int* tab = (int*)(smem + gp::STAGE_BYTES);
    build_moe(p, tab);
    MoeSched S; S.tab = (const GP_LAS int*)tab; S.G = gridDim.x; S.c = (gridDim.x % 8 == 0) ? (int)((blockIdx.x % 8) * (gridDim.x / 8) + blockIdx.x / 8) : (int)blockIdx.x;   S.ntn = 2; S.U = __builtin_amdgcn_readfirstlane(tab[T_GUP + 65]); S.down = 0; S.chunk = 0;
    S.TOKL = (const int*)(ws + WS_TOKL); S.Bt = (const char*)(ws + WS_WGUT);
    S.prepare(tab, p.chunk);
    EpiGU E{ws + WS_ACT, (const int*)(ws + WS_TOKL), (const float*)(ws + WS_TW), (const GP_LAS int*)tab};
    gp::gemm_phase<EpiGU, MoeSched, true, true>(p.chunk, (GP_LAS unsigned char*)smem, (const char*)(ws + WS_H2), D / 2, S, E);
}
__device__ __forceinline__ void ph_moe_down(const Params& p, unsigned char* smem, int c) {
    unsigned char* ws = p.ws;
    int* tab = (int*)(smem + gp::STAGE_BYTES);
    build_moe(p, tab);
    MoeSched S; S.tab = (const GP_LAS int*)tab; S.G = gridDim.x; S.c = (gridDim.x % 8 == 0) ? (int)((blockIdx.x % 8) * (gridDim.x / 8) + blockIdx.x / 8) : (int)blockIdx.x;   S.ntn = 4; S.U = __builtin_amdgcn_readfirstlane(tab[T_DUP + 65] + tab[T_DUP + 66 + 65] + tab[T_DUP + 132 + 65] + tab[T_DUP + 198 + 65]); S.down = 1; S.chunk = c;
    S.TOKL = nullptr; S.Bt = (const char*)(ws + WS_WDT);
    S.prepare(tab, p.chunk);
    EpiDown E{ws};
    gp::gemm_phase<EpiDown, MoeSched, false, true>(p.chunk, (GP_LAS unsigned char*)smem, (const char*)(ws + WS_ACT), DE / 2, S, E);
}

__device__ __forceinline__ void ph_final(const Params& p, float* lds) {
    unsigned char* ws = p.ws;
    int* tab = (int*)lds;
    build_moe(p, tab);
    const int tid = otid(), wave = tid >> 6, lane = tid & 63;
    const int gw = blockIdx.x * NWV + wave, GW = gridDim.x * NWV;
    const int* TE = (const int*)(ws + WS_TE); const int* TP = (const int*)(ws + WS_TP);
    const unsigned char* Y = ws;
    for (int m = gw; m < T; m += GW) {
        const int b = m >> 13, t = m & (SEQ - 1);
        const float* mod = (const float*)(ws + WS_MOD) + b * 6144 + 5 * 1024;
        float acc[16];
#pragma unroll
        for (int i = 0; i < 16; ++i) acc[i] = 0.f;
#pragma unroll
        for (int k = 0; k < 9; ++k) {
            int row;
            if (k < 8) { const int e = TE[m * 8 + k]; row = tab[T_YB + 65 * b + e] + TP[m * 8 + k]; }
            else row = tab[T_YB + 65 * b + 64] + t;
            row += yrow0(b);
            const unsigned char* yr = Y + (size_t)row * D;
#pragma unroll
            for (int j = 0; j < 4; ++j) { const int w = *(const int*)(yr + 4 * (lane + 64 * j));
                acc[4 * j] += __builtin_amdgcn_cvt_f32_fp8(w, 0); acc[4 * j + 1] += __builtin_amdgcn_cvt_f32_fp8(w, 1); acc[4 * j + 2] += __builtin_amdgcn_cvt_f32_fp8(w, 2); acc[4 * j + 3] += __builtin_amdgcn_cvt_f32_fp8(w, 3); }
        }
        float ss = 0.f;
#pragma unroll
        for (int i = 0; i < 16; ++i) { acc[i] *= (1.f / YSCALE); ss += acc[i] * acc[i]; }
        ss = wave_sum(ss);
        const float rs = 1.0f / sqrtf(ss * (1.0f / D) + EPS);
#pragma unroll
        for (int j = 0; j < 4; ++j) {
            const int col = 4 * (lane + 64 * j);
            const f32x4 gp = *(const f32x4*)(p.in[I_GFPOST] + col), gt = *(const f32x4*)(mod + col);
            f32x4 x1 = ((const f32x4*)(p.out + (size_t)m * D))[lane + 64 * j];
#pragma unroll
            for (int i = 0; i < 4; ++i) x1[i] += gt[i] * (acc[4 * j + i] * rs * gp[i]);
            ((f32x4*)(p.out + (size_t)m * D))[lane + 64 * j] = x1;
        }
    }
}

#define GAS __attribute__((address_space(1)))
#define LAS __attribute__((address_space(3)))
#define XB_TMO      128
#define XB_XCNT(j)  (256  + 64 * (j))
#define XB_XSUB(j)  (1280 + 64 * (j))
#define XB_XGEN(j)  (2304 + 64 * (j))
#define XB_TOP      3328
#define XB_TOPGEN   3392
#define XCD_BAR_WORDS 3456
#define XB_SPIN_CAP (1u << 21)
__device__ __forceinline__ unsigned xb_ld(unsigned* p)              { return __hip_atomic_load(p, __ATOMIC_RELAXED, __HIP_MEMORY_SCOPE_AGENT); }
__device__ __forceinline__ unsigned xb_add(unsigned* p, unsigned v) { return __hip_atomic_fetch_add(p, v, __ATOMIC_RELAXED, __HIP_MEMORY_SCOPE_AGENT); }
__device__ __forceinline__ unsigned xb_xcc_id() { return (unsigned)__builtin_amdgcn_s_getreg((3 << 11) | 20) & 0xFu; }
#define XB_SPIN(cond, bar) do { unsigned _sp = 0; while (cond) { __builtin_amdgcn_s_sleep(1); \
    if ((++_sp & 255u) == 0u) { if (xb_ld(&(bar)[XB_TMO])) break; if (_sp > XB_SPIN_CAP) { atomicAdd(&(bar)[XB_TMO], 1u); break; } } } } while (0)
struct XcdBarrier { unsigned* bar; unsigned x; volatile LAS unsigned* st; };
__device__ __forceinline__ XcdBarrier xcd_barrier_post(unsigned* bar, volatile LAS unsigned* st, int wv) {
    XcdBarrier b; b.bar = bar; b.x = xb_xcc_id(); b.st = st;
    if (wv == 0 && lane_id() == 0) (void)xb_add(&bar[XB_XCNT(b.x)], 1u);
    return b;
}
__device__ __forceinline__ void xcd_barrier_complete(unsigned* bar, unsigned x, unsigned& nloc, unsigned& nx) {
    const unsigned G = gridDim.x * gridDim.y * gridDim.z;
    unsigned sum, cnt, mine, sp = 0u;
    for (;;) {
        sum = 0u; cnt = 0u; mine = 0u;
#pragma unroll
        for (unsigned j = 0; j < 16; ++j) { const unsigned c = xb_ld(&bar[XB_XCNT(j)]); sum += c; cnt += (c > 0u) ? 1u : 0u; mine = (j == x) ? c : mine; }
        if (sum == G) break;
        __builtin_amdgcn_s_sleep(1);
        if ((++sp & 255u) == 0u) { if (xb_ld(&bar[XB_TMO])) break; if (sp > XB_SPIN_CAP) { atomicAdd(&bar[XB_TMO], 1u); break; } }
    }
    nloc = mine > 0u ? mine : 1u; nx = cnt > 0u ? cnt : 1u;
}
__device__ __forceinline__ void xcd_barrier(const XcdBarrier& b, int wv) {
    asm volatile("s_waitcnt vmcnt(0)" ::: "memory");
    __syncthreads();
    if (wv == 0 && lane_id() == 0) {
        unsigned* bar = b.bar;
        __builtin_amdgcn_s_waitcnt(0);
        unsigned nloc = b.st[0], nx = b.st[1];
        if (nloc == 0u) { xcd_barrier_complete(bar, b.x, nloc, nx); b.st[0] = nloc; b.st[1] = nx; }
        const unsigned old = xb_add(&bar[XB_XSUB(b.x)], 1u);
        const unsigned gen = old / nloc;
        if (old + 1u == (gen + 1u) * nloc) {
            __builtin_amdgcn_fence(__ATOMIC_RELEASE, "agent");
            asm volatile("s_waitcnt vmcnt(0)" ::: "memory");
            const unsigned og = xb_add(&bar[XB_TOP], 1u);
            const unsigned tg = og / nx;
            if (og + 1u == (tg + 1u) * nx) xb_add(&bar[XB_TOPGEN], 1u);
            else XB_SPIN(xb_ld(&bar[XB_TOPGEN]) == tg, bar);
            __builtin_amdgcn_fence(__ATOMIC_ACQUIRE, "agent");
            xb_add(&bar[XB_XGEN(b.x)], 1u);
            asm volatile("s_waitcnt vmcnt(0)" ::: "memory");
        } else {
            XB_SPIN(xb_ld(&bar[XB_XGEN(b.x)]) == gen, bar);
            __builtin_amdgcn_fence(__ATOMIC_ACQUIRE, "agent");
            asm volatile("s_waitcnt vmcnt(0)" ::: "memory");
        }
    }
    __syncthreads();
}

namespace cg = cooperative_groups;
constexpr int LDS_BYTES = 144 * 1024;
typedef const __attribute__((address_space(4))) Params* KP;
__device__ __forceinline__ Params kargs() {
    Params p;
#if defined(__HIP_DEVICE_COMPILE__)
    typedef const __attribute__((address_space(4))) unsigned long long* KQ;
    KQ kq = (KQ)__builtin_amdgcn_kernarg_segment_ptr(); asm volatile("" : "+s"(kq));
    unsigned long long* d = (unsigned long long*)&p;
#pragma unroll
    for (int i = 0; i < (int)(sizeof(Params) / 8); ++i) d[i] = kq[i];
#endif
    return p;
}
#define PH(call) do { Params p = kargs(); p.chunk = wv; call; } while (0)
__global__ void __launch_bounds__(NT) mega_fwd(Params p_unused) {
    extern __shared__ __attribute__((aligned(16))) unsigned char smem[];
    float* lds = (float*)smem;
    volatile LAS unsigned* misc = (volatile LAS unsigned*)((LAS unsigned char*)smem + (LDS_BYTES - 64));
    if (threadIdx.x < 16) misc[threadIdx.x] = 0u;
    __syncthreads();
    unsigned* barw; { const Params p = kargs(); barw = (unsigned*)(p.ws + WS_CTL) + 4096; }
    const int wv = __builtin_amdgcn_readfirstlane(threadIdx.x >> 6);
    const XcdBarrier bar = xcd_barrier_post(barw, misc, wv);
#define SYNC() xcd_barrier(bar, wv)
    PH(ph_prep(p, lds)); PH(ph_prep_weights(p, lds, 0, 0));   SYNC();
    PH(ph_norm1(p));                SYNC();
    PH(ph_inproj(p, smem)); PH(ph_prep_weights(p, lds, 1, (MTOT / 256) * (INW / 256) % (int)gridDim.x));         SYNC();
    PH(ph_attn(p, smem)); PH(ph_fourierA(p, smem));  SYNC();
    PH(ph_fourierB(p, smem));       SYNC();
    PH(ph_outproj(p, smem));        SYNC();
    PH(ph_mid(p, smem));            SYNC();
    PH(ph_moe_gu(p, smem));         SYNC();
#pragma unroll 1
    PH(ph_moe_down(p, smem, 0));    SYNC();
    PH(ph_final(p, lds));
#undef SYNC
}

extern "C" void kernel_launch(void* const* d_in, const int* in_sizes, int n_in, void* d_out, int out_size, void* d_ws, size_t ws_size, hipStream_t stream) {
    if (n_in != 26 || ws_size < WS_END) { fprintf(stderr, "kernel_launch: unexpected n_in %d / ws %zu\n", n_in, ws_size); return; }
    static int grid_blocks = 0;
    if (!grid_blocks) {
        int dev = 0, cus = 0, per_cu = 0;
        (void)hipGetDevice(&dev);
        (void)hipDeviceGetAttribute(&cus, hipDeviceAttributeMultiprocessorCount, dev);
        (void)hipFuncSetAttribute((const void*)mega_fwd, hipFuncAttributeMaxDynamicSharedMemorySize, LDS_BYTES);
        (void)hipOccupancyMaxActiveBlocksPerMultiprocessor(&per_cu, (const void*)mega_fwd, NT, LDS_BYTES);
        if (per_cu < 1) { fprintf(stderr, "kernel_launch: occupancy query says %d blocks/CU\n", per_cu); per_cu = 1; }
        if (per_cu > 1) per_cu = 1;
        grid_blocks = cus * per_cu;
    }
    Params p{};
    for (int i = 0; i < 26; ++i) p.in[i] = (const float*)d_in[i];
    p.out = (float*)d_out; p.ws = (unsigned char*)d_ws; p.chunk = 0; p.pad = 0;
    (void)hipMemsetAsync((char*)d_ws + WS_CTL, 0, 32768, stream);
    void* args[] = {&p};
    hipError_t e = hipLaunchCooperativeKernel((const void*)mega_fwd, dim3(grid_blocks), dim3(NT), args, LDS_BYTES, stream);
    if (e != hipSuccess) fprintf(stderr, "cooperative launch failed: %s (grid %d)\n", hipGetErrorString(e), grid_blocks);
}
```

```cpp
#include <hip/hip_runtime.h>
#include <hip/hip_cooperative_groups.h>
#include <cstdio>
#include <cstdint>

typedef unsigned short bf16_t;
typedef float f32x4 __attribute__((ext_vector_type(4)));

constexpr int D = 1024, BATCH = 4, SEQ = 8192, T = BATCH * SEQ, CTX = 256, TC = BATCH * CTX;
constexpr int MTOT = T + TC;
constexpr int KVLEN = CTX + SEQ;
constexpr int INW = 2560, NH = 6, QKW = 768, FW = 256;
constexpr int NE = 64, DE = 256, TOPK = 8;
constexpr int NT = 512, NWV = 8;
constexpr int SLOTS_B = 90112;
constexpr float EPS = 1e-6f;
constexpr float LAM_INIT = 0.2f;
constexpr float QSCALE = 0.125f * 1.4426950408889634f;
constexpr float SQS = 0.42466090014400953f;

constexpr size_t MiB = 1u << 20;
constexpr size_t WS_CTL = 0;
constexpr size_t WS_MOD = 1 * MiB;
constexpr size_t WS_TABW = WS_MOD + 128 * 1024;
constexpr size_t WS_ROPE = WS_MOD + 192 * 1024;
constexpr size_t WS_GCS = WS_MOD + 256 * 1024;
constexpr size_t WS_W128E = WS_MOD + 768 * 1024;
constexpr size_t WS_M64E = WS_MOD + 832 * 1024;
constexpr size_t WS_GT = WS_MOD + 864 * 1024;
constexpr size_t WS_WRT = WS_MOD + 512 * 1024;
constexpr size_t WS_WINT = 2 * MiB;
constexpr size_t WS_WOUTT = 7 * MiB;
constexpr size_t WS_WGUT = 9 * MiB;
constexpr size_t WS_WDT = 74 * MiB;
constexpr size_t WS_TE = 107 * MiB;
constexpr size_t WS_TP = 108 * MiB;
constexpr size_t WS_TW = 109 * MiB;
constexpr size_t WS_TOKL = 110 * MiB;
constexpr size_t WS_AO = 118 * MiB;
constexpr size_t WS_ACT = 118 * MiB;
constexpr size_t WS_Q = 182 * MiB;
constexpr size_t WS_K = 230 * MiB;
constexpr size_t WS_V = WS_K + (size_t)BATCH * KVLEN * QKW * 2;
constexpr size_t WS_F = 329 * MiB;
constexpr size_t WS_FY = 361 * MiB;
constexpr size_t WS_HX = 425 * MiB;
constexpr size_t WS_YX = 358 * MiB;
constexpr size_t WS_H2 = 294 * MiB;
constexpr size_t WS_Y = 294 * MiB;
constexpr size_t WS_END = 491 * MiB;

struct Params {
    const float* in[26];
    float* out;
    unsigned char* ws;
    int chunk;
    int pad;
};
enum { I_X = 0, I_C, I_CTX, I_CCTX, I_WMOD, I_BMOD, I_GAPRE, I_GAPOST, I_WIN, I_WF, I_LQ1, I_LK1, I_LQ2, I_LK2, I_GSUB, I_WOUT,
       I_GFPRE, I_GFPOST, I_WR, I_RB, I_WG, I_WU, I_WD, I_WSG, I_WSU, I_WSD };

__device__ __forceinline__ float bf2f(bf16_t v) { return __uint_as_float(((unsigned)v) << 16); }
__device__ __forceinline__ bf16_t f2bf(float f) { unsigned u = __float_as_uint(f); return (bf16_t)((u + 0x7fffu + ((u >> 16) & 1u)) >> 16); }
__device__ __forceinline__ unsigned pk2(float lo, float hi) { return (unsigned)f2bf(lo) | ((unsigned)f2bf(hi) << 16); }
template <int M> __device__ __forceinline__ float sx(float v) { return __int_as_float(__builtin_amdgcn_ds_swizzle(__float_as_int(v), (M << 10) | 0x1f)); }
template <int M> __device__ __forceinline__ int sxi(int v) { return __builtin_amdgcn_ds_swizzle(v, (M << 10) | 0x1f); }
__device__ __forceinline__ float wave_sum(float v) {
    v += sx<1>(v); v += sx<2>(v); v += sx<4>(v); v += sx<8>(v); v += sx<16>(v);
    auto rr = __builtin_amdgcn_permlane32_swap(__float_as_uint(v), __float_as_uint(v), false, false);
    return __uint_as_float(rr[0]) + __uint_as_float(rr[1]);
}
__device__ __forceinline__ float dpp_f(float v, const int ctrl_sel) {
    const int x = __float_as_int(v); int r;
    if (ctrl_sel == 0) r = __builtin_amdgcn_update_dpp(x, x, 0xB1, 0xf, 0xf, false);
    else if (ctrl_sel == 1) r = __builtin_amdgcn_update_dpp(x, x, 0x4E, 0xf, 0xf, false);
    else if (ctrl_sel == 2) r = __builtin_amdgcn_update_dpp(x, x, 0x141, 0xf, 0xf, false);
    else r = __builtin_amdgcn_update_dpp(x, x, 0x140, 0xf, 0xf, false);
    return __int_as_float(r);
}
__device__ __forceinline__ float wave_max(float v) {
    v = fmaxf(v, dpp_f(v, 0)); v = fmaxf(v, dpp_f(v, 1)); v = fmaxf(v, dpp_f(v, 2)); v = fmaxf(v, dpp_f(v, 3));
    const float a = __uint_as_float(__builtin_amdgcn_readlane(__float_as_uint(v), 0)), b = __uint_as_float(__builtin_amdgcn_readlane(__float_as_uint(v), 16));
    const float c = __uint_as_float(__builtin_amdgcn_readlane(__float_as_uint(v), 32)), d = __uint_as_float(__builtin_amdgcn_readlane(__float_as_uint(v), 48));
    return fmaxf(fmaxf(a, b), fmaxf(c, d));
}
__device__ __forceinline__ int lane_id() { int l; asm volatile("v_mbcnt_lo_u32_b32 %0, -1, 0\n\tv_mbcnt_hi_u32_b32 %0, -1, %0" : "=v"(l)); return l; }
__device__ __forceinline__ int otid_w(int wv) { return wv * 64 + lane_id(); }
#define otid() otid_w(p.chunk)
__device__ __forceinline__ float silu_f(float x) { return x / (1.f + expf(-x)); }

__device__ __forceinline__ void ph_prep(const Params& p, float* lds) {
    const int tid = otid(), bid = blockIdx.x, nblk = gridDim.x;
    const int gt = bid * NT + tid, GT = nblk * NT;
    unsigned char* ws = p.ws;
    float2* tabw = (float2*)(ws + WS_TABW);
    for (int i = gt; i < 8192; i += GT) { float s, c; sincospif((float)i * (1.0f / 4096.0f), &s, &c); tabw[i] = make_float2(c, s); }
    float* rope = (float*)(ws + WS_ROPE);
    for (int i = gt; i < 192 * 16; i += GT) {
        const int pos = (i < 2048) ? (i >> 4) : ((i - 2048) >> 4); const int f = i & 15;
        const float inv = powf(10000.0f, -(float)(2 * f) / 32.0f); const float ang = (float)pos * inv;
        const float c = cosf(ang), s = sinf(ang);
        if (i < 2048) { rope[i] = c; rope[2048 + i] = s; } else { rope[4096 + (i - 2048)] = c; rope[4096 + 1024 + (i - 2048)] = s; }
    }
    { bf16_t* gt = (bf16_t*)(ws + WS_GT); const float* wf = p.in[I_WF];
      for (int i = bid * NT + tid; i < 4 * 64 * 128; i += GT) {
        const int g = i >> 13, d = (i >> 7) & 63, part = (i >> 6) & 1, c = i & 63;
        float a = 0.f;
        for (int j = 0; j < 64; ++j) { float s, co; sincospif((float)((c * j) & 63) * (1.0f / 32.0f), &s, &co); a += (part ? s : co) * wf[(g * 64 + j) * 64 + d]; }
        gt[i] = f2bf(a * 0.0013810679320049757f);
      }
      bf16_t* w128 = (bf16_t*)(ws + WS_W128E);
      for (int i = bid * NT + tid; i < 256 * 128; i += GT) { const int kk = i >> 7, n1 = i & 127; float s, co; sincospif((float)(((kk & 127) * n1) & 127) * (1.0f / 64.0f), &s, &co); w128[i] = f2bf(kk < 128 ? co : -s); }
      bf16_t* m64 = (bf16_t*)(ws + WS_M64E);
      for (int i = bid * NT + tid; i < 128 * 128; i += GT) { const int ro = i >> 7, ci = i & 127, po = ro >> 6, k2 = ro & 63, pi = ci >> 6, n2 = ci & 63;
        float s, co; sincospif((float)((k2 * n2) & 63) * (1.0f / 32.0f), &s, &co); m64[i] = f2bf(po == pi ? co : (po == 0 ? s : -s)); }
    }
    {
      bf16_t* wrt = (bf16_t*)(ws + WS_WRT); const float* wr = p.in[I_WR];
      for (int i = gt; i < 64 * 1024; i += GT) {
        const int j = i & 7, ln = (i >> 3) & 63, nb = (i >> 9) & 3, ks = (i >> 11) & 3, wv_ = i >> 13;
        const int e = 16 * nb + (ln & 15), k = wv_ * 128 + ks * 32 + 8 * (ln >> 4) + j;
        const float w = wr[k * 64 + e]; const bf16_t h = f2bf(w);
        const int o = ((((wv_ * 4 + ks) * 4 + nb) * 2) * 64 + ln) * 8 + j;
        wrt[o] = h; wrt[o + 512] = f2bf(w - bf2f(h)); } }
    if (gt == 0) {
        float s1 = 0.f, s2 = 0.f;
        for (int i = 0; i < 64; ++i) { s1 += p.in[I_LQ1][i] * p.in[I_LK1][i]; s2 += p.in[I_LQ2][i] * p.in[I_LK2][i]; }
        ((float*)(ws + WS_CTL))[1024] = expf(s1) - expf(s2) + LAM_INIT;
    }
    float* sc = lds;
    float* red = lds + 5 * 1024;
    for (int i = tid; i < 5 * 1024; i += NT) { const int r = i >> 10, k = i & 1023; const float v = (r < 4) ? p.in[I_C][r * 1024 + k] : p.in[I_CCTX][k]; sc[i] = silu_f(v); }
    __syncthreads();
    const int wave = tid >> 6, lane = tid & 63;
    float* mod = (float*)(ws + WS_MOD);
    for (int task = bid; task < 96; task += nblk) {
        const int col = task * 64 + lane;
        float a0 = 0, a1 = 0, a2 = 0, a3 = 0, a4 = 0;
        const float* wm = p.in[I_WMOD];
#pragma unroll 32
        for (int k = wave * 128; k < wave * 128 + 128; ++k) { const float w = wm[(size_t)k * 6144 + col]; a0 += sc[k] * w; a1 += sc[1024 + k] * w; a2 += sc[2048 + k] * w; a3 += sc[3072 + k] * w; a4 += sc[4096 + k] * w; }
        red[(wave * 5 + 0) * 64 + lane] = a0; red[(wave * 5 + 1) * 64 + lane] = a1; red[(wave * 5 + 2) * 64 + lane] = a2; red[(wave * 5 + 3) * 64 + lane] = a3; red[(wave * 5 + 4) * 64 + lane] = a4;
        __syncthreads();
        if (tid < 320) { const int r = tid >> 6, l = tid & 63; float s = 0.f; for (int w = 0; w < 8; ++w) s += red[(w * 5 + r) * 64 + l]; mod[r * 6144 + task * 64 + l] = s + p.in[I_BMOD][task * 64 + l]; }
        __syncthreads();
    }
}

__device__ __forceinline__ void ph_norm1(const Params& p) {
    const int tid = otid(), wave = tid >> 6, lane = tid & 63;
    const int gw = blockIdx.x * NWV + wave, GW = gridDim.x * NWV;
    const float* mod = (const float*)(p.ws + WS_MOD);
    bf16_t* hx = (bf16_t*)(p.ws + WS_HX);
    const float* g = p.in[I_GAPRE];
    for (int m = gw; m < MTOT; m += GW) {
        const float* src = (m < T) ? p.in[I_X] + (size_t)m * D : p.in[I_CTX] + (size_t)(m - T) * D;
        const int r = (m < T) ? (m >> 13) : 4;
        const float* shift = mod + r * 6144; const float* scale = shift + 1024;
        f32x4 v[4]; float ss = 0.f;
#pragma unroll
        for (int j = 0; j < 4; ++j) { v[j] = ((const f32x4*)src)[lane + 64 * j]; ss += v[j][0] * v[j][0] + v[j][1] * v[j][1] + v[j][2] * v[j][2] + v[j][3] * v[j][3]; }
        ss = wave_sum(ss);
        const float rs = 1.0f / sqrtf(ss * (1.0f / D) + EPS);
#pragma unroll
        for (int j = 0; j < 4; ++j) {
            const int col = 4 * (lane + 64 * j);
            const f32x4 g4 = *(const f32x4*)(g + col), sc4 = *(const f32x4*)(scale + col), sh4 = *(const f32x4*)(shift + col);
            float h[4];
#pragma unroll
            for (int i = 0; i < 4; ++i) h[i] = v[j][i] * rs * g4[i] * (1.f + sc4[i]) + sh4[i];
            uint2 o; o.x = pk2(h[0], h[1]); o.y = pk2(h[2], h[3]);
            *(uint2*)(hx + (size_t)m * D + col) = o;
        }
    }
}

namespace gp {
#define GP_LAS __attribute__((address_space(3)))
typedef short bf16x8 __attribute__((ext_vector_type(8)));
typedef unsigned u32x4 __attribute__((ext_vector_type(4)));
typedef int i32x4 __attribute__((ext_vector_type(4)));
constexpr int BM = 256, BK = 64, HALF = 128, HTB = HALF * BK * 2, STAGE_BYTES = 8 * HTB;
__device__ __forceinline__ int lds_byte(int r, int c) { const int st = (r >> 4) * 2 + (c >> 5), rr = r & 15, cc = c & 31, ob = rr * 64 + cc * 2; return st * 1024 + (ob ^ (((ob >> 9) & 1) << 5)); }
__device__ __forceinline__ void stage_rc(int b, int& R, int& C) { const int st = b / 1024, sb = b % 1024, swz = sb ^ (((sb >> 9) & 1) << 5); R = (st >> 1) * 16 + swz / 64; C = (st & 1) * 32 + (swz % 64) / 2; }
__device__ __forceinline__ int perm32(int rho) { const int n = rho >> 4, i = rho & 15; return 8 * (i >> 2) + 4 * n + (i & 3); }
struct Unit { int pm, pn, e, b, cnt, base; };
__device__ __forceinline__ unsigned cvt_pk_bf16(float lo, float hi) { unsigned r; asm volatile("v_cvt_pk_bf16_f32 %0, %1, %2" : "=v"(r) : "v"(lo), "v"(hi)); return r; }

template <class Epi, class Sched, bool ALIGN_EPI, bool F8 = false>
__device__ __forceinline__ void gemm_phase(const int wv, GP_LAS unsigned char* lds, const char* Abase, const int K, const Sched& S, const Epi& E) {
    const int wid = wv, wr = wid >> 2, wc = wid & 3;
    const int nt = K / BK;
    unsigned voffB[2];
#pragma unroll
    for (int i = 0; i < 2; ++i) { int R, C; stage_rc(otid_w(wv) * 16 + i * 8192, R, C); const int Rb = (R & ~31) + perm32(R & 31); voffB[i] = (unsigned)(Rb * K + C) * 2u; }
#define GP_AOFFS(u, o00, o01, o10, o11) do { int R0, C0, R1, C1; const int t_ = otid_w(wv); stage_rc(t_ * 16, R0, C0); stage_rc(t_ * 16 + 8192, R1, C1); \
        o00 = S.arow(u, R0) + (unsigned)C0 * 2u; o01 = S.arow(u, R1) + (unsigned)C1 * 2u; o10 = S.arow(u, HALF + R0) + (unsigned)C0 * 2u; o11 = S.arow(u, HALF + R1) + (unsigned)C1 * 2u; } while (0)
    const size_t kstep = (size_t)(BK * 2);
    const size_t hstep = (size_t)HALF * K * 2;
    const unsigned ldsw = (unsigned)wid * 1024u;
    int aoff, boff; { const int l_ = lane_id(), fr = l_ & 15, fq = l_ >> 4; aoff = lds_byte(wr * 64 + fr, fq * 8); boff = lds_byte(wc * 32 + fr, fq * 8); }
#define GP_SA(b, h) (((b) * 2 + (h)) * HTB)
#define GP_SB(b, h) ((4 + (b) * 2 + (h)) * HTB)
#define GP_STAGE_B(bufoff, gbase) do { _Pragma("unroll") for (int _i = 0; _i < 2; ++_i) \
        __builtin_amdgcn_global_load_lds((const unsigned*)((const char*)(gbase) + voffB[_i]), (GP_LAS unsigned*)(lds + (bufoff) + ldsw + _i * 8192), 16, 0, 0); } while (0)
#define GP_STAGE_A(bufoff, gbase, o0, o1) do { \
        __builtin_amdgcn_global_load_lds((const unsigned*)((const char*)(gbase) + (o0)), (GP_LAS unsigned*)(lds + (bufoff) + ldsw), 16, 0, 0); \
        __builtin_amdgcn_global_load_lds((const unsigned*)((const char*)(gbase) + (o1)), (GP_LAS unsigned*)(lds + (bufoff) + ldsw + 8192), 16, 0, 0); } while (0)
#define GP_LDA(dst, b, h) do { _Pragma("unroll") for (int m = 0; m < 4; ++m) _Pragma("unroll") for (int k = 0; k < 2; ++k) dst[m][k] = *(const GP_LAS bf16x8*)(lds + GP_SA(b, h) + aoff + m * 2048 + k * 1024); } while (0)
#define GP_LDB(dst, b, h) do { _Pragma("unroll") for (int n = 0; n < 2; ++n) _Pragma("unroll") for (int k = 0; k < 2; ++k) dst[n][k] = *(const GP_LAS bf16x8*)(lds + GP_SB(b, h) + boff + n * 2048 + k * 1024); } while (0)
#define GP_CAT8(x) __builtin_shufflevector(__builtin_bit_cast(i32x4, x[0]), __builtin_bit_cast(i32x4, x[1]), 0, 1, 2, 3, 4, 5, 6, 7)
#define GP_MMA(ai, bj, At, Bt) do { __builtin_amdgcn_s_setprio(1); _Pragma("unroll") for (int m = 0; m < 4; ++m) _Pragma("unroll") for (int n = 0; n < 2; ++n) { \
        if constexpr (F8) acc[ai][bj][m][n] = __builtin_amdgcn_mfma_scale_f32_16x16x128_f8f6f4(GP_CAT8(Bt[n]), GP_CAT8(At[m]), acc[ai][bj][m][n], 0, 0, 0, 0, 0, 0); \
        else { _Pragma("unroll") for (int k = 0; k < 2; ++k) acc[ai][bj][m][n] = __builtin_amdgcn_mfma_f32_16x16x32_bf16(Bt[n][k], At[m][k], acc[ai][bj][m][n], 0, 0, 0); } } \
        __builtin_amdgcn_s_setprio(0); } while (0)
#define GP_WAIT_V(n) asm volatile("s_waitcnt vmcnt(" #n ")" ::: "memory")
#define GP_WAIT_L(n) asm volatile("s_waitcnt lgkmcnt(" #n ")" ::: "memory")
#define GP_BAR __builtin_amdgcn_s_barrier()
#define GP_SCHED __builtin_amdgcn_sched_barrier(0)
    Unit cur, nxt; int ui = 0;
    if (!S.next(0, cur)) return;
    f32x4 acc[2][2][4][2];
#pragma unroll
    for (int a = 0; a < 2; ++a)
#pragma unroll
        for (int b = 0; b < 2; ++b)
#pragma unroll
            for (int m = 0; m < 4; ++m)
#pragma unroll
                for (int n = 0; n < 2; ++n) acc[a][b][m][n] = (f32x4){0.f, 0.f, 0.f, 0.f};
    bf16x8 At[4][2], B0[2][2], B1[2][2];
    unsigned ac00, ac01, ac10, ac11, an00, an01, an10, an11;
    GP_AOFFS(cur, ac00, ac01, ac10, ac11);
    const char* cB = S.bptr(cur);
    GP_STAGE_B(GP_SB(0, 0), cB); GP_STAGE_B(GP_SB(0, 1), cB + hstep); GP_STAGE_A(GP_SA(0, 0), Abase, ac00, ac01); GP_STAGE_A(GP_SA(0, 1), Abase, ac10, ac11);
    if (wr == 1) GP_BAR;
    GP_WAIT_V(2); GP_BAR;
    GP_STAGE_B(GP_SB(1, 0), cB + kstep); GP_STAGE_A(GP_SA(1, 0), Abase + kstep, ac00, ac01); GP_STAGE_B(GP_SB(1, 1), cB + hstep + kstep);
    GP_WAIT_V(6); GP_BAR;
    for (;;) {
        const bool has_next = S.next(ui + 1, nxt);
        if (has_next) { GP_AOFFS(nxt, an00, an01, an10, an11); }
        else { an00 = ac00; an01 = ac01; an10 = ac10; an11 = ac11; }
        const char* nB = has_next ? S.bptr(nxt) : cB;
#pragma unroll 1
        for (int t = 0; t < nt; t += 2) {
            const bool last = (t == nt - 2);
            const char* a1 = Abase + (size_t)(t + 1) * kstep;
            const char* a2 = last ? Abase : Abase + (size_t)(t + 2) * kstep; const char* b2 = last ? nB : cB + (size_t)(t + 2) * kstep;
            const char* a3 = a2 + kstep; const char* b3 = b2 + kstep;
            asm volatile("" : "+s"(a1), "+s"(a2), "+s"(b2), "+s"(a3), "+s"(b3));
            GP_LDB(B0, 0, 0); GP_LDB(B1, 0, 1); GP_SCHED; GP_LDA(At, 0, 0); GP_STAGE_A(GP_SA(1, 1), a1, ac10, ac11);
            if (last) { ac00 = an00; ac01 = an01; ac10 = an10; ac11 = an11; }
            GP_WAIT_V(8); GP_WAIT_L(0); GP_BAR; GP_MMA(0, 0, At, B0); GP_MMA(0, 1, At, B1); GP_BAR; GP_SCHED;
            GP_LDA(At, 0, 1); GP_STAGE_B(GP_SB(0, 0), b2); GP_STAGE_B(GP_SB(0, 1), b2 + hstep); GP_STAGE_A(GP_SA(0, 0), a2, ac00, ac01);
            GP_WAIT_V(8); GP_WAIT_L(0); GP_BAR; GP_MMA(1, 0, At, B0); GP_MMA(1, 1, At, B1); GP_BAR; GP_SCHED;
            GP_LDB(B0, 1, 0); GP_LDB(B1, 1, 1); GP_SCHED; GP_LDA(At, 1, 0); GP_STAGE_A(GP_SA(0, 1), a2, ac10, ac11);
            GP_WAIT_V(8); GP_WAIT_L(0); GP_BAR; GP_MMA(0, 0, At, B0); GP_MMA(0, 1, At, B1); GP_BAR; GP_SCHED;
            GP_LDA(At, 1, 1); GP_STAGE_B(GP_SB(1, 0), b3); GP_STAGE_B(GP_SB(1, 1), b3 + hstep); GP_STAGE_A(GP_SA(1, 0), a3, ac00, ac01);
            GP_WAIT_V(8); GP_WAIT_L(0); GP_BAR; GP_MMA(1, 0, At, B0); GP_MMA(1, 1, At, B1); GP_BAR; GP_SCHED;
        }
        if constexpr (ALIGN_EPI) { if (wr == 0) GP_BAR; }
        { const int l_ = lane_id(); E(acc, cur, wr, wc, l_ & 15, l_ >> 4); }
        if (!has_next) break;
#pragma unroll
        for (int a = 0; a < 2; ++a)
#pragma unroll
            for (int b = 0; b < 2; ++b)
#pragma unroll
                for (int m = 0; m < 4; ++m)
#pragma unroll
                    for (int n = 0; n < 2; ++n) acc[a][b][m][n] = (f32x4){0.f, 0.f, 0.f, 0.f};
        cur = nxt; cB = nB; ++ui;
        if constexpr (ALIGN_EPI) { if (wr == 1) GP_BAR; }
    }
    GP_WAIT_V(0);
    if constexpr (!ALIGN_EPI) { if (wr == 0) GP_BAR; }
    GP_BAR;
#undef GP_AOFFS
#undef GP_SA
#undef GP_SB
#undef GP_STAGE_A
#undef GP_STAGE_B
#undef GP_LDA
#undef GP_LDB
#undef GP_MMA
#undef GP_CAT8
#undef GP_WAIT_V
#undef GP_WAIT_L
#undef GP_BAR
#undef GP_SCHED
}

struct DenseSched {
    int nM, nN, nwg, G, c, K; const char* Bt;
    __device__ __forceinline__ void init(int M, int N, int K_, const void* Bt_, int G_, int c_) { nM = M / BM; nN = N / BM; nwg = nM * nN; G = G_; c = c_; K = K_; Bt = (const char*)Bt_; }
    __device__ __forceinline__ bool next(int i, Unit& u) const {
        const long L = (long)i * G + c; if (L >= nwg) return false;
        int wgid = (int)L; { const int q = nwg / 8, r = nwg % 8, xcd = wgid % 8, off = wgid / 8; wgid = (xcd < r ? xcd * (q + 1) : r * (q + 1) + (xcd - r) * q) + off; }
        const int nig = 8 * nN, gid = wgid / nig, fm = gid * 8, gsz = (nM - fm) < 8 ? (nM - fm) : 8;
        u.pm = fm + ((wgid % nig) % gsz); u.pn = (wgid % nig) / gsz; u.e = 0; u.b = 0; u.cnt = 0; u.base = 0; return true;
    }
    __device__ __forceinline__ unsigned arow(const Unit& u, int r) const { return (unsigned)(u.pm * BM + r) * (unsigned)(K * 2); }
    __device__ __forceinline__ const char* bptr(const Unit& u) const { return Bt + (size_t)u.pn * BM * K * 2; }
};
}

struct EpiInProj {
    bf16_t* F; bf16_t* Q; bf16_t* Kb; bf16_t* Vb; const float* rope;
    __device__ __forceinline__ void operator()(const f32x4 (&acc)[2][2][4][2], const gp::Unit& u, int wr, int wc, int fr, int fq) const {
        const int pn = u.pn, pm = u.pm; const bool isctx = pm >= T / 256;
        if (isctx && pn < 4) return;
        if (pn >= 7) {
            unsigned char* V8 = (unsigned char*)Vb;
#pragma unroll
            for (int ai = 0; ai < 2; ++ai) {
                const int row0 = pm * 256 + ai * 128 + wr * 64;
                int b, tile;
                if (!isctx) { b = row0 >> 13; tile = (CTX >> 6) + ((row0 & 8191) >> 6); } else { const int j = row0 - T; b = j >> 8; tile = (j & 255) >> 6; }
#pragma unroll
                for (int bj = 0; bj < 2; ++bj) {
                    const int head = (pn - 7) * 2 + bj;
                    unsigned char* dst = V8 + ((size_t)(b * NH + head) * (KVLEN / 64) + tile) * 8192 + wc * 2048 + fq * 64 + (fr >> 3) * 32 + (fr & 1) * 16 + ((fr >> 1) & 3) * 4;
#pragma unroll
                    for (int e = 0; e < 8; ++e) {
                        int w = __builtin_amdgcn_cvt_pk_fp8_f32(acc[ai][bj][0][e >> 2][e & 3], acc[ai][bj][1][e >> 2][e & 3], 0, false);
                        w = __builtin_amdgcn_cvt_pk_fp8_f32(acc[ai][bj][2][e >> 2][e & 3], acc[ai][bj][3][e >> 2][e & 3], w, true);
                        *(int*)(dst + e * 256) = w;
                    }
                }
            }
            return;
        }
        const int axis = wc & 1; const float* ct = rope + (axis ? 4096 : 0); const float* st = rope + (axis ? 4096 + 1024 : 2048);
#pragma unroll
        for (int ai = 0; ai < 2; ++ai)
#pragma unroll
            for (int m = 0; m < 4; ++m) {
                const int row = pm * 256 + ai * 128 + wr * 64 + m * 16 + fr;
                int t, kb, tile;
                if (!isctx) { kb = row >> 13; t = row & 8191; tile = (CTX >> 6) + (t >> 6); } else { const int j = row - T; t = 0; kb = j >> 8; tile = (j & 255) >> 6; }
                const int pos = axis ? (t & 63) : (t >> 6);
#pragma unroll
                for (int bj = 0; bj < 2; ++bj) {
                    const int col0 = pn * 256 + bj * 128 + wc * 32 + fq * 8;
                    f32x4 v0 = acc[ai][bj][m][0], v1 = acc[ai][bj][m][1];
                    if (pn == 0) { gp::u32x4 w; w.x = gp::cvt_pk_bf16(v0[0], v0[1]); w.y = gp::cvt_pk_bf16(v0[2], v0[3]); w.z = gp::cvt_pk_bf16(v1[0], v1[1]); w.w = gp::cvt_pk_bf16(v1[2], v1[3]);
                        *(gp::u32x4*)(F + (size_t)row * 256 + col0) = w; continue; }
                    if (pn < 7 && !isctx) {
                        const f32x4 c0 = *(const f32x4*)(ct + pos * 16 + 8 * (fq & 1)), c1 = *(const f32x4*)(ct + pos * 16 + 8 * (fq & 1) + 4);
                        const f32x4 s0 = *(const f32x4*)(st + pos * 16 + 8 * (fq & 1)), s1 = *(const f32x4*)(st + pos * 16 + 8 * (fq & 1) + 4);
                        const float sg = (fq < 2) ? -1.f : 1.f;
#pragma unroll
                        for (int i = 0; i < 4; ++i) {
                            const auto r0 = __builtin_amdgcn_permlane32_swap(__float_as_uint(v0[i]), __float_as_uint(v0[i]), false, false);
                            const auto r1 = __builtin_amdgcn_permlane32_swap(__float_as_uint(v1[i]), __float_as_uint(v1[i]), false, false);
                            const float p0 = __uint_as_float(fq < 2 ? r0[1] : r0[0]), p1 = __uint_as_float(fq < 2 ? r1[1] : r1[0]);
                            v0[i] = v0[i] * c0[i] + sg * p0 * s0[i]; v1[i] = v1[i] * c1[i] + sg * p1 * s1[i]; }
                    }
                    v0 = v0 * SQS; v1 = v1 * SQS;
                    int w0 = __builtin_amdgcn_cvt_pk_fp8_f32(v0[0], v0[1], 0, false); w0 = __builtin_amdgcn_cvt_pk_fp8_f32(v0[2], v0[3], w0, true);
                    int w1 = __builtin_amdgcn_cvt_pk_fp8_f32(v1[0], v1[1], 0, false); w1 = __builtin_amdgcn_cvt_pk_fp8_f32(v1[2], v1[3], w1, true);
                    unsigned char* d;
                    if (pn < 4) d = (unsigned char*)Q + (size_t)row * QKW + (col0 - 256);
                    else d = (unsigned char*)Kb + ((size_t)(kb * NH + (pn - 4) * 2 + bj) * (KVLEN / 64) + tile) * 8192 + wc * 2048 + m * 512 + fr * 32 + fq * 8;
                    typedef int i32x2_t __attribute__((ext_vector_type(2)));
                    *(i32x2_t*)d = (i32x2_t){w0, w1};
                }
            }
    }
};
struct EpiStoreBf16 {
    bf16_t* O; int ldc;
    __device__ __forceinline__ void operator()(const f32x4 (&acc)[2][2][4][2], const gp::Unit& u, int wr, int wc, int fr, int fq) const {
#pragma unroll
        for (int ai = 0; ai < 2; ++ai)
#pragma unroll
            for (int m = 0; m < 4; ++m) {
                bf16_t* rowp = O + (size_t)(u.pm * 256 + ai * 128 + wr * 64 + m * 16 + fr) * ldc + u.pn * 256 + wc * 32 + fq * 8;
#pragma unroll
                for (int bj = 0; bj < 2; ++bj) { const f32x4 v0 = acc[ai][bj][m][0], v1 = acc[ai][bj][m][1];
                    gp::u32x4 w; w.x = gp::cvt_pk_bf16(v0[0], v0[1]); w.y = gp::cvt_pk_bf16(v0[2], v0[3]); w.z = gp::cvt_pk_bf16(v1[0], v1[1]); w.w = gp::cvt_pk_bf16(v1[2], v1[3]);
                    *(gp::u32x4*)(rowp + bj * 128) = w; }
            }
    }
};

__device__ __forceinline__ void ph_inproj(const Params& p, unsigned char* smem) {
    unsigned char* ws = p.ws;
    gp::DenseSched S; S.init(MTOT, INW, D, ws + WS_WINT, gridDim.x, blockIdx.x);
    EpiInProj E{(bf16_t*)(ws + WS_F), (bf16_t*)(ws + WS_Q), (bf16_t*)(ws + WS_K), (bf16_t*)(ws + WS_V), (const float*)(ws + WS_ROPE)};
    gp::gemm_phase<EpiInProj, gp::DenseSched, true>(p.chunk, (GP_LAS unsigned char*)smem, (const char*)(ws + WS_HX), D, S, E);
}
__device__ __forceinline__ void ph_outproj(const Params& p, unsigned char* smem) {
    unsigned char* ws = p.ws;
    gp::DenseSched S; S.init(T, D, D, ws + WS_WOUTT, gridDim.x, blockIdx.x);
    EpiStoreBf16 E{(bf16_t*)(ws + WS_YX), D};
    gp::gemm_phase<EpiStoreBf16, gp::DenseSched, true>(p.chunk, (GP_LAS unsigned char*)smem, (const char*)(ws + WS_AO), D, S, E);
}

constexpr float GUSCALE = 64.f;
constexpr float WDSCALE = 16.f, ASCALE = 4.f;
struct TItem8 { const float* W; unsigned char* WT; int K, N, row_base, k0, n0; float sc; };
__device__ __forceinline__ void titem8_load(const TItem8& t, float (&tv)[32], int lane) {
#pragma unroll
    for (int i = 0; i < 32; ++i) tv[i] = t.W[(size_t)(t.k0 + 2 * i + (lane >> 5)) * t.N + t.n0 + (lane & 31)];
}
__device__ __forceinline__ void titem8_finish(const TItem8& t, const float (&tv)[32], float* scr, int lane) {
#pragma unroll
    for (int i = 0; i < 32; ++i) scr[(2 * i + (lane >> 5)) * 33 + (lane & 31)] = tv[i] * t.sc;
    asm volatile("s_waitcnt lgkmcnt(0)" ::: "memory");
    const int c = lane & 7;
#pragma unroll
    for (int j = 0; j < 4; ++j) { const int n = (lane >> 3) + 8 * j; const float* s = scr + (8 * c) * 33 + n;
        int w0 = __builtin_amdgcn_cvt_pk_fp8_f32(s[0 * 33], s[1 * 33], 0, false); w0 = __builtin_amdgcn_cvt_pk_fp8_f32(s[2 * 33], s[3 * 33], w0, true);
        int w1 = __builtin_amdgcn_cvt_pk_fp8_f32(s[4 * 33], s[5 * 33], 0, false); w1 = __builtin_amdgcn_cvt_pk_fp8_f32(s[6 * 33], s[7 * 33], w1, true);
        uint2 o; o.x = (unsigned)w0; o.y = (unsigned)w1;
        *(uint2*)(t.WT + (size_t)(t.row_base + t.n0 + n) * t.K + t.k0 + 8 * c) = o; }
    asm volatile("s_waitcnt lgkmcnt(0)" ::: "memory");
}
__device__ __forceinline__ void transpose_item(const float* W, int K, int N, bf16_t* WT, int row_base, int kb, int nb, float* scr, int lane) {
    const int k0 = 64 * kb, n0 = 32 * nb;
    float tv[32];
#pragma unroll
    for (int i = 0; i < 32; ++i) tv[i] = W[(size_t)(k0 + 2 * i + (lane >> 5)) * N + n0 + (lane & 31)];
#pragma unroll
    for (int i = 0; i < 32; ++i) scr[(2 * i + (lane >> 5)) * 33 + (lane & 31)] = tv[i];
    asm volatile("s_waitcnt lgkmcnt(0)" ::: "memory");
    const int c = lane & 7;
#pragma unroll
    for (int j = 0; j < 4; ++j) { const int n = (lane >> 3) + 8 * j; const float* s = scr + (8 * c) * 33 + n;
        uint4 o; o.x = pk2(s[0 * 33], s[1 * 33]); o.y = pk2(s[2 * 33], s[3 * 33]); o.z = pk2(s[4 * 33], s[5 * 33]); o.w = pk2(s[6 * 33], s[7 * 33]);
        *(uint4*)(WT + (size_t)(row_base + n0 + n) * K + k0 + 8 * c) = o; }
    asm volatile("s_waitcnt lgkmcnt(0)" ::: "memory");
}
__device__ __forceinline__ void ph_prep_weights(const Params& p, float* lds, const int part, const int first) {
    const int tid = otid(), wave = tid >> 6, lane = tid & 63;
    float* scr = lds + 8192 + wave * (64 * 33);
    if ((int)blockIdx.x < first) return;
    const int gw = ((int)blockIdx.x - first) * NWV + wave, GW = ((int)gridDim.x - first) * NWV;
    unsigned char* ws = p.ws;
    constexpr int I_IN = 16 * 80, I_OUT = 16 * 32, I_GU = 16 * 8, I_D = 4 * 32;
    constexpr int NITEMS = I_IN + I_OUT + 65 * (2 * I_GU + I_D);
    const int it_lo = part ? I_IN + I_OUT : 0, it_hi = part ? NITEMS : I_IN + I_OUT;
    if (part == 0) {
        for (int it = it_lo + gw; it < it_hi; it += GW) {
            int r = it;
            if (r < I_IN) { transpose_item(p.in[I_WIN], D, INW, (bf16_t*)(ws + WS_WINT), 0, r / 80, r % 80, scr, lane); continue; } r -= I_IN;
            transpose_item(p.in[I_WOUT], D, D, (bf16_t*)(ws + WS_WOUTT), 0, r / 32, r % 32, scr, lane);
        }
        return;
    }
    auto decode = [&](int it, TItem8& t) {
        int r = it - (I_IN + I_OUT);
        const int e = r / (2 * I_GU + I_D); r -= e * (2 * I_GU + I_D);
        if (r < 2 * I_GU) {
            const int half = r / I_GU, q = r % I_GU, kb = q / 8, nb = q % 8;
            t.W = (e < 64) ? p.in[half ? I_WU : I_WG] + (size_t)e * D * DE : p.in[half ? I_WSU : I_WSG];
            const int n0 = 32 * nb, drow = e * 512 + (n0 >> 7) * 256 + half * 128 + (n0 & 127);
            t.WT = ws + WS_WGUT; t.K = D; t.N = DE; t.row_base = drow - n0; t.k0 = 64 * kb; t.n0 = n0; t.sc = GUSCALE;
        } else {
            r -= 2 * I_GU;
            t.W = (e < 64) ? p.in[I_WD] + (size_t)e * DE * D : p.in[I_WSD];
            t.WT = ws + WS_WDT; t.K = DE; t.N = D; t.row_base = e * 1024; t.k0 = 64 * (r / 32); t.n0 = 32 * (r % 32); t.sc = WDSCALE;
        }
    };
    int it = it_lo + gw;
    if (it >= it_hi) return;
    TItem8 ta, tb; float va[32], vb[32];
    decode(it, ta); titem8_load(ta, va, lane);
    for (;;) {
        const bool hb = it + GW < it_hi;
        if (hb) { decode(it + GW, tb); titem8_load(tb, vb, lane); }
        titem8_finish(ta, va, scr, lane);
        if (!hb) break;
        const bool ha = it + 2 * GW < it_hi;
        if (ha) { decode(it + 2 * GW, ta); titem8_load(ta, va, lane); }
        titem8_finish(tb, vb, scr, lane);
        if (!ha) break;
        it += 2 * GW;
    }
}

namespace fa {
typedef short bf16x8 __attribute__((ext_vector_type(8)));
typedef short s16x4 __attribute__((ext_vector_type(4)));
typedef float f32x16 __attribute__((ext_vector_type(16)));
typedef unsigned u32x4 __attribute__((ext_vector_type(4)));
constexpr int KVBLK = 64, LDK = QKW;
constexpr float SCALE = 0.125f, THR = 8.f;
constexpr size_t SHM_V = KVBLK * 128 * 2, SHM_K = KVBLK * 128 * 2;
#define KSWZ(row, colB) ((row) * 256 + ((colB) ^ (((row) & 15) << 4)))
#define SBAR() __builtin_amdgcn_sched_barrier(0)
__device__ __forceinline__ int crow(int r, int hi) { return (r & 3) + 8 * (r >> 2) + 4 * hi; }
__device__ __forceinline__ unsigned cvtpk(float lo, float hi) { unsigned r; asm volatile("v_cvt_pk_bf16_f32 %0, %1, %2" : "=v"(r) : "v"(lo), "v"(hi)); return r; }
constexpr float PBIAS = 5.f, THR2 = PBIAS + 3.5f;
template <bool FIRST>
__device__ __forceinline__ void partialSM(f32x16& p0, f32x16& p1, float& m_reg, f32x16& negm, float& alpha) {
  float pmax = p0[0];
#pragma unroll
  for (int r = 1; r < 16; ++r) pmax = fmaxf(pmax, p0[r]);
#pragma unroll
  for (int r = 0; r < 16; ++r) pmax = fmaxf(pmax, p1[r]);
  { auto rr = __builtin_amdgcn_permlane32_swap(__float_as_uint(pmax), __float_as_uint(pmax), false, false);
    pmax = fmaxf(__uint_as_float(rr[0]), __uint_as_float(rr[1])); }
  if (!FIRST && __builtin_expect(__all(pmax <= THR2), 1)) { alpha = 1.f; }
  else { const float dl = FIRST ? pmax - PBIAS : fmaxf(pmax - PBIAS, 0.f); alpha = FIRST ? 0.f : __builtin_amdgcn_exp2f(-dl); m_reg += dl;
#pragma unroll
    for (int r = 0; r < 16; ++r) { p0[r] -= dl; p1[r] -= dl; }
#pragma unroll
    for (int r = 0; r < 16; ++r) negm[r] = -m_reg;
    asm volatile("" : "+v"(negm)); }
#pragma unroll
  for (int r = 0; r < 16; ++r) p0[r] = __builtin_amdgcn_exp2f(p0[r]);
}
typedef int i32x8 __attribute__((ext_vector_type(8)));
__device__ __forceinline__ int pk4_fp8(float a, float b, float c, float d) { int w; asm("v_cvt_pk_fp8_f32 %0, %1, %2" : "=v"(w) : "v"(a), "v"(b)); asm("v_cvt_pk_fp8_f32 %0, %1, %2 op_sel:[0,0,1]" : "+v"(w) : "v"(c), "v"(d)); return w; }
__device__ __forceinline__ void finishSM_T(f32x16& p0, f32x16& p1, i32x8& pb) {
#pragma unroll
  for (int r = 0; r < 16; ++r) p1[r] = __builtin_amdgcn_exp2f(p1[r]);
#pragma unroll
  for (int g = 0; g < 4; ++g) {
    pb[g] = pk4_fp8(p0[4 * g], p0[4 * g + 1], p0[4 * g + 2], p0[4 * g + 3]); pb[4 + g] = pk4_fp8(p1[4 * g], p1[4 * g + 1], p1[4 * g + 2], p1[4 * g + 3]); }
}
__device__ __forceinline__ void qkt(f32x16& p0, f32x16& p1, const char* Ks, const i32x8 qf, int lane, int mm, const f32x16& negm) {
  const char* kp = Ks + mm * 4096 + lane * 16;
  const u32x4 a0 = *reinterpret_cast<const u32x4*>(kp), a1 = *reinterpret_cast<const u32x4*>(kp + 1024), b0 = *reinterpret_cast<const u32x4*>(kp + 2048), b1 = *reinterpret_cast<const u32x4*>(kp + 3072);
  p0 = __builtin_amdgcn_mfma_scale_f32_32x32x64_f8f6f4((i32x8){(int)a0.x, (int)a0.y, (int)a0.z, (int)a0.w, (int)a1.x, (int)a1.y, (int)a1.z, (int)a1.w}, qf, negm, 0, 0, 0, 0, 0, 0);
  p1 = __builtin_amdgcn_mfma_scale_f32_32x32x64_f8f6f4((i32x8){(int)b0.x, (int)b0.y, (int)b0.z, (int)b0.w, (int)b1.x, (int)b1.y, (int)b1.z, (int)b1.w}, qf, negm, 0, 0, 0, 0, 0, 0);
}
__device__ __forceinline__ int v_st(int k, int c) { const int kk = (k & ~0xC) | ((k & 4) << 1) | ((k & 8) >> 1); return ((kk >> 3) * 4 + (c >> 5)) * 512 + ((kk & 7) * 32 + (c & 31)) * 2; }
__device__ __forceinline__ int v_rd_base(int lane) { return ((lane & 3) << 3) | (((lane >> 2) & 3) << 6) | (((lane >> 4) & 1) << 5) | (((lane >> 5) & 1) << 8); }
constexpr int v_rd_off(int d0, int ks, int half) { return d0 * 512 + ks * 4096 + half * 2048; }
template <int OFF> __device__ __forceinline__ s16x4 tr_read(int vb) {
  s16x4 r; asm volatile("ds_read_b64_tr_b16 %0, %1 offset:%2" : "=&v"(r) : "v"(vb), "i"(OFF) : "memory"); return r;
}
template <int D0> __device__ __forceinline__ void pv_one(f32x16& od, int vb, bf16x8 pa0, bf16x8 pa1, bf16x8 pa2, bf16x8 pa3) {
  const s16x4 l0 = tr_read<v_rd_off(D0, 0, 0)>(vb), h0 = tr_read<v_rd_off(D0, 0, 1)>(vb), l1 = tr_read<v_rd_off(D0, 1, 0)>(vb), h1 = tr_read<v_rd_off(D0, 1, 1)>(vb);
  const s16x4 l2 = tr_read<v_rd_off(D0, 2, 0)>(vb), h2 = tr_read<v_rd_off(D0, 2, 1)>(vb), l3 = tr_read<v_rd_off(D0, 3, 0)>(vb), h3 = tr_read<v_rd_off(D0, 3, 1)>(vb);
  asm volatile("s_waitcnt lgkmcnt(0)" ::: "memory"); SBAR();
#define PK(L, H) (bf16x8){L[0], L[1], L[2], L[3], H[0], H[1], H[2], H[3]}
  od = __builtin_amdgcn_mfma_f32_32x32x16_bf16(pa0, PK(l0, h0), od, 0, 0, 0);
  od = __builtin_amdgcn_mfma_f32_32x32x16_bf16(pa1, PK(l1, h1), od, 0, 0, 0);
  od = __builtin_amdgcn_mfma_f32_32x32x16_bf16(pa2, PK(l2, h2), od, 0, 0, 0);
  od = __builtin_amdgcn_mfma_f32_32x32x16_bf16(pa3, PK(l3, h3), od, 0, 0, 0);
#undef PK
}
__device__ __forceinline__ void pv_d0(f32x16* o, int vb, bf16x8 pa0, bf16x8 pa1, bf16x8 pa2, bf16x8 pa3) {
  pv_one<0>(o[0], vb, pa0, pa1, pa2, pa3); pv_one<1>(o[1], vb, pa0, pa1, pa2, pa3); pv_one<2>(o[2], vb, pa0, pa1, pa2, pa3); pv_one<3>(o[3], vb, pa0, pa1, pa2, pa3);
}

template <int OFF> __device__ __forceinline__ u32x4 rd128(int vb) { u32x4 r; asm volatile("ds_read_b128 %0, %1 offset:%2" : "=&v"(r) : "v"(vb), "i"(OFF) : "memory"); return r; }
#define PV_RD(D0) const u32x4 va##D0 = rd128<D0 * 2048>(vb), vc##D0 = rd128<D0 * 2048 + 1024>(vb); SBAR()
#define PV_MM(D0) do { asm volatile("s_waitcnt lgkmcnt(0)" ::: "memory"); SBAR(); \
    o[D0] = __builtin_amdgcn_mfma_scale_f32_32x32x64_f8f6f4((i32x8){(int)va##D0.x, (int)va##D0.y, (int)va##D0.z, (int)va##D0.w, (int)vc##D0.x, (int)vc##D0.y, (int)vc##D0.z, (int)vc##D0.w}, pb, o[D0], 0, 0, 0, 0, 0, 0); } while (0)
__device__ __forceinline__ float max3f(float a, float b, float c) { float r; asm("v_max3_f32 %0, %1, %2, %3" : "=v"(r) : "v"(a), "v"(b), "v"(c)); return r; }
#define PV_LSUM() lacc = __builtin_amdgcn_mfma_scale_f32_32x32x64_f8f6f4((i32x8){0x38383838, 0x38383838, 0x38383838, 0x38383838, 0x38383838, 0x38383838, 0x38383838, 0x38383838}, pb, lacc, 0, 0, 0, 0, 0, 0)
__device__ __forceinline__ void pv_psm(f32x16* o, f32x16& lacc, int vb, i32x8 pb, f32x16& p0, f32x16& p1, float& m_reg, f32x16& negm, float& alpha) {
  float pmax;
  { PV_RD(0);
    pmax = max3f(p0[0], p0[1], p0[2]);
#pragma unroll
    for (int r = 3; r < 15; r += 2) pmax = max3f(pmax, p0[r], p0[r + 1]);
    pmax = max3f(pmax, p0[15], p1[0]);
    SBAR(); PV_MM(0); }
  { PV_RD(1);
#pragma unroll
    for (int r = 1; r < 15; r += 2) pmax = max3f(pmax, p1[r], p1[r + 1]);
    pmax = max3f(pmax, p1[15], p1[15]);
    { auto rr = __builtin_amdgcn_permlane32_swap(__float_as_uint(pmax), __float_as_uint(pmax), false, false);
      pmax = max3f(__uint_as_float(rr[0]), __uint_as_float(rr[1]), __uint_as_float(rr[1])); }
    if (__builtin_expect(__all(pmax <= THR2), 1)) { alpha = 1.f; }
    else { const float dl = fmaxf(pmax - PBIAS, 0.f); alpha = __builtin_amdgcn_exp2f(-dl); m_reg += dl;
#pragma unroll
      for (int r = 0; r < 16; ++r) { p0[r] -= dl; p1[r] -= dl; }
#pragma unroll
      for (int r = 0; r < 16; ++r) negm[r] = -m_reg;
      asm volatile("" : "+v"(negm)); }
    SBAR(); PV_MM(1); }
  { PV_RD(2);
#pragma unroll
    for (int r = 0; r < 8; ++r) p0[r] = __builtin_amdgcn_exp2f(p0[r]);
    asm volatile("" : "+v"(p0));
    SBAR(); PV_MM(2); }
  { PV_RD(3);
#pragma unroll
    for (int r = 8; r < 16; ++r) p0[r] = __builtin_amdgcn_exp2f(p0[r]);
    asm volatile("" : "+v"(p0));
    SBAR(); PV_MM(3); PV_LSUM(); }
}
__device__ __forceinline__ void pvT_d0(f32x16* o, f32x16& lacc, int vb, i32x8 pb) {
  { PV_RD(0); PV_MM(0); } { PV_RD(1); PV_MM(1); } { PV_RD(2); PV_MM(2); } { PV_RD(3); PV_MM(3); PV_LSUM(); }
}
#undef PV_RD
#undef PV_MM
#undef PV_LSUM

__device__ __forceinline__ void attn_unit(const unsigned char* __restrict__ Qb, const unsigned char* __restrict__ Kh, const unsigned char* __restrict__ Vh, bf16_t* __restrict__ Ob,
                                          const float* __restrict__ gsub, const float lam, char* lds, const int wv) {
  typedef __attribute__((address_space(3))) unsigned* ldsu_t;
  const int tid = otid_w(wv), wid = wv, lane = tid & 63, r32 = lane & 31, hi = lane >> 5, mm = wid >> 2, wq = wid & 3;
  constexpr int NB = 4;
  constexpr int SHM_V8 = KVBLK * 128;
  char* V_lds = lds; char* K_lds = lds + NB * SHM_V8; constexpr int SHM_K8 = KVBLK * 128;
  float m_reg = 0.f; f32x16 o[4] = {}; f32x16 lacc = {}; i32x8 qf; f32x16 negm = {}; asm volatile("" : "+v"(negm));
  const unsigned koff = (unsigned)((2 * (wid >> 2) + (lane >> 5)) * 2048 + (lane & 3) * 512 + (8 * ((wid >> 1) & 1) + 2 * ((lane & 31) >> 3) + ((lane >> 2) & 1)) * 32 + (wid & 1) * 16);
  const unsigned voff = (unsigned)((wid >> 1) * 2048 + (lane & 7) * 256 + ((lane >> 3) & 3) * 64 + (wid & 1) * 32 + (lane >> 5) * 16);
#define DMA(t, buf) do { const char* kb_ = (const char*)(Kh + (size_t)(t) * SHM_K8); const char* vb_ = (const char*)(Vh + (size_t)(t) * SHM_V8); asm volatile("" : "+s"(kb_), "+s"(vb_)); \
    __builtin_amdgcn_global_load_lds((const unsigned*)(kb_ + koff), (ldsu_t)(K_lds + (buf) * SHM_K8 + wid * 1024), 16, 0, 0); \
    __builtin_amdgcn_global_load_lds((const unsigned*)(vb_ + voff), (ldsu_t)(V_lds + (buf) * SHM_V8 + wid * 1024), 16, 0, 0); } while (0)
#define WAIT_BAR(N) asm volatile("s_waitcnt vmcnt(" #N ") lgkmcnt(0)\n\ts_barrier" ::: "memory")
#define RESC(a) do { if (__any((a) < 1.f)) { _Pragma("unroll") for (int d = 0; d < 4; ++d) _Pragma("unroll") for (int r = 0; r < 16; ++r) o[d][r] *= (a); lacc[0] *= (a); } } while (0)
  DMA(0, 0); DMA(1, 1);
  { const unsigned char* Qw = Qb + (long)(wq * 32 + r32) * QKW + mm * 64 + hi * 32;
    const u32x4 q0 = *reinterpret_cast<const u32x4*>(Qw), q1 = *reinterpret_cast<const u32x4*>(Qw + 16);
    qf = (i32x8){(int)q0.x, (int)q0.y, (int)q0.z, (int)q0.w, (int)q1.x, (int)q1.y, (int)q1.z, (int)q1.w}; }
  const int vb0 = (int)(uintptr_t)V_lds + lane * 16;
  f32x16 pA0, pA1, pB0, pB1; float alA, alB; i32x8 pb; constexpr int NTL = KVLEN / KVBLK;
  WAIT_BAR(0);
  DMA(2, 2);
  qkt(pA0, pA1, K_lds, qf, lane, mm, negm); partialSM<true>(pA0, pA1, m_reg, negm, alA);
  WAIT_BAR(2);
  for (int j = 1; j + 1 < NTL; j += 2) {
    DMA(j + 2, (j + 2) & 3);
    SBAR(); qkt(pB0, pB1, K_lds + (j & 3) * SHM_K8, qf, lane, mm, negm);
    finishSM_T(pA0, pA1, pb); SBAR();
    pv_psm(o, lacc, vb0 + ((j - 1) & 3) * SHM_V8, pb, pB0, pB1, m_reg, negm, alB);
    RESC(alB);
    WAIT_BAR(2);
    if (j + 3 < NTL) DMA(j + 3, (j + 3) & 3);
    SBAR(); qkt(pA0, pA1, K_lds + ((j + 1) & 3) * SHM_K8, qf, lane, mm, negm);
    finishSM_T(pB0, pB1, pb); SBAR();
    pv_psm(o, lacc, vb0 + (j & 3) * SHM_V8, pb, pA0, pA1, m_reg, negm, alA);
    RESC(alA);
    if (j + 3 < NTL) WAIT_BAR(2); else WAIT_BAR(0);
  }
  SBAR(); qkt(pB0, pB1, K_lds + ((NTL - 1) & 3) * SHM_K8, qf, lane, mm, negm);
  finishSM_T(pA0, pA1, pb); SBAR();
  pv_psm(o, lacc, vb0 + ((NTL - 2) & 3) * SHM_V8, pb, pB0, pB1, m_reg, negm, alB);
  RESC(alB);
  finishSM_T(pB0, pB1, pb); SBAR();
  pvT_d0(o, lacc, vb0 + ((NTL - 1) & 3) * SHM_V8, pb);
#undef DMA
#undef WAIT_BAR
  const float rl = __builtin_amdgcn_rcpf(lacc[0]) * (mm ? lam : 1.0f);
  __syncthreads();
  constexpr int XS = 132;
  float* X = (float*)lds;
  if (mm == 1) {
#pragma unroll
    for (int r = 0; r < 16; ++r)
#pragma unroll
      for (int d0 = 0; d0 < 4; ++d0) X[(wq * 32 + r32) * XS + d0 * 32 + crow(r, hi)] = o[d0][r] * rl;
  }
  __syncthreads();
  if (mm == 0) {
#pragma unroll
    for (int r = 0; r < 16; ++r)
#pragma unroll
      for (int d0 = 0; d0 < 4; ++d0) { float* xp = X + (wq * 32 + r32) * XS + d0 * 32 + crow(r, hi); *xp = o[d0][r] * rl - *xp; }
  }
  __syncthreads();
  {
    const int row = tid >> 2, seg = tid & 3;
    const float* xr = X + row * XS + seg * 32;
    f32x4 v[8]; float ss = 0.f;
#pragma unroll
    for (int i = 0; i < 8; ++i) { v[i] = *(const f32x4*)(xr + 4 * i); ss += v[i][0] * v[i][0] + v[i][1] * v[i][1] + v[i][2] * v[i][2] + v[i][3] * v[i][3]; }
    ss += sx<1>(ss); ss += sx<2>(ss);
    const float rs = (1.0f - LAM_INIT) / sqrtf(ss * (1.0f / 128.0f) + EPS);
    bf16_t* dst = Ob + (long)row * D + seg * 32;
#pragma unroll
    for (int i = 0; i < 8; i += 2) {
      const f32x4 g0 = *(const f32x4*)(gsub + seg * 32 + 4 * i), g1 = *(const f32x4*)(gsub + seg * 32 + 4 * i + 4);
      u32x4 w; w.x = cvtpk(v[i][0] * rs * g0[0], v[i][1] * rs * g0[1]); w.y = cvtpk(v[i][2] * rs * g0[2], v[i][3] * rs * g0[3]);
      w.z = cvtpk(v[i + 1][0] * rs * g1[0], v[i + 1][1] * rs * g1[1]); w.w = cvtpk(v[i + 1][2] * rs * g1[2], v[i + 1][3] * rs * g1[3]);
      *(u32x4*)(dst + 4 * i) = w;
    }
  }
  __syncthreads();
#undef RESC
}
#undef KSWZ
#undef SBAR
}

__device__ __forceinline__ void ph_attn(const Params& p, unsigned char* smem) {
    unsigned char* ws = p.ws;
    const unsigned char* Q = ws + WS_Q; const unsigned char* Kb = ws + WS_K; const unsigned char* Vb = ws + WS_V;
    bf16_t* AO = (bf16_t*)(ws + WS_AO);
    const float lam = ((const float*)(ws + WS_CTL))[1024];
    const int c = blockIdx.x, G = gridDim.x;
    if (G == 256) {
        const int x = c & 7, s = c >> 3;
        for (int rd = 0; rd < 6; ++rd) {
            const int bh = rd * 4 + (x >> 1), qb = (x & 1) * 32 + s, b = bh / NH, h = bh % NH;
            fa::attn_unit(Q + ((size_t)b * SEQ + qb * 128) * QKW + h * 128, Kb + (size_t)(b * NH + h) * (KVLEN / 64) * 8192, Vb + (size_t)(b * NH + h) * (KVLEN / 64) * 8192,
                          AO + ((size_t)b * SEQ + qb * 128) * D + 256 + h * 128, p.in[I_GSUB], lam, (char*)smem, p.chunk);
        }
    } else {
        for (int u = c; u < BATCH * NH * 64; u += G) {
            const int bh = u >> 6, qb = u & 63, b = bh / NH, h = bh % NH;
            fa::attn_unit(Q + ((size_t)b * SEQ + qb * 128) * QKW + h * 128, Kb + (size_t)(b * NH + h) * (KVLEN / 64) * 8192, Vb + (size_t)(b * NH + h) * (KVLEN / 64) * 8192,
                          AO + ((size_t)b * SEQ + qb * 128) * D + 256 + h * 128, p.in[I_GSUB], lam, (char*)smem, p.chunk);
        }
    }
}

__device__ __forceinline__ void ph_fourierA(const Params& p, unsigned char* smem) {
    using namespace fa;
    unsigned char* ws = p.ws;
    const bf16_t* F = (const bf16_t*)(ws + WS_F); bf16_t* FY = (bf16_t*)(ws + WS_FY); const bf16_t* W = (const bf16_t*)(ws + WS_W128E);
    const int tid = otid(), wid = tid >> 6, lane = tid & 63, r32 = lane & 31, hi = lane >> 5;
    const int sr = tid >> 4, sc = (tid & 15) * 8, vst0 = v_st(sr, sc), vst1 = v_st(32 + sr, sc);
    const int vb0 = (int)(uintptr_t)smem + v_rd_base(lane);
    for (int task = blockIdx.x; task < BATCH * 64; task += gridDim.x) {
        const int b = task >> 6, n2 = task & 63;
        bf16x8 st[4][2];
#pragma unroll
        for (int kt = 0; kt < 2; ++kt)
#pragma unroll
            for (int ct = 0; ct < 2; ++ct) {
                st[kt * 2 + ct][0] = *(const bf16x8*)(F + ((size_t)b * SEQ + 64 * (64 * kt + sr) + n2) * 256 + 128 * ct + sc);
                st[kt * 2 + ct][1] = *(const bf16x8*)(F + ((size_t)b * SEQ + 64 * (64 * kt + 32 + sr) + n2) * 256 + 128 * ct + sc);
            }
        bf16x8 pa[2][4];
#pragma unroll
        for (int kt = 0; kt < 2; ++kt)
#pragma unroll
            for (int ks = 0; ks < 4; ++ks) pa[kt][ks] = *(const bf16x8*)(W + (size_t)(32 * wid + r32) * 128 + 64 * kt + 16 * ks + 8 * hi);
        __syncthreads();
#pragma unroll
        for (int q = 0; q < 4; ++q) { *(bf16x8*)(smem + q * 16384 + vst0) = st[q][0]; *(bf16x8*)(smem + q * 16384 + vst1) = st[q][1]; }
        __syncthreads();
        f32x16 o[2][4] = {};
#pragma unroll
        for (int ct = 0; ct < 2; ++ct)
#pragma unroll
            for (int kt = 0; kt < 2; ++kt) pv_d0(o[ct], vb0 + (kt * 2 + ct) * 16384, pa[kt][0], pa[kt][1], pa[kt][2], pa[kt][3]);
        const int plane = wid >> 2;
#pragma unroll
        for (int r = 0; r < 16; ++r) {
            const int k1 = 32 * (wid & 3) + crow(r, hi);
            bf16_t* dst = FY + ((((size_t)plane * BATCH + b) * 128 + k1) * 64 + n2) * 256 + r32;
#pragma unroll
            for (int ct = 0; ct < 2; ++ct)
#pragma unroll
                for (int d0 = 0; d0 < 4; ++d0) dst[128 * ct + 32 * d0] = f2bf(o[ct][d0][r]);
        }
    }
    __syncthreads();
}
__device__ __forceinline__ void ph_fourierB(const Params& p, unsigned char* smem) {
    using namespace fa;
    unsigned char* ws = p.ws;
    const bf16_t* FY = (const bf16_t*)(ws + WS_FY); const float2* tabw = (const float2*)(ws + WS_TABW);
    const bf16_t* M64 = (const bf16_t*)(ws + WS_M64E); const bf16_t* GT = (const bf16_t*)(ws + WS_GT);
    bf16_t* AO = (bf16_t*)(ws + WS_AO);
    const int tid = otid(), wid = tid >> 6, lane = tid & 63, r32 = lane & 31, hi = lane >> 5;
    const int sr = tid >> 4, sc = (tid & 15) * 8, vst0 = v_st(sr, sc), vst1 = v_st(32 + sr, sc);
    const int vb0 = (int)(uintptr_t)smem + v_rd_base(lane);
    constexpr int XRS = 528;
    unsigned char* XL = smem + 65536;
    const int mt = wid & 3, ctw = wid >> 2;
    for (int task = blockIdx.x; task < BATCH * 128; task += gridDim.x) {
        const int b = task >> 7, k1 = task & 127;
        __syncthreads();
#pragma unroll
        for (int ct = 0; ct < 2; ++ct)
#pragma unroll
            for (int rh = 0; rh < 2; ++rh) {
                const int n2 = sr + 32 * rh;
                const size_t off = ((((size_t)b) * 128 + k1) * 64 + n2) * 256 + 128 * ct + sc;
                const uint4 yr = *(const uint4*)(FY + off), yi = *(const uint4*)(FY + (size_t)BATCH * 128 * 64 * 256 + off);
                const float2 tw = tabw[n2 * k1];
                const unsigned yrw[4] = {yr.x, yr.y, yr.z, yr.w}, yiw[4] = {yi.x, yi.y, yi.z, yi.w};
                unsigned zr[4], zi[4];
#pragma unroll
                for (int q = 0; q < 4; ++q) {
                    const float a0 = __uint_as_float(yrw[q] << 16), a1 = __uint_as_float(yrw[q] & 0xffff0000u), b0 = __uint_as_float(yiw[q] << 16), b1 = __uint_as_float(yiw[q] & 0xffff0000u);
                    zr[q] = pk2(a0 * tw.x + b0 * tw.y, a1 * tw.x + b1 * tw.y); zi[q] = pk2(b0 * tw.x - a0 * tw.y, b1 * tw.x - a1 * tw.y);
                }
                const int vs = rh ? vst1 : vst0;
                *(uint4*)(smem + (0 * 2 + ct) * 16384 + vs) = make_uint4(zr[0], zr[1], zr[2], zr[3]);
                *(uint4*)(smem + (1 * 2 + ct) * 16384 + vs) = make_uint4(zi[0], zi[1], zi[2], zi[3]);
            }
        __syncthreads();
        {
            f32x16 o[4] = {};
#pragma unroll
            for (int kt = 0; kt < 2; ++kt) {
                bf16x8 pa[4];
#pragma unroll
                for (int ks = 0; ks < 4; ++ks) pa[ks] = *(const bf16x8*)(M64 + (size_t)(32 * mt + r32) * 128 + 64 * kt + 16 * ks + 8 * hi);
                pv_d0(o, vb0 + (kt * 2 + ctw) * 16384, pa[0], pa[1], pa[2], pa[3]);
            }
#pragma unroll
            for (int r = 0; r < 16; ++r) {
                const int ro = 32 * mt + crow(r, hi);
                bf16_t* xr = (bf16_t*)(XL + ((ro >> 6) * 64 + (ro & 63)) * XRS) + 128 * ctw + r32;
#pragma unroll
                for (int d0 = 0; d0 < 4; ++d0) xr[32 * d0] = f2bf(o[d0][r]);
            }
        }
        __syncthreads();
#pragma unroll
        for (int tt = 0; tt < 2; ++tt) {
            const int tau = 2 * wid + tt, g = tau >> 2, mt2 = (tau >> 1) & 1, nt2 = tau & 1;
            f32x16 acc = {};
#pragma unroll
            for (int ks8 = 0; ks8 < 8; ++ks8) {
                const int part = ks8 >> 2, cb = ks8 & 3;
                const bf16x8 af = *(const bf16x8*)(XL + (part * 64 + 32 * mt2 + r32) * XRS + (g * 64 + 16 * cb + 8 * hi) * 2);
                const bf16x8 bfr = *(const bf16x8*)(GT + ((size_t)g * 64 + 32 * nt2 + r32) * 128 + part * 64 + 16 * cb + 8 * hi);
                acc = __builtin_amdgcn_mfma_f32_32x32x16_bf16(af, bfr, acc, 0, 0, 0);
            }
#pragma unroll
            for (int r = 0; r < 16; ++r) { const int k2 = 32 * mt2 + crow(r, hi);
                AO[((size_t)b * SEQ + k1 + 128 * k2) * D + g * 64 + 32 * nt2 + r32] = f2bf(acc[r]); }
        }
    }
    __syncthreads();
}

__device__ __forceinline__ void ph_mid(const Params& p, unsigned char* smem) {
    typedef short bf16x8 __attribute__((ext_vector_type(8)));
    unsigned char* ws = p.ws;
    const int tid = otid(), wave = tid >> 6, lane = tid & 63, fr = lane & 15, fq = lane >> 4;
    const float* mod = (const float*)(ws + WS_MOD);
    const bf16_t* YX = (const bf16_t*)(ws + WS_YX);
    unsigned char* H2 = ws + WS_H2;
    unsigned* counts = (unsigned*)(ws + WS_CTL);
    int* TE = (int*)(ws + WS_TE); int* TP = (int*)(ws + WS_TP); float* TW = (float*)(ws + WS_TW); int* TOKL = (int*)(ws + WS_TOKL);
    constexpr int RS = 2064;
    unsigned char* Ahi = smem; unsigned char* Alo = smem + 16 * RS; float* Pp = (float*)(smem + 2 * 16 * RS + 512);
    const float rbias = p.in[I_RB][lane];
    int* lcnt = (int*)(smem + 99328); int* gb = lcnt + 64; int* PE = gb + 64; float* PW = (float*)(PE + 1024); float* PV = PW + 1024;
    for (int chunk = blockIdx.x; chunk < T / 128; chunk += gridDim.x) {
      const int mc = chunk * 128, b = mc >> 13;
      if (tid < 64) lcnt[tid] = 0;
      {
          const float* mrow_ = mod + b * 6144;
          for (int i = tid; i < 5 * 256; i += NT) { const int v_ = i >> 8, q_ = (i & 255) * 4;
              const float* s_ = (v_ == 0) ? p.in[I_GAPOST] + q_ : (v_ == 1) ? mrow_ + 2 * 1024 + q_ : (v_ == 2) ? p.in[I_GFPRE] + q_ : (v_ == 3) ? mrow_ + 3 * 1024 + q_ : mrow_ + 4 * 1024 + q_;
              *(f32x4*)(PV + v_ * 1024 + q_) = *(const f32x4*)s_; }
          __syncthreads();
      }
      uint2 yw[2][4]; f32x4 xv[2][4];
#define MID_LOAD(m0_) do { _Pragma("unroll") for (int rr = 0; rr < 2; ++rr) { const int m_ = (m0_) + 2 * wave + rr; _Pragma("unroll") for (int j = 0; j < 4; ++j) { \
          yw[rr][j] = *(const uint2*)(YX + (size_t)m_ * D + 4 * (lane + 64 * j)); xv[rr][j] = ((const f32x4*)(p.in[I_X] + (size_t)m_ * D))[lane + 64 * j]; } } } while (0)
      MID_LOAD(mc);
      for (int it = 0; it < 8; ++it) {
        const int m0 = mc + it * 16;
        {
            float ss[2] = {0.f, 0.f};
#define YV(rr, j, i) ((i) == 0 ? __uint_as_float(yw[rr][j].x << 16) : (i) == 1 ? __uint_as_float(yw[rr][j].x & 0xffff0000u) : (i) == 2 ? __uint_as_float(yw[rr][j].y << 16) : __uint_as_float(yw[rr][j].y & 0xffff0000u))
#pragma unroll
            for (int rr = 0; rr < 2; ++rr) {
#pragma unroll
                for (int j = 0; j < 4; ++j) ss[rr] += YV(rr, j, 0) * YV(rr, j, 0) + YV(rr, j, 1) * YV(rr, j, 1) + YV(rr, j, 2) * YV(rr, j, 2) + YV(rr, j, 3) * YV(rr, j, 3);
                ss[rr] = wave_sum(ss[rr]);
            }
#pragma unroll
            for (int rr = 0; rr < 2; ++rr) {
                const int lr = 2 * wave + rr, m = m0 + lr;
                const float r1 = 1.0f / sqrtf(ss[rr] * (1.0f / D) + EPS);
                float ss2 = 0.f;
#pragma unroll
                for (int j = 0; j < 4; ++j) {
                    const int col = 4 * (lane + 64 * j);
                    const f32x4 gp = *(const f32x4*)(PV + col), gt = *(const f32x4*)(PV + 1024 + col);
#pragma unroll
                    for (int i = 0; i < 4; ++i) { xv[rr][j][i] = xv[rr][j][i] + gt[i] * (YV(rr, j, i) * r1 * gp[i]); ss2 += xv[rr][j][i] * xv[rr][j][i]; }
                    ((f32x4*)(p.out + (size_t)m * D))[lane + 64 * j] = xv[rr][j];
                }
                ss2 = wave_sum(ss2);
                const float r2 = 1.0f / sqrtf(ss2 * (1.0f / D) + EPS);
#pragma unroll
                for (int j = 0; j < 4; ++j) {
                    const int col = 4 * (lane + 64 * j);
                    const f32x4 gp = *(const f32x4*)(PV + 2048 + col), sh = *(const f32x4*)(PV + 3072 + col), sc = *(const f32x4*)(PV + 4096 + col);
                    float h[4];
#pragma unroll
                    for (int i = 0; i < 4; ++i) h[i] = xv[rr][j][i] * r2 * gp[i] * (1.f + sc[i]) + sh[i];
                    uint2 o; o.x = pk2(h[0], h[1]); o.y = pk2(h[2], h[3]);
                    { int w8 = __builtin_amdgcn_cvt_pk_fp8_f32(h[0], h[1], 0, false); w8 = __builtin_amdgcn_cvt_pk_fp8_f32(h[2], h[3], w8, true); *(int*)(H2 + (size_t)m * D + col) = w8; }
                    *(uint2*)(Ahi + lr * RS + col * 2) = o;
                }
            }
            if (it < 7) MID_LOAD(m0 + 16);
        }
        asm volatile("s_waitcnt lgkmcnt(0)\n\ts_barrier" ::: "memory");
        {
            f32x4 acc[4];
#pragma unroll
            for (int nb = 0; nb < 4; ++nb) acc[nb] = (f32x4){0.f, 0.f, 0.f, 0.f};
            const bf16_t* wrtlo = (const bf16_t*)(ws + WS_WRT); asm volatile("" : "+s"(wrtlo));
#pragma unroll
            for (int ks = 0; ks < 4; ++ks) {
                const int ko = (wave * 128 + ks * 32 + 8 * fq) * 2;
                const bf16x8 ah = *(const bf16x8*)(Ahi + fr * RS + ko);
#pragma unroll
                for (int nb = 0; nb < 4; ++nb) {
                    const size_t wo_ = ((size_t)(((wave * 4 + ks) * 4 + nb) * 2) * 64 + lane) * 8;
                    const bf16x8 bhv = *(const bf16x8*)(wrtlo + wo_);
                    acc[nb] = __builtin_amdgcn_mfma_f32_16x16x32_bf16(ah, bhv, acc[nb], 0, 0, 0);
                }
            }
#pragma unroll
            for (int nb = 0; nb < 4; ++nb)
#pragma unroll
                for (int j = 0; j < 4; ++j) Pp[(wave * 16 + 4 * fq + j) * 64 + 16 * nb + fr] = acc[nb][j];
        }
        asm volatile("s_waitcnt lgkmcnt(0)\n\ts_barrier" ::: "memory");
#pragma unroll
        for (int rr = 0; rr < 2; ++rr) {
            const int lr = 2 * wave + rr;
            float lg = 0.f;
#pragma unroll
            for (int w = 0; w < 8; ++w) lg += Pp[(w * 16 + lr) * 64 + lane];
            const float score = 1.0f / (1.0f + expf(-lg));
            const float sel = score + rbias;
            float t1 = sel, t2 = -INFINITY;
#define TOP2(M) do { const float o1 = sx<M>(t1), o2 = sx<M>(t2); const float n1 = fmaxf(t1, o1), n2 = fmaxf(fminf(t1, o1), fmaxf(t2, o2)); t1 = n1; t2 = n2; } while (0)
            TOP2(1); TOP2(2); TOP2(4);
#undef TOP2
            const float gs = t1 + t2; const int grp = lane >> 3;
            int gr = 0;
#pragma unroll
            for (int j = 0; j < 8; ++j) { const float sj = __uint_as_float(__builtin_amdgcn_readlane(__float_as_uint(gs), j * 8)); gr += (sj > gs || (sj == gs && j < grp)) ? 1 : 0; }
            const bool gsel = gr < 4;
            float v = gsel ? sel : -INFINITY;
            int rk = TOPK;
#pragma unroll
            for (int it8 = 0; it8 < TOPK; ++it8) {
                const float mx = wave_max(v);
                const unsigned long long eq = __ballot(v == mx);
                const int win = __builtin_ctzll(eq);
                if (lane == win) { rk = it8; v = -INFINITY; }
            }
            const bool chosen = rk < TOPK;
            const float ssum = wave_sum(chosen ? score : 0.f);
            const float w = score / (ssum + 1e-20f) * 2.5f;
            if (chosen) {
                const int lpos = atomicAdd(&lcnt[lane], 1);
                const int idx = (it * 16 + lr) * 8 + rk;
                PE[idx] = lane | (lpos << 8); PW[idx] = w;
            }
        }
      }
      __syncthreads();
      if (tid < 64) { const int c = lcnt[tid]; gb[tid] = c ? (int)atomicAdd(&counts[b * 65 + tid], (unsigned)c) : 0; }
      __syncthreads();
      for (int i = tid; i < 1024; i += NT) {
          const int pe = PE[i], e = pe & 255, pos = gb[e] + (pe >> 8), mk = mc * 8 + i;
          TOKL[((size_t)b * 64 + e) * 8192 + pos] = mk; TE[mk] = e; TP[mk] = pos; TW[mk] = PW[i];
      }
      __syncthreads();
    }
}

constexpr int T_CNT = 0;
constexpr int T_TOT = 256;
constexpr int T_AB = 328;
constexpr int T_OFF = 400;
constexpr int T_GUP = 660;
constexpr int T_YC = 730;
constexpr int T_YB = 990;
constexpr int T_DUP = 1250;
constexpr int T_UL = 1520;
constexpr int T_END = 1520 + 512;
__device__ __forceinline__ int scan_incl(int v, int lane) {
#pragma unroll
    for (int off = 1; off < 64; off <<= 1) { const int t = __builtin_amdgcn_ds_bpermute(((lane - off) & 63) << 2, v); if (lane >= off) v += t; }
    return v;
}
__device__ __forceinline__ void build_moe(const Params& p, int* tab) {
    const unsigned* counts = (const unsigned*)(p.ws + WS_CTL);
    __syncthreads();
    const int tid = otid(), wave = tid >> 6, lane = tid & 63;
    if (wave == 0) {
        const int c0 = (int)counts[0 * 65 + lane], c1 = (int)counts[1 * 65 + lane], c2 = (int)counts[2 * 65 + lane], c3 = (int)counts[3 * 65 + lane];
        tab[T_CNT + 0 * 64 + lane] = c0; tab[T_CNT + 1 * 64 + lane] = c1; tab[T_CNT + 2 * 64 + lane] = c2; tab[T_CNT + 3 * 64 + lane] = c3;
        tab[T_OFF + lane * 4 + 0] = 0; tab[T_OFF + lane * 4 + 1] = c0; tab[T_OFF + lane * 4 + 2] = c0 + c1; tab[T_OFF + lane * 4 + 3] = c0 + c1 + c2;
        const int tot = c0 + c1 + c2 + c3, pad = (tot + 255) & ~255, gu = ((tot + 255) >> 8) * 2;
        const int sp = scan_incl(pad, lane), sg = scan_incl(gu, lane);
        tab[T_TOT + lane] = tot; tab[T_AB + lane] = sp - pad; tab[T_GUP + lane] = sg - gu;
        const int cb[4] = {c0, c1, c2, c3};
#pragma unroll
        for (int b = 0; b < 4; ++b) {
            const int du = ((cb[b] + 255) >> 8) * 4;
            const int sy = scan_incl(cb[b], lane), sd = scan_incl(du, lane);
            tab[T_YB + 65 * b + lane] = sy - cb[b]; tab[T_DUP + 66 * b + lane] = sd - du;
            if (lane == 63) { tab[T_YB + 65 * b + 64] = sy; tab[T_DUP + 66 * b + 64] = sd; tab[T_DUP + 66 * b + 65] = sd + (SEQ / 256) * 4; }
        }
        if (lane == 63) { tab[T_TOT + 64] = T; tab[T_AB + 64] = sp; tab[T_GUP + 64] = sg; tab[T_GUP + 65] = sg + (T / 256) * 2; }
    }
    __syncthreads();
}

__device__ __forceinline__ void moe_decode(const GP_LAS int* tab, int e, int pos_e, int& b, int& pos) {
    const int o1 = tab[T_OFF + e * 4 + 1], o2 = tab[T_OFF + e * 4 + 2], o3 = tab[T_OFF + e * 4 + 3];
    b = (pos_e >= o1 ? 1 : 0) + (pos_e >= o2 ? 1 : 0) + (pos_e >= o3 ? 1 : 0);
    pos = pos_e - (b == 0 ? 0 : (b == 1 ? o1 : (b == 2 ? o2 : o3)));
}
__device__ __forceinline__ int yrow0(int b) { return b == 0 ? 2 * 1024 : (272 + 72 * (b - 1)) * 1024; }
struct MoeSched {
    const GP_LAS int* tab; int G, c, ntn, U, down, chunk; const int* TOKL; const char* Bt;
    __device__ __forceinline__ void prepare(int* tabw, int wv) const {
        if (wv == 0) {
            const int i = lane_id(); int L = i * G + c;
            if (L < U) {
                int bt = 0;
                if (down) {
#pragma unroll
                    for (int q = 0; q < 3; ++q) { const int u0 = tabw[T_DUP + 66 * bt + 65]; if (L >= u0) { L -= u0; ++bt; } } }
                const int pre = down ? T_DUP + 66 * bt : T_GUP;
                int lo = 0, hi = 64;
                while (lo < hi) { const int mid = (lo + hi + 1) >> 1; if (tabw[pre + mid] <= L) lo = mid; else hi = mid - 1; }
                const int loc = L - tabw[pre + lo];
                int cnt, base, bb;
                if (down) { cnt = (lo < 64) ? tabw[T_CNT + bt * 64 + (lo & 63)] : SEQ; base = tabw[T_YB + 65 * bt + lo] + yrow0(bt);
                            bb = tabw[T_AB + lo] + (lo < 64 ? tabw[T_OFF + (lo & 63) * 4 + bt] : bt * SEQ); }
                else { cnt = tabw[T_TOT + lo]; base = tabw[T_AB + lo]; bb = 0; }
                int* ul = tabw + T_UL + 8 * i;
                ul[0] = lo; ul[1] = loc / ntn; ul[2] = loc % ntn; ul[3] = cnt; ul[4] = base; ul[5] = bb;
            }
        }
        __syncthreads();
    }
    __device__ __forceinline__ bool next(int i, gp::Unit& u) const {
        if (i * G + c >= U) return false;
        const GP_LAS int* ul = tab + T_UL + 8 * i;
        u.e = __builtin_amdgcn_readfirstlane(ul[0]); u.pm = __builtin_amdgcn_readfirstlane(ul[1]); u.pn = __builtin_amdgcn_readfirstlane(ul[2]);
        u.cnt = __builtin_amdgcn_readfirstlane(ul[3]); u.base = __builtin_amdgcn_readfirstlane(ul[4]); u.b = __builtin_amdgcn_readfirstlane(ul[5]);
        return true;
    }
    __device__ __forceinline__ unsigned arow(const gp::Unit& u, int r) const {
        const int pos_e = u.pm * 256 + r;
        if (down) return (unsigned)(u.b + pos_e) * 256u;
        int tok;
        if (u.e < 64) { int b, pos; moe_decode(tab, u.e, pos_e, b, pos); tok = (pos_e < u.cnt) ? (TOKL[((size_t)b * 64 + u.e) * 8192 + pos] >> 3) : 0; } else tok = pos_e;
        return (unsigned)tok * 1024u;
    }
    __device__ __forceinline__ const char* bptr(const gp::Unit& u) const {
        return down ? Bt + ((size_t)u.e * 1024 + u.pn * 256) * 256 : Bt + ((size_t)u.e * 512 + u.pn * 256) * 1024;
    }
};
struct EpiGU {
    unsigned char* ACT; const int* TOKL; const float* TW; const GP_LAS int* tab;
    __device__ __forceinline__ void operator()(const f32x4 (&acc)[2][2][4][2], const gp::Unit& u, int wr, int wc, int fr, int fq) const {
#pragma unroll
        for (int ai = 0; ai < 2; ++ai)
#pragma unroll
            for (int m = 0; m < 4; ++m) {
                const int pos_e = u.pm * 256 + ai * 128 + wr * 64 + m * 16 + fr;
                if (pos_e < u.cnt) {
                    float w = 1.0f;
                    if (u.e < 64) { int b, pos; moe_decode(tab, u.e, pos_e, b, pos); w = TW[TOKL[((size_t)b * 64 + u.e) * 8192 + pos]]; }
                    float a[8];
#pragma unroll
                    for (int n = 0; n < 2; ++n)
#pragma unroll
                        for (int i = 0; i < 4; ++i) { const float g = acc[ai][0][m][n][i] * (1.f / GUSCALE), up = acc[ai][1][m][n][i] * (1.f / GUSCALE);
                            a[4 * n + i] = __builtin_amdgcn_fmed3f(g * __builtin_amdgcn_rcpf(1.0f + __builtin_amdgcn_exp2f(-1.4426950408889634f * g)) * up * (w * ASCALE), -448.f, 448.f); }
                    int w0 = __builtin_amdgcn_cvt_pk_fp8_f32(a[0], a[1], 0, false); w0 = __builtin_amdgcn_cvt_pk_fp8_f32(a[2], a[3], w0, true);
                    int w1 = __builtin_amdgcn_cvt_pk_fp8_f32(a[4], a[5], 0, false); w1 = __builtin_amdgcn_cvt_pk_fp8_f32(a[6], a[7], w1, true);
                    uint2 o; o.x = (unsigned)w0; o.y = (unsigned)w1;
                    *(uint2*)(ACT + ((size_t)u.base + pos_e) * DE + u.pn * 128 + wc * 32 + fq * 8) = o;
                }
            }
    }
};
constexpr float YSCALE = 16.f;
struct EpiDown {
    unsigned char* ws;
    __device__ __forceinline__ void operator()(const f32x4 (&acc)[2][2][4][2], const gp::Unit& u, int wr, int wc, int fr, int fq) const {
#pragma unroll
        for (int ai = 0; ai < 2; ++ai)
#pragma unroll
            for (int m = 0; m < 4; ++m) {
                const int pos = u.pm * 256 + ai * 128 + wr * 64 + m * 16 + fr;
                if (pos < u.cnt) {
                    unsigned char* rowp = ws + (size_t)(u.base + pos) * D + u.pn * 256 + wc * 32 + fq * 8;
#pragma unroll
                    for (int bj = 0; bj < 2; ++bj) { const f32x4 v0 = acc[ai][bj][m][0] * (YSCALE / (WDSCALE * ASCALE)), v1 = acc[ai][bj][m][1] * (YSCALE / (WDSCALE * ASCALE));
                        int w0 = __builtin_amdgcn_cvt_pk_fp8_f32(v0[0], v0[1], 0, false); w0 = __builtin_amdgcn_cvt_pk_fp8_f32(v0[2], v0[3], w0, true);
                        int w1 = __builtin_amdgcn_cvt_pk_fp8_f32(v1[0], v1[1], 0, false); w1 = __builtin_amdgcn_cvt_pk_fp8_f32(v1[2], v1[3], w1, true);
                        uint2 o; o.x = (unsigned)w0; o.y = (unsigned)w1;
                        *(uint2*)(rowp + bj * 128) = o; }
                }
            }
    }
};
__device__ __forceinline__ void ph_moe_gu(const Params& p, unsigned char* smem) {
    unsigned char* ws = p.ws;
    int* tab = (int*)(smem + gp::STAGE_BYTES);
    build_moe(p, tab);
    MoeSched S; S.tab = (const GP_LAS int*)tab; S.G = gridDim.x; S.c = (gridDim.x % 8 == 0) ? (int)((blockIdx.x % 8) * (gridDim.x / 8) + blockIdx.x / 8) : (int)blockIdx.x;   S.ntn = 2; S.U = __builtin_amdgcn_readfirstlane(tab[T_GUP + 65]); S.down = 0; S.chunk = 0;
    S.TOKL = (const int*)(ws + WS_TOKL); S.Bt = (const char*)(ws + WS_WGUT);
    S.prepare(tab, p.chunk);
    EpiGU E{ws + WS_ACT, (const int*)(ws + WS_TOKL), (const float*)(ws + WS_TW), (const GP_LAS int*)tab};
    gp::gemm_phase<EpiGU, MoeSched, true, true>(p.chunk, (GP_LAS unsigned char*)smem, (const char*)(ws + WS_H2), D / 2, S, E);
}
__device__ __forceinline__ void ph_moe_down(const Params& p, unsigned char* smem, int c) {
    unsigned char* ws = p.ws;
    int* tab = (int*)(smem + gp::STAGE_BYTES);
    build_moe(p, tab);
    MoeSched S; S.tab = (const GP_LAS int*)tab; S.G = gridDim.x; S.c = (gridDim.x % 8 == 0) ? (int)((blockIdx.x % 8) * (gridDim.x / 8) + blockIdx.x / 8) : (int)blockIdx.x;   S.ntn = 4; S.U = __builtin_amdgcn_readfirstlane(tab[T_DUP + 65] + tab[T_DUP + 66 + 65] + tab[T_DUP + 132 + 65] + tab[T_DUP + 198 + 65]); S.down = 1; S.chunk = c;
    S.TOKL = nullptr; S.Bt = (const char*)(ws + WS_WDT);
    S.prepare(tab, p.chunk);
    EpiDown E{ws};
    gp::gemm_phase<EpiDown, MoeSched, false, true>(p.chunk, (GP_LAS unsigned char*)smem, (const char*)(ws + WS_ACT), DE / 2, S, E);
}

__device__ __forceinline__ void ph_final(const Params& p, float* lds) {
    unsigned char* ws = p.ws;
    int* tab = (int*)lds;
    build_moe(p, tab);
    const int tid = otid(), wave = tid >> 6, lane = tid & 63;
    const int gw = blockIdx.x * NWV + wave, GW = gridDim.x * NWV;
    const int* TE = (const int*)(ws + WS_TE); const int* TP = (const int*)(ws + WS_TP);
    const unsigned char* Y = ws;
    for (int m = gw; m < T; m += GW) {
        const int b = m >> 13, t = m & (SEQ - 1);
        const float* mod = (const float*)(ws + WS_MOD) + b * 6144 + 5 * 1024;
        float acc[16];
#pragma unroll
        for (int i = 0; i < 16; ++i) acc[i] = 0.f;
#pragma unroll
        for (int k = 0; k < 9; ++k) {
            int row;
            if (k < 8) { const int e = TE[m * 8 + k]; row = tab[T_YB + 65 * b + e] + TP[m * 8 + k]; }
            else row = tab[T_YB + 65 * b + 64] + t;
            row += yrow0(b);
            const unsigned char* yr = Y + (size_t)row * D;
#pragma unroll
            for (int j = 0; j < 4; ++j) { const int w = *(const int*)(yr + 4 * (lane + 64 * j));
                acc[4 * j] += __builtin_amdgcn_cvt_f32_fp8(w, 0); acc[4 * j + 1] += __builtin_amdgcn_cvt_f32_fp8(w, 1); acc[4 * j + 2] += __builtin_amdgcn_cvt_f32_fp8(w, 2); acc[4 * j + 3] += __builtin_amdgcn_cvt_f32_fp8(w, 3); }
        }
        float ss = 0.f;
#pragma unroll
        for (int i = 0; i < 16; ++i) { acc[i] *= (1.f / YSCALE); ss += acc[i] * acc[i]; }
        ss = wave_sum(ss);
        const float rs = 1.0f / sqrtf(ss * (1.0f / D) + EPS);
#pragma unroll
        for (int j = 0; j < 4; ++j) {
            const int col = 4 * (lane + 64 * j);
            const f32x4 gp = *(const f32x4*)(p.in[I_GFPOST] + col), gt = *(const f32x4*)(mod + col);
            f32x4 x1 = ((const f32x4*)(p.out + (size_t)m * D))[lane + 64 * j];
#pragma unroll
            for (int i = 0; i < 4; ++i) x1[i] += gt[i] * (acc[4 * j + i] * rs * gp[i]);
            ((f32x4*)(p.out + (size_t)m * D))[lane + 64 * j] = x1;
        }
    }
}

#define GAS __attribute__((address_space(1)))
#define LAS __attribute__((address_space(3)))
#define XB_TMO      128
#define XB_XCNT(j)  (256  + 64 * (j))
#define XB_XSUB(j)  (1280 + 64 * (j))
#define XB_XGEN(j)  (2304 + 64 * (j))
#define XB_TOP      3328
#define XB_TOPGEN   3392
#define XCD_BAR_WORDS 3456
#define XB_SPIN_CAP (1u << 21)
__device__ __forceinline__ unsigned xb_ld(unsigned* p)              { return __hip_atomic_load(p, __ATOMIC_RELAXED, __HIP_MEMORY_SCOPE_AGENT); }
__device__ __forceinline__ unsigned xb_add(unsigned* p, unsigned v) { return __hip_atomic_fetch_add(p, v, __ATOMIC_RELAXED, __HIP_MEMORY_SCOPE_AGENT); }
__device__ __forceinline__ unsigned xb_xcc_id() { return (unsigned)__builtin_amdgcn_s_getreg((3 << 11) | 20) & 0xFu; }
#define XB_SPIN(cond, bar) do { unsigned _sp = 0; while (cond) { __builtin_amdgcn_s_sleep(1); \
    if ((++_sp & 255u) == 0u) { if (xb_ld(&(bar)[XB_TMO])) break; if (_sp > XB_SPIN_CAP) { atomicAdd(&(bar)[XB_TMO], 1u); break; } } } } while (0)
struct XcdBarrier { unsigned* bar; unsigned x; volatile LAS unsigned* st; };
__device__ __forceinline__ XcdBarrier xcd_barrier_post(unsigned* bar, volatile LAS unsigned* st, int wv) {
    XcdBarrier b; b.bar = bar; b.x = xb_xcc_id(); b.st = st;
    if (wv == 0 && lane_id() == 0) (void)xb_add(&bar[XB_XCNT(b.x)], 1u);
    return b;
}
__device__ __forceinline__ void xcd_barrier_complete(unsigned* bar, unsigned x, unsigned& nloc, unsigned& nx) {
    const unsigned G = gridDim.x * gridDim.y * gridDim.z;
    unsigned sum, cnt, mine, sp = 0u;
    for (;;) {
        sum = 0u; cnt = 0u; mine = 0u;
#pragma unroll
        for (unsigned j = 0; j < 16; ++j) { const unsigned c = xb_ld(&bar[XB_XCNT(j)]); sum += c; cnt += (c > 0u) ? 1u : 0u; mine = (j == x) ? c : mine; }
        if (sum == G) break;
        __builtin_amdgcn_s_sleep(1);
        if ((++sp & 255u) == 0u) { if (xb_ld(&bar[XB_TMO])) break; if (sp > XB_SPIN_CAP) { atomicAdd(&bar[XB_TMO], 1u); break; } }
    }
    nloc = mine > 0u ? mine : 1u; nx = cnt > 0u ? cnt : 1u;
}
__device__ __forceinline__ void xcd_barrier(const XcdBarrier& b, int wv) {
    asm volatile("s_waitcnt vmcnt(0)" ::: "memory");
    __syncthreads();
    if (wv == 0 && lane_id() == 0) {
        unsigned* bar = b.bar;
        __builtin_amdgcn_s_waitcnt(0);
        unsigned nloc = b.st[0], nx = b.st[1];
        if (nloc == 0u) { xcd_barrier_complete(bar, b.x, nloc, nx); b.st[0] = nloc; b.st[1] = nx; }
        const unsigned old = xb_add(&bar[XB_XSUB(b.x)], 1u);
        const unsigned gen = old / nloc;
        if (old + 1u == (gen + 1u) * nloc) {
            __builtin_amdgcn_fence(__ATOMIC_RELEASE, "agent");
            asm volatile("s_waitcnt vmcnt(0)" ::: "memory");
            const unsigned og = xb_add(&bar[XB_TOP], 1u);
            const unsigned tg = og / nx;
            if (og + 1u == (tg + 1u) * nx) xb_add(&bar[XB_TOPGEN], 1u);
            else XB_SPIN(xb_ld(&bar[XB_TOPGEN]) == tg, bar);
            __builtin_amdgcn_fence(__ATOMIC_ACQUIRE, "agent");
            xb_add(&bar[XB_XGEN(b.x)], 1u);
            asm volatile("s_waitcnt vmcnt(0)" ::: "memory");
        } else {
            XB_SPIN(xb_ld(&bar[XB_XGEN(b.x)]) == gen, bar);
            __builtin_amdgcn_fence(__ATOMIC_ACQUIRE, "agent");
            asm volatile("s_waitcnt vmcnt(0)" ::: "memory");
        }
    }
    __syncthreads();
}

namespace cg = cooperative_groups;
constexpr int LDS_BYTES = 144 * 1024;
typedef const __attribute__((address_space(4))) Params* KP;
__device__ __forceinline__ Params kargs() {
    Params p;
#if defined(__HIP_DEVICE_COMPILE__)
    typedef const __attribute__((address_space(4))) unsigned long long* KQ;
    KQ kq = (KQ)__builtin_amdgcn_kernarg_segment_ptr(); asm volatile("" : "+s"(kq));
    unsigned long long* d = (unsigned long long*)&p;
#pragma unroll
    for (int i = 0; i < (int)(sizeof(Params) / 8); ++i) d[i] = kq[i];
#endif
    return p;
}
#define PH(call) do { Params p = kargs(); p.chunk = wv; call; } while (0)
__global__ void __launch_bounds__(NT) mega_fwd(Params p_unused) {
    extern __shared__ __attribute__((aligned(16))) unsigned char smem[];
    float* lds = (float*)smem;
    volatile LAS unsigned* misc = (volatile LAS unsigned*)((LAS unsigned char*)smem + (LDS_BYTES - 64));
    if (threadIdx.x < 16) misc[threadIdx.x] = 0u;
    __syncthreads();
    unsigned* barw; { const Params p = kargs(); barw = (unsigned*)(p.ws + WS_CTL) + 4096; }
    const int wv = __builtin_amdgcn_readfirstlane(threadIdx.x >> 6);
    const XcdBarrier bar = xcd_barrier_post(barw, misc, wv);
#define SYNC() xcd_barrier(bar, wv)
    PH(ph_prep(p, lds)); PH(ph_prep_weights(p, lds, 0, 0));   SYNC();
    PH(ph_norm1(p));                SYNC();
    PH(ph_inproj(p, smem)); PH(ph_prep_weights(p, lds, 1, (MTOT / 256) * (INW / 256) % (int)gridDim.x));         SYNC();
    PH(ph_attn(p, smem)); PH(ph_fourierA(p, smem));  SYNC();
    PH(ph_fourierB(p, smem));       SYNC();
    PH(ph_outproj(p, smem));        SYNC();
    PH(ph_mid(p, smem));            SYNC();
    PH(ph_moe_gu(p, smem));         SYNC();
#pragma unroll 1
    PH(ph_moe_down(p, smem, 0));    SYNC();
    PH(ph_final(p, lds));
#undef SYNC
}

extern "C" void kernel_launch(void* const* d_in, const int* in_sizes, int n_in, void* d_out, int out_size, void* d_ws, size_t ws_size, hipStream_t stream) {
    if (n_in != 26 || ws_size < WS_END) { fprintf(stderr, "kernel_launch: unexpected n_in %d / ws %zu\n", n_in, ws_size); return; }
    static int grid_blocks = 0;
    if (!grid_blocks) {
        int dev = 0, cus = 0, per_cu = 0;
        (void)hipGetDevice(&dev);
        (void)hipDeviceGetAttribute(&cus, hipDeviceAttributeMultiprocessorCount, dev);
        (void)hipFuncSetAttribute((const void*)mega_fwd, hipFuncAttributeMaxDynamicSharedMemorySize, LDS_BYTES);
        (void)hipOccupancyMaxActiveBlocksPerMultiprocessor(&per_cu, (const void*)mega_fwd, NT, LDS_BYTES);
        if (per_cu < 1) { fprintf(stderr, "kernel_launch: occupancy query says %d blocks/CU\n", per_cu); per_cu = 1; }
        if (per_cu > 1) per_cu = 1;
        grid_blocks = cus * per_cu;
    }
    Params p{};
    for (int i = 0; i < 26; ++i) p.in[i] = (const float*)d_in[i];
    p.out = (float*)d_out; p.ws = (unsigned char*)d_ws; p.chunk = 0; p.pad = 0;
    (void)hipMemsetAsync((char*)d_ws + WS_CTL, 0, 32768, stream);
    void* args[] = {&p};
    hipError_t e = hipLaunchCooperativeKernel((const void*)mega_fwd, dim3(grid_blocks), dim3(NT), args, LDS_BYTES, stream);
    if (e != hipSuccess) fprintf(stderr, "cooperative launch failed: %s (grid %d)\n", hipGetErrorString(e), grid_blocks);
}
```

```cpp
#include <hip/hip_runtime.h>
#include <hip/hip_cooperative_groups.h>
#include <cstdio>
#include <cstdint>

typedef unsigned short bf16_t;
typedef float f32x4 __attribute__((ext_vector_type(4)));

constexpr int D = 1024, BATCH = 4, SEQ = 8192, T = BATCH * SEQ, CTX = 256, TC = BATCH * CTX;
constexpr int MTOT = T + TC;
constexpr int KVLEN = CTX + SEQ;
constexpr int INW = 2560, NH = 6, QKW = 768, FW = 256;
constexpr int NE = 64, DE = 256, TOPK = 8;
constexpr int NT = 512, NWV = 8;
constexpr int SLOTS_B = 90112;
constexpr float EPS = 1e-6f;
constexpr float LAM_INIT = 0.2f;
constexpr float QSCALE = 0.125f * 1.4426950408889634f;
constexpr float SQS = 0.42466090014400953f;

constexpr size_t MiB = 1u << 20;
constexpr size_t WS_CTL = 0;
constexpr size_t WS_MOD = 1 * MiB;
constexpr size_t WS_TABW = WS_MOD + 128 * 1024;
constexpr size_t WS_ROPE = WS_MOD + 192 * 1024;
constexpr size_t WS_GCS = WS_MOD + 256 * 1024;
constexpr size_t WS_W128E = WS_MOD + 768 * 1024;
constexpr size_t WS_M64E = WS_MOD + 832 * 1024;
constexpr size_t WS_GT = WS_MOD + 864 * 1024;
constexpr size_t WS_WRT = WS_MOD + 512 * 1024;
constexpr size_t WS_WINT = 2 * MiB;
constexpr size_t WS_WOUTT = 7 * MiB;
constexpr size_t WS_WGUT = 9 * MiB;
constexpr size_t WS_WDT = 74 * MiB;
constexpr size_t WS_TE = 107 * MiB;
constexpr size_t WS_TP = 108 * MiB;
constexpr size_t WS_TW = 109 * MiB;
constexpr size_t WS_TOKL = 110 * MiB;
constexpr size_t WS_AO = 118 * MiB;
constexpr size_t WS_ACT = 118 * MiB;
constexpr size_t WS_Q = 182 * MiB;
constexpr size_t WS_K = 230 * MiB;
constexpr size_t WS_V = WS_K + (size_t)BATCH * KVLEN * QKW * 2;
constexpr size_t WS_F = 329 * MiB;
constexpr size_t WS_FY = 361 * MiB;
constexpr size_t WS_HX = 425 * MiB;
constexpr size_t WS_YX = 358 * MiB;
constexpr size_t WS_H2 = 294 * MiB;
constexpr size_t WS_Y = 294 * MiB;
constexpr size_t WS_END = 491 * MiB;

struct Params {
    const float* in[26];
    float* out;
    unsigned char* ws;
    int chunk;
    int pad;
};
enum { I_X = 0, I_C, I_CTX, I_CCTX, I_WMOD, I_BMOD, I_GAPRE, I_GAPOST, I_WIN, I_WF, I_LQ1, I_LK1, I_LQ2, I_LK2, I_GSUB, I_WOUT,
       I_GFPRE, I_GFPOST, I_WR, I_RB, I_WG, I_WU, I_WD, I_WSG, I_WSU, I_WSD };

__device__ __forceinline__ float bf2f(bf16_t v) { return __uint_as_float(((unsigned)v) << 16); }
__device__ __forceinline__ bf16_t f2bf(float f) { unsigned u = __float_as_uint(f); return (bf16_t)((u + 0x7fffu + ((u >> 16) & 1u)) >> 16); }
__device__ __forceinline__ unsigned pk2(float lo, float hi) { return (unsigned)f2bf(lo) | ((unsigned)f2bf(hi) << 16); }
template <int M> __device__ __forceinline__ float sx(float v) { return __int_as_float(__builtin_amdgcn_ds_swizzle(__float_as_int(v), (M << 10) | 0x1f)); }
template <int M> __device__ __forceinline__ int sxi(int v) { return __builtin_amdgcn_ds_swizzle(v, (M << 10) | 0x1f); }
__device__ __forceinline__ float wave_sum(float v) {
    v += sx<1>(v); v += sx<2>(v); v += sx<4>(v); v += sx<8>(v); v += sx<16>(v);
    auto rr = __builtin_amdgcn_permlane32_swap(__float_as_uint(v), __float_as_uint(v), false, false);
    return __uint_as_float(rr[0]) + __uint_as_float(rr[1]);
}
__device__ __forceinline__ float dpp_f(float v, const int ctrl_sel) {
    const int x = __float_as_int(v); int r;
    if (ctrl_sel == 0) r = __builtin_amdgcn_update_dpp(x, x, 0xB1, 0xf, 0xf, false);
    else if (ctrl_sel == 1) r = __builtin_amdgcn_update_dpp(x, x, 0x4E, 0xf, 0xf, false);
    else if (ctrl_sel == 2) r = __builtin_amdgcn_update_dpp(x, x, 0x141, 0xf, 0xf, false);
    else r = __builtin_amdgcn_update_dpp(x, x, 0x140, 0xf, 0xf, false);
    return __int_as_float(r);
}
__device__ __forceinline__ float wave_max(float v) {
    v = fmaxf(v, dpp_f(v, 0)); v = fmaxf(v, dpp_f(v, 1)); v = fmaxf(v, dpp_f(v, 2)); v = fmaxf(v, dpp_f(v, 3));
    const float a = __uint_as_float(__builtin_amdgcn_readlane(__float_as_uint(v), 0)), b = __uint_as_float(__builtin_amdgcn_readlane(__float_as_uint(v), 16));
    const float c = __uint_as_float(__builtin_amdgcn_readlane(__float_as_uint(v), 32)), d = __uint_as_float(__builtin_amdgcn_readlane(__float_as_uint(v), 48));
    return fmaxf(fmaxf(a, b), fmaxf(c, d));
}
__device__ __forceinline__ int lane_id() { int l; asm volatile("v_mbcnt_lo_u32_b32 %0, -1, 0\n\tv_mbcnt_hi_u32_b32 %0, -1, %0" : "=v"(l)); return l; }
__device__ __forceinline__ int otid_w(int wv) { return wv * 64 + lane_id(); }
#define otid() otid_w(p.chunk)
__device__ __forceinline__ float silu_f(float x) { return x / (1.f + expf(-x)); }

__device__ __forceinline__ void ph_prep(const Params& p, float* lds) {
    const int tid = otid(), bid = blockIdx.x, nblk = gridDim.x;
    const int gt = bid * NT + tid, GT = nblk * NT;
    unsigned char* ws = p.ws;
    float2* tabw = (float2*)(ws + WS_TABW);
    for (int i = gt; i < 8192; i += GT) { float s, c; sincospif((float)i * (1.0f / 4096.0f), &s, &c); tabw[i] = make_float2(c, s); }
    float* rope = (float*)(ws + WS_ROPE);
    for (int i = gt; i < 192 * 16; i += GT) {
        const int pos = (i < 2048) ? (i >> 4) : ((i - 2048) >> 4); const int f = i & 15;
        const float inv = powf(10000.0f, -(float)(2 * f) / 32.0f); const float ang = (float)pos * inv;
        const float c = cosf(ang), s = sinf(ang);
        if (i < 2048) { rope[i] = c; rope[2048 + i] = s; } else { rope[4096 + (i - 2048)] = c; rope[4096 + 1024 + (i - 2048)] = s; }
    }
    { bf16_t* gt = (bf16_t*)(ws + WS_GT); const float* wf = p.in[I_WF];
      for (int i = bid * NT + tid; i < 4 * 64 * 128; i += GT) {
        const int g = i >> 13, d = (i >> 7) & 63, part = (i >> 6) & 1, c = i & 63;
        float a = 0.f;
        for (int j = 0; j < 64; ++j) { float s, co; sincospif((float)((c * j) & 63) * (1.0f / 32.0f), &s, &co); a += (part ? s : co) * wf[(g * 64 + j) * 64 + d]; }
        gt[i] = f2bf(a * 0.0013810679320049757f);
      }
      bf16_t* w128 = (bf16_t*)(ws + WS_W128E);
      for (int i = bid * NT + tid; i < 256 * 128; i += GT) { const int kk = i >> 7, n1 = i & 127; float s, co; sincospif((float)(((kk & 127) * n1) & 127) * (1.0f / 64.0f), &s, &co); w128[i] = f2bf(kk < 128 ? co : -s); }
      bf16_t* m64 = (bf16_t*)(ws + WS_M64E);
      for (int i = bid * NT + tid; i < 128 * 128; i += GT) { const int ro = i >> 7, ci = i & 127, po = ro >> 6, k2 = ro & 63, pi = ci >> 6, n2 = ci & 63;
        float s, co; sincospif((float)((k2 * n2) & 63) * (1.0f / 32.0f), &s, &co); m64[i] = f2bf(po == pi ? co : (po == 0 ? s : -s)); }
    }
    {
      bf16_t* wrt = (bf16_t*)(ws + WS_WRT); const float* wr = p.in[I_WR];
      for (int i = gt; i < 64 * 1024; i += GT) {
        const int j = i & 7, ln = (i >> 3) & 63, nb = (i >> 9) & 3, ks = (i >> 11) & 3, wv_ = i >> 13;
        const int e = 16 * nb + (ln & 15), k = wv_ * 128 + ks * 32 + 8 * (ln >> 4) + j;
        const float w = wr[k * 64 + e]; const bf16_t h = f2bf(w);
        const int o = ((((wv_ * 4 + ks) * 4 + nb) * 2) * 64 + ln) * 8 + j;
        wrt[o] = h; wrt[o + 512] = f2bf(w - bf2f(h)); } }
    if (gt == 0) {
        float s1 = 0.f, s2 = 0.f;
        for (int i = 0; i < 64; ++i) { s1 += p.in[I_LQ1][i] * p.in[I_LK1][i]; s2 += p.in[I_LQ2][i] * p.in[I_LK2][i]; }
        ((float*)(ws + WS_CTL))[1024] = expf(s1) - expf(s2) + LAM_INIT;
    }
    float* sc = lds;
    float* red = lds + 5 * 1024;
    for (int i = tid; i < 5 * 1024; i += NT) { const int r = i >> 10, k = i & 1023; const float v = (r < 4) ? p.in[I_C][r * 1024 + k] : p.in[I_CCTX][k]; sc[i] = silu_f(v); }
    __syncthreads();
    const int wave = tid >> 6, lane = tid & 63;
    float* mod = (float*)(ws + WS_MOD);
    for (int task = bid; task < 96; task += nblk) {
        const int col = task * 64 + lane;
        float a0 = 0, a1 = 0, a2 = 0, a3 = 0, a4 = 0;
        const float* wm = p.in[I_WMOD];
#pragma unroll 32
        for (int k = wave * 128; k < wave * 128 + 128; ++k) { const float w = wm[(size_t)k * 6144 + col]; a0 += sc[k] * w; a1 += sc[1024 + k] * w; a2 += sc[2048 + k] * w; a3 += sc[3072 + k] * w; a4 += sc[4096 + k] * w; }
        red[(wave * 5 + 0) * 64 + lane] = a0; red[(wave * 5 + 1) * 64 + lane] = a1; red[(wave * 5 + 2) * 64 + lane] = a2; red[(wave * 5 + 3) * 64 + lane] = a3; red[(wave * 5 + 4) * 64 + lane] = a4;
        __syncthreads();
        if (tid < 320) { const int r = tid >> 6, l = tid & 63; float s = 0.f; for (int w = 0; w < 8; ++w) s += red[(w * 5 + r) * 64 + l]; mod[r * 6144 + task * 64 + l] = s + p.in[I_BMOD][task * 64 + l]; }
        __syncthreads();
    }
}

__device__ __forceinline__ void ph_norm1(const Params& p) {
    const int tid = otid(), wave = tid >> 6, lane = tid & 63;
    const int gw = blockIdx.x * NWV + wave, GW = gridDim.x * NWV;
    const float* mod = (const float*)(p.ws + WS_MOD);
    bf16_t* hx = (bf16_t*)(p.ws + WS_HX);
    const float* g = p.in[I_GAPRE];
    for (int m = gw; m < MTOT; m += GW) {
        const float* src = (m < T) ? p.in[I_X] + (size_t)m * D : p.in[I_CTX] + (size_t)(m - T) * D;
        const int r = (m < T) ? (m >> 13) : 4;
        const float* shift = mod + r * 6144; const float* scale = shift + 1024;
        f32x4 v[4]; float ss = 0.f;
#pragma unroll
        for (int j = 0; j < 4; ++j) { v[j] = ((const f32x4*)src)[lane + 64 * j]; ss += v[j][0] * v[j][0] + v[j][1] * v[j][1] + v[j][2] * v[j][2] + v[j][3] * v[j][3]; }
        ss = wave_sum(ss);
        const float rs = 1.0f / sqrtf(ss * (1.0f / D) + EPS);
#pragma unroll
        for (int j = 0; j < 4; ++j) {
            const int col = 4 * (lane + 64 * j);
            const f32x4 g4 = *(const f32x4*)(g + col), sc4 = *(const f32x4*)(scale + col), sh4 = *(const f32x4*)(shift + col);
            float h[4];
#pragma unroll
            for (int i = 0; i < 4; ++i) h[i] = v[j][i] * rs * g4[i] * (1.f + sc4[i]) + sh4[i];
            uint2 o; o.x = pk2(h[0], h[1]); o.y = pk2(h[2], h[3]);
            *(uint2*)(hx + (size_t)m * D + col) = o;
        }
    }
}

namespace gp {
#define GP_LAS __attribute__((address_space(3)))
typedef short bf16x8 __attribute__((ext_vector_type(8)));
typedef unsigned u32x4 __attribute__((ext_vector_type(4)));
typedef int i32x4 __attribute__((ext_vector_type(4)));
constexpr int BM = 256, BK = 64, HALF = 128, HTB = HALF * BK * 2, STAGE_BYTES = 8 * HTB;
__device__ __forceinline__ int lds_byte(int r, int c) { const int st = (r >> 4) * 2 + (c >> 5), rr = r & 15, cc = c & 31, ob = rr * 64 + cc * 2; return st * 1024 + (ob ^ (((ob >> 9) & 1) << 5)); }
__device__ __forceinline__ void stage_rc(int b, int& R, int& C) { const int st = b / 1024, sb = b % 1024, swz = sb ^ (((sb >> 9) & 1) << 5); R = (st >> 1) * 16 + swz / 64; C = (st & 1) * 32 + (swz % 64) / 2; }
__device__ __forceinline__ int perm32(int rho) { const int n = rho >> 4, i = rho & 15; return 8 * (i >> 2) + 4 * n + (i & 3); }
struct Unit { int pm, pn, e, b, cnt, base; };
__device__ __forceinline__ unsigned cvt_pk_bf16(float lo, float hi) { unsigned r; asm volatile("v_cvt_pk_bf16_f32 %0, %1, %2" : "=v"(r) : "v"(lo), "v"(hi)); return r; }

template <class Epi, class Sched, bool ALIGN_EPI, bool F8 = false>
__device__ __forceinline__ void gemm_phase(const int wv, GP_LAS unsigned char* lds, const char* Abase, const int K, const Sched& S, const Epi& E) {
    const int wid = wv, wr = wid >> 2, wc = wid & 3;
    const int nt = K / BK;
    unsigned voffB[2];
#pragma unroll
    for (int i = 0; i < 2; ++i) { int R, C; stage_rc(otid_w(wv) * 16 + i * 8192, R, C); const int Rb = (R & ~31) + perm32(R & 31); voffB[i] = (unsigned)(Rb * K + C) * 2u; }
#define GP_AOFFS(u, o00, o01, o10, o11) do { int R0, C0, R1, C1; const int t_ = otid_w(wv); stage_rc(t_ * 16, R0, C0); stage_rc(t_ * 16 + 8192, R1, C1); \
        o00 = S.arow(u, R0) + (unsigned)C0 * 2u; o01 = S.arow(u, R1) + (unsigned)C1 * 2u; o10 = S.arow(u, HALF + R0) + (unsigned)C0 * 2u; o11 = S.arow(u, HALF + R1) + (unsigned)C1 * 2u; } while (0)
    const size_t kstep = (size_t)(BK * 2);
    const size_t hstep = (size_t)HALF * K * 2;
    const unsigned ldsw = (unsigned)wid * 1024u;
    int aoff, boff; { const int l_ = lane_id(), fr = l_ & 15, fq = l_ >> 4; aoff = lds_byte(wr * 64 + fr, fq * 8); boff = lds_byte(wc * 32 + fr, fq * 8); }
#define GP_SA(b, h) (((b) * 2 + (h)) * HTB)
#define GP_SB(b, h) ((4 + (b) * 2 + (h)) * HTB)
#define GP_STAGE_B(bufoff, gbase) do { _Pragma("unroll") for (int _i = 0; _i < 2; ++_i) \
        __builtin_amdgcn_global_load_lds((const unsigned*)((const char*)(gbase) + voffB[_i]), (GP_LAS unsigned*)(lds + (bufoff) + ldsw + _i * 8192), 16, 0, 0); } while (0)
#define GP_STAGE_A(bufoff, gbase, o0, o1) do { \
        __builtin_amdgcn_global_load_lds((const unsigned*)((const char*)(gbase) + (o0)), (GP_LAS unsigned*)(lds + (bufoff) + ldsw), 16, 0, 0); \
        __builtin_amdgcn_global_load_lds((const unsigned*)((const char*)(gbase) + (o1)), (GP_LAS unsigned*)(lds + (bufoff) + ldsw + 8192), 16, 0, 0); } while (0)
#define GP_LDA(dst, b, h) do { _Pragma("unroll") for (int m = 0; m < 4; ++m) _Pragma("unroll") for (int k = 0; k < 2; ++k) dst[m][k] = *(const GP_LAS bf16x8*)(lds + GP_SA(b, h) + aoff + m * 2048 + k * 1024); } while (0)
#define GP_LDB(dst, b, h) do { _Pragma("unroll") for (int n = 0; n < 2; ++n) _Pragma("unroll") for (int k = 0; k < 2; ++k) dst[n][k] = *(const GP_LAS bf16x8*)(lds + GP_SB(b, h) + boff + n * 2048 + k * 1024); } while (0)
#define GP_CAT8(x) __builtin_shufflevector(__builtin_bit_cast(i32x4, x[0]), __builtin_bit_cast(i32x4, x[1]), 0, 1, 2, 3, 4, 5, 6, 7)
#define GP_MMA(ai, bj, At, Bt) do { __builtin_amdgcn_s_setprio(1); _Pragma("unroll") for (int m = 0; m < 4; ++m) _Pragma("unroll") for (int n = 0; n < 2; ++n) { \
        if constexpr (F8) acc[ai][bj][m][n] = __builtin_amdgcn_mfma_scale_f32_16x16x128_f8f6f4(GP_CAT8(Bt[n]), GP_CAT8(At[m]), acc[ai][bj][m][n], 0, 0, 0, 0, 0, 0); \
        else { _Pragma("unroll") for (int k = 0; k < 2; ++k) acc[ai][bj][m][n] = __builtin_amdgcn_mfma_f32_16x16x32_bf16(Bt[n][k], At[m][k], acc[ai][bj][m][n], 0, 0, 0); } } \
        __builtin_amdgcn_s_setprio(0); } while (0)
#define GP_WAIT_V(n) asm volatile("s_waitcnt vmcnt(" #n ")" ::: "memory")
#define GP_WAIT_L(n) asm volatile("s_waitcnt lgkmcnt(" #n ")" ::: "memory")
#define GP_BAR __builtin_amdgcn_s_barrier()
#define GP_SCHED __builtin_amdgcn_sched_barrier(0)
    Unit cur, nxt; int ui = 0;
    if (!S.next(0, cur)) return;
    f32x4 acc[2][2][4][2];
#pragma unroll
    for (int a = 0; a < 2; ++a)
#pragma unroll
        for (int b = 0; b < 2; ++b)
#pragma unroll
            for (int m = 0; m < 4; ++m)
#pragma unroll
                for (int n = 0; n < 2; ++n) acc[a][b][m][n] = (f32x4){0.f, 0.f, 0.f, 0.f};
    bf16x8 At[4][2], B0[2][2], B1[2][2];
    unsigned ac00, ac01, ac10, ac11, an00, an01, an10, an11;
    GP_AOFFS(cur, ac00, ac01, ac10, ac11);
    const char* cB = S.bptr(cur);
    GP_STAGE_B(GP_SB(0, 0), cB); GP_STAGE_B(GP_SB(0, 1), cB + hstep); GP_STAGE_A(GP_SA(0, 0), Abase, ac00, ac01); GP_STAGE_A(GP_SA(0, 1), Abase, ac10, ac11);
    if (wr == 1) GP_BAR;
    GP_WAIT_V(2); GP_BAR;
    GP_STAGE_B(GP_SB(1, 0), cB + kstep); GP_STAGE_A(GP_SA(1, 0), Abase + kstep, ac00, ac01); GP_STAGE_B(GP_SB(1, 1), cB + hstep + kstep);
    GP_WAIT_V(6); GP_BAR;
    for (;;) {
        const bool has_next = S.next(ui + 1, nxt);
        if (has_next) { GP_AOFFS(nxt, an00, an01, an10, an11); }
        else { an00 = ac00; an01 = ac01; an10 = ac10; an11 = ac11; }
        const char* nB = has_next ? S.bptr(nxt) : cB;
#pragma unroll 1
        for (int t = 0; t < nt; t += 2) {
            const bool last = (t == nt - 2);
            const char* a1 = Abase + (size_t)(t + 1) * kstep;
            const char* a2 = last ? Abase : Abase + (size_t)(t + 2) * kstep; const char* b2 = last ? nB : cB + (size_t)(t + 2) * kstep;
            const char* a3 = a2 + kstep; const char* b3 = b2 + kstep;
            asm volatile("" : "+s"(a1), "+s"(a2), "+s"(b2), "+s"(a3), "+s"(b3));
            GP_LDB(B0, 0, 0); GP_LDB(B1, 0, 1); GP_SCHED; GP_LDA(At, 0, 0); GP_STAGE_A(GP_SA(1, 1), a1, ac10, ac11);
            if (last) { ac00 = an00; ac01 = an01; ac10 = an10; ac11 = an11; }
            GP_WAIT_V(8); GP_WAIT_L(0); GP_BAR; GP_MMA(0, 0, At, B0); GP_MMA(0, 1, At, B1); GP_BAR; GP_SCHED;
            GP_LDA(At, 0, 1); GP_STAGE_B(GP_SB(0, 0), b2); GP_STAGE_B(GP_SB(0, 1), b2 + hstep); GP_STAGE_A(GP_SA(0, 0), a2, ac00, ac01);
            GP_WAIT_V(8); GP_WAIT_L(0); GP_BAR; GP_MMA(1, 0, At, B0); GP_MMA(1, 1, At, B1); GP_BAR; GP_SCHED;
            GP_LDB(B0, 1, 0); GP_LDB(B1, 1, 1); GP_SCHED; GP_LDA(At, 1, 0); GP_STAGE_A(GP_SA(0, 1), a2, ac10, ac11);
            GP_WAIT_V(8); GP_WAIT_L(0); GP_BAR; GP_MMA(0, 0, At, B0); GP_MMA(0, 1, At, B1); GP_BAR; GP_SCHED;
            GP_LDA(At, 1, 1); GP_STAGE_B(GP_SB(1, 0), b3); GP_STAGE_B(GP_SB(1, 1), b3 + hstep); GP_STAGE_A(GP_SA(1, 0), a3, ac00, ac01);
            GP_WAIT_V(8); GP_WAIT_L(0); GP_BAR; GP_MMA(1, 0, At, B0); GP_MMA(1, 1, At, B1); GP_BAR; GP_SCHED;
        }
        if constexpr (ALIGN_EPI) { if (wr == 0) GP_BAR; }
        { const int l_ = lane_id(); E(acc, cur, wr, wc, l_ & 15, l_ >> 4); }
        if (!has_next) break;
#pragma unroll
        for (int a = 0; a < 2; ++a)
#pragma unroll
            for (int b = 0; b < 2; ++b)
#pragma unroll
                for (int m = 0; m < 4; ++m)
#pragma unroll
                    for (int n = 0; n < 2; ++n) acc[a][b][m][n] = (f32x4){0.f, 0.f, 0.f, 0.f};
        cur = nxt; cB = nB; ++ui;
        if constexpr (ALIGN_EPI) { if (wr == 1) GP_BAR; }
    }
    GP_WAIT_V(0);
    if constexpr (!ALIGN_EPI) { if (wr == 0) GP_BAR; }
    GP_BAR;
#undef GP_AOFFS
#undef GP_SA
#undef GP_SB
#undef GP_STAGE_A
#undef GP_STAGE_B
#undef GP_LDA
#undef GP_LDB
#undef GP_MMA
#undef GP_CAT8
#undef GP_WAIT_V
#undef GP_WAIT_L
#undef GP_BAR
#undef GP_SCHED
}

struct DenseSched {
    int nM, nN, nwg, G, c, K; const char* Bt;
    __device__ __forceinline__ void init(int M, int N, int K_, const void* Bt_, int G_, int c_) { nM = M / BM; nN = N / BM; nwg = nM * nN; G = G_; c = c_; K = K_; Bt = (const char*)Bt_; }
    __device__ __forceinline__ bool next(int i, Unit& u) const {
        const long L = (long)i * G + c; if (L >= nwg) return false;
        int wgid = (int)L; { const int q = nwg / 8, r = nwg % 8, xcd = wgid % 8, off = wgid / 8; wgid = (xcd < r ? xcd * (q + 1) : r * (q + 1) + (xcd - r) * q) + off; }
        const int nig = 8 * nN, gid = wgid / nig, fm = gid * 8, gsz = (nM - fm) < 8 ? (nM - fm) : 8;
        u.pm = fm + ((wgid % nig) % gsz); u.pn = (wgid % nig) / gsz; u.e = 0; u.b = 0; u.cnt = 0; u.base = 0; return true;
    }
    __device__ __forceinline__ unsigned arow(const Unit& u, int r) const { return (unsigned)(u.pm * BM + r) * (unsigned)(K * 2); }
    __device__ __forceinline__ const char* bptr(const Unit& u) const { return Bt + (size_t)u.pn * BM * K * 2; }
};
}

struct EpiInProj {
    bf16_t* F; bf16_t* Q; bf16_t* Kb; bf16_t* Vb; const float* rope;
    __device__ __forceinline__ void operator()(const f32x4 (&acc)[2][2][4][2], const gp::Unit& u, int wr, int wc, int fr, int fq) const {
        const int pn = u.pn, pm = u.pm; const bool isctx = pm >= T / 256;
        if (isctx && pn < 4) return;
        if (pn >= 7) {
            unsigned char* V8 = (unsigned char*)Vb;
#pragma unroll
            for (int ai = 0; ai < 2; ++ai) {
                const int row0 = pm * 256 + ai * 128 + wr * 64;
                int b, tile;
                if (!isctx) { b = row0 >> 13; tile = (CTX >> 6) + ((row0 & 8191) >> 6); } else { const int j = row0 - T; b = j >> 8; tile = (j & 255) >> 6; }
#pragma unroll
                for (int bj = 0; bj < 2; ++bj) {
                    const int head = (pn - 7) * 2 + bj;
                    unsigned char* dst = V8 + ((size_t)(b * NH + head) * (KVLEN / 64) + tile) * 8192 + wc * 2048 + fq * 64 + (fr >> 3) * 32 + (fr & 1) * 16 + ((fr >> 1) & 3) * 4;
#pragma unroll
                    for (int e = 0; e < 8; ++e) {
                        int w = __builtin_amdgcn_cvt_pk_fp8_f32(acc[ai][bj][0][e >> 2][e & 3], acc[ai][bj][1][e >> 2][e & 3], 0, false);
                        w = __builtin_amdgcn_cvt_pk_fp8_f32(acc[ai][bj][2][e >> 2][e & 3], acc[ai][bj][3][e >> 2][e & 3], w, true);
                        *(int*)(dst + e * 256) = w;
                    }
                }
            }
            return;
        }
        const int axis = wc & 1; const float* ct = rope + (axis ? 4096 : 0); const float* st = rope + (axis ? 4096 + 1024 : 2048);
#pragma unroll
        for (int ai = 0; ai < 2; ++ai)
#pragma unroll
            for (int m = 0; m < 4; ++m) {
                const int row = pm * 256 + ai * 128 + wr * 64 + m * 16 + fr;
                int t, kb, tile;
                if (!isctx) { kb = row >> 13; t = row & 8191; tile = (CTX >> 6) + (t >> 6); } else { const int j = row - T; t = 0; kb = j >> 8; tile = (j & 255) >> 6; }
                const int pos = axis ? (t & 63) : (t >> 6);
#pragma unroll
                for (int bj = 0; bj < 2; ++bj) {
                    const int col0 = pn * 256 + bj * 128 + wc * 32 + fq * 8;
                    f32x4 v0 = acc[ai][bj][m][0], v1 = acc[ai][bj][m][1];
                    if (pn == 0) { gp::u32x4 w; w.x = gp::cvt_pk_bf16(v0[0], v0[1]); w.y = gp::cvt_pk_bf16(v0[2], v0[3]); w.z = gp::cvt_pk_bf16(v1[0], v1[1]); w.w = gp::cvt_pk_bf16(v1[2], v1[3]);
                        *(gp::u32x4*)(F + (size_t)row * 256 + col0) = w; continue; }
                    if (pn < 7 && !isctx) {
                        const f32x4 c0 = *(const f32x4*)(ct + pos * 16 + 8 * (fq & 1)), c1 = *(const f32x4*)(ct + pos * 16 + 8 * (fq & 1) + 4);
                        const f32x4 s0 = *(const f32x4*)(st + pos * 16 + 8 * (fq & 1)), s1 = *(const f32x4*)(st + pos * 16 + 8 * (fq & 1) + 4);
                        const float sg = (fq < 2) ? -1.f : 1.f;
#pragma unroll
                        for (int i = 0; i < 4; ++i) {
                            const auto r0 = __builtin_amdgcn_permlane32_swap(__float_as_uint(v0[i]), __float_as_uint(v0[i]), false, false);
                            const auto r1 = __builtin_amdgcn_permlane32_swap(__float_as_uint(v1[i]), __float_as_uint(v1[i]), false, false);
                            const float p0 = __uint_as_float(fq < 2 ? r0[1] : r0[0]), p1 = __uint_as_float(fq < 2 ? r1[1] : r1[0]);
                            v0[i] = v0[i] * c0[i] + sg * p0 * s0[i]; v1[i] = v1[i] * c1[i] + sg * p1 * s1[i]; }
                    }
                    v0 = v0 * SQS; v1 = v1 * SQS;
                    int w0 = __builtin_amdgcn_cvt_pk_fp8_f32(v0[0], v0[1], 0, false); w0 = __builtin_amdgcn_cvt_pk_fp8_f32(v0[2], v0[3], w0, true);
                    int w1 = __builtin_amdgcn_cvt_pk_fp8_f32(v1[0], v1[1], 0, false); w1 = __builtin_amdgcn_cvt_pk_fp8_f32(v1[2], v1[3], w1, true);
                    unsigned char* d;
                    if (pn < 4) d = (unsigned char*)Q + (size_t)row * QKW + (col0 - 256);
                    else d = (unsigned char*)Kb + ((size_t)(kb * NH + (pn - 4) * 2 + bj) * (KVLEN / 64) + tile) * 8192 + wc * 2048 + m * 512 + fr * 32 + fq * 8;
                    typedef int i32x2_t __attribute__((ext_vector_type(2)));
                    *(i32x2_t*)d = (i32x2_t){w0, w1};
                }
            }
    }
};
struct EpiStoreBf16 {
    bf16_t* O; int ldc;
    __device__ __forceinline__ void operator()(const f32x4 (&acc)[2][2][4][2], const gp::Unit& u, int wr, int wc, int fr, int fq) const {
#pragma unroll
        for (int ai = 0; ai < 2; ++ai)
#pragma unroll
            for (int m = 0; m < 4; ++m) {
                bf16_t* rowp = O + (size_t)(u.pm * 256 + ai * 128 + wr * 64 + m * 16 + fr) * ldc + u.pn * 256 + wc * 32 + fq * 8;
#pragma unroll
                for (int bj = 0; bj < 2; ++bj) { const f32x4 v0 = acc[ai][bj][m][0], v1 = acc[ai][bj][m][1];
                    gp::u32x4 w; w.x = gp::cvt_pk_bf16(v0[0], v0[1]); w.y = gp::cvt_pk_bf16(v0[2], v0[3]); w.z = gp::cvt_pk_bf16(v1[0], v1[1]); w.w = gp::cvt_pk_bf16(v1[2], v1[3]);
                    *(gp::u32x4*)(rowp + bj * 128) = w; }
            }
    }
};

__device__ __forceinline__ void ph_inproj(const Params& p, unsigned char* smem) {
    unsigned char* ws = p.ws;
    gp::DenseSched S; S.init(MTOT, INW, D, ws + WS_WINT, gridDim.x, blockIdx.x);
    EpiInProj E{(bf16_t*)(ws + WS_F), (bf16_t*)(ws + WS_Q), (bf16_t*)(ws + WS_K), (bf16_t*)(ws + WS_V), (const float*)(ws + WS_ROPE)};
    gp::gemm_phase<EpiInProj, gp::DenseSched, true>(p.chunk, (GP_LAS unsigned char*)smem, (const char*)(ws + WS_HX), D, S, E);
}
__device__ __forceinline__ void ph_outproj(const Params& p, unsigned char* smem) {
    unsigned char* ws = p.ws;
    gp::DenseSched S; S.init(T, D, D, ws + WS_WOUTT, gridDim.x, blockIdx.x);
    EpiStoreBf16 E{(bf16_t*)(ws + WS_YX), D};
    gp::gemm_phase<EpiStoreBf16, gp::DenseSched, true>(p.chunk, (GP_LAS unsigned char*)smem, (const char*)(ws + WS_AO), D, S, E);
}

constexpr float GUSCALE = 64.f;
constexpr float WDSCALE = 16.f, ASCALE = 4.f;
struct TItem8 { const float* W; unsigned char* WT; int K, N, row_base, k0, n0; float sc; };
__device__ __forceinline__ void titem8_load(const TItem8& t, float (&tv)[32], int lane) {
#pragma unroll
    for (int i = 0; i < 32; ++i) tv[i] = t.W[(size_t)(t.k0 + 2 * i + (lane >> 5)) * t.N + t.n0 + (lane & 31)];
}
__device__ __forceinline__ void titem8_finish(const TItem8& t, const float (&tv)[32], float* scr, int lane) {
#pragma unroll
    for (int i = 0; i < 32; ++i) scr[(2 * i + (lane >> 5)) * 33 + (lane & 31)] = tv[i] * t.sc;
    asm volatile("s_waitcnt lgkmcnt(0)" ::: "memory");
    const int c = lane & 7;
#pragma unroll
    for (int j = 0; j < 4; ++j) { const int n = (lane >> 3) + 8 * j; const float* s = scr + (8 * c) * 33 + n;
        int w0 = __builtin_amdgcn_cvt_pk_fp8_f32(s[0 * 33], s[1 * 33], 0, false); w0 = __builtin_amdgcn_cvt_pk_fp8_f32(s[2 * 33], s[3 * 33], w0, true);
        int w1 = __builtin_amdgcn_cvt_pk_fp8_f32(s[4 * 33], s[5 * 33], 0, false); w1 = __builtin_amdgcn_cvt_pk_fp8_f32(s[6 * 33], s[7 * 33], w1, true);
        uint2 o; o.x = (unsigned)w0; o.y = (unsigned)w1;
        *(uint2*)(t.WT + (size_t)(t.row_base + t.n0 + n) * t.K + t.k0 + 8 * c) = o; }
    asm volatile("s_waitcnt lgkmcnt(0)" ::: "memory");
}
__device__ __forceinline__ void transpose_item(const float* W, int K, int N, bf16_t* WT, int row_base, int kb, int nb, float* scr, int lane) {
    const int k0 = 64 * kb, n0 = 32 * nb;
    float tv[32];
#pragma unroll
    for (int i = 0; i < 32; ++i) tv[i] = W[(size_t)(k0 + 2 * i + (lane >> 5)) * N + n0 + (lane & 31)];
#pragma unroll
    for (int i = 0; i < 32; ++i) scr[(2 * i + (lane >> 5)) * 33 + (lane & 31)] = tv[i];
    asm volatile("s_waitcnt lgkmcnt(0)" ::: "memory");
    const int c = lane & 7;
#pragma unroll
    for (int j = 0; j < 4; ++j) { const int n = (lane >> 3) + 8 * j; const float* s = scr + (8 * c) * 33 + n;
        uint4 o; o.x = pk2(s[0 * 33], s[1 * 33]); o.y = pk2(s[2 * 33], s[3 * 33]); o.z = pk2(s[4 * 33], s[5 * 33]); o.w = pk2(s[6 * 33], s[7 * 33]);
        *(uint4*)(WT + (size_t)(row_base + n0 + n) * K + k0 + 8 * c) = o; }
    asm volatile("s_waitcnt lgkmcnt(0)" ::: "memory");
}
__device__ __forceinline__ void ph_prep_weights(const Params& p, float* lds, const int part, const int first) {
    const int tid = otid(), wave = tid >> 6, lane = tid & 63;
    float* scr = lds + 8192 + wave * (64 * 33);
    if ((int)blockIdx.x < first) return;
    const int gw = ((int)blockIdx.x - first) * NWV + wave, GW = ((int)gridDim.x - first) * NWV;
    unsigned char* ws = p.ws;
    constexpr int I_IN = 16 * 80, I_OUT = 16 * 32, I_GU = 16 * 8, I_D = 4 * 32;
    constexpr int NITEMS = I_IN + I_OUT + 65 * (2 * I_GU + I_D);
    const int it_lo = part ? I_IN + I_OUT : 0, it_hi = part ? NITEMS : I_IN + I_OUT;
    if (part == 0) {
        for (int it = it_lo + gw; it < it_hi; it += GW) {
            int r = it;
            if (r < I_IN) { transpose_item(p.in[I_WIN], D, INW, (bf16_t*)(ws + WS_WINT), 0, r / 80, r % 80, scr, lane); continue; } r -= I_IN;
            transpose_item(p.in[I_WOUT], D, D, (bf16_t*)(ws + WS_WOUTT), 0, r / 32, r % 32, scr, lane);
        }
        return;
    }
    auto decode = [&](int it, TItem8& t) {
        int r = it - (I_IN + I_OUT);
        const int e = r / (2 * I_GU + I_D); r -= e * (2 * I_GU + I_D);
        if (r < 2 * I_GU) {
            const int half = r / I_GU, q = r % I_GU, kb = q / 8, nb = q % 8;
            t.W = (e < 64) ? p.in[half ? I_WU : I_WG] + (size_t)e * D * DE : p.in[half ? I_WSU : I_WSG];
            const int n0 = 32 * nb, drow = e * 512 + (n0 >> 7) * 256 + half * 128 + (n0 & 127);
            t.WT = ws + WS_WGUT; t.K = D; t.N = DE; t.row_base = drow - n0; t.k0 = 64 * kb; t.n0 = n0; t.sc = GUSCALE;
        } else {
            r -= 2 * I_GU;
            t.W = (e < 64) ? p.in[I_WD] + (size_t)e * DE * D : p.in[I_WSD];
            t.WT = ws + WS_WDT; t.K = DE; t.N = D; t.row_base = e * 1024; t.k0 = 64 * (r / 32); t.n0 = 32 * (r % 32); t.sc = WDSCALE;
        }
    };
    int it = it_lo + gw;
    if (it >= it_hi) return;
    TItem8 ta, tb; float va[32], vb[32];
    decode(it, ta); titem8_load(ta, va, lane);
    for (;;) {
        const bool hb = it + GW < it_hi;
        if (hb) { decode(it + GW, tb); titem8_load(tb, vb, lane); }
        titem8_finish(ta, va, scr, lane);
        if (!hb) break;
        const bool ha = it + 2 * GW < it_hi;
        if (ha) { decode(it + 2 * GW, ta); titem8_load(ta, va, lane); }
        titem8_finish(tb, vb, scr, lane);
        if (!ha) break;
        it += 2 * GW;
    }
}

namespace fa {
typedef short bf16x8 __attribute__((ext_vector_type(8)));
typedef short s16x4 __attribute__((ext_vector_type(4)));
typedef float f32x16 __attribute__((ext_vector_type(16)));
typedef unsigned u32x4 __attribute__((ext_vector_type(4)));
constexpr int KVBLK = 64, LDK = QKW;
constexpr float SCALE = 0.125f, THR = 8.f;
constexpr size_t SHM_V = KVBLK * 128 * 2, SHM_K = KVBLK * 128 * 2;
#define KSWZ(row, colB) ((row) * 256 + ((colB) ^ (((row) & 15) << 4)))
#define SBAR() __builtin_amdgcn_sched_barrier(0)
__device__ __forceinline__ int crow(int r, int hi) { return (r & 3) + 8 * (r >> 2) + 4 * hi; }
__device__ __forceinline__ unsigned cvtpk(float lo, float hi) { unsigned r; asm volatile("v_cvt_pk_bf16_f32 %0, %1, %2" : "=v"(r) : "v"(lo), "v"(hi)); return r; }
constexpr float PBIAS = 5.f, THR2 = PBIAS + 3.5f;
template <bool FIRST>
__device__ __forceinline__ void partialSM(f32x16& p0, f32x16& p1, float& m_reg, f32x16& negm, float& alpha) {
  float pmax = p0[0];
#pragma unroll
  for (int r = 1; r < 16; ++r) pmax = fmaxf(pmax, p0[r]);
#pragma unroll
  for (int r = 0; r < 16; ++r) pmax = fmaxf(pmax, p1[r]);
  { auto rr = __builtin_amdgcn_permlane32_swap(__float_as_uint(pmax), __float_as_uint(pmax), false, false);
    pmax = fmaxf(__uint_as_float(rr[0]), __uint_as_float(rr[1])); }
  if (!FIRST && __builtin_expect(__all(pmax <= THR2), 1)) { alpha = 1.f; }
  else { const float dl = FIRST ? pmax - PBIAS : fmaxf(pmax - PBIAS, 0.f); alpha = FIRST ? 0.f : __builtin_amdgcn_exp2f(-dl); m_reg += dl;
#pragma unroll
    for (int r = 0; r < 16; ++r) { p0[r] -= dl; p1[r] -= dl; }
#pragma unroll
    for (int r = 0; r < 16; ++r) negm[r] = -m_reg;
    asm volatile("" : "+v"(negm)); }
#pragma unroll
  for (int r = 0; r < 16; ++r) p0[r] = __builtin_amdgcn_exp2f(p0[r]);
}
typedef int i32x8 __attribute__((ext_vector_type(8)));
__device__ __forceinline__ int pk4_fp8(float a, float b, float c, float d) { int w; asm("v_cvt_pk_fp8_f32 %0, %1, %2" : "=v"(w) : "v"(a), "v"(b)); asm("v_cvt_pk_fp8_f32 %0, %1, %2 op_sel:[0,0,1]" : "+v"(w) : "v"(c), "v"(d)); return w; }
__device__ __forceinline__ void finishSM_T(f32x16& p0, f32x16& p1, i32x8& pb) {
#pragma unroll
  for (int r = 0; r < 16; ++r) p1[r] = __builtin_amdgcn_exp2f(p1[r]);
#pragma unroll
  for (int g = 0; g < 4; ++g) {
    pb[g] = pk4_fp8(p0[4 * g], p0[4 * g + 1], p0[4 * g + 2], p0[4 * g + 3]); pb[4 + g] = pk4_fp8(p1[4 * g], p1[4 * g + 1], p1[4 * g + 2], p1[4 * g + 3]); }
}
__device__ __forceinline__ void qkt(f32x16& p0, f32x16& p1, const char* Ks, const i32x8 qf, int lane, int mm, const f32x16& negm) {
  const char* kp = Ks + mm * 4096 + lane * 16;
  const u32x4 a0 = *reinterpret_cast<const u32x4*>(kp), a1 = *reinterpret_cast<const u32x4*>(kp + 1024), b0 = *reinterpret_cast<const u32x4*>(kp + 2048), b1 = *reinterpret_cast<const u32x4*>(kp + 3072);
  p0 = __builtin_amdgcn_mfma_scale_f32_32x32x64_f8f6f4((i32x8){(int)a0.x, (int)a0.y, (int)a0.z, (int)a0.w, (int)a1.x, (int)a1.y, (int)a1.z, (int)a1.w}, qf, negm, 0, 0, 0, 0, 0, 0);
  p1 = __builtin_amdgcn_mfma_scale_f32_32x32x64_f8f6f4((i32x8){(int)b0.x, (int)b0.y, (int)b0.z, (int)b0.w, (int)b1.x, (int)b1.y, (int)b1.z, (int)b1.w}, qf, negm, 0, 0, 0, 0, 0, 0);
}
__device__ __forceinline__ int v_st(int k, int c) { const int kk = (k & ~0xC) | ((k & 4) << 1) | ((k & 8) >> 1); return ((kk >> 3) * 4 + (c >> 5)) * 512 + ((kk & 7) * 32 + (c & 31)) * 2; }
__device__ __forceinline__ int v_rd_base(int lane) { return ((lane & 3) << 3) | (((lane >> 2) & 3) << 6) | (((lane >> 4) & 1) << 5) | (((lane >> 5) & 1) << 8); }
constexpr int v_rd_off(int d0, int ks, int half) { return d0 * 512 + ks * 4096 + half * 2048; }
template <int OFF> __device__ __forceinline__ s16x4 tr_read(int vb) {
  s16x4 r; asm volatile("ds_read_b64_tr_b16 %0, %1 offset:%2" : "=&v"(r) : "v"(vb), "i"(OFF) : "memory"); return r;
}
template <int D0> __device__ __forceinline__ void pv_one(f32x16& od, int vb, bf16x8 pa0, bf16x8 pa1, bf16x8 pa2, bf16x8 pa3) {
  const s16x4 l0 = tr_read<v_rd_off(D0, 0, 0)>(vb), h0 = tr_read<v_rd_off(D0, 0, 1)>(vb), l1 = tr_read<v_rd_off(D0, 1, 0)>(vb), h1 = tr_read<v_rd_off(D0, 1, 1)>(vb);
  const s16x4 l2 = tr_read<v_rd_off(D0, 2, 0)>(vb), h2 = tr_read<v_rd_off(D0, 2, 1)>(vb), l3 = tr_read<v_rd_off(D0, 3, 0)>(vb), h3 = tr_read<v_rd_off(D0, 3, 1)>(vb);
  asm volatile("s_waitcnt lgkmcnt(0)" ::: "memory"); SBAR();
#define PK(L, H) (bf16x8){L[0], L[1], L[2], L[3], H[0], H[1], H[2], H[3]}
  od = __builtin_amdgcn_mfma_f32_32x32x16_bf16(pa0, PK(l0, h0), od, 0, 0, 0);
  od = __builtin_amdgcn_mfma_f32_32x32x16_bf16(pa1, PK(l1, h1), od, 0, 0, 0);
  od = __builtin_amdgcn_mfma_f32_32x32x16_bf16(pa2, PK(l2, h2), od, 0, 0, 0);
  od = __builtin_amdgcn_mfma_f32_32x32x16_bf16(pa3, PK(l3, h3), od, 0, 0, 0);
#undef PK
}
__device__ __forceinline__ void pv_d0(f32x16* o, int vb, bf16x8 pa0, bf16x8 pa1, bf16x8 pa2, bf16x8 pa3) {
  pv_one<0>(o[0], vb, pa0, pa1, pa2, pa3); pv_one<1>(o[1], vb, pa0, pa1, pa2, pa3); pv_one<2>(o[2], vb, pa0, pa1, pa2, pa3); pv_one<3>(o[3], vb, pa0, pa1, pa2, pa3);
}

template <int OFF> __device__ __forceinline__ u32x4 rd128(int vb) { u32x4 r; asm volatile("ds_read_b128 %0, %1 offset:%2" : "=&v"(r) : "v"(vb), "i"(OFF) : "memory"); return r; }
#define PV_RD(D0) const u32x4 va##D0 = rd128<D0 * 2048>(vb), vc##D0 = rd128<D0 * 2048 + 1024>(vb); SBAR()
#define PV_MM(D0) do { asm volatile("s_waitcnt lgkmcnt(0)" ::: "memory"); SBAR(); \
    o[D0] = __builtin_amdgcn_mfma_scale_f32_32x32x64_f8f6f4((i32x8){(int)va##D0.x, (int)va##D0.y, (int)va##D0.z, (int)va##D0.w, (int)vc##D0.x, (int)vc##D0.y, (int)vc##D0.z, (int)vc##D0.w}, pb, o[D0], 0, 0, 0, 0, 0, 0); } while (0)
__device__ __forceinline__ float max3f(float a, float b, float c) { float r; asm("v_max3_f32 %0, %1, %2, %3" : "=v"(r) : "v"(a), "v"(b), "v"(c)); return r; }
#define PV_LSUM() lacc = __builtin_amdgcn_mfma_scale_f32_32x32x64_f8f6f4((i32x8){0x38383838, 0x38383838, 0x38383838, 0x38383838, 0x38383838, 0x38383838, 0x38383838, 0x38383838}, pb, lacc, 0, 0, 0, 0, 0, 0)
__device__ __forceinline__ void pv_psm(f32x16* o, f32x16& lacc, int vb, i32x8 pb, f32x16& p0, f32x16& p1, float& m_reg, f32x16& negm, float& alpha) {
  float pmax;
  { PV_RD(0);
    pmax = max3f(p0[0], p0[1], p0[2]);
#pragma unroll
    for (int r = 3; r < 15; r += 2) pmax = max3f(pmax, p0[r], p0[r + 1]);
    pmax = max3f(pmax, p0[15], p1[0]);
    SBAR(); PV_MM(0); }
  { PV_RD(1);
#pragma unroll
    for (int r = 1; r < 15; r += 2) pmax = max3f(pmax, p1[r], p1[r + 1]);
    pmax = max3f(pmax, p1[15], p1[15]);
    { auto rr = __builtin_amdgcn_permlane32_swap(__float_as_uint(pmax), __float_as_uint(pmax), false, false);
      pmax = max3f(__uint_as_float(rr[0]), __uint_as_float(rr[1]), __uint_as_float(rr[1])); }
    if (__builtin_expect(__all(pmax <= THR2), 1)) { alpha = 1.f; }
    else { const float dl = fmaxf(pmax - PBIAS, 0.f); alpha = __builtin_amdgcn_exp2f(-dl); m_reg += dl;
#pragma unroll
      for (int r = 0; r < 16; ++r) { p0[r] -= dl; p1[r] -= dl; }
#pragma unroll
      for (int r = 0; r < 16; ++r) negm[r] = -m_reg;
      asm volatile("" : "+v"(negm)); }
    SBAR(); PV_MM(1); }
  { PV_RD(2);
#pragma unroll
    for (int r = 0; r < 8; ++r) p0[r] = __builtin_amdgcn_exp2f(p0[r]);
    asm volatile("" : "+v"(p0));
    SBAR(); PV_MM(2); }
  { PV_RD(3);
#pragma unroll
    for (int r = 8; r < 16; ++r) p0[r] = __builtin_amdgcn_exp2f(p0[r]);
    asm volatile("" : "+v"(p0));
    SBAR(); PV_MM(3); PV_LSUM(); }
}
__device__ __forceinline__ void pvT_d0(f32x16* o, f32x16& lacc, int vb, i32x8 pb) {
  { PV_RD(0); PV_MM(0); } { PV_RD(1); PV_MM(1); } { PV_RD(2); PV_MM(2); } { PV_RD(3); PV_MM(3); PV_LSUM(); }
}
#undef PV_RD
#undef PV_MM
#undef PV_LSUM

__device__ __forceinline__ void attn_unit(const unsigned char* __restrict__ Qb, const unsigned char* __restrict__ Kh, const unsigned char* __restrict__ Vh, bf16_t* __restrict__ Ob,
                                          const float* __restrict__ gsub, const float lam, char* lds, const int wv) {
  typedef __attribute__((address_space(3))) unsigned* ldsu_t;
  const int tid = otid_w(wv), wid = wv, lane = tid & 63, r32 = lane & 31, hi = lane >> 5, mm = wid >> 2, wq = wid & 3;
  constexpr int NB = 4;
  constexpr int SHM_V8 = KVBLK * 128;
  char* V_lds = lds; char* K_lds = lds + NB * SHM_V8; constexpr int SHM_K8 = KVBLK * 128;
  float m_reg = 0.f; f32x16 o[4] = {}; f32x16 lacc = {}; i32x8 qf; f32x16 negm = {}; asm volatile("" : "+v"(negm));
  const unsigned koff = (unsigned)((2 * (wid >> 2) + (lane >> 5)) * 2048 + (lane & 3) * 512 + (8 * ((wid >> 1) & 1) + 2 * ((lane & 31) >> 3) + ((lane >> 2) & 1)) * 32 + (wid & 1) * 16);
  const unsigned voff = (unsigned)((wid >> 1) * 2048 + (lane & 7) * 256 + ((lane >> 3) & 3) * 64 + (wid & 1) * 32 + (lane >> 5) * 16);
#define DMA(t, buf) do { const char* kb_ = (const char*)(Kh + (size_t)(t) * SHM_K8); const char* vb_ = (const char*)(Vh + (size_t)(t) * SHM_V8); asm volatile("" : "+s"(kb_), "+s"(vb_)); \
    __builtin_amdgcn_global_load_lds((const unsigned*)(kb_ + koff), (ldsu_t)(K_lds + (buf) * SHM_K8 + wid * 1024), 16, 0, 0); \
    __builtin_amdgcn_global_load_lds((const unsigned*)(vb_ + voff), (ldsu_t)(V_lds + (buf) * SHM_V8 + wid * 1024), 16, 0, 0); } while (0)
#define WAIT_BAR(N) asm volatile("s_waitcnt vmcnt(" #N ") lgkmcnt(0)\n\ts_barrier" ::: "memory")
#define RESC(a) do { if (__any((a) < 1.f)) { _Pragma("unroll") for (int d = 0; d < 4; ++d) _Pragma("unroll") for (int r = 0; r < 16; ++r) o[d][r] *= (a); lacc[0] *= (a); } } while (0)
  DMA(0, 0); DMA(1, 1);
  { const unsigned char* Qw = Qb + (long)(wq * 32 + r32) * QKW + mm * 64 + hi * 32;
    const u32x4 q0 = *reinterpret_cast<const u32x4*>(Qw), q1 = *reinterpret_cast<const u32x4*>(Qw + 16);
    qf = (i32x8){(int)q0.x, (int)q0.y, (int)q0.z, (int)q0.w, (int)q1.x, (int)q1.y, (int)q1.z, (int)q1.w}; }
  const int vb0 = (int)(uintptr_t)V_lds + lane * 16;
  f32x16 pA0, pA1, pB0, pB1; float alA, alB; i32x8 pb; constexpr int NTL = KVLEN / KVBLK;
  WAIT_BAR(0);
  DMA(2, 2);
  qkt(pA0, pA1, K_lds, qf, lane, mm, negm); partialSM<true>(pA0, pA1, m_reg, negm, alA);
  WAIT_BAR(2);
  for (int j = 1; j + 1 < NTL; j += 2) {
    DMA(j + 2, (j + 2) & 3);
    SBAR(); qkt(pB0, pB1, K_lds + (j & 3) * SHM_K8, qf, lane, mm, negm);
    finishSM_T(pA0, pA1, pb); SBAR();
    pv_psm(o, lacc, vb0 + ((j - 1) & 3) * SHM_V8, pb, pB0, pB1, m_reg, negm, alB);
    RESC(alB);
    WAIT_BAR(2);
    if (j + 3 < NTL) DMA(j + 3, (j + 3) & 3);
    SBAR(); qkt(pA0, pA1, K_lds + ((j + 1) & 3) * SHM_K8, qf, lane, mm, negm);
    finishSM_T(pB0, pB1, pb); SBAR();
    pv_psm(o, lacc, vb0 + (j & 3) * SHM_V8, pb, pA0, pA1, m_reg, negm, alA);
    RESC(alA);
    if (j + 3 < NTL) WAIT_BAR(2); else WAIT_BAR(0);
  }
  SBAR(); qkt(pB0, pB1, K_lds + ((NTL - 1) & 3) * SHM_K8, qf, lane, mm, negm);
  finishSM_T(pA0, pA1, pb); SBAR();
  pv_psm(o, lacc, vb0 + ((NTL - 2) & 3) * SHM_V8, pb, pB0, pB1, m_reg, negm, alB);
  RESC(alB);
  finishSM_T(pB0, pB1, pb); SBAR();
  pvT_d0(o, lacc, vb0 + ((NTL - 1) & 3) * SHM_V8, pb);
#undef DMA
#undef WAIT_BAR
  const float rl = __builtin_amdgcn_rcpf(lacc[0]) * (mm ? lam : 1.0f);
  __syncthreads();
  constexpr int XS = 132;
  float* X = (float*)lds;
  if (mm == 1) {
#pragma unroll
    for (int r = 0; r < 16; ++r)
#pragma unroll
      for (int d0 = 0; d0 < 4; ++d0) X[(wq * 32 + r32) * XS + d0 * 32 + crow(r, hi)] = o[d0][r] * rl;
  }
  __syncthreads();
  if (mm == 0) {
#pragma unroll
    for (int r = 0; r < 16; ++r)
#pragma unroll
      for (int d0 = 0; d0 < 4; ++d0) { float* xp = X + (wq * 32 + r32) * XS + d0 * 32 + crow(r, hi); *xp = o[d0][r] * rl - *xp; }
  }
  __syncthreads();
  {
    const int row = tid >> 2, seg = tid & 3;
    const float* xr = X + row * XS + seg * 32;
    f32x4 v[8]; float ss = 0.f;
#pragma unroll
    for (int i = 0; i < 8; ++i) { v[i] = *(const f32x4*)(xr + 4 * i); ss += v[i][0] * v[i][0] + v[i][1] * v[i][1] + v[i][2] * v[i][2] + v[i][3] * v[i][3]; }
    ss += sx<1>(ss); ss += sx<2>(ss);
    const float rs = (1.0f - LAM_INIT) / sqrtf(ss * (1.0f / 128.0f) + EPS);
    bf16_t* dst = Ob + (long)row * D + seg * 32;
#pragma unroll
    for (int i = 0; i < 8; i += 2) {
      const f32x4 g0 = *(const f32x4*)(gsub + seg * 32 + 4 * i), g1 = *(const f32x4*)(gsub + seg * 32 + 4 * i + 4);
      u32x4 w; w.x = cvtpk(v[i][0] * rs * g0[0], v[i][1] * rs * g0[1]); w.y = cvtpk(v[i][2] * rs * g0[2], v[i][3] * rs * g0[3]);
      w.z = cvtpk(v[i + 1][0] * rs * g1[0], v[i + 1][1] * rs * g1[1]); w.w = cvtpk(v[i + 1][2] * rs * g1[2], v[i + 1][3] * rs * g1[3]);
      *(u32x4*)(dst + 4 * i) = w;
    }
  }
  __syncthreads();
#undef RESC
}
#undef KSWZ
#undef SBAR
}

__device__ __forceinline__ void ph_attn(const Params& p, unsigned char* smem) {
    unsigned char* ws = p.ws;
    const unsigned char* Q = ws + WS_Q; const unsigned char* Kb = ws + WS_K; const unsigned char* Vb = ws + WS_V;
    bf16_t* AO = (bf16_t*)(ws + WS_AO);
    const float lam = ((const float*)(ws + WS_CTL))[1024];
    const int c = blockIdx.x, G = gridDim.x;
    if (G == 256) {
        const int x = c & 7, s = c >> 3;
        for (int rd = 0; rd < 6; ++rd) {
            const int bh = rd * 4 + (x >> 1), qb = (x & 1) * 32 + s, b = bh / NH, h = bh % NH;
            fa::attn_unit(Q + ((size_t)b * SEQ + qb * 128) * QKW + h * 128, Kb + (size_t)(b * NH + h) * (KVLEN / 64) * 8192, Vb + (size_t)(b * NH + h) * (KVLEN / 64) * 8192,
                          AO + ((size_t)b * SEQ + qb * 128) * D + 256 + h * 128, p.in[I_GSUB], lam, (char*)smem, p.chunk);
        }
    } else {
        for (int u = c; u < BATCH * NH * 64; u += G) {
            const int bh = u >> 6, qb = u & 63, b = bh / NH, h = bh % NH;
            fa::attn_unit(Q + ((size_t)b * SEQ + qb * 128) * QKW + h * 128, Kb + (size_t)(b * NH + h) * (KVLEN / 64) * 8192, Vb + (size_t)(b * NH + h) * (KVLEN / 64) * 8192,
                          AO + ((size_t)b * SEQ + qb * 128) * D + 256 + h * 128, p.in[I_GSUB], lam, (char*)smem, p.chunk);
        }
    }
}

__device__ __forceinline__ void ph_fourierA(const Params& p, unsigned char* smem) {
    using namespace fa;
    unsigned char* ws = p.ws;
    const bf16_t* F = (const bf16_t*)(ws + WS_F); bf16_t* FY = (bf16_t*)(ws + WS_FY); const bf16_t* W = (const bf16_t*)(ws + WS_W128E);
    const int tid = otid(), wid = tid >> 6, lane = tid & 63, r32 = lane & 31, hi = lane >> 5;
    const int sr = tid >> 4, sc = (tid & 15) * 8, vst0 = v_st(sr, sc), vst1 = v_st(32 + sr, sc);
    const int vb0 = (int)(uintptr_t)smem + v_rd_base(lane);
    for (int task = blockIdx.x; task < BATCH * 64; task += gridDim.x) {
        const int b = task >> 6, n2 = task & 63;
        bf16x8 st[4][2];
#pragma unroll
        for (int kt = 0; kt < 2; ++kt)
#pragma unroll
            for (int ct = 0; ct < 2; ++ct) {
                st[kt * 2 + ct][0] = *(const bf16x8*)(F + ((size_t)b * SEQ + 64 * (64 * kt + sr) + n2) * 256 + 128 * ct + sc);
                st[kt * 2 + ct][1] = *(const bf16x8*)(F + ((size_t)b * SEQ + 64 * (64 * kt + 32 + sr) + n2) * 256 + 128 * ct + sc);
            }
        bf16x8 pa[2][4];
#pragma unroll
        for (int kt = 0; kt < 2; ++kt)
#pragma unroll
            for (int ks = 0; ks < 4; ++ks) pa[kt][ks] = *(const bf16x8*)(W + (size_t)(32 * wid + r32) * 128 + 64 * kt + 16 * ks + 8 * hi);
        __syncthreads();
#pragma unroll
        for (int q = 0; q < 4; ++q) { *(bf16x8*)(smem + q * 16384 + vst0) = st[q][0]; *(bf16x8*)(smem + q * 16384 + vst1) = st[q][1]; }
        __syncthreads();
        f32x16 o[2][4] = {};
#pragma unroll
        for (int ct = 0; ct < 2; ++ct)
#pragma unroll
            for (int kt = 0; kt < 2; ++kt) pv_d0(o[ct], vb0 + (kt * 2 + ct) * 16384, pa[kt][0], pa[kt][1], pa[kt][2], pa[kt][3]);
        const int plane = wid >> 2;
#pragma unroll
        for (int r = 0; r < 16; ++r) {
            const int k1 = 32 * (wid & 3) + crow(r, hi);
            bf16_t* dst = FY + ((((size_t)plane * BATCH + b) * 128 + k1) * 64 + n2) * 256 + r32;
#pragma unroll
            for (int ct = 0; ct < 2; ++ct)
#pragma unroll
                for (int d0 = 0; d0 < 4; ++d0) dst[128 * ct + 32 * d0] = f2bf(o[ct][d0][r]);
        }
    }
    __syncthreads();
}
__device__ __forceinline__ void ph_fourierB(const Params& p, unsigned char* smem) {
    using namespace fa;
    unsigned char* ws = p.ws;
    const bf16_t* FY = (const bf16_t*)(ws + WS_FY); const float2* tabw = (const float2*)(ws + WS_TABW);
    const bf16_t* M64 = (const bf16_t*)(ws + WS_M64E); const bf16_t* GT = (const bf16_t*)(ws + WS_GT);
    bf16_t* AO = (bf16_t*)(ws + WS_AO);
    const int tid = otid(), wid = tid >> 6, lane = tid & 63, r32 = lane & 31, hi = lane >> 5;
    const int sr = tid >> 4, sc = (tid & 15) * 8, vst0 = v_st(sr, sc), vst1 = v_st(32 + sr, sc);
    const int vb0 = (int)(uintptr_t)smem + v_rd_base(lane);
    constexpr int XRS = 528;
    unsigned char* XL = smem + 65536;
    const int mt = wid & 3, ctw = wid >> 2;
    for (int task = blockIdx.x; task < BATCH * 128; task += gridDim.x) {
        const int b = task >> 7, k1 = task & 127;
        __syncthreads();
#pragma unroll
        for (int ct = 0; ct < 2; ++ct)
#pragma unroll
            for (int rh = 0; rh < 2; ++rh) {
                const int n2 = sr + 32 * rh;
                const size_t off = ((((size_t)b) * 128 + k1) * 64 + n2) * 256 + 128 * ct + sc;
                const uint4 yr = *(const uint4*)(FY + off), yi = *(const uint4*)(FY + (size_t)BATCH * 128 * 64 * 256 + off);
                const float2 tw = tabw[n2 * k1];
                const unsigned yrw[4] = {yr.x, yr.y, yr.z, yr.w}, yiw[4] = {yi.x, yi.y, yi.z, yi.w};
                unsigned zr[4], zi[4];
#pragma unroll
                for (int q = 0; q < 4; ++q) {
                    const float a0 = __uint_as_float(yrw[q] << 16), a1 = __uint_as_float(yrw[q] & 0xffff0000u), b0 = __uint_as_float(yiw[q] << 16), b1 = __uint_as_float(yiw[q] & 0xffff0000u);
                    zr[q] = pk2(a0 * tw.x + b0 * tw.y, a1 * tw.x + b1 * tw.y); zi[q] = pk2(b0 * tw.x - a0 * tw.y, b1 * tw.x - a1 * tw.y);
                }
                const int vs = rh ? vst1 : vst0;
                *(uint4*)(smem + (0 * 2 + ct) * 16384 + vs) = make_uint4(zr[0], zr[1], zr[2], zr[3]);
                *(uint4*)(smem + (1 * 2 + ct) * 16384 + vs) = make_uint4(zi[0], zi[1], zi[2], zi[3]);
            }
        __syncthreads();
        {
            f32x16 o[4] = {};
#pragma unroll
            for (int kt = 0; kt < 2; ++kt) {
                bf16x8 pa[4];
#pragma unroll
                for (int ks = 0; ks < 4; ++ks) pa[ks] = *(const bf16x8*)(M64 + (size_t)(32 * mt + r32) * 128 + 64 * kt + 16 * ks + 8 * hi);
                pv_d0(o, vb0 + (kt * 2 + ctw) * 16384, pa[0], pa[1], pa[2], pa[3]);
            }
#pragma unroll
            for (int r = 0; r < 16; ++r) {
                const int ro = 32 * mt + crow(r, hi);
                bf16_t* xr = (bf16_t*)(XL + ((ro >> 6) * 64 + (ro & 63)) * XRS) + 128 * ctw + r32;
#pragma unroll
                for (int d0 = 0; d0 < 4; ++d0) xr[32 * d0] = f2bf(o[d0][r]);
            }
        }
        __syncthreads();
#pragma unroll
        for (int tt = 0; tt < 2; ++tt) {
            const int tau = 2 * wid + tt, g = tau >> 2, mt2 = (tau >> 1) & 1, nt2 = tau & 1;
            f32x16 acc = {};
#pragma unroll
            for (int ks8 = 0; ks8 < 8; ++ks8) {
                const int part = ks8 >> 2, cb = ks8 & 3;
                const bf16x8 af = *(const bf16x8*)(XL + (part * 64 + 32 * mt2 + r32) * XRS + (g * 64 + 16 * cb + 8 * hi) * 2);
                const bf16x8 bfr = *(const bf16x8*)(GT + ((size_t)g * 64 + 32 * nt2 + r32) * 128 + part * 64 + 16 * cb + 8 * hi);
                acc = __builtin_amdgcn_mfma_f32_32x32x16_bf16(af, bfr, acc, 0, 0, 0);
            }
#pragma unroll
            for (int r = 0; r < 16; ++r) { const int k2 = 32 * mt2 + crow(r, hi);
                AO[((size_t)b * SEQ + k1 + 128 * k2) * D + g * 64 + 32 * nt2 + r32] = f2bf(acc[r]); }
        }
    }
    __syncthreads();
}

__device__ __forceinline__ void ph_mid(const Params& p, unsigned char* smem) {
    typedef short bf16x8 __attribute__((ext_vector_type(8)));
    unsigned char* ws = p.ws;
    const int tid = otid(), wave = tid >> 6, lane = tid & 63, fr = lane & 15, fq = lane >> 4;
    const float* mod = (const float*)(ws + WS_MOD);
    const bf16_t* YX = (const bf16_t*)(ws + WS_YX);
    unsigned char* H2 = ws + WS_H2;
    unsigned* counts = (unsigned*)(ws + WS_CTL);
    int* TE = (int*)(ws + WS_TE); int* TP = (int*)(ws + WS_TP); float* TW = (float*)(ws + WS_TW); int* TOKL = (int*)(ws + WS_TOKL);
    constexpr int RS = 2064;
    unsigned char* Ahi = smem; unsigned char* Alo = smem + 16 * RS; float* Pp = (float*)(smem + 2 * 16 * RS + 512);
    const float rbias = p.in[I_RB][lane];
    int* lcnt = (int*)(smem + 99328); int* gb = lcnt + 64; int* PE = gb + 64; float* PW = (float*)(PE + 1024); float* PV = PW + 1024;
    for (int chunk = blockIdx.x; chunk < T / 128; chunk += gridDim.x) {
      const int mc = chunk * 128, b = mc >> 13;
      if (tid < 64) lcnt[tid] = 0;
      {
          const float* mrow_ = mod + b * 6144;
          for (int i = tid; i < 5 * 256; i += NT) { const int v_ = i >> 8, q_ = (i & 255) * 4;
              const float* s_ = (v_ == 0) ? p.in[I_GAPOST] + q_ : (v_ == 1) ? mrow_ + 2 * 1024 + q_ : (v_ == 2) ? p.in[I_GFPRE] + q_ : (v_ == 3) ? mrow_ + 3 * 1024 + q_ : mrow_ + 4 * 1024 + q_;
              *(f32x4*)(PV + v_ * 1024 + q_) = *(const f32x4*)s_; }
          __syncthreads();
      }
      uint2 yw[2][4]; f32x4 xv[2][4];
      bf16x8 wfr[4][4];
      { const bf16_t* wrt_ = (const bf16_t*)(ws + WS_WRT) + (size_t)p.chunk * 16 * 1024; asm volatile("" : "+s"(wrt_));
#pragma unroll
        for (int ks = 0; ks < 4; ++ks) {
#pragma unroll
          for (int nb = 0; nb < 4; ++nb) wfr[ks][nb] = *(const bf16x8*)(wrt_ + (size_t)((ks * 4 + nb) * 2 * 64 + lane) * 8);
          __builtin_amdgcn_sched_barrier(0); } }
#define MID_LOAD(m0_) do { _Pragma("unroll") for (int rr = 0; rr < 2; ++rr) { const int m_ = (m0_) + 2 * wave + rr; _Pragma("unroll") for (int j = 0; j < 4; ++j) { \
          yw[rr][j] = *(const uint2*)(YX + (size_t)m_ * D + 4 * (lane + 64 * j)); xv[rr][j] = ((const f32x4*)(p.in[I_X] + (size_t)m_ * D))[lane + 64 * j]; } } } while (0)
      MID_LOAD(mc);
#pragma unroll 1
      for (int it = 0; it < 8; ++it) {
        const int m0 = mc + it * 16;
        {
            float ss[2] = {0.f, 0.f};
#define YV(rr, j, i) ((i) == 0 ? __uint_as_float(yw[rr][j].x << 16) : (i) == 1 ? __uint_as_float(yw[rr][j].x & 0xffff0000u) : (i) == 2 ? __uint_as_float(yw[rr][j].y << 16) : __uint_as_float(yw[rr][j].y & 0xffff0000u))
#pragma unroll
            for (int rr = 0; rr < 2; ++rr) {
#pragma unroll
                for (int j = 0; j < 4; ++j) ss[rr] += YV(rr, j, 0) * YV(rr, j, 0) + YV(rr, j, 1) * YV(rr, j, 1) + YV(rr, j, 2) * YV(rr, j, 2) + YV(rr, j, 3) * YV(rr, j, 3);
                ss[rr] = wave_sum(ss[rr]);
            }
#pragma unroll
            for (int rr = 0; rr < 2; ++rr) {
                const int lr = 2 * wave + rr, m = m0 + lr;
                const float r1 = 1.0f / sqrtf(ss[rr] * (1.0f / D) + EPS);
                float ss2 = 0.f;
#pragma unroll
                for (int j = 0; j < 4; ++j) {
                    const int col = 4 * (lane + 64 * j);
                    const f32x4 gp = *(const f32x4*)(PV + col), gt = *(const f32x4*)(PV + 1024 + col);
#pragma unroll
                    for (int i = 0; i < 4; ++i) { xv[rr][j][i] = xv[rr][j][i] + gt[i] * (YV(rr, j, i) * r1 * gp[i]); ss2 += xv[rr][j][i] * xv[rr][j][i]; }
                    ((f32x4*)(p.out + (size_t)m * D))[lane + 64 * j] = xv[rr][j];
                }
                ss2 = wave_sum(ss2);
                const float r2 = 1.0f / sqrtf(ss2 * (1.0f / D) + EPS);
#pragma unroll
                for (int j = 0; j < 4; ++j) {
                    const int col = 4 * (lane + 64 * j);
                    const f32x4 gp = *(const f32x4*)(PV + 2048 + col), sh = *(const f32x4*)(PV + 3072 + col), sc = *(const f32x4*)(PV + 4096 + col);
                    float h[4];
#pragma unroll
                    for (int i = 0; i < 4; ++i) h[i] = xv[rr][j][i] * r2 * gp[i] * (1.f + sc[i]) + sh[i];
                    uint2 o; o.x = pk2(h[0], h[1]); o.y = pk2(h[2], h[3]);
                    { int w8 = __builtin_amdgcn_cvt_pk_fp8_f32(h[0], h[1], 0, false); w8 = __builtin_amdgcn_cvt_pk_fp8_f32(h[2], h[3], w8, true); *(int*)(H2 + (size_t)m * D + col) = w8; }
                    *(uint2*)(Ahi + lr * RS + col * 2) = o;
                }
            }
            if (it < 7) MID_LOAD(m0 + 16);
        }
        asm volatile("s_waitcnt lgkmcnt(0)\n\ts_barrier" ::: "memory");
        {
            f32x4 acc[4];
#pragma unroll
            for (int nb = 0; nb < 4; ++nb) acc[nb] = (f32x4){0.f, 0.f, 0.f, 0.f};
#pragma unroll
            for (int ks = 0; ks < 4; ++ks) {
                const int ko = (wave * 128 + ks * 32 + 8 * fq) * 2;
                const bf16x8 ah = *(const bf16x8*)(Ahi + fr * RS + ko);
#pragma unroll
                for (int nb = 0; nb < 4; ++nb) acc[nb] = __builtin_amdgcn_mfma_f32_16x16x32_bf16(ah, wfr[ks][nb], acc[nb], 0, 0, 0);
            }
#pragma unroll
            for (int nb = 0; nb < 4; ++nb)
#pragma unroll
                for (int j = 0; j < 4; ++j) Pp[(wave * 16 + 4 * fq + j) * 64 + 16 * nb + fr] = acc[nb][j];
        }
        asm volatile("s_waitcnt lgkmcnt(0)\n\ts_barrier" ::: "memory");
#pragma unroll
        for (int rr = 0; rr < 2; ++rr) {
            const int lr = 2 * wave + rr;
            float lg = 0.f;
#pragma unroll
            for (int w = 0; w < 8; ++w) lg += Pp[(w * 16 + lr) * 64 + lane];
            const float score = 1.0f / (1.0f + expf(-lg));
            const float sel = score + rbias;
            float t1 = sel, t2 = -INFINITY;
#define TOP2(M) do { const float o1 = sx<M>(t1), o2 = sx<M>(t2); const float n1 = fmaxf(t1, o1), n2 = fmaxf(fminf(t1, o1), fmaxf(t2, o2)); t1 = n1; t2 = n2; } while (0)
            TOP2(1); TOP2(2); TOP2(4);
#undef TOP2
            const float gs = t1 + t2; const int grp = lane >> 3;
            int gr = 0;
#pragma unroll
            for (int j = 0; j < 8; ++j) { const float sj = __uint_as_float(__builtin_amdgcn_readlane(__float_as_uint(gs), j * 8)); gr += (sj > gs || (sj == gs && j < grp)) ? 1 : 0; }
            const bool gsel = gr < 4;
            float v = gsel ? sel : -INFINITY;
            int rk = TOPK;
#pragma unroll
            for (int it8 = 0; it8 < TOPK; ++it8) {
                const float mx = wave_max(v);
                const unsigned long long eq = __ballot(v == mx);
                const int win = __builtin_ctzll(eq);
                if (lane == win) { rk = it8; v = -INFINITY; }
            }
            const bool chosen = rk < TOPK;
            const float ssum = wave_sum(chosen ? score : 0.f);
            const float w = score / (ssum + 1e-20f) * 2.5f;
            if (chosen) {
                const int lpos = atomicAdd(&lcnt[lane], 1);
                const int idx = (it * 16 + lr) * 8 + rk;
                PE[idx] = lane | (lpos << 8); PW[idx] = w;
            }
        }
      }
      __syncthreads();
      if (tid < 64) { const int c = lcnt[tid]; gb[tid] = c ? (int)atomicAdd(&counts[b * 65 + tid], (unsigned)c) : 0; }
      __syncthreads();
      for (int i = tid; i < 1024; i += NT) {
          const int pe = PE[i], e = pe & 255, pos = gb[e] + (pe >> 8), mk = mc * 8 + i;
          TOKL[((size_t)b * 64 + e) * 8192 + pos] = mk; TE[mk] = e; TP[mk] = pos; TW[mk] = PW[i];
      }
      __syncthreads();
    }
}

constexpr int T_CNT = 0;
constexpr int T_TOT = 256;
constexpr int T_AB = 328;
constexpr int T_OFF = 400;
constexpr int T_GUP = 660;
constexpr int T_YC = 730;
constexpr int T_YB = 990;
constexpr int T_DUP = 1250;
constexpr int T_UL = 1520;
constexpr int T_END = 1520 + 512;
__device__ __forceinline__ int scan_incl(int v, int lane) {
#pragma unroll
    for (int off = 1; off < 64; off <<= 1) { const int t = __builtin_amdgcn_ds_bpermute(((lane - off) & 63) << 2, v); if (lane >= off) v += t; }
    return v;
}
__device__ __forceinline__ void build_moe(const Params& p, int* tab) {
    const unsigned* counts = (const unsigned*)(p.ws + WS_CTL);
    __syncthreads();
    const int tid = otid(), wave = tid >> 6, lane = tid & 63;
    if (wave == 0) {
        const int c0 = (int)counts[0 * 65 + lane], c1 = (int)counts[1 * 65 + lane], c2 = (int)counts[2 * 65 + lane], c3 = (int)counts[3 * 65 + lane];
        tab[T_CNT + 0 * 64 + lane] = c0; tab[T_CNT + 1 * 64 + lane] = c1; tab[T_CNT + 2 * 64 + lane] = c2; tab[T_CNT + 3 * 64 + lane] = c3;
        tab[T_OFF + lane * 4 + 0] = 0; tab[T_OFF + lane * 4 + 1] = c0; tab[T_OFF + lane * 4 + 2] = c0 + c1; tab[T_OFF + lane * 4 + 3] = c0 + c1 + c2;
        const int tot = c0 + c1 + c2 + c3, pad = (tot + 255) & ~255, gu = ((tot + 255) >> 8) * 2;
        const int sp = scan_incl(pad, lane), sg = scan_incl(gu, lane);
        tab[T_TOT + lane] = tot; tab[T_AB + lane] = sp - pad; tab[T_GUP + lane] = sg - gu;
        const int cb[4] = {c0, c1, c2, c3};
#pragma unroll
        for (int b = 0; b < 4; ++b) {
            const int du = ((cb[b] + 255) >> 8) * 4;
            const int sy = scan_incl(cb[b], lane), sd = scan_incl(du, lane);
            tab[T_YB + 65 * b + lane] = sy - cb[b]; tab[T_DUP + 66 * b + lane] = sd - du;
            if (lane == 63) { tab[T_YB + 65 * b + 64] = sy; tab[T_DUP + 66 * b + 64] = sd; tab[T_DUP + 66 * b + 65] = sd + (SEQ / 256) * 4; }
        }
        if (lane == 63) { tab[T_TOT + 64] = T; tab[T_AB + 64] = sp; tab[T_GUP + 64] = sg; tab[T_GUP + 65] = sg + (T / 256) * 2; }
    }
    __syncthreads();
}

__device__ __forceinline__ void moe_decode(const GP_LAS int* tab, int e, int pos_e, int& b, int& pos) {
    const int o1 = tab[T_OFF + e * 4 + 1], o2 = tab[T_OFF + e * 4 + 2], o3 = tab[T_OFF + e * 4 + 3];
    b = (pos_e >= o1 ? 1 : 0) + (pos_e >= o2 ? 1 : 0) + (pos_e >= o3 ? 1 : 0);
    pos = pos_e - (b == 0 ? 0 : (b == 1 ? o1 : (b == 2 ? o2 : o3)));
}
__device__ __forceinline__ int yrow0(int b) { return b == 0 ? 2 * 1024 : (272 + 72 * (b - 1)) * 1024; }
struct MoeSched {
    const GP_LAS int* tab; int G, c, ntn, U, down, chunk; const int* TOKL; const char* Bt;
    __device__ __forceinline__ void prepare(int* tabw, int wv) const {
        if (wv == 0) {
            const int i = lane_id(); int L = i * G + c;
            if (L < U) {
                int bt = 0;
                if (down) {
#pragma unroll
                    for (int q = 0; q < 3; ++q) { const int u0 = tabw[T_DUP + 66 * bt + 65]; if (L >= u0) { L -= u0; ++bt; } } }
                const int pre = down ? T_DUP + 66 * bt : T_GUP;
                int lo = 0, hi = 64;
                while (lo < hi) { const int mid = (lo + hi + 1) >> 1; if (tabw[pre + mid] <= L) lo = mid; else hi = mid - 1; }
                const int loc = L - tabw[pre + lo];
                int cnt, base, bb;
                if (down) { cnt = (lo < 64) ? tabw[T_CNT + bt * 64 + (lo & 63)] : SEQ; base = tabw[T_YB + 65 * bt + lo] + yrow0(bt);
                            bb = tabw[T_AB + lo] + (lo < 64 ? tabw[T_OFF + (lo & 63) * 4 + bt] : bt * SEQ); }
                else { cnt = tabw[T_TOT + lo]; base = tabw[T_AB + lo]; bb = 0; }
                int* ul = tabw + T_UL + 8 * i;
                ul[0] = lo; ul[1] = loc / ntn; ul[2] = loc % ntn; ul[3] = cnt; ul[4] = base; ul[5] = bb;
            }
        }
        __syncthreads();
    }
    __device__ __forceinline__ bool next(int i, gp::Unit& u) const {
        if (i * G + c >= U) return false;
        const GP_LAS int* ul = tab + T_UL + 8 * i;
        u.e = __builtin_amdgcn_readfirstlane(ul[0]); u.pm = __builtin_amdgcn_readfirstlane(ul[1]); u.pn = __builtin_amdgcn_readfirstlane(ul[2]);
        u.cnt = __builtin_amdgcn_readfirstlane(ul[3]); u.base = __builtin_amdgcn_readfirstlane(ul[4]); u.b = __builtin_amdgcn_readfirstlane(ul[5]);
        return true;
    }
    __device__ __forceinline__ unsigned arow(const gp::Unit& u, int r) const {
        const int pos_e = u.pm * 256 + r;
        if (down) return (unsigned)(u.b + pos_e) * 256u;
        int tok;
        if (u.e < 64) { int b, pos; moe_decode(tab, u.e, pos_e, b, pos); tok = (pos_e < u.cnt) ? (TOKL[((size_t)b * 64 + u.e) * 8192 + pos] >> 3) : 0; } else tok = pos_e;
        return (unsigned)tok * 1024u;
    }
    __device__ __forceinline__ const char* bptr(const gp::Unit& u) const {
        return down ? Bt + ((size_t)u.e * 1024 + u.pn * 256) * 256 : Bt + ((size_t)u.e * 512 + u.pn * 256) * 1024;
    }
};
struct EpiGU {
    unsigned char* ACT; const int* TOKL; const float* TW; const GP_LAS int* tab;
    __device__ __forceinline__ void operator()(const f32x4 (&acc)[2][2][4][2], const gp::Unit& u, int wr, int wc, int fr, int fq) const {
#pragma unroll
        for (int ai = 0; ai < 2; ++ai)
#pragma unroll
            for (int m = 0; m < 4; ++m) {
                const int pos_e = u.pm * 256 + ai * 128 + wr * 64 + m * 16 + fr;
                if (pos_e < u.cnt) {
                    float w = 1.0f;
                    if (u.e < 64) { int b, pos; moe_decode(tab, u.e, pos_e, b, pos); w = TW[TOKL[((size_t)b * 64 + u.e) * 8192 + pos]]; }
                    float a[8];
#pragma unroll
                    for (int n = 0; n < 2; ++n)
#pragma unroll
                        for (int i = 0; i < 4; ++i) { const float g = acc[ai][0][m][n][i] * (1.f / GUSCALE), up = acc[ai][1][m][n][i] * (1.f / GUSCALE);
                            a[4 * n + i] = __builtin_amdgcn_fmed3f(g * __builtin_amdgcn_rcpf(1.0f + __builtin_amdgcn_exp2f(-1.4426950408889634f * g)) * up * (w * ASCALE), -448.f, 448.f); }
                    int w0 = __builtin_amdgcn_cvt_pk_fp8_f32(a[0], a[1], 0, false); w0 = __builtin_amdgcn_cvt_pk_fp8_f32(a[2], a[3], w0, true);
                    int w1 = __builtin_amdgcn_cvt_pk_fp8_f32(a[4], a[5], 0, false); w1 = __builtin_amdgcn_cvt_pk_fp8_f32(a[6], a[7], w1, true);
                    uint2 o; o.x = (unsigned)w0; o.y = (unsigned)w1;
                    *(uint2*)(ACT + ((size_t)u.base + pos_e) * DE + u.pn * 128 + wc * 32 + fq * 8) = o;
                }
            }
    }
};
constexpr float YSCALE = 16.f;
struct EpiDown {
    unsigned char* ws;
    __device__ __forceinline__ void operator()(const f32x4 (&acc)[2][2][4][2], const gp::Unit& u, int wr, int wc, int fr, int fq) const {
#pragma unroll
        for (int ai = 0; ai < 2; ++ai)
#pragma unroll
            for (int m = 0; m < 4; ++m) {
                const int pos = u.pm * 256 + ai * 128 + wr * 64 + m * 16 + fr;
                if (pos < u.cnt) {
                    unsigned char* rowp = ws + (size_t)(u.base + pos) * D + u.pn * 256 + wc * 32 + fq * 8;
#pragma unroll
                    for (int bj = 0; bj < 2; ++bj) { const f32x4 v0 = acc[ai][bj][m][0] * (YSCALE / (WDSCALE * ASCALE)), v1 = acc[ai][bj][m][1] * (YSCALE / (WDSCALE * ASCALE));
                        int w0 = __builtin_amdgcn_cvt_pk_fp8_f32(v0[0], v0[1], 0, false); w0 = __builtin_amdgcn_cvt_pk_fp8_f32(v0[2], v0[3], w0, true);
                        int w1 = __builtin_amdgcn_cvt_pk_fp8_f32(v1[0], v1[1], 0, false); w1 = __builtin_amdgcn_cvt_pk_fp8_f32(v1[2], v1[3], w1, true);
                        uint2 o; o.x = (unsigned)w0; o.y = (unsigned)w1;
                        *(uint2*)(rowp + bj * 128) = o; }
                }
            }
    }
};
__device__ __forceinline__ void ph_moe_gu(const Params& p, unsigned char* smem) {
    unsigned char* ws = p.ws;
    int* tab = (int*)(smem + gp::STAGE_BYTES);
    build_moe(p, tab);
    MoeSched S; S.tab = (const GP_LAS int*)tab; S.G = gridDim.x; S.c = (gridDim.x % 8 == 0) ? (int)((blockIdx.x % 8) * (gridDim.x / 8) + blockIdx.x / 8) : (int)blockIdx.x;   S.ntn = 2; S.U = __builtin_amdgcn_readfirstlane(tab[T_GUP + 65]); S.down = 0; S.chunk = 0;
    S.TOKL = (const int*)(ws + WS_TOKL); S.Bt = (const char*)(ws + WS_WGUT);
    S.prepare(tab, p.chunk);
    EpiGU E{ws + WS_ACT, (const int*)(ws + WS_TOKL), (const float*)(ws + WS_TW), (const GP_LAS int*)tab};
    gp::gemm_phase<EpiGU, MoeSched, true, true>(p.chunk, (GP_LAS unsigned char*)smem, (const char*)(ws + WS_H2), D / 2, S, E);
}
__device__ __forceinline__ void ph_moe_down(const Params& p, unsigned char* smem, int c) {
    unsigned char* ws = p.ws;
    int* tab = (int*)(smem + gp::STAGE_BYTES);
    build_moe(p, tab);
    MoeSched S; S.tab = (const GP_LAS int*)tab; S.G = gridDim.x; S.c = (gridDim.x % 8 == 0) ? (int)((blockIdx.x % 8) * (gridDim.x / 8) + blockIdx.x / 8) : (int)blockIdx.x;   S.ntn = 4; S.U = __builtin_amdgcn_readfirstlane(tab[T_DUP + 65] + tab[T_DUP + 66 + 65] + tab[T_DUP + 132 + 65] + tab[T_DUP + 198 + 65]); S.down = 1; S.chunk = c;
    S.TOKL = nullptr; S.Bt = (const char*)(ws + WS_WDT);
    S.prepare(tab, p.chunk);
    EpiDown E{ws};
    gp::gemm_phase<EpiDown, MoeSched, false, true>(p.chunk, (GP_LAS unsigned char*)smem, (const char*)(ws + WS_ACT), DE / 2, S, E);
}

__device__ __forceinline__ void ph_final(const Params& p, float* lds) {
    unsigned char* ws = p.ws;
    int* tab = (int*)lds;
    build_moe(p, tab);
    const int tid = otid(), wave = tid >> 6, lane = tid & 63;
    const int gw = blockIdx.x * NWV + wave, GW = gridDim.x * NWV;
    const int* TE = (const int*)(ws + WS_TE); const int* TP = (const int*)(ws + WS_TP);
    const unsigned char* Y = ws;
    for (int m = gw; m < T; m += GW) {
        const int b = m >> 13, t = m & (SEQ - 1);
        const float* mod = (const float*)(ws + WS_MOD) + b * 6144 + 5 * 1024;
        float acc[16];
#pragma unroll
        for (int i = 0; i < 16; ++i) acc[i] = 0.f;
#pragma unroll
        for (int k = 0; k < 9; ++k) {
            int row;
            if (k < 8) { const int e = TE[m * 8 + k]; row = tab[T_YB + 65 * b + e] + TP[m * 8 + k]; }
            else row = tab[T_YB + 65 * b + 64] + t;
            row += yrow0(b);
            const unsigned char* yr = Y + (size_t)row * D;
#pragma unroll
            for (int j = 0; j < 4; ++j) { const int w = *(const int*)(yr + 4 * (lane + 64 * j));
                acc[4 * j] += __builtin_amdgcn_cvt_f32_fp8(w, 0); acc[4 * j + 1] += __builtin_amdgcn_cvt_f32_fp8(w, 1); acc[4 * j + 2] += __builtin_amdgcn_cvt_f32_fp8(w, 2); acc[4 * j + 3] += __builtin_amdgcn_cvt_f32_fp8(w, 3); }
        }
        float ss = 0.f;
#pragma unroll
        for (int i = 0; i < 16; ++i) { acc[i] *= (1.f / YSCALE); ss += acc[i] * acc[i]; }
        ss = wave_sum(ss);
        const float rs = 1.0f / sqrtf(ss * (1.0f / D) + EPS);
#pragma unroll
        for (int j = 0; j < 4; ++j) {
            const int col = 4 * (lane + 64 * j);
            const f32x4 gp = *(const f32x4*)(p.in[I_GFPOST] + col), gt = *(const f32x4*)(mod + col);
            f32x4 x1 = ((const f32x4*)(p.out + (size_t)m * D))[lane + 64 * j];
#pragma unroll
            for (int i = 0; i < 4; ++i) x1[i] += gt[i] * (acc[4 * j + i] * rs * gp[i]);
            ((f32x4*)(p.out + (size_t)m * D))[lane + 64 * j] = x1;
        }
    }
}

#define GAS __attribute__((address_space(1)))
#define LAS __attribute__((address_space(3)))
#define XB_TMO      128
#define XB_XCNT(j)  (256  + 64 * (j))
#define XB_XSUB(j)  (1280 + 64 * (j))
#define XB_XGEN(j)  (2304 + 64 * (j))
#define XB_TOP      3328
#define XB_TOPGEN   3392
#define XCD_BAR_WORDS 3456
#define XB_SPIN_CAP (1u << 21)
__device__ __forceinline__ unsigned xb_ld(unsigned* p)              { return __hip_atomic_load(p, __ATOMIC_RELAXED, __HIP_MEMORY_SCOPE_AGENT); }
__device__ __forceinline__ unsigned xb_add(unsigned* p, unsigned v) { return __hip_atomic_fetch_add(p, v, __ATOMIC_RELAXED, __HIP_MEMORY_SCOPE_AGENT); }
__device__ __forceinline__ unsigned xb_xcc_id() { return (unsigned)__builtin_amdgcn_s_getreg((3 << 11) | 20) & 0xFu; }
#define XB_SPIN(cond, bar) do { unsigned _sp = 0; while (cond) { __builtin_amdgcn_s_sleep(1); \
    if ((++_sp & 255u) == 0u) { if (xb_ld(&(bar)[XB_TMO])) break; if (_sp > XB_SPIN_CAP) { atomicAdd(&(bar)[XB_TMO], 1u); break; } } } } while (0)
struct XcdBarrier { unsigned* bar; unsigned x; volatile LAS unsigned* st; };
__device__ __forceinline__ XcdBarrier xcd_barrier_post(unsigned* bar, volatile LAS unsigned* st, int wv) {
    XcdBarrier b; b.bar = bar; b.x = xb_xcc_id(); b.st = st;
    if (wv == 0 && lane_id() == 0) (void)xb_add(&bar[XB_XCNT(b.x)], 1u);
    return b;
}
__device__ __forceinline__ void xcd_barrier_complete(unsigned* bar, unsigned x, unsigned& nloc, unsigned& nx) {
    const unsigned G = gridDim.x * gridDim.y * gridDim.z;
    unsigned sum, cnt, mine, sp = 0u;
    for (;;) {
        sum = 0u; cnt = 0u; mine = 0u;
#pragma unroll
        for (unsigned j = 0; j < 16; ++j) { const unsigned c = xb_ld(&bar[XB_XCNT(j)]); sum += c; cnt += (c > 0u) ? 1u : 0u; mine = (j == x) ? c : mine; }
        if (sum == G) break;
        __builtin_amdgcn_s_sleep(1);
        if ((++sp & 255u) == 0u) { if (xb_ld(&bar[XB_TMO])) break; if (sp > XB_SPIN_CAP) { atomicAdd(&bar[XB_TMO], 1u); break; } }
    }
    nloc = mine > 0u ? mine : 1u; nx = cnt > 0u ? cnt : 1u;
}
__device__ __forceinline__ void xcd_barrier(const XcdBarrier& b, int wv) {
    asm volatile("s_waitcnt vmcnt(0)" ::: "memory");
    __syncthreads();
    if (wv == 0 && lane_id() == 0) {
        unsigned* bar = b.bar;
        __builtin_amdgcn_s_waitcnt(0);
        unsigned nloc = b.st[0], nx = b.st[1];
        if (nloc == 0u) { xcd_barrier_complete(bar, b.x, nloc, nx); b.st[0] = nloc; b.st[1] = nx; }
        const unsigned old = xb_add(&bar[XB_XSUB(b.x)], 1u);
        const unsigned gen = old / nloc;
        if (old + 1u == (gen + 1u) * nloc) {
            __builtin_amdgcn_fence(__ATOMIC_RELEASE, "agent");
            asm volatile("s_waitcnt vmcnt(0)" ::: "memory");
            const unsigned og = xb_add(&bar[XB_TOP], 1u);
            const unsigned tg = og / nx;
            if (og + 1u == (tg + 1u) * nx) xb_add(&bar[XB_TOPGEN], 1u);
            else XB_SPIN(xb_ld(&bar[XB_TOPGEN]) == tg, bar);
            __builtin_amdgcn_fence(__ATOMIC_ACQUIRE, "agent");
            xb_add(&bar[XB_XGEN(b.x)], 1u);
            asm volatile("s_waitcnt vmcnt(0)" ::: "memory");
        } else {
            XB_SPIN(xb_ld(&bar[XB_XGEN(b.x)]) == gen, bar);
            __builtin_amdgcn_fence(__ATOMIC_ACQUIRE, "agent");
            asm volatile("s_waitcnt vmcnt(0)" ::: "memory");
        }
    }
    __syncthreads();
}

namespace cg = cooperative_groups;
constexpr int LDS_BYTES = 144 * 1024;
typedef const __attribute__((address_space(4))) Params* KP;
__device__ __forceinline__ Params kargs() {
    Params p;
#if defined(__HIP_DEVICE_COMPILE__)
    typedef const __attribute__((address_space(4))) unsigned long long* KQ;
    KQ kq = (KQ)__builtin_amdgcn_kernarg_segment_ptr(); asm volatile("" : "+s"(kq));
    unsigned long long* d = (unsigned long long*)&p;
#pragma unroll
    for (int i = 0; i < (int)(sizeof(Params) / 8); ++i) d[i] = kq[i];
#endif
    return p;
}
#define PH(call) do { Params p = kargs(); p.chunk = wv; call; } while (0)
__global__ void __launch_bounds__(NT) mega_fwd(Params p_unused) {
    extern __shared__ __attribute__((aligned(16))) unsigned char smem[];
    float* lds = (float*)smem;
    volatile LAS unsigned* misc = (volatile LAS unsigned*)((LAS unsigned char*)smem + (LDS_BYTES - 64));
    if (threadIdx.x < 16) misc[threadIdx.x] = 0u;
    __syncthreads();
    unsigned* barw; { const Params p = kargs(); barw = (unsigned*)(p.ws + WS_CTL) + 4096; }
    const int wv = __builtin_amdgcn_readfirstlane(threadIdx.x >> 6);
    const XcdBarrier bar = xcd_barrier_post(barw, misc, wv);
#define SYNC() xcd_barrier(bar, wv)
    PH(ph_prep(p, lds)); PH(ph_prep_weights(p, lds, 0, 0));   SYNC();
    PH(ph_norm1(p));                SYNC();
    PH(ph_inproj(p, smem)); PH(ph_prep_weights(p, lds, 1, (MTOT / 256) * (INW / 256) % (int)gridDim.x));         SYNC();
    PH(ph_attn(p, smem)); PH(ph_fourierA(p, smem));  SYNC();
    PH(ph_fourierB(p, smem));       SYNC();
    PH(ph_outproj(p, smem));        SYNC();
    PH(ph_mid(p, smem));            SYNC();
    PH(ph_moe_gu(p, smem));         SYNC();
#pragma unroll 1
    PH(ph_moe_down(p, smem, 0));    SYNC();
    PH(ph_final(p, lds));
#undef SYNC
}

extern "C" void kernel_launch(void* const* d_in, const int* in_sizes, int n_in, void* d_out, int out_size, void* d_ws, size_t ws_size, hipStream_t stream) {
    if (n_in != 26 || ws_size < WS_END) { fprintf(stderr, "kernel_launch: unexpected n_in %d / ws %zu\n", n_in, ws_size); return; }
    static int grid_blocks = 0;
    if (!grid_blocks) {
        int dev = 0, cus = 0, per_cu = 0;
        (void)hipGetDevice(&dev);
        (void)hipDeviceGetAttribute(&cus, hipDeviceAttributeMultiprocessorCount, dev);
        (void)hipFuncSetAttribute((const void*)mega_fwd, hipFuncAttributeMaxDynamicSharedMemorySize, LDS_BYTES);
        (void)hipOccupancyMaxActiveBlocksPerMultiprocessor(&per_cu, (const void*)mega_fwd, NT, LDS_BYTES);
        if (per_cu < 1) { fprintf(stderr, "kernel_launch: occupancy query says %d blocks/CU\n", per_cu); per_cu = 1; }
        if (per_cu > 1) per_cu = 1;
        grid_blocks = cus * per_cu;
    }
    Params p{};
    for (int i = 0; i < 26; ++i) p.in[i] = (const float*)d_in[i];
    p.out = (float*)d_out; p.ws = (unsigned char*)d_ws; p.chunk = 0; p.pad = 0;
    (void)hipMemsetAsync((char*)d_ws + WS_CTL, 0, 32768, stream);
    void* args[] = {&p};
    hipError_t e = hipLaunchCooperativeKernel((const void*)mega_fwd, dim3(grid_blocks), dim3(NT), args, LDS_BYTES, stream);
    if (e != hipSuccess) fprintf(stderr, "cooperative launch failed: %s (grid %d)\n", hipGetErrorString(e), grid_blocks);
}
```

```cpp
#include <hip/hip_runtime.h>
#include <hip/hip_cooperative_groups.h>
#include <cstdio>
#include <cstdint>

typedef unsigned short bf16_t;
typedef float f32x4 __attribute__((ext_vector_type(4)));

constexpr int D = 1024, BATCH = 4, SEQ = 8192, T = BATCH * SEQ, CTX = 256, TC = BATCH * CTX;
constexpr int MTOT = T + TC;
constexpr int KVLEN = CTX + SEQ;
constexpr int INW = 2560, NH = 6, QKW = 768, FW = 256;
constexpr int NE = 64, DE = 256, TOPK = 8;
constexpr int NT = 512, NWV = 8;
constexpr int SLOTS_B = 90112;
constexpr float EPS = 1e-6f;
constexpr float LAM_INIT = 0.2f;
constexpr float QSCALE = 0.125f * 1.4426950408889634f;
constexpr float SQS = 0.42466090014400953f;

constexpr size_t MiB = 1u << 20;
constexpr size_t WS_CTL = 0;
constexpr size_t WS_MOD = 1 * MiB;
constexpr size_t WS_TABW = WS_MOD + 128 * 1024;
constexpr size_t WS_ROPE = WS_MOD + 192 * 1024;
constexpr size_t WS_GCS = WS_MOD + 256 * 1024;
constexpr size_t WS_W128E = WS_MOD + 768 * 1024;
constexpr size_t WS_M64E = WS_MOD + 832 * 1024;
constexpr size_t WS_GT = WS_MOD + 864 * 1024;
constexpr size_t WS_WRT = WS_MOD + 512 * 1024;
constexpr size_t WS_WINT = 2 * MiB;
constexpr size_t WS_WOUTT = 7 * MiB;
constexpr size_t WS_WGUT = 9 * MiB;
constexpr size_t WS_WDT = 74 * MiB;
constexpr size_t WS_TE = 107 * MiB;
constexpr size_t WS_TP = 108 * MiB;
constexpr size_t WS_TW = 109 * MiB;
constexpr size_t WS_TOKL = 110 * MiB;
constexpr size_t WS_AO = 118 * MiB;
constexpr size_t WS_ACT = 118 * MiB;
constexpr size_t WS_Q = 182 * MiB;
constexpr size_t WS_K = 230 * MiB;
constexpr size_t WS_V = WS_K + (size_t)BATCH * KVLEN * QKW * 2;
constexpr size_t WS_F = 329 * MiB;
constexpr size_t WS_FY = 361 * MiB;
constexpr size_t WS_HX = 425 * MiB;
constexpr size_t WS_YX = 358 * MiB;
constexpr size_t WS_H2 = 294 * MiB;
constexpr size_t WS_Y = 294 * MiB;
constexpr size_t WS_END = 491 * MiB;

struct Params {
    const float* in[26];
    float* out;
    unsigned char* ws;
    int chunk;
    int pad;
};
enum { I_X = 0, I_C, I_CTX, I_CCTX, I_WMOD, I_BMOD, I_GAPRE, I_GAPOST, I_WIN, I_WF, I_LQ1, I_LK1, I_LQ2, I_LK2, I_GSUB, I_WOUT,
       I_GFPRE, I_GFPOST, I_WR, I_RB, I_WG, I_WU, I_WD, I_WSG, I_WSU, I_WSD };

__device__ __forceinline__ float bf2f(bf16_t v) { return __uint_as_float(((unsigned)v) << 16); }
__device__ __forceinline__ bf16_t f2bf(float f) { unsigned u = __float_as_uint(f); return (bf16_t)((u + 0x7fffu + ((u >> 16) & 1u)) >> 16); }
__device__ __forceinline__ unsigned pk2(float lo, float hi) { return (unsigned)f2bf(lo) | ((unsigned)f2bf(hi) << 16); }
template <int M> __device__ __forceinline__ float sx(float v) { return __int_as_float(__builtin_amdgcn_ds_swizzle(__float_as_int(v), (M << 10) | 0x1f)); }
template <int M> __device__ __forceinline__ int sxi(int v) { return __builtin_amdgcn_ds_swizzle(v, (M << 10) | 0x1f); }
__device__ __forceinline__ float wave_sum(float v) {
    v += sx<1>(v); v += sx<2>(v); v += sx<4>(v); v += sx<8>(v); v += sx<16>(v);
    auto rr = __builtin_amdgcn_permlane32_swap(__float_as_uint(v), __float_as_uint(v), false, false);
    return __uint_as_float(rr[0]) + __uint_as_float(rr[1]);
}
__device__ __forceinline__ float dpp_f(float v, const int ctrl_sel) {
    const int x = __float_as_int(v); int r;
    if (ctrl_sel == 0) r = __builtin_amdgcn_update_dpp(x, x, 0xB1, 0xf, 0xf, false);
    else if (ctrl_sel == 1) r = __builtin_amdgcn_update_dpp(x, x, 0x4E, 0xf, 0xf, false);
    else if (ctrl_sel == 2) r = __builtin_amdgcn_update_dpp(x, x, 0x141, 0xf, 0xf, false);
    else r = __builtin_amdgcn_update_dpp(x, x, 0x140, 0xf, 0xf, false);
    return __int_as_float(r);
}
__device__ __forceinline__ float wave_max(float v) {
    v = fmaxf(v, dpp_f(v, 0)); v = fmaxf(v, dpp_f(v, 1)); v = fmaxf(v, dpp_f(v, 2)); v = fmaxf(v, dpp_f(v, 3));
    const float a = __uint_as_float(__builtin_amdgcn_readlane(__float_as_uint(v), 0)), b = __uint_as_float(__builtin_amdgcn_readlane(__float_as_uint(v), 16));
    const float c = __uint_as_float(__builtin_amdgcn_readlane(__float_as_uint(v), 32)), d = __uint_as_float(__builtin_amdgcn_readlane(__float_as_uint(v), 48));
    return fmaxf(fmaxf(a, b), fmaxf(c, d));
}
__device__ __forceinline__ int lane_id() { int l; asm volatile("v_mbcnt_lo_u32_b32 %0, -1, 0\n\tv_mbcnt_hi_u32_b32 %0, -1, %0" : "=v"(l)); return l; }
__device__ __forceinline__ int otid_w(int wv) { return wv * 64 + lane_id(); }
#define otid() otid_w(p.chunk)
__device__ __forceinline__ float silu_f(float x) { return x / (1.f + expf(-x)); }

__device__ __forceinline__ void ph_prep(const Params& p, float* lds) {
    const int tid = otid(), bid = blockIdx.x, nblk = gridDim.x;
    const int gt = bid * NT + tid, GT = nblk * NT;
    unsigned char* ws = p.ws;
    float2* tabw = (float2*)(ws + WS_TABW);
    for (int i = gt; i < 8192; i += GT) { float s, c; sincospif((float)i * (1.0f / 4096.0f), &s, &c); tabw[i] = make_float2(c, s); }
    float* rope = (float*)(ws + WS_ROPE);
    for (int i = gt; i < 192 * 16; i += GT) {
        const int pos = (i < 2048) ? (i >> 4) : ((i - 2048) >> 4); const int f = i & 15;
        const float inv = powf(10000.0f, -(float)(2 * f) / 32.0f); const float ang = (float)pos * inv;
        const float c = cosf(ang), s = sinf(ang);
        if (i < 2048) { rope[i] = c; rope[2048 + i] = s; } else { rope[4096 + (i - 2048)] = c; rope[4096 + 1024 + (i - 2048)] = s; }
    }
    { bf16_t* gt = (bf16_t*)(ws + WS_GT); const float* wf = p.in[I_WF];
      for (int i = bid * NT + tid; i < 4 * 64 * 128; i += GT) {
        const int g = i >> 13, d = (i >> 7) & 63, part = (i >> 6) & 1, c = i & 63;
        float a = 0.f;
        for (int j = 0; j < 64; ++j) { float s, co; sincospif((float)((c * j) & 63) * (1.0f / 32.0f), &s, &co); a += (part ? s : co) * wf[(g * 64 + j) * 64 + d]; }
        gt[i] = f2bf(a * 0.0013810679320049757f);
      }
      bf16_t* w128 = (bf16_t*)(ws + WS_W128E);
      for (int i = bid * NT + tid; i < 256 * 128; i += GT) { const int kk = i >> 7, n1 = i & 127; float s, co; sincospif((float)(((kk & 127) * n1) & 127) * (1.0f / 64.0f), &s, &co); w128[i] = f2bf(kk < 128 ? co : -s); }
      bf16_t* m64 = (bf16_t*)(ws + WS_M64E);
      for (int i = bid * NT + tid; i < 128 * 128; i += GT) { const int ro = i >> 7, ci = i & 127, po = ro >> 6, k2 = ro & 63, pi = ci >> 6, n2 = ci & 63;
        float s, co; sincospif((float)((k2 * n2) & 63) * (1.0f / 32.0f), &s, &co); m64[i] = f2bf(po == pi ? co : (po == 0 ? s : -s)); }
    }
    {
      bf16_t* wrt = (bf16_t*)(ws + WS_WRT); const float* wr = p.in[I_WR];
      for (int i = gt; i < 64 * 1024; i += GT) {
        const int j = i & 7, ln = (i >> 3) & 63, nb = (i >> 9) & 3, ks = (i >> 11) & 3, wv_ = i >> 13;
        const int e = 16 * nb + (ln & 15), k = wv_ * 128 + ks * 32 + 8 * (ln >> 4) + j;
        const float w = wr[k * 64 + e]; const bf16_t h = f2bf(w);
        const int o = ((((wv_ * 4 + ks) * 4 + nb) * 2) * 64 + ln) * 8 + j;
        wrt[o] = h; wrt[o + 512] = f2bf(w - bf2f(h)); } }
    if (gt == 0) {
        float s1 = 0.f, s2 = 0.f;
        for (int i = 0; i < 64; ++i) { s1 += p.in[I_LQ1][i] * p.in[I_LK1][i]; s2 += p.in[I_LQ2][i] * p.in[I_LK2][i]; }
        ((float*)(ws + WS_CTL))[1024] = expf(s1) - expf(s2) + LAM_INIT;
    }
    float* sc = lds;
    float* red = lds + 5 * 1024;
    for (int i = tid; i < 5 * 1024; i += NT) { const int r = i >> 10, k = i & 1023; const float v = (r < 4) ? p.in[I_C][r * 1024 + k] : p.in[I_CCTX][k]; sc[i] = silu_f(v); }
    __syncthreads();
    const int wave = tid >> 6, lane = tid & 63;
    float* mod = (float*)(ws + WS_MOD);
    for (int task = bid; task < 96; task += nblk) {
        const int col = task * 64 + lane;
        float a0 = 0, a1 = 0, a2 = 0, a3 = 0, a4 = 0;
        const float* wm = p.in[I_WMOD];
#pragma unroll 32
        for (int k = wave * 128; k < wave * 128 + 128; ++k) { const float w = wm[(size_t)k * 6144 + col]; a0 += sc[k] * w; a1 += sc[1024 + k] * w; a2 += sc[2048 + k] * w; a3 += sc[3072 + k] * w; a4 += sc[4096 + k] * w; }
        red[(wave * 5 + 0) * 64 + lane] = a0; red[(wave * 5 + 1) * 64 + lane] = a1; red[(wave * 5 + 2) * 64 + lane] = a2; red[(wave * 5 + 3) * 64 + lane] = a3; red[(wave * 5 + 4) * 64 + lane] = a4;
        __syncthreads();
        if (tid < 320) { const int r = tid >> 6, l = tid & 63; float s = 0.f; for (int w = 0; w < 8; ++w) s += red[(w * 5 + r) * 64 + l]; mod[r * 6144 + task * 64 + l] = s + p.in[I_BMOD][task * 64 + l]; }
        __syncthreads();
    }
}

__device__ __forceinline__ void ph_norm1(const Params& p) {
    const int tid = otid(), wave = tid >> 6, lane = tid & 63;
    const int gw = blockIdx.x * NWV + wave, GW = gridDim.x * NWV;
    const float* mod = (const float*)(p.ws + WS_MOD);
    bf16_t* hx = (bf16_t*)(p.ws + WS_HX);
    const float* g = p.in[I_GAPRE];
    for (int m = gw; m < MTOT; m += GW) {
        const float* src = (m < T) ? p.in[I_X] + (size_t)m * D : p.in[I_CTX] + (size_t)(m - T) * D;
        const int r = (m < T) ? (m >> 13) : 4;
        const float* shift = mod + r * 6144; const float* scale = shift + 1024;
        f32x4 v[4]; float ss = 0.f;
#pragma unroll
        for (int j = 0; j < 4; ++j) { v[j] = ((const f32x4*)src)[lane + 64 * j]; ss += v[j][0] * v[j][0] + v[j][1] * v[j][1] + v[j][2] * v[j][2] + v[j][3] * v[j][3]; }
        ss = wave_sum(ss);
        const float rs = 1.0f / sqrtf(ss * (1.0f / D) + EPS);
#pragma unroll
        for (int j = 0; j < 4; ++j) {
            const int col = 4 * (lane + 64 * j);
            const f32x4 g4 = *(const f32x4*)(g + col), sc4 = *(const f32x4*)(scale + col), sh4 = *(const f32x4*)(shift + col);
            float h[4];
#pragma unroll
            for (int i = 0; i < 4; ++i) h[i] = v[j][i] * rs * g4[i] * (1.f + sc4[i]) + sh4[i];
            uint2 o; o.x = pk2(h[0], h[1]); o.y = pk2(h[2], h[3]);
            *(uint2*)(hx + (size_t)m * D + col) = o;
        }
    }
}

namespace gp {
#define GP_LAS __attribute__((address_space(3)))
typedef short bf16x8 __attribute__((ext_vector_type(8)));
typedef unsigned u32x4 __attribute__((ext_vector_type(4)));
typedef int i32x4 __attribute__((ext_vector_type(4)));
constexpr int BM = 256, BK = 64, HALF = 128, HTB = HALF * BK * 2, STAGE_BYTES = 8 * HTB;
__device__ __forceinline__ int lds_byte(int r, int c) { const int st = (r >> 4) * 2 + (c >> 5), rr = r & 15, cc = c & 31, ob = rr * 64 + cc * 2; return st * 1024 + (ob ^ (((ob >> 9) & 1) << 5)); }
__device__ __forceinline__ void stage_rc(int b, int& R, int& C) { const int st = b / 1024, sb = b % 1024, swz = sb ^ (((sb >> 9) & 1) << 5); R = (st >> 1) * 16 + swz / 64; C = (st & 1) * 32 + (swz % 64) / 2; }
__device__ __forceinline__ int perm32(int rho) { const int n = rho >> 4, i = rho & 15; return 8 * (i >> 2) + 4 * n + (i & 3); }
struct Unit { int pm, pn, e, b, cnt, base; };
__device__ __forceinline__ unsigned cvt_pk_bf16(float lo, float hi) { unsigned r; asm volatile("v_cvt_pk_bf16_f32 %0, %1, %2" : "=v"(r) : "v"(lo), "v"(hi)); return r; }

template <class Epi, class Sched, bool ALIGN_EPI, bool F8 = false>
__device__ __forceinline__ void gemm_phase(const int wv, GP_LAS unsigned char* lds, const char* Abase, const int K, const Sched& S, const Epi& E) {
    const int wid = wv, wr = wid >> 2, wc = wid & 3;
    const int nt = K / BK;
    unsigned voffB[2];
#pragma unroll
    for (int i = 0; i < 2; ++i) { int R, C; stage_rc(otid_w(wv) * 16 + i * 8192, R, C); const int Rb = (R & ~31) + perm32(R & 31); voffB[i] = (unsigned)(Rb * K + C) * 2u; }
#define GP_AOFFS(u, o00, o01, o10, o11) do { int R0, C0, R1, C1; const int t_ = otid_w(wv); stage_rc(t_ * 16, R0, C0); stage_rc(t_ * 16 + 8192, R1, C1); \
        o00 = S.arow(u, R0) + (unsigned)C0 * 2u; o01 = S.arow(u, R1) + (unsigned)C1 * 2u; o10 = S.arow(u, HALF + R0) + (unsigned)C0 * 2u; o11 = S.arow(u, HALF + R1) + (unsigned)C1 * 2u; } while (0)
    const size_t kstep = (size_t)(BK * 2);
    const size_t hstep = (size_t)HALF * K * 2;
    const unsigned ldsw = (unsigned)wid * 1024u;
    int aoff, boff; { const int l_ = lane_id(), fr = l_ & 15, fq = l_ >> 4; aoff = lds_byte(wr * 64 + fr, fq * 8); boff = lds_byte(wc * 32 + fr, fq * 8); }
#define GP_SA(b, h) (((b) * 2 + (h)) * HTB)
#define GP_SB(b, h) ((4 + (b) * 2 + (h)) * HTB)
#define GP_STAGE_B(bufoff, gbase) do { _Pragma("unroll") for (int _i = 0; _i < 2; ++_i) \
        __builtin_amdgcn_global_load_lds((const unsigned*)((const char*)(gbase) + voffB[_i]), (GP_LAS unsigned*)(lds + (bufoff) + ldsw + _i * 8192), 16, 0, 0); } while (0)
#define GP_STAGE_A(bufoff, gbase, o0, o1) do { \
        __builtin_amdgcn_global_load_lds((const unsigned*)((const char*)(gbase) + (o0)), (GP_LAS unsigned*)(lds + (bufoff) + ldsw), 16, 0, 0); \
        __builtin_amdgcn_global_load_lds((const unsigned*)((const char*)(gbase) + (o1)), (GP_LAS unsigned*)(lds + (bufoff) + ldsw + 8192), 16, 0, 0); } while (0)
#define GP_LDA(dst, b, h) do { _Pragma("unroll") for (int m = 0; m < 4; ++m) _Pragma("unroll") for (int k = 0; k < 2; ++k) dst[m][k] = *(const GP_LAS bf16x8*)(lds + GP_SA(b, h) + aoff + m * 2048 + k * 1024); } while (0)
#define GP_LDB(dst, b, h) do { _Pragma("unroll") for (int n = 0; n < 2; ++n) _Pragma("unroll") for (int k = 0; k < 2; ++k) dst[n][k] = *(const GP_LAS bf16x8*)(lds + GP_SB(b, h) + boff + n * 2048 + k * 1024); } while (0)
#define GP_CAT8(x) __builtin_shufflevector(__builtin_bit_cast(i32x4, x[0]), __builtin_bit_cast(i32x4, x[1]), 0, 1, 2, 3, 4, 5, 6, 7)
#define GP_MMA(ai, bj, At, Bt) do { __builtin_amdgcn_s_setprio(1); _Pragma("unroll") for (int m = 0; m < 4; ++m) _Pragma("unroll") for (int n = 0; n < 2; ++n) { \
        if constexpr (F8) acc[ai][bj][m][n] = __builtin_amdgcn_mfma_scale_f32_16x16x128_f8f6f4(GP_CAT8(Bt[n]), GP_CAT8(At[m]), acc[ai][bj][m][n], 0, 0, 0, 0, 0, 0); \
        else { _Pragma("unroll") for (int k = 0; k < 2; ++k) acc[ai][bj][m][n] = __builtin_amdgcn_mfma_f32_16x16x32_bf16(Bt[n][k], At[m][k], acc[ai][bj][m][n], 0, 0, 0); } } \
        __builtin_amdgcn_s_setprio(0); } while (0)
#define GP_WAIT_V(n) asm volatile("s_waitcnt vmcnt(" #n ")" ::: "memory")
#define GP_WAIT_L(n) asm volatile("s_waitcnt lgkmcnt(" #n ")" ::: "memory")
#define GP_BAR __builtin_amdgcn_s_barrier()
#define GP_SCHED __builtin_amdgcn_sched_barrier(0)
    Unit cur, nxt; int ui = 0;
    if (!S.next(0, cur)) return;
    f32x4 acc[2][2][4][2];
#pragma unroll
    for (int a = 0; a < 2; ++a)
#pragma unroll
        for (int b = 0; b < 2; ++b)
#pragma unroll
            for (int m = 0; m < 4; ++m)
#pragma unroll
                for (int n = 0; n < 2; ++n) acc[a][b][m][n] = (f32x4){0.f, 0.f, 0.f, 0.f};
    bf16x8 At[4][2], B0[2][2], B1[2][2];
    unsigned ac00, ac01, ac10, ac11, an00, an01, an10, an11;
    GP_AOFFS(cur, ac00, ac01, ac10, ac11);
    const char* cB = S.bptr(cur);
    GP_STAGE_B(GP_SB(0, 0), cB); GP_STAGE_B(GP_SB(0, 1), cB + hstep); GP_STAGE_A(GP_SA(0, 0), Abase, ac00, ac01); GP_STAGE_A(GP_SA(0, 1), Abase, ac10, ac11);
    if (wr == 1) GP_BAR;
    GP_WAIT_V(2); GP_BAR;
    GP_STAGE_B(GP_SB(1, 0), cB + kstep); GP_STAGE_A(GP_SA(1, 0), Abase + kstep, ac00, ac01); GP_STAGE_B(GP_SB(1, 1), cB + hstep + kstep);
    GP_WAIT_V(6); GP_BAR;
    for (;;) {
        const bool has_next = S.next(ui + 1, nxt);
        if (has_next) { GP_AOFFS(nxt, an00, an01, an10, an11); }
        else { an00 = ac00; an01 = ac01; an10 = ac10; an11 = ac11; }
        const char* nB = has_next ? S.bptr(nxt) : cB;
#pragma unroll 1
        for (int t = 0; t < nt; t += 2) {
            const bool last = (t == nt - 2);
            const char* a1 = Abase + (size_t)(t + 1) * kstep;
            const char* a2 = last ? Abase : Abase + (size_t)(t + 2) * kstep; const char* b2 = last ? nB : cB + (size_t)(t + 2) * kstep;
            const char* a3 = a2 + kstep; const char* b3 = b2 + kstep;
            asm volatile("" : "+s"(a1), "+s"(a2), "+s"(b2), "+s"(a3), "+s"(b3));
            GP_LDB(B0, 0, 0); GP_LDB(B1, 0, 1); GP_SCHED; GP_LDA(At, 0, 0); GP_STAGE_A(GP_SA(1, 1), a1, ac10, ac11);
            if (last) { ac00 = an00; ac01 = an01; ac10 = an10; ac11 = an11; }
            GP_WAIT_V(8); GP_WAIT_L(0); GP_BAR; GP_MMA(0, 0, At, B0); GP_MMA(0, 1, At, B1); GP_BAR; GP_SCHED;
            GP_LDA(At, 0, 1); GP_STAGE_B(GP_SB(0, 0), b2); GP_STAGE_B(GP_SB(0, 1), b2 + hstep); GP_STAGE_A(GP_SA(0, 0), a2, ac00, ac01);
            GP_WAIT_V(8); GP_WAIT_L(0); GP_BAR; GP_MMA(1, 0, At, B0); GP_MMA(1, 1, At, B1); GP_BAR; GP_SCHED;
            GP_LDB(B0, 1, 0); GP_LDB(B1, 1, 1); GP_SCHED; GP_LDA(At, 1, 0); GP_STAGE_A(GP_SA(0, 1), a2, ac10, ac11);
            GP_WAIT_V(8); GP_WAIT_L(0); GP_BAR; GP_MMA(0, 0, At, B0); GP_MMA(0, 1, At, B1); GP_BAR; GP_SCHED;
            GP_LDA(At, 1, 1); GP_STAGE_B(GP_SB(1, 0), b3); GP_STAGE_B(GP_SB(1, 1), b3 + hstep); GP_STAGE_A(GP_SA(1, 0), a3, ac00, ac01);
            GP_WAIT_V(8); GP_WAIT_L(0); GP_BAR; GP_MMA(1, 0, At, B0); GP_MMA(1, 1, At, B1); GP_BAR; GP_SCHED;
        }
        if constexpr (ALIGN_EPI) { if (wr == 0) GP_BAR; }
        { const int l_ = lane_id(); E(acc, cur, wr, wc, l_ & 15, l_ >> 4); }
        if (!has_next) break;
#pragma unroll
        for (int a = 0; a < 2; ++a)
#pragma unroll
            for (int b = 0; b < 2; ++b)
#pragma unroll
                for (int m = 0; m < 4; ++m)
#pragma unroll
                    for (int n = 0; n < 2; ++n) acc[a][b][m][n] = (f32x4){0.f, 0.f, 0.f, 0.f};
        cur = nxt; cB = nB; ++ui;
        if constexpr (ALIGN_EPI) { if (wr == 1) GP_BAR; }
    }
    GP_WAIT_V(0);
    if constexpr (!ALIGN_EPI) { if (wr == 0) GP_BAR; }
    GP_BAR;
#undef GP_AOFFS
#undef GP_SA
#undef GP_SB
#undef GP_STAGE_A
#undef GP_STAGE_B
#undef GP_LDA
#undef GP_LDB
#undef GP_MMA
#undef GP_CAT8
#undef GP_WAIT_V
#undef GP_WAIT_L
#undef GP_BAR
#undef GP_SCHED
}

struct DenseSched {
    int nM, nN, nwg, G, c, K; const char* Bt;
    __device__ __forceinline__ void init(int M, int N, int K_, const void* Bt_, int G_, int c_) { nM = M / BM; nN = N / BM; nwg = nM * nN; G = G_; c = c_; K = K_; Bt = (const char*)Bt_; }
    __device__ __forceinline__ bool next(int i, Unit& u) const {
        const long L = (long)i * G + c; if (L >= nwg) return false;
        int wgid = (int)L; { const int q = nwg / 8, r = nwg % 8, xcd = wgid % 8, off = wgid / 8; wgid = (xcd < r ? xcd * (q + 1) : r * (q + 1) + (xcd - r) * q) + off; }
        const int nig = 8 * nN, gid = wgid / nig, fm = gid * 8, gsz = (nM - fm) < 8 ? (nM - fm) : 8;
        u.pm = fm + ((wgid % nig) % gsz); u.pn = (wgid % nig) / gsz; u.e = 0; u.b = 0; u.cnt = 0; u.base = 0; return true;
    }
    __device__ __forceinline__ unsigned arow(const Unit& u, int r) const { return (unsigned)(u.pm * BM + r) * (unsigned)(K * 2); }
    __device__ __forceinline__ const char* bptr(const Unit& u) const { return Bt + (size_t)u.pn * BM * K * 2; }
};
}

struct EpiInProj {
    bf16_t* F; bf16_t* Q; bf16_t* Kb; bf16_t* Vb; const float* rope;
    __device__ __forceinline__ void operator()(const f32x4 (&acc)[2][2][4][2], const gp::Unit& u, int wr, int wc, int fr, int fq) const {
        const int pn = u.pn, pm = u.pm; const bool isctx = pm >= T / 256;
        if (isctx && pn < 4) return;
        if (pn >= 7) {
            unsigned char* V8 = (unsigned char*)Vb;
#pragma unroll
            for (int ai = 0; ai < 2; ++ai) {
                const int row0 = pm * 256 + ai * 128 + wr * 64;
                int b, tile;
                if (!isctx) { b = row0 >> 13; tile = (CTX >> 6) + ((row0 & 8191) >> 6); } else { const int j = row0 - T; b = j >> 8; tile = (j & 255) >> 6; }
#pragma unroll
                for (int bj = 0; bj < 2; ++bj) {
                    const int head = (pn - 7) * 2 + bj;
                    unsigned char* dst = V8 + ((size_t)(b * NH + head) * (KVLEN / 64) + tile) * 8192 + wc * 2048 + fq * 64 + (fr >> 3) * 32 + (fr & 1) * 16 + ((fr >> 1) & 3) * 4;
#pragma unroll
                    for (int e = 0; e < 8; ++e) {
                        int w = __builtin_amdgcn_cvt_pk_fp8_f32(acc[ai][bj][0][e >> 2][e & 3], acc[ai][bj][1][e >> 2][e & 3], 0, false);
                        w = __builtin_amdgcn_cvt_pk_fp8_f32(acc[ai][bj][2][e >> 2][e & 3], acc[ai][bj][3][e >> 2][e & 3], w, true);
                        *(int*)(dst + e * 256) = w;
                    }
                }
            }
            return;
        }
        const int axis = wc & 1; const float* ct = rope + (axis ? 4096 : 0); const float* st = rope + (axis ? 4096 + 1024 : 2048);
#pragma unroll
        for (int ai = 0; ai < 2; ++ai)
#pragma unroll
            for (int m = 0; m < 4; ++m) {
                const int row = pm * 256 + ai * 128 + wr * 64 + m * 16 + fr;
                int t, kb, tile;
                if (!isctx) { kb = row >> 13; t = row & 8191; tile = (CTX >> 6) + (t >> 6); } else { const int j = row - T; t = 0; kb = j >> 8; tile = (j & 255) >> 6; }
                const int pos = axis ? (t & 63) : (t >> 6);
#pragma unroll
                for (int bj = 0; bj < 2; ++bj) {
                    const int col0 = pn * 256 + bj * 128 + wc * 32 + fq * 8;
                    f32x4 v0 = acc[ai][bj][m][0], v1 = acc[ai][bj][m][1];
                    if (pn == 0) { gp::u32x4 w; w.x = gp::cvt_pk_bf16(v0[0], v0[1]); w.y = gp::cvt_pk_bf16(v0[2], v0[3]); w.z = gp::cvt_pk_bf16(v1[0], v1[1]); w.w = gp::cvt_pk_bf16(v1[2], v1[3]);
                        *(gp::u32x4*)(F + (size_t)row * 256 + col0) = w; continue; }
                    if (pn < 7 && !isctx) {
                        const f32x4 c0 = *(const f32x4*)(ct + pos * 16 + 8 * (fq & 1)), c1 = *(const f32x4*)(ct + pos * 16 + 8 * (fq & 1) + 4);
                        const f32x4 s0 = *(const f32x4*)(st + pos * 16 + 8 * (fq & 1)), s1 = *(const f32x4*)(st + pos * 16 + 8 * (fq & 1) + 4);
                        const float sg = (fq < 2) ? -1.f : 1.f;
#pragma unroll
                        for (int i = 0; i < 4; ++i) {
                            const auto r0 = __builtin_amdgcn_permlane32_swap(__float_as_uint(v0[i]), __float_as_uint(v0[i]), false, false);
                            const auto r1 = __builtin_amdgcn_permlane32_swap(__float_as_uint(v1[i]), __float_as_uint(v1[i]), false, false);
                            const float p0 = __uint_as_float(fq < 2 ? r0[1] : r0[0]), p1 = __uint_as_float(fq < 2 ? r1[1] : r1[0]);
                            v0[i] = v0[i] * c0[i] + sg * p0 * s0[i]; v1[i] = v1[i] * c1[i] + sg * p1 * s1[i]; }
                    }
                    v0 = v0 * SQS; v1 = v1 * SQS;
                    int w0 = __builtin_amdgcn_cvt_pk_fp8_f32(v0[0], v0[1], 0, false); w0 = __builtin_amdgcn_cvt_pk_fp8_f32(v0[2], v0[3], w0, true);
                    int w1 = __builtin_amdgcn_cvt_pk_fp8_f32(v1[0], v1[1], 0, false); w1 = __builtin_amdgcn_cvt_pk_fp8_f32(v1[2], v1[3], w1, true);
                    unsigned char* d;
                    if (pn < 4) d = (unsigned char*)Q + (size_t)row * QKW + (col0 - 256);
                    else d = (unsigned char*)Kb + ((size_t)(kb * NH + (pn - 4) * 2 + bj) * (KVLEN / 64) + tile) * 8192 + wc * 2048 + m * 512 + fr * 32 + fq * 8;
                    typedef int i32x2_t __attribute__((ext_vector_type(2)));
                    *(i32x2_t*)d = (i32x2_t){w0, w1};
                }
            }
    }
};
struct EpiStoreBf16 {
    bf16_t* O; int ldc;
    __device__ __forceinline__ void operator()(const f32x4 (&acc)[2][2][4][2], const gp::Unit& u, int wr, int wc, int fr, int fq) const {
#pragma unroll
        for (int ai = 0; ai < 2; ++ai)
#pragma unroll
            for (int m = 0; m < 4; ++m) {
                bf16_t* rowp = O + (size_t)(u.pm * 256 + ai * 128 + wr * 64 + m * 16 + fr) * ldc + u.pn * 256 + wc * 32 + fq * 8;
#pragma unroll
                for (int bj = 0; bj < 2; ++bj) { const f32x4 v0 = acc[ai][bj][m][0], v1 = acc[ai][bj][m][1];
                    gp::u32x4 w; w.x = gp::cvt_pk_bf16(v0[0], v0[1]); w.y = gp::cvt_pk_bf16(v0[2], v0[3]); w.z = gp::cvt_pk_bf16(v1[0], v1[1]); w.w = gp::cvt_pk_bf16(v1[2], v1[3]);
                    *(gp::u32x4*)(rowp + bj * 128) = w; }
            }
    }
};

__device__ __forceinline__ void ph_inproj(const Params& p, unsigned char* smem) {
    unsigned char* ws = p.ws;
    gp::DenseSched S; S.init(MTOT, INW, D, ws + WS_WINT, gridDim.x, blockIdx.x);
    EpiInProj E{(bf16_t*)(ws + WS_F), (bf16_t*)(ws + WS_Q), (bf16_t*)(ws + WS_K), (bf16_t*)(ws + WS_V), (const float*)(ws + WS_ROPE)};
    gp::gemm_phase<EpiInProj, gp::DenseSched, true>(p.chunk, (GP_LAS unsigned char*)smem, (const char*)(ws + WS_HX), D, S, E);
}
__device__ __forceinline__ void ph_outproj(const Params& p, unsigned char* smem) {
    unsigned char* ws = p.ws;
    gp::DenseSched S; S.init(T, D, D, ws + WS_WOUTT, gridDim.x, blockIdx.x);
    EpiStoreBf16 E{(bf16_t*)(ws + WS_YX), D};
    gp::gemm_phase<EpiStoreBf16, gp::DenseSched, true>(p.chunk, (GP_LAS unsigned char*)smem, (const char*)(ws + WS_AO), D, S, E);
}

constexpr float GUSCALE = 64.f;
constexpr float WDSCALE = 16.f, ASCALE = 4.f;
struct TItem8 { const float* W; unsigned char* WT; int K, N, row_base, k0, n0; float sc; };
__device__ __forceinline__ void titem8_load(const TItem8& t, float (&tv)[32], int lane) {
#pragma unroll
    for (int i = 0; i < 32; ++i) tv[i] = t.W[(size_t)(t.k0 + 2 * i + (lane >> 5)) * t.N + t.n0 + (lane & 31)];
}
__device__ __forceinline__ void titem8_finish(const TItem8& t, const float (&tv)[32], float* scr, int lane) {
#pragma unroll
    for (int i = 0; i < 32; ++i) scr[(2 * i + (lane >> 5)) * 33 + (lane & 31)] = tv[i] * t.sc;
    asm volatile("s_waitcnt lgkmcnt(0)" ::: "memory");
    const int c = lane & 7;
#pragma unroll
    for (int j = 0; j < 4; ++j) { const int n = (lane >> 3) + 8 * j; const float* s = scr + (8 * c) * 33 + n;
        int w0 = __builtin_amdgcn_cvt_pk_fp8_f32(s[0 * 33], s[1 * 33], 0, false); w0 = __builtin_amdgcn_cvt_pk_fp8_f32(s[2 * 33], s[3 * 33], w0, true);
        int w1 = __builtin_amdgcn_cvt_pk_fp8_f32(s[4 * 33], s[5 * 33], 0, false); w1 = __builtin_amdgcn_cvt_pk_fp8_f32(s[6 * 33], s[7 * 33], w1, true);
        uint2 o; o.x = (unsigned)w0; o.y = (unsigned)w1;
        *(uint2*)(t.WT + (size_t)(t.row_base + t.n0 + n) * t.K + t.k0 + 8 * c) = o; }
    asm volatile("s_waitcnt lgkmcnt(0)" ::: "memory");
}
__device__ __forceinline__ void transpose_item(const float* W, int K, int N, bf16_t* WT, int row_base, int kb, int nb, float* scr, int lane) {
    const int k0 = 64 * kb, n0 = 32 * nb;
    float tv[32];
#pragma unroll
    for (int i = 0; i < 32; ++i) tv[i] = W[(size_t)(k0 + 2 * i + (lane >> 5)) * N + n0 + (lane & 31)];
#pragma unroll
    for (int i = 0; i < 32; ++i) scr[(2 * i + (lane >> 5)) * 33 + (lane & 31)] = tv[i];
    asm volatile("s_waitcnt lgkmcnt(0)" ::: "memory");
    const int c = lane & 7;
#pragma unroll
    for (int j = 0; j < 4; ++j) { const int n = (lane >> 3) + 8 * j; const float* s = scr + (8 * c) * 33 + n;
        uint4 o; o.x = pk2(s[0 * 33], s[1 * 33]); o.y = pk2(s[2 * 33], s[3 * 33]); o.z = pk2(s[4 * 33], s[5 * 33]); o.w = pk2(s[6 * 33], s[7 * 33]);
        *(uint4*)(WT + (size_t)(row_base + n0 + n) * K + k0 + 8 * c) = o; }
    asm volatile("s_waitcnt lgkmcnt(0)" ::: "memory");
}
__device__ __forceinline__ void ph_prep_weights(const Params& p, float* lds, const int part, const int first) {
    const int tid = otid(), wave = tid >> 6, lane = tid & 63;
    float* scr = lds + 8192 + wave * (64 * 33);
    if ((int)blockIdx.x < first) return;
    const int gw = ((int)blockIdx.x - first) * NWV + wave, GW = ((int)gridDim.x - first) * NWV;
    unsigned char* ws = p.ws;
    constexpr int I_IN = 16 * 80, I_OUT = 16 * 32, I_GU = 16 * 8, I_D = 4 * 32;
    constexpr int NITEMS = I_IN + I_OUT + 65 * (2 * I_GU + I_D);
    const int it_lo = part ? I_IN + I_OUT : 0, it_hi = part ? NITEMS : I_IN + I_OUT;
    if (part == 0) {
        for (int it = it_lo + gw; it < it_hi; it += GW) {
            int r = it;
            if (r < I_IN) { transpose_item(p.in[I_WIN], D, INW, (bf16_t*)(ws + WS_WINT), 0, r / 80, r % 80, scr, lane); continue; } r -= I_IN;
            transpose_item(p.in[I_WOUT], D, D, (bf16_t*)(ws + WS_WOUTT), 0, r / 32, r % 32, scr, lane);
        }
        return;
    }
    auto decode = [&](int it, TItem8& t) {
        int r = it - (I_IN + I_OUT);
        const int e = r / (2 * I_GU + I_D); r -= e * (2 * I_GU + I_D);
        if (r < 2 * I_GU) {
            const int half = r / I_GU, q = r % I_GU, kb = q / 8, nb = q % 8;
            t.W = (e < 64) ? p.in[half ? I_WU : I_WG] + (size_t)e * D * DE : p.in[half ? I_WSU : I_WSG];
            const int n0 = 32 * nb, drow = e * 512 + (n0 >> 7) * 256 + half * 128 + (n0 & 127);
            t.WT = ws + WS_WGUT; t.K = D; t.N = DE; t.row_base = drow - n0; t.k0 = 64 * kb; t.n0 = n0; t.sc = GUSCALE;
        } else {
            r -= 2 * I_GU;
            t.W = (e < 64) ? p.in[I_WD] + (size_t)e * DE * D : p.in[I_WSD];
            t.WT = ws + WS_WDT; t.K = DE; t.N = D; t.row_base = e * 1024; t.k0 = 64 * (r / 32); t.n0 = 32 * (r % 32); t.sc = WDSCALE;
        }
    };
    int it = it_lo + gw;
    if (it >= it_hi) return;
    TItem8 ta, tb; float va[32], vb[32];
    decode(it, ta); titem8_load(ta, va, lane);
    for (;;) {
        const bool hb = it + GW < it_hi;
        if (hb) { decode(it + GW, tb); titem8_load(tb, vb, lane); }
        titem8_finish(ta, va, scr, lane);
        if (!hb) break;
        const bool ha = it + 2 * GW < it_hi;
        if (ha) { decode(it + 2 * GW, ta); titem8_load(ta, va, lane); }
        titem8_finish(tb, vb, scr, lane);
        if (!ha) break;
        it += 2 * GW;
    }
}

namespace fa {
typedef short bf16x8 __attribute__((ext_vector_type(8)));
typedef short s16x4 __attribute__((ext_vector_type(4)));
typedef float f32x16 __attribute__((ext_vector_type(16)));
typedef unsigned u32x4 __attribute__((ext_vector_type(4)));
constexpr int KVBLK = 64, LDK = QKW;
constexpr float SCALE = 0.125f, THR = 8.f;
constexpr size_t SHM_V = KVBLK * 128 * 2, SHM_K = KVBLK * 128 * 2;
#define KSWZ(row, colB) ((row) * 256 + ((colB) ^ (((row) & 15) << 4)))
#define SBAR() __builtin_amdgcn_sched_barrier(0)
__device__ __forceinline__ int crow(int r, int hi) { return (r & 3) + 8 * (r >> 2) + 4 * hi; }
__device__ __forceinline__ unsigned cvtpk(float lo, float hi) { unsigned r; asm volatile("v_cvt_pk_bf16_f32 %0, %1, %2" : "=v"(r) : "v"(lo), "v"(hi)); return r; }
constexpr float PBIAS = 5.f, THR2 = PBIAS + 3.5f;
template <bool FIRST>
__device__ __forceinline__ void partialSM(f32x16& p0, f32x16& p1, float& m_reg, f32x16& negm, float& alpha) {
  float pmax = p0[0];
#pragma unroll
  for (int r = 1; r < 16; ++r) pmax = fmaxf(pmax, p0[r]);
#pragma unroll
  for (int r = 0; r < 16; ++r) pmax = fmaxf(pmax, p1[r]);
  { auto rr = __builtin_amdgcn_permlane32_swap(__float_as_uint(pmax), __float_as_uint(pmax), false, false);
    pmax = fmaxf(__uint_as_float(rr[0]), __uint_as_float(rr[1])); }
  if (!FIRST && __builtin_expect(__all(pmax <= THR2), 1)) { alpha = 1.f; }
  else { const float dl = FIRST ? pmax - PBIAS : fmaxf(pmax - PBIAS, 0.f); alpha = FIRST ? 0.f : __builtin_amdgcn_exp2f(-dl); m_reg += dl;
#pragma unroll
    for (int r = 0; r < 16; ++r) { p0[r] -= dl; p1[r] -= dl; }
#pragma unroll
    for (int r = 0; r < 16; ++r) negm[r] = -m_reg;
    asm volatile("" : "+v"(negm)); }
#pragma unroll
  for (int r = 0; r < 16; ++r) p0[r] = __builtin_amdgcn_exp2f(p0[r]);
}
typedef int i32x8 __attribute__((ext_vector_type(8)));
__device__ __forceinline__ int pk4_fp8(float a, float b, float c, float d) { int w; asm("v_cvt_pk_fp8_f32 %0, %1, %2" : "=v"(w) : "v"(a), "v"(b)); asm("v_cvt_pk_fp8_f32 %0, %1, %2 op_sel:[0,0,1]" : "+v"(w) : "v"(c), "v"(d)); return w; }
__device__ __forceinline__ void finishSM_T(f32x16& p0, f32x16& p1, i32x8& pb) {
#pragma unroll
  for (int r = 0; r < 16; ++r) p1[r] = __builtin_amdgcn_exp2f(p1[r]);
#pragma unroll
  for (int g = 0; g < 4; ++g) {
    pb[g] = pk4_fp8(p0[4 * g], p0[4 * g + 1], p0[4 * g + 2], p0[4 * g + 3]); pb[4 + g] = pk4_fp8(p1[4 * g], p1[4 * g + 1], p1[4 * g + 2], p1[4 * g + 3]); }
}
__device__ __forceinline__ void qkt(f32x16& p0, f32x16& p1, const char* Ks, const i32x8 qf, int lane, int mm, const f32x16& negm) {
  const char* kp = Ks + mm * 4096 + lane * 16;
  const u32x4 a0 = *reinterpret_cast<const u32x4*>(kp), a1 = *reinterpret_cast<const u32x4*>(kp + 1024), b0 = *reinterpret_cast<const u32x4*>(kp + 2048), b1 = *reinterpret_cast<const u32x4*>(kp + 3072);
  p0 = __builtin_amdgcn_mfma_scale_f32_32x32x64_f8f6f4((i32x8){(int)a0.x, (int)a0.y, (int)a0.z, (int)a0.w, (int)a1.x, (int)a1.y, (int)a1.z, (int)a1.w}, qf, negm, 0, 0, 0, 0, 0, 0);
  p1 = __builtin_amdgcn_mfma_scale_f32_32x32x64_f8f6f4((i32x8){(int)b0.x, (int)b0.y, (int)b0.z, (int)b0.w, (int)b1.x, (int)b1.y, (int)b1.z, (int)b1.w}, qf, negm, 0, 0, 0, 0, 0, 0);
}
__device__ __forceinline__ int v_st(int k, int c) { const int kk = (k & ~0xC) | ((k & 4) << 1) | ((k & 8) >> 1); return ((kk >> 3) * 4 + (c >> 5)) * 512 + ((kk & 7) * 32 + (c & 31)) * 2; }
__device__ __forceinline__ int v_rd_base(int lane) { return ((lane & 3) << 3) | (((lane >> 2) & 3) << 6) | (((lane >> 4) & 1) << 5) | (((lane >> 5) & 1) << 8); }
constexpr int v_rd_off(int d0, int ks, int half) { return d0 * 512 + ks * 4096 + half * 2048; }
template <int OFF> __device__ __forceinline__ s16x4 tr_read(int vb) {
  s16x4 r; asm volatile("ds_read_b64_tr_b16 %0, %1 offset:%2" : "=&v"(r) : "v"(vb), "i"(OFF) : "memory"); return r;
}
template <int D0> __device__ __forceinline__ void pv_one(f32x16& od, int vb, bf16x8 pa0, bf16x8 pa1, bf16x8 pa2, bf16x8 pa3) {
  const s16x4 l0 = tr_read<v_rd_off(D0, 0, 0)>(vb), h0 = tr_read<v_rd_off(D0, 0, 1)>(vb), l1 = tr_read<v_rd_off(D0, 1, 0)>(vb), h1 = tr_read<v_rd_off(D0, 1, 1)>(vb);
  const s16x4 l2 = tr_read<v_rd_off(D0, 2, 0)>(vb), h2 = tr_read<v_rd_off(D0, 2, 1)>(vb), l3 = tr_read<v_rd_off(D0, 3, 0)>(vb), h3 = tr_read<v_rd_off(D0, 3, 1)>(vb);
  asm volatile("s_waitcnt lgkmcnt(0)" ::: "memory"); SBAR();
#define PK(L, H) (bf16x8){L[0], L[1], L[2], L[3], H[0], H[1], H[2], H[3]}
  od = __builtin_amdgcn_mfma_f32_32x32x16_bf16(pa0, PK(l0, h0), od, 0, 0, 0);
  od = __builtin_amdgcn_mfma_f32_32x32x16_bf16(pa1, PK(l1, h1), od, 0, 0, 0);
  od = __builtin_amdgcn_mfma_f32_32x32x16_bf16(pa2, PK(l2, h2), od, 0, 0, 0);
  od = __builtin_amdgcn_mfma_f32_32x32x16_bf16(pa3, PK(l3, h3), od, 0, 0, 0);
#undef PK
}
__device__ __forceinline__ void pv_d0(f32x16* o, int vb, bf16x8 pa0, bf16x8 pa1, bf16x8 pa2, bf16x8 pa3) {
  pv_one<0>(o[0], vb, pa0, pa1, pa2, pa3); pv_one<1>(o[1], vb, pa0, pa1, pa2, pa3); pv_one<2>(o[2], vb, pa0, pa1, pa2, pa3); pv_one<3>(o[3], vb, pa0, pa1, pa2, pa3);
}

template <int OFF> __device__ __forceinline__ u32x4 rd128(int vb) { u32x4 r; asm volatile("ds_read_b128 %0, %1 offset:%2" : "=&v"(r) : "v"(vb), "i"(OFF) : "memory"); return r; }
#define PV_RD(D0) const u32x4 va##D0 = rd128<D0 * 2048>(vb), vc##D0 = rd128<D0 * 2048 + 1024>(vb); SBAR()
#define PV_MM(D0) do { asm volatile("s_waitcnt lgkmcnt(0)" ::: "memory"); SBAR(); \
    o[D0] = __builtin_amdgcn_mfma_scale_f32_32x32x64_f8f6f4((i32x8){(int)va##D0.x, (int)va##D0.y, (int)va##D0.z, (int)va##D0.w, (int)vc##D0.x, (int)vc##D0.y, (int)vc##D0.z, (int)vc##D0.w}, pb, o[D0], 0, 0, 0, 0, 0, 0); } while (0)
__device__ __forceinline__ float max3f(float a, float b, float c) { float r; asm("v_max3_f32 %0, %1, %2, %3" : "=v"(r) : "v"(a), "v"(b), "v"(c)); return r; }
#define PV_LSUM() lacc = __builtin_amdgcn_mfma_scale_f32_32x32x64_f8f6f4((i32x8){0x38383838, 0x38383838, 0x38383838, 0x38383838, 0x38383838, 0x38383838, 0x38383838, 0x38383838}, pb, lacc, 0, 0, 0, 0, 0, 0)
__device__ __forceinline__ void pv_psm(f32x16* o, f32x16& lacc, int vb, i32x8 pb, f32x16& p0, f32x16& p1, float& m_reg, f32x16& negm, float& alpha) {
  float pmax;
  { PV_RD(0);
    pmax = max3f(p0[0], p0[1], p0[2]);
#pragma unroll
    for (int r = 3; r < 15; r += 2) pmax = max3f(pmax, p0[r], p0[r + 1]);
    pmax = max3f(pmax, p0[15], p1[0]);
    SBAR(); PV_MM(0); }
  { PV_RD(1);
#pragma unroll
    for (int r = 1; r < 15; r += 2) pmax = max3f(pmax, p1[r], p1[r + 1]);
    pmax = max3f(pmax, p1[15], p1[15]);
    { auto rr = __builtin_amdgcn_permlane32_swap(__float_as_uint(pmax), __float_as_uint(pmax), false, false);
      pmax = max3f(__uint_as_float(rr[0]), __uint_as_float(rr[1]), __uint_as_float(rr[1])); }
    if (__builtin_expect(__all(pmax <= THR2), 1)) { alpha = 1.f; }
    else { const float dl = fmaxf(pmax - PBIAS, 0.f); alpha = __builtin_amdgcn_exp2f(-dl); m_reg += dl;
#pragma unroll
      for (int r = 0; r < 16; ++r) { p0[r] -= dl; p1[r] -= dl; }
#pragma unroll
      for (int r = 0; r < 16; ++r) negm[r] = -m_reg;
      asm volatile("" : "+v"(negm)); }
    SBAR(); PV_MM(1); }
  { PV_RD(2);
#pragma unroll
    for (int r = 0; r < 8; ++r) p0[r] = __builtin_amdgcn_exp2f(p0[r]);
    asm volatile("" : "+v"(p0));
    SBAR(); PV_MM(2); }
  { PV_RD(3);
#pragma unroll
    for (int r = 8; r < 16; ++r) p0[r] = __builtin_amdgcn_exp2f(p0[r]);
    asm volatile("" : "+v"(p0));
    SBAR(); PV_MM(3); PV_LSUM(); }
}
__device__ __forceinline__ void pvT_d0(f32x16* o, f32x16& lacc, int vb, i32x8 pb) {
  { PV_RD(0); PV_MM(0); } { PV_RD(1); PV_MM(1); } { PV_RD(2); PV_MM(2); } { PV_RD(3); PV_MM(3); PV_LSUM(); }
}
#undef PV_RD
#undef PV_MM
#undef PV_LSUM

__device__ __forceinline__ void attn_unit(const unsigned char* __restrict__ Qb, const unsigned char* __restrict__ Kh, const unsigned char* __restrict__ Vh, bf16_t* __restrict__ Ob,
                                          const float* __restrict__ gsub, const float lam, char* lds, const int wv) {
  typedef __attribute__((address_space(3))) unsigned* ldsu_t;
  const int tid = otid_w(wv), wid = wv, lane = tid & 63, r32 = lane & 31, hi = lane >> 5, mm = wid >> 2, wq = wid & 3;
  constexpr int NB = 4;
  constexpr int SHM_V8 = KVBLK * 128;
  char* V_lds = lds; char* K_lds = lds + NB * SHM_V8; constexpr int SHM_K8 = KVBLK * 128;
  float m_reg = 0.f; f32x16 o[4] = {}; f32x16 lacc = {}; i32x8 qf; f32x16 negm = {}; asm volatile("" : "+v"(negm));
  const unsigned koff = (unsigned)((2 * (wid >> 2) + (lane >> 5)) * 2048 + (lane & 3) * 512 + (8 * ((wid >> 1) & 1) + 2 * ((lane & 31) >> 3) + ((lane >> 2) & 1)) * 32 + (wid & 1) * 16);
  const unsigned voff = (unsigned)((wid >> 1) * 2048 + (lane & 7) * 256 + ((lane >> 3) & 3) * 64 + (wid & 1) * 32 + (lane >> 5) * 16);
#define DMA(t, buf) do { const char* kb_ = (const char*)(Kh + (size_t)(t) * SHM_K8); const char* vb_ = (const char*)(Vh + (size_t)(t) * SHM_V8); asm volatile("" : "+s"(kb_), "+s"(vb_)); \
    __builtin_amdgcn_global_load_lds((const unsigned*)(kb_ + koff), (ldsu_t)(K_lds + (buf) * SHM_K8 + wid * 1024), 16, 0, 0); \
    __builtin_amdgcn_global_load_lds((const unsigned*)(vb_ + voff), (ldsu_t)(V_lds + (buf) * SHM_V8 + wid * 1024), 16, 0, 0); } while (0)
#define WAIT_BAR(N) asm volatile("s_waitcnt vmcnt(" #N ") lgkmcnt(0)\n\ts_barrier" ::: "memory")
#define RESC(a) do { if (__any((a) < 1.f)) { _Pragma("unroll") for (int d = 0; d < 4; ++d) _Pragma("unroll") for (int r = 0; r < 16; ++r) o[d][r] *= (a); lacc[0] *= (a); } } while (0)
  DMA(0, 0); DMA(1, 1);
  { const unsigned char* Qw = Qb + (long)(wq * 32 + r32) * QKW + mm * 64 + hi * 32;
    const u32x4 q0 = *reinterpret_cast<const u32x4*>(Qw), q1 = *reinterpret_cast<const u32x4*>(Qw + 16);
    qf = (i32x8){(int)q0.x, (int)q0.y, (int)q0.z, (int)q0.w, (int)q1.x, (int)q1.y, (int)q1.z, (int)q1.w}; }
  const int vb0 = (int)(uintptr_t)V_lds + lane * 16;
  f32x16 pA0, pA1, pB0, pB1; float alA, alB; i32x8 pb; constexpr int NTL = KVLEN / KVBLK;
  WAIT_BAR(0);
  DMA(2, 2);
  qkt(pA0, pA1, K_lds, qf, lane, mm, negm); partialSM<true>(pA0, pA1, m_reg, negm, alA);
  WAIT_BAR(2);
  for (int j = 1; j + 1 < NTL; j += 2) {
    DMA(j + 2, (j + 2) & 3);
    SBAR(); qkt(pB0, pB1, K_lds + (j & 3) * SHM_K8, qf, lane, mm, negm);
    finishSM_T(pA0, pA1, pb); SBAR();
    pv_psm(o, lacc, vb0 + ((j - 1) & 3) * SHM_V8, pb, pB0, pB1, m_reg, negm, alB);
    RESC(alB);
    WAIT_BAR(2);
    if (j + 3 < NTL) DMA(j + 3, (j + 3) & 3);
    SBAR(); qkt(pA0, pA1, K_lds + ((j + 1) & 3) * SHM_K8, qf, lane, mm, negm);
    finishSM_T(pB0, pB1, pb); SBAR();
    pv_psm(o, lacc, vb0 + (j & 3) * SHM_V8, pb, pA0, pA1, m_reg, negm, alA);
    RESC(alA);
    if (j + 3 < NTL) WAIT_BAR(2); else WAIT_BAR(0);
  }
  SBAR(); qkt(pB0, pB1, K_lds + ((NTL - 1) & 3) * SHM_K8, qf, lane, mm, negm);
  finishSM_T(pA0, pA1, pb); SBAR();
  pv_psm(o, lacc, vb0 + ((NTL - 2) & 3) * SHM_V8, pb, pB0, pB1, m_reg, negm, alB);
  RESC(alB);
  finishSM_T(pB0, pB1, pb); SBAR();
  pvT_d0(o, lacc, vb0 + ((NTL - 1) & 3) * SHM_V8, pb);
#undef DMA
#undef WAIT_BAR
  const float rl = __builtin_amdgcn_rcpf(lacc[0]) * (mm ? lam : 1.0f);
  __syncthreads();
  constexpr int XS = 132;
  float* X = (float*)lds;
  if (mm == 1) {
#pragma unroll
    for (int r = 0; r < 16; ++r)
#pragma unroll
      for (int d0 = 0; d0 < 4; ++d0) X[(wq * 32 + r32) * XS + d0 * 32 + crow(r, hi)] = o[d0][r] * rl;
  }
  __syncthreads();
  if (mm == 0) {
#pragma unroll
    for (int r = 0; r < 16; ++r)
#pragma unroll
      for (int d0 = 0; d0 < 4; ++d0) { float* xp = X + (wq * 32 + r32) * XS + d0 * 32 + crow(r, hi); *xp = o[d0][r] * rl - *xp; }
  }
  __syncthreads();
  {
    const int row = tid >> 2, seg = tid & 3;
    const float* xr = X + row * XS + seg * 32;
    f32x4 v[8]; float ss = 0.f;
#pragma unroll
    for (int i = 0; i < 8; ++i) { v[i] = *(const f32x4*)(xr + 4 * i); ss += v[i][0] * v[i][0] + v[i][1] * v[i][1] + v[i][2] * v[i][2] + v[i][3] * v[i][3]; }
    ss += sx<1>(ss); ss += sx<2>(ss);
    const float rs = (1.0f - LAM_INIT) / sqrtf(ss * (1.0f / 128.0f) + EPS);
    bf16_t* dst = Ob + (long)row * D + seg * 32;
#pragma unroll
    for (int i = 0; i < 8; i += 2) {
      const f32x4 g0 = *(const f32x4*)(gsub + seg * 32 + 4 * i), g1 = *(const f32x4*)(gsub + seg * 32 + 4 * i + 4);
      u32x4 w; w.x = cvtpk(v[i][0] * rs * g0[0], v[i][1] * rs * g0[1]); w.y = cvtpk(v[i][2] * rs * g0[2], v[i][3] * rs * g0[3]);
      w.z = cvtpk(v[i + 1][0] * rs * g1[0], v[i + 1][1] * rs * g1[1]); w.w = cvtpk(v[i + 1][2] * rs * g1[2], v[i + 1][3] * rs * g1[3]);
      *(u32x4*)(dst + 4 * i) = w;
    }
  }
  __syncthreads();
#undef RESC
}
#undef KSWZ
#undef SBAR
}

__device__ __forceinline__ void ph_attn(const Params& p, unsigned char* smem) {
    unsigned char* ws = p.ws;
    const unsigned char* Q = ws + WS_Q; const unsigned char* Kb = ws + WS_K; const unsigned char* Vb = ws + WS_V;
    bf16_t* AO = (bf16_t*)(ws + WS_AO);
    const float lam = ((const float*)(ws + WS_CTL))[1024];
    const int c = blockIdx.x, G = gridDim.x;
    if (G == 256) {
        const int x = c & 7, s = c >> 3;
        for (int rd = 0; rd < 6; ++rd) {
            const int bh = rd * 4 + (x >> 1), qb = (x & 1) * 32 + s, b = bh / NH, h = bh % NH;
            fa::attn_unit(Q + ((size_t)b * SEQ + qb * 128) * QKW + h * 128, Kb + (size_t)(b * NH + h) * (KVLEN / 64) * 8192, Vb + (size_t)(b * NH + h) * (KVLEN / 64) * 8192,
                          AO + ((size_t)b * SEQ + qb * 128) * D + 256 + h * 128, p.in[I_GSUB], lam, (char*)smem, p.chunk);
        }
    } else {
        for (int u = c; u < BATCH * NH * 64; u += G) {
            const int bh = u >> 6, qb = u & 63, b = bh / NH, h = bh % NH;
            fa::attn_unit(Q + ((size_t)b * SEQ + qb * 128) * QKW + h * 128, Kb + (size_t)(b * NH + h) * (KVLEN / 64) * 8192, Vb + (size_t)(b * NH + h) * (KVLEN / 64) * 8192,
                          AO + ((size_t)b * SEQ + qb * 128) * D + 256 + h * 128, p.in[I_GSUB], lam, (char*)smem, p.chunk);
        }
    }
}

__device__ __forceinline__ void ph_fourierA(const Params& p, unsigned char* smem) {
    using namespace fa;
    unsigned char* ws = p.ws;
    const bf16_t* F = (const bf16_t*)(ws + WS_F); bf16_t* FY = (bf16_t*)(ws + WS_FY); const bf16_t* W = (const bf16_t*)(ws + WS_W128E);
    const int tid = otid(), wid = tid >> 6, lane = tid & 63, r32 = lane & 31, hi = lane >> 5;
    const int sr = tid >> 4, sc = (tid & 15) * 8, vst0 = v_st(sr, sc), vst1 = v_st(32 + sr, sc);
    const int vb0 = (int)(uintptr_t)smem + v_rd_base(lane);
    for (int task = blockIdx.x; task < BATCH * 64; task += gridDim.x) {
        const int b = task >> 6, n2 = task & 63;
        bf16x8 st[4][2];
#pragma unroll
        for (int kt = 0; kt < 2; ++kt)
#pragma unroll
            for (int ct = 0; ct < 2; ++ct) {
                st[kt * 2 + ct][0] = *(const bf16x8*)(F + ((size_t)b * SEQ + 64 * (64 * kt + sr) + n2) * 256 + 128 * ct + sc);
                st[kt * 2 + ct][1] = *(const bf16x8*)(F + ((size_t)b * SEQ + 64 * (64 * kt + 32 + sr) + n2) * 256 + 128 * ct + sc);
            }
        bf16x8 pa[2][4];
#pragma unroll
        for (int kt = 0; kt < 2; ++kt)
#pragma unroll
            for (int ks = 0; ks < 4; ++ks) pa[kt][ks] = *(const bf16x8*)(W + (size_t)(32 * wid + r32) * 128 + 64 * kt + 16 * ks + 8 * hi);
        __syncthreads();
#pragma unroll
        for (int q = 0; q < 4; ++q) { *(bf16x8*)(smem + q * 16384 + vst0) = st[q][0]; *(bf16x8*)(smem + q * 16384 + vst1) = st[q][1]; }
        __syncthreads();
        f32x16 o[2][4] = {};
#pragma unroll
        for (int ct = 0; ct < 2; ++ct)
#pragma unroll
            for (int kt = 0; kt < 2; ++kt) pv_d0(o[ct], vb0 + (kt * 2 + ct) * 16384, pa[kt][0], pa[kt][1], pa[kt][2], pa[kt][3]);
        const int plane = wid >> 2;
#pragma unroll
        for (int r = 0; r < 16; ++r) {
            const int k1 = 32 * (wid & 3) + crow(r, hi);
            bf16_t* dst = FY + ((((size_t)plane * BATCH + b) * 128 + k1) * 64 + n2) * 256 + r32;
#pragma unroll
            for (int ct = 0; ct < 2; ++ct)
#pragma unroll
                for (int d0 = 0; d0 < 4; ++d0) dst[128 * ct + 32 * d0] = f2bf(o[ct][d0][r]);
        }
    }
    __syncthreads();
}
__device__ __forceinline__ void ph_fourierB(const Params& p, unsigned char* smem) {
    using namespace fa;
    unsigned char* ws = p.ws;
    const bf16_t* FY = (const bf16_t*)(ws + WS_FY); const float2* tabw = (const float2*)(ws + WS_TABW);
    const bf16_t* M64 = (const bf16_t*)(ws + WS_M64E); const bf16_t* GT = (const bf16_t*)(ws + WS_GT);
    bf16_t* AO = (bf16_t*)(ws + WS_AO);
    const int tid = otid(), wid = tid >> 6, lane = tid & 63, r32 = lane & 31, hi = lane >> 5;
    const int sr = tid >> 4, sc = (tid & 15) * 8, vst0 = v_st(sr, sc), vst1 = v_st(32 + sr, sc);
    const int vb0 = (int)(uintptr_t)smem + v_rd_base(lane);
    constexpr int XRS = 528;
    unsigned char* XL = smem + 65536;
    const int mt = wid & 3, ctw = wid >> 2;
    for (int task = blockIdx.x; task < BATCH * 128; task += gridDim.x) {
        const int b = task >> 7, k1 = task & 127;
        __syncthreads();
#pragma unroll
        for (int ct = 0; ct < 2; ++ct)
#pragma unroll
            for (int rh = 0; rh < 2; ++rh) {
                const int n2 = sr + 32 * rh;
                const size_t off = ((((size_t)b) * 128 + k1) * 64 + n2) * 256 + 128 * ct + sc;
                const uint4 yr = *(const uint4*)(FY + off), yi = *(const uint4*)(FY + (size_t)BATCH * 128 * 64 * 256 + off);
                const float2 tw = tabw[n2 * k1];
                const unsigned yrw[4] = {yr.x, yr.y, yr.z, yr.w}, yiw[4] = {yi.x, yi.y, yi.z, yi.w};
                unsigned zr[4], zi[4];
#pragma unroll
                for (int q = 0; q < 4; ++q) {
                    const float a0 = __uint_as_float(yrw[q] << 16), a1 = __uint_as_float(yrw[q] & 0xffff0000u), b0 = __uint_as_float(yiw[q] << 16), b1 = __uint_as_float(yiw[q] & 0xffff0000u);
                    zr[q] = pk2(a0 * tw.x + b0 * tw.y, a1 * tw.x + b1 * tw.y); zi[q] = pk2(b0 * tw.x - a0 * tw.y, b1 * tw.x - a1 * tw.y);
                }
                const int vs = rh ? vst1 : vst0;
                *(uint4*)(smem + (0 * 2 + ct) * 16384 + vs) = make_uint4(zr[0], zr[1], zr[2], zr[3]);
                *(uint4*)(smem + (1 * 2 + ct) * 16384 + vs) = make_uint4(zi[0], zi[1], zi[2], zi[3]);
            }
        __syncthreads();
        {
            f32x16 o[4] = {};
#pragma unroll
            for (int kt = 0; kt < 2; ++kt) {
                bf16x8 pa[4];
#pragma unroll
                for (int ks = 0; ks < 4; ++ks) pa[ks] = *(const bf16x8*)(M64 + (size_t)(32 * mt + r32) * 128 + 64 * kt + 16 * ks + 8 * hi);
                pv_d0(o, vb0 + (kt * 2 + ctw) * 16384, pa[0], pa[1], pa[2], pa[3]);
            }
#pragma unroll
            for (int r = 0; r < 16; ++r) {
                const int ro = 32 * mt + crow(r, hi);
                bf16_t* xr = (bf16_t*)(XL + ((ro >> 6) * 64 + (ro & 63)) * XRS) + 128 * ctw + r32;
#pragma unroll
                for (int d0 = 0; d0 < 4; ++d0) xr[32 * d0] = f2bf(o[d0][r]);
            }
        }
        __syncthreads();
#pragma unroll
        for (int tt = 0; tt < 2; ++tt) {
            const int tau = 2 * wid + tt, g = tau >> 2, mt2 = (tau >> 1) & 1, nt2 = tau & 1;
            f32x16 acc = {};
#pragma unroll
            for (int ks8 = 0; ks8 < 8; ++ks8) {
                const int part = ks8 >> 2, cb = ks8 & 3;
                const bf16x8 af = *(const bf16x8*)(XL + (part * 64 + 32 * mt2 + r32) * XRS + (g * 64 + 16 * cb + 8 * hi) * 2);
                const bf16x8 bfr = *(const bf16x8*)(GT + ((size_t)g * 64 + 32 * nt2 + r32) * 128 + part * 64 + 16 * cb + 8 * hi);
                acc = __builtin_amdgcn_mfma_f32_32x32x16_bf16(af, bfr, acc, 0, 0, 0);
            }
#pragma unroll
            for (int r = 0; r < 16; ++r) { const int k2 = 32 * mt2 + crow(r, hi);
                AO[((size_t)b * SEQ + k1 + 128 * k2) * D + g * 64 + 32 * nt2 + r32] = f2bf(acc[r]); }
        }
    }
    __syncthreads();
}

__device__ __forceinline__ void ph_mid(const Params& p, unsigned char* smem) {
    typedef short bf16x8 __attribute__((ext_vector_type(8)));
    unsigned char* ws = p.ws;
    const int tid = otid(), wave = tid >> 6, lane = tid & 63, fr = lane & 15, fq = lane >> 4;
    const float* mod = (const float*)(ws + WS_MOD);
    const bf16_t* YX = (const bf16_t*)(ws + WS_YX);
    unsigned char* H2 = ws + WS_H2;
    unsigned* counts = (unsigned*)(ws + WS_CTL);
    int* TE = (int*)(ws + WS_TE); int* TP = (int*)(ws + WS_TP); float* TW = (float*)(ws + WS_TW); int* TOKL = (int*)(ws + WS_TOKL);
    constexpr int RS = 2064;
    unsigned char* Ahi = smem; unsigned char* Alo = smem + 16 * RS; float* Pp = (float*)(smem + 2 * 16 * RS + 512);
    const float rbias = p.in[I_RB][lane];
    int* lcnt = (int*)(smem + 99328); int* gb = lcnt + 64; int* PE = gb + 64; float* PW = (float*)(PE + 1024); float* PV = PW + 1024;
    for (int chunk = blockIdx.x; chunk < T / 128; chunk += gridDim.x) {
      const int mc = chunk * 128, b = mc >> 13;
      if (tid < 64) lcnt[tid] = 0;
      {
          const float* mrow_ = mod + b * 6144;
          for (int i = tid; i < 5 * 256; i += NT) { const int v_ = i >> 8, q_ = (i & 255) * 4;
              const float* s_ = (v_ == 0) ? p.in[I_GAPOST] + q_ : (v_ == 1) ? mrow_ + 2 * 1024 + q_ : (v_ == 2) ? p.in[I_GFPRE] + q_ : (v_ == 3) ? mrow_ + 3 * 1024 + q_ : mrow_ + 4 * 1024 + q_;
              *(f32x4*)(PV + v_ * 1024 + q_) = *(const f32x4*)s_; }
          __syncthreads();
      }
      uint2 yw[2][4]; f32x4 xv[2][4];
      bf16x8 wfr[4][4];
      { const bf16_t* wrt_ = (const bf16_t*)(ws + WS_WRT) + (size_t)p.chunk * 16 * 1024; asm volatile("" : "+s"(wrt_));
#pragma unroll
        for (int ks = 0; ks < 4; ++ks) {
#pragma unroll
          for (int nb = 0; nb < 4; ++nb) wfr[ks][nb] = *(const bf16x8*)(wrt_ + (size_t)((ks * 4 + nb) * 2 * 64 + lane) * 8);
          __builtin_amdgcn_sched_barrier(0); } }
#define MID_LOAD(m0_) do { _Pragma("unroll") for (int rr = 0; rr < 2; ++rr) { const int m_ = (m0_) + 2 * wave + rr; _Pragma("unroll") for (int j = 0; j < 4; ++j) { \
          yw[rr][j] = *(const uint2*)(YX + (size_t)m_ * D + 4 * (lane + 64 * j)); xv[rr][j] = ((const f32x4*)(p.in[I_X] + (size_t)m_ * D))[lane + 64 * j]; } } } while (0)
      MID_LOAD(mc);
#pragma unroll 1
      for (int it = 0; it < 8; ++it) {
        const int m0 = mc + it * 16;
        {
            float ss[2] = {0.f, 0.f};
#define YV(rr, j, i) ((i) == 0 ? __uint_as_float(yw[rr][j].x << 16) : (i) == 1 ? __uint_as_float(yw[rr][j].x & 0xffff0000u) : (i) == 2 ? __uint_as_float(yw[rr][j].y << 16) : __uint_as_float(yw[rr][j].y & 0xffff0000u))
#pragma unroll
            for (int rr = 0; rr < 2; ++rr) {
#pragma unroll
                for (int j = 0; j < 4; ++j) ss[rr] += YV(rr, j, 0) * YV(rr, j, 0) + YV(rr, j, 1) * YV(rr, j, 1) + YV(rr, j, 2) * YV(rr, j, 2) + YV(rr, j, 3) * YV(rr, j, 3);
                ss[rr] = wave_sum(ss[rr]);
            }
#pragma unroll
            for (int rr = 0; rr < 2; ++rr) {
                const int lr = 2 * wave + rr, m = m0 + lr;
                const float r1 = 1.0f / sqrtf(ss[rr] * (1.0f / D) + EPS);
                float ss2 = 0.f;
#pragma unroll
                for (int j = 0; j < 4; ++j) {
                    const int col = 4 * (lane + 64 * j);
                    const f32x4 gp = *(const f32x4*)(PV + col), gt = *(const f32x4*)(PV + 1024 + col);
#pragma unroll
                    for (int i = 0; i < 4; ++i) { xv[rr][j][i] = xv[rr][j][i] + gt[i] * (YV(rr, j, i) * r1 * gp[i]); ss2 += xv[rr][j][i] * xv[rr][j][i]; }
                    ((f32x4*)(p.out + (size_t)m * D))[lane + 64 * j] = xv[rr][j];
                }
                ss2 = wave_sum(ss2);
                const float r2 = 1.0f / sqrtf(ss2 * (1.0f / D) + EPS);
#pragma unroll
                for (int j = 0; j < 4; ++j) {
                    const int col = 4 * (lane + 64 * j);
                    const f32x4 gp = *(const f32x4*)(PV + 2048 + col), sh = *(const f32x4*)(PV + 3072 + col), sc = *(const f32x4*)(PV + 4096 + col);
                    float h[4];
#pragma unroll
                    for (int i = 0; i < 4; ++i) h[i] = xv[rr][j][i] * r2 * gp[i] * (1.f + sc[i]) + sh[i];
                    uint2 o; o.x = pk2(h[0], h[1]); o.y = pk2(h[2], h[3]);
                    { int w8 = __builtin_amdgcn_cvt_pk_fp8_f32(h[0], h[1], 0, false); w8 = __builtin_amdgcn_cvt_pk_fp8_f32(h[2], h[3], w8, true); *(int*)(H2 + (size_t)m * D + col) = w8; }
                    *(uint2*)(Ahi + lr * RS + col * 2) = o;
                }
            }
            if (it < 7) MID_LOAD(m0 + 16);
        }
        asm volatile("s_waitcnt lgkmcnt(0)\n\ts_barrier" ::: "memory");
        {
            f32x4 acc[4];
#pragma unroll
            for (int nb = 0; nb < 4; ++nb) acc[nb] = (f32x4){0.f, 0.f, 0.f, 0.f};
#pragma unroll
            for (int ks = 0; ks < 4; ++ks) {
                const int ko = (wave * 128 + ks * 32 + 8 * fq) * 2;
                const bf16x8 ah = *(const bf16x8*)(Ahi + fr * RS + ko);
#pragma unroll
                for (int nb = 0; nb < 4; ++nb) acc[nb] = __builtin_amdgcn_mfma_f32_16x16x32_bf16(ah, wfr[ks][nb], acc[nb], 0, 0, 0);
            }
#pragma unroll
            for (int nb = 0; nb < 4; ++nb)
#pragma unroll
                for (int j = 0; j < 4; ++j) Pp[(wave * 16 + 4 * fq + j) * 64 + 16 * nb + fr] = acc[nb][j];
        }
        asm volatile("s_waitcnt lgkmcnt(0)\n\ts_barrier" ::: "memory");
#pragma unroll
        for (int rr = 0; rr < 2; ++rr) {
            const int lr = 2 * wave + rr;
            float lg = 0.f;
#pragma unroll
            for (int w = 0; w < 8; ++w) lg += Pp[(w * 16 + lr) * 64 + lane];
            const float score = 1.0f / (1.0f + expf(-lg));
            const float sel = score + rbias;
            float t1 = sel, t2 = -INFINITY;
#define TOP2(M) do { const float o1 = sx<M>(t1), o2 = sx<M>(t2); const float n1 = fmaxf(t1, o1), n2 = fmaxf(fminf(t1, o1), fmaxf(t2, o2)); t1 = n1; t2 = n2; } while (0)
            TOP2(1); TOP2(2); TOP2(4);
#undef TOP2
            const float gs = t1 + t2; const int grp = lane >> 3;
            int gr = 0;
#pragma unroll
            for (int j = 0; j < 8; ++j) { const float sj = __uint_as_float(__builtin_amdgcn_readlane(__float_as_uint(gs), j * 8)); gr += (sj > gs || (sj == gs && j < grp)) ? 1 : 0; }
            const bool gsel = gr < 4;
            float v = gsel ? sel : -INFINITY;
            int rk = TOPK;
#pragma unroll
            for (int it8 = 0; it8 < TOPK; ++it8) {
                const float mx = wave_max(v);
                const unsigned long long eq = __ballot(v == mx);
                const int win = __builtin_ctzll(eq);
                if (lane == win) { rk = it8; v = -INFINITY; }
            }
            const bool chosen = rk < TOPK;
            const float ssum = wave_sum(chosen ? score : 0.f);
            const float w = score / (ssum + 1e-20f) * 2.5f;
            if (chosen) {
                const int lpos = atomicAdd(&lcnt[lane], 1);
                const int idx = (it * 16 + lr) * 8 + rk;
                PE[idx] = lane | (lpos << 8); PW[idx] = w;
            }
        }
      }
      __syncthreads();
      if (tid < 64) { const int c = lcnt[tid]; gb[tid] = c ? (int)atomicAdd(&counts[b * 65 + tid], (unsigned)c) : 0; }
      __syncthreads();
      for (int i = tid; i < 1024; i += NT) {
          const int pe = PE[i], e = pe & 255, pos = gb[e] + (pe >> 8), mk = mc * 8 + i;
          TOKL[((size_t)b * 64 + e) * 8192 + pos] = mk; TE[mk] = e; TP[mk] = pos; TW[mk] = PW[i];
      }
      __syncthreads();
    }
}

constexpr int T_CNT = 0;
constexpr int T_TOT = 256;
constexpr int T_AB = 328;
constexpr int T_OFF = 400;
constexpr int T_GUP = 660;
constexpr int T_YC = 730;
constexpr int T_YB = 990;
constexpr int T_DUP = 1250;
constexpr int T_UL = 1520;
constexpr int T_END = 1520 + 512;
__device__ __forceinline__ int scan_incl(int v, int lane) {
#pragma unroll
    for (int off = 1; off < 64; off <<= 1) { const int t = __builtin_amdgcn_ds_bpermute(((lane - off) & 63) << 2, v); if (lane >= off) v += t; }
    return v;
}
__device__ __forceinline__ void build_moe(const Params& p, int* tab) {
    const unsigned* counts = (const unsigned*)(p.ws + WS_CTL);
    __syncthreads();
    const int tid = otid(), wave = tid >> 6, lane = tid & 63;
    if (wave == 0) {
        const int c0 = (int)counts[0 * 65 + lane], c1 = (int)counts[1 * 65 + lane], c2 = (int)counts[2 * 65 + lane], c3 = (int)counts[3 * 65 + lane];
        tab[T_CNT + 0 * 64 + lane] = c0; tab[T_CNT + 1 * 64 + lane] = c1; tab[T_CNT + 2 * 64 + lane] = c2; tab[T_CNT + 3 * 64 + lane] = c3;
        tab[T_OFF + lane * 4 + 0] = 0; tab[T_OFF + lane * 4 + 1] = c0; tab[T_OFF + lane * 4 + 2] = c0 + c1; tab[T_OFF + lane * 4 + 3] = c0 + c1 + c2;
        const int tot = c0 + c1 + c2 + c3, pad = (tot + 255) & ~255, gu = ((tot + 255) >> 8) * 2;
        const int sp = scan_incl(pad, lane), sg = scan_incl(gu, lane);
        tab[T_TOT + lane] = tot; tab[T_AB + lane] = sp - pad; tab[T_GUP + lane] = sg - gu;
        const int cb[4] = {c0, c1, c2, c3};
#pragma unroll
        for (int b = 0; b < 4; ++b) {
            const int du = ((cb[b] + 255) >> 8) * 4;
            const int sy = scan_incl(cb[b], lane), sd = scan_incl(du, lane);
            tab[T_YB + 65 * b + lane] = sy - cb[b]; tab[T_DUP + 66 * b + lane] = sd - du;
            if (lane == 63) { tab[T_YB + 65 * b + 64] = sy; tab[T_DUP + 66 * b + 64] = sd; tab[T_DUP + 66 * b + 65] = sd + (SEQ / 256) * 4; }
        }
        if (lane == 63) { tab[T_TOT + 64] = T; tab[T_AB + 64] = sp; tab[T_GUP + 64] = sg; tab[T_GUP + 65] = sg + (T / 256) * 2; }
    }
    __syncthreads();
}

__device__ __forceinline__ void moe_decode(const GP_LAS int* tab, int e, int pos_e, int& b, int& pos) {
    const int o1 = tab[T_OFF + e * 4 + 1], o2 = tab[T_OFF + e * 4 + 2], o3 = tab[T_OFF + e * 4 + 3];
    b = (pos_e >= o1 ? 1 : 0) + (pos_e >= o2 ? 1 : 0) + (pos_e >= o3 ? 1 : 0);
    pos = pos_e - (b == 0 ? 0 : (b == 1 ? o1 : (b == 2 ? o2 : o3)));
}
__device__ __forceinline__ int yrow0(int b) { return b == 0 ? 2 * 1024 : (272 + 72 * (b - 1)) * 1024; }
struct MoeSched {
    const GP_LAS int* tab; int G, c, ntn, U, down, chunk; const int* TOKL; const char* Bt;
    __device__ __forceinline__ void prepare(int* tabw, int wv) const {
        if (wv == 0) {
            const int i = lane_id(); int L = i * G + c;
            if (L < U) {
                int bt = 0;
                if (down) {
#pragma unroll
                    for (int q = 0; q < 3; ++q) { const int u0 = tabw[T_DUP + 66 * bt + 65]; if (L >= u0) { L -= u0; ++bt; } } }
                const int pre = down ? T_DUP + 66 * bt : T_GUP;
                int lo = 0, hi = 64;
                while (lo < hi) { const int mid = (lo + hi + 1) >> 1; if (tabw[pre + mid] <= L) lo = mid; else hi = mid - 1; }
                const int loc = L - tabw[pre + lo];
                int cnt, base, bb;
                if (down) { cnt = (lo < 64) ? tabw[T_CNT + bt * 64 + (lo & 63)] : SEQ; base = tabw[T_YB + 65 * bt + lo] + yrow0(bt);
                            bb = tabw[T_AB + lo] + (lo < 64 ? tabw[T_OFF + (lo & 63) * 4 + bt] : bt * SEQ); }
                else { cnt = tabw[T_TOT + lo]; base = tabw[T_AB + lo]; bb = 0; }
                int* ul = tabw + T_UL + 8 * i;
                ul[0] = lo; ul[1] = loc / ntn; ul[2] = loc % ntn; ul[3] = cnt; ul[4] = base; ul[5] = bb;
            }
        }
        __syncthreads();
    }
    __device__ __forceinline__ bool next(int i, gp::Unit& u) const {
        if (i * G + c >= U) return false;
        const GP_LAS int* ul = tab + T_UL + 8 * i;
        u.e = __builtin_amdgcn_readfirstlane(ul[0]); u.pm = __builtin_amdgcn_readfirstlane(ul[1]); u.pn = __builtin_amdgcn_readfirstlane(ul[2]);
        u.cnt = __builtin_amdgcn_readfirstlane(ul[3]); u.base = __builtin_amdgcn_readfirstlane(ul[4]); u.b = __builtin_amdgcn_readfirstlane(ul[5]);
        return true;
    }
    __device__ __forceinline__ unsigned arow(const gp::Unit& u, int r) const {
        const int pos_e = u.pm * 256 + r;
        if (down) return (unsigned)(u.b + pos_e) * 256u;
        int tok;
        if (u.e < 64) { int b, pos; moe_decode(tab, u.e, pos_e, b, pos); tok = (pos_e < u.cnt) ? (TOKL[((size_t)b * 64 + u.e) * 8192 + pos] >> 3) : 0; } else tok = pos_e;
        return (unsigned)tok * 1024u;
    }
    __device__ __forceinline__ const char* bptr(const gp::Unit& u) const {
        return down ? Bt + ((size_t)u.e * 1024 + u.pn * 256) * 256 : Bt + ((size_t)u.e * 512 + u.pn * 256) * 1024;
    }
};
struct EpiGU {
    unsigned char* ACT; const int* TOKL; const float* TW; const GP_LAS int* tab;
    __device__ __forceinline__ void operator()(const f32x4 (&acc)[2][2][4][2], const gp::Unit& u, int wr, int wc, int fr, int fq) const {
#pragma unroll
        for (int ai = 0; ai < 2; ++ai)
#pragma unroll
            for (int m = 0; m < 4; ++m) {
                const int pos_e = u.pm * 256 + ai * 128 + wr * 64 + m * 16 + fr;
                if (pos_e < u.cnt) {
                    float a[8];
#pragma unroll
                    for (int n = 0; n < 2; ++n)
#pragma unroll
                        for (int i = 0; i < 4; ++i) { const float g = acc[ai][0][m][n][i] * (1.f / GUSCALE), up = acc[ai][1][m][n][i] * (1.f / GUSCALE);
                            a[4 * n + i] = __builtin_amdgcn_fmed3f(g * __builtin_amdgcn_rcpf(1.0f + __builtin_amdgcn_exp2f(-1.4426950408889634f * g)) * up * ASCALE, -448.f, 448.f); }
                    int w0 = __builtin_amdgcn_cvt_pk_fp8_f32(a[0], a[1], 0, false); w0 = __builtin_amdgcn_cvt_pk_fp8_f32(a[2], a[3], w0, true);
                    int w1 = __builtin_amdgcn_cvt_pk_fp8_f32(a[4], a[5], 0, false); w1 = __builtin_amdgcn_cvt_pk_fp8_f32(a[6], a[7], w1, true);
                    uint2 o; o.x = (unsigned)w0; o.y = (unsigned)w1;
                    *(uint2*)(ACT + ((size_t)u.base + pos_e) * DE + u.pn * 128 + wc * 32 + fq * 8) = o;
                }
            }
    }
};
constexpr float YSCALE = 16.f;
struct EpiDown {
    unsigned char* ws;
    __device__ __forceinline__ void operator()(const f32x4 (&acc)[2][2][4][2], const gp::Unit& u, int wr, int wc, int fr, int fq) const {
#pragma unroll
        for (int ai = 0; ai < 2; ++ai)
#pragma unroll
            for (int m = 0; m < 4; ++m) {
                const int pos = u.pm * 256 + ai * 128 + wr * 64 + m * 16 + fr;
                if (pos < u.cnt) {
                    unsigned char* rowp = ws + (size_t)(u.base + pos) * D + u.pn * 256 + wc * 32 + fq * 8;
#pragma unroll
                    for (int bj = 0; bj < 2; ++bj) { const f32x4 v0 = acc[ai][bj][m][0] * (YSCALE / (WDSCALE * ASCALE)), v1 = acc[ai][bj][m][1] * (YSCALE / (WDSCALE * ASCALE));
                        int w0 = __builtin_amdgcn_cvt_pk_fp8_f32(v0[0], v0[1], 0, false); w0 = __builtin_amdgcn_cvt_pk_fp8_f32(v0[2], v0[3], w0, true);
                        int w1 = __builtin_amdgcn_cvt_pk_fp8_f32(v1[0], v1[1], 0, false); w1 = __builtin_amdgcn_cvt_pk_fp8_f32(v1[2], v1[3], w1, true);
                        uint2 o; o.x = (unsigned)w0; o.y = (unsigned)w1;
                        *(uint2*)(rowp + bj * 128) = o; }
                }
            }
    }
};
__device__ __forceinline__ void ph_moe_gu(const Params& p, unsigned char* smem) {
    unsigned char* ws = p.ws;
    int* tab = (int*)(smem + gp::STAGE_BYTES);
    build_moe(p, tab);
    MoeSched S; S.tab = (const GP_LAS int*)tab; S.G = gridDim.x; S.c = (gridDim.x % 8 == 0) ? (int)((blockIdx.x % 8) * (gridDim.x / 8) + blockIdx.x / 8) : (int)blockIdx.x;   S.ntn = 2; S.U = __builtin_amdgcn_readfirstlane(tab[T_GUP + 65]); S.down = 0; S.chunk = 0;
    S.TOKL = (const int*)(ws + WS_TOKL); S.Bt = (const char*)(ws + WS_WGUT);
    S.prepare(tab, p.chunk);
    EpiGU E{ws + WS_ACT, (const int*)(ws + WS_TOKL), (const float*)(ws + WS_TW), (const GP_LAS int*)tab};
    gp::gemm_phase<EpiGU, MoeSched, true, true>(p.chunk, (GP_LAS unsigned char*)smem, (const char*)(ws + WS_H2), D / 2, S, E);
}
__device__ __forceinline__ void ph_moe_down(const Params& p, unsigned char* smem, int c) {
    unsigned char* ws = p.ws;
    int* tab = (int*)(smem + gp::STAGE_BYTES);
    build_moe(p, tab);
    MoeSched S; S.tab = (const GP_LAS int*)tab; S.G = gridDim.x; S.c = (gridDim.x % 8 == 0) ? (int)((blockIdx.x % 8) * (gridDim.x / 8) + blockIdx.x / 8) : (int)blockIdx.x;   S.ntn = 4; S.U = __builtin_amdgcn_readfirstlane(tab[T_DUP + 65] + tab[T_DUP + 66 + 65] + tab[T_DUP + 132 + 65] + tab[T_DUP + 198 + 65]); S.down = 1; S.chunk = c;
    S.TOKL = nullptr; S.Bt = (const char*)(ws + WS_WDT);
    S.prepare(tab, p.chunk);
    EpiDown E{ws};
    gp::gemm_phase<EpiDown, MoeSched, false, true>(p.chunk, (GP_LAS unsigned char*)smem, (const char*)(ws + WS_ACT), DE / 2, S, E);
}

__device__ __forceinline__ void ph_final(const Params& p, float* lds) {
    unsigned char* ws = p.ws;
    int* tab = (int*)lds;
    build_moe(p, tab);
    const int tid = otid(), wave = tid >> 6, lane = tid & 63;
    const int gw = blockIdx.x * NWV + wave, GW = gridDim.x * NWV;
    const int* TE = (const int*)(ws + WS_TE); const int* TP = (const int*)(ws + WS_TP); const float* TW = (const float*)(ws + WS_TW);
    const unsigned char* Y = ws;
    for (int m = gw; m < T; m += GW) {
        const int b = m >> 13, t = m & (SEQ - 1);
        const float* mod = (const float*)(ws + WS_MOD) + b * 6144 + 5 * 1024;
        float acc[16];
#pragma unroll
        for (int i = 0; i < 16; ++i) acc[i] = 0.f;
#pragma unroll
        for (int k = 0; k < 9; ++k) {
            int row; float wk = 1.f;
            if (k < 8) { const int e = TE[m * 8 + k]; row = tab[T_YB + 65 * b + e] + TP[m * 8 + k]; wk = TW[m * 8 + k]; }
            else row = tab[T_YB + 65 * b + 64] + t;
            row += yrow0(b);
            const unsigned char* yr = Y + (size_t)row * D;
#pragma unroll
            for (int j = 0; j < 4; ++j) { const int w = *(const int*)(yr + 4 * (lane + 64 * j));
                acc[4 * j] += wk * __builtin_amdgcn_cvt_f32_fp8(w, 0); acc[4 * j + 1] += wk * __builtin_amdgcn_cvt_f32_fp8(w, 1); acc[4 * j + 2] += wk * __builtin_amdgcn_cvt_f32_fp8(w, 2); acc[4 * j + 3] += wk * __builtin_amdgcn_cvt_f32_fp8(w, 3); }
        }
        float ss = 0.f;
#pragma unroll
        for (int i = 0; i < 16; ++i) { acc[i] *= (1.f / YSCALE); ss += acc[i] * acc[i]; }
        ss = wave_sum(ss);
        const float rs = 1.0f / sqrtf(ss * (1.0f / D) + EPS);
#pragma unroll
        for (int j = 0; j < 4; ++j) {
            const int col = 4 * (lane + 64 * j);
            const f32x4 gp = *(const f32x4*)(p.in[I_GFPOST] + col), gt = *(const f32x4*)(mod + col);
            f32x4 x1 = ((const f32x4*)(p.out + (size_t)m * D))[lane + 64 * j];
#pragma unroll
            for (int i = 0; i < 4; ++i) x1[i] += gt[i] * (acc[4 * j + i] * rs * gp[i]);
            ((f32x4*)(p.out + (size_t)m * D))[lane + 64 * j] = x1;
        }
    }
}

#define GAS __attribute__((address_space(1)))
#define LAS __attribute__((address_space(3)))
#define XB_TMO      128
#define XB_XCNT(j)  (256  + 64 * (j))
#define XB_XSUB(j)  (1280 + 64 * (j))
#define XB_XGEN(j)  (2304 + 64 * (j))
#define XB_TOP      3328
#define XB_TOPGEN   3392
#define XCD_BAR_WORDS 3456
#define XB_SPIN_CAP (1u << 21)
__device__ __forceinline__ unsigned xb_ld(unsigned* p)              { return __hip_atomic_load(p, __ATOMIC_RELAXED, __HIP_MEMORY_SCOPE_AGENT); }
__device__ __forceinline__ unsigned xb_add(unsigned* p, unsigned v) { return __hip_atomic_fetch_add(p, v, __ATOMIC_RELAXED, __HIP_MEMORY_SCOPE_AGENT); }
__device__ __forceinline__ unsigned xb_xcc_id() { return (unsigned)__builtin_amdgcn_s_getreg((3 << 11) | 20) & 0xFu; }
#define XB_SPIN(cond, bar) do { unsigned _sp = 0; while (cond) { __builtin_amdgcn_s_sleep(1); \
    if ((++_sp & 255u) == 0u) { if (xb_ld(&(bar)[XB_TMO])) break; if (_sp > XB_SPIN_CAP) { atomicAdd(&(bar)[XB_TMO], 1u); break; } } } } while (0)
struct XcdBarrier { unsigned* bar; unsigned x; volatile LAS unsigned* st; };
__device__ __forceinline__ XcdBarrier xcd_barrier_post(unsigned* bar, volatile LAS unsigned* st, int wv) {
    XcdBarrier b; b.bar = bar; b.x = xb_xcc_id(); b.st = st;
    if (wv == 0 && lane_id() == 0) (void)xb_add(&bar[XB_XCNT(b.x)], 1u);
    return b;
}
__device__ __forceinline__ void xcd_barrier_complete(unsigned* bar, unsigned x, unsigned& nloc, unsigned& nx) {
    const unsigned G = gridDim.x * gridDim.y * gridDim.z;
    unsigned sum, cnt, mine, sp = 0u;
    for (;;) {
        sum = 0u; cnt = 0u; mine = 0u;
#pragma unroll
        for (unsigned j = 0; j < 16; ++j) { const unsigned c = xb_ld(&bar[XB_XCNT(j)]); sum += c; cnt += (c > 0u) ? 1u : 0u; mine = (j == x) ? c : mine; }
        if (sum == G) break;
        __builtin_amdgcn_s_sleep(1);
        if ((++sp & 255u) == 0u) { if (xb_ld(&bar[XB_TMO])) break; if (sp > XB_SPIN_CAP) { atomicAdd(&bar[XB_TMO], 1u); break; } }
    }
    nloc = mine > 0u ? mine : 1u; nx = cnt > 0u ? cnt : 1u;
}
__device__ __forceinline__ void xcd_barrier(const XcdBarrier& b, int wv) {
    asm volatile("s_waitcnt vmcnt(0)" ::: "memory");
    __syncthreads();
    if (wv == 0 && lane_id() == 0) {
        unsigned* bar = b.bar;
        __builtin_amdgcn_s_waitcnt(0);
        unsigned nloc = b.st[0], nx = b.st[1];
        if (nloc == 0u) { xcd_barrier_complete(bar, b.x, nloc, nx); b.st[0] = nloc; b.st[1] = nx; }
        const unsigned old = xb_add(&bar[XB_XSUB(b.x)], 1u);
        const unsigned gen = old / nloc;
        if (old + 1u == (gen + 1u) * nloc) {
            __builtin_amdgcn_fence(__ATOMIC_RELEASE, "agent");
            asm volatile("s_waitcnt vmcnt(0)" ::: "memory");
            const unsigned og = xb_add(&bar[XB_TOP], 1u);
            const unsigned tg = og / nx;
            if (og + 1u == (tg + 1u) * nx) xb_add(&bar[XB_TOPGEN], 1u);
            else XB_SPIN(xb_ld(&bar[XB_TOPGEN]) == tg, bar);
            __builtin_amdgcn_fence(__ATOMIC_ACQUIRE, "agent");
            xb_add(&bar[XB_XGEN(b.x)], 1u);
            asm volatile("s_waitcnt vmcnt(0)" ::: "memory");
        } else {
            XB_SPIN(xb_ld(&bar[XB_XGEN(b.x)]) == gen, bar);
            __builtin_amdgcn_fence(__ATOMIC_ACQUIRE, "agent");
            asm volatile("s_waitcnt vmcnt(0)" ::: "memory");
        }
    }
    __syncthreads();
}

namespace cg = cooperative_groups;
constexpr int LDS_BYTES = 144 * 1024;
typedef const __attribute__((address_space(4))) Params* KP;
__device__ __forceinline__ Params kargs() {
    Params p;
#if defined(__HIP_DEVICE_COMPILE__)
    typedef const __attribute__((address_space(4))) unsigned long long* KQ;
    KQ kq = (KQ)__builtin_amdgcn_kernarg_segment_ptr(); asm volatile("" : "+s"(kq));
    unsigned long long* d = (unsigned long long*)&p;
#pragma unroll
    for (int i = 0; i < (int)(sizeof(Params) / 8); ++i) d[i] = kq[i];
#endif
    return p;
}
#define PH(call) do { Params p = kargs(); p.chunk = wv; call; } while (0)
__global__ void __launch_bounds__(NT) mega_fwd(Params p_unused) {
    extern __shared__ __attribute__((aligned(16))) unsigned char smem[];
    float* lds = (float*)smem;
    volatile LAS unsigned* misc = (volatile LAS unsigned*)((LAS unsigned char*)smem + (LDS_BYTES - 64));
    if (threadIdx.x < 16) misc[threadIdx.x] = 0u;
    __syncthreads();
    unsigned* barw; { const Params p = kargs(); barw = (unsigned*)(p.ws + WS_CTL) + 4096; }
    const int wv = __builtin_amdgcn_readfirstlane(threadIdx.x >> 6);
    const XcdBarrier bar = xcd_barrier_post(barw, misc, wv);
#define SYNC() xcd_barrier(bar, wv)
    PH(ph_prep(p, lds)); PH(ph_prep_weights(p, lds, 0, 0));   SYNC();
    PH(ph_norm1(p));                SYNC();
    PH(ph_inproj(p, smem)); PH(ph_prep_weights(p, lds, 1, (MTOT / 256) * (INW / 256) % (int)gridDim.x));         SYNC();
    PH(ph_attn(p, smem)); PH(ph_fourierA(p, smem));  SYNC();
    PH(ph_fourierB(p, smem));       SYNC();
    PH(ph_outproj(p, smem));        SYNC();
    PH(ph_mid(p, smem));            SYNC();
    PH(ph_moe_gu(p, smem));         SYNC();
#pragma unroll 1
    PH(ph_moe_down(p, smem, 0));    SYNC();
    PH(ph_final(p, lds));
#undef SYNC
}

extern "C" void kernel_launch(void* const* d_in, const int* in_sizes, int n_in, void* d_out, int out_size, void* d_ws, size_t ws_size, hipStream_t stream) {
    if (n_in != 26 || ws_size < WS_END) { fprintf(stderr, "kernel_launch: unexpected n_in %d / ws %zu\n", n_in, ws_size); return; }
    static int grid_blocks = 0;
    if (!grid_blocks) {
        int dev = 0, cus = 0, per_cu = 0;
        (void)hipGetDevice(&dev);
        (void)hipDeviceGetAttribute(&cus, hipDeviceAttributeMultiprocessorCount, dev);
        (void)hipFuncSetAttribute((const void*)mega_fwd, hipFuncAttributeMaxDynamicSharedMemorySize, LDS_BYTES);
        (void)hipOccupancyMaxActiveBlocksPerMultiprocessor(&per_cu, (const void*)mega_fwd, NT, LDS_BYTES);
        if (per_cu < 1) { fprintf(stderr, "kernel_launch: occupancy query says %d blocks/CU\n", per_cu); per_cu = 1; }
        if (per_cu > 1) per_cu = 1;
        grid_blocks = cus * per_cu;
    }
    Params p{};
    for (int i = 0; i < 26; ++i) p.in[i] = (const float*)d_in[i];
    p.out = (float*)d_out; p.ws = (unsigned char*)d_ws; p.chunk = 0; p.pad = 0;
    (void)hipMemsetAsync((char*)d_ws + WS_CTL, 0, 32768, stream);
    void* args[] = {&p};
    hipError_t e = hipLaunchCooperativeKernel((const void*)mega_fwd, dim3(grid_blocks), dim3(NT), args, LDS_BYTES, stream);
    if (e != hipSuccess) fprintf(stderr, "cooperative launch failed: %s (grid %d)\n", hipGetErrorString(e), grid_blocks);
}
```

```cpp
#include <hip/hip_runtime.h>
#include <hip/hip_cooperative_groups.h>
#include <cstdio>
#include <cstdint>

typedef unsigned short bf16_t;
typedef float f32x4 __attribute__((ext_vector_type(4)));

constexpr int D = 1024, BATCH = 4, SEQ = 8192, T = BATCH * SEQ, CTX = 256, TC = BATCH * CTX;
constexpr int MTOT = T + TC;
constexpr int KVLEN = CTX + SEQ;
constexpr int INW = 2560, NH = 6, QKW = 768, FW = 256;
constexpr int NE = 64, DE = 256, TOPK = 8;
constexpr int NT = 512, NWV = 8;
constexpr int SLOTS_B = 90112;
constexpr float EPS = 1e-6f;
constexpr float LAM_INIT = 0.2f;
constexpr float QSCALE = 0.125f * 1.4426950408889634f;
constexpr float SQS = 0.42466090014400953f;

constexpr size_t MiB = 1u << 20;
constexpr size_t WS_CTL = 0;
constexpr size_t WS_MOD = 1 * MiB;
constexpr size_t WS_TABW = WS_MOD + 128 * 1024;
constexpr size_t WS_ROPE = WS_MOD + 192 * 1024;
constexpr size_t WS_GCS = WS_MOD + 256 * 1024;
constexpr size_t WS_W128E = WS_MOD + 768 * 1024;
constexpr size_t WS_M64E = WS_MOD + 832 * 1024;
constexpr size_t WS_GT = WS_MOD + 864 * 1024;
constexpr size_t WS_WRT = WS_MOD + 512 * 1024;
constexpr size_t WS_WINT = 2 * MiB;
constexpr size_t WS_WOUTT = 7 * MiB;
constexpr size_t WS_WGUT = 9 * MiB;
constexpr size_t WS_WDT = 74 * MiB;
constexpr size_t WS_TE = 107 * MiB;
constexpr size_t WS_TP = 108 * MiB;
constexpr size_t WS_TW = 109 * MiB;
constexpr size_t WS_TOKL = 110 * MiB;
constexpr size_t WS_AO = 118 * MiB;
constexpr size_t WS_ACT = 118 * MiB;
constexpr size_t WS_Q = 182 * MiB;
constexpr size_t WS_K = 230 * MiB;
constexpr size_t WS_V = WS_K + (size_t)BATCH * KVLEN * QKW * 2;
constexpr size_t WS_F = 329 * MiB;
constexpr size_t WS_FY = 361 * MiB;
constexpr size_t WS_HX = 425 * MiB;
constexpr size_t WS_YX = 358 * MiB;
constexpr size_t WS_H2 = 294 * MiB;
constexpr size_t WS_Y = 294 * MiB;
constexpr size_t WS_END = 491 * MiB;

struct Params {
    const float* in[26];
    float* out;
    unsigned char* ws;
    int chunk;
    int pad;
};
enum { I_X = 0, I_C, I_CTX, I_CCTX, I_WMOD, I_BMOD, I_GAPRE, I_GAPOST, I_WIN, I_WF, I_LQ1, I_LK1, I_LQ2, I_LK2, I_GSUB, I_WOUT,
       I_GFPRE, I_GFPOST, I_WR, I_RB, I_WG, I_WU, I_WD, I_WSG, I_WSU, I_WSD };

__device__ __forceinline__ float bf2f(bf16_t v) { return __uint_as_float(((unsigned)v) << 16); }
__device__ __forceinline__ bf16_t f2bf(float f) { unsigned u = __float_as_uint(f); return (bf16_t)((u + 0x7fffu + ((u >> 16) & 1u)) >> 16); }
__device__ __forceinline__ unsigned pk2(float lo, float hi) { return (unsigned)f2bf(lo) | ((unsigned)f2bf(hi) << 16); }
template <int M> __device__ __forceinline__ float sx(float v) { return __int_as_float(__builtin_amdgcn_ds_swizzle(__float_as_int(v), (M << 10) | 0x1f)); }
template <int M> __device__ __forceinline__ int sxi(int v) { return __builtin_amdgcn_ds_swizzle(v, (M << 10) | 0x1f); }
__device__ __forceinline__ float wave_sum(float v) {
    v += sx<1>(v); v += sx<2>(v); v += sx<4>(v); v += sx<8>(v); v += sx<16>(v);
    auto rr = __builtin_amdgcn_permlane32_swap(__float_as_uint(v), __float_as_uint(v), false, false);
    return __uint_as_float(rr[0]) + __uint_as_float(rr[1]);
}
__device__ __forceinline__ float dpp_f(float v, const int ctrl_sel) {
    const int x = __float_as_int(v); int r;
    if (ctrl_sel == 0) r = __builtin_amdgcn_update_dpp(x, x, 0xB1, 0xf, 0xf, false);
    else if (ctrl_sel == 1) r = __builtin_amdgcn_update_dpp(x, x, 0x4E, 0xf, 0xf, false);
    else if (ctrl_sel == 2) r = __builtin_amdgcn_update_dpp(x, x, 0x141, 0xf, 0xf, false);
    else r = __builtin_amdgcn_update_dpp(x, x, 0x140, 0xf, 0xf, false);
    return __int_as_float(r);
}
__device__ __forceinline__ float wave_max(float v) {
    v = fmaxf(v, dpp_f(v, 0)); v = fmaxf(v, dpp_f(v, 1)); v = fmaxf(v, dpp_f(v, 2)); v = fmaxf(v, dpp_f(v, 3));
    const float a = __uint_as_float(__builtin_amdgcn_readlane(__float_as_uint(v), 0)), b = __uint_as_float(__builtin_amdgcn_readlane(__float_as_uint(v), 16));
    const float c = __uint_as_float(__builtin_amdgcn_readlane(__float_as_uint(v), 32)), d = __uint_as_float(__builtin_amdgcn_readlane(__float_as_uint(v), 48));
    return fmaxf(fmaxf(a, b), fmaxf(c, d));
}
__device__ __forceinline__ int lane_id() { int l; asm volatile("v_mbcnt_lo_u32_b32 %0, -1, 0\n\tv_mbcnt_hi_u32_b32 %0, -1, %0" : "=v"(l)); return l; }
__device__ __forceinline__ int otid_w(int wv) { return wv * 64 + lane_id(); }
#define otid() otid_w(p.chunk)
__device__ __forceinline__ float silu_f(float x) { return x / (1.f + expf(-x)); }

__device__ __forceinline__ void ph_prep(const Params& p, float* lds) {
    const int tid = otid(), bid = blockIdx.x, nblk = gridDim.x;
    const int gt = bid * NT + tid, GT = nblk * NT;
    unsigned char* ws = p.ws;
    float2* tabw = (float2*)(ws + WS_TABW);
    for (int i = gt; i < 8192; i += GT) { float s, c; sincospif((float)i * (1.0f / 4096.0f), &s, &c); tabw[i] = make_float2(c, s); }
    float* rope = (float*)(ws + WS_ROPE);
    for (int i = gt; i < 192 * 16; i += GT) {
        const int pos = (i < 2048) ? (i >> 4) : ((i - 2048) >> 4); const int f = i & 15;
        const float inv = powf(10000.0f, -(float)(2 * f) / 32.0f); const float ang = (float)pos * inv;
        const float c = cosf(ang), s = sinf(ang);
        if (i < 2048) { rope[i] = c; rope[2048 + i] = s; } else { rope[4096 + (i - 2048)] = c; rope[4096 + 1024 + (i - 2048)] = s; }
    }
    { bf16_t* gt = (bf16_t*)(ws + WS_GT); const float* wf = p.in[I_WF];
      for (int i = bid * NT + tid; i < 4 * 64 * 128; i += GT) {
        const int g = i >> 13, d = (i >> 7) & 63, part = (i >> 6) & 1, c = i & 63;
        float a = 0.f;
        for (int j = 0; j < 64; ++j) { float s, co; sincospif((float)((c * j) & 63) * (1.0f / 32.0f), &s, &co); a += (part ? s : co) * wf[(g * 64 + j) * 64 + d]; }
        gt[i] = f2bf(a * 0.0013810679320049757f);
      }
      bf16_t* w128 = (bf16_t*)(ws + WS_W128E);
      for (int i = bid * NT + tid; i < 256 * 128; i += GT) { const int kk = i >> 7, n1 = i & 127; float s, co; sincospif((float)(((kk & 127) * n1) & 127) * (1.0f / 64.0f), &s, &co); w128[i] = f2bf(kk < 128 ? co : -s); }
      bf16_t* m64 = (bf16_t*)(ws + WS_M64E);
      for (int i = bid * NT + tid; i < 128 * 128; i += GT) { const int ro = i >> 7, ci = i & 127, po = ro >> 6, k2 = ro & 63, pi = ci >> 6, n2 = ci & 63;
        float s, co; sincospif((float)((k2 * n2) & 63) * (1.0f / 32.0f), &s, &co); m64[i] = f2bf(po == pi ? co : (po == 0 ? s : -s)); }
    }
    {
      bf16_t* wrt = (bf16_t*)(ws + WS_WRT); const float* wr = p.in[I_WR];
      for (int i = gt; i < 64 * 1024; i += GT) {
        const int j = i & 7, ln = (i >> 3) & 63, nb = (i >> 9) & 3, ks = (i >> 11) & 3, wv_ = i >> 13;
        const int e = 16 * nb + (ln & 15), k = wv_ * 128 + ks * 32 + 8 * (ln >> 4) + j;
        const float w = wr[k * 64 + e]; const bf16_t h = f2bf(w);
        const int o = ((((wv_ * 4 + ks) * 4 + nb) * 2) * 64 + ln) * 8 + j;
        wrt[o] = h; wrt[o + 512] = f2bf(w - bf2f(h)); } }
    if (gt == 0) {
        float s1 = 0.f, s2 = 0.f;
        for (int i = 0; i < 64; ++i) { s1 += p.in[I_LQ1][i] * p.in[I_LK1][i]; s2 += p.in[I_LQ2][i] * p.in[I_LK2][i]; }
        ((float*)(ws + WS_CTL))[1024] = expf(s1) - expf(s2) + LAM_INIT;
    }
    float* sc = lds;
    float* red = lds + 5 * 1024;
    for (int i = tid; i < 5 * 1024; i += NT) { const int r = i >> 10, k = i & 1023; const float v = (r < 4) ? p.in[I_C][r * 1024 + k] : p.in[I_CCTX][k]; sc[i] = silu_f(v); }
    __syncthreads();
    const int wave = tid >> 6, lane = tid & 63;
    float* mod = (float*)(ws + WS_MOD);
    for (int task = bid; task < 96; task += nblk) {
        const int col = task * 64 + lane;
        float a0 = 0, a1 = 0, a2 = 0, a3 = 0, a4 = 0;
        const float* wm = p.in[I_WMOD];
#pragma unroll 32
        for (int k = wave * 128; k < wave * 128 + 128; ++k) { const float w = wm[(size_t)k * 6144 + col]; a0 += sc[k] * w; a1 += sc[1024 + k] * w; a2 += sc[2048 + k] * w; a3 += sc[3072 + k] * w; a4 += sc[4096 + k] * w; }
        red[(wave * 5 + 0) * 64 + lane] = a0; red[(wave * 5 + 1) * 64 + lane] = a1; red[(wave * 5 + 2) * 64 + lane] = a2; red[(wave * 5 + 3) * 64 + lane] = a3; red[(wave * 5 + 4) * 64 + lane] = a4;
        __syncthreads();
        if (tid < 320) { const int r = tid >> 6, l = tid & 63; float s = 0.f; for (int w = 0; w < 8; ++w) s += red[(w * 5 + r) * 64 + l]; mod[r * 6144 + task * 64 + l] = s + p.in[I_BMOD][task * 64 + l]; }
        __syncthreads();
    }
}

__device__ __forceinline__ void ph_norm1(const Params& p) {
    const int tid = otid(), wave = tid >> 6, lane = tid & 63;
    const int gw = blockIdx.x * NWV + wave, GW = gridDim.x * NWV;
    const float* mod = (const float*)(p.ws + WS_MOD);
    bf16_t* hx = (bf16_t*)(p.ws + WS_HX);
    const float* g = p.in[I_GAPRE];
    for (int m = gw; m < MTOT; m += GW) {
        const float* src = (m < T) ? p.in[I_X] + (size_t)m * D : p.in[I_CTX] + (size_t)(m - T) * D;
        const int r = (m < T) ? (m >> 13) : 4;
        const float* shift = mod + r * 6144; const float* scale = shift + 1024;
        f32x4 v[4]; float ss = 0.f;
#pragma unroll
        for (int j = 0; j < 4; ++j) { v[j] = ((const f32x4*)src)[lane + 64 * j]; ss += v[j][0] * v[j][0] + v[j][1] * v[j][1] + v[j][2] * v[j][2] + v[j][3] * v[j][3]; }
        ss = wave_sum(ss);
        const float rs = 1.0f / sqrtf(ss * (1.0f / D) + EPS);
#pragma unroll
        for (int j = 0; j < 4; ++j) {
            const int col = 4 * (lane + 64 * j);
            const f32x4 g4 = *(const f32x4*)(g + col), sc4 = *(const f32x4*)(scale + col), sh4 = *(const f32x4*)(shift + col);
            float h[4];
#pragma unroll
            for (int i = 0; i < 4; ++i) h[i] = v[j][i] * rs * g4[i] * (1.f + sc4[i]) + sh4[i];
            uint2 o; o.x = pk2(h[0], h[1]); o.y = pk2(h[2], h[3]);
            *(uint2*)(hx + (size_t)m * D + col) = o;
        }
    }
}

namespace gp {
#define GP_LAS __attribute__((address_space(3)))
typedef short bf16x8 __attribute__((ext_vector_type(8)));
typedef unsigned u32x4 __attribute__((ext_vector_type(4)));
typedef int i32x4 __attribute__((ext_vector_type(4)));
constexpr int BM = 256, BK = 64, HALF = 128, HTB = HALF * BK * 2, STAGE_BYTES = 8 * HTB;
__device__ __forceinline__ int lds_byte(int r, int c) { const int st = (r >> 4) * 2 + (c >> 5), rr = r & 15, cc = c & 31, ob = rr * 64 + cc * 2; return st * 1024 + (ob ^ (((ob >> 9) & 1) << 5)); }
__device__ __forceinline__ void stage_rc(int b, int& R, int& C) { const int st = b / 1024, sb = b % 1024, swz = sb ^ (((sb >> 9) & 1) << 5); R = (st >> 1) * 16 + swz / 64; C = (st & 1) * 32 + (swz % 64) / 2; }
__device__ __forceinline__ int perm32(int rho) { const int n = rho >> 4, i = rho & 15; return 8 * (i >> 2) + 4 * n + (i & 3); }
struct Unit { int pm, pn, e, b, cnt, base; };
typedef unsigned u32x2 __attribute__((ext_vector_type(2)));
typedef float f32x4g __attribute__((ext_vector_type(4)));
#define GP_G1(T, ptr) ((__attribute__((address_space(1))) T*)(ptr))
__device__ __forceinline__ void gst4(void* p, u32x4 v) { *GP_G1(u32x4, p) = v; }
__device__ __forceinline__ void gst2(void* p, unsigned a, unsigned b) { *GP_G1(u32x2, p) = (u32x2){a, b}; }
__device__ __forceinline__ void gst1(void* p, unsigned a) { *GP_G1(unsigned, p) = a; }
__device__ __forceinline__ f32x4g gld4f(const void* p) { return *GP_G1(const f32x4g, p); }
__device__ __forceinline__ unsigned cvt_pk_bf16(float lo, float hi) { unsigned r; asm volatile("v_cvt_pk_bf16_f32 %0, %1, %2" : "=v"(r) : "v"(lo), "v"(hi)); return r; }

template <class Epi, class Sched, bool ALIGN_EPI, bool F8 = false, int EST = 0>
__device__ __forceinline__ void gemm_phase(const int wv, GP_LAS unsigned char* lds, const char* Abase, const int K, const Sched& S, const Epi& E) {
    const int wid = wv, wr = wid >> 2, wc = wid & 3;
    const int nt = K / BK;
    unsigned voffB[2];
#pragma unroll
    for (int i = 0; i < 2; ++i) { int R, C; stage_rc(otid_w(wv) * 16 + i * 8192, R, C); const int Rb = (R & ~31) + perm32(R & 31); voffB[i] = (unsigned)(Rb * K + C) * 2u; }
#define GP_AOFFS(u, o00, o01, o10, o11) do { int R0, C0, R1, C1; const int t_ = otid_w(wv); stage_rc(t_ * 16, R0, C0); stage_rc(t_ * 16 + 8192, R1, C1); \
        o00 = S.arow(u, R0) + (unsigned)C0 * 2u; o01 = S.arow(u, R1) + (unsigned)C1 * 2u; o10 = S.arow(u, HALF + R0) + (unsigned)C0 * 2u; o11 = S.arow(u, HALF + R1) + (unsigned)C1 * 2u; } while (0)
    const size_t kstep = (size_t)(BK * 2);
    const size_t hstep = (size_t)HALF * K * 2;
    const unsigned ldsw = (unsigned)wid * 1024u;
    int aoff, boff; { const int l_ = lane_id(), fr = l_ & 15, fq = l_ >> 4; aoff = lds_byte(wr * 64 + fr, fq * 8); boff = lds_byte(wc * 32 + fr, fq * 8); }
#define GP_SA(b, h) (((b) * 2 + (h)) * HTB)
#define GP_SB(b, h) ((4 + (b) * 2 + (h)) * HTB)
#define GP_STAGE_B(bufoff, gbase) do { _Pragma("unroll") for (int _i = 0; _i < 2; ++_i) \
        __builtin_amdgcn_global_load_lds((const unsigned*)((const char*)(gbase) + voffB[_i]), (GP_LAS unsigned*)(lds + (bufoff) + ldsw + _i * 8192), 16, 0, 0); } while (0)
#define GP_STAGE_A(bufoff, gbase, o0, o1) do { \
        __builtin_amdgcn_global_load_lds((const unsigned*)((const char*)(gbase) + (o0)), (GP_LAS unsigned*)(lds + (bufoff) + ldsw), 16, 0, 0); \
        __builtin_amdgcn_global_load_lds((const unsigned*)((const char*)(gbase) + (o1)), (GP_LAS unsigned*)(lds + (bufoff) + ldsw + 8192), 16, 0, 0); } while (0)
#define GP_LDA(dst, b, h) do { _Pragma("unroll") for (int m = 0; m < 4; ++m) _Pragma("unroll") for (int k = 0; k < 2; ++k) dst[m][k] = *(const GP_LAS bf16x8*)(lds + GP_SA(b, h) + aoff + m * 2048 + k * 1024); } while (0)
#define GP_LDB(dst, b, h) do { _Pragma("unroll") for (int n = 0; n < 2; ++n) _Pragma("unroll") for (int k = 0; k < 2; ++k) dst[n][k] = *(const GP_LAS bf16x8*)(lds + GP_SB(b, h) + boff + n * 2048 + k * 1024); } while (0)
#define GP_CAT8(x) __builtin_shufflevector(__builtin_bit_cast(i32x4, x[0]), __builtin_bit_cast(i32x4, x[1]), 0, 1, 2, 3, 4, 5, 6, 7)
#define GP_MMA(ai, bj, At, Bt) do { __builtin_amdgcn_s_setprio(1); _Pragma("unroll") for (int m = 0; m < 4; ++m) _Pragma("unroll") for (int n = 0; n < 2; ++n) { \
        if constexpr (F8) acc[ai][bj][m][n] = __builtin_amdgcn_mfma_scale_f32_16x16x128_f8f6f4(GP_CAT8(Bt[n]), GP_CAT8(At[m]), acc[ai][bj][m][n], 0, 0, 0, 0, 0, 0); \
        else { _Pragma("unroll") for (int k = 0; k < 2; ++k) acc[ai][bj][m][n] = __builtin_amdgcn_mfma_f32_16x16x32_bf16(Bt[n][k], At[m][k], acc[ai][bj][m][n], 0, 0, 0); } } \
        __builtin_amdgcn_s_setprio(0); } while (0)
#define GP_WAIT_V(n) asm volatile("s_waitcnt vmcnt(" #n ")" ::: "memory")
#define GP_WAIT_L(n) asm volatile("s_waitcnt lgkmcnt(" #n ")" ::: "memory")
#define GP_BAR __builtin_amdgcn_s_barrier()
#define GP_SCHED __builtin_amdgcn_sched_barrier(0)
    Unit cur, nxt; int ui = 0;
    if (!S.next(0, cur)) return;
    f32x4 acc[2][2][4][2];
#pragma unroll
    for (int a = 0; a < 2; ++a)
#pragma unroll
        for (int b = 0; b < 2; ++b)
#pragma unroll
            for (int m = 0; m < 4; ++m)
#pragma unroll
                for (int n = 0; n < 2; ++n) acc[a][b][m][n] = (f32x4){0.f, 0.f, 0.f, 0.f};
    bf16x8 At[4][2], B0[2][2], B1[2][2];
    unsigned ac00, ac01, ac10, ac11, an00, an01, an10, an11;
    GP_AOFFS(cur, ac00, ac01, ac10, ac11);
    const char* cB = S.bptr(cur);
    GP_STAGE_B(GP_SB(0, 0), cB); GP_STAGE_B(GP_SB(0, 1), cB + hstep); GP_STAGE_A(GP_SA(0, 0), Abase, ac00, ac01); GP_STAGE_A(GP_SA(0, 1), Abase, ac10, ac11);
    if (wr == 1) GP_BAR;
    GP_WAIT_V(2); GP_BAR;
    GP_STAGE_B(GP_SB(1, 0), cB + kstep); GP_STAGE_A(GP_SA(1, 0), Abase + kstep, ac00, ac01); GP_STAGE_B(GP_SB(1, 1), cB + hstep + kstep);
    GP_WAIT_V(6); GP_BAR;
    for (;;) {
        const bool has_next = S.next(ui + 1, nxt);
        if (has_next) { GP_AOFFS(nxt, an00, an01, an10, an11); }
        else { an00 = ac00; an01 = ac01; an10 = ac10; an11 = ac11; }
        const char* nB = has_next ? S.bptr(nxt) : cB;
#pragma unroll 1
        for (int t = 0; t < nt; t += 2) {
            const bool last = (t == nt - 2);
            const char* a1 = Abase + (size_t)(t + 1) * kstep;
            const char* a2 = last ? Abase : Abase + (size_t)(t + 2) * kstep; const char* b2 = last ? nB : cB + (size_t)(t + 2) * kstep;
            const char* a3 = a2 + kstep; const char* b3 = b2 + kstep;
            asm volatile("" : "+s"(a1), "+s"(a2), "+s"(b2), "+s"(a3), "+s"(b3));
            GP_LDB(B0, 0, 0); GP_LDB(B1, 0, 1); GP_SCHED; GP_LDA(At, 0, 0); GP_STAGE_A(GP_SA(1, 1), a1, ac10, ac11);
            if (last) { ac00 = an00; ac01 = an01; ac10 = an10; ac11 = an11; }
            const bool relax = EST > 0 && ui > 0 && t == 0;
            if (relax) { static_assert(EST == 0 || EST == 16, "add a wait variant"); asm volatile("s_waitcnt vmcnt(24)" ::: "memory"); } else GP_WAIT_V(8);
            GP_WAIT_L(0); GP_BAR; GP_MMA(0, 0, At, B0); GP_MMA(0, 1, At, B1); GP_BAR; GP_SCHED;
            GP_LDA(At, 0, 1); GP_STAGE_B(GP_SB(0, 0), b2); GP_STAGE_B(GP_SB(0, 1), b2 + hstep); GP_STAGE_A(GP_SA(0, 0), a2, ac00, ac01);
            if (relax) asm volatile("s_waitcnt vmcnt(24)" ::: "memory"); else GP_WAIT_V(8);
            GP_WAIT_L(0); GP_BAR; GP_MMA(1, 0, At, B0); GP_MMA(1, 1, At, B1); GP_BAR; GP_SCHED;
            GP_LDB(B0, 1, 0); GP_LDB(B1, 1, 1); GP_SCHED; GP_LDA(At, 1, 0); GP_STAGE_A(GP_SA(0, 1), a2, ac10, ac11);
            GP_WAIT_V(8); GP_WAIT_L(0); GP_BAR; GP_MMA(0, 0, At, B0); GP_MMA(0, 1, At, B1); GP_BAR; GP_SCHED;
            GP_LDA(At, 1, 1); GP_STAGE_B(GP_SB(1, 0), b3); GP_STAGE_B(GP_SB(1, 1), b3 + hstep); GP_STAGE_A(GP_SA(1, 0), a3, ac00, ac01);
            GP_WAIT_V(8); GP_WAIT_L(0); GP_BAR; GP_MMA(1, 0, At, B0); GP_MMA(1, 1, At, B1); GP_BAR; GP_SCHED;
        }
        if constexpr (ALIGN_EPI) { if (wr == 0) GP_BAR; }
        { const int l_ = lane_id(); E(acc, cur, wr, wc, l_ & 15, l_ >> 4); }
        if (!has_next) break;
#pragma unroll
        for (int a = 0; a < 2; ++a)
#pragma unroll
            for (int b = 0; b < 2; ++b)
#pragma unroll
                for (int m = 0; m < 4; ++m)
#pragma unroll
                    for (int n = 0; n < 2; ++n) acc[a][b][m][n] = (f32x4){0.f, 0.f, 0.f, 0.f};
        cur = nxt; cB = nB; ++ui;
        if constexpr (ALIGN_EPI) { if (wr == 1) GP_BAR; }
    }
    GP_WAIT_V(0);
    if constexpr (!ALIGN_EPI) { if (wr == 0) GP_BAR; }
    GP_BAR;
#undef GP_AOFFS
#undef GP_SA
#undef GP_SB
#undef GP_STAGE_A
#undef GP_STAGE_B
#undef GP_LDA
#undef GP_LDB
#undef GP_MMA
#undef GP_CAT8
#undef GP_WAIT_V
#undef GP_WAIT_L
#undef GP_BAR
#undef GP_SCHED
}

struct DenseSched {
    int nM, nN, nwg, G, c, K; const char* Bt;
    __device__ __forceinline__ void init(int M, int N, int K_, const void* Bt_, int G_, int c_) { nM = M / BM; nN = N / BM; nwg = nM * nN; G = G_; c = c_; K = K_; Bt = (const char*)Bt_; }
    __device__ __forceinline__ bool next(int i, Unit& u) const {
        const long L = (long)i * G + c; if (L >= nwg) return false;
        int wgid = (int)L; { const int q = nwg / 8, r = nwg % 8, xcd = wgid % 8, off = wgid / 8; wgid = (xcd < r ? xcd * (q + 1) : r * (q + 1) + (xcd - r) * q) + off; }
        const int nig = 8 * nN, gid = wgid / nig, fm = gid * 8, gsz = (nM - fm) < 8 ? (nM - fm) : 8;
        u.pm = fm + ((wgid % nig) % gsz); u.pn = (wgid % nig) / gsz; u.e = 0; u.b = 0; u.cnt = 0; u.base = 0; return true;
    }
    __device__ __forceinline__ unsigned arow(const Unit& u, int r) const { return (unsigned)(u.pm * BM + r) * (unsigned)(K * 2); }
    __device__ __forceinline__ const char* bptr(const Unit& u) const { return Bt + (size_t)u.pn * BM * K * 2; }
};
}

struct EpiInProj {
    bf16_t* F; bf16_t* Q; bf16_t* Kb; bf16_t* Vb; const float* rope;
    __device__ __forceinline__ void operator()(const f32x4 (&acc)[2][2][4][2], const gp::Unit& u, int wr, int wc, int fr, int fq) const {
        const int pn = u.pn, pm = u.pm; const bool isctx = pm >= T / 256;
        if (isctx && pn < 4) return;
        if (pn >= 7) {
            unsigned char* V8 = (unsigned char*)Vb;
#pragma unroll
            for (int ai = 0; ai < 2; ++ai) {
                const int row0 = pm * 256 + ai * 128 + wr * 64;
                int b, tile;
                if (!isctx) { b = row0 >> 13; tile = (CTX >> 6) + ((row0 & 8191) >> 6); } else { const int j = row0 - T; b = j >> 8; tile = (j & 255) >> 6; }
#pragma unroll
                for (int bj = 0; bj < 2; ++bj) {
                    const int head = (pn - 7) * 2 + bj;
                    unsigned char* dst = V8 + ((size_t)(b * NH + head) * (KVLEN / 64) + tile) * 8192 + wc * 2048 + fq * 64 + (fr >> 3) * 32 + (fr & 1) * 16 + ((fr >> 1) & 3) * 4;
#pragma unroll
                    for (int e = 0; e < 8; ++e) {
                        int w = __builtin_amdgcn_cvt_pk_fp8_f32(acc[ai][bj][0][e >> 2][e & 3], acc[ai][bj][1][e >> 2][e & 3], 0, false);
                        w = __builtin_amdgcn_cvt_pk_fp8_f32(acc[ai][bj][2][e >> 2][e & 3], acc[ai][bj][3][e >> 2][e & 3], w, true);
                        gp::gst1(dst + e * 256, (unsigned)w);
                    }
                }
            }
            return;
        }
        const int axis = wc & 1; const float* ct = rope + (axis ? 4096 : 0); const float* st = rope + (axis ? 4096 + 1024 : 2048);
#pragma unroll
        for (int ai = 0; ai < 2; ++ai)
#pragma unroll
            for (int m = 0; m < 4; ++m) {
                const int row = pm * 256 + ai * 128 + wr * 64 + m * 16 + fr;
                int t, kb, tile;
                if (!isctx) { kb = row >> 13; t = row & 8191; tile = (CTX >> 6) + (t >> 6); } else { const int j = row - T; t = 0; kb = j >> 8; tile = (j & 255) >> 6; }
                const int pos = axis ? (t & 63) : (t >> 6);
#pragma unroll
                for (int bj = 0; bj < 2; ++bj) {
                    const int col0 = pn * 256 + bj * 128 + wc * 32 + fq * 8;
                    f32x4 v0 = acc[ai][bj][m][0], v1 = acc[ai][bj][m][1];
                    if (pn == 0) { gp::u32x4 w; w.x = gp::cvt_pk_bf16(v0[0], v0[1]); w.y = gp::cvt_pk_bf16(v0[2], v0[3]); w.z = gp::cvt_pk_bf16(v1[0], v1[1]); w.w = gp::cvt_pk_bf16(v1[2], v1[3]);
                        gp::gst4(F + (size_t)row * 256 + col0, w); continue; }
                    if (pn < 7 && !isctx) {
                        const f32x4 c0 = gp::gld4f(ct + pos * 16 + 8 * (fq & 1)), c1 = gp::gld4f(ct + pos * 16 + 8 * (fq & 1) + 4);
                        const f32x4 s0 = gp::gld4f(st + pos * 16 + 8 * (fq & 1)), s1 = gp::gld4f(st + pos * 16 + 8 * (fq & 1) + 4);
                        const float sg = (fq < 2) ? -1.f : 1.f;
#pragma unroll
                        for (int i = 0; i < 4; ++i) {
                            const auto r0 = __builtin_amdgcn_permlane32_swap(__float_as_uint(v0[i]), __float_as_uint(v0[i]), false, false);
                            const auto r1 = __builtin_amdgcn_permlane32_swap(__float_as_uint(v1[i]), __float_as_uint(v1[i]), false, false);
                            const float p0 = __uint_as_float(fq < 2 ? r0[1] : r0[0]), p1 = __uint_as_float(fq < 2 ? r1[1] : r1[0]);
                            v0[i] = v0[i] * c0[i] + sg * p0 * s0[i]; v1[i] = v1[i] * c1[i] + sg * p1 * s1[i]; }
                    }
                    v0 = v0 * SQS; v1 = v1 * SQS;
                    int w0 = __builtin_amdgcn_cvt_pk_fp8_f32(v0[0], v0[1], 0, false); w0 = __builtin_amdgcn_cvt_pk_fp8_f32(v0[2], v0[3], w0, true);
                    int w1 = __builtin_amdgcn_cvt_pk_fp8_f32(v1[0], v1[1], 0, false); w1 = __builtin_amdgcn_cvt_pk_fp8_f32(v1[2], v1[3], w1, true);
                    unsigned char* d;
                    if (pn < 4) d = (unsigned char*)Q + (size_t)row * QKW + (col0 - 256);
                    else d = (unsigned char*)Kb + ((size_t)(kb * NH + (pn - 4) * 2 + bj) * (KVLEN / 64) + tile) * 8192 + wc * 2048 + m * 512 + fr * 32 + fq * 8;
                    gp::gst2(d, (unsigned)w0, (unsigned)w1);
                }
            }
    }
};
struct EpiStoreBf16 {
    bf16_t* O; int ldc;
    __device__ __forceinline__ void operator()(const f32x4 (&acc)[2][2][4][2], const gp::Unit& u, int wr, int wc, int fr, int fq) const {
#pragma unroll
        for (int ai = 0; ai < 2; ++ai)
#pragma unroll
            for (int m = 0; m < 4; ++m) {
                bf16_t* rowp = O + (size_t)(u.pm * 256 + ai * 128 + wr * 64 + m * 16 + fr) * ldc + u.pn * 256 + wc * 32 + fq * 8;
#pragma unroll
                for (int bj = 0; bj < 2; ++bj) { const f32x4 v0 = acc[ai][bj][m][0], v1 = acc[ai][bj][m][1];
                    gp::u32x4 w; w.x = gp::cvt_pk_bf16(v0[0], v0[1]); w.y = gp::cvt_pk_bf16(v0[2], v0[3]); w.z = gp::cvt_pk_bf16(v1[0], v1[1]); w.w = gp::cvt_pk_bf16(v1[2], v1[3]);
                    gp::gst4(rowp + bj * 128, w); }
            }
    }
};

__device__ __forceinline__ void ph_inproj(const Params& p, unsigned char* smem) {
    unsigned char* ws = p.ws;
    gp::DenseSched S; S.init(MTOT, INW, D, ws + WS_WINT, gridDim.x, blockIdx.x);
    EpiInProj E{(bf16_t*)(ws + WS_F), (bf16_t*)(ws + WS_Q), (bf16_t*)(ws + WS_K), (bf16_t*)(ws + WS_V), (const float*)(ws + WS_ROPE)};
    gp::gemm_phase<EpiInProj, gp::DenseSched, true>(p.chunk, (GP_LAS unsigned char*)smem, (const char*)(ws + WS_HX), D, S, E);
}
__device__ __forceinline__ void ph_outproj(const Params& p, unsigned char* smem) {
    unsigned char* ws = p.ws;
    gp::DenseSched S; S.init(T, D, D, ws + WS_WOUTT, gridDim.x, blockIdx.x);
    EpiStoreBf16 E{(bf16_t*)(ws + WS_YX), D};
    gp::gemm_phase<EpiStoreBf16, gp::DenseSched, true>(p.chunk, (GP_LAS unsigned char*)smem, (const char*)(ws + WS_AO), D, S, E);
}

constexpr float GUSCALE = 64.f;
constexpr float WDSCALE = 16.f, ASCALE = 4.f;
struct TItem8 { const float* W; unsigned char* WT; int K, N, row_base, k0, n0; float sc; };
__device__ __forceinline__ void titem8_load(const TItem8& t, float (&tv)[32], int lane) {
#pragma unroll
    for (int i = 0; i < 32; ++i) tv[i] = t.W[(size_t)(t.k0 + 2 * i + (lane >> 5)) * t.N + t.n0 + (lane & 31)];
}
__device__ __forceinline__ void titem8_finish(const TItem8& t, const float (&tv)[32], float* scr, int lane) {
#pragma unroll
    for (int i = 0; i < 32; ++i) scr[(2 * i + (lane >> 5)) * 33 + (lane & 31)] = tv[i] * t.sc;
    asm volatile("s_waitcnt lgkmcnt(0)" ::: "memory");
    const int c = lane & 7;
#pragma unroll
    for (int j = 0; j < 4; ++j) { const int n = (lane >> 3) + 8 * j; const float* s = scr + (8 * c) * 33 + n;
        int w0 = __builtin_amdgcn_cvt_pk_fp8_f32(s[0 * 33], s[1 * 33], 0, false); w0 = __builtin_amdgcn_cvt_pk_fp8_f32(s[2 * 33], s[3 * 33], w0, true);
        int w1 = __builtin_amdgcn_cvt_pk_fp8_f32(s[4 * 33], s[5 * 33], 0, false); w1 = __builtin_amdgcn_cvt_pk_fp8_f32(s[6 * 33], s[7 * 33], w1, true);
        uint2 o; o.x = (unsigned)w0; o.y = (unsigned)w1;
        *(uint2*)(t.WT + (size_t)(t.row_base + t.n0 + n) * t.K + t.k0 + 8 * c) = o; }
    asm volatile("s_waitcnt lgkmcnt(0)" ::: "memory");
}
__device__ __forceinline__ void transpose_item(const float* W, int K, int N, bf16_t* WT, int row_base, int kb, int nb, float* scr, int lane) {
    const int k0 = 64 * kb, n0 = 32 * nb;
    float tv[32];
#pragma unroll
    for (int i = 0; i < 32; ++i) tv[i] = W[(size_t)(k0 + 2 * i + (lane >> 5)) * N + n0 + (lane & 31)];
#pragma unroll
    for (int i = 0; i < 32; ++i) scr[(2 * i + (lane >> 5)) * 33 + (lane & 31)] = tv[i];
    asm volatile("s_waitcnt lgkmcnt(0)" ::: "memory");
    const int c = lane & 7;
#pragma unroll
    for (int j = 0; j < 4; ++j) { const int n = (lane >> 3) + 8 * j; const float* s = scr + (8 * c) * 33 + n;
        uint4 o; o.x = pk2(s[0 * 33], s[1 * 33]); o.y = pk2(s[2 * 33], s[3 * 33]); o.z = pk2(s[4 * 33], s[5 * 33]); o.w = pk2(s[6 * 33], s[7 * 33]);
        *(uint4*)(WT + (size_t)(row_base + n0 + n) * K + k0 + 8 * c) = o; }
    asm volatile("s_waitcnt lgkmcnt(0)" ::: "memory");
}
__device__ __forceinline__ void ph_prep_weights(const Params& p, float* lds, const int part, const int first) {
    const int tid = otid(), wave = tid >> 6, lane = tid & 63;
    float* scr = lds + 8192 + wave * (64 * 33);
    if ((int)blockIdx.x < first) return;
    const int gw = ((int)blockIdx.x - first) * NWV + wave, GW = ((int)gridDim.x - first) * NWV;
    unsigned char* ws = p.ws;
    constexpr int I_IN = 16 * 80, I_OUT = 16 * 32, I_GU = 16 * 8, I_D = 4 * 32;
    constexpr int NITEMS = I_IN + I_OUT + 65 * (2 * I_GU + I_D);
    const int it_lo = part ? I_IN + I_OUT : 0, it_hi = part ? NITEMS : I_IN + I_OUT;
    if (part == 0) {
        for (int it = it_lo + gw; it < it_hi; it += GW) {
            int r = it;
            if (r < I_IN) { transpose_item(p.in[I_WIN], D, INW, (bf16_t*)(ws + WS_WINT), 0, r / 80, r % 80, scr, lane); continue; } r -= I_IN;
            transpose_item(p.in[I_WOUT], D, D, (bf16_t*)(ws + WS_WOUTT), 0, r / 32, r % 32, scr, lane);
        }
        return;
    }
    auto decode = [&](int it, TItem8& t) {
        int r = it - (I_IN + I_OUT);
        const int e = r / (2 * I_GU + I_D); r -= e * (2 * I_GU + I_D);
        if (r < 2 * I_GU) {
            const int half = r / I_GU, q = r % I_GU, kb = q / 8, nb = q % 8;
            t.W = (e < 64) ? p.in[half ? I_WU : I_WG] + (size_t)e * D * DE : p.in[half ? I_WSU : I_WSG];
            const int n0 = 32 * nb, drow = e * 512 + (n0 >> 7) * 256 + half * 128 + (n0 & 127);
            t.WT = ws + WS_WGUT; t.K = D; t.N = DE; t.row_base = drow - n0; t.k0 = 64 * kb; t.n0 = n0; t.sc = GUSCALE;
        } else {
            r -= 2 * I_GU;
            t.W = (e < 64) ? p.in[I_WD] + (size_t)e * DE * D : p.in[I_WSD];
            t.WT = ws + WS_WDT; t.K = DE; t.N = D; t.row_base = e * 1024; t.k0 = 64 * (r / 32); t.n0 = 32 * (r % 32); t.sc = WDSCALE;
        }
    };
    int it = it_lo + gw;
    if (it >= it_hi) return;
    TItem8 ta, tb; float va[32], vb[32];
    decode(it, ta); titem8_load(ta, va, lane);
    for (;;) {
        const bool hb = it + GW < it_hi;
        if (hb) { decode(it + GW, tb); titem8_load(tb, vb, lane); }
        titem8_finish(ta, va, scr, lane);
        if (!hb) break;
        const bool ha = it + 2 * GW < it_hi;
        if (ha) { decode(it + 2 * GW, ta); titem8_load(ta, va, lane); }
        titem8_finish(tb, vb, scr, lane);
        if (!ha) break;
        it += 2 * GW;
    }
}

namespace fa {
typedef short bf16x8 __attribute__((ext_vector_type(8)));
typedef short s16x4 __attribute__((ext_vector_type(4)));
typedef float f32x16 __attribute__((ext_vector_type(16)));
typedef unsigned u32x4 __attribute__((ext_vector_type(4)));
constexpr int KVBLK = 64, LDK = QKW;
constexpr float SCALE = 0.125f, THR = 8.f;
constexpr size_t SHM_V = KVBLK * 128 * 2, SHM_K = KVBLK * 128 * 2;
#define KSWZ(row, colB) ((row) * 256 + ((colB) ^ (((row) & 15) << 4)))
#define SBAR() __builtin_amdgcn_sched_barrier(0)
__device__ __forceinline__ int crow(int r, int hi) { return (r & 3) + 8 * (r >> 2) + 4 * hi; }
__device__ __forceinline__ unsigned cvtpk(float lo, float hi) { unsigned r; asm volatile("v_cvt_pk_bf16_f32 %0, %1, %2" : "=v"(r) : "v"(lo), "v"(hi)); return r; }
constexpr float PBIAS = 5.f, THR2 = PBIAS + 3.5f;
template <bool FIRST>
__device__ __forceinline__ void partialSM(f32x16& p0, f32x16& p1, float& m_reg, f32x16& negm, float& alpha) {
  float pmax = p0[0];
#pragma unroll
  for (int r = 1; r < 16; ++r) pmax = fmaxf(pmax, p0[r]);
#pragma unroll
  for (int r = 0; r < 16; ++r) pmax = fmaxf(pmax, p1[r]);
  { auto rr = __builtin_amdgcn_permlane32_swap(__float_as_uint(pmax), __float_as_uint(pmax), false, false);
    pmax = fmaxf(__uint_as_float(rr[0]), __uint_as_float(rr[1])); }
  if (!FIRST && __builtin_expect(__all(pmax <= THR2), 1)) { alpha = 1.f; }
  else { const float dl = FIRST ? pmax - PBIAS : fmaxf(pmax - PBIAS, 0.f); alpha = FIRST ? 0.f : __builtin_amdgcn_exp2f(-dl); m_reg += dl;
#pragma unroll
    for (int r = 0; r < 16; ++r) { p0[r] -= dl; p1[r] -= dl; }
#pragma unroll
    for (int r = 0; r < 16; ++r) negm[r] = -m_reg;
    asm volatile("" : "+v"(negm)); }
#pragma unroll
  for (int r = 0; r < 16; ++r) p0[r] = __builtin_amdgcn_exp2f(p0[r]);
}
typedef int i32x8 __attribute__((ext_vector_type(8)));
__device__ __forceinline__ int pk4_fp8(float a, float b, float c, float d) { int w; asm("v_cvt_pk_fp8_f32 %0, %1, %2" : "=v"(w) : "v"(a), "v"(b)); asm("v_cvt_pk_fp8_f32 %0, %1, %2 op_sel:[0,0,1]" : "+v"(w) : "v"(c), "v"(d)); return w; }
__device__ __forceinline__ void finishSM_T(f32x16& p0, f32x16& p1, i32x8& pb) {
#pragma unroll
  for (int r = 0; r < 16; ++r) p1[r] = __builtin_amdgcn_exp2f(p1[r]);
#pragma unroll
  for (int g = 0; g < 4; ++g) {
    pb[g] = pk4_fp8(p0[4 * g], p0[4 * g + 1], p0[4 * g + 2], p0[4 * g + 3]); pb[4 + g] = pk4_fp8(p1[4 * g], p1[4 * g + 1], p1[4 * g + 2], p1[4 * g + 3]); }
}
__device__ __forceinline__ void qkt(f32x16& p0, f32x16& p1, const char* Ks, const i32x8 qf, int lane, int mm, const f32x16& negm) {
  const char* kp = Ks + mm * 4096 + lane * 16;
  const u32x4 a0 = *reinterpret_cast<const u32x4*>(kp), a1 = *reinterpret_cast<const u32x4*>(kp + 1024), b0 = *reinterpret_cast<const u32x4*>(kp + 2048), b1 = *reinterpret_cast<const u32x4*>(kp + 3072);
  p0 = __builtin_amdgcn_mfma_scale_f32_32x32x64_f8f6f4((i32x8){(int)a0.x, (int)a0.y, (int)a0.z, (int)a0.w, (int)a1.x, (int)a1.y, (int)a1.z, (int)a1.w}, qf, negm, 0, 0, 0, 0, 0, 0);
  p1 = __builtin_amdgcn_mfma_scale_f32_32x32x64_f8f6f4((i32x8){(int)b0.x, (int)b0.y, (int)b0.z, (int)b0.w, (int)b1.x, (int)b1.y, (int)b1.z, (int)b1.w}, qf, negm, 0, 0, 0, 0, 0, 0);
}
__device__ __forceinline__ int v_st(int k, int c) { const int kk = (k & ~0xC) | ((k & 4) << 1) | ((k & 8) >> 1); return ((kk >> 3) * 4 + (c >> 5)) * 512 + ((kk & 7) * 32 + (c & 31)) * 2; }
__device__ __forceinline__ int v_rd_base(int lane) { return ((lane & 3) << 3) | (((lane >> 2) & 3) << 6) | (((lane >> 4) & 1) << 5) | (((lane >> 5) & 1) << 8); }
constexpr int v_rd_off(int d0, int ks, int half) { return d0 * 512 + ks * 4096 + half * 2048; }
template <int OFF> __device__ __forceinline__ s16x4 tr_read(int vb) {
  s16x4 r; asm volatile("ds_read_b64_tr_b16 %0, %1 offset:%2" : "=&v"(r) : "v"(vb), "i"(OFF) : "memory"); return r;
}
template <int D0> __device__ __forceinline__ void pv_one(f32x16& od, int vb, bf16x8 pa0, bf16x8 pa1, bf16x8 pa2, bf16x8 pa3) {
  const s16x4 l0 = tr_read<v_rd_off(D0, 0, 0)>(vb), h0 = tr_read<v_rd_off(D0, 0, 1)>(vb), l1 = tr_read<v_rd_off(D0, 1, 0)>(vb), h1 = tr_read<v_rd_off(D0, 1, 1)>(vb);
  const s16x4 l2 = tr_read<v_rd_off(D0, 2, 0)>(vb), h2 = tr_read<v_rd_off(D0, 2, 1)>(vb), l3 = tr_read<v_rd_off(D0, 3, 0)>(vb), h3 = tr_read<v_rd_off(D0, 3, 1)>(vb);
  asm volatile("s_waitcnt lgkmcnt(0)" ::: "memory"); SBAR();
#define PK(L, H) (bf16x8){L[0], L[1], L[2], L[3], H[0], H[1], H[2], H[3]}
  od = __builtin_amdgcn_mfma_f32_32x32x16_bf16(pa0, PK(l0, h0), od, 0, 0, 0);
  od = __builtin_amdgcn_mfma_f32_32x32x16_bf16(pa1, PK(l1, h1), od, 0, 0, 0);
  od = __builtin_amdgcn_mfma_f32_32x32x16_bf16(pa2, PK(l2, h2), od, 0, 0, 0);
  od = __builtin_amdgcn_mfma_f32_32x32x16_bf16(pa3, PK(l3, h3), od, 0, 0, 0);
#undef PK
}
__device__ __forceinline__ void pv_d0(f32x16* o, int vb, bf16x8 pa0, bf16x8 pa1, bf16x8 pa2, bf16x8 pa3) {
  pv_one<0>(o[0], vb, pa0, pa1, pa2, pa3); pv_one<1>(o[1], vb, pa0, pa1, pa2, pa3); pv_one<2>(o[2], vb, pa0, pa1, pa2, pa3); pv_one<3>(o[3], vb, pa0, pa1, pa2, pa3);
}

template <int OFF> __device__ __forceinline__ u32x4 rd128(int vb) { u32x4 r; asm volatile("ds_read_b128 %0, %1 offset:%2" : "=&v"(r) : "v"(vb), "i"(OFF) : "memory"); return r; }
#define PV_RD(D0) const u32x4 va##D0 = rd128<D0 * 2048>(vb), vc##D0 = rd128<D0 * 2048 + 1024>(vb); SBAR()
#define PV_MM(D0) do { asm volatile("s_waitcnt lgkmcnt(0)" ::: "memory"); SBAR(); \
    o[D0] = __builtin_amdgcn_mfma_scale_f32_32x32x64_f8f6f4((i32x8){(int)va##D0.x, (int)va##D0.y, (int)va##D0.z, (int)va##D0.w, (int)vc##D0.x, (int)vc##D0.y, (int)vc##D0.z, (int)vc##D0.w}, pb, o[D0], 0, 0, 0, 0, 0, 0); } while (0)
__device__ __forceinline__ float max3f(float a, float b, float c) { float r; asm("v_max3_f32 %0, %1, %2, %3" : "=v"(r) : "v"(a), "v"(b), "v"(c)); return r; }
#define PV_LSUM() lacc = __builtin_amdgcn_mfma_scale_f32_32x32x64_f8f6f4((i32x8){0x38383838, 0x38383838, 0x38383838, 0x38383838, 0x38383838, 0x38383838, 0x38383838, 0x38383838}, pb, lacc, 0, 0, 0, 0, 0, 0)
__device__ __forceinline__ void pv_psm(f32x16* o, f32x16& lacc, int vb, i32x8 pb, f32x16& p0, f32x16& p1, float& m_reg, f32x16& negm, float& alpha) {
  float pmax;
  { PV_RD(0);
    pmax = max3f(p0[0], p0[1], p0[2]);
#pragma unroll
    for (int r = 3; r < 15; r += 2) pmax = max3f(pmax, p0[r], p0[r + 1]);
    pmax = max3f(pmax, p0[15], p1[0]);
    SBAR(); PV_MM(0); }
  { PV_RD(1);
#pragma unroll
    for (int r = 1; r < 15; r += 2) pmax = max3f(pmax, p1[r], p1[r + 1]);
    pmax = max3f(pmax, p1[15], p1[15]);
    { auto rr = __builtin_amdgcn_permlane32_swap(__float_as_uint(pmax), __float_as_uint(pmax), false, false);
      pmax = max3f(__uint_as_float(rr[0]), __uint_as_float(rr[1]), __uint_as_float(rr[1])); }
    if (__builtin_expect(__all(pmax <= THR2), 1)) { alpha = 1.f; }
    else { const float dl = fmaxf(pmax - PBIAS, 0.f); alpha = __builtin_amdgcn_exp2f(-dl); m_reg += dl;
#pragma unroll
      for (int r = 0; r < 16; ++r) { p0[r] -= dl; p1[r] -= dl; }
#pragma unroll
      for (int r = 0; r < 16; ++r) negm[r] = -m_reg;
      asm volatile("" : "+v"(negm)); }
    SBAR(); PV_MM(1); }
  { PV_RD(2);
#pragma unroll
    for (int r = 0; r < 8; ++r) p0[r] = __builtin_amdgcn_exp2f(p0[r]);
    asm volatile("" : "+v"(p0));
    SBAR(); PV_MM(2); }
  { PV_RD(3);
#pragma unroll
    for (int r = 8; r < 16; ++r) p0[r] = __builtin_amdgcn_exp2f(p0[r]);
    asm volatile("" : "+v"(p0));
    SBAR(); PV_MM(3); PV_LSUM(); }
}
__device__ __forceinline__ void pvT_d0(f32x16* o, f32x16& lacc, int vb, i32x8 pb) {
  { PV_RD(0); PV_MM(0); } { PV_RD(1); PV_MM(1); } { PV_RD(2); PV_MM(2); } { PV_RD(3); PV_MM(3); PV_LSUM(); }
}
#undef PV_RD
#undef PV_MM
#undef PV_LSUM

__device__ __forceinline__ void attn_unit(const unsigned char* __restrict__ Qb, const unsigned char* __restrict__ Kh, const unsigned char* __restrict__ Vh, bf16_t* __restrict__ Ob,
                                          const float* __restrict__ gsub, const float lam, char* lds, const int wv) {
  typedef __attribute__((address_space(3))) unsigned* ldsu_t;
  const int tid = otid_w(wv), wid = wv, lane = tid & 63, r32 = lane & 31, hi = lane >> 5, mm = wid >> 2, wq = wid & 3;
  constexpr int NB = 4;
  constexpr int SHM_V8 = KVBLK * 128;
  char* V_lds = lds; char* K_lds = lds + NB * SHM_V8; constexpr int SHM_K8 = KVBLK * 128;
  float m_reg = 0.f; f32x16 o[4] = {}; f32x16 lacc = {}; i32x8 qf; f32x16 negm = {}; asm volatile("" : "+v"(negm));
  const unsigned koff = (unsigned)((2 * (wid >> 2) + (lane >> 5)) * 2048 + (lane & 3) * 512 + (8 * ((wid >> 1) & 1) + 2 * ((lane & 31) >> 3) + ((lane >> 2) & 1)) * 32 + (wid & 1) * 16);
  const unsigned voff = (unsigned)((wid >> 1) * 2048 + (lane & 7) * 256 + ((lane >> 3) & 3) * 64 + (wid & 1) * 32 + (lane >> 5) * 16);
#define DMA(t, buf) do { const char* kb_ = (const char*)(Kh + (size_t)(t) * SHM_K8); const char* vb_ = (const char*)(Vh + (size_t)(t) * SHM_V8); asm volatile("" : "+s"(kb_), "+s"(vb_)); \
    __builtin_amdgcn_global_load_lds((const unsigned*)(kb_ + koff), (ldsu_t)(K_lds + (buf) * SHM_K8 + wid * 1024), 16, 0, 0); \
    __builtin_amdgcn_global_load_lds((const unsigned*)(vb_ + voff), (ldsu_t)(V_lds + (buf) * SHM_V8 + wid * 1024), 16, 0, 0); } while (0)
#define WAIT_BAR(N) asm volatile("s_waitcnt vmcnt(" #N ") lgkmcnt(0)\n\ts_barrier" ::: "memory")
#define RESC(a) do { if (__any((a) < 1.f)) { _Pragma("unroll") for (int d = 0; d < 4; ++d) _Pragma("unroll") for (int r = 0; r < 16; ++r) o[d][r] *= (a); lacc[0] *= (a); } } while (0)
  DMA(0, 0); DMA(1, 1);
  { const unsigned char* Qw = Qb + (long)(wq * 32 + r32) * QKW + mm * 64 + hi * 32;
    const u32x4 q0 = *reinterpret_cast<const u32x4*>(Qw), q1 = *reinterpret_cast<const u32x4*>(Qw + 16);
    qf = (i32x8){(int)q0.x, (int)q0.y, (int)q0.z, (int)q0.w, (int)q1.x, (int)q1.y, (int)q1.z, (int)q1.w}; }
  const int vb0 = (int)(uintptr_t)V_lds + lane * 16;
  f32x16 pA0, pA1, pB0, pB1; float alA, alB; i32x8 pb; constexpr int NTL = KVLEN / KVBLK;
  WAIT_BAR(0);
  DMA(2, 2);
  qkt(pA0, pA1, K_lds, qf, lane, mm, negm); partialSM<true>(pA0, pA1, m_reg, negm, alA);
  WAIT_BAR(2);
  for (int j = 1; j + 1 < NTL; j += 2) {
    DMA(j + 2, (j + 2) & 3);
    SBAR(); qkt(pB0, pB1, K_lds + (j & 3) * SHM_K8, qf, lane, mm, negm);
    finishSM_T(pA0, pA1, pb); SBAR();
    pv_psm(o, lacc, vb0 + ((j - 1) & 3) * SHM_V8, pb, pB0, pB1, m_reg, negm, alB);
    RESC(alB);
    WAIT_BAR(2);
    if (j + 3 < NTL) DMA(j + 3, (j + 3) & 3);
    SBAR(); qkt(pA0, pA1, K_lds + ((j + 1) & 3) * SHM_K8, qf, lane, mm, negm);
    finishSM_T(pB0, pB1, pb); SBAR();
    pv_psm(o, lacc, vb0 + (j & 3) * SHM_V8, pb, pA0, pA1, m_reg, negm, alA);
    RESC(alA);
    if (j + 3 < NTL) WAIT_BAR(2); else WAIT_BAR(0);
  }
  SBAR(); qkt(pB0, pB1, K_lds + ((NTL - 1) & 3) * SHM_K8, qf, lane, mm, negm);
  finishSM_T(pA0, pA1, pb); SBAR();
  pv_psm(o, lacc, vb0 + ((NTL - 2) & 3) * SHM_V8, pb, pB0, pB1, m_reg, negm, alB);
  RESC(alB);
  finishSM_T(pB0, pB1, pb); SBAR();
  pvT_d0(o, lacc, vb0 + ((NTL - 1) & 3) * SHM_V8, pb);
#undef DMA
#undef WAIT_BAR
  const float rl = __builtin_amdgcn_rcpf(lacc[0]) * (mm ? lam : 1.0f);
  __syncthreads();
  constexpr int XS = 132;
  float* X = (float*)lds;
  if (mm == 1) {
#pragma unroll
    for (int r = 0; r < 16; ++r)
#pragma unroll
      for (int d0 = 0; d0 < 4; ++d0) X[(wq * 32 + r32) * XS + d0 * 32 + crow(r, hi)] = o[d0][r] * rl;
  }
  __syncthreads();
  if (mm == 0) {
#pragma unroll
    for (int r = 0; r < 16; ++r)
#pragma unroll
      for (int d0 = 0; d0 < 4; ++d0) { float* xp = X + (wq * 32 + r32) * XS + d0 * 32 + crow(r, hi); *xp = o[d0][r] * rl - *xp; }
  }
  __syncthreads();
  {
    const int row = tid >> 2, seg = tid & 3;
    const float* xr = X + row * XS + seg * 32;
    f32x4 v[8]; float ss = 0.f;
#pragma unroll
    for (int i = 0; i < 8; ++i) { v[i] = *(const f32x4*)(xr + 4 * i); ss += v[i][0] * v[i][0] + v[i][1] * v[i][1] + v[i][2] * v[i][2] + v[i][3] * v[i][3]; }
    ss += sx<1>(ss); ss += sx<2>(ss);
    const float rs = (1.0f - LAM_INIT) / sqrtf(ss * (1.0f / 128.0f) + EPS);
    bf16_t* dst = Ob + (long)row * D + seg * 32;
#pragma unroll
    for (int i = 0; i < 8; i += 2) {
      const f32x4 g0 = *(const f32x4*)(gsub + seg * 32 + 4 * i), g1 = *(const f32x4*)(gsub + seg * 32 + 4 * i + 4);
      u32x4 w; w.x = cvtpk(v[i][0] * rs * g0[0], v[i][1] * rs * g0[1]); w.y = cvtpk(v[i][2] * rs * g0[2], v[i][3] * rs * g0[3]);
      w.z = cvtpk(v[i + 1][0] * rs * g1[0], v[i + 1][1] * rs * g1[1]); w.w = cvtpk(v[i + 1][2] * rs * g1[2], v[i + 1][3] * rs * g1[3]);
      *(u32x4*)(dst + 4 * i) = w;
    }
  }
  __syncthreads();
#undef RESC
}
#undef KSWZ
#undef SBAR
}

__device__ __forceinline__ void ph_attn(const Params& p, unsigned char* smem) {
    unsigned char* ws = p.ws;
    const unsigned char* Q = ws + WS_Q; const unsigned char* Kb = ws + WS_K; const unsigned char* Vb = ws + WS_V;
    bf16_t* AO = (bf16_t*)(ws + WS_AO);
    const float lam = ((const float*)(ws + WS_CTL))[1024];
    const int c = blockIdx.x, G = gridDim.x;
    if (G == 256) {
        const int x = c & 7, s = c >> 3;
        for (int rd = 0; rd < 6; ++rd) {
            const int bh = rd * 4 + (x >> 1), qb = (x & 1) * 32 + s, b = bh / NH, h = bh % NH;
            fa::attn_unit(Q + ((size_t)b * SEQ + qb * 128) * QKW + h * 128, Kb + (size_t)(b * NH + h) * (KVLEN / 64) * 8192, Vb + (size_t)(b * NH + h) * (KVLEN / 64) * 8192,
                          AO + ((size_t)b * SEQ + qb * 128) * D + 256 + h * 128, p.in[I_GSUB], lam, (char*)smem, p.chunk);
        }
    } else {
        for (int u = c; u < BATCH * NH * 64; u += G) {
            const int bh = u >> 6, qb = u & 63, b = bh / NH, h = bh % NH;
            fa::attn_unit(Q + ((size_t)b * SEQ + qb * 128) * QKW + h * 128, Kb + (size_t)(b * NH + h) * (KVLEN / 64) * 8192, Vb + (size_t)(b * NH + h) * (KVLEN / 64) * 8192,
                          AO + ((size_t)b * SEQ + qb * 128) * D + 256 + h * 128, p.in[I_GSUB], lam, (char*)smem, p.chunk);
        }
    }
}

__device__ __forceinline__ void ph_fourierA(const Params& p, unsigned char* smem) {
    using namespace fa;
    unsigned char* ws = p.ws;
    const bf16_t* F = (const bf16_t*)(ws + WS_F); bf16_t* FY = (bf16_t*)(ws + WS_FY); const bf16_t* W = (const bf16_t*)(ws + WS_W128E);
    const int tid = otid(), wid = tid >> 6, lane = tid & 63, r32 = lane & 31, hi = lane >> 5;
    const int sr = tid >> 4, sc = (tid & 15) * 8, vst0 = v_st(sr, sc), vst1 = v_st(32 + sr, sc);
    const int vb0 = (int)(uintptr_t)smem + v_rd_base(lane);
    for (int task = blockIdx.x; task < BATCH * 64; task += gridDim.x) {
        const int b = task >> 6, n2 = task & 63;
        bf16x8 st[4][2];
#pragma unroll
        for (int kt = 0; kt < 2; ++kt)
#pragma unroll
            for (int ct = 0; ct < 2; ++ct) {
                st[kt * 2 + ct][0] = *(const bf16x8*)(F + ((size_t)b * SEQ + 64 * (64 * kt + sr) + n2) * 256 + 128 * ct + sc);
                st[kt * 2 + ct][1] = *(const bf16x8*)(F + ((size_t)b * SEQ + 64 * (64 * kt + 32 + sr) + n2) * 256 + 128 * ct + sc);
            }
        bf16x8 pa[2][4];
#pragma unroll
        for (int kt = 0; kt < 2; ++kt)
#pragma unroll
            for (int ks = 0; ks < 4; ++ks) pa[kt][ks] = *(const bf16x8*)(W + (size_t)(32 * wid + r32) * 128 + 64 * kt + 16 * ks + 8 * hi);
        __syncthreads();
#pragma unroll
        for (int q = 0; q < 4; ++q) { *(bf16x8*)(smem + q * 16384 + vst0) = st[q][0]; *(bf16x8*)(smem + q * 16384 + vst1) = st[q][1]; }
        __syncthreads();
        f32x16 o[2][4] = {};
#pragma unroll
        for (int ct = 0; ct < 2; ++ct)
#pragma unroll
            for (int kt = 0; kt < 2; ++kt) pv_d0(o[ct], vb0 + (kt * 2 + ct) * 16384, pa[kt][0], pa[kt][1], pa[kt][2], pa[kt][3]);
        const int plane = wid >> 2;
#pragma unroll
        for (int r = 0; r < 16; ++r) {
            const int k1 = 32 * (wid & 3) + crow(r, hi);
            bf16_t* dst = FY + ((((size_t)plane * BATCH + b) * 128 + k1) * 64 + n2) * 256 + r32;
#pragma unroll
            for (int ct = 0; ct < 2; ++ct)
#pragma unroll
                for (int d0 = 0; d0 < 4; ++d0) dst[128 * ct + 32 * d0] = f2bf(o[ct][d0][r]);
        }
    }
    __syncthreads();
}
__device__ __forceinline__ void ph_fourierB(const Params& p, unsigned char* smem) {
    using namespace fa;
    unsigned char* ws = p.ws;
    const bf16_t* FY = (const bf16_t*)(ws + WS_FY); const float2* tabw = (const float2*)(ws + WS_TABW);
    const bf16_t* M64 = (const bf16_t*)(ws + WS_M64E); const bf16_t* GT = (const bf16_t*)(ws + WS_GT);
    bf16_t* AO = (bf16_t*)(ws + WS_AO);
    const int tid = otid(), wid = tid >> 6, lane = tid & 63, r32 = lane & 31, hi = lane >> 5;
    const int sr = tid >> 4, sc = (tid & 15) * 8, vst0 = v_st(sr, sc), vst1 = v_st(32 + sr, sc);
    const int vb0 = (int)(uintptr_t)smem + v_rd_base(lane);
    constexpr int XRS = 528;
    unsigned char* XL = smem + 65536;
    const int mt = wid & 3, ctw = wid >> 2;
    for (int task = blockIdx.x; task < BATCH * 128; task += gridDim.x) {
        const int b = task >> 7, k1 = task & 127;
        __syncthreads();
#pragma unroll
        for (int ct = 0; ct < 2; ++ct)
#pragma unroll
            for (int rh = 0; rh < 2; ++rh) {
                const int n2 = sr + 32 * rh;
                const size_t off = ((((size_t)b) * 128 + k1) * 64 + n2) * 256 + 128 * ct + sc;
                const uint4 yr = *(const uint4*)(FY + off), yi = *(const uint4*)(FY + (size_t)BATCH * 128 * 64 * 256 + off);
                const float2 tw = tabw[n2 * k1];
                const unsigned yrw[4] = {yr.x, yr.y, yr.z, yr.w}, yiw[4] = {yi.x, yi.y, yi.z, yi.w};
                unsigned zr[4], zi[4];
#pragma unroll
                for (int q = 0; q < 4; ++q) {
                    const float a0 = __uint_as_float(yrw[q] << 16), a1 = __uint_as_float(yrw[q] & 0xffff0000u), b0 = __uint_as_float(yiw[q] << 16), b1 = __uint_as_float(yiw[q] & 0xffff0000u);
                    zr[q] = pk2(a0 * tw.x + b0 * tw.y, a1 * tw.x + b1 * tw.y); zi[q] = pk2(b0 * tw.x - a0 * tw.y, b1 * tw.x - a1 * tw.y);
                }
                const int vs = rh ? vst1 : vst0;
                *(uint4*)(smem + (0 * 2 + ct) * 16384 + vs) = make_uint4(zr[0], zr[1], zr[2], zr[3]);
                *(uint4*)(smem + (1 * 2 + ct) * 16384 + vs) = make_uint4(zi[0], zi[1], zi[2], zi[3]);
            }
        __syncthreads();
        {
            f32x16 o[4] = {};
#pragma unroll
            for (int kt = 0; kt < 2; ++kt) {
                bf16x8 pa[4];
#pragma unroll
                for (int ks = 0; ks < 4; ++ks) pa[ks] = *(const bf16x8*)(M64 + (size_t)(32 * mt + r32) * 128 + 64 * kt + 16 * ks + 8 * hi);
                pv_d0(o, vb0 + (kt * 2 + ctw) * 16384, pa[0], pa[1], pa[2], pa[3]);
            }
#pragma unroll
            for (int r = 0; r < 16; ++r) {
                const int ro = 32 * mt + crow(r, hi);
                bf16_t* xr = (bf16_t*)(XL + ((ro >> 6) * 64 + (ro & 63)) * XRS) + 128 * ctw + r32;
#pragma unroll
                for (int d0 = 0; d0 < 4; ++d0) xr[32 * d0] = f2bf(o[d0][r]);
            }
        }
        __syncthreads();
#pragma unroll
        for (int tt = 0; tt < 2; ++tt) {
            const int tau = 2 * wid + tt, g = tau >> 2, mt2 = (tau >> 1) & 1, nt2 = tau & 1;
            f32x16 acc = {};
#pragma unroll
            for (int ks8 = 0; ks8 < 8; ++ks8) {
                const int part = ks8 >> 2, cb = ks8 & 3;
                const bf16x8 af = *(const bf16x8*)(XL + (part * 64 + 32 * mt2 + r32) * XRS + (g * 64 + 16 * cb + 8 * hi) * 2);
                const bf16x8 bfr = *(const bf16x8*)(GT + ((size_t)g * 64 + 32 * nt2 + r32) * 128 + part * 64 + 16 * cb + 8 * hi);
                acc = __builtin_amdgcn_mfma_f32_32x32x16_bf16(af, bfr, acc, 0, 0, 0);
            }
#pragma unroll
            for (int r = 0; r < 16; ++r) { const int k2 = 32 * mt2 + crow(r, hi);
                AO[((size_t)b * SEQ + k1 + 128 * k2) * D + g * 64 + 32 * nt2 + r32] = f2bf(acc[r]); }
        }
    }
    __syncthreads();
}

__device__ __forceinline__ void ph_mid(const Params& p, unsigned char* smem) {
    typedef short bf16x8 __attribute__((ext_vector_type(8)));
    unsigned char* ws = p.ws;
    const int tid = otid(), wave = tid >> 6, lane = tid & 63, fr = lane & 15, fq = lane >> 4;
    const float* mod = (const float*)(ws + WS_MOD);
    const bf16_t* YX = (const bf16_t*)(ws + WS_YX);
    unsigned char* H2 = ws + WS_H2;
    unsigned* counts = (unsigned*)(ws + WS_CTL);
    int* TE = (int*)(ws + WS_TE); int* TP = (int*)(ws + WS_TP); float* TW = (float*)(ws + WS_TW); int* TOKL = (int*)(ws + WS_TOKL);
    constexpr int RS = 2064;
    unsigned char* Ahi = smem; unsigned char* Alo = smem + 16 * RS; float* Pp = (float*)(smem + 2 * 16 * RS + 512);
    const float rbias = p.in[I_RB][lane];
    int* lcnt = (int*)(smem + 99328); int* gb = lcnt + 64; int* PE = gb + 64; float* PW = (float*)(PE + 1024); float* PV = PW + 1024;
    for (int chunk = blockIdx.x; chunk < T / 128; chunk += gridDim.x) {
      const int mc = chunk * 128, b = mc >> 13;
      if (tid < 64) lcnt[tid] = 0;
      {
          const float* mrow_ = mod + b * 6144;
          for (int i = tid; i < 5 * 256; i += NT) { const int v_ = i >> 8, q_ = (i & 255) * 4;
              const float* s_ = (v_ == 0) ? p.in[I_GAPOST] + q_ : (v_ == 1) ? mrow_ + 2 * 1024 + q_ : (v_ == 2) ? p.in[I_GFPRE] + q_ : (v_ == 3) ? mrow_ + 3 * 1024 + q_ : mrow_ + 4 * 1024 + q_;
              *(f32x4*)(PV + v_ * 1024 + q_) = *(const f32x4*)s_; }
          __syncthreads();
      }
      uint2 yw[2][4]; f32x4 xv[2][4];
      bf16x8 wfr[4][4];
      { const bf16_t* wrt_ = (const bf16_t*)(ws + WS_WRT) + (size_t)p.chunk * 16 * 1024; asm volatile("" : "+s"(wrt_));
#pragma unroll
        for (int ks = 0; ks < 4; ++ks) {
#pragma unroll
          for (int nb = 0; nb < 4; ++nb) wfr[ks][nb] = *(const bf16x8*)(wrt_ + (size_t)((ks * 4 + nb) * 2 * 64 + lane) * 8);
          __builtin_amdgcn_sched_barrier(0); } }
#define MID_LOAD(m0_) do { _Pragma("unroll") for (int rr = 0; rr < 2; ++rr) { const int m_ = (m0_) + 2 * wave + rr; _Pragma("unroll") for (int j = 0; j < 4; ++j) { \
          yw[rr][j] = *(const uint2*)(YX + (size_t)m_ * D + 4 * (lane + 64 * j)); xv[rr][j] = ((const f32x4*)(p.in[I_X] + (size_t)m_ * D))[lane + 64 * j]; } } } while (0)
      MID_LOAD(mc);
#pragma unroll 1
      for (int it = 0; it < 8; ++it) {
        const int m0 = mc + it * 16;
        {
            float ss[2] = {0.f, 0.f};
#define YV(rr, j, i) ((i) == 0 ? __uint_as_float(yw[rr][j].x << 16) : (i) == 1 ? __uint_as_float(yw[rr][j].x & 0xffff0000u) : (i) == 2 ? __uint_as_float(yw[rr][j].y << 16) : __uint_as_float(yw[rr][j].y & 0xffff0000u))
#pragma unroll
            for (int rr = 0; rr < 2; ++rr) {
#pragma unroll
                for (int j = 0; j < 4; ++j) ss[rr] += YV(rr, j, 0) * YV(rr, j, 0) + YV(rr, j, 1) * YV(rr, j, 1) + YV(rr, j, 2) * YV(rr, j, 2) + YV(rr, j, 3) * YV(rr, j, 3);
                ss[rr] = wave_sum(ss[rr]);
            }
#pragma unroll
            for (int rr = 0; rr < 2; ++rr) {
                const int lr = 2 * wave + rr, m = m0 + lr;
                const float r1 = 1.0f / sqrtf(ss[rr] * (1.0f / D) + EPS);
                float ss2 = 0.f;
#pragma unroll
                for (int j = 0; j < 4; ++j) {
                    const int col = 4 * (lane + 64 * j);
                    const f32x4 gp = *(const f32x4*)(PV + col), gt = *(const f32x4*)(PV + 1024 + col);
#pragma unroll
                    for (int i = 0; i < 4; ++i) { xv[rr][j][i] = xv[rr][j][i] + gt[i] * (YV(rr, j, i) * r1 * gp[i]); ss2 += xv[rr][j][i] * xv[rr][j][i]; }
                    ((f32x4*)(p.out + (size_t)m * D))[lane + 64 * j] = xv[rr][j];
                }
                ss2 = wave_sum(ss2);
                const float r2 = 1.0f / sqrtf(ss2 * (1.0f / D) + EPS);
#pragma unroll
                for (int j = 0; j < 4; ++j) {
                    const int col = 4 * (lane + 64 * j);
                    const f32x4 gp = *(const f32x4*)(PV + 2048 + col), sh = *(const f32x4*)(PV + 3072 + col), sc = *(const f32x4*)(PV + 4096 + col);
                    float h[4];
#pragma unroll
                    for (int i = 0; i < 4; ++i) h[i] = xv[rr][j][i] * r2 * gp[i] * (1.f + sc[i]) + sh[i];
                    uint2 o; o.x = pk2(h[0], h[1]); o.y = pk2(h[2], h[3]);
                    { int w8 = __builtin_amdgcn_cvt_pk_fp8_f32(h[0], h[1], 0, false); w8 = __builtin_amdgcn_cvt_pk_fp8_f32(h[2], h[3], w8, true); *(int*)(H2 + (size_t)m * D + col) = w8; }
                    *(uint2*)(Ahi + lr * RS + col * 2) = o;
                }
            }
            if (it < 7) MID_LOAD(m0 + 16);
        }
        asm volatile("s_waitcnt lgkmcnt(0)\n\ts_barrier" ::: "memory");
        {
            f32x4 acc[4];
#pragma unroll
            for (int nb = 0; nb < 4; ++nb) acc[nb] = (f32x4){0.f, 0.f, 0.f, 0.f};
#pragma unroll
            for (int ks = 0; ks < 4; ++ks) {
                const int ko = (wave * 128 + ks * 32 + 8 * fq) * 2;
                const bf16x8 ah = *(const bf16x8*)(Ahi + fr * RS + ko);
#pragma unroll
                for (int nb = 0; nb < 4; ++nb) acc[nb] = __builtin_amdgcn_mfma_f32_16x16x32_bf16(ah, wfr[ks][nb], acc[nb], 0, 0, 0);
            }
#pragma unroll
            for (int nb = 0; nb < 4; ++nb)
#pragma unroll
                for (int j = 0; j < 4; ++j) Pp[(wave * 16 + 4 * fq + j) * 64 + 16 * nb + fr] = acc[nb][j];
        }
        asm volatile("s_waitcnt lgkmcnt(0)\n\ts_barrier" ::: "memory");
#pragma unroll
        for (int rr = 0; rr < 2; ++rr) {
            const int lr = 2 * wave + rr;
            float lg = 0.f;
#pragma unroll
            for (int w = 0; w < 8; ++w) lg += Pp[(w * 16 + lr) * 64 + lane];
            const float score = 1.0f / (1.0f + expf(-lg));
            const float sel = score + rbias;
            float t1 = sel, t2 = -INFINITY;
#define TOP2(M) do { const float o1 = sx<M>(t1), o2 = sx<M>(t2); const float n1 = fmaxf(t1, o1), n2 = fmaxf(fminf(t1, o1), fmaxf(t2, o2)); t1 = n1; t2 = n2; } while (0)
            TOP2(1); TOP2(2); TOP2(4);
#undef TOP2
            const float gs = t1 + t2; const int grp = lane >> 3;
            int gr = 0;
#pragma unroll
            for (int j = 0; j < 8; ++j) { const float sj = __uint_as_float(__builtin_amdgcn_readlane(__float_as_uint(gs), j * 8)); gr += (sj > gs || (sj == gs && j < grp)) ? 1 : 0; }
            const bool gsel = gr < 4;
            float v = gsel ? sel : -INFINITY;
            int rk = TOPK;
#pragma unroll
            for (int it8 = 0; it8 < TOPK; ++it8) {
                const float mx = wave_max(v);
                const unsigned long long eq = __ballot(v == mx);
                const int win = __builtin_ctzll(eq);
                if (lane == win) { rk = it8; v = -INFINITY; }
            }
            const bool chosen = rk < TOPK;
            const float ssum = wave_sum(chosen ? score : 0.f);
            const float w = score / (ssum + 1e-20f) * 2.5f;
            if (chosen) {
                const int lpos = atomicAdd(&lcnt[lane], 1);
                const int idx = (it * 16 + lr) * 8 + rk;
                PE[idx] = lane | (lpos << 8); PW[idx] = w;
            }
        }
      }
      __syncthreads();
      if (tid < 64) { const int c = lcnt[tid]; gb[tid] = c ? (int)atomicAdd(&counts[b * 65 + tid], (unsigned)c) : 0; }
      __syncthreads();
      for (int i = tid; i < 1024; i += NT) {
          const int pe = PE[i], e = pe & 255, pos = gb[e] + (pe >> 8), mk = mc * 8 + i;
          TOKL[((size_t)b * 64 + e) * 8192 + pos] = mk; TE[mk] = e; TP[mk] = pos; TW[mk] = PW[i];
      }
      __syncthreads();
    }
}

constexpr int T_CNT = 0;
constexpr int T_TOT = 256;
constexpr int T_AB = 328;
constexpr int T_OFF = 400;
constexpr int T_GUP = 660;
constexpr int T_YC = 730;
constexpr int T_YB = 990;
constexpr int T_DUP = 1250;
constexpr int T_UL = 1520;
constexpr int T_END = 1520 + 512;
__device__ __forceinline__ int scan_incl(int v, int lane) {
#pragma unroll
    for (int off = 1; off < 64; off <<= 1) { const int t = __builtin_amdgcn_ds_bpermute(((lane - off) & 63) << 2, v); if (lane >= off) v += t; }
    return v;
}
__device__ __forceinline__ void build_moe(const Params& p, int* tab) {
    const unsigned* counts = (const unsigned*)(p.ws + WS_CTL);
    __syncthreads();
    const int tid = otid(), wave = tid >> 6, lane = tid & 63;
    if (wave == 0) {
        const int c0 = (int)counts[0 * 65 + lane], c1 = (int)counts[1 * 65 + lane], c2 = (int)counts[2 * 65 + lane], c3 = (int)counts[3 * 65 + lane];
        tab[T_CNT + 0 * 64 + lane] = c0; tab[T_CNT + 1 * 64 + lane] = c1; tab[T_CNT + 2 * 64 + lane] = c2; tab[T_CNT + 3 * 64 + lane] = c3;
        tab[T_OFF + lane * 4 + 0] = 0; tab[T_OFF + lane * 4 + 1] = c0; tab[T_OFF + lane * 4 + 2] = c0 + c1; tab[T_OFF + lane * 4 + 3] = c0 + c1 + c2;
        const int tot = c0 + c1 + c2 + c3, pad = (tot + 255) & ~255, gu = ((tot + 255) >> 8) * 2;
        const int sp = scan_incl(pad, lane), sg = scan_incl(gu, lane);
        tab[T_TOT + lane] = tot; tab[T_AB + lane] = sp - pad; tab[T_GUP + lane] = sg - gu;
        const int cb[4] = {c0, c1, c2, c3};
#pragma unroll
        for (int b = 0; b < 4; ++b) {
            const int du = ((cb[b] + 255) >> 8) * 4;
            const int sy = scan_incl(cb[b], lane), sd = scan_incl(du, lane);
            tab[T_YB + 65 * b + lane] = sy - cb[b]; tab[T_DUP + 66 * b + lane] = sd - du;
            if (lane == 63) { tab[T_YB + 65 * b + 64] = sy; tab[T_DUP + 66 * b + 64] = sd; tab[T_DUP + 66 * b + 65] = sd + (SEQ / 256) * 4; }
        }
        if (lane == 63) { tab[T_TOT + 64] = T; tab[T_AB + 64] = sp; tab[T_GUP + 64] = sg; tab[T_GUP + 65] = sg + (T / 256) * 2; }
    }
    __syncthreads();
}

__device__ __forceinline__ void moe_decode(const GP_LAS int* tab, int e, int pos_e, int& b, int& pos) {
    const int o1 = tab[T_OFF + e * 4 + 1], o2 = tab[T_OFF + e * 4 + 2], o3 = tab[T_OFF + e * 4 + 3];
    b = (pos_e >= o1 ? 1 : 0) + (pos_e >= o2 ? 1 : 0) + (pos_e >= o3 ? 1 : 0);
    pos = pos_e - (b == 0 ? 0 : (b == 1 ? o1 : (b == 2 ? o2 : o3)));
}
__device__ __forceinline__ int yrow0(int b) { return b == 0 ? 2 * 1024 : (272 + 72 * (b - 1)) * 1024; }
struct MoeSched {
    const GP_LAS int* tab; int G, c, ntn, U, down, chunk; const int* TOKL; const char* Bt;
    __device__ __forceinline__ void prepare(int* tabw, int wv) const {
        if (wv == 0) {
            const int i = lane_id(); int L = i * G + c;
            if (L < U) {
                int bt = 0;
                if (down) {
#pragma unroll
                    for (int q = 0; q < 3; ++q) { const int u0 = tabw[T_DUP + 66 * bt + 65]; if (L >= u0) { L -= u0; ++bt; } } }
                const int pre = down ? T_DUP + 66 * bt : T_GUP;
                int lo = 0, hi = 64;
                while (lo < hi) { const int mid = (lo + hi + 1) >> 1; if (tabw[pre + mid] <= L) lo = mid; else hi = mid - 1; }
                const int loc = L - tabw[pre + lo];
                int cnt, base, bb;
                if (down) { cnt = (lo < 64) ? tabw[T_CNT + bt * 64 + (lo & 63)] : SEQ; base = tabw[T_YB + 65 * bt + lo] + yrow0(bt);
                            bb = tabw[T_AB + lo] + (lo < 64 ? tabw[T_OFF + (lo & 63) * 4 + bt] : bt * SEQ); }
                else { cnt = tabw[T_TOT + lo]; base = tabw[T_AB + lo]; bb = 0; }
                int* ul = tabw + T_UL + 8 * i;
                ul[0] = lo; ul[1] = loc / ntn; ul[2] = loc % ntn; ul[3] = cnt; ul[4] = base; ul[5] = bb;
            }
        }
        __syncthreads();
    }
    __device__ __forceinline__ bool next(int i, gp::Unit& u) const {
        if (i * G + c >= U) return false;
        const GP_LAS int* ul = tab + T_UL + 8 * i;
        u.e = __builtin_amdgcn_readfirstlane(ul[0]); u.pm = __builtin_amdgcn_readfirstlane(ul[1]); u.pn = __builtin_amdgcn_readfirstlane(ul[2]);
        u.cnt = __builtin_amdgcn_readfirstlane(ul[3]); u.base = __builtin_amdgcn_readfirstlane(ul[4]); u.b = __builtin_amdgcn_readfirstlane(ul[5]);
        return true;
    }
    __device__ __forceinline__ unsigned arow(const gp::Unit& u, int r) const {
        const int pos_e = u.pm * 256 + r;
        if (down) return (unsigned)(u.b + pos_e) * 256u;
        int tok;
        if (u.e < 64) { int b, pos; moe_decode(tab, u.e, pos_e, b, pos); tok = (pos_e < u.cnt) ? (TOKL[((size_t)b * 64 + u.e) * 8192 + pos] >> 3) : 0; } else tok = pos_e;
        return (unsigned)tok * 1024u;
    }
    __device__ __forceinline__ const char* bptr(const gp::Unit& u) const {
        return down ? Bt + ((size_t)u.e * 1024 + u.pn * 256) * 256 : Bt + ((size_t)u.e * 512 + u.pn * 256) * 1024;
    }
};
struct EpiGU {
    unsigned char* ACT; const int* TOKL; const float* TW; const GP_LAS int* tab;
    __device__ __forceinline__ void operator()(const f32x4 (&acc)[2][2][4][2], const gp::Unit& u, int wr, int wc, int fr, int fq) const {
#pragma unroll
        for (int ai = 0; ai < 2; ++ai)
#pragma unroll
            for (int m = 0; m < 4; ++m) {
                const int pos_e = u.pm * 256 + ai * 128 + wr * 64 + m * 16 + fr;
                if (pos_e < u.cnt) {
                    float a[8];
#pragma unroll
                    for (int n = 0; n < 2; ++n)
#pragma unroll
                        for (int i = 0; i < 4; ++i) { const float g = acc[ai][0][m][n][i] * (1.f / GUSCALE), up = acc[ai][1][m][n][i] * (1.f / GUSCALE);
                            a[4 * n + i] = __builtin_amdgcn_fmed3f(g * __builtin_amdgcn_rcpf(1.0f + __builtin_amdgcn_exp2f(-1.4426950408889634f * g)) * up * ASCALE, -448.f, 448.f); }
                    int w0 = __builtin_amdgcn_cvt_pk_fp8_f32(a[0], a[1], 0, false); w0 = __builtin_amdgcn_cvt_pk_fp8_f32(a[2], a[3], w0, true);
                    int w1 = __builtin_amdgcn_cvt_pk_fp8_f32(a[4], a[5], 0, false); w1 = __builtin_amdgcn_cvt_pk_fp8_f32(a[6], a[7], w1, true);
                    gp::gst2(ACT + ((size_t)u.base + pos_e) * DE + u.pn * 128 + wc * 32 + fq * 8, (unsigned)w0, (unsigned)w1);
                }
            }
    }
};
constexpr float YSCALE = 16.f;
struct EpiDown {
    unsigned char* ws;
    __device__ __forceinline__ void operator()(const f32x4 (&acc)[2][2][4][2], const gp::Unit& u, int wr, int wc, int fr, int fq) const {
#pragma unroll
        for (int ai = 0; ai < 2; ++ai)
#pragma unroll
            for (int m = 0; m < 4; ++m) {
                const int pos = u.pm * 256 + ai * 128 + wr * 64 + m * 16 + fr;
                {
                    unsigned char* rowp = ws + (size_t)((pos < u.cnt) ? (u.base + pos) : (489 * 1024 + fr)) * D + u.pn * 256 + wc * 32 + fq * 8;
#pragma unroll
                    for (int bj = 0; bj < 2; ++bj) { const f32x4 v0 = acc[ai][bj][m][0] * (YSCALE / (WDSCALE * ASCALE)), v1 = acc[ai][bj][m][1] * (YSCALE / (WDSCALE * ASCALE));
                        int w0 = __builtin_amdgcn_cvt_pk_fp8_f32(v0[0], v0[1], 0, false); w0 = __builtin_amdgcn_cvt_pk_fp8_f32(v0[2], v0[3], w0, true);
                        int w1 = __builtin_amdgcn_cvt_pk_fp8_f32(v1[0], v1[1], 0, false); w1 = __builtin_amdgcn_cvt_pk_fp8_f32(v1[2], v1[3], w1, true);
                        gp::gst2(rowp + bj * 128, (unsigned)w0, (unsigned)w1); }
                }
            }
    }
};
__device__ __forceinline__ void ph_moe_gu(const Params& p, unsigned char* smem) {
    unsigned char* ws = p.ws;
    int* tab = (int*)(smem + gp::STAGE_BYTES);
    build_moe(p, tab);
    MoeSched S; S.tab = (const GP_LAS int*)tab; S.G = gridDim.x; S.c = (gridDim.x % 8 == 0) ? (int)((blockIdx.x % 8) * (gridDim.x / 8) + blockIdx.x / 8) : (int)blockIdx.x;   S.ntn = 2; S.U = __builtin_amdgcn_readfirstlane(tab[T_GUP + 65]); S.down = 0; S.chunk = 0;
    S.TOKL = (const int*)(ws + WS_TOKL); S.Bt = (const char*)(ws + WS_WGUT);
    S.prepare(tab, p.chunk);
    EpiGU E{ws + WS_ACT, (const int*)(ws + WS_TOKL), (const float*)(ws + WS_TW), (const GP_LAS int*)tab};
    gp::gemm_phase<EpiGU, MoeSched, true, true>(p.chunk, (GP_LAS unsigned char*)smem, (const char*)(ws + WS_H2), D / 2, S, E);
}
__device__ __forceinline__ void ph_moe_down(const Params& p, unsigned char* smem, int c) {
    unsigned char* ws = p.ws;
    int* tab = (int*)(smem + gp::STAGE_BYTES);
    build_moe(p, tab);
    MoeSched S; S.tab = (const GP_LAS int*)tab; S.G = gridDim.x; S.c = (gridDim.x % 8 == 0) ? (int)((blockIdx.x % 8) * (gridDim.x / 8) + blockIdx.x / 8) : (int)blockIdx.x;   S.ntn = 4; S.U = __builtin_amdgcn_readfirstlane(tab[T_DUP + 65] + tab[T_DUP + 66 + 65] + tab[T_DUP + 132 + 65] + tab[T_DUP + 198 + 65]); S.down = 1; S.chunk = c;
    S.TOKL = nullptr; S.Bt = (const char*)(ws + WS_WDT);
    S.prepare(tab, p.chunk);
    EpiDown E{ws};
    gp::gemm_phase<EpiDown, MoeSched, false, true, 0>(p.chunk, (GP_LAS unsigned char*)smem, (const char*)(ws + WS_ACT), DE / 2, S, E);
}

__device__ __forceinline__ void ph_final(const Params& p, float* lds) {
    unsigned char* ws = p.ws;
    int* tab = (int*)lds;
    build_moe(p, tab);
    const int tid = otid(), wave = tid >> 6, lane = tid & 63;
    const int gw = blockIdx.x * NWV + wave, GW = gridDim.x * NWV;
    const int* TE = (const int*)(ws + WS_TE); const int* TP = (const int*)(ws + WS_TP); const float* TW = (const float*)(ws + WS_TW);
    const unsigned char* Y = ws;
    for (int m = gw; m < T; m += GW) {
        const int b = m >> 13, t = m & (SEQ - 1);
        const float* mod = (const float*)(ws + WS_MOD) + b * 6144 + 5 * 1024;
        float acc[16];
#pragma unroll
        for (int i = 0; i < 16; ++i) acc[i] = 0.f;
#pragma unroll
        for (int k = 0; k < 9; ++k) {
            int row; float wk = 1.f;
            if (k < 8) { const int e = TE[m * 8 + k]; row = tab[T_YB + 65 * b + e] + TP[m * 8 + k]; wk = TW[m * 8 + k]; }
            else row = tab[T_YB + 65 * b + 64] + t;
            row += yrow0(b);
            const unsigned char* yr = Y + (size_t)row * D;
#pragma unroll
            for (int j = 0; j < 4; ++j) { const int w = *(const int*)(yr + 4 * (lane + 64 * j));
                acc[4 * j] += wk * __builtin_amdgcn_cvt_f32_fp8(w, 0); acc[4 * j + 1] += wk * __builtin_amdgcn_cvt_f32_fp8(w, 1); acc[4 * j + 2] += wk * __builtin_amdgcn_cvt_f32_fp8(w, 2); acc[4 * j + 3] += wk * __builtin_amdgcn_cvt_f32_fp8(w, 3); }
        }
        float ss = 0.f;
#pragma unroll
        for (int i = 0; i < 16; ++i) { acc[i] *= (1.f / YSCALE); ss += acc[i] * acc[i]; }
        ss = wave_sum(ss);
        const float rs = 1.0f / sqrtf(ss * (1.0f / D) + EPS);
#pragma unroll
        for (int j = 0; j < 4; ++j) {
            const int col = 4 * (lane + 64 * j);
            const f32x4 gp = *(const f32x4*)(p.in[I_GFPOST] + col), gt = *(const f32x4*)(mod + col);
            f32x4 x1 = ((const f32x4*)(p.out + (size_t)m * D))[lane + 64 * j];
#pragma unroll
            for (int i = 0; i < 4; ++i) x1[i] += gt[i] * (acc[4 * j + i] * rs * gp[i]);
            ((f32x4*)(p.out + (size_t)m * D))[lane + 64 * j] = x1;
        }
    }
}

#define GAS __attribute__((address_space(1)))
#define LAS __attribute__((address_space(3)))
#define XB_TMO      128
#define XB_XCNT(j)  (256  + 64 * (j))
#define XB_XSUB(j)  (1280 + 64 * (j))
#define XB_XGEN(j)  (2304 + 64 * (j))
#define XB_TOP      3328
#define XB_TOPGEN   3392
#define XCD_BAR_WORDS 3456
#define XB_SPIN_CAP (1u << 21)
__device__ __forceinline__ unsigned xb_ld(unsigned* p)              { return __hip_atomic_load(p, __ATOMIC_RELAXED, __HIP_MEMORY_SCOPE_AGENT); }
__device__ __forceinline__ unsigned xb_add(unsigned* p, unsigned v) { return __hip_atomic_fetch_add(p, v, __ATOMIC_RELAXED, __HIP_MEMORY_SCOPE_AGENT); }
__device__ __forceinline__ unsigned xb_xcc_id() { return (unsigned)__builtin_amdgcn_s_getreg((3 << 11) | 20) & 0xFu; }
#define XB_SPIN(cond, bar) do { unsigned _sp = 0; while (cond) { __builtin_amdgcn_s_sleep(1); \
    if ((++_sp & 255u) == 0u) { if (xb_ld(&(bar)[XB_TMO])) break; if (_sp > XB_SPIN_CAP) { atomicAdd(&(bar)[XB_TMO], 1u); break; } } } } while (0)
struct XcdBarrier { unsigned* bar; unsigned x; volatile LAS unsigned* st; };
__device__ __forceinline__ XcdBarrier xcd_barrier_post(unsigned* bar, volatile LAS unsigned* st, int wv) {
    XcdBarrier b; b.bar = bar; b.x = xb_xcc_id(); b.st = st;
    if (wv == 0 && lane_id() == 0) (void)xb_add(&bar[XB_XCNT(b.x)], 1u);
    return b;
}
__device__ __forceinline__ void xcd_barrier_complete(unsigned* bar, unsigned x, unsigned& nloc, unsigned& nx) {
    const unsigned G = gridDim.x * gridDim.y * gridDim.z;
    unsigned sum, cnt, mine, sp = 0u;
    for (;;) {
        sum = 0u; cnt = 0u; mine = 0u;
#pragma unroll
        for (unsigned j = 0; j < 16; ++j) { const unsigned c = xb_ld(&bar[XB_XCNT(j)]); sum += c; cnt += (c > 0u) ? 1u : 0u; mine = (j == x) ? c : mine; }
        if (sum == G) break;
        __builtin_amdgcn_s_sleep(1);
        if ((++sp & 255u) == 0u) { if (xb_ld(&bar[XB_TMO])) break; if (sp > XB_SPIN_CAP) { atomicAdd(&bar[XB_TMO], 1u); break; } }
    }
    nloc = mine > 0u ? mine : 1u; nx = cnt > 0u ? cnt : 1u;
}
__device__ __forceinline__ void xcd_barrier(const XcdBarrier& b, int wv) {
    asm volatile("s_waitcnt vmcnt(0)" ::: "memory");
    __syncthreads();
    if (wv == 0 && lane_id() == 0) {
        unsigned* bar = b.bar;
        __builtin_amdgcn_s_waitcnt(0);
        unsigned nloc = b.st[0], nx = b.st[1];
        if (nloc == 0u) { xcd_barrier_complete(bar, b.x, nloc, nx); b.st[0] = nloc; b.st[1] = nx; }
        const unsigned old = xb_add(&bar[XB_XSUB(b.x)], 1u);
        const unsigned gen = old / nloc;
        if (old + 1u == (gen + 1u) * nloc) {
            __builtin_amdgcn_fence(__ATOMIC_RELEASE, "agent");
            asm volatile("s_waitcnt vmcnt(0)" ::: "memory");
            const unsigned og = xb_add(&bar[XB_TOP], 1u);
            const unsigned tg = og / nx;
            if (og + 1u == (tg + 1u) * nx) xb_add(&bar[XB_TOPGEN], 1u);
            else XB_SPIN(xb_ld(&bar[XB_TOPGEN]) == tg, bar);
            __builtin_amdgcn_fence(__ATOMIC_ACQUIRE, "agent");
            xb_add(&bar[XB_XGEN(b.x)], 1u);
            asm volatile("s_waitcnt vmcnt(0)" ::: "memory");
        } else {
            XB_SPIN(xb_ld(&bar[XB_XGEN(b.x)]) == gen, bar);
            __builtin_amdgcn_fence(__ATOMIC_ACQUIRE, "agent");
            asm volatile("s_waitcnt vmcnt(0)" ::: "memory");
        }
    }
    __syncthreads();
}

namespace cg = cooperative_groups;
constexpr int LDS_BYTES = 144 * 1024;
typedef const __attribute__((address_space(4))) Params* KP;
__device__ __forceinline__ Params kargs() {
    Params p;
#if defined(__HIP_DEVICE_COMPILE__)
    typedef const __attribute__((address_space(4))) unsigned long long* KQ;
    KQ kq = (KQ)__builtin_amdgcn_kernarg_segment_ptr(); asm volatile("" : "+s"(kq));
    unsigned long long* d = (unsigned long long*)&p;
#pragma unroll
    for (int i = 0; i < (int)(sizeof(Params) / 8); ++i) d[i] = kq[i];
#endif
    return p;
}
#define PH(call) do { Params p = kargs(); p.chunk = wv; call; } while (0)
__global__ void __launch_bounds__(NT) mega_fwd(Params p_unused) {
    extern __shared__ __attribute__((aligned(16))) unsigned char smem[];
    float* lds = (float*)smem;
    volatile LAS unsigned* misc = (volatile LAS unsigned*)((LAS unsigned char*)smem + (LDS_BYTES - 64));
    if (threadIdx.x < 16) misc[threadIdx.x] = 0u;
    __syncthreads();
    unsigned* barw; { const Params p = kargs(); barw = (unsigned*)(p.ws + WS_CTL) + 4096; }
    const int wv = __builtin_amdgcn_readfirstlane(threadIdx.x >> 6);
    const XcdBarrier bar = xcd_barrier_post(barw, misc, wv);
#define SYNC() xcd_barrier(bar, wv)
    PH(ph_prep(p, lds)); PH(ph_prep_weights(p, lds, 0, 0));   SYNC();
    PH(ph_norm1(p));                SYNC();
    PH(ph_inproj(p, smem)); PH(ph_prep_weights(p, lds, 1, (MTOT / 256) * (INW / 256) % (int)gridDim.x));         SYNC();
    PH(ph_attn(p, smem)); PH(ph_fourierA(p, smem));  SYNC();
    PH(ph_fourierB(p, smem));       SYNC();
    PH(ph_outproj(p, smem));        SYNC();
    PH(ph_mid(p, smem));            SYNC();
    PH(ph_moe_gu(p, smem));         SYNC();
#pragma unroll 1
    PH(ph_moe_down(p, smem, 0));    SYNC();
    PH(ph_final(p, lds));
#undef SYNC
}

extern "C" void kernel_launch(void* const* d_in, const int* in_sizes, int n_in, void* d_out, int out_size, void* d_ws, size_t ws_size, hipStream_t stream) {
    if (n_in != 26 || ws_size < WS_END) { fprintf(stderr, "kernel_launch: unexpected n_in %d / ws %zu\n", n_in, ws_size); return; }
    static int grid_blocks = 0;
    if (!grid_blocks) {
        int dev = 0, cus = 0, per_cu = 0;
        (void)hipGetDevice(&dev);
        (void)hipDeviceGetAttribute(&cus, hipDeviceAttributeMultiprocessorCount, dev);
        (void)hipFuncSetAttribute((const void*)mega_fwd, hipFuncAttributeMaxDynamicSharedMemorySize, LDS_BYTES);
        (void)hipOccupancyMaxActiveBlocksPerMultiprocessor(&per_cu, (const void*)mega_fwd, NT, LDS_BYTES);
        if (per_cu < 1) { fprintf(stderr, "kernel_launch: occupancy query says %d blocks/CU\n", per_cu); per_cu = 1; }
        if (per_cu > 1) per_cu = 1;
        grid_blocks = cus * per_cu;
    }
    Params p{};
    for (int i = 0; i < 26; ++i) p.in[i] = (const float*)d_in[i];
    p.out = (float*)d_out; p.ws = (unsigned char*)d_ws; p.chunk = 0; p.pad = 0;
    (void)hipMemsetAsync((char*)d_ws + WS_CTL, 0, 32768, stream);
    void* args[] = {&p};
    hipError_t e = hipLaunchCooperativeKernel((const void*)mega_fwd, dim3(grid_blocks), dim3(NT), args, LDS_BYTES, stream);
    if (e != hipSuccess) fprintf(stderr, "cooperative launch failed: %s (grid %d)\n", hipGetErrorString(e), grid_blocks);
}
```

```cpp
#include <hip/hip_runtime.h>
#include <hip/hip_cooperative_groups.h>
#include <cstdio>
#include <cstdint>

typedef unsigned short bf16_t;
typedef float f32x4 __attribute__((ext_vector_type(4)));

constexpr int D = 1024, BATCH = 4, SEQ = 8192, T = BATCH * SEQ, CTX = 256, TC = BATCH * CTX;
constexpr int MTOT = T + TC;
constexpr int KVLEN = CTX + SEQ;
constexpr int INW = 2560, NH = 6, QKW = 768, FW = 256;
constexpr int NE = 64, DE = 256, TOPK = 8;
constexpr int NT = 512, NWV = 8;
constexpr int SLOTS_B = 90112;
constexpr float EPS = 1e-6f;
constexpr float LAM_INIT = 0.2f;
constexpr float QSCALE = 0.125f * 1.4426950408889634f;
constexpr float SQS = 0.42466090014400953f;

constexpr size_t MiB = 1u << 20;
constexpr size_t WS_CTL = 0;
constexpr size_t WS_MOD = 1 * MiB;
constexpr size_t WS_TABW = WS_MOD + 128 * 1024;
constexpr size_t WS_ROPE = WS_MOD + 192 * 1024;
constexpr size_t WS_GCS = WS_MOD + 256 * 1024;
constexpr size_t WS_W128E = WS_MOD + 768 * 1024;
constexpr size_t WS_M64E = WS_MOD + 832 * 1024;
constexpr size_t WS_GT = WS_MOD + 864 * 1024;
constexpr size_t WS_WRT = WS_MOD + 512 * 1024;
constexpr size_t WS_WINT = 2 * MiB;
constexpr size_t WS_WOUTT = 7 * MiB;
constexpr size_t WS_WGUT = 9 * MiB;
constexpr size_t WS_WDT = 74 * MiB;
constexpr size_t WS_TE = 107 * MiB;
constexpr size_t WS_TP = 108 * MiB;
constexpr size_t WS_TW = 109 * MiB;
constexpr size_t WS_TOKL = 110 * MiB;
constexpr size_t WS_AO = 118 * MiB;
constexpr size_t WS_ACT = 118 * MiB;
constexpr size_t WS_Q = 182 * MiB;
constexpr size_t WS_K = 230 * MiB;
constexpr size_t WS_V = WS_K + (size_t)BATCH * KVLEN * QKW * 2;
constexpr size_t WS_F = 329 * MiB;
constexpr size_t WS_FY = 361 * MiB;
constexpr size_t WS_HX = 425 * MiB;
constexpr size_t WS_YX = 358 * MiB;
constexpr size_t WS_H2 = 294 * MiB;
constexpr size_t WS_Y = 294 * MiB;
constexpr size_t WS_END = 491 * MiB;

struct Params {
    const float* in[26];
    float* out;
    unsigned char* ws;
    int chunk;
    int pad;
};
enum { I_X = 0, I_C, I_CTX, I_CCTX, I_WMOD, I_BMOD, I_GAPRE, I_GAPOST, I_WIN, I_WF, I_LQ1, I_LK1, I_LQ2, I_LK2, I_GSUB, I_WOUT,
       I_GFPRE, I_GFPOST, I_WR, I_RB, I_WG, I_WU, I_WD, I_WSG, I_WSU, I_WSD };

__device__ __forceinline__ float bf2f(bf16_t v) { return __uint_as_float(((unsigned)v) << 16); }
__device__ __forceinline__ bf16_t f2bf(float f) { unsigned u = __float_as_uint(f); return (bf16_t)((u + 0x7fffu + ((u >> 16) & 1u)) >> 16); }
__device__ __forceinline__ unsigned pk2(float lo, float hi) { return (unsigned)f2bf(lo) | ((unsigned)f2bf(hi) << 16); }
template <int M> __device__ __forceinline__ float sx(float v) { return __int_as_float(__builtin_amdgcn_ds_swizzle(__float_as_int(v), (M << 10) | 0x1f)); }
template <int M> __device__ __forceinline__ int sxi(int v) { return __builtin_amdgcn_ds_swizzle(v, (M << 10) | 0x1f); }
__device__ __forceinline__ float wave_sum(float v) {
    v += sx<1>(v); v += sx<2>(v); v += sx<4>(v); v += sx<8>(v); v += sx<16>(v);
    auto rr = __builtin_amdgcn_permlane32_swap(__float_as_uint(v), __float_as_uint(v), false, false);
    return __uint_as_float(rr[0]) + __uint_as_float(rr[1]);
}
__device__ __forceinline__ float dpp_f(float v, const int ctrl_sel) {
    const int x = __float_as_int(v); int r;
    if (ctrl_sel == 0) r = __builtin_amdgcn_update_dpp(x, x, 0xB1, 0xf, 0xf, false);
    else if (ctrl_sel == 1) r = __builtin_amdgcn_update_dpp(x, x, 0x4E, 0xf, 0xf, false);
    else if (ctrl_sel == 2) r = __builtin_amdgcn_update_dpp(x, x, 0x141, 0xf, 0xf, false);
    else r = __builtin_amdgcn_update_dpp(x, x, 0x140, 0xf, 0xf, false);
    return __int_as_float(r);
}
__device__ __forceinline__ float wave_max(float v) {
    v = fmaxf(v, dpp_f(v, 0)); v = fmaxf(v, dpp_f(v, 1)); v = fmaxf(v, dpp_f(v, 2)); v = fmaxf(v, dpp_f(v, 3));
    const float a = __uint_as_float(__builtin_amdgcn_readlane(__float_as_uint(v), 0)), b = __uint_as_float(__builtin_amdgcn_readlane(__float_as_uint(v), 16));
    const float c = __uint_as_float(__builtin_amdgcn_readlane(__float_as_uint(v), 32)), d = __uint_as_float(__builtin_amdgcn_readlane(__float_as_uint(v), 48));
    return fmaxf(fmaxf(a, b), fmaxf(c, d));
}
__device__ __forceinline__ int lane_id() { int l; asm volatile("v_mbcnt_lo_u32_b32 %0, -1, 0\n\tv_mbcnt_hi_u32_b32 %0, -1, %0" : "=v"(l)); return l; }
__device__ __forceinline__ int otid_w(int wv) { return wv * 64 + lane_id(); }
#define otid() otid_w(p.chunk)
__device__ __forceinline__ float silu_f(float x) { return x / (1.f + expf(-x)); }

__device__ __forceinline__ void ph_prep(const Params& p, float* lds) {
    const int tid = otid(), bid = blockIdx.x, nblk = gridDim.x;
    const int gt = bid * NT + tid, GT = nblk * NT;
    unsigned char* ws = p.ws;
    float2* tabw = (float2*)(ws + WS_TABW);
    for (int i = gt; i < 8192; i += GT) { float s, c; sincospif((float)i * (1.0f / 4096.0f), &s, &c); tabw[i] = make_float2(c, s); }
    float* rope = (float*)(ws + WS_ROPE);
    for (int i = gt; i < 192 * 16; i += GT) {
        const int pos = (i < 2048) ? (i >> 4) : ((i - 2048) >> 4); const int f = i & 15;
        const float inv = powf(10000.0f, -(float)(2 * f) / 32.0f); const float ang = (float)pos * inv;
        const float c = cosf(ang), s = sinf(ang);
        if (i < 2048) { rope[i] = c; rope[2048 + i] = s; } else { rope[4096 + (i - 2048)] = c; rope[4096 + 1024 + (i - 2048)] = s; }
    }
    { bf16_t* gt = (bf16_t*)(ws + WS_GT); const float* wf = p.in[I_WF];
      for (int i = bid * NT + tid; i < 4 * 64 * 128; i += GT) {
        const int g = i >> 13, d = (i >> 7) & 63, part = (i >> 6) & 1, c = i & 63;
        float a = 0.f;
        for (int j = 0; j < 64; ++j) { float s, co; sincospif((float)((c * j) & 63) * (1.0f / 32.0f), &s, &co); a += (part ? s : co) * wf[(g * 64 + j) * 64 + d]; }
        gt[i] = f2bf(a * 0.0013810679320049757f);
      }
      bf16_t* w128 = (bf16_t*)(ws + WS_W128E);
      for (int i = bid * NT + tid; i < 256 * 128; i += GT) { const int kk = i >> 7, n1 = i & 127; float s, co; sincospif((float)(((kk & 127) * n1) & 127) * (1.0f / 64.0f), &s, &co); w128[i] = f2bf(kk < 128 ? co : -s); }
      bf16_t* m64 = (bf16_t*)(ws + WS_M64E);
      for (int i = bid * NT + tid; i < 128 * 128; i += GT) { const int ro = i >> 7, ci = i & 127, po = ro >> 6, k2 = ro & 63, pi = ci >> 6, n2 = ci & 63;
        float s, co; sincospif((float)((k2 * n2) & 63) * (1.0f / 32.0f), &s, &co); m64[i] = f2bf(po == pi ? co : (po == 0 ? s : -s)); }
    }
    {
      bf16_t* wrt = (bf16_t*)(ws + WS_WRT); const float* wr = p.in[I_WR];
      for (int i = gt; i < 64 * 1024; i += GT) {
        const int j = i & 7, ln = (i >> 3) & 63, nb = (i >> 9) & 3, ks = (i >> 11) & 3, wv_ = i >> 13;
        const int e = 16 * nb + (ln & 15), k = wv_ * 128 + ks * 32 + 8 * (ln >> 4) + j;
        const float w = wr[k * 64 + e]; const bf16_t h = f2bf(w);
        const int o = ((((wv_ * 4 + ks) * 4 + nb) * 2) * 64 + ln) * 8 + j;
        wrt[o] = h; wrt[o + 512] = f2bf(w - bf2f(h)); } }
    if (gt == 0) {
        float s1 = 0.f, s2 = 0.f;
        for (int i = 0; i < 64; ++i) { s1 += p.in[I_LQ1][i] * p.in[I_LK1][i]; s2 += p.in[I_LQ2][i] * p.in[I_LK2][i]; }
        ((float*)(ws + WS_CTL))[1024] = expf(s1) - expf(s2) + LAM_INIT;
    }
    float* sc = lds;
    float* red = lds + 5 * 1024;
    for (int i = tid; i < 5 * 1024; i += NT) { const int r = i >> 10, k = i & 1023; const float v = (r < 4) ? p.in[I_C][r * 1024 + k] : p.in[I_CCTX][k]; sc[i] = silu_f(v); }
    __syncthreads();
    const int wave = tid >> 6, lane = tid & 63;
    float* mod = (float*)(ws + WS_MOD);
    for (int task = bid; task < 96; task += nblk) {
        const int col = task * 64 + lane;
        float a0 = 0, a1 = 0, a2 = 0, a3 = 0, a4 = 0;
        const float* wm = p.in[I_WMOD];
#pragma unroll 32
        for (int k = wave * 128; k < wave * 128 + 128; ++k) { const float w = wm[(size_t)k * 6144 + col]; a0 += sc[k] * w; a1 += sc[1024 + k] * w; a2 += sc[2048 + k] * w; a3 += sc[3072 + k] * w; a4 += sc[4096 + k] * w; }
        red[(wave * 5 + 0) * 64 + lane] = a0; red[(wave * 5 + 1) * 64 + lane] = a1; red[(wave * 5 + 2) * 64 + lane] = a2; red[(wave * 5 + 3) * 64 + lane] = a3; red[(wave * 5 + 4) * 64 + lane] = a4;
        __syncthreads();
        if (tid < 320) { const int r = tid >> 6, l = tid & 63; float s = 0.f; for (int w = 0; w < 8; ++w) s += red[(w * 5 + r) * 64 + l]; mod[r * 6144 + task * 64 + l] = s + p.in[I_BMOD][task * 64 + l]; }
        __syncthreads();
    }
}

__device__ __forceinline__ void ph_norm1(const Params& p) {
    const int tid = otid(), wave = tid >> 6, lane = tid & 63;
    const int gw = blockIdx.x * NWV + wave, GW = gridDim.x * NWV;
    const float* mod = (const float*)(p.ws + WS_MOD);
    bf16_t* hx = (bf16_t*)(p.ws + WS_HX);
    const float* g = p.in[I_GAPRE];
    for (int m = gw; m < MTOT; m += GW) {
        const float* src = (m < T) ? p.in[I_X] + (size_t)m * D : p.in[I_CTX] + (size_t)(m - T) * D;
        const int r = (m < T) ? (m >> 13) : 4;
        const float* shift = mod + r * 6144; const float* scale = shift + 1024;
        f32x4 v[4]; float ss = 0.f;
#pragma unroll
        for (int j = 0; j < 4; ++j) { v[j] = ((const f32x4*)src)[lane + 64 * j]; ss += v[j][0] * v[j][0] + v[j][1] * v[j][1] + v[j][2] * v[j][2] + v[j][3] * v[j][3]; }
        ss = wave_sum(ss);
        const float rs = 1.0f / sqrtf(ss * (1.0f / D) + EPS);
#pragma unroll
        for (int j = 0; j < 4; ++j) {
            const int col = 4 * (lane + 64 * j);
            const f32x4 g4 = *(const f32x4*)(g + col), sc4 = *(const f32x4*)(scale + col), sh4 = *(const f32x4*)(shift + col);
            float h[4];
#pragma unroll
            for (int i = 0; i < 4; ++i) h[i] = v[j][i] * rs * g4[i] * (1.f + sc4[i]) + sh4[i];
            uint2 o; o.x = pk2(h[0], h[1]); o.y = pk2(h[2], h[3]);
            *(uint2*)(hx + (size_t)m * D + col) = o;
        }
    }
}

namespace gp {
#define GP_LAS __attribute__((address_space(3)))
typedef short bf16x8 __attribute__((ext_vector_type(8)));
typedef unsigned u32x4 __attribute__((ext_vector_type(4)));
typedef int i32x4 __attribute__((ext_vector_type(4)));
constexpr int BM = 256, BK = 64, HALF = 128, HTB = HALF * BK * 2, STAGE_BYTES = 8 * HTB;
__device__ __forceinline__ int lds_byte(int r, int c) { const int st = (r >> 4) * 2 + (c >> 5), rr = r & 15, cc = c & 31, ob = rr * 64 + cc * 2; return st * 1024 + (ob ^ (((ob >> 9) & 1) << 5)); }
__device__ __forceinline__ void stage_rc(int b, int& R, int& C) { const int st = b / 1024, sb = b % 1024, swz = sb ^ (((sb >> 9) & 1) << 5); R = (st >> 1) * 16 + swz / 64; C = (st & 1) * 32 + (swz % 64) / 2; }
__device__ __forceinline__ int perm32(int rho) { const int n = rho >> 4, i = rho & 15; return 8 * (i >> 2) + 4 * n + (i & 3); }
struct Unit { int pm, pn, e, b, cnt, base; };
typedef unsigned u32x2 __attribute__((ext_vector_type(2)));
typedef float f32x4g __attribute__((ext_vector_type(4)));
#define GP_G1(T, ptr) ((__attribute__((address_space(1))) T*)(ptr))
__device__ __forceinline__ void gst4(void* p, u32x4 v) { *GP_G1(u32x4, p) = v; }
__device__ __forceinline__ void gst2(void* p, unsigned a, unsigned b) { *GP_G1(u32x2, p) = (u32x2){a, b}; }
__device__ __forceinline__ void gst1(void* p, unsigned a) { *GP_G1(unsigned, p) = a; }
__device__ __forceinline__ f32x4g gld4f(const void* p) { return *GP_G1(const f32x4g, p); }
__device__ __forceinline__ unsigned cvt_pk_bf16(float lo, float hi) { unsigned r; asm volatile("v_cvt_pk_bf16_f32 %0, %1, %2" : "=v"(r) : "v"(lo), "v"(hi)); return r; }

template <class Epi, class Sched, bool ALIGN_EPI, bool F8 = false, int EST = 0>
__device__ __forceinline__ void gemm_phase(const int wv, GP_LAS unsigned char* lds, const char* Abase, const int K, const Sched& S, const Epi& E) {
    const int wid = wv, wr = wid >> 2, wc = wid & 3;
    const int nt = K / BK;
    unsigned voffB[2];
#pragma unroll
    for (int i = 0; i < 2; ++i) { int R, C; stage_rc(otid_w(wv) * 16 + i * 8192, R, C); const int Rb = (R & ~31) + perm32(R & 31); voffB[i] = (unsigned)(Rb * K + C) * 2u; }
#define GP_AOFFS(u, o00, o01, o10, o11) do { int R0, C0, R1, C1; const int t_ = otid_w(wv); stage_rc(t_ * 16, R0, C0); stage_rc(t_ * 16 + 8192, R1, C1); \
        o00 = S.arow(u, R0) + (unsigned)C0 * 2u; o01 = S.arow(u, R1) + (unsigned)C1 * 2u; o10 = S.arow(u, HALF + R0) + (unsigned)C0 * 2u; o11 = S.arow(u, HALF + R1) + (unsigned)C1 * 2u; } while (0)
    const size_t kstep = (size_t)(BK * 2);
    const size_t hstep = (size_t)HALF * K * 2;
    const unsigned ldsw = (unsigned)wid * 1024u;
    int aoff, boff; { const int l_ = lane_id(), fr = l_ & 15, fq = l_ >> 4; aoff = lds_byte(wr * 64 + fr, fq * 8); boff = lds_byte(wc * 32 + fr, fq * 8); }
#define GP_SA(b, h) (((b) * 2 + (h)) * HTB)
#define GP_SB(b, h) ((4 + (b) * 2 + (h)) * HTB)
#define GP_STAGE_B(bufoff, gbase) do { _Pragma("unroll") for (int _i = 0; _i < 2; ++_i) \
        __builtin_amdgcn_global_load_lds((const unsigned*)((const char*)(gbase) + voffB[_i]), (GP_LAS unsigned*)(lds + (bufoff) + ldsw + _i * 8192), 16, 0, 0); } while (0)
#define GP_STAGE_A(bufoff, gbase, o0, o1) do { \
        __builtin_amdgcn_global_load_lds((const unsigned*)((const char*)(gbase) + (o0)), (GP_LAS unsigned*)(lds + (bufoff) + ldsw), 16, 0, 0); \
        __builtin_amdgcn_global_load_lds((const unsigned*)((const char*)(gbase) + (o1)), (GP_LAS unsigned*)(lds + (bufoff) + ldsw + 8192), 16, 0, 0); } while (0)
#define GP_LDA(dst, b, h) do { _Pragma("unroll") for (int m = 0; m < 4; ++m) _Pragma("unroll") for (int k = 0; k < 2; ++k) dst[m][k] = *(const GP_LAS bf16x8*)(lds + GP_SA(b, h) + aoff + m * 2048 + k * 1024); } while (0)
#define GP_LDB(dst, b, h) do { _Pragma("unroll") for (int n = 0; n < 2; ++n) _Pragma("unroll") for (int k = 0; k < 2; ++k) dst[n][k] = *(const GP_LAS bf16x8*)(lds + GP_SB(b, h) + boff + n * 2048 + k * 1024); } while (0)
#define GP_CAT8(x) __builtin_shufflevector(__builtin_bit_cast(i32x4, x[0]), __builtin_bit_cast(i32x4, x[1]), 0, 1, 2, 3, 4, 5, 6, 7)
#define GP_MMA(ai, bj, At, Bt) do { __builtin_amdgcn_s_setprio(1); _Pragma("unroll") for (int m = 0; m < 4; ++m) _Pragma("unroll") for (int n = 0; n < 2; ++n) { \
        if constexpr (F8) acc[ai][bj][m][n] = __builtin_amdgcn_mfma_scale_f32_16x16x128_f8f6f4(GP_CAT8(Bt[n]), GP_CAT8(At[m]), acc[ai][bj][m][n], 0, 0, 0, 0, 0, 0); \
        else { _Pragma("unroll") for (int k = 0; k < 2; ++k) acc[ai][bj][m][n] = __builtin_amdgcn_mfma_f32_16x16x32_bf16(Bt[n][k], At[m][k], acc[ai][bj][m][n], 0, 0, 0); } } \
        __builtin_amdgcn_s_setprio(0); } while (0)
#define GP_WAIT_V(n) asm volatile("s_waitcnt vmcnt(" #n ")" ::: "memory")
#define GP_WAIT_L(n) asm volatile("s_waitcnt lgkmcnt(" #n ")" ::: "memory")
#define GP_BAR __builtin_amdgcn_s_barrier()
#define GP_SCHED __builtin_amdgcn_sched_barrier(0)
    Unit cur, nxt; int ui = 0;
    if (!S.next(0, cur)) return;
    f32x4 acc[2][2][4][2];
#pragma unroll
    for (int a = 0; a < 2; ++a)
#pragma unroll
        for (int b = 0; b < 2; ++b)
#pragma unroll
            for (int m = 0; m < 4; ++m)
#pragma unroll
                for (int n = 0; n < 2; ++n) acc[a][b][m][n] = (f32x4){0.f, 0.f, 0.f, 0.f};
    bf16x8 At[4][2], B0[2][2], B1[2][2];
    unsigned ac00, ac01, ac10, ac11, an00, an01, an10, an11;
    GP_AOFFS(cur, ac00, ac01, ac10, ac11);
    const char* cB = S.bptr(cur);
    GP_STAGE_B(GP_SB(0, 0), cB); GP_STAGE_B(GP_SB(0, 1), cB + hstep); GP_STAGE_A(GP_SA(0, 0), Abase, ac00, ac01); GP_STAGE_A(GP_SA(0, 1), Abase, ac10, ac11);
    if (wr == 1) GP_BAR;
    GP_WAIT_V(2); GP_BAR;
    GP_STAGE_B(GP_SB(1, 0), cB + kstep); GP_STAGE_A(GP_SA(1, 0), Abase + kstep, ac00, ac01); GP_STAGE_B(GP_SB(1, 1), cB + hstep + kstep);
    GP_WAIT_V(6); GP_BAR;
    for (;;) {
        const bool has_next = S.next(ui + 1, nxt);
        if (has_next) { GP_AOFFS(nxt, an00, an01, an10, an11); }
        else { an00 = ac00; an01 = ac01; an10 = ac10; an11 = ac11; }
        const char* nB = has_next ? S.bptr(nxt) : cB;
#pragma unroll 1
        for (int t = 0; t < nt; t += 2) {
            const bool last = (t == nt - 2);
            const char* a1 = Abase + (size_t)(t + 1) * kstep;
            const char* a2 = last ? Abase : Abase + (size_t)(t + 2) * kstep; const char* b2 = last ? nB : cB + (size_t)(t + 2) * kstep;
            const char* a3 = a2 + kstep; const char* b3 = b2 + kstep;
            asm volatile("" : "+s"(a1), "+s"(a2), "+s"(b2), "+s"(a3), "+s"(b3));
            GP_LDB(B0, 0, 0); GP_LDB(B1, 0, 1); GP_SCHED; GP_LDA(At, 0, 0); GP_STAGE_A(GP_SA(1, 1), a1, ac10, ac11);
            if (last) { ac00 = an00; ac01 = an01; ac10 = an10; ac11 = an11; }
            const bool relax = EST > 0 && ui > 0 && t == 0;
            if (relax) { static_assert(EST == 0 || EST == 16, "add a wait variant"); asm volatile("s_waitcnt vmcnt(24)" ::: "memory"); } else GP_WAIT_V(8);
            GP_WAIT_L(0); GP_BAR; GP_MMA(0, 0, At, B0); GP_MMA(0, 1, At, B1); GP_BAR; GP_SCHED;
            GP_LDA(At, 0, 1); GP_STAGE_B(GP_SB(0, 0), b2); GP_STAGE_B(GP_SB(0, 1), b2 + hstep); GP_STAGE_A(GP_SA(0, 0), a2, ac00, ac01);
            if (relax) asm volatile("s_waitcnt vmcnt(24)" ::: "memory"); else GP_WAIT_V(8);
            GP_WAIT_L(0); GP_BAR; GP_MMA(1, 0, At, B0); GP_MMA(1, 1, At, B1); GP_BAR; GP_SCHED;
            GP_LDB(B0, 1, 0); GP_LDB(B1, 1, 1); GP_SCHED; GP_LDA(At, 1, 0); GP_STAGE_A(GP_SA(0, 1), a2, ac10, ac11);
            GP_WAIT_V(8); GP_WAIT_L(0); GP_BAR; GP_MMA(0, 0, At, B0); GP_MMA(0, 1, At, B1); GP_BAR; GP_SCHED;
            GP_LDA(At, 1, 1); GP_STAGE_B(GP_SB(1, 0), b3); GP_STAGE_B(GP_SB(1, 1), b3 + hstep); GP_STAGE_A(GP_SA(1, 0), a3, ac00, ac01);
            GP_WAIT_V(8); GP_WAIT_L(0); GP_BAR; GP_MMA(1, 0, At, B0); GP_MMA(1, 1, At, B1); GP_BAR; GP_SCHED;
        }
        if constexpr (ALIGN_EPI) { if (wr == 0) GP_BAR; }
        { const int l_ = lane_id(); E(acc, cur, wr, wc, l_ & 15, l_ >> 4); }
        if (!has_next) break;
#pragma unroll
        for (int a = 0; a < 2; ++a)
#pragma unroll
            for (int b = 0; b < 2; ++b)
#pragma unroll
                for (int m = 0; m < 4; ++m)
#pragma unroll
                    for (int n = 0; n < 2; ++n) acc[a][b][m][n] = (f32x4){0.f, 0.f, 0.f, 0.f};
        cur = nxt; cB = nB; ++ui;
        if constexpr (ALIGN_EPI) { if (wr == 1) GP_BAR; }
    }
    GP_WAIT_V(0);
    if constexpr (!ALIGN_EPI) { if (wr == 0) GP_BAR; }
    GP_BAR;
#undef GP_AOFFS
#undef GP_SA
#undef GP_SB
#undef GP_STAGE_A
#undef GP_STAGE_B
#undef GP_LDA
#undef GP_LDB
#undef GP_MMA
#undef GP_CAT8
#undef GP_WAIT_V
#undef GP_WAIT_L
#undef GP_BAR
#undef GP_SCHED
}

struct DenseSched {
    int nM, nN, nwg, G, c, K; const char* Bt;
    __device__ __forceinline__ void init(int M, int N, int K_, const void* Bt_, int G_, int c_) { nM = M / BM; nN = N / BM; nwg = nM * nN; G = G_; c = c_; K = K_; Bt = (const char*)Bt_; }
    __device__ __forceinline__ bool next(int i, Unit& u) const {
        const long L = (long)i * G + c; if (L >= nwg) return false;
        int wgid = (int)L; { const int q = nwg / 8, r = nwg % 8, xcd = wgid % 8, off = wgid / 8; wgid = (xcd < r ? xcd * (q + 1) : r * (q + 1) + (xcd - r) * q) + off; }
        const int nig = 8 * nN, gid = wgid / nig, fm = gid * 8, gsz = (nM - fm) < 8 ? (nM - fm) : 8;
        u.pm = fm + ((wgid % nig) % gsz); u.pn = (wgid % nig) / gsz; u.e = 0; u.b = 0; u.cnt = 0; u.base = 0; return true;
    }
    __device__ __forceinline__ unsigned arow(const Unit& u, int r) const { return (unsigned)(u.pm * BM + r) * (unsigned)(K * 2); }
    __device__ __forceinline__ const char* bptr(const Unit& u) const { return Bt + (size_t)u.pn * BM * K * 2; }
};
}

struct EpiInProj {
    bf16_t* F; bf16_t* Q; bf16_t* Kb; bf16_t* Vb; const float* rope;
    __device__ __forceinline__ void operator()(const f32x4 (&acc)[2][2][4][2], const gp::Unit& u, int wr, int wc, int fr, int fq) const {
        const int pn = u.pn, pm = u.pm; const bool isctx = pm >= T / 256;
        if (isctx && pn < 4) return;
        if (pn >= 7) {
            unsigned char* V8 = (unsigned char*)Vb;
#pragma unroll
            for (int ai = 0; ai < 2; ++ai) {
                const int row0 = pm * 256 + ai * 128 + wr * 64;
                int b, tile;
                if (!isctx) { b = row0 >> 13; tile = (CTX >> 6) + ((row0 & 8191) >> 6); } else { const int j = row0 - T; b = j >> 8; tile = (j & 255) >> 6; }
#pragma unroll
                for (int bj = 0; bj < 2; ++bj) {
                    const int head = (pn - 7) * 2 + bj;
                    unsigned char* dst = V8 + ((size_t)(b * NH + head) * (KVLEN / 64) + tile) * 8192 + wc * 2048 + fq * 64 + (fr >> 3) * 32 + (fr & 1) * 16 + ((fr >> 1) & 3) * 4;
#pragma unroll
                    for (int e = 0; e < 8; ++e) {
                        int w = __builtin_amdgcn_cvt_pk_fp8_f32(acc[ai][bj][0][e >> 2][e & 3], acc[ai][bj][1][e >> 2][e & 3], 0, false);
                        w = __builtin_amdgcn_cvt_pk_fp8_f32(acc[ai][bj][2][e >> 2][e & 3], acc[ai][bj][3][e >> 2][e & 3], w, true);
                        gp::gst1(dst + e * 256, (unsigned)w);
                    }
                }
            }
            return;
        }
        const int axis = wc & 1; const float* ct = rope + (axis ? 4096 : 0); const float* st = rope + (axis ? 4096 + 1024 : 2048);
#pragma unroll
        for (int ai = 0; ai < 2; ++ai)
#pragma unroll
            for (int m = 0; m < 4; ++m) {
                const int row = pm * 256 + ai * 128 + wr * 64 + m * 16 + fr;
                int t, kb, tile;
                if (!isctx) { kb = row >> 13; t = row & 8191; tile = (CTX >> 6) + (t >> 6); } else { const int j = row - T; t = 0; kb = j >> 8; tile = (j & 255) >> 6; }
                const int pos = axis ? (t & 63) : (t >> 6);
#pragma unroll
                for (int bj = 0; bj < 2; ++bj) {
                    const int col0 = pn * 256 + bj * 128 + wc * 32 + fq * 8;
                    f32x4 v0 = acc[ai][bj][m][0], v1 = acc[ai][bj][m][1];
                    if (pn == 0) { gp::u32x4 w; w.x = gp::cvt_pk_bf16(v0[0], v0[1]); w.y = gp::cvt_pk_bf16(v0[2], v0[3]); w.z = gp::cvt_pk_bf16(v1[0], v1[1]); w.w = gp::cvt_pk_bf16(v1[2], v1[3]);
                        gp::gst4(F + (size_t)row * 256 + col0, w); continue; }
                    if (pn < 7 && !isctx) {
                        const f32x4 c0 = gp::gld4f(ct + pos * 16 + 8 * (fq & 1)), c1 = gp::gld4f(ct + pos * 16 + 8 * (fq & 1) + 4);
                        const f32x4 s0 = gp::gld4f(st + pos * 16 + 8 * (fq & 1)), s1 = gp::gld4f(st + pos * 16 + 8 * (fq & 1) + 4);
                        const float sg = (fq < 2) ? -1.f : 1.f;
#pragma unroll
                        for (int i = 0; i < 4; ++i) {
                            const auto r0 = __builtin_amdgcn_permlane32_swap(__float_as_uint(v0[i]), __float_as_uint(v0[i]), false, false);
                            const auto r1 = __builtin_amdgcn_permlane32_swap(__float_as_uint(v1[i]), __float_as_uint(v1[i]), false, false);
                            const float p0 = __uint_as_float(fq < 2 ? r0[1] : r0[0]), p1 = __uint_as_float(fq < 2 ? r1[1] : r1[0]);
                            v0[i] = v0[i] * c0[i] + sg * p0 * s0[i]; v1[i] = v1[i] * c1[i] + sg * p1 * s1[i]; }
                    }
                    v0 = v0 * SQS; v1 = v1 * SQS;
                    int w0 = __builtin_amdgcn_cvt_pk_fp8_f32(v0[0], v0[1], 0, false); w0 = __builtin_amdgcn_cvt_pk_fp8_f32(v0[2], v0[3], w0, true);
                    int w1 = __builtin_amdgcn_cvt_pk_fp8_f32(v1[0], v1[1], 0, false); w1 = __builtin_amdgcn_cvt_pk_fp8_f32(v1[2], v1[3], w1, true);
                    unsigned char* d;
                    if (pn < 4) d = (unsigned char*)Q + (size_t)row * QKW + (col0 - 256);
                    else d = (unsigned char*)Kb + ((size_t)(kb * NH + (pn - 4) * 2 + bj) * (KVLEN / 64) + tile) * 8192 + wc * 2048 + m * 512 + fr * 32 + fq * 8;
                    gp::gst2(d, (unsigned)w0, (unsigned)w1);
                }
            }
    }
};
struct EpiStoreBf16 {
    bf16_t* O; int ldc;
    __device__ __forceinline__ void operator()(const f32x4 (&acc)[2][2][4][2], const gp::Unit& u, int wr, int wc, int fr, int fq) const {
#pragma unroll
        for (int ai = 0; ai < 2; ++ai)
#pragma unroll
            for (int m = 0; m < 4; ++m) {
                bf16_t* rowp = O + (size_t)(u.pm * 256 + ai * 128 + wr * 64 + m * 16 + fr) * ldc + u.pn * 256 + wc * 32 + fq * 8;
#pragma unroll
                for (int bj = 0; bj < 2; ++bj) { const f32x4 v0 = acc[ai][bj][m][0], v1 = acc[ai][bj][m][1];
                    gp::u32x4 w; w.x = gp::cvt_pk_bf16(v0[0], v0[1]); w.y = gp::cvt_pk_bf16(v0[2], v0[3]); w.z = gp::cvt_pk_bf16(v1[0], v1[1]); w.w = gp::cvt_pk_bf16(v1[2], v1[3]);
                    gp::gst4(rowp + bj * 128, w); }
            }
    }
};

__device__ __forceinline__ void ph_inproj(const Params& p, unsigned char* smem) {
    unsigned char* ws = p.ws;
    gp::DenseSched S; S.init(MTOT, INW, D, ws + WS_WINT, gridDim.x, blockIdx.x);
    EpiInProj E{(bf16_t*)(ws + WS_F), (bf16_t*)(ws + WS_Q), (bf16_t*)(ws + WS_K), (bf16_t*)(ws + WS_V), (const float*)(ws + WS_ROPE)};
    gp::gemm_phase<EpiInProj, gp::DenseSched, true>(p.chunk, (GP_LAS unsigned char*)smem, (const char*)(ws + WS_HX), D, S, E);
}
__device__ __forceinline__ void ph_outproj(const Params& p, unsigned char* smem) {
    unsigned char* ws = p.ws;
    gp::DenseSched S; S.init(T, D, D, ws + WS_WOUTT, gridDim.x, blockIdx.x);
    EpiStoreBf16 E{(bf16_t*)(ws + WS_YX), D};
    gp::gemm_phase<EpiStoreBf16, gp::DenseSched, true>(p.chunk, (GP_LAS unsigned char*)smem, (const char*)(ws + WS_AO), D, S, E);
}

constexpr float GUSCALE = 64.f;
constexpr float WDSCALE = 16.f, ASCALE = 4.f;
struct TItem8 { const float* W; unsigned char* WT; int K, N, row_base, k0, n0; float sc; };
__device__ __forceinline__ void titem8_load(const TItem8& t, float (&tv)[32], int lane) {
#pragma unroll
    for (int i = 0; i < 32; ++i) tv[i] = t.W[(size_t)(t.k0 + 2 * i + (lane >> 5)) * t.N + t.n0 + (lane & 31)];
}
__device__ __forceinline__ void titem8_finish(const TItem8& t, const float (&tv)[32], float* scr, int lane) {
#pragma unroll
    for (int i = 0; i < 32; ++i) scr[(2 * i + (lane >> 5)) * 33 + (lane & 31)] = tv[i] * t.sc;
    asm volatile("s_waitcnt lgkmcnt(0)" ::: "memory");
    const int c = lane & 7;
#pragma unroll
    for (int j = 0; j < 4; ++j) { const int n = (lane >> 3) + 8 * j; const float* s = scr + (8 * c) * 33 + n;
        int w0 = __builtin_amdgcn_cvt_pk_fp8_f32(s[0 * 33], s[1 * 33], 0, false); w0 = __builtin_amdgcn_cvt_pk_fp8_f32(s[2 * 33], s[3 * 33], w0, true);
        int w1 = __builtin_amdgcn_cvt_pk_fp8_f32(s[4 * 33], s[5 * 33], 0, false); w1 = __builtin_amdgcn_cvt_pk_fp8_f32(s[6 * 33], s[7 * 33], w1, true);
        uint2 o; o.x = (unsigned)w0; o.y = (unsigned)w1;
        *(uint2*)(t.WT + (size_t)(t.row_base + t.n0 + n) * t.K + t.k0 + 8 * c) = o; }
    asm volatile("s_waitcnt lgkmcnt(0)" ::: "memory");
}
__device__ __forceinline__ void transpose_item(const float* W, int K, int N, bf16_t* WT, int row_base, int kb, int nb, float* scr, int lane) {
    const int k0 = 64 * kb, n0 = 32 * nb;
    float tv[32];
#pragma unroll
    for (int i = 0; i < 32; ++i) tv[i] = W[(size_t)(k0 + 2 * i + (lane >> 5)) * N + n0 + (lane & 31)];
#pragma unroll
    for (int i = 0; i < 32; ++i) scr[(2 * i + (lane >> 5)) * 33 + (lane & 31)] = tv[i];
    asm volatile("s_waitcnt lgkmcnt(0)" ::: "memory");
    const int c = lane & 7;
#pragma unroll
    for (int j = 0; j < 4; ++j) { const int n = (lane >> 3) + 8 * j; const float* s = scr + (8 * c) * 33 + n;
        uint4 o; o.x = pk2(s[0 * 33], s[1 * 33]); o.y = pk2(s[2 * 33], s[3 * 33]); o.z = pk2(s[4 * 33], s[5 * 33]); o.w = pk2(s[6 * 33], s[7 * 33]);
        *(uint4*)(WT + (size_t)(row_base + n0 + n) * K + k0 + 8 * c) = o; }
    asm volatile("s_waitcnt lgkmcnt(0)" ::: "memory");
}
__device__ __forceinline__ void ph_prep_weights(const Params& p, float* lds, const int part, const int first) {
    const int tid = otid(), wave = tid >> 6, lane = tid & 63;
    float* scr = lds + 8192 + wave * (64 * 33);
    if ((int)blockIdx.x < first) return;
    const int gw = ((int)blockIdx.x - first) * NWV + wave, GW = ((int)gridDim.x - first) * NWV;
    unsigned char* ws = p.ws;
    constexpr int I_IN = 16 * 80, I_OUT = 16 * 32, I_GU = 16 * 8, I_D = 4 * 32;
    constexpr int NITEMS = I_IN + I_OUT + 65 * (2 * I_GU + I_D);
    const int it_lo = part ? I_IN + I_OUT : 0, it_hi = part ? NITEMS : I_IN + I_OUT;
    if (part == 0) {
        for (int it = it_lo + gw; it < it_hi; it += GW) {
            int r = it;
            if (r < I_IN) { transpose_item(p.in[I_WIN], D, INW, (bf16_t*)(ws + WS_WINT), 0, r / 80, r % 80, scr, lane); continue; } r -= I_IN;
            transpose_item(p.in[I_WOUT], D, D, (bf16_t*)(ws + WS_WOUTT), 0, r / 32, r % 32, scr, lane);
        }
        return;
    }
    auto decode = [&](int it, TItem8& t) {
        int r = it - (I_IN + I_OUT);
        const int e = r / (2 * I_GU + I_D); r -= e * (2 * I_GU + I_D);
        if (r < 2 * I_GU) {
            const int half = r / I_GU, q = r % I_GU, kb = q / 8, nb = q % 8;
            t.W = (e < 64) ? p.in[half ? I_WU : I_WG] + (size_t)e * D * DE : p.in[half ? I_WSU : I_WSG];
            const int n0 = 32 * nb, drow = e * 512 + (n0 >> 7) * 256 + half * 128 + (n0 & 127);
            t.WT = ws + WS_WGUT; t.K = D; t.N = DE; t.row_base = drow - n0; t.k0 = 64 * kb; t.n0 = n0; t.sc = GUSCALE;
        } else {
            r -= 2 * I_GU;
            t.W = (e < 64) ? p.in[I_WD] + (size_t)e * DE * D : p.in[I_WSD];
            t.WT = ws + WS_WDT; t.K = DE; t.N = D; t.row_base = e * 1024; t.k0 = 64 * (r / 32); t.n0 = 32 * (r % 32); t.sc = WDSCALE;
        }
    };
    int it = it_lo + gw;
    if (it >= it_hi) return;
    TItem8 ta, tb; float va[32], vb[32];
    decode(it, ta); titem8_load(ta, va, lane);
    for (;;) {
        const bool hb = it + GW < it_hi;
        if (hb) { decode(it + GW, tb); titem8_load(tb, vb, lane); }
        titem8_finish(ta, va, scr, lane);
        if (!hb) break;
        const bool ha = it + 2 * GW < it_hi;
        if (ha) { decode(it + 2 * GW, ta); titem8_load(ta, va, lane); }
        titem8_finish(tb, vb, scr, lane);
        if (!ha) break;
        it += 2 * GW;
    }
}

namespace fa {
typedef short bf16x8 __attribute__((ext_vector_type(8)));
typedef short s16x4 __attribute__((ext_vector_type(4)));
typedef float f32x16 __attribute__((ext_vector_type(16)));
typedef unsigned u32x4 __attribute__((ext_vector_type(4)));
constexpr int KVBLK = 64, LDK = QKW;
constexpr float SCALE = 0.125f, THR = 8.f;
constexpr size_t SHM_V = KVBLK * 128 * 2, SHM_K = KVBLK * 128 * 2;
#define KSWZ(row, colB) ((row) * 256 + ((colB) ^ (((row) & 15) << 4)))
#define SBAR() __builtin_amdgcn_sched_barrier(0)
__device__ __forceinline__ int crow(int r, int hi) { return (r & 3) + 8 * (r >> 2) + 4 * hi; }
__device__ __forceinline__ unsigned cvtpk(float lo, float hi) { unsigned r; asm volatile("v_cvt_pk_bf16_f32 %0, %1, %2" : "=v"(r) : "v"(lo), "v"(hi)); return r; }
constexpr float PBIAS = 5.f, THR2 = PBIAS + 3.5f;
template <bool FIRST>
__device__ __forceinline__ void partialSM(f32x16& p0, f32x16& p1, float& m_reg, f32x16& negm, float& alpha) {
  float pmax = p0[0];
#pragma unroll
  for (int r = 1; r < 16; ++r) pmax = fmaxf(pmax, p0[r]);
#pragma unroll
  for (int r = 0; r < 16; ++r) pmax = fmaxf(pmax, p1[r]);
  { auto rr = __builtin_amdgcn_permlane32_swap(__float_as_uint(pmax), __float_as_uint(pmax), false, false);
    pmax = fmaxf(__uint_as_float(rr[0]), __uint_as_float(rr[1])); }
  if (!FIRST && __builtin_expect(__all(pmax <= THR2), 1)) { alpha = 1.f; }
  else { const float dl = FIRST ? pmax - PBIAS : fmaxf(pmax - PBIAS, 0.f); alpha = FIRST ? 0.f : __builtin_amdgcn_exp2f(-dl); m_reg += dl;
#pragma unroll
    for (int r = 0; r < 16; ++r) { p0[r] -= dl; p1[r] -= dl; }
#pragma unroll
    for (int r = 0; r < 16; ++r) negm[r] = -m_reg;
    asm volatile("" : "+v"(negm)); }
#pragma unroll
  for (int r = 0; r < 16; ++r) p0[r] = __builtin_amdgcn_exp2f(p0[r]);
}
typedef int i32x8 __attribute__((ext_vector_type(8)));
__device__ __forceinline__ int pk4_fp8(float a, float b, float c, float d) { int w; asm("v_cvt_pk_fp8_f32 %0, %1, %2" : "=v"(w) : "v"(a), "v"(b)); asm("v_cvt_pk_fp8_f32 %0, %1, %2 op_sel:[0,0,1]" : "+v"(w) : "v"(c), "v"(d)); return w; }
__device__ __forceinline__ void finishSM_T(f32x16& p0, f32x16& p1, i32x8& pb) {
#pragma unroll
  for (int r = 0; r < 16; ++r) p1[r] = __builtin_amdgcn_exp2f(p1[r]);
#pragma unroll
  for (int g = 0; g < 4; ++g) {
    pb[g] = pk4_fp8(p0[4 * g], p0[4 * g + 1], p0[4 * g + 2], p0[4 * g + 3]); pb[4 + g] = pk4_fp8(p1[4 * g], p1[4 * g + 1], p1[4 * g + 2], p1[4 * g + 3]); }
}
__device__ __forceinline__ void qkt(f32x16& p0, f32x16& p1, const char* Ks, const i32x8 qf, int lane, int mm, const f32x16& negm) {
  const char* kp = Ks + mm * 4096 + lane * 16;
  const u32x4 a0 = *reinterpret_cast<const u32x4*>(kp), a1 = *reinterpret_cast<const u32x4*>(kp + 1024), b0 = *reinterpret_cast<const u32x4*>(kp + 2048), b1 = *reinterpret_cast<const u32x4*>(kp + 3072);
  p0 = __builtin_amdgcn_mfma_scale_f32_32x32x64_f8f6f4((i32x8){(int)a0.x, (int)a0.y, (int)a0.z, (int)a0.w, (int)a1.x, (int)a1.y, (int)a1.z, (int)a1.w}, qf, negm, 0, 0, 0, 0, 0, 0);
  p1 = __builtin_amdgcn_mfma_scale_f32_32x32x64_f8f6f4((i32x8){(int)b0.x, (int)b0.y, (int)b0.z, (int)b0.w, (int)b1.x, (int)b1.y, (int)b1.z, (int)b1.w}, qf, negm, 0, 0, 0, 0, 0, 0);
}
__device__ __forceinline__ int v_st(int k, int c) { const int kk = (k & ~0xC) | ((k & 4) << 1) | ((k & 8) >> 1); return ((kk >> 3) * 4 + (c >> 5)) * 512 + ((kk & 7) * 32 + (c & 31)) * 2; }
__device__ __forceinline__ int v_rd_base(int lane) { return ((lane & 3) << 3) | (((lane >> 2) & 3) << 6) | (((lane >> 4) & 1) << 5) | (((lane >> 5) & 1) << 8); }
constexpr int v_rd_off(int d0, int ks, int half) { return d0 * 512 + ks * 4096 + half * 2048; }
template <int OFF> __device__ __forceinline__ s16x4 tr_read(int vb) {
  s16x4 r; asm volatile("ds_read_b64_tr_b16 %0, %1 offset:%2" : "=&v"(r) : "v"(vb), "i"(OFF) : "memory"); return r;
}
template <int D0> __device__ __forceinline__ void pv_one(f32x16& od, int vb, bf16x8 pa0, bf16x8 pa1, bf16x8 pa2, bf16x8 pa3) {
  const s16x4 l0 = tr_read<v_rd_off(D0, 0, 0)>(vb), h0 = tr_read<v_rd_off(D0, 0, 1)>(vb), l1 = tr_read<v_rd_off(D0, 1, 0)>(vb), h1 = tr_read<v_rd_off(D0, 1, 1)>(vb);
  const s16x4 l2 = tr_read<v_rd_off(D0, 2, 0)>(vb), h2 = tr_read<v_rd_off(D0, 2, 1)>(vb), l3 = tr_read<v_rd_off(D0, 3, 0)>(vb), h3 = tr_read<v_rd_off(D0, 3, 1)>(vb);
  asm volatile("s_waitcnt lgkmcnt(0)" ::: "memory"); SBAR();
#define PK(L, H) (bf16x8){L[0], L[1], L[2], L[3], H[0], H[1], H[2], H[3]}
  od = __builtin_amdgcn_mfma_f32_32x32x16_bf16(pa0, PK(l0, h0), od, 0, 0, 0);
  od = __builtin_amdgcn_mfma_f32_32x32x16_bf16(pa1, PK(l1, h1), od, 0, 0, 0);
  od = __builtin_amdgcn_mfma_f32_32x32x16_bf16(pa2, PK(l2, h2), od, 0, 0, 0);
  od = __builtin_amdgcn_mfma_f32_32x32x16_bf16(pa3, PK(l3, h3), od, 0, 0, 0);
#undef PK
}
__device__ __forceinline__ void pv_d0(f32x16* o, int vb, bf16x8 pa0, bf16x8 pa1, bf16x8 pa2, bf16x8 pa3) {
  pv_one<0>(o[0], vb, pa0, pa1, pa2, pa3); pv_one<1>(o[1], vb, pa0, pa1, pa2, pa3); pv_one<2>(o[2], vb, pa0, pa1, pa2, pa3); pv_one<3>(o[3], vb, pa0, pa1, pa2, pa3);
}

template <int OFF> __device__ __forceinline__ u32x4 rd128(int vb) { u32x4 r; asm volatile("ds_read_b128 %0, %1 offset:%2" : "=&v"(r) : "v"(vb), "i"(OFF) : "memory"); return r; }
#define PV_RD(D0) const u32x4 va##D0 = rd128<D0 * 2048>(vb), vc##D0 = rd128<D0 * 2048 + 1024>(vb); SBAR()
#define PV_MM(D0) do { asm volatile("s_waitcnt lgkmcnt(0)" ::: "memory"); SBAR(); \
    o[D0] = __builtin_amdgcn_mfma_scale_f32_32x32x64_f8f6f4((i32x8){(int)va##D0.x, (int)va##D0.y, (int)va##D0.z, (int)va##D0.w, (int)vc##D0.x, (int)vc##D0.y, (int)vc##D0.z, (int)vc##D0.w}, pb, o[D0], 0, 0, 0, 0, 0, 0); } while (0)
__device__ __forceinline__ float max3f(float a, float b, float c) { float r; asm("v_max3_f32 %0, %1, %2, %3" : "=v"(r) : "v"(a), "v"(b), "v"(c)); return r; }
#define PV_LSUM() lacc = __builtin_amdgcn_mfma_scale_f32_32x32x64_f8f6f4((i32x8){0x38383838, 0x38383838, 0x38383838, 0x38383838, 0x38383838, 0x38383838, 0x38383838, 0x38383838}, pb, lacc, 0, 0, 0, 0, 0, 0)
__device__ __forceinline__ void pv_psm(f32x16* o, f32x16& lacc, int vb, i32x8 pb, f32x16& p0, f32x16& p1, float& m_reg, f32x16& negm, float& alpha) {
  float pmax;
  { PV_RD(0);
    pmax = max3f(p0[0], p0[1], p0[2]);
#pragma unroll
    for (int r = 3; r < 15; r += 2) pmax = max3f(pmax, p0[r], p0[r + 1]);
    pmax = max3f(pmax, p0[15], p1[0]);
    SBAR(); PV_MM(0); }
  { PV_RD(1);
#pragma unroll
    for (int r = 1; r < 15; r += 2) pmax = max3f(pmax, p1[r], p1[r + 1]);
    pmax = max3f(pmax, p1[15], p1[15]);
    { auto rr = __builtin_amdgcn_permlane32_swap(__float_as_uint(pmax), __float_as_uint(pmax), false, false);
      pmax = max3f(__uint_as_float(rr[0]), __uint_as_float(rr[1]), __uint_as_float(rr[1])); }
    if (__builtin_expect(__all(pmax <= THR2), 1)) { alpha = 1.f; }
    else { const float dl = fmaxf(pmax - PBIAS, 0.f); alpha = __builtin_amdgcn_exp2f(-dl); m_reg += dl;
#pragma unroll
      for (int r = 0; r < 16; ++r) { p0[r] -= dl; p1[r] -= dl; }
#pragma unroll
      for (int r = 0; r < 16; ++r) negm[r] = -m_reg;
      asm volatile("" : "+v"(negm)); }
    SBAR(); PV_MM(1); }
  { PV_RD(2);
#pragma unroll
    for (int r = 0; r < 8; ++r) p0[r] = __builtin_amdgcn_exp2f(p0[r]);
    asm volatile("" : "+v"(p0));
    SBAR(); PV_MM(2); }
  { PV_RD(3);
#pragma unroll
    for (int r = 8; r < 16; ++r) p0[r] = __builtin_amdgcn_exp2f(p0[r]);
    asm volatile("" : "+v"(p0));
    SBAR(); PV_MM(3); PV_LSUM(); }
}
__device__ __forceinline__ void pvT_d0(f32x16* o, f32x16& lacc, int vb, i32x8 pb) {
  { PV_RD(0); PV_MM(0); } { PV_RD(1); PV_MM(1); } { PV_RD(2); PV_MM(2); } { PV_RD(3); PV_MM(3); PV_LSUM(); }
}
#undef PV_RD
#undef PV_MM
#undef PV_LSUM

__device__ __forceinline__ void attn_unit(const unsigned char* __restrict__ Qb, const unsigned char* __restrict__ Kh, const unsigned char* __restrict__ Vh, bf16_t* __restrict__ Ob,
                                          const float* __restrict__ gsub, const float lam, char* lds, const int wv) {
  typedef __attribute__((address_space(3))) unsigned* ldsu_t;
  const int tid = otid_w(wv), wid = wv, lane = tid & 63, r32 = lane & 31, hi = lane >> 5, mm = wid >> 2, wq = wid & 3;
  constexpr int NB = 4;
  constexpr int SHM_V8 = KVBLK * 128;
  char* V_lds = lds; char* K_lds = lds + NB * SHM_V8; constexpr int SHM_K8 = KVBLK * 128;
  float m_reg = 0.f; f32x16 o[4] = {}; f32x16 lacc = {}; i32x8 qf; f32x16 negm = {}; asm volatile("" : "+v"(negm));
  const unsigned koff = (unsigned)((2 * (wid >> 2) + (lane >> 5)) * 2048 + (lane & 3) * 512 + (8 * ((wid >> 1) & 1) + 2 * ((lane & 31) >> 3) + ((lane >> 2) & 1)) * 32 + (wid & 1) * 16);
  const unsigned voff = (unsigned)((wid >> 1) * 2048 + (lane & 7) * 256 + ((lane >> 3) & 3) * 64 + (wid & 1) * 32 + (lane >> 5) * 16);
#define DMA(t, buf) do { const char* kb_ = (const char*)(Kh + (size_t)(t) * SHM_K8); const char* vb_ = (const char*)(Vh + (size_t)(t) * SHM_V8); asm volatile("" : "+s"(kb_), "+s"(vb_)); \
    __builtin_amdgcn_global_load_lds((const unsigned*)(kb_ + koff), (ldsu_t)(K_lds + (buf) * SHM_K8 + wid * 1024), 16, 0, 0); \
    __builtin_amdgcn_global_load_lds((const unsigned*)(vb_ + voff), (ldsu_t)(V_lds + (buf) * SHM_V8 + wid * 1024), 16, 0, 0); } while (0)
#define WAIT_BAR(N) asm volatile("s_waitcnt vmcnt(" #N ") lgkmcnt(0)\n\ts_barrier" ::: "memory")
#define RESC(a) do { if (__any((a) < 1.f)) { _Pragma("unroll") for (int d = 0; d < 4; ++d) _Pragma("unroll") for (int r = 0; r < 16; ++r) o[d][r] *= (a); lacc[0] *= (a); } } while (0)
  DMA(0, 0); DMA(1, 1);
  { const unsigned char* Qw = Qb + (long)(wq * 32 + r32) * QKW + mm * 64 + hi * 32;
    const u32x4 q0 = *reinterpret_cast<const u32x4*>(Qw), q1 = *reinterpret_cast<const u32x4*>(Qw + 16);
    qf = (i32x8){(int)q0.x, (int)q0.y, (int)q0.z, (int)q0.w, (int)q1.x, (int)q1.y, (int)q1.z, (int)q1.w}; }
  const int vb0 = (int)(uintptr_t)V_lds + lane * 16;
  f32x16 pA0, pA1, pB0, pB1; float alA, alB; i32x8 pb; constexpr int NTL = KVLEN / KVBLK;
  WAIT_BAR(0);
  DMA(2, 2);
  qkt(pA0, pA1, K_lds, qf, lane, mm, negm); partialSM<true>(pA0, pA1, m_reg, negm, alA);
  WAIT_BAR(2);
  for (int j = 1; j + 1 < NTL; j += 2) {
    DMA(j + 2, (j + 2) & 3);
    SBAR(); qkt(pB0, pB1, K_lds + (j & 3) * SHM_K8, qf, lane, mm, negm);
    finishSM_T(pA0, pA1, pb); SBAR();
    pv_psm(o, lacc, vb0 + ((j - 1) & 3) * SHM_V8, pb, pB0, pB1, m_reg, negm, alB);
    RESC(alB);
    WAIT_BAR(2);
    if (j + 3 < NTL) DMA(j + 3, (j + 3) & 3);
    SBAR(); qkt(pA0, pA1, K_lds + ((j + 1) & 3) * SHM_K8, qf, lane, mm, negm);
    finishSM_T(pB0, pB1, pb); SBAR();
    pv_psm(o, lacc, vb0 + (j & 3) * SHM_V8, pb, pA0, pA1, m_reg, negm, alA);
    RESC(alA);
    if (j + 3 < NTL) WAIT_BAR(2); else WAIT_BAR(0);
  }
  SBAR(); qkt(pB0, pB1, K_lds + ((NTL - 1) & 3) * SHM_K8, qf, lane, mm, negm);
  finishSM_T(pA0, pA1, pb); SBAR();
  pv_psm(o, lacc, vb0 + ((NTL - 2) & 3) * SHM_V8, pb, pB0, pB1, m_reg, negm, alB);
  RESC(alB);
  finishSM_T(pB0, pB1, pb); SBAR();
  pvT_d0(o, lacc, vb0 + ((NTL - 1) & 3) * SHM_V8, pb);
#undef DMA
#undef WAIT_BAR
  const float rl = __builtin_amdgcn_rcpf(lacc[0]) * (mm ? lam : 1.0f);
  __syncthreads();
  constexpr int XS = 132;
  float* X = (float*)lds;
  if (mm == 1) {
#pragma unroll
    for (int r = 0; r < 16; ++r)
#pragma unroll
      for (int d0 = 0; d0 < 4; ++d0) X[(wq * 32 + r32) * XS + d0 * 32 + crow(r, hi)] = o[d0][r] * rl;
  }
  __syncthreads();
  if (mm == 0) {
#pragma unroll
    for (int r = 0; r < 16; ++r)
#pragma unroll
      for (int d0 = 0; d0 < 4; ++d0) { float* xp = X + (wq * 32 + r32) * XS + d0 * 32 + crow(r, hi); *xp = o[d0][r] * rl - *xp; }
  }
  __syncthreads();
  {
    const int row = tid >> 2, seg = tid & 3;
    const float* xr = X + row * XS + seg * 32;
    f32x4 v[8]; float ss = 0.f;
#pragma unroll
    for (int i = 0; i < 8; ++i) { v[i] = *(const f32x4*)(xr + 4 * i); ss += v[i][0] * v[i][0] + v[i][1] * v[i][1] + v[i][2] * v[i][2] + v[i][3] * v[i][3]; }
    ss += sx<1>(ss); ss += sx<2>(ss);
    const float rs = (1.0f - LAM_INIT) / sqrtf(ss * (1.0f / 128.0f) + EPS);
    bf16_t* dst = Ob + (long)row * D + seg * 32;
#pragma unroll
    for (int i = 0; i < 8; i += 2) {
      const f32x4 g0 = *(const f32x4*)(gsub + seg * 32 + 4 * i), g1 = *(const f32x4*)(gsub + seg * 32 + 4 * i + 4);
      u32x4 w; w.x = cvtpk(v[i][0] * rs * g0[0], v[i][1] * rs * g0[1]); w.y = cvtpk(v[i][2] * rs * g0[2], v[i][3] * rs * g0[3]);
      w.z = cvtpk(v[i + 1][0] * rs * g1[0], v[i + 1][1] * rs * g1[1]); w.w = cvtpk(v[i + 1][2] * rs * g1[2], v[i + 1][3] * rs * g1[3]);
      *(u32x4*)(dst + 4 * i) = w;
    }
  }
  __syncthreads();
#undef RESC
}
#undef KSWZ
#undef SBAR
}

__device__ __forceinline__ void ph_attn(const Params& p, unsigned char* smem) {
    unsigned char* ws = p.ws;
    const unsigned char* Q = ws + WS_Q; const unsigned char* Kb = ws + WS_K; const unsigned char* Vb = ws + WS_V;
    bf16_t* AO = (bf16_t*)(ws + WS_AO);
    const float lam = ((const float*)(ws + WS_CTL))[1024];
    const int c = blockIdx.x, G = gridDim.x;
    if (G == 256) {
        const int x = c & 7, s = c >> 3;
        for (int rd = 0; rd < 6; ++rd) {
            const int bh = rd * 4 + (x >> 1), qb = (x & 1) * 32 + s, b = bh / NH, h = bh % NH;
            fa::attn_unit(Q + ((size_t)b * SEQ + qb * 128) * QKW + h * 128, Kb + (size_t)(b * NH + h) * (KVLEN / 64) * 8192, Vb + (size_t)(b * NH + h) * (KVLEN / 64) * 8192,
                          AO + ((size_t)b * SEQ + qb * 128) * D + 256 + h * 128, p.in[I_GSUB], lam, (char*)smem, p.chunk);
        }
    } else {
        for (int u = c; u < BATCH * NH * 64; u += G) {
            const int bh = u >> 6, qb = u & 63, b = bh / NH, h = bh % NH;
            fa::attn_unit(Q + ((size_t)b * SEQ + qb * 128) * QKW + h * 128, Kb + (size_t)(b * NH + h) * (KVLEN / 64) * 8192, Vb + (size_t)(b * NH + h) * (KVLEN / 64) * 8192,
                          AO + ((size_t)b * SEQ + qb * 128) * D + 256 + h * 128, p.in[I_GSUB], lam, (char*)smem, p.chunk);
        }
    }
}

__device__ __forceinline__ void ph_fourierA(const Params& p, unsigned char* smem) {
    using namespace fa;
    unsigned char* ws = p.ws;
    const bf16_t* F = (const bf16_t*)(ws + WS_F); bf16_t* FY = (bf16_t*)(ws + WS_FY); const bf16_t* W = (const bf16_t*)(ws + WS_W128E);
    const int tid = otid(), wid = tid >> 6, lane = tid & 63, r32 = lane & 31, hi = lane >> 5;
    const int sr = tid >> 4, sc = (tid & 15) * 8, vst0 = v_st(sr, sc), vst1 = v_st(32 + sr, sc);
    const int vb0 = (int)(uintptr_t)smem + v_rd_base(lane);
    for (int task = blockIdx.x; task < BATCH * 64; task += gridDim.x) {
        const int b = task >> 6, n2 = task & 63;
        bf16x8 st[4][2];
#pragma unroll
        for (int kt = 0; kt < 2; ++kt)
#pragma unroll
            for (int ct = 0; ct < 2; ++ct) {
                st[kt * 2 + ct][0] = *(const bf16x8*)(F + ((size_t)b * SEQ + 64 * (64 * kt + sr) + n2) * 256 + 128 * ct + sc);
                st[kt * 2 + ct][1] = *(const bf16x8*)(F + ((size_t)b * SEQ + 64 * (64 * kt + 32 + sr) + n2) * 256 + 128 * ct + sc);
            }
        bf16x8 pa[2][4];
#pragma unroll
        for (int kt = 0; kt < 2; ++kt)
#pragma unroll
            for (int ks = 0; ks < 4; ++ks) pa[kt][ks] = *(const bf16x8*)(W + (size_t)(32 * wid + r32) * 128 + 64 * kt + 16 * ks + 8 * hi);
        __syncthreads();
#pragma unroll
        for (int q = 0; q < 4; ++q) { *(bf16x8*)(smem + q * 16384 + vst0) = st[q][0]; *(bf16x8*)(smem + q * 16384 + vst1) = st[q][1]; }
        __syncthreads();
        f32x16 o[2][4] = {};
#pragma unroll
        for (int ct = 0; ct < 2; ++ct)
#pragma unroll
            for (int kt = 0; kt < 2; ++kt) pv_d0(o[ct], vb0 + (kt * 2 + ct) * 16384, pa[kt][0], pa[kt][1], pa[kt][2], pa[kt][3]);
        const int plane = wid >> 2;
#pragma unroll
        for (int r = 0; r < 16; ++r) {
            const int k1 = 32 * (wid & 3) + crow(r, hi);
            bf16_t* dst = FY + ((((size_t)plane * BATCH + b) * 128 + k1) * 64 + n2) * 256 + r32;
#pragma unroll
            for (int ct = 0; ct < 2; ++ct)
#pragma unroll
                for (int d0 = 0; d0 < 4; ++d0) dst[128 * ct + 32 * d0] = f2bf(o[ct][d0][r]);
        }
    }
    __syncthreads();
}
__device__ __forceinline__ void ph_fourierB(const Params& p, unsigned char* smem) {
    using namespace fa;
    unsigned char* ws = p.ws;
    const bf16_t* FY = (const bf16_t*)(ws + WS_FY); const float2* tabw = (const float2*)(ws + WS_TABW);
    const bf16_t* M64 = (const bf16_t*)(ws + WS_M64E); const bf16_t* GT = (const bf16_t*)(ws + WS_GT);
    bf16_t* AO = (bf16_t*)(ws + WS_AO);
    const int tid = otid(), wid = tid >> 6, lane = tid & 63, r32 = lane & 31, hi = lane >> 5;
    const int sr = tid >> 4, sc = (tid & 15) * 8, vst0 = v_st(sr, sc), vst1 = v_st(32 + sr, sc);
    const int vb0 = (int)(uintptr_t)smem + v_rd_base(lane);
    constexpr int XRS = 528;
    unsigned char* XL = smem + 65536;
    const int mt = wid & 3, ctw = wid >> 2;
    for (int task = blockIdx.x; task < BATCH * 128; task += gridDim.x) {
        const int b = task >> 7, k1 = task & 127;
        __syncthreads();
#pragma unroll
        for (int ct = 0; ct < 2; ++ct)
#pragma unroll
            for (int rh = 0; rh < 2; ++rh) {
                const int n2 = sr + 32 * rh;
                const size_t off = ((((size_t)b) * 128 + k1) * 64 + n2) * 256 + 128 * ct + sc;
                const uint4 yr = *(const uint4*)(FY + off), yi = *(const uint4*)(FY + (size_t)BATCH * 128 * 64 * 256 + off);
                const float2 tw = tabw[n2 * k1];
                const unsigned yrw[4] = {yr.x, yr.y, yr.z, yr.w}, yiw[4] = {yi.x, yi.y, yi.z, yi.w};
                unsigned zr[4], zi[4];
#pragma unroll
                for (int q = 0; q < 4; ++q) {
                    const float a0 = __uint_as_float(yrw[q] << 16), a1 = __uint_as_float(yrw[q] & 0xffff0000u), b0 = __uint_as_float(yiw[q] << 16), b1 = __uint_as_float(yiw[q] & 0xffff0000u);
                    zr[q] = pk2(a0 * tw.x + b0 * tw.y, a1 * tw.x + b1 * tw.y); zi[q] = pk2(b0 * tw.x - a0 * tw.y, b1 * tw.x - a1 * tw.y);
                }
                const int vs = rh ? vst1 : vst0;
                *(uint4*)(smem + (0 * 2 + ct) * 16384 + vs) = make_uint4(zr[0], zr[1], zr[2], zr[3]);
                *(uint4*)(smem + (1 * 2 + ct) * 16384 + vs) = make_uint4(zi[0], zi[1], zi[2], zi[3]);
            }
        __syncthreads();
        {
            f32x16 o[4] = {};
#pragma unroll
            for (int kt = 0; kt < 2; ++kt) {
                bf16x8 pa[4];
#pragma unroll
                for (int ks = 0; ks < 4; ++ks) pa[ks] = *(const bf16x8*)(M64 + (size_t)(32 * mt + r32) * 128 + 64 * kt + 16 * ks + 8 * hi);
                pv_d0(o, vb0 + (kt * 2 + ctw) * 16384, pa[0], pa[1], pa[2], pa[3]);
            }
#pragma unroll
            for (int r = 0; r < 16; ++r) {
                const int ro = 32 * mt + crow(r, hi);
                bf16_t* xr = (bf16_t*)(XL + ((ro >> 6) * 64 + (ro & 63)) * XRS) + 128 * ctw + r32;
#pragma unroll
                for (int d0 = 0; d0 < 4; ++d0) xr[32 * d0] = f2bf(o[d0][r]);
            }
        }
        __syncthreads();
#pragma unroll
        for (int tt = 0; tt < 2; ++tt) {
            const int tau = 2 * wid + tt, g = tau >> 2, mt2 = (tau >> 1) & 1, nt2 = tau & 1;
            f32x16 acc = {};
#pragma unroll
            for (int ks8 = 0; ks8 < 8; ++ks8) {
                const int part = ks8 >> 2, cb = ks8 & 3;
                const bf16x8 af = *(const bf16x8*)(XL + (part * 64 + 32 * mt2 + r32) * XRS + (g * 64 + 16 * cb + 8 * hi) * 2);
                const bf16x8 bfr = *(const bf16x8*)(GT + ((size_t)g * 64 + 32 * nt2 + r32) * 128 + part * 64 + 16 * cb + 8 * hi);
                acc = __builtin_amdgcn_mfma_f32_32x32x16_bf16(af, bfr, acc, 0, 0, 0);
            }
#pragma unroll
            for (int r = 0; r < 16; ++r) { const int k2 = 32 * mt2 + crow(r, hi);
                AO[((size_t)b * SEQ + k1 + 128 * k2) * D + g * 64 + 32 * nt2 + r32] = f2bf(acc[r]); }
        }
    }
    __syncthreads();
}

__device__ __forceinline__ void ph_mid(const Params& p, unsigned char* smem) {
    typedef short bf16x8 __attribute__((ext_vector_type(8)));
    unsigned char* ws = p.ws;
    const int tid = otid(), wave = tid >> 6, lane = tid & 63, fr = lane & 15, fq = lane >> 4;
    const float* mod = (const float*)(ws + WS_MOD);
    const bf16_t* YX = (const bf16_t*)(ws + WS_YX);
    unsigned char* H2 = ws + WS_H2;
    unsigned* counts = (unsigned*)(ws + WS_CTL);
    int* TE = (int*)(ws + WS_TE); int* TP = (int*)(ws + WS_TP); float* TW = (float*)(ws + WS_TW); int* TOKL = (int*)(ws + WS_TOKL);
    constexpr int RS = 2064;
    unsigned char* Ahi = smem; unsigned char* Alo = smem + 16 * RS; float* Pp = (float*)(smem + 2 * 16 * RS + 512);
    const float rbias = p.in[I_RB][lane];
    int* lcnt = (int*)(smem + 99328); int* gb = lcnt + 64; int* PE = gb + 64; float* PW = (float*)(PE + 1024); float* PV = PW + 1024;
    for (int chunk = blockIdx.x; chunk < T / 128; chunk += gridDim.x) {
      const int mc = chunk * 128, b = mc >> 13;
      if (tid < 64) lcnt[tid] = 0;
      {
          const float* mrow_ = mod + b * 6144;
          for (int i = tid; i < 5 * 256; i += NT) { const int v_ = i >> 8, q_ = (i & 255) * 4;
              const float* s_ = (v_ == 0) ? p.in[I_GAPOST] + q_ : (v_ == 1) ? mrow_ + 2 * 1024 + q_ : (v_ == 2) ? p.in[I_GFPRE] + q_ : (v_ == 3) ? mrow_ + 3 * 1024 + q_ : mrow_ + 4 * 1024 + q_;
              *(f32x4*)(PV + v_ * 1024 + q_) = *(const f32x4*)s_; }
          __syncthreads();
      }
      uint2 yw[2][4]; f32x4 xv[2][4];
      bf16x8 wfr[4][4];
      { const bf16_t* wrt_ = (const bf16_t*)(ws + WS_WRT) + (size_t)p.chunk * 16 * 1024; asm volatile("" : "+s"(wrt_));
#pragma unroll
        for (int ks = 0; ks < 4; ++ks) {
#pragma unroll
          for (int nb = 0; nb < 4; ++nb) wfr[ks][nb] = *(const bf16x8*)(wrt_ + (size_t)((ks * 4 + nb) * 2 * 64 + lane) * 8);
          __builtin_amdgcn_sched_barrier(0); } }
#define MID_LOAD(m0_) do { _Pragma("unroll") for (int rr = 0; rr < 2; ++rr) { const int m_ = (m0_) + 2 * wave + rr; _Pragma("unroll") for (int j = 0; j < 4; ++j) { \
          yw[rr][j] = *(const uint2*)(YX + (size_t)m_ * D + 4 * (lane + 64 * j)); xv[rr][j] = ((const f32x4*)(p.in[I_X] + (size_t)m_ * D))[lane + 64 * j]; } } } while (0)
      MID_LOAD(mc);
#pragma unroll 1
      for (int it = 0; it < 8; ++it) {
        const int m0 = mc + it * 16;
        {
            float ss[2] = {0.f, 0.f};
#define YV(rr, j, i) ((i) == 0 ? __uint_as_float(yw[rr][j].x << 16) : (i) == 1 ? __uint_as_float(yw[rr][j].x & 0xffff0000u) : (i) == 2 ? __uint_as_float(yw[rr][j].y << 16) : __uint_as_float(yw[rr][j].y & 0xffff0000u))
#pragma unroll
            for (int rr = 0; rr < 2; ++rr) {
#pragma unroll
                for (int j = 0; j < 4; ++j) ss[rr] += YV(rr, j, 0) * YV(rr, j, 0) + YV(rr, j, 1) * YV(rr, j, 1) + YV(rr, j, 2) * YV(rr, j, 2) + YV(rr, j, 3) * YV(rr, j, 3);
                ss[rr] = wave_sum(ss[rr]);
            }
#pragma unroll
            for (int rr = 0; rr < 2; ++rr) {
                const int lr = 2 * wave + rr, m = m0 + lr;
                const float r1 = 1.0f / sqrtf(ss[rr] * (1.0f / D) + EPS);
                float ss2 = 0.f;
#pragma unroll
                for (int j = 0; j < 4; ++j) {
                    const int col = 4 * (lane + 64 * j);
                    const f32x4 gp = *(const f32x4*)(PV + col), gt = *(const f32x4*)(PV + 1024 + col);
#pragma unroll
                    for (int i = 0; i < 4; ++i) { xv[rr][j][i] = xv[rr][j][i] + gt[i] * (YV(rr, j, i) * r1 * gp[i]); ss2 += xv[rr][j][i] * xv[rr][j][i]; }
                    ((f32x4*)(p.out + (size_t)m * D))[lane + 64 * j] = xv[rr][j];
                }
                ss2 = wave_sum(ss2);
                const float r2 = 1.0f / sqrtf(ss2 * (1.0f / D) + EPS);
#pragma unroll
                for (int j = 0; j < 4; ++j) {
                    const int col = 4 * (lane + 64 * j);
                    const f32x4 gp = *(const f32x4*)(PV + 2048 + col), sh = *(const f32x4*)(PV + 3072 + col), sc = *(const f32x4*)(PV + 4096 + col);
                    float h[4];
#pragma unroll
                    for (int i = 0; i < 4; ++i) h[i] = xv[rr][j][i] * r2 * gp[i] * (1.f + sc[i]) + sh[i];
                    uint2 o; o.x = pk2(h[0], h[1]); o.y = pk2(h[2], h[3]);
                    { int w8 = __builtin_amdgcn_cvt_pk_fp8_f32(h[0], h[1], 0, false); w8 = __builtin_amdgcn_cvt_pk_fp8_f32(h[2], h[3], w8, true); *(int*)(H2 + (size_t)m * D + col) = w8; }
                    *(uint2*)(Ahi + lr * RS + col * 2) = o;
                }
            }
            if (it < 7) MID_LOAD(m0 + 16);
        }
        asm volatile("s_waitcnt lgkmcnt(0)\n\ts_barrier" ::: "memory");
        {
            f32x4 acc[4];
#pragma unroll
            for (int nb = 0; nb < 4; ++nb) acc[nb] = (f32x4){0.f, 0.f, 0.f, 0.f};
#pragma unroll
            for (int ks = 0; ks < 4; ++ks) {
                const int ko = (wave * 128 + ks * 32 + 8 * fq) * 2;
                const bf16x8 ah = *(const bf16x8*)(Ahi + fr * RS + ko);
#pragma unroll
                for (int nb = 0; nb < 4; ++nb) acc[nb] = __builtin_amdgcn_mfma_f32_16x16x32_bf16(ah, wfr[ks][nb], acc[nb], 0, 0, 0);
            }
#pragma unroll
            for (int nb = 0; nb < 4; ++nb)
#pragma unroll
                for (int j = 0; j < 4; ++j) Pp[(wave * 16 + 4 * fq + j) * 64 + 16 * nb + fr] = acc[nb][j];
        }
        asm volatile("s_waitcnt lgkmcnt(0)\n\ts_barrier" ::: "memory");
#pragma unroll
        for (int rr = 0; rr < 2; ++rr) {
            const int lr = 2 * wave + rr;
            float lg = 0.f;
#pragma unroll
            for (int w = 0; w < 8; ++w) lg += Pp[(w * 16 + lr) * 64 + lane];
            const float score = 1.0f / (1.0f + expf(-lg));
            const float sel = score + rbias;
            float t1 = sel, t2 = -INFINITY;
#define TOP2(M) do { const float o1 = sx<M>(t1), o2 = sx<M>(t2); const float n1 = fmaxf(t1, o1), n2 = fmaxf(fminf(t1, o1), fmaxf(t2, o2)); t1 = n1; t2 = n2; } while (0)
            TOP2(1); TOP2(2); TOP2(4);
#undef TOP2
            const float gs = t1 + t2; const int grp = lane >> 3;
            int gr = 0;
#pragma unroll
            for (int j = 0; j < 8; ++j) { const float sj = __uint_as_float(__builtin_amdgcn_readlane(__float_as_uint(gs), j * 8)); gr += (sj > gs || (sj == gs && j < grp)) ? 1 : 0; }
            const bool gsel = gr < 4;
            float v = gsel ? sel : -INFINITY;
            int rk = TOPK;
#pragma unroll
            for (int it8 = 0; it8 < TOPK; ++it8) {
                const float mx = wave_max(v);
                const unsigned long long eq = __ballot(v == mx);
                const int win = __builtin_ctzll(eq);
                if (lane == win) { rk = it8; v = -INFINITY; }
            }
            const bool chosen = rk < TOPK;
            const float ssum = wave_sum(chosen ? score : 0.f);
            const float w = score / (ssum + 1e-20f) * 2.5f;
            if (chosen) {
                const int lpos = atomicAdd(&lcnt[lane], 1);
                const int idx = (it * 16 + lr) * 8 + rk;
                PE[idx] = lane | (lpos << 8); PW[idx] = w;
            }
        }
      }
      __syncthreads();
      if (tid < 64) { const int c = lcnt[tid]; gb[tid] = c ? (int)atomicAdd(&counts[b * 65 + tid], (unsigned)c) : 0; }
      __syncthreads();
      for (int i = tid; i < 1024; i += NT) {
          const int pe = PE[i], e = pe & 255, pos = gb[e] + (pe >> 8), mk = mc * 8 + i;
          TOKL[((size_t)b * 64 + e) * 8192 + pos] = mk; TE[mk] = e; TP[mk] = pos; TW[mk] = PW[i];
      }
      __syncthreads();
    }
}

constexpr int T_CNT = 0;
constexpr int T_TOT = 256;
constexpr int T_AB = 328;
constexpr int T_OFF = 400;
constexpr int T_GUP = 660;
constexpr int T_YC = 730;
constexpr int T_YB = 990;
constexpr int T_DUP = 1250;
constexpr int T_UL = 1520;
constexpr int T_END = 1520 + 512;
__device__ __forceinline__ int scan_incl(int v, int lane) {
#pragma unroll
    for (int off = 1; off < 64; off <<= 1) { const int t = __builtin_amdgcn_ds_bpermute(((lane - off) & 63) << 2, v); if (lane >= off) v += t; }
    return v;
}
__device__ __forceinline__ void build_moe(const Params& p, int* tab) {
    const unsigned* counts = (const unsigned*)(p.ws + WS_CTL);
    __syncthreads();
    const int tid = otid(), wave = tid >> 6, lane = tid & 63;
    if (wave == 0) {
        const int c0 = (int)counts[0 * 65 + lane], c1 = (int)counts[1 * 65 + lane], c2 = (int)counts[2 * 65 + lane], c3 = (int)counts[3 * 65 + lane];
        tab[T_CNT + 0 * 64 + lane] = c0; tab[T_CNT + 1 * 64 + lane] = c1; tab[T_CNT + 2 * 64 + lane] = c2; tab[T_CNT + 3 * 64 + lane] = c3;
        tab[T_OFF + lane * 4 + 0] = 0; tab[T_OFF + lane * 4 + 1] = c0; tab[T_OFF + lane * 4 + 2] = c0 + c1; tab[T_OFF + lane * 4 + 3] = c0 + c1 + c2;
        const int tot = c0 + c1 + c2 + c3, pad = (tot + 255) & ~255, gu = ((tot + 255) >> 8) * 2;
        const int sp = scan_incl(pad, lane), sg = scan_incl(gu, lane);
        tab[T_TOT + lane] = tot; tab[T_AB + lane] = sp - pad; tab[T_GUP + lane] = sg - gu;
        const int cb[4] = {c0, c1, c2, c3};
#pragma unroll
        for (int b = 0; b < 4; ++b) {
            const int du = ((cb[b] + 255) >> 8) * 4;
            const int sy = scan_incl(cb[b], lane), sd = scan_incl(du, lane);
            tab[T_YB + 65 * b + lane] = sy - cb[b]; tab[T_DUP + 66 * b + lane] = sd - du;
            if (lane == 63) { tab[T_YB + 65 * b + 64] = sy; tab[T_DUP + 66 * b + 64] = sd; tab[T_DUP + 66 * b + 65] = sd + (SEQ / 256) * 4; }
        }
        if (lane == 63) { tab[T_TOT + 64] = T; tab[T_AB + 64] = sp; tab[T_GUP + 64] = sg; tab[T_GUP + 65] = sg + (T / 256) * 2; }
    }
    __syncthreads();
}

__device__ __forceinline__ void moe_decode(const GP_LAS int* tab, int e, int pos_e, int& b, int& pos) {
    const int o1 = tab[T_OFF + e * 4 + 1], o2 = tab[T_OFF + e * 4 + 2], o3 = tab[T_OFF + e * 4 + 3];
    b = (pos_e >= o1 ? 1 : 0) + (pos_e >= o2 ? 1 : 0) + (pos_e >= o3 ? 1 : 0);
    pos = pos_e - (b == 0 ? 0 : (b == 1 ? o1 : (b == 2 ? o2 : o3)));
}
__device__ __forceinline__ int yrow0(int b) { return b == 0 ? 2 * 1024 : (272 + 72 * (b - 1)) * 1024; }
struct MoeSched {
    const GP_LAS int* tab; int G, c, ntn, U, down, chunk; const int* TOKL; const char* Bt;
    __device__ __forceinline__ void prepare(int* tabw, int wv) const {
        if (wv == 0) {
            const int i = lane_id(); int L = i * G + c;
            if (L < U) {
                int bt = 0;
                if (down) {
#pragma unroll
                    for (int q = 0; q < 3; ++q) { const int u0 = tabw[T_DUP + 66 * bt + 65]; if (L >= u0) { L -= u0; ++bt; } } }
                const int pre = down ? T_DUP + 66 * bt : T_GUP;
                int lo = 0, hi = 64;
                while (lo < hi) { const int mid = (lo + hi + 1) >> 1; if (tabw[pre + mid] <= L) lo = mid; else hi = mid - 1; }
                const int loc = L - tabw[pre + lo];
                int cnt, base, bb;
                if (down) { cnt = (lo < 64) ? tabw[T_CNT + bt * 64 + (lo & 63)] : SEQ; base = tabw[T_YB + 65 * bt + lo] + yrow0(bt);
                            bb = tabw[T_AB + lo] + (lo < 64 ? tabw[T_OFF + (lo & 63) * 4 + bt] : bt * SEQ); }
                else { cnt = tabw[T_TOT + lo]; base = tabw[T_AB + lo]; bb = 0; }
                int* ul = tabw + T_UL + 8 * i;
                ul[0] = lo; ul[1] = loc / ntn; ul[2] = loc % ntn; ul[3] = cnt; ul[4] = base; ul[5] = bb;
            }
        }
        __syncthreads();
    }
    __device__ __forceinline__ bool next(int i, gp::Unit& u) const {
        if (i * G + c >= U) return false;
        const GP_LAS int* ul = tab + T_UL + 8 * i;
        u.e = __builtin_amdgcn_readfirstlane(ul[0]); u.pm = __builtin_amdgcn_readfirstlane(ul[1]); u.pn = __builtin_amdgcn_readfirstlane(ul[2]);
        u.cnt = __builtin_amdgcn_readfirstlane(ul[3]); u.base = __builtin_amdgcn_readfirstlane(ul[4]); u.b = __builtin_amdgcn_readfirstlane(ul[5]);
        return true;
    }
    __device__ __forceinline__ unsigned arow(const gp::Unit& u, int r) const {
        const int pos_e = u.pm * 256 + r;
        if (down) return (unsigned)(u.b + pos_e) * 256u;
        int tok;
        if (u.e < 64) { int b, pos; moe_decode(tab, u.e, pos_e, b, pos); tok = (pos_e < u.cnt) ? (TOKL[((size_t)b * 64 + u.e) * 8192 + pos] >> 3) : 0; } else tok = pos_e;
        return (unsigned)tok * 1024u;
    }
    __device__ __forceinline__ const char* bptr(const gp::Unit& u) const {
        return down ? Bt + ((size_t)u.e * 1024 + u.pn * 256) * 256 : Bt + ((size_t)u.e * 512 + u.pn * 256) * 1024;
    }
};
struct EpiGU {
    unsigned char* ACT; const int* TOKL; const float* TW; const GP_LAS int* tab;
    __device__ __forceinline__ void operator()(const f32x4 (&acc)[2][2][4][2], const gp::Unit& u, int wr, int wc, int fr, int fq) const {
#pragma unroll
        for (int ai = 0; ai < 2; ++ai)
#pragma unroll
            for (int m = 0; m < 4; ++m) {
                const int pos_e = u.pm * 256 + ai * 128 + wr * 64 + m * 16 + fr;
                if (pos_e < u.cnt) {
                    float a[8];
#pragma unroll
                    for (int n = 0; n < 2; ++n)
#pragma unroll
                        for (int i = 0; i < 4; ++i) { const float g = acc[ai][0][m][n][i] * (1.f / GUSCALE), up = acc[ai][1][m][n][i] * (1.f / GUSCALE);
                            a[4 * n + i] = __builtin_amdgcn_fmed3f(g * __builtin_amdgcn_rcpf(1.0f + __builtin_amdgcn_exp2f(-1.4426950408889634f * g)) * up * ASCALE, -448.f, 448.f); }
                    int w0 = __builtin_amdgcn_cvt_pk_fp8_f32(a[0], a[1], 0, false); w0 = __builtin_amdgcn_cvt_pk_fp8_f32(a[2], a[3], w0, true);
                    int w1 = __builtin_amdgcn_cvt_pk_fp8_f32(a[4], a[5], 0, false); w1 = __builtin_amdgcn_cvt_pk_fp8_f32(a[6], a[7], w1, true);
                    gp::gst2(ACT + ((size_t)u.base + pos_e) * DE + u.pn * 128 + wc * 32 + fq * 8, (unsigned)w0, (unsigned)w1);
                }
            }
    }
};
constexpr float YSCALE = 16.f;
struct EpiDown {
    unsigned char* ws;
    __device__ __forceinline__ void operator()(const f32x4 (&acc)[2][2][4][2], const gp::Unit& u, int wr, int wc, int fr, int fq) const {
#pragma unroll
        for (int ai = 0; ai < 2; ++ai)
#pragma unroll
            for (int m = 0; m < 4; ++m) {
                const int pos = u.pm * 256 + ai * 128 + wr * 64 + m * 16 + fr;
                {
                    unsigned char* rowp = ws + (size_t)((pos < u.cnt) ? (u.base + pos) : (489 * 1024 + fr)) * D + u.pn * 256 + wc * 64 + fq * 16;
                    gp::u32x4 o;
#pragma unroll
                    for (int bj = 0; bj < 2; ++bj) { const f32x4 v0 = acc[ai][bj][m][0] * (YSCALE / (WDSCALE * ASCALE)), v1 = acc[ai][bj][m][1] * (YSCALE / (WDSCALE * ASCALE));
                        int w0 = __builtin_amdgcn_cvt_pk_fp8_f32(v0[0], v0[1], 0, false); w0 = __builtin_amdgcn_cvt_pk_fp8_f32(v0[2], v0[3], w0, true);
                        int w1 = __builtin_amdgcn_cvt_pk_fp8_f32(v1[0], v1[1], 0, false); w1 = __builtin_amdgcn_cvt_pk_fp8_f32(v1[2], v1[3], w1, true);
                        if (bj == 0) { o.x = (unsigned)w0; o.y = (unsigned)w1; } else { o.z = (unsigned)w0; o.w = (unsigned)w1; } }
                    gp::gst4(rowp, o);
                }
            }
    }
};
__device__ __forceinline__ void ph_moe_gu(const Params& p, unsigned char* smem) {
    unsigned char* ws = p.ws;
    int* tab = (int*)(smem + gp::STAGE_BYTES);
    build_moe(p, tab);
    MoeSched S; S.tab = (const GP_LAS int*)tab; S.G = gridDim.x; S.c = (gridDim.x % 8 == 0) ? (int)((blockIdx.x % 8) * (gridDim.x / 8) + blockIdx.x / 8) : (int)blockIdx.x;   S.ntn = 2; S.U = __builtin_amdgcn_readfirstlane(tab[T_GUP + 65]); S.down = 0; S.chunk = 0;
    S.TOKL = (const int*)(ws + WS_TOKL); S.Bt = (const char*)(ws + WS_WGUT);
    S.prepare(tab, p.chunk);
    EpiGU E{ws + WS_ACT, (const int*)(ws + WS_TOKL), (const float*)(ws + WS_TW), (const GP_LAS int*)tab};
    gp::gemm_phase<EpiGU, MoeSched, true, true>(p.chunk, (GP_LAS unsigned char*)smem, (const char*)(ws + WS_H2), D / 2, S, E);
}
__device__ __forceinline__ void ph_moe_down(const Params& p, unsigned char* smem, int c) {
    unsigned char* ws = p.ws;
    int* tab = (int*)(smem + gp::STAGE_BYTES);
    build_moe(p, tab);
    MoeSched S; S.tab = (const GP_LAS int*)tab; S.G = gridDim.x; S.c = (gridDim.x % 8 == 0) ? (int)((blockIdx.x % 8) * (gridDim.x / 8) + blockIdx.x / 8) : (int)blockIdx.x;   S.ntn = 4; S.U = __builtin_amdgcn_readfirstlane(tab[T_DUP + 65] + tab[T_DUP + 66 + 65] + tab[T_DUP + 132 + 65] + tab[T_DUP + 198 + 65]); S.down = 1; S.chunk = c;
    S.TOKL = nullptr; S.Bt = (const char*)(ws + WS_WDT);
    S.prepare(tab, p.chunk);
    EpiDown E{ws};
    gp::gemm_phase<EpiDown, MoeSched, false, true, 0>(p.chunk, (GP_LAS unsigned char*)smem, (const char*)(ws + WS_ACT), DE / 2, S, E);
}

__device__ __forceinline__ void ph_final(const Params& p, float* lds) {
    unsigned char* ws = p.ws;
    int* tab = (int*)lds;
    build_moe(p, tab);
    const int tid = otid(), wave = tid >> 6, lane = tid & 63;
    const int gw = blockIdx.x * NWV + wave, GW = gridDim.x * NWV;
    const int* TE = (const int*)(ws + WS_TE); const int* TP = (const int*)(ws + WS_TP); const float* TW = (const float*)(ws + WS_TW);
    const unsigned char* Y = ws;
    for (int m = gw; m < T; m += GW) {
        const int b = m >> 13, t = m & (SEQ - 1);
        const float* mod = (const float*)(ws + WS_MOD) + b * 6144 + 5 * 1024;
        float acc[16];
#pragma unroll
        for (int i = 0; i < 16; ++i) acc[i] = 0.f;
#pragma unroll
        for (int k = 0; k < 9; ++k) {
            int row; float wk = 1.f;
            if (k < 8) { const int e = TE[m * 8 + k]; row = tab[T_YB + 65 * b + e] + TP[m * 8 + k]; wk = TW[m * 8 + k]; }
            else row = tab[T_YB + 65 * b + 64] + t;
            row += yrow0(b);
            const unsigned char* yr = Y + (size_t)row * D;
#pragma unroll
            for (int j = 0; j < 4; ++j) { const int w = *(const int*)(yr + 4 * (lane + 64 * j));
                acc[4 * j] += wk * __builtin_amdgcn_cvt_f32_fp8(w, 0); acc[4 * j + 1] += wk * __builtin_amdgcn_cvt_f32_fp8(w, 1); acc[4 * j + 2] += wk * __builtin_amdgcn_cvt_f32_fp8(w, 2); acc[4 * j + 3] += wk * __builtin_amdgcn_cvt_f32_fp8(w, 3); }
        }
        float ss = 0.f;
#pragma unroll
        for (int i = 0; i < 16; ++i) { acc[i] *= (1.f / YSCALE); ss += acc[i] * acc[i]; }
        ss = wave_sum(ss);
        const float rs = 1.0f / sqrtf(ss * (1.0f / D) + EPS);
#pragma unroll
        for (int j = 0; j < 4; ++j) {
            const int col = 256 * j + 128 * ((lane >> 1) & 1) + 32 * (lane >> 4) + 8 * ((lane >> 2) & 3) + 4 * (lane & 1);
            const f32x4 gp = *(const f32x4*)(p.in[I_GFPOST] + col), gt = *(const f32x4*)(mod + col);
            f32x4 x1 = *(const f32x4*)(p.out + (size_t)m * D + col);
#pragma unroll
            for (int i = 0; i < 4; ++i) x1[i] += gt[i] * (acc[4 * j + i] * rs * gp[i]);
            *(f32x4*)(p.out + (size_t)m * D + col) = x1;
        }
    }
}

#define GAS __attribute__((address_space(1)))
#define LAS __attribute__((address_space(3)))
#define XB_TMO      128
#define XB_XCNT(j)  (256  + 64 * (j))
#define XB_XSUB(j)  (1280 + 64 * (j))
#define XB_XGEN(j)  (2304 + 64 * (j))
#define XB_TOP      3328
#define XB_TOPGEN   3392
#define XCD_BAR_WORDS 3456
#define XB_SPIN_CAP (1u << 21)
__device__ __forceinline__ unsigned xb_ld(unsigned* p)              { return __hip_atomic_load(p, __ATOMIC_RELAXED, __HIP_MEMORY_SCOPE_AGENT); }
__device__ __forceinline__ unsigned xb_add(unsigned* p, unsigned v) { return __hip_atomic_fetch_add(p, v, __ATOMIC_RELAXED, __HIP_MEMORY_SCOPE_AGENT); }
__device__ __forceinline__ unsigned xb_xcc_id() { return (unsigned)__builtin_amdgcn_s_getreg((3 << 11) | 20) & 0xFu; }
#define XB_SPIN(cond, bar) do { unsigned _sp = 0; while (cond) { __builtin_amdgcn_s_sleep(1); \
    if ((++_sp & 255u) == 0u) { if (xb_ld(&(bar)[XB_TMO])) break; if (_sp > XB_SPIN_CAP) { atomicAdd(&(bar)[XB_TMO], 1u); break; } } } } while (0)
struct XcdBarrier { unsigned* bar; unsigned x; volatile LAS unsigned* st; };
__device__ __forceinline__ XcdBarrier xcd_barrier_post(unsigned* bar, volatile LAS unsigned* st, int wv) {
    XcdBarrier b; b.bar = bar; b.x = xb_xcc_id(); b.st = st;
    if (wv == 0 && lane_id() == 0) (void)xb_add(&bar[XB_XCNT(b.x)], 1u);
    return b;
}
__device__ __forceinline__ void xcd_barrier_complete(unsigned* bar, unsigned x, unsigned& nloc, unsigned& nx) {
    const unsigned G = gridDim.x * gridDim.y * gridDim.z;
    unsigned sum, cnt, mine, sp = 0u;
    for (;;) {
        sum = 0u; cnt = 0u; mine = 0u;
#pragma unroll
        for (unsigned j = 0; j < 16; ++j) { const unsigned c = xb_ld(&bar[XB_XCNT(j)]); sum += c; cnt += (c > 0u) ? 1u : 0u; mine = (j == x) ? c : mine; }
        if (sum == G) break;
        __builtin_amdgcn_s_sleep(1);
        if ((++sp & 255u) == 0u) { if (xb_ld(&bar[XB_TMO])) break; if (sp > XB_SPIN_CAP) { atomicAdd(&bar[XB_TMO], 1u); break; } }
    }
    nloc = mine > 0u ? mine : 1u; nx = cnt > 0u ? cnt : 1u;
}
__device__ __forceinline__ void xcd_barrier(const XcdBarrier& b, int wv) {
    asm volatile("s_waitcnt vmcnt(0)" ::: "memory");
    __syncthreads();
    if (wv == 0 && lane_id() == 0) {
        unsigned* bar = b.bar;
        __builtin_amdgcn_s_waitcnt(0);
        unsigned nloc = b.st[0], nx = b.st[1];
        if (nloc == 0u) { xcd_barrier_complete(bar, b.x, nloc, nx); b.st[0] = nloc; b.st[1] = nx; }
        const unsigned old = xb_add(&bar[XB_XSUB(b.x)], 1u);
        const unsigned gen = old / nloc;
        if (old + 1u == (gen + 1u) * nloc) {
            __builtin_amdgcn_fence(__ATOMIC_RELEASE, "agent");
            asm volatile("s_waitcnt vmcnt(0)" ::: "memory");
            const unsigned og = xb_add(&bar[XB_TOP], 1u);
            const unsigned tg = og / nx;
            if (og + 1u == (tg + 1u) * nx) xb_add(&bar[XB_TOPGEN], 1u);
            else XB_SPIN(xb_ld(&bar[XB_TOPGEN]) == tg, bar);
            __builtin_amdgcn_fence(__ATOMIC_ACQUIRE, "agent");
            xb_add(&bar[XB_XGEN(b.x)], 1u);
            asm volatile("s_waitcnt vmcnt(0)" ::: "memory");
        } else {
            XB_SPIN(xb_ld(&bar[XB_XGEN(b.x)]) == gen, bar);
            __builtin_amdgcn_fence(__ATOMIC_ACQUIRE, "agent");
            asm volatile("s_waitcnt vmcnt(0)" ::: "memory");
        }
    }
    __syncthreads();
}

namespace cg = cooperative_groups;
constexpr int LDS_BYTES = 144 * 1024;
typedef const __attribute__((address_space(4))) Params* KP;
__device__ __forceinline__ Params kargs() {
    Params p;
#if defined(__HIP_DEVICE_COMPILE__)
    typedef const __attribute__((address_space(4))) unsigned long long* KQ;
    KQ kq = (KQ)__builtin_amdgcn_kernarg_segment_ptr(); asm volatile("" : "+s"(kq));
    unsigned long long* d = (unsigned long long*)&p;
#pragma unroll
    for (int i = 0; i < (int)(sizeof(Params) / 8); ++i) d[i] = kq[i];
#endif
    return p;
}
#define PH(call) do { Params p = kargs(); p.chunk = wv; call; } while (0)
__global__ void __launch_bounds__(NT) mega_fwd(Params p_unused) {
    extern __shared__ __attribute__((aligned(16))) unsigned char smem[];
    float* lds = (float*)smem;
    volatile LAS unsigned* misc = (volatile LAS unsigned*)((LAS unsigned char*)smem + (LDS_BYTES - 64));
    if (threadIdx.x < 16) misc[threadIdx.x] = 0u;
    __syncthreads();
    unsigned* barw; { const Params p = kargs(); barw = (unsigned*)(p.ws + WS_CTL) + 4096; }
    const int wv = __builtin_amdgcn_readfirstlane(threadIdx.x >> 6);
    const XcdBarrier bar = xcd_barrier_post(barw, misc, wv);
#define SYNC() xcd_barrier(bar, wv)
    PH(ph_prep(p, lds)); PH(ph_prep_weights(p, lds, 0, 0));   SYNC();
    PH(ph_norm1(p));                SYNC();
    PH(ph_inproj(p, smem)); PH(ph_prep_weights(p, lds, 1, (MTOT / 256) * (INW / 256) % (int)gridDim.x));         SYNC();
    PH(ph_attn(p, smem)); PH(ph_fourierA(p, smem));  SYNC();
    PH(ph_fourierB(p, smem));       SYNC();
    PH(ph_outproj(p, smem));        SYNC();
    PH(ph_mid(p, smem));            SYNC();
    PH(ph_moe_gu(p, smem));         SYNC();
#pragma unroll 1
    PH(ph_moe_down(p, smem, 0));    SYNC();
    PH(ph_final(p, lds));
#undef SYNC
}

extern "C" void kernel_launch(void* const* d_in, const int* in_sizes, int n_in, void* d_out, int out_size, void* d_ws, size_t ws_size, hipStream_t stream) {
    if (n_in != 26 || ws_size < WS_END) { fprintf(stderr, "kernel_launch: unexpected n_in %d / ws %zu\n", n_in, ws_size); return; }
    static int grid_blocks = 0;
    if (!grid_blocks) {
        int dev = 0, cus = 0, per_cu = 0;
        (void)hipGetDevice(&dev);
        (void)hipDeviceGetAttribute(&cus, hipDeviceAttributeMultiprocessorCount, dev);
        (void)hipFuncSetAttribute((const void*)mega_fwd, hipFuncAttributeMaxDynamicSharedMemorySize, LDS_BYTES);
        (void)hipOccupancyMaxActiveBlocksPerMultiprocessor(&per_cu, (const void*)mega_fwd, NT, LDS_BYTES);
        if (per_cu < 1) { fprintf(stderr, "kernel_launch: occupancy query says %d blocks/CU\n", per_cu); per_cu = 1; }
        if (per_cu > 1) per_cu = 1;
        grid_blocks = cus * per_cu;
    }
    Params p{};
    for (int i = 0; i < 26; ++i) p.in[i] = (const float*)d_in[i];
    p.out = (float*)d_out; p.ws = (unsigned char*)d_ws; p.chunk = 0; p.pad = 0;
    (void)hipMemsetAsync((char*)d_ws + WS_CTL, 0, 32768, stream);
    void* args[] = {&p};
    hipError_t e = hipLaunchCooperativeKernel((const void*)mega_fwd, dim3(grid_blocks), dim3(NT), args, LDS_BYTES, stream);
    if (e != hipSuccess) fprintf(stderr, "cooperative launch failed: %s (grid %d)\n", hipGetErrorString(e), grid_blocks);
}
```

```cpp
#include <hip/hip_runtime.h>
#include <hip/hip_cooperative_groups.h>
#include <cstdio>
#include <cstdint>

typedef unsigned short bf16_t;
typedef float f32x4 __attribute__((ext_vector_type(4)));

constexpr int D = 1024, BATCH = 4, SEQ = 8192, T = BATCH * SEQ, CTX = 256, TC = BATCH * CTX;
constexpr int MTOT = T + TC;
constexpr int KVLEN = CTX + SEQ;
constexpr int INW = 2560, NH = 6, QKW = 768, FW = 256;
constexpr int NE = 64, DE = 256, TOPK = 8;
constexpr int NT = 512, NWV = 8;
constexpr int SLOTS_B = 90112;
constexpr float EPS = 1e-6f;
constexpr float LAM_INIT = 0.2f;
constexpr float QSCALE = 0.125f * 1.4426950408889634f;
constexpr float SQS = 0.42466090014400953f;

constexpr size_t MiB = 1u << 20;
constexpr size_t WS_CTL = 0;
constexpr size_t WS_MOD = 1 * MiB;
constexpr size_t WS_TABW = WS_MOD + 128 * 1024;
constexpr size_t WS_ROPE = WS_MOD + 192 * 1024;
constexpr size_t WS_GCS = WS_MOD + 256 * 1024;
constexpr size_t WS_W128E = WS_MOD + 768 * 1024;
constexpr size_t WS_M64E = WS_MOD + 832 * 1024;
constexpr size_t WS_GT = WS_MOD + 864 * 1024;
constexpr size_t WS_WRT = WS_MOD + 512 * 1024;
constexpr size_t WS_WINT = 2 * MiB;
constexpr size_t WS_WOUTT = 7 * MiB;
constexpr size_t WS_WGUT = 9 * MiB;
constexpr size_t WS_WDT = 74 * MiB;
constexpr size_t WS_TE = 107 * MiB;
constexpr size_t WS_TP = 108 * MiB;
constexpr size_t WS_TW = 109 * MiB;
constexpr size_t WS_TOKL = 110 * MiB;
constexpr size_t WS_AO = 118 * MiB;
constexpr size_t WS_ACT = 118 * MiB;
constexpr size_t WS_Q = 182 * MiB;
constexpr size_t WS_K = 230 * MiB;
constexpr size_t WS_V = WS_K + (size_t)BATCH * KVLEN * QKW * 2;
constexpr size_t WS_F = 329 * MiB;
constexpr size_t WS_FY = 361 * MiB;
constexpr size_t WS_HX = 425 * MiB;
constexpr size_t WS_YX = 358 * MiB;
constexpr size_t WS_H2 = 294 * MiB;
constexpr size_t WS_Y = 294 * MiB;
constexpr size_t WS_END = 491 * MiB;

struct Params {
    const float* in[26];
    float* out;
    unsigned char* ws;
    int chunk;
    int pad;
};
enum { I_X = 0, I_C, I_CTX, I_CCTX, I_WMOD, I_BMOD, I_GAPRE, I_GAPOST, I_WIN, I_WF, I_LQ1, I_LK1, I_LQ2, I_LK2, I_GSUB, I_WOUT,
       I_GFPRE, I_GFPOST, I_WR, I_RB, I_WG, I_WU, I_WD, I_WSG, I_WSU, I_WSD };

__device__ __forceinline__ float bf2f(bf16_t v) { return __uint_as_float(((unsigned)v) << 16); }
__device__ __forceinline__ bf16_t f2bf(float f) { unsigned u = __float_as_uint(f); return (bf16_t)((u + 0x7fffu + ((u >> 16) & 1u)) >> 16); }
__device__ __forceinline__ unsigned pk2(float lo, float hi) { return (unsigned)f2bf(lo) | ((unsigned)f2bf(hi) << 16); }
template <int M> __device__ __forceinline__ float sx(float v) { return __int_as_float(__builtin_amdgcn_ds_swizzle(__float_as_int(v), (M << 10) | 0x1f)); }
template <int M> __device__ __forceinline__ int sxi(int v) { return __builtin_amdgcn_ds_swizzle(v, (M << 10) | 0x1f); }
__device__ __forceinline__ float wave_sum(float v) {
    v += sx<1>(v); v += sx<2>(v); v += sx<4>(v); v += sx<8>(v); v += sx<16>(v);
    auto rr = __builtin_amdgcn_permlane32_swap(__float_as_uint(v), __float_as_uint(v), false, false);
    return __uint_as_float(rr[0]) + __uint_as_float(rr[1]);
}
__device__ __forceinline__ float dpp_f(float v, const int ctrl_sel) {
    const int x = __float_as_int(v); int r;
    if (ctrl_sel == 0) r = __builtin_amdgcn_update_dpp(x, x, 0xB1, 0xf, 0xf, false);
    else if (ctrl_sel == 1) r = __builtin_amdgcn_update_dpp(x, x, 0x4E, 0xf, 0xf, false);
    else if (ctrl_sel == 2) r = __builtin_amdgcn_update_dpp(x, x, 0x141, 0xf, 0xf, false);
    else r = __builtin_amdgcn_update_dpp(x, x, 0x140, 0xf, 0xf, false);
    return __int_as_float(r);
}
__device__ __forceinline__ float wave_max(float v) {
    v = fmaxf(v, dpp_f(v, 0)); v = fmaxf(v, dpp_f(v, 1)); v = fmaxf(v, dpp_f(v, 2)); v = fmaxf(v, dpp_f(v, 3));
    const float a = __uint_as_float(__builtin_amdgcn_readlane(__float_as_uint(v), 0)), b = __uint_as_float(__builtin_amdgcn_readlane(__float_as_uint(v), 16));
    const float c = __uint_as_float(__builtin_amdgcn_readlane(__float_as_uint(v), 32)), d = __uint_as_float(__builtin_amdgcn_readlane(__float_as_uint(v), 48));
    return fmaxf(fmaxf(a, b), fmaxf(c, d));
}
__device__ __forceinline__ int lane_id() { int l; asm volatile("v_mbcnt_lo_u32_b32 %0, -1, 0\n\tv_mbcnt_hi_u32_b32 %0, -1, %0" : "=v"(l)); return l; }
__device__ __forceinline__ int otid_w(int wv) { return wv * 64 + lane_id(); }
#define otid() otid_w(p.chunk)
__device__ __forceinline__ float silu_f(float x) { return x / (1.f + expf(-x)); }

__device__ __forceinline__ void ph_prep(const Params& p, float* lds) {
    const int tid = otid(), bid = blockIdx.x, nblk = gridDim.x;
    const int gt = bid * NT + tid, GT = nblk * NT;
    unsigned char* ws = p.ws;
    float2* tabw = (float2*)(ws + WS_TABW);
    for (int i = gt; i < 8192; i += GT) { float s, c; sincospif((float)i * (1.0f / 4096.0f), &s, &c); tabw[i] = make_float2(c, s); }
    float* rope = (float*)(ws + WS_ROPE);
    for (int i = gt; i < 192 * 16; i += GT) {
        const int pos = (i < 2048) ? (i >> 4) : ((i - 2048) >> 4); const int f = i & 15;
        const float inv = powf(10000.0f, -(float)(2 * f) / 32.0f); const float ang = (float)pos * inv;
        const float c = cosf(ang), s = sinf(ang);
        if (i < 2048) { rope[i] = c; rope[2048 + i] = s; } else { rope[4096 + (i - 2048)] = c; rope[4096 + 1024 + (i - 2048)] = s; }
    }
    { bf16_t* gt = (bf16_t*)(ws + WS_GT); const float* wf = p.in[I_WF];
      for (int i = bid * NT + tid; i < 4 * 64 * 128; i += GT) {
        const int g = i >> 13, d = (i >> 7) & 63, part = (i >> 6) & 1, c = i & 63;
        float a = 0.f;
        for (int j = 0; j < 64; ++j) { float s, co; sincospif((float)((c * j) & 63) * (1.0f / 32.0f), &s, &co); a += (part ? s : co) * wf[(g * 64 + j) * 64 + d]; }
        gt[i] = f2bf(a * 0.0013810679320049757f);
      }
      bf16_t* w128 = (bf16_t*)(ws + WS_W128E);
      for (int i = bid * NT + tid; i < 256 * 128; i += GT) { const int kk = i >> 7, n1 = i & 127; float s, co; sincospif((float)(((kk & 127) * n1) & 127) * (1.0f / 64.0f), &s, &co); w128[i] = f2bf(kk < 128 ? co : -s); }
      bf16_t* m64 = (bf16_t*)(ws + WS_M64E);
      for (int i = bid * NT + tid; i < 128 * 128; i += GT) { const int ro = i >> 7, ci = i & 127, po = ro >> 6, k2 = ro & 63, pi = ci >> 6, n2 = ci & 63;
        float s, co; sincospif((float)((k2 * n2) & 63) * (1.0f / 32.0f), &s, &co); m64[i] = f2bf(po == pi ? co : (po == 0 ? s : -s)); }
    }
    {
      bf16_t* wrt = (bf16_t*)(ws + WS_WRT); const float* wr = p.in[I_WR];
      for (int i = gt; i < 64 * 1024; i += GT) {
        const int j = i & 7, ln = (i >> 3) & 63, nb = (i >> 9) & 3, ks = (i >> 11) & 3, wv_ = i >> 13;
        const int e = 16 * nb + (ln & 15), k = wv_ * 128 + ks * 32 + 8 * (ln >> 4) + j;
        const float w = wr[k * 64 + e]; const bf16_t h = f2bf(w);
        const int o = ((((wv_ * 4 + ks) * 4 + nb) * 2) * 64 + ln) * 8 + j;
        wrt[o] = h; wrt[o + 512] = f2bf(w - bf2f(h)); } }
    if (gt == 0) {
        float s1 = 0.f, s2 = 0.f;
        for (int i = 0; i < 64; ++i) { s1 += p.in[I_LQ1][i] * p.in[I_LK1][i]; s2 += p.in[I_LQ2][i] * p.in[I_LK2][i]; }
        ((float*)(ws + WS_CTL))[1024] = expf(s1) - expf(s2) + LAM_INIT;
    }
    float* sc = lds;
    float* red = lds + 5 * 1024;
    for (int i = tid; i < 5 * 1024; i += NT) { const int r = i >> 10, k = i & 1023; const float v = (r < 4) ? p.in[I_C][r * 1024 + k] : p.in[I_CCTX][k]; sc[i] = silu_f(v); }
    __syncthreads();
    const int wave = tid >> 6, lane = tid & 63;
    float* mod = (float*)(ws + WS_MOD);
    for (int task = bid; task < 96; task += nblk) {
        const int col = task * 64 + lane;
        float a0 = 0, a1 = 0, a2 = 0, a3 = 0, a4 = 0;
        const float* wm = p.in[I_WMOD];
#pragma unroll 32
        for (int k = wave * 128; k < wave * 128 + 128; ++k) { const float w = wm[(size_t)k * 6144 + col]; a0 += sc[k] * w; a1 += sc[1024 + k] * w; a2 += sc[2048 + k] * w; a3 += sc[3072 + k] * w; a4 += sc[4096 + k] * w; }
        red[(wave * 5 + 0) * 64 + lane] = a0; red[(wave * 5 + 1) * 64 + lane] = a1; red[(wave * 5 + 2) * 64 + lane] = a2; red[(wave * 5 + 3) * 64 + lane] = a3; red[(wave * 5 + 4) * 64 + lane] = a4;
        __syncthreads();
        if (tid < 320) { const int r = tid >> 6, l = tid & 63; float s = 0.f; for (int w = 0; w < 8; ++w) s += red[(w * 5 + r) * 64 + l]; mod[r * 6144 + task * 64 + l] = s + p.in[I_BMOD][task * 64 + l]; }
        __syncthreads();
    }
}

__device__ __forceinline__ void ph_norm1(const Params& p) {
    const int tid = otid(), wave = tid >> 6, lane = tid & 63;
    const int gw = blockIdx.x * NWV + wave, GW = gridDim.x * NWV;
    const float* mod = (const float*)(p.ws + WS_MOD);
    bf16_t* hx = (bf16_t*)(p.ws + WS_HX);
    const float* g = p.in[I_GAPRE];
    for (int m = gw; m < MTOT; m += GW) {
        const float* src = (m < T) ? p.in[I_X] + (size_t)m * D : p.in[I_CTX] + (size_t)(m - T) * D;
        const int r = (m < T) ? (m >> 13) : 4;
        const float* shift = mod + r * 6144; const float* scale = shift + 1024;
        f32x4 v[4]; float ss = 0.f;
#pragma unroll
        for (int j = 0; j < 4; ++j) { v[j] = ((const f32x4*)src)[lane + 64 * j]; ss += v[j][0] * v[j][0] + v[j][1] * v[j][1] + v[j][2] * v[j][2] + v[j][3] * v[j][3]; }
        ss = wave_sum(ss);
        const float rs = 1.0f / sqrtf(ss * (1.0f / D) + EPS);
#pragma unroll
        for (int j = 0; j < 4; ++j) {
            const int col = 4 * (lane + 64 * j);
            const f32x4 g4 = *(const f32x4*)(g + col), sc4 = *(const f32x4*)(scale + col), sh4 = *(const f32x4*)(shift + col);
            float h[4];
#pragma unroll
            for (int i = 0; i < 4; ++i) h[i] = v[j][i] * rs * g4[i] * (1.f + sc4[i]) + sh4[i];
            uint2 o; o.x = pk2(h[0], h[1]); o.y = pk2(h[2], h[3]);
            *(uint2*)(hx + (size_t)m * D + col) = o;
        }
    }
}

namespace gp {
#define GP_LAS __attribute__((address_space(3)))
typedef short bf16x8 __attribute__((ext_vector_type(8)));
typedef unsigned u32x4 __attribute__((ext_vector_type(4)));
typedef int i32x4 __attribute__((ext_vector_type(4)));
constexpr int BM = 256, BK = 64, HALF = 128, HTB = HALF * BK * 2, STAGE_BYTES = 8 * HTB;
__device__ __forceinline__ int lds_byte(int r, int c) { const int st = (r >> 4) * 2 + (c >> 5), rr = r & 15, cc = c & 31, ob = rr * 64 + cc * 2; return st * 1024 + (ob ^ (((ob >> 9) & 1) << 5)); }
__device__ __forceinline__ void stage_rc(int b, int& R, int& C) { const int st = b / 1024, sb = b % 1024, swz = sb ^ (((sb >> 9) & 1) << 5); R = (st >> 1) * 16 + swz / 64; C = (st & 1) * 32 + (swz % 64) / 2; }
__device__ __forceinline__ int perm32(int rho) { const int n = rho >> 4, i = rho & 15; return 8 * (i >> 2) + 4 * n + (i & 3); }
struct Unit { int pm, pn, e, b, cnt, base; };
typedef unsigned u32x2 __attribute__((ext_vector_type(2)));
typedef float f32x4g __attribute__((ext_vector_type(4)));
#define GP_G1(T, ptr) ((__attribute__((address_space(1))) T*)(ptr))
__device__ __forceinline__ void gst4(void* p, u32x4 v) { *GP_G1(u32x4, p) = v; }
__device__ __forceinline__ void gst2(void* p, unsigned a, unsigned b) { *GP_G1(u32x2, p) = (u32x2){a, b}; }
__device__ __forceinline__ void gst1(void* p, unsigned a) { *GP_G1(unsigned, p) = a; }
__device__ __forceinline__ f32x4g gld4f(const void* p) { return *GP_G1(const f32x4g, p); }
__device__ __forceinline__ unsigned cvt_pk_bf16(float lo, float hi) { unsigned r; asm volatile("v_cvt_pk_bf16_f32 %0, %1, %2" : "=v"(r) : "v"(lo), "v"(hi)); return r; }

template <class Epi, class Sched, bool ALIGN_EPI, bool F8 = false, int EST = 0>
__device__ __forceinline__ void gemm_phase(const int wv, GP_LAS unsigned char* lds, const char* Abase, const int K, const Sched& S, const Epi& E) {
    const int wid = wv, wr = wid >> 2, wc = wid & 3;
    const int nt = K / BK;
    unsigned voffB[2];
#pragma unroll
    for (int i = 0; i < 2; ++i) { int R, C; stage_rc(otid_w(wv) * 16 + i * 8192, R, C); const int Rb = (R & ~31) + perm32(R & 31); voffB[i] = (unsigned)(Rb * K + C) * 2u; }
#define GP_AOFFS(u, o00, o01, o10, o11) do { int R0, C0, R1, C1; const int t_ = otid_w(wv); stage_rc(t_ * 16, R0, C0); stage_rc(t_ * 16 + 8192, R1, C1); \
        o00 = S.arow(u, R0) + (unsigned)C0 * 2u; o01 = S.arow(u, R1) + (unsigned)C1 * 2u; o10 = S.arow(u, HALF + R0) + (unsigned)C0 * 2u; o11 = S.arow(u, HALF + R1) + (unsigned)C1 * 2u; } while (0)
    const size_t kstep = (size_t)(BK * 2);
    const size_t hstep = (size_t)HALF * K * 2;
    const unsigned ldsw = (unsigned)wid * 1024u;
    int aoff, boff; { const int l_ = lane_id(), fr = l_ & 15, fq = l_ >> 4; aoff = lds_byte(wr * 64 + fr, fq * 8); boff = lds_byte(wc * 32 + fr, fq * 8); }
#define GP_SA(b, h) (((b) * 2 + (h)) * HTB)
#define GP_SB(b, h) ((4 + (b) * 2 + (h)) * HTB)
#define GP_STAGE_B(bufoff, gbase) do { _Pragma("unroll") for (int _i = 0; _i < 2; ++_i) \
        __builtin_amdgcn_global_load_lds((const unsigned*)((const char*)(gbase) + voffB[_i]), (GP_LAS unsigned*)(lds + (bufoff) + ldsw + _i * 8192), 16, 0, 0); } while (0)
#define GP_STAGE_A(bufoff, gbase, o0, o1) do { \
        __builtin_amdgcn_global_load_lds((const unsigned*)((const char*)(gbase) + (o0)), (GP_LAS unsigned*)(lds + (bufoff) + ldsw), 16, 0, 0); \
        __builtin_amdgcn_global_load_lds((const unsigned*)((const char*)(gbase) + (o1)), (GP_LAS unsigned*)(lds + (bufoff) + ldsw + 8192), 16, 0, 0); } while (0)
#define GP_LDA(dst, b, h) do { _Pragma("unroll") for (int m = 0; m < 4; ++m) _Pragma("unroll") for (int k = 0; k < 2; ++k) dst[m][k] = *(const GP_LAS bf16x8*)(lds + GP_SA(b, h) + aoff + m * 2048 + k * 1024); } while (0)
#define GP_LDB(dst, b, h) do { _Pragma("unroll") for (int n = 0; n < 2; ++n) _Pragma("unroll") for (int k = 0; k < 2; ++k) dst[n][k] = *(const GP_LAS bf16x8*)(lds + GP_SB(b, h) + boff + n * 2048 + k * 1024); } while (0)
#define GP_CAT8(x) __builtin_shufflevector(__builtin_bit_cast(i32x4, x[0]), __builtin_bit_cast(i32x4, x[1]), 0, 1, 2, 3, 4, 5, 6, 7)
#define GP_MMA(ai, bj, At, Bt) do { __builtin_amdgcn_s_setprio(1); _Pragma("unroll") for (int m = 0; m < 4; ++m) _Pragma("unroll") for (int n = 0; n < 2; ++n) { \
        if constexpr (F8) acc[ai][bj][m][n] = __builtin_amdgcn_mfma_scale_f32_16x16x128_f8f6f4(GP_CAT8(Bt[n]), GP_CAT8(At[m]), acc[ai][bj][m][n], 0, 0, 0, 0, 0, 0); \
        else { _Pragma("unroll") for (int k = 0; k < 2; ++k) acc[ai][bj][m][n] = __builtin_amdgcn_mfma_f32_16x16x32_bf16(Bt[n][k], At[m][k], acc[ai][bj][m][n], 0, 0, 0); } } \
        __builtin_amdgcn_s_setprio(0); } while (0)
#define GP_WAIT_V(n) asm volatile("s_waitcnt vmcnt(" #n ")" ::: "memory")
#define GP_WAIT_L(n) asm volatile("s_waitcnt lgkmcnt(" #n ")" ::: "memory")
#define GP_BAR __builtin_amdgcn_s_barrier()
#define GP_SCHED __builtin_amdgcn_sched_barrier(0)
    Unit cur, nxt; int ui = 0;
    if (!S.next(0, cur)) return;
    f32x4 acc[2][2][4][2];
#pragma unroll
    for (int a = 0; a < 2; ++a)
#pragma unroll
        for (int b = 0; b < 2; ++b)
#pragma unroll
            for (int m = 0; m < 4; ++m)
#pragma unroll
                for (int n = 0; n < 2; ++n) acc[a][b][m][n] = (f32x4){0.f, 0.f, 0.f, 0.f};
    bf16x8 At[4][2], B0[2][2], B1[2][2];
    unsigned ac00, ac01, ac10, ac11, an00, an01, an10, an11;
    GP_AOFFS(cur, ac00, ac01, ac10, ac11);
    const char* cB = S.bptr(cur);
    GP_STAGE_B(GP_SB(0, 0), cB); GP_STAGE_B(GP_SB(0, 1), cB + hstep); GP_STAGE_A(GP_SA(0, 0), Abase, ac00, ac01); GP_STAGE_A(GP_SA(0, 1), Abase, ac10, ac11);
    if (wr == 1) GP_BAR;
    GP_WAIT_V(2); GP_BAR;
    GP_STAGE_B(GP_SB(1, 0), cB + kstep); GP_STAGE_A(GP_SA(1, 0), Abase + kstep, ac00, ac01); GP_STAGE_B(GP_SB(1, 1), cB + hstep + kstep);
    GP_WAIT_V(6); GP_BAR;
    for (;;) {
        const bool has_next = S.next(ui + 1, nxt);
        if (has_next) { GP_AOFFS(nxt, an00, an01, an10, an11); }
        else { an00 = ac00; an01 = ac01; an10 = ac10; an11 = ac11; }
        const char* nB = has_next ? S.bptr(nxt) : cB;
#pragma unroll 1
        for (int t = 0; t < nt; t += 2) {
            const bool last = (t == nt - 2);
            const char* a1 = Abase + (size_t)(t + 1) * kstep;
            const char* a2 = last ? Abase : Abase + (size_t)(t + 2) * kstep; const char* b2 = last ? nB : cB + (size_t)(t + 2) * kstep;
            const char* a3 = a2 + kstep; const char* b3 = b2 + kstep;
            asm volatile("" : "+s"(a1), "+s"(a2), "+s"(b2), "+s"(a3), "+s"(b3));
            GP_LDB(B0, 0, 0); GP_LDB(B1, 0, 1); GP_SCHED; GP_LDA(At, 0, 0); GP_STAGE_A(GP_SA(1, 1), a1, ac10, ac11);
            if (last) { ac00 = an00; ac01 = an01; ac10 = an10; ac11 = an11; }
            const bool relax = EST > 0 && ui > 0 && t == 0;
            if (relax) { static_assert(EST == 0 || EST == 16, "add a wait variant"); asm volatile("s_waitcnt vmcnt(24)" ::: "memory"); } else GP_WAIT_V(8);
            GP_WAIT_L(0); GP_BAR; GP_MMA(0, 0, At, B0); GP_MMA(0, 1, At, B1); GP_BAR; GP_SCHED;
            GP_LDA(At, 0, 1); GP_STAGE_B(GP_SB(0, 0), b2); GP_STAGE_B(GP_SB(0, 1), b2 + hstep); GP_STAGE_A(GP_SA(0, 0), a2, ac00, ac01);
            if (relax) asm volatile("s_waitcnt vmcnt(24)" ::: "memory"); else GP_WAIT_V(8);
            GP_WAIT_L(0); GP_BAR; GP_MMA(1, 0, At, B0); GP_MMA(1, 1, At, B1); GP_BAR; GP_SCHED;
            GP_LDB(B0, 1, 0); GP_LDB(B1, 1, 1); GP_SCHED; GP_LDA(At, 1, 0); GP_STAGE_A(GP_SA(0, 1), a2, ac10, ac11);
            GP_WAIT_V(8); GP_WAIT_L(0); GP_BAR; GP_MMA(0, 0, At, B0); GP_MMA(0, 1, At, B1); GP_BAR; GP_SCHED;
            GP_LDA(At, 1, 1); GP_STAGE_B(GP_SB(1, 0), b3); GP_STAGE_B(GP_SB(1, 1), b3 + hstep); GP_STAGE_A(GP_SA(1, 0), a3, ac00, ac01);
            GP_WAIT_V(8); GP_WAIT_L(0); GP_BAR; GP_MMA(1, 0, At, B0); GP_MMA(1, 1, At, B1); GP_BAR; GP_SCHED;
        }
        if constexpr (ALIGN_EPI) { if (wr == 0) GP_BAR; }
        { const int l_ = lane_id(); E(acc, cur, wr, wc, l_ & 15, l_ >> 4); }
        if (!has_next) break;
#pragma unroll
        for (int a = 0; a < 2; ++a)
#pragma unroll
            for (int b = 0; b < 2; ++b)
#pragma unroll
                for (int m = 0; m < 4; ++m)
#pragma unroll
                    for (int n = 0; n < 2; ++n) acc[a][b][m][n] = (f32x4){0.f, 0.f, 0.f, 0.f};
        cur = nxt; cB = nB; ++ui;
        if constexpr (ALIGN_EPI) { if (wr == 1) GP_BAR; }
    }
    GP_WAIT_V(0);
    if constexpr (!ALIGN_EPI) { if (wr == 0) GP_BAR; }
    GP_BAR;
#undef GP_AOFFS
#undef GP_SA
#undef GP_SB
#undef GP_STAGE_A
#undef GP_STAGE_B
#undef GP_LDA
#undef GP_LDB
#undef GP_MMA
#undef GP_CAT8
#undef GP_WAIT_V
#undef GP_WAIT_L
#undef GP_BAR
#undef GP_SCHED
}

struct DenseSched {
    int nM, nN, nwg, G, c, K; const char* Bt;
    __device__ __forceinline__ void init(int M, int N, int K_, const void* Bt_, int G_, int c_) { nM = M / BM; nN = N / BM; nwg = nM * nN; G = G_; c = c_; K = K_; Bt = (const char*)Bt_; }
    __device__ __forceinline__ bool next(int i, Unit& u) const {
        const long L = (long)i * G + c; if (L >= nwg) return false;
        int wgid = (int)L; { const int q = nwg / 8, r = nwg % 8, xcd = wgid % 8, off = wgid / 8; wgid = (xcd < r ? xcd * (q + 1) : r * (q + 1) + (xcd - r) * q) + off; }
        const int nig = 8 * nN, gid = wgid / nig, fm = gid * 8, gsz = (nM - fm) < 8 ? (nM - fm) : 8;
        u.pm = fm + ((wgid % nig) % gsz); u.pn = (wgid % nig) / gsz; u.e = 0; u.b = 0; u.cnt = 0; u.base = 0; return true;
    }
    __device__ __forceinline__ unsigned arow(const Unit& u, int r) const { return (unsigned)(u.pm * BM + r) * (unsigned)(K * 2); }
    __device__ __forceinline__ const char* bptr(const Unit& u) const { return Bt + (size_t)u.pn * BM * K * 2; }
};
}

struct EpiInProj {
    bf16_t* F; bf16_t* Q; bf16_t* Kb; bf16_t* Vb; const float* rope;
    __device__ __forceinline__ void operator()(const f32x4 (&acc)[2][2][4][2], const gp::Unit& u, int wr, int wc, int fr, int fq) const {
        const int pn = u.pn, pm = u.pm; const bool isctx = pm >= T / 256;
        if (isctx && pn < 4) return;
        if (pn >= 7) {
            unsigned char* V8 = (unsigned char*)Vb;
#pragma unroll
            for (int ai = 0; ai < 2; ++ai) {
                const int row0 = pm * 256 + ai * 128 + wr * 64;
                int b, tile;
                if (!isctx) { b = row0 >> 13; tile = (CTX >> 6) + ((row0 & 8191) >> 6); } else { const int j = row0 - T; b = j >> 8; tile = (j & 255) >> 6; }
#pragma unroll
                for (int bj = 0; bj < 2; ++bj) {
                    const int head = (pn - 7) * 2 + bj;
                    unsigned char* dst = V8 + ((size_t)(b * NH + head) * (KVLEN / 64) + tile) * 8192 + wc * 2048 + fq * 64 + (fr >> 3) * 32 + (fr & 1) * 16 + ((fr >> 1) & 3) * 4;
#pragma unroll
                    for (int e = 0; e < 8; ++e) {
                        int w = __builtin_amdgcn_cvt_pk_fp8_f32(acc[ai][bj][0][e >> 2][e & 3], acc[ai][bj][1][e >> 2][e & 3], 0, false);
                        w = __builtin_amdgcn_cvt_pk_fp8_f32(acc[ai][bj][2][e >> 2][e & 3], acc[ai][bj][3][e >> 2][e & 3], w, true);
                        gp::gst1(dst + e * 256, (unsigned)w);
                    }
                }
            }
            return;
        }
        const int axis = wc & 1; const float* ct = rope + (axis ? 4096 : 0); const float* st = rope + (axis ? 4096 + 1024 : 2048);
#pragma unroll
        for (int ai = 0; ai < 2; ++ai)
#pragma unroll
            for (int m = 0; m < 4; ++m) {
                const int row = pm * 256 + ai * 128 + wr * 64 + m * 16 + fr;
                int t, kb, tile;
                if (!isctx) { kb = row >> 13; t = row & 8191; tile = (CTX >> 6) + (t >> 6); } else { const int j = row - T; t = 0; kb = j >> 8; tile = (j & 255) >> 6; }
                const int pos = axis ? (t & 63) : (t >> 6);
#pragma unroll
                for (int bj = 0; bj < 2; ++bj) {
                    const int col0 = pn * 256 + bj * 128 + wc * 32 + fq * 8;
                    f32x4 v0 = acc[ai][bj][m][0], v1 = acc[ai][bj][m][1];
                    if (pn == 0) { gp::u32x4 w; w.x = gp::cvt_pk_bf16(v0[0], v0[1]); w.y = gp::cvt_pk_bf16(v0[2], v0[3]); w.z = gp::cvt_pk_bf16(v1[0], v1[1]); w.w = gp::cvt_pk_bf16(v1[2], v1[3]);
                        gp::gst4(F + (size_t)row * 256 + col0, w); continue; }
                    if (pn < 7 && !isctx) {
                        const f32x4 c0 = gp::gld4f(ct + pos * 16 + 8 * (fq & 1)), c1 = gp::gld4f(ct + pos * 16 + 8 * (fq & 1) + 4);
                        const f32x4 s0 = gp::gld4f(st + pos * 16 + 8 * (fq & 1)), s1 = gp::gld4f(st + pos * 16 + 8 * (fq & 1) + 4);
                        const float sg = (fq < 2) ? -1.f : 1.f;
#pragma unroll
                        for (int i = 0; i < 4; ++i) {
                            const auto r0 = __builtin_amdgcn_permlane32_swap(__float_as_uint(v0[i]), __float_as_uint(v0[i]), false, false);
                            const auto r1 = __builtin_amdgcn_permlane32_swap(__float_as_uint(v1[i]), __float_as_uint(v1[i]), false, false);
                            const float p0 = __uint_as_float(fq < 2 ? r0[1] : r0[0]), p1 = __uint_as_float(fq < 2 ? r1[1] : r1[0]);
                            v0[i] = v0[i] * c0[i] + sg * p0 * s0[i]; v1[i] = v1[i] * c1[i] + sg * p1 * s1[i]; }
                    }
                    v0 = v0 * SQS; v1 = v1 * SQS;
                    int w0 = __builtin_amdgcn_cvt_pk_fp8_f32(v0[0], v0[1], 0, false); w0 = __builtin_amdgcn_cvt_pk_fp8_f32(v0[2], v0[3], w0, true);
                    int w1 = __builtin_amdgcn_cvt_pk_fp8_f32(v1[0], v1[1], 0, false); w1 = __builtin_amdgcn_cvt_pk_fp8_f32(v1[2], v1[3], w1, true);
                    unsigned char* d;
                    if (pn < 4) d = (unsigned char*)Q + (size_t)row * QKW + (col0 - 256);
                    else d = (unsigned char*)Kb + ((size_t)(kb * NH + (pn - 4) * 2 + bj) * (KVLEN / 64) + tile) * 8192 + wc * 2048 + m * 512 + fr * 32 + fq * 8;
                    gp::gst2(d, (unsigned)w0, (unsigned)w1);
                }
            }
    }
};
struct EpiStoreBf16 {
    bf16_t* O; int ldc;
    __device__ __forceinline__ void operator()(const f32x4 (&acc)[2][2][4][2], const gp::Unit& u, int wr, int wc, int fr, int fq) const {
#pragma unroll
        for (int ai = 0; ai < 2; ++ai)
#pragma unroll
            for (int m = 0; m < 4; ++m) {
                bf16_t* rowp = O + (size_t)(u.pm * 256 + ai * 128 + wr * 64 + m * 16 + fr) * ldc + u.pn * 256 + wc * 32 + fq * 8;
#pragma unroll
                for (int bj = 0; bj < 2; ++bj) { const f32x4 v0 = acc[ai][bj][m][0], v1 = acc[ai][bj][m][1];
                    gp::u32x4 w; w.x = gp::cvt_pk_bf16(v0[0], v0[1]); w.y = gp::cvt_pk_bf16(v0[2], v0[3]); w.z = gp::cvt_pk_bf16(v1[0], v1[1]); w.w = gp::cvt_pk_bf16(v1[2], v1[3]);
                    gp::gst4(rowp + bj * 128, w); }
            }
    }
};

__device__ __forceinline__ void ph_inproj(const Params& p, unsigned char* smem) {
    unsigned char* ws = p.ws;
    gp::DenseSched S; S.init(MTOT, INW, D, ws + WS_WINT, gridDim.x, blockIdx.x);
    EpiInProj E{(bf16_t*)(ws + WS_F), (bf16_t*)(ws + WS_Q), (bf16_t*)(ws + WS_K), (bf16_t*)(ws + WS_V), (const float*)(ws + WS_ROPE)};
    gp::gemm_phase<EpiInProj, gp::DenseSched, true>(p.chunk, (GP_LAS unsigned char*)smem, (const char*)(ws + WS_HX), D, S, E);
}
__device__ __forceinline__ void ph_outproj(const Params& p, unsigned char* smem) {
    unsigned char* ws = p.ws;
    gp::DenseSched S; S.init(T, D, D, ws + WS_WOUTT, gridDim.x, blockIdx.x);
    EpiStoreBf16 E{(bf16_t*)(ws + WS_YX), D};
    gp::gemm_phase<EpiStoreBf16, gp::DenseSched, true>(p.chunk, (GP_LAS unsigned char*)smem, (const char*)(ws + WS_AO), D, S, E);
}

constexpr float GUSCALE = 64.f;
constexpr float WDSCALE = 16.f, ASCALE = 4.f;
struct TItem8 { const float* W; unsigned char* WT; int K, N, row_base, k0, n0; float sc; };
__device__ __forceinline__ void titem8_load(const TItem8& t, float (&tv)[32], int lane) {
#pragma unroll
    for (int i = 0; i < 32; ++i) tv[i] = t.W[(size_t)(t.k0 + 2 * i + (lane >> 5)) * t.N + t.n0 + (lane & 31)];
}
__device__ __forceinline__ void titem8_finish(const TItem8& t, const float (&tv)[32], float* scr, int lane) {
#pragma unroll
    for (int i = 0; i < 32; ++i) scr[(2 * i + (lane >> 5)) * 33 + (lane & 31)] = tv[i] * t.sc;
    asm volatile("s_waitcnt lgkmcnt(0)" ::: "memory");
    const int c = lane & 7;
#pragma unroll
    for (int j = 0; j < 4; ++j) { const int n = (lane >> 3) + 8 * j; const float* s = scr + (8 * c) * 33 + n;
        int w0 = __builtin_amdgcn_cvt_pk_fp8_f32(s[0 * 33], s[1 * 33], 0, false); w0 = __builtin_amdgcn_cvt_pk_fp8_f32(s[2 * 33], s[3 * 33], w0, true);
        int w1 = __builtin_amdgcn_cvt_pk_fp8_f32(s[4 * 33], s[5 * 33], 0, false); w1 = __builtin_amdgcn_cvt_pk_fp8_f32(s[6 * 33], s[7 * 33], w1, true);
        uint2 o; o.x = (unsigned)w0; o.y = (unsigned)w1;
        *(uint2*)(t.WT + (size_t)(t.row_base + t.n0 + n) * t.K + t.k0 + 8 * c) = o; }
    asm volatile("s_waitcnt lgkmcnt(0)" ::: "memory");
}
__device__ __forceinline__ void transpose_item(const float* W, int K, int N, bf16_t* WT, int row_base, int kb, int nb, float* scr, int lane) {
    const int k0 = 64 * kb, n0 = 32 * nb;
    float tv[32];
#pragma unroll
    for (int i = 0; i < 32; ++i) tv[i] = W[(size_t)(k0 + 2 * i + (lane >> 5)) * N + n0 + (lane & 31)];
#pragma unroll
    for (int i = 0; i < 32; ++i) scr[(2 * i + (lane >> 5)) * 33 + (lane & 31)] = tv[i];
    asm volatile("s_waitcnt lgkmcnt(0)" ::: "memory");
    const int c = lane & 7;
#pragma unroll
    for (int j = 0; j < 4; ++j) { const int n = (lane >> 3) + 8 * j; const float* s = scr + (8 * c) * 33 + n;
        uint4 o; o.x = pk2(s[0 * 33], s[1 * 33]); o.y = pk2(s[2 * 33], s[3 * 33]); o.z = pk2(s[4 * 33], s[5 * 33]); o.w = pk2(s[6 * 33], s[7 * 33]);
        *(uint4*)(WT + (size_t)(row_base + n0 + n) * K + k0 + 8 * c) = o; }
    asm volatile("s_waitcnt lgkmcnt(0)" ::: "memory");
}
__device__ __forceinline__ void ph_prep_weights(const Params& p, float* lds, const int part, const int first) {
    const int tid = otid(), wave = tid >> 6, lane = tid & 63;
    float* scr = lds + 8192 + wave * (64 * 33);
    if ((int)blockIdx.x < first) return;
    const int gw = ((int)blockIdx.x - first) * NWV + wave, GW = ((int)gridDim.x - first) * NWV;
    unsigned char* ws = p.ws;
    constexpr int I_IN = 16 * 80, I_OUT = 16 * 32, I_GU = 16 * 8, I_D = 4 * 32;
    constexpr int NITEMS = I_IN + I_OUT + 65 * (2 * I_GU + I_D);
    const int it_lo = part ? I_IN + I_OUT : 0, it_hi = part ? NITEMS : I_IN + I_OUT;
    if (part == 0) {
        for (int it = it_lo + gw; it < it_hi; it += GW) {
            int r = it;
            if (r < I_IN) { transpose_item(p.in[I_WIN], D, INW, (bf16_t*)(ws + WS_WINT), 0, r / 80, r % 80, scr, lane); continue; } r -= I_IN;
            transpose_item(p.in[I_WOUT], D, D, (bf16_t*)(ws + WS_WOUTT), 0, r / 32, r % 32, scr, lane);
        }
        return;
    }
    auto decode = [&](int it, TItem8& t) {
        int r = it - (I_IN + I_OUT);
        const int e = r / (2 * I_GU + I_D); r -= e * (2 * I_GU + I_D);
        if (r < 2 * I_GU) {
            const int half = r / I_GU, q = r % I_GU, kb = q / 8, nb = q % 8;
            t.W = (e < 64) ? p.in[half ? I_WU : I_WG] + (size_t)e * D * DE : p.in[half ? I_WSU : I_WSG];
            const int n0 = 32 * nb, drow = e * 512 + (n0 >> 7) * 256 + half * 128 + (n0 & 127);
            t.WT = ws + WS_WGUT; t.K = D; t.N = DE; t.row_base = drow - n0; t.k0 = 64 * kb; t.n0 = n0; t.sc = GUSCALE;
        } else {
            r -= 2 * I_GU;
            t.W = (e < 64) ? p.in[I_WD] + (size_t)e * DE * D : p.in[I_WSD];
            t.WT = ws + WS_WDT; t.K = DE; t.N = D; t.row_base = e * 1024; t.k0 = 64 * (r / 32); t.n0 = 32 * (r % 32); t.sc = WDSCALE;
        }
    };
    int it = it_lo + gw;
    if (it >= it_hi) return;
    TItem8 ta, tb; float va[32], vb[32];
    decode(it, ta); titem8_load(ta, va, lane);
    for (;;) {
        const bool hb = it + GW < it_hi;
        if (hb) { decode(it + GW, tb); titem8_load(tb, vb, lane); }
        titem8_finish(ta, va, scr, lane);
        if (!hb) break;
        const bool ha = it + 2 * GW < it_hi;
        if (ha) { decode(it + 2 * GW, ta); titem8_load(ta, va, lane); }
        titem8_finish(tb, vb, scr, lane);
        if (!ha) break;
        it += 2 * GW;
    }
}

namespace fa {
typedef short bf16x8 __attribute__((ext_vector_type(8)));
typedef short s16x4 __attribute__((ext_vector_type(4)));
typedef float f32x16 __attribute__((ext_vector_type(16)));
typedef unsigned u32x4 __attribute__((ext_vector_type(4)));
constexpr int KVBLK = 64, LDK = QKW;
constexpr float SCALE = 0.125f, THR = 8.f;
constexpr size_t SHM_V = KVBLK * 128 * 2, SHM_K = KVBLK * 128 * 2;
#define KSWZ(row, colB) ((row) * 256 + ((colB) ^ (((row) & 15) << 4)))
#define SBAR() __builtin_amdgcn_sched_barrier(0)
__device__ __forceinline__ int crow(int r, int hi) { return (r & 3) + 8 * (r >> 2) + 4 * hi; }
__device__ __forceinline__ unsigned cvtpk(float lo, float hi) { unsigned r; asm volatile("v_cvt_pk_bf16_f32 %0, %1, %2" : "=v"(r) : "v"(lo), "v"(hi)); return r; }
constexpr float PBIAS = 5.f, THR2 = PBIAS + 3.5f;
template <bool FIRST>
__device__ __forceinline__ void partialSM(f32x16& p0, f32x16& p1, float& m_reg, f32x16& negm, float& alpha) {
  float pmax = p0[0];
#pragma unroll
  for (int r = 1; r < 16; ++r) pmax = fmaxf(pmax, p0[r]);
#pragma unroll
  for (int r = 0; r < 16; ++r) pmax = fmaxf(pmax, p1[r]);
  { auto rr = __builtin_amdgcn_permlane32_swap(__float_as_uint(pmax), __float_as_uint(pmax), false, false);
    pmax = fmaxf(__uint_as_float(rr[0]), __uint_as_float(rr[1])); }
  if (!FIRST && __builtin_expect(__all(pmax <= THR2), 1)) { alpha = 1.f; }
  else { const float dl = FIRST ? pmax - PBIAS : fmaxf(pmax - PBIAS, 0.f); alpha = FIRST ? 0.f : __builtin_amdgcn_exp2f(-dl); m_reg += dl;
#pragma unroll
    for (int r = 0; r < 16; ++r) { p0[r] -= dl; p1[r] -= dl; }
#pragma unroll
    for (int r = 0; r < 16; ++r) negm[r] = -m_reg;
    asm volatile("" : "+v"(negm)); }
#pragma unroll
  for (int r = 0; r < 16; ++r) p0[r] = __builtin_amdgcn_exp2f(p0[r]);
}
typedef int i32x8 __attribute__((ext_vector_type(8)));
__device__ __forceinline__ int pk4_fp8(float a, float b, float c, float d) { int w; asm("v_cvt_pk_fp8_f32 %0, %1, %2" : "=v"(w) : "v"(a), "v"(b)); asm("v_cvt_pk_fp8_f32 %0, %1, %2 op_sel:[0,0,1]" : "+v"(w) : "v"(c), "v"(d)); return w; }
__device__ __forceinline__ void finishSM_T(f32x16& p0, f32x16& p1, i32x8& pb) {
#pragma unroll
  for (int r = 0; r < 16; ++r) p1[r] = __builtin_amdgcn_exp2f(p1[r]);
#pragma unroll
  for (int g = 0; g < 4; ++g) {
    pb[g] = pk4_fp8(p0[4 * g], p0[4 * g + 1], p0[4 * g + 2], p0[4 * g + 3]); pb[4 + g] = pk4_fp8(p1[4 * g], p1[4 * g + 1], p1[4 * g + 2], p1[4 * g + 3]); }
}
__device__ __forceinline__ void qkt(f32x16& p0, f32x16& p1, const char* Ks, const i32x8 qf, int lane, int mm, const f32x16& negm) {
  const char* kp = Ks + mm * 4096 + lane * 16;
  const u32x4 a0 = *reinterpret_cast<const u32x4*>(kp), a1 = *reinterpret_cast<const u32x4*>(kp + 1024), b0 = *reinterpret_cast<const u32x4*>(kp + 2048), b1 = *reinterpret_cast<const u32x4*>(kp + 3072);
  p0 = __builtin_amdgcn_mfma_scale_f32_32x32x64_f8f6f4((i32x8){(int)a0.x, (int)a0.y, (int)a0.z, (int)a0.w, (int)a1.x, (int)a1.y, (int)a1.z, (int)a1.w}, qf, negm, 0, 0, 0, 0, 0, 0);
  p1 = __builtin_amdgcn_mfma_scale_f32_32x32x64_f8f6f4((i32x8){(int)b0.x, (int)b0.y, (int)b0.z, (int)b0.w, (int)b1.x, (int)b1.y, (int)b1.z, (int)b1.w}, qf, negm, 0, 0, 0, 0, 0, 0);
}
__device__ __forceinline__ int v_st(int k, int c) { const int kk = (k & ~0xC) | ((k & 4) << 1) | ((k & 8) >> 1); return ((kk >> 3) * 4 + (c >> 5)) * 512 + ((kk & 7) * 32 + (c & 31)) * 2; }
__device__ __forceinline__ int v_rd_base(int lane) { return ((lane & 3) << 3) | (((lane >> 2) & 3) << 6) | (((lane >> 4) & 1) << 5) | (((lane >> 5) & 1) << 8); }
constexpr int v_rd_off(int d0, int ks, int half) { return d0 * 512 + ks * 4096 + half * 2048; }
template <int OFF> __device__ __forceinline__ s16x4 tr_read(int vb) {
  s16x4 r; asm volatile("ds_read_b64_tr_b16 %0, %1 offset:%2" : "=&v"(r) : "v"(vb), "i"(OFF) : "memory"); return r;
}
template <int D0> __device__ __forceinline__ void pv_one(f32x16& od, int vb, bf16x8 pa0, bf16x8 pa1, bf16x8 pa2, bf16x8 pa3) {
  const s16x4 l0 = tr_read<v_rd_off(D0, 0, 0)>(vb), h0 = tr_read<v_rd_off(D0, 0, 1)>(vb), l1 = tr_read<v_rd_off(D0, 1, 0)>(vb), h1 = tr_read<v_rd_off(D0, 1, 1)>(vb);
  const s16x4 l2 = tr_read<v_rd_off(D0, 2, 0)>(vb), h2 = tr_read<v_rd_off(D0, 2, 1)>(vb), l3 = tr_read<v_rd_off(D0, 3, 0)>(vb), h3 = tr_read<v_rd_off(D0, 3, 1)>(vb);
  asm volatile("s_waitcnt lgkmcnt(0)" ::: "memory"); SBAR();
#define PK(L, H) (bf16x8){L[0], L[1], L[2], L[3], H[0], H[1], H[2], H[3]}
  od = __builtin_amdgcn_mfma_f32_32x32x16_bf16(pa0, PK(l0, h0), od, 0, 0, 0);
  od = __builtin_amdgcn_mfma_f32_32x32x16_bf16(pa1, PK(l1, h1), od, 0, 0, 0);
  od = __builtin_amdgcn_mfma_f32_32x32x16_bf16(pa2, PK(l2, h2), od, 0, 0, 0);
  od = __builtin_amdgcn_mfma_f32_32x32x16_bf16(pa3, PK(l3, h3), od, 0, 0, 0);
#undef PK
}
__device__ __forceinline__ void pv_d0(f32x16* o, int vb, bf16x8 pa0, bf16x8 pa1, bf16x8 pa2, bf16x8 pa3) {
  pv_one<0>(o[0], vb, pa0, pa1, pa2, pa3); pv_one<1>(o[1], vb, pa0, pa1, pa2, pa3); pv_one<2>(o[2], vb, pa0, pa1, pa2, pa3); pv_one<3>(o[3], vb, pa0, pa1, pa2, pa3);
}

template <int OFF> __device__ __forceinline__ u32x4 rd128(int vb) { u32x4 r; asm volatile("ds_read_b128 %0, %1 offset:%2" : "=&v"(r) : "v"(vb), "i"(OFF) : "memory"); return r; }
#define PV_RD(D0) const u32x4 va##D0 = rd128<D0 * 2048>(vb), vc##D0 = rd128<D0 * 2048 + 1024>(vb); SBAR()
#define PV_MM(D0) do { asm volatile("s_waitcnt lgkmcnt(0)" ::: "memory"); SBAR(); \
    o[D0] = __builtin_amdgcn_mfma_scale_f32_32x32x64_f8f6f4((i32x8){(int)va##D0.x, (int)va##D0.y, (int)va##D0.z, (int)va##D0.w, (int)vc##D0.x, (int)vc##D0.y, (int)vc##D0.z, (int)vc##D0.w}, pb, o[D0], 0, 0, 0, 0, 0, 0); } while (0)
__device__ __forceinline__ float max3f(float a, float b, float c) { float r; asm("v_max3_f32 %0, %1, %2, %3" : "=v"(r) : "v"(a), "v"(b), "v"(c)); return r; }
#define PV_LSUM() lacc = __builtin_amdgcn_mfma_scale_f32_32x32x64_f8f6f4((i32x8){0x38383838, 0x38383838, 0x38383838, 0x38383838, 0x38383838, 0x38383838, 0x38383838, 0x38383838}, pb, lacc, 0, 0, 0, 0, 0, 0)
__device__ __forceinline__ void pv_psm(f32x16* o, f32x16& lacc, int vb, i32x8 pb, f32x16& p0, f32x16& p1, float& m_reg, f32x16& negm, float& alpha) {
  float pmax;
  { PV_RD(0);
    pmax = max3f(p0[0], p0[1], p0[2]);
#pragma unroll
    for (int r = 3; r < 15; r += 2) pmax = max3f(pmax, p0[r], p0[r + 1]);
    pmax = max3f(pmax, p0[15], p1[0]);
    SBAR(); PV_MM(0); }
  { PV_RD(1);
#pragma unroll
    for (int r = 1; r < 15; r += 2) pmax = max3f(pmax, p1[r], p1[r + 1]);
    pmax = max3f(pmax, p1[15], p1[15]);
    { auto rr = __builtin_amdgcn_permlane32_swap(__float_as_uint(pmax), __float_as_uint(pmax), false, false);
      pmax = max3f(__uint_as_float(rr[0]), __uint_as_float(rr[1]), __uint_as_float(rr[1])); }
    if (__builtin_expect(__all(pmax <= THR2), 1)) { alpha = 1.f; }
    else { const float dl = fmaxf(pmax - PBIAS, 0.f); alpha = __builtin_amdgcn_exp2f(-dl); m_reg += dl;
#pragma unroll
      for (int r = 0; r < 16; ++r) { p0[r] -= dl; p1[r] -= dl; }
#pragma unroll
      for (int r = 0; r < 16; ++r) negm[r] = -m_reg;
      asm volatile("" : "+v"(negm)); }
    SBAR(); PV_MM(1); }
  { PV_RD(2);
#pragma unroll
    for (int r = 0; r < 8; ++r) p0[r] = __builtin_amdgcn_exp2f(p0[r]);
    asm volatile("" : "+v"(p0));
    SBAR(); PV_MM(2); }
  { PV_RD(3);
#pragma unroll
    for (int r = 8; r < 16; ++r) p0[r] = __builtin_amdgcn_exp2f(p0[r]);
    asm volatile("" : "+v"(p0));
    SBAR(); PV_MM(3); PV_LSUM(); }
}
__device__ __forceinline__ void pvT_d0(f32x16* o, f32x16& lacc, int vb, i32x8 pb) {
  { PV_RD(0); PV_MM(0); } { PV_RD(1); PV_MM(1); } { PV_RD(2); PV_MM(2); } { PV_RD(3); PV_MM(3); PV_LSUM(); }
}
#undef PV_RD
#undef PV_MM
#undef PV_LSUM

__device__ __forceinline__ void attn_unit(const unsigned char* __restrict__ Qb, const unsigned char* __restrict__ Kh, const unsigned char* __restrict__ Vh, bf16_t* __restrict__ Ob,
                                          const float* __restrict__ gsub, const float lam, char* lds, const int wv) {
  typedef __attribute__((address_space(3))) unsigned* ldsu_t;
  const int tid = otid_w(wv), wid = wv, lane = tid & 63, r32 = lane & 31, hi = lane >> 5, mm = wid >> 2, wq = wid & 3;
  constexpr int NB = 4;
  constexpr int SHM_V8 = KVBLK * 128;
  char* V_lds = lds; char* K_lds = lds + NB * SHM_V8; constexpr int SHM_K8 = KVBLK * 128;
  float m_reg = 0.f; f32x16 o[4] = {}; f32x16 lacc = {}; i32x8 qf; f32x16 negm = {}; asm volatile("" : "+v"(negm));
  const unsigned koff = (unsigned)((2 * (wid >> 2) + (lane >> 5)) * 2048 + (lane & 3) * 512 + (8 * ((wid >> 1) & 1) + 2 * ((lane & 31) >> 3) + ((lane >> 2) & 1)) * 32 + (wid & 1) * 16);
  const unsigned voff = (unsigned)((wid >> 1) * 2048 + (lane & 7) * 256 + ((lane >> 3) & 3) * 64 + (wid & 1) * 32 + (lane >> 5) * 16);
#define DMA(t, buf) do { const char* kb_ = (const char*)(Kh + (size_t)(t) * SHM_K8); const char* vb_ = (const char*)(Vh + (size_t)(t) * SHM_V8); asm volatile("" : "+s"(kb_), "+s"(vb_)); \
    __builtin_amdgcn_global_load_lds((const unsigned*)(kb_ + koff), (ldsu_t)(K_lds + (buf) * SHM_K8 + wid * 1024), 16, 0, 0); \
    __builtin_amdgcn_global_load_lds((const unsigned*)(vb_ + voff), (ldsu_t)(V_lds + (buf) * SHM_V8 + wid * 1024), 16, 0, 0); } while (0)
#define WAIT_BAR(N) asm volatile("s_waitcnt vmcnt(" #N ") lgkmcnt(0)\n\ts_barrier" ::: "memory")
#define RESC(a) do { if (__any((a) < 1.f)) { _Pragma("unroll") for (int d = 0; d < 4; ++d) _Pragma("unroll") for (int r = 0; r < 16; ++r) o[d][r] *= (a); lacc[0] *= (a); } } while (0)
  DMA(0, 0); DMA(1, 1);
  { const unsigned char* Qw = Qb + (long)(wq * 32 + r32) * QKW + mm * 64 + hi * 32;
    const u32x4 q0 = *reinterpret_cast<const u32x4*>(Qw), q1 = *reinterpret_cast<const u32x4*>(Qw + 16);
    qf = (i32x8){(int)q0.x, (int)q0.y, (int)q0.z, (int)q0.w, (int)q1.x, (int)q1.y, (int)q1.z, (int)q1.w}; }
  const int vb0 = (int)(uintptr_t)V_lds + lane * 16;
  f32x16 pA0, pA1, pB0, pB1; float alA, alB; i32x8 pb; constexpr int NTL = KVLEN / KVBLK;
  WAIT_BAR(0);
  DMA(2, 2);
  qkt(pA0, pA1, K_lds, qf, lane, mm, negm); partialSM<true>(pA0, pA1, m_reg, negm, alA);
  WAIT_BAR(2);
  for (int j = 1; j + 1 < NTL; j += 2) {
    DMA(j + 2, (j + 2) & 3);
    SBAR(); qkt(pB0, pB1, K_lds + (j & 3) * SHM_K8, qf, lane, mm, negm);
    finishSM_T(pA0, pA1, pb); SBAR();
    pv_psm(o, lacc, vb0 + ((j - 1) & 3) * SHM_V8, pb, pB0, pB1, m_reg, negm, alB);
    RESC(alB);
    WAIT_BAR(2);
    if (j + 3 < NTL) DMA(j + 3, (j + 3) & 3);
    SBAR(); qkt(pA0, pA1, K_lds + ((j + 1) & 3) * SHM_K8, qf, lane, mm, negm);
    finishSM_T(pB0, pB1, pb); SBAR();
    pv_psm(o, lacc, vb0 + (j & 3) * SHM_V8, pb, pA0, pA1, m_reg, negm, alA);
    RESC(alA);
    if (j + 3 < NTL) WAIT_BAR(2); else WAIT_BAR(0);
  }
  SBAR(); qkt(pB0, pB1, K_lds + ((NTL - 1) & 3) * SHM_K8, qf, lane, mm, negm);
  finishSM_T(pA0, pA1, pb); SBAR();
  pv_psm(o, lacc, vb0 + ((NTL - 2) & 3) * SHM_V8, pb, pB0, pB1, m_reg, negm, alB);
  RESC(alB);
  finishSM_T(pB0, pB1, pb); SBAR();
  pvT_d0(o, lacc, vb0 + ((NTL - 1) & 3) * SHM_V8, pb);
#undef DMA
#undef WAIT_BAR
  const float rl = __builtin_amdgcn_rcpf(lacc[0]) * (mm ? lam : 1.0f);
  __syncthreads();
  constexpr int XS = 132;
  float* X = (float*)lds;
  if (mm == 1) {
#pragma unroll
    for (int r = 0; r < 16; ++r)
#pragma unroll
      for (int d0 = 0; d0 < 4; ++d0) X[(wq * 32 + r32) * XS + d0 * 32 + crow(r, hi)] = o[d0][r] * rl;
  }
  __syncthreads();
  if (mm == 0) {
#pragma unroll
    for (int r = 0; r < 16; ++r)
#pragma unroll
      for (int d0 = 0; d0 < 4; ++d0) { float* xp = X + (wq * 32 + r32) * XS + d0 * 32 + crow(r, hi); *xp = o[d0][r] * rl - *xp; }
  }
  __syncthreads();
  {
    const int row = tid >> 2, seg = tid & 3;
    const float* xr = X + row * XS + seg * 32;
    f32x4 v[8]; float ss = 0.f;
#pragma unroll
    for (int i = 0; i < 8; ++i) { v[i] = *(const f32x4*)(xr + 4 * i); ss += v[i][0] * v[i][0] + v[i][1] * v[i][1] + v[i][2] * v[i][2] + v[i][3] * v[i][3]; }
    ss += sx<1>(ss); ss += sx<2>(ss);
    const float rs = (1.0f - LAM_INIT) / sqrtf(ss * (1.0f / 128.0f) + EPS);
    bf16_t* dst = Ob + (long)row * D + seg * 32;
#pragma unroll
    for (int i = 0; i < 8; i += 2) {
      const f32x4 g0 = *(const f32x4*)(gsub + seg * 32 + 4 * i), g1 = *(const f32x4*)(gsub + seg * 32 + 4 * i + 4);
      u32x4 w; w.x = cvtpk(v[i][0] * rs * g0[0], v[i][1] * rs * g0[1]); w.y = cvtpk(v[i][2] * rs * g0[2], v[i][3] * rs * g0[3]);
      w.z = cvtpk(v[i + 1][0] * rs * g1[0], v[i + 1][1] * rs * g1[1]); w.w = cvtpk(v[i + 1][2] * rs * g1[2], v[i + 1][3] * rs * g1[3]);
      *(u32x4*)(dst + 4 * i) = w;
    }
  }
  __syncthreads();
#undef RESC
}
#undef KSWZ
#undef SBAR
}

__device__ __forceinline__ void ph_attn(const Params& p, unsigned char* smem) {
    unsigned char* ws = p.ws;
    const unsigned char* Q = ws + WS_Q; const unsigned char* Kb = ws + WS_K; const unsigned char* Vb = ws + WS_V;
    bf16_t* AO = (bf16_t*)(ws + WS_AO);
    const float lam = ((const float*)(ws + WS_CTL))[1024];
    const int c = blockIdx.x, G = gridDim.x;
    if (G == 256) {
        const int x = c & 7, s = c >> 3;
        for (int rd = 0; rd < 6; ++rd) {
            const int bh = rd * 4 + (x >> 1), qb = (x & 1) * 32 + s, b = bh / NH, h = bh % NH;
            fa::attn_unit(Q + ((size_t)b * SEQ + qb * 128) * QKW + h * 128, Kb + (size_t)(b * NH + h) * (KVLEN / 64) * 8192, Vb + (size_t)(b * NH + h) * (KVLEN / 64) * 8192,
                          AO + ((size_t)b * SEQ + qb * 128) * D + 256 + h * 128, p.in[I_GSUB], lam, (char*)smem, p.chunk);
        }
    } else {
        for (int u = c; u < BATCH * NH * 64; u += G) {
            const int bh = u >> 6, qb = u & 63, b = bh / NH, h = bh % NH;
            fa::attn_unit(Q + ((size_t)b * SEQ + qb * 128) * QKW + h * 128, Kb + (size_t)(b * NH + h) * (KVLEN / 64) * 8192, Vb + (size_t)(b * NH + h) * (KVLEN / 64) * 8192,
                          AO + ((size_t)b * SEQ + qb * 128) * D + 256 + h * 128, p.in[I_GSUB], lam, (char*)smem, p.chunk);
        }
    }
}

__device__ __forceinline__ void ph_fourierA(const Params& p, unsigned char* smem) {
    using namespace fa;
    unsigned char* ws = p.ws;
    const bf16_t* F = (const bf16_t*)(ws + WS_F); bf16_t* FY = (bf16_t*)(ws + WS_FY); const bf16_t* W = (const bf16_t*)(ws + WS_W128E);
    const int tid = otid(), wid = tid >> 6, lane = tid & 63, r32 = lane & 31, hi = lane >> 5;
    const int sr = tid >> 4, sc = (tid & 15) * 8, vst0 = v_st(sr, sc), vst1 = v_st(32 + sr, sc);
    const int vb0 = (int)(uintptr_t)smem + v_rd_base(lane);
    for (int task = blockIdx.x; task < BATCH * 64; task += gridDim.x) {
        const int b = task >> 6, n2 = task & 63;
        bf16x8 st[4][2];
#pragma unroll
        for (int kt = 0; kt < 2; ++kt)
#pragma unroll
            for (int ct = 0; ct < 2; ++ct) {
                st[kt * 2 + ct][0] = *(const bf16x8*)(F + ((size_t)b * SEQ + 64 * (64 * kt + sr) + n2) * 256 + 128 * ct + sc);
                st[kt * 2 + ct][1] = *(const bf16x8*)(F + ((size_t)b * SEQ + 64 * (64 * kt + 32 + sr) + n2) * 256 + 128 * ct + sc);
            }
        bf16x8 pa[2][4];
#pragma unroll
        for (int kt = 0; kt < 2; ++kt)
#pragma unroll
            for (int ks = 0; ks < 4; ++ks) pa[kt][ks] = *(const bf16x8*)(W + (size_t)(32 * wid + r32) * 128 + 64 * kt + 16 * ks + 8 * hi);
        __syncthreads();
#pragma unroll
        for (int q = 0; q < 4; ++q) { *(bf16x8*)(smem + q * 16384 + vst0) = st[q][0]; *(bf16x8*)(smem + q * 16384 + vst1) = st[q][1]; }
        __syncthreads();
        f32x16 o[2][4] = {};
#pragma unroll
        for (int ct = 0; ct < 2; ++ct)
#pragma unroll
            for (int kt = 0; kt < 2; ++kt) pv_d0(o[ct], vb0 + (kt * 2 + ct) * 16384, pa[kt][0], pa[kt][1], pa[kt][2], pa[kt][3]);
        const int plane = wid >> 2;
#pragma unroll
        for (int r = 0; r < 16; ++r) {
            const int k1 = 32 * (wid & 3) + crow(r, hi);
            bf16_t* dst = FY + ((((size_t)plane * BATCH + b) * 128 + k1) * 64 + n2) * 256 + r32;
#pragma unroll
            for (int ct = 0; ct < 2; ++ct)
#pragma unroll
                for (int d0 = 0; d0 < 4; ++d0) dst[128 * ct + 32 * d0] = f2bf(o[ct][d0][r]);
        }
    }
    __syncthreads();
}
__device__ __forceinline__ void ph_fourierB(const Params& p, unsigned char* smem) {
    using namespace fa;
    unsigned char* ws = p.ws;
    const bf16_t* FY = (const bf16_t*)(ws + WS_FY); const float2* tabw = (const float2*)(ws + WS_TABW);
    const bf16_t* M64 = (const bf16_t*)(ws + WS_M64E); const bf16_t* GT = (const bf16_t*)(ws + WS_GT);
    bf16_t* AO = (bf16_t*)(ws + WS_AO);
    const int tid = otid(), wid = tid >> 6, lane = tid & 63, r32 = lane & 31, hi = lane >> 5;
    const int sr = tid >> 4, sc = (tid & 15) * 8, vst0 = v_st(sr, sc), vst1 = v_st(32 + sr, sc);
    const int vb0 = (int)(uintptr_t)smem + v_rd_base(lane);
    constexpr int XRS = 528;
    unsigned char* XL = smem + 65536;
    const int mt = wid & 3, ctw = wid >> 2;
    for (int task = blockIdx.x; task < BATCH * 128; task += gridDim.x) {
        const int b = task >> 7, k1 = task & 127;
        __syncthreads();
#pragma unroll
        for (int ct = 0; ct < 2; ++ct)
#pragma unroll
            for (int rh = 0; rh < 2; ++rh) {
                const int n2 = sr + 32 * rh;
                const size_t off = ((((size_t)b) * 128 + k1) * 64 + n2) * 256 + 128 * ct + sc;
                const uint4 yr = *(const uint4*)(FY + off), yi = *(const uint4*)(FY + (size_t)BATCH * 128 * 64 * 256 + off);
                const float2 tw = tabw[n2 * k1];
                const unsigned yrw[4] = {yr.x, yr.y, yr.z, yr.w}, yiw[4] = {yi.x, yi.y, yi.z, yi.w};
                unsigned zr[4], zi[4];
#pragma unroll
                for (int q = 0; q < 4; ++q) {
                    const float a0 = __uint_as_float(yrw[q] << 16), a1 = __uint_as_float(yrw[q] & 0xffff0000u), b0 = __uint_as_float(yiw[q] << 16), b1 = __uint_as_float(yiw[q] & 0xffff0000u);
                    zr[q] = pk2(a0 * tw.x + b0 * tw.y, a1 * tw.x + b1 * tw.y); zi[q] = pk2(b0 * tw.x - a0 * tw.y, b1 * tw.x - a1 * tw.y);
                }
                const int vs = rh ? vst1 : vst0;
                *(uint4*)(smem + (0 * 2 + ct) * 16384 + vs) = make_uint4(zr[0], zr[1], zr[2], zr[3]);
                *(uint4*)(smem + (1 * 2 + ct) * 16384 + vs) = make_uint4(zi[0], zi[1], zi[2], zi[3]);
            }
        __syncthreads();
        {
            f32x16 o[4] = {};
#pragma unroll
            for (int kt = 0; kt < 2; ++kt) {
                bf16x8 pa[4];
#pragma unroll
                for (int ks = 0; ks < 4; ++ks) pa[ks] = *(const bf16x8*)(M64 + (size_t)(32 * mt + r32) * 128 + 64 * kt + 16 * ks + 8 * hi);
                pv_d0(o, vb0 + (kt * 2 + ctw) * 16384, pa[0], pa[1], pa[2], pa[3]);
            }
#pragma unroll
            for (int r = 0; r < 16; ++r) {
                const int ro = 32 * mt + crow(r, hi);
                bf16_t* xr = (bf16_t*)(XL + ((ro >> 6) * 64 + (ro & 63)) * XRS) + 128 * ctw + r32;
#pragma unroll
                for (int d0 = 0; d0 < 4; ++d0) xr[32 * d0] = f2bf(o[d0][r]);
            }
        }
        __syncthreads();
#pragma unroll
        for (int tt = 0; tt < 2; ++tt) {
            const int tau = 2 * wid + tt, g = tau >> 2, mt2 = (tau >> 1) & 1, nt2 = tau & 1;
            f32x16 acc = {};
#pragma unroll
            for (int ks8 = 0; ks8 < 8; ++ks8) {
                const int part = ks8 >> 2, cb = ks8 & 3;
                const bf16x8 af = *(const bf16x8*)(XL + (part * 64 + 32 * mt2 + r32) * XRS + (g * 64 + 16 * cb + 8 * hi) * 2);
                const bf16x8 bfr = *(const bf16x8*)(GT + ((size_t)g * 64 + 32 * nt2 + r32) * 128 + part * 64 + 16 * cb + 8 * hi);
                acc = __builtin_amdgcn_mfma_f32_32x32x16_bf16(af, bfr, acc, 0, 0, 0);
            }
#pragma unroll
            for (int r = 0; r < 16; ++r) { const int k2 = 32 * mt2 + crow(r, hi);
                AO[((size_t)b * SEQ + k1 + 128 * k2) * D + g * 64 + 32 * nt2 + r32] = f2bf(acc[r]); }
        }
    }
    __syncthreads();
}

__device__ __forceinline__ void ph_mid(const Params& p, unsigned char* smem) {
    typedef short bf16x8 __attribute__((ext_vector_type(8)));
    unsigned char* ws = p.ws;
    const int tid = otid(), wave = tid >> 6, lane = tid & 63, fr = lane & 15, fq = lane >> 4;
    const float* mod = (const float*)(ws + WS_MOD);
    const bf16_t* YX = (const bf16_t*)(ws + WS_YX);
    unsigned char* H2 = ws + WS_H2;
    unsigned* counts = (unsigned*)(ws + WS_CTL);
    int* TE = (int*)(ws + WS_TE); int* TP = (int*)(ws + WS_TP); float* TW = (float*)(ws + WS_TW); int* TOKL = (int*)(ws + WS_TOKL);
    constexpr int RS = 2064;
    unsigned char* Ahi = smem; unsigned char* Alo = smem + 16 * RS; float* Pp = (float*)(smem + 2 * 16 * RS + 512);
    const float rbias = p.in[I_RB][lane];
    int* lcnt = (int*)(smem + 99328); int* gb = lcnt + 64; int* PE = gb + 64; float* PW = (float*)(PE + 1024); float* PV = PW + 1024;
    for (int chunk = blockIdx.x; chunk < T / 128; chunk += gridDim.x) {
      const int mc = chunk * 128, b = mc >> 13;
      if (tid < 64) lcnt[tid] = 0;
      {
          const float* mrow_ = mod + b * 6144;
          for (int i = tid; i < 5 * 256; i += NT) { const int v_ = i >> 8, q_ = (i & 255) * 4;
              const float* s_ = (v_ == 0) ? p.in[I_GAPOST] + q_ : (v_ == 1) ? mrow_ + 2 * 1024 + q_ : (v_ == 2) ? p.in[I_GFPRE] + q_ : (v_ == 3) ? mrow_ + 3 * 1024 + q_ : mrow_ + 4 * 1024 + q_;
              *(f32x4*)(PV + v_ * 1024 + q_) = *(const f32x4*)s_; }
          __syncthreads();
      }
      uint2 yw[2][4]; f32x4 xv[2][4];
      bf16x8 wfr[4][4];
      { const bf16_t* wrt_ = (const bf16_t*)(ws + WS_WRT) + (size_t)p.chunk * 16 * 1024; asm volatile("" : "+s"(wrt_));
#pragma unroll
        for (int ks = 0; ks < 4; ++ks) {
#pragma unroll
          for (int nb = 0; nb < 4; ++nb) wfr[ks][nb] = *(const bf16x8*)(wrt_ + (size_t)((ks * 4 + nb) * 2 * 64 + lane) * 8);
          __builtin_amdgcn_sched_barrier(0); } }
#define MID_LOAD(m0_) do { _Pragma("unroll") for (int rr = 0; rr < 2; ++rr) { const int m_ = (m0_) + 2 * wave + rr; _Pragma("unroll") for (int j = 0; j < 4; ++j) { \
          yw[rr][j] = *(const uint2*)(YX + (size_t)m_ * D + 4 * (lane + 64 * j)); xv[rr][j] = ((const f32x4*)(p.in[I_X] + (size_t)m_ * D))[lane + 64 * j]; } } } while (0)
      MID_LOAD(mc);
#pragma unroll 1
      for (int it = 0; it < 8; ++it) {
        const int m0 = mc + it * 16;
        {
            float ss[2] = {0.f, 0.f};
#define YV(rr, j, i) ((i) == 0 ? __uint_as_float(yw[rr][j].x << 16) : (i) == 1 ? __uint_as_float(yw[rr][j].x & 0xffff0000u) : (i) == 2 ? __uint_as_float(yw[rr][j].y << 16) : __uint_as_float(yw[rr][j].y & 0xffff0000u))
#pragma unroll
            for (int rr = 0; rr < 2; ++rr) {
#pragma unroll
                for (int j = 0; j < 4; ++j) ss[rr] += YV(rr, j, 0) * YV(rr, j, 0) + YV(rr, j, 1) * YV(rr, j, 1) + YV(rr, j, 2) * YV(rr, j, 2) + YV(rr, j, 3) * YV(rr, j, 3);
                ss[rr] = wave_sum(ss[rr]);
            }
#pragma unroll
            for (int rr = 0; rr < 2; ++rr) {
                const int lr = 2 * wave + rr, m = m0 + lr;
                const float r1 = 1.0f / sqrtf(ss[rr] * (1.0f / D) + EPS);
                float ss2 = 0.f;
#pragma unroll
                for (int j = 0; j < 4; ++j) {
                    const int col = 4 * (lane + 64 * j);
                    const f32x4 gp = *(const f32x4*)(PV + col), gt = *(const f32x4*)(PV + 1024 + col);
#pragma unroll
                    for (int i = 0; i < 4; ++i) { xv[rr][j][i] = xv[rr][j][i] + gt[i] * (YV(rr, j, i) * r1 * gp[i]); ss2 += xv[rr][j][i] * xv[rr][j][i]; }
                    ((f32x4*)(p.out + (size_t)m * D))[lane + 64 * j] = xv[rr][j];
                }
                ss2 = wave_sum(ss2);
                const float r2 = 1.0f / sqrtf(ss2 * (1.0f / D) + EPS);
#pragma unroll
                for (int j = 0; j < 4; ++j) {
                    const int col = 4 * (lane + 64 * j);
                    const f32x4 gp = *(const f32x4*)(PV + 2048 + col), sh = *(const f32x4*)(PV + 3072 + col), sc = *(const f32x4*)(PV + 4096 + col);
                    float h[4];
#pragma unroll
                    for (int i = 0; i < 4; ++i) h[i] = xv[rr][j][i] * r2 * gp[i] * (1.f + sc[i]) + sh[i];
                    uint2 o; o.x = pk2(h[0], h[1]); o.y = pk2(h[2], h[3]);
                    { int w8 = __builtin_amdgcn_cvt_pk_fp8_f32(h[0], h[1], 0, false); w8 = __builtin_amdgcn_cvt_pk_fp8_f32(h[2], h[3], w8, true); *(int*)(H2 + (size_t)m * D + col) = w8; }
                    *(uint2*)(Ahi + lr * RS + col * 2) = o;
                }
            }
            if (it < 7) MID_LOAD(m0 + 16);
        }
        asm volatile("s_waitcnt lgkmcnt(0)\n\ts_barrier" ::: "memory");
        {
            f32x4 acc[4];
#pragma unroll
            for (int nb = 0; nb < 4; ++nb) acc[nb] = (f32x4){0.f, 0.f, 0.f, 0.f};
#pragma unroll
            for (int ks = 0; ks < 4; ++ks) {
                const int ko = (wave * 128 + ks * 32 + 8 * fq) * 2;
                const bf16x8 ah = *(const bf16x8*)(Ahi + fr * RS + ko);
#pragma unroll
                for (int nb = 0; nb < 4; ++nb) acc[nb] = __builtin_amdgcn_mfma_f32_16x16x32_bf16(ah, wfr[ks][nb], acc[nb], 0, 0, 0);
            }
#pragma unroll
            for (int nb = 0; nb < 4; ++nb)
#pragma unroll
                for (int j = 0; j < 4; ++j) Pp[(wave * 16 + 4 * fq + j) * 64 + 16 * nb + fr] = acc[nb][j];
        }
        asm volatile("s_waitcnt lgkmcnt(0)\n\ts_barrier" ::: "memory");
#pragma unroll
        for (int rr = 0; rr < 2; ++rr) {
            const int lr = 2 * wave + rr;
            float lg = 0.f;
#pragma unroll
            for (int w = 0; w < 8; ++w) lg += Pp[(w * 16 + lr) * 64 + lane];
            const float score = 1.0f / (1.0f + expf(-lg));
            const float sel = score + rbias;
            float t1 = sel, t2 = -INFINITY;
#define TOP2(M) do { const float o1 = sx<M>(t1), o2 = sx<M>(t2); const float n1 = fmaxf(t1, o1), n2 = fmaxf(fminf(t1, o1), fmaxf(t2, o2)); t1 = n1; t2 = n2; } while (0)
            TOP2(1); TOP2(2); TOP2(4);
#undef TOP2
            const float gs = t1 + t2; const int grp = lane >> 3;
            int gr = 0;
#pragma unroll
            for (int j = 0; j < 8; ++j) { const float sj = __uint_as_float(__builtin_amdgcn_readlane(__float_as_uint(gs), j * 8)); gr += (sj > gs || (sj == gs && j < grp)) ? 1 : 0; }
            const bool gsel = gr < 4;
            float v = gsel ? sel : -INFINITY;
            int rk = TOPK;
#pragma unroll
            for (int it8 = 0; it8 < TOPK; ++it8) {
                const float mx = wave_max(v);
                const unsigned long long eq = __ballot(v == mx);
                const int win = __builtin_ctzll(eq);
                if (lane == win) { rk = it8; v = -INFINITY; }
            }
            const bool chosen = rk < TOPK;
            const float ssum = wave_sum(chosen ? score : 0.f);
            const float w = score / (ssum + 1e-20f) * 2.5f;
            if (chosen) {
                const int lpos = atomicAdd(&lcnt[lane], 1);
                const int idx = (it * 16 + lr) * 8 + rk;
                PE[idx] = lane | (lpos << 8); PW[idx] = w;
            }
        }
      }
      __syncthreads();
      if (tid < 64) { const int c = lcnt[tid]; gb[tid] = c ? (int)atomicAdd(&counts[b * 65 + tid], (unsigned)c) : 0; }
      __syncthreads();
      for (int i = tid; i < 1024; i += NT) {
          const int pe = PE[i], e = pe & 255, pos = gb[e] + (pe >> 8), mk = mc * 8 + i;
          TOKL[((size_t)b * 64 + e) * 8192 + pos] = mk; TE[mk] = e; TP[mk] = pos; TW[mk] = PW[i];
      }
      __syncthreads();
    }
}

constexpr int T_CNT = 0;
constexpr int T_TOT = 256;
constexpr int T_AB = 328;
constexpr int T_OFF = 400;
constexpr int T_GUP = 660;
constexpr int T_YC = 730;
constexpr int T_YB = 990;
constexpr int T_DUP = 1250;
constexpr int T_UL = 1520;
constexpr int T_END = 1520 + 512;
__device__ __forceinline__ int scan_incl(int v, int lane) {
#pragma unroll
    for (int off = 1; off < 64; off <<= 1) { const int t = __builtin_amdgcn_ds_bpermute(((lane - off) & 63) << 2, v); if (lane >= off) v += t; }
    return v;
}
__device__ __forceinline__ void build_moe(const Params& p, int* tab) {
    const unsigned* counts = (const unsigned*)(p.ws + WS_CTL);
    __syncthreads();
    const int tid = otid(), wave = tid >> 6, lane = tid & 63;
    if (wave == 0) {
        const int c0 = (int)counts[0 * 65 + lane], c1 = (int)counts[1 * 65 + lane], c2 = (int)counts[2 * 65 + lane], c3 = (int)counts[3 * 65 + lane];
        tab[T_CNT + 0 * 64 + lane] = c0; tab[T_CNT + 1 * 64 + lane] = c1; tab[T_CNT + 2 * 64 + lane] = c2; tab[T_CNT + 3 * 64 + lane] = c3;
        tab[T_OFF + lane * 4 + 0] = 0; tab[T_OFF + lane * 4 + 1] = c0; tab[T_OFF + lane * 4 + 2] = c0 + c1; tab[T_OFF + lane * 4 + 3] = c0 + c1 + c2;
        const int tot = c0 + c1 + c2 + c3, pad = (tot + 255) & ~255, gu = ((tot + 255) >> 8) * 2;
        const int sp = scan_incl(pad, lane), sg = scan_incl(gu, lane);
        tab[T_TOT + lane] = tot; tab[T_AB + lane] = sp - pad; tab[T_GUP + lane] = sg - gu;
        const int cb[4] = {c0, c1, c2, c3};
#pragma unroll
        for (int b = 0; b < 4; ++b) {
            const int du = ((cb[b] + 255) >> 8) * 4;
            const int sy = scan_incl(cb[b], lane), sd = scan_incl(du, lane);
            tab[T_YB + 65 * b + lane] = sy - cb[b]; tab[T_DUP + 66 * b + lane] = sd - du;
            if (lane == 63) { tab[T_YB + 65 * b + 64] = sy; tab[T_DUP + 66 * b + 64] = sd; tab[T_DUP + 66 * b + 65] = sd + (SEQ / 256) * 4; }
        }
        if (lane == 63) { tab[T_TOT + 64] = T; tab[T_AB + 64] = sp; tab[T_GUP + 64] = sg; tab[T_GUP + 65] = sg + (T / 256) * 2; }
    }
    __syncthreads();
}

__device__ __forceinline__ void moe_decode(const GP_LAS int* tab, int e, int pos_e, int& b, int& pos) {
    const int o1 = tab[T_OFF + e * 4 + 1], o2 = tab[T_OFF + e * 4 + 2], o3 = tab[T_OFF + e * 4 + 3];
    b = (pos_e >= o1 ? 1 : 0) + (pos_e >= o2 ? 1 : 0) + (pos_e >= o3 ? 1 : 0);
    pos = pos_e - (b == 0 ? 0 : (b == 1 ? o1 : (b == 2 ? o2 : o3)));
}
__device__ __forceinline__ int yrow0(int b) { return b == 0 ? 2 * 1024 : (272 + 72 * (b - 1)) * 1024; }
struct MoeSched {
    const GP_LAS int* tab; int G, c, ntn, U, down, chunk; const int* TOKL; const char* Bt;
    __device__ __forceinline__ void prepare(int* tabw, int wv) const {
        if (wv == 0) {
            const int i = lane_id(); int L = i * G + c;
            if (L < U) {
                int bt = 0;
                if (down) {
#pragma unroll
                    for (int q = 0; q < 3; ++q) { const int u0 = tabw[T_DUP + 66 * bt + 65]; if (L >= u0) { L -= u0; ++bt; } } }
                const int pre = down ? T_DUP + 66 * bt : T_GUP;
                int lo = 0, hi = 64;
                while (lo < hi) { const int mid = (lo + hi + 1) >> 1; if (tabw[pre + mid] <= L) lo = mid; else hi = mid - 1; }
                const int loc = L - tabw[pre + lo];
                int cnt, base, bb;
                if (down) { cnt = (lo < 64) ? tabw[T_CNT + bt * 64 + (lo & 63)] : SEQ; base = tabw[T_YB + 65 * bt + lo] + yrow0(bt);
                            bb = tabw[T_AB + lo] + (lo < 64 ? tabw[T_OFF + (lo & 63) * 4 + bt] : bt * SEQ); }
                else { cnt = tabw[T_TOT + lo]; base = tabw[T_AB + lo]; bb = 0; }
                int* ul = tabw + T_UL + 8 * i;
                ul[0] = lo; ul[1] = loc / ntn; ul[2] = loc % ntn; ul[3] = cnt; ul[4] = base; ul[5] = bb;
            }
        }
        __syncthreads();
    }
    __device__ __forceinline__ bool next(int i, gp::Unit& u) const {
        if (i * G + c >= U) return false;
        const GP_LAS int* ul = tab + T_UL + 8 * i;
        u.e = __builtin_amdgcn_readfirstlane(ul[0]); u.pm = __builtin_amdgcn_readfirstlane(ul[1]); u.pn = __builtin_amdgcn_readfirstlane(ul[2]);
        u.cnt = __builtin_amdgcn_readfirstlane(ul[3]); u.base = __builtin_amdgcn_readfirstlane(ul[4]); u.b = __builtin_amdgcn_readfirstlane(ul[5]);
        return true;
    }
    __device__ __forceinline__ unsigned arow(const gp::Unit& u, int r) const {
        const int pos_e = u.pm * 256 + r;
        if (down) return (unsigned)(u.b + pos_e) * 256u;
        int tok;
        if (u.e < 64) { int b, pos; moe_decode(tab, u.e, pos_e, b, pos); tok = (pos_e < u.cnt) ? (TOKL[((size_t)b * 64 + u.e) * 8192 + pos] >> 3) : 0; } else tok = pos_e;
        return (unsigned)tok * 1024u;
    }
    __device__ __forceinline__ const char* bptr(const gp::Unit& u) const {
        return down ? Bt + ((size_t)u.e * 1024 + u.pn * 256) * 256 : Bt + ((size_t)u.e * 512 + u.pn * 256) * 1024;
    }
};
struct EpiGU {
    unsigned char* ACT; const int* TOKL; const float* TW; const GP_LAS int* tab;
    __device__ __forceinline__ void operator()(const f32x4 (&acc)[2][2][4][2], const gp::Unit& u, int wr, int wc, int fr, int fq) const {
#pragma unroll
        for (int ai = 0; ai < 2; ++ai)
#pragma unroll
            for (int m = 0; m < 4; ++m) {
                const int pos_e = u.pm * 256 + ai * 128 + wr * 64 + m * 16 + fr;
                if (pos_e < u.cnt) {
                    float a[8];
#pragma unroll
                    for (int n = 0; n < 2; ++n)
#pragma unroll
                        for (int i = 0; i < 4; ++i) { const float g = acc[ai][0][m][n][i] * (1.f / GUSCALE), up = acc[ai][1][m][n][i] * (1.f / GUSCALE);
                            a[4 * n + i] = __builtin_amdgcn_fmed3f(g * __builtin_amdgcn_rcpf(1.0f + __builtin_amdgcn_exp2f(-1.4426950408889634f * g)) * up * ASCALE, -448.f, 448.f); }
                    int w0 = __builtin_amdgcn_cvt_pk_fp8_f32(a[0], a[1], 0, false); w0 = __builtin_amdgcn_cvt_pk_fp8_f32(a[2], a[3], w0, true);
                    int w1 = __builtin_amdgcn_cvt_pk_fp8_f32(a[4], a[5], 0, false); w1 = __builtin_amdgcn_cvt_pk_fp8_f32(a[6], a[7], w1, true);
                    gp::gst2(ACT + ((size_t)u.base + pos_e) * DE + u.pn * 128 + wc * 32 + fq * 8, (unsigned)w0, (unsigned)w1);
                }
            }
    }
};
constexpr float YSCALE = 16.f;
struct EpiDown {
    unsigned char* ws;
    __device__ __forceinline__ void operator()(const f32x4 (&acc)[2][2][4][2], const gp::Unit& u, int wr, int wc, int fr, int fq) const {
#pragma unroll
        for (int ai = 0; ai < 2; ++ai)
#pragma unroll
            for (int m = 0; m < 4; ++m) {
                const int pos = u.pm * 256 + ai * 128 + wr * 64 + m * 16 + fr;
                {
                    unsigned char* rowp = ws + (size_t)((pos < u.cnt) ? (u.base + pos) : (489 * 1024 + fr)) * D + u.pn * 256 + wc * 64 + fq * 16;
                    gp::u32x4 o;
#pragma unroll
                    for (int bj = 0; bj < 2; ++bj) { const f32x4 v0 = acc[ai][bj][m][0] * (YSCALE / (WDSCALE * ASCALE)), v1 = acc[ai][bj][m][1] * (YSCALE / (WDSCALE * ASCALE));
                        int w0 = __builtin_amdgcn_cvt_pk_fp8_f32(v0[0], v0[1], 0, false); w0 = __builtin_amdgcn_cvt_pk_fp8_f32(v0[2], v0[3], w0, true);
                        int w1 = __builtin_amdgcn_cvt_pk_fp8_f32(v1[0], v1[1], 0, false); w1 = __builtin_amdgcn_cvt_pk_fp8_f32(v1[2], v1[3], w1, true);
                        if (bj == 0) { o.x = (unsigned)w0; o.y = (unsigned)w1; } else { o.z = (unsigned)w0; o.w = (unsigned)w1; } }
                    gp::gst4(rowp, o);
                }
            }
    }
};
__device__ __forceinline__ void ph_moe_gu(const Params& p, unsigned char* smem) {
    unsigned char* ws = p.ws;
    int* tab = (int*)(smem + gp::STAGE_BYTES);
    build_moe(p, tab);
    MoeSched S; S.tab = (const GP_LAS int*)tab; S.G = gridDim.x; S.c = (gridDim.x % 8 == 0) ? (int)((blockIdx.x % 8) * (gridDim.x / 8) + blockIdx.x / 8) : (int)blockIdx.x;   S.ntn = 2; S.U = __builtin_amdgcn_readfirstlane(tab[T_GUP + 65]); S.down = 0; S.chunk = 0;
    S.TOKL = (const int*)(ws + WS_TOKL); S.Bt = (const char*)(ws + WS_WGUT);
    S.prepare(tab, p.chunk);
    EpiGU E{ws + WS_ACT, (const int*)(ws + WS_TOKL), (const float*)(ws + WS_TW), (const GP_LAS int*)tab};
    gp::gemm_phase<EpiGU, MoeSched, true, true>(p.chunk, (GP_LAS unsigned char*)smem, (const char*)(ws + WS_H2), D / 2, S, E);
}
__device__ __forceinline__ void ph_moe_down(const Params& p, unsigned char* smem, int c) {
    unsigned char* ws = p.ws;
    int* tab = (int*)(smem + gp::STAGE_BYTES);
    build_moe(p, tab);
    MoeSched S; S.tab = (const GP_LAS int*)tab; S.G = gridDim.x; S.c = (gridDim.x % 8 == 0) ? (int)((blockIdx.x % 8) * (gridDim.x / 8) + blockIdx.x / 8) : (int)blockIdx.x;   S.ntn = 4; S.U = __builtin_amdgcn_readfirstlane(tab[T_DUP + 65] + tab[T_DUP + 66 + 65] + tab[T_DUP + 132 + 65] + tab[T_DUP + 198 + 65]); S.down = 1; S.chunk = c;
    S.TOKL = nullptr; S.Bt = (const char*)(ws + WS_WDT);
    S.prepare(tab, p.chunk);
    EpiDown E{ws};
    gp::gemm_phase<EpiDown, MoeSched, false, true, 0>(p.chunk, (GP_LAS unsigned char*)smem, (const char*)(ws + WS_ACT), DE / 2, S, E);
}

__device__ __forceinline__ void ph_final(const Params& p, float* lds) {
    unsigned char* ws = p.ws;
    int* tab = (int*)lds;
    build_moe(p, tab);
    const int tid = otid(), wave = tid >> 6, lane = tid & 63;
    const int gw = blockIdx.x * NWV + wave, GW = gridDim.x * NWV;
    const int* TE = (const int*)(ws + WS_TE); const int* TP = (const int*)(ws + WS_TP); const float* TW = (const float*)(ws + WS_TW);
    const unsigned char* Y = ws;
    for (int m = gw; m < T; m += GW) {
        const int b = m >> 13, t = m & (SEQ - 1);
        const float* mod = (const float*)(ws + WS_MOD) + b * 6144 + 5 * 1024;
        float acc[16];
#pragma unroll
        for (int i = 0; i < 16; ++i) acc[i] = 0.f;
#pragma unroll
        for (int k = 0; k < 9; ++k) {
            int row; float wk = 1.f;
            if (k < 8) { const int e = TE[m * 8 + k]; row = tab[T_YB + 65 * b + e] + TP[m * 8 + k]; wk = TW[m * 8 + k]; }
            else row = tab[T_YB + 65 * b + 64] + t;
            row += yrow0(b);
            const unsigned char* yr = Y + (size_t)row * D;
#pragma unroll
            for (int j = 0; j < 4; ++j) { const int w = *(const int*)(yr + 4 * (lane + 64 * j));
                acc[4 * j] += wk * __builtin_amdgcn_cvt_f32_fp8(w, 0); acc[4 * j + 1] += wk * __builtin_amdgcn_cvt_f32_fp8(w, 1); acc[4 * j + 2] += wk * __builtin_amdgcn_cvt_f32_fp8(w, 2); acc[4 * j + 3] += wk * __builtin_amdgcn_cvt_f32_fp8(w, 3); }
        }
        float ss = 0.f;
#pragma unroll
        for (int i = 0; i < 16; ++i) { acc[i] *= (1.f / YSCALE); ss += acc[i] * acc[i]; }
        ss = wave_sum(ss);
        const float rs = 1.0f / sqrtf(ss * (1.0f / D) + EPS);
#pragma unroll
        for (int j = 0; j < 4; ++j) {
            const int col = 256 * j + 128 * ((lane >> 1) & 1) + 32 * (lane >> 4) + 8 * ((lane >> 2) & 3) + 4 * (lane & 1);
            const f32x4 gp = *(const f32x4*)(p.in[I_GFPOST] + col), gt = *(const f32x4*)(mod + col);
            f32x4 x1 = *(const f32x4*)(p.out + (size_t)m * D + col);
#pragma unroll
            for (int i = 0; i < 4; ++i) x1[i] += gt[i] * (acc[4 * j + i] * rs * gp[i]);
            *(f32x4*)(p.out + (size_t)m * D + col) = x1;
        }
    }
}

#define GAS __attribute__((address_space(1)))
#define LAS __attribute__((address_space(3)))
#define XB_TMO      128
#define XB_XCNT(j)  (256  + 64 * (j))
#define XB_XSUB(j)  (1280 + 64 * (j))
#define XB_XGEN(j)  (2304 + 64 * (j))
#define XB_TOP      3328
#define XB_TOPGEN   3392
#define XCD_BAR_WORDS 3456
#define XB_SPIN_CAP (1u << 21)
__device__ __forceinline__ unsigned xb_ld(unsigned* p)              { return __hip_atomic_load(p, __ATOMIC_RELAXED, __HIP_MEMORY_SCOPE_AGENT); }
__device__ __forceinline__ unsigned xb_add(unsigned* p, unsigned v) { return __hip_atomic_fetch_add(p, v, __ATOMIC_RELAXED, __HIP_MEMORY_SCOPE_AGENT); }
__device__ __forceinline__ unsigned xb_xcc_id() { return (unsigned)__builtin_amdgcn_s_getreg((3 << 11) | 20) & 0xFu; }
#define XB_SPIN(cond, bar) do { unsigned _sp = 0; while (cond) { __builtin_amdgcn_s_sleep(1); \
    if ((++_sp & 255u) == 0u) { if (xb_ld(&(bar)[XB_TMO])) break; if (_sp > XB_SPIN_CAP) { atomicAdd(&(bar)[XB_TMO], 1u); break; } } } } while (0)
struct XcdBarrier { unsigned* bar; unsigned x; volatile LAS unsigned* st; };
__device__ __forceinline__ XcdBarrier xcd_barrier_post(unsigned* bar, volatile LAS unsigned* st, int wv) {
    XcdBarrier b; b.bar = bar; b.x = xb_xcc_id(); b.st = st;
    if (wv == 0 && lane_id() == 0) (void)xb_add(&bar[XB_XCNT(b.x)], 1u);
    return b;
}
__device__ __forceinline__ void xcd_barrier_complete(unsigned* bar, unsigned x, unsigned& nloc, unsigned& nx) {
    const unsigned G = gridDim.x * gridDim.y * gridDim.z;
    unsigned sum, cnt, mine, sp = 0u;
    for (;;) {
        sum = 0u; cnt = 0u; mine = 0u;
#pragma unroll
        for (unsigned j = 0; j < 16; ++j) { const unsigned c = xb_ld(&bar[XB_XCNT(j)]); sum += c; cnt += (c > 0u) ? 1u : 0u; mine = (j == x) ? c : mine; }
        if (sum == G) break;
        __builtin_amdgcn_s_sleep(1);
        if ((++sp & 255u) == 0u) { if (xb_ld(&bar[XB_TMO])) break; if (sp > XB_SPIN_CAP) { atomicAdd(&bar[XB_TMO], 1u); break; } }
    }
    nloc = mine > 0u ? mine : 1u; nx = cnt > 0u ? cnt : 1u;
}
__device__ __forceinline__ void xcd_barrier(const XcdBarrier& b, int wv) {
    asm volatile("s_waitcnt vmcnt(0)" ::: "memory");
    __syncthreads();
    if (wv == 0 && lane_id() == 0) {
        unsigned* bar = b.bar;
        __builtin_amdgcn_s_waitcnt(0);
        unsigned nloc = b.st[0], nx = b.st[1];
        if (nloc == 0u) { xcd_barrier_complete(bar, b.x, nloc, nx); b.st[0] = nloc; b.st[1] = nx; }
        const unsigned old = xb_add(&bar[XB_XSUB(b.x)], 1u);
        const unsigned gen = old / nloc;
        if (old + 1u == (gen + 1u) * nloc) {
            __builtin_amdgcn_fence(__ATOMIC_RELEASE, "agent");
            asm volatile("s_waitcnt vmcnt(0)" ::: "memory");
            const unsigned og = xb_add(&bar[XB_TOP], 1u);
            const unsigned tg = og / nx;
            if (og + 1u == (tg + 1u) * nx) xb_add(&bar[XB_TOPGEN], 1u);
            else XB_SPIN(xb_ld(&bar[XB_TOPGEN]) == tg, bar);
            __builtin_amdgcn_fence(__ATOMIC_ACQUIRE, "agent");
            xb_add(&bar[XB_XGEN(b.x)], 1u);
            asm volatile("s_waitcnt vmcnt(0)" ::: "memory");
        } else {
            XB_SPIN(xb_ld(&bar[XB_XGEN(b.x)]) == gen, bar);
            __builtin_amdgcn_fence(__ATOMIC_ACQUIRE, "agent");
            asm volatile("s_waitcnt vmcnt(0)" ::: "memory");
        }
    }
    __syncthreads();
}

namespace cg = cooperative_groups;
constexpr int LDS_BYTES = 144 * 1024;
typedef const __attribute__((address_space(4))) Params* KP;
__device__ __forceinline__ Params kargs() {
    Params p;
#if defined(__HIP_DEVICE_COMPILE__)
    typedef const __attribute__((address_space(4))) unsigned long long* KQ;
    KQ kq = (KQ)__builtin_amdgcn_kernarg_segment_ptr(); asm volatile("" : "+s"(kq));
    unsigned long long* d = (unsigned long long*)&p;
#pragma unroll
    for (int i = 0; i < (int)(sizeof(Params) / 8); ++i) d[i] = kq[i];
#endif
    return p;
}
#define PH(call) do { Params p = kargs(); p.chunk = wv; call; } while (0)
__global__ void __launch_bounds__(NT) mega_fwd(Params p_unused) {
    extern __shared__ __attribute__((aligned(16))) unsigned char smem[];
    float* lds = (float*)smem;
    volatile LAS unsigned* misc = (volatile LAS unsigned*)((LAS unsigned char*)smem + (LDS_BYTES - 64));
    if (threadIdx.x < 16) misc[threadIdx.x] = 0u;
    __syncthreads();
    unsigned* barw; { const Params p = kargs(); barw = (unsigned*)(p.ws + WS_CTL) + 4096; }
    const int wv = __builtin_amdgcn_readfirstlane(threadIdx.x >> 6);
    const XcdBarrier bar = xcd_barrier_post(barw, misc, wv);
#define SYNC() xcd_barrier(bar, wv)
    PH(ph_prep(p, lds));            SYNC();
    PH(ph_norm1(p)); PH(ph_prep_weights(p, lds, 0, 0));   SYNC();
    PH(ph_inproj(p, smem)); PH(ph_prep_weights(p, lds, 1, (MTOT / 256) * (INW / 256) % (int)gridDim.x));         SYNC();
    PH(ph_attn(p, smem)); PH(ph_fourierA(p, smem));  SYNC();
    PH(ph_fourierB(p, smem));       SYNC();
    PH(ph_outproj(p, smem));        SYNC();
    PH(ph_mid(p, smem));            SYNC();
    PH(ph_moe_gu(p, smem));         SYNC();
#pragma unroll 1
    PH(ph_moe_down(p, smem, 0));    SYNC();
    PH(ph_final(p, lds));
#undef SYNC
}

extern "C" void kernel_launch(void* const* d_in, const int* in_sizes, int n_in, void* d_out, int out_size, void* d_ws, size_t ws_size, hipStream_t stream) {
    if (n_in != 26 || ws_size < WS_END) { fprintf(stderr, "kernel_launch: unexpected n_in %d / ws %zu\n", n_in, ws_size); return; }
    static int grid_blocks = 0;
    if (!grid_blocks) {
        int dev = 0, cus = 0, per_cu = 0;
        (void)hipGetDevice(&dev);
        (void)hipDeviceGetAttribute(&cus, hipDeviceAttributeMultiprocessorCount, dev);
        (void)hipFuncSetAttribute((const void*)mega_fwd, hipFuncAttributeMaxDynamicSharedMemorySize, LDS_BYTES);
        (void)hipOccupancyMaxActiveBlocksPerMultiprocessor(&per_cu, (const void*)mega_fwd, NT, LDS_BYTES);
        if (per_cu < 1) { fprintf(stderr, "kernel_launch: occupancy query says %d blocks/CU\n", per_cu); per_cu = 1; }
        if (per_cu > 1) per_cu = 1;
        grid_blocks = cus * per_cu;
    }
    Params p{};
    for (int i = 0; i < 26; ++i) p.in[i] = (const float*)d_in[i];
    p.out = (float*)d_out; p.ws = (unsigned char*)d_ws; p.chunk = 0; p.pad = 0;
    (void)hipMemsetAsync((char*)d_ws + WS_CTL, 0, 32768, stream);
    void* args[] = {&p};
    hipError_t e = hipLaunchCooperativeKernel((const void*)mega_fwd, dim3(grid_blocks), dim3(NT), args, LDS_BYTES, stream);
    if (e != hipSuccess) fprintf(stderr, "cooperative launch failed: %s (grid %d)\n", hipGetErrorString(e), grid_blocks);
}
```

```cpp
#include <hip/hip_runtime.h>
#include <hip/hip_cooperative_groups.h>
#include <cstdio>
#include <cstdint>

typedef unsigned short bf16_t;
typedef float f32x4 __attribute__((ext_vector_type(4)));

constexpr int D = 1024, BATCH = 4, SEQ = 8192, T = BATCH * SEQ, CTX = 256, TC = BATCH * CTX;
constexpr int MTOT = T + TC;
constexpr int KVLEN = CTX + SEQ;
constexpr int INW = 2560, NH = 6, QKW = 768, FW = 256;
constexpr int NE = 64, DE = 256, TOPK = 8;
constexpr int NT = 512, NWV = 8;
constexpr int SLOTS_B = 90112;
constexpr float EPS = 1e-6f;
constexpr float LAM_INIT = 0.2f;
constexpr float QSCALE = 0.125f * 1.4426950408889634f;
constexpr float SQS = 0.42466090014400953f;

constexpr size_t MiB = 1u << 20;
constexpr size_t WS_CTL = 0;
constexpr size_t WS_MOD = 1 * MiB;
constexpr size_t WS_TABW = WS_MOD + 128 * 1024;
constexpr size_t WS_ROPE = WS_MOD + 192 * 1024;
constexpr size_t WS_GCS = WS_MOD + 256 * 1024;
constexpr size_t WS_W128E = WS_MOD + 768 * 1024;
constexpr size_t WS_M64E = WS_MOD + 832 * 1024;
constexpr size_t WS_GT = WS_MOD + 864 * 1024;
constexpr size_t WS_WRT = WS_MOD + 512 * 1024;
constexpr size_t WS_WINT = 2 * MiB;
constexpr size_t WS_WOUTT = 7 * MiB;
constexpr size_t WS_WGUT = 9 * MiB;
constexpr size_t WS_WDT = 74 * MiB;
constexpr size_t WS_TE = 107 * MiB;
constexpr size_t WS_TP = 108 * MiB;
constexpr size_t WS_TW = 109 * MiB;
constexpr size_t WS_TOKL = 110 * MiB;
constexpr size_t WS_AO = 118 * MiB;
constexpr size_t WS_ACT = 118 * MiB;
constexpr size_t WS_Q = 182 * MiB;
constexpr size_t WS_K = 230 * MiB;
constexpr size_t WS_V = WS_K + (size_t)BATCH * KVLEN * QKW * 2;
constexpr size_t WS_F = 329 * MiB;
constexpr size_t WS_FY = 361 * MiB;
constexpr size_t WS_HX = 425 * MiB;
constexpr size_t WS_YX = 358 * MiB;
constexpr size_t WS_H2 = 294 * MiB;
constexpr size_t WS_Y = 294 * MiB;
constexpr size_t WS_END = 491 * MiB;

struct Params {
    const float* in[26];
    float* out;
    unsigned char* ws;
    int chunk;
    int pad;
};
enum { I_X = 0, I_C, I_CTX, I_CCTX, I_WMOD, I_BMOD, I_GAPRE, I_GAPOST, I_WIN, I_WF, I_LQ1, I_LK1, I_LQ2, I_LK2, I_GSUB, I_WOUT,
       I_GFPRE, I_GFPOST, I_WR, I_RB, I_WG, I_WU, I_WD, I_WSG, I_WSU, I_WSD };

__device__ __forceinline__ float bf2f(bf16_t v) { return __uint_as_float(((unsigned)v) << 16); }
__device__ __forceinline__ bf16_t f2bf(float f) { unsigned u = __float_as_uint(f); return (bf16_t)((u + 0x7fffu + ((u >> 16) & 1u)) >> 16); }
__device__ __forceinline__ unsigned pk2(float lo, float hi) { return (unsigned)f2bf(lo) | ((unsigned)f2bf(hi) << 16); }
template <int M> __device__ __forceinline__ float sx(float v) { return __int_as_float(__builtin_amdgcn_ds_swizzle(__float_as_int(v), (M << 10) | 0x1f)); }
template <int M> __device__ __forceinline__ int sxi(int v) { return __builtin_amdgcn_ds_swizzle(v, (M << 10) | 0x1f); }
__device__ __forceinline__ float wave_sum(float v) {
    v += sx<1>(v); v += sx<2>(v); v += sx<4>(v); v += sx<8>(v); v += sx<16>(v);
    auto rr = __builtin_amdgcn_permlane32_swap(__float_as_uint(v), __float_as_uint(v), false, false);
    return __uint_as_float(rr[0]) + __uint_as_float(rr[1]);
}
__device__ __forceinline__ float dpp_f(float v, const int ctrl_sel) {
    const int x = __float_as_int(v); int r;
    if (ctrl_sel == 0) r = __builtin_amdgcn_update_dpp(x, x, 0xB1, 0xf, 0xf, false);
    else if (ctrl_sel == 1) r = __builtin_amdgcn_update_dpp(x, x, 0x4E, 0xf, 0xf, false);
    else if (ctrl_sel == 2) r = __builtin_amdgcn_update_dpp(x, x, 0x141, 0xf, 0xf, false);
    else r = __builtin_amdgcn_update_dpp(x, x, 0x140, 0xf, 0xf, false);
    return __int_as_float(r);
}
__device__ __forceinline__ float wave_max(float v) {
    v = fmaxf(v, dpp_f(v, 0)); v = fmaxf(v, dpp_f(v, 1)); v = fmaxf(v, dpp_f(v, 2)); v = fmaxf(v, dpp_f(v, 3));
    const float a = __uint_as_float(__builtin_amdgcn_readlane(__float_as_uint(v), 0)), b = __uint_as_float(__builtin_amdgcn_readlane(__float_as_uint(v), 16));
    const float c = __uint_as_float(__builtin_amdgcn_readlane(__float_as_uint(v), 32)), d = __uint_as_float(__builtin_amdgcn_readlane(__float_as_uint(v), 48));
    return fmaxf(fmaxf(a, b), fmaxf(c, d));
}
__device__ __forceinline__ int lane_id() { int l; asm volatile("v_mbcnt_lo_u32_b32 %0, -1, 0\n\tv_mbcnt_hi_u32_b32 %0, -1, %0" : "=v"(l)); return l; }
__device__ __forceinline__ int otid_w(int wv) { return wv * 64 + lane_id(); }
#define otid() otid_w(p.chunk)
__device__ __forceinline__ float silu_f(float x) { return x / (1.f + expf(-x)); }

__device__ __forceinline__ void ph_prep(const Params& p, float* lds) {
    const int tid = otid(), bid = blockIdx.x, nblk = gridDim.x;
    const bool split = nblk >= 192;
    const int gt = split ? (bid - 96) * NT + tid : bid * NT + tid, GT = split ? (nblk - 96) * NT : nblk * NT;
    const int gidx = gt;
    unsigned char* ws = p.ws;
    if (gt >= 0) {
    float2* tabw = (float2*)(ws + WS_TABW);
    for (int i = gt; i < 8192; i += GT) { float s, c; sincospif((float)i * (1.0f / 4096.0f), &s, &c); tabw[i] = make_float2(c, s); }
    float* rope = (float*)(ws + WS_ROPE);
    for (int i = gt; i < 192 * 16; i += GT) {
        const int pos = (i < 2048) ? (i >> 4) : ((i - 2048) >> 4); const int f = i & 15;
        const float inv = powf(10000.0f, -(float)(2 * f) / 32.0f); const float ang = (float)pos * inv;
        const float c = cosf(ang), s = sinf(ang);
        if (i < 2048) { rope[i] = c; rope[2048 + i] = s; } else { rope[4096 + (i - 2048)] = c; rope[4096 + 1024 + (i - 2048)] = s; }
    }
    { bf16_t* gt = (bf16_t*)(ws + WS_GT); const float* wf = p.in[I_WF];
      for (int i = gidx; i < 4 * 64 * 128; i += GT) {
        const int g = i >> 13, d = (i >> 7) & 63, part = (i >> 6) & 1, c = i & 63;
        float a = 0.f;
        for (int j = 0; j < 64; ++j) { float s, co; sincospif((float)((c * j) & 63) * (1.0f / 32.0f), &s, &co); a += (part ? s : co) * wf[(g * 64 + j) * 64 + d]; }
        gt[i] = f2bf(a * 0.0013810679320049757f);
      }
      bf16_t* w128 = (bf16_t*)(ws + WS_W128E);
      for (int i = gidx; i < 256 * 128; i += GT) { const int kk = i >> 7, n1 = i & 127; float s, co; sincospif((float)(((kk & 127) * n1) & 127) * (1.0f / 64.0f), &s, &co); w128[i] = f2bf(kk < 128 ? co : -s); }
      bf16_t* m64 = (bf16_t*)(ws + WS_M64E);
      for (int i = gidx; i < 128 * 128; i += GT) { const int ro = i >> 7, ci = i & 127, po = ro >> 6, k2 = ro & 63, pi = ci >> 6, n2 = ci & 63;
        float s, co; sincospif((float)((k2 * n2) & 63) * (1.0f / 32.0f), &s, &co); m64[i] = f2bf(po == pi ? co : (po == 0 ? s : -s)); }
    }
    {
      bf16_t* wrt = (bf16_t*)(ws + WS_WRT); const float* wr = p.in[I_WR];
      for (int i = gt; i < 64 * 1024; i += GT) {
        const int j = i & 7, ln = (i >> 3) & 63, nb = (i >> 9) & 3, ks = (i >> 11) & 3, wv_ = i >> 13;
        const int e = 16 * nb + (ln & 15), k = wv_ * 128 + ks * 32 + 8 * (ln >> 4) + j;
        const float w = wr[k * 64 + e]; const bf16_t h = f2bf(w);
        const int o = ((((wv_ * 4 + ks) * 4 + nb) * 2) * 64 + ln) * 8 + j;
        wrt[o] = h; wrt[o + 512] = f2bf(w - bf2f(h)); } }
    if (gt == 0) {
        float s1 = 0.f, s2 = 0.f;
        for (int i = 0; i < 64; ++i) { s1 += p.in[I_LQ1][i] * p.in[I_LK1][i]; s2 += p.in[I_LQ2][i] * p.in[I_LK2][i]; }
        ((float*)(ws + WS_CTL))[1024] = expf(s1) - expf(s2) + LAM_INIT;
    }
    }
    float* sc = lds;
    float* red = lds + 5 * 1024;
    for (int i = tid; i < 5 * 1024; i += NT) { const int r = i >> 10, k = i & 1023; const float v = (r < 4) ? p.in[I_C][r * 1024 + k] : p.in[I_CCTX][k]; sc[i] = silu_f(v); }
    __syncthreads();
    const int wave = tid >> 6, lane = tid & 63;
    float* mod = (float*)(ws + WS_MOD);
    for (int task = bid; task < 96; task += nblk) {
        const int col = task * 64 + lane;
        float a0 = 0, a1 = 0, a2 = 0, a3 = 0, a4 = 0;
        const float* wm = p.in[I_WMOD];
#pragma unroll 32
        for (int k = wave * 128; k < wave * 128 + 128; ++k) { const float w = wm[(size_t)k * 6144 + col]; a0 += sc[k] * w; a1 += sc[1024 + k] * w; a2 += sc[2048 + k] * w; a3 += sc[3072 + k] * w; a4 += sc[4096 + k] * w; }
        red[(wave * 5 + 0) * 64 + lane] = a0; red[(wave * 5 + 1) * 64 + lane] = a1; red[(wave * 5 + 2) * 64 + lane] = a2; red[(wave * 5 + 3) * 64 + lane] = a3; red[(wave * 5 + 4) * 64 + lane] = a4;
        __syncthreads();
        if (tid < 320) { const int r = tid >> 6, l = tid & 63; float s = 0.f; for (int w = 0; w < 8; ++w) s += red[(w * 5 + r) * 64 + l]; mod[r * 6144 + task * 64 + l] = s + p.in[I_BMOD][task * 64 + l]; }
        __syncthreads();
    }
}

__device__ __forceinline__ void ph_norm1(const Params& p) {
    const int tid = otid(), wave = tid >> 6, lane = tid & 63;
    const int gw = blockIdx.x * NWV + wave, GW = gridDim.x * NWV;
    const float* mod = (const float*)(p.ws + WS_MOD);
    bf16_t* hx = (bf16_t*)(p.ws + WS_HX);
    const float* g = p.in[I_GAPRE];
    for (int m = gw; m < MTOT; m += GW) {
        const float* src = (m < T) ? p.in[I_X] + (size_t)m * D : p.in[I_CTX] + (size_t)(m - T) * D;
        const int r = (m < T) ? (m >> 13) : 4;
        const float* shift = mod + r * 6144; const float* scale = shift + 1024;
        f32x4 v[4]; float ss = 0.f;
#pragma unroll
        for (int j = 0; j < 4; ++j) { v[j] = ((const f32x4*)src)[lane + 64 * j]; ss += v[j][0] * v[j][0] + v[j][1] * v[j][1] + v[j][2] * v[j][2] + v[j][3] * v[j][3]; }
        ss = wave_sum(ss);
        const float rs = 1.0f / sqrtf(ss * (1.0f / D) + EPS);
#pragma unroll
        for (int j = 0; j < 4; ++j) {
            const int col = 4 * (lane + 64 * j);
            const f32x4 g4 = *(const f32x4*)(g + col), sc4 = *(const f32x4*)(scale + col), sh4 = *(const f32x4*)(shift + col);
            float h[4];
#pragma unroll
            for (int i = 0; i < 4; ++i) h[i] = v[j][i] * rs * g4[i] * (1.f + sc4[i]) + sh4[i];
            uint2 o; o.x = pk2(h[0], h[1]); o.y = pk2(h[2], h[3]);
            *(uint2*)(hx + (size_t)m * D + col) = o;
        }
    }
}

namespace gp {
#define GP_LAS __attribute__((address_space(3)))
typedef short bf16x8 __attribute__((ext_vector_type(8)));
typedef unsigned u32x4 __attribute__((ext_vector_type(4)));
typedef int i32x4 __attribute__((ext_vector_type(4)));
constexpr int BM = 256, BK = 64, HALF = 128, HTB = HALF * BK * 2, STAGE_BYTES = 8 * HTB;
__device__ __forceinline__ int lds_byte(int r, int c) { const int st = (r >> 4) * 2 + (c >> 5), rr = r & 15, cc = c & 31, ob = rr * 64 + cc * 2; return st * 1024 + (ob ^ (((ob >> 9) & 1) << 5)); }
__device__ __forceinline__ void stage_rc(int b, int& R, int& C) { const int st = b / 1024, sb = b % 1024, swz = sb ^ (((sb >> 9) & 1) << 5); R = (st >> 1) * 16 + swz / 64; C = (st & 1) * 32 + (swz % 64) / 2; }
__device__ __forceinline__ int perm32(int rho) { const int n = rho >> 4, i = rho & 15; return 8 * (i >> 2) + 4 * n + (i & 3); }
struct Unit { int pm, pn, e, b, cnt, base; };
typedef unsigned u32x2 __attribute__((ext_vector_type(2)));
typedef float f32x4g __attribute__((ext_vector_type(4)));
#define GP_G1(T, ptr) ((__attribute__((address_space(1))) T*)(ptr))
__device__ __forceinline__ void gst4(void* p, u32x4 v) { *GP_G1(u32x4, p) = v; }
__device__ __forceinline__ void gst2(void* p, unsigned a, unsigned b) { *GP_G1(u32x2, p) = (u32x2){a, b}; }
__device__ __forceinline__ void gst1(void* p, unsigned a) { *GP_G1(unsigned, p) = a; }
__device__ __forceinline__ f32x4g gld4f(const void* p) { return *GP_G1(const f32x4g, p); }
__device__ __forceinline__ unsigned cvt_pk_bf16(float lo, float hi) { unsigned r; asm volatile("v_cvt_pk_bf16_f32 %0, %1, %2" : "=v"(r) : "v"(lo), "v"(hi)); return r; }

template <class Epi, class Sched, bool ALIGN_EPI, bool F8 = false, int EST = 0>
__device__ __forceinline__ void gemm_phase(const int wv, GP_LAS unsigned char* lds, const char* Abase, const int K, const Sched& S, const Epi& E) {
    const int wid = wv, wr = wid >> 2, wc = wid & 3;
    const int nt = K / BK;
    unsigned voffB[2];
#pragma unroll
    for (int i = 0; i < 2; ++i) { int R, C; stage_rc(otid_w(wv) * 16 + i * 8192, R, C); const int Rb = (R & ~31) + perm32(R & 31); voffB[i] = (unsigned)(Rb * K + C) * 2u; }
#define GP_AOFFS(u, o00, o01, o10, o11) do { int R0, C0, R1, C1; const int t_ = otid_w(wv); stage_rc(t_ * 16, R0, C0); stage_rc(t_ * 16 + 8192, R1, C1); \
        o00 = S.arow(u, R0) + (unsigned)C0 * 2u; o01 = S.arow(u, R1) + (unsigned)C1 * 2u; o10 = S.arow(u, HALF + R0) + (unsigned)C0 * 2u; o11 = S.arow(u, HALF + R1) + (unsigned)C1 * 2u; } while (0)
    const size_t kstep = (size_t)(BK * 2);
    const size_t hstep = (size_t)HALF * K * 2;
    const unsigned ldsw = (unsigned)wid * 1024u;
    int aoff, boff; { const int l_ = lane_id(), fr = l_ & 15, fq = l_ >> 4; aoff = lds_byte(wr * 64 + fr, fq * 8); boff = lds_byte(wc * 32 + fr, fq * 8); }
#define GP_SA(b, h) (((b) * 2 + (h)) * HTB)
#define GP_SB(b, h) ((4 + (b) * 2 + (h)) * HTB)
#define GP_STAGE_B(bufoff, gbase) do { _Pragma("unroll") for (int _i = 0; _i < 2; ++_i) \
        __builtin_amdgcn_global_load_lds((const unsigned*)((const char*)(gbase) + voffB[_i]), (GP_LAS unsigned*)(lds + (bufoff) + ldsw + _i * 8192), 16, 0, 0); } while (0)
#define GP_STAGE_A(bufoff, gbase, o0, o1) do { \
        __builtin_amdgcn_global_load_lds((const unsigned*)((const char*)(gbase) + (o0)), (GP_LAS unsigned*)(lds + (bufoff) + ldsw), 16, 0, 0); \
        __builtin_amdgcn_global_load_lds((const unsigned*)((const char*)(gbase) + (o1)), (GP_LAS unsigned*)(lds + (bufoff) + ldsw + 8192), 16, 0, 0); } while (0)
#define GP_LDA(dst, b, h) do { _Pragma("unroll") for (int m = 0; m < 4; ++m) _Pragma("unroll") for (int k = 0; k < 2; ++k) dst[m][k] = *(const GP_LAS bf16x8*)(lds + GP_SA(b, h) + aoff + m * 2048 + k * 1024); } while (0)
#define GP_LDB(dst, b, h) do { _Pragma("unroll") for (int n = 0; n < 2; ++n) _Pragma("unroll") for (int k = 0; k < 2; ++k) dst[n][k] = *(const GP_LAS bf16x8*)(lds + GP_SB(b, h) + boff + n * 2048 + k * 1024); } while (0)
#define GP_CAT8(x) __builtin_shufflevector(__builtin_bit_cast(i32x4, x[0]), __builtin_bit_cast(i32x4, x[1]), 0, 1, 2, 3, 4, 5, 6, 7)
#define GP_MMA(ai, bj, At, Bt) do { __builtin_amdgcn_s_setprio(1); _Pragma("unroll") for (int m = 0; m < 4; ++m) _Pragma("unroll") for (int n = 0; n < 2; ++n) { \
        if constexpr (F8) acc[ai][bj][m][n] = __builtin_amdgcn_mfma_scale_f32_16x16x128_f8f6f4(GP_CAT8(Bt[n]), GP_CAT8(At[m]), acc[ai][bj][m][n], 0, 0, 0, 0, 0, 0); \
        else { _Pragma("unroll") for (int k = 0; k < 2; ++k) acc[ai][bj][m][n] = __builtin_amdgcn_mfma_f32_16x16x32_bf16(Bt[n][k], At[m][k], acc[ai][bj][m][n], 0, 0, 0); } } \
        __builtin_amdgcn_s_setprio(0); } while (0)
#define GP_WAIT_V(n) asm volatile("s_waitcnt vmcnt(" #n ")" ::: "memory")
#define GP_WAIT_L(n) asm volatile("s_waitcnt lgkmcnt(" #n ")" ::: "memory")
#define GP_BAR __builtin_amdgcn_s_barrier()
#define GP_SCHED __builtin_amdgcn_sched_barrier(0)
    Unit cur, nxt; int ui = 0;
    if (!S.next(0, cur)) return;
    f32x4 acc[2][2][4][2];
#pragma unroll
    for (int a = 0; a < 2; ++a)
#pragma unroll
        for (int b = 0; b < 2; ++b)
#pragma unroll
            for (int m = 0; m < 4; ++m)
#pragma unroll
                for (int n = 0; n < 2; ++n) acc[a][b][m][n] = (f32x4){0.f, 0.f, 0.f, 0.f};
    bf16x8 At[4][2], B0[2][2], B1[2][2];
    unsigned ac00, ac01, ac10, ac11, an00, an01, an10, an11;
    GP_AOFFS(cur, ac00, ac01, ac10, ac11);
    const char* cB = S.bptr(cur);
    GP_STAGE_B(GP_SB(0, 0), cB); GP_STAGE_B(GP_SB(0, 1), cB + hstep); GP_STAGE_A(GP_SA(0, 0), Abase, ac00, ac01); GP_STAGE_A(GP_SA(0, 1), Abase, ac10, ac11);
    if (wr == 1) GP_BAR;
    GP_WAIT_V(2); GP_BAR;
    GP_STAGE_B(GP_SB(1, 0), cB + kstep); GP_STAGE_A(GP_SA(1, 0), Abase + kstep, ac00, ac01); GP_STAGE_B(GP_SB(1, 1), cB + hstep + kstep);
    GP_WAIT_V(6); GP_BAR;
    for (;;) {
        const bool has_next = S.next(ui + 1, nxt);
        if (has_next) { GP_AOFFS(nxt, an00, an01, an10, an11); }
        else { an00 = ac00; an01 = ac01; an10 = ac10; an11 = ac11; }
        const char* nB = has_next ? S.bptr(nxt) : cB;
#pragma unroll 1
        for (int t = 0; t < nt; t += 2) {
            const bool last = (t == nt - 2);
            const char* a1 = Abase + (size_t)(t + 1) * kstep;
            const char* a2 = last ? Abase : Abase + (size_t)(t + 2) * kstep; const char* b2 = last ? nB : cB + (size_t)(t + 2) * kstep;
            const char* a3 = a2 + kstep; const char* b3 = b2 + kstep;
            asm volatile("" : "+s"(a1), "+s"(a2), "+s"(b2), "+s"(a3), "+s"(b3));
            GP_LDB(B0, 0, 0); GP_LDB(B1, 0, 1); GP_SCHED; GP_LDA(At, 0, 0); GP_STAGE_A(GP_SA(1, 1), a1, ac10, ac11);
            if (last) { ac00 = an00; ac01 = an01; ac10 = an10; ac11 = an11; }
            const bool relax = EST > 0 && ui > 0 && t == 0;
            if (relax) { static_assert(EST == 0 || EST == 16, "add a wait variant"); asm volatile("s_waitcnt vmcnt(24)" ::: "memory"); } else GP_WAIT_V(8);
            GP_WAIT_L(0); GP_BAR; GP_MMA(0, 0, At, B0); GP_MMA(0, 1, At, B1); GP_BAR; GP_SCHED;
            GP_LDA(At, 0, 1); GP_STAGE_B(GP_SB(0, 0), b2); GP_STAGE_B(GP_SB(0, 1), b2 + hstep); GP_STAGE_A(GP_SA(0, 0), a2, ac00, ac01);
            if (relax) asm volatile("s_waitcnt vmcnt(24)" ::: "memory"); else GP_WAIT_V(8);
            GP_WAIT_L(0); GP_BAR; GP_MMA(1, 0, At, B0); GP_MMA(1, 1, At, B1); GP_BAR; GP_SCHED;
            GP_LDB(B0, 1, 0); GP_LDB(B1, 1, 1); GP_SCHED; GP_LDA(At, 1, 0); GP_STAGE_A(GP_SA(0, 1), a2, ac10, ac11);
            GP_WAIT_V(8); GP_WAIT_L(0); GP_BAR; GP_MMA(0, 0, At, B0); GP_MMA(0, 1, At, B1); GP_BAR; GP_SCHED;
            GP_LDA(At, 1, 1); GP_STAGE_B(GP_SB(1, 0), b3); GP_STAGE_B(GP_SB(1, 1), b3 + hstep); GP_STAGE_A(GP_SA(1, 0), a3, ac00, ac01);
            GP_WAIT_V(8); GP_WAIT_L(0); GP_BAR; GP_MMA(1, 0, At, B0); GP_MMA(1, 1, At, B1); GP_BAR; GP_SCHED;
        }
        if constexpr (ALIGN_EPI) { if (wr == 0) GP_BAR; }
        { const int l_ = lane_id(); E(acc, cur, wr, wc, l_ & 15, l_ >> 4); }
        if (!has_next) break;
#pragma unroll
        for (int a = 0; a < 2; ++a)
#pragma unroll
            for (int b = 0; b < 2; ++b)
#pragma unroll
                for (int m = 0; m < 4; ++m)
#pragma unroll
                    for (int n = 0; n < 2; ++n) acc[a][b][m][n] = (f32x4){0.f, 0.f, 0.f, 0.f};
        cur = nxt; cB = nB; ++ui;
        if constexpr (ALIGN_EPI) { if (wr == 1) GP_BAR; }
    }
    GP_WAIT_V(0);
    if constexpr (!ALIGN_EPI) { if (wr == 0) GP_BAR; }
    GP_BAR;
#undef GP_AOFFS
#undef GP_SA
#undef GP_SB
#undef GP_STAGE_A
#undef GP_STAGE_B
#undef GP_LDA
#undef GP_LDB
#undef GP_MMA
#undef GP_CAT8
#undef GP_WAIT_V
#undef GP_WAIT_L
#undef GP_BAR
#undef GP_SCHED
}

struct DenseSched {
    int nM, nN, nwg, G, c, K; const char* Bt;
    __device__ __forceinline__ void init(int M, int N, int K_, const void* Bt_, int G_, int c_) { nM = M / BM; nN = N / BM; nwg = nM * nN; G = G_; c = c_; K = K_; Bt = (const char*)Bt_; }
    __device__ __forceinline__ bool next(int i, Unit& u) const {
        const long L = (long)i * G + c; if (L >= nwg) return false;
        int wgid = (int)L; { const int q = nwg / 8, r = nwg % 8, xcd = wgid % 8, off = wgid / 8; wgid = (xcd < r ? xcd * (q + 1) : r * (q + 1) + (xcd - r) * q) + off; }
        const int nig = 8 * nN, gid = wgid / nig, fm = gid * 8, gsz = (nM - fm) < 8 ? (nM - fm) : 8;
        u.pm = fm + ((wgid % nig) % gsz); u.pn = (wgid % nig) / gsz; u.e = 0; u.b = 0; u.cnt = 0; u.base = 0; return true;
    }
    __device__ __forceinline__ unsigned arow(const Unit& u, int r) const { return (unsigned)(u.pm * BM + r) * (unsigned)(K * 2); }
    __device__ __forceinline__ const char* bptr(const Unit& u) const { return Bt + (size_t)u.pn * BM * K * 2; }
};
}

struct EpiInProj {
    bf16_t* F; bf16_t* Q; bf16_t* Kb; bf16_t* Vb; const float* rope;
    __device__ __forceinline__ void operator()(const f32x4 (&acc)[2][2][4][2], const gp::Unit& u, int wr, int wc, int fr, int fq) const {
        const int pn = u.pn, pm = u.pm; const bool isctx = pm >= T / 256;
        if (isctx && pn < 4) return;
        if (pn >= 7) {
            unsigned char* V8 = (unsigned char*)Vb;
#pragma unroll
            for (int ai = 0; ai < 2; ++ai) {
                const int row0 = pm * 256 + ai * 128 + wr * 64;
                int b, tile;
                if (!isctx) { b = row0 >> 13; tile = (CTX >> 6) + ((row0 & 8191) >> 6); } else { const int j = row0 - T; b = j >> 8; tile = (j & 255) >> 6; }
#pragma unroll
                for (int bj = 0; bj < 2; ++bj) {
                    const int head = (pn - 7) * 2 + bj;
                    unsigned char* dst = V8 + ((size_t)(b * NH + head) * (KVLEN / 64) + tile) * 8192 + wc * 2048 + fq * 64 + (fr >> 3) * 32 + (fr & 1) * 16 + ((fr >> 1) & 3) * 4;
#pragma unroll
                    for (int e = 0; e < 8; ++e) {
                        int w = __builtin_amdgcn_cvt_pk_fp8_f32(acc[ai][bj][0][e >> 2][e & 3], acc[ai][bj][1][e >> 2][e & 3], 0, false);
                        w = __builtin_amdgcn_cvt_pk_fp8_f32(acc[ai][bj][2][e >> 2][e & 3], acc[ai][bj][3][e >> 2][e & 3], w, true);
                        gp::gst1(dst + e * 256, (unsigned)w);
                    }
                }
            }
            return;
        }
        const int axis = wc & 1; const float* ct = rope + (axis ? 4096 : 0); const float* st = rope + (axis ? 4096 + 1024 : 2048);
#pragma unroll
        for (int ai = 0; ai < 2; ++ai)
#pragma unroll
            for (int m = 0; m < 4; ++m) {
                const int row = pm * 256 + ai * 128 + wr * 64 + m * 16 + fr;
                int t, kb, tile;
                if (!isctx) { kb = row >> 13; t = row & 8191; tile = (CTX >> 6) + (t >> 6); } else { const int j = row - T; t = 0; kb = j >> 8; tile = (j & 255) >> 6; }
                const int pos = axis ? (t & 63) : (t >> 6);
#pragma unroll
                for (int bj = 0; bj < 2; ++bj) {
                    const int col0 = pn * 256 + bj * 128 + wc * 32 + fq * 8;
                    f32x4 v0 = acc[ai][bj][m][0], v1 = acc[ai][bj][m][1];
                    if (pn == 0) { gp::u32x4 w; w.x = gp::cvt_pk_bf16(v0[0], v0[1]); w.y = gp::cvt_pk_bf16(v0[2], v0[3]); w.z = gp::cvt_pk_bf16(v1[0], v1[1]); w.w = gp::cvt_pk_bf16(v1[2], v1[3]);
                        gp::gst4(F + (size_t)row * 256 + col0, w); continue; }
                    if (pn < 7 && !isctx) {
                        const f32x4 c0 = gp::gld4f(ct + pos * 16 + 8 * (fq & 1)), c1 = gp::gld4f(ct + pos * 16 + 8 * (fq & 1) + 4);
                        const f32x4 s0 = gp::gld4f(st + pos * 16 + 8 * (fq & 1)), s1 = gp::gld4f(st + pos * 16 + 8 * (fq & 1) + 4);
                        const float sg = (fq < 2) ? -1.f : 1.f;
#pragma unroll
                        for (int i = 0; i < 4; ++i) {
                            const auto r0 = __builtin_amdgcn_permlane32_swap(__float_as_uint(v0[i]), __float_as_uint(v0[i]), false, false);
                            const auto r1 = __builtin_amdgcn_permlane32_swap(__float_as_uint(v1[i]), __float_as_uint(v1[i]), false, false);
                            const float p0 = __uint_as_float(fq < 2 ? r0[1] : r0[0]), p1 = __uint_as_float(fq < 2 ? r1[1] : r1[0]);
                            v0[i] = v0[i] * c0[i] + sg * p0 * s0[i]; v1[i] = v1[i] * c1[i] + sg * p1 * s1[i]; }
                    }
                    v0 = v0 * SQS; v1 = v1 * SQS;
                    int w0 = __builtin_amdgcn_cvt_pk_fp8_f32(v0[0], v0[1], 0, false); w0 = __builtin_amdgcn_cvt_pk_fp8_f32(v0[2], v0[3], w0, true);
                    int w1 = __builtin_amdgcn_cvt_pk_fp8_f32(v1[0], v1[1], 0, false); w1 = __builtin_amdgcn_cvt_pk_fp8_f32(v1[2], v1[3], w1, true);
                    unsigned char* d;
                    if (pn < 4) d = (unsigned char*)Q + (size_t)row * QKW + (col0 - 256);
                    else d = (unsigned char*)Kb + ((size_t)(kb * NH + (pn - 4) * 2 + bj) * (KVLEN / 64) + tile) * 8192 + wc * 2048 + m * 512 + fr * 32 + fq * 8;
                    gp::gst2(d, (unsigned)w0, (unsigned)w1);
                }
            }
    }
};
struct EpiStoreBf16 {
    bf16_t* O; int ldc;
    __device__ __forceinline__ void operator()(const f32x4 (&acc)[2][2][4][2], const gp::Unit& u, int wr, int wc, int fr, int fq) const {
#pragma unroll
        for (int ai = 0; ai < 2; ++ai)
#pragma unroll
            for (int m = 0; m < 4; ++m) {
                bf16_t* rowp = O + (size_t)(u.pm * 256 + ai * 128 + wr * 64 + m * 16 + fr) * ldc + u.pn * 256 + wc * 32 + fq * 8;
#pragma unroll
                for (int bj = 0; bj < 2; ++bj) { const f32x4 v0 = acc[ai][bj][m][0], v1 = acc[ai][bj][m][1];
                    gp::u32x4 w; w.x = gp::cvt_pk_bf16(v0[0], v0[1]); w.y = gp::cvt_pk_bf16(v0[2], v0[3]); w.z = gp::cvt_pk_bf16(v1[0], v1[1]); w.w = gp::cvt_pk_bf16(v1[2], v1[3]);
                    gp::gst4(rowp + bj * 128, w); }
            }
    }
};

__device__ __forceinline__ void ph_inproj(const Params& p, unsigned char* smem) {
    unsigned char* ws = p.ws;
    gp::DenseSched S; S.init(MTOT, INW, D, ws + WS_WINT, gridDim.x, blockIdx.x);
    EpiInProj E{(bf16_t*)(ws + WS_F), (bf16_t*)(ws + WS_Q), (bf16_t*)(ws + WS_K), (bf16_t*)(ws + WS_V), (const float*)(ws + WS_ROPE)};
    gp::gemm_phase<EpiInProj, gp::DenseSched, true>(p.chunk, (GP_LAS unsigned char*)smem, (const char*)(ws + WS_HX), D, S, E);
}
__device__ __forceinline__ void ph_outproj(const Params& p, unsigned char* smem) {
    unsigned char* ws = p.ws;
    gp::DenseSched S; S.init(T, D, D, ws + WS_WOUTT, gridDim.x, blockIdx.x);
    EpiStoreBf16 E{(bf16_t*)(ws + WS_YX), D};
    gp::gemm_phase<EpiStoreBf16, gp::DenseSched, true>(p.chunk, (GP_LAS unsigned char*)smem, (const char*)(ws + WS_AO), D, S, E);
}

constexpr float GUSCALE = 64.f;
constexpr float WDSCALE = 16.f, ASCALE = 4.f;
struct TItem8 { const float* W; unsigned char* WT; int K, N, row_base, k0, n0; float sc; };
__device__ __forceinline__ void titem8_load(const TItem8& t, float (&tv)[32], int lane) {
#pragma unroll
    for (int i = 0; i < 32; ++i) tv[i] = t.W[(size_t)(t.k0 + 2 * i + (lane >> 5)) * t.N + t.n0 + (lane & 31)];
}
__device__ __forceinline__ void titem8_finish(const TItem8& t, const float (&tv)[32], float* scr, int lane) {
#pragma unroll
    for (int i = 0; i < 32; ++i) scr[(2 * i + (lane >> 5)) * 33 + (lane & 31)] = tv[i] * t.sc;
    asm volatile("s_waitcnt lgkmcnt(0)" ::: "memory");
    const int c = lane & 7;
#pragma unroll
    for (int j = 0; j < 4; ++j) { const int n = (lane >> 3) + 8 * j; const float* s = scr + (8 * c) * 33 + n;
        int w0 = __builtin_amdgcn_cvt_pk_fp8_f32(s[0 * 33], s[1 * 33], 0, false); w0 = __builtin_amdgcn_cvt_pk_fp8_f32(s[2 * 33], s[3 * 33], w0, true);
        int w1 = __builtin_amdgcn_cvt_pk_fp8_f32(s[4 * 33], s[5 * 33], 0, false); w1 = __builtin_amdgcn_cvt_pk_fp8_f32(s[6 * 33], s[7 * 33], w1, true);
        uint2 o; o.x = (unsigned)w0; o.y = (unsigned)w1;
        *(uint2*)(t.WT + (size_t)(t.row_base + t.n0 + n) * t.K + t.k0 + 8 * c) = o; }
    asm volatile("s_waitcnt lgkmcnt(0)" ::: "memory");
}
__device__ __forceinline__ void transpose_item(const float* W, int K, int N, bf16_t* WT, int row_base, int kb, int nb, float* scr, int lane) {
    const int k0 = 64 * kb, n0 = 32 * nb;
    float tv[32];
#pragma unroll
    for (int i = 0; i < 32; ++i) tv[i] = W[(size_t)(k0 + 2 * i + (lane >> 5)) * N + n0 + (lane & 31)];
#pragma unroll
    for (int i = 0; i < 32; ++i) scr[(2 * i + (lane >> 5)) * 33 + (lane & 31)] = tv[i];
    asm volatile("s_waitcnt lgkmcnt(0)" ::: "memory");
    const int c = lane & 7;
#pragma unroll
    for (int j = 0; j < 4; ++j) { const int n = (lane >> 3) + 8 * j; const float* s = scr + (8 * c) * 33 + n;
        uint4 o; o.x = pk2(s[0 * 33], s[1 * 33]); o.y = pk2(s[2 * 33], s[3 * 33]); o.z = pk2(s[4 * 33], s[5 * 33]); o.w = pk2(s[6 * 33], s[7 * 33]);
        *(uint4*)(WT + (size_t)(row_base + n0 + n) * K + k0 + 8 * c) = o; }
    asm volatile("s_waitcnt lgkmcnt(0)" ::: "memory");
}
__device__ __forceinline__ void ph_prep_weights(const Params& p, float* lds, const int part, const int first) {
    const int tid = otid(), wave = tid >> 6, lane = tid & 63;
    float* scr = lds + 8192 + wave * (64 * 33);
    if ((int)blockIdx.x < first) return;
    const int gw = ((int)blockIdx.x - first) * NWV + wave, GW = ((int)gridDim.x - first) * NWV;
    unsigned char* ws = p.ws;
    constexpr int I_IN = 16 * 80, I_OUT = 16 * 32, I_GU = 16 * 8, I_D = 4 * 32;
    constexpr int NITEMS = I_IN + I_OUT + 65 * (2 * I_GU + I_D);
    const int it_lo = part ? I_IN + I_OUT : 0, it_hi = part ? NITEMS : I_IN + I_OUT;
    if (part == 0) {
        for (int it = it_lo + gw; it < it_hi; it += GW) {
            int r = it;
            if (r < I_IN) { transpose_item(p.in[I_WIN], D, INW, (bf16_t*)(ws + WS_WINT), 0, r / 80, r % 80, scr, lane); continue; } r -= I_IN;
            transpose_item(p.in[I_WOUT], D, D, (bf16_t*)(ws + WS_WOUTT), 0, r / 32, r % 32, scr, lane);
        }
        return;
    }
    auto decode = [&](int it, TItem8& t) {
        int r = it - (I_IN + I_OUT);
        const int e = r / (2 * I_GU + I_D); r -= e * (2 * I_GU + I_D);
        if (r < 2 * I_GU) {
            const int half = r / I_GU, q = r % I_GU, kb = q / 8, nb = q % 8;
            t.W = (e < 64) ? p.in[half ? I_WU : I_WG] + (size_t)e * D * DE : p.in[half ? I_WSU : I_WSG];
            const int n0 = 32 * nb, drow = e * 512 + (n0 >> 7) * 256 + half * 128 + (n0 & 127);
            t.WT = ws + WS_WGUT; t.K = D; t.N = DE; t.row_base = drow - n0; t.k0 = 64 * kb; t.n0 = n0; t.sc = GUSCALE;
        } else {
            r -= 2 * I_GU;
            t.W = (e < 64) ? p.in[I_WD] + (size_t)e * DE * D : p.in[I_WSD];
            t.WT = ws + WS_WDT; t.K = DE; t.N = D; t.row_base = e * 1024; t.k0 = 64 * (r / 32); t.n0 = 32 * (r % 32); t.sc = WDSCALE;
        }
    };
    int it = it_lo + gw;
    if (it >= it_hi) return;
    TItem8 ta, tb; float va[32], vb[32];
    decode(it, ta); titem8_load(ta, va, lane);
    for (;;) {
        const bool hb = it + GW < it_hi;
        if (hb) { decode(it + GW, tb); titem8_load(tb, vb, lane); }
        titem8_finish(ta, va, scr, lane);
        if (!hb) break;
        const bool ha = it + 2 * GW < it_hi;
        if (ha) { decode(it + 2 * GW, ta); titem8_load(ta, va, lane); }
        titem8_finish(tb, vb, scr, lane);
        if (!ha) break;
        it += 2 * GW;
    }
}

namespace fa {
typedef short bf16x8 __attribute__((ext_vector_type(8)));
typedef short s16x4 __attribute__((ext_vector_type(4)));
typedef float f32x16 __attribute__((ext_vector_type(16)));
typedef unsigned u32x4 __attribute__((ext_vector_type(4)));
constexpr int KVBLK = 64, LDK = QKW;
constexpr float SCALE = 0.125f, THR = 8.f;
constexpr size_t SHM_V = KVBLK * 128 * 2, SHM_K = KVBLK * 128 * 2;
#define KSWZ(row, colB) ((row) * 256 + ((colB) ^ (((row) & 15) << 4)))
#define SBAR() __builtin_amdgcn_sched_barrier(0)
__device__ __forceinline__ int crow(int r, int hi) { return (r & 3) + 8 * (r >> 2) + 4 * hi; }
__device__ __forceinline__ unsigned cvtpk(float lo, float hi) { unsigned r; asm volatile("v_cvt_pk_bf16_f32 %0, %1, %2" : "=v"(r) : "v"(lo), "v"(hi)); return r; }
constexpr float PBIAS = 5.f, THR2 = PBIAS + 3.5f;
template <bool FIRST>
__device__ __forceinline__ void partialSM(f32x16& p0, f32x16& p1, float& m_reg, f32x16& negm, float& alpha) {
  float pmax = p0[0];
#pragma unroll
  for (int r = 1; r < 16; ++r) pmax = fmaxf(pmax, p0[r]);
#pragma unroll
  for (int r = 0; r < 16; ++r) pmax = fmaxf(pmax, p1[r]);
  { auto rr = __builtin_amdgcn_permlane32_swap(__float_as_uint(pmax), __float_as_uint(pmax), false, false);
    pmax = fmaxf(__uint_as_float(rr[0]), __uint_as_float(rr[1])); }
  if (!FIRST && __builtin_expect(__all(pmax <= THR2), 1)) { alpha = 1.f; }
  else { const float dl = FIRST ? pmax - PBIAS : fmaxf(pmax - PBIAS, 0.f); alpha = FIRST ? 0.f : __builtin_amdgcn_exp2f(-dl); m_reg += dl;
#pragma unroll
    for (int r = 0; r < 16; ++r) { p0[r] -= dl; p1[r] -= dl; }
#pragma unroll
    for (int r = 0; r < 16; ++r) negm[r] = -m_reg;
    asm volatile("" : "+v"(negm)); }
#pragma unroll
  for (int r = 0; r < 16; ++r) p0[r] = __builtin_amdgcn_exp2f(p0[r]);
}
typedef int i32x8 __attribute__((ext_vector_type(8)));
__device__ __forceinline__ int pk4_fp8(float a, float b, float c, float d) { int w; asm("v_cvt_pk_fp8_f32 %0, %1, %2" : "=v"(w) : "v"(a), "v"(b)); asm("v_cvt_pk_fp8_f32 %0, %1, %2 op_sel:[0,0,1]" : "+v"(w) : "v"(c), "v"(d)); return w; }
__device__ __forceinline__ void finishSM_T(f32x16& p0, f32x16& p1, i32x8& pb) {
#pragma unroll
  for (int r = 0; r < 16; ++r) p1[r] = __builtin_amdgcn_exp2f(p1[r]);
#pragma unroll
  for (int g = 0; g < 4; ++g) {
    pb[g] = pk4_fp8(p0[4 * g], p0[4 * g + 1], p0[4 * g + 2], p0[4 * g + 3]); pb[4 + g] = pk4_fp8(p1[4 * g], p1[4 * g + 1], p1[4 * g + 2], p1[4 * g + 3]); }
}
__device__ __forceinline__ void qkt(f32x16& p0, f32x16& p1, const char* Ks, const i32x8 qf, int lane, int mm, const f32x16& negm) {
  const char* kp = Ks + mm * 4096 + lane * 16;
  const u32x4 a0 = *reinterpret_cast<const u32x4*>(kp), a1 = *reinterpret_cast<const u32x4*>(kp + 1024), b0 = *reinterpret_cast<const u32x4*>(kp + 2048), b1 = *reinterpret_cast<const u32x4*>(kp + 3072);
  p0 = __builtin_amdgcn_mfma_scale_f32_32x32x64_f8f6f4((i32x8){(int)a0.x, (int)a0.y, (int)a0.z, (int)a0.w, (int)a1.x, (int)a1.y, (int)a1.z, (int)a1.w}, qf, negm, 0, 0, 0, 0, 0, 0);
  p1 = __builtin_amdgcn_mfma_scale_f32_32x32x64_f8f6f4((i32x8){(int)b0.x, (int)b0.y, (int)b0.z, (int)b0.w, (int)b1.x, (int)b1.y, (int)b1.z, (int)b1.w}, qf, negm, 0, 0, 0, 0, 0, 0);
}
__device__ __forceinline__ int v_st(int k, int c) { const int kk = (k & ~0xC) | ((k & 4) << 1) | ((k & 8) >> 1); return ((kk >> 3) * 4 + (c >> 5)) * 512 + ((kk & 7) * 32 + (c & 31)) * 2; }
__device__ __forceinline__ int v_rd_base(int lane) { return ((lane & 3) << 3) | (((lane >> 2) & 3) << 6) | (((lane >> 4) & 1) << 5) | (((lane >> 5) & 1) << 8); }
constexpr int v_rd_off(int d0, int ks, int half) { return d0 * 512 + ks * 4096 + half * 2048; }
template <int OFF> __device__ __forceinline__ s16x4 tr_read(int vb) {
  s16x4 r; asm volatile("ds_read_b64_tr_b16 %0, %1 offset:%2" : "=&v"(r) : "v"(vb), "i"(OFF) : "memory"); return r;
}
template <int D0> __device__ __forceinline__ void pv_one(f32x16& od, int vb, bf16x8 pa0, bf16x8 pa1, bf16x8 pa2, bf16x8 pa3) {
  const s16x4 l0 = tr_read<v_rd_off(D0, 0, 0)>(vb), h0 = tr_read<v_rd_off(D0, 0, 1)>(vb), l1 = tr_read<v_rd_off(D0, 1, 0)>(vb), h1 = tr_read<v_rd_off(D0, 1, 1)>(vb);
  const s16x4 l2 = tr_read<v_rd_off(D0, 2, 0)>(vb), h2 = tr_read<v_rd_off(D0, 2, 1)>(vb), l3 = tr_read<v_rd_off(D0, 3, 0)>(vb), h3 = tr_read<v_rd_off(D0, 3, 1)>(vb);
  asm volatile("s_waitcnt lgkmcnt(0)" ::: "memory"); SBAR();
#define PK(L, H) (bf16x8){L[0], L[1], L[2], L[3], H[0], H[1], H[2], H[3]}
  od = __builtin_amdgcn_mfma_f32_32x32x16_bf16(pa0, PK(l0, h0), od, 0, 0, 0);
  od = __builtin_amdgcn_mfma_f32_32x32x16_bf16(pa1, PK(l1, h1), od, 0, 0, 0);
  od = __builtin_amdgcn_mfma_f32_32x32x16_bf16(pa2, PK(l2, h2), od, 0, 0, 0);
  od = __builtin_amdgcn_mfma_f32_32x32x16_bf16(pa3, PK(l3, h3), od, 0, 0, 0);
#undef PK
}
__device__ __forceinline__ void pv_d0(f32x16* o, int vb, bf16x8 pa0, bf16x8 pa1, bf16x8 pa2, bf16x8 pa3) {
  pv_one<0>(o[0], vb, pa0, pa1, pa2, pa3); pv_one<1>(o[1], vb, pa0, pa1, pa2, pa3); pv_one<2>(o[2], vb, pa0, pa1, pa2, pa3); pv_one<3>(o[3], vb, pa0, pa1, pa2, pa3);
}

template <int OFF> __device__ __forceinline__ u32x4 rd128(int vb) { u32x4 r; asm volatile("ds_read_b128 %0, %1 offset:%2" : "=&v"(r) : "v"(vb), "i"(OFF) : "memory"); return r; }
#define PV_RD(D0) const u32x4 va##D0 = rd128<D0 * 2048>(vb), vc##D0 = rd128<D0 * 2048 + 1024>(vb); SBAR()
#define PV_MM(D0) do { asm volatile("s_waitcnt lgkmcnt(0)" ::: "memory"); SBAR(); \
    o[D0] = __builtin_amdgcn_mfma_scale_f32_32x32x64_f8f6f4((i32x8){(int)va##D0.x, (int)va##D0.y, (int)va##D0.z, (int)va##D0.w, (int)vc##D0.x, (int)vc##D0.y, (int)vc##D0.z, (int)vc##D0.w}, pb, o[D0], 0, 0, 0, 0, 0, 0); } while (0)
__device__ __forceinline__ float max3f(float a, float b, float c) { float r; asm("v_max3_f32 %0, %1, %2, %3" : "=v"(r) : "v"(a), "v"(b), "v"(c)); return r; }
#define PV_LSUM() lacc = __builtin_amdgcn_mfma_scale_f32_32x32x64_f8f6f4((i32x8){0x38383838, 0x38383838, 0x38383838, 0x38383838, 0x38383838, 0x38383838, 0x38383838, 0x38383838}, pb, lacc, 0, 0, 0, 0, 0, 0)
__device__ __forceinline__ void pv_psm(f32x16* o, f32x16& lacc, int vb, i32x8 pb, f32x16& p0, f32x16& p1, float& m_reg, f32x16& negm, float& alpha) {
  float pmax;
  { PV_RD(0);
    pmax = max3f(p0[0], p0[1], p0[2]);
#pragma unroll
    for (int r = 3; r < 15; r += 2) pmax = max3f(pmax, p0[r], p0[r + 1]);
    pmax = max3f(pmax, p0[15], p1[0]);
    SBAR(); PV_MM(0); }
  { PV_RD(1);
#pragma unroll
    for (int r = 1; r < 15; r += 2) pmax = max3f(pmax, p1[r], p1[r + 1]);
    pmax = max3f(pmax, p1[15], p1[15]);
    { auto rr = __builtin_amdgcn_permlane32_swap(__float_as_uint(pmax), __float_as_uint(pmax), false, false);
      pmax = max3f(__uint_as_float(rr[0]), __uint_as_float(rr[1]), __uint_as_float(rr[1])); }
    if (__builtin_expect(__all(pmax <= THR2), 1)) { alpha = 1.f; }
    else { const float dl = fmaxf(pmax - PBIAS, 0.f); alpha = __builtin_amdgcn_exp2f(-dl); m_reg += dl;
#pragma unroll
      for (int r = 0; r < 16; ++r) { p0[r] -= dl; p1[r] -= dl; }
#pragma unroll
      for (int r = 0; r < 16; ++r) negm[r] = -m_reg;
      asm volatile("" : "+v"(negm)); }
    SBAR(); PV_MM(1); }
  { PV_RD(2);
#pragma unroll
    for (int r = 0; r < 8; ++r) p0[r] = __builtin_amdgcn_exp2f(p0[r]);
    asm volatile("" : "+v"(p0));
    SBAR(); PV_MM(2); }
  { PV_RD(3);
#pragma unroll
    for (int r = 8; r < 16; ++r) p0[r] = __builtin_amdgcn_exp2f(p0[r]);
    asm volatile("" : "+v"(p0));
    SBAR(); PV_MM(3); PV_LSUM(); }
}
__device__ __forceinline__ void pvT_d0(f32x16* o, f32x16& lacc, int vb, i32x8 pb) {
  { PV_RD(0); PV_MM(0); } { PV_RD(1); PV_MM(1); } { PV_RD(2); PV_MM(2); } { PV_RD(3); PV_MM(3); PV_LSUM(); }
}
#undef PV_RD
#undef PV_MM
#undef PV_LSUM

__device__ __forceinline__ void attn_unit(const unsigned char* __restrict__ Qb, const unsigned char* __restrict__ Kh, const unsigned char* __restrict__ Vh, bf16_t* __restrict__ Ob,
                                          const float* __restrict__ gsub, const float lam, char* lds, const int wv) {
  typedef __attribute__((address_space(3))) unsigned* ldsu_t;
  const int tid = otid_w(wv), wid = wv, lane = tid & 63, r32 = lane & 31, hi = lane >> 5, mm = wid >> 2, wq = wid & 3;
  constexpr int NB = 4;
  constexpr int SHM_V8 = KVBLK * 128;
  char* V_lds = lds; char* K_lds = lds + NB * SHM_V8; constexpr int SHM_K8 = KVBLK * 128;
  float m_reg = 0.f; f32x16 o[4] = {}; f32x16 lacc = {}; i32x8 qf; f32x16 negm = {}; asm volatile("" : "+v"(negm));
  const unsigned koff = (unsigned)((2 * (wid >> 2) + (lane >> 5)) * 2048 + (lane & 3) * 512 + (8 * ((wid >> 1) & 1) + 2 * ((lane & 31) >> 3) + ((lane >> 2) & 1)) * 32 + (wid & 1) * 16);
  const unsigned voff = (unsigned)((wid >> 1) * 2048 + (lane & 7) * 256 + ((lane >> 3) & 3) * 64 + (wid & 1) * 32 + (lane >> 5) * 16);
#define DMA(t, buf) do { const char* kb_ = (const char*)(Kh + (size_t)(t) * SHM_K8); const char* vb_ = (const char*)(Vh + (size_t)(t) * SHM_V8); asm volatile("" : "+s"(kb_), "+s"(vb_)); \
    __builtin_amdgcn_global_load_lds((const unsigned*)(kb_ + koff), (ldsu_t)(K_lds + (buf) * SHM_K8 + wid * 1024), 16, 0, 0); \
    __builtin_amdgcn_global_load_lds((const unsigned*)(vb_ + voff), (ldsu_t)(V_lds + (buf) * SHM_V8 + wid * 1024), 16, 0, 0); } while (0)
#define WAIT_BAR(N) asm volatile("s_waitcnt vmcnt(" #N ") lgkmcnt(0)\n\ts_barrier" ::: "memory")
#define RESC(a) do { if (__any((a) < 1.f)) { _Pragma("unroll") for (int d = 0; d < 4; ++d) _Pragma("unroll") for (int r = 0; r < 16; ++r) o[d][r] *= (a); lacc[0] *= (a); } } while (0)
  DMA(0, 0); DMA(1, 1);
  { const unsigned char* Qw = Qb + (long)(wq * 32 + r32) * QKW + mm * 64 + hi * 32;
    const u32x4 q0 = *reinterpret_cast<const u32x4*>(Qw), q1 = *reinterpret_cast<const u32x4*>(Qw + 16);
    qf = (i32x8){(int)q0.x, (int)q0.y, (int)q0.z, (int)q0.w, (int)q1.x, (int)q1.y, (int)q1.z, (int)q1.w}; }
  const int vb0 = (int)(uintptr_t)V_lds + lane * 16;
  f32x16 pA0, pA1, pB0, pB1; float alA, alB; i32x8 pb; constexpr int NTL = KVLEN / KVBLK;
  WAIT_BAR(0);
  DMA(2, 2);
  qkt(pA0, pA1, K_lds, qf, lane, mm, negm); partialSM<true>(pA0, pA1, m_reg, negm, alA);
  WAIT_BAR(2);
  for (int j = 1; j + 1 < NTL; j += 2) {
    DMA(j + 2, (j + 2) & 3);
    SBAR(); qkt(pB0, pB1, K_lds + (j & 3) * SHM_K8, qf, lane, mm, negm);
    finishSM_T(pA0, pA1, pb); SBAR();
    pv_psm(o, lacc, vb0 + ((j - 1) & 3) * SHM_V8, pb, pB0, pB1, m_reg, negm, alB);
    RESC(alB);
    WAIT_BAR(2);
    if (j + 3 < NTL) DMA(j + 3, (j + 3) & 3);
    SBAR(); qkt(pA0, pA1, K_lds + ((j + 1) & 3) * SHM_K8, qf, lane, mm, negm);
    finishSM_T(pB0, pB1, pb); SBAR();
    pv_psm(o, lacc, vb0 + (j & 3) * SHM_V8, pb, pA0, pA1, m_reg, negm, alA);
    RESC(alA);
    if (j + 3 < NTL) WAIT_BAR(2); else WAIT_BAR(0);
  }
  SBAR(); qkt(pB0, pB1, K_lds + ((NTL - 1) & 3) * SHM_K8, qf, lane, mm, negm);
  finishSM_T(pA0, pA1, pb); SBAR();
  pv_psm(o, lacc, vb0 + ((NTL - 2) & 3) * SHM_V8, pb, pB0, pB1, m_reg, negm, alB);
  RESC(alB);
  finishSM_T(pB0, pB1, pb); SBAR();
  pvT_d0(o, lacc, vb0 + ((NTL - 1) & 3) * SHM_V8, pb);
#undef DMA
#undef WAIT_BAR
  const float rl = __builtin_amdgcn_rcpf(lacc[0]) * (mm ? lam : 1.0f);
  __syncthreads();
  constexpr int XS = 132;
  float* X = (float*)lds;
  if (mm == 1) {
#pragma unroll
    for (int r = 0; r < 16; ++r)
#pragma unroll
      for (int d0 = 0; d0 < 4; ++d0) X[(wq * 32 + r32) * XS + d0 * 32 + crow(r, hi)] = o[d0][r] * rl;
  }
  __syncthreads();
  if (mm == 0) {
#pragma unroll
    for (int r = 0; r < 16; ++r)
#pragma unroll
      for (int d0 = 0; d0 < 4; ++d0) { float* xp = X + (wq * 32 + r32) * XS + d0 * 32 + crow(r, hi); *xp = o[d0][r] * rl - *xp; }
  }
  __syncthreads();
  {
    const int row = tid >> 2, seg = tid & 3;
    const float* xr = X + row * XS + seg * 32;
    f32x4 v[8]; float ss = 0.f;
#pragma unroll
    for (int i = 0; i < 8; ++i) { v[i] = *(const f32x4*)(xr + 4 * i); ss += v[i][0] * v[i][0] + v[i][1] * v[i][1] + v[i][2] * v[i][2] + v[i][3] * v[i][3]; }
    ss += sx<1>(ss); ss += sx<2>(ss);
    const float rs = (1.0f - LAM_INIT) / sqrtf(ss * (1.0f / 128.0f) + EPS);
    bf16_t* dst = Ob + (long)row * D + seg * 32;
#pragma unroll
    for (int i = 0; i < 8; i += 2) {
      const f32x4 g0 = *(const f32x4*)(gsub + seg * 32 + 4 * i), g1 = *(const f32x4*)(gsub + seg * 32 + 4 * i + 4);
      u32x4 w; w.x = cvtpk(v[i][0] * rs * g0[0], v[i][1] * rs * g0[1]); w.y = cvtpk(v[i][2] * rs * g0[2], v[i][3] * rs * g0[3]);
      w.z = cvtpk(v[i + 1][0] * rs * g1[0], v[i + 1][1] * rs * g1[1]); w.w = cvtpk(v[i + 1][2] * rs * g1[2], v[i + 1][3] * rs * g1[3]);
      *(u32x4*)(dst + 4 * i) = w;
    }
  }
  __syncthreads();
#undef RESC
}
#undef KSWZ
#undef SBAR
}

__device__ __forceinline__ void ph_attn(const Params& p, unsigned char* smem) {
    unsigned char* ws = p.ws;
    const unsigned char* Q = ws + WS_Q; const unsigned char* Kb = ws + WS_K; const unsigned char* Vb = ws + WS_V;
    bf16_t* AO = (bf16_t*)(ws + WS_AO);
    const float lam = ((const float*)(ws + WS_CTL))[1024];
    const int c = blockIdx.x, G = gridDim.x;
    if (G == 256) {
        const int x = c & 7, s = c >> 3;
        for (int rd = 0; rd < 6; ++rd) {
            const int bh = rd * 4 + (x >> 1), qb = (x & 1) * 32 + s, b = bh / NH, h = bh % NH;
            fa::attn_unit(Q + ((size_t)b * SEQ + qb * 128) * QKW + h * 128, Kb + (size_t)(b * NH + h) * (KVLEN / 64) * 8192, Vb + (size_t)(b * NH + h) * (KVLEN / 64) * 8192,
                          AO + ((size_t)b * SEQ + qb * 128) * D + 256 + h * 128, p.in[I_GSUB], lam, (char*)smem, p.chunk);
        }
    } else {
        for (int u = c; u < BATCH * NH * 64; u += G) {
            const int bh = u >> 6, qb = u & 63, b = bh / NH, h = bh % NH;
            fa::attn_unit(Q + ((size_t)b * SEQ + qb * 128) * QKW + h * 128, Kb + (size_t)(b * NH + h) * (KVLEN / 64) * 8192, Vb + (size_t)(b * NH + h) * (KVLEN / 64) * 8192,
                          AO + ((size_t)b * SEQ + qb * 128) * D + 256 + h * 128, p.in[I_GSUB], lam, (char*)smem, p.chunk);
        }
    }
}

__device__ __forceinline__ void ph_fourierA(const Params& p, unsigned char* smem) {
    using namespace fa;
    unsigned char* ws = p.ws;
    const bf16_t* F = (const bf16_t*)(ws + WS_F); bf16_t* FY = (bf16_t*)(ws + WS_FY); const bf16_t* W = (const bf16_t*)(ws + WS_W128E);
    const int tid = otid(), wid = tid >> 6, lane = tid & 63, r32 = lane & 31, hi = lane >> 5;
    const int sr = tid >> 4, sc = (tid & 15) * 8, vst0 = v_st(sr, sc), vst1 = v_st(32 + sr, sc);
    const int vb0 = (int)(uintptr_t)smem + v_rd_base(lane);
    for (int task = blockIdx.x; task < BATCH * 64; task += gridDim.x) {
        const int b = task >> 6, n2 = task & 63;
        bf16x8 st[4][2];
#pragma unroll
        for (int kt = 0; kt < 2; ++kt)
#pragma unroll
            for (int ct = 0; ct < 2; ++ct) {
                st[kt * 2 + ct][0] = *(const bf16x8*)(F + ((size_t)b * SEQ + 64 * (64 * kt + sr) + n2) * 256 + 128 * ct + sc);
                st[kt * 2 + ct][1] = *(const bf16x8*)(F + ((size_t)b * SEQ + 64 * (64 * kt + 32 + sr) + n2) * 256 + 128 * ct + sc);
            }
        bf16x8 pa[2][4];
#pragma unroll
        for (int kt = 0; kt < 2; ++kt)
#pragma unroll
            for (int ks = 0; ks < 4; ++ks) pa[kt][ks] = *(const bf16x8*)(W + (size_t)(32 * wid + r32) * 128 + 64 * kt + 16 * ks + 8 * hi);
        __syncthreads();
#pragma unroll
        for (int q = 0; q < 4; ++q) { *(bf16x8*)(smem + q * 16384 + vst0) = st[q][0]; *(bf16x8*)(smem + q * 16384 + vst1) = st[q][1]; }
        __syncthreads();
        f32x16 o[2][4] = {};
#pragma unroll
        for (int ct = 0; ct < 2; ++ct)
#pragma unroll
            for (int kt = 0; kt < 2; ++kt) pv_d0(o[ct], vb0 + (kt * 2 + ct) * 16384, pa[kt][0], pa[kt][1], pa[kt][2], pa[kt][3]);
        const int plane = wid >> 2;
#pragma unroll
        for (int r = 0; r < 16; ++r) {
            const int k1 = 32 * (wid & 3) + crow(r, hi);
            bf16_t* dst = FY + ((((size_t)plane * BATCH + b) * 128 + k1) * 64 + n2) * 256 + r32;
#pragma unroll
            for (int ct = 0; ct < 2; ++ct)
#pragma unroll
                for (int d0 = 0; d0 < 4; ++d0) dst[128 * ct + 32 * d0] = f2bf(o[ct][d0][r]);
        }
    }
    __syncthreads();
}
__device__ __forceinline__ void ph_fourierB(const Params& p, unsigned char* smem) {
    using namespace fa;
    unsigned char* ws = p.ws;
    const bf16_t* FY = (const bf16_t*)(ws + WS_FY); const float2* tabw = (const float2*)(ws + WS_TABW);
    const bf16_t* M64 = (const bf16_t*)(ws + WS_M64E); const bf16_t* GT = (const bf16_t*)(ws + WS_GT);
    bf16_t* AO = (bf16_t*)(ws + WS_AO);
    const int tid = otid(), wid = tid >> 6, lane = tid & 63, r32 = lane & 31, hi = lane >> 5;
    const int sr = tid >> 4, sc = (tid & 15) * 8, vst0 = v_st(sr, sc), vst1 = v_st(32 + sr, sc);
    const int vb0 = (int)(uintptr_t)smem + v_rd_base(lane);
    constexpr int XRS = 528;
    unsigned char* XL = smem + 65536;
    const int mt = wid & 3, ctw = wid >> 2;
    for (int task = blockIdx.x; task < BATCH * 128; task += gridDim.x) {
        const int b = task >> 7, k1 = task & 127;
        __syncthreads();
#pragma unroll
        for (int ct = 0; ct < 2; ++ct)
#pragma unroll
            for (int rh = 0; rh < 2; ++rh) {
                const int n2 = sr + 32 * rh;
                const size_t off = ((((size_t)b) * 128 + k1) * 64 + n2) * 256 + 128 * ct + sc;
                const uint4 yr = *(const uint4*)(FY + off), yi = *(const uint4*)(FY + (size_t)BATCH * 128 * 64 * 256 + off);
                const float2 tw = tabw[n2 * k1];
                const unsigned yrw[4] = {yr.x, yr.y, yr.z, yr.w}, yiw[4] = {yi.x, yi.y, yi.z, yi.w};
                unsigned zr[4], zi[4];
#pragma unroll
                for (int q = 0; q < 4; ++q) {
                    const float a0 = __uint_as_float(yrw[q] << 16), a1 = __uint_as_float(yrw[q] & 0xffff0000u), b0 = __uint_as_float(yiw[q] << 16), b1 = __uint_as_float(yiw[q] & 0xffff0000u);
                    zr[q] = pk2(a0 * tw.x + b0 * tw.y, a1 * tw.x + b1 * tw.y); zi[q] = pk2(b0 * tw.x - a0 * tw.y, b1 * tw.x - a1 * tw.y);
                }
                const int vs = rh ? vst1 : vst0;
                *(uint4*)(smem + (0 * 2 + ct) * 16384 + vs) = make_uint4(zr[0], zr[1], zr[2], zr[3]);
                *(uint4*)(smem + (1 * 2 + ct) * 16384 + vs) = make_uint4(zi[0], zi[1], zi[2], zi[3]);
            }
        __syncthreads();
        {
            f32x16 o[4] = {};
#pragma unroll
            for (int kt = 0; kt < 2; ++kt) {
                bf16x8 pa[4];
#pragma unroll
                for (int ks = 0; ks < 4; ++ks) pa[ks] = *(const bf16x8*)(M64 + (size_t)(32 * mt + r32) * 128 + 64 * kt + 16 * ks + 8 * hi);
                pv_d0(o, vb0 + (kt * 2 + ctw) * 16384, pa[0], pa[1], pa[2], pa[3]);
            }
#pragma unroll
            for (int r = 0; r < 16; ++r) {
                const int ro = 32 * mt + crow(r, hi);
                bf16_t* xr = (bf16_t*)(XL + ((ro >> 6) * 64 + (ro & 63)) * XRS) + 128 * ctw + r32;
#pragma unroll
                for (int d0 = 0; d0 < 4; ++d0) xr[32 * d0] = f2bf(o[d0][r]);
            }
        }
        __syncthreads();
#pragma unroll
        for (int tt = 0; tt < 2; ++tt) {
            const int tau = 2 * wid + tt, g = tau >> 2, mt2 = (tau >> 1) & 1, nt2 = tau & 1;
            f32x16 acc = {};
#pragma unroll
            for (int ks8 = 0; ks8 < 8; ++ks8) {
                const int part = ks8 >> 2, cb = ks8 & 3;
                const bf16x8 af = *(const bf16x8*)(XL + (part * 64 + 32 * mt2 + r32) * XRS + (g * 64 + 16 * cb + 8 * hi) * 2);
                const bf16x8 bfr = *(const bf16x8*)(GT + ((size_t)g * 64 + 32 * nt2 + r32) * 128 + part * 64 + 16 * cb + 8 * hi);
                acc = __builtin_amdgcn_mfma_f32_32x32x16_bf16(af, bfr, acc, 0, 0, 0);
            }
#pragma unroll
            for (int r = 0; r < 16; ++r) { const int k2 = 32 * mt2 + crow(r, hi);
                AO[((size_t)b * SEQ + k1 + 128 * k2) * D + g * 64 + 32 * nt2 + r32] = f2bf(acc[r]); }
        }
    }
    __syncthreads();
}

__device__ __forceinline__ void ph_mid(const Params& p, unsigned char* smem) {
    typedef short bf16x8 __attribute__((ext_vector_type(8)));
    unsigned char* ws = p.ws;
    const int tid = otid(), wave = tid >> 6, lane = tid & 63, fr = lane & 15, fq = lane >> 4;
    const float* mod = (const float*)(ws + WS_MOD);
    const bf16_t* YX = (const bf16_t*)(ws + WS_YX);
    unsigned char* H2 = ws + WS_H2;
    unsigned* counts = (unsigned*)(ws + WS_CTL);
    int* TE = (int*)(ws + WS_TE); int* TP = (int*)(ws + WS_TP); float* TW = (float*)(ws + WS_TW); int* TOKL = (int*)(ws + WS_TOKL);
    constexpr int RS = 2064;
    unsigned char* Ahi = smem; unsigned char* Alo = smem + 16 * RS; float* Pp = (float*)(smem + 2 * 16 * RS + 512);
    const float rbias = p.in[I_RB][lane];
    int* lcnt = (int*)(smem + 99328); int* gb = lcnt + 64; int* PE = gb + 64; float* PW = (float*)(PE + 1024); float* PV = PW + 1024;
    for (int chunk = blockIdx.x; chunk < T / 128; chunk += gridDim.x) {
      const int mc = chunk * 128, b = mc >> 13;
      if (tid < 64) lcnt[tid] = 0;
      {
          const float* mrow_ = mod + b * 6144;
          for (int i = tid; i < 5 * 256; i += NT) { const int v_ = i >> 8, q_ = (i & 255) * 4;
              const float* s_ = (v_ == 0) ? p.in[I_GAPOST] + q_ : (v_ == 1) ? mrow_ + 2 * 1024 + q_ : (v_ == 2) ? p.in[I_GFPRE] + q_ : (v_ == 3) ? mrow_ + 3 * 1024 + q_ : mrow_ + 4 * 1024 + q_;
              *(f32x4*)(PV + v_ * 1024 + q_) = *(const f32x4*)s_; }
          __syncthreads();
      }
      uint2 yw[2][4]; f32x4 xv[2][4];
      bf16x8 wfr[4][4];
      { const bf16_t* wrt_ = (const bf16_t*)(ws + WS_WRT) + (size_t)p.chunk * 16 * 1024; asm volatile("" : "+s"(wrt_));
#pragma unroll
        for (int ks = 0; ks < 4; ++ks) {
#pragma unroll
          for (int nb = 0; nb < 4; ++nb) wfr[ks][nb] = *(const bf16x8*)(wrt_ + (size_t)((ks * 4 + nb) * 2 * 64 + lane) * 8);
          __builtin_amdgcn_sched_barrier(0); } }
#define MID_LOAD(m0_) do { _Pragma("unroll") for (int rr = 0; rr < 2; ++rr) { const int m_ = (m0_) + 2 * wave + rr; _Pragma("unroll") for (int j = 0; j < 4; ++j) { \
          yw[rr][j] = *(const uint2*)(YX + (size_t)m_ * D + 4 * (lane + 64 * j)); xv[rr][j] = ((const f32x4*)(p.in[I_X] + (size_t)m_ * D))[lane + 64 * j]; } } } while (0)
      MID_LOAD(mc);
#pragma unroll 1
      for (int it = 0; it < 8; ++it) {
        const int m0 = mc + it * 16;
        {
            float ss[2] = {0.f, 0.f};
#define YV(rr, j, i) ((i) == 0 ? __uint_as_float(yw[rr][j].x << 16) : (i) == 1 ? __uint_as_float(yw[rr][j].x & 0xffff0000u) : (i) == 2 ? __uint_as_float(yw[rr][j].y << 16) : __uint_as_float(yw[rr][j].y & 0xffff0000u))
#pragma unroll
            for (int rr = 0; rr < 2; ++rr) {
#pragma unroll
                for (int j = 0; j < 4; ++j) ss[rr] += YV(rr, j, 0) * YV(rr, j, 0) + YV(rr, j, 1) * YV(rr, j, 1) + YV(rr, j, 2) * YV(rr, j, 2) + YV(rr, j, 3) * YV(rr, j, 3);
                ss[rr] = wave_sum(ss[rr]);
            }
#pragma unroll
            for (int rr = 0; rr < 2; ++rr) {
                const int lr = 2 * wave + rr, m = m0 + lr;
                const float r1 = 1.0f / sqrtf(ss[rr] * (1.0f / D) + EPS);
                float ss2 = 0.f;
#pragma unroll
                for (int j = 0; j < 4; ++j) {
                    const int col = 4 * (lane + 64 * j);
                    const f32x4 gp = *(const f32x4*)(PV + col), gt = *(const f32x4*)(PV + 1024 + col);
#pragma unroll
                    for (int i = 0; i < 4; ++i) { xv[rr][j][i] = xv[rr][j][i] + gt[i] * (YV(rr, j, i) * r1 * gp[i]); ss2 += xv[rr][j][i] * xv[rr][j][i]; }
                    ((f32x4*)(p.out + (size_t)m * D))[lane + 64 * j] = xv[rr][j];
                }
                ss2 = wave_sum(ss2);
                const float r2 = 1.0f / sqrtf(ss2 * (1.0f / D) + EPS);
#pragma unroll
                for (int j = 0; j < 4; ++j) {
                    const int col = 4 * (lane + 64 * j);
                    const f32x4 gp = *(const f32x4*)(PV + 2048 + col), sh = *(const f32x4*)(PV + 3072 + col), sc = *(const f32x4*)(PV + 4096 + col);
                    float h[4];
#pragma unroll
                    for (int i = 0; i < 4; ++i) h[i] = xv[rr][j][i] * r2 * gp[i] * (1.f + sc[i]) + sh[i];
                    uint2 o; o.x = pk2(h[0], h[1]); o.y = pk2(h[2], h[3]);
                    { int w8 = __builtin_amdgcn_cvt_pk_fp8_f32(h[0], h[1], 0, false); w8 = __builtin_amdgcn_cvt_pk_fp8_f32(h[2], h[3], w8, true); *(int*)(H2 + (size_t)m * D + col) = w8; }
                    *(uint2*)(Ahi + lr * RS + col * 2) = o;
                }
            }
            if (it < 7) MID_LOAD(m0 + 16);
        }
        asm volatile("s_waitcnt lgkmcnt(0)\n\ts_barrier" ::: "memory");
        {
            f32x4 acc[4];
#pragma unroll
            for (int nb = 0; nb < 4; ++nb) acc[nb] = (f32x4){0.f, 0.f, 0.f, 0.f};
#pragma unroll
            for (int ks = 0; ks < 4; ++ks) {
                const int ko = (wave * 128 + ks * 32 + 8 * fq) * 2;
                const bf16x8 ah = *(const bf16x8*)(Ahi + fr * RS + ko);
#pragma unroll
                for (int nb = 0; nb < 4; ++nb) acc[nb] = __builtin_amdgcn_mfma_f32_16x16x32_bf16(ah, wfr[ks][nb], acc[nb], 0, 0, 0);
            }
#pragma unroll
            for (int nb = 0; nb < 4; ++nb)
#pragma unroll
                for (int j = 0; j < 4; ++j) Pp[(wave * 16 + 4 * fq + j) * 64 + 16 * nb + fr] = acc[nb][j];
        }
        asm volatile("s_waitcnt lgkmcnt(0)\n\ts_barrier" ::: "memory");
#pragma unroll
        for (int rr = 0; rr < 2; ++rr) {
            const int lr = 2 * wave + rr;
            float lg = 0.f;
#pragma unroll
            for (int w = 0; w < 8; ++w) lg += Pp[(w * 16 + lr) * 64 + lane];
            const float score = 1.0f / (1.0f + expf(-lg));
            const float sel = score + rbias;
            float t1 = sel, t2 = -INFINITY;
#define TOP2(M) do { const float o1 = sx<M>(t1), o2 = sx<M>(t2); const float n1 = fmaxf(t1, o1), n2 = fmaxf(fminf(t1, o1), fmaxf(t2, o2)); t1 = n1; t2 = n2; } while (0)
            TOP2(1); TOP2(2); TOP2(4);
#undef TOP2
            const float gs = t1 + t2; const int grp = lane >> 3;
            int gr = 0;
#pragma unroll
            for (int j = 0; j < 8; ++j) { const float sj = __uint_as_float(__builtin_amdgcn_readlane(__float_as_uint(gs), j * 8)); gr += (sj > gs || (sj == gs && j < grp)) ? 1 : 0; }
            const bool gsel = gr < 4;
            float v = gsel ? sel : -INFINITY;
            int rk = TOPK;
#pragma unroll
            for (int it8 = 0; it8 < TOPK; ++it8) {
                const float mx = wave_max(v);
                const unsigned long long eq = __ballot(v == mx);
                const int win = __builtin_ctzll(eq);
                if (lane == win) { rk = it8; v = -INFINITY; }
            }
            const bool chosen = rk < TOPK;
            const float ssum = wave_sum(chosen ? score : 0.f);
            const float w = score / (ssum + 1e-20f) * 2.5f;
            if (chosen) {
                const int lpos = atomicAdd(&lcnt[lane], 1);
                const int idx = (it * 16 + lr) * 8 + rk;
                PE[idx] = lane | (lpos << 8); PW[idx] = w;
            }
        }
      }
      __syncthreads();
      if (tid < 64) { const int c = lcnt[tid]; gb[tid] = c ? (int)atomicAdd(&counts[b * 65 + tid], (unsigned)c) : 0; }
      __syncthreads();
      for (int i = tid; i < 1024; i += NT) {
          const int pe = PE[i], e = pe & 255, pos = gb[e] + (pe >> 8), mk = mc * 8 + i;
          TOKL[((size_t)b * 64 + e) * 8192 + pos] = mk; TE[mk] = e; TP[mk] = pos; TW[mk] = PW[i];
      }
      __syncthreads();
    }
}

constexpr int T_CNT = 0;
constexpr int T_TOT = 256;
constexpr int T_AB = 328;
constexpr int T_OFF = 400;
constexpr int T_GUP = 660;
constexpr int T_YC = 730;
constexpr int T_YB = 990;
constexpr int T_DUP = 1250;
constexpr int T_UL = 1520;
constexpr int T_END = 1520 + 512;
__device__ __forceinline__ int scan_incl(int v, int lane) {
#pragma unroll
    for (int off = 1; off < 64; off <<= 1) { const int t = __builtin_amdgcn_ds_bpermute(((lane - off) & 63) << 2, v); if (lane >= off) v += t; }
    return v;
}
__device__ __forceinline__ void build_moe(const Params& p, int* tab) {
    const unsigned* counts = (const unsigned*)(p.ws + WS_CTL);
    __syncthreads();
    const int tid = otid(), wave = tid >> 6, lane = tid & 63;
    if (wave == 0) {
        const int c0 = (int)counts[0 * 65 + lane], c1 = (int)counts[1 * 65 + lane], c2 = (int)counts[2 * 65 + lane], c3 = (int)counts[3 * 65 + lane];
        tab[T_CNT + 0 * 64 + lane] = c0; tab[T_CNT + 1 * 64 + lane] = c1; tab[T_CNT + 2 * 64 + lane] = c2; tab[T_CNT + 3 * 64 + lane] = c3;
        tab[T_OFF + lane * 4 + 0] = 0; tab[T_OFF + lane * 4 + 1] = c0; tab[T_OFF + lane * 4 + 2] = c0 + c1; tab[T_OFF + lane * 4 + 3] = c0 + c1 + c2;
        const int tot = c0 + c1 + c2 + c3, pad = (tot + 255) & ~255, gu = ((tot + 255) >> 8) * 2;
        const int sp = scan_incl(pad, lane), sg = scan_incl(gu, lane);
        tab[T_TOT + lane] = tot; tab[T_AB + lane] = sp - pad; tab[T_GUP + lane] = sg - gu;
        const int cb[4] = {c0, c1, c2, c3};
#pragma unroll
        for (int b = 0; b < 4; ++b) {
            const int du = ((cb[b] + 255) >> 8) * 4;
            const int sy = scan_incl(cb[b], lane), sd = scan_incl(du, lane);
            tab[T_YB + 65 * b + lane] = sy - cb[b]; tab[T_DUP + 66 * b + lane] = sd - du;
            if (lane == 63) { tab[T_YB + 65 * b + 64] = sy; tab[T_DUP + 66 * b + 64] = sd; tab[T_DUP + 66 * b + 65] = sd + (SEQ / 256) * 4; }
        }
        if (lane == 63) { tab[T_TOT + 64] = T; tab[T_AB + 64] = sp; tab[T_GUP + 64] = sg; tab[T_GUP + 65] = sg + (T / 256) * 2; }
    }
    __syncthreads();
}

__device__ __forceinline__ void moe_decode(const GP_LAS int* tab, int e, int pos_e, int& b, int& pos) {
    const int o1 = tab[T_OFF + e * 4 + 1], o2 = tab[T_OFF + e * 4 + 2], o3 = tab[T_OFF + e * 4 + 3];
    b = (pos_e >= o1 ? 1 : 0) + (pos_e >= o2 ? 1 : 0) + (pos_e >= o3 ? 1 : 0);
    pos = pos_e - (b == 0 ? 0 : (b == 1 ? o1 : (b == 2 ? o2 : o3)));
}
__device__ __forceinline__ int yrow0(int b) { return b == 0 ? 2 * 1024 : (272 + 72 * (b - 1)) * 1024; }
struct MoeSched {
    const GP_LAS int* tab; int G, c, ntn, U, down, chunk; const int* TOKL; const char* Bt;
    __device__ __forceinline__ void prepare(int* tabw, int wv) const {
        if (wv == 0) {
            const int i = lane_id(); int L = i * G + c;
            if (L < U) {
                int bt = 0;
                if (down) {
#pragma unroll
                    for (int q = 0; q < 3; ++q) { const int u0 = tabw[T_DUP + 66 * bt + 65]; if (L >= u0) { L -= u0; ++bt; } } }
                const int pre = down ? T_DUP + 66 * bt : T_GUP;
                int lo = 0, hi = 64;
                while (lo < hi) { const int mid = (lo + hi + 1) >> 1; if (tabw[pre + mid] <= L) lo = mid; else hi = mid - 1; }
                const int loc = L - tabw[pre + lo];
                int cnt, base, bb;
                if (down) { cnt = (lo < 64) ? tabw[T_CNT + bt * 64 + (lo & 63)] : SEQ; base = tabw[T_YB + 65 * bt + lo] + yrow0(bt);
                            bb = tabw[T_AB + lo] + (lo < 64 ? tabw[T_OFF + (lo & 63) * 4 + bt] : bt * SEQ); }
                else { cnt = tabw[T_TOT + lo]; base = tabw[T_AB + lo]; bb = 0; }
                int* ul = tabw + T_UL + 8 * i;
                ul[0] = lo; ul[1] = loc / ntn; ul[2] = loc % ntn; ul[3] = cnt; ul[4] = base; ul[5] = bb;
            }
        }
        __syncthreads();
    }
    __device__ __forceinline__ bool next(int i, gp::Unit& u) const {
        if (i * G + c >= U) return false;
        const GP_LAS int* ul = tab + T_UL + 8 * i;
        u.e = __builtin_amdgcn_readfirstlane(ul[0]); u.pm = __builtin_amdgcn_readfirstlane(ul[1]); u.pn = __builtin_amdgcn_readfirstlane(ul[2]);
        u.cnt = __builtin_amdgcn_readfirstlane(ul[3]); u.base = __builtin_amdgcn_readfirstlane(ul[4]); u.b = __builtin_amdgcn_readfirstlane(ul[5]);
        return true;
    }
    __device__ __forceinline__ unsigned arow(const gp::Unit& u, int r) const {
        const int pos_e = u.pm * 256 + r;
        if (down) return (unsigned)(u.b + pos_e) * 256u;
        int tok;
        if (u.e < 64) { int b, pos; moe_decode(tab, u.e, pos_e, b, pos); tok = (pos_e < u.cnt) ? (TOKL[((size_t)b * 64 + u.e) * 8192 + pos] >> 3) : 0; } else tok = pos_e;
        return (unsigned)tok * 1024u;
    }
    __device__ __forceinline__ const char* bptr(const gp::Unit& u) const {
        return down ? Bt + ((size_t)u.e * 1024 + u.pn * 256) * 256 : Bt + ((size_t)u.e * 512 + u.pn * 256) * 1024;
    }
};
struct EpiGU {
    unsigned char* ACT; const int* TOKL; const float* TW; const GP_LAS int* tab;
    __device__ __forceinline__ void operator()(const f32x4 (&acc)[2][2][4][2], const gp::Unit& u, int wr, int wc, int fr, int fq) const {
#pragma unroll
        for (int ai = 0; ai < 2; ++ai)
#pragma unroll
            for (int m = 0; m < 4; ++m) {
                const int pos_e = u.pm * 256 + ai * 128 + wr * 64 + m * 16 + fr;
                if (pos_e < u.cnt) {
                    float a[8];
#pragma unroll
                    for (int n = 0; n < 2; ++n)
#pragma unroll
                        for (int i = 0; i < 4; ++i) { const float g = acc[ai][0][m][n][i] * (1.f / GUSCALE), up = acc[ai][1][m][n][i] * (1.f / GUSCALE);
                            a[4 * n + i] = __builtin_amdgcn_fmed3f(g * __builtin_amdgcn_rcpf(1.0f + __builtin_amdgcn_exp2f(-1.4426950408889634f * g)) * up * ASCALE, -448.f, 448.f); }
                    int w0 = __builtin_amdgcn_cvt_pk_fp8_f32(a[0], a[1], 0, false); w0 = __builtin_amdgcn_cvt_pk_fp8_f32(a[2], a[3], w0, true);
                    int w1 = __builtin_amdgcn_cvt_pk_fp8_f32(a[4], a[5], 0, false); w1 = __builtin_amdgcn_cvt_pk_fp8_f32(a[6], a[7], w1, true);
                    gp::gst2(ACT + ((size_t)u.base + pos_e) * DE + u.pn * 128 + wc * 32 + fq * 8, (unsigned)w0, (unsigned)w1);
                }
            }
    }
};
constexpr float YSCALE = 16.f;
struct EpiDown {
    unsigned char* ws;
    __device__ __forceinline__ void operator()(const f32x4 (&acc)[2][2][4][2], const gp::Unit& u, int wr, int wc, int fr, int fq) const {
#pragma unroll
        for (int ai = 0; ai < 2; ++ai)
#pragma unroll
            for (int m = 0; m < 4; ++m) {
                const int pos = u.pm * 256 + ai * 128 + wr * 64 + m * 16 + fr;
                {
                    unsigned char* rowp = ws + (size_t)((pos < u.cnt) ? (u.base + pos) : (489 * 1024 + fr)) * D + u.pn * 256 + wc * 64 + fq * 16;
                    gp::u32x4 o;
#pragma unroll
                    for (int bj = 0; bj < 2; ++bj) { const f32x4 v0 = acc[ai][bj][m][0] * (YSCALE / (WDSCALE * ASCALE)), v1 = acc[ai][bj][m][1] * (YSCALE / (WDSCALE * ASCALE));
                        int w0 = __builtin_amdgcn_cvt_pk_fp8_f32(v0[0], v0[1], 0, false); w0 = __builtin_amdgcn_cvt_pk_fp8_f32(v0[2], v0[3], w0, true);
                        int w1 = __builtin_amdgcn_cvt_pk_fp8_f32(v1[0], v1[1], 0, false); w1 = __builtin_amdgcn_cvt_pk_fp8_f32(v1[2], v1[3], w1, true);
                        if (bj == 0) { o.x = (unsigned)w0; o.y = (unsigned)w1; } else { o.z = (unsigned)w0; o.w = (unsigned)w1; } }
                    gp::gst4(rowp, o);
                }
            }
    }
};
__device__ __forceinline__ void ph_moe_gu(const Params& p, unsigned char* smem) {
    unsigned char* ws = p.ws;
    int* tab = (int*)(smem + gp::STAGE_BYTES);
    build_moe(p, tab);
    MoeSched S; S.tab = (const GP_LAS int*)tab; S.G = gridDim.x; S.c = (gridDim.x % 8 == 0) ? (int)((blockIdx.x % 8) * (gridDim.x / 8) + blockIdx.x / 8) : (int)blockIdx.x;   S.ntn = 2; S.U = __builtin_amdgcn_readfirstlane(tab[T_GUP + 65]); S.down = 0; S.chunk = 0;
    S.TOKL = (const int*)(ws + WS_TOKL); S.Bt = (const char*)(ws + WS_WGUT);
    S.prepare(tab, p.chunk);
    EpiGU E{ws + WS_ACT, (const int*)(ws + WS_TOKL), (const float*)(ws + WS_TW), (const GP_LAS int*)tab};
    gp::gemm_phase<EpiGU, MoeSched, true, true>(p.chunk, (GP_LAS unsigned char*)smem, (const char*)(ws + WS_H2), D / 2, S, E);
}
__device__ __forceinline__ void ph_moe_down(const Params& p, unsigned char* smem, int c) {
    unsigned char* ws = p.ws;
    int* tab = (int*)(smem + gp::STAGE_BYTES);
    build_moe(p, tab);
    MoeSched S; S.tab = (const GP_LAS int*)tab; S.G = gridDim.x; S.c = (gridDim.x % 8 == 0) ? (int)((blockIdx.x % 8) * (gridDim.x / 8) + blockIdx.x / 8) : (int)blockIdx.x;   S.ntn = 4; S.U = __builtin_amdgcn_readfirstlane(tab[T_DUP + 65] + tab[T_DUP + 66 + 65] + tab[T_DUP + 132 + 65] + tab[T_DUP + 198 + 65]); S.down = 1; S.chunk = c;
    S.TOKL = nullptr; S.Bt = (const char*)(ws + WS_WDT);
    S.prepare(tab, p.chunk);
    EpiDown E{ws};
    gp::gemm_phase<EpiDown, MoeSched, false, true, 0>(p.chunk, (GP_LAS unsigned char*)smem, (const char*)(ws + WS_ACT), DE / 2, S, E);
}

__device__ __forceinline__ void ph_final(const Params& p, float* lds) {
    unsigned char* ws = p.ws;
    int* tab = (int*)lds;
    build_moe(p, tab);
    const int tid = otid(), wave = tid >> 6, lane = tid & 63;
    const int gw = blockIdx.x * NWV + wave, GW = gridDim.x * NWV;
    const int* TE = (const int*)(ws + WS_TE); const int* TP = (const int*)(ws + WS_TP); const float* TW = (const float*)(ws + WS_TW);
    const unsigned char* Y = ws;
    for (int m = gw; m < T; m += GW) {
        const int b = m >> 13, t = m & (SEQ - 1);
        const float* mod = (const float*)(ws + WS_MOD) + b * 6144 + 5 * 1024;
        float acc[16];
#pragma unroll
        for (int i = 0; i < 16; ++i) acc[i] = 0.f;
#pragma unroll
        for (int k = 0; k < 9; ++k) {
            int row; float wk = 1.f;
            if (k < 8) { const int e = TE[m * 8 + k]; row = tab[T_YB + 65 * b + e] + TP[m * 8 + k]; wk = TW[m * 8 + k]; }
            else row = tab[T_YB + 65 * b + 64] + t;
            row += yrow0(b);
            const unsigned char* yr = Y + (size_t)row * D;
#pragma unroll
            for (int j = 0; j < 4; ++j) { const int w = *(const int*)(yr + 4 * (lane + 64 * j));
                acc[4 * j] += wk * __builtin_amdgcn_cvt_f32_fp8(w, 0); acc[4 * j + 1] += wk * __builtin_amdgcn_cvt_f32_fp8(w, 1); acc[4 * j + 2] += wk * __builtin_amdgcn_cvt_f32_fp8(w, 2); acc[4 * j + 3] += wk * __builtin_amdgcn_cvt_f32_fp8(w, 3); }
        }
        float ss = 0.f;
#pragma unroll
        for (int i = 0; i < 16; ++i) { acc[i] *= (1.f / YSCALE); ss += acc[i] * acc[i]; }
        ss = wave_sum(ss);
        const float rs = 1.0f / sqrtf(ss * (1.0f / D) + EPS);
#pragma unroll
        for (int j = 0; j < 4; ++j) {
            const int col = 256 * j + 128 * ((lane >> 1) & 1) + 32 * (lane >> 4) + 8 * ((lane >> 2) & 3) + 4 * (lane & 1);
            const f32x4 gp = *(const f32x4*)(p.in[I_GFPOST] + col), gt = *(const f32x4*)(mod + col);
            f32x4 x1 = *(const f32x4*)(p.out + (size_t)m * D + col);
#pragma unroll
            for (int i = 0; i < 4; ++i) x1[i] += gt[i] * (acc[4 * j + i] * rs * gp[i]);
            *(f32x4*)(p.out + (size_t)m * D + col) = x1;
        }
    }
}

#define GAS __attribute__((address_space(1)))
#define LAS __attribute__((address_space(3)))
#define XB_TMO      128
#define XB_XCNT(j)  (256  + 64 * (j))
#define XB_XSUB(j)  (1280 + 64 * (j))
#define XB_XGEN(j)  (2304 + 64 * (j))
#define XB_TOP      3328
#define XB_TOPGEN   3392
#define XCD_BAR_WORDS 3456
#define XB_SPIN_CAP (1u << 21)
__device__ __forceinline__ unsigned xb_ld(unsigned* p)              { return __hip_atomic_load(p, __ATOMIC_RELAXED, __HIP_MEMORY_SCOPE_AGENT); }
__device__ __forceinline__ unsigned xb_add(unsigned* p, unsigned v) { return __hip_atomic_fetch_add(p, v, __ATOMIC_RELAXED, __HIP_MEMORY_SCOPE_AGENT); }
__device__ __forceinline__ unsigned xb_xcc_id() { return (unsigned)__builtin_amdgcn_s_getreg((3 << 11) | 20) & 0xFu; }
#define XB_SPIN(cond, bar) do { unsigned _sp = 0; while (cond) { __builtin_amdgcn_s_sleep(1); \
    if ((++_sp & 255u) == 0u) { if (xb_ld(&(bar)[XB_TMO])) break; if (_sp > XB_SPIN_CAP) { atomicAdd(&(bar)[XB_TMO], 1u); break; } } } } while (0)
struct XcdBarrier { unsigned* bar; unsigned x; volatile LAS unsigned* st; };
__device__ __forceinline__ XcdBarrier xcd_barrier_post(unsigned* bar, volatile LAS unsigned* st, int wv) {
    XcdBarrier b; b.bar = bar; b.x = xb_xcc_id(); b.st = st;
    if (wv == 0 && lane_id() == 0) (void)xb_add(&bar[XB_XCNT(b.x)], 1u);
    return b;
}
__device__ __forceinline__ void xcd_barrier_complete(unsigned* bar, unsigned x, unsigned& nloc, unsigned& nx) {
    const unsigned G = gridDim.x * gridDim.y * gridDim.z;
    unsigned sum, cnt, mine, sp = 0u;
    for (;;) {
        sum = 0u; cnt = 0u; mine = 0u;
#pragma unroll
        for (unsigned j = 0; j < 16; ++j) { const unsigned c = xb_ld(&bar[XB_XCNT(j)]); sum += c; cnt += (c > 0u) ? 1u : 0u; mine = (j == x) ? c : mine; }
        if (sum == G) break;
        __builtin_amdgcn_s_sleep(1);
        if ((++sp & 255u) == 0u) { if (xb_ld(&bar[XB_TMO])) break; if (sp > XB_SPIN_CAP) { atomicAdd(&bar[XB_TMO], 1u); break; } }
    }
    nloc = mine > 0u ? mine : 1u; nx = cnt > 0u ? cnt : 1u;
}
__device__ __forceinline__ void xcd_barrier(const XcdBarrier& b, int wv) {
    asm volatile("s_waitcnt vmcnt(0)" ::: "memory");
    __syncthreads();
    if (wv == 0 && lane_id() == 0) {
        unsigned* bar = b.bar;
        __builtin_amdgcn_s_waitcnt(0);
        unsigned nloc = b.st[0], nx = b.st[1];
        if (nloc == 0u) { xcd_barrier_complete(bar, b.x, nloc, nx); b.st[0] = nloc; b.st[1] = nx; }
        const unsigned old = xb_add(&bar[XB_XSUB(b.x)], 1u);
        const unsigned gen = old / nloc;
        if (old + 1u == (gen + 1u) * nloc) {
            __builtin_amdgcn_fence(__ATOMIC_RELEASE, "agent");
            asm volatile("s_waitcnt vmcnt(0)" ::: "memory");
            const unsigned og = xb_add(&bar[XB_TOP], 1u);
            const unsigned tg = og / nx;
            if (og + 1u == (tg + 1u) * nx) xb_add(&bar[XB_TOPGEN], 1u);
            else XB_SPIN(xb_ld(&bar[XB_TOPGEN]) == tg, bar);
            __builtin_amdgcn_fence(__ATOMIC_ACQUIRE, "agent");
            xb_add(&bar[XB_XGEN(b.x)], 1u);
            asm volatile("s_waitcnt vmcnt(0)" ::: "memory");
        } else {
            XB_SPIN(xb_ld(&bar[XB_XGEN(b.x)]) == gen, bar);
            __builtin_amdgcn_fence(__ATOMIC_ACQUIRE, "agent");
            asm volatile("s_waitcnt vmcnt(0)" ::: "memory");
        }
    }
    __syncthreads();
}

namespace cg = cooperative_groups;
constexpr int LDS_BYTES = 144 * 1024;
typedef const __attribute__((address_space(4))) Params* KP;
__device__ __forceinline__ Params kargs() {
    Params p;
#if defined(__HIP_DEVICE_COMPILE__)
    typedef const __attribute__((address_space(4))) unsigned long long* KQ;
    KQ kq = (KQ)__builtin_amdgcn_kernarg_segment_ptr(); asm volatile("" : "+s"(kq));
    unsigned long long* d = (unsigned long long*)&p;
#pragma unroll
    for (int i = 0; i < (int)(sizeof(Params) / 8); ++i) d[i] = kq[i];
#endif
    return p;
}
#define PH(call) do { Params p = kargs(); p.chunk = wv; call; } while (0)
__global__ void __launch_bounds__(NT) mega_fwd(Params p_unused) {
    extern __shared__ __attribute__((aligned(16))) unsigned char smem[];
    float* lds = (float*)smem;
    volatile LAS unsigned* misc = (volatile LAS unsigned*)((LAS unsigned char*)smem + (LDS_BYTES - 64));
    if (threadIdx.x < 16) misc[threadIdx.x] = 0u;
    __syncthreads();
    unsigned* barw; { const Params p = kargs(); barw = (unsigned*)(p.ws + WS_CTL) + 4096; }
    const int wv = __builtin_amdgcn_readfirstlane(threadIdx.x >> 6);
    const XcdBarrier bar = xcd_barrier_post(barw, misc, wv);
#define SYNC() xcd_barrier(bar, wv)
    PH(ph_prep(p, lds));            SYNC();
    PH(ph_norm1(p)); PH(ph_prep_weights(p, lds, 0, 0));   SYNC();
    PH(ph_inproj(p, smem)); PH(ph_prep_weights(p, lds, 1, (MTOT / 256) * (INW / 256) % (int)gridDim.x));         SYNC();
    PH(ph_attn(p, smem)); PH(ph_fourierA(p, smem));  SYNC();
    PH(ph_fourierB(p, smem));       SYNC();
    PH(ph_outproj(p, smem));        SYNC();
    PH(ph_mid(p, smem));            SYNC();
    PH(ph_moe_gu(p, smem));         SYNC();
#pragma unroll 1
    PH(ph_moe_down(p, smem, 0));    SYNC();
    PH(ph_final(p, lds));
#undef SYNC
}

extern "C" void kernel_launch(void* const* d_in, const int* in_sizes, int n_in, void* d_out, int out_size, void* d_ws, size_t ws_size, hipStream_t stream) {
    if (n_in != 26 || ws_size < WS_END) { fprintf(stderr, "kernel_launch: unexpected n_in %d / ws %zu\n", n_in, ws_size); return; }
    static int grid_blocks = 0;
    if (!grid_blocks) {
        int dev = 0, cus = 0, per_cu = 0;
        (void)hipGetDevice(&dev);
        (void)hipDeviceGetAttribute(&cus, hipDeviceAttributeMultiprocessorCount, dev);
        (void)hipFuncSetAttribute((const void*)mega_fwd, hipFuncAttributeMaxDynamicSharedMemorySize, LDS_BYTES);
        (void)hipOccupancyMaxActiveBlocksPerMultiprocessor(&per_cu, (const void*)mega_fwd, NT, LDS_BYTES);
        if (per_cu < 1) { fprintf(stderr, "kernel_launch: occupancy query says %d blocks/CU\n", per_cu); per_cu = 1; }
        if (per_cu > 1) per_cu = 1;
        grid_blocks = cus * per_cu;
    }
    Params p{};
    for (int i = 0; i < 26; ++i) p.in[i] = (const float*)d_in[i];
    p.out = (float*)d_out; p.ws = (unsigned char*)d_ws; p.chunk = 0; p.pad = 0;
    (void)hipMemsetAsync((char*)d_ws + WS_CTL, 0, 32768, stream);
    void* args[] = {&p};
    hipError_t e = hipLaunchCooperativeKernel((const void*)mega_fwd, dim3(grid_blocks), dim3(NT), args, LDS_BYTES, stream);
    if (e != hipSuccess) fprintf(stderr, "cooperative launch failed: %s (grid %d)\n", hipGetErrorString(e), grid_blocks);
}
```

```cpp
#include <hip/hip_runtime.h>
#include <hip/hip_cooperative_groups.h>
#include <cstdio>
#include <cstdint>

typedef unsigned short bf16_t;
typedef float f32x4 __attribute__((ext_vector_type(4)));

constexpr int D = 1024, BATCH = 4, SEQ = 8192, T = BATCH * SEQ, CTX = 256, TC = BATCH * CTX;
constexpr int MTOT = T + TC;
constexpr int KVLEN = CTX + SEQ;
constexpr int INW = 2560, NH = 6, QKW = 768, FW = 256;
constexpr int NE = 64, DE = 256, TOPK = 8;
constexpr int NT = 512, NWV = 8;
constexpr int SLOTS_B = 90112;
constexpr float EPS = 1e-6f;
constexpr float LAM_INIT = 0.2f;
constexpr float QSCALE = 0.125f * 1.4426950408889634f;
constexpr float SQS = 0.42466090014400953f;

constexpr size_t MiB = 1u << 20;
constexpr size_t WS_CTL = 0;
constexpr size_t WS_MOD = 1 * MiB;
constexpr size_t WS_TABW = WS_MOD + 128 * 1024;
constexpr size_t WS_ROPE = WS_MOD + 192 * 1024;
constexpr size_t WS_GCS = WS_MOD + 256 * 1024;
constexpr size_t WS_W128E = WS_MOD + 768 * 1024;
constexpr size_t WS_M64E = WS_MOD + 832 * 1024;
constexpr size_t WS_GT = WS_MOD + 864 * 1024;
constexpr size_t WS_WRT = WS_MOD + 512 * 1024;
constexpr size_t WS_WINT = 2 * MiB;
constexpr size_t WS_WOUTT = 7 * MiB;
constexpr size_t WS_WGUT = 9 * MiB;
constexpr size_t WS_WDT = 74 * MiB;
constexpr size_t WS_TE = 107 * MiB;
constexpr size_t WS_TP = 108 * MiB;
constexpr size_t WS_TW = 109 * MiB;
constexpr size_t WS_TOKL = 110 * MiB;
constexpr size_t WS_AO = 118 * MiB;
constexpr size_t WS_ACT = 118 * MiB;
constexpr size_t WS_Q = 182 * MiB;
constexpr size_t WS_K = 230 * MiB;
constexpr size_t WS_V = WS_K + (size_t)BATCH * KVLEN * QKW * 2;
constexpr size_t WS_F = 329 * MiB;
constexpr size_t WS_FY = 361 * MiB;
constexpr size_t WS_HX = 425 * MiB;
constexpr size_t WS_YX = 358 * MiB;
constexpr size_t WS_H2 = 294 * MiB;
constexpr size_t WS_Y = 294 * MiB;
constexpr size_t WS_END = 491 * MiB;

struct Params {
    const float* in[26];
    float* out;
    unsigned char* ws;
    int chunk;
    int pad;
};
enum { I_X = 0, I_C, I_CTX, I_CCTX, I_WMOD, I_BMOD, I_GAPRE, I_GAPOST, I_WIN, I_WF, I_LQ1, I_LK1, I_LQ2, I_LK2, I_GSUB, I_WOUT,
       I_GFPRE, I_GFPOST, I_WR, I_RB, I_WG, I_WU, I_WD, I_WSG, I_WSU, I_WSD };

__device__ __forceinline__ float bf2f(bf16_t v) { return __uint_as_float(((unsigned)v) << 16); }
__device__ __forceinline__ bf16_t f2bf(float f) { unsigned u = __float_as_uint(f); return (bf16_t)((u + 0x7fffu + ((u >> 16) & 1u)) >> 16); }
__device__ __forceinline__ unsigned pk2(float lo, float hi) { return (unsigned)f2bf(lo) | ((unsigned)f2bf(hi) << 16); }
template <int M> __device__ __forceinline__ float sx(float v) { return __int_as_float(__builtin_amdgcn_ds_swizzle(__float_as_int(v), (M << 10) | 0x1f)); }
template <int M> __device__ __forceinline__ int sxi(int v) { return __builtin_amdgcn_ds_swizzle(v, (M << 10) | 0x1f); }
__device__ __forceinline__ float wave_sum(float v) {
    v += sx<1>(v); v += sx<2>(v); v += sx<4>(v); v += sx<8>(v); v += sx<16>(v);
    auto rr = __builtin_amdgcn_permlane32_swap(__float_as_uint(v), __float_as_uint(v), false, false);
    return __uint_as_float(rr[0]) + __uint_as_float(rr[1]);
}
__device__ __forceinline__ float dpp_f(float v, const int ctrl_sel) {
    const int x = __float_as_int(v); int r;
    if (ctrl_sel == 0) r = __builtin_amdgcn_update_dpp(x, x, 0xB1, 0xf, 0xf, false);
    else if (ctrl_sel == 1) r = __builtin_amdgcn_update_dpp(x, x, 0x4E, 0xf, 0xf, false);
    else if (ctrl_sel == 2) r = __builtin_amdgcn_update_dpp(x, x, 0x141, 0xf, 0xf, false);
    else r = __builtin_amdgcn_update_dpp(x, x, 0x140, 0xf, 0xf, false);
    return __int_as_float(r);
}
__device__ __forceinline__ float wave_max(float v) {
    v = fmaxf(v, dpp_f(v, 0)); v = fmaxf(v, dpp_f(v, 1)); v = fmaxf(v, dpp_f(v, 2)); v = fmaxf(v, dpp_f(v, 3));
    const float a = __uint_as_float(__builtin_amdgcn_readlane(__float_as_uint(v), 0)), b = __uint_as_float(__builtin_amdgcn_readlane(__float_as_uint(v), 16));
    const float c = __uint_as_float(__builtin_amdgcn_readlane(__float_as_uint(v), 32)), d = __uint_as_float(__builtin_amdgcn_readlane(__float_as_uint(v), 48));
    return fmaxf(fmaxf(a, b), fmaxf(c, d));
}
__device__ __forceinline__ int lane_id() { int l; asm volatile("v_mbcnt_lo_u32_b32 %0, -1, 0\n\tv_mbcnt_hi_u32_b32 %0, -1, %0" : "=v"(l)); return l; }
__device__ __forceinline__ int otid_w(int wv) { return wv * 64 + lane_id(); }
#define otid() otid_w(p.chunk)
__device__ __forceinline__ float silu_f(float x) { return x / (1.f + expf(-x)); }

__device__ __forceinline__ void ph_prep(const Params& p, float* lds) {
    const int tid = otid(), bid = blockIdx.x, nblk = gridDim.x;
    const bool split = nblk >= 192;
    const int gt = split ? (bid - 96) * NT + tid : bid * NT + tid, GT = split ? (nblk - 96) * NT : nblk * NT;
    const int gidx = gt;
    unsigned char* ws = p.ws;
    if (gt >= 0) {
    float2* tabw = (float2*)(ws + WS_TABW);
    for (int i = gt; i < 8192; i += GT) { float s, c; sincospif((float)i * (1.0f / 4096.0f), &s, &c); tabw[i] = make_float2(c, s); }
    float* rope = (float*)(ws + WS_ROPE);
    for (int i = gt; i < 192 * 16; i += GT) {
        const int pos = (i < 2048) ? (i >> 4) : ((i - 2048) >> 4); const int f = i & 15;
        const float inv = powf(10000.0f, -(float)(2 * f) / 32.0f); const float ang = (float)pos * inv;
        const float c = cosf(ang), s = sinf(ang);
        if (i < 2048) { rope[i] = c; rope[2048 + i] = s; } else { rope[4096 + (i - 2048)] = c; rope[4096 + 1024 + (i - 2048)] = s; }
    }
    { bf16_t* gt = (bf16_t*)(ws + WS_GT); const float* wf = p.in[I_WF];
      for (int i = gidx; i < 4 * 64 * 128; i += GT) {
        const int g = i >> 13, d = (i >> 7) & 63, part = (i >> 6) & 1, c = i & 63;
        float a = 0.f;
        for (int j = 0; j < 64; ++j) { float s, co; sincospif((float)((c * j) & 63) * (1.0f / 32.0f), &s, &co); a += (part ? s : co) * wf[(g * 64 + j) * 64 + d]; }
        gt[i] = f2bf(a * 0.0013810679320049757f);
      }
      bf16_t* w128 = (bf16_t*)(ws + WS_W128E);
      for (int i = gidx; i < 256 * 128; i += GT) { const int kk = i >> 7, n1 = i & 127; float s, co; sincospif((float)(((kk & 127) * n1) & 127) * (1.0f / 64.0f), &s, &co); w128[i] = f2bf(kk < 128 ? co : -s); }
      bf16_t* m64 = (bf16_t*)(ws + WS_M64E);
      for (int i = gidx; i < 128 * 128; i += GT) { const int ro = i >> 7, ci = i & 127, po = ro >> 6, k2 = ro & 63, pi = ci >> 6, n2 = ci & 63;
        float s, co; sincospif((float)((k2 * n2) & 63) * (1.0f / 32.0f), &s, &co); m64[i] = f2bf(po == pi ? co : (po == 0 ? s : -s)); }
    }
    {
      bf16_t* wrt = (bf16_t*)(ws + WS_WRT); const float* wr = p.in[I_WR];
      for (int i = gt; i < 64 * 1024; i += GT) {
        const int j = i & 7, ln = (i >> 3) & 63, nb = (i >> 9) & 3, ks = (i >> 11) & 3, wv_ = i >> 13;
        const int e = 16 * nb + (ln & 15), k = wv_ * 128 + ks * 32 + 8 * (ln >> 4) + j;
        const float w = wr[k * 64 + e]; const bf16_t h = f2bf(w);
        const int o = ((((wv_ * 4 + ks) * 4 + nb) * 2) * 64 + ln) * 8 + j;
        wrt[o] = h; wrt[o + 512] = f2bf(w - bf2f(h)); } }
    if (gt == 0) {
        float s1 = 0.f, s2 = 0.f;
        for (int i = 0; i < 64; ++i) { s1 += p.in[I_LQ1][i] * p.in[I_LK1][i]; s2 += p.in[I_LQ2][i] * p.in[I_LK2][i]; }
        ((float*)(ws + WS_CTL))[1024] = expf(s1) - expf(s2) + LAM_INIT;
    }
    }
    float* sc = lds;
    float* red = lds + 5 * 1024;
    for (int i = tid; i < 5 * 1024; i += NT) { const int r = i >> 10, k = i & 1023; const float v = (r < 4) ? p.in[I_C][r * 1024 + k] : p.in[I_CCTX][k]; sc[i] = silu_f(v); }
    __syncthreads();
    const int wave = tid >> 6, lane = tid & 63;
    float* mod = (float*)(ws + WS_MOD);
    for (int task = bid; task < 96; task += nblk) {
        const int col = task * 64 + lane;
        float a0 = 0, a1 = 0, a2 = 0, a3 = 0, a4 = 0;
        const float* wm = p.in[I_WMOD];
#pragma unroll 32
        for (int k = wave * 128; k < wave * 128 + 128; ++k) { const float w = wm[(size_t)k * 6144 + col]; a0 += sc[k] * w; a1 += sc[1024 + k] * w; a2 += sc[2048 + k] * w; a3 += sc[3072 + k] * w; a4 += sc[4096 + k] * w; }
        red[(wave * 5 + 0) * 64 + lane] = a0; red[(wave * 5 + 1) * 64 + lane] = a1; red[(wave * 5 + 2) * 64 + lane] = a2; red[(wave * 5 + 3) * 64 + lane] = a3; red[(wave * 5 + 4) * 64 + lane] = a4;
        __syncthreads();
        if (tid < 320) { const int r = tid >> 6, l = tid & 63; float s = 0.f; for (int w = 0; w < 8; ++w) s += red[(w * 5 + r) * 64 + l]; mod[r * 6144 + task * 64 + l] = s + p.in[I_BMOD][task * 64 + l]; }
        __syncthreads();
    }
}

__device__ __forceinline__ void ph_norm1(const Params& p) {
    const int tid = otid(), wave = tid >> 6, lane = tid & 63;
    const int gw = blockIdx.x * NWV + wave, GW = gridDim.x * NWV;
    const float* mod = (const float*)(p.ws + WS_MOD);
    bf16_t* hx = (bf16_t*)(p.ws + WS_HX);
    const float* g = p.in[I_GAPRE];
    for (int m = gw; m < MTOT; m += GW) {
        const float* src = (m < T) ? p.in[I_X] + (size_t)m * D : p.in[I_CTX] + (size_t)(m - T) * D;
        const int r = (m < T) ? (m >> 13) : 4;
        const float* shift = mod + r * 6144; const float* scale = shift + 1024;
        f32x4 v[4]; float ss = 0.f;
#pragma unroll
        for (int j = 0; j < 4; ++j) { v[j] = ((const f32x4*)src)[lane + 64 * j]; ss += v[j][0] * v[j][0] + v[j][1] * v[j][1] + v[j][2] * v[j][2] + v[j][3] * v[j][3]; }
        ss = wave_sum(ss);
        const float rs = 1.0f / sqrtf(ss * (1.0f / D) + EPS);
#pragma unroll
        for (int j = 0; j < 4; ++j) {
            const int col = 4 * (lane + 64 * j);
            const f32x4 g4 = *(const f32x4*)(g + col), sc4 = *(const f32x4*)(scale + col), sh4 = *(const f32x4*)(shift + col);
            float h[4];
#pragma unroll
            for (int i = 0; i < 4; ++i) h[i] = v[j][i] * rs * g4[i] * (1.f + sc4[i]) + sh4[i];
            uint2 o; o.x = pk2(h[0], h[1]); o.y = pk2(h[2], h[3]);
            *(uint2*)(hx + (size_t)m * D + col) = o;
        }
    }
}

namespace gp {
#define GP_LAS __attribute__((address_space(3)))
typedef short bf16x8 __attribute__((ext_vector_type(8)));
typedef unsigned u32x4 __attribute__((ext_vector_type(4)));
typedef int i32x4 __attribute__((ext_vector_type(4)));
constexpr int BM = 256, BK = 64, HALF = 128, HTB = HALF * BK * 2, STAGE_BYTES = 8 * HTB;
__device__ __forceinline__ int lds_byte(int r, int c) { const int st = (r >> 4) * 2 + (c >> 5), rr = r & 15, cc = c & 31, ob = rr * 64 + cc * 2; return st * 1024 + (ob ^ (((ob >> 9) & 1) << 5)); }
__device__ __forceinline__ void stage_rc(int b, int& R, int& C) { const int st = b / 1024, sb = b % 1024, swz = sb ^ (((sb >> 9) & 1) << 5); R = (st >> 1) * 16 + swz / 64; C = (st & 1) * 32 + (swz % 64) / 2; }
__device__ __forceinline__ int perm32(int rho) { const int n = rho >> 4, i = rho & 15; return 8 * (i >> 2) + 4 * n + (i & 3); }
struct Unit { int pm, pn, e, b, cnt, base; };
typedef unsigned u32x2 __attribute__((ext_vector_type(2)));
typedef float f32x4g __attribute__((ext_vector_type(4)));
#define GP_G1(T, ptr) ((__attribute__((address_space(1))) T*)(ptr))
__device__ __forceinline__ void gst4(void* p, u32x4 v) { *GP_G1(u32x4, p) = v; }
__device__ __forceinline__ void gst4_nt(void* p, u32x4 v) { __builtin_nontemporal_store(v, GP_G1(u32x4, p)); }
__device__ __forceinline__ void gst2(void* p, unsigned a, unsigned b) { *GP_G1(u32x2, p) = (u32x2){a, b}; }
__device__ __forceinline__ void gst1(void* p, unsigned a) { *GP_G1(unsigned, p) = a; }
__device__ __forceinline__ f32x4g gld4f(const void* p) { return *GP_G1(const f32x4g, p); }
__device__ __forceinline__ unsigned cvt_pk_bf16(float lo, float hi) { unsigned r; asm volatile("v_cvt_pk_bf16_f32 %0, %1, %2" : "=v"(r) : "v"(lo), "v"(hi)); return r; }

template <class Epi, class Sched, bool ALIGN_EPI, bool F8 = false, int EST = 0>
__device__ __forceinline__ void gemm_phase(const int wv, GP_LAS unsigned char* lds, const char* Abase, const int K, const Sched& S, const Epi& E) {
    const int wid = wv, wr = wid >> 2, wc = wid & 3;
    const int nt = K / BK;
    unsigned voffB[2];
#pragma unroll
    for (int i = 0; i < 2; ++i) { int R, C; stage_rc(otid_w(wv) * 16 + i * 8192, R, C); const int Rb = (R & ~31) + perm32(R & 31); voffB[i] = (unsigned)(Rb * K + C) * 2u; }
#define GP_AOFFS(u, o00, o01, o10, o11) do { int R0, C0, R1, C1; const int t_ = otid_w(wv); stage_rc(t_ * 16, R0, C0); stage_rc(t_ * 16 + 8192, R1, C1); \
        o00 = S.arow(u, R0) + (unsigned)C0 * 2u; o01 = S.arow(u, R1) + (unsigned)C1 * 2u; o10 = S.arow(u, HALF + R0) + (unsigned)C0 * 2u; o11 = S.arow(u, HALF + R1) + (unsigned)C1 * 2u; } while (0)
    const size_t kstep = (size_t)(BK * 2);
    const size_t hstep = (size_t)HALF * K * 2;
    const unsigned ldsw = (unsigned)wid * 1024u;
    int aoff, boff; { const int l_ = lane_id(), fr = l_ & 15, fq = l_ >> 4; aoff = lds_byte(wr * 64 + fr, fq * 8); boff = lds_byte(wc * 32 + fr, fq * 8); }
#define GP_SA(b, h) (((b) * 2 + (h)) * HTB)
#define GP_SB(b, h) ((4 + (b) * 2 + (h)) * HTB)
#define GP_STAGE_B(bufoff, gbase) do { _Pragma("unroll") for (int _i = 0; _i < 2; ++_i) \
        __builtin_amdgcn_global_load_lds((const unsigned*)((const char*)(gbase) + voffB[_i]), (GP_LAS unsigned*)(lds + (bufoff) + ldsw + _i * 8192), 16, 0, 0); } while (0)
#define GP_STAGE_A(bufoff, gbase, o0, o1) do { \
        __builtin_amdgcn_global_load_lds((const unsigned*)((const char*)(gbase) + (o0)), (GP_LAS unsigned*)(lds + (bufoff) + ldsw), 16, 0, 0); \
        __builtin_amdgcn_global_load_lds((const unsigned*)((const char*)(gbase) + (o1)), (GP_LAS unsigned*)(lds + (bufoff) + ldsw + 8192), 16, 0, 0); } while (0)
#define GP_LDA(dst, b, h) do { _Pragma("unroll") for (int m = 0; m < 4; ++m) _Pragma("unroll") for (int k = 0; k < 2; ++k) dst[m][k] = *(const GP_LAS bf16x8*)(lds + GP_SA(b, h) + aoff + m * 2048 + k * 1024); } while (0)
#define GP_LDB(dst, b, h) do { _Pragma("unroll") for (int n = 0; n < 2; ++n) _Pragma("unroll") for (int k = 0; k < 2; ++k) dst[n][k] = *(const GP_LAS bf16x8*)(lds + GP_SB(b, h) + boff + n * 2048 + k * 1024); } while (0)
#define GP_CAT8(x) __builtin_shufflevector(__builtin_bit_cast(i32x4, x[0]), __builtin_bit_cast(i32x4, x[1]), 0, 1, 2, 3, 4, 5, 6, 7)
#define GP_MMA(ai, bj, At, Bt) do { __builtin_amdgcn_s_setprio(1); _Pragma("unroll") for (int m = 0; m < 4; ++m) _Pragma("unroll") for (int n = 0; n < 2; ++n) { \
        if constexpr (F8) acc[ai][bj][m][n] = __builtin_amdgcn_mfma_scale_f32_16x16x128_f8f6f4(GP_CAT8(Bt[n]), GP_CAT8(At[m]), acc[ai][bj][m][n], 0, 0, 0, 0, 0, 0); \
        else { _Pragma("unroll") for (int k = 0; k < 2; ++k) acc[ai][bj][m][n] = __builtin_amdgcn_mfma_f32_16x16x32_bf16(Bt[n][k], At[m][k], acc[ai][bj][m][n], 0, 0, 0); } } \
        __builtin_amdgcn_s_setprio(0); } while (0)
#define GP_WAIT_V(n) asm volatile("s_waitcnt vmcnt(" #n ")" ::: "memory")
#define GP_WAIT_L(n) asm volatile("s_waitcnt lgkmcnt(" #n ")" ::: "memory")
#define GP_BAR __builtin_amdgcn_s_barrier()
#define GP_SCHED __builtin_amdgcn_sched_barrier(0)
    Unit cur, nxt; int ui = 0;
    if (!S.next(0, cur)) return;
    f32x4 acc[2][2][4][2];
#pragma unroll
    for (int a = 0; a < 2; ++a)
#pragma unroll
        for (int b = 0; b < 2; ++b)
#pragma unroll
            for (int m = 0; m < 4; ++m)
#pragma unroll
                for (int n = 0; n < 2; ++n) acc[a][b][m][n] = (f32x4){0.f, 0.f, 0.f, 0.f};
    bf16x8 At[4][2], B0[2][2], B1[2][2];
    unsigned ac00, ac01, ac10, ac11, an00, an01, an10, an11;
    GP_AOFFS(cur, ac00, ac01, ac10, ac11);
    const char* cB = S.bptr(cur);
    GP_STAGE_B(GP_SB(0, 0), cB); GP_STAGE_B(GP_SB(0, 1), cB + hstep); GP_STAGE_A(GP_SA(0, 0), Abase, ac00, ac01); GP_STAGE_A(GP_SA(0, 1), Abase, ac10, ac11);
    if (wr == 1) GP_BAR;
    GP_WAIT_V(2); GP_BAR;
    GP_STAGE_B(GP_SB(1, 0), cB + kstep); GP_STAGE_A(GP_SA(1, 0), Abase + kstep, ac00, ac01); GP_STAGE_B(GP_SB(1, 1), cB + hstep + kstep);
    GP_WAIT_V(6); GP_BAR;
    for (;;) {
        const bool has_next = S.next(ui + 1, nxt);
        if (has_next) { GP_AOFFS(nxt, an00, an01, an10, an11); }
        else { an00 = ac00; an01 = ac01; an10 = ac10; an11 = ac11; }
        const char* nB = has_next ? S.bptr(nxt) : cB;
#pragma unroll 1
        for (int t = 0; t < nt; t += 2) {
            const bool last = (t == nt - 2);
            const char* a1 = Abase + (size_t)(t + 1) * kstep;
            const char* a2 = last ? Abase : Abase + (size_t)(t + 2) * kstep; const char* b2 = last ? nB : cB + (size_t)(t + 2) * kstep;
            const char* a3 = a2 + kstep; const char* b3 = b2 + kstep;
            asm volatile("" : "+s"(a1), "+s"(a2), "+s"(b2), "+s"(a3), "+s"(b3));
            GP_LDB(B0, 0, 0); GP_LDB(B1, 0, 1); GP_SCHED; GP_LDA(At, 0, 0); GP_STAGE_A(GP_SA(1, 1), a1, ac10, ac11);
            if (last) { ac00 = an00; ac01 = an01; ac10 = an10; ac11 = an11; }
            const bool relax = EST > 0 && ui > 0 && t == 0;
            if (relax) { static_assert(EST == 0 || EST == 16, "add a wait variant"); asm volatile("s_waitcnt vmcnt(24)" ::: "memory"); } else GP_WAIT_V(8);
            GP_WAIT_L(0); GP_BAR; GP_MMA(0, 0, At, B0); GP_MMA(0, 1, At, B1); GP_BAR; GP_SCHED;
            GP_LDA(At, 0, 1); GP_STAGE_B(GP_SB(0, 0), b2); GP_STAGE_B(GP_SB(0, 1), b2 + hstep); GP_STAGE_A(GP_SA(0, 0), a2, ac00, ac01);
            if (relax) asm volatile("s_waitcnt vmcnt(24)" ::: "memory"); else GP_WAIT_V(8);
            GP_WAIT_L(0); GP_BAR; GP_MMA(1, 0, At, B0); GP_MMA(1, 1, At, B1); GP_BAR; GP_SCHED;
            GP_LDB(B0, 1, 0); GP_LDB(B1, 1, 1); GP_SCHED; GP_LDA(At, 1, 0); GP_STAGE_A(GP_SA(0, 1), a2, ac10, ac11);
            GP_WAIT_V(8); GP_WAIT_L(0); GP_BAR; GP_MMA(0, 0, At, B0); GP_MMA(0, 1, At, B1); GP_BAR; GP_SCHED;
            GP_LDA(At, 1, 1); GP_STAGE_B(GP_SB(1, 0), b3); GP_STAGE_B(GP_SB(1, 1), b3 + hstep); GP_STAGE_A(GP_SA(1, 0), a3, ac00, ac01);
            GP_WAIT_V(8); GP_WAIT_L(0); GP_BAR; GP_MMA(1, 0, At, B0); GP_MMA(1, 1, At, B1); GP_BAR; GP_SCHED;
        }
        if constexpr (ALIGN_EPI) { if (wr == 0) GP_BAR; }
        { const int l_ = lane_id(); E(acc, cur, wr, wc, l_ & 15, l_ >> 4); }
        if (!has_next) break;
#pragma unroll
        for (int a = 0; a < 2; ++a)
#pragma unroll
            for (int b = 0; b < 2; ++b)
#pragma unroll
                for (int m = 0; m < 4; ++m)
#pragma unroll
                    for (int n = 0; n < 2; ++n) acc[a][b][m][n] = (f32x4){0.f, 0.f, 0.f, 0.f};
        cur = nxt; cB = nB; ++ui;
        if constexpr (ALIGN_EPI) { if (wr == 1) GP_BAR; }
    }
    GP_WAIT_V(0);
    if constexpr (!ALIGN_EPI) { if (wr == 0) GP_BAR; }
    GP_BAR;
#undef GP_AOFFS
#undef GP_SA
#undef GP_SB
#undef GP_STAGE_A
#undef GP_STAGE_B
#undef GP_LDA
#undef GP_LDB
#undef GP_MMA
#undef GP_CAT8
#undef GP_WAIT_V
#undef GP_WAIT_L
#undef GP_BAR
#undef GP_SCHED
}

struct DenseSched {
    int nM, nN, nwg, G, c, K; const char* Bt;
    __device__ __forceinline__ void init(int M, int N, int K_, const void* Bt_, int G_, int c_) { nM = M / BM; nN = N / BM; nwg = nM * nN; G = G_; c = c_; K = K_; Bt = (const char*)Bt_; }
    __device__ __forceinline__ bool next(int i, Unit& u) const {
        const long L = (long)i * G + c; if (L >= nwg) return false;
        int wgid = (int)L; { const int q = nwg / 8, r = nwg % 8, xcd = wgid % 8, off = wgid / 8; wgid = (xcd < r ? xcd * (q + 1) : r * (q + 1) + (xcd - r) * q) + off; }
        const int nig = 8 * nN, gid = wgid / nig, fm = gid * 8, gsz = (nM - fm) < 8 ? (nM - fm) : 8;
        u.pm = fm + ((wgid % nig) % gsz); u.pn = (wgid % nig) / gsz; u.e = 0; u.b = 0; u.cnt = 0; u.base = 0; return true;
    }
    __device__ __forceinline__ unsigned arow(const Unit& u, int r) const { return (unsigned)(u.pm * BM + r) * (unsigned)(K * 2); }
    __device__ __forceinline__ const char* bptr(const Unit& u) const { return Bt + (size_t)u.pn * BM * K * 2; }
};
}

struct EpiInProj {
    bf16_t* F; bf16_t* Q; bf16_t* Kb; bf16_t* Vb; const float* rope;
    __device__ __forceinline__ void operator()(const f32x4 (&acc)[2][2][4][2], const gp::Unit& u, int wr, int wc, int fr, int fq) const {
        const int pn = u.pn, pm = u.pm; const bool isctx = pm >= T / 256;
        if (isctx && pn < 4) return;
        if (pn >= 7) {
            unsigned char* V8 = (unsigned char*)Vb;
#pragma unroll
            for (int ai = 0; ai < 2; ++ai) {
                const int row0 = pm * 256 + ai * 128 + wr * 64;
                int b, tile;
                if (!isctx) { b = row0 >> 13; tile = (CTX >> 6) + ((row0 & 8191) >> 6); } else { const int j = row0 - T; b = j >> 8; tile = (j & 255) >> 6; }
#pragma unroll
                for (int bj = 0; bj < 2; ++bj) {
                    const int head = (pn - 7) * 2 + bj;
                    unsigned char* dst = V8 + ((size_t)(b * NH + head) * (KVLEN / 64) + tile) * 8192 + wc * 2048 + fq * 64 + (fr >> 3) * 32 + (fr & 1) * 16 + ((fr >> 1) & 3) * 4;
#pragma unroll
                    for (int e = 0; e < 8; ++e) {
                        int w = __builtin_amdgcn_cvt_pk_fp8_f32(acc[ai][bj][0][e >> 2][e & 3], acc[ai][bj][1][e >> 2][e & 3], 0, false);
                        w = __builtin_amdgcn_cvt_pk_fp8_f32(acc[ai][bj][2][e >> 2][e & 3], acc[ai][bj][3][e >> 2][e & 3], w, true);
                        gp::gst1(dst + e * 256, (unsigned)w);
                    }
                }
            }
            return;
        }
        const int axis = wc & 1; const float* ct = rope + (axis ? 4096 : 0); const float* st = rope + (axis ? 4096 + 1024 : 2048);
#pragma unroll
        for (int ai = 0; ai < 2; ++ai)
#pragma unroll
            for (int m = 0; m < 4; ++m) {
                const int row = pm * 256 + ai * 128 + wr * 64 + m * 16 + fr;
                int t, kb, tile;
                if (!isctx) { kb = row >> 13; t = row & 8191; tile = (CTX >> 6) + (t >> 6); } else { const int j = row - T; t = 0; kb = j >> 8; tile = (j & 255) >> 6; }
                const int pos = axis ? (t & 63) : (t >> 6);
#pragma unroll
                for (int bj = 0; bj < 2; ++bj) {
                    const int col0 = pn * 256 + bj * 128 + wc * 32 + fq * 8;
                    f32x4 v0 = acc[ai][bj][m][0], v1 = acc[ai][bj][m][1];
                    if (pn == 0) { gp::u32x4 w; w.x = gp::cvt_pk_bf16(v0[0], v0[1]); w.y = gp::cvt_pk_bf16(v0[2], v0[3]); w.z = gp::cvt_pk_bf16(v1[0], v1[1]); w.w = gp::cvt_pk_bf16(v1[2], v1[3]);
                        gp::gst4(F + (size_t)row * 256 + col0, w); continue; }
                    if (pn < 7 && !isctx) {
                        const f32x4 c0 = gp::gld4f(ct + pos * 16 + 8 * (fq & 1)), c1 = gp::gld4f(ct + pos * 16 + 8 * (fq & 1) + 4);
                        const f32x4 s0 = gp::gld4f(st + pos * 16 + 8 * (fq & 1)), s1 = gp::gld4f(st + pos * 16 + 8 * (fq & 1) + 4);
                        const float sg = (fq < 2) ? -1.f : 1.f;
#pragma unroll
                        for (int i = 0; i < 4; ++i) {
                            const auto r0 = __builtin_amdgcn_permlane32_swap(__float_as_uint(v0[i]), __float_as_uint(v0[i]), false, false);
                            const auto r1 = __builtin_amdgcn_permlane32_swap(__float_as_uint(v1[i]), __float_as_uint(v1[i]), false, false);
                            const float p0 = __uint_as_float(fq < 2 ? r0[1] : r0[0]), p1 = __uint_as_float(fq < 2 ? r1[1] : r1[0]);
                            v0[i] = v0[i] * c0[i] + sg * p0 * s0[i]; v1[i] = v1[i] * c1[i] + sg * p1 * s1[i]; }
                    }
                    v0 = v0 * SQS; v1 = v1 * SQS;
                    int w0 = __builtin_amdgcn_cvt_pk_fp8_f32(v0[0], v0[1], 0, false); w0 = __builtin_amdgcn_cvt_pk_fp8_f32(v0[2], v0[3], w0, true);
                    int w1 = __builtin_amdgcn_cvt_pk_fp8_f32(v1[0], v1[1], 0, false); w1 = __builtin_amdgcn_cvt_pk_fp8_f32(v1[2], v1[3], w1, true);
                    unsigned char* d;
                    if (pn < 4) d = (unsigned char*)Q + (size_t)row * QKW + (col0 - 256);
                    else d = (unsigned char*)Kb + ((size_t)(kb * NH + (pn - 4) * 2 + bj) * (KVLEN / 64) + tile) * 8192 + wc * 2048 + m * 512 + fr * 32 + fq * 8;
                    gp::gst2(d, (unsigned)w0, (unsigned)w1);
                }
            }
    }
};
struct EpiStoreBf16 {
    bf16_t* O; int ldc;
    __device__ __forceinline__ void operator()(const f32x4 (&acc)[2][2][4][2], const gp::Unit& u, int wr, int wc, int fr, int fq) const {
#pragma unroll
        for (int ai = 0; ai < 2; ++ai)
#pragma unroll
            for (int m = 0; m < 4; ++m) {
                bf16_t* rowp = O + (size_t)(u.pm * 256 + ai * 128 + wr * 64 + m * 16 + fr) * ldc + u.pn * 256 + wc * 32 + fq * 8;
#pragma unroll
                for (int bj = 0; bj < 2; ++bj) { const f32x4 v0 = acc[ai][bj][m][0], v1 = acc[ai][bj][m][1];
                    gp::u32x4 w; w.x = gp::cvt_pk_bf16(v0[0], v0[1]); w.y = gp::cvt_pk_bf16(v0[2], v0[3]); w.z = gp::cvt_pk_bf16(v1[0], v1[1]); w.w = gp::cvt_pk_bf16(v1[2], v1[3]);
                    gp::gst4(rowp + bj * 128, w); }
            }
    }
};

__device__ __forceinline__ void ph_inproj(const Params& p, unsigned char* smem) {
    unsigned char* ws = p.ws;
    gp::DenseSched S; S.init(MTOT, INW, D, ws + WS_WINT, gridDim.x, blockIdx.x);
    EpiInProj E{(bf16_t*)(ws + WS_F), (bf16_t*)(ws + WS_Q), (bf16_t*)(ws + WS_K), (bf16_t*)(ws + WS_V), (const float*)(ws + WS_ROPE)};
    gp::gemm_phase<EpiInProj, gp::DenseSched, true>(p.chunk, (GP_LAS unsigned char*)smem, (const char*)(ws + WS_HX), D, S, E);
}
__device__ __forceinline__ void ph_outproj(const Params& p, unsigned char* smem) {
    unsigned char* ws = p.ws;
    gp::DenseSched S; S.init(T, D, D, ws + WS_WOUTT, gridDim.x, blockIdx.x);
    EpiStoreBf16 E{(bf16_t*)(ws + WS_YX), D};
    gp::gemm_phase<EpiStoreBf16, gp::DenseSched, true>(p.chunk, (GP_LAS unsigned char*)smem, (const char*)(ws + WS_AO), D, S, E);
}

constexpr float GUSCALE = 64.f;
constexpr float WDSCALE = 16.f, ASCALE = 4.f;
struct TItem8 { const float* W; unsigned char* WT; int K, N, row_base, k0, n0; float sc; };
__device__ __forceinline__ void titem8_load(const TItem8& t, float (&tv)[32], int lane) {
#pragma unroll
    for (int i = 0; i < 32; ++i) tv[i] = t.W[(size_t)(t.k0 + 2 * i + (lane >> 5)) * t.N + t.n0 + (lane & 31)];
}
__device__ __forceinline__ void titem8_finish(const TItem8& t, const float (&tv)[32], float* scr, int lane) {
#pragma unroll
    for (int i = 0; i < 32; ++i) scr[(2 * i + (lane >> 5)) * 33 + (lane & 31)] = tv[i] * t.sc;
    asm volatile("s_waitcnt lgkmcnt(0)" ::: "memory");
    const int c = lane & 7;
#pragma unroll
    for (int j = 0; j < 4; ++j) { const int n = (lane >> 3) + 8 * j; const float* s = scr + (8 * c) * 33 + n;
        int w0 = __builtin_amdgcn_cvt_pk_fp8_f32(s[0 * 33], s[1 * 33], 0, false); w0 = __builtin_amdgcn_cvt_pk_fp8_f32(s[2 * 33], s[3 * 33], w0, true);
        int w1 = __builtin_amdgcn_cvt_pk_fp8_f32(s[4 * 33], s[5 * 33], 0, false); w1 = __builtin_amdgcn_cvt_pk_fp8_f32(s[6 * 33], s[7 * 33], w1, true);
        uint2 o; o.x = (unsigned)w0; o.y = (unsigned)w1;
        *(uint2*)(t.WT + (size_t)(t.row_base + t.n0 + n) * t.K + t.k0 + 8 * c) = o; }
    asm volatile("s_waitcnt lgkmcnt(0)" ::: "memory");
}
__device__ __forceinline__ void transpose_item(const float* W, int K, int N, bf16_t* WT, int row_base, int kb, int nb, float* scr, int lane) {
    const int k0 = 64 * kb, n0 = 32 * nb;
    float tv[32];
#pragma unroll
    for (int i = 0; i < 32; ++i) tv[i] = W[(size_t)(k0 + 2 * i + (lane >> 5)) * N + n0 + (lane & 31)];
#pragma unroll
    for (int i = 0; i < 32; ++i) scr[(2 * i + (lane >> 5)) * 33 + (lane & 31)] = tv[i];
    asm volatile("s_waitcnt lgkmcnt(0)" ::: "memory");
    const int c = lane & 7;
#pragma unroll
    for (int j = 0; j < 4; ++j) { const int n = (lane >> 3) + 8 * j; const float* s = scr + (8 * c) * 33 + n;
        uint4 o; o.x = pk2(s[0 * 33], s[1 * 33]); o.y = pk2(s[2 * 33], s[3 * 33]); o.z = pk2(s[4 * 33], s[5 * 33]); o.w = pk2(s[6 * 33], s[7 * 33]);
        *(uint4*)(WT + (size_t)(row_base + n0 + n) * K + k0 + 8 * c) = o; }
    asm volatile("s_waitcnt lgkmcnt(0)" ::: "memory");
}
__device__ __forceinline__ void ph_prep_weights(const Params& p, float* lds, const int part, const int first) {
    const int tid = otid(), wave = tid >> 6, lane = tid & 63;
    float* scr = lds + 8192 + wave * (64 * 33);
    if ((int)blockIdx.x < first) return;
    const int gw = ((int)blockIdx.x - first) * NWV + wave, GW = ((int)gridDim.x - first) * NWV;
    unsigned char* ws = p.ws;
    constexpr int I_IN = 16 * 80, I_OUT = 16 * 32, I_GU = 16 * 8, I_D = 4 * 32;
    constexpr int NITEMS = I_IN + I_OUT + 65 * (2 * I_GU + I_D);
    const int it_lo = part ? I_IN + I_OUT : 0, it_hi = part ? NITEMS : I_IN + I_OUT;
    if (part == 0) {
        for (int it = it_lo + gw; it < it_hi; it += GW) {
            int r = it;
            if (r < I_IN) { transpose_item(p.in[I_WIN], D, INW, (bf16_t*)(ws + WS_WINT), 0, r / 80, r % 80, scr, lane); continue; } r -= I_IN;
            transpose_item(p.in[I_WOUT], D, D, (bf16_t*)(ws + WS_WOUTT), 0, r / 32, r % 32, scr, lane);
        }
        return;
    }
    auto decode = [&](int it, TItem8& t) {
        int r = it - (I_IN + I_OUT);
        const int e = r / (2 * I_GU + I_D); r -= e * (2 * I_GU + I_D);
        if (r < 2 * I_GU) {
            const int half = r / I_GU, q = r % I_GU, kb = q / 8, nb = q % 8;
            t.W = (e < 64) ? p.in[half ? I_WU : I_WG] + (size_t)e * D * DE : p.in[half ? I_WSU : I_WSG];
            const int n0 = 32 * nb, drow = e * 512 + (n0 >> 7) * 256 + half * 128 + (n0 & 127);
            t.WT = ws + WS_WGUT; t.K = D; t.N = DE; t.row_base = drow - n0; t.k0 = 64 * kb; t.n0 = n0; t.sc = GUSCALE;
        } else {
            r -= 2 * I_GU;
            t.W = (e < 64) ? p.in[I_WD] + (size_t)e * DE * D : p.in[I_WSD];
            t.WT = ws + WS_WDT; t.K = DE; t.N = D; t.row_base = e * 1024; t.k0 = 64 * (r / 32); t.n0 = 32 * (r % 32); t.sc = WDSCALE;
        }
    };
    int it = it_lo + gw;
    if (it >= it_hi) return;
    TItem8 ta, tb; float va[32], vb[32];
    decode(it, ta); titem8_load(ta, va, lane);
    for (;;) {
        const bool hb = it + GW < it_hi;
        if (hb) { decode(it + GW, tb); titem8_load(tb, vb, lane); }
        titem8_finish(ta, va, scr, lane);
        if (!hb) break;
        const bool ha = it + 2 * GW < it_hi;
        if (ha) { decode(it + 2 * GW, ta); titem8_load(ta, va, lane); }
        titem8_finish(tb, vb, scr, lane);
        if (!ha) break;
        it += 2 * GW;
    }
}

namespace fa {
typedef short bf16x8 __attribute__((ext_vector_type(8)));
typedef short s16x4 __attribute__((ext_vector_type(4)));
typedef float f32x16 __attribute__((ext_vector_type(16)));
typedef unsigned u32x4 __attribute__((ext_vector_type(4)));
constexpr int KVBLK = 64, LDK = QKW;
constexpr float SCALE = 0.125f, THR = 8.f;
constexpr size_t SHM_V = KVBLK * 128 * 2, SHM_K = KVBLK * 128 * 2;
#define KSWZ(row, colB) ((row) * 256 + ((colB) ^ (((row) & 15) << 4)))
#define SBAR() __builtin_amdgcn_sched_barrier(0)
__device__ __forceinline__ int crow(int r, int hi) { return (r & 3) + 8 * (r >> 2) + 4 * hi; }
__device__ __forceinline__ unsigned cvtpk(float lo, float hi) { unsigned r; asm volatile("v_cvt_pk_bf16_f32 %0, %1, %2" : "=v"(r) : "v"(lo), "v"(hi)); return r; }
constexpr float PBIAS = 5.f, THR2 = PBIAS + 3.5f;
template <bool FIRST>
__device__ __forceinline__ void partialSM(f32x16& p0, f32x16& p1, float& m_reg, f32x16& negm, float& alpha) {
  float pmax = p0[0];
#pragma unroll
  for (int r = 1; r < 16; ++r) pmax = fmaxf(pmax, p0[r]);
#pragma unroll
  for (int r = 0; r < 16; ++r) pmax = fmaxf(pmax, p1[r]);
  { auto rr = __builtin_amdgcn_permlane32_swap(__float_as_uint(pmax), __float_as_uint(pmax), false, false);
    pmax = fmaxf(__uint_as_float(rr[0]), __uint_as_float(rr[1])); }
  if (!FIRST && __builtin_expect(__all(pmax <= THR2), 1)) { alpha = 1.f; }
  else { const float dl = FIRST ? pmax - PBIAS : fmaxf(pmax - PBIAS, 0.f); alpha = FIRST ? 0.f : __builtin_amdgcn_exp2f(-dl); m_reg += dl;
#pragma unroll
    for (int r = 0; r < 16; ++r) { p0[r] -= dl; p1[r] -= dl; }
#pragma unroll
    for (int r = 0; r < 16; ++r) negm[r] = -m_reg;
    asm volatile("" : "+v"(negm)); }
#pragma unroll
  for (int r = 0; r < 16; ++r) p0[r] = __builtin_amdgcn_exp2f(p0[r]);
}
typedef int i32x8 __attribute__((ext_vector_type(8)));
__device__ __forceinline__ int pk4_fp8(float a, float b, float c, float d) { int w; asm("v_cvt_pk_fp8_f32 %0, %1, %2" : "=v"(w) : "v"(a), "v"(b)); asm("v_cvt_pk_fp8_f32 %0, %1, %2 op_sel:[0,0,1]" : "+v"(w) : "v"(c), "v"(d)); return w; }
__device__ __forceinline__ void finishSM_T(f32x16& p0, f32x16& p1, i32x8& pb) {
#pragma unroll
  for (int r = 0; r < 16; ++r) p1[r] = __builtin_amdgcn_exp2f(p1[r]);
#pragma unroll
  for (int g = 0; g < 4; ++g) {
    pb[g] = pk4_fp8(p0[4 * g], p0[4 * g + 1], p0[4 * g + 2], p0[4 * g + 3]); pb[4 + g] = pk4_fp8(p1[4 * g], p1[4 * g + 1], p1[4 * g + 2], p1[4 * g + 3]); }
}
__device__ __forceinline__ void qkt(f32x16& p0, f32x16& p1, const char* Ks, const i32x8 qf, int lane, int mm, const f32x16& negm) {
  const char* kp = Ks + mm * 4096 + lane * 16;
  const u32x4 a0 = *reinterpret_cast<const u32x4*>(kp), a1 = *reinterpret_cast<const u32x4*>(kp + 1024), b0 = *reinterpret_cast<const u32x4*>(kp + 2048), b1 = *reinterpret_cast<const u32x4*>(kp + 3072);
  p0 = __builtin_amdgcn_mfma_scale_f32_32x32x64_f8f6f4((i32x8){(int)a0.x, (int)a0.y, (int)a0.z, (int)a0.w, (int)a1.x, (int)a1.y, (int)a1.z, (int)a1.w}, qf, negm, 0, 0, 0, 0, 0, 0);
  p1 = __builtin_amdgcn_mfma_scale_f32_32x32x64_f8f6f4((i32x8){(int)b0.x, (int)b0.y, (int)b0.z, (int)b0.w, (int)b1.x, (int)b1.y, (int)b1.z, (int)b1.w}, qf, negm, 0, 0, 0, 0, 0, 0);
}
__device__ __forceinline__ int v_st(int k, int c) { const int kk = (k & ~0xC) | ((k & 4) << 1) | ((k & 8) >> 1); return ((kk >> 3) * 4 + (c >> 5)) * 512 + ((kk & 7) * 32 + (c & 31)) * 2; }
__device__ __forceinline__ int v_rd_base(int lane) { return ((lane & 3) << 3) | (((lane >> 2) & 3) << 6) | (((lane >> 4) & 1) << 5) | (((lane >> 5) & 1) << 8); }
constexpr int v_rd_off(int d0, int ks, int half) { return d0 * 512 + ks * 4096 + half * 2048; }
template <int OFF> __device__ __forceinline__ s16x4 tr_read(int vb) {
  s16x4 r; asm volatile("ds_read_b64_tr_b16 %0, %1 offset:%2" : "=&v"(r) : "v"(vb), "i"(OFF) : "memory"); return r;
}
template <int D0> __device__ __forceinline__ void pv_one(f32x16& od, int vb, bf16x8 pa0, bf16x8 pa1, bf16x8 pa2, bf16x8 pa3) {
  const s16x4 l0 = tr_read<v_rd_off(D0, 0, 0)>(vb), h0 = tr_read<v_rd_off(D0, 0, 1)>(vb), l1 = tr_read<v_rd_off(D0, 1, 0)>(vb), h1 = tr_read<v_rd_off(D0, 1, 1)>(vb);
  const s16x4 l2 = tr_read<v_rd_off(D0, 2, 0)>(vb), h2 = tr_read<v_rd_off(D0, 2, 1)>(vb), l3 = tr_read<v_rd_off(D0, 3, 0)>(vb), h3 = tr_read<v_rd_off(D0, 3, 1)>(vb);
  asm volatile("s_waitcnt lgkmcnt(0)" ::: "memory"); SBAR();
#define PK(L, H) (bf16x8){L[0], L[1], L[2], L[3], H[0], H[1], H[2], H[3]}
  od = __builtin_amdgcn_mfma_f32_32x32x16_bf16(pa0, PK(l0, h0), od, 0, 0, 0);
  od = __builtin_amdgcn_mfma_f32_32x32x16_bf16(pa1, PK(l1, h1), od, 0, 0, 0);
  od = __builtin_amdgcn_mfma_f32_32x32x16_bf16(pa2, PK(l2, h2), od, 0, 0, 0);
  od = __builtin_amdgcn_mfma_f32_32x32x16_bf16(pa3, PK(l3, h3), od, 0, 0, 0);
#undef PK
}
__device__ __forceinline__ void pv_d0(f32x16* o, int vb, bf16x8 pa0, bf16x8 pa1, bf16x8 pa2, bf16x8 pa3) {
  pv_one<0>(o[0], vb, pa0, pa1, pa2, pa3); pv_one<1>(o[1], vb, pa0, pa1, pa2, pa3); pv_one<2>(o[2], vb, pa0, pa1, pa2, pa3); pv_one<3>(o[3], vb, pa0, pa1, pa2, pa3);
}

template <int OFF> __device__ __forceinline__ u32x4 rd128(int vb) { u32x4 r; asm volatile("ds_read_b128 %0, %1 offset:%2" : "=&v"(r) : "v"(vb), "i"(OFF) : "memory"); return r; }
#define PV_RD(D0) const u32x4 va##D0 = rd128<D0 * 2048>(vb), vc##D0 = rd128<D0 * 2048 + 1024>(vb); SBAR()
#define PV_MM(D0) do { asm volatile("s_waitcnt lgkmcnt(0)" ::: "memory"); SBAR(); \
    o[D0] = __builtin_amdgcn_mfma_scale_f32_32x32x64_f8f6f4((i32x8){(int)va##D0.x, (int)va##D0.y, (int)va##D0.z, (int)va##D0.w, (int)vc##D0.x, (int)vc##D0.y, (int)vc##D0.z, (int)vc##D0.w}, pb, o[D0], 0, 0, 0, 0, 0, 0); } while (0)
__device__ __forceinline__ float max3f(float a, float b, float c) { float r; asm("v_max3_f32 %0, %1, %2, %3" : "=v"(r) : "v"(a), "v"(b), "v"(c)); return r; }
#define PV_LSUM() lacc = __builtin_amdgcn_mfma_scale_f32_32x32x64_f8f6f4((i32x8){0x38383838, 0x38383838, 0x38383838, 0x38383838, 0x38383838, 0x38383838, 0x38383838, 0x38383838}, pb, lacc, 0, 0, 0, 0, 0, 0)
__device__ __forceinline__ void pv_psm(f32x16* o, f32x16& lacc, int vb, i32x8 pb, f32x16& p0, f32x16& p1, float& m_reg, f32x16& negm, float& alpha) {
  float pmax;
  { PV_RD(0);
    pmax = max3f(p0[0], p0[1], p0[2]);
#pragma unroll
    for (int r = 3; r < 15; r += 2) pmax = max3f(pmax, p0[r], p0[r + 1]);
    pmax = max3f(pmax, p0[15], p1[0]);
    SBAR(); PV_MM(0); }
  { PV_RD(1);
#pragma unroll
    for (int r = 1; r < 15; r += 2) pmax = max3f(pmax, p1[r], p1[r + 1]);
    pmax = max3f(pmax, p1[15], p1[15]);
    { auto rr = __builtin_amdgcn_permlane32_swap(__float_as_uint(pmax), __float_as_uint(pmax), false, false);
      pmax = max3f(__uint_as_float(rr[0]), __uint_as_float(rr[1]), __uint_as_float(rr[1])); }
    if (__builtin_expect(__all(pmax <= THR2), 1)) { alpha = 1.f; }
    else { const float dl = fmaxf(pmax - PBIAS, 0.f); alpha = __builtin_amdgcn_exp2f(-dl); m_reg += dl;
#pragma unroll
      for (int r = 0; r < 16; ++r) { p0[r] -= dl; p1[r] -= dl; }
#pragma unroll
      for (int r = 0; r < 16; ++r) negm[r] = -m_reg;
      asm volatile("" : "+v"(negm)); }
    SBAR(); PV_MM(1); }
  { PV_RD(2);
#pragma unroll
    for (int r = 0; r < 8; ++r) p0[r] = __builtin_amdgcn_exp2f(p0[r]);
    asm volatile("" : "+v"(p0));
    SBAR(); PV_MM(2); }
  { PV_RD(3);
#pragma unroll
    for (int r = 8; r < 16; ++r) p0[r] = __builtin_amdgcn_exp2f(p0[r]);
    asm volatile("" : "+v"(p0));
    SBAR(); PV_MM(3); PV_LSUM(); }
}
__device__ __forceinline__ void pvT_d0(f32x16* o, f32x16& lacc, int vb, i32x8 pb) {
  { PV_RD(0); PV_MM(0); } { PV_RD(1); PV_MM(1); } { PV_RD(2); PV_MM(2); } { PV_RD(3); PV_MM(3); PV_LSUM(); }
}
#undef PV_RD
#undef PV_MM
#undef PV_LSUM

__device__ __forceinline__ void attn_unit(const unsigned char* __restrict__ Qb, const unsigned char* __restrict__ Kh, const unsigned char* __restrict__ Vh, bf16_t* __restrict__ Ob,
                                          const float* __restrict__ gsub, const float lam, char* lds, const int wv) {
  typedef __attribute__((address_space(3))) unsigned* ldsu_t;
  const int tid = otid_w(wv), wid = wv, lane = tid & 63, r32 = lane & 31, hi = lane >> 5, mm = wid >> 2, wq = wid & 3;
  constexpr int NB = 4;
  constexpr int SHM_V8 = KVBLK * 128;
  char* V_lds = lds; char* K_lds = lds + NB * SHM_V8; constexpr int SHM_K8 = KVBLK * 128;
  float m_reg = 0.f; f32x16 o[4] = {}; f32x16 lacc = {}; i32x8 qf; f32x16 negm = {}; asm volatile("" : "+v"(negm));
  const unsigned koff = (unsigned)((2 * (wid >> 2) + (lane >> 5)) * 2048 + (lane & 3) * 512 + (8 * ((wid >> 1) & 1) + 2 * ((lane & 31) >> 3) + ((lane >> 2) & 1)) * 32 + (wid & 1) * 16);
  const unsigned voff = (unsigned)((wid >> 1) * 2048 + (lane & 7) * 256 + ((lane >> 3) & 3) * 64 + (wid & 1) * 32 + (lane >> 5) * 16);
#define DMA(t, buf) do { const char* kb_ = (const char*)(Kh + (size_t)(t) * SHM_K8); const char* vb_ = (const char*)(Vh + (size_t)(t) * SHM_V8); asm volatile("" : "+s"(kb_), "+s"(vb_)); \
    __builtin_amdgcn_global_load_lds((const unsigned*)(kb_ + koff), (ldsu_t)(K_lds + (buf) * SHM_K8 + wid * 1024), 16, 0, 0); \
    __builtin_amdgcn_global_load_lds((const unsigned*)(vb_ + voff), (ldsu_t)(V_lds + (buf) * SHM_V8 + wid * 1024), 16, 0, 0); } while (0)
#define WAIT_BAR(N) asm volatile("s_waitcnt vmcnt(" #N ") lgkmcnt(0)\n\ts_barrier" ::: "memory")
#define RESC(a) do { if (__any((a) < 1.f)) { _Pragma("unroll") for (int d = 0; d < 4; ++d) _Pragma("unroll") for (int r = 0; r < 16; ++r) o[d][r] *= (a); lacc[0] *= (a); } } while (0)
  DMA(0, 0); DMA(1, 1);
  { const unsigned char* Qw = Qb + (long)(wq * 32 + r32) * QKW + mm * 64 + hi * 32;
    const u32x4 q0 = *reinterpret_cast<const u32x4*>(Qw), q1 = *reinterpret_cast<const u32x4*>(Qw + 16);
    qf = (i32x8){(int)q0.x, (int)q0.y, (int)q0.z, (int)q0.w, (int)q1.x, (int)q1.y, (int)q1.z, (int)q1.w}; }
  const int vb0 = (int)(uintptr_t)V_lds + lane * 16;
  f32x16 pA0, pA1, pB0, pB1; float alA, alB; i32x8 pb; constexpr int NTL = KVLEN / KVBLK;
  WAIT_BAR(0);
  DMA(2, 2);
  qkt(pA0, pA1, K_lds, qf, lane, mm, negm); partialSM<true>(pA0, pA1, m_reg, negm, alA);
  WAIT_BAR(2);
  for (int j = 1; j + 1 < NTL; j += 2) {
    DMA(j + 2, (j + 2) & 3);
    SBAR(); qkt(pB0, pB1, K_lds + (j & 3) * SHM_K8, qf, lane, mm, negm);
    finishSM_T(pA0, pA1, pb); SBAR();
    pv_psm(o, lacc, vb0 + ((j - 1) & 3) * SHM_V8, pb, pB0, pB1, m_reg, negm, alB);
    RESC(alB);
    WAIT_BAR(2);
    if (j + 3 < NTL) DMA(j + 3, (j + 3) & 3);
    SBAR(); qkt(pA0, pA1, K_lds + ((j + 1) & 3) * SHM_K8, qf, lane, mm, negm);
    finishSM_T(pB0, pB1, pb); SBAR();
    pv_psm(o, lacc, vb0 + (j & 3) * SHM_V8, pb, pA0, pA1, m_reg, negm, alA);
    RESC(alA);
    if (j + 3 < NTL) WAIT_BAR(2); else WAIT_BAR(0);
  }
  SBAR(); qkt(pB0, pB1, K_lds + ((NTL - 1) & 3) * SHM_K8, qf, lane, mm, negm);
  finishSM_T(pA0, pA1, pb); SBAR();
  pv_psm(o, lacc, vb0 + ((NTL - 2) & 3) * SHM_V8, pb, pB0, pB1, m_reg, negm, alB);
  RESC(alB);
  finishSM_T(pB0, pB1, pb); SBAR();
  pvT_d0(o, lacc, vb0 + ((NTL - 1) & 3) * SHM_V8, pb);
#undef DMA
#undef WAIT_BAR
  const float rl = __builtin_amdgcn_rcpf(lacc[0]) * (mm ? lam : 1.0f);
  __syncthreads();
  constexpr int XS = 132;
  float* X = (float*)lds;
  if (mm == 1) {
#pragma unroll
    for (int r = 0; r < 16; ++r)
#pragma unroll
      for (int d0 = 0; d0 < 4; ++d0) X[(wq * 32 + r32) * XS + d0 * 32 + crow(r, hi)] = o[d0][r] * rl;
  }
  __syncthreads();
  if (mm == 0) {
#pragma unroll
    for (int r = 0; r < 16; ++r)
#pragma unroll
      for (int d0 = 0; d0 < 4; ++d0) { float* xp = X + (wq * 32 + r32) * XS + d0 * 32 + crow(r, hi); *xp = o[d0][r] * rl - *xp; }
  }
  __syncthreads();
  {
    const int row = tid >> 2, seg = tid & 3;
    const float* xr = X + row * XS + seg * 32;
    f32x4 v[8]; float ss = 0.f;
#pragma unroll
    for (int i = 0; i < 8; ++i) { v[i] = *(const f32x4*)(xr + 4 * i); ss += v[i][0] * v[i][0] + v[i][1] * v[i][1] + v[i][2] * v[i][2] + v[i][3] * v[i][3]; }
    ss += sx<1>(ss); ss += sx<2>(ss);
    const float rs = (1.0f - LAM_INIT) / sqrtf(ss * (1.0f / 128.0f) + EPS);
    bf16_t* dst = Ob + (long)row * D + seg * 32;
#pragma unroll
    for (int i = 0; i < 8; i += 2) {
      const f32x4 g0 = *(const f32x4*)(gsub + seg * 32 + 4 * i), g1 = *(const f32x4*)(gsub + seg * 32 + 4 * i + 4);
      u32x4 w; w.x = cvtpk(v[i][0] * rs * g0[0], v[i][1] * rs * g0[1]); w.y = cvtpk(v[i][2] * rs * g0[2], v[i][3] * rs * g0[3]);
      w.z = cvtpk(v[i + 1][0] * rs * g1[0], v[i + 1][1] * rs * g1[1]); w.w = cvtpk(v[i + 1][2] * rs * g1[2], v[i + 1][3] * rs * g1[3]);
      *(u32x4*)(dst + 4 * i) = w;
    }
  }
  __syncthreads();
#undef RESC
}
#undef KSWZ
#undef SBAR
}

__device__ __forceinline__ void ph_attn(const Params& p, unsigned char* smem) {
    unsigned char* ws = p.ws;
    const unsigned char* Q = ws + WS_Q; const unsigned char* Kb = ws + WS_K; const unsigned char* Vb = ws + WS_V;
    bf16_t* AO = (bf16_t*)(ws + WS_AO);
    const float lam = ((const float*)(ws + WS_CTL))[1024];
    const int c = blockIdx.x, G = gridDim.x;
    if (G == 256) {
        const int x = c & 7, s = c >> 3;
        for (int rd = 0; rd < 6; ++rd) {
            const int bh = rd * 4 + (x >> 1), qb = (x & 1) * 32 + s, b = bh / NH, h = bh % NH;
            fa::attn_unit(Q + ((size_t)b * SEQ + qb * 128) * QKW + h * 128, Kb + (size_t)(b * NH + h) * (KVLEN / 64) * 8192, Vb + (size_t)(b * NH + h) * (KVLEN / 64) * 8192,
                          AO + ((size_t)b * SEQ + qb * 128) * D + 256 + h * 128, p.in[I_GSUB], lam, (char*)smem, p.chunk);
        }
    } else {
        for (int u = c; u < BATCH * NH * 64; u += G) {
            const int bh = u >> 6, qb = u & 63, b = bh / NH, h = bh % NH;
            fa::attn_unit(Q + ((size_t)b * SEQ + qb * 128) * QKW + h * 128, Kb + (size_t)(b * NH + h) * (KVLEN / 64) * 8192, Vb + (size_t)(b * NH + h) * (KVLEN / 64) * 8192,
                          AO + ((size_t)b * SEQ + qb * 128) * D + 256 + h * 128, p.in[I_GSUB], lam, (char*)smem, p.chunk);
        }
    }
}

__device__ __forceinline__ void ph_fourierA(const Params& p, unsigned char* smem) {
    using namespace fa;
    unsigned char* ws = p.ws;
    const bf16_t* F = (const bf16_t*)(ws + WS_F); bf16_t* FY = (bf16_t*)(ws + WS_FY); const bf16_t* W = (const bf16_t*)(ws + WS_W128E);
    const int tid = otid(), wid = tid >> 6, lane = tid & 63, r32 = lane & 31, hi = lane >> 5;
    const int sr = tid >> 4, sc = (tid & 15) * 8, vst0 = v_st(sr, sc), vst1 = v_st(32 + sr, sc);
    const int vb0 = (int)(uintptr_t)smem + v_rd_base(lane);
    for (int task = blockIdx.x; task < BATCH * 64; task += gridDim.x) {
        const int b = task >> 6, n2 = task & 63;
        bf16x8 st[4][2];
#pragma unroll
        for (int kt = 0; kt < 2; ++kt)
#pragma unroll
            for (int ct = 0; ct < 2; ++ct) {
                st[kt * 2 + ct][0] = *(const bf16x8*)(F + ((size_t)b * SEQ + 64 * (64 * kt + sr) + n2) * 256 + 128 * ct + sc);
                st[kt * 2 + ct][1] = *(const bf16x8*)(F + ((size_t)b * SEQ + 64 * (64 * kt + 32 + sr) + n2) * 256 + 128 * ct + sc);
            }
        bf16x8 pa[2][4];
#pragma unroll
        for (int kt = 0; kt < 2; ++kt)
#pragma unroll
            for (int ks = 0; ks < 4; ++ks) pa[kt][ks] = *(const bf16x8*)(W + (size_t)(32 * wid + r32) * 128 + 64 * kt + 16 * ks + 8 * hi);
        __syncthreads();
#pragma unroll
        for (int q = 0; q < 4; ++q) { *(bf16x8*)(smem + q * 16384 + vst0) = st[q][0]; *(bf16x8*)(smem + q * 16384 + vst1) = st[q][1]; }
        __syncthreads();
        f32x16 o[2][4] = {};
#pragma unroll
        for (int ct = 0; ct < 2; ++ct)
#pragma unroll
            for (int kt = 0; kt < 2; ++kt) pv_d0(o[ct], vb0 + (kt * 2 + ct) * 16384, pa[kt][0], pa[kt][1], pa[kt][2], pa[kt][3]);
        const int plane = wid >> 2;
#pragma unroll
        for (int r = 0; r < 16; ++r) {
            const int k1 = 32 * (wid & 3) + crow(r, hi);
            bf16_t* dst = FY + ((((size_t)plane * BATCH + b) * 128 + k1) * 64 + n2) * 256 + r32;
#pragma unroll
            for (int ct = 0; ct < 2; ++ct)
#pragma unroll
                for (int d0 = 0; d0 < 4; ++d0) dst[128 * ct + 32 * d0] = f2bf(o[ct][d0][r]);
        }
    }
    __syncthreads();
}
__device__ __forceinline__ void ph_fourierB(const Params& p, unsigned char* smem) {
    using namespace fa;
    unsigned char* ws = p.ws;
    const bf16_t* FY = (const bf16_t*)(ws + WS_FY); const float2* tabw = (const float2*)(ws + WS_TABW);
    const bf16_t* M64 = (const bf16_t*)(ws + WS_M64E); const bf16_t* GT = (const bf16_t*)(ws + WS_GT);
    bf16_t* AO = (bf16_t*)(ws + WS_AO);
    const int tid = otid(), wid = tid >> 6, lane = tid & 63, r32 = lane & 31, hi = lane >> 5;
    const int sr = tid >> 4, sc = (tid & 15) * 8, vst0 = v_st(sr, sc), vst1 = v_st(32 + sr, sc);
    const int vb0 = (int)(uintptr_t)smem + v_rd_base(lane);
    constexpr int XRS = 528;
    unsigned char* XL = smem + 65536;
    const int mt = wid & 3, ctw = wid >> 2;
    for (int task = blockIdx.x; task < BATCH * 128; task += gridDim.x) {
        const int b = task >> 7, k1 = task & 127;
        __syncthreads();
#pragma unroll
        for (int ct = 0; ct < 2; ++ct)
#pragma unroll
            for (int rh = 0; rh < 2; ++rh) {
                const int n2 = sr + 32 * rh;
                const size_t off = ((((size_t)b) * 128 + k1) * 64 + n2) * 256 + 128 * ct + sc;
                const uint4 yr = *(const uint4*)(FY + off), yi = *(const uint4*)(FY + (size_t)BATCH * 128 * 64 * 256 + off);
                const float2 tw = tabw[n2 * k1];
                const unsigned yrw[4] = {yr.x, yr.y, yr.z, yr.w}, yiw[4] = {yi.x, yi.y, yi.z, yi.w};
                unsigned zr[4], zi[4];
#pragma unroll
                for (int q = 0; q < 4; ++q) {
                    const float a0 = __uint_as_float(yrw[q] << 16), a1 = __uint_as_float(yrw[q] & 0xffff0000u), b0 = __uint_as_float(yiw[q] << 16), b1 = __uint_as_float(yiw[q] & 0xffff0000u);
                    zr[q] = pk2(a0 * tw.x + b0 * tw.y, a1 * tw.x + b1 * tw.y); zi[q] = pk2(b0 * tw.x - a0 * tw.y, b1 * tw.x - a1 * tw.y);
                }
                const int vs = rh ? vst1 : vst0;
                *(uint4*)(smem + (0 * 2 + ct) * 16384 + vs) = make_uint4(zr[0], zr[1], zr[2], zr[3]);
                *(uint4*)(smem + (1 * 2 + ct) * 16384 + vs) = make_uint4(zi[0], zi[1], zi[2], zi[3]);
            }
        __syncthreads();
        {
            f32x16 o[4] = {};
#pragma unroll
            for (int kt = 0; kt < 2; ++kt) {
                bf16x8 pa[4];
#pragma unroll
                for (int ks = 0; ks < 4; ++ks) pa[ks] = *(const bf16x8*)(M64 + (size_t)(32 * mt + r32) * 128 + 64 * kt + 16 * ks + 8 * hi);
                pv_d0(o, vb0 + (kt * 2 + ctw) * 16384, pa[0], pa[1], pa[2], pa[3]);
            }
#pragma unroll
            for (int r = 0; r < 16; ++r) {
                const int ro = 32 * mt + crow(r, hi);
                bf16_t* xr = (bf16_t*)(XL + ((ro >> 6) * 64 + (ro & 63)) * XRS) + 128 * ctw + r32;
#pragma unroll
                for (int d0 = 0; d0 < 4; ++d0) xr[32 * d0] = f2bf(o[d0][r]);
            }
        }
        __syncthreads();
#pragma unroll
        for (int tt = 0; tt < 2; ++tt) {
            const int tau = 2 * wid + tt, g = tau >> 2, mt2 = (tau >> 1) & 1, nt2 = tau & 1;
            f32x16 acc = {};
#pragma unroll
            for (int ks8 = 0; ks8 < 8; ++ks8) {
                const int part = ks8 >> 2, cb = ks8 & 3;
                const bf16x8 af = *(const bf16x8*)(XL + (part * 64 + 32 * mt2 + r32) * XRS + (g * 64 + 16 * cb + 8 * hi) * 2);
                const bf16x8 bfr = *(const bf16x8*)(GT + ((size_t)g * 64 + 32 * nt2 + r32) * 128 + part * 64 + 16 * cb + 8 * hi);
                acc = __builtin_amdgcn_mfma_f32_32x32x16_bf16(af, bfr, acc, 0, 0, 0);
            }
#pragma unroll
            for (int r = 0; r < 16; ++r) { const int k2 = 32 * mt2 + crow(r, hi);
                AO[((size_t)b * SEQ + k1 + 128 * k2) * D + g * 64 + 32 * nt2 + r32] = f2bf(acc[r]); }
        }
    }
    __syncthreads();
}

__device__ __forceinline__ void ph_mid(const Params& p, unsigned char* smem) {
    typedef short bf16x8 __attribute__((ext_vector_type(8)));
    unsigned char* ws = p.ws;
    const int tid = otid(), wave = tid >> 6, lane = tid & 63, fr = lane & 15, fq = lane >> 4;
    const float* mod = (const float*)(ws + WS_MOD);
    const bf16_t* YX = (const bf16_t*)(ws + WS_YX);
    unsigned char* H2 = ws + WS_H2;
    unsigned* counts = (unsigned*)(ws + WS_CTL);
    int* TE = (int*)(ws + WS_TE); int* TP = (int*)(ws + WS_TP); float* TW = (float*)(ws + WS_TW); int* TOKL = (int*)(ws + WS_TOKL);
    constexpr int RS = 2064;
    unsigned char* Ahi = smem; unsigned char* Alo = smem + 16 * RS; float* Pp = (float*)(smem + 2 * 16 * RS + 512);
    const float rbias = p.in[I_RB][lane];
    int* lcnt = (int*)(smem + 99328); int* gb = lcnt + 64; int* PE = gb + 64; float* PW = (float*)(PE + 1024); float* PV = PW + 1024;
    for (int chunk = blockIdx.x; chunk < T / 128; chunk += gridDim.x) {
      const int mc = chunk * 128, b = mc >> 13;
      if (tid < 64) lcnt[tid] = 0;
      {
          const float* mrow_ = mod + b * 6144;
          for (int i = tid; i < 5 * 256; i += NT) { const int v_ = i >> 8, q_ = (i & 255) * 4;
              const float* s_ = (v_ == 0) ? p.in[I_GAPOST] + q_ : (v_ == 1) ? mrow_ + 2 * 1024 + q_ : (v_ == 2) ? p.in[I_GFPRE] + q_ : (v_ == 3) ? mrow_ + 3 * 1024 + q_ : mrow_ + 4 * 1024 + q_;
              *(f32x4*)(PV + v_ * 1024 + q_) = *(const f32x4*)s_; }
          __syncthreads();
      }
      uint2 yw[2][4]; f32x4 xv[2][4];
      bf16x8 wfr[4][4];
      { const bf16_t* wrt_ = (const bf16_t*)(ws + WS_WRT) + (size_t)p.chunk * 16 * 1024; asm volatile("" : "+s"(wrt_));
#pragma unroll
        for (int ks = 0; ks < 4; ++ks) {
#pragma unroll
          for (int nb = 0; nb < 4; ++nb) wfr[ks][nb] = *(const bf16x8*)(wrt_ + (size_t)((ks * 4 + nb) * 2 * 64 + lane) * 8);
          __builtin_amdgcn_sched_barrier(0); } }
#define MID_LOAD(m0_) do { _Pragma("unroll") for (int rr = 0; rr < 2; ++rr) { const int m_ = (m0_) + 2 * wave + rr; _Pragma("unroll") for (int j = 0; j < 4; ++j) { \
          yw[rr][j] = *(const uint2*)(YX + (size_t)m_ * D + 4 * (lane + 64 * j)); xv[rr][j] = ((const f32x4*)(p.in[I_X] + (size_t)m_ * D))[lane + 64 * j]; } } } while (0)
      MID_LOAD(mc);
#pragma unroll 1
      for (int it = 0; it < 8; ++it) {
        const int m0 = mc + it * 16;
        {
            float ss[2] = {0.f, 0.f};
#define YV(rr, j, i) ((i) == 0 ? __uint_as_float(yw[rr][j].x << 16) : (i) == 1 ? __uint_as_float(yw[rr][j].x & 0xffff0000u) : (i) == 2 ? __uint_as_float(yw[rr][j].y << 16) : __uint_as_float(yw[rr][j].y & 0xffff0000u))
#pragma unroll
            for (int rr = 0; rr < 2; ++rr) {
#pragma unroll
                for (int j = 0; j < 4; ++j) ss[rr] += YV(rr, j, 0) * YV(rr, j, 0) + YV(rr, j, 1) * YV(rr, j, 1) + YV(rr, j, 2) * YV(rr, j, 2) + YV(rr, j, 3) * YV(rr, j, 3);
                ss[rr] = wave_sum(ss[rr]);
            }
#pragma unroll
            for (int rr = 0; rr < 2; ++rr) {
                const int lr = 2 * wave + rr, m = m0 + lr;
                const float r1 = 1.0f / sqrtf(ss[rr] * (1.0f / D) + EPS);
                float ss2 = 0.f;
#pragma unroll
                for (int j = 0; j < 4; ++j) {
                    const int col = 4 * (lane + 64 * j);
                    const f32x4 gp = *(const f32x4*)(PV + col), gt = *(const f32x4*)(PV + 1024 + col);
#pragma unroll
                    for (int i = 0; i < 4; ++i) { xv[rr][j][i] = xv[rr][j][i] + gt[i] * (YV(rr, j, i) * r1 * gp[i]); ss2 += xv[rr][j][i] * xv[rr][j][i]; }
                    ((f32x4*)(p.out + (size_t)m * D))[lane + 64 * j] = xv[rr][j];
                }
                ss2 = wave_sum(ss2);
                const float r2 = 1.0f / sqrtf(ss2 * (1.0f / D) + EPS);
#pragma unroll
                for (int j = 0; j < 4; ++j) {
                    const int col = 4 * (lane + 64 * j);
                    const f32x4 gp = *(const f32x4*)(PV + 2048 + col), sh = *(const f32x4*)(PV + 3072 + col), sc = *(const f32x4*)(PV + 4096 + col);
                    float h[4];
#pragma unroll
                    for (int i = 0; i < 4; ++i) h[i] = xv[rr][j][i] * r2 * gp[i] * (1.f + sc[i]) + sh[i];
                    uint2 o; o.x = pk2(h[0], h[1]); o.y = pk2(h[2], h[3]);
                    { int w8 = __builtin_amdgcn_cvt_pk_fp8_f32(h[0], h[1], 0, false); w8 = __builtin_amdgcn_cvt_pk_fp8_f32(h[2], h[3], w8, true); *(int*)(H2 + (size_t)m * D + col) = w8; }
                    *(uint2*)(Ahi + lr * RS + col * 2) = o;
                }
            }
            if (it < 7) MID_LOAD(m0 + 16);
        }
        asm volatile("s_waitcnt lgkmcnt(0)\n\ts_barrier" ::: "memory");
        {
            f32x4 acc[4];
#pragma unroll
            for (int nb = 0; nb < 4; ++nb) acc[nb] = (f32x4){0.f, 0.f, 0.f, 0.f};
#pragma unroll
            for (int ks = 0; ks < 4; ++ks) {
                const int ko = (wave * 128 + ks * 32 + 8 * fq) * 2;
                const bf16x8 ah = *(const bf16x8*)(Ahi + fr * RS + ko);
#pragma unroll
                for (int nb = 0; nb < 4; ++nb) acc[nb] = __builtin_amdgcn_mfma_f32_16x16x32_bf16(ah, wfr[ks][nb], acc[nb], 0, 0, 0);
            }
#pragma unroll
            for (int nb = 0; nb < 4; ++nb)
#pragma unroll
                for (int j = 0; j < 4; ++j) Pp[(wave * 16 + 4 * fq + j) * 64 + 16 * nb + fr] = acc[nb][j];
        }
        asm volatile("s_waitcnt lgkmcnt(0)\n\ts_barrier" ::: "memory");
#pragma unroll
        for (int rr = 0; rr < 2; ++rr) {
            const int lr = 2 * wave + rr;
            float lg = 0.f;
#pragma unroll
            for (int w = 0; w < 8; ++w) lg += Pp[(w * 16 + lr) * 64 + lane];
            const float score = 1.0f / (1.0f + expf(-lg));
            const float sel = score + rbias;
            float t1 = sel, t2 = -INFINITY;
#define TOP2(M) do { const float o1 = sx<M>(t1), o2 = sx<M>(t2); const float n1 = fmaxf(t1, o1), n2 = fmaxf(fminf(t1, o1), fmaxf(t2, o2)); t1 = n1; t2 = n2; } while (0)
            TOP2(1); TOP2(2); TOP2(4);
#undef TOP2
            const float gs = t1 + t2; const int grp = lane >> 3;
            int gr = 0;
#pragma unroll
            for (int j = 0; j < 8; ++j) { const float sj = __uint_as_float(__builtin_amdgcn_readlane(__float_as_uint(gs), j * 8)); gr += (sj > gs || (sj == gs && j < grp)) ? 1 : 0; }
            const bool gsel = gr < 4;
            float v = gsel ? sel : -INFINITY;
            int rk = TOPK;
#pragma unroll
            for (int it8 = 0; it8 < TOPK; ++it8) {
                const float mx = wave_max(v);
                const unsigned long long eq = __ballot(v == mx);
                const int win = __builtin_ctzll(eq);
                if (lane == win) { rk = it8; v = -INFINITY; }
            }
            const bool chosen = rk < TOPK;
            const float ssum = wave_sum(chosen ? score : 0.f);
            const float w = score / (ssum + 1e-20f) * 2.5f;
            if (chosen) {
                const int lpos = atomicAdd(&lcnt[lane], 1);
                const int idx = (it * 16 + lr) * 8 + rk;
                PE[idx] = lane | (lpos << 8); PW[idx] = w;
            }
        }
      }
      __syncthreads();
      if (tid < 64) { const int c = lcnt[tid]; gb[tid] = c ? (int)atomicAdd(&counts[b * 65 + tid], (unsigned)c) : 0; }
      __syncthreads();
      for (int i = tid; i < 1024; i += NT) {
          const int pe = PE[i], e = pe & 255, pos = gb[e] + (pe >> 8), mk = mc * 8 + i;
          TOKL[((size_t)b * 64 + e) * 8192 + pos] = mk; TE[mk] = e; TP[mk] = pos; TW[mk] = PW[i];
      }
      __syncthreads();
    }
}

constexpr int T_CNT = 0;
constexpr int T_TOT = 256;
constexpr int T_AB = 328;
constexpr int T_OFF = 400;
constexpr int T_GUP = 660;
constexpr int T_YC = 730;
constexpr int T_YB = 990;
constexpr int T_DUP = 1250;
constexpr int T_UL = 1520;
constexpr int T_END = 1520 + 512;
__device__ __forceinline__ int scan_incl(int v, int lane) {
#pragma unroll
    for (int off = 1; off < 64; off <<= 1) { const int t = __builtin_amdgcn_ds_bpermute(((lane - off) & 63) << 2, v); if (lane >= off) v += t; }
    return v;
}
__device__ __forceinline__ void build_moe(const Params& p, int* tab) {
    const unsigned* counts = (const unsigned*)(p.ws + WS_CTL);
    __syncthreads();
    const int tid = otid(), wave = tid >> 6, lane = tid & 63;
    if (wave == 0) {
        const int c0 = (int)counts[0 * 65 + lane], c1 = (int)counts[1 * 65 + lane], c2 = (int)counts[2 * 65 + lane], c3 = (int)counts[3 * 65 + lane];
        tab[T_CNT + 0 * 64 + lane] = c0; tab[T_CNT + 1 * 64 + lane] = c1; tab[T_CNT + 2 * 64 + lane] = c2; tab[T_CNT + 3 * 64 + lane] = c3;
        tab[T_OFF + lane * 4 + 0] = 0; tab[T_OFF + lane * 4 + 1] = c0; tab[T_OFF + lane * 4 + 2] = c0 + c1; tab[T_OFF + lane * 4 + 3] = c0 + c1 + c2;
        const int tot = c0 + c1 + c2 + c3, pad = (tot + 255) & ~255, gu = ((tot + 255) >> 8) * 2;
        const int sp = scan_incl(pad, lane), sg = scan_incl(gu, lane);
        tab[T_TOT + lane] = tot; tab[T_AB + lane] = sp - pad; tab[T_GUP + lane] = sg - gu;
        const int cb[4] = {c0, c1, c2, c3};
#pragma unroll
        for (int b = 0; b < 4; ++b) {
            const int du = ((cb[b] + 255) >> 8) * 4;
            const int sy = scan_incl(cb[b], lane), sd = scan_incl(du, lane);
            tab[T_YB + 65 * b + lane] = sy - cb[b]; tab[T_DUP + 66 * b + lane] = sd - du;
            if (lane == 63) { tab[T_YB + 65 * b + 64] = sy; tab[T_DUP + 66 * b + 64] = sd; tab[T_DUP + 66 * b + 65] = sd + (SEQ / 256) * 4; }
        }
        if (lane == 63) { tab[T_TOT + 64] = T; tab[T_AB + 64] = sp; tab[T_GUP + 64] = sg; tab[T_GUP + 65] = sg + (T / 256) * 2; }
    }
    __syncthreads();
}

__device__ __forceinline__ void moe_decode(const GP_LAS int* tab, int e, int pos_e, int& b, int& pos) {
    const int o1 = tab[T_OFF + e * 4 + 1], o2 = tab[T_OFF + e * 4 + 2], o3 = tab[T_OFF + e * 4 + 3];
    b = (pos_e >= o1 ? 1 : 0) + (pos_e >= o2 ? 1 : 0) + (pos_e >= o3 ? 1 : 0);
    pos = pos_e - (b == 0 ? 0 : (b == 1 ? o1 : (b == 2 ? o2 : o3)));
}
__device__ __forceinline__ int yrow0(int b) { return b == 0 ? 2 * 1024 : (272 + 72 * (b - 1)) * 1024; }
struct MoeSched {
    const GP_LAS int* tab; int G, c, ntn, U, down, chunk; const int* TOKL; const char* Bt;
    __device__ __forceinline__ void prepare(int* tabw, int wv) const {
        if (wv == 0) {
            const int i = lane_id(); int L = i * G + c;
            if (L < U) {
                int bt = 0;
                if (down) {
#pragma unroll
                    for (int q = 0; q < 3; ++q) { const int u0 = tabw[T_DUP + 66 * bt + 65]; if (L >= u0) { L -= u0; ++bt; } } }
                const int pre = down ? T_DUP + 66 * bt : T_GUP;
                int lo = 0, hi = 64;
                while (lo < hi) { const int mid = (lo + hi + 1) >> 1; if (tabw[pre + mid] <= L) lo = mid; else hi = mid - 1; }
                const int loc = L - tabw[pre + lo];
                int cnt, base, bb;
                if (down) { cnt = (lo < 64) ? tabw[T_CNT + bt * 64 + (lo & 63)] : SEQ; base = tabw[T_YB + 65 * bt + lo] + yrow0(bt);
                            bb = tabw[T_AB + lo] + (lo < 64 ? tabw[T_OFF + (lo & 63) * 4 + bt] : bt * SEQ); }
                else { cnt = tabw[T_TOT + lo]; base = tabw[T_AB + lo]; bb = 0; }
                int* ul = tabw + T_UL + 8 * i;
                ul[0] = lo; ul[1] = loc / ntn; ul[2] = loc % ntn; ul[3] = cnt; ul[4] = base; ul[5] = bb;
            }
        }
        __syncthreads();
    }
    __device__ __forceinline__ bool next(int i, gp::Unit& u) const {
        if (i * G + c >= U) return false;
        const GP_LAS int* ul = tab + T_UL + 8 * i;
        u.e = __builtin_amdgcn_readfirstlane(ul[0]); u.pm = __builtin_amdgcn_readfirstlane(ul[1]); u.pn = __builtin_amdgcn_readfirstlane(ul[2]);
        u.cnt = __builtin_amdgcn_readfirstlane(ul[3]); u.base = __builtin_amdgcn_readfirstlane(ul[4]); u.b = __builtin_amdgcn_readfirstlane(ul[5]);
        return true;
    }
    __device__ __forceinline__ unsigned arow(const gp::Unit& u, int r) const {
        const int pos_e = u.pm * 256 + r;
        if (down) return (unsigned)(u.b + pos_e) * 256u;
        int tok;
        if (u.e < 64) { int b, pos; moe_decode(tab, u.e, pos_e, b, pos); tok = (pos_e < u.cnt) ? (TOKL[((size_t)b * 64 + u.e) * 8192 + pos] >> 3) : 0; } else tok = pos_e;
        return (unsigned)tok * 1024u;
    }
    __device__ __forceinline__ const char* bptr(const gp::Unit& u) const {
        return down ? Bt + ((size_t)u.e * 1024 + u.pn * 256) * 256 : Bt + ((size_t)u.e * 512 + u.pn * 256) * 1024;
    }
};
struct EpiGU {
    unsigned char* ACT; const int* TOKL; const float* TW; const GP_LAS int* tab;
    __device__ __forceinline__ void operator()(const f32x4 (&acc)[2][2][4][2], const gp::Unit& u, int wr, int wc, int fr, int fq) const {
#pragma unroll
        for (int ai = 0; ai < 2; ++ai)
#pragma unroll
            for (int m = 0; m < 4; ++m) {
                const int pos_e = u.pm * 256 + ai * 128 + wr * 64 + m * 16 + fr;
                if (pos_e < u.cnt) {
                    float a[8];
#pragma unroll
                    for (int n = 0; n < 2; ++n)
#pragma unroll
                        for (int i = 0; i < 4; ++i) { const float g = acc[ai][0][m][n][i] * (1.f / GUSCALE), up = acc[ai][1][m][n][i] * (1.f / GUSCALE);
                            a[4 * n + i] = __builtin_amdgcn_fmed3f(g * __builtin_amdgcn_rcpf(1.0f + __builtin_amdgcn_exp2f(-1.4426950408889634f * g)) * up * ASCALE, -448.f, 448.f); }
                    int w0 = __builtin_amdgcn_cvt_pk_fp8_f32(a[0], a[1], 0, false); w0 = __builtin_amdgcn_cvt_pk_fp8_f32(a[2], a[3], w0, true);
                    int w1 = __builtin_amdgcn_cvt_pk_fp8_f32(a[4], a[5], 0, false); w1 = __builtin_amdgcn_cvt_pk_fp8_f32(a[6], a[7], w1, true);
                    gp::gst2(ACT + ((size_t)u.base + pos_e) * DE + u.pn * 128 + wc * 32 + fq * 8, (unsigned)w0, (unsigned)w1);
                }
            }
    }
};
constexpr float YSCALE = 16.f;
struct EpiDown {
    unsigned char* ws;
    __device__ __forceinline__ void operator()(const f32x4 (&acc)[2][2][4][2], const gp::Unit& u, int wr, int wc, int fr, int fq) const {
#pragma unroll
        for (int ai = 0; ai < 2; ++ai)
#pragma unroll
            for (int m = 0; m < 4; ++m) {
                const int pos = u.pm * 256 + ai * 128 + wr * 64 + m * 16 + fr;
                {
                    unsigned char* rowp = ws + (size_t)((pos < u.cnt) ? (u.base + pos) : (489 * 1024 + fr)) * D + u.pn * 256 + wc * 64 + fq * 16;
                    gp::u32x4 o;
#pragma unroll
                    for (int bj = 0; bj < 2; ++bj) { const f32x4 v0 = acc[ai][bj][m][0] * (YSCALE / (WDSCALE * ASCALE)), v1 = acc[ai][bj][m][1] * (YSCALE / (WDSCALE * ASCALE));
                        int w0 = __builtin_amdgcn_cvt_pk_fp8_f32(v0[0], v0[1], 0, false); w0 = __builtin_amdgcn_cvt_pk_fp8_f32(v0[2], v0[3], w0, true);
                        int w1 = __builtin_amdgcn_cvt_pk_fp8_f32(v1[0], v1[1], 0, false); w1 = __builtin_amdgcn_cvt_pk_fp8_f32(v1[2], v1[3], w1, true);
                        if (bj == 0) { o.x = (unsigned)w0; o.y = (unsigned)w1; } else { o.z = (unsigned)w0; o.w = (unsigned)w1; } }
                    gp::gst4_nt(rowp, o);
                }
            }
    }
};
__device__ __forceinline__ void ph_moe_gu(const Params& p, unsigned char* smem) {
    unsigned char* ws = p.ws;
    int* tab = (int*)(smem + gp::STAGE_BYTES);
    build_moe(p, tab);
    MoeSched S; S.tab = (const GP_LAS int*)tab; S.G = gridDim.x; S.c = (gridDim.x % 8 == 0) ? (int)((blockIdx.x % 8) * (gridDim.x / 8) + blockIdx.x / 8) : (int)blockIdx.x;   S.ntn = 2; S.U = __builtin_amdgcn_readfirstlane(tab[T_GUP + 65]); S.down = 0; S.chunk = 0;
    S.TOKL = (const int*)(ws + WS_TOKL); S.Bt = (const char*)(ws + WS_WGUT);
    S.prepare(tab, p.chunk);
    EpiGU E{ws + WS_ACT, (const int*)(ws + WS_TOKL), (const float*)(ws + WS_TW), (const GP_LAS int*)tab};
    gp::gemm_phase<EpiGU, MoeSched, true, true>(p.chunk, (GP_LAS unsigned char*)smem, (const char*)(ws + WS_H2), D / 2, S, E);
}
__device__ __forceinline__ void ph_moe_down(const Params& p, unsigned char* smem, int c) {
    unsigned char* ws = p.ws;
    int* tab = (int*)(smem + gp::STAGE_BYTES);
    build_moe(p, tab);
    MoeSched S; S.tab = (const GP_LAS int*)tab; S.G = gridDim.x; S.c = (gridDim.x % 8 == 0) ? (int)((blockIdx.x % 8) * (gridDim.x / 8) + blockIdx.x / 8) : (int)blockIdx.x;   S.ntn = 4; S.U = __builtin_amdgcn_readfirstlane(tab[T_DUP + 65] + tab[T_DUP + 66 + 65] + tab[T_DUP + 132 + 65] + tab[T_DUP + 198 + 65]); S.down = 1; S.chunk = c;
    S.TOKL = nullptr; S.Bt = (const char*)(ws + WS_WDT);
    S.prepare(tab, p.chunk);
    EpiDown E{ws};
    gp::gemm_phase<EpiDown, MoeSched, false, true, 0>(p.chunk, (GP_LAS unsigned char*)smem, (const char*)(ws + WS_ACT), DE / 2, S, E);
}

__device__ __forceinline__ void ph_final(const Params& p, float* lds) {
    unsigned char* ws = p.ws;
    int* tab = (int*)lds;
    build_moe(p, tab);
    const int tid = otid(), wave = tid >> 6, lane = tid & 63;
    const int gw = blockIdx.x * NWV + wave, GW = gridDim.x * NWV;
    const int* TE = (const int*)(ws + WS_TE); const int* TP = (const int*)(ws + WS_TP); const float* TW = (const float*)(ws + WS_TW);
    const unsigned char* Y = ws;
    for (int m = gw; m < T; m += GW) {
        const int b = m >> 13, t = m & (SEQ - 1);
        const float* mod = (const float*)(ws + WS_MOD) + b * 6144 + 5 * 1024;
        float acc[16];
#pragma unroll
        for (int i = 0; i < 16; ++i) acc[i] = 0.f;
#pragma unroll
        for (int k = 0; k < 9; ++k) {
            int row; float wk = 1.f;
            if (k < 8) { const int e = TE[m * 8 + k]; row = tab[T_YB + 65 * b + e] + TP[m * 8 + k]; wk = TW[m * 8 + k]; }
            else row = tab[T_YB + 65 * b + 64] + t;
            row += yrow0(b);
            const unsigned char* yr = Y + (size_t)row * D;
#pragma unroll
            for (int j = 0; j < 4; ++j) { const int w = __builtin_nontemporal_load((const int*)(yr + 4 * (lane + 64 * j)));
                acc[4 * j] += wk * __builtin_amdgcn_cvt_f32_fp8(w, 0); acc[4 * j + 1] += wk * __builtin_amdgcn_cvt_f32_fp8(w, 1); acc[4 * j + 2] += wk * __builtin_amdgcn_cvt_f32_fp8(w, 2); acc[4 * j + 3] += wk * __builtin_amdgcn_cvt_f32_fp8(w, 3); }
        }
        float ss = 0.f;
#pragma unroll
        for (int i = 0; i < 16; ++i) { acc[i] *= (1.f / YSCALE); ss += acc[i] * acc[i]; }
        ss = wave_sum(ss);
        const float rs = 1.0f / sqrtf(ss * (1.0f / D) + EPS);
#pragma unroll
        for (int j = 0; j < 4; ++j) {
            const int col = 256 * j + 128 * ((lane >> 1) & 1) + 32 * (lane >> 4) + 8 * ((lane >> 2) & 3) + 4 * (lane & 1);
            const f32x4 gp = *(const f32x4*)(p.in[I_GFPOST] + col), gt = *(const f32x4*)(mod + col);
            f32x4 x1 = *(const f32x4*)(p.out + (size_t)m * D + col);
#pragma unroll
            for (int i = 0; i < 4; ++i) x1[i] += gt[i] * (acc[4 * j + i] * rs * gp[i]);
            __builtin_nontemporal_store(x1, (f32x4*)(p.out + (size_t)m * D + col));
        }
    }
}

#define GAS __attribute__((address_space(1)))
#define LAS __attribute__((address_space(3)))
#define XB_TMO      128
#define XB_XCNT(j)  (256  + 64 * (j))
#define XB_XSUB(j)  (1280 + 64 * (j))
#define XB_XGEN(j)  (2304 + 64 * (j))
#define XB_TOP      3328
#define XB_TOPGEN   3392
#define XCD_BAR_WORDS 3456
#define XB_SPIN_CAP (1u << 21)
__device__ __forceinline__ unsigned xb_ld(unsigned* p)              { return __hip_atomic_load(p, __ATOMIC_RELAXED, __HIP_MEMORY_SCOPE_AGENT); }
__device__ __forceinline__ unsigned xb_add(unsigned* p, unsigned v) { return __hip_atomic_fetch_add(p, v, __ATOMIC_RELAXED, __HIP_MEMORY_SCOPE_AGENT); }
__device__ __forceinline__ unsigned xb_xcc_id() { return (unsigned)__builtin_amdgcn_s_getreg((3 << 11) | 20) & 0xFu; }
#define XB_SPIN(cond, bar) do { unsigned _sp = 0; while (cond) { __builtin_amdgcn_s_sleep(1); \
    if ((++_sp & 255u) == 0u) { if (xb_ld(&(bar)[XB_TMO])) break; if (_sp > XB_SPIN_CAP) { atomicAdd(&(bar)[XB_TMO], 1u); break; } } } } while (0)
struct XcdBarrier { unsigned* bar; unsigned x; volatile LAS unsigned* st; };
__device__ __forceinline__ XcdBarrier xcd_barrier_post(unsigned* bar, volatile LAS unsigned* st, int wv) {
    XcdBarrier b; b.bar = bar; b.x = xb_xcc_id(); b.st = st;
    if (wv == 0 && lane_id() == 0) (void)xb_add(&bar[XB_XCNT(b.x)], 1u);
    return b;
}
__device__ __forceinline__ void xcd_barrier_complete(unsigned* bar, unsigned x, unsigned& nloc, unsigned& nx) {
    const unsigned G = gridDim.x * gridDim.y * gridDim.z;
    unsigned sum, cnt, mine, sp = 0u;
    for (;;) {
        sum = 0u; cnt = 0u; mine = 0u;
#pragma unroll
        for (unsigned j = 0; j < 16; ++j) { const unsigned c = xb_ld(&bar[XB_XCNT(j)]); sum += c; cnt += (c > 0u) ? 1u : 0u; mine = (j == x) ? c : mine; }
        if (sum == G) break;
        __builtin_amdgcn_s_sleep(1);
        if ((++sp & 255u) == 0u) { if (xb_ld(&bar[XB_TMO])) break; if (sp > XB_SPIN_CAP) { atomicAdd(&bar[XB_TMO], 1u); break; } }
    }
    nloc = mine > 0u ? mine : 1u; nx = cnt > 0u ? cnt : 1u;
}
__device__ __forceinline__ void xcd_barrier(const XcdBarrier& b, int wv) {
    asm volatile("s_waitcnt vmcnt(0)" ::: "memory");
    __syncthreads();
    if (wv == 0 && lane_id() == 0) {
        unsigned* bar = b.bar;
        __builtin_amdgcn_s_waitcnt(0);
        unsigned nloc = b.st[0], nx = b.st[1];
        if (nloc == 0u) { xcd_barrier_complete(bar, b.x, nloc, nx); b.st[0] = nloc; b.st[1] = nx; }
        const unsigned old = xb_add(&bar[XB_XSUB(b.x)], 1u);
        const unsigned gen = old / nloc;
        if (old + 1u == (gen + 1u) * nloc) {
            __builtin_amdgcn_fence(__ATOMIC_RELEASE, "agent");
            asm volatile("s_waitcnt vmcnt(0)" ::: "memory");
            const unsigned og = xb_add(&bar[XB_TOP], 1u);
            const unsigned tg = og / nx;
            if (og + 1u == (tg + 1u) * nx) xb_add(&bar[XB_TOPGEN], 1u);
            else XB_SPIN(xb_ld(&bar[XB_TOPGEN]) == tg, bar);
            __builtin_amdgcn_fence(__ATOMIC_ACQUIRE, "agent");
            xb_add(&bar[XB_XGEN(b.x)], 1u);
            asm volatile("s_waitcnt vmcnt(0)" ::: "memory");
        } else {
            XB_SPIN(xb_ld(&bar[XB_XGEN(b.x)]) == gen, bar);
            __builtin_amdgcn_fence(__ATOMIC_ACQUIRE, "agent");
            asm volatile("s_waitcnt vmcnt(0)" ::: "memory");
        }
    }
    __syncthreads();
}

namespace cg = cooperative_groups;
constexpr int LDS_BYTES = 144 * 1024;
typedef const __attribute__((address_space(4))) Params* KP;
__device__ __forceinline__ Params kargs() {
    Params p;
#if defined(__HIP_DEVICE_COMPILE__)
    typedef const __attribute__((address_space(4))) unsigned long long* KQ;
    KQ kq = (KQ)__builtin_amdgcn_kernarg_segment_ptr(); asm volatile("" : "+s"(kq));
    unsigned long long* d = (unsigned long long*)&p;
#pragma unroll
    for (int i = 0; i < (int)(sizeof(Params) / 8); ++i) d[i] = kq[i];
#endif
    return p;
}
#define PH(call) do { Params p = kargs(); p.chunk = wv; call; } while (0)
__global__ void __launch_bounds__(NT) mega_fwd(Params p_unused) {
    extern __shared__ __attribute__((aligned(16))) unsigned char smem[];
    float* lds = (float*)smem;
    volatile LAS unsigned* misc = (volatile LAS unsigned*)((LAS unsigned char*)smem + (LDS_BYTES - 64));
    if (threadIdx.x < 16) misc[threadIdx.x] = 0u;
    __syncthreads();
    unsigned* barw; { const Params p = kargs(); barw = (unsigned*)(p.ws + WS_CTL) + 4096; }
    const int wv = __builtin_amdgcn_readfirstlane(threadIdx.x >> 6);
    const XcdBarrier bar = xcd_barrier_post(barw, misc, wv);
#define SYNC() xcd_barrier(bar, wv)
    PH(ph_prep(p, lds));            SYNC();
    PH(ph_norm1(p)); PH(ph_prep_weights(p, lds, 0, 0));   SYNC();
    PH(ph_inproj(p, smem)); PH(ph_prep_weights(p, lds, 1, (MTOT / 256) * (INW / 256) % (int)gridDim.x));         SYNC();
    PH(ph_attn(p, smem)); PH(ph_fourierA(p, smem));  SYNC();
    PH(ph_fourierB(p, smem));       SYNC();
    PH(ph_outproj(p, smem));        SYNC();
    PH(ph_mid(p, smem));            SYNC();
    PH(ph_moe_gu(p, smem));         SYNC();
#pragma unroll 1
    PH(ph_moe_down(p, smem, 0));    SYNC();
    PH(ph_final(p, lds));
#undef SYNC
}

extern "C" void kernel_launch(void* const* d_in, const int* in_sizes, int n_in, void* d_out, int out_size, void* d_ws, size_t ws_size, hipStream_t stream) {
    if (n_in != 26 || ws_size < WS_END) { fprintf(stderr, "kernel_launch: unexpected n_in %d / ws %zu\n", n_in, ws_size); return; }
    static int grid_blocks = 0;
    if (!grid_blocks) {
        int dev = 0, cus = 0, per_cu = 0;
        (void)hipGetDevice(&dev);
        (void)hipDeviceGetAttribute(&cus, hipDeviceAttributeMultiprocessorCount, dev);
        (void)hipFuncSetAttribute((const void*)mega_fwd, hipFuncAttributeMaxDynamicSharedMemorySize, LDS_BYTES);
        (void)hipOccupancyMaxActiveBlocksPerMultiprocessor(&per_cu, (const void*)mega_fwd, NT, LDS_BYTES);
        if (per_cu < 1) { fprintf(stderr, "kernel_launch: occupancy query says %d blocks/CU\n", per_cu); per_cu = 1; }
        if (per_cu > 1) per_cu = 1;
        grid_blocks = cus * per_cu;
    }
    Params p{};
    for (int i = 0; i < 26; ++i) p.in[i] = (const float*)d_in[i];
    p.out = (float*)d_out; p.ws = (unsigned char*)d_ws; p.chunk = 0; p.pad = 0;
    (void)hipMemsetAsync((char*)d_ws + WS_CTL, 0, 32768, stream);
    void* args[] = {&p};
    hipError_t e = hipLaunchCooperativeKernel((const void*)mega_fwd, dim3(grid_blocks), dim3(NT), args, LDS_BYTES, stream);
    if (e != hipSuccess) fprintf(stderr, "cooperative launch failed: %s (grid %d)\n", hipGetErrorString(e), grid_blocks);
}
```

```cpp
#include <hip/hip_runtime.h>
#include <hip/hip_cooperative_groups.h>
#include <cstdio>
#include <cstdint>

typedef unsigned short bf16_t;
typedef float f32x4 __attribute__((ext_vector_type(4)));

constexpr int D = 1024, BATCH = 4, SEQ = 8192, T = BATCH * SEQ, CTX = 256, TC = BATCH * CTX;
constexpr int MTOT = T + TC;
constexpr int KVLEN = CTX + SEQ;
constexpr int INW = 2560, NH = 6, QKW = 768, FW = 256;
constexpr int NE = 64, DE = 256, TOPK = 8;
constexpr int NT = 512, NWV = 8;
constexpr int SLOTS_B = 90112;
constexpr float EPS = 1e-6f;
constexpr float LAM_INIT = 0.2f;
constexpr float QSCALE = 0.125f * 1.4426950408889634f;
constexpr float SQS = 0.42466090014400953f;

constexpr size_t MiB = 1u << 20;
constexpr size_t WS_CTL = 0;
constexpr size_t WS_MOD = 1 * MiB;
constexpr size_t WS_TABW = WS_MOD + 128 * 1024;
constexpr size_t WS_ROPE = WS_MOD + 192 * 1024;
constexpr size_t WS_GCS = WS_MOD + 256 * 1024;
constexpr size_t WS_W128E = WS_MOD + 768 * 1024;
constexpr size_t WS_M64E = WS_MOD + 832 * 1024;
constexpr size_t WS_GT = WS_MOD + 864 * 1024;
constexpr size_t WS_WRT = WS_MOD + 512 * 1024;
constexpr size_t WS_WINT = 2 * MiB;
constexpr size_t WS_WOUTT = 7 * MiB;
constexpr size_t WS_WGUT = 9 * MiB;
constexpr size_t WS_WDT = 74 * MiB;
constexpr size_t WS_TE = 107 * MiB;
constexpr size_t WS_TP = 108 * MiB;
constexpr size_t WS_TW = 109 * MiB;
constexpr size_t WS_TOKL = 110 * MiB;
constexpr size_t WS_AO = 118 * MiB;
constexpr size_t WS_ACT = 118 * MiB;
constexpr size_t WS_Q = 182 * MiB;
constexpr size_t WS_K = 230 * MiB;
constexpr size_t WS_V = WS_K + (size_t)BATCH * KVLEN * QKW * 2;
constexpr size_t WS_F = 329 * MiB;
constexpr size_t WS_FY = 361 * MiB;
constexpr size_t WS_HX = 425 * MiB;
constexpr size_t WS_YX = 358 * MiB;
constexpr size_t WS_H2 = 294 * MiB;
constexpr size_t WS_Y = 294 * MiB;
constexpr size_t WS_END = 491 * MiB;

struct Params {
    const float* in[26];
    float* out;
    unsigned char* ws;
    int chunk;
    int pad;
};
enum { I_X = 0, I_C, I_CTX, I_CCTX, I_WMOD, I_BMOD, I_GAPRE, I_GAPOST, I_WIN, I_WF, I_LQ1, I_LK1, I_LQ2, I_LK2, I_GSUB, I_WOUT,
       I_GFPRE, I_GFPOST, I_WR, I_RB, I_WG, I_WU, I_WD, I_WSG, I_WSU, I_WSD };

__device__ __forceinline__ float bf2f(bf16_t v) { return __uint_as_float(((unsigned)v) << 16); }
__device__ __forceinline__ bf16_t f2bf(float f) { unsigned u = __float_as_uint(f); return (bf16_t)((u + 0x7fffu + ((u >> 16) & 1u)) >> 16); }
__device__ __forceinline__ unsigned pk2(float lo, float hi) { return (unsigned)f2bf(lo) | ((unsigned)f2bf(hi) << 16); }
template <int M> __device__ __forceinline__ float sx(float v) { return __int_as_float(__builtin_amdgcn_ds_swizzle(__float_as_int(v), (M << 10) | 0x1f)); }
template <int M> __device__ __forceinline__ int sxi(int v) { return __builtin_amdgcn_ds_swizzle(v, (M << 10) | 0x1f); }
__device__ __forceinline__ float wave_sum(float v) {
    v += sx<1>(v); v += sx<2>(v); v += sx<4>(v); v += sx<8>(v); v += sx<16>(v);
    auto rr = __builtin_amdgcn_permlane32_swap(__float_as_uint(v), __float_as_uint(v), false, false);
    return __uint_as_float(rr[0]) + __uint_as_float(rr[1]);
}
__device__ __forceinline__ float dpp_f(float v, const int ctrl_sel) {
    const int x = __float_as_int(v); int r;
    if (ctrl_sel == 0) r = __builtin_amdgcn_update_dpp(x, x, 0xB1, 0xf, 0xf, false);
    else if (ctrl_sel == 1) r = __builtin_amdgcn_update_dpp(x, x, 0x4E, 0xf, 0xf, false);
    else if (ctrl_sel == 2) r = __builtin_amdgcn_update_dpp(x, x, 0x141, 0xf, 0xf, false);
    else r = __builtin_amdgcn_update_dpp(x, x, 0x140, 0xf, 0xf, false);
    return __int_as_float(r);
}
__device__ __forceinline__ float wave_max(float v) {
    v = fmaxf(v, dpp_f(v, 0)); v = fmaxf(v, dpp_f(v, 1)); v = fmaxf(v, dpp_f(v, 2)); v = fmaxf(v, dpp_f(v, 3));
    const float a = __uint_as_float(__builtin_amdgcn_readlane(__float_as_uint(v), 0)), b = __uint_as_float(__builtin_amdgcn_readlane(__float_as_uint(v), 16));
    const float c = __uint_as_float(__builtin_amdgcn_readlane(__float_as_uint(v), 32)), d = __uint_as_float(__builtin_amdgcn_readlane(__float_as_uint(v), 48));
    return fmaxf(fmaxf(a, b), fmaxf(c, d));
}
__device__ __forceinline__ int lane_id() { int l; asm volatile("v_mbcnt_lo_u32_b32 %0, -1, 0\n\tv_mbcnt_hi_u32_b32 %0, -1, %0" : "=v"(l)); return l; }
__device__ __forceinline__ int otid_w(int wv) { return wv * 64 + lane_id(); }
#define otid() otid_w(p.chunk)
__device__ __forceinline__ float silu_f(float x) { return x / (1.f + expf(-x)); }

__device__ __forceinline__ void ph_prep(const Params& p, float* lds) {
    const int tid = otid(), bid = blockIdx.x, nblk = gridDim.x;
    const bool split = nblk >= 192;
    const int gt = split ? (bid - 96) * NT + tid : bid * NT + tid, GT = split ? (nblk - 96) * NT : nblk * NT;
    const int gidx = gt;
    unsigned char* ws = p.ws;
    if (gt >= 0) {
    float2* tabw = (float2*)(ws + WS_TABW);
    for (int i = gt; i < 8192; i += GT) { float s, c; sincospif((float)i * (1.0f / 4096.0f), &s, &c); tabw[i] = make_float2(c, s); }
    float* rope = (float*)(ws + WS_ROPE);
    for (int i = gt; i < 192 * 16; i += GT) {
        const int pos = (i < 2048) ? (i >> 4) : ((i - 2048) >> 4); const int f = i & 15;
        const float inv = powf(10000.0f, -(float)(2 * f) / 32.0f); const float ang = (float)pos * inv;
        const float c = cosf(ang), s = sinf(ang);
        if (i < 2048) { rope[i] = c; rope[2048 + i] = s; } else { rope[4096 + (i - 2048)] = c; rope[4096 + 1024 + (i - 2048)] = s; }
    }
    { bf16_t* gt = (bf16_t*)(ws + WS_GT); const float* wf = p.in[I_WF];
      for (int i = gidx; i < 4 * 64 * 128; i += GT) {
        const int g = i >> 13, d = (i >> 7) & 63, part = (i >> 6) & 1, c = i & 63;
        float a = 0.f;
        for (int j = 0; j < 64; ++j) { float s, co; sincospif((float)((c * j) & 63) * (1.0f / 32.0f), &s, &co); a += (part ? s : co) * wf[(g * 64 + j) * 64 + d]; }
        gt[i] = f2bf(a * 0.0013810679320049757f);
      }
      bf16_t* w128 = (bf16_t*)(ws + WS_W128E);
      for (int i = gidx; i < 256 * 128; i += GT) { const int kk = i >> 7, n1 = i & 127; float s, co; sincospif((float)(((kk & 127) * n1) & 127) * (1.0f / 64.0f), &s, &co); w128[i] = f2bf(kk < 128 ? co : -s); }
      bf16_t* m64 = (bf16_t*)(ws + WS_M64E);
      for (int i = gidx; i < 128 * 128; i += GT) { const int ro = i >> 7, ci = i & 127, po = ro >> 6, k2 = ro & 63, pi = ci >> 6, n2 = ci & 63;
        float s, co; sincospif((float)((k2 * n2) & 63) * (1.0f / 32.0f), &s, &co); m64[i] = f2bf(po == pi ? co : (po == 0 ? s : -s)); }
    }
    {
      bf16_t* wrt = (bf16_t*)(ws + WS_WRT); const float* wr = p.in[I_WR];
      for (int i = gt; i < 64 * 1024; i += GT) {
        const int j = i & 7, ln = (i >> 3) & 63, nb = (i >> 9) & 3, ks = (i >> 11) & 3, wv_ = i >> 13;
        const int e = 16 * nb + (ln & 15), k = wv_ * 128 + ks * 32 + 8 * (ln >> 4) + j;
        const float w = wr[k * 64 + e]; const bf16_t h = f2bf(w);
        const int o = ((((wv_ * 4 + ks) * 4 + nb) * 2) * 64 + ln) * 8 + j;
        wrt[o] = h; wrt[o + 512] = f2bf(w - bf2f(h)); } }
    if (gt == 0) {
        float s1 = 0.f, s2 = 0.f;
        for (int i = 0; i < 64; ++i) { s1 += p.in[I_LQ1][i] * p.in[I_LK1][i]; s2 += p.in[I_LQ2][i] * p.in[I_LK2][i]; }
        ((float*)(ws + WS_CTL))[1024] = expf(s1) - expf(s2) + LAM_INIT;
    }
    }
    float* sc = lds;
    float* red = lds + 5 * 1024;
    for (int i = tid; i < 5 * 1024; i += NT) { const int r = i >> 10, k = i & 1023; const float v = (r < 4) ? p.in[I_C][r * 1024 + k] : p.in[I_CCTX][k]; sc[i] = silu_f(v); }
    __syncthreads();
    const int wave = tid >> 6, lane = tid & 63;
    float* mod = (float*)(ws + WS_MOD);
    for (int task = bid; task < 96; task += nblk) {
        const int col = task * 64 + lane;
        float a0 = 0, a1 = 0, a2 = 0, a3 = 0, a4 = 0;
        const float* wm = p.in[I_WMOD];
#pragma unroll 32
        for (int k = wave * 128; k < wave * 128 + 128; ++k) { const float w = wm[(size_t)k * 6144 + col]; a0 += sc[k] * w; a1 += sc[1024 + k] * w; a2 += sc[2048 + k] * w; a3 += sc[3072 + k] * w; a4 += sc[4096 + k] * w; }
        red[(wave * 5 + 0) * 64 + lane] = a0; red[(wave * 5 + 1) * 64 + lane] = a1; red[(wave * 5 + 2) * 64 + lane] = a2; red[(wave * 5 + 3) * 64 + lane] = a3; red[(wave * 5 + 4) * 64 + lane] = a4;
        __syncthreads();
        if (tid < 320) { const int r = tid >> 6, l = tid & 63; float s = 0.f; for (int w = 0; w < 8; ++w) s += red[(w * 5 + r) * 64 + l]; mod[r * 6144 + task * 64 + l] = s + p.in[I_BMOD][task * 64 + l]; }
        __syncthreads();
    }
}

__device__ __forceinline__ void ph_norm1(const Params& p) {
    const int tid = otid(), wave = tid >> 6, lane = tid & 63;
    const int gw = blockIdx.x * NWV + wave, GW = gridDim.x * NWV;
    const float* mod = (const float*)(p.ws + WS_MOD);
    bf16_t* hx = (bf16_t*)(p.ws + WS_HX);
    const float* g = p.in[I_GAPRE];
    for (int m = gw; m < MTOT; m += GW) {
        const float* src = (m < T) ? p.in[I_X] + (size_t)m * D : p.in[I_CTX] + (size_t)(m - T) * D;
        const int r = (m < T) ? (m >> 13) : 4;
        const float* shift = mod + r * 6144; const float* scale = shift + 1024;
        f32x4 v[4]; float ss = 0.f;
#pragma unroll
        for (int j = 0; j < 4; ++j) { v[j] = ((const f32x4*)src)[lane + 64 * j]; ss += v[j][0] * v[j][0] + v[j][1] * v[j][1] + v[j][2] * v[j][2] + v[j][3] * v[j][3]; }
        ss = wave_sum(ss);
        const float rs = 1.0f / sqrtf(ss * (1.0f / D) + EPS);
#pragma unroll
        for (int j = 0; j < 4; ++j) {
            const int col = 4 * (lane + 64 * j);
            const f32x4 g4 = *(const f32x4*)(g + col), sc4 = *(const f32x4*)(scale + col), sh4 = *(const f32x4*)(shift + col);
            float h[4];
#pragma unroll
            for (int i = 0; i < 4; ++i) h[i] = v[j][i] * rs * g4[i] * (1.f + sc4[i]) + sh4[i];
            uint2 o; o.x = pk2(h[0], h[1]); o.y = pk2(h[2], h[3]);
            *(uint2*)(hx + (size_t)m * D + col) = o;
        }
    }
}

namespace gp {
#define GP_LAS __attribute__((address_space(3)))
typedef short bf16x8 __attribute__((ext_vector_type(8)));
typedef unsigned u32x4 __attribute__((ext_vector_type(4)));
typedef int i32x4 __attribute__((ext_vector_type(4)));
constexpr int BM = 256, BK = 64, HALF = 128, HTB = HALF * BK * 2, STAGE_BYTES = 8 * HTB;
__device__ __forceinline__ int lds_byte(int r, int c) { const int st = (r >> 4) * 2 + (c >> 5), rr = r & 15, cc = c & 31, ob = rr * 64 + cc * 2; return st * 1024 + (ob ^ (((ob >> 9) & 1) << 5)); }
__device__ __forceinline__ void stage_rc(int b, int& R, int& C) { const int st = b / 1024, sb = b % 1024, swz = sb ^ (((sb >> 9) & 1) << 5); R = (st >> 1) * 16 + swz / 64; C = (st & 1) * 32 + (swz % 64) / 2; }
__device__ __forceinline__ int perm32(int rho) { const int n = rho >> 4, i = rho & 15; return 8 * (i >> 2) + 4 * n + (i & 3); }
struct Unit { int pm, pn, e, b, cnt, base; };
typedef unsigned u32x2 __attribute__((ext_vector_type(2)));
typedef float f32x4g __attribute__((ext_vector_type(4)));
#define GP_G1(T, ptr) ((__attribute__((address_space(1))) T*)(ptr))
__device__ __forceinline__ void gst4(void* p, u32x4 v) { *GP_G1(u32x4, p) = v; }
__device__ __forceinline__ void gst4_nt(void* p, u32x4 v) { __builtin_nontemporal_store(v, GP_G1(u32x4, p)); }
__device__ __forceinline__ void gst2(void* p, unsigned a, unsigned b) { *GP_G1(u32x2, p) = (u32x2){a, b}; }
__device__ __forceinline__ void gst1(void* p, unsigned a) { *GP_G1(unsigned, p) = a; }
__device__ __forceinline__ f32x4g gld4f(const void* p) { return *GP_G1(const f32x4g, p); }
__device__ __forceinline__ unsigned cvt_pk_bf16(float lo, float hi) { unsigned r; asm volatile("v_cvt_pk_bf16_f32 %0, %1, %2" : "=v"(r) : "v"(lo), "v"(hi)); return r; }

template <class Epi, class Sched, bool ALIGN_EPI, bool F8 = false, int EST = 0>
__device__ __forceinline__ void gemm_phase(const int wv, GP_LAS unsigned char* lds, const char* Abase, const int K, const Sched& S, const Epi& E) {
    const int wid = wv, wr = wid >> 2, wc = wid & 3;
    const int nt = K / BK;
    unsigned voffB[2];
#pragma unroll
    for (int i = 0; i < 2; ++i) { int R, C; stage_rc(otid_w(wv) * 16 + i * 8192, R, C); const int Rb = (R & ~31) + perm32(R & 31); voffB[i] = (unsigned)(Rb * K + C) * 2u; }
#define GP_AOFFS(u, o00, o01, o10, o11) do { int R0, C0, R1, C1; const int t_ = otid_w(wv); stage_rc(t_ * 16, R0, C0); stage_rc(t_ * 16 + 8192, R1, C1); \
        o00 = S.arow(u, R0) + (unsigned)C0 * 2u; o01 = S.arow(u, R1) + (unsigned)C1 * 2u; o10 = S.arow(u, HALF + R0) + (unsigned)C0 * 2u; o11 = S.arow(u, HALF + R1) + (unsigned)C1 * 2u; } while (0)
    const size_t kstep = (size_t)(BK * 2);
    const size_t hstep = (size_t)HALF * K * 2;
    const unsigned ldsw = (unsigned)wid * 1024u;
    int aoff, boff; { const int l_ = lane_id(), fr = l_ & 15, fq = l_ >> 4; aoff = lds_byte(wr * 64 + fr, fq * 8); boff = lds_byte(wc * 32 + fr, fq * 8); }
#define GP_SA(b, h) (((b) * 2 + (h)) * HTB)
#define GP_SB(b, h) ((4 + (b) * 2 + (h)) * HTB)
#define GP_STAGE_B(bufoff, gbase) do { _Pragma("unroll") for (int _i = 0; _i < 2; ++_i) \
        __builtin_amdgcn_global_load_lds((const unsigned*)((const char*)(gbase) + voffB[_i]), (GP_LAS unsigned*)(lds + (bufoff) + ldsw + _i * 8192), 16, 0, 0); } while (0)
#define GP_STAGE_A(bufoff, gbase, o0, o1) do { \
        __builtin_amdgcn_global_load_lds((const unsigned*)((const char*)(gbase) + (o0)), (GP_LAS unsigned*)(lds + (bufoff) + ldsw), 16, 0, 0); \
        __builtin_amdgcn_global_load_lds((const unsigned*)((const char*)(gbase) + (o1)), (GP_LAS unsigned*)(lds + (bufoff) + ldsw + 8192), 16, 0, 0); } while (0)
#define GP_LDA(dst, b, h) do { _Pragma("unroll") for (int m = 0; m < 4; ++m) _Pragma("unroll") for (int k = 0; k < 2; ++k) dst[m][k] = *(const GP_LAS bf16x8*)(lds + GP_SA(b, h) + aoff + m * 2048 + k * 1024); } while (0)
#define GP_LDB(dst, b, h) do { _Pragma("unroll") for (int n = 0; n < 2; ++n) _Pragma("unroll") for (int k = 0; k < 2; ++k) dst[n][k] = *(const GP_LAS bf16x8*)(lds + GP_SB(b, h) + boff + n * 2048 + k * 1024); } while (0)
#define GP_CAT8(x) __builtin_shufflevector(__builtin_bit_cast(i32x4, x[0]), __builtin_bit_cast(i32x4, x[1]), 0, 1, 2, 3, 4, 5, 6, 7)
#define GP_MMA(ai, bj, At, Bt) do { __builtin_amdgcn_s_setprio(1); _Pragma("unroll") for (int m = 0; m < 4; ++m) _Pragma("unroll") for (int n = 0; n < 2; ++n) { \
        if constexpr (F8) acc[ai][bj][m][n] = __builtin_amdgcn_mfma_scale_f32_16x16x128_f8f6f4(GP_CAT8(Bt[n]), GP_CAT8(At[m]), acc[ai][bj][m][n], 0, 0, 0, 0, 0, 0); \
        else { _Pragma("unroll") for (int k = 0; k < 2; ++k) acc[ai][bj][m][n] = __builtin_amdgcn_mfma_f32_16x16x32_bf16(Bt[n][k], At[m][k], acc[ai][bj][m][n], 0, 0, 0); } } \
        __builtin_amdgcn_s_setprio(0); } while (0)
#define GP_WAIT_V(n) asm volatile("s_waitcnt vmcnt(" #n ")" ::: "memory")
#define GP_WAIT_L(n) asm volatile("s_waitcnt lgkmcnt(" #n ")" ::: "memory")
#define GP_BAR __builtin_amdgcn_s_barrier()
#define GP_SCHED __builtin_amdgcn_sched_barrier(0)
    Unit cur, nxt; int ui = 0;
    if (!S.next(0, cur)) return;
    f32x4 acc[2][2][4][2];
#pragma unroll
    for (int a = 0; a < 2; ++a)
#pragma unroll
        for (int b = 0; b < 2; ++b)
#pragma unroll
            for (int m = 0; m < 4; ++m)
#pragma unroll
                for (int n = 0; n < 2; ++n) acc[a][b][m][n] = (f32x4){0.f, 0.f, 0.f, 0.f};
    bf16x8 At[4][2], B0[2][2], B1[2][2];
    unsigned ac00, ac01, ac10, ac11, an00, an01, an10, an11;
    GP_AOFFS(cur, ac00, ac01, ac10, ac11);
    const char* cB = S.bptr(cur);
    GP_STAGE_B(GP_SB(0, 0), cB); GP_STAGE_B(GP_SB(0, 1), cB + hstep); GP_STAGE_A(GP_SA(0, 0), Abase, ac00, ac01); GP_STAGE_A(GP_SA(0, 1), Abase, ac10, ac11);
    if (wr == 1) GP_BAR;
    GP_WAIT_V(2); GP_BAR;
    GP_STAGE_B(GP_SB(1, 0), cB + kstep); GP_STAGE_A(GP_SA(1, 0), Abase + kstep, ac00, ac01); GP_STAGE_B(GP_SB(1, 1), cB + hstep + kstep);
    GP_WAIT_V(6); GP_BAR;
    for (;;) {
        const bool has_next = S.next(ui + 1, nxt);
        if (has_next) { GP_AOFFS(nxt, an00, an01, an10, an11); }
        else { an00 = ac00; an01 = ac01; an10 = ac10; an11 = ac11; }
        const char* nB = has_next ? S.bptr(nxt) : cB;
#pragma unroll 1
        for (int t = 0; t < nt; t += 2) {
            const bool last = (t == nt - 2);
            const char* a1 = Abase + (size_t)(t + 1) * kstep;
            const char* a2 = last ? Abase : Abase + (size_t)(t + 2) * kstep; const char* b2 = last ? nB : cB + (size_t)(t + 2) * kstep;
            const char* a3 = a2 + kstep; const char* b3 = b2 + kstep;
            asm volatile("" : "+s"(a1), "+s"(a2), "+s"(b2), "+s"(a3), "+s"(b3));
            GP_LDB(B0, 0, 0); GP_LDB(B1, 0, 1); GP_SCHED; GP_LDA(At, 0, 0); GP_STAGE_A(GP_SA(1, 1), a1, ac10, ac11);
            if (last) { ac00 = an00; ac01 = an01; ac10 = an10; ac11 = an11; }
            const bool relax = EST > 0 && ui > 0 && t == 0;
            if (relax) { static_assert(EST == 0 || EST == 16, "add a wait variant"); asm volatile("s_waitcnt vmcnt(24)" ::: "memory"); } else GP_WAIT_V(8);
            GP_WAIT_L(0); GP_BAR; GP_MMA(0, 0, At, B0); GP_MMA(0, 1, At, B1); GP_BAR; GP_SCHED;
            GP_LDA(At, 0, 1); GP_STAGE_B(GP_SB(0, 0), b2); GP_STAGE_B(GP_SB(0, 1), b2 + hstep); GP_STAGE_A(GP_SA(0, 0), a2, ac00, ac01);
            if (relax) asm volatile("s_waitcnt vmcnt(24)" ::: "memory"); else GP_WAIT_V(8);
            GP_WAIT_L(0); GP_BAR; GP_MMA(1, 0, At, B0); GP_MMA(1, 1, At, B1); GP_BAR; GP_SCHED;
            GP_LDB(B0, 1, 0); GP_LDB(B1, 1, 1); GP_SCHED; GP_LDA(At, 1, 0); GP_STAGE_A(GP_SA(0, 1), a2, ac10, ac11);
            GP_WAIT_V(8); GP_WAIT_L(0); GP_BAR; GP_MMA(0, 0, At, B0); GP_MMA(0, 1, At, B1); GP_BAR; GP_SCHED;
            GP_LDA(At, 1, 1); GP_STAGE_B(GP_SB(1, 0), b3); GP_STAGE_B(GP_SB(1, 1), b3 + hstep); GP_STAGE_A(GP_SA(1, 0), a3, ac00, ac01);
            GP_WAIT_V(8); GP_WAIT_L(0); GP_BAR; GP_MMA(1, 0, At, B0); GP_MMA(1, 1, At, B1); GP_BAR; GP_SCHED;
        }
        if constexpr (ALIGN_EPI) { if (wr == 0) GP_BAR; }
        { const int l_ = lane_id(); E(acc, cur, wr, wc, l_ & 15, l_ >> 4); }
        if (!has_next) break;
#pragma unroll
        for (int a = 0; a < 2; ++a)
#pragma unroll
            for (int b = 0; b < 2; ++b)
#pragma unroll
                for (int m = 0; m < 4; ++m)
#pragma unroll
                    for (int n = 0; n < 2; ++n) acc[a][b][m][n] = (f32x4){0.f, 0.f, 0.f, 0.f};
        cur = nxt; cB = nB; ++ui;
        if constexpr (ALIGN_EPI) { if (wr == 1) GP_BAR; }
    }
    GP_WAIT_V(0);
    if constexpr (!ALIGN_EPI) { if (wr == 0) GP_BAR; }
    GP_BAR;
#undef GP_AOFFS
#undef GP_SA
#undef GP_SB
#undef GP_STAGE_A
#undef GP_STAGE_B
#undef GP_LDA
#undef GP_LDB
#undef GP_MMA
#undef GP_CAT8
#undef GP_WAIT_V
#undef GP_WAIT_L
#undef GP_BAR
#undef GP_SCHED
}

struct DenseSched {
    int nM, nN, nwg, G, c, K; const char* Bt;
    __device__ __forceinline__ void init(int M, int N, int K_, const void* Bt_, int G_, int c_) { nM = M / BM; nN = N / BM; nwg = nM * nN; G = G_; c = c_; K = K_; Bt = (const char*)Bt_; }
    __device__ __forceinline__ bool next(int i, Unit& u) const {
        const long L = (long)i * G + c; if (L >= nwg) return false;
        int wgid = (int)L; { const int q = nwg / 8, r = nwg % 8, xcd = wgid % 8, off = wgid / 8; wgid = (xcd < r ? xcd * (q + 1) : r * (q + 1) + (xcd - r) * q) + off; }
        const int nig = 8 * nN, gid = wgid / nig, fm = gid * 8, gsz = (nM - fm) < 8 ? (nM - fm) : 8;
        u.pm = fm + ((wgid % nig) % gsz); u.pn = (wgid % nig) / gsz; u.e = 0; u.b = 0; u.cnt = 0; u.base = 0; return true;
    }
    __device__ __forceinline__ unsigned arow(const Unit& u, int r) const { return (unsigned)(u.pm * BM + r) * (unsigned)(K * 2); }
    __device__ __forceinline__ const char* bptr(const Unit& u) const { return Bt + (size_t)u.pn * BM * K * 2; }
};
}

struct EpiInProj {
    bf16_t* F; bf16_t* Q; bf16_t* Kb; bf16_t* Vb; const GP_LAS _Float16* rope;
    __device__ __forceinline__ void operator()(const f32x4 (&acc)[2][2][4][2], const gp::Unit& u, int wr, int wc, int fr, int fq) const {
        const int pn = u.pn, pm = u.pm; const bool isctx = pm >= T / 256;
        if (isctx && pn < 4) return;
        if (pn >= 7) {
            unsigned char* V8 = (unsigned char*)Vb;
#pragma unroll
            for (int ai = 0; ai < 2; ++ai) {
                const int row0 = pm * 256 + ai * 128 + wr * 64;
                int b, tile;
                if (!isctx) { b = row0 >> 13; tile = (CTX >> 6) + ((row0 & 8191) >> 6); } else { const int j = row0 - T; b = j >> 8; tile = (j & 255) >> 6; }
#pragma unroll
                for (int bj = 0; bj < 2; ++bj) {
                    const int head = (pn - 7) * 2 + bj;
                    unsigned char* dst = V8 + ((size_t)(b * NH + head) * (KVLEN / 64) + tile) * 8192 + wc * 2048 + fq * 64 + (fr >> 3) * 32 + (fr & 1) * 16 + ((fr >> 1) & 3) * 4;
#pragma unroll
                    for (int e = 0; e < 8; ++e) {
                        int w = __builtin_amdgcn_cvt_pk_fp8_f32(acc[ai][bj][0][e >> 2][e & 3], acc[ai][bj][1][e >> 2][e & 3], 0, false);
                        w = __builtin_amdgcn_cvt_pk_fp8_f32(acc[ai][bj][2][e >> 2][e & 3], acc[ai][bj][3][e >> 2][e & 3], w, true);
                        gp::gst1(dst + e * 256, (unsigned)w);
                    }
                }
            }
            return;
        }
        const int axis = wc & 1; const GP_LAS _Float16* ct = rope + (axis ? 4096 : 0); const GP_LAS _Float16* st = rope + (axis ? 4096 + 1024 : 2048);
#pragma unroll
        for (int ai = 0; ai < 2; ++ai)
#pragma unroll
            for (int m = 0; m < 4; ++m) {
                const int row = pm * 256 + ai * 128 + wr * 64 + m * 16 + fr;
                int t, kb, tile;
                if (!isctx) { kb = row >> 13; t = row & 8191; tile = (CTX >> 6) + (t >> 6); } else { const int j = row - T; t = 0; kb = j >> 8; tile = (j & 255) >> 6; }
                const int pos = axis ? (t & 63) : (t >> 6);
#pragma unroll
                for (int bj = 0; bj < 2; ++bj) {
                    const int col0 = pn * 256 + bj * 128 + wc * 32 + fq * 8;
                    f32x4 v0 = acc[ai][bj][m][0], v1 = acc[ai][bj][m][1];
                    if (pn == 0) { gp::u32x4 w; w.x = gp::cvt_pk_bf16(v0[0], v0[1]); w.y = gp::cvt_pk_bf16(v0[2], v0[3]); w.z = gp::cvt_pk_bf16(v1[0], v1[1]); w.w = gp::cvt_pk_bf16(v1[2], v1[3]);
                        gp::gst4(F + (size_t)row * 256 + col0, w); continue; }
                    if (pn < 7 && !isctx) {
                        typedef _Float16 h8 __attribute__((ext_vector_type(8)));
                        const h8 ch = *(const GP_LAS h8*)(ct + pos * 16 + 8 * (fq & 1)), sh = *(const GP_LAS h8*)(st + pos * 16 + 8 * (fq & 1));
                        const f32x4 c0 = {(float)ch[0], (float)ch[1], (float)ch[2], (float)ch[3]}, c1 = {(float)ch[4], (float)ch[5], (float)ch[6], (float)ch[7]};
                        const f32x4 s0 = {(float)sh[0], (float)sh[1], (float)sh[2], (float)sh[3]}, s1 = {(float)sh[4], (float)sh[5], (float)sh[6], (float)sh[7]};
                        const float sg = (fq < 2) ? -1.f : 1.f;
#pragma unroll
                        for (int i = 0; i < 4; ++i) {
                            const auto r0 = __builtin_amdgcn_permlane32_swap(__float_as_uint(v0[i]), __float_as_uint(v0[i]), false, false);
                            const auto r1 = __builtin_amdgcn_permlane32_swap(__float_as_uint(v1[i]), __float_as_uint(v1[i]), false, false);
                            const float p0 = __uint_as_float(fq < 2 ? r0[1] : r0[0]), p1 = __uint_as_float(fq < 2 ? r1[1] : r1[0]);
                            v0[i] = v0[i] * c0[i] + sg * p0 * s0[i]; v1[i] = v1[i] * c1[i] + sg * p1 * s1[i]; }
                    }
                    v0 = v0 * SQS; v1 = v1 * SQS;
                    int w0 = __builtin_amdgcn_cvt_pk_fp8_f32(v0[0], v0[1], 0, false); w0 = __builtin_amdgcn_cvt_pk_fp8_f32(v0[2], v0[3], w0, true);
                    int w1 = __builtin_amdgcn_cvt_pk_fp8_f32(v1[0], v1[1], 0, false); w1 = __builtin_amdgcn_cvt_pk_fp8_f32(v1[2], v1[3], w1, true);
                    unsigned char* d;
                    if (pn < 4) d = (unsigned char*)Q + (size_t)row * QKW + (col0 - 256);
                    else d = (unsigned char*)Kb + ((size_t)(kb * NH + (pn - 4) * 2 + bj) * (KVLEN / 64) + tile) * 8192 + wc * 2048 + m * 512 + fr * 32 + fq * 8;
                    gp::gst2(d, (unsigned)w0, (unsigned)w1);
                }
            }
    }
};
struct EpiStoreBf16 {
    bf16_t* O; int ldc;
    __device__ __forceinline__ void operator()(const f32x4 (&acc)[2][2][4][2], const gp::Unit& u, int wr, int wc, int fr, int fq) const {
#pragma unroll
        for (int ai = 0; ai < 2; ++ai)
#pragma unroll
            for (int m = 0; m < 4; ++m) {
                bf16_t* rowp = O + (size_t)(u.pm * 256 + ai * 128 + wr * 64 + m * 16 + fr) * ldc + u.pn * 256 + wc * 32 + fq * 8;
#pragma unroll
                for (int bj = 0; bj < 2; ++bj) { const f32x4 v0 = acc[ai][bj][m][0], v1 = acc[ai][bj][m][1];
                    gp::u32x4 w; w.x = gp::cvt_pk_bf16(v0[0], v0[1]); w.y = gp::cvt_pk_bf16(v0[2], v0[3]); w.z = gp::cvt_pk_bf16(v1[0], v1[1]); w.w = gp::cvt_pk_bf16(v1[2], v1[3]);
                    gp::gst4(rowp + bj * 128, w); }
            }
    }
};

__device__ __forceinline__ void ph_inproj(const Params& p, unsigned char* smem) {
    unsigned char* ws = p.ws;
    gp::DenseSched S; S.init(MTOT, INW, D, ws + WS_WINT, gridDim.x, blockIdx.x);
    GP_LAS _Float16* ropel = (GP_LAS _Float16*)((GP_LAS unsigned char*)smem + gp::STAGE_BYTES);
    { const float* rope = (const float*)(ws + WS_ROPE); for (int i = otid(); i < 6144; i += NT) ropel[i] = (_Float16)rope[i]; }
    __syncthreads();
    EpiInProj E{(bf16_t*)(ws + WS_F), (bf16_t*)(ws + WS_Q), (bf16_t*)(ws + WS_K), (bf16_t*)(ws + WS_V), ropel};
    gp::gemm_phase<EpiInProj, gp::DenseSched, true>(p.chunk, (GP_LAS unsigned char*)smem, (const char*)(ws + WS_HX), D, S, E);
}
__device__ __forceinline__ void ph_outproj(const Params& p, unsigned char* smem) {
    unsigned char* ws = p.ws;
    gp::DenseSched S; S.init(T, D, D, ws + WS_WOUTT, gridDim.x, blockIdx.x);
    EpiStoreBf16 E{(bf16_t*)(ws + WS_YX), D};
    gp::gemm_phase<EpiStoreBf16, gp::DenseSched, true>(p.chunk, (GP_LAS unsigned char*)smem, (const char*)(ws + WS_AO), D, S, E);
}

constexpr float GUSCALE = 64.f;
constexpr float WDSCALE = 16.f, ASCALE = 4.f;
struct TItem8 { const float* W; unsigned char* WT; int K, N, row_base, k0, n0; float sc; };
__device__ __forceinline__ void titem8_load(const TItem8& t, float (&tv)[32], int lane) {
#pragma unroll
    for (int i = 0; i < 32; ++i) tv[i] = t.W[(size_t)(t.k0 + 2 * i + (lane >> 5)) * t.N + t.n0 + (lane & 31)];
}
__device__ __forceinline__ void titem8_finish(const TItem8& t, const float (&tv)[32], float* scr, int lane) {
#pragma unroll
    for (int i = 0; i < 32; ++i) scr[(2 * i + (lane >> 5)) * 33 + (lane & 31)] = tv[i] * t.sc;
    asm volatile("s_waitcnt lgkmcnt(0)" ::: "memory");
    const int c = lane & 7;
#pragma unroll
    for (int j = 0; j < 4; ++j) { const int n = (lane >> 3) + 8 * j; const float* s = scr + (8 * c) * 33 + n;
        int w0 = __builtin_amdgcn_cvt_pk_fp8_f32(s[0 * 33], s[1 * 33], 0, false); w0 = __builtin_amdgcn_cvt_pk_fp8_f32(s[2 * 33], s[3 * 33], w0, true);
        int w1 = __builtin_amdgcn_cvt_pk_fp8_f32(s[4 * 33], s[5 * 33], 0, false); w1 = __builtin_amdgcn_cvt_pk_fp8_f32(s[6 * 33], s[7 * 33], w1, true);
        uint2 o; o.x = (unsigned)w0; o.y = (unsigned)w1;
        *(uint2*)(t.WT + (size_t)(t.row_base + t.n0 + n) * t.K + t.k0 + 8 * c) = o; }
    asm volatile("s_waitcnt lgkmcnt(0)" ::: "memory");
}
__device__ __forceinline__ void transpose_item(const float* W, int K, int N, bf16_t* WT, int row_base, int kb, int nb, float* scr, int lane) {
    const int k0 = 64 * kb, n0 = 32 * nb;
    float tv[32];
#pragma unroll
    for (int i = 0; i < 32; ++i) tv[i] = W[(size_t)(k0 + 2 * i + (lane >> 5)) * N + n0 + (lane & 31)];
#pragma unroll
    for (int i = 0; i < 32; ++i) scr[(2 * i + (lane >> 5)) * 33 + (lane & 31)] = tv[i];
    asm volatile("s_waitcnt lgkmcnt(0)" ::: "memory");
    const int c = lane & 7;
#pragma unroll
    for (int j = 0; j < 4; ++j) { const int n = (lane >> 3) + 8 * j; const float* s = scr + (8 * c) * 33 + n;
        uint4 o; o.x = pk2(s[0 * 33], s[1 * 33]); o.y = pk2(s[2 * 33], s[3 * 33]); o.z = pk2(s[4 * 33], s[5 * 33]); o.w = pk2(s[6 * 33], s[7 * 33]);
        *(uint4*)(WT + (size_t)(row_base + n0 + n) * K + k0 + 8 * c) = o; }
    asm volatile("s_waitcnt lgkmcnt(0)" ::: "memory");
}
__device__ __forceinline__ void ph_prep_weights(const Params& p, float* lds, const int part, const int first) {
    const int tid = otid(), wave = tid >> 6, lane = tid & 63;
    float* scr = lds + 8192 + wave * (64 * 33);
    if ((int)blockIdx.x < first) return;
    const int gw = ((int)blockIdx.x - first) * NWV + wave, GW = ((int)gridDim.x - first) * NWV;
    unsigned char* ws = p.ws;
    constexpr int I_IN = 16 * 80, I_OUT = 16 * 32, I_GU = 16 * 8, I_D = 4 * 32;
    constexpr int NITEMS = I_IN + I_OUT + 65 * (2 * I_GU + I_D);
    const int it_lo = part ? I_IN + I_OUT : 0, it_hi = part ? NITEMS : I_IN + I_OUT;
    if (part == 0) {
        for (int it = it_lo + gw; it < it_hi; it += GW) {
            int r = it;
            if (r < I_IN) { transpose_item(p.in[I_WIN], D, INW, (bf16_t*)(ws + WS_WINT), 0, r / 80, r % 80, scr, lane); continue; } r -= I_IN;
            transpose_item(p.in[I_WOUT], D, D, (bf16_t*)(ws + WS_WOUTT), 0, r / 32, r % 32, scr, lane);
        }
        return;
    }
    auto decode = [&](int it, TItem8& t) {
        int r = it - (I_IN + I_OUT);
        const int e = r / (2 * I_GU + I_D); r -= e * (2 * I_GU + I_D);
        if (r < 2 * I_GU) {
            const int half = r / I_GU, q = r % I_GU, kb = q / 8, nb = q % 8;
            t.W = (e < 64) ? p.in[half ? I_WU : I_WG] + (size_t)e * D * DE : p.in[half ? I_WSU : I_WSG];
            const int n0 = 32 * nb, drow = e * 512 + (n0 >> 7) * 256 + half * 128 + (n0 & 127);
            t.WT = ws + WS_WGUT; t.K = D; t.N = DE; t.row_base = drow - n0; t.k0 = 64 * kb; t.n0 = n0; t.sc = GUSCALE;
        } else {
            r -= 2 * I_GU;
            t.W = (e < 64) ? p.in[I_WD] + (size_t)e * DE * D : p.in[I_WSD];
            t.WT = ws + WS_WDT; t.K = DE; t.N = D; t.row_base = e * 1024; t.k0 = 64 * (r / 32); t.n0 = 32 * (r % 32); t.sc = WDSCALE;
        }
    };
    int it = it_lo + gw;
    if (it >= it_hi) return;
    TItem8 ta, tb; float va[32], vb[32];
    decode(it, ta); titem8_load(ta, va, lane);
    for (;;) {
        const bool hb = it + GW < it_hi;
        if (hb) { decode(it + GW, tb); titem8_load(tb, vb, lane); }
        titem8_finish(ta, va, scr, lane);
        if (!hb) break;
        const bool ha = it + 2 * GW < it_hi;
        if (ha) { decode(it + 2 * GW, ta); titem8_load(ta, va, lane); }
        titem8_finish(tb, vb, scr, lane);
        if (!ha) break;
        it += 2 * GW;
    }
}

namespace fa {
typedef short bf16x8 __attribute__((ext_vector_type(8)));
typedef short s16x4 __attribute__((ext_vector_type(4)));
typedef float f32x16 __attribute__((ext_vector_type(16)));
typedef unsigned u32x4 __attribute__((ext_vector_type(4)));
constexpr int KVBLK = 64, LDK = QKW;
constexpr float SCALE = 0.125f, THR = 8.f;
constexpr size_t SHM_V = KVBLK * 128 * 2, SHM_K = KVBLK * 128 * 2;
#define KSWZ(row, colB) ((row) * 256 + ((colB) ^ (((row) & 15) << 4)))
#define SBAR() __builtin_amdgcn_sched_barrier(0)
__device__ __forceinline__ int crow(int r, int hi) { return (r & 3) + 8 * (r >> 2) + 4 * hi; }
__device__ __forceinline__ unsigned cvtpk(float lo, float hi) { unsigned r; asm volatile("v_cvt_pk_bf16_f32 %0, %1, %2" : "=v"(r) : "v"(lo), "v"(hi)); return r; }
constexpr float PBIAS = 5.f, THR2 = PBIAS + 3.5f;
template <bool FIRST>
__device__ __forceinline__ void partialSM(f32x16& p0, f32x16& p1, float& m_reg, f32x16& negm, float& alpha) {
  float pmax = p0[0];
#pragma unroll
  for (int r = 1; r < 16; ++r) pmax = fmaxf(pmax, p0[r]);
#pragma unroll
  for (int r = 0; r < 16; ++r) pmax = fmaxf(pmax, p1[r]);
  { auto rr = __builtin_amdgcn_permlane32_swap(__float_as_uint(pmax), __float_as_uint(pmax), false, false);
    pmax = fmaxf(__uint_as_float(rr[0]), __uint_as_float(rr[1])); }
  if (!FIRST && __builtin_expect(__all(pmax <= THR2), 1)) { alpha = 1.f; }
  else { const float dl = FIRST ? pmax - PBIAS : fmaxf(pmax - PBIAS, 0.f); alpha = FIRST ? 0.f : __builtin_amdgcn_exp2f(-dl); m_reg += dl;
#pragma unroll
    for (int r = 0; r < 16; ++r) { p0[r] -= dl; p1[r] -= dl; }
#pragma unroll
    for (int r = 0; r < 16; ++r) negm[r] = -m_reg;
    asm volatile("" : "+v"(negm)); }
#pragma unroll
  for (int r = 0; r < 16; ++r) p0[r] = __builtin_amdgcn_exp2f(p0[r]);
}
typedef int i32x8 __attribute__((ext_vector_type(8)));
__device__ __forceinline__ int pk4_fp8(float a, float b, float c, float d) { int w; asm("v_cvt_pk_fp8_f32 %0, %1, %2" : "=v"(w) : "v"(a), "v"(b)); asm("v_cvt_pk_fp8_f32 %0, %1, %2 op_sel:[0,0,1]" : "+v"(w) : "v"(c), "v"(d)); return w; }
__device__ __forceinline__ void finishSM_T(f32x16& p0, f32x16& p1, i32x8& pb) {
#pragma unroll
  for (int r = 0; r < 16; ++r) p1[r] = __builtin_amdgcn_exp2f(p1[r]);
#pragma unroll
  for (int g = 0; g < 4; ++g) {
    pb[g] = pk4_fp8(p0[4 * g], p0[4 * g + 1], p0[4 * g + 2], p0[4 * g + 3]); pb[4 + g] = pk4_fp8(p1[4 * g], p1[4 * g + 1], p1[4 * g + 2], p1[4 * g + 3]); }
}
__device__ __forceinline__ void qkt(f32x16& p0, f32x16& p1, const char* Ks, const i32x8 qf, int lane, int mm, const f32x16& negm) {
  const char* kp = Ks + mm * 4096 + lane * 16;
  const u32x4 a0 = *reinterpret_cast<const u32x4*>(kp), a1 = *reinterpret_cast<const u32x4*>(kp + 1024), b0 = *reinterpret_cast<const u32x4*>(kp + 2048), b1 = *reinterpret_cast<const u32x4*>(kp + 3072);
  p0 = __builtin_amdgcn_mfma_scale_f32_32x32x64_f8f6f4((i32x8){(int)a0.x, (int)a0.y, (int)a0.z, (int)a0.w, (int)a1.x, (int)a1.y, (int)a1.z, (int)a1.w}, qf, negm, 0, 0, 0, 0, 0, 0);
  p1 = __builtin_amdgcn_mfma_scale_f32_32x32x64_f8f6f4((i32x8){(int)b0.x, (int)b0.y, (int)b0.z, (int)b0.w, (int)b1.x, (int)b1.y, (int)b1.z, (int)b1.w}, qf, negm, 0, 0, 0, 0, 0, 0);
}
__device__ __forceinline__ int v_st(int k, int c) { const int kk = (k & ~0xC) | ((k & 4) << 1) | ((k & 8) >> 1); return ((kk >> 3) * 4 + (c >> 5)) * 512 + ((kk & 7) * 32 + (c & 31)) * 2; }
__device__ __forceinline__ int v_rd_base(int lane) { return ((lane & 3) << 3) | (((lane >> 2) & 3) << 6) | (((lane >> 4) & 1) << 5) | (((lane >> 5) & 1) << 8); }
constexpr int v_rd_off(int d0, int ks, int half) { return d0 * 512 + ks * 4096 + half * 2048; }
template <int OFF> __device__ __forceinline__ s16x4 tr_read(int vb) {
  s16x4 r; asm volatile("ds_read_b64_tr_b16 %0, %1 offset:%2" : "=&v"(r) : "v"(vb), "i"(OFF) : "memory"); return r;
}
template <int D0> __device__ __forceinline__ void pv_one(f32x16& od, int vb, bf16x8 pa0, bf16x8 pa1, bf16x8 pa2, bf16x8 pa3) {
  const s16x4 l0 = tr_read<v_rd_off(D0, 0, 0)>(vb), h0 = tr_read<v_rd_off(D0, 0, 1)>(vb), l1 = tr_read<v_rd_off(D0, 1, 0)>(vb), h1 = tr_read<v_rd_off(D0, 1, 1)>(vb);
  const s16x4 l2 = tr_read<v_rd_off(D0, 2, 0)>(vb), h2 = tr_read<v_rd_off(D0, 2, 1)>(vb), l3 = tr_read<v_rd_off(D0, 3, 0)>(vb), h3 = tr_read<v_rd_off(D0, 3, 1)>(vb);
  asm volatile("s_waitcnt lgkmcnt(0)" ::: "memory"); SBAR();
#define PK(L, H) (bf16x8){L[0], L[1], L[2], L[3], H[0], H[1], H[2], H[3]}
  od = __builtin_amdgcn_mfma_f32_32x32x16_bf16(pa0, PK(l0, h0), od, 0, 0, 0);
  od = __builtin_amdgcn_mfma_f32_32x32x16_bf16(pa1, PK(l1, h1), od, 0, 0, 0);
  od = __builtin_amdgcn_mfma_f32_32x32x16_bf16(pa2, PK(l2, h2), od, 0, 0, 0);
  od = __builtin_amdgcn_mfma_f32_32x32x16_bf16(pa3, PK(l3, h3), od, 0, 0, 0);
#undef PK
}
__device__ __forceinline__ void pv_d0(f32x16* o, int vb, bf16x8 pa0, bf16x8 pa1, bf16x8 pa2, bf16x8 pa3) {
  pv_one<0>(o[0], vb, pa0, pa1, pa2, pa3); pv_one<1>(o[1], vb, pa0, pa1, pa2, pa3); pv_one<2>(o[2], vb, pa0, pa1, pa2, pa3); pv_one<3>(o[3], vb, pa0, pa1, pa2, pa3);
}

template <int OFF> __device__ __forceinline__ u32x4 rd128(int vb) { u32x4 r; asm volatile("ds_read_b128 %0, %1 offset:%2" : "=&v"(r) : "v"(vb), "i"(OFF) : "memory"); return r; }
#define PV_RD(D0) const u32x4 va##D0 = rd128<D0 * 2048>(vb), vc##D0 = rd128<D0 * 2048 + 1024>(vb); SBAR()
#define PV_MM(D0) do { asm volatile("s_waitcnt lgkmcnt(0)" ::: "memory"); SBAR(); \
    o[D0] = __builtin_amdgcn_mfma_scale_f32_32x32x64_f8f6f4((i32x8){(int)va##D0.x, (int)va##D0.y, (int)va##D0.z, (int)va##D0.w, (int)vc##D0.x, (int)vc##D0.y, (int)vc##D0.z, (int)vc##D0.w}, pb, o[D0], 0, 0, 0, 0, 0, 0); } while (0)
__device__ __forceinline__ float max3f(float a, float b, float c) { float r; asm("v_max3_f32 %0, %1, %2, %3" : "=v"(r) : "v"(a), "v"(b), "v"(c)); return r; }
#define PV_LSUM() lacc = __builtin_amdgcn_mfma_scale_f32_32x32x64_f8f6f4((i32x8){0x38383838, 0x38383838, 0x38383838, 0x38383838, 0x38383838, 0x38383838, 0x38383838, 0x38383838}, pb, lacc, 0, 0, 0, 0, 0, 0)
__device__ __forceinline__ void pv_psm(f32x16* o, f32x16& lacc, int vb, i32x8 pb, f32x16& p0, f32x16& p1, float& m_reg, f32x16& negm, float& alpha) {
  float pmax;
  { PV_RD(0);
    pmax = max3f(p0[0], p0[1], p0[2]);
#pragma unroll
    for (int r = 3; r < 15; r += 2) pmax = max3f(pmax, p0[r], p0[r + 1]);
    pmax = max3f(pmax, p0[15], p1[0]);
    SBAR(); PV_MM(0); }
  { PV_RD(1);
#pragma unroll
    for (int r = 1; r < 15; r += 2) pmax = max3f(pmax, p1[r], p1[r + 1]);
    pmax = max3f(pmax, p1[15], p1[15]);
    { auto rr = __builtin_amdgcn_permlane32_swap(__float_as_uint(pmax), __float_as_uint(pmax), false, false);
      pmax = max3f(__uint_as_float(rr[0]), __uint_as_float(rr[1]), __uint_as_float(rr[1])); }
    if (__builtin_expect(__all(pmax <= THR2), 1)) { alpha = 1.f; }
    else { const float dl = fmaxf(pmax - PBIAS, 0.f); alpha = __builtin_amdgcn_exp2f(-dl); m_reg += dl;
#pragma unroll
      for (int r = 0; r < 16; ++r) { p0[r] -= dl; p1[r] -= dl; }
#pragma unroll
      for (int r = 0; r < 16; ++r) negm[r] = -m_reg;
      asm volatile("" : "+v"(negm)); }
    SBAR(); PV_MM(1); }
  { PV_RD(2);
#pragma unroll
    for (int r = 0; r < 8; ++r) p0[r] = __builtin_amdgcn_exp2f(p0[r]);
    asm volatile("" : "+v"(p0));
    SBAR(); PV_MM(2); }
  { PV_RD(3);
#pragma unroll
    for (int r = 8; r < 16; ++r) p0[r] = __builtin_amdgcn_exp2f(p0[r]);
    asm volatile("" : "+v"(p0));
    SBAR(); PV_MM(3); PV_LSUM(); }
}
__device__ __forceinline__ void pvT_d0(f32x16* o, f32x16& lacc, int vb, i32x8 pb) {
  { PV_RD(0); PV_MM(0); } { PV_RD(1); PV_MM(1); } { PV_RD(2); PV_MM(2); } { PV_RD(3); PV_MM(3); PV_LSUM(); }
}
#undef PV_RD
#undef PV_MM
#undef PV_LSUM

__device__ __forceinline__ void attn_unit(const unsigned char* __restrict__ Qb, const unsigned char* __restrict__ Kh, const unsigned char* __restrict__ Vh, bf16_t* __restrict__ Ob,
                                          const float* __restrict__ gsub, const float lam, char* lds, const int wv) {
  typedef __attribute__((address_space(3))) unsigned* ldsu_t;
  const int tid = otid_w(wv), wid = wv, lane = tid & 63, r32 = lane & 31, hi = lane >> 5, mm = wid >> 2, wq = wid & 3;
  constexpr int NB = 4;
  constexpr int SHM_V8 = KVBLK * 128;
  char* V_lds = lds; char* K_lds = lds + NB * SHM_V8; constexpr int SHM_K8 = KVBLK * 128;
  float m_reg = 0.f; f32x16 o[4] = {}; f32x16 lacc = {}; i32x8 qf; f32x16 negm = {}; asm volatile("" : "+v"(negm));
  const unsigned koff = (unsigned)((2 * (wid >> 2) + (lane >> 5)) * 2048 + (lane & 3) * 512 + (8 * ((wid >> 1) & 1) + 2 * ((lane & 31) >> 3) + ((lane >> 2) & 1)) * 32 + (wid & 1) * 16);
  const unsigned voff = (unsigned)((wid >> 1) * 2048 + (lane & 7) * 256 + ((lane >> 3) & 3) * 64 + (wid & 1) * 32 + (lane >> 5) * 16);
#define DMA(t, buf) do { const char* kb_ = (const char*)(Kh + (size_t)(t) * SHM_K8); const char* vb_ = (const char*)(Vh + (size_t)(t) * SHM_V8); asm volatile("" : "+s"(kb_), "+s"(vb_)); \
    __builtin_amdgcn_global_load_lds((const unsigned*)(kb_ + koff), (ldsu_t)(K_lds + (buf) * SHM_K8 + wid * 1024), 16, 0, 0); \
    __builtin_amdgcn_global_load_lds((const unsigned*)(vb_ + voff), (ldsu_t)(V_lds + (buf) * SHM_V8 + wid * 1024), 16, 0, 0); } while (0)
#define WAIT_BAR(N) asm volatile("s_waitcnt vmcnt(" #N ") lgkmcnt(0)\n\ts_barrier" ::: "memory")
#define RESC(a) do { if (__any((a) < 1.f)) { _Pragma("unroll") for (int d = 0; d < 4; ++d) _Pragma("unroll") for (int r = 0; r < 16; ++r) o[d][r] *= (a); lacc[0] *= (a); } } while (0)
  DMA(0, 0); DMA(1, 1);
  { const unsigned char* Qw = Qb + (long)(wq * 32 + r32) * QKW + mm * 64 + hi * 32;
    const u32x4 q0 = *reinterpret_cast<const u32x4*>(Qw), q1 = *reinterpret_cast<const u32x4*>(Qw + 16);
    qf = (i32x8){(int)q0.x, (int)q0.y, (int)q0.z, (int)q0.w, (int)q1.x, (int)q1.y, (int)q1.z, (int)q1.w}; }
  const int vb0 = (int)(uintptr_t)V_lds + lane * 16;
  f32x16 pA0, pA1, pB0, pB1; float alA, alB; i32x8 pb; constexpr int NTL = KVLEN / KVBLK;
  WAIT_BAR(0);
  DMA(2, 2);
  qkt(pA0, pA1, K_lds, qf, lane, mm, negm); partialSM<true>(pA0, pA1, m_reg, negm, alA);
  WAIT_BAR(2);
  for (int j = 1; j + 1 < NTL; j += 2) {
    DMA(j + 2, (j + 2) & 3);
    SBAR(); qkt(pB0, pB1, K_lds + (j & 3) * SHM_K8, qf, lane, mm, negm);
    finishSM_T(pA0, pA1, pb); SBAR();
    pv_psm(o, lacc, vb0 + ((j - 1) & 3) * SHM_V8, pb, pB0, pB1, m_reg, negm, alB);
    RESC(alB);
    WAIT_BAR(2);
    if (j + 3 < NTL) DMA(j + 3, (j + 3) & 3);
    SBAR(); qkt(pA0, pA1, K_lds + ((j + 1) & 3) * SHM_K8, qf, lane, mm, negm);
    finishSM_T(pB0, pB1, pb); SBAR();
    pv_psm(o, lacc, vb0 + (j & 3) * SHM_V8, pb, pA0, pA1, m_reg, negm, alA);
    RESC(alA);
    if (j + 3 < NTL) WAIT_BAR(2); else WAIT_BAR(0);
  }
  SBAR(); qkt(pB0, pB1, K_lds + ((NTL - 1) & 3) * SHM_K8, qf, lane, mm, negm);
  finishSM_T(pA0, pA1, pb); SBAR();
  pv_psm(o, lacc, vb0 + ((NTL - 2) & 3) * SHM_V8, pb, pB0, pB1, m_reg, negm, alB);
  RESC(alB);
  finishSM_T(pB0, pB1, pb); SBAR();
  pvT_d0(o, lacc, vb0 + ((NTL - 1) & 3) * SHM_V8, pb);
#undef DMA
#undef WAIT_BAR
  const float rl = __builtin_amdgcn_rcpf(lacc[0]) * (mm ? lam : 1.0f);
  __syncthreads();
  constexpr int XS = 132;
  float* X = (float*)lds;
  if (mm == 1) {
#pragma unroll
    for (int r = 0; r < 16; ++r)
#pragma unroll
      for (int d0 = 0; d0 < 4; ++d0) X[(wq * 32 + r32) * XS + d0 * 32 + crow(r, hi)] = o[d0][r] * rl;
  }
  __syncthreads();
  if (mm == 0) {
#pragma unroll
    for (int r = 0; r < 16; ++r)
#pragma unroll
      for (int d0 = 0; d0 < 4; ++d0) { float* xp = X + (wq * 32 + r32) * XS + d0 * 32 + crow(r, hi); *xp = o[d0][r] * rl - *xp; }
  }
  __syncthreads();
  {
    const int row = tid >> 2, seg = tid & 3;
    const float* xr = X + row * XS + seg * 32;
    f32x4 v[8]; float ss = 0.f;
#pragma unroll
    for (int i = 0; i < 8; ++i) { v[i] = *(const f32x4*)(xr + 4 * i); ss += v[i][0] * v[i][0] + v[i][1] * v[i][1] + v[i][2] * v[i][2] + v[i][3] * v[i][3]; }
    ss += sx<1>(ss); ss += sx<2>(ss);
    const float rs = (1.0f - LAM_INIT) / sqrtf(ss * (1.0f / 128.0f) + EPS);
    bf16_t* dst = Ob + (long)row * D + seg * 32;
#pragma unroll
    for (int i = 0; i < 8; i += 2) {
      const f32x4 g0 = *(const f32x4*)(gsub + seg * 32 + 4 * i), g1 = *(const f32x4*)(gsub + seg * 32 + 4 * i + 4);
      u32x4 w; w.x = cvtpk(v[i][0] * rs * g0[0], v[i][1] * rs * g0[1]); w.y = cvtpk(v[i][2] * rs * g0[2], v[i][3] * rs * g0[3]);
      w.z = cvtpk(v[i + 1][0] * rs * g1[0], v[i + 1][1] * rs * g1[1]); w.w = cvtpk(v[i + 1][2] * rs * g1[2], v[i + 1][3] * rs * g1[3]);
      *(u32x4*)(dst + 4 * i) = w;
    }
  }
  __syncthreads();
#undef RESC
}
#undef KSWZ
#undef SBAR
}

__device__ __forceinline__ void ph_attn(const Params& p, unsigned char* smem) {
    unsigned char* ws = p.ws;
    const unsigned char* Q = ws + WS_Q; const unsigned char* Kb = ws + WS_K; const unsigned char* Vb = ws + WS_V;
    bf16_t* AO = (bf16_t*)(ws + WS_AO);
    const float lam = ((const float*)(ws + WS_CTL))[1024];
    const int c = blockIdx.x, G = gridDim.x;
    if (G == 256) {
        const int x = c & 7, s = c >> 3;
        for (int rd = 0; rd < 6; ++rd) {
            const int bh = rd * 4 + (x >> 1), qb = (x & 1) * 32 + s, b = bh / NH, h = bh % NH;
            fa::attn_unit(Q + ((size_t)b * SEQ + qb * 128) * QKW + h * 128, Kb + (size_t)(b * NH + h) * (KVLEN / 64) * 8192, Vb + (size_t)(b * NH + h) * (KVLEN / 64) * 8192,
                          AO + ((size_t)b * SEQ + qb * 128) * D + 256 + h * 128, p.in[I_GSUB], lam, (char*)smem, p.chunk);
        }
    } else {
        for (int u = c; u < BATCH * NH * 64; u += G) {
            const int bh = u >> 6, qb = u & 63, b = bh / NH, h = bh % NH;
            fa::attn_unit(Q + ((size_t)b * SEQ + qb * 128) * QKW + h * 128, Kb + (size_t)(b * NH + h) * (KVLEN / 64) * 8192, Vb + (size_t)(b * NH + h) * (KVLEN / 64) * 8192,
                          AO + ((size_t)b * SEQ + qb * 128) * D + 256 + h * 128, p.in[I_GSUB], lam, (char*)smem, p.chunk);
        }
    }
}

__device__ __forceinline__ void ph_fourierA(const Params& p, unsigned char* smem) {
    using namespace fa;
    unsigned char* ws = p.ws;
    const bf16_t* F = (const bf16_t*)(ws + WS_F); bf16_t* FY = (bf16_t*)(ws + WS_FY); const bf16_t* W = (const bf16_t*)(ws + WS_W128E);
    const int tid = otid(), wid = tid >> 6, lane = tid & 63, r32 = lane & 31, hi = lane >> 5;
    const int sr = tid >> 4, sc = (tid & 15) * 8, vst0 = v_st(sr, sc), vst1 = v_st(32 + sr, sc);
    const int vb0 = (int)(uintptr_t)smem + v_rd_base(lane);
    for (int task = blockIdx.x; task < BATCH * 64; task += gridDim.x) {
        const int b = task >> 6, n2 = task & 63;
        bf16x8 st[4][2];
#pragma unroll
        for (int kt = 0; kt < 2; ++kt)
#pragma unroll
            for (int ct = 0; ct < 2; ++ct) {
                st[kt * 2 + ct][0] = *(const bf16x8*)(F + ((size_t)b * SEQ + 64 * (64 * kt + sr) + n2) * 256 + 128 * ct + sc);
                st[kt * 2 + ct][1] = *(const bf16x8*)(F + ((size_t)b * SEQ + 64 * (64 * kt + 32 + sr) + n2) * 256 + 128 * ct + sc);
            }
        bf16x8 pa[2][4];
#pragma unroll
        for (int kt = 0; kt < 2; ++kt)
#pragma unroll
            for (int ks = 0; ks < 4; ++ks) pa[kt][ks] = *(const bf16x8*)(W + (size_t)(32 * wid + r32) * 128 + 64 * kt + 16 * ks + 8 * hi);
        __syncthreads();
#pragma unroll
        for (int q = 0; q < 4; ++q) { *(bf16x8*)(smem + q * 16384 + vst0) = st[q][0]; *(bf16x8*)(smem + q * 16384 + vst1) = st[q][1]; }
        __syncthreads();
        f32x16 o[2][4] = {};
#pragma unroll
        for (int ct = 0; ct < 2; ++ct)
#pragma unroll
            for (int kt = 0; kt < 2; ++kt) pv_d0(o[ct], vb0 + (kt * 2 + ct) * 16384, pa[kt][0], pa[kt][1], pa[kt][2], pa[kt][3]);
        const int plane = wid >> 2;
#pragma unroll
        for (int r = 0; r < 16; ++r) {
            const int k1 = 32 * (wid & 3) + crow(r, hi);
            bf16_t* dst = FY + ((((size_t)plane * BATCH + b) * 128 + k1) * 64 + n2) * 256 + r32;
#pragma unroll
            for (int ct = 0; ct < 2; ++ct)
#pragma unroll
                for (int d0 = 0; d0 < 4; ++d0) dst[128 * ct + 32 * d0] = f2bf(o[ct][d0][r]);
        }
    }
    __syncthreads();
}
__device__ __forceinline__ void ph_fourierB(const Params& p, unsigned char* smem) {
    using namespace fa;
    unsigned char* ws = p.ws;
    const bf16_t* FY = (const bf16_t*)(ws + WS_FY); const float2* tabw = (const float2*)(ws + WS_TABW);
    const bf16_t* M64 = (const bf16_t*)(ws + WS_M64E); const bf16_t* GT = (const bf16_t*)(ws + WS_GT);
    bf16_t* AO = (bf16_t*)(ws + WS_AO);
    const int tid = otid(), wid = tid >> 6, lane = tid & 63, r32 = lane & 31, hi = lane >> 5;
    const int sr = tid >> 4, sc = (tid & 15) * 8, vst0 = v_st(sr, sc), vst1 = v_st(32 + sr, sc);
    const int vb0 = (int)(uintptr_t)smem + v_rd_base(lane);
    constexpr int XRS = 528;
    unsigned char* XL = smem + 65536;
    const int mt = wid & 3, ctw = wid >> 2;
    for (int task = blockIdx.x; task < BATCH * 128; task += gridDim.x) {
        const int b = task >> 7, k1 = task & 127;
        __syncthreads();
#pragma unroll
        for (int ct = 0; ct < 2; ++ct)
#pragma unroll
            for (int rh = 0; rh < 2; ++rh) {
                const int n2 = sr + 32 * rh;
                const size_t off = ((((size_t)b) * 128 + k1) * 64 + n2) * 256 + 128 * ct + sc;
                const uint4 yr = *(const uint4*)(FY + off), yi = *(const uint4*)(FY + (size_t)BATCH * 128 * 64 * 256 + off);
                const float2 tw = tabw[n2 * k1];
                const unsigned yrw[4] = {yr.x, yr.y, yr.z, yr.w}, yiw[4] = {yi.x, yi.y, yi.z, yi.w};
                unsigned zr[4], zi[4];
#pragma unroll
                for (int q = 0; q < 4; ++q) {
                    const float a0 = __uint_as_float(yrw[q] << 16), a1 = __uint_as_float(yrw[q] & 0xffff0000u), b0 = __uint_as_float(yiw[q] << 16), b1 = __uint_as_float(yiw[q] & 0xffff0000u);
                    zr[q] = pk2(a0 * tw.x + b0 * tw.y, a1 * tw.x + b1 * tw.y); zi[q] = pk2(b0 * tw.x - a0 * tw.y, b1 * tw.x - a1 * tw.y);
                }
                const int vs = rh ? vst1 : vst0;
                *(uint4*)(smem + (0 * 2 + ct) * 16384 + vs) = make_uint4(zr[0], zr[1], zr[2], zr[3]);
                *(uint4*)(smem + (1 * 2 + ct) * 16384 + vs) = make_uint4(zi[0], zi[1], zi[2], zi[3]);
            }
        __syncthreads();
        {
            f32x16 o[4] = {};
#pragma unroll
            for (int kt = 0; kt < 2; ++kt) {
                bf16x8 pa[4];
#pragma unroll
                for (int ks = 0; ks < 4; ++ks) pa[ks] = *(const bf16x8*)(M64 + (size_t)(32 * mt + r32) * 128 + 64 * kt + 16 * ks + 8 * hi);
                pv_d0(o, vb0 + (kt * 2 + ctw) * 16384, pa[0], pa[1], pa[2], pa[3]);
            }
#pragma unroll
            for (int r = 0; r < 16; ++r) {
                const int ro = 32 * mt + crow(r, hi);
                bf16_t* xr = (bf16_t*)(XL + ((ro >> 6) * 64 + (ro & 63)) * XRS) + 128 * ctw + r32;
#pragma unroll
                for (int d0 = 0; d0 < 4; ++d0) xr[32 * d0] = f2bf(o[d0][r]);
            }
        }
        __syncthreads();
#pragma unroll
        for (int tt = 0; tt < 2; ++tt) {
            const int tau = 2 * wid + tt, g = tau >> 2, mt2 = (tau >> 1) & 1, nt2 = tau & 1;
            f32x16 acc = {};
#pragma unroll
            for (int ks8 = 0; ks8 < 8; ++ks8) {
                const int part = ks8 >> 2, cb = ks8 & 3;
                const bf16x8 af = *(const bf16x8*)(XL + (part * 64 + 32 * mt2 + r32) * XRS + (g * 64 + 16 * cb + 8 * hi) * 2);
                const bf16x8 bfr = *(const bf16x8*)(GT + ((size_t)g * 64 + 32 * nt2 + r32) * 128 + part * 64 + 16 * cb + 8 * hi);
                acc = __builtin_amdgcn_mfma_f32_32x32x16_bf16(af, bfr, acc, 0, 0, 0);
            }
#pragma unroll
            for (int r = 0; r < 16; ++r) { const int k2 = 32 * mt2 + crow(r, hi);
                AO[((size_t)b * SEQ + k1 + 128 * k2) * D + g * 64 + 32 * nt2 + r32] = f2bf(acc[r]); }
        }
    }
    __syncthreads();
}

__device__ __forceinline__ void ph_mid(const Params& p, unsigned char* smem) {
    typedef short bf16x8 __attribute__((ext_vector_type(8)));
    unsigned char* ws = p.ws;
    const int tid = otid(), wave = tid >> 6, lane = tid & 63, fr = lane & 15, fq = lane >> 4;
    const float* mod = (const float*)(ws + WS_MOD);
    const bf16_t* YX = (const bf16_t*)(ws + WS_YX);
    unsigned char* H2 = ws + WS_H2;
    unsigned* counts = (unsigned*)(ws + WS_CTL);
    int* TE = (int*)(ws + WS_TE); int* TP = (int*)(ws + WS_TP); float* TW = (float*)(ws + WS_TW); int* TOKL = (int*)(ws + WS_TOKL);
    constexpr int RS = 2064;
    unsigned char* Ahi = smem; unsigned char* Alo = smem + 16 * RS; float* Pp = (float*)(smem + 2 * 16 * RS + 512);
    const float rbias = p.in[I_RB][lane];
    int* lcnt = (int*)(smem + 99328); int* gb = lcnt + 64; int* PE = gb + 64; float* PW = (float*)(PE + 1024); float* PV = PW + 1024;
    for (int chunk = blockIdx.x; chunk < T / 128; chunk += gridDim.x) {
      const int mc = chunk * 128, b = mc >> 13;
      if (tid < 64) lcnt[tid] = 0;
      {
          const float* mrow_ = mod + b * 6144;
          for (int i = tid; i < 5 * 256; i += NT) { const int v_ = i >> 8, q_ = (i & 255) * 4;
              const float* s_ = (v_ == 0) ? p.in[I_GAPOST] + q_ : (v_ == 1) ? mrow_ + 2 * 1024 + q_ : (v_ == 2) ? p.in[I_GFPRE] + q_ : (v_ == 3) ? mrow_ + 3 * 1024 + q_ : mrow_ + 4 * 1024 + q_;
              *(f32x4*)(PV + v_ * 1024 + q_) = *(const f32x4*)s_; }
          __syncthreads();
      }
      uint2 yw[2][4]; f32x4 xv[2][4];
      bf16x8 wfr[4][4];
      { const bf16_t* wrt_ = (const bf16_t*)(ws + WS_WRT) + (size_t)p.chunk * 16 * 1024; asm volatile("" : "+s"(wrt_));
#pragma unroll
        for (int ks = 0; ks < 4; ++ks) {
#pragma unroll
          for (int nb = 0; nb < 4; ++nb) wfr[ks][nb] = *(const bf16x8*)(wrt_ + (size_t)((ks * 4 + nb) * 2 * 64 + lane) * 8);
          __builtin_amdgcn_sched_barrier(0); } }
#define MID_LOAD(m0_) do { _Pragma("unroll") for (int rr = 0; rr < 2; ++rr) { const int m_ = (m0_) + 2 * wave + rr; _Pragma("unroll") for (int j = 0; j < 4; ++j) { \
          yw[rr][j] = *(const uint2*)(YX + (size_t)m_ * D + 4 * (lane + 64 * j)); xv[rr][j] = ((const f32x4*)(p.in[I_X] + (size_t)m_ * D))[lane + 64 * j]; } } } while (0)
      MID_LOAD(mc);
#pragma unroll 1
      for (int it = 0; it < 8; ++it) {
        const int m0 = mc + it * 16;
        {
            float ss[2] = {0.f, 0.f};
#define YV(rr, j, i) ((i) == 0 ? __uint_as_float(yw[rr][j].x << 16) : (i) == 1 ? __uint_as_float(yw[rr][j].x & 0xffff0000u) : (i) == 2 ? __uint_as_float(yw[rr][j].y << 16) : __uint_as_float(yw[rr][j].y & 0xffff0000u))
#pragma unroll
            for (int rr = 0; rr < 2; ++rr) {
#pragma unroll
                for (int j = 0; j < 4; ++j) ss[rr] += YV(rr, j, 0) * YV(rr, j, 0) + YV(rr, j, 1) * YV(rr, j, 1) + YV(rr, j, 2) * YV(rr, j, 2) + YV(rr, j, 3) * YV(rr, j, 3);
                ss[rr] = wave_sum(ss[rr]);
            }
#pragma unroll
            for (int rr = 0; rr < 2; ++rr) {
                const int lr = 2 * wave + rr, m = m0 + lr;
                const float r1 = 1.0f / sqrtf(ss[rr] * (1.0f / D) + EPS);
                float ss2 = 0.f;
#pragma unroll
                for (int j = 0; j < 4; ++j) {
                    const int col = 4 * (lane + 64 * j);
                    const f32x4 gp = *(const f32x4*)(PV + col), gt = *(const f32x4*)(PV + 1024 + col);
#pragma unroll
                    for (int i = 0; i < 4; ++i) { xv[rr][j][i] = xv[rr][j][i] + gt[i] * (YV(rr, j, i) * r1 * gp[i]); ss2 += xv[rr][j][i] * xv[rr][j][i]; }
                    ((f32x4*)(p.out + (size_t)m * D))[lane + 64 * j] = xv[rr][j];
                }
                ss2 = wave_sum(ss2);
                const float r2 = 1.0f / sqrtf(ss2 * (1.0f / D) + EPS);
#pragma unroll
                for (int j = 0; j < 4; ++j) {
                    const int col = 4 * (lane + 64 * j);
                    const f32x4 gp = *(const f32x4*)(PV + 2048 + col), sh = *(const f32x4*)(PV + 3072 + col), sc = *(const f32x4*)(PV + 4096 + col);
                    float h[4];
#pragma unroll
                    for (int i = 0; i < 4; ++i) h[i] = xv[rr][j][i] * r2 * gp[i] * (1.f + sc[i]) + sh[i];
                    uint2 o; o.x = pk2(h[0], h[1]); o.y = pk2(h[2], h[3]);
                    { int w8 = __builtin_amdgcn_cvt_pk_fp8_f32(h[0], h[1], 0, false); w8 = __builtin_amdgcn_cvt_pk_fp8_f32(h[2], h[3], w8, true); *(int*)(H2 + (size_t)m * D + col) = w8; }
                    *(uint2*)(Ahi + lr * RS + col * 2) = o;
                }
            }
            if (it < 7) MID_LOAD(m0 + 16);
        }
        asm volatile("s_waitcnt lgkmcnt(0)\n\ts_barrier" ::: "memory");
        {
            f32x4 acc[4];
#pragma unroll
            for (int nb = 0; nb < 4; ++nb) acc[nb] = (f32x4){0.f, 0.f, 0.f, 0.f};
#pragma unroll
            for (int ks = 0; ks < 4; ++ks) {
                const int ko = (wave * 128 + ks * 32 + 8 * fq) * 2;
                const bf16x8 ah = *(const bf16x8*)(Ahi + fr * RS + ko);
#pragma unroll
                for (int nb = 0; nb < 4; ++nb) acc[nb] = __builtin_amdgcn_mfma_f32_16x16x32_bf16(ah, wfr[ks][nb], acc[nb], 0, 0, 0);
            }
#pragma unroll
            for (int nb = 0; nb < 4; ++nb)
#pragma unroll
                for (int j = 0; j < 4; ++j) Pp[(wave * 16 + 4 * fq + j) * 64 + 16 * nb + fr] = acc[nb][j];
        }
        asm volatile("s_waitcnt lgkmcnt(0)\n\ts_barrier" ::: "memory");
#pragma unroll
        for (int rr = 0; rr < 2; ++rr) {
            const int lr = 2 * wave + rr;
            float lg = 0.f;
#pragma unroll
            for (int w = 0; w < 8; ++w) lg += Pp[(w * 16 + lr) * 64 + lane];
            const float score = 1.0f / (1.0f + expf(-lg));
            const float sel = score + rbias;
            float t1 = sel, t2 = -INFINITY;
#define TOP2(M) do { const float o1 = sx<M>(t1), o2 = sx<M>(t2); const float n1 = fmaxf(t1, o1), n2 = fmaxf(fminf(t1, o1), fmaxf(t2, o2)); t1 = n1; t2 = n2; } while (0)
            TOP2(1); TOP2(2); TOP2(4);
#undef TOP2
            const float gs = t1 + t2; const int grp = lane >> 3;
            int gr = 0;
#pragma unroll
            for (int j = 0; j < 8; ++j) { const float sj = __uint_as_float(__builtin_amdgcn_readlane(__float_as_uint(gs), j * 8)); gr += (sj > gs || (sj == gs && j < grp)) ? 1 : 0; }
            const bool gsel = gr < 4;
            float v = gsel ? sel : -INFINITY;
            int rk = TOPK;
#pragma unroll
            for (int it8 = 0; it8 < TOPK; ++it8) {
                const float mx = wave_max(v);
                const unsigned long long eq = __ballot(v == mx);
                const int win = __builtin_ctzll(eq);
                if (lane == win) { rk = it8; v = -INFINITY; }
            }
            const bool chosen = rk < TOPK;
            const float ssum = wave_sum(chosen ? score : 0.f);
            const float w = score / (ssum + 1e-20f) * 2.5f;
            if (chosen) {
                const int lpos = atomicAdd(&lcnt[lane], 1);
                const int idx = (it * 16 + lr) * 8 + rk;
                PE[idx] = lane | (lpos << 8); PW[idx] = w;
            }
        }
      }
      __syncthreads();
      if (tid < 64) { const int c = lcnt[tid]; gb[tid] = c ? (int)atomicAdd(&counts[b * 65 + tid], (unsigned)c) : 0; }
      __syncthreads();
      for (int i = tid; i < 1024; i += NT) {
          const int pe = PE[i], e = pe & 255, pos = gb[e] + (pe >> 8), mk = mc * 8 + i;
          TOKL[((size_t)b * 64 + e) * 8192 + pos] = mk; TE[mk] = e; TP[mk] = pos; TW[mk] = PW[i];
      }
      __syncthreads();
    }
}

constexpr int T_CNT = 0;
constexpr int T_TOT = 256;
constexpr int T_AB = 328;
constexpr int T_OFF = 400;
constexpr int T_GUP = 660;
constexpr int T_YC = 730;
constexpr int T_YB = 990;
constexpr int T_DUP = 1250;
constexpr int T_UL = 1520;
constexpr int T_END = 1520 + 512;
__device__ __forceinline__ int scan_incl(int v, int lane) {
#pragma unroll
    for (int off = 1; off < 64; off <<= 1) { const int t = __builtin_amdgcn_ds_bpermute(((lane - off) & 63) << 2, v); if (lane >= off) v += t; }
    return v;
}
__device__ __forceinline__ void build_moe(const Params& p, int* tab) {
    const unsigned* counts = (const unsigned*)(p.ws + WS_CTL);
    __syncthreads();
    const int tid = otid(), wave = tid >> 6, lane = tid & 63;
    if (wave == 0) {
        const int c0 = (int)counts[0 * 65 + lane], c1 = (int)counts[1 * 65 + lane], c2 = (int)counts[2 * 65 + lane], c3 = (int)counts[3 * 65 + lane];
        tab[T_CNT + 0 * 64 + lane] = c0; tab[T_CNT + 1 * 64 + lane] = c1; tab[T_CNT + 2 * 64 + lane] = c2; tab[T_CNT + 3 * 64 + lane] = c3;
        tab[T_OFF + lane * 4 + 0] = 0; tab[T_OFF + lane * 4 + 1] = c0; tab[T_OFF + lane * 4 + 2] = c0 + c1; tab[T_OFF + lane * 4 + 3] = c0 + c1 + c2;
        const int tot = c0 + c1 + c2 + c3, pad = (tot + 255) & ~255, gu = ((tot + 255) >> 8) * 2;
        const int sp = scan_incl(pad, lane), sg = scan_incl(gu, lane);
        tab[T_TOT + lane] = tot; tab[T_AB + lane] = sp - pad; tab[T_GUP + lane] = sg - gu;
        const int cb[4] = {c0, c1, c2, c3};
#pragma unroll
        for (int b = 0; b < 4; ++b) {
            const int du = ((cb[b] + 255) >> 8) * 4;
            const int sy = scan_incl(cb[b], lane), sd = scan_incl(du, lane);
            tab[T_YB + 65 * b + lane] = sy - cb[b]; tab[T_DUP + 66 * b + lane] = sd - du;
            if (lane == 63) { tab[T_YB + 65 * b + 64] = sy; tab[T_DUP + 66 * b + 64] = sd; tab[T_DUP + 66 * b + 65] = sd + (SEQ / 256) * 4; }
        }
        if (lane == 63) { tab[T_TOT + 64] = T; tab[T_AB + 64] = sp; tab[T_GUP + 64] = sg; tab[T_GUP + 65] = sg + (T / 256) * 2; }
    }
    __syncthreads();
}

__device__ __forceinline__ void moe_decode(const GP_LAS int* tab, int e, int pos_e, int& b, int& pos) {
    const int o1 = tab[T_OFF + e * 4 + 1], o2 = tab[T_OFF + e * 4 + 2], o3 = tab[T_OFF + e * 4 + 3];
    b = (pos_e >= o1 ? 1 : 0) + (pos_e >= o2 ? 1 : 0) + (pos_e >= o3 ? 1 : 0);
    pos = pos_e - (b == 0 ? 0 : (b == 1 ? o1 : (b == 2 ? o2 : o3)));
}
__device__ __forceinline__ int yrow0(int b) { return b == 0 ? 2 * 1024 : (272 + 72 * (b - 1)) * 1024; }
struct MoeSched {
    const GP_LAS int* tab; int G, c, ntn, U, down, chunk; const int* TOKL; const char* Bt;
    __device__ __forceinline__ void prepare(int* tabw, int wv) const {
        if (wv == 0) {
            const int i = lane_id(); int L = i * G + c;
            if (L < U) {
                int bt = 0;
                if (down) {
#pragma unroll
                    for (int q = 0; q < 3; ++q) { const int u0 = tabw[T_DUP + 66 * bt + 65]; if (L >= u0) { L -= u0; ++bt; } } }
                const int pre = down ? T_DUP + 66 * bt : T_GUP;
                int lo = 0, hi = 64;
                while (lo < hi) { const int mid = (lo + hi + 1) >> 1; if (tabw[pre + mid] <= L) lo = mid; else hi = mid - 1; }
                const int loc = L - tabw[pre + lo];
                int cnt, base, bb;
                if (down) { cnt = (lo < 64) ? tabw[T_CNT + bt * 64 + (lo & 63)] : SEQ; base = tabw[T_YB + 65 * bt + lo] + yrow0(bt);
                            bb = tabw[T_AB + lo] + (lo < 64 ? tabw[T_OFF + (lo & 63) * 4 + bt] : bt * SEQ); }
                else { cnt = tabw[T_TOT + lo]; base = tabw[T_AB + lo]; bb = 0; }
                int* ul = tabw + T_UL + 8 * i;
                ul[0] = lo; ul[1] = loc / ntn; ul[2] = loc % ntn; ul[3] = cnt; ul[4] = base; ul[5] = bb;
            }
        }
        __syncthreads();
    }
    __device__ __forceinline__ bool next(int i, gp::Unit& u) const {
        if (i * G + c >= U) return false;
        const GP_LAS int* ul = tab + T_UL + 8 * i;
        u.e = __builtin_amdgcn_readfirstlane(ul[0]); u.pm = __builtin_amdgcn_readfirstlane(ul[1]); u.pn = __builtin_amdgcn_readfirstlane(ul[2]);
        u.cnt = __builtin_amdgcn_readfirstlane(ul[3]); u.base = __builtin_amdgcn_readfirstlane(ul[4]); u.b = __builtin_amdgcn_readfirstlane(ul[5]);
        return true;
    }
    __device__ __forceinline__ unsigned arow(const gp::Unit& u, int r) const {
        const int pos_e = u.pm * 256 + r;
        if (down) return (unsigned)(u.b + pos_e) * 256u;
        int tok;
        if (u.e < 64) { int b, pos; moe_decode(tab, u.e, pos_e, b, pos); tok = (pos_e < u.cnt) ? (TOKL[((size_t)b * 64 + u.e) * 8192 + pos] >> 3) : 0; } else tok = pos_e;
        return (unsigned)tok * 1024u;
    }
    __device__ __forceinline__ const char* bptr(const gp::Unit& u) const {
        return down ? Bt + ((size_t)u.e * 1024 + u.pn * 256) * 256 : Bt + ((size_t)u.e * 512 + u.pn * 256) * 1024;
    }
};
struct EpiGU {
    unsigned char* ACT; const int* TOKL; const float* TW; const GP_LAS int* tab;
    __device__ __forceinline__ void operator()(const f32x4 (&acc)[2][2][4][2], const gp::Unit& u, int wr, int wc, int fr, int fq) const {
#pragma unroll
        for (int ai = 0; ai < 2; ++ai)
#pragma unroll
            for (int m = 0; m < 4; ++m) {
                const int pos_e = u.pm * 256 + ai * 128 + wr * 64 + m * 16 + fr;
                if (pos_e < u.cnt) {
                    float a[8];
#pragma unroll
                    for (int n = 0; n < 2; ++n)
#pragma unroll
                        for (int i = 0; i < 4; ++i) { const float g = acc[ai][0][m][n][i] * (1.f / GUSCALE), up = acc[ai][1][m][n][i] * (1.f / GUSCALE);
                            a[4 * n + i] = __builtin_amdgcn_fmed3f(g * __builtin_amdgcn_rcpf(1.0f + __builtin_amdgcn_exp2f(-1.4426950408889634f * g)) * up * ASCALE, -448.f, 448.f); }
                    int w0 = __builtin_amdgcn_cvt_pk_fp8_f32(a[0], a[1], 0, false); w0 = __builtin_amdgcn_cvt_pk_fp8_f32(a[2], a[3], w0, true);
                    int w1 = __builtin_amdgcn_cvt_pk_fp8_f32(a[4], a[5], 0, false); w1 = __builtin_amdgcn_cvt_pk_fp8_f32(a[6], a[7], w1, true);
                    gp::gst2(ACT + ((size_t)u.base + pos_e) * DE + u.pn * 128 + wc * 32 + fq * 8, (unsigned)w0, (unsigned)w1);
                }
            }
    }
};
constexpr float YSCALE = 16.f;
struct EpiDown {
    unsigned char* ws;
    __device__ __forceinline__ void operator()(const f32x4 (&acc)[2][2][4][2], const gp::Unit& u, int wr, int wc, int fr, int fq) const {
#pragma unroll
        for (int ai = 0; ai < 2; ++ai)
#pragma unroll
            for (int m = 0; m < 4; ++m) {
                const int pos = u.pm * 256 + ai * 128 + wr * 64 + m * 16 + fr;
                {
                    unsigned char* rowp = ws + (size_t)((pos < u.cnt) ? (u.base + pos) : (489 * 1024 + fr)) * D + u.pn * 256 + wc * 64 + fq * 16;
                    gp::u32x4 o;
#pragma unroll
                    for (int bj = 0; bj < 2; ++bj) { const f32x4 v0 = acc[ai][bj][m][0] * (YSCALE / (WDSCALE * ASCALE)), v1 = acc[ai][bj][m][1] * (YSCALE / (WDSCALE * ASCALE));
                        int w0 = __builtin_amdgcn_cvt_pk_fp8_f32(v0[0], v0[1], 0, false); w0 = __builtin_amdgcn_cvt_pk_fp8_f32(v0[2], v0[3], w0, true);
                        int w1 = __builtin_amdgcn_cvt_pk_fp8_f32(v1[0], v1[1], 0, false); w1 = __builtin_amdgcn_cvt_pk_fp8_f32(v1[2], v1[3], w1, true);
                        if (bj == 0) { o.x = (unsigned)w0; o.y = (unsigned)w1; } else { o.z = (unsigned)w0; o.w = (unsigned)w1; } }
                    gp::gst4_nt(rowp, o);
                }
            }
    }
};
__device__ __forceinline__ void ph_moe_gu(const Params& p, unsigned char* smem) {
    unsigned char* ws = p.ws;
    int* tab = (int*)(smem + gp::STAGE_BYTES);
    build_moe(p, tab);
    MoeSched S; S.tab = (const GP_LAS int*)tab; S.G = gridDim.x; S.c = (gridDim.x % 8 == 0) ? (int)((blockIdx.x % 8) * (gridDim.x / 8) + blockIdx.x / 8) : (int)blockIdx.x;   S.ntn = 2; S.U = __builtin_amdgcn_readfirstlane(tab[T_GUP + 65]); S.down = 0; S.chunk = 0;
    S.TOKL = (const int*)(ws + WS_TOKL); S.Bt = (const char*)(ws + WS_WGUT);
    S.prepare(tab, p.chunk);
    EpiGU E{ws + WS_ACT, (const int*)(ws + WS_TOKL), (const float*)(ws + WS_TW), (const GP_LAS int*)tab};
    gp::gemm_phase<EpiGU, MoeSched, true, true>(p.chunk, (GP_LAS unsigned char*)smem, (const char*)(ws + WS_H2), D / 2, S, E);
}
__device__ __forceinline__ void ph_moe_down(const Params& p, unsigned char* smem, int c) {
    unsigned char* ws = p.ws;
    int* tab = (int*)(smem + gp::STAGE_BYTES);
    build_moe(p, tab);
    MoeSched S; S.tab = (const GP_LAS int*)tab; S.G = gridDim.x; S.c = (gridDim.x % 8 == 0) ? (int)((blockIdx.x % 8) * (gridDim.x / 8) + blockIdx.x / 8) : (int)blockIdx.x;   S.ntn = 4; S.U = __builtin_amdgcn_readfirstlane(tab[T_DUP + 65] + tab[T_DUP + 66 + 65] + tab[T_DUP + 132 + 65] + tab[T_DUP + 198 + 65]); S.down = 1; S.chunk = c;
    S.TOKL = nullptr; S.Bt = (const char*)(ws + WS_WDT);
    S.prepare(tab, p.chunk);
    EpiDown E{ws};
    gp::gemm_phase<EpiDown, MoeSched, false, true, 0>(p.chunk, (GP_LAS unsigned char*)smem, (const char*)(ws + WS_ACT), DE / 2, S, E);
}

__device__ __forceinline__ void ph_final(const Params& p, float* lds) {
    unsigned char* ws = p.ws;
    int* tab = (int*)lds;
    build_moe(p, tab);
    const int tid = otid(), wave = tid >> 6, lane = tid & 63;
    const int gw = blockIdx.x * NWV + wave, GW = gridDim.x * NWV;
    const int* TE = (const int*)(ws + WS_TE); const int* TP = (const int*)(ws + WS_TP); const float* TW = (const float*)(ws + WS_TW);
    const unsigned char* Y = ws;
    for (int m = gw; m < T; m += GW) {
        const int b = m >> 13, t = m & (SEQ - 1);
        const float* mod = (const float*)(ws + WS_MOD) + b * 6144 + 5 * 1024;
        float acc[16];
#pragma unroll
        for (int i = 0; i < 16; ++i) acc[i] = 0.f;
#pragma unroll
        for (int k = 0; k < 9; ++k) {
            int row; float wk = 1.f;
            if (k < 8) { const int e = TE[m * 8 + k]; row = tab[T_YB + 65 * b + e] + TP[m * 8 + k]; wk = TW[m * 8 + k]; }
            else row = tab[T_YB + 65 * b + 64] + t;
            row += yrow0(b);
            const unsigned char* yr = Y + (size_t)row * D;
#pragma unroll
            for (int j = 0; j < 4; ++j) { const int w = __builtin_nontemporal_load((const int*)(yr + 4 * (lane + 64 * j)));
                acc[4 * j] += wk * __builtin_amdgcn_cvt_f32_fp8(w, 0); acc[4 * j + 1] += wk * __builtin_amdgcn_cvt_f32_fp8(w, 1); acc[4 * j + 2] += wk * __builtin_amdgcn_cvt_f32_fp8(w, 2); acc[4 * j + 3] += wk * __builtin_amdgcn_cvt_f32_fp8(w, 3); }
        }
        float ss = 0.f;
#pragma unroll
        for (int i = 0; i < 16; ++i) { acc[i] *= (1.f / YSCALE); ss += acc[i] * acc[i]; }
        ss = wave_sum(ss);
        const float rs = 1.0f / sqrtf(ss * (1.0f / D) + EPS);
#pragma unroll
        for (int j = 0; j < 4; ++j) {
            const int col = 256 * j + 128 * ((lane >> 1) & 1) + 32 * (lane >> 4) + 8 * ((lane >> 2) & 3) + 4 * (lane & 1);
            const f32x4 gp = *(const f32x4*)(p.in[I_GFPOST] + col), gt = *(const f32x4*)(mod + col);
            f32x4 x1 = *(const f32x4*)(p.out + (size_t)m * D + col);
#pragma unroll
            for (int i = 0; i < 4; ++i) x1[i] += gt[i] * (acc[4 * j + i] * rs * gp[i]);
            __builtin_nontemporal_store(x1, (f32x4*)(p.out + (size_t)m * D + col));
        }
    }
}

#define GAS __attribute__((address_space(1)))
#define LAS __attribute__((address_space(3)))
#define XB_TMO      128
#define XB_XCNT(j)  (256  + 64 * (j))
#define XB_XSUB(j)  (1280 + 64 * (j))
#define XB_XGEN(j)  (2304 + 64 * (j))
#define XB_TOP      3328
#define XB_TOPGEN   3392
#define XCD_BAR_WORDS 3456
#define XB_SPIN_CAP (1u << 21)
__device__ __forceinline__ unsigned xb_ld(unsigned* p)              { return __hip_atomic_load(p, __ATOMIC_RELAXED, __HIP_MEMORY_SCOPE_AGENT); }
__device__ __forceinline__ unsigned xb_add(unsigned* p, unsigned v) { return __hip_atomic_fetch_add(p, v, __ATOMIC_RELAXED, __HIP_MEMORY_SCOPE_AGENT); }
__device__ __forceinline__ unsigned xb_xcc_id() { return (unsigned)__builtin_amdgcn_s_getreg((3 << 11) | 20) & 0xFu; }
#define XB_SPIN(cond, bar) do { unsigned _sp = 0; while (cond) { __builtin_amdgcn_s_sleep(1); \
    if ((++_sp & 255u) == 0u) { if (xb_ld(&(bar)[XB_TMO])) break; if (_sp > XB_SPIN_CAP) { atomicAdd(&(bar)[XB_TMO], 1u); break; } } } } while (0)
struct XcdBarrier { unsigned* bar; unsigned x; volatile LAS unsigned* st; };
__device__ __forceinline__ XcdBarrier xcd_barrier_post(unsigned* bar, volatile LAS unsigned* st, int wv) {
    XcdBarrier b; b.bar = bar; b.x = xb_xcc_id(); b.st = st;
    if (wv == 0 && lane_id() == 0) (void)xb_add(&bar[XB_XCNT(b.x)], 1u);
    return b;
}
__device__ __forceinline__ void xcd_barrier_complete(unsigned* bar, unsigned x, unsigned& nloc, unsigned& nx) {
    const unsigned G = gridDim.x * gridDim.y * gridDim.z;
    unsigned sum, cnt, mine, sp = 0u;
    for (;;) {
        sum = 0u; cnt = 0u; mine = 0u;
#pragma unroll
        for (unsigned j = 0; j < 16; ++j) { const unsigned c = xb_ld(&bar[XB_XCNT(j)]); sum += c; cnt += (c > 0u) ? 1u : 0u; mine = (j == x) ? c : mine; }
        if (sum == G) break;
        __builtin_amdgcn_s_sleep(1);
        if ((++sp & 255u) == 0u) { if (xb_ld(&bar[XB_TMO])) break; if (sp > XB_SPIN_CAP) { atomicAdd(&bar[XB_TMO], 1u); break; } }
    }
    nloc = mine > 0u ? mine : 1u; nx = cnt > 0u ? cnt : 1u;
}
__device__ __forceinline__ void xcd_barrier(const XcdBarrier& b, int wv) {
    asm volatile("s_waitcnt vmcnt(0)" ::: "memory");
    __syncthreads();
    if (wv == 0 && lane_id() == 0) {
        unsigned* bar = b.bar;
        __builtin_amdgcn_s_waitcnt(0);
        unsigned nloc = b.st[0], nx = b.st[1];
        if (nloc == 0u) { xcd_barrier_complete(bar, b.x, nloc, nx); b.st[0] = nloc; b.st[1] = nx; }
        const unsigned old = xb_add(&bar[XB_XSUB(b.x)], 1u);
        const unsigned gen = old / nloc;
        if (old + 1u == (gen + 1u) * nloc) {
            __builtin_amdgcn_fence(__ATOMIC_RELEASE, "agent");
            asm volatile("s_waitcnt vmcnt(0)" ::: "memory");
            const unsigned og = xb_add(&bar[XB_TOP], 1u);
            const unsigned tg = og / nx;
            if (og + 1u == (tg + 1u) * nx) xb_add(&bar[XB_TOPGEN], 1u);
            else XB_SPIN(xb_ld(&bar[XB_TOPGEN]) == tg, bar);
            __builtin_amdgcn_fence(__ATOMIC_ACQUIRE, "agent");
            xb_add(&bar[XB_XGEN(b.x)], 1u);
            asm volatile("s_waitcnt vmcnt(0)" ::: "memory");
        } else {
            XB_SPIN(xb_ld(&bar[XB_XGEN(b.x)]) == gen, bar);
            __builtin_amdgcn_fence(__ATOMIC_ACQUIRE, "agent");
            asm volatile("s_waitcnt vmcnt(0)" ::: "memory");
        }
    }
    __syncthreads();
}

namespace cg = cooperative_groups;
constexpr int LDS_BYTES = 144 * 1024;
typedef const __attribute__((address_space(4))) Params* KP;
__device__ __forceinline__ Params kargs() {
    Params p;
#if defined(__HIP_DEVICE_COMPILE__)
    typedef const __attribute__((address_space(4))) unsigned long long* KQ;
    KQ kq = (KQ)__builtin_amdgcn_kernarg_segment_ptr(); asm volatile("" : "+s"(kq));
    unsigned long long* d = (unsigned long long*)&p;
#pragma unroll
    for (int i = 0; i < (int)(sizeof(Params) / 8); ++i) d[i] = kq[i];
#endif
    return p;
}
#define PH(call) do { Params p = kargs(); p.chunk = wv; call; } while (0)
__global__ void __launch_bounds__(NT) mega_fwd(Params p_unused) {
    extern __shared__ __attribute__((aligned(16))) unsigned char smem[];
    float* lds = (float*)smem;
    volatile LAS unsigned* misc = (volatile LAS unsigned*)((LAS unsigned char*)smem + (LDS_BYTES - 64));
    if (threadIdx.x < 16) misc[threadIdx.x] = 0u;
    __syncthreads();
    unsigned* barw; { const Params p = kargs(); barw = (unsigned*)(p.ws + WS_CTL) + 4096; }
    const int wv = __builtin_amdgcn_readfirstlane(threadIdx.x >> 6);
    const XcdBarrier bar = xcd_barrier_post(barw, misc, wv);
#define SYNC() xcd_barrier(bar, wv)
    PH(ph_prep(p, lds));            SYNC();
    PH(ph_norm1(p)); PH(ph_prep_weights(p, lds, 0, 0));   SYNC();
    PH(ph_inproj(p, smem)); PH(ph_prep_weights(p, lds, 1, (MTOT / 256) * (INW / 256) % (int)gridDim.x));         SYNC();
    PH(ph_attn(p, smem)); PH(ph_fourierA(p, smem));  SYNC();
    PH(ph_fourierB(p, smem));       SYNC();
    PH(ph_outproj(p, smem));        SYNC();
    PH(ph_mid(p, smem));            SYNC();
    PH(ph_moe_gu(p, smem));         SYNC();
#pragma unroll 1
    PH(ph_moe_down(p, smem, 0));    SYNC();
    PH(ph_final(p, lds));
#undef SYNC
}

extern "C" void kernel_launch(void* const* d_in, const int* in_sizes, int n_in, void* d_out, int out_size, void* d_ws, size_t ws_size, hipStream_t stream) {
    if (n_in != 26 || ws_size < WS_END) { fprintf(stderr, "kernel_launch: unexpected n_in %d / ws %zu\n", n_in, ws_size); return; }
    static int grid_blocks = 0;
    if (!grid_blocks) {
        int dev = 0, cus = 0, per_cu = 0;
        (void)hipGetDevice(&dev);
        (void)hipDeviceGetAttribute(&cus, hipDeviceAttributeMultiprocessorCount, dev);
        (void)hipFuncSetAttribute((const void*)mega_fwd, hipFuncAttributeMaxDynamicSharedMemorySize, LDS_BYTES);
        (void)hipOccupancyMaxActiveBlocksPerMultiprocessor(&per_cu, (const void*)mega_fwd, NT, LDS_BYTES);
        if (per_cu < 1) { fprintf(stderr, "kernel_launch: occupancy query says %d blocks/CU\n", per_cu); per_cu = 1; }
        if (per_cu > 1) per_cu = 1;
        grid_blocks = cus * per_cu;
    }
    Params p{};
    for (int i = 0; i < 26; ++i) p.in[i] = (const float*)d_in[i];
    p.out = (float*)d_out; p.ws = (unsigned char*)d_ws; p.chunk = 0; p.pad = 0;
    (void)hipMemsetAsync((char*)d_ws + WS_CTL, 0, 32768, stream);
    void* args[] = {&p};
    hipError_t e = hipLaunchCooperativeKernel((const void*)mega_fwd, dim3(grid_blocks), dim3(NT), args, LDS_BYTES, stream);
    if (e != hipSuccess) fprintf(stderr, "cooperative launch failed: %s (grid %d)\n", hipGetErrorString(e), grid_blocks);
}
```

```cpp
#include <hip/hip_runtime.h>
#include <hip/hip_cooperative_groups.h>
#include <cstdio>
#include <cstdint>

typedef unsigned short bf16_t;
typedef float f32x4 __attribute__((ext_vector_type(4)));

constexpr int D = 1024, BATCH = 4, SEQ = 8192, T = BATCH * SEQ, CTX = 256, TC = BATCH * CTX;
constexpr int MTOT = T + TC;
constexpr int KVLEN = CTX + SEQ;
constexpr int INW = 2560, NH = 6, QKW = 768, FW = 256;
constexpr int NE = 64, DE = 256, TOPK = 8;
constexpr int NT = 512, NWV = 8;
constexpr int SLOTS_B = 90112;
constexpr float EPS = 1e-6f;
constexpr float LAM_INIT = 0.2f;
constexpr float QSCALE = 0.125f * 1.4426950408889634f;
constexpr float SQS = 0.42466090014400953f;

constexpr size_t MiB = 1u << 20;
constexpr size_t WS_CTL = 0;
constexpr size_t WS_MOD = 1 * MiB;
constexpr size_t WS_TABW = WS_MOD + 128 * 1024;
constexpr size_t WS_ROPE = WS_MOD + 192 * 1024;
constexpr size_t WS_GCS = WS_MOD + 256 * 1024;
constexpr size_t WS_W128E = WS_MOD + 768 * 1024;
constexpr size_t WS_M64E = WS_MOD + 832 * 1024;
constexpr size_t WS_GT = WS_MOD + 864 * 1024;
constexpr size_t WS_WRT = WS_MOD + 512 * 1024;
constexpr size_t WS_WINT = 2 * MiB;
constexpr size_t WS_WOUTT = 7 * MiB;
constexpr size_t WS_WGUT = 9 * MiB;
constexpr size_t WS_WDT = 74 * MiB;
constexpr size_t WS_TE = 107 * MiB;
constexpr size_t WS_TP = 108 * MiB;
constexpr size_t WS_TW = 109 * MiB;
constexpr size_t WS_TOKL = 110 * MiB;
constexpr size_t WS_AO = 118 * MiB;
constexpr size_t WS_ACT = 118 * MiB;
constexpr size_t WS_Q = 182 * MiB;
constexpr size_t WS_K = 230 * MiB;
constexpr size_t WS_V = WS_K + (size_t)BATCH * KVLEN * QKW * 2;
constexpr size_t WS_F = 329 * MiB;
constexpr size_t WS_FY = 361 * MiB;
constexpr size_t WS_HX = 425 * MiB;
constexpr size_t WS_YX = 358 * MiB;
constexpr size_t WS_H2 = 294 * MiB;
constexpr size_t WS_Y = 294 * MiB;
constexpr size_t WS_END = 491 * MiB;

struct Params {
    const float* in[26];
    float* out;
    unsigned char* ws;
    int chunk;
    int pad;
};
enum { I_X = 0, I_C, I_CTX, I_CCTX, I_WMOD, I_BMOD, I_GAPRE, I_GAPOST, I_WIN, I_WF, I_LQ1, I_LK1, I_LQ2, I_LK2, I_GSUB, I_WOUT,
       I_GFPRE, I_GFPOST, I_WR, I_RB, I_WG, I_WU, I_WD, I_WSG, I_WSU, I_WSD };

__device__ __forceinline__ float bf2f(bf16_t v) { return __uint_as_float(((unsigned)v) << 16); }
__device__ __forceinline__ bf16_t f2bf(float f) { unsigned u = __float_as_uint(f); return (bf16_t)((u + 0x7fffu + ((u >> 16) & 1u)) >> 16); }
__device__ __forceinline__ unsigned pk2(float lo, float hi) { return (unsigned)f2bf(lo) | ((unsigned)f2bf(hi) << 16); }
template <int M> __device__ __forceinline__ float sx(float v) { return __int_as_float(__builtin_amdgcn_ds_swizzle(__float_as_int(v), (M << 10) | 0x1f)); }
template <int M> __device__ __forceinline__ int sxi(int v) { return __builtin_amdgcn_ds_swizzle(v, (M << 10) | 0x1f); }
__device__ __forceinline__ float wave_sum(float v) {
    v += sx<1>(v); v += sx<2>(v); v += sx<4>(v); v += sx<8>(v); v += sx<16>(v);
    auto rr = __builtin_amdgcn_permlane32_swap(__float_as_uint(v), __float_as_uint(v), false, false);
    return __uint_as_float(rr[0]) + __uint_as_float(rr[1]);
}
__device__ __forceinline__ float dpp_f(float v, const int ctrl_sel) {
    const int x = __float_as_int(v); int r;
    if (ctrl_sel == 0) r = __builtin_amdgcn_update_dpp(x, x, 0xB1, 0xf, 0xf, false);
    else if (ctrl_sel == 1) r = __builtin_amdgcn_update_dpp(x, x, 0x4E, 0xf, 0xf, false);
    else if (ctrl_sel == 2) r = __builtin_amdgcn_update_dpp(x, x, 0x141, 0xf, 0xf, false);
    else r = __builtin_amdgcn_update_dpp(x, x, 0x140, 0xf, 0xf, false);
    return __int_as_float(r);
}
__device__ __forceinline__ float wave_max(float v) {
    v = fmaxf(v, dpp_f(v, 0)); v = fmaxf(v, dpp_f(v, 1)); v = fmaxf(v, dpp_f(v, 2)); v = fmaxf(v, dpp_f(v, 3));
    const float a = __uint_as_float(__builtin_amdgcn_readlane(__float_as_uint(v), 0)), b = __uint_as_float(__builtin_amdgcn_readlane(__float_as_uint(v), 16));
    const float c = __uint_as_float(__builtin_amdgcn_readlane(__float_as_uint(v), 32)), d = __uint_as_float(__builtin_amdgcn_readlane(__float_as_uint(v), 48));
    return fmaxf(fmaxf(a, b), fmaxf(c, d));
}
__device__ __forceinline__ int lane_id() { int l; asm volatile("v_mbcnt_lo_u32_b32 %0, -1, 0\n\tv_mbcnt_hi_u32_b32 %0, -1, %0" : "=v"(l)); return l; }
__device__ __forceinline__ int otid_w(int wv) { return wv * 64 + lane_id(); }
#define otid() otid_w(p.chunk)
__device__ __forceinline__ float silu_f(float x) { return x / (1.f + expf(-x)); }

__device__ __forceinline__ void ph_prep(const Params& p, float* lds) {
    const int tid = otid(), bid = blockIdx.x, nblk = gridDim.x;
    const bool split = nblk >= 192;
    const int gt = split ? (bid - 96) * NT + tid : bid * NT + tid, GT = split ? (nblk - 96) * NT : nblk * NT;
    const int gidx = gt;
    unsigned char* ws = p.ws;
    if (gt >= 0) {
    float2* tabw = (float2*)(ws + WS_TABW);
    for (int i = gt; i < 8192; i += GT) { float s, c; sincospif((float)i * (1.0f / 4096.0f), &s, &c); tabw[i] = make_float2(c, s); }
    float* rope = (float*)(ws + WS_ROPE);
    for (int i = gt; i < 192 * 16; i += GT) {
        const int pos = (i < 2048) ? (i >> 4) : ((i - 2048) >> 4); const int f = i & 15;
        const float inv = powf(10000.0f, -(float)(2 * f) / 32.0f); const float ang = (float)pos * inv;
        const float c = cosf(ang), s = sinf(ang);
        if (i < 2048) { rope[i] = c; rope[2048 + i] = s; } else { rope[4096 + (i - 2048)] = c; rope[4096 + 1024 + (i - 2048)] = s; }
    }
    { bf16_t* gt = (bf16_t*)(ws + WS_GT); const float* wf = p.in[I_WF];
      for (int i = gidx; i < 4 * 64 * 128; i += GT) {
        const int g = i >> 13, d = (i >> 7) & 63, part = (i >> 6) & 1, c = i & 63;
        float a = 0.f;
        for (int j = 0; j < 64; ++j) { float s, co; sincospif((float)((c * j) & 63) * (1.0f / 32.0f), &s, &co); a += (part ? s : co) * wf[(g * 64 + j) * 64 + d]; }
        gt[i] = f2bf(a * 0.0013810679320049757f);
      }
      bf16_t* w128 = (bf16_t*)(ws + WS_W128E);
      for (int i = gidx; i < 256 * 128; i += GT) { const int kk = i >> 7, n1 = i & 127; float s, co; sincospif((float)(((kk & 127) * n1) & 127) * (1.0f / 64.0f), &s, &co); w128[i] = f2bf(kk < 128 ? co : -s); }
      bf16_t* m64 = (bf16_t*)(ws + WS_M64E);
      for (int i = gidx; i < 128 * 128; i += GT) { const int ro = i >> 7, ci = i & 127, po = ro >> 6, k2 = ro & 63, pi = ci >> 6, n2 = ci & 63;
        float s, co; sincospif((float)((k2 * n2) & 63) * (1.0f / 32.0f), &s, &co); m64[i] = f2bf(po == pi ? co : (po == 0 ? s : -s)); }
    }
    {
      bf16_t* wrt = (bf16_t*)(ws + WS_WRT); const float* wr = p.in[I_WR];
      for (int i = gt; i < 64 * 1024; i += GT) {
        const int j = i & 7, ln = (i >> 3) & 63, nb = (i >> 9) & 3, ks = (i >> 11) & 3, wv_ = i >> 13;
        const int e = 16 * nb + (ln & 15), k = wv_ * 128 + ks * 32 + 8 * (ln >> 4) + j;
        const float w = wr[k * 64 + e]; const bf16_t h = f2bf(w);
        const int o = ((((wv_ * 4 + ks) * 4 + nb) * 2) * 64 + ln) * 8 + j;
        wrt[o] = h; wrt[o + 512] = f2bf(w - bf2f(h)); } }
    if (gt == 0) {
        float s1 = 0.f, s2 = 0.f;
        for (int i = 0; i < 64; ++i) { s1 += p.in[I_LQ1][i] * p.in[I_LK1][i]; s2 += p.in[I_LQ2][i] * p.in[I_LK2][i]; }
        ((float*)(ws + WS_CTL))[1024] = expf(s1) - expf(s2) + LAM_INIT;
    }
    }
    float* sc = lds;
    float* red = lds + 5 * 1024;
    for (int i = tid; i < 5 * 1024; i += NT) { const int r = i >> 10, k = i & 1023; const float v = (r < 4) ? p.in[I_C][r * 1024 + k] : p.in[I_CCTX][k]; sc[i] = silu_f(v); }
    __syncthreads();
    const int wave = tid >> 6, lane = tid & 63;
    float* mod = (float*)(ws + WS_MOD);
    for (int task = bid; task < 96; task += nblk) {
        const int col = task * 64 + lane;
        float a0 = 0, a1 = 0, a2 = 0, a3 = 0, a4 = 0;
        const float* wm = p.in[I_WMOD];
#pragma unroll 32
        for (int k = wave * 128; k < wave * 128 + 128; ++k) { const float w = wm[(size_t)k * 6144 + col]; a0 += sc[k] * w; a1 += sc[1024 + k] * w; a2 += sc[2048 + k] * w; a3 += sc[3072 + k] * w; a4 += sc[4096 + k] * w; }
        red[(wave * 5 + 0) * 64 + lane] = a0; red[(wave * 5 + 1) * 64 + lane] = a1; red[(wave * 5 + 2) * 64 + lane] = a2; red[(wave * 5 + 3) * 64 + lane] = a3; red[(wave * 5 + 4) * 64 + lane] = a4;
        __syncthreads();
        if (tid < 320) { const int r = tid >> 6, l = tid & 63; float s = 0.f; for (int w = 0; w < 8; ++w) s += red[(w * 5 + r) * 64 + l]; mod[r * 6144 + task * 64 + l] = s + p.in[I_BMOD][task * 64 + l]; }
        __syncthreads();
    }
}

__device__ __forceinline__ void ph_norm1(const Params& p) {
    const int tid = otid(), wave = tid >> 6, lane = tid & 63;
    const int gw = blockIdx.x * NWV + wave, GW = gridDim.x * NWV;
    const float* mod = (const float*)(p.ws + WS_MOD);
    bf16_t* hx = (bf16_t*)(p.ws + WS_HX);
    const float* g = p.in[I_GAPRE];
    for (int m = gw; m < MTOT; m += GW) {
        const float* src = (m < T) ? p.in[I_X] + (size_t)m * D : p.in[I_CTX] + (size_t)(m - T) * D;
        const int r = (m < T) ? (m >> 13) : 4;
        const float* shift = mod + r * 6144; const float* scale = shift + 1024;
        f32x4 v[4]; float ss = 0.f;
#pragma unroll
        for (int j = 0; j < 4; ++j) { v[j] = __builtin_nontemporal_load((const f32x4*)src + lane + 64 * j); ss += v[j][0] * v[j][0] + v[j][1] * v[j][1] + v[j][2] * v[j][2] + v[j][3] * v[j][3]; }
        ss = wave_sum(ss);
        const float rs = 1.0f / sqrtf(ss * (1.0f / D) + EPS);
#pragma unroll
        for (int j = 0; j < 4; ++j) {
            const int col = 4 * (lane + 64 * j);
            const f32x4 g4 = *(const f32x4*)(g + col), sc4 = *(const f32x4*)(scale + col), sh4 = *(const f32x4*)(shift + col);
            float h[4];
#pragma unroll
            for (int i = 0; i < 4; ++i) h[i] = v[j][i] * rs * g4[i] * (1.f + sc4[i]) + sh4[i];
            int w8 = __builtin_amdgcn_cvt_pk_fp8_f32(h[0], h[1], 0, false); w8 = __builtin_amdgcn_cvt_pk_fp8_f32(h[2], h[3], w8, true);
            *(int*)((unsigned char*)hx + (size_t)m * D + col) = w8;
        }
    }
}

namespace gp {
#define GP_LAS __attribute__((address_space(3)))
typedef short bf16x8 __attribute__((ext_vector_type(8)));
typedef unsigned u32x4 __attribute__((ext_vector_type(4)));
typedef int i32x4 __attribute__((ext_vector_type(4)));
constexpr int BM = 256, BK = 64, HALF = 128, HTB = HALF * BK * 2, STAGE_BYTES = 8 * HTB;
__device__ __forceinline__ int lds_byte(int r, int c) { const int st = (r >> 4) * 2 + (c >> 5), rr = r & 15, cc = c & 31, ob = rr * 64 + cc * 2; return st * 1024 + (ob ^ (((ob >> 9) & 1) << 5)); }
__device__ __forceinline__ void stage_rc(int b, int& R, int& C) { const int st = b / 1024, sb = b % 1024, swz = sb ^ (((sb >> 9) & 1) << 5); R = (st >> 1) * 16 + swz / 64; C = (st & 1) * 32 + (swz % 64) / 2; }
__device__ __forceinline__ int perm32(int rho) { const int n = rho >> 4, i = rho & 15; return 8 * (i >> 2) + 4 * n + (i & 3); }
struct Unit { int pm, pn, e, b, cnt, base; };
typedef unsigned u32x2 __attribute__((ext_vector_type(2)));
typedef float f32x4g __attribute__((ext_vector_type(4)));
#define GP_G1(T, ptr) ((__attribute__((address_space(1))) T*)(ptr))
__device__ __forceinline__ void gst4(void* p, u32x4 v) { *GP_G1(u32x4, p) = v; }
__device__ __forceinline__ void gst4_nt(void* p, u32x4 v) { __builtin_nontemporal_store(v, GP_G1(u32x4, p)); }
__device__ __forceinline__ void gst2(void* p, unsigned a, unsigned b) { *GP_G1(u32x2, p) = (u32x2){a, b}; }
__device__ __forceinline__ void gst1(void* p, unsigned a) { *GP_G1(unsigned, p) = a; }
__device__ __forceinline__ f32x4g gld4f(const void* p) { return *GP_G1(const f32x4g, p); }
__device__ __forceinline__ unsigned cvt_pk_bf16(float lo, float hi) { unsigned r; asm volatile("v_cvt_pk_bf16_f32 %0, %1, %2" : "=v"(r) : "v"(lo), "v"(hi)); return r; }

template <class Epi, class Sched, bool ALIGN_EPI, bool F8 = false, int EST = 0, bool DENSE_A = false>
__device__ __forceinline__ void gemm_phase(const int wv, GP_LAS unsigned char* lds, const char* Abase, const int K, const Sched& S, const Epi& E) {
    const int wid = wv, wr = wid >> 2, wc = wid & 3;
    const int nt = K / BK;
    unsigned voffB[2];
#pragma unroll
    for (int i = 0; i < 2; ++i) { int R, C; stage_rc(otid_w(wv) * 16 + i * 8192, R, C); const int Rb = (R & ~31) + perm32(R & 31); voffB[i] = (unsigned)(Rb * K + C) * 2u; }
#define GP_AOFFS(u, o00, o01, o10, o11) do { int R0, C0, R1, C1; const int t_ = otid_w(wv); stage_rc(t_ * 16, R0, C0); stage_rc(t_ * 16 + 8192, R1, C1); \
        o00 = S.arow(u, R0) + (unsigned)C0 * 2u; o01 = S.arow(u, R1) + (unsigned)C1 * 2u; o10 = S.arow(u, HALF + R0) + (unsigned)C0 * 2u; o11 = S.arow(u, HALF + R1) + (unsigned)C1 * 2u; } while (0)
    const size_t kstep = (size_t)(BK * 2);
    const size_t hstep = (size_t)HALF * K * 2;
    const unsigned ldsw = (unsigned)wid * 1024u;
    int aoff, boff; { const int l_ = lane_id(), fr = l_ & 15, fq = l_ >> 4; aoff = lds_byte(wr * 64 + fr, fq * 8); boff = lds_byte(wc * 32 + fr, fq * 8); }
#define GP_SA(b, h) (((b) * 2 + (h)) * HTB)
#define GP_SB(b, h) ((4 + (b) * 2 + (h)) * HTB)
#define GP_STAGE_B(bufoff, gbase) do { _Pragma("unroll") for (int _i = 0; _i < 2; ++_i) { unsigned vo_ = voffB[_i]; asm volatile("" : "+v"(vo_));        \
        __builtin_amdgcn_global_load_lds((const unsigned*)((const char*)(gbase) + vo_), (GP_LAS unsigned*)(lds + (bufoff) + ldsw + _i * 8192), 16, 0, 0); } } while (0)
#define GP_STAGE_A(bufoff, gbase, o0, o1) do { unsigned va0_ = (o0), va1_ = (o1); asm volatile("" : "+v"(va0_), "+v"(va1_)); \
        __builtin_amdgcn_global_load_lds((const unsigned*)((const char*)(gbase) + va0_), (GP_LAS unsigned*)(lds + (bufoff) + ldsw), 16, 0, 0); \
        __builtin_amdgcn_global_load_lds((const unsigned*)((const char*)(gbase) + va1_), (GP_LAS unsigned*)(lds + (bufoff) + ldsw + 8192), 16, 0, 0); } while (0)
#define GP_STAGE_AH(bufoff, gbase, h) do { if constexpr (DENSE_A) { const char* g_ = (const char*)(gbase) + ((h) ? hstep : (size_t)0); asm volatile("" : "+s"(g_)); GP_STAGE_A(bufoff, g_, ad0, ad1); } \
        else GP_STAGE_A(bufoff, gbase, (h) ? ac10 : ac00, (h) ? ac11 : ac01); } while (0)
#define GP_LDA(dst, b, h) do { _Pragma("unroll") for (int m = 0; m < 4; ++m) _Pragma("unroll") for (int k = 0; k < 2; ++k) dst[m][k] = *(const GP_LAS bf16x8*)(lds + GP_SA(b, h) + aoff + m * 2048 + k * 1024); } while (0)
#define GP_LDB(dst, b, h) do { _Pragma("unroll") for (int n = 0; n < 2; ++n) _Pragma("unroll") for (int k = 0; k < 2; ++k) dst[n][k] = *(const GP_LAS bf16x8*)(lds + GP_SB(b, h) + boff + n * 2048 + k * 1024); } while (0)
#define GP_CAT8(x) __builtin_shufflevector(__builtin_bit_cast(i32x4, x[0]), __builtin_bit_cast(i32x4, x[1]), 0, 1, 2, 3, 4, 5, 6, 7)
#define GP_MMA(ai, bj, At, Bt) do { __builtin_amdgcn_s_setprio(1); _Pragma("unroll") for (int m = 0; m < 4; ++m) _Pragma("unroll") for (int n = 0; n < 2; ++n) { \
        if constexpr (F8) acc[ai][bj][m][n] = __builtin_amdgcn_mfma_scale_f32_16x16x128_f8f6f4(GP_CAT8(Bt[n]), GP_CAT8(At[m]), acc[ai][bj][m][n], 0, 0, 0, 0, 0, 0); \
        else { _Pragma("unroll") for (int k = 0; k < 2; ++k) acc[ai][bj][m][n] = __builtin_amdgcn_mfma_f32_16x16x32_bf16(Bt[n][k], At[m][k], acc[ai][bj][m][n], 0, 0, 0); } } \
        __builtin_amdgcn_s_setprio(0); } while (0)
#define GP_WAIT_V(n) asm volatile("s_waitcnt vmcnt(" #n ")" ::: "memory")
#define GP_WAIT_L(n) asm volatile("s_waitcnt lgkmcnt(" #n ")" ::: "memory")
#define GP_BAR __builtin_amdgcn_s_barrier()
#define GP_SCHED __builtin_amdgcn_sched_barrier(0)
    Unit cur, nxt; int ui = 0;
    if (!S.next(0, cur)) return;
    f32x4 acc[2][2][4][2];
#pragma unroll
    for (int a = 0; a < 2; ++a)
#pragma unroll
        for (int b = 0; b < 2; ++b)
#pragma unroll
            for (int m = 0; m < 4; ++m)
#pragma unroll
                for (int n = 0; n < 2; ++n) acc[a][b][m][n] = (f32x4){0.f, 0.f, 0.f, 0.f};
    bf16x8 At[4][2], B0[2][2], B1[2][2];
    unsigned ac00 = 0, ac01 = 0, ac10 = 0, ac11 = 0, an00 = 0, an01 = 0, an10 = 0, an11 = 0;
    unsigned ad0 = 0, ad1 = 0;
    const char* cA = Abase; const char* nA = Abase;
    if constexpr (DENSE_A) { int R0, C0, R1, C1; const int t_ = otid_w(wv); stage_rc(t_ * 16, R0, C0); stage_rc(t_ * 16 + 8192, R1, C1);
        ad0 = (unsigned)(R0 * K + C0) * 2u; ad1 = (unsigned)(R1 * K + C1) * 2u; cA = Abase + S.abase(cur); }
    else GP_AOFFS(cur, ac00, ac01, ac10, ac11);
    const char* cB = S.bptr(cur);
    GP_STAGE_B(GP_SB(0, 0), cB); GP_STAGE_B(GP_SB(0, 1), cB + hstep); GP_STAGE_AH(GP_SA(0, 0), cA, 0); GP_STAGE_AH(GP_SA(0, 1), cA, 1);
    if (wr == 1) GP_BAR;
    GP_WAIT_V(2); GP_BAR;
    GP_STAGE_B(GP_SB(1, 0), cB + kstep); GP_STAGE_AH(GP_SA(1, 0), cA + kstep, 0); GP_STAGE_B(GP_SB(1, 1), cB + hstep + kstep);
    GP_WAIT_V(6); GP_BAR;
    for (;;) {
        const bool has_next = S.next(ui + 1, nxt);
        if constexpr (DENSE_A) nA = has_next ? Abase + S.abase(nxt) : cA;
        else { if (has_next) { GP_AOFFS(nxt, an00, an01, an10, an11); } else { an00 = ac00; an01 = ac01; an10 = ac10; an11 = ac11; } }
        const char* nB = has_next ? S.bptr(nxt) : cB;
#pragma unroll 1
        for (int t = 0; t < nt; t += 2) {
            const bool last = (t == nt - 2);
            const char* a1 = cA + (size_t)(t + 1) * kstep;
            const char* a2 = last ? nA : cA + (size_t)(t + 2) * kstep; const char* b2 = last ? nB : cB + (size_t)(t + 2) * kstep;
            const char* a3 = a2 + kstep; const char* b3 = b2 + kstep;
            asm volatile("" : "+s"(a1), "+s"(a2), "+s"(b2), "+s"(a3), "+s"(b3));
            GP_LDB(B0, 0, 0); GP_LDB(B1, 0, 1); GP_SCHED; GP_LDA(At, 0, 0); GP_STAGE_AH(GP_SA(1, 1), a1, 1);
            if constexpr (!DENSE_A) if (last) { ac00 = an00; ac01 = an01; ac10 = an10; ac11 = an11; }
            const bool relax = EST > 0 && ui > 0 && t == 0;
            if (relax) { static_assert(EST == 0 || EST == 16, "add a wait variant"); asm volatile("s_waitcnt vmcnt(24)" ::: "memory"); } else GP_WAIT_V(8);
            GP_WAIT_L(0); GP_BAR; GP_MMA(0, 0, At, B0); GP_MMA(0, 1, At, B1); GP_BAR; GP_SCHED;
            GP_LDA(At, 0, 1); GP_STAGE_B(GP_SB(0, 0), b2); GP_STAGE_B(GP_SB(0, 1), b2 + hstep); GP_STAGE_AH(GP_SA(0, 0), a2, 0);
            if (relax) asm volatile("s_waitcnt vmcnt(24)" ::: "memory"); else GP_WAIT_V(8);
            GP_WAIT_L(0); GP_BAR; GP_MMA(1, 0, At, B0); GP_MMA(1, 1, At, B1); GP_BAR; GP_SCHED;
            GP_LDB(B0, 1, 0); GP_LDB(B1, 1, 1); GP_SCHED; GP_LDA(At, 1, 0); GP_STAGE_AH(GP_SA(0, 1), a2, 1);
            GP_WAIT_V(8); GP_WAIT_L(0); GP_BAR; GP_MMA(0, 0, At, B0); GP_MMA(0, 1, At, B1); GP_BAR; GP_SCHED;
            GP_LDA(At, 1, 1); GP_STAGE_B(GP_SB(1, 0), b3); GP_STAGE_B(GP_SB(1, 1), b3 + hstep); GP_STAGE_AH(GP_SA(1, 0), a3, 0);
            GP_WAIT_V(8); GP_WAIT_L(0); GP_BAR; GP_MMA(1, 0, At, B0); GP_MMA(1, 1, At, B1); GP_BAR; GP_SCHED;
        }
        if constexpr (ALIGN_EPI) { if (wr == 0) GP_BAR; }
        { const int l_ = lane_id(); E(acc, cur, wr, wc, l_ & 15, l_ >> 4); }
        if (!has_next) break;
#pragma unroll
        for (int a = 0; a < 2; ++a)
#pragma unroll
            for (int b = 0; b < 2; ++b)
#pragma unroll
                for (int m = 0; m < 4; ++m)
#pragma unroll
                    for (int n = 0; n < 2; ++n) acc[a][b][m][n] = (f32x4){0.f, 0.f, 0.f, 0.f};
        cur = nxt; cB = nB; cA = nA; ++ui;
        if constexpr (ALIGN_EPI) { if (wr == 1) GP_BAR; }
    }
    GP_WAIT_V(0);
    if constexpr (!ALIGN_EPI) { if (wr == 0) GP_BAR; }
    GP_BAR;
#undef GP_AOFFS
#undef GP_SA
#undef GP_SB
#undef GP_STAGE_A
#undef GP_STAGE_AH
#undef GP_STAGE_B
#undef GP_LDA
#undef GP_LDB
#undef GP_MMA
#undef GP_CAT8
#undef GP_WAIT_V
#undef GP_WAIT_L
#undef GP_BAR
#undef GP_SCHED
}

struct DenseSched {
    int nM, nN, nwg, G, c, K; const char* Bt; int gs = 8;
    __device__ __forceinline__ void init(int M, int N, int K_, const void* Bt_, int G_, int c_) { nM = M / BM; nN = N / BM; nwg = nM * nN; G = G_; c = c_; K = K_; Bt = (const char*)Bt_; }
    __device__ __forceinline__ bool next(int i, Unit& u) const {
        const long L = (long)i * G + c; if (L >= nwg) return false;
        int wgid = (int)L; { const int q = nwg / 8, r = nwg % 8, xcd = wgid % 8, off = wgid / 8; wgid = (xcd < r ? xcd * (q + 1) : r * (q + 1) + (xcd - r) * q) + off; }
        const int nig = gs * nN, gid = wgid / nig, fm = gid * gs, gsz = (nM - fm) < gs ? (nM - fm) : gs;
        u.pm = fm + ((wgid % nig) % gsz); u.pn = (wgid % nig) / gsz; u.e = 0; u.b = 0; u.cnt = 0; u.base = 0; return true;
    }
    __device__ __forceinline__ unsigned arow(const Unit& u, int r) const { return (unsigned)(u.pm * BM + r) * (unsigned)(K * 2); }
    __device__ __forceinline__ size_t abase(const Unit& u) const { return (size_t)u.pm * BM * K * 2; }
    __device__ __forceinline__ const char* bptr(const Unit& u) const { return Bt + (size_t)u.pn * BM * K * 2; }
};
}

__device__ __forceinline__ int pk4f8(float a, float b, float c, float d) { int w; asm("v_cvt_pk_fp8_f32 %0, %1, %2" : "=v"(w) : "v"(a), "v"(b)); asm("v_cvt_pk_fp8_f32 %0, %1, %2 op_sel:[0,0,1]" : "+v"(w) : "v"(c), "v"(d)); return w; }
struct EpiInProj {
    bf16_t* F; bf16_t* Q; bf16_t* Kb; bf16_t* Vb; const float* rope;
    __device__ __forceinline__ void operator()(const f32x4 (&acc)[2][2][4][2], const gp::Unit& u, int wr, int wc, int fr, int fq) const {
        const int pn = u.pn, pm = u.pm; const bool isctx = pm >= T / 256;
        if (isctx && pn < 4) return;
        if (pn >= 7) {
            unsigned char* V8 = (unsigned char*)Vb;
#pragma unroll
            for (int ai = 0; ai < 2; ++ai) {
                const int row0 = pm * 256 + ai * 128 + wr * 64;
                int b, tile;
                if (!isctx) { b = row0 >> 13; tile = (CTX >> 6) + ((row0 & 8191) >> 6); } else { const int j = row0 - T; b = j >> 8; tile = (j & 255) >> 6; }
#pragma unroll
                for (int bj = 0; bj < 2; ++bj) {
                    const int head = (pn - 7) * 2 + bj;
                    unsigned char* dst = V8 + ((size_t)(b * NH + head) * (KVLEN / 64) + tile) * 8192 + wc * 2048 + fq * 64 + (fr >> 3) * 32 + (fr & 1) * 16 + ((fr >> 1) & 3) * 4;
#pragma unroll
                    for (int e = 0; e < 8; ++e) {
                        constexpr float IW = 1.f / 64.f;
                        const int w = pk4f8(acc[ai][bj][0][e >> 2][e & 3] * IW, acc[ai][bj][1][e >> 2][e & 3] * IW, acc[ai][bj][2][e >> 2][e & 3] * IW, acc[ai][bj][3][e >> 2][e & 3] * IW);
                        gp::gst1(dst + e * 256, (unsigned)w);
                    }
                }
            }
            return;
        }
        const int axis = wc & 1; const float* ct = rope + (axis ? 4096 : 0); const float* st = rope + (axis ? 4096 + 1024 : 2048);
#pragma unroll
        for (int ai = 0; ai < 2; ++ai)
#pragma unroll
            for (int m = 0; m < 4; ++m) {
                const int row = pm * 256 + ai * 128 + wr * 64 + m * 16 + fr;
                int t, kb, tile;
                if (!isctx) { kb = row >> 13; t = row & 8191; tile = (CTX >> 6) + (t >> 6); } else { const int j = row - T; t = 0; kb = j >> 8; tile = (j & 255) >> 6; }
                const int pos = axis ? (t & 63) : (t >> 6);
#pragma unroll
                for (int bj = 0; bj < 2; ++bj) {
                    const int col0 = pn * 256 + bj * 128 + wc * 32 + fq * 8;
                    f32x4 v0 = acc[ai][bj][m][0] * (1.f / 64.f), v1 = acc[ai][bj][m][1] * (1.f / 64.f);
                    if (pn == 0) { gp::u32x4 w; w.x = gp::cvt_pk_bf16(v0[0], v0[1]); w.y = gp::cvt_pk_bf16(v0[2], v0[3]); w.z = gp::cvt_pk_bf16(v1[0], v1[1]); w.w = gp::cvt_pk_bf16(v1[2], v1[3]);
                        gp::gst4(F + (size_t)row * 256 + col0, w); continue; }
                    if (pn < 7 && !isctx) {
                        const f32x4 c0 = gp::gld4f(ct + pos * 16 + 8 * (fq & 1)), c1 = gp::gld4f(ct + pos * 16 + 8 * (fq & 1) + 4);
                        const f32x4 s0 = gp::gld4f(st + pos * 16 + 8 * (fq & 1)), s1 = gp::gld4f(st + pos * 16 + 8 * (fq & 1) + 4);
                        const float sg = (fq < 2) ? -1.f : 1.f;
#pragma unroll
                        for (int i = 0; i < 4; ++i) {
                            const auto r0 = __builtin_amdgcn_permlane32_swap(__float_as_uint(v0[i]), __float_as_uint(v0[i]), false, false);
                            const auto r1 = __builtin_amdgcn_permlane32_swap(__float_as_uint(v1[i]), __float_as_uint(v1[i]), false, false);
                            const float p0 = __uint_as_float(fq < 2 ? r0[1] : r0[0]), p1 = __uint_as_float(fq < 2 ? r1[1] : r1[0]);
                            v0[i] = v0[i] * c0[i] + sg * p0 * s0[i]; v1[i] = v1[i] * c1[i] + sg * p1 * s1[i]; }
                    }
                    v0 = v0 * SQS; v1 = v1 * SQS;
                    const int w0 = pk4f8(v0[0], v0[1], v0[2], v0[3]), w1 = pk4f8(v1[0], v1[1], v1[2], v1[3]);
                    unsigned char* d;
                    if (pn < 4) d = (unsigned char*)Q + (size_t)row * QKW + (col0 - 256);
                    else d = (unsigned char*)Kb + ((size_t)(kb * NH + (pn - 4) * 2 + bj) * (KVLEN / 64) + tile) * 8192 + wc * 2048 + m * 512 + fr * 32 + fq * 8;
                    gp::gst2(d, (unsigned)w0, (unsigned)w1);
                }
            }
    }
};
struct EpiStoreBf16 {
    bf16_t* O; int ldc;
    __device__ __forceinline__ void operator()(const f32x4 (&acc)[2][2][4][2], const gp::Unit& u, int wr, int wc, int fr, int fq) const {
#pragma unroll
        for (int ai = 0; ai < 2; ++ai)
#pragma unroll
            for (int m = 0; m < 4; ++m) {
                bf16_t* rowp = O + (size_t)(u.pm * 256 + ai * 128 + wr * 64 + m * 16 + fr) * ldc + u.pn * 256 + wc * 32 + fq * 8;
#pragma unroll
                for (int bj = 0; bj < 2; ++bj) { const f32x4 v0 = acc[ai][bj][m][0] * (1.f / 64.f), v1 = acc[ai][bj][m][1] * (1.f / 64.f);
                    gp::u32x4 w; w.x = gp::cvt_pk_bf16(v0[0], v0[1]); w.y = gp::cvt_pk_bf16(v0[2], v0[3]); w.z = gp::cvt_pk_bf16(v1[0], v1[1]); w.w = gp::cvt_pk_bf16(v1[2], v1[3]);
                    gp::gst4(rowp + bj * 128, w); }
            }
    }
};

__device__ __forceinline__ void ph_inproj(const Params& p, unsigned char* smem) {
    unsigned char* ws = p.ws;
    gp::DenseSched S; S.init(MTOT, INW, D / 2, ws + WS_WINT, gridDim.x, blockIdx.x);
    S.gs = 4;
    EpiInProj E{(bf16_t*)(ws + WS_F), (bf16_t*)(ws + WS_Q), (bf16_t*)(ws + WS_K), (bf16_t*)(ws + WS_V), (const float*)(ws + WS_ROPE)};
    gp::gemm_phase<EpiInProj, gp::DenseSched, true, true, 0, true>(p.chunk, (GP_LAS unsigned char*)smem, (const char*)(ws + WS_HX), D / 2, S, E);
}
__device__ __forceinline__ void ph_outproj(const Params& p, unsigned char* smem) {
    unsigned char* ws = p.ws;
    gp::DenseSched S; S.init(T, D, D / 2, ws + WS_WOUTT, gridDim.x, blockIdx.x);
    EpiStoreBf16 E{(bf16_t*)(ws + WS_YX), D};
    gp::gemm_phase<EpiStoreBf16, gp::DenseSched, true, true, 0, true>(p.chunk, (GP_LAS unsigned char*)smem, (const char*)(ws + WS_AO), D / 2, S, E);
}

constexpr float GUSCALE = 64.f;
constexpr float WINSCALE = 64.f;
constexpr float WDSCALE = 16.f, ASCALE = 1.f;
struct TItem8 { const float* W; unsigned char* WT; int K, N, row_base, k0, n0; float sc; };
__device__ __forceinline__ void titem8_load(const TItem8& t, float (&tv)[32], int lane) {
#pragma unroll
    for (int i = 0; i < 32; ++i) tv[i] = __builtin_nontemporal_load(t.W + (size_t)(t.k0 + 2 * i + (lane >> 5)) * t.N + t.n0 + (lane & 31));
}
__device__ __forceinline__ void titem8_finish(const TItem8& t, const float (&tv)[32], float* scr, int lane) {
#pragma unroll
    for (int i = 0; i < 32; ++i) scr[(2 * i + (lane >> 5)) * 33 + (lane & 31)] = tv[i] * t.sc;
    asm volatile("s_waitcnt lgkmcnt(0)" ::: "memory");
    const int c = lane & 7;
#pragma unroll
    for (int j = 0; j < 4; ++j) { const int n = (lane >> 3) + 8 * j; const float* s = scr + (8 * c) * 33 + n;
        int w0 = __builtin_amdgcn_cvt_pk_fp8_f32(s[0 * 33], s[1 * 33], 0, false); w0 = __builtin_amdgcn_cvt_pk_fp8_f32(s[2 * 33], s[3 * 33], w0, true);
        int w1 = __builtin_amdgcn_cvt_pk_fp8_f32(s[4 * 33], s[5 * 33], 0, false); w1 = __builtin_amdgcn_cvt_pk_fp8_f32(s[6 * 33], s[7 * 33], w1, true);
        uint2 o; o.x = (unsigned)w0; o.y = (unsigned)w1;
        *(uint2*)(t.WT + (size_t)(t.row_base + t.n0 + n) * t.K + t.k0 + 8 * c) = o; }
    asm volatile("s_waitcnt lgkmcnt(0)" ::: "memory");
}
__device__ __forceinline__ void transpose_item(const float* W, int K, int N, bf16_t* WT, int row_base, int kb, int nb, float* scr, int lane) {
    const int k0 = 64 * kb, n0 = 32 * nb;
    float tv[32];
#pragma unroll
    for (int i = 0; i < 32; ++i) tv[i] = W[(size_t)(k0 + 2 * i + (lane >> 5)) * N + n0 + (lane & 31)];
#pragma unroll
    for (int i = 0; i < 32; ++i) scr[(2 * i + (lane >> 5)) * 33 + (lane & 31)] = tv[i];
    asm volatile("s_waitcnt lgkmcnt(0)" ::: "memory");
    const int c = lane & 7;
#pragma unroll
    for (int j = 0; j < 4; ++j) { const int n = (lane >> 3) + 8 * j; const float* s = scr + (8 * c) * 33 + n;
        uint4 o; o.x = pk2(s[0 * 33], s[1 * 33]); o.y = pk2(s[2 * 33], s[3 * 33]); o.z = pk2(s[4 * 33], s[5 * 33]); o.w = pk2(s[6 * 33], s[7 * 33]);
        *(uint4*)(WT + (size_t)(row_base + n0 + n) * K + k0 + 8 * c) = o; }
    asm volatile("s_waitcnt lgkmcnt(0)" ::: "memory");
}
__device__ __forceinline__ void ph_prep_weights(const Params& p, float* lds, const int part, const int first) {
    const int tid = otid(), wave = tid >> 6, lane = tid & 63;
    float* scr = lds + 8192 + wave * (64 * 33);
    if ((int)blockIdx.x < first) return;
    const int gw = ((int)blockIdx.x - first) * NWV + wave, GW = ((int)gridDim.x - first) * NWV;
    unsigned char* ws = p.ws;
    constexpr int I_IN = 16 * 80, I_OUT = 16 * 32, I_GU = 16 * 8, I_D = 4 * 32;
    constexpr int NITEMS = I_IN + I_OUT + 65 * (2 * I_GU + I_D);
    const int it_lo = part ? I_IN + I_OUT : 0, it_hi = part ? NITEMS : I_IN + I_OUT;
    if (part == 0) {
        for (int it = it_lo + gw; it < it_hi; it += GW) {
            int r = it;
            if (r < I_IN) { TItem8 t; t.W = p.in[I_WIN]; t.WT = ws + WS_WINT; t.K = D; t.N = INW; t.row_base = 0; t.k0 = 64 * (r / 80); t.n0 = 32 * (r % 80); t.sc = WINSCALE;
                float tv[32]; titem8_load(t, tv, lane); titem8_finish(t, tv, scr, lane); continue; } r -= I_IN;
            { TItem8 t; t.W = p.in[I_WOUT]; t.WT = ws + WS_WOUTT; t.K = D; t.N = D; t.row_base = 0; t.k0 = 64 * (r / 32); t.n0 = 32 * (r % 32); t.sc = WINSCALE;
              float tv[32]; titem8_load(t, tv, lane); titem8_finish(t, tv, scr, lane); }
        }
        return;
    }
    auto decode = [&](int it, TItem8& t) {
        int r = it - (I_IN + I_OUT);
        const int e = r / (2 * I_GU + I_D); r -= e * (2 * I_GU + I_D);
        if (r < 2 * I_GU) {
            const int half = r / I_GU, q = r % I_GU, kb = q / 8, nb = q % 8;
            t.W = (e < 64) ? p.in[half ? I_WU : I_WG] + (size_t)e * D * DE : p.in[half ? I_WSU : I_WSG];
            const int n0 = 32 * nb, drow = e * 512 + (n0 >> 7) * 256 + half * 128 + (n0 & 127);
            t.WT = ws + WS_WGUT; t.K = D; t.N = DE; t.row_base = drow - n0; t.k0 = 64 * kb; t.n0 = n0; t.sc = GUSCALE;
        } else {
            r -= 2 * I_GU;
            t.W = (e < 64) ? p.in[I_WD] + (size_t)e * DE * D : p.in[I_WSD];
            t.WT = ws + WS_WDT; t.K = DE; t.N = D; t.row_base = e * 1024; t.k0 = 64 * (r / 32); t.n0 = 32 * (r % 32); t.sc = WDSCALE;
        }
    };
    int it = it_lo + gw;
    if (it >= it_hi) return;
    TItem8 ta, tb; float va[32], vb[32];
    decode(it, ta); titem8_load(ta, va, lane);
    for (;;) {
        const bool hb = it + GW < it_hi;
        if (hb) { decode(it + GW, tb); titem8_load(tb, vb, lane); }
        titem8_finish(ta, va, scr, lane);
        if (!hb) break;
        const bool ha = it + 2 * GW < it_hi;
        if (ha) { decode(it + 2 * GW, ta); titem8_load(ta, va, lane); }
        titem8_finish(tb, vb, scr, lane);
        if (!ha) break;
        it += 2 * GW;
    }
}

namespace fa {
typedef short bf16x8 __attribute__((ext_vector_type(8)));
typedef short s16x4 __attribute__((ext_vector_type(4)));
typedef float f32x16 __attribute__((ext_vector_type(16)));
typedef unsigned u32x4 __attribute__((ext_vector_type(4)));
constexpr int KVBLK = 64, LDK = QKW;
constexpr float SCALE = 0.125f, THR = 8.f;
constexpr size_t SHM_V = KVBLK * 128 * 2, SHM_K = KVBLK * 128 * 2;
#define KSWZ(row, colB) ((row) * 256 + ((colB) ^ (((row) & 15) << 4)))
#define SBAR() __builtin_amdgcn_sched_barrier(0)
__device__ __forceinline__ int crow(int r, int hi) { return (r & 3) + 8 * (r >> 2) + 4 * hi; }
__device__ __forceinline__ unsigned cvtpk(float lo, float hi) { unsigned r; asm volatile("v_cvt_pk_bf16_f32 %0, %1, %2" : "=v"(r) : "v"(lo), "v"(hi)); return r; }
constexpr float PBIAS = 5.f, THR2 = PBIAS + 3.5f;
template <bool FIRST>
__device__ __forceinline__ void partialSM(f32x16& p0, f32x16& p1, float& m_reg, f32x16& negm, float& alpha) {
  float pmax = p0[0];
#pragma unroll
  for (int r = 1; r < 16; ++r) pmax = fmaxf(pmax, p0[r]);
#pragma unroll
  for (int r = 0; r < 16; ++r) pmax = fmaxf(pmax, p1[r]);
  { auto rr = __builtin_amdgcn_permlane32_swap(__float_as_uint(pmax), __float_as_uint(pmax), false, false);
    pmax = fmaxf(__uint_as_float(rr[0]), __uint_as_float(rr[1])); }
  if (!FIRST && __builtin_expect(__all(pmax <= THR2), 1)) { alpha = 1.f; }
  else { const float dl = FIRST ? pmax - PBIAS : fmaxf(pmax - PBIAS, 0.f); alpha = FIRST ? 0.f : __builtin_amdgcn_exp2f(-dl); m_reg += dl;
#pragma unroll
    for (int r = 0; r < 16; ++r) { p0[r] -= dl; p1[r] -= dl; }
#pragma unroll
    for (int r = 0; r < 16; ++r) negm[r] = -m_reg;
    asm volatile("" : "+v"(negm)); }
#pragma unroll
  for (int r = 0; r < 16; ++r) p0[r] = __builtin_amdgcn_exp2f(p0[r]);
}
typedef int i32x8 __attribute__((ext_vector_type(8)));
__device__ __forceinline__ int pk4_fp8(float a, float b, float c, float d) { int w; asm("v_cvt_pk_fp8_f32 %0, %1, %2" : "=v"(w) : "v"(a), "v"(b)); asm("v_cvt_pk_fp8_f32 %0, %1, %2 op_sel:[0,0,1]" : "+v"(w) : "v"(c), "v"(d)); return w; }
__device__ __forceinline__ void finishSM_T(f32x16& p0, f32x16& p1, i32x8& pb) {
#pragma unroll
  for (int r = 0; r < 16; ++r) p1[r] = __builtin_amdgcn_exp2f(p1[r]);
#pragma unroll
  for (int g = 0; g < 4; ++g) {
    pb[g] = pk4_fp8(p0[4 * g], p0[4 * g + 1], p0[4 * g + 2], p0[4 * g + 3]); pb[4 + g] = pk4_fp8(p1[4 * g], p1[4 * g + 1], p1[4 * g + 2], p1[4 * g + 3]); }
}
__device__ __forceinline__ void qkt(f32x16& p0, f32x16& p1, const char* Ks, const i32x8 qf, int lane, int mm, const f32x16& negm) {
  const char* kp = Ks + mm * 4096 + lane * 16;
  const u32x4 a0 = *reinterpret_cast<const u32x4*>(kp), a1 = *reinterpret_cast<const u32x4*>(kp + 1024), b0 = *reinterpret_cast<const u32x4*>(kp + 2048), b1 = *reinterpret_cast<const u32x4*>(kp + 3072);
  p0 = __builtin_amdgcn_mfma_scale_f32_32x32x64_f8f6f4((i32x8){(int)a0.x, (int)a0.y, (int)a0.z, (int)a0.w, (int)a1.x, (int)a1.y, (int)a1.z, (int)a1.w}, qf, negm, 0, 0, 0, 0, 0, 0);
  p1 = __builtin_amdgcn_mfma_scale_f32_32x32x64_f8f6f4((i32x8){(int)b0.x, (int)b0.y, (int)b0.z, (int)b0.w, (int)b1.x, (int)b1.y, (int)b1.z, (int)b1.w}, qf, negm, 0, 0, 0, 0, 0, 0);
}
__device__ __forceinline__ int v_st(int k, int c) { const int kk = (k & ~0xC) | ((k & 4) << 1) | ((k & 8) >> 1); return ((kk >> 3) * 4 + (c >> 5)) * 512 + ((kk & 7) * 32 + (c & 31)) * 2; }
__device__ __forceinline__ int v_rd_base(int lane) { return ((lane & 3) << 3) | (((lane >> 2) & 3) << 6) | (((lane >> 4) & 1) << 5) | (((lane >> 5) & 1) << 8); }
constexpr int v_rd_off(int d0, int ks, int half) { return d0 * 512 + ks * 4096 + half * 2048; }
template <int OFF> __device__ __forceinline__ s16x4 tr_read(int vb) {
  s16x4 r; asm volatile("ds_read_b64_tr_b16 %0, %1 offset:%2" : "=&v"(r) : "v"(vb), "i"(OFF) : "memory"); return r;
}
template <int D0> __device__ __forceinline__ void pv_one(f32x16& od, int vb, bf16x8 pa0, bf16x8 pa1, bf16x8 pa2, bf16x8 pa3) {
  const s16x4 l0 = tr_read<v_rd_off(D0, 0, 0)>(vb), h0 = tr_read<v_rd_off(D0, 0, 1)>(vb), l1 = tr_read<v_rd_off(D0, 1, 0)>(vb), h1 = tr_read<v_rd_off(D0, 1, 1)>(vb);
  const s16x4 l2 = tr_read<v_rd_off(D0, 2, 0)>(vb), h2 = tr_read<v_rd_off(D0, 2, 1)>(vb), l3 = tr_read<v_rd_off(D0, 3, 0)>(vb), h3 = tr_read<v_rd_off(D0, 3, 1)>(vb);
  asm volatile("s_waitcnt lgkmcnt(0)" ::: "memory"); SBAR();
#define PK(L, H) (bf16x8){L[0], L[1], L[2], L[3], H[0], H[1], H[2], H[3]}
  od = __builtin_amdgcn_mfma_f32_32x32x16_bf16(pa0, PK(l0, h0), od, 0, 0, 0);
  od = __builtin_amdgcn_mfma_f32_32x32x16_bf16(pa1, PK(l1, h1), od, 0, 0, 0);
  od = __builtin_amdgcn_mfma_f32_32x32x16_bf16(pa2, PK(l2, h2), od, 0, 0, 0);
  od = __builtin_amdgcn_mfma_f32_32x32x16_bf16(pa3, PK(l3, h3), od, 0, 0, 0);
#undef PK
}
__device__ __forceinline__ void pv_d0(f32x16* o, int vb, bf16x8 pa0, bf16x8 pa1, bf16x8 pa2, bf16x8 pa3) {
  pv_one<0>(o[0], vb, pa0, pa1, pa2, pa3); pv_one<1>(o[1], vb, pa0, pa1, pa2, pa3); pv_one<2>(o[2], vb, pa0, pa1, pa2, pa3); pv_one<3>(o[3], vb, pa0, pa1, pa2, pa3);
}

template <int OFF> __device__ __forceinline__ u32x4 rd128(int vb) { u32x4 r; asm volatile("ds_read_b128 %0, %1 offset:%2" : "=&v"(r) : "v"(vb), "i"(OFF) : "memory"); return r; }
#define PV_RD(D0) const u32x4 va##D0 = rd128<D0 * 2048>(vb), vc##D0 = rd128<D0 * 2048 + 1024>(vb); SBAR()
#define PV_MM(D0) do { asm volatile("s_waitcnt lgkmcnt(0)" ::: "memory"); SBAR(); \
    o[D0] = __builtin_amdgcn_mfma_scale_f32_32x32x64_f8f6f4((i32x8){(int)va##D0.x, (int)va##D0.y, (int)va##D0.z, (int)va##D0.w, (int)vc##D0.x, (int)vc##D0.y, (int)vc##D0.z, (int)vc##D0.w}, pb, o[D0], 0, 0, 0, 0, 0, 0); } while (0)
__device__ __forceinline__ float max3f(float a, float b, float c) { float r; asm("v_max3_f32 %0, %1, %2, %3" : "=v"(r) : "v"(a), "v"(b), "v"(c)); return r; }
typedef float f32x4a __attribute__((ext_vector_type(4)));
#define PV_LSUM() lacc = __builtin_amdgcn_mfma_scale_f32_16x16x128_f8f6f4(onesA, pb, lacc, 0, 0, 0, 0, 0, 0)
__device__ __forceinline__ void pv_psm(f32x16* o, f32x4a& lacc, const i32x8 onesA, int vb, i32x8 pb, f32x16& p0, f32x16& p1, float& m_reg, f32x16& negm, float& alpha) {
  float pmax;
  { PV_RD(0);
    pmax = max3f(p0[0], p0[1], p0[2]);
#pragma unroll
    for (int r = 3; r < 15; r += 2) pmax = max3f(pmax, p0[r], p0[r + 1]);
    pmax = max3f(pmax, p0[15], p1[0]);
    SBAR(); PV_MM(0); }
  { PV_RD(1);
#pragma unroll
    for (int r = 1; r < 15; r += 2) pmax = max3f(pmax, p1[r], p1[r + 1]);
    pmax = max3f(pmax, p1[15], p1[15]);
    { auto rr = __builtin_amdgcn_permlane32_swap(__float_as_uint(pmax), __float_as_uint(pmax), false, false);
      pmax = max3f(__uint_as_float(rr[0]), __uint_as_float(rr[1]), __uint_as_float(rr[1])); }
    if (__builtin_expect(__all(pmax <= THR2), 1)) { alpha = 1.f; }
    else { const float dl = fmaxf(pmax - PBIAS, 0.f); alpha = __builtin_amdgcn_exp2f(-dl); m_reg += dl;
#pragma unroll
      for (int r = 0; r < 16; ++r) { p0[r] -= dl; p1[r] -= dl; }
#pragma unroll
      for (int r = 0; r < 16; ++r) negm[r] = -m_reg;
      asm volatile("" : "+v"(negm)); }
    SBAR(); PV_MM(1); }
  { PV_RD(2);
#pragma unroll
    for (int r = 0; r < 8; ++r) p0[r] = __builtin_amdgcn_exp2f(p0[r]);
    asm volatile("" : "+v"(p0));
    SBAR(); PV_MM(2); }
  { PV_RD(3);
#pragma unroll
    for (int r = 8; r < 16; ++r) p0[r] = __builtin_amdgcn_exp2f(p0[r]);
    asm volatile("" : "+v"(p0));
    SBAR(); PV_MM(3); PV_LSUM(); }
}
__device__ __forceinline__ void pvT_d0(f32x16* o, f32x4a& lacc, const i32x8 onesA, int vb, i32x8 pb) {
  { PV_RD(0); PV_MM(0); } { PV_RD(1); PV_MM(1); } { PV_RD(2); PV_MM(2); } { PV_RD(3); PV_MM(3); PV_LSUM(); }
}
#undef PV_RD
#undef PV_MM
#undef PV_LSUM

__device__ __forceinline__ void tile_step(f32x16* o, f32x4a& lacc, const i32x8 onesA, const int kaddr, const int vb, const i32x8 qf,
                                          f32x16& pn0, f32x16& pn1, f32x16& pc0, f32x16& pc1, float& m_reg, f32x16& negm, float& alpha) {
#define F8MM(A0, A1, B, C) __builtin_amdgcn_mfma_scale_f32_32x32x64_f8f6f4((i32x8){(int)A0.x, (int)A0.y, (int)A0.z, (int)A0.w, (int)A1.x, (int)A1.y, (int)A1.z, (int)A1.w}, B, C, 0, 0, 0, 0, 0, 0)
#define LGKM(N) asm volatile("s_waitcnt lgkmcnt(" #N ")" ::: "memory")
  const u32x4 ka0 = rd128<0>(kaddr), ka1 = rd128<1024>(kaddr), kb0 = rd128<2048>(kaddr), kb1 = rd128<3072>(kaddr);
  const u32x4 va0 = rd128<0>(vb), vc0 = rd128<1024>(vb); SBAR();
#pragma unroll
  for (int r = 0; r < 8; ++r) pc1[r] = __builtin_amdgcn_exp2f(pc1[r]);
  asm volatile("" : "+v"(pc1)); SBAR();
  LGKM(2); SBAR();
  pn0 = F8MM(ka0, ka1, qf, negm); SBAR();
#pragma unroll
  for (int r = 8; r < 16; ++r) pc1[r] = __builtin_amdgcn_exp2f(pc1[r]);
  asm volatile("" : "+v"(pc1)); SBAR();
  pn1 = F8MM(kb0, kb1, qf, negm); SBAR();
  i32x8 pb;
#pragma unroll
  for (int g = 0; g < 4; ++g) { pb[g] = pk4_fp8(pc0[4 * g], pc0[4 * g + 1], pc0[4 * g + 2], pc0[4 * g + 3]); pb[4 + g] = pk4_fp8(pc1[4 * g], pc1[4 * g + 1], pc1[4 * g + 2], pc1[4 * g + 3]); }
  asm volatile("" : "+v"(pb)); SBAR();
  LGKM(0); SBAR();
  o[0] = F8MM(va0, vc0, pb, o[0]); SBAR();
  const u32x4 va1 = rd128<2048>(vb), vc1 = rd128<2048 + 1024>(vb); SBAR();
  float pmax;
  asm("v_max3_f32 %0, %1, %2, %3\n\tv_max3_f32 %0, %0, %4, %5\n\tv_max3_f32 %0, %0, %6, %7\n\tv_max3_f32 %0, %0, %8, %9\n\tv_max3_f32 %0, %0, %10, %11\n\tv_max3_f32 %0, %0, %12, %13\n\tv_max3_f32 %0, %0, %14, %15\n\tv_max3_f32 %0, %0, %16, %17"
      : "=&v"(pmax) : "v"(pn0[0]), "v"(pn0[1]), "v"(pn0[2]), "v"(pn0[3]), "v"(pn0[4]), "v"(pn0[5]), "v"(pn0[6]), "v"(pn0[7]), "v"(pn0[8]), "v"(pn0[9]), "v"(pn0[10]), "v"(pn0[11]), "v"(pn0[12]), "v"(pn0[13]), "v"(pn0[14]), "v"(pn0[15]), "v"(pn1[0]));
  SBAR(); LGKM(0); SBAR();
  o[1] = F8MM(va1, vc1, pb, o[1]); SBAR();
  const u32x4 va2 = rd128<4096>(vb), vc2 = rd128<4096 + 1024>(vb); SBAR();
  asm("v_max3_f32 %0, %0, %1, %2\n\tv_max3_f32 %0, %0, %3, %4\n\tv_max3_f32 %0, %0, %5, %6\n\tv_max3_f32 %0, %0, %7, %8\n\tv_max3_f32 %0, %0, %9, %10\n\tv_max3_f32 %0, %0, %11, %12\n\tv_max3_f32 %0, %0, %13, %14\n\tv_max_f32 %0, %0, %15"
      : "+v"(pmax) : "v"(pn1[1]), "v"(pn1[2]), "v"(pn1[3]), "v"(pn1[4]), "v"(pn1[5]), "v"(pn1[6]), "v"(pn1[7]), "v"(pn1[8]), "v"(pn1[9]), "v"(pn1[10]), "v"(pn1[11]), "v"(pn1[12]), "v"(pn1[13]), "v"(pn1[14]), "v"(pn1[15]));
  { auto rr = __builtin_amdgcn_permlane32_swap(__float_as_uint(pmax), __float_as_uint(pmax), false, false);
    pmax = fmaxf(__uint_as_float(rr[0]), __uint_as_float(rr[1])); }
  if (__builtin_expect(__all(pmax <= THR2), 1)) { alpha = 1.f; }
  else { const float dl = fmaxf(pmax - PBIAS, 0.f); alpha = __builtin_amdgcn_exp2f(-dl); m_reg += dl;
#pragma unroll
    for (int r = 0; r < 16; ++r) { pn0[r] -= dl; pn1[r] -= dl; }
#pragma unroll
    for (int r = 0; r < 16; ++r) negm[r] = -m_reg;
    asm volatile("" : "+v"(negm)); }
  SBAR(); LGKM(0); SBAR();
  o[2] = F8MM(va2, vc2, pb, o[2]); SBAR();
  const u32x4 va3 = rd128<6144>(vb), vc3 = rd128<6144 + 1024>(vb); SBAR();
#pragma unroll
  for (int r = 0; r < 8; ++r) pn0[r] = __builtin_amdgcn_exp2f(pn0[r]);
  asm volatile("" : "+v"(pn0)); SBAR();
  LGKM(0); SBAR();
  o[3] = F8MM(va3, vc3, pb, o[3]); SBAR();
#pragma unroll
  for (int r = 8; r < 16; ++r) pn0[r] = __builtin_amdgcn_exp2f(pn0[r]);
  asm volatile("" : "+v"(pn0)); SBAR();
  lacc = __builtin_amdgcn_mfma_scale_f32_16x16x128_f8f6f4(onesA, pb, lacc, 0, 0, 0, 0, 0, 0); SBAR();
#undef F8MM
#undef LGKM
}

__device__ __forceinline__ void attn_unit(const unsigned char* __restrict__ Qb, const unsigned char* __restrict__ Kh, const unsigned char* __restrict__ Vh, bf16_t* __restrict__ Ob,
                                          const float* __restrict__ gsub, const float lam, char* lds, const int wv,
                                          const unsigned char* __restrict__ Qn, const unsigned char* __restrict__ Kn, const unsigned char* __restrict__ Vn, const bool first, const bool has_next, i32x8& qcarry) {
  typedef __attribute__((address_space(3))) unsigned* ldsu_t;
  const int tid = otid_w(wv), wid = wv, lane = tid & 63, r32 = lane & 31, hi = lane >> 5, mm = wid >> 2, wq = wid & 3;
  constexpr int NB = 4;
  constexpr int SHM_V8 = KVBLK * 128;
  char* V_lds = lds; char* K_lds = lds + NB * SHM_V8; constexpr int SHM_K8 = KVBLK * 128;
  float m_reg = 0.f; f32x16 o[4] = {}; f32x4a lacc = {}; i32x8 qf;
  const int ov_ = (lane == 0 || lane == 32 || lane == 17 || lane == 49) ? 0x38383838 : 0;
  const i32x8 onesA = {ov_, ov_, ov_, ov_, ov_, ov_, ov_, ov_}; f32x16 negm = {}; asm volatile("" : "+v"(negm));
  const unsigned koff = (unsigned)((2 * (wid >> 2) + (lane >> 5)) * 2048 + (lane & 3) * 512 + (8 * ((wid >> 1) & 1) + 2 * ((lane & 31) >> 3) + ((lane >> 2) & 1)) * 32 + (wid & 1) * 16);
  const unsigned voff = (unsigned)((wid >> 1) * 2048 + (lane & 7) * 256 + ((lane >> 3) & 3) * 64 + (wid & 1) * 32 + (lane >> 5) * 16);
#define DMA(t, buf) DMAX(Kh, Vh, t, buf)
#define DMAX(KP, VP, t, buf) do { const char* kb_ = (const char*)((KP) + (size_t)(t) * SHM_K8); const char* vb_ = (const char*)((VP) + (size_t)(t) * SHM_V8); asm volatile("" : "+s"(kb_), "+s"(vb_)); \
    __builtin_amdgcn_global_load_lds((const unsigned*)(kb_ + koff), (ldsu_t)(K_lds + (buf) * SHM_K8 + wid * 1024), 16, 0, 0); \
    __builtin_amdgcn_global_load_lds((const unsigned*)(vb_ + voff), (ldsu_t)(V_lds + (buf) * SHM_V8 + wid * 1024), 16, 0, 0); } while (0)
#define WAIT_BAR(N) asm volatile("s_waitcnt vmcnt(" #N ") lgkmcnt(0)\n\ts_barrier" ::: "memory")
#define RESC(a) do { if (__any((a) < 1.f)) { _Pragma("unroll") for (int d = 0; d < 4; ++d) _Pragma("unroll") for (int r = 0; r < 16; ++r) o[d][r] *= (a); lacc[0] *= (a); lacc[1] *= __uint_as_float(__builtin_amdgcn_ds_bpermute(((lane + 16) & 63) * 4, __float_as_uint(a))); } } while (0)
#define QLOAD(QP, DST) do { const unsigned char* Qw = (QP) + (long)(wq * 32 + r32) * QKW + mm * 64 + hi * 32; \
    const u32x4 q0 = *reinterpret_cast<const u32x4*>(Qw), q1 = *reinterpret_cast<const u32x4*>(Qw + 16); \
    DST = (i32x8){(int)q0.x, (int)q0.y, (int)q0.z, (int)q0.w, (int)q1.x, (int)q1.y, (int)q1.z, (int)q1.w}; } while (0)
  if (first) { DMA(0, 0); DMA(1, 1); QLOAD(Qb, qf); } else qf = qcarry;
  const int vb0 = (int)(uintptr_t)V_lds + lane * 16, ka0 = (int)(uintptr_t)K_lds + mm * 4096 + lane * 16;
  f32x16 pA0, pA1, pB0, pB1; float alA, alB; i32x8 pb; constexpr int NTL = KVLEN / KVBLK;
  WAIT_BAR(0);
  DMA(2, 2);
  qkt(pA0, pA1, K_lds, qf, lane, mm, negm); partialSM<true>(pA0, pA1, m_reg, negm, alA);
  WAIT_BAR(2);
  for (int j = 1; j + 1 < NTL; j += 2) {
    DMA(j + 2, (j + 2) & 3);
    SBAR(); tile_step(o, lacc, onesA, ka0 + (j & 3) * SHM_K8, vb0 + ((j - 1) & 3) * SHM_V8, qf, pB0, pB1, pA0, pA1, m_reg, negm, alB);
    RESC(alB);
    WAIT_BAR(2);
    if (j + 3 < NTL) DMA(j + 3, (j + 3) & 3);
    SBAR(); tile_step(o, lacc, onesA, ka0 + ((j + 1) & 3) * SHM_K8, vb0 + (j & 3) * SHM_V8, qf, pA0, pA1, pB0, pB1, m_reg, negm, alA);
    RESC(alA);
    if (j + 3 < NTL) WAIT_BAR(2); else WAIT_BAR(0);
  }
  if (has_next) { DMAX(Kn, Vn, 0, 0); DMAX(Kn, Vn, 1, 1); QLOAD(Qn, qcarry); }
  SBAR(); qkt(pB0, pB1, K_lds + ((NTL - 1) & 3) * SHM_K8, qf, lane, mm, negm);
  finishSM_T(pA0, pA1, pb); SBAR();
  pv_psm(o, lacc, onesA, vb0 + ((NTL - 2) & 3) * SHM_V8, pb, pB0, pB1, m_reg, negm, alB);
  RESC(alB);
  finishSM_T(pB0, pB1, pb); SBAR();
  pvT_d0(o, lacc, onesA, vb0 + ((NTL - 1) & 3) * SHM_V8, pb);
#undef DMA
#undef DMAX
#undef QLOAD
#undef WAIT_BAR
  const float l0_ = __uint_as_float(__builtin_amdgcn_ds_bpermute((lane & 15) * 4, __float_as_uint(lacc[0]))), l1_ = __uint_as_float(__builtin_amdgcn_ds_bpermute((lane & 15) * 4, __float_as_uint(lacc[1])));
  const float rl = __builtin_amdgcn_rcpf((lane & 16) ? l1_ : l0_) * (mm ? lam : 1.0f);
  constexpr int XS = 132;
  float* X = (float*)(lds + 65536);
#define LBAR() asm volatile("s_waitcnt lgkmcnt(0)\n\ts_barrier" ::: "memory")
  if (mm == 1) {
#pragma unroll
    for (int r = 0; r < 16; ++r)
#pragma unroll
      for (int d0 = 0; d0 < 4; ++d0) X[(wq * 32 + r32) * XS + d0 * 32 + crow(r, hi)] = o[d0][r] * rl;
  }
  LBAR();
  if (mm == 0) {
#pragma unroll
    for (int r = 0; r < 16; ++r)
#pragma unroll
      for (int d0 = 0; d0 < 4; ++d0) { float* xp = X + (wq * 32 + r32) * XS + d0 * 32 + crow(r, hi); *xp = o[d0][r] * rl - *xp; }
  }
  LBAR();
  {
    const int row = tid >> 2, seg = tid & 3;
    const float* xr = X + row * XS + seg * 32;
    f32x4 v[8]; float ss = 0.f;
#pragma unroll
    for (int i = 0; i < 8; ++i) { v[i] = *(const f32x4*)(xr + 4 * i); ss += v[i][0] * v[i][0] + v[i][1] * v[i][1] + v[i][2] * v[i][2] + v[i][3] * v[i][3]; }
    ss += sx<1>(ss); ss += sx<2>(ss);
    const float rs = (1.0f - LAM_INIT) / sqrtf(ss * (1.0f / 128.0f) + EPS);
    unsigned char* dst = (unsigned char*)Ob + (long)row * D + seg * 32;
#pragma unroll
    for (int i = 0; i < 8; i += 4) {
      u32x4 w;
#pragma unroll
      for (int q = 0; q < 4; ++q) { const f32x4 g0 = *(const f32x4*)(gsub + seg * 32 + 4 * (i + q));
        w[q] = (unsigned)pk4f8(v[i + q][0] * rs * g0[0], v[i + q][1] * rs * g0[1], v[i + q][2] * rs * g0[2], v[i + q][3] * rs * g0[3]); }
      *(u32x4*)(dst + 4 * i) = w;
    }
  }
  LBAR();
#undef LBAR
#undef RESC
}
#undef KSWZ
#undef SBAR
}

__device__ __forceinline__ void ph_attn(const Params& p, unsigned char* smem) {
    unsigned char* ws = p.ws;
    const unsigned char* Q = ws + WS_Q; const unsigned char* Kb = ws + WS_K; const unsigned char* Vb = ws + WS_V;
    bf16_t* AO = (bf16_t*)(ws + WS_AO);
    const float lam = ((const float*)(ws + WS_CTL))[1024];
    const int c = blockIdx.x, G = gridDim.x;
    fa::i32x8 qc = {};
    if (G == 256) {
        const int x = c & 7, s = c >> 3;
#pragma unroll 1
        for (int rd = 0; rd < 6; ++rd) {
            const int bh = rd * 4 + (x >> 1), qb = (x & 1) * 32 + s, b = bh / NH, h = bh % NH;
            const int rn = rd < 5 ? rd + 1 : rd, bhn = rn * 4 + (x >> 1), bn = bhn / NH, hn = bhn % NH;
            fa::attn_unit(Q + ((size_t)b * SEQ + qb * 128) * QKW + h * 128, Kb + (size_t)(b * NH + h) * (KVLEN / 64) * 8192, Vb + (size_t)(b * NH + h) * (KVLEN / 64) * 8192,
                          (bf16_t*)((unsigned char*)AO + ((size_t)b * SEQ + qb * 128) * D + 256 + h * 128), p.in[I_GSUB], lam, (char*)smem, p.chunk,
                          Q + ((size_t)bn * SEQ + qb * 128) * QKW + hn * 128, Kb + (size_t)(bn * NH + hn) * (KVLEN / 64) * 8192, Vb + (size_t)(bn * NH + hn) * (KVLEN / 64) * 8192, rd == 0, rd < 5, qc);
        }
    } else {
        for (int u = c; u < BATCH * NH * 64; u += G) {
            const int bh = u >> 6, qb = u & 63, b = bh / NH, h = bh % NH;
            const unsigned char* q_ = Q + ((size_t)b * SEQ + qb * 128) * QKW + h * 128; const unsigned char* k_ = Kb + (size_t)(b * NH + h) * (KVLEN / 64) * 8192; const unsigned char* v_ = Vb + (size_t)(b * NH + h) * (KVLEN / 64) * 8192;
            fa::attn_unit(q_, k_, v_, (bf16_t*)((unsigned char*)AO + ((size_t)b * SEQ + qb * 128) * D + 256 + h * 128), p.in[I_GSUB], lam, (char*)smem, p.chunk, q_, k_, v_, true, false, qc);
            __syncthreads();
        }
    }
    __syncthreads();
}

__device__ __forceinline__ void ph_fourierA(const Params& p, unsigned char* smem) {
    using namespace fa;
    unsigned char* ws = p.ws;
    const bf16_t* F = (const bf16_t*)(ws + WS_F); bf16_t* FY = (bf16_t*)(ws + WS_FY); const bf16_t* W = (const bf16_t*)(ws + WS_W128E);
    const int tid = otid(), wid = tid >> 6, lane = tid & 63, r32 = lane & 31, hi = lane >> 5;
    const int sr = tid >> 4, sc = (tid & 15) * 8, vst0 = v_st(sr, sc), vst1 = v_st(32 + sr, sc);
    const int vb0 = (int)(uintptr_t)smem + v_rd_base(lane);
    for (int task = blockIdx.x; task < BATCH * 64; task += gridDim.x) {
        const int b = task >> 6, n2 = task & 63;
        bf16x8 st[4][2];
#pragma unroll
        for (int kt = 0; kt < 2; ++kt)
#pragma unroll
            for (int ct = 0; ct < 2; ++ct) {
                st[kt * 2 + ct][0] = __builtin_nontemporal_load((const bf16x8*)(F + ((size_t)b * SEQ + 64 * (64 * kt + sr) + n2) * 256 + 128 * ct + sc));
                st[kt * 2 + ct][1] = __builtin_nontemporal_load((const bf16x8*)(F + ((size_t)b * SEQ + 64 * (64 * kt + 32 + sr) + n2) * 256 + 128 * ct + sc));
            }
        bf16x8 pa[2][4];
#pragma unroll
        for (int kt = 0; kt < 2; ++kt)
#pragma unroll
            for (int ks = 0; ks < 4; ++ks) pa[kt][ks] = *(const bf16x8*)(W + (size_t)(32 * wid + r32) * 128 + 64 * kt + 16 * ks + 8 * hi);
        __syncthreads();
#pragma unroll
        for (int q = 0; q < 4; ++q) { *(bf16x8*)(smem + q * 16384 + vst0) = st[q][0]; *(bf16x8*)(smem + q * 16384 + vst1) = st[q][1]; }
        __syncthreads();
        f32x16 o[2][4] = {};
#pragma unroll
        for (int ct = 0; ct < 2; ++ct)
#pragma unroll
            for (int kt = 0; kt < 2; ++kt) pv_d0(o[ct], vb0 + (kt * 2 + ct) * 16384, pa[kt][0], pa[kt][1], pa[kt][2], pa[kt][3]);
        const int plane = wid >> 2;
#pragma unroll
        for (int r = 0; r < 16; ++r) {
            const int k1 = 32 * (wid & 3) + crow(r, hi);
            bf16_t* dst = FY + ((((size_t)plane * BATCH + b) * 128 + k1) * 64 + n2) * 256 + r32;
#pragma unroll
            for (int ct = 0; ct < 2; ++ct)
#pragma unroll
                for (int d0 = 0; d0 < 4; ++d0) dst[128 * ct + 32 * d0] = f2bf(o[ct][d0][r]);
        }
    }
    __syncthreads();
}
__device__ __forceinline__ void ph_fourierB(const Params& p, unsigned char* smem) {
    using namespace fa;
    unsigned char* ws = p.ws;
    const bf16_t* FY = (const bf16_t*)(ws + WS_FY); const float2* tabw = (const float2*)(ws + WS_TABW);
    const bf16_t* M64 = (const bf16_t*)(ws + WS_M64E); const bf16_t* GT = (const bf16_t*)(ws + WS_GT);
    bf16_t* AO = (bf16_t*)(ws + WS_AO);
    const int tid = otid(), wid = tid >> 6, lane = tid & 63, r32 = lane & 31, hi = lane >> 5;
    const int sr = tid >> 4, sc = (tid & 15) * 8, vst0 = v_st(sr, sc), vst1 = v_st(32 + sr, sc);
    const int vb0 = (int)(uintptr_t)smem + v_rd_base(lane);
    constexpr int XRS = 528;
    unsigned char* XL = smem + 65536;
    const int mt = wid & 3, ctw = wid >> 2;
    for (int task = blockIdx.x; task < BATCH * 128; task += gridDim.x) {
        const int b = task >> 7, k1 = task & 127;
        __syncthreads();
#pragma unroll
        for (int ct = 0; ct < 2; ++ct)
#pragma unroll
            for (int rh = 0; rh < 2; ++rh) {
                const int n2 = sr + 32 * rh;
                const size_t off = ((((size_t)b) * 128 + k1) * 64 + n2) * 256 + 128 * ct + sc;
                const gp::u32x4 yr = __builtin_nontemporal_load((const gp::u32x4*)(FY + off)), yi = __builtin_nontemporal_load((const gp::u32x4*)(FY + (size_t)BATCH * 128 * 64 * 256 + off));
                const float2 tw = tabw[n2 * k1];
                const unsigned yrw[4] = {yr.x, yr.y, yr.z, yr.w}, yiw[4] = {yi.x, yi.y, yi.z, yi.w};
                unsigned zr[4], zi[4];
#pragma unroll
                for (int q = 0; q < 4; ++q) {
                    const float a0 = __uint_as_float(yrw[q] << 16), a1 = __uint_as_float(yrw[q] & 0xffff0000u), b0 = __uint_as_float(yiw[q] << 16), b1 = __uint_as_float(yiw[q] & 0xffff0000u);
                    zr[q] = pk2(a0 * tw.x + b0 * tw.y, a1 * tw.x + b1 * tw.y); zi[q] = pk2(b0 * tw.x - a0 * tw.y, b1 * tw.x - a1 * tw.y);
                }
                const int vs = rh ? vst1 : vst0;
                *(uint4*)(smem + (0 * 2 + ct) * 16384 + vs) = make_uint4(zr[0], zr[1], zr[2], zr[3]);
                *(uint4*)(smem + (1 * 2 + ct) * 16384 + vs) = make_uint4(zi[0], zi[1], zi[2], zi[3]);
            }
        __syncthreads();
        {
            f32x16 o[4] = {};
#pragma unroll
            for (int kt = 0; kt < 2; ++kt) {
                bf16x8 pa[4];
#pragma unroll
                for (int ks = 0; ks < 4; ++ks) pa[ks] = *(const bf16x8*)(M64 + (size_t)(32 * mt + r32) * 128 + 64 * kt + 16 * ks + 8 * hi);
                pv_d0(o, vb0 + (kt * 2 + ctw) * 16384, pa[0], pa[1], pa[2], pa[3]);
            }
#pragma unroll
            for (int r = 0; r < 16; ++r) {
                const int ro = 32 * mt + crow(r, hi);
                bf16_t* xr = (bf16_t*)(XL + ((ro >> 6) * 64 + (ro & 63)) * XRS) + 128 * ctw + r32;
#pragma unroll
                for (int d0 = 0; d0 < 4; ++d0) xr[32 * d0] = f2bf(o[d0][r]);
            }
        }
        __syncthreads();
#pragma unroll
        for (int tt = 0; tt < 2; ++tt) {
            const int tau = 2 * wid + tt, g = tau >> 2, mt2 = (tau >> 1) & 1, nt2 = tau & 1;
            f32x16 acc = {};
#pragma unroll
            for (int ks8 = 0; ks8 < 8; ++ks8) {
                const int part = ks8 >> 2, cb = ks8 & 3;
                const bf16x8 af = *(const bf16x8*)(XL + (part * 64 + 32 * mt2 + r32) * XRS + (g * 64 + 16 * cb + 8 * hi) * 2);
                const bf16x8 bfr = *(const bf16x8*)(GT + ((size_t)g * 64 + 32 * nt2 + r32) * 128 + part * 64 + 16 * cb + 8 * hi);
                acc = __builtin_amdgcn_mfma_f32_32x32x16_bf16(af, bfr, acc, 0, 0, 0);
            }
#pragma unroll
            for (int r = 0; r < 16; ++r) { const int k2 = 32 * mt2 + crow(r, hi);
                ((unsigned char*)AO)[((size_t)b * SEQ + k1 + 128 * k2) * D + g * 64 + 32 * nt2 + r32] = (unsigned char)__builtin_amdgcn_cvt_pk_fp8_f32(acc[r], acc[r], 0, false); }
        }
    }
    __syncthreads();
}

__device__ __forceinline__ void ph_mid(const Params& p, unsigned char* smem) {
    typedef short bf16x8 __attribute__((ext_vector_type(8)));
    unsigned char* ws = p.ws;
    const int tid = otid(), wave = tid >> 6, lane = tid & 63, fr = lane & 15, fq = lane >> 4;
    const float* mod = (const float*)(ws + WS_MOD);
    const bf16_t* YX = (const bf16_t*)(ws + WS_YX);
    unsigned char* H2 = ws + WS_H2;
    unsigned* counts = (unsigned*)(ws + WS_CTL);
    int* TE = (int*)(ws + WS_TE); int* TP = (int*)(ws + WS_TP); float* TW = (float*)(ws + WS_TW); int* TOKL = (int*)(ws + WS_TOKL);
    constexpr int RS = 2064;
    unsigned char* Ahi = smem; unsigned char* Alo = smem + 16 * RS; float* Pp = (float*)(smem + 2 * 16 * RS + 512);
    const float rbias = p.in[I_RB][lane];
    int* lcnt = (int*)(smem + 99328); int* gb = lcnt + 64; int* PE = gb + 64; float* PW = (float*)(PE + 1024); float* PV = PW + 1024;
    for (int chunk = blockIdx.x; chunk < T / 128; chunk += gridDim.x) {
      const int mc = chunk * 128, b = mc >> 13;
      if (tid < 64) lcnt[tid] = 0;
      {
          const float* mrow_ = mod + b * 6144;
          for (int i = tid; i < 5 * 256; i += NT) { const int v_ = i >> 8, q_ = (i & 255) * 4;
              const float* s_ = (v_ == 0) ? p.in[I_GAPOST] + q_ : (v_ == 1) ? mrow_ + 2 * 1024 + q_ : (v_ == 2) ? p.in[I_GFPRE] + q_ : (v_ == 3) ? mrow_ + 3 * 1024 + q_ : mrow_ + 4 * 1024 + q_;
              *(f32x4*)(PV + v_ * 1024 + q_) = *(const f32x4*)s_; }
          __syncthreads();
      }
      uint2 yw[2][4]; f32x4 xvA[2][4], xvB[2][4];
      bf16x8 wfr[3][4];
      { const bf16_t* wrt_ = (const bf16_t*)(ws + WS_WRT) + (size_t)p.chunk * 16 * 1024; asm volatile("" : "+s"(wrt_));
#pragma unroll
        for (int ks = 0; ks < 3; ++ks) {
#pragma unroll
          for (int nb = 0; nb < 4; ++nb) wfr[ks][nb] = *(const bf16x8*)(wrt_ + (size_t)((ks * 4 + nb) * 2 * 64 + lane) * 8);
          __builtin_amdgcn_sched_barrier(0); } }
#define MID_LOADY(m0_) do { _Pragma("unroll") for (int rr = 0; rr < 2; ++rr) { const int m_ = (m0_) + 2 * wave + rr; _Pragma("unroll") for (int j = 0; j < 4; ++j) \
          { const __attribute__((address_space(1))) gp::u32x2* yp_ = (const __attribute__((address_space(1))) gp::u32x2*)(YX + (size_t)m_ * D); const gp::u32x2 t_ = __builtin_nontemporal_load(yp_ + lane + 64 * j); yw[rr][j].x = t_.x; yw[rr][j].y = t_.y; } } } while (0)
#define MID_LOADX(m0_, XV_) do { _Pragma("unroll") for (int rr = 0; rr < 2; ++rr) { const int m_ = (m0_) + 2 * wave + rr; _Pragma("unroll") for (int j = 0; j < 4; ++j) \
          XV_[rr][j] = __builtin_nontemporal_load((const __attribute__((address_space(1))) f32x4*)(p.in[I_X] + (size_t)m_ * D) + lane + 64 * j); } } while (0)
      MID_LOADX(mc, xvA); MID_LOADY(mc);
      auto step = [&](const int it, f32x4 (&xv)[2][4], f32x4 (&xvn)[2][4]) __attribute__((always_inline)) {
        const int m0 = mc + it * 16;
        if (it < 7) MID_LOADX(m0 + 16, xvn);
        {
            float ss[2] = {0.f, 0.f};
#define YV(rr, j, i) ((i) == 0 ? __uint_as_float(yw[rr][j].x << 16) : (i) == 1 ? __uint_as_float(yw[rr][j].x & 0xffff0000u) : (i) == 2 ? __uint_as_float(yw[rr][j].y << 16) : __uint_as_float(yw[rr][j].y & 0xffff0000u))
#pragma unroll
            for (int rr = 0; rr < 2; ++rr) {
#pragma unroll
                for (int j = 0; j < 4; ++j) ss[rr] += YV(rr, j, 0) * YV(rr, j, 0) + YV(rr, j, 1) * YV(rr, j, 1) + YV(rr, j, 2) * YV(rr, j, 2) + YV(rr, j, 3) * YV(rr, j, 3);
                ss[rr] = wave_sum(ss[rr]);
            }
#pragma unroll
            for (int rr = 0; rr < 2; ++rr) {
                const int lr = 2 * wave + rr, m = m0 + lr;
                const float r1 = 1.0f / sqrtf(ss[rr] * (1.0f / D) + EPS);
                float ss2 = 0.f;
#pragma unroll
                for (int j = 0; j < 4; ++j) {
                    const int col = 4 * (lane + 64 * j);
                    const f32x4 gp = *(const f32x4*)(PV + col), gt = *(const f32x4*)(PV + 1024 + col);
#pragma unroll
                    for (int i = 0; i < 4; ++i) { xv[rr][j][i] = xv[rr][j][i] + gt[i] * (YV(rr, j, i) * r1 * gp[i]); ss2 += xv[rr][j][i] * xv[rr][j][i]; }
                    ((f32x4*)(p.out + (size_t)m * D))[lane + 64 * j] = xv[rr][j];
                }
                ss2 = wave_sum(ss2);
                const float r2 = 1.0f / sqrtf(ss2 * (1.0f / D) + EPS);
#pragma unroll
                for (int j = 0; j < 4; ++j) {
                    const int col = 4 * (lane + 64 * j);
                    const f32x4 gp = *(const f32x4*)(PV + 2048 + col), sh = *(const f32x4*)(PV + 3072 + col), sc = *(const f32x4*)(PV + 4096 + col);
                    float h[4];
#pragma unroll
                    for (int i = 0; i < 4; ++i) h[i] = xv[rr][j][i] * r2 * gp[i] * (1.f + sc[i]) + sh[i];
                    uint2 o; o.x = pk2(h[0], h[1]); o.y = pk2(h[2], h[3]);
                    { const int w8 = pk4f8(h[0], h[1], h[2], h[3]); *(int*)(H2 + (size_t)m * D + col) = w8; }
                    *(uint2*)(Ahi + lr * RS + col * 2) = o;
                }
            }
            if (it < 7) MID_LOADY(m0 + 16);
        }
        asm volatile("s_waitcnt lgkmcnt(0)\n\ts_barrier" ::: "memory");
        {
            f32x4 acc[4];
#pragma unroll
            for (int nb = 0; nb < 4; ++nb) acc[nb] = (f32x4){0.f, 0.f, 0.f, 0.f};
#pragma unroll
            for (int ks = 0; ks < 4; ++ks) {
                const int ko = (wave * 128 + ks * 32 + 8 * fq) * 2;
                const bf16x8 ah = *(const bf16x8*)(Ahi + fr * RS + ko);
#pragma unroll
                for (int nb = 0; nb < 4; ++nb) { const bf16x8 wf_ = (ks < 3) ? wfr[ks < 3 ? ks : 0][nb] : *(const bf16x8*)((const bf16_t*)(ws + WS_WRT) + (size_t)p.chunk * 16 * 1024 + (size_t)((12 + nb) * 2 * 64 + lane) * 8);
                    acc[nb] = __builtin_amdgcn_mfma_f32_16x16x32_bf16(ah, wf_, acc[nb], 0, 0, 0); }
            }
#pragma unroll
            for (int nb = 0; nb < 4; ++nb)
#pragma unroll
                for (int j = 0; j < 4; ++j) Pp[(wave * 16 + 4 * fq + j) * 64 + 16 * nb + fr] = acc[nb][j];
        }
        asm volatile("s_waitcnt lgkmcnt(0)\n\ts_barrier" ::: "memory");
#pragma unroll
        for (int rr = 0; rr < 2; ++rr) {
            const int lr = 2 * wave + rr;
            float lg = 0.f;
#pragma unroll
            for (int w = 0; w < 8; ++w) lg += Pp[(w * 16 + lr) * 64 + lane];
            const float score = 1.0f / (1.0f + expf(-lg));
            const float sel = score + rbias;
            float t1 = sel, t2 = -INFINITY;
#define TOP2(M) do { const float o1 = sx<M>(t1), o2 = sx<M>(t2); const float n1 = fmaxf(t1, o1), n2 = fmaxf(fminf(t1, o1), fmaxf(t2, o2)); t1 = n1; t2 = n2; } while (0)
            TOP2(1); TOP2(2); TOP2(4);
#undef TOP2
            const float gs = t1 + t2; const int grp = lane >> 3;
            int gr = 0;
#pragma unroll
            for (int j = 0; j < 8; ++j) { const float sj = __uint_as_float(__builtin_amdgcn_readlane(__float_as_uint(gs), j * 8)); gr += (sj > gs || (sj == gs && j < grp)) ? 1 : 0; }
            const bool gsel = gr < 4;
            float v = gsel ? sel : -INFINITY;
            int rk = TOPK;
#pragma unroll
            for (int it8 = 0; it8 < TOPK; ++it8) {
                const float mx = wave_max(v);
                const unsigned long long eq = __ballot(v == mx);
                const int win = __builtin_ctzll(eq);
                if (lane == win) { rk = it8; v = -INFINITY; }
            }
            const bool chosen = rk < TOPK;
            const float ssum = wave_sum(chosen ? score : 0.f);
            const float w = score / (ssum + 1e-20f) * 2.5f;
            if (chosen) {
                const int lpos = atomicAdd(&lcnt[lane], 1);
                const int idx = (it * 16 + lr) * 8 + rk;
                PE[idx] = lane | (lpos << 8); PW[idx] = w;
            }
        }
      };
#pragma unroll 1
      for (int it2 = 0; it2 < 8; it2 += 2) { step(it2, xvA, xvB); step(it2 + 1, xvB, xvA); }
      __syncthreads();
      if (tid < 64) { const int c = lcnt[tid]; gb[tid] = c ? (int)atomicAdd(&counts[b * 65 + tid], (unsigned)c) : 0; }
      __syncthreads();
      for (int i = tid; i < 1024; i += NT) {
          const int pe = PE[i], e = pe & 255, pos = gb[e] + (pe >> 8), mk = mc * 8 + i;
          TOKL[((size_t)b * 64 + e) * 8192 + pos] = mk; TE[mk] = e; TP[mk] = pos; TW[mk] = PW[i];
      }
      __syncthreads();
    }
}

constexpr int T_CNT = 0;
constexpr int T_TOT = 256;
constexpr int T_AB = 328;
constexpr int T_OFF = 400;
constexpr int T_GUP = 660;
constexpr int T_YC = 730;
constexpr int T_YB = 990;
constexpr int T_DUP = 1250;
constexpr int T_UL = 1520;
constexpr int T_END = 1520 + 512;
__device__ __forceinline__ int scan_incl(int v, int lane) {
#pragma unroll
    for (int off = 1; off < 64; off <<= 1) { const int t = __builtin_amdgcn_ds_bpermute(((lane - off) & 63) << 2, v); if (lane >= off) v += t; }
    return v;
}
__device__ __forceinline__ void build_moe(const Params& p, int* tab) {
    const unsigned* counts = (const unsigned*)(p.ws + WS_CTL);
    __syncthreads();
    const int tid = otid(), wave = tid >> 6, lane = tid & 63;
    if (wave == 0) {
        const int c0 = (int)counts[0 * 65 + lane], c1 = (int)counts[1 * 65 + lane], c2 = (int)counts[2 * 65 + lane], c3 = (int)counts[3 * 65 + lane];
        tab[T_CNT + 0 * 64 + lane] = c0; tab[T_CNT + 1 * 64 + lane] = c1; tab[T_CNT + 2 * 64 + lane] = c2; tab[T_CNT + 3 * 64 + lane] = c3;
        tab[T_OFF + lane * 4 + 0] = 0; tab[T_OFF + lane * 4 + 1] = c0; tab[T_OFF + lane * 4 + 2] = c0 + c1; tab[T_OFF + lane * 4 + 3] = c0 + c1 + c2;
        const int tot = c0 + c1 + c2 + c3, pad = (tot + 255) & ~255, gu = ((tot + 255) >> 8) * 2;
        const int sp = scan_incl(pad, lane), sg = scan_incl(gu, lane);
        tab[T_TOT + lane] = tot; tab[T_AB + lane] = sp - pad; tab[T_GUP + lane] = sg - gu;
        const int cb[4] = {c0, c1, c2, c3};
#pragma unroll
        for (int b = 0; b < 4; ++b) {
            const int du = ((cb[b] + 255) >> 8) * 4;
            const int sy = scan_incl(cb[b], lane), sd = scan_incl(du, lane);
            tab[T_YB + 65 * b + lane] = sy - cb[b]; tab[T_DUP + 66 * b + lane] = sd - du;
            if (lane == 63) { tab[T_YB + 65 * b + 64] = sy; tab[T_DUP + 66 * b + 64] = sd; tab[T_DUP + 66 * b + 65] = sd + (SEQ / 256) * 4; }
        }
        if (lane == 63) { tab[T_TOT + 64] = T; tab[T_AB + 64] = sp; tab[T_GUP + 64] = sg; tab[T_GUP + 65] = sg + (T / 256) * 2; }
    }
    __syncthreads();
}

__device__ __forceinline__ void moe_decode(const GP_LAS int* tab, int e, int pos_e, int& b, int& pos) {
    const int o1 = tab[T_OFF + e * 4 + 1], o2 = tab[T_OFF + e * 4 + 2], o3 = tab[T_OFF + e * 4 + 3];
    b = (pos_e >= o1 ? 1 : 0) + (pos_e >= o2 ? 1 : 0) + (pos_e >= o3 ? 1 : 0);
    pos = pos_e - (b == 0 ? 0 : (b == 1 ? o1 : (b == 2 ? o2 : o3)));
}
__device__ __forceinline__ int yrow0(int b) { return b == 0 ? 2 * 1024 : (272 + 72 * (b - 1)) * 1024; }
struct MoeSched {
    const GP_LAS int* tab; int G, c, ntn, U, down, chunk; const int* TOKL; const char* Bt;
    __device__ __forceinline__ void prepare(int* tabw, int wv) const {
        if (wv == 0) {
            const int i = lane_id(); int L = i * G + c;
            if (L < U) {
                int bt = 0;
                if (down) {
#pragma unroll
                    for (int q = 0; q < 3; ++q) { const int u0 = tabw[T_DUP + 66 * bt + 65]; if (L >= u0) { L -= u0; ++bt; } } }
                const int pre = down ? T_DUP + 66 * bt : T_GUP;
                int lo = 0, hi = 64;
                while (lo < hi) { const int mid = (lo + hi + 1) >> 1; if (tabw[pre + mid] <= L) lo = mid; else hi = mid - 1; }
                const int loc = L - tabw[pre + lo];
                int cnt, base, bb;
                if (down) { cnt = (lo < 64) ? tabw[T_CNT + bt * 64 + (lo & 63)] : SEQ; base = tabw[T_YB + 65 * bt + lo] + yrow0(bt);
                            bb = tabw[T_AB + lo] + (lo < 64 ? tabw[T_OFF + (lo & 63) * 4 + bt] : bt * SEQ); }
                else { cnt = tabw[T_TOT + lo]; base = tabw[T_AB + lo]; bb = 0; }
                int* ul = tabw + T_UL + 8 * i;
                ul[0] = lo; ul[1] = loc / ntn; ul[2] = loc % ntn; ul[3] = cnt; ul[4] = base; ul[5] = bb;
            }
        }
        __syncthreads();
    }
    __device__ __forceinline__ bool next(int i, gp::Unit& u) const {
        if (i * G + c >= U) return false;
        const GP_LAS int* ul = tab + T_UL + 8 * i;
        u.e = __builtin_amdgcn_readfirstlane(ul[0]); u.pm = __builtin_amdgcn_readfirstlane(ul[1]); u.pn = __builtin_amdgcn_readfirstlane(ul[2]);
        u.cnt = __builtin_amdgcn_readfirstlane(ul[3]); u.base = __builtin_amdgcn_readfirstlane(ul[4]); u.b = __builtin_amdgcn_readfirstlane(ul[5]);
        return true;
    }
    __device__ __forceinline__ unsigned arow(const gp::Unit& u, int r) const {
        const int pos_e = u.pm * 256 + r;
        if (down) return (unsigned)(u.b + pos_e) * 256u;
        int tok;
        if (u.e < 64) { int b, pos; moe_decode(tab, u.e, pos_e, b, pos); tok = (pos_e < u.cnt) ? (TOKL[((size_t)b * 64 + u.e) * 8192 + pos] >> 3) : 0; } else tok = pos_e;
        return (unsigned)tok * 1024u;
    }
    __device__ __forceinline__ size_t abase(const gp::Unit& u) const { return (size_t)(u.b + u.pm * 256) * 256; }
    __device__ __forceinline__ const char* bptr(const gp::Unit& u) const {
        return down ? Bt + ((size_t)u.e * 1024 + u.pn * 256) * 256 : Bt + ((size_t)u.e * 512 + u.pn * 256) * 1024;
    }
};
struct EpiGU {
    unsigned char* ACT; const int* TOKL; const float* TW; const GP_LAS int* tab;
    __device__ __forceinline__ void operator()(const f32x4 (&acc)[2][2][4][2], const gp::Unit& u, int wr, int wc, int fr, int fq) const {
#pragma unroll
        for (int ai = 0; ai < 2; ++ai)
#pragma unroll
            for (int m = 0; m < 4; ++m) {
                const int pos_e = u.pm * 256 + ai * 128 + wr * 64 + m * 16 + fr;
                if (pos_e < u.cnt) {
                    float a[8];
#pragma unroll
                    for (int n = 0; n < 2; ++n)
#pragma unroll
                        for (int i = 0; i < 4; ++i) { const float g = acc[ai][0][m][n][i] * (1.f / GUSCALE), up = acc[ai][1][m][n][i] * (1.f / GUSCALE);
                            a[4 * n + i] = __builtin_amdgcn_fmed3f(g * __builtin_amdgcn_rcpf(1.0f + __builtin_amdgcn_exp2f(-1.4426950408889634f * g)) * up, -448.f, 448.f); }
                    const int w0 = pk4f8(a[0], a[1], a[2], a[3]), w1 = pk4f8(a[4], a[5], a[6], a[7]);
                    gp::gst2(ACT + ((size_t)u.base + pos_e) * DE + u.pn * 128 + wc * 32 + fq * 8, (unsigned)w0, (unsigned)w1);
                }
            }
    }
};
constexpr float YSCALE = 16.f;
static_assert(YSCALE == WDSCALE * ASCALE, "the down accumulators leave unscaled: Y = YSCALE * y");
struct EpiDown {
    unsigned char* ws;
    __device__ __forceinline__ void operator()(const f32x4 (&acc)[2][2][4][2], const gp::Unit& u, int wr, int wc, int fr, int fq) const {
#pragma unroll
        for (int ai = 0; ai < 2; ++ai)
#pragma unroll
            for (int m = 0; m < 4; ++m) {
                const int pos = u.pm * 256 + ai * 128 + wr * 64 + m * 16 + fr;
                if (pos < u.cnt) {
                    unsigned char* rowp = ws + (size_t)(u.base + pos) * D + u.pn * 256 + wc * 64 + fq * 16;
                    gp::u32x4 o;
#pragma unroll
                    for (int bj = 0; bj < 2; ++bj) { const f32x4 v0 = acc[ai][bj][m][0], v1 = acc[ai][bj][m][1];
                        const int w0 = pk4f8(v0[0], v0[1], v0[2], v0[3]), w1 = pk4f8(v1[0], v1[1], v1[2], v1[3]);
                        if (bj == 0) { o.x = (unsigned)w0; o.y = (unsigned)w1; } else { o.z = (unsigned)w0; o.w = (unsigned)w1; } }
                    gp::gst4_nt(rowp, o);
                }
            }
    }
};
__device__ __forceinline__ void ph_moe_gu(const Params& p, unsigned char* smem) {
    unsigned char* ws = p.ws;
    int* tab = (int*)(smem + gp::STAGE_BYTES);
    build_moe(p, tab);
    MoeSched S; S.tab = (const GP_LAS int*)tab; S.G = gridDim.x; S.c = (gridDim.x % 8 == 0) ? (int)((blockIdx.x % 8) * (gridDim.x / 8) + blockIdx.x / 8) : (int)blockIdx.x;   S.ntn = 2; S.U = __builtin_amdgcn_readfirstlane(tab[T_GUP + 65]); S.down = 0; S.chunk = 0;
    S.TOKL = (const int*)(ws + WS_TOKL); S.Bt = (const char*)(ws + WS_WGUT);
    S.prepare(tab, p.chunk);
    EpiGU E{ws + WS_ACT, (const int*)(ws + WS_TOKL), (const float*)(ws + WS_TW), (const GP_LAS int*)tab};
    gp::gemm_phase<EpiGU, MoeSched, true, true>(p.chunk, (GP_LAS unsigned char*)smem, (const char*)(ws + WS_H2), D / 2, S, E);
}
__device__ __forceinline__ void ph_moe_down(const Params& p, unsigned char* smem, int c) {
    unsigned char* ws = p.ws;
    int* tab = (int*)(smem + gp::STAGE_BYTES);
    __syncthreads();
    MoeSched S; S.tab = (const GP_LAS int*)tab; S.G = gridDim.x; S.c = (gridDim.x % 8 == 0) ? (int)((blockIdx.x % 8) * (gridDim.x / 8) + blockIdx.x / 8) : (int)blockIdx.x;   S.ntn = 4; S.U = __builtin_amdgcn_readfirstlane(tab[T_DUP + 65] + tab[T_DUP + 66 + 65] + tab[T_DUP + 132 + 65] + tab[T_DUP + 198 + 65]); S.down = 1; S.chunk = c;
    S.TOKL = nullptr; S.Bt = (const char*)(ws + WS_WDT);
    S.prepare(tab, p.chunk);
    EpiDown E{ws};
    gp::gemm_phase<EpiDown, MoeSched, false, true, 0, true>(p.chunk, (GP_LAS unsigned char*)smem, (const char*)(ws + WS_ACT), DE / 2, S, E);
}

__device__ __forceinline__ void ph_final(const Params& p, float* lds) {
    unsigned char* ws = p.ws;
    int* tab = (int*)((unsigned char*)lds + gp::STAGE_BYTES);
    __syncthreads();
    const int tid = otid(), wave = tid >> 6, lane = tid & 63;
    const int gw = blockIdx.x * NWV + wave, GW = gridDim.x * NWV;
    const int* TE = (const int*)(ws + WS_TE); const int* TP = (const int*)(ws + WS_TP); const float* TW = (const float*)(ws + WS_TW);
    const unsigned char* Y = ws;
    for (int m = gw; m < T; m += GW) {
        const int b = m >> 13, t = m & (SEQ - 1);
        const float* mod = (const float*)(ws + WS_MOD) + b * 6144 + 5 * 1024;
        float acc[16];
#pragma unroll
        for (int i = 0; i < 16; ++i) acc[i] = 0.f;
#pragma unroll
        for (int k = 0; k < 9; ++k) {
            int row; float wk = 1.f;
            if (k < 8) { const int e = TE[m * 8 + k]; row = tab[T_YB + 65 * b + e] + TP[m * 8 + k]; wk = TW[m * 8 + k]; }
            else row = tab[T_YB + 65 * b + 64] + t;
            row += yrow0(b);
            const unsigned char* yr = Y + (size_t)row * D;
#pragma unroll
            for (int j = 0; j < 4; ++j) { const int w = __builtin_nontemporal_load((const int*)(yr + 4 * (lane + 64 * j)));
                acc[4 * j] += wk * __builtin_amdgcn_cvt_f32_fp8(w, 0); acc[4 * j + 1] += wk * __builtin_amdgcn_cvt_f32_fp8(w, 1); acc[4 * j + 2] += wk * __builtin_amdgcn_cvt_f32_fp8(w, 2); acc[4 * j + 3] += wk * __builtin_amdgcn_cvt_f32_fp8(w, 3); }
        }
        float ss = 0.f;
#pragma unroll
        for (int i = 0; i < 16; ++i) { acc[i] *= (1.f / YSCALE); ss += acc[i] * acc[i]; }
        ss = wave_sum(ss);
        const float rs = 1.0f / sqrtf(ss * (1.0f / D) + EPS);
#pragma unroll
        for (int j = 0; j < 4; ++j) {
            const int col = 256 * j + 128 * ((lane >> 1) & 1) + 32 * (lane >> 4) + 8 * ((lane >> 2) & 3) + 4 * (lane & 1);
            const f32x4 gp = *(const f32x4*)(p.in[I_GFPOST] + col), gt = *(const f32x4*)(mod + col);
            f32x4 x1 = __builtin_nontemporal_load((const f32x4*)(p.out + (size_t)m * D + col));
#pragma unroll
            for (int i = 0; i < 4; ++i) x1[i] += gt[i] * (acc[4 * j + i] * rs * gp[i]);
            __builtin_nontemporal_store(x1, (f32x4*)(p.out + (size_t)m * D + col));
        }
    }
}

#define GAS __attribute__((address_space(1)))
#define LAS __attribute__((address_space(3)))
#define XB_TMO      128
#define XB_XCNT(j)  (256  + 64 * (j))
#define XB_XSUB(j)  (1280 + 64 * (j))
#define XB_XGEN(j)  (2304 + 64 * (j))
#define XB_TOP      3328
#define XB_TOPGEN   3392
#define XCD_BAR_WORDS 3456
#define XB_SPIN_CAP (1u << 21)
__device__ __forceinline__ unsigned xb_ld(unsigned* p)              { return __hip_atomic_load(p, __ATOMIC_RELAXED, __HIP_MEMORY_SCOPE_AGENT); }
__device__ __forceinline__ unsigned xb_add(unsigned* p, unsigned v) { return __hip_atomic_fetch_add(p, v, __ATOMIC_RELAXED, __HIP_MEMORY_SCOPE_AGENT); }
__device__ __forceinline__ unsigned xb_xcc_id() { return (unsigned)__builtin_amdgcn_s_getreg((3 << 11) | 20) & 0xFu; }
#define XB_SPIN(cond, bar) do { unsigned _sp = 0; while (cond) { __builtin_amdgcn_s_sleep(1); \
    if ((++_sp & 255u) == 0u) { if (xb_ld(&(bar)[XB_TMO])) break; if (_sp > XB_SPIN_CAP) { atomicAdd(&(bar)[XB_TMO], 1u); break; } } } } while (0)
struct XcdBarrier { unsigned* bar; unsigned x; volatile LAS unsigned* st; };
__device__ __forceinline__ XcdBarrier xcd_barrier_post(unsigned* bar, volatile LAS unsigned* st, int wv) {
    XcdBarrier b; b.bar = bar; b.x = xb_xcc_id(); b.st = st;
    if (wv == 0 && lane_id() == 0) (void)xb_add(&bar[XB_XCNT(b.x)], 1u);
    return b;
}
__device__ __forceinline__ void xcd_barrier_complete(unsigned* bar, unsigned x, unsigned& nloc, unsigned& nx) {
    const unsigned G = gridDim.x * gridDim.y * gridDim.z;
    unsigned sum, cnt, mine, sp = 0u;
    for (;;) {
        sum = 0u; cnt = 0u; mine = 0u;
#pragma unroll
        for (unsigned j = 0; j < 16; ++j) { const unsigned c = xb_ld(&bar[XB_XCNT(j)]); sum += c; cnt += (c > 0u) ? 1u : 0u; mine = (j == x) ? c : mine; }
        if (sum == G) break;
        __builtin_amdgcn_s_sleep(1);
        if ((++sp & 255u) == 0u) { if (xb_ld(&bar[XB_TMO])) break; if (sp > XB_SPIN_CAP) { atomicAdd(&bar[XB_TMO], 1u); break; } }
    }
    nloc = mine > 0u ? mine : 1u; nx = cnt > 0u ? cnt : 1u;
}
__device__ __forceinline__ void xcd_barrier(const XcdBarrier& b, int wv) {
    asm volatile("s_waitcnt vmcnt(0)" ::: "memory");
    __syncthreads();
    if (wv == 0 && lane_id() == 0) {
        unsigned* bar = b.bar;
        __builtin_amdgcn_s_waitcnt(0);
        unsigned nloc = b.st[0], nx = b.st[1];
        if (nloc == 0u) { xcd_barrier_complete(bar, b.x, nloc, nx); b.st[0] = nloc; b.st[1] = nx; }
        const unsigned old = xb_add(&bar[XB_XSUB(b.x)], 1u);
        const unsigned gen = old / nloc;
        if (old + 1u == (gen + 1u) * nloc) {
            __builtin_amdgcn_fence(__ATOMIC_RELEASE, "agent");
            asm volatile("s_waitcnt vmcnt(0)" ::: "memory");
            const unsigned og = xb_add(&bar[XB_TOP], 1u);
            const unsigned tg = og / nx;
            if (og + 1u == (tg + 1u) * nx) xb_add(&bar[XB_TOPGEN], 1u);
            else XB_SPIN(xb_ld(&bar[XB_TOPGEN]) == tg, bar);
            __builtin_amdgcn_fence(__ATOMIC_ACQUIRE, "agent");
            xb_add(&bar[XB_XGEN(b.x)], 1u);
            asm volatile("s_waitcnt vmcnt(0)" ::: "memory");
        } else {
            XB_SPIN(xb_ld(&bar[XB_XGEN(b.x)]) == gen, bar);
            __builtin_amdgcn_fence(__ATOMIC_ACQUIRE, "agent");
            asm volatile("s_waitcnt vmcnt(0)" ::: "memory");
        }
    }
    __syncthreads();
}

namespace cg = cooperative_groups;
constexpr int LDS_BYTES = 144 * 1024;
typedef const __attribute__((address_space(4))) Params* KP;
__device__ __forceinline__ Params kargs() {
    Params p;
#if defined(__HIP_DEVICE_COMPILE__)
    typedef const __attribute__((address_space(4))) unsigned long long* KQ;
    KQ kq = (KQ)__builtin_amdgcn_kernarg_segment_ptr(); asm volatile("" : "+s"(kq));
    unsigned long long* d = (unsigned long long*)&p;
#pragma unroll
    for (int i = 0; i < (int)(sizeof(Params) / 8); ++i) d[i] = kq[i];
#endif
    return p;
}
#define PH(call) do { Params p = kargs(); p.chunk = wv; call; } while (0)
__global__ void __launch_bounds__(NT) mega_fwd(Params p_unused) {
    extern __shared__ __attribute__((aligned(16))) unsigned char smem[];
    float* lds = (float*)smem;
    volatile LAS unsigned* misc = (volatile LAS unsigned*)((LAS unsigned char*)smem + (LDS_BYTES - 64));
    if (threadIdx.x < 16) misc[threadIdx.x] = 0u;
    __syncthreads();
    unsigned* barw; { const Params p = kargs(); barw = (unsigned*)(p.ws + WS_CTL) + 4096; }
    const int wv = __builtin_amdgcn_readfirstlane(threadIdx.x >> 6);
    const XcdBarrier bar = xcd_barrier_post(barw, misc, wv);
#define SYNC() xcd_barrier(bar, wv)
    PH(ph_prep(p, lds));            SYNC();
    PH(ph_norm1(p)); PH(ph_prep_weights(p, lds, 0, 0));   SYNC();
    {
        const int first_ = (MTOT / 256) * (INW / 256) % (int)gridDim.x, mid_ = first_ + ((int)gridDim.x - first_) / 2;
        const bool early_ = (int)blockIdx.x >= first_ && (int)blockIdx.x < mid_;
        if (early_) { PH(ph_prep_weights(p, lds, 1, first_)); __syncthreads(); }
        PH(ph_inproj(p, smem));
        if (!early_) PH(ph_prep_weights(p, lds, 1, first_));
    }
    SYNC();
    PH(ph_attn(p, smem)); PH(ph_fourierA(p, smem));  SYNC();
    PH(ph_fourierB(p, smem));       SYNC();
    PH(ph_outproj(p, smem));        SYNC();
    PH(ph_mid(p, smem));            SYNC();
    PH(ph_moe_gu(p, smem));         SYNC();
#pragma unroll 1
    PH(ph_moe_down(p, smem, 0));    SYNC();
    PH(ph_final(p, lds));
#undef SYNC
}

extern "C" void kernel_launch(void* const* d_in, const int* in_sizes, int n_in, void* d_out, int out_size, void* d_ws, size_t ws_size, hipStream_t stream) {
    if (n_in != 26 || ws_size < WS_END) { fprintf(stderr, "kernel_launch: unexpected n_in %d / ws %zu\n", n_in, ws_size); return; }
    static int grid_blocks = 0;
    if (!grid_blocks) {
        int dev = 0, cus = 0, per_cu = 0;
        (void)hipGetDevice(&dev);
        (void)hipDeviceGetAttribute(&cus, hipDeviceAttributeMultiprocessorCount, dev);
        (void)hipFuncSetAttribute((const void*)mega_fwd, hipFuncAttributeMaxDynamicSharedMemorySize, LDS_BYTES);
        (void)hipOccupancyMaxActiveBlocksPerMultiprocessor(&per_cu, (const void*)mega_fwd, NT, LDS_BYTES);
        if (per_cu < 1) { fprintf(stderr, "kernel_launch: occupancy query says %d blocks/CU\n", per_cu); per_cu = 1; }
        if (per_cu > 1) per_cu = 1;
        grid_blocks = cus * per_cu;
    }
    Params p{};
    for (int i = 0; i < 26; ++i) p.in[i] = (const float*)d_in[i];
    p.out = (float*)d_out; p.ws = (unsigned char*)d_ws; p.chunk = 0; p.pad = 0;
    (void)hipMemsetAsync((char*)d_ws + WS_CTL, 0, 32768, stream);
    void* args[] = {&p};
    hipError_t e = hipLaunchCooperativeKernel((const void*)mega_fwd, dim3(grid_blocks), dim3(NT), args, LDS_BYTES, stream);
    if (e != hipSuccess) fprintf(stderr, "cooperative launch failed: %s (grid %d)\n", hipGetErrorString(e), grid_blocks);
}
```
